# Optimizing an MI355X kernel written in HIP

```python
import math
import jax
import jax.numpy as jnp
from jax import lax
import numpy as np

D_MODEL = 2048
BATCH = 4
SEQ = 2048
DEPTH = 2

CTX_LEN = 256
GRID_W = 64
BLOCK = 128
NORM_EPS = 1e-6
ROPE_THETA = 10000.0

MLA_HEADS = 8
MLA_NOPE = 128
MLA_ROPE = 64
MLA_V = 128
MLA_Q_LORA = 768
MLA_KV_LORA = 512

HY_WIDTH = 512
HY_SHORT = 3
HY_BANDS = 16
HY_EMB = 1 + 2 * HY_BANDS
HY_FILTER_HIDDEN = 64
HY_DECAY_TARGET = 1e-2
HY_QUICK_DECAY_PCT = 0.3
HY_SLOW_DECAY_PCT = 1.5
HY_FILTER_OUT_SCALE = 0.02

SWA_HEADS = 8
SWA_KV_HEADS = 2
SWA_HEAD_DIM = 64
SWA_WINDOW = 128

IN_SIZES = (MLA_Q_LORA, MLA_KV_LORA, MLA_ROPE, 3 * HY_WIDTH, SWA_HEADS * SWA_HEAD_DIM, SWA_KV_HEADS * SWA_HEAD_DIM, SWA_KV_HEADS * SWA_HEAD_DIM)
IN_WIDTH = sum(IN_SIZES)
MIX_WIDTH = MLA_HEADS * MLA_V + HY_WIDTH + SWA_HEADS * SWA_HEAD_DIM

D_FF = 5632
N_EXPERTS = 8
TOP_K = 2
D_FF_EXPERT = 7168

kernel_name = "hybrid_mla_hyena_swa_moe_dit_block"


def rms_norm(x, g):
    xf = x.astype(jnp.float32)
    y = xf * lax.rsqrt(jnp.mean(xf * xf, axis=-1, keepdims=True) + NORM_EPS)
    return (y * g.astype(jnp.float32)).astype(x.dtype)


def modulate(h, shift, scale):
    return h * (1.0 + scale) + shift


def axial_rope(L, dim):
    rows = L // GRID_W
    row = jnp.repeat(jnp.arange(rows), GRID_W).astype(jnp.float32)
    col = jnp.tile(jnp.arange(GRID_W), rows).astype(jnp.float32)
    quarter = dim // 4
    freqs = ROPE_THETA ** (-jnp.arange(quarter, dtype=jnp.float32) / quarter)
    ang = jnp.concatenate([row[:, None] * freqs[None], col[:, None] * freqs[None]], axis=-1)
    return jnp.cos(ang), jnp.sin(ang)


def apply_rope(x, cos, sin):
    half = x.shape[-1] // 2
    x1, x2 = x[..., :half], x[..., half:]
    c = cos[None, :, None, :].astype(x.dtype)
    s = sin[None, :, None, :].astype(x.dtype)
    return jnp.concatenate([x1 * c - x2 * s, x1 * s + x2 * c], axis=-1)


def split_in(u):
    offs = [int(o) for o in np.cumsum(IN_SIZES)[:-1]]
    return jnp.split(u, offs, axis=-1)


def mla_queries(cq, g_q, w_q_up, rope):
    B, L, _ = cq.shape
    q = (rms_norm(cq, g_q) @ w_q_up).reshape(B, L, MLA_HEADS, MLA_NOPE + MLA_ROPE)
    q_nope, q_pe = q[..., :MLA_NOPE], q[..., MLA_NOPE:]
    if rope is not None:
        q_pe = apply_rope(q_pe, *rope)
    return jnp.concatenate([q_nope, q_pe], axis=-1)


def mla_keys_values(ckv, k_pe, g_kv, w_kv_up, rope):
    B, L, _ = ckv.shape
    kv = (rms_norm(ckv, g_kv) @ w_kv_up).reshape(B, L, MLA_HEADS, MLA_NOPE + MLA_V)
    k_nope, v = kv[..., :MLA_NOPE], kv[..., MLA_NOPE:]
    k_pe = k_pe[:, :, None, :]
    if rope is not None:
        k_pe = apply_rope(k_pe, *rope)
    k = jnp.concatenate([k_nope, jnp.broadcast_to(k_pe, k_nope.shape[:-1] + (MLA_ROPE,))], axis=-1)
    return k, v


def full_attention(q, k, v, scale):
    B, Lq, H, _ = q.shape
    s = jnp.einsum('bqhd,bkhd->bhqk', q, k).astype(jnp.float32) * scale
    p = jax.nn.softmax(s, axis=-1).astype(v.dtype)
    return jnp.einsum('bhqk,bkhd->bqhd', p, v).reshape(B, Lq, H * v.shape[-1])


def blockwise_attention(q, k, v, scale):
    B, L, H, dk = q.shape
    nb = L // BLOCK
    qb = jnp.moveaxis(q.reshape(B, nb, BLOCK, H, dk), 1, 0)

    def one_block(qi):
        s = jnp.einsum('bqhd,bkhd->bhqk', qi, k).astype(jnp.float32) * scale
        p = jax.nn.softmax(s, axis=-1).astype(v.dtype)
        return jnp.einsum('bhqk,bkhd->bqhd', p, v)

    o = lax.map(one_block, qb)
    return jnp.moveaxis(o, 0, 1).reshape(B, L, H * v.shape[-1])


def short_conv(u, w, b):
    ch = u.shape[-1]
    y = lax.conv_general_dilated(u, w[:, None, :].astype(u.dtype), window_strides=(1,),
                                 padding=((HY_SHORT // 2, HY_SHORT // 2),),
                                 dimension_numbers=('NWC', 'WIO', 'NWC'), feature_group_count=ch)
    return y + b


def hyena_filters(L, w1, b1, w2, b2, w3, b3, w_filt, freq):
    pos = jnp.arange(L, dtype=jnp.float32)
    t = pos / max(L - 1, 1)
    bands = jnp.linspace(1e-4, HY_BANDS - 1, HY_BANDS, dtype=jnp.float32)
    ang = (2.0 * math.pi / L) * pos[:, None] * bands[None]
    z = jnp.concatenate([t[:, None], jnp.cos(ang), -jnp.sin(ang)], axis=-1).astype(w1.dtype)
    h = jnp.sin(freq * (z @ w1 + b1))
    h = jnp.sin(freq * (h @ w2 + b2))
    h = jnp.sin(freq * (h @ w3 + b3))
    h = h @ w_filt
    deltas = jnp.linspace(math.log(HY_DECAY_TARGET) / HY_SLOW_DECAY_PCT,
                          math.log(HY_DECAY_TARGET) / HY_QUICK_DECAY_PCT, HY_WIDTH, dtype=jnp.float32)
    decay = jnp.exp(-t[:, None] * jnp.abs(deltas)[None])
    h = h * jnp.concatenate([decay, decay], axis=-1).astype(h.dtype)
    return h[:, :HY_WIDTH], h[:, HY_WIDTH:]


def bidir_long_conv(u, h_f, h_b, skip):
    L, ch = h_f.shape
    taps = jnp.concatenate([h_f, jnp.zeros((1, ch), h_f.dtype), h_b[:0:-1]], axis=0).astype(jnp.float32)
    uf = jnp.fft.rfft(u.astype(jnp.float32), n=2 * L, axis=1)
    tf = jnp.fft.rfft(taps, n=2 * L, axis=0)
    y = jnp.fft.irfft(uf * tf[None], n=2 * L, axis=1)[:, :L]
    return (y + u.astype(jnp.float32) * skip.astype(jnp.float32)).astype(u.dtype)


def hyena_mixer(u, conv_w, conv_b, filt, skip):
    u = short_conv(u, conv_w, conv_b)
    x0, x1, v = jnp.split(u, 3, axis=-1)
    v = bidir_long_conv(v * x1, filt[0], filt[1], skip)
    return x0 * v


def swa_latent(q, k, v, kc, vc, sink):
    B, L, Hq, d = q.shape
    Hk = k.shape[2]
    G = Hq // Hk
    nb = L // BLOCK
    scale = d ** -0.5
    qb = q.reshape(B, nb, BLOCK, Hk, G, d)
    padw = ((0, 0), (BLOCK, BLOCK), (0, 0), (0, 0))
    kp = jnp.pad(k, padw).reshape(B, nb + 2, BLOCK, Hk, d)
    vp = jnp.pad(v, padw).reshape(B, nb + 2, BLOCK, Hk, d)
    kw = jnp.concatenate([kp[:, :-2], kp[:, 1:-1], kp[:, 2:]], axis=2)
    vw = jnp.concatenate([vp[:, :-2], vp[:, 1:-1], vp[:, 2:]], axis=2)
    s_loc = jnp.einsum('bnqhgd,bnkhd->bnhgqk', qb, kw).astype(jnp.float32) * scale
    q_pos = jnp.arange(L).reshape(nb, BLOCK)
    k_pos = (jnp.arange(nb)[:, None] - 1) * BLOCK + jnp.arange(3 * BLOCK)[None]
    valid = ((jnp.abs(q_pos[:, :, None] - k_pos[:, None, :]) <= SWA_WINDOW)
             & (k_pos >= 0)[:, None, :] & (k_pos < L)[:, None, :])
    s_loc = jnp.where(valid[None, :, None, None], s_loc, -jnp.inf)
    s_ctx = jnp.einsum('bnqhgd,bkhd->bnhgqk', qb, kc).astype(jnp.float32) * scale
    s_sink = jnp.broadcast_to(sink.reshape(Hk, G)[None, None, :, :, None, None].astype(jnp.float32),
                              s_loc.shape[:-1] + (1,))
    p = jax.nn.softmax(jnp.concatenate([s_loc, s_ctx, s_sink], axis=-1), axis=-1)
    W = 3 * BLOCK
    C = kc.shape[1]
    p_loc = p[..., :W].astype(v.dtype)
    p_ctx = p[..., W:W + C].astype(v.dtype)
    o = (jnp.einsum('bnhgqk,bnkhd->bnqhgd', p_loc, vw)
         + jnp.einsum('bnhgqk,bkhd->bnqhgd', p_ctx, vc))
    return o.reshape(B, L, Hq * d)


def sink_attention(q, k, v, sink):
    B, L, Hq, d = q.shape
    Hk = k.shape[2]
    G = Hq // Hk
    qg = q.reshape(B, L, Hk, G, d)
    s = jnp.einsum('bqhgd,bkhd->bhgqk', qg, k).astype(jnp.float32) * (d ** -0.5)
    s_sink = jnp.broadcast_to(sink.reshape(Hk, G)[None, :, :, None, None].astype(jnp.float32), s.shape[:-1] + (1,))
    p = jax.nn.softmax(jnp.concatenate([s, s_sink], axis=-1), axis=-1)[..., :-1].astype(v.dtype)
    return jnp.einsum('bhgqk,bkhd->bqhgd', p, v).reshape(B, L, Hq * d)


def mixer(h_lat, h_ctx, lp, need_ctx):
    B, L, _ = h_lat.shape
    C = h_ctx.shape[1]
    rope_mla = axial_rope(L, MLA_ROPE)
    rope_swa = axial_rope(L, SWA_HEAD_DIM)
    mla_scale = (MLA_NOPE + MLA_ROPE) ** -0.5
    cq_l, ckv_l, kpe_l, hy_l, sq_l, sk_l, sv_l = split_in(h_lat @ lp['w_in'])
    cq_c, ckv_c, kpe_c, hy_c, sq_c, sk_c, sv_c = split_in(h_ctx @ lp['w_in'])

    k_l, v_l = mla_keys_values(ckv_l, kpe_l, lp['g_kv'], lp['w_kv_up'], rope_mla)
    k_c, v_c = mla_keys_values(ckv_c, kpe_c, lp['g_kv'], lp['w_kv_up'], None)
    q_l = mla_queries(cq_l, lp['g_q'], lp['w_q_up'], rope_mla)
    a_l = blockwise_attention(q_l, jnp.concatenate([k_l, k_c], axis=1), jnp.concatenate([v_l, v_c], axis=1), mla_scale)

    filt_l = hyena_filters(L, lp['hy_w1'], lp['hy_b1'], lp['hy_w2'], lp['hy_b2'], lp['hy_w3'], lp['hy_b3'],
                           lp['hy_w_filt'], lp['hy_freq'])
    y_l = hyena_mixer(hy_l, lp['hy_conv_w'], lp['hy_conv_b'], filt_l, lp['hy_skip'])

    sq_l = apply_rope(sq_l.reshape(B, L, SWA_HEADS, SWA_HEAD_DIM), *rope_swa)
    sk_l = apply_rope(sk_l.reshape(B, L, SWA_KV_HEADS, SWA_HEAD_DIM), *rope_swa)
    sv_l = sv_l.reshape(B, L, SWA_KV_HEADS, SWA_HEAD_DIM)
    sk_c = sk_c.reshape(B, C, SWA_KV_HEADS, SWA_HEAD_DIM)
    sv_c = sv_c.reshape(B, C, SWA_KV_HEADS, SWA_HEAD_DIM)
    s_l = swa_latent(sq_l, sk_l, sv_l, sk_c, sv_c, lp['swa_sink'])

    out_lat = jnp.concatenate([a_l, y_l, s_l], axis=-1) @ lp['w_out']
    if not need_ctx:
        return out_lat, None

    q_c = mla_queries(cq_c, lp['g_q'], lp['w_q_up'], None)
    a_c = full_attention(q_c, k_c, v_c, mla_scale)
    filt_c = hyena_filters(C, lp['hy_w1'], lp['hy_b1'], lp['hy_w2'], lp['hy_b2'], lp['hy_w3'], lp['hy_b3'],
                           lp['hy_w_filt'], lp['hy_freq'])
    y_c = hyena_mixer(hy_c, lp['hy_conv_w'], lp['hy_conv_b'], filt_c, lp['hy_skip'])
    s_c = sink_attention(sq_c.reshape(B, C, SWA_HEADS, SWA_HEAD_DIM), sk_c, sv_c, lp['swa_sink'])
    out_ctx = jnp.concatenate([a_c, y_c, s_c], axis=-1) @ lp['w_out']
    return out_lat, out_ctx


def swiglu(x, w_gate, w_up, w_down):
    return (jax.nn.silu(x @ w_gate) * (x @ w_up)) @ w_down


def moe_swiglu(x, router, w_gate, w_up, w_down):
    logits = (x @ router).astype(jnp.float32)
    top_v, top_i = lax.top_k(logits, TOP_K)
    top_w = jax.nn.softmax(top_v, axis=-1)
    gates = jnp.sum(jax.nn.one_hot(top_i, N_EXPERTS, dtype=jnp.float32) * top_w[..., None], axis=-2).astype(x.dtype)
    y = jnp.zeros_like(x)
    for e in range(N_EXPERTS):
        y = y + gates[..., e:e + 1] * swiglu(x, w_gate[e], w_up[e], w_down[e])
    return y


def setup_inputs(seed: int = 0) -> dict:
    key = jax.random.key(seed)
    ks = iter(jax.random.split(key, 48))
    f32 = jnp.float32
    D = D_MODEL
    FH = HY_FILTER_HIDDEN
    n_dense = (DEPTH + 1) // 2
    n_moe = DEPTH // 2

    def nrm(shape, scale):
        return jax.random.normal(next(ks), shape, f32) * scale

    def gain(shape):
        return 1.0 + 0.1 * jax.random.normal(next(ks), shape, f32)

    return {
        "x": nrm((BATCH, SEQ, D), 1.0),
        "c": nrm((BATCH, D), 1.0),
        "ctx": nrm((BATCH, CTX_LEN, D), 1.0),
        "c_ctx": nrm((D,), 1.0),
        "w_mod": nrm((DEPTH, D, 6 * D), 0.5 * D ** -0.5),
        "b_mod": nrm((DEPTH, 6 * D), 0.02),
        "g_mix": gain((DEPTH, D)),
        "g_ffn": gain((DEPTH, D)),
        "w_in": nrm((DEPTH, D, IN_WIDTH), D ** -0.5),
        "g_q": gain((DEPTH, MLA_Q_LORA)),
        "w_q_up": nrm((DEPTH, MLA_Q_LORA, MLA_HEADS * (MLA_NOPE + MLA_ROPE)), MLA_Q_LORA ** -0.5),
        "g_kv": gain((DEPTH, MLA_KV_LORA)),
        "w_kv_up": nrm((DEPTH, MLA_KV_LORA, MLA_HEADS * (MLA_NOPE + MLA_V)), MLA_KV_LORA ** -0.5),
        "hy_conv_w": nrm((DEPTH, HY_SHORT, 3 * HY_WIDTH), HY_SHORT ** -0.5),
        "hy_conv_b": nrm((DEPTH, 3 * HY_WIDTH), 0.02),
        "hy_w1": nrm((DEPTH, HY_EMB, FH), HY_EMB ** -0.5),
        "hy_b1": nrm((DEPTH, FH), 0.02),
        "hy_w2": nrm((DEPTH, FH, FH), FH ** -0.5),
        "hy_b2": nrm((DEPTH, FH), 0.02),
        "hy_w3": nrm((DEPTH, FH, FH), FH ** -0.5),
        "hy_b3": nrm((DEPTH, FH), 0.02),
        "hy_w_filt": nrm((DEPTH, FH, 2 * HY_WIDTH), HY_FILTER_OUT_SCALE),
        "hy_freq": gain((DEPTH, FH)),
        "hy_skip": nrm((DEPTH, HY_WIDTH), 1.0),
        "swa_sink": nrm((DEPTH, SWA_HEADS), 1.0),
        "w_out": nrm((DEPTH, MIX_WIDTH, D), MIX_WIDTH ** -0.5),
        "ffn_w_gate": nrm((n_dense, D, D_FF), D ** -0.5),
        "ffn_w_up": nrm((n_dense, D, D_FF), D ** -0.5),
        "ffn_w_down": nrm((n_dense, D_FF, D), D_FF ** -0.5),
        "moe_router": nrm((n_moe, D, N_EXPERTS), D ** -0.5),
        "moe_w_gate": nrm((n_moe, N_EXPERTS, D, D_FF_EXPERT), D ** -0.5),
        "moe_w_up": nrm((n_moe, N_EXPERTS, D, D_FF_EXPERT), D ** -0.5),
        "moe_w_down": nrm((n_moe, N_EXPERTS, D_FF_EXPERT, D), D_FF_EXPERT ** -0.5),
        "g_final": gain((D,)),
    }


def reference(x, c, ctx, c_ctx, w_mod, b_mod, g_mix, g_ffn, w_in, g_q, w_q_up, g_kv, w_kv_up,
              hy_conv_w, hy_conv_b, hy_w1, hy_b1, hy_w2, hy_b2, hy_w3, hy_b3, hy_w_filt, hy_freq, hy_skip,
              swa_sink, w_out, ffn_w_gate, ffn_w_up, ffn_w_down, moe_router, moe_w_gate, moe_w_up, moe_w_down,
              g_final):
    x_lat, x_ctx = x, ctx
    for l in range(DEPTH):
        last = l == DEPTH - 1
        sh1, sc1, g1, sh2, sc2, g2 = [m[:, None, :] for m in jnp.split(jax.nn.silu(c) @ w_mod[l] + b_mod[l], 6, axis=-1)]
        sh1c, sc1c, g1c, sh2c, sc2c, g2c = jnp.split(jax.nn.silu(c_ctx) @ w_mod[l] + b_mod[l], 6, axis=-1)
        lp = dict(w_in=w_in[l], g_q=g_q[l], w_q_up=w_q_up[l], g_kv=g_kv[l], w_kv_up=w_kv_up[l],
                  hy_conv_w=hy_conv_w[l], hy_conv_b=hy_conv_b[l], hy_w1=hy_w1[l], hy_b1=hy_b1[l],
                  hy_w2=hy_w2[l], hy_b2=hy_b2[l], hy_w3=hy_w3[l], hy_b3=hy_b3[l], hy_w_filt=hy_w_filt[l],
                  hy_freq=hy_freq[l], hy_skip=hy_skip[l], swa_sink=swa_sink[l], w_out=w_out[l])
        h_lat = modulate(rms_norm(x_lat, g_mix[l]), sh1, sc1)
        h_ctx = modulate(rms_norm(x_ctx, g_mix[l]), sh1c, sc1c)
        y_lat, y_ctx = mixer(h_lat, h_ctx, lp, not last)
        x_lat = x_lat + g1 * y_lat
        if not last:
            x_ctx = x_ctx + g1c * y_ctx

        if l % 2 == 0:
            i = l // 2
            f_lat = swiglu(modulate(rms_norm(x_lat, g_ffn[l]), sh2, sc2), ffn_w_gate[i], ffn_w_up[i], ffn_w_down[i])
            if not last:
                f_ctx = swiglu(modulate(rms_norm(x_ctx, g_ffn[l]), sh2c, sc2c), ffn_w_gate[i], ffn_w_up[i], ffn_w_down[i])
        else:
            i = l // 2
            f_lat = moe_swiglu(modulate(rms_norm(x_lat, g_ffn[l]), sh2, sc2), moe_router[i], moe_w_gate[i], moe_w_up[i], moe_w_down[i])
            if not last:
                f_ctx = moe_swiglu(modulate(rms_norm(x_ctx, g_ffn[l]), sh2c, sc2c), moe_router[i], moe_w_gate[i], moe_w_up[i], moe_w_down[i])
        x_lat = x_lat + g2 * f_lat
        if not last:
            x_ctx = x_ctx + g2c * f_ctx
    return rms_norm(x_lat, g_final)
```

```cpp
#include <hip/hip_runtime.h>
#include <stdint.h>
#include <stdio.h>

typedef unsigned short bf16_t;
typedef float f32x4 __attribute__((ext_vector_type(4)));
typedef unsigned u32x4 __attribute__((ext_vector_type(4)));
typedef unsigned u32x2 __attribute__((ext_vector_type(2)));

constexpr int D = 2048, NB = 4, L = 2048, C = 256, NLAT = NB * L, NCTX = NB * C, NTOK = NLAT + NCTX;
constexpr int UW = 3840;
constexpr int O_CQ = 0, O_CKV = 768, O_KPE = 1280, O_HY = 1344, O_SQ = 2880, O_SK = 3392, O_SV = 3520, INW = 3648;
constexpr int QW = 1536, KVW = 2048, DFF = 5632, DFE = 7168, NE = 8;
constexpr int MOE_ROWS = 18432;
constexpr float EPS = 1e-6f;

__device__ __forceinline__ float bf2f(bf16_t h) { return __uint_as_float(((unsigned)h) << 16); }
__device__ __forceinline__ bf16_t f2bf(float f) { unsigned u = __float_as_uint(f); u += 0x7fffu + ((u >> 16) & 1u); return (bf16_t)(u >> 16); }
__device__ __forceinline__ float wave_sum(float v) { for (int o = 32; o > 0; o >>= 1) v += __shfl_xor(v, o); return v; }
__device__ __forceinline__ float wave_max(float v) { for (int o = 32; o > 0; o >>= 1) v = fmaxf(v, __shfl_xor(v, o)); return v; }
__device__ __forceinline__ float silu(float x) { return x / (1.0f + __expf(-x)); }
__device__ __forceinline__ int tok_mod(int tok) { return tok < NLAT ? (tok >> 11) : 4; }

constexpr size_t al(size_t x) { return (x + 255) & ~(size_t)255; }
constexpr size_t WS_CTL = 0;
constexpr size_t WS_MOD = 65536;
constexpr size_t WS_ROPE = WS_MOD + al((size_t)2 * 5 * 12288 * 4);
constexpr size_t WS_FILTL = WS_ROPE + al((size_t)2 * 2048 * 32 * 4);
constexpr size_t WS_FILTC = WS_FILTL + al((size_t)2 * 512 * 4096 * 4);
constexpr size_t WS_HA = WS_FILTC + al((size_t)2 * 512 * 512 * 4);
constexpr size_t WS_U = WS_HA + al((size_t)NTOK * D * 2);
constexpr size_t WS_CQN = WS_U + al((size_t)NTOK * UW * 2);
constexpr size_t WS_CKVN = WS_CQN + al((size_t)NTOK * 768 * 2);
constexpr size_t WS_KPE = WS_CKVN + al((size_t)NTOK * 512 * 2);
constexpr size_t WS_X0 = WS_KPE + al((size_t)NTOK * 64 * 2);
constexpr size_t WS_WTL = WS_X0 + al((size_t)NTOK * 512 * 2);
constexpr size_t WS_WTC = WS_WTL + al((size_t)NB * 512 * L * 2);
constexpr size_t WS_SQ = WS_WTC + al((size_t)NB * 512 * C * 2);
constexpr size_t WS_SK = WS_SQ + al((size_t)NTOK * 512 * 2);
constexpr size_t WS_SV = WS_SK + al((size_t)NTOK * 128 * 2);
constexpr size_t WS_Q = WS_SV + al((size_t)NTOK * 128 * 2);
constexpr size_t WS_KV = WS_Q + al((size_t)NTOK * QW * 2);
constexpr size_t WS_MIX = WS_KV + al((size_t)NTOK * KVW * 2);
constexpr size_t WS_XS = WS_MIX + al((size_t)NTOK * D * 2);
constexpr size_t WS_ACT = WS_XS + al((size_t)NTOK * D * 4);
constexpr size_t WS_HBS = WS_ACT + al((size_t)MOE_ROWS * DFE * 2);
constexpr size_t WS_YS = WS_HBS + al((size_t)MOE_ROWS * D * 2);
constexpr size_t WS_TOPI = WS_YS + al((size_t)MOE_ROWS * D * 4);
constexpr size_t WS_TOPW = WS_TOPI + al((size_t)NLAT * 2 * 4);
constexpr size_t WS_POS = WS_TOPW + al((size_t)NLAT * 2 * 4);
constexpr size_t WS_SRC = WS_POS + al((size_t)NLAT * 2 * 4);
constexpr size_t WS_END = WS_SRC + al((size_t)MOE_ROWS * 4);
constexpr int CT_EOFF = 1024, CT_EPAD = 1040;

__global__ void k_rope_table(float* cosT, float* sinT) {
    const int i = blockIdx.x * blockDim.x + threadIdx.x;
    if (i >= 2048 * 32) return;
    const int t = i >> 5, f = i & 31;
    const float pos = (float)((f < 16) ? (t >> 6) : (t & 63));
    const float freq = powf(10000.0f, -(float)(f & 15) / 16.0f);
    const float ang = pos * freq;
    cosT[i] = cosf(ang); sinT[i] = sinf(ang);
}

__global__ void __launch_bounds__(512) k_adaln(const float* __restrict__ c, const float* __restrict__ cctx, const float* __restrict__ w_mod,
                                               const float* __restrict__ b_mod, float* __restrict__ mod) {
    __shared__ float sm[10240];
    const int tid = threadIdx.x, l = blockIdx.x / 96, chunk = blockIdx.x % 96;
    const int cg = tid & 31, ks = tid >> 5;
    for (int i = tid; i < 5 * 2048; i += 512) { const int v = i >> 11, k = i & 2047; const float val = v < 4 ? c[v * 2048 + k] : cctx[k]; sm[i] = val / (1.0f + expf(-val)); }
    __syncthreads();
    float acc[5][4];
#pragma unroll
    for (int v = 0; v < 5; ++v)
#pragma unroll
        for (int j = 0; j < 4; ++j) acc[v][j] = 0.f;
    const float* wp = w_mod + ((size_t)l * 2048 + (size_t)ks * 128) * 12288 + chunk * 128 + cg * 4;
    for (int kk = 0; kk < 128; ++kk) {
        const f32x4 w = *(const f32x4*)(wp + (size_t)kk * 12288);
        const int k = ks * 128 + kk;
#pragma unroll
        for (int v = 0; v < 5; ++v) { const float s = sm[v * 2048 + k];
#pragma unroll
            for (int j = 0; j < 4; ++j) acc[v][j] += s * w[j]; }
    }
    __syncthreads();
#pragma unroll
    for (int v = 0; v < 5; ++v)
#pragma unroll
        for (int j = 0; j < 4; ++j) sm[(ks * 5 + v) * 128 + cg * 4 + j] = acc[v][j];
    __syncthreads();
    for (int o = tid; o < 640; o += 512) {
        const int v = o >> 7, cc = o & 127; float s = 0.f;
        for (int k2 = 0; k2 < 16; ++k2) s += sm[(k2 * 5 + v) * 128 + cc];
        mod[((size_t)l * 5 + v) * 12288 + chunk * 128 + cc] = s + b_mod[(size_t)l * 12288 + chunk * 128 + cc];
    }
}

__global__ void __launch_bounds__(512) k_filters(const float* __restrict__ w1, const float* __restrict__ b1, const float* __restrict__ w2, const float* __restrict__ b2,
                                                 const float* __restrict__ w3, const float* __restrict__ b3, const float* __restrict__ wf, const float* __restrict__ fr,
                                                 float* __restrict__ filtL, float* __restrict__ filtC) {
    __shared__ float zs[8][36]; __shared__ float ha[8][64]; __shared__ float hb[8][64];
    const int tid = threadIdx.x, l = blockIdx.x / 288, r = blockIdx.x % 288;
    const bool lat = r < 256; const int Lf = lat ? 2048 : 256; const int p0 = lat ? r * 8 : (r - 256) * 8;
    float* T = lat ? filtL + (size_t)l * 512 * 4096 : filtC + (size_t)l * 512 * 512;
    w1 += l * 33 * 64; b1 += l * 64; w2 += l * 64 * 64; b2 += l * 64; w3 += l * 64 * 64; b3 += l * 64; wf += (size_t)l * 64 * 1024; fr += l * 64;
    const int p = tid >> 6, j = tid & 63; const int pos = p0 + p;
    const float tn = (float)pos / (float)(Lf - 1);
    if (j < 33) {
        float z;
        if (j == 0) z = tn;
        else { const int bi = (j - 1) & 15; const float band = 1e-4f + (float)bi * ((15.0f - 1e-4f) / 15.0f);
               const float ang = (6.283185307179586f / (float)Lf) * (float)pos * band; z = (j <= 16) ? cosf(ang) : -sinf(ang); }
        zs[p][j] = z;
    }
    __syncthreads();
    const float f = fr[j];
    { float s = b1[j]; for (int i = 0; i < 33; ++i) s += zs[p][i] * w1[i * 64 + j]; ha[p][j] = sinf(f * s); }
    __syncthreads();
    { float s = b2[j]; for (int i = 0; i < 64; ++i) s += ha[p][i] * w2[i * 64 + j]; hb[p][j] = sinf(f * s); }
    __syncthreads();
    { float s = b3[j]; for (int i = 0; i < 64; ++i) s += hb[p][i] * w3[i * 64 + j]; ha[p][j] = sinf(f * s); }
    __syncthreads();
#pragma unroll
    for (int rr = 0; rr < 2; ++rr) {
        const int o = tid + rr * 512; float acc[8];
#pragma unroll
        for (int q = 0; q < 8; ++q) acc[q] = 0.f;
        for (int i = 0; i < 64; ++i) { const float w = wf[i * 1024 + o];
#pragma unroll
            for (int q = 0; q < 8; ++q) acc[q] += ha[q][i] * w; }
        const int ch = o & 511; const bool back = o >= 512;
        const float delta = 3.0701134573253944f + (float)ch * ((15.350567286626972f - 3.0701134573253944f) / 511.0f);
#pragma unroll
        for (int q = 0; q < 8; ++q) {
            const int ps = p0 + q; const float t2 = (float)ps / (float)(Lf - 1);
            const float val = acc[q] * expf(-t2 * delta);
            if (!back) T[(size_t)ch * (2 * Lf) + Lf + ps] = val;
            else if (ps > 0) T[(size_t)ch * (2 * Lf) + Lf - ps] = val;
            else T[(size_t)ch * (2 * Lf)] = 0.f;
        }
    }
}

template <bool ROUTER>
__global__ void __launch_bounds__(512) k_normmod(const float* __restrict__ xlat, const float* __restrict__ xctx, const float* __restrict__ gain,
                                                 const float* __restrict__ modl, int sh_off, int sc_off, bf16_t* __restrict__ out, int nrows,
                                                 const float* __restrict__ router, int* __restrict__ topi, float* __restrict__ topw) {
    const int lane = threadIdx.x & 63, wid = threadIdx.x >> 6;
    for (int row = blockIdx.x * 8 + wid; row < nrows; row += gridDim.x * 8) {
        const float* xr = row < NLAT ? xlat + (size_t)row * D : xctx + (size_t)(row - NLAT) * D;
        const float* mv = modl + (size_t)tok_mod(row) * 12288;
        f32x4 v[8]; float ss = 0.f;
#pragma unroll
        for (int i = 0; i < 8; ++i) { v[i] = *(const f32x4*)(xr + i * 256 + lane * 4); ss += v[i][0] * v[i][0] + v[i][1] * v[i][1] + v[i][2] * v[i][2] + v[i][3] * v[i][3]; }
        ss = wave_sum(ss);
        const float rstd = rsqrtf(ss * (1.0f / D) + EPS);
        float lg[8];
#pragma unroll
        for (int e = 0; e < 8; ++e) lg[e] = 0.f;
#pragma unroll
        for (int i = 0; i < 8; ++i) {
            const int col = i * 256 + lane * 4;
            const f32x4 g = *(const f32x4*)(gain + col), sc = *(const f32x4*)(mv + sc_off + col), sh = *(const f32x4*)(mv + sh_off + col);
            f32x4 o;
#pragma unroll
            for (int j = 0; j < 4; ++j) o[j] = (v[i][j] * rstd * g[j]) * (1.0f + sc[j]) + sh[j];
            u32x2 w; w.x = (unsigned)f2bf(o[0]) | ((unsigned)f2bf(o[1]) << 16); w.y = (unsigned)f2bf(o[2]) | ((unsigned)f2bf(o[3]) << 16);
            *(u32x2*)(out + (size_t)row * D + col) = w;
            if (ROUTER) {
#pragma unroll
                for (int j = 0; j < 4; ++j) { const f32x4 r0 = *(const f32x4*)(router + (size_t)(col + j) * 8), r1 = *(const f32x4*)(router + (size_t)(col + j) * 8 + 4);
                    lg[0] += o[j] * r0[0]; lg[1] += o[j] * r0[1]; lg[2] += o[j] * r0[2]; lg[3] += o[j] * r0[3];
                    lg[4] += o[j] * r1[0]; lg[5] += o[j] * r1[1]; lg[6] += o[j] * r1[2]; lg[7] += o[j] * r1[3]; }
                asm volatile("" ::: "memory");
            }
        }
        if (ROUTER) {
#pragma unroll
            for (int e = 0; e < 8; ++e) lg[e] = wave_sum(lg[e]);
            if (lane == 0) {
                int i0 = 0; float v0 = lg[0];
#pragma unroll
                for (int e = 1; e < 8; ++e) if (lg[e] > v0) { v0 = lg[e]; i0 = e; }
                int i1 = -1; float v1 = -3.0e38f;
#pragma unroll
                for (int e = 0; e < 8; ++e) if (e != i0 && lg[e] > v1) { v1 = lg[e]; i1 = e; }
                const float e1 = expf(v1 - v0), w0 = 1.0f / (1.0f + e1), w1 = e1 / (1.0f + e1);
                topi[row * 2] = i0; topi[row * 2 + 1] = i1; topw[row * 2] = w0; topw[row * 2 + 1] = w1;
            }
        }
    }
}

__global__ void __launch_bounds__(512) k_mid(const bf16_t* __restrict__ U, const float* __restrict__ g_q, const float* __restrict__ g_kv,
                                             const float* __restrict__ conv_w, const float* __restrict__ conv_b, const float* __restrict__ cosT, const float* __restrict__ sinT,
                                             bf16_t* __restrict__ cqn, bf16_t* __restrict__ ckvn, bf16_t* __restrict__ kpe, bf16_t* __restrict__ x0o,
                                             bf16_t* __restrict__ wtl, bf16_t* __restrict__ wtc, bf16_t* __restrict__ sq, bf16_t* __restrict__ sk, bf16_t* __restrict__ sv) {
    const int tid = threadIdx.x, lane = tid & 63, wid = tid >> 6;
    for (int unit = blockIdx.x; unit < NTOK / 16; unit += gridDim.x) {
        const int tok0 = unit * 16;
        for (int tt = 0; tt < 2; ++tt) {
            const int tok = tok0 + wid * 2 + tt; const bool lat = tok < NLAT; const int t = lat ? (tok & 2047) : ((tok - NLAT) & 255);
            const bf16_t* u = U + (size_t)tok * UW;
            { float x[12]; float ss = 0.f;
#pragma unroll
              for (int i = 0; i < 12; ++i) { x[i] = bf2f(u[O_CQ + i * 64 + lane]); ss += x[i] * x[i]; }
              ss = wave_sum(ss); const float rs = rsqrtf(ss * (1.0f / 768.0f) + EPS);
#pragma unroll
              for (int i = 0; i < 12; ++i) cqn[(size_t)tok * 768 + i * 64 + lane] = f2bf(x[i] * rs * g_q[i * 64 + lane]); }
            { float x[8]; float ss = 0.f;
#pragma unroll
              for (int i = 0; i < 8; ++i) { x[i] = bf2f(u[O_CKV + i * 64 + lane]); ss += x[i] * x[i]; }
              ss = wave_sum(ss); const float rs = rsqrtf(ss * (1.0f / 512.0f) + EPS);
#pragma unroll
              for (int i = 0; i < 8; ++i) ckvn[(size_t)tok * 512 + i * 64 + lane] = f2bf(x[i] * rs * g_kv[i * 64 + lane]); }
            const int pi = lane & 31;
            const float cs = lat ? cosT[t * 32 + pi] : 1.0f, sn = lat ? sinT[t * 32 + pi] : 0.0f;
            if (lane < 32) {
                const float a = bf2f(u[O_KPE + pi]), b = bf2f(u[O_KPE + 32 + pi]);
                kpe[(size_t)tok * 64 + 2 * pi] = f2bf(a * cs - b * sn); kpe[(size_t)tok * 64 + 2 * pi + 1] = f2bf(a * sn + b * cs);
            }
#pragma unroll
            for (int r = 0; r < 4; ++r) { const int pr = r * 64 + lane, h = pr >> 5;
                const float a = bf2f(u[O_SQ + h * 64 + pi]), b = bf2f(u[O_SQ + h * 64 + 32 + pi]);
                sq[(size_t)tok * 512 + h * 64 + pi] = f2bf(a * cs - b * sn); sq[(size_t)tok * 512 + h * 64 + 32 + pi] = f2bf(a * sn + b * cs); }
            { const int h = lane >> 5;
              const float a = bf2f(u[O_SK + h * 64 + pi]), b = bf2f(u[O_SK + h * 64 + 32 + pi]);
              sk[(size_t)tok * 128 + h * 64 + pi] = f2bf(a * cs - b * sn); sk[(size_t)tok * 128 + h * 64 + 32 + pi] = f2bf(a * sn + b * cs); }
            sv[(size_t)tok * 128 + lane] = u[O_SV + lane]; sv[(size_t)tok * 128 + 64 + lane] = u[O_SV + 64 + lane];
        }
        {
            const bool lat = tok0 < NLAT; const int Ls = lat ? L : C;
            const int b = lat ? (tok0 >> 11) : ((tok0 - NLAT) >> 8), t0 = lat ? (tok0 & 2047) : ((tok0 - NLAT) & 255);
            const int ch = tid;
            float cw[3][3], cb[3];
#pragma unroll
            for (int g = 0; g < 3; ++g) { cb[g] = conv_b[g * 512 + ch];
#pragma unroll
                for (int j = 0; j < 3; ++j) cw[g][j] = conv_w[j * 1536 + g * 512 + ch]; }
            float prev[3], cur[3], nxt[3];
#pragma unroll
            for (int g = 0; g < 3; ++g) { prev[g] = (t0 > 0) ? bf2f(U[(size_t)(tok0 - 1) * UW + O_HY + g * 512 + ch]) : 0.f; cur[g] = bf2f(U[(size_t)tok0 * UW + O_HY + g * 512 + ch]); }
            unsigned pk[8];
#pragma unroll
            for (int i = 0; i < 16; ++i) {
                const bool hasn = (t0 + i + 1) < Ls;
                float y[3];
#pragma unroll
                for (int g = 0; g < 3; ++g) { nxt[g] = hasn ? bf2f(U[(size_t)(tok0 + i + 1) * UW + O_HY + g * 512 + ch]) : 0.f;
                    y[g] = cb[g] + cw[g][0] * prev[g] + cw[g][1] * cur[g] + cw[g][2] * nxt[g]; prev[g] = cur[g]; cur[g] = nxt[g]; }
                x0o[(size_t)(tok0 + i) * 512 + ch] = f2bf(y[0]);
                const unsigned wv = f2bf(y[2] * y[1]);
                if (i & 1) pk[i >> 1] |= wv << 16; else pk[i >> 1] = wv;
            }
            bf16_t* wt = lat ? wtl + ((size_t)b * 512 + ch) * L + t0 : wtc + ((size_t)b * 512 + ch) * C + t0;
            u32x4 w0, w1; w0.x = pk[0]; w0.y = pk[1]; w0.z = pk[2]; w0.w = pk[3]; w1.x = pk[4]; w1.y = pk[5]; w1.z = pk[6]; w1.w = pk[7];
            *(u32x4*)wt = w0; *(u32x4*)(wt + 8) = w1;
        }
    }
}

__global__ void __launch_bounds__(256) k_rope_q(bf16_t* __restrict__ Q, const float* __restrict__ cosT, const float* __restrict__ sinT, int nrows) {
    const int tok = blockIdx.x; if (tok >= nrows) return;
    const int tid = threadIdx.x, h = tid >> 5, pi = tid & 31;
    const bool lat = tok < NLAT; const int t = tok & 2047;
    bf16_t* q = Q + (size_t)tok * QW + h * 192 + 128;
    const float a = bf2f(q[pi]), b = bf2f(q[32 + pi]);
    const float cs = lat ? cosT[t * 32 + pi] : 1.0f, sn = lat ? sinT[t * 32 + pi] : 0.0f;
    __syncthreads();
    q[2 * pi] = f2bf(a * cs - b * sn); q[2 * pi + 1] = f2bf(a * sn + b * cs);
}

enum { EP_BF16 = 0, EP_RESID = 1, EP_SWIGLU = 2, EP_F32 = 3 };
struct GArgs {
    const bf16_t* A; int lda; const float* B; const float* B2; int ldb; int M, N, K;
    void* O; int ldo;
    const float* rlat; const float* rctx; const float* gate; int gate_off;
    const int* eoff; const int* epad; size_t bstride;
};
template <int EP, bool GROUPED>
__global__ void __launch_bounds__(256) k_gemm_naive(GArgs a) {
    __shared__ float As[16][65]; __shared__ float Bs[16][64]; __shared__ float Bs2[EP == EP_SWIGLU ? 16 : 1][64];
    const int tid = threadIdx.x, tx = tid & 15, ty = tid >> 4;
    int rowbase = blockIdx.y * 64; const float* B = a.B; const float* B2 = a.B2; int M = a.M;
    if (GROUPED) { const int e = blockIdx.z; M = a.epad[e]; if (rowbase >= M) return; rowbase += a.eoff[e]; B += (size_t)e * a.bstride; if (EP == EP_SWIGLU) B2 += (size_t)e * a.bstride; }
    else if (rowbase >= M) return;
    const int colbase = blockIdx.x * 64;
    float acc[4][4], acc2[4][4];
#pragma unroll
    for (int i = 0; i < 4; ++i)
#pragma unroll
        for (int j = 0; j < 4; ++j) { acc[i][j] = 0.f; acc2[i][j] = 0.f; }
    const int ar = tid >> 2, ak = (tid & 3) * 4, bk = tid >> 4, bn = (tid & 15) * 4;
    for (int k0 = 0; k0 < a.K; k0 += 16) {
        const u32x2 av = *(const u32x2*)(a.A + (size_t)(rowbase + ar) * a.lda + k0 + ak);
        As[ak + 0][ar] = __uint_as_float(av.x << 16); As[ak + 1][ar] = __uint_as_float(av.x & 0xffff0000u);
        As[ak + 2][ar] = __uint_as_float(av.y << 16); As[ak + 3][ar] = __uint_as_float(av.y & 0xffff0000u);
        *(f32x4*)&Bs[bk][bn] = *(const f32x4*)(B + (size_t)(k0 + bk) * a.ldb + colbase + bn);
        if (EP == EP_SWIGLU) *(f32x4*)&Bs2[bk][bn] = *(const f32x4*)(B2 + (size_t)(k0 + bk) * a.ldb + colbase + bn);
        __syncthreads();
#pragma unroll
        for (int k = 0; k < 16; ++k) {
            float av4[4], bv4[4], cv4[4];
#pragma unroll
            for (int i = 0; i < 4; ++i) av4[i] = As[k][ty * 4 + i];
#pragma unroll
            for (int j = 0; j < 4; ++j) { bv4[j] = Bs[k][tx * 4 + j]; cv4[j] = (EP == EP_SWIGLU) ? Bs2[k][tx * 4 + j] : 0.f; }
#pragma unroll
            for (int i = 0; i < 4; ++i)
#pragma unroll
                for (int j = 0; j < 4; ++j) { acc[i][j] += av4[i] * bv4[j]; if (EP == EP_SWIGLU) acc2[i][j] += av4[i] * cv4[j]; }
        }
        __syncthreads();
    }
#pragma unroll
    for (int i = 0; i < 4; ++i) {
        const int row = rowbase + ty * 4 + i;
#pragma unroll
        for (int j = 0; j < 4; ++j) {
            const int col = colbase + tx * 4 + j; float v = acc[i][j];
            if (EP == EP_BF16) ((bf16_t*)a.O)[(size_t)row * a.ldo + col] = f2bf(v);
            else if (EP == EP_SWIGLU) ((bf16_t*)a.O)[(size_t)row * a.ldo + col] = f2bf(silu(v) * acc2[i][j]);
            else if (EP == EP_F32) ((float*)a.O)[(size_t)row * a.ldo + col] = v;
            else { const float r = row < NLAT ? a.rlat[(size_t)row * D + col] : a.rctx[(size_t)(row - NLAT) * D + col];
                   ((float*)a.O)[(size_t)row * a.ldo + col] = r + a.gate[(size_t)tok_mod(row) * 12288 + a.gate_off + col] * v; }
        }
    }
}

__global__ void __launch_bounds__(256) k_mla_naive(const bf16_t* __restrict__ Q, const bf16_t* __restrict__ KV, const bf16_t* __restrict__ KPE, bf16_t* __restrict__ mix, int tok_base) {
    __shared__ float qf[4][192]; __shared__ float sc[4][2304];
    const int lane = threadIdx.x & 63, w = threadIdx.x >> 6, h = blockIdx.y;
    const int qt = tok_base + blockIdx.x * 4 + w; const bool lat = qt < NLAT;
    const int b = lat ? (qt >> 11) : ((qt - NLAT) >> 8);
    const int nk = lat ? (L + C) : C;
    for (int i = lane; i < 192; i += 64) qf[w][i] = bf2f(Q[(size_t)qt * QW + h * 192 + i]);
    __syncthreads();
    const float scale = 0.07216878364870322f;
    float mx = -3.0e38f;
    for (int kc = 0; kc < nk; kc += 64) {
        const int kk = kc + lane;
        const int kt = lat ? (kk < L ? b * L + kk : NLAT + b * C + (kk - L)) : (NLAT + b * C + kk);
        float s = 0.f;
        const u32x4* kp = (const u32x4*)(KV + (size_t)kt * KVW + h * 256);
        for (int i = 0; i < 16; ++i) { const u32x4 v = kp[i];
            s += qf[w][i * 8 + 0] * __uint_as_float(v.x << 16) + qf[w][i * 8 + 1] * __uint_as_float(v.x & 0xffff0000u)
               + qf[w][i * 8 + 2] * __uint_as_float(v.y << 16) + qf[w][i * 8 + 3] * __uint_as_float(v.y & 0xffff0000u)
               + qf[w][i * 8 + 4] * __uint_as_float(v.z << 16) + qf[w][i * 8 + 5] * __uint_as_float(v.z & 0xffff0000u)
               + qf[w][i * 8 + 6] * __uint_as_float(v.w << 16) + qf[w][i * 8 + 7] * __uint_as_float(v.w & 0xffff0000u); }
        const u32x4* pp = (const u32x4*)(KPE + (size_t)kt * 64);
        for (int i = 0; i < 8; ++i) { const u32x4 v = pp[i]; const float* q8 = &qf[w][128 + i * 8];
            s += q8[0] * __uint_as_float(v.x << 16) + q8[1] * __uint_as_float(v.x & 0xffff0000u)
               + q8[2] * __uint_as_float(v.y << 16) + q8[3] * __uint_as_float(v.y & 0xffff0000u)
               + q8[4] * __uint_as_float(v.z << 16) + q8[5] * __uint_as_float(v.z & 0xffff0000u)
               + q8[6] * __uint_as_float(v.w << 16) + q8[7] * __uint_as_float(v.w & 0xffff0000u); }
        s *= scale; sc[w][kk] = s; mx = fmaxf(mx, s);
    }
    mx = wave_max(mx);
    float sum = 0.f;
    for (int kc = 0; kc < nk; kc += 64) { const float p = expf(sc[w][kc + lane] - mx); sc[w][kc + lane] = p; sum += p; }
    sum = wave_sum(sum);
    __syncthreads();
    float o0 = 0.f, o1 = 0.f;
    for (int kk = 0; kk < nk; ++kk) {
        const int kt = lat ? (kk < L ? b * L + kk : NLAT + b * C + (kk - L)) : (NLAT + b * C + kk);
        const unsigned v = *(const unsigned*)(KV + (size_t)kt * KVW + h * 256 + 128 + lane * 2);
        const float p = sc[w][kk];
        o0 += p * __uint_as_float(v << 16); o1 += p * __uint_as_float(v & 0xffff0000u);
    }
    const float inv = 1.0f / sum;
    *(unsigned*)(mix + (size_t)qt * D + h * 128 + lane * 2) = (unsigned)f2bf(o0 * inv) | ((unsigned)f2bf(o1 * inv) << 16);
}

__global__ void __launch_bounds__(256) k_swa_naive(const bf16_t* __restrict__ SQ, const bf16_t* __restrict__ SK, const bf16_t* __restrict__ SV, const float* __restrict__ sink,
                                                   bf16_t* __restrict__ mix, int tok_base) {
    __shared__ float qf[4][64]; __shared__ float sc[4][576]; __shared__ int kts[4][576];
    const int lane = threadIdx.x & 63, w = threadIdx.x >> 6, hq = blockIdx.y, hk = hq >> 2;
    const int qt = tok_base + blockIdx.x * 4 + w; const bool lat = qt < NLAT;
    const int b = lat ? (qt >> 11) : ((qt - NLAT) >> 8), t = lat ? (qt & 2047) : 0;
    int lo = 0, nloc = 0;
    if (lat) { lo = t - 128 < 0 ? 0 : t - 128; const int hi = t + 128 > L - 1 ? L - 1 : t + 128; nloc = hi - lo + 1; }
    const int nk = nloc + C;
    qf[w][lane] = bf2f(SQ[(size_t)qt * 512 + hq * 64 + lane]);
    __syncthreads();
    const float skv = sink[hq];
    float mx = skv;
    for (int kc = 0; kc < nk; kc += 64) {
        const int kk = kc + lane;
        if (kk < nk) {
            const int kt = kk < nloc ? (b * L + lo + kk) : (NLAT + b * C + (kk - nloc));
            const u32x4* kp = (const u32x4*)(SK + (size_t)kt * 128 + hk * 64);
            float s = 0.f;
            for (int i = 0; i < 8; ++i) { const u32x4 v = kp[i]; const float* q8 = &qf[w][i * 8];
                s += q8[0] * __uint_as_float(v.x << 16) + q8[1] * __uint_as_float(v.x & 0xffff0000u)
                   + q8[2] * __uint_as_float(v.y << 16) + q8[3] * __uint_as_float(v.y & 0xffff0000u)
                   + q8[4] * __uint_as_float(v.z << 16) + q8[5] * __uint_as_float(v.z & 0xffff0000u)
                   + q8[6] * __uint_as_float(v.w << 16) + q8[7] * __uint_as_float(v.w & 0xffff0000u); }
            s *= 0.125f; sc[w][kk] = s; kts[w][kk] = kt; mx = fmaxf(mx, s);
        }
    }
    mx = wave_max(mx);
    float sum = 0.f;
    for (int kc = 0; kc < nk; kc += 64) { const int kk = kc + lane; if (kk < nk) { const float p = expf(sc[w][kk] - mx); sc[w][kk] = p; sum += p; } }
    sum = wave_sum(sum) + expf(skv - mx);
    __syncthreads();
    float o = 0.f;
    for (int kk = 0; kk < nk; ++kk) o += sc[w][kk] * bf2f(SV[(size_t)kts[w][kk] * 128 + hk * 64 + lane]);
    mix[(size_t)qt * D + 1536 + hq * 64 + lane] = f2bf(o / sum);
}

template <int LS>
__global__ void __launch_bounds__(256) k_hyena_naive(const float* __restrict__ filt, const bf16_t* __restrict__ wt, const bf16_t* __restrict__ x0, const float* __restrict__ skip,
                                                     bf16_t* __restrict__ mix, int tok_base) {
    __shared__ float T[2 * LS]; __shared__ float ws[LS];
    const int ch = blockIdx.x, b = blockIdx.y, tid = threadIdx.x;
    for (int i = tid; i < 2 * LS; i += 256) T[i] = filt[(size_t)ch * 2 * LS + i];
    for (int i = tid; i < LS; i += 256) ws[i] = bf2f(wt[((size_t)b * 512 + ch) * LS + i]);
    __syncthreads();
    const float sk = skip[ch];
    for (int t = tid; t < LS; t += 256) {
        float y = 0.f;
        for (int s = 0; s < LS; ++s) y += T[t - s + LS] * ws[s];
        const int tok = tok_base + b * LS + t;
        mix[(size_t)tok * D + 1024 + ch] = f2bf(bf2f(x0[(size_t)tok * 512 + ch]) * (y + sk * ws[t]));
    }
}

__global__ void __launch_bounds__(1024) k_route(const int* __restrict__ topi, int* __restrict__ pos, int* __restrict__ src, int* __restrict__ ctl) {
    __shared__ int cnt[8][1024]; __shared__ int eoff[8];
    const int tid = threadIdx.x;
    for (int i = tid; i < MOE_ROWS; i += 1024) src[i] = -1;
    int c[8];
#pragma unroll
    for (int e = 0; e < 8; ++e) c[e] = 0;
    for (int i = 0; i < 16; ++i) { const int e = topi[tid * 16 + i];
#pragma unroll
        for (int q = 0; q < 8; ++q) c[q] += (e == q) ? 1 : 0; }
#pragma unroll
    for (int e = 0; e < 8; ++e) cnt[e][tid] = c[e];
    __syncthreads();
    if (tid < 8) { int s = 0; for (int i = 0; i < 1024; ++i) { const int v = cnt[tid][i]; cnt[tid][i] = s; s += v; } eoff[tid] = s; }
    __syncthreads();
    if (tid == 0) { int o = 0; for (int e = 0; e < 8; ++e) { const int n = eoff[e], p = (n + 255) & ~255; ctl[CT_EOFF + e] = o; ctl[CT_EPAD + e] = p; eoff[e] = o; o += p; } }
    __syncthreads();
#pragma unroll
    for (int e = 0; e < 8; ++e) c[e] = eoff[e] + cnt[e][tid];
    for (int i = 0; i < 16; ++i) { const int idx = tid * 16 + i; const int e = topi[idx]; int p = 0;
#pragma unroll
        for (int q = 0; q < 8; ++q) if (e == q) { p = c[q]; c[q]++; }
        pos[idx] = p; src[p] = idx >> 1; }
}
__global__ void __launch_bounds__(256) k_gather(const bf16_t* __restrict__ hb, const int* __restrict__ src, bf16_t* __restrict__ hbs) {
    const int r = blockIdx.x; const int s = src[r];
    u32x4 v = (u32x4){0u, 0u, 0u, 0u};
    if (s >= 0) v = *(const u32x4*)(hb + (size_t)s * D + threadIdx.x * 8);
    *(u32x4*)(hbs + (size_t)r * D + threadIdx.x * 8) = v;
}

__global__ void __launch_bounds__(512) k_final(const float* __restrict__ xs, const float* __restrict__ ys, const int* __restrict__ pos, const float* __restrict__ topw,
                                               const float* __restrict__ modl, const float* __restrict__ gfin, float* __restrict__ out) {
    const int lane = threadIdx.x & 63, wid = threadIdx.x >> 6;
    for (int row = blockIdx.x * 8 + wid; row < NLAT; row += gridDim.x * 8) {
        const float* g2 = modl + (size_t)tok_mod(row) * 12288 + 10240;
        const int p0 = pos[row * 2], p1 = pos[row * 2 + 1]; const float w0 = topw[row * 2], w1 = topw[row * 2 + 1];
        f32x4 v[8]; float ss = 0.f;
#pragma unroll
        for (int i = 0; i < 8; ++i) { const int col = i * 256 + lane * 4;
            const f32x4 x = *(const f32x4*)(xs + (size_t)row * D + col), a = *(const f32x4*)(ys + (size_t)p0 * D + col), b = *(const f32x4*)(ys + (size_t)p1 * D + col), g = *(const f32x4*)(g2 + col);
#pragma unroll
            for (int j = 0; j < 4; ++j) { v[i][j] = x[j] + g[j] * (w0 * a[j] + w1 * b[j]); ss += v[i][j] * v[i][j]; } }
        ss = wave_sum(ss); const float rstd = rsqrtf(ss * (1.0f / D) + EPS);
#pragma unroll
        for (int i = 0; i < 8; ++i) { const int col = i * 256 + lane * 4; const f32x4 g = *(const f32x4*)(gfin + col); f32x4 o;
#pragma unroll
            for (int j = 0; j < 4; ++j) o[j] = v[i][j] * rstd * g[j];
            *(f32x4*)(out + (size_t)row * D + col) = o; }
    }
}

template <int EP, bool GROUPED>
static void gemm_naive(hipStream_t st, const GArgs& a, int maxM, int nz) {
    dim3 grid(a.N / 64, (maxM + 63) / 64, nz);
    hipLaunchKernelGGL((k_gemm_naive<EP, GROUPED>), grid, dim3(256), 0, st, a);
}

extern "C" void kernel_launch(void* const* d_in, const int* in_sizes, int n_in, void* d_out, int out_size, void* d_ws, size_t ws_size, hipStream_t stream) {
    (void)in_sizes; (void)n_in; (void)out_size;
    if (ws_size < WS_END) { fprintf(stderr, "kernel_launch: workspace too small: %zu < %zu\n", ws_size, (size_t)WS_END); return; }
    const float* x = (const float*)d_in[0]; const float* c = (const float*)d_in[1]; const float* ctx = (const float*)d_in[2]; const float* c_ctx = (const float*)d_in[3];
    const float* w_mod = (const float*)d_in[4]; const float* b_mod = (const float*)d_in[5]; const float* g_mix = (const float*)d_in[6]; const float* g_ffn = (const float*)d_in[7];
    const float* w_in = (const float*)d_in[8]; const float* g_q = (const float*)d_in[9]; const float* w_q_up = (const float*)d_in[10]; const float* g_kv = (const float*)d_in[11];
    const float* w_kv_up = (const float*)d_in[12]; const float* hy_conv_w = (const float*)d_in[13]; const float* hy_conv_b = (const float*)d_in[14];
    const float* hy_w1 = (const float*)d_in[15]; const float* hy_b1 = (const float*)d_in[16]; const float* hy_w2 = (const float*)d_in[17]; const float* hy_b2 = (const float*)d_in[18];
    const float* hy_w3 = (const float*)d_in[19]; const float* hy_b3 = (const float*)d_in[20]; const float* hy_w_filt = (const float*)d_in[21]; const float* hy_freq = (const float*)d_in[22];
    const float* hy_skip = (const float*)d_in[23]; const float* swa_sink = (const float*)d_in[24]; const float* w_out = (const float*)d_in[25];
    const float* ffn_w_gate = (const float*)d_in[26]; const float* ffn_w_up = (const float*)d_in[27]; const float* ffn_w_down = (const float*)d_in[28];
    const float* moe_router = (const float*)d_in[29]; const float* moe_w_gate = (const float*)d_in[30]; const float* moe_w_up = (const float*)d_in[31]; const float* moe_w_down = (const float*)d_in[32];
    const float* g_final = (const float*)d_in[33];
    char* ws = (char*)d_ws;
    int* ctl = (int*)(ws + WS_CTL); float* mod = (float*)(ws + WS_MOD); float* cosT = (float*)(ws + WS_ROPE); float* sinT = cosT + 2048 * 32;
    float* filtL = (float*)(ws + WS_FILTL); float* filtC = (float*)(ws + WS_FILTC);
    bf16_t* hA = (bf16_t*)(ws + WS_HA); bf16_t* U = (bf16_t*)(ws + WS_U); bf16_t* cqn = (bf16_t*)(ws + WS_CQN); bf16_t* ckvn = (bf16_t*)(ws + WS_CKVN); bf16_t* kpe = (bf16_t*)(ws + WS_KPE);
    bf16_t* x0 = (bf16_t*)(ws + WS_X0); bf16_t* wtl = (bf16_t*)(ws + WS_WTL); bf16_t* wtc = (bf16_t*)(ws + WS_WTC); bf16_t* sq = (bf16_t*)(ws + WS_SQ); bf16_t* sk = (bf16_t*)(ws + WS_SK);
    bf16_t* sv = (bf16_t*)(ws + WS_SV); bf16_t* Q = (bf16_t*)(ws + WS_Q); bf16_t* KV = (bf16_t*)(ws + WS_KV); bf16_t* mix = (bf16_t*)(ws + WS_MIX); float* xs = (float*)(ws + WS_XS);
    bf16_t* act = (bf16_t*)(ws + WS_ACT); bf16_t* hbs = (bf16_t*)(ws + WS_HBS); float* ys = (float*)(ws + WS_YS);
    int* topi = (int*)(ws + WS_TOPI); float* topw = (float*)(ws + WS_TOPW); int* pos = (int*)(ws + WS_POS); int* src = (int*)(ws + WS_SRC);

    hipLaunchKernelGGL(k_rope_table, dim3(2048 * 32 / 256), dim3(256), 0, stream, cosT, sinT);
    hipLaunchKernelGGL(k_adaln, dim3(192), dim3(512), 0, stream, c, c_ctx, w_mod, b_mod, mod);
    hipLaunchKernelGGL(k_filters, dim3(576), dim3(512), 0, stream, hy_w1, hy_b1, hy_w2, hy_b2, hy_w3, hy_b3, hy_w_filt, hy_freq, filtL, filtC);

    for (int l = 0; l < 2; ++l) {
        const bool last = (l == 1);
        const float* xl = l == 0 ? x : xs; const float* xc = l == 0 ? ctx : xs + (size_t)NLAT * D;
        const float* modl = mod + (size_t)l * 5 * 12288;
        const int nq = last ? NLAT : NTOK;
        hipLaunchKernelGGL((k_normmod<false>), dim3(NTOK / 8), dim3(512), 0, stream, xl, xc, g_mix + l * D, modl, 0, 2048, hA, NTOK, (const float*)nullptr, (int*)nullptr, (float*)nullptr);
        { GArgs a{}; a.A = hA; a.lda = D; a.B = w_in + (size_t)l * D * INW; a.ldb = INW; a.M = NTOK; a.N = INW; a.K = D; a.O = U; a.ldo = UW; gemm_naive<EP_BF16, false>(stream, a, NTOK, 1); }
        hipLaunchKernelGGL(k_mid, dim3(NTOK / 16), dim3(512), 0, stream, U, g_q + l * 768, g_kv + l * 512, hy_conv_w + (size_t)l * 3 * 1536, hy_conv_b + l * 1536, cosT, sinT,
                           cqn, ckvn, kpe, x0, wtl, wtc, sq, sk, sv);
        { GArgs a{}; a.A = cqn; a.lda = 768; a.B = w_q_up + (size_t)l * 768 * QW; a.ldb = QW; a.M = nq; a.N = QW; a.K = 768; a.O = Q; a.ldo = QW; gemm_naive<EP_BF16, false>(stream, a, nq, 1); }
        hipLaunchKernelGGL(k_rope_q, dim3(nq), dim3(256), 0, stream, Q, cosT, sinT, nq);
        { GArgs a{}; a.A = ckvn; a.lda = 512; a.B = w_kv_up + (size_t)l * 512 * KVW; a.ldb = KVW; a.M = NTOK; a.N = KVW; a.K = 512; a.O = KV; a.ldo = KVW; gemm_naive<EP_BF16, false>(stream, a, NTOK, 1); }
        hipLaunchKernelGGL(k_mla_naive, dim3(nq / 4, 8), dim3(256), 0, stream, Q, KV, kpe, mix, 0);
        hipLaunchKernelGGL(k_swa_naive, dim3(nq / 4, 8), dim3(256), 0, stream, sq, sk, sv, swa_sink + l * 8, mix, 0);
        hipLaunchKernelGGL((k_hyena_naive<L>), dim3(512, NB), dim3(256), 0, stream, filtL + (size_t)l * 512 * 4096, wtl, x0, hy_skip + l * 512, mix, 0);
        if (!last) hipLaunchKernelGGL((k_hyena_naive<C>), dim3(512, NB), dim3(256), 0, stream, filtC + (size_t)l * 512 * 512, wtc, x0, hy_skip + l * 512, mix, NLAT);
        { GArgs a{}; a.A = mix; a.lda = D; a.B = w_out + (size_t)l * D * D; a.ldb = D; a.M = nq; a.N = D; a.K = D; a.O = xs; a.ldo = D; a.rlat = xl; a.rctx = xc; a.gate = modl; a.gate_off = 4096;
          gemm_naive<EP_RESID, false>(stream, a, nq, 1); }
        if (!last) {
            hipLaunchKernelGGL((k_normmod<false>), dim3(NTOK / 8), dim3(512), 0, stream, xs, xs + (size_t)NLAT * D, g_ffn + l * D, modl, 6144, 8192, hA, NTOK, (const float*)nullptr, (int*)nullptr, (float*)nullptr);
            { GArgs a{}; a.A = hA; a.lda = D; a.B = ffn_w_gate; a.B2 = ffn_w_up; a.ldb = DFF; a.M = NTOK; a.N = DFF; a.K = D; a.O = act; a.ldo = DFF; gemm_naive<EP_SWIGLU, false>(stream, a, NTOK, 1); }
            { GArgs a{}; a.A = act; a.lda = DFF; a.B = ffn_w_down; a.ldb = D; a.M = NTOK; a.N = D; a.K = DFF; a.O = xs; a.ldo = D; a.rlat = xs; a.rctx = xs + (size_t)NLAT * D; a.gate = modl; a.gate_off = 10240;
              gemm_naive<EP_RESID, false>(stream, a, NTOK, 1); }
        } else {
            hipLaunchKernelGGL((k_normmod<true>), dim3(NLAT / 8), dim3(512), 0, stream, xs, xs + (size_t)NLAT * D, g_ffn + l * D, modl, 6144, 8192, hA, NLAT, moe_router, topi, topw);
            hipLaunchKernelGGL(k_route, dim3(1), dim3(1024), 0, stream, topi, pos, src, ctl);
            hipLaunchKernelGGL(k_gather, dim3(MOE_ROWS), dim3(256), 0, stream, hA, src, hbs);
            { GArgs a{}; a.A = hbs; a.lda = D; a.B = moe_w_gate; a.B2 = moe_w_up; a.ldb = DFE; a.M = 0; a.N = DFE; a.K = D; a.O = act; a.ldo = DFE; a.eoff = ctl + CT_EOFF; a.epad = ctl + CT_EPAD; a.bstride = (size_t)D * DFE;
              gemm_naive<EP_SWIGLU, true>(stream, a, NLAT + 256, 8); }
            { GArgs a{}; a.A = act; a.lda = DFE; a.B = moe_w_down; a.ldb = D; a.M = 0; a.N = D; a.K = DFE; a.O = ys; a.ldo = D; a.eoff = ctl + CT_EOFF; a.epad = ctl + CT_EPAD; a.bstride = (size_t)DFE * D;
              gemm_naive<EP_F32, true>(stream, a, NLAT + 256, 8); }
            hipLaunchKernelGGL(k_final, dim3(NLAT / 8), dim3(512), 0, stream, xs, ys, pos, topw, modl, g_final, (float*)d_out);
        }
    }
}
```

```cpp
#include <hip/hip_runtime.h>
#include <stdint.h>
#include <stdio.h>

#ifndef MK_PER_PHASE
#define MK_PER_PHASE 0
#endif

typedef unsigned short bf16_t;
typedef float f32x4 __attribute__((ext_vector_type(4)));
typedef float f32x16 __attribute__((ext_vector_type(16)));
typedef unsigned u32x4 __attribute__((ext_vector_type(4)));
typedef unsigned u32x2 __attribute__((ext_vector_type(2)));
typedef short bf16x8 __attribute__((ext_vector_type(8)));

constexpr int D = 2048, NB = 4, L = 2048, C = 256, NLAT = NB * L, NCTX = NB * C, NTOK = NLAT + NCTX;
constexpr int UW = 3840;
constexpr int O_CQ = 0, O_CKV = 768, O_KPE = 1280, O_HY = 1344, O_SQ = 2880, O_SK = 3392, O_SV = 3520, INW = 3648;
constexpr int QW = 1536, KVW = 2048, DFF = 5632, DFE = 7168, NE = 8;
constexpr int MOE_ROWS = 18432;
constexpr float EPS = 1e-6f;
constexpr int NTHR = 512;

__device__ __forceinline__ float bf2f(bf16_t h) { return __uint_as_float(((unsigned)h) << 16); }
__device__ __forceinline__ bf16_t f2bf(float f) { unsigned u = __float_as_uint(f); u += 0x7fffu + ((u >> 16) & 1u); return (bf16_t)(u >> 16); }
__device__ __forceinline__ float wave_sum(float v) { for (int o = 32; o > 0; o >>= 1) v += __shfl_xor(v, o); return v; }
__device__ __forceinline__ float wave_max(float v) { for (int o = 32; o > 0; o >>= 1) v = fmaxf(v, __shfl_xor(v, o)); return v; }
__device__ __forceinline__ float silu(float x) { return x / (1.0f + __expf(-x)); }
__device__ __forceinline__ int tok_mod(int tok) { return tok < NLAT ? (tok >> 11) : 4; }

constexpr size_t al(size_t x) { return (x + 255) & ~(size_t)255; }
constexpr size_t WS_CTL = 0, CTL_ZERO_BYTES = 65536;
constexpr size_t WS_MOD = 65536;
constexpr size_t WS_ROPE = WS_MOD + al((size_t)2 * 5 * 12288 * 4);
constexpr size_t WS_FILTL = WS_ROPE + al((size_t)2 * 2048 * 32 * 4);
constexpr size_t WS_FILTC = WS_FILTL + al((size_t)2 * 512 * 4096 * 4);
constexpr size_t WS_WIN = WS_FILTC + al((size_t)2 * 512 * 512 * 4);
constexpr size_t WS_WQ = WS_WIN + al((size_t)2 * UW * D * 2);
constexpr size_t WS_WKV = WS_WQ + al((size_t)2 * QW * 768 * 2);
constexpr size_t WS_WOUT = WS_WKV + al((size_t)2 * KVW * 512 * 2);
constexpr size_t WS_WGU = WS_WOUT + al((size_t)2 * D * D * 2);
constexpr size_t WS_WDN = WS_WGU + al((size_t)2 * DFF * D * 2);
constexpr size_t WS_MGU = WS_WDN + al((size_t)D * DFF * 2);
constexpr size_t WS_MDN = WS_MGU + al((size_t)NE * 2 * DFE * D * 2);
constexpr size_t WS_HA = WS_MDN + al((size_t)NE * D * DFE * 2);
constexpr size_t WS_U = WS_HA + al((size_t)NTOK * D * 2);
constexpr size_t WS_CQN = WS_U + al((size_t)NTOK * UW * 2);
constexpr size_t WS_CKVN = WS_CQN + al((size_t)NTOK * 768 * 2);
constexpr size_t WS_KPE = WS_CKVN + al((size_t)NTOK * 512 * 2);
constexpr size_t WS_X0 = WS_KPE + al((size_t)NTOK * 64 * 2);
constexpr size_t WS_WTL = WS_X0 + al((size_t)NTOK * 512 * 2);
constexpr size_t WS_WTC = WS_WTL + al((size_t)NB * 512 * L * 2);
constexpr size_t WS_SQ = WS_WTC + al((size_t)NB * 512 * C * 2);
constexpr size_t WS_SK = WS_SQ + al((size_t)NTOK * 512 * 2);
constexpr size_t WS_SV = WS_SK + al((size_t)NTOK * 128 * 2);
constexpr size_t WS_Q = WS_SV + al((size_t)NTOK * 128 * 2);
constexpr size_t WS_KV = WS_Q + al((size_t)NTOK * QW * 2);
constexpr size_t WS_MIX = WS_KV + al((size_t)NTOK * KVW * 2);
constexpr size_t WS_MIXEND = WS_MIX + al((size_t)NTOK * D * 2);
constexpr size_t WS_YS = WS_U;
static_assert(WS_YS + (size_t)MOE_ROWS * D * 4 <= WS_MIXEND, "ys overlay");
constexpr size_t WS_XS = WS_MIXEND;
constexpr size_t WS_ACT = WS_XS + al((size_t)NTOK * D * 4);
constexpr size_t WS_HBS = WS_ACT + al((size_t)MOE_ROWS * DFE * 2);
constexpr size_t WS_TOPI = WS_HBS + al((size_t)MOE_ROWS * D * 2);
constexpr size_t WS_TOPW = WS_TOPI + al((size_t)NLAT * 2 * 4);
constexpr size_t WS_POS = WS_TOPW + al((size_t)NLAT * 2 * 4);
constexpr size_t WS_SRC = WS_POS + al((size_t)NLAT * 2 * 4);
constexpr size_t WS_END = WS_SRC + al((size_t)MOE_ROWS * 4);
constexpr int CT_EOFF = 1024, CT_EPAD = 1040, CT_NTILE = 1056;
constexpr int CW_BAR = 4096;

constexpr int RING_BYTES = 131072, LDSCTL_OFF = RING_BYTES, LDS_BYTES = 147456;

namespace pg8 {
#define PG8_LAS __attribute__((address_space(3)))
typedef unsigned short bf16_t;
typedef short bf16x8 __attribute__((ext_vector_type(8)));
typedef float f32x4 __attribute__((ext_vector_type(4)));
typedef unsigned u32x4 __attribute__((ext_vector_type(4)));
constexpr int BM = 256, BK = 64, HALF = 128, HTB = HALF * BK * 2  , STAGE_BYTES = 8 * HTB, NXCD = 8, WGM = 8;

__host__ __device__ __forceinline__ int lds_byte(int r, int c) { const int st = (r >> 4) * 2 + (c >> 5), rr = r & 15, cc = c & 31, ob = rr * 64 + cc * 2; return st * 1024 + (ob ^ (((ob >> 9) & 1) << 5)); }
__host__ __device__ __forceinline__ void stage_rc(int b, int& R, int& C) { const int st = b / 1024, sb = b % 1024, swz = sb ^ (((sb >> 9) & 1) << 5); R = (st >> 1) * 16 + swz / 64; C = (st & 1) * 32 + (swz % 64) / 2; }
__host__ __device__ __forceinline__ int perm32(int rho) { const int n = rho >> 4, i = rho & 15; return 8 * (i >> 2) + 4 * n + (i & 3); }

struct Unit { int pm, pn; };
struct Gemm { const bf16_t* A; const bf16_t* Bt; int M, N, K; };

struct StaticOrder {
    int nM, nN, nwg, G, c;
    __host__ __device__ void init(int M, int N, int G_, int c_) { nM = M / BM; nN = N / BM; nwg = nM * nN; G = G_; c = c_; }
    __host__ __device__ bool next(int i, Unit& u) const {
        const long L = (long)i * G + c; if (L >= nwg) return false;
        int wgid = (int)L; { const int q = nwg / NXCD, r = nwg % NXCD, xcd = wgid % NXCD, off = wgid / NXCD; wgid = (xcd < r ? xcd * (q + 1) : r * (q + 1) + (xcd - r) * q) + off; }
        const int nig = WGM * nN, gid = wgid / nig, fm = gid * WGM, gsz = (nM - fm) < WGM ? (nM - fm) : WGM;
        u.pm = fm + ((wgid % nig) % gsz); u.pn = (wgid % nig) / gsz; return true;
    }
    __device__ __forceinline__ size_t bt_off(const Unit&) const { return 0; }
    __device__ __forceinline__ void a_ready(const Unit&) const {}
    __device__ __forceinline__ void done(const Unit&) const {}
};

__device__ __forceinline__ unsigned cvt_pk_bf16(float lo, float hi) { unsigned r; asm volatile("v_cvt_pk_bf16_f32 %0, %1, %2" : "=v"(r) : "v"(lo), "v"(hi)); return r; }
typedef float f32x2 __attribute__((ext_vector_type(2)));
template <class Epi, class Sched, bool ALIGN_EPI = false, bool SP2 = false>
__device__ __forceinline__ void gemm_phase(PG8_LAS unsigned char* lds, const Gemm g, const Sched& S, const Epi& E) {
    const int tid = threadIdx.x, wid = __builtin_amdgcn_readfirstlane(tid >> 6), lane = tid & 63, wr = wid >> 2, wc = wid & 3, fr = lane & 15, fq = lane >> 4;
    const int K = g.K, nt = K / BK;
    unsigned voffA[2], voffB[2];
#pragma unroll
    for (int i = 0; i < 2; ++i) { int R, C; stage_rc(tid * 16 + i * 8192, R, C); const int Rb = Epi::PERM ? ((R & ~31) + perm32(R & 31)) : R;
        voffA[i] = (unsigned)(R * K + C) * 2u; voffB[i] = (unsigned)(Rb * K + C) * 2u; }
    const size_t kstep = (size_t)(BK * 2);
    const size_t hstep = (size_t)HALF * K * 2;
    const size_t tstep = 2 * hstep;
    const unsigned ldsw = (unsigned)wid * 1024u;
    const int aoff = lds_byte(wr * 64 + fr, fq * 8), boff = lds_byte(wc * 32 + fr, fq * 8);
#define PG8_SA(b, h) (((b) * 2 + (h)) * HTB)
#define PG8_SB(b, h) ((4 + (b) * 2 + (h)) * HTB)
#define PG8_STAGE(bufoff, gbase, voff) do { _Pragma("unroll") for (int _i = 0; _i < 2; ++_i) \
        __builtin_amdgcn_global_load_lds((const unsigned*)((const char*)(gbase) + (voff)[_i]), (PG8_LAS unsigned*)(lds + (bufoff) + ldsw + _i * 8192), 16, 0, 0); } while (0)
#define PG8_LDA(dst, b, h) do { _Pragma("unroll") for (int m = 0; m < 4; ++m) _Pragma("unroll") for (int k = 0; k < 2; ++k) dst[m][k] = *(const PG8_LAS bf16x8*)(lds + PG8_SA(b, h) + aoff + m * 2048 + k * 1024); } while (0)
#define PG8_LDB(dst, b, h) do { _Pragma("unroll") for (int n = 0; n < 2; ++n) _Pragma("unroll") for (int k = 0; k < 2; ++k) dst[n][k] = *(const PG8_LAS bf16x8*)(lds + PG8_SB(b, h) + boff + n * 2048 + k * 1024); } while (0)
#define PG8_MMA(ai, bj, At, Bt) do { __builtin_amdgcn_s_setprio(1); _Pragma("unroll") for (int m = 0; m < 4; ++m) _Pragma("unroll") for (int n = 0; n < 2; ++n) _Pragma("unroll") for (int k = 0; k < 2; ++k) \
        acc[ai][bj][m][n] = __builtin_amdgcn_mfma_f32_16x16x32_bf16(Bt[n][k], At[m][k], acc[ai][bj][m][n], 0, 0, 0); __builtin_amdgcn_s_setprio(0); } while (0)
#define PG8_WAIT_V(n) asm volatile("s_waitcnt vmcnt(" #n ")" ::: "memory")
#define PG8_WAIT_L(n) asm volatile("s_waitcnt lgkmcnt(" #n ")" ::: "memory")
#define PG8_BAR __builtin_amdgcn_s_barrier()
#define PG8_SCHED __builtin_amdgcn_sched_barrier(0)
    Unit cur, nxt; int ui = 0;
    if (!S.next(0, cur)) return;
    f32x4 acc[2][2][4][2];
#pragma unroll
    for (int a = 0; a < 2; ++a)
#pragma unroll
        for (int b = 0; b < 2; ++b)
#pragma unroll
            for (int m = 0; m < 4; ++m)
#pragma unroll
                for (int n = 0; n < 2; ++n) acc[a][b][m][n] = (f32x4){0.f, 0.f, 0.f, 0.f};
    bf16x8 At[4][2], B0[2][2], B1[2][2];
    const char* cA = (const char*)g.A + (size_t)cur.pm * tstep; const char* cB = (const char*)g.Bt + S.bt_off(cur) + (size_t)cur.pn * tstep;
    S.a_ready(cur);
    if constexpr (SP2) {
        PG8_STAGE(PG8_SB(0, 0), cB, voffB); PG8_STAGE(PG8_SB(0, 1), cB + hstep, voffB); PG8_STAGE(PG8_SA(0, 0), cA, voffA); PG8_STAGE(PG8_SA(0, 1), cA + hstep, voffA);
        if (wr == 1) PG8_BAR;
        PG8_WAIT_V(2); PG8_BAR;
        PG8_STAGE(PG8_SB(1, 0), cB + kstep, voffB); PG8_STAGE(PG8_SA(1, 0), cA + kstep, voffA); PG8_STAGE(PG8_SB(1, 1), cB + hstep + kstep, voffB);
        PG8_WAIT_V(6); PG8_BAR;
    } else {
        PG8_STAGE(PG8_SB(0, 0), cB, voffB); PG8_STAGE(PG8_SA(0, 0), cA, voffA); PG8_STAGE(PG8_SB(0, 1), cB + hstep, voffB); PG8_STAGE(PG8_SA(0, 1), cA + hstep, voffA);
        if (wr == 1) PG8_BAR;
        PG8_WAIT_V(4); PG8_BAR;
        PG8_STAGE(PG8_SB(1, 0), cB + kstep, voffB); PG8_STAGE(PG8_SA(1, 0), cA + kstep, voffA); PG8_STAGE(PG8_SB(1, 1), cB + hstep + kstep, voffB);
        PG8_WAIT_V(6); PG8_BAR;
    }
    for (;;) {
        const bool has_next = S.next(ui + 1, nxt);
        const char* nA = has_next ? (const char*)g.A + (size_t)nxt.pm * tstep : cA; const char* nB = has_next ? (const char*)g.Bt + S.bt_off(nxt) + (size_t)nxt.pn * tstep : cB;
        for (int t = 0; t < nt; t += 2) {
            const bool last = (t == nt - 2);
            const char* a1 = cA + (size_t)(t + 1) * kstep;
            const char* a2 = last ? nA : cA + (size_t)(t + 2) * kstep; const char* b2 = last ? nB : cB + (size_t)(t + 2) * kstep;
            const char* a3 = a2 + kstep; const char* b3 = b2 + kstep;
            if (last && has_next) S.a_ready(nxt);
            if constexpr (SP2) {
            PG8_LDB(B0, 0, 0); PG8_LDB(B1, 0, 1); PG8_SCHED; PG8_LDA(At, 0, 0); PG8_STAGE(PG8_SA(1, 1), a1 + hstep, voffA);
            PG8_WAIT_V(8); PG8_WAIT_L(0); PG8_BAR; PG8_MMA(0, 0, At, B0); PG8_MMA(0, 1, At, B1); PG8_BAR; PG8_SCHED;
            PG8_LDA(At, 0, 1); PG8_STAGE(PG8_SB(0, 0), b2, voffB); PG8_STAGE(PG8_SB(0, 1), b2 + hstep, voffB); PG8_STAGE(PG8_SA(0, 0), a2, voffA);
            PG8_WAIT_V(8); PG8_WAIT_L(0); PG8_BAR; PG8_MMA(1, 0, At, B0); PG8_MMA(1, 1, At, B1); PG8_BAR; PG8_SCHED;
            PG8_LDB(B0, 1, 0); PG8_LDB(B1, 1, 1); PG8_SCHED; PG8_LDA(At, 1, 0); PG8_STAGE(PG8_SA(0, 1), a2 + hstep, voffA);
            PG8_WAIT_V(8); PG8_WAIT_L(0); PG8_BAR; PG8_MMA(0, 0, At, B0); PG8_MMA(0, 1, At, B1); PG8_BAR; PG8_SCHED;
            PG8_LDA(At, 1, 1); PG8_STAGE(PG8_SB(1, 0), b3, voffB); PG8_STAGE(PG8_SB(1, 1), b3 + hstep, voffB); PG8_STAGE(PG8_SA(1, 0), a3, voffA);
            PG8_WAIT_V(8); PG8_WAIT_L(0); PG8_BAR; PG8_MMA(1, 0, At, B0); PG8_MMA(1, 1, At, B1); PG8_BAR; PG8_SCHED;
            } else {
            PG8_LDB(B0, 0, 0); PG8_SCHED; PG8_LDA(At, 0, 0); PG8_STAGE(PG8_SA(1, 1), a1 + hstep, voffA);
            PG8_WAIT_L(8); PG8_BAR; PG8_WAIT_L(0); PG8_MMA(0, 0, At, B0); PG8_BAR; PG8_SCHED;
            PG8_LDB(B1, 0, 1); PG8_STAGE(PG8_SB(0, 0), b2, voffB);
            PG8_BAR; PG8_WAIT_L(0); PG8_MMA(0, 1, At, B1); PG8_BAR;
            PG8_LDA(At, 0, 1); PG8_STAGE(PG8_SA(0, 0), a2, voffA);
            PG8_BAR; PG8_WAIT_L(0); PG8_MMA(1, 0, At, B0); PG8_BAR; PG8_SCHED;
            PG8_STAGE(PG8_SB(0, 1), b2 + hstep, voffB);
            PG8_WAIT_V(6); PG8_BAR; PG8_MMA(1, 1, At, B1); PG8_BAR;
            PG8_LDB(B0, 1, 0); PG8_SCHED; PG8_LDA(At, 1, 0); PG8_STAGE(PG8_SA(0, 1), a2 + hstep, voffA);
            PG8_WAIT_L(8); PG8_BAR; PG8_WAIT_L(0); PG8_MMA(0, 0, At, B0); PG8_BAR; PG8_SCHED;
            PG8_LDB(B1, 1, 1); PG8_STAGE(PG8_SB(1, 0), b3, voffB);
            PG8_BAR; PG8_WAIT_L(0); PG8_MMA(0, 1, At, B1); PG8_BAR;
            PG8_LDA(At, 1, 1); PG8_STAGE(PG8_SA(1, 0), a3, voffA);
            PG8_BAR; PG8_WAIT_L(0); PG8_MMA(1, 0, At, B0); PG8_BAR; PG8_SCHED;
            PG8_STAGE(PG8_SB(1, 1), b3 + hstep, voffB);
            PG8_WAIT_V(6); PG8_BAR; PG8_MMA(1, 1, At, B1); PG8_BAR;
            }
        }
        if constexpr (ALIGN_EPI) { if (wr == 0) PG8_BAR; }
        if constexpr (!Epi::AFTER_DRAIN) { E(acc, cur, wr, wc, fr, fq); S.done(cur); }
        if (!has_next) break;
#pragma unroll
        for (int a = 0; a < 2; ++a)
#pragma unroll
            for (int b = 0; b < 2; ++b)
#pragma unroll
                for (int m = 0; m < 4; ++m)
#pragma unroll
                    for (int n = 0; n < 2; ++n) acc[a][b][m][n] = (f32x4){0.f, 0.f, 0.f, 0.f};
        cur = nxt; cA = nA; cB = nB; ++ui;
        if constexpr (ALIGN_EPI) { if (wr == 1) PG8_BAR; }
    }
    PG8_WAIT_V(0);
    if constexpr (!ALIGN_EPI) { if (wr == 0) PG8_BAR; }
    PG8_BAR;
    if constexpr (Epi::AFTER_DRAIN) { E.fused(acc, cur, wr, wc, fr, fq, lds, wid, lane); S.done(cur); }
#undef PG8_SA
#undef PG8_SB
#undef PG8_STAGE
#undef PG8_LDA
#undef PG8_LDB
#undef PG8_MMA
#undef PG8_WAIT_V
#undef PG8_WAIT_L
#undef PG8_BAR
#undef PG8_SCHED
}
}

namespace pg8 {
__device__ __forceinline__ u32x4 pack8(const f32x4 v0, const f32x4 v1) { u32x4 w; w.x = cvt_pk_bf16(v0[0], v0[1]); w.y = cvt_pk_bf16(v0[2], v0[3]); w.z = cvt_pk_bf16(v1[0], v1[1]); w.w = cvt_pk_bf16(v1[2], v1[3]); return w; }
struct EpiStore {
    static constexpr bool PERM = true, AFTER_DRAIN = false;
    bf16_t* O; int ldc;
    __device__ __forceinline__ void operator()(const f32x4 (&acc)[2][2][4][2], const Unit& u, int wr, int wc, int fr, int fq) const {
        const int row0 = u.pm * BM + wr * 64 + fr, col0 = u.pn * BM + wc * 32 + 8 * fq;
#pragma unroll
        for (int ai = 0; ai < 2; ++ai)
#pragma unroll
            for (int m = 0; m < 4; ++m) { bf16_t* rowp = O + (size_t)(row0 + ai * HALF + m * 16) * ldc + col0;
#pragma unroll
                for (int bj = 0; bj < 2; ++bj) *(u32x4*)(rowp + bj * HALF) = pack8(acc[ai][bj][m][0], acc[ai][bj][m][1]); }
    }
};
struct EpiQ {
    static constexpr bool PERM = true, AFTER_DRAIN = false;
    bf16_t* O; const float* cosT; const float* sinT;
    __device__ __forceinline__ void operator()(const f32x4 (&acc)[2][2][4][2], const Unit& u, int wr, int wc, int fr, int fq) const {
        const int row0 = u.pm * BM + wr * 64 + fr, col0 = u.pn * BM + wc * 32 + 8 * fq;
#pragma unroll
        for (int ai = 0; ai < 2; ++ai)
#pragma unroll
            for (int m = 0; m < 4; ++m) { const int row = row0 + ai * HALF + m * 16; const bool lat = row < 8192; const int t = row & 2047;
#pragma unroll
                for (int bj = 0; bj < 2; ++bj) { const int col = col0 + bj * HALF; const int jn = col - 192 * (col / 192);
                    f32x4 v0 = acc[ai][bj][m][0], v1 = acc[ai][bj][m][1];
                    if (jn >= 128 && lat) { const int i0 = (jn - 128) >> 1;
                        const f32x4 cs = *(const f32x4*)(cosT + t * 32 + i0), sn = *(const f32x4*)(sinT + t * 32 + i0);
                        f32x4 r0, r1;
                        r0[0] = v0[0] * cs[0] - v0[1] * sn[0]; r0[1] = v0[0] * sn[0] + v0[1] * cs[0];
                        r0[2] = v0[2] * cs[1] - v0[3] * sn[1]; r0[3] = v0[2] * sn[1] + v0[3] * cs[1];
                        r1[0] = v1[0] * cs[2] - v1[1] * sn[2]; r1[1] = v1[0] * sn[2] + v1[1] * cs[2];
                        r1[2] = v1[2] * cs[3] - v1[3] * sn[3]; r1[3] = v1[2] * sn[3] + v1[3] * cs[3];
                        v0 = r0; v1 = r1; }
                    *(u32x4*)(O + (size_t)row * 1536 + col) = pack8(v0, v1); } }
    }
};
struct EpiResid {
    static constexpr bool PERM = false, AFTER_DRAIN = false;
    float* xs; const float* gate;
    __device__ __forceinline__ void operator()(const f32x4 (&acc)[2][2][4][2], const Unit& u, int wr, int wc, int fr, int fq) const {
        const int row0 = u.pm * BM + wr * 64 + fr, colb = u.pn * BM + wc * 32 + 4 * fq;
#pragma unroll
        for (int ai = 0; ai < 2; ++ai)
#pragma unroll
            for (int m = 0; m < 4; ++m) { const int row = row0 + ai * HALF + m * 16; const float* gv = gate + (size_t)(row < 8192 ? (row >> 11) : 4) * 12288; float* xr = xs + (size_t)row * 2048;
#pragma unroll
                for (int bj = 0; bj < 2; ++bj)
#pragma unroll
                    for (int n = 0; n < 2; ++n) { const int col = colb + bj * HALF + n * 16; f32x4 x = *(const f32x4*)(xr + col); const f32x4 g = *(const f32x4*)(gv + col);
                        x += g * acc[ai][bj][m][n]; *(f32x4*)(xr + col) = x; }
                if (m & 1) asm volatile("" ::: "memory"); }
    }
};
struct EpiSwiGLU {
    static constexpr bool PERM = true, AFTER_DRAIN = false;
    bf16_t* O; int ldc;
    __device__ __forceinline__ void operator()(const f32x4 (&acc)[2][2][4][2], const Unit& u, int wr, int wc, int fr, int fq) const {
        const int row0 = u.pm * BM + wr * 64 + fr, col0 = u.pn * HALF + wc * 32 + 8 * fq;
#pragma unroll
        for (int ai = 0; ai < 2; ++ai)
#pragma unroll
            for (int m = 0; m < 4; ++m) { f32x4 o0, o1;
#pragma unroll
                for (int j = 0; j < 4; ++j) { const float g0 = acc[ai][0][m][0][j], g1 = acc[ai][0][m][1][j];
                    o0[j] = g0 / (1.0f + __expf(-g0)) * acc[ai][1][m][0][j]; o1[j] = g1 / (1.0f + __expf(-g1)) * acc[ai][1][m][1][j]; }
                *(u32x4*)(O + (size_t)(row0 + ai * HALF + m * 16) * ldc + col0) = pack8(o0, o1); }
    }
};
struct EpiF32 {
    static constexpr bool PERM = false, AFTER_DRAIN = false;
    float* O; int ldc;
    __device__ __forceinline__ void operator()(const f32x4 (&acc)[2][2][4][2], const Unit& u, int wr, int wc, int fr, int fq) const {
        const int row0 = u.pm * BM + wr * 64 + fr, colb = u.pn * BM + wc * 32 + 4 * fq;
#pragma unroll
        for (int ai = 0; ai < 2; ++ai)
#pragma unroll
            for (int m = 0; m < 4; ++m) { float* xr = O + (size_t)(row0 + ai * HALF + m * 16) * ldc;
#pragma unroll
                for (int bj = 0; bj < 2; ++bj)
#pragma unroll
                    for (int n = 0; n < 2; ++n) *(f32x4*)(xr + colb + bj * HALF + n * 16) = acc[ai][bj][m][n]; }
    }
};
struct MoeOrder {
    int nM, nN, nwg, G, c; int t1[8]; size_t estride;
    __device__ __forceinline__ void init(const int* ctl, int nN_, int G_, int c_, size_t estride_) {
        int acc = 0;
#pragma unroll
        for (int e = 0; e < 8; ++e) { acc += ctl[CT_EPAD + e] >> 8; t1[e] = acc; }
        nM = acc; nN = nN_; nwg = nM * nN; G = G_; c = c_; estride = estride_;
    }
    __device__ __forceinline__ bool next(int i, Unit& u) const {
        const long L = (long)i * G + c; if (L >= nwg) return false;
        int wgid = (int)L; { const int q = nwg / NXCD, r = nwg % NXCD, xcd = wgid % NXCD, off = wgid / NXCD; wgid = (xcd < r ? xcd * (q + 1) : r * (q + 1) + (xcd - r) * q) + off; }
        const int nig = WGM * nN, gid = wgid / nig, fm = gid * WGM, gsz = (nM - fm) < WGM ? (nM - fm) : WGM;
        u.pm = fm + ((wgid % nig) % gsz); u.pn = (wgid % nig) / gsz; return true;
    }
    __device__ __forceinline__ size_t bt_off(const Unit& u) const { int e = 0;
#pragma unroll
        for (int k = 0; k < 7; ++k) e += (u.pm >= t1[k]) ? 1 : 0;
        return (size_t)e * estride; }
    __device__ __forceinline__ void a_ready(const Unit&) const {}
    __device__ __forceinline__ void done(const Unit&) const {}
};
}

#define LAS __attribute__((address_space(3)))
#define XB_TMO      128
#define XB_XCNT(j)  (256  + 64 * (j))
#define XB_XSUB(j)  (1280 + 64 * (j))
#define XB_XGEN(j)  (2304 + 64 * (j))
#define XB_TOP      3328
#define XB_TOPGEN   3392
#define XCD_BAR_WORDS 3456
#define XB_SPIN_CAP (1u << 18)

__device__ __forceinline__ unsigned xb_ld(unsigned* p)              { return __hip_atomic_load(p, __ATOMIC_RELAXED, __HIP_MEMORY_SCOPE_AGENT); }
__device__ __forceinline__ unsigned xb_add(unsigned* p, unsigned v) { return __hip_atomic_fetch_add(p, v, __ATOMIC_RELAXED, __HIP_MEMORY_SCOPE_AGENT); }
__device__ __forceinline__ unsigned xb_xcc_id() { return (unsigned)__builtin_amdgcn_s_getreg((3 << 11) | 20) & 0xFu; }
#define XB_SPIN(cond, bar) do { unsigned _sp = 0; while (cond) { __builtin_amdgcn_s_sleep(1); \
    if ((++_sp & 255u) == 0u) { if (xb_ld(&(bar)[XB_TMO])) break; if (_sp > XB_SPIN_CAP) { atomicAdd(&(bar)[XB_TMO], 1u); break; } } } } while (0)

struct XcdBarrier {
    unsigned* bar; unsigned x;
    volatile LAS unsigned* st;
};

__device__ __forceinline__ XcdBarrier xcd_barrier_post(unsigned* bar, volatile LAS unsigned* st) {
    XcdBarrier b; b.bar = bar; b.x = xb_xcc_id(); b.st = st;
    if (threadIdx.x == 0) (void)xb_add(&bar[XB_XCNT(b.x)], 1u);
    return b;
}
__device__ __forceinline__ void xcd_barrier_complete(unsigned* bar, unsigned x, unsigned& nloc, unsigned& nx) {
    const unsigned G = gridDim.x * gridDim.y * gridDim.z;
    unsigned sum, cnt, mine, sp = 0u;
    for (;;) {
        sum = 0u; cnt = 0u; mine = 0u;
#pragma unroll
        for (unsigned j = 0; j < 16; ++j) { const unsigned c = xb_ld(&bar[XB_XCNT(j)]); sum += c; cnt += (c > 0u) ? 1u : 0u; mine = (j == x) ? c : mine; }
        if (sum == G) break;
        __builtin_amdgcn_s_sleep(1);
        if ((++sp & 255u) == 0u) { if (xb_ld(&bar[XB_TMO])) break; if (sp > XB_SPIN_CAP) { atomicAdd(&bar[XB_TMO], 1u); break; } }
    }
    nloc = mine > 0u ? mine : 1u; nx = cnt > 0u ? cnt : 1u;
}

__device__ __forceinline__ void xcd_barrier(const XcdBarrier& b) {
    asm volatile("s_waitcnt vmcnt(0)" ::: "memory");
    __syncthreads();
    if (threadIdx.x == 0) {
        unsigned* bar = b.bar;
        __builtin_amdgcn_s_waitcnt(0);
        unsigned nloc = b.st[0], nx = b.st[1];
        if (nloc == 0u) { xcd_barrier_complete(bar, b.x, nloc, nx); b.st[0] = nloc; b.st[1] = nx; }
        const unsigned old = xb_add(&bar[XB_XSUB(b.x)], 1u);
        const unsigned gen = old / nloc;
        if (old + 1u == (gen + 1u) * nloc) {
            __builtin_amdgcn_fence(__ATOMIC_RELEASE, "agent");
            asm volatile("s_waitcnt vmcnt(0)" ::: "memory");
            const unsigned og = xb_add(&bar[XB_TOP], 1u);
            const unsigned tg = og / nx;
            if (og + 1u == (tg + 1u) * nx) xb_add(&bar[XB_TOPGEN], 1u);
            else XB_SPIN(xb_ld(&bar[XB_TOPGEN]) == tg, bar);
            __builtin_amdgcn_fence(__ATOMIC_ACQUIRE, "agent");
            xb_add(&bar[XB_XGEN(b.x)], 1u);
            asm volatile("s_waitcnt vmcnt(0)" ::: "memory");
        } else {
            XB_SPIN(xb_ld(&bar[XB_XGEN(b.x)]) == gen, bar);
            __builtin_amdgcn_fence(__ATOMIC_ACQUIRE, "agent");
            asm volatile("s_waitcnt vmcnt(0)" ::: "memory");
        }
    }
    __syncthreads();
}


struct Args { const float* in[34]; float* out; unsigned char* ws; int ph_lo, ph_hi; };

enum { MAP_ID = 0, MAP_ROPEQ = 1, MAP_GU0 = 2, MAP_GU1 = 3 };
struct JobDesc { int in_idx, K, N, nbatch, upb, map; long long src_off, src_bstride, dst_off, dst_bstride; };
constexpr int NJOBS = 14, NCONV = 50624;
__constant__ JobDesc c_jobs[NJOBS] = {
    {8, 2048, 3648, 1, 912, MAP_ID, 0, 0, (long long)WS_WIN, 0},
    {8, 2048, 3648, 1, 912, MAP_ID, 2048LL * 3648, 0, (long long)(WS_WIN + (size_t)UW * D * 2), 0},
    {10, 768, 1536, 1, 144, MAP_ROPEQ, 0, 0, (long long)WS_WQ, 0},
    {10, 768, 1536, 1, 144, MAP_ROPEQ, 768LL * 1536, 0, (long long)(WS_WQ + (size_t)QW * 768 * 2), 0},
    {12, 512, 2048, 1, 128, MAP_ID, 0, 0, (long long)WS_WKV, 0},
    {12, 512, 2048, 1, 128, MAP_ID, 512LL * 2048, 0, (long long)(WS_WKV + (size_t)KVW * 512 * 2), 0},
    {25, 2048, 2048, 1, 512, MAP_ID, 0, 0, (long long)WS_WOUT, 0},
    {25, 2048, 2048, 1, 512, MAP_ID, 2048LL * 2048, 0, (long long)(WS_WOUT + (size_t)D * D * 2), 0},
    {26, 2048, 5632, 1, 1408, MAP_GU0, 0, 0, (long long)WS_WGU, 0},
    {27, 2048, 5632, 1, 1408, MAP_GU1, 0, 0, (long long)WS_WGU, 0},
    {28, 5632, 2048, 1, 1408, MAP_ID, 0, 0, (long long)WS_WDN, 0},
    {30, 2048, 7168, 8, 1792, MAP_GU0, 0, 2048LL * 7168, (long long)WS_MGU, 2LL * DFE * D * 2},
    {31, 2048, 7168, 8, 1792, MAP_GU1, 0, 2048LL * 7168, (long long)WS_MGU, 2LL * DFE * D * 2},
    {32, 7168, 2048, 8, 1792, MAP_ID, 0, 7168LL * 2048, (long long)WS_MDN, (long long)D * DFE * 2},
};
struct ConvUnit { const float* src; bf16_t* dst; int K, N, map, k0, n0; };
__device__ __forceinline__ void conv_decode(const Args& a, int u, ConvUnit& cu) {
    int j = 0, base = 0;
    for (;;) { const int n = c_jobs[j].nbatch * c_jobs[j].upb; if (u < base + n || j == NJOBS - 1) break; base += n; ++j; }
    const JobDesc& jd = c_jobs[j];
    int r = u - base; const int bt = r / jd.upb; r -= bt * jd.upb; const int ntn = jd.N >> 6; const int kt = r / ntn, nt = r - kt * ntn;
    cu.K = jd.K; cu.N = jd.N; cu.map = jd.map; cu.k0 = kt * 128; cu.n0 = nt * 64;
    const float* sb = j < 2 ? a.in[8] : j < 4 ? a.in[10] : j < 6 ? a.in[12] : j < 8 ? a.in[25] : j == 8 ? a.in[26] : j == 9 ? a.in[27] : j == 10 ? a.in[28] : j == 11 ? a.in[30] : j == 12 ? a.in[31] : a.in[32];
    cu.src = sb + jd.src_off + (long long)bt * jd.src_bstride + (size_t)cu.k0 * jd.N + cu.n0;
    cu.dst = (bf16_t*)(a.ws + jd.dst_off + (long long)bt * jd.dst_bstride);
}
__device__ __forceinline__ int conv_row(int map, int n) {
    if (map == MAP_ID) return n;
    if (map == MAP_GU0) return ((n >> 7) << 8) + (n & 127);
    if (map == MAP_GU1) return ((n >> 7) << 8) + 128 + (n & 127);
    const int hh = n / 192, jn = n - hh * 192; if (jn < 128) return n; const int q = jn - 128; return hh * 192 + 128 + 2 * (q & 31) + (q >> 5);
}
__device__ __forceinline__ void ph_convert(const Args& a, float* tile) {
    const int tid = threadIdx.x, G = gridDim.x;
    int u = blockIdx.x; ConvUnit cu; f32x4 r[4];
    if (u < NCONV) { conv_decode(a, u, cu);
#pragma unroll
        for (int i = 0; i < 4; ++i) { const int idx = tid + 512 * i; r[i] = *(const f32x4*)(cu.src + (size_t)(idx >> 4) * cu.N + (idx & 15) * 4); } }
    while (u < NCONV) {
#pragma unroll
        for (int i = 0; i < 4; ++i) { const int idx = tid + 512 * i; float* tp = tile + (idx >> 4) * 65 + (idx & 15) * 4; tp[0] = r[i][0]; tp[1] = r[i][1]; tp[2] = r[i][2]; tp[3] = r[i][3]; }
        __syncthreads();
        const ConvUnit cur = cu; const int un = u + G;
        if (un < NCONV) { conv_decode(a, un, cu);
#pragma unroll
            for (int i = 0; i < 4; ++i) { const int idx = tid + 512 * i; r[i] = *(const f32x4*)(cu.src + (size_t)(idx >> 4) * cu.N + (idx & 15) * 4); } }
        const int nl = tid >> 3; const int row = conv_row(cur.map, cur.n0 + nl);
#pragma unroll
        for (int j = 0; j < 2; ++j) { const int kc = (tid & 7) + 8 * j; const float* tp = tile + (kc * 8) * 65 + nl;
            u32x4 w; w.x = pg8::cvt_pk_bf16(tp[0], tp[65]); w.y = pg8::cvt_pk_bf16(tp[130], tp[195]); w.z = pg8::cvt_pk_bf16(tp[260], tp[325]); w.w = pg8::cvt_pk_bf16(tp[390], tp[455]);
            *(u32x4*)(cur.dst + (size_t)row * cur.K + cur.k0 + kc * 8) = w; }
        __syncthreads();
        u = un;
    }
}
__device__ __forceinline__ void adaln_unit(const Args& a, int unit, float* sm) {
    const float* c = a.in[1]; const float* cctx = a.in[3]; const float* w_mod = a.in[4]; const float* b_mod = a.in[5]; float* mod = (float*)(a.ws + WS_MOD);
    const int tid = threadIdx.x, l = unit / 96, chunk = unit % 96;
    const int cg = tid & 31, ks = tid >> 5;
    for (int i = tid; i < 5 * 2048; i += 512) { const int v = i >> 11, k = i & 2047; const float val = v < 4 ? c[v * 2048 + k] : cctx[k]; sm[i] = val / (1.0f + expf(-val)); }
    __syncthreads();
    float acc[5][4];
#pragma unroll
    for (int v = 0; v < 5; ++v)
#pragma unroll
        for (int j = 0; j < 4; ++j) acc[v][j] = 0.f;
    const float* wp = w_mod + ((size_t)l * 2048 + (size_t)ks * 128) * 12288 + chunk * 128 + cg * 4;
#pragma unroll 4
    for (int kk = 0; kk < 128; ++kk) {
        const f32x4 w = *(const f32x4*)(wp + (size_t)kk * 12288);
        const int k = ks * 128 + kk;
#pragma unroll
        for (int v = 0; v < 5; ++v) { const float s = sm[v * 2048 + k];
#pragma unroll
            for (int j = 0; j < 4; ++j) acc[v][j] += s * w[j]; }
    }
    __syncthreads();
#pragma unroll
    for (int v = 0; v < 5; ++v)
#pragma unroll
        for (int j = 0; j < 4; ++j) sm[(ks * 5 + v) * 128 + cg * 4 + j] = acc[v][j];
    __syncthreads();
    for (int o = tid; o < 640; o += 512) {
        const int v = o >> 7, cc = o & 127; float s = 0.f;
        for (int k2 = 0; k2 < 16; ++k2) s += sm[(k2 * 5 + v) * 128 + cc];
        mod[((size_t)l * 5 + v) * 12288 + chunk * 128 + cc] = s + b_mod[(size_t)l * 12288 + chunk * 128 + cc];
    }
    __syncthreads();
}
__device__ __forceinline__ void filters_unit(const Args& a, int unit, float* sm) {
    float (*zs)[36] = (float (*)[36])sm; float (*ha)[64] = (float (*)[64])(sm + 8 * 36); float (*hb)[64] = (float (*)[64])(sm + 8 * 36 + 8 * 64);
    const int tid = threadIdx.x, l = unit / 288, r = unit % 288;
    const bool lat = r < 256; const int Lf = lat ? 2048 : 256; const int p0 = lat ? r * 8 : (r - 256) * 8;
    float* T = lat ? (float*)(a.ws + WS_FILTL) + (size_t)l * 512 * 4096 : (float*)(a.ws + WS_FILTC) + (size_t)l * 512 * 512;
    const float* w1 = a.in[15] + l * 33 * 64; const float* b1 = a.in[16] + l * 64; const float* w2 = a.in[17] + l * 64 * 64; const float* b2 = a.in[18] + l * 64;
    const float* w3 = a.in[19] + l * 64 * 64; const float* b3 = a.in[20] + l * 64; const float* wf = a.in[21] + (size_t)l * 64 * 1024; const float* fr = a.in[22] + l * 64;
    const int p = tid >> 6, j = tid & 63; const int pos = p0 + p;
    const float tn = (float)pos / (float)(Lf - 1);
    if (j < 33) {
        float z;
        if (j == 0) z = tn;
        else { const int bi = (j - 1) & 15; const float band = 1e-4f + (float)bi * ((15.0f - 1e-4f) / 15.0f);
               const float ang = (6.283185307179586f / (float)Lf) * (float)pos * band; z = (j <= 16) ? cosf(ang) : -sinf(ang); }
        zs[p][j] = z;
    }
    __syncthreads();
    const float f = fr[j];
    { float s = b1[j]; for (int i = 0; i < 33; ++i) s += zs[p][i] * w1[i * 64 + j]; ha[p][j] = sinf(f * s); }
    __syncthreads();
    { float s = b2[j]; for (int i = 0; i < 64; ++i) s += ha[p][i] * w2[i * 64 + j]; hb[p][j] = sinf(f * s); }
    __syncthreads();
    { float s = b3[j]; for (int i = 0; i < 64; ++i) s += hb[p][i] * w3[i * 64 + j]; ha[p][j] = sinf(f * s); }
    __syncthreads();
#pragma unroll
    for (int rr = 0; rr < 2; ++rr) {
        const int o = tid + rr * 512; float acc[8];
#pragma unroll
        for (int q = 0; q < 8; ++q) acc[q] = 0.f;
        for (int i = 0; i < 64; ++i) { const float w = wf[i * 1024 + o];
#pragma unroll
            for (int q = 0; q < 8; ++q) acc[q] += ha[q][i] * w; }
        const int ch = o & 511; const bool back = o >= 512;
        const float delta = 3.0701134573253944f + (float)ch * ((15.350567286626972f - 3.0701134573253944f) / 511.0f);
#pragma unroll
        for (int q = 0; q < 8; ++q) {
            const int ps = p0 + q; const float t2 = (float)ps / (float)(Lf - 1);
            const float val = acc[q] * expf(-t2 * delta);
            if (!back) T[(size_t)ch * (2 * Lf) + Lf + ps] = val;
            else if (ps > 0) T[(size_t)ch * (2 * Lf) + Lf - ps] = val;
            else T[(size_t)ch * (2 * Lf)] = 0.f;
        }
    }
    __syncthreads();
}
__device__ __forceinline__ void ph_prologue(const Args& a, float* sm) {
    const int bid = blockIdx.x, G = gridDim.x, tid = threadIdx.x;
    for (int u = bid; u < 192; u += G) adaln_unit(a, u, sm);
    for (int u = bid; u < 576; u += G) filters_unit(a, u, sm);
    { float* cosT = (float*)(a.ws + WS_ROPE); float* sinT = cosT + 2048 * 32;
      for (int i = bid * 512 + tid; i < 2048 * 32; i += G * 512) { const int t = i >> 5, f = i & 31;
          const float pos = (float)((f < 16) ? (t >> 6) : (t & 63)); const float freq = powf(10000.0f, -(float)(f & 15) / 16.0f); const float ang = pos * freq;
          cosT[i] = cosf(ang); sinT[i] = sinf(ang); } }
    for (int i = bid * 512 + tid; i < 2 * 192 * 256; i += G * 512) { const int l = i / (192 * 256), r = i % (192 * 256);
        *(u32x4*)(a.ws + WS_WIN + (size_t)l * UW * D * 2 + (size_t)INW * D * 2 + (size_t)r * 16) = (u32x4){0u, 0u, 0u, 0u}; }
    ph_convert(a, sm);
}

template <bool ROUTER, bool COPYX>
__device__ __forceinline__ void ph_normmod(const float* __restrict__ xlat, const float* __restrict__ xctx, const float* __restrict__ gain, const float* __restrict__ modl, int sh_off, int sc_off,
                                           bf16_t* __restrict__ out, int nrows, float* __restrict__ xs, const float* __restrict__ router, int* __restrict__ topi, float* __restrict__ topw) {
    const int lane = threadIdx.x & 63, wid = threadIdx.x >> 6;
    for (int row = blockIdx.x * 8 + wid; row < nrows; row += gridDim.x * 8) {
        const float* xr = row < NLAT ? xlat + (size_t)row * D : xctx + (size_t)(row - NLAT) * D;
        const float* mv = modl + (size_t)tok_mod(row) * 12288;
        f32x4 v[8]; float ss = 0.f;
#pragma unroll
        for (int i = 0; i < 8; ++i) { v[i] = *(const f32x4*)(xr + i * 256 + lane * 4); ss += v[i][0] * v[i][0] + v[i][1] * v[i][1] + v[i][2] * v[i][2] + v[i][3] * v[i][3];
            if (COPYX) *(f32x4*)(xs + (size_t)row * D + i * 256 + lane * 4) = v[i]; }
        ss = wave_sum(ss);
        const float rstd = rsqrtf(ss * (1.0f / D) + EPS);
        float lg[8];
#pragma unroll
        for (int e = 0; e < 8; ++e) lg[e] = 0.f;
#pragma unroll
        for (int i = 0; i < 8; ++i) {
            const int col = i * 256 + lane * 4;
            const f32x4 g = *(const f32x4*)(gain + col), sc = *(const f32x4*)(mv + sc_off + col), sh = *(const f32x4*)(mv + sh_off + col);
            f32x4 o;
#pragma unroll
            for (int j = 0; j < 4; ++j) o[j] = (v[i][j] * rstd * g[j]) * (1.0f + sc[j]) + sh[j];
            u32x2 w; w.x = (unsigned)f2bf(o[0]) | ((unsigned)f2bf(o[1]) << 16); w.y = (unsigned)f2bf(o[2]) | ((unsigned)f2bf(o[3]) << 16);
            *(u32x2*)(out + (size_t)row * D + col) = w;
            if (ROUTER) {
#pragma unroll
                for (int j = 0; j < 4; ++j) { const f32x4 r0 = *(const f32x4*)(router + (size_t)(col + j) * 8), r1 = *(const f32x4*)(router + (size_t)(col + j) * 8 + 4);
                    lg[0] += o[j] * r0[0]; lg[1] += o[j] * r0[1]; lg[2] += o[j] * r0[2]; lg[3] += o[j] * r0[3];
                    lg[4] += o[j] * r1[0]; lg[5] += o[j] * r1[1]; lg[6] += o[j] * r1[2]; lg[7] += o[j] * r1[3]; }
                asm volatile("" ::: "memory");
            }
        }
        if (ROUTER) {
#pragma unroll
            for (int e = 0; e < 8; ++e) lg[e] = wave_sum(lg[e]);
            if (lane == 0) {
                int i0 = 0; float v0 = lg[0];
#pragma unroll
                for (int e = 1; e < 8; ++e) if (lg[e] > v0) { v0 = lg[e]; i0 = e; }
                int i1 = -1; float v1 = -3.0e38f;
#pragma unroll
                for (int e = 0; e < 8; ++e) if (e != i0 && lg[e] > v1) { v1 = lg[e]; i1 = e; }
                const float e1 = expf(v1 - v0), w0 = 1.0f / (1.0f + e1), w1 = e1 / (1.0f + e1);
                topi[row * 2] = i0; topi[row * 2 + 1] = i1; topw[row * 2] = w0; topw[row * 2 + 1] = w1;
            }
        }
    }
}

__device__ __forceinline__ void ph_mid(const Args& a, int l) {
    const bf16_t* __restrict__ U = (const bf16_t*)(a.ws + WS_U);
    const float* g_q = a.in[9] + l * 768; const float* g_kv = a.in[11] + l * 512; const float* conv_w = a.in[13] + (size_t)l * 3 * 1536; const float* conv_b = a.in[14] + l * 1536;
    const float* cosT = (const float*)(a.ws + WS_ROPE); const float* sinT = cosT + 2048 * 32;
    bf16_t* cqn = (bf16_t*)(a.ws + WS_CQN); bf16_t* ckvn = (bf16_t*)(a.ws + WS_CKVN); bf16_t* kpe = (bf16_t*)(a.ws + WS_KPE); bf16_t* x0o = (bf16_t*)(a.ws + WS_X0);
    bf16_t* wtl = (bf16_t*)(a.ws + WS_WTL); bf16_t* wtc = (bf16_t*)(a.ws + WS_WTC); bf16_t* sq = (bf16_t*)(a.ws + WS_SQ); bf16_t* sk = (bf16_t*)(a.ws + WS_SK); bf16_t* sv = (bf16_t*)(a.ws + WS_SV);
    const int tid = threadIdx.x, lane = tid & 63, wid = tid >> 6;
    for (int unit = blockIdx.x; unit < NTOK / 16; unit += gridDim.x) {
        const int tok0 = unit * 16;
        for (int tt = 0; tt < 2; ++tt) {
            const int tok = tok0 + wid * 2 + tt; const bool lat = tok < NLAT; const int t = lat ? (tok & 2047) : ((tok - NLAT) & 255);
            const bf16_t* u = U + (size_t)tok * UW;
            { float x[12]; float ss = 0.f;
#pragma unroll
              for (int i = 0; i < 12; ++i) { x[i] = bf2f(u[O_CQ + i * 64 + lane]); ss += x[i] * x[i]; }
              ss = wave_sum(ss); const float rs = rsqrtf(ss * (1.0f / 768.0f) + EPS);
#pragma unroll
              for (int i = 0; i < 12; ++i) cqn[(size_t)tok * 768 + i * 64 + lane] = f2bf(x[i] * rs * g_q[i * 64 + lane]); }
            { float x[8]; float ss = 0.f;
#pragma unroll
              for (int i = 0; i < 8; ++i) { x[i] = bf2f(u[O_CKV + i * 64 + lane]); ss += x[i] * x[i]; }
              ss = wave_sum(ss); const float rs = rsqrtf(ss * (1.0f / 512.0f) + EPS);
#pragma unroll
              for (int i = 0; i < 8; ++i) ckvn[(size_t)tok * 512 + i * 64 + lane] = f2bf(x[i] * rs * g_kv[i * 64 + lane]); }
            const int pi = lane & 31;
            const float cs = lat ? cosT[t * 32 + pi] : 1.0f, sn = lat ? sinT[t * 32 + pi] : 0.0f;
            if (lane < 32) {
                const float aa = bf2f(u[O_KPE + pi]), bb = bf2f(u[O_KPE + 32 + pi]);
                kpe[(size_t)tok * 64 + 2 * pi] = f2bf(aa * cs - bb * sn); kpe[(size_t)tok * 64 + 2 * pi + 1] = f2bf(aa * sn + bb * cs);
            }
#pragma unroll
            for (int r = 0; r < 4; ++r) { const int pr = r * 64 + lane, h = pr >> 5;
                const float aa = bf2f(u[O_SQ + h * 64 + pi]), bb = bf2f(u[O_SQ + h * 64 + 32 + pi]);
                sq[(size_t)tok * 512 + h * 64 + pi] = f2bf(aa * cs - bb * sn); sq[(size_t)tok * 512 + h * 64 + 32 + pi] = f2bf(aa * sn + bb * cs); }
            { const int h = lane >> 5;
              const float aa = bf2f(u[O_SK + h * 64 + pi]), bb = bf2f(u[O_SK + h * 64 + 32 + pi]);
              sk[(size_t)tok * 128 + h * 64 + pi] = f2bf(aa * cs - bb * sn); sk[(size_t)tok * 128 + h * 64 + 32 + pi] = f2bf(aa * sn + bb * cs); }
            sv[(size_t)tok * 128 + lane] = u[O_SV + lane]; sv[(size_t)tok * 128 + 64 + lane] = u[O_SV + 64 + lane];
        }
        {
            const bool lat = tok0 < NLAT; const int Ls = lat ? L : C;
            const int b = lat ? (tok0 >> 11) : ((tok0 - NLAT) >> 8), t0 = lat ? (tok0 & 2047) : ((tok0 - NLAT) & 255);
            const int ch = tid;
            float cw[3][3], cb[3];
#pragma unroll
            for (int g = 0; g < 3; ++g) { cb[g] = conv_b[g * 512 + ch];
#pragma unroll
                for (int j = 0; j < 3; ++j) cw[g][j] = conv_w[j * 1536 + g * 512 + ch]; }
            float prev[3], cur[3], nxt[3];
#pragma unroll
            for (int g = 0; g < 3; ++g) { prev[g] = (t0 > 0) ? bf2f(U[(size_t)(tok0 - 1) * UW + O_HY + g * 512 + ch]) : 0.f; cur[g] = bf2f(U[(size_t)tok0 * UW + O_HY + g * 512 + ch]); }
            unsigned pk[8];
#pragma unroll
            for (int i = 0; i < 16; ++i) {
                const bool hasn = (t0 + i + 1) < Ls;
                float y[3];
#pragma unroll
                for (int g = 0; g < 3; ++g) { nxt[g] = hasn ? bf2f(U[(size_t)(tok0 + i + 1) * UW + O_HY + g * 512 + ch]) : 0.f;
                    y[g] = cb[g] + cw[g][0] * prev[g] + cw[g][1] * cur[g] + cw[g][2] * nxt[g]; prev[g] = cur[g]; cur[g] = nxt[g]; }
                x0o[(size_t)(tok0 + i) * 512 + ch] = f2bf(y[0]);
                const unsigned wv = f2bf(y[2] * y[1]);
                if (i & 1) pk[i >> 1] |= wv << 16; else pk[i >> 1] = wv;
            }
            bf16_t* wt = lat ? wtl + ((size_t)b * 512 + ch) * L + t0 : wtc + ((size_t)b * 512 + ch) * C + t0;
            u32x4 w0, w1; w0.x = pk[0]; w0.y = pk[1]; w0.z = pk[2]; w0.w = pk[3]; w1.x = pk[4]; w1.y = pk[5]; w1.z = pk[6]; w1.w = pk[7];
            *(u32x4*)wt = w0; *(u32x4*)(wt + 8) = w1;
        }
    }
}

__device__ __forceinline__ void ph_mla_naive(const Args& a, int nq, float* sm) {
    const bf16_t* __restrict__ Q = (const bf16_t*)(a.ws + WS_Q); const bf16_t* __restrict__ KV = (const bf16_t*)(a.ws + WS_KV); const bf16_t* __restrict__ KPE = (const bf16_t*)(a.ws + WS_KPE);
    bf16_t* mix = (bf16_t*)(a.ws + WS_MIX);
    const int lane = threadIdx.x & 63, w = threadIdx.x >> 6;
    float* qf = sm + w * 192; float* sc = sm + 8 * 192 + w * 2304;
    for (int unit = blockIdx.x; unit < nq; unit += gridDim.x) {
        const int h = unit & 7, qt = (unit >> 3) * 8 + w; const bool lat = qt < NLAT;
        const int b = lat ? (qt >> 11) : ((qt - NLAT) >> 8);
        const int nk = lat ? (L + C) : C;
        for (int i = lane; i < 192; i += 64) qf[i] = bf2f(Q[(size_t)qt * QW + h * 192 + i]);
        __syncthreads();
        const float scale = 0.07216878364870322f;
        float mx = -3.0e38f;
        for (int kc = 0; kc < nk; kc += 64) {
            const int kk = kc + lane;
            const int kt = lat ? (kk < L ? b * L + kk : NLAT + b * C + (kk - L)) : (NLAT + b * C + kk);
            float s = 0.f;
            const u32x4* kp = (const u32x4*)(KV + (size_t)kt * KVW + h * 256);
            for (int i = 0; i < 16; ++i) { const u32x4 v = kp[i]; const float* q8 = qf + i * 8;
                s += q8[0] * __uint_as_float(v.x << 16) + q8[1] * __uint_as_float(v.x & 0xffff0000u) + q8[2] * __uint_as_float(v.y << 16) + q8[3] * __uint_as_float(v.y & 0xffff0000u)
                   + q8[4] * __uint_as_float(v.z << 16) + q8[5] * __uint_as_float(v.z & 0xffff0000u) + q8[6] * __uint_as_float(v.w << 16) + q8[7] * __uint_as_float(v.w & 0xffff0000u); }
            const u32x4* pp = (const u32x4*)(KPE + (size_t)kt * 64);
            for (int i = 0; i < 8; ++i) { const u32x4 v = pp[i]; const float* q8 = qf + 128 + i * 8;
                s += q8[0] * __uint_as_float(v.x << 16) + q8[1] * __uint_as_float(v.x & 0xffff0000u) + q8[2] * __uint_as_float(v.y << 16) + q8[3] * __uint_as_float(v.y & 0xffff0000u)
                   + q8[4] * __uint_as_float(v.z << 16) + q8[5] * __uint_as_float(v.z & 0xffff0000u) + q8[6] * __uint_as_float(v.w << 16) + q8[7] * __uint_as_float(v.w & 0xffff0000u); }
            s *= scale; sc[kk] = s; mx = fmaxf(mx, s);
        }
        mx = wave_max(mx);
        float sum = 0.f;
        for (int kc = 0; kc < nk; kc += 64) { const float p = expf(sc[kc + lane] - mx); sc[kc + lane] = p; sum += p; }
        sum = wave_sum(sum);
        __syncthreads();
        float o0 = 0.f, o1 = 0.f;
        for (int kk = 0; kk < nk; ++kk) {
            const int kt = lat ? (kk < L ? b * L + kk : NLAT + b * C + (kk - L)) : (NLAT + b * C + kk);
            const unsigned v = *(const unsigned*)(KV + (size_t)kt * KVW + h * 256 + 128 + lane * 2);
            const float p = sc[kk];
            o0 += p * __uint_as_float(v << 16); o1 += p * __uint_as_float(v & 0xffff0000u);
        }
        const float inv = 1.0f / sum;
        *(unsigned*)(mix + (size_t)qt * D + h * 128 + lane * 2) = (unsigned)f2bf(o0 * inv) | ((unsigned)f2bf(o1 * inv) << 16);
        __syncthreads();
    }
}
__device__ __forceinline__ void ph_swa_naive(const Args& a, int l, int nq, float* sm) {
    const bf16_t* __restrict__ SQ = (const bf16_t*)(a.ws + WS_SQ); const bf16_t* __restrict__ SK = (const bf16_t*)(a.ws + WS_SK); const bf16_t* __restrict__ SV = (const bf16_t*)(a.ws + WS_SV);
    const float* sink = a.in[24] + l * 8; bf16_t* mix = (bf16_t*)(a.ws + WS_MIX);
    const int lane = threadIdx.x & 63, w = threadIdx.x >> 6;
    float* qf = sm + w * 64; float* sc = sm + 8 * 64 + w * 576; int* kts = (int*)(sm + 8 * 64 + 8 * 576) + w * 576;
    for (int unit = blockIdx.x; unit < nq; unit += gridDim.x) {
        const int hq = unit & 7, hk = hq >> 2, qt = (unit >> 3) * 8 + w; const bool lat = qt < NLAT;
        const int b = lat ? (qt >> 11) : ((qt - NLAT) >> 8), t = lat ? (qt & 2047) : 0;
        int lo = 0, nloc = 0;
        if (lat) { lo = t - 128 < 0 ? 0 : t - 128; const int hi = t + 128 > L - 1 ? L - 1 : t + 128; nloc = hi - lo + 1; }
        const int nk = nloc + C;
        qf[lane] = bf2f(SQ[(size_t)qt * 512 + hq * 64 + lane]);
        __syncthreads();
        const float skv = sink[hq];
        float mx = skv;
        for (int kc = 0; kc < nk; kc += 64) {
            const int kk = kc + lane;
            if (kk < nk) {
                const int kt = kk < nloc ? (b * L + lo + kk) : (NLAT + b * C + (kk - nloc));
                const u32x4* kp = (const u32x4*)(SK + (size_t)kt * 128 + hk * 64);
                float s = 0.f;
                for (int i = 0; i < 8; ++i) { const u32x4 v = kp[i]; const float* q8 = qf + i * 8;
                    s += q8[0] * __uint_as_float(v.x << 16) + q8[1] * __uint_as_float(v.x & 0xffff0000u) + q8[2] * __uint_as_float(v.y << 16) + q8[3] * __uint_as_float(v.y & 0xffff0000u)
                       + q8[4] * __uint_as_float(v.z << 16) + q8[5] * __uint_as_float(v.z & 0xffff0000u) + q8[6] * __uint_as_float(v.w << 16) + q8[7] * __uint_as_float(v.w & 0xffff0000u); }
                s *= 0.125f; sc[kk] = s; kts[kk] = kt; mx = fmaxf(mx, s);
            }
        }
        mx = wave_max(mx);
        float sum = 0.f;
        for (int kc = 0; kc < nk; kc += 64) { const int kk = kc + lane; if (kk < nk) { const float p = expf(sc[kk] - mx); sc[kk] = p; sum += p; } }
        sum = wave_sum(sum) + expf(skv - mx);
        __syncthreads();
        float o = 0.f;
        for (int kk = 0; kk < nk; ++kk) o += sc[kk] * bf2f(SV[(size_t)kts[kk] * 128 + hk * 64 + lane]);
        mix[(size_t)qt * D + 1536 + hq * 64 + lane] = f2bf(o / sum);
        __syncthreads();
    }
}
template <int LS>
__device__ __forceinline__ void ph_hyena_naive(const Args& a, int l, float* sm) {
    const float* filt = LS == L ? (const float*)(a.ws + WS_FILTL) + (size_t)l * 512 * 4096 : (const float*)(a.ws + WS_FILTC) + (size_t)l * 512 * 512;
    const bf16_t* wt = (const bf16_t*)(a.ws + (LS == L ? WS_WTL : WS_WTC)); const bf16_t* x0 = (const bf16_t*)(a.ws + WS_X0); const float* skip = a.in[23] + l * 512;
    bf16_t* mix = (bf16_t*)(a.ws + WS_MIX); const int tok_base = LS == L ? 0 : NLAT;
    float* T = sm; float* ws = sm + 2 * LS; const int tid = threadIdx.x;
    for (int unit = blockIdx.x; unit < 512 * NB; unit += gridDim.x) {
        const int ch = unit >> 2, b = unit & 3;
        for (int i = tid; i < 2 * LS; i += NTHR) T[i] = filt[(size_t)ch * 2 * LS + i];
        for (int i = tid; i < LS; i += NTHR) ws[i] = bf2f(wt[((size_t)b * 512 + ch) * LS + i]);
        __syncthreads();
        const float sk = skip[ch];
        for (int t = tid; t < LS; t += NTHR) {
            float y = 0.f;
            for (int s = 0; s < LS; ++s) y += T[t - s + LS] * ws[s];
            const int tok = tok_base + b * LS + t;
            mix[(size_t)tok * D + 1024 + ch] = f2bf(bf2f(x0[(size_t)tok * 512 + ch]) * (y + sk * ws[t]));
        }
        __syncthreads();
    }
}
__device__ __forceinline__ void ph_route(const Args& a, int* sm) {
    const int* topi = (const int*)(a.ws + WS_TOPI); int* pos = (int*)(a.ws + WS_POS); int* src = (int*)(a.ws + WS_SRC); int* ctl = (int*)(a.ws + WS_CTL);
    if (blockIdx.x != 0) return;
    int (*cnt)[512] = (int (*)[512])sm; int* eoff = sm + 8 * 512;
    const int tid = threadIdx.x;
    for (int i = tid; i < MOE_ROWS; i += NTHR) src[i] = -1;
    int c[8];
#pragma unroll
    for (int e = 0; e < 8; ++e) c[e] = 0;
    for (int i = 0; i < 32; ++i) { const int e = topi[tid * 32 + i];
#pragma unroll
        for (int q = 0; q < 8; ++q) c[q] += (e == q) ? 1 : 0; }
#pragma unroll
    for (int e = 0; e < 8; ++e) cnt[e][tid] = c[e];
    __syncthreads();
    if (tid < 8) { int s = 0; for (int i = 0; i < 512; ++i) { const int v = cnt[tid][i]; cnt[tid][i] = s; s += v; } eoff[tid] = s; }
    __syncthreads();
    if (tid == 0) { int o = 0; for (int e = 0; e < 8; ++e) { const int n = eoff[e], p = (n + 255) & ~255; ctl[CT_EOFF + e] = o; ctl[CT_EPAD + e] = p; eoff[e] = o; o += p; } ctl[CT_NTILE] = o >> 8; }
    __syncthreads();
#pragma unroll
    for (int e = 0; e < 8; ++e) c[e] = eoff[e] + cnt[e][tid];
    for (int i = 0; i < 32; ++i) { const int idx = tid * 32 + i; const int e = topi[idx]; int p = 0;
#pragma unroll
        for (int q = 0; q < 8; ++q) if (e == q) { p = c[q]; c[q]++; }
        pos[idx] = p; src[p] = idx >> 1; }
}
__device__ __forceinline__ void ph_gather(const Args& a) {
    const bf16_t* hb = (const bf16_t*)(a.ws + WS_HA); const int* src = (const int*)(a.ws + WS_SRC); bf16_t* hbs = (bf16_t*)(a.ws + WS_HBS);
    const int nrows = ((const int*)(a.ws + WS_CTL))[CT_NTILE] * 256;
    const int half = threadIdx.x >> 8, t = threadIdx.x & 255;
    for (int r = blockIdx.x * 2 + half; r < nrows; r += gridDim.x * 2) {
        const int s = src[r]; u32x4 v = (u32x4){0u, 0u, 0u, 0u};
        if (s >= 0) v = *(const u32x4*)(hb + (size_t)s * D + t * 8);
        *(u32x4*)(hbs + (size_t)r * D + t * 8) = v;
    }
}
__device__ __forceinline__ void ph_final(const Args& a) {
    const float* xs = (const float*)(a.ws + WS_XS); const float* ys = (const float*)(a.ws + WS_YS); const int* pos = (const int*)(a.ws + WS_POS); const float* topw = (const float*)(a.ws + WS_TOPW);
    const float* modl = (const float*)(a.ws + WS_MOD) + (size_t)5 * 12288; const float* gfin = a.in[33]; float* out = a.out;
    const int lane = threadIdx.x & 63, wid = threadIdx.x >> 6;
    for (int row = blockIdx.x * 8 + wid; row < NLAT; row += gridDim.x * 8) {
        const float* g2 = modl + (size_t)tok_mod(row) * 12288 + 10240;
        const int p0 = pos[row * 2], p1 = pos[row * 2 + 1]; const float w0 = topw[row * 2], w1 = topw[row * 2 + 1];
        f32x4 v[8]; float ss = 0.f;
#pragma unroll
        for (int i = 0; i < 8; ++i) { const int col = i * 256 + lane * 4;
            const f32x4 x = *(const f32x4*)(xs + (size_t)row * D + col), ya = *(const f32x4*)(ys + (size_t)p0 * D + col), yb = *(const f32x4*)(ys + (size_t)p1 * D + col), g = *(const f32x4*)(g2 + col);
#pragma unroll
            for (int j = 0; j < 4; ++j) { v[i][j] = x[j] + g[j] * (w0 * ya[j] + w1 * yb[j]); ss += v[i][j] * v[i][j]; } }
        ss = wave_sum(ss); const float rstd = rsqrtf(ss * (1.0f / D) + EPS);
#pragma unroll
        for (int i = 0; i < 8; ++i) { const int col = i * 256 + lane * 4; const f32x4 g = *(const f32x4*)(gfin + col); f32x4 o;
#pragma unroll
            for (int j = 0; j < 4; ++j) o[j] = v[i][j] * rstd * g[j];
            *(f32x4*)(out + (size_t)row * D + col) = o; }
    }
}

constexpr int NPHASES = 22;
#define GEMM_CALL(EPI, SCHED, g, S, E) pg8::gemm_phase<EPI, SCHED, true, true>((PG8_LAS unsigned char*)lds, g, S, E)

template <int LYR>
__device__ __forceinline__ void layer_phases(const Args& a, unsigned char* lds, const XcdBarrier& bar, int lo, int hi) {
#define IN(k) (lo <= (k) && (k) < hi)
#if MK_PER_PHASE
#define SEAM(k) do { } while (0)
#else
#define SEAM(k) do { if (IN(k) && IN((k) + 1)) xcd_barrier(bar); } while (0)
#endif
    constexpr int P0 = 1 + LYR * 9;
    constexpr bool LAST = (LYR == 1);
    const int G = gridDim.x, bid = blockIdx.x;
    unsigned char* ws = a.ws;
    const float* modl = (const float*)(ws + WS_MOD) + (size_t)LYR * 5 * 12288;
    float* xs = (float*)(ws + WS_XS);
    const int nq = LAST ? NLAT : NTOK;
    if (IN(P0 + 0)) {
        if (LYR == 0) ph_normmod<false, true>(a.in[0], a.in[2], a.in[6], modl, 0, 2048, (bf16_t*)(ws + WS_HA), NTOK, xs, nullptr, nullptr, nullptr);
        else ph_normmod<false, false>(xs, xs + (size_t)NLAT * D, a.in[6] + D, modl, 0, 2048, (bf16_t*)(ws + WS_HA), NTOK, nullptr, nullptr, nullptr, nullptr);
    }
    SEAM(P0 + 0);
    if (IN(P0 + 1)) {
        pg8::Gemm g{(const bf16_t*)(ws + WS_HA), (const bf16_t*)(ws + WS_WIN + (size_t)LYR * UW * D * 2), NTOK, UW, D};
        pg8::StaticOrder S; S.init(NTOK, UW, G, bid); pg8::EpiStore E{(bf16_t*)(ws + WS_U), UW};
        GEMM_CALL(pg8::EpiStore, pg8::StaticOrder, g, S, E);
    }
    SEAM(P0 + 1);
    if (IN(P0 + 2)) ph_mid(a, LYR);
    SEAM(P0 + 2);
    if (IN(P0 + 3)) {
        { pg8::Gemm g{(const bf16_t*)(ws + WS_CQN), (const bf16_t*)(ws + WS_WQ + (size_t)LYR * QW * 768 * 2), nq, QW, 768};
          pg8::StaticOrder S; S.init(nq, QW, G, bid); pg8::EpiQ E{(bf16_t*)(ws + WS_Q), (const float*)(ws + WS_ROPE), (const float*)(ws + WS_ROPE) + 2048 * 32};
          GEMM_CALL(pg8::EpiQ, pg8::StaticOrder, g, S, E); }
        __syncthreads();
        { pg8::Gemm g{(const bf16_t*)(ws + WS_CKVN), (const bf16_t*)(ws + WS_WKV + (size_t)LYR * KVW * 512 * 2), NTOK, KVW, 512};
          pg8::StaticOrder S; S.init(NTOK, KVW, G, G - 1 - bid); pg8::EpiStore E{(bf16_t*)(ws + WS_KV), KVW};
          GEMM_CALL(pg8::EpiStore, pg8::StaticOrder, g, S, E); }
        __syncthreads();
        ph_hyena_naive<L>(a, LYR, (float*)lds);
        if (!LAST) ph_hyena_naive<C>(a, LYR, (float*)lds);
        ph_swa_naive(a, LYR, nq, (float*)lds);
    }
    SEAM(P0 + 3);
    if (IN(P0 + 4)) ph_mla_naive(a, nq, (float*)lds);
    SEAM(P0 + 4);
    if (IN(P0 + 5)) {
        pg8::Gemm g{(const bf16_t*)(ws + WS_MIX), (const bf16_t*)(ws + WS_WOUT + (size_t)LYR * D * D * 2), nq, D, D};
        pg8::StaticOrder S; S.init(nq, D, G, bid); pg8::EpiResid E{xs, modl + 4096};
        GEMM_CALL(pg8::EpiResid, pg8::StaticOrder, g, S, E);
    }
    SEAM(P0 + 5);
    if (!LAST) {
        if (IN(P0 + 6)) ph_normmod<false, false>(xs, xs + (size_t)NLAT * D, a.in[7], modl, 6144, 8192, (bf16_t*)(ws + WS_HA), NTOK, nullptr, nullptr, nullptr, nullptr);
        SEAM(P0 + 6);
        if (IN(P0 + 7)) {
            pg8::Gemm g{(const bf16_t*)(ws + WS_HA), (const bf16_t*)(ws + WS_WGU), NTOK, 2 * DFF, D};
            pg8::StaticOrder S; S.init(NTOK, 2 * DFF, G, bid); pg8::EpiSwiGLU E{(bf16_t*)(ws + WS_ACT), DFF};
            GEMM_CALL(pg8::EpiSwiGLU, pg8::StaticOrder, g, S, E);
        }
        SEAM(P0 + 7);
        if (IN(P0 + 8)) {
            pg8::Gemm g{(const bf16_t*)(ws + WS_ACT), (const bf16_t*)(ws + WS_WDN), NTOK, D, DFF};
            pg8::StaticOrder S; S.init(NTOK, D, G, bid); pg8::EpiResid E{xs, modl + 10240};
            GEMM_CALL(pg8::EpiResid, pg8::StaticOrder, g, S, E);
        }
        SEAM(P0 + 8);
    } else {
        if (IN(P0 + 6)) ph_normmod<true, false>(xs, xs + (size_t)NLAT * D, a.in[7] + D, modl, 6144, 8192, (bf16_t*)(ws + WS_HA), NLAT, nullptr, a.in[29], (int*)(ws + WS_TOPI), (float*)(ws + WS_TOPW));
        SEAM(P0 + 6);
        if (IN(P0 + 7)) ph_route(a, (int*)lds);
        SEAM(P0 + 7);
        if (IN(P0 + 8)) ph_gather(a);
        SEAM(P0 + 8);
        if (IN(P0 + 9)) {
            pg8::Gemm g{(const bf16_t*)(ws + WS_HBS), (const bf16_t*)(ws + WS_MGU), MOE_ROWS, 2 * DFE, D};
            pg8::MoeOrder S; S.init((const int*)(ws + WS_CTL), 2 * DFE / 256, G, bid, (size_t)2 * DFE * D * 2); pg8::EpiSwiGLU E{(bf16_t*)(ws + WS_ACT), DFE};
            GEMM_CALL(pg8::EpiSwiGLU, pg8::MoeOrder, g, S, E);
        }
        SEAM(P0 + 9);
        if (IN(P0 + 10)) {
            pg8::Gemm g{(const bf16_t*)(ws + WS_ACT), (const bf16_t*)(ws + WS_MDN), MOE_ROWS, D, DFE};
            pg8::MoeOrder S; S.init((const int*)(ws + WS_CTL), D / 256, G, bid, (size_t)D * DFE * 2); pg8::EpiF32 E{(float*)(ws + WS_YS), D};
            GEMM_CALL(pg8::EpiF32, pg8::MoeOrder, g, S, E);
        }
        SEAM(P0 + 10);
        if (IN(P0 + 11)) ph_final(a);
    }
#undef IN
#undef SEAM
}

__global__ void __launch_bounds__(NTHR, 2) mk_fwd(Args a) {
    extern __shared__ __attribute__((aligned(16))) unsigned char lds[];
    const int tid = threadIdx.x;
    for (int u = tid; u < (LDS_BYTES - LDSCTL_OFF) / 4; u += NTHR) ((unsigned*)(lds + LDSCTL_OFF))[u] = 0u;
    __syncthreads();
    XcdBarrier bar; bar.bar = (unsigned*)(a.ws + WS_CTL) + CW_BAR; bar.x = 0; bar.st = nullptr;
#if !MK_PER_PHASE
    bar = xcd_barrier_post((unsigned*)(a.ws + WS_CTL) + CW_BAR, (volatile LAS unsigned*)(lds + LDSCTL_OFF + 32));
#endif
    const int lo = a.ph_lo, hi = a.ph_hi;
    if (lo <= 0 && 0 < hi) {
        ph_prologue(a, (float*)lds);
#if !MK_PER_PHASE
        if (1 < hi) xcd_barrier(bar);
#endif
    }
    layer_phases<0>(a, lds, bar, lo, hi);
    layer_phases<1>(a, lds, bar, lo, hi);
}

extern "C" void kernel_launch(void* const* d_in, const int* in_sizes, int n_in, void* d_out, int out_size, void* d_ws, size_t ws_size, hipStream_t stream) {
    (void)in_sizes; (void)out_size;
    static int grid = 0;
    if (grid == 0) {
        if (n_in != 34 || ws_size < WS_END) { fprintf(stderr, "kernel_launch: need 34 inputs and >= %zu bytes of workspace (got %d, %zu)\n", (size_t)WS_END, n_in, ws_size); grid = -1; return; }
        int dev = 0, cus = 0, per_cu = 0;
        if (hipGetDevice(&dev) != hipSuccess || hipDeviceGetAttribute(&cus, hipDeviceAttributeMultiprocessorCount, dev) != hipSuccess) { grid = -1; return; }
        if (hipFuncSetAttribute((const void*)mk_fwd, hipFuncAttributeMaxDynamicSharedMemorySize, LDS_BYTES) != hipSuccess) { fprintf(stderr, "kernel_launch: hipFuncSetAttribute failed\n"); grid = -1; return; }
        if (hipOccupancyMaxActiveBlocksPerMultiprocessor(&per_cu, (const void*)mk_fwd, NTHR, LDS_BYTES) != hipSuccess || per_cu < 1) { fprintf(stderr, "kernel_launch: occupancy query says %d blocks per CU\n", per_cu); }
        (void)hipGetLastError();
        grid = cus;
    }
    if (grid < 0) return;
    if (hipMemsetAsync((char*)d_ws + WS_CTL, 0, CTL_ZERO_BYTES, stream) != hipSuccess) return;
    Args a{};
    for (int i = 0; i < 34; ++i) a.in[i] = (const float*)d_in[i];
    a.out = (float*)d_out; a.ws = (unsigned char*)d_ws;
#if MK_PER_PHASE
    for (int p = 0; p < NPHASES; ++p) { a.ph_lo = p; a.ph_hi = p + 1; hipLaunchKernelGGL(mk_fwd, dim3(grid), dim3(NTHR), LDS_BYTES, stream, a); }
#else
    a.ph_lo = 0; a.ph_hi = NPHASES;
    hipLaunchKernelGGL(mk_fwd, dim3(grid), dim3(NTHR), LDS_BYTES, stream, a);
#endif
}
```

```cpp
#include <hip/hip_runtime.h>
#include <stdint.h>
#include <stdio.h>

#ifndef MK_PER_PHASE
#define MK_PER_PHASE 0
#endif

typedef unsigned short bf16_t;
typedef float f32x4 __attribute__((ext_vector_type(4)));
typedef float f32x16 __attribute__((ext_vector_type(16)));
typedef unsigned u32x4 __attribute__((ext_vector_type(4)));
typedef unsigned u32x2 __attribute__((ext_vector_type(2)));
typedef short bf16x8 __attribute__((ext_vector_type(8)));

constexpr int D = 2048, NB = 4, L = 2048, C = 256, NLAT = NB * L, NCTX = NB * C, NTOK = NLAT + NCTX;
constexpr int UW = 3840;
constexpr int O_CQ = 0, O_CKV = 768, O_KPE = 1280, O_HY = 1344, O_SQ = 2880, O_SK = 3392, O_SV = 3520, INW = 3648;
constexpr int QW = 1536, KVW = 2048, DFF = 5632, DFE = 7168, NE = 8;
constexpr int MOE_ROWS = 18432;
constexpr float EPS = 1e-6f;
constexpr int NTHR = 512;

__device__ __forceinline__ float bf2f(bf16_t h) { return __uint_as_float(((unsigned)h) << 16); }
__device__ __forceinline__ bf16_t f2bf(float f) { unsigned u = __float_as_uint(f); u += 0x7fffu + ((u >> 16) & 1u); return (bf16_t)(u >> 16); }
__device__ __forceinline__ float wave_sum(float v) { for (int o = 32; o > 0; o >>= 1) v += __shfl_xor(v, o); return v; }
__device__ __forceinline__ float wave_max(float v) { for (int o = 32; o > 0; o >>= 1) v = fmaxf(v, __shfl_xor(v, o)); return v; }
__device__ __forceinline__ float silu(float x) { return x / (1.0f + __expf(-x)); }
__device__ __forceinline__ int tok_mod(int tok) { return tok < NLAT ? (tok >> 11) : 4; }

constexpr size_t al(size_t x) { return (x + 255) & ~(size_t)255; }
constexpr size_t WS_CTL = 0, CTL_ZERO_BYTES = 65536;
constexpr size_t WS_MOD = 65536;
constexpr size_t WS_ROPE = WS_MOD + al((size_t)2 * 5 * 12288 * 4);
constexpr size_t WS_FILTL = WS_ROPE + al((size_t)2 * 2048 * 32 * 4);
constexpr size_t WS_FILTC = WS_FILTL + al((size_t)2 * 512 * 4096 * 4);
constexpr size_t WS_WIN = WS_FILTC + al((size_t)2 * 512 * 512 * 4);
constexpr size_t WS_WQ = WS_WIN + al((size_t)2 * UW * D * 2);
constexpr size_t WS_WKV = WS_WQ + al((size_t)2 * QW * 768 * 2);
constexpr size_t WS_WOUT = WS_WKV + al((size_t)2 * KVW * 512 * 2);
constexpr size_t WS_WGU = WS_WOUT + al((size_t)2 * D * D * 2);
constexpr size_t WS_WDN = WS_WGU + al((size_t)2 * DFF * D * 2);
constexpr size_t WS_MGU = WS_WDN + al((size_t)D * DFF * 2);
constexpr size_t WS_MDN = WS_MGU + al((size_t)NE * 2 * DFE * D * 2);
constexpr size_t WS_HA = WS_MDN + al((size_t)NE * D * DFE * 2);
constexpr size_t WS_U = WS_HA + al((size_t)NTOK * D * 2);
constexpr size_t WS_CQN = WS_U + al((size_t)NTOK * UW * 2);
constexpr size_t WS_CKVN = WS_CQN + al((size_t)NTOK * 768 * 2);
constexpr size_t WS_KPE = WS_CKVN + al((size_t)NTOK * 512 * 2);
constexpr size_t WS_X0 = WS_KPE + al((size_t)NTOK * 64 * 2);
constexpr size_t WS_WTL = WS_X0 + al((size_t)NTOK * 512 * 2);
constexpr size_t WS_WTC = WS_WTL + al((size_t)NB * 512 * L * 2);
constexpr size_t WS_SQ = WS_WTC + al((size_t)NB * 512 * C * 2);
constexpr size_t WS_SK = WS_SQ + al((size_t)NTOK * 512 * 2);
constexpr size_t WS_SV = WS_SK + al((size_t)NTOK * 128 * 2);
constexpr size_t WS_Q = WS_SV + al((size_t)NTOK * 128 * 2);
constexpr size_t WS_KV = WS_Q + al((size_t)NTOK * QW * 2);
constexpr size_t WS_KN = WS_KV;
constexpr size_t WS_VT = WS_KV + (size_t)NTOK * 1024 * 2;
constexpr size_t WS_MIX = WS_KV + al((size_t)NTOK * KVW * 2);
constexpr size_t WS_MIXEND = WS_MIX + al((size_t)NTOK * D * 2);
constexpr size_t WS_YS = WS_U;
static_assert(WS_YS + (size_t)MOE_ROWS * D * 4 <= WS_MIXEND, "ys overlay");
constexpr size_t WS_XS = WS_MIXEND;
constexpr size_t WS_ACT = WS_XS + al((size_t)NTOK * D * 4);
constexpr size_t WS_HBS = WS_ACT + al((size_t)MOE_ROWS * DFE * 2);
constexpr size_t WS_TOPI = WS_HBS + al((size_t)MOE_ROWS * D * 2);
constexpr size_t WS_TOPW = WS_TOPI + al((size_t)NLAT * 2 * 4);
constexpr size_t WS_POS = WS_TOPW + al((size_t)NLAT * 2 * 4);
constexpr size_t WS_SRC = WS_POS + al((size_t)NLAT * 2 * 4);
constexpr size_t WS_END = WS_SRC + al((size_t)MOE_ROWS * 4);
constexpr int CT_EOFF = 1024, CT_EPAD = 1040, CT_NTILE = 1056;
constexpr int CW_BAR = 4096;

constexpr int RING_BYTES = 131072, LDSCTL_OFF = RING_BYTES, LDS_BYTES = 147456;

namespace pg8 {
#define PG8_LAS __attribute__((address_space(3)))
typedef unsigned short bf16_t;
typedef short bf16x8 __attribute__((ext_vector_type(8)));
typedef float f32x4 __attribute__((ext_vector_type(4)));
typedef unsigned u32x4 __attribute__((ext_vector_type(4)));
constexpr int BM = 256, BK = 64, HALF = 128, HTB = HALF * BK * 2  , STAGE_BYTES = 8 * HTB, NXCD = 8, WGM = 8;

__host__ __device__ __forceinline__ int lds_byte(int r, int c) { const int st = (r >> 4) * 2 + (c >> 5), rr = r & 15, cc = c & 31, ob = rr * 64 + cc * 2; return st * 1024 + (ob ^ (((ob >> 9) & 1) << 5)); }
__host__ __device__ __forceinline__ void stage_rc(int b, int& R, int& C) { const int st = b / 1024, sb = b % 1024, swz = sb ^ (((sb >> 9) & 1) << 5); R = (st >> 1) * 16 + swz / 64; C = (st & 1) * 32 + (swz % 64) / 2; }
__host__ __device__ __forceinline__ int perm32(int rho) { const int n = rho >> 4, i = rho & 15; return 8 * (i >> 2) + 4 * n + (i & 3); }

struct Unit { int pm, pn; };
struct Gemm { const bf16_t* A; const bf16_t* Bt; int M, N, K; };

struct StaticOrder {
    int nM, nN, nwg, G, c;
    __host__ __device__ void init(int M, int N, int G_, int c_) { nM = M / BM; nN = N / BM; nwg = nM * nN; G = G_; c = c_; }
    __host__ __device__ bool next(int i, Unit& u) const {
        const long L = (long)i * G + c; if (L >= nwg) return false;
        int wgid = (int)L; { const int q = nwg / NXCD, r = nwg % NXCD, xcd = wgid % NXCD, off = wgid / NXCD; wgid = (xcd < r ? xcd * (q + 1) : r * (q + 1) + (xcd - r) * q) + off; }
        const int nig = WGM * nN, gid = wgid / nig, fm = gid * WGM, gsz = (nM - fm) < WGM ? (nM - fm) : WGM;
        u.pm = fm + ((wgid % nig) % gsz); u.pn = (wgid % nig) / gsz; return true;
    }
    __device__ __forceinline__ size_t bt_off(const Unit&) const { return 0; }
    __device__ __forceinline__ void a_ready(const Unit&) const {}
    __device__ __forceinline__ void done(const Unit&) const {}
};

__device__ __forceinline__ unsigned cvt_pk_bf16(float lo, float hi) { unsigned r; asm volatile("v_cvt_pk_bf16_f32 %0, %1, %2" : "=v"(r) : "v"(lo), "v"(hi)); return r; }
typedef float f32x2 __attribute__((ext_vector_type(2)));
template <class Epi, class Sched, bool ALIGN_EPI = false, bool SP2 = false>
__device__ __forceinline__ void gemm_phase(PG8_LAS unsigned char* lds, const Gemm g, const Sched& S, const Epi& E) {
    int tid_ = threadIdx.x; asm volatile("" : "+v"(tid_));
    const int tid = tid_, wid = __builtin_amdgcn_readfirstlane(tid >> 6), lane = tid & 63, wr = wid >> 2, wc = wid & 3, fr = lane & 15, fq = lane >> 4;
    const int K = g.K, nt = K / BK;
    unsigned voffA[2], voffB[2];
#pragma unroll
    for (int i = 0; i < 2; ++i) { int R, C; stage_rc(tid * 16 + i * 8192, R, C); const int Rb = Epi::PERM ? ((R & ~31) + perm32(R & 31)) : R;
        voffA[i] = (unsigned)(R * K + C) * 2u; voffB[i] = (unsigned)(Rb * K + C) * 2u; }
    const size_t kstep = (size_t)(BK * 2);
    const size_t hstep = (size_t)HALF * K * 2;
    const size_t tstep = 2 * hstep;
    const unsigned ldsw = (unsigned)wid * 1024u;
    const int aoff = lds_byte(wr * 64 + fr, fq * 8), boff = lds_byte(wc * 32 + fr, fq * 8);
#define PG8_SA(b, h) (((b) * 2 + (h)) * HTB)
#define PG8_SB(b, h) ((4 + (b) * 2 + (h)) * HTB)
#define PG8_STAGE(bufoff, gbase, voff) do { _Pragma("unroll") for (int _i = 0; _i < 2; ++_i) \
        __builtin_amdgcn_global_load_lds((const unsigned*)((const char*)(gbase) + (voff)[_i]), (PG8_LAS unsigned*)(lds + (bufoff) + ldsw + _i * 8192), 16, 0, 0); } while (0)
#define PG8_LDA(dst, b, h) do { _Pragma("unroll") for (int m = 0; m < 4; ++m) _Pragma("unroll") for (int k = 0; k < 2; ++k) dst[m][k] = *(const PG8_LAS bf16x8*)(lds + PG8_SA(b, h) + aoff + m * 2048 + k * 1024); } while (0)
#define PG8_LDB(dst, b, h) do { _Pragma("unroll") for (int n = 0; n < 2; ++n) _Pragma("unroll") for (int k = 0; k < 2; ++k) dst[n][k] = *(const PG8_LAS bf16x8*)(lds + PG8_SB(b, h) + boff + n * 2048 + k * 1024); } while (0)
#define PG8_MMA(ai, bj, At, Bt) do { __builtin_amdgcn_s_setprio(1); _Pragma("unroll") for (int m = 0; m < 4; ++m) _Pragma("unroll") for (int n = 0; n < 2; ++n) _Pragma("unroll") for (int k = 0; k < 2; ++k) \
        acc[ai][bj][m][n] = __builtin_amdgcn_mfma_f32_16x16x32_bf16(Bt[n][k], At[m][k], acc[ai][bj][m][n], 0, 0, 0); __builtin_amdgcn_s_setprio(0); } while (0)
#define PG8_WAIT_V(n) asm volatile("s_waitcnt vmcnt(" #n ")" ::: "memory")
#define PG8_WAIT_L(n) asm volatile("s_waitcnt lgkmcnt(" #n ")" ::: "memory")
#define PG8_BAR __builtin_amdgcn_s_barrier()
#define PG8_SCHED __builtin_amdgcn_sched_barrier(0)
    Unit cur, nxt; int ui = 0;
    if (!S.next(0, cur)) return;
    f32x4 acc[2][2][4][2];
#pragma unroll
    for (int a = 0; a < 2; ++a)
#pragma unroll
        for (int b = 0; b < 2; ++b)
#pragma unroll
            for (int m = 0; m < 4; ++m)
#pragma unroll
                for (int n = 0; n < 2; ++n) acc[a][b][m][n] = (f32x4){0.f, 0.f, 0.f, 0.f};
    bf16x8 At[4][2], B0[2][2], B1[2][2];
    const char* cA = (const char*)g.A + (size_t)cur.pm * tstep; const char* cB = (const char*)g.Bt + S.bt_off(cur) + (size_t)cur.pn * tstep;
    S.a_ready(cur);
    if constexpr (SP2) {
        PG8_STAGE(PG8_SB(0, 0), cB, voffB); PG8_STAGE(PG8_SB(0, 1), cB + hstep, voffB); PG8_STAGE(PG8_SA(0, 0), cA, voffA); PG8_STAGE(PG8_SA(0, 1), cA + hstep, voffA);
        if (wr == 1) PG8_BAR;
        PG8_WAIT_V(2); PG8_BAR;
        PG8_STAGE(PG8_SB(1, 0), cB + kstep, voffB); PG8_STAGE(PG8_SA(1, 0), cA + kstep, voffA); PG8_STAGE(PG8_SB(1, 1), cB + hstep + kstep, voffB);
        PG8_WAIT_V(6); PG8_BAR;
    } else {
        PG8_STAGE(PG8_SB(0, 0), cB, voffB); PG8_STAGE(PG8_SA(0, 0), cA, voffA); PG8_STAGE(PG8_SB(0, 1), cB + hstep, voffB); PG8_STAGE(PG8_SA(0, 1), cA + hstep, voffA);
        if (wr == 1) PG8_BAR;
        PG8_WAIT_V(4); PG8_BAR;
        PG8_STAGE(PG8_SB(1, 0), cB + kstep, voffB); PG8_STAGE(PG8_SA(1, 0), cA + kstep, voffA); PG8_STAGE(PG8_SB(1, 1), cB + hstep + kstep, voffB);
        PG8_WAIT_V(6); PG8_BAR;
    }
    for (;;) {
        const bool has_next = S.next(ui + 1, nxt);
        const char* nA = has_next ? (const char*)g.A + (size_t)nxt.pm * tstep : cA; const char* nB = has_next ? (const char*)g.Bt + S.bt_off(nxt) + (size_t)nxt.pn * tstep : cB;
        for (int t = 0; t < nt; t += 2) {
            const bool last = (t == nt - 2);
            const char* a1 = cA + (size_t)(t + 1) * kstep;
            const char* a2 = last ? nA : cA + (size_t)(t + 2) * kstep; const char* b2 = last ? nB : cB + (size_t)(t + 2) * kstep;
            const char* a3 = a2 + kstep; const char* b3 = b2 + kstep;
            if (last && has_next) S.a_ready(nxt);
            if constexpr (SP2) {
            PG8_LDB(B0, 0, 0); PG8_LDB(B1, 0, 1); PG8_SCHED; PG8_LDA(At, 0, 0); PG8_STAGE(PG8_SA(1, 1), a1 + hstep, voffA);
            PG8_WAIT_V(8); PG8_WAIT_L(0); PG8_BAR; PG8_MMA(0, 0, At, B0); PG8_MMA(0, 1, At, B1); PG8_BAR; PG8_SCHED;
            PG8_LDA(At, 0, 1); PG8_STAGE(PG8_SB(0, 0), b2, voffB); PG8_STAGE(PG8_SB(0, 1), b2 + hstep, voffB); PG8_STAGE(PG8_SA(0, 0), a2, voffA);
            PG8_WAIT_V(8); PG8_WAIT_L(0); PG8_BAR; PG8_MMA(1, 0, At, B0); PG8_MMA(1, 1, At, B1); PG8_BAR; PG8_SCHED;
            PG8_LDB(B0, 1, 0); PG8_LDB(B1, 1, 1); PG8_SCHED; PG8_LDA(At, 1, 0); PG8_STAGE(PG8_SA(0, 1), a2 + hstep, voffA);
            PG8_WAIT_V(8); PG8_WAIT_L(0); PG8_BAR; PG8_MMA(0, 0, At, B0); PG8_MMA(0, 1, At, B1); PG8_BAR; PG8_SCHED;
            PG8_LDA(At, 1, 1); PG8_STAGE(PG8_SB(1, 0), b3, voffB); PG8_STAGE(PG8_SB(1, 1), b3 + hstep, voffB); PG8_STAGE(PG8_SA(1, 0), a3, voffA);
            PG8_WAIT_V(8); PG8_WAIT_L(0); PG8_BAR; PG8_MMA(1, 0, At, B0); PG8_MMA(1, 1, At, B1); PG8_BAR; PG8_SCHED;
            } else {
            PG8_LDB(B0, 0, 0); PG8_SCHED; PG8_LDA(At, 0, 0); PG8_STAGE(PG8_SA(1, 1), a1 + hstep, voffA);
            PG8_WAIT_L(8); PG8_BAR; PG8_WAIT_L(0); PG8_MMA(0, 0, At, B0); PG8_BAR; PG8_SCHED;
            PG8_LDB(B1, 0, 1); PG8_STAGE(PG8_SB(0, 0), b2, voffB);
            PG8_BAR; PG8_WAIT_L(0); PG8_MMA(0, 1, At, B1); PG8_BAR;
            PG8_LDA(At, 0, 1); PG8_STAGE(PG8_SA(0, 0), a2, voffA);
            PG8_BAR; PG8_WAIT_L(0); PG8_MMA(1, 0, At, B0); PG8_BAR; PG8_SCHED;
            PG8_STAGE(PG8_SB(0, 1), b2 + hstep, voffB);
            PG8_WAIT_V(6); PG8_BAR; PG8_MMA(1, 1, At, B1); PG8_BAR;
            PG8_LDB(B0, 1, 0); PG8_SCHED; PG8_LDA(At, 1, 0); PG8_STAGE(PG8_SA(0, 1), a2 + hstep, voffA);
            PG8_WAIT_L(8); PG8_BAR; PG8_WAIT_L(0); PG8_MMA(0, 0, At, B0); PG8_BAR; PG8_SCHED;
            PG8_LDB(B1, 1, 1); PG8_STAGE(PG8_SB(1, 0), b3, voffB);
            PG8_BAR; PG8_WAIT_L(0); PG8_MMA(0, 1, At, B1); PG8_BAR;
            PG8_LDA(At, 1, 1); PG8_STAGE(PG8_SA(1, 0), a3, voffA);
            PG8_BAR; PG8_WAIT_L(0); PG8_MMA(1, 0, At, B0); PG8_BAR; PG8_SCHED;
            PG8_STAGE(PG8_SB(1, 1), b3 + hstep, voffB);
            PG8_WAIT_V(6); PG8_BAR; PG8_MMA(1, 1, At, B1); PG8_BAR;
            }
        }
        if constexpr (ALIGN_EPI) { if (wr == 0) PG8_BAR; }
        if constexpr (!Epi::AFTER_DRAIN) { E(acc, cur, wr, wc, fr, fq); S.done(cur); }
        if (!has_next) break;
#pragma unroll
        for (int a = 0; a < 2; ++a)
#pragma unroll
            for (int b = 0; b < 2; ++b)
#pragma unroll
                for (int m = 0; m < 4; ++m)
#pragma unroll
                    for (int n = 0; n < 2; ++n) acc[a][b][m][n] = (f32x4){0.f, 0.f, 0.f, 0.f};
        cur = nxt; cA = nA; cB = nB; ++ui;
        if constexpr (ALIGN_EPI) { if (wr == 1) PG8_BAR; }
    }
    PG8_WAIT_V(0);
    if constexpr (!ALIGN_EPI) { if (wr == 0) PG8_BAR; }
    PG8_BAR;
    if constexpr (Epi::AFTER_DRAIN) { E.fused(acc, cur, wr, wc, fr, fq, lds, wid, lane); S.done(cur); }
#undef PG8_SA
#undef PG8_SB
#undef PG8_STAGE
#undef PG8_LDA
#undef PG8_LDB
#undef PG8_MMA
#undef PG8_WAIT_V
#undef PG8_WAIT_L
#undef PG8_BAR
#undef PG8_SCHED
}
}

namespace pg8 {
__device__ __forceinline__ u32x4 pack8(const f32x4 v0, const f32x4 v1) { u32x4 w; w.x = cvt_pk_bf16(v0[0], v0[1]); w.y = cvt_pk_bf16(v0[2], v0[3]); w.z = cvt_pk_bf16(v1[0], v1[1]); w.w = cvt_pk_bf16(v1[2], v1[3]); return w; }
struct EpiStore {
    static constexpr bool PERM = true, AFTER_DRAIN = false;
    bf16_t* O; int ldc;
    __device__ __forceinline__ void operator()(const f32x4 (&acc)[2][2][4][2], const Unit& u, int wr, int wc, int fr, int fq) const {
        const int row0 = u.pm * BM + wr * 64 + fr, col0 = u.pn * BM + wc * 32 + 8 * fq;
#pragma unroll
        for (int ai = 0; ai < 2; ++ai)
#pragma unroll
            for (int m = 0; m < 4; ++m) { bf16_t* rowp = O + (size_t)(row0 + ai * HALF + m * 16) * ldc + col0;
#pragma unroll
                for (int bj = 0; bj < 2; ++bj) *(u32x4*)(rowp + bj * HALF) = pack8(acc[ai][bj][m][0], acc[ai][bj][m][1]); }
    }
};
struct EpiQ {
    static constexpr bool PERM = true, AFTER_DRAIN = false;
    bf16_t* O; const float* cosT; const float* sinT;
    __device__ __forceinline__ void operator()(const f32x4 (&acc)[2][2][4][2], const Unit& u, int wr, int wc, int fr, int fq) const {
        const int row0 = u.pm * BM + wr * 64 + fr, col0 = u.pn * BM + wc * 32 + 8 * fq;
#pragma unroll
        for (int ai = 0; ai < 2; ++ai)
#pragma unroll
            for (int m = 0; m < 4; ++m) { const int row = row0 + ai * HALF + m * 16; const bool lat = row < 8192; const int t = row & 2047;
#pragma unroll
                for (int bj = 0; bj < 2; ++bj) { const int col = col0 + bj * HALF; const int jn = col - 192 * (col / 192);
                    f32x4 v0 = acc[ai][bj][m][0], v1 = acc[ai][bj][m][1];
                    if (jn >= 128 && lat) { const int i0 = (jn - 128) >> 1;
                        const f32x4 cs = *(const f32x4*)(cosT + t * 32 + i0), sn = *(const f32x4*)(sinT + t * 32 + i0);
                        f32x4 r0, r1;
                        r0[0] = v0[0] * cs[0] - v0[1] * sn[0]; r0[1] = v0[0] * sn[0] + v0[1] * cs[0];
                        r0[2] = v0[2] * cs[1] - v0[3] * sn[1]; r0[3] = v0[2] * sn[1] + v0[3] * cs[1];
                        r1[0] = v1[0] * cs[2] - v1[1] * sn[2]; r1[1] = v1[0] * sn[2] + v1[1] * cs[2];
                        r1[2] = v1[2] * cs[3] - v1[3] * sn[3]; r1[3] = v1[2] * sn[3] + v1[3] * cs[3];
                        v0 = r0; v1 = r1; }
                    *(u32x4*)(O + (size_t)row * 1536 + col) = pack8(v0, v1); } }
    }
};
struct EpiResid {
    static constexpr bool PERM = false, AFTER_DRAIN = false;
    float* xs; const float* gate;
    __device__ __forceinline__ void operator()(const f32x4 (&acc)[2][2][4][2], const Unit& u, int wr, int wc, int fr, int fq) const {
        const int row0 = u.pm * BM + wr * 64 + fr, colb = u.pn * BM + wc * 32 + 4 * fq;
#pragma unroll
        for (int ai = 0; ai < 2; ++ai)
#pragma unroll
            for (int m = 0; m < 4; ++m) { const int row = row0 + ai * HALF + m * 16; const float* gv = gate + (size_t)(row < 8192 ? (row >> 11) : 4) * 12288; float* xr = xs + (size_t)row * 2048;
#pragma unroll
                for (int bj = 0; bj < 2; ++bj)
#pragma unroll
                    for (int n = 0; n < 2; ++n) { const int col = colb + bj * HALF + n * 16; f32x4 x = *(const f32x4*)(xr + col); const f32x4 g = *(const f32x4*)(gv + col);
                        x += g * acc[ai][bj][m][n]; *(f32x4*)(xr + col) = x; }
                if (m & 1) asm volatile("" ::: "memory"); }
    }
};
struct EpiSwiGLU {
    static constexpr bool PERM = true, AFTER_DRAIN = false;
    bf16_t* O; int ldc;
    __device__ __forceinline__ void operator()(const f32x4 (&acc)[2][2][4][2], const Unit& u, int wr, int wc, int fr, int fq) const {
        const int row0 = u.pm * BM + wr * 64 + fr, col0 = u.pn * HALF + wc * 32 + 8 * fq;
#pragma unroll
        for (int ai = 0; ai < 2; ++ai)
#pragma unroll
            for (int m = 0; m < 4; ++m) { f32x4 o0, o1;
#pragma unroll
                for (int j = 0; j < 4; ++j) { const float g0 = acc[ai][0][m][0][j], g1 = acc[ai][0][m][1][j];
                    o0[j] = g0 / (1.0f + __expf(-g0)) * acc[ai][1][m][0][j]; o1[j] = g1 / (1.0f + __expf(-g1)) * acc[ai][1][m][1][j]; }
                *(u32x4*)(O + (size_t)(row0 + ai * HALF + m * 16) * ldc + col0) = pack8(o0, o1); }
    }
};
struct EpiF32 {
    static constexpr bool PERM = false, AFTER_DRAIN = false;
    float* O; int ldc;
    __device__ __forceinline__ void operator()(const f32x4 (&acc)[2][2][4][2], const Unit& u, int wr, int wc, int fr, int fq) const {
        const int row0 = u.pm * BM + wr * 64 + fr, colb = u.pn * BM + wc * 32 + 4 * fq;
#pragma unroll
        for (int ai = 0; ai < 2; ++ai)
#pragma unroll
            for (int m = 0; m < 4; ++m) { float* xr = O + (size_t)(row0 + ai * HALF + m * 16) * ldc;
#pragma unroll
                for (int bj = 0; bj < 2; ++bj)
#pragma unroll
                    for (int n = 0; n < 2; ++n) *(f32x4*)(xr + colb + bj * HALF + n * 16) = acc[ai][bj][m][n]; }
    }
};
struct MoeOrder {
    int nM, nN, nwg, G, c; int t1[8]; size_t estride;
    __device__ __forceinline__ void init(const int* ctl, int nN_, int G_, int c_, size_t estride_) {
        int acc = 0;
#pragma unroll
        for (int e = 0; e < 8; ++e) { acc += ctl[CT_EPAD + e] >> 8; t1[e] = acc; }
        nM = acc; nN = nN_; nwg = nM * nN; G = G_; c = c_; estride = estride_;
    }
    __device__ __forceinline__ bool next(int i, Unit& u) const {
        const long L = (long)i * G + c; if (L >= nwg) return false;
        int wgid = (int)L; { const int q = nwg / NXCD, r = nwg % NXCD, xcd = wgid % NXCD, off = wgid / NXCD; wgid = (xcd < r ? xcd * (q + 1) : r * (q + 1) + (xcd - r) * q) + off; }
        const int nig = WGM * nN, gid = wgid / nig, fm = gid * WGM, gsz = (nM - fm) < WGM ? (nM - fm) : WGM;
        u.pm = fm + ((wgid % nig) % gsz); u.pn = (wgid % nig) / gsz; return true;
    }
    __device__ __forceinline__ size_t bt_off(const Unit& u) const { int e = 0;
#pragma unroll
        for (int k = 0; k < 7; ++k) e += (u.pm >= t1[k]) ? 1 : 0;
        return (size_t)e * estride; }
    __device__ __forceinline__ void a_ready(const Unit&) const {}
    __device__ __forceinline__ void done(const Unit&) const {}
};
}

#define LAS __attribute__((address_space(3)))
#define XB_TMO      128
#define XB_XCNT(j)  (256  + 64 * (j))
#define XB_XSUB(j)  (1280 + 64 * (j))
#define XB_XGEN(j)  (2304 + 64 * (j))
#define XB_TOP      3328
#define XB_TOPGEN   3392
#define XCD_BAR_WORDS 3456
#define XB_SPIN_CAP (1u << 18)

__device__ __forceinline__ unsigned xb_ld(unsigned* p)              { return __hip_atomic_load(p, __ATOMIC_RELAXED, __HIP_MEMORY_SCOPE_AGENT); }
__device__ __forceinline__ unsigned xb_add(unsigned* p, unsigned v) { return __hip_atomic_fetch_add(p, v, __ATOMIC_RELAXED, __HIP_MEMORY_SCOPE_AGENT); }
__device__ __forceinline__ unsigned xb_xcc_id() { return (unsigned)__builtin_amdgcn_s_getreg((3 << 11) | 20) & 0xFu; }
#define XB_SPIN(cond, bar) do { unsigned _sp = 0; while (cond) { __builtin_amdgcn_s_sleep(1); \
    if ((++_sp & 255u) == 0u) { if (xb_ld(&(bar)[XB_TMO])) break; if (_sp > XB_SPIN_CAP) { atomicAdd(&(bar)[XB_TMO], 1u); break; } } } } while (0)

struct XcdBarrier {
    unsigned* bar; unsigned x;
    volatile LAS unsigned* st;
};

__device__ __forceinline__ XcdBarrier xcd_barrier_post(unsigned* bar, volatile LAS unsigned* st) {
    XcdBarrier b; b.bar = bar; b.x = xb_xcc_id(); b.st = st;
    if (threadIdx.x == 0) (void)xb_add(&bar[XB_XCNT(b.x)], 1u);
    return b;
}
__device__ __forceinline__ void xcd_barrier_complete(unsigned* bar, unsigned x, unsigned& nloc, unsigned& nx) {
    const unsigned G = gridDim.x * gridDim.y * gridDim.z;
    unsigned sum, cnt, mine, sp = 0u;
    for (;;) {
        sum = 0u; cnt = 0u; mine = 0u;
#pragma unroll
        for (unsigned j = 0; j < 16; ++j) { const unsigned c = xb_ld(&bar[XB_XCNT(j)]); sum += c; cnt += (c > 0u) ? 1u : 0u; mine = (j == x) ? c : mine; }
        if (sum == G) break;
        __builtin_amdgcn_s_sleep(1);
        if ((++sp & 255u) == 0u) { if (xb_ld(&bar[XB_TMO])) break; if (sp > XB_SPIN_CAP) { atomicAdd(&bar[XB_TMO], 1u); break; } }
    }
    nloc = mine > 0u ? mine : 1u; nx = cnt > 0u ? cnt : 1u;
}

__device__ __forceinline__ void xcd_barrier(const XcdBarrier& b) {
    asm volatile("s_waitcnt vmcnt(0)" ::: "memory");
    __syncthreads();
    if (threadIdx.x == 0) {
        unsigned* bar = b.bar;
        __builtin_amdgcn_s_waitcnt(0);
        unsigned nloc = b.st[0], nx = b.st[1];
        if (nloc == 0u) { xcd_barrier_complete(bar, b.x, nloc, nx); b.st[0] = nloc; b.st[1] = nx; }
        const unsigned old = xb_add(&bar[XB_XSUB(b.x)], 1u);
        const unsigned gen = old / nloc;
        if (old + 1u == (gen + 1u) * nloc) {
            __builtin_amdgcn_fence(__ATOMIC_RELEASE, "agent");
            asm volatile("s_waitcnt vmcnt(0)" ::: "memory");
            const unsigned og = xb_add(&bar[XB_TOP], 1u);
            const unsigned tg = og / nx;
            if (og + 1u == (tg + 1u) * nx) xb_add(&bar[XB_TOPGEN], 1u);
            else XB_SPIN(xb_ld(&bar[XB_TOPGEN]) == tg, bar);
            __builtin_amdgcn_fence(__ATOMIC_ACQUIRE, "agent");
            xb_add(&bar[XB_XGEN(b.x)], 1u);
            asm volatile("s_waitcnt vmcnt(0)" ::: "memory");
        } else {
            XB_SPIN(xb_ld(&bar[XB_XGEN(b.x)]) == gen, bar);
            __builtin_amdgcn_fence(__ATOMIC_ACQUIRE, "agent");
            asm volatile("s_waitcnt vmcnt(0)" ::: "memory");
        }
    }
    __syncthreads();
}


struct Args { const float* in[34]; float* out; unsigned char* ws; int ph_lo, ph_hi; };

enum { MAP_ID = 0, MAP_ROPEQ = 1, MAP_GU0 = 2, MAP_GU1 = 3, MAP_KV = 4 };
struct JobDesc { int in_idx, K, N, nbatch, upb, map; long long src_off, src_bstride, dst_off, dst_bstride; };
constexpr int NJOBS = 14, NCONV = 50624;
__constant__ JobDesc c_jobs[NJOBS] = {
    {8, 2048, 3648, 1, 912, MAP_ID, 0, 0, (long long)WS_WIN, 0},
    {8, 2048, 3648, 1, 912, MAP_ID, 2048LL * 3648, 0, (long long)(WS_WIN + (size_t)UW * D * 2), 0},
    {10, 768, 1536, 1, 144, MAP_ROPEQ, 0, 0, (long long)WS_WQ, 0},
    {10, 768, 1536, 1, 144, MAP_ROPEQ, 768LL * 1536, 0, (long long)(WS_WQ + (size_t)QW * 768 * 2), 0},
    {12, 512, 2048, 1, 128, MAP_KV, 0, 0, (long long)WS_WKV, 0},
    {12, 512, 2048, 1, 128, MAP_KV, 512LL * 2048, 0, (long long)(WS_WKV + (size_t)KVW * 512 * 2), 0},
    {25, 2048, 2048, 1, 512, MAP_ID, 0, 0, (long long)WS_WOUT, 0},
    {25, 2048, 2048, 1, 512, MAP_ID, 2048LL * 2048, 0, (long long)(WS_WOUT + (size_t)D * D * 2), 0},
    {26, 2048, 5632, 1, 1408, MAP_GU0, 0, 0, (long long)WS_WGU, 0},
    {27, 2048, 5632, 1, 1408, MAP_GU1, 0, 0, (long long)WS_WGU, 0},
    {28, 5632, 2048, 1, 1408, MAP_ID, 0, 0, (long long)WS_WDN, 0},
    {30, 2048, 7168, 8, 1792, MAP_GU0, 0, 2048LL * 7168, (long long)WS_MGU, 2LL * DFE * D * 2},
    {31, 2048, 7168, 8, 1792, MAP_GU1, 0, 2048LL * 7168, (long long)WS_MGU, 2LL * DFE * D * 2},
    {32, 7168, 2048, 8, 1792, MAP_ID, 0, 7168LL * 2048, (long long)WS_MDN, (long long)D * DFE * 2},
};
struct ConvUnit { const float* src; bf16_t* dst; int K, N, map, k0, n0; };
__device__ __forceinline__ void conv_decode(const Args& a, int u, ConvUnit& cu) {
    int j = 0, base = 0;
    for (;;) { const int n = c_jobs[j].nbatch * c_jobs[j].upb; if (u < base + n || j == NJOBS - 1) break; base += n; ++j; }
    const JobDesc& jd = c_jobs[j];
    int r = u - base; const int bt = r / jd.upb; r -= bt * jd.upb; const int ntn = jd.N >> 6; const int kt = r / ntn, nt = r - kt * ntn;
    cu.K = jd.K; cu.N = jd.N; cu.map = jd.map; cu.k0 = kt * 128; cu.n0 = nt * 64;
    const float* sb = j < 2 ? a.in[8] : j < 4 ? a.in[10] : j < 6 ? a.in[12] : j < 8 ? a.in[25] : j == 8 ? a.in[26] : j == 9 ? a.in[27] : j == 10 ? a.in[28] : j == 11 ? a.in[30] : j == 12 ? a.in[31] : a.in[32];
    cu.src = sb + jd.src_off + (long long)bt * jd.src_bstride + (size_t)cu.k0 * jd.N + cu.n0;
    cu.dst = (bf16_t*)(a.ws + jd.dst_off + (long long)bt * jd.dst_bstride);
}
__device__ __forceinline__ int conv_row(int map, int n) {
    if (map == MAP_ID) return n;
    if (map == MAP_GU0) return ((n >> 7) << 8) + (n & 127);
    if (map == MAP_GU1) return ((n >> 7) << 8) + 128 + (n & 127);
    if (map == MAP_KV) { const int hh = n >> 8, jn = n & 255; return jn < 128 ? hh * 128 + jn : 1024 + hh * 128 + (jn - 128); }
    const int hh = n / 192, jn = n - hh * 192; if (jn < 128) return n; const int q = jn - 128; return hh * 192 + 128 + 2 * (q & 31) + (q >> 5);
}
__device__ __forceinline__ void ph_convert(const Args& a, float* tile) {
    const int tid = threadIdx.x, G = gridDim.x;
    int u = blockIdx.x; ConvUnit cu; f32x4 r[4];
    if (u < NCONV) { conv_decode(a, u, cu);
#pragma unroll
        for (int i = 0; i < 4; ++i) { const int idx = tid + 512 * i; r[i] = *(const f32x4*)(cu.src + (size_t)(idx >> 4) * cu.N + (idx & 15) * 4); } }
    while (u < NCONV) {
#pragma unroll
        for (int i = 0; i < 4; ++i) { const int idx = tid + 512 * i; float* tp = tile + (idx >> 4) * 65 + (idx & 15) * 4; tp[0] = r[i][0]; tp[1] = r[i][1]; tp[2] = r[i][2]; tp[3] = r[i][3]; }
        __syncthreads();
        const ConvUnit cur = cu; const int un = u + G;
        if (un < NCONV) { conv_decode(a, un, cu);
#pragma unroll
            for (int i = 0; i < 4; ++i) { const int idx = tid + 512 * i; r[i] = *(const f32x4*)(cu.src + (size_t)(idx >> 4) * cu.N + (idx & 15) * 4); } }
        const int nl = tid >> 3; const int row = conv_row(cur.map, cur.n0 + nl);
#pragma unroll
        for (int j = 0; j < 2; ++j) { const int kc = (tid & 7) + 8 * j; const float* tp = tile + (kc * 8) * 65 + nl;
            u32x4 w; w.x = pg8::cvt_pk_bf16(tp[0], tp[65]); w.y = pg8::cvt_pk_bf16(tp[130], tp[195]); w.z = pg8::cvt_pk_bf16(tp[260], tp[325]); w.w = pg8::cvt_pk_bf16(tp[390], tp[455]);
            *(u32x4*)(cur.dst + (size_t)row * cur.K + cur.k0 + kc * 8) = w; }
        __syncthreads();
        u = un;
    }
}
__device__ __forceinline__ void adaln_unit(const Args& a, int unit, float* sm) {
    const float* c = a.in[1]; const float* cctx = a.in[3]; const float* w_mod = a.in[4]; const float* b_mod = a.in[5]; float* mod = (float*)(a.ws + WS_MOD);
    const int tid = threadIdx.x, l = unit / 96, chunk = unit % 96;
    const int cg = tid & 31, ks = tid >> 5;
    for (int i = tid; i < 5 * 2048; i += 512) { const int v = i >> 11, k = i & 2047; const float val = v < 4 ? c[v * 2048 + k] : cctx[k]; sm[i] = val / (1.0f + expf(-val)); }
    __syncthreads();
    float acc[5][4];
#pragma unroll
    for (int v = 0; v < 5; ++v)
#pragma unroll
        for (int j = 0; j < 4; ++j) acc[v][j] = 0.f;
    const float* wp = w_mod + ((size_t)l * 2048 + (size_t)ks * 128) * 12288 + chunk * 128 + cg * 4;
#pragma unroll 4
    for (int kk = 0; kk < 128; ++kk) {
        const f32x4 w = *(const f32x4*)(wp + (size_t)kk * 12288);
        const int k = ks * 128 + kk;
#pragma unroll
        for (int v = 0; v < 5; ++v) { const float s = sm[v * 2048 + k];
#pragma unroll
            for (int j = 0; j < 4; ++j) acc[v][j] += s * w[j]; }
    }
    __syncthreads();
#pragma unroll
    for (int v = 0; v < 5; ++v)
#pragma unroll
        for (int j = 0; j < 4; ++j) sm[(ks * 5 + v) * 128 + cg * 4 + j] = acc[v][j];
    __syncthreads();
    for (int o = tid; o < 640; o += 512) {
        const int v = o >> 7, cc = o & 127; float s = 0.f;
        for (int k2 = 0; k2 < 16; ++k2) s += sm[(k2 * 5 + v) * 128 + cc];
        mod[((size_t)l * 5 + v) * 12288 + chunk * 128 + cc] = s + b_mod[(size_t)l * 12288 + chunk * 128 + cc];
    }
    __syncthreads();
}
__device__ __forceinline__ void filters_unit(const Args& a, int unit, float* sm) {
    float (*zs)[36] = (float (*)[36])sm; float (*ha)[64] = (float (*)[64])(sm + 8 * 36); float (*hb)[64] = (float (*)[64])(sm + 8 * 36 + 8 * 64);
    const int tid = threadIdx.x, l = unit / 288, r = unit % 288;
    const bool lat = r < 256; const int Lf = lat ? 2048 : 256; const int p0 = lat ? r * 8 : (r - 256) * 8;
    float* T = lat ? (float*)(a.ws + WS_FILTL) + (size_t)l * 512 * 4096 : (float*)(a.ws + WS_FILTC) + (size_t)l * 512 * 512;
    const float* w1 = a.in[15] + l * 33 * 64; const float* b1 = a.in[16] + l * 64; const float* w2 = a.in[17] + l * 64 * 64; const float* b2 = a.in[18] + l * 64;
    const float* w3 = a.in[19] + l * 64 * 64; const float* b3 = a.in[20] + l * 64; const float* wf = a.in[21] + (size_t)l * 64 * 1024; const float* fr = a.in[22] + l * 64;
    const int p = tid >> 6, j = tid & 63; const int pos = p0 + p;
    const float tn = (float)pos / (float)(Lf - 1);
    if (j < 33) {
        float z;
        if (j == 0) z = tn;
        else { const int bi = (j - 1) & 15; const float band = 1e-4f + (float)bi * ((15.0f - 1e-4f) / 15.0f);
               const float ang = (6.283185307179586f / (float)Lf) * (float)pos * band; z = (j <= 16) ? cosf(ang) : -sinf(ang); }
        zs[p][j] = z;
    }
    __syncthreads();
    const float f = fr[j];
    { float s = b1[j]; for (int i = 0; i < 33; ++i) s += zs[p][i] * w1[i * 64 + j]; ha[p][j] = sinf(f * s); }
    __syncthreads();
    { float s = b2[j]; for (int i = 0; i < 64; ++i) s += ha[p][i] * w2[i * 64 + j]; hb[p][j] = sinf(f * s); }
    __syncthreads();
    { float s = b3[j]; for (int i = 0; i < 64; ++i) s += hb[p][i] * w3[i * 64 + j]; ha[p][j] = sinf(f * s); }
    __syncthreads();
#pragma unroll
    for (int rr = 0; rr < 2; ++rr) {
        const int o = tid + rr * 512; float acc[8];
#pragma unroll
        for (int q = 0; q < 8; ++q) acc[q] = 0.f;
        for (int i = 0; i < 64; ++i) { const float w = wf[i * 1024 + o];
#pragma unroll
            for (int q = 0; q < 8; ++q) acc[q] += ha[q][i] * w; }
        const int ch = o & 511; const bool back = o >= 512;
        const float delta = 3.0701134573253944f + (float)ch * ((15.350567286626972f - 3.0701134573253944f) / 511.0f);
#pragma unroll
        for (int q = 0; q < 8; ++q) {
            const int ps = p0 + q; const float t2 = (float)ps / (float)(Lf - 1);
            const float val = acc[q] * expf(-t2 * delta);
            if (!back) T[(size_t)ch * (2 * Lf) + Lf + ps] = val;
            else if (ps > 0) T[(size_t)ch * (2 * Lf) + Lf - ps] = val;
            else T[(size_t)ch * (2 * Lf)] = 0.f;
        }
    }
    __syncthreads();
}
__device__ __forceinline__ void ph_prologue(const Args& a, float* sm) {
    const int bid = blockIdx.x, G = gridDim.x, tid = threadIdx.x;
    for (int u = bid; u < 192; u += G) adaln_unit(a, u, sm);
    for (int u = bid; u < 576; u += G) filters_unit(a, u, sm);
    { float* cosT = (float*)(a.ws + WS_ROPE); float* sinT = cosT + 2048 * 32;
      for (int i = bid * 512 + tid; i < 2048 * 32; i += G * 512) { const int t = i >> 5, f = i & 31;
          const float pos = (float)((f < 16) ? (t >> 6) : (t & 63)); const float freq = powf(10000.0f, -(float)(f & 15) / 16.0f); const float ang = pos * freq;
          cosT[i] = cosf(ang); sinT[i] = sinf(ang); } }
    for (int i = bid * 512 + tid; i < 2 * 192 * 256; i += G * 512) { const int l = i / (192 * 256), r = i % (192 * 256);
        *(u32x4*)(a.ws + WS_WIN + (size_t)l * UW * D * 2 + (size_t)INW * D * 2 + (size_t)r * 16) = (u32x4){0u, 0u, 0u, 0u}; }
    ph_convert(a, sm);
}

template <bool ROUTER, bool COPYX>
__device__ __forceinline__ void ph_normmod(const float* __restrict__ xlat, const float* __restrict__ xctx, const float* __restrict__ gain, const float* __restrict__ modl, int sh_off, int sc_off,
                                           bf16_t* __restrict__ out, int nrows, float* __restrict__ xs, const float* __restrict__ router, int* __restrict__ topi, float* __restrict__ topw) {
    const int lane = threadIdx.x & 63, wid = threadIdx.x >> 6;
    for (int row = blockIdx.x * 8 + wid; row < nrows; row += gridDim.x * 8) {
        const float* xr = row < NLAT ? xlat + (size_t)row * D : xctx + (size_t)(row - NLAT) * D;
        const float* mv = modl + (size_t)tok_mod(row) * 12288;
        f32x4 v[8]; float ss = 0.f;
#pragma unroll
        for (int i = 0; i < 8; ++i) { v[i] = *(const f32x4*)(xr + i * 256 + lane * 4); ss += v[i][0] * v[i][0] + v[i][1] * v[i][1] + v[i][2] * v[i][2] + v[i][3] * v[i][3];
            if (COPYX) *(f32x4*)(xs + (size_t)row * D + i * 256 + lane * 4) = v[i]; }
        ss = wave_sum(ss);
        const float rstd = rsqrtf(ss * (1.0f / D) + EPS);
        float lg[8];
#pragma unroll
        for (int e = 0; e < 8; ++e) lg[e] = 0.f;
#pragma unroll
        for (int i = 0; i < 8; ++i) {
            const int col = i * 256 + lane * 4;
            const f32x4 g = *(const f32x4*)(gain + col), sc = *(const f32x4*)(mv + sc_off + col), sh = *(const f32x4*)(mv + sh_off + col);
            f32x4 o;
#pragma unroll
            for (int j = 0; j < 4; ++j) o[j] = (v[i][j] * rstd * g[j]) * (1.0f + sc[j]) + sh[j];
            u32x2 w; w.x = (unsigned)f2bf(o[0]) | ((unsigned)f2bf(o[1]) << 16); w.y = (unsigned)f2bf(o[2]) | ((unsigned)f2bf(o[3]) << 16);
            *(u32x2*)(out + (size_t)row * D + col) = w;
            if (ROUTER) {
#pragma unroll
                for (int j = 0; j < 4; ++j) { const f32x4 r0 = *(const f32x4*)(router + (size_t)(col + j) * 8), r1 = *(const f32x4*)(router + (size_t)(col + j) * 8 + 4);
                    lg[0] += o[j] * r0[0]; lg[1] += o[j] * r0[1]; lg[2] += o[j] * r0[2]; lg[3] += o[j] * r0[3];
                    lg[4] += o[j] * r1[0]; lg[5] += o[j] * r1[1]; lg[6] += o[j] * r1[2]; lg[7] += o[j] * r1[3]; }
                asm volatile("" ::: "memory");
            }
        }
        if (ROUTER) {
#pragma unroll
            for (int e = 0; e < 8; ++e) lg[e] = wave_sum(lg[e]);
            if (lane == 0) {
                int i0 = 0; float v0 = lg[0];
#pragma unroll
                for (int e = 1; e < 8; ++e) if (lg[e] > v0) { v0 = lg[e]; i0 = e; }
                int i1 = -1; float v1 = -3.0e38f;
#pragma unroll
                for (int e = 0; e < 8; ++e) if (e != i0 && lg[e] > v1) { v1 = lg[e]; i1 = e; }
                const float e1 = expf(v1 - v0), w0 = 1.0f / (1.0f + e1), w1 = e1 / (1.0f + e1);
                topi[row * 2] = i0; topi[row * 2 + 1] = i1; topw[row * 2] = w0; topw[row * 2 + 1] = w1;
            }
        }
    }
}

__device__ __forceinline__ void ph_mid(const Args& a, int l) {
    const bf16_t* __restrict__ U = (const bf16_t*)(a.ws + WS_U);
    const float* g_q = a.in[9] + l * 768; const float* g_kv = a.in[11] + l * 512; const float* conv_w = a.in[13] + (size_t)l * 3 * 1536; const float* conv_b = a.in[14] + l * 1536;
    const float* cosT = (const float*)(a.ws + WS_ROPE); const float* sinT = cosT + 2048 * 32;
    bf16_t* cqn = (bf16_t*)(a.ws + WS_CQN); bf16_t* ckvn = (bf16_t*)(a.ws + WS_CKVN); bf16_t* kpe = (bf16_t*)(a.ws + WS_KPE); bf16_t* x0o = (bf16_t*)(a.ws + WS_X0);
    bf16_t* wtl = (bf16_t*)(a.ws + WS_WTL); bf16_t* wtc = (bf16_t*)(a.ws + WS_WTC); bf16_t* sq = (bf16_t*)(a.ws + WS_SQ); bf16_t* sk = (bf16_t*)(a.ws + WS_SK); bf16_t* sv = (bf16_t*)(a.ws + WS_SV);
    const int tid = threadIdx.x, lane = tid & 63, wid = tid >> 6;
    for (int unit = blockIdx.x; unit < NTOK / 16; unit += gridDim.x) {
        const int tok0 = unit * 16;
        for (int tt = 0; tt < 2; ++tt) {
            const int tok = tok0 + wid * 2 + tt; const bool lat = tok < NLAT; const int t = lat ? (tok & 2047) : ((tok - NLAT) & 255);
            const bf16_t* u = U + (size_t)tok * UW;
            { float x[12]; float ss = 0.f;
#pragma unroll
              for (int i = 0; i < 12; ++i) { x[i] = bf2f(u[O_CQ + i * 64 + lane]); ss += x[i] * x[i]; }
              ss = wave_sum(ss); const float rs = rsqrtf(ss * (1.0f / 768.0f) + EPS);
#pragma unroll
              for (int i = 0; i < 12; ++i) cqn[(size_t)tok * 768 + i * 64 + lane] = f2bf(x[i] * rs * g_q[i * 64 + lane]); }
            { float x[8]; float ss = 0.f;
#pragma unroll
              for (int i = 0; i < 8; ++i) { x[i] = bf2f(u[O_CKV + i * 64 + lane]); ss += x[i] * x[i]; }
              ss = wave_sum(ss); const float rs = rsqrtf(ss * (1.0f / 512.0f) + EPS);
#pragma unroll
              for (int i = 0; i < 8; ++i) ckvn[(size_t)tok * 512 + i * 64 + lane] = f2bf(x[i] * rs * g_kv[i * 64 + lane]); }
            const int pi = lane & 31;
            const float cs = lat ? cosT[t * 32 + pi] : 1.0f, sn = lat ? sinT[t * 32 + pi] : 0.0f;
            if (lane < 32) {
                const float aa = bf2f(u[O_KPE + pi]), bb = bf2f(u[O_KPE + 32 + pi]);
                kpe[(size_t)tok * 64 + 2 * pi] = f2bf(aa * cs - bb * sn); kpe[(size_t)tok * 64 + 2 * pi + 1] = f2bf(aa * sn + bb * cs);
            }
#pragma unroll
            for (int r = 0; r < 4; ++r) { const int pr = r * 64 + lane, h = pr >> 5;
                const float aa = bf2f(u[O_SQ + h * 64 + pi]), bb = bf2f(u[O_SQ + h * 64 + 32 + pi]);
                sq[(size_t)tok * 512 + h * 64 + pi] = f2bf(aa * cs - bb * sn); sq[(size_t)tok * 512 + h * 64 + 32 + pi] = f2bf(aa * sn + bb * cs); }
            { const int h = lane >> 5;
              const float aa = bf2f(u[O_SK + h * 64 + pi]), bb = bf2f(u[O_SK + h * 64 + 32 + pi]);
              sk[(size_t)tok * 128 + h * 64 + pi] = f2bf(aa * cs - bb * sn); sk[(size_t)tok * 128 + h * 64 + 32 + pi] = f2bf(aa * sn + bb * cs); }
            sv[(size_t)tok * 128 + lane] = u[O_SV + lane]; sv[(size_t)tok * 128 + 64 + lane] = u[O_SV + 64 + lane];
        }
        {
            const bool lat = tok0 < NLAT; const int Ls = lat ? L : C;
            const int b = lat ? (tok0 >> 11) : ((tok0 - NLAT) >> 8), t0 = lat ? (tok0 & 2047) : ((tok0 - NLAT) & 255);
            const int ch = tid;
            float cw[3][3], cb[3];
#pragma unroll
            for (int g = 0; g < 3; ++g) { cb[g] = conv_b[g * 512 + ch];
#pragma unroll
                for (int j = 0; j < 3; ++j) cw[g][j] = conv_w[j * 1536 + g * 512 + ch]; }
            float prev[3], cur[3], nxt[3];
#pragma unroll
            for (int g = 0; g < 3; ++g) { prev[g] = (t0 > 0) ? bf2f(U[(size_t)(tok0 - 1) * UW + O_HY + g * 512 + ch]) : 0.f; cur[g] = bf2f(U[(size_t)tok0 * UW + O_HY + g * 512 + ch]); }
            unsigned pk[8];
#pragma unroll
            for (int i = 0; i < 16; ++i) {
                const bool hasn = (t0 + i + 1) < Ls;
                float y[3];
#pragma unroll
                for (int g = 0; g < 3; ++g) { nxt[g] = hasn ? bf2f(U[(size_t)(tok0 + i + 1) * UW + O_HY + g * 512 + ch]) : 0.f;
                    y[g] = cb[g] + cw[g][0] * prev[g] + cw[g][1] * cur[g] + cw[g][2] * nxt[g]; prev[g] = cur[g]; cur[g] = nxt[g]; }
                x0o[(size_t)(tok0 + i) * 512 + ch] = f2bf(y[0]);
                const unsigned wv = f2bf(y[2] * y[1]);
                if (i & 1) pk[i >> 1] |= wv << 16; else pk[i >> 1] = wv;
            }
            bf16_t* wt = lat ? wtl + ((size_t)b * 512 + ch) * L + t0 : wtc + ((size_t)b * 512 + ch) * C + t0;
            u32x4 w0, w1; w0.x = pk[0]; w0.y = pk[1]; w0.z = pk[2]; w0.w = pk[3]; w1.x = pk[4]; w1.y = pk[5]; w1.z = pk[6]; w1.w = pk[7];
            *(u32x4*)wt = w0; *(u32x4*)(wt + 8) = w1;
        }
    }
}

__device__ __forceinline__ void ph_mla_naive(const Args& a, int nq, float* sm) {
    const bf16_t* __restrict__ Q = (const bf16_t*)(a.ws + WS_Q); const bf16_t* __restrict__ KV = (const bf16_t*)(a.ws + WS_KV); const bf16_t* __restrict__ KPE = (const bf16_t*)(a.ws + WS_KPE);
    bf16_t* mix = (bf16_t*)(a.ws + WS_MIX);
    const int lane = threadIdx.x & 63, w = threadIdx.x >> 6;
    float* qf = sm + w * 192; float* sc = sm + 8 * 192 + w * 2304;
    for (int unit = blockIdx.x; unit < nq; unit += gridDim.x) {
        const int h = unit & 7, qt = (unit >> 3) * 8 + w; const bool lat = qt < NLAT;
        const int b = lat ? (qt >> 11) : ((qt - NLAT) >> 8);
        const int nk = lat ? (L + C) : C;
        for (int i = lane; i < 192; i += 64) qf[i] = bf2f(Q[(size_t)qt * QW + h * 192 + i]);
        __syncthreads();
        const float scale = 0.07216878364870322f;
        float mx = -3.0e38f;
        for (int kc = 0; kc < nk; kc += 64) {
            const int kk = kc + lane;
            const int kt = lat ? (kk < L ? b * L + kk : NLAT + b * C + (kk - L)) : (NLAT + b * C + kk);
            float s = 0.f;
            const u32x4* kp = (const u32x4*)(KV + (size_t)kt * KVW + h * 256);
            for (int i = 0; i < 16; ++i) { const u32x4 v = kp[i]; const float* q8 = qf + i * 8;
                s += q8[0] * __uint_as_float(v.x << 16) + q8[1] * __uint_as_float(v.x & 0xffff0000u) + q8[2] * __uint_as_float(v.y << 16) + q8[3] * __uint_as_float(v.y & 0xffff0000u)
                   + q8[4] * __uint_as_float(v.z << 16) + q8[5] * __uint_as_float(v.z & 0xffff0000u) + q8[6] * __uint_as_float(v.w << 16) + q8[7] * __uint_as_float(v.w & 0xffff0000u); }
            const u32x4* pp = (const u32x4*)(KPE + (size_t)kt * 64);
            for (int i = 0; i < 8; ++i) { const u32x4 v = pp[i]; const float* q8 = qf + 128 + i * 8;
                s += q8[0] * __uint_as_float(v.x << 16) + q8[1] * __uint_as_float(v.x & 0xffff0000u) + q8[2] * __uint_as_float(v.y << 16) + q8[3] * __uint_as_float(v.y & 0xffff0000u)
                   + q8[4] * __uint_as_float(v.z << 16) + q8[5] * __uint_as_float(v.z & 0xffff0000u) + q8[6] * __uint_as_float(v.w << 16) + q8[7] * __uint_as_float(v.w & 0xffff0000u); }
            s *= scale; sc[kk] = s; mx = fmaxf(mx, s);
        }
        mx = wave_max(mx);
        float sum = 0.f;
        for (int kc = 0; kc < nk; kc += 64) { const float p = expf(sc[kc + lane] - mx); sc[kc + lane] = p; sum += p; }
        sum = wave_sum(sum);
        __syncthreads();
        float o0 = 0.f, o1 = 0.f;
        for (int kk = 0; kk < nk; ++kk) {
            const int kt = lat ? (kk < L ? b * L + kk : NLAT + b * C + (kk - L)) : (NLAT + b * C + kk);
            const unsigned v = *(const unsigned*)(KV + (size_t)kt * KVW + h * 256 + 128 + lane * 2);
            const float p = sc[kk];
            o0 += p * __uint_as_float(v << 16); o1 += p * __uint_as_float(v & 0xffff0000u);
        }
        const float inv = 1.0f / sum;
        *(unsigned*)(mix + (size_t)qt * D + h * 128 + lane * 2) = (unsigned)f2bf(o0 * inv) | ((unsigned)f2bf(o1 * inv) << 16);
        __syncthreads();
    }
}
__device__ __forceinline__ void ph_swa_naive(const Args& a, int l, int nq, float* sm) {
    const bf16_t* __restrict__ SQ = (const bf16_t*)(a.ws + WS_SQ); const bf16_t* __restrict__ SK = (const bf16_t*)(a.ws + WS_SK); const bf16_t* __restrict__ SV = (const bf16_t*)(a.ws + WS_SV);
    const float* sink = a.in[24] + l * 8; bf16_t* mix = (bf16_t*)(a.ws + WS_MIX);
    const int lane = threadIdx.x & 63, w = threadIdx.x >> 6;
    float* qf = sm + w * 64; float* sc = sm + 8 * 64 + w * 576; int* kts = (int*)(sm + 8 * 64 + 8 * 576) + w * 576;
    for (int unit = blockIdx.x; unit < nq; unit += gridDim.x) {
        const int hq = unit & 7, hk = hq >> 2, qt = (unit >> 3) * 8 + w; const bool lat = qt < NLAT;
        const int b = lat ? (qt >> 11) : ((qt - NLAT) >> 8), t = lat ? (qt & 2047) : 0;
        int lo = 0, nloc = 0;
        if (lat) { lo = t - 128 < 0 ? 0 : t - 128; const int hi = t + 128 > L - 1 ? L - 1 : t + 128; nloc = hi - lo + 1; }
        const int nk = nloc + C;
        qf[lane] = bf2f(SQ[(size_t)qt * 512 + hq * 64 + lane]);
        __syncthreads();
        const float skv = sink[hq];
        float mx = skv;
        for (int kc = 0; kc < nk; kc += 64) {
            const int kk = kc + lane;
            if (kk < nk) {
                const int kt = kk < nloc ? (b * L + lo + kk) : (NLAT + b * C + (kk - nloc));
                const u32x4* kp = (const u32x4*)(SK + (size_t)kt * 128 + hk * 64);
                float s = 0.f;
                for (int i = 0; i < 8; ++i) { const u32x4 v = kp[i]; const float* q8 = qf + i * 8;
                    s += q8[0] * __uint_as_float(v.x << 16) + q8[1] * __uint_as_float(v.x & 0xffff0000u) + q8[2] * __uint_as_float(v.y << 16) + q8[3] * __uint_as_float(v.y & 0xffff0000u)
                       + q8[4] * __uint_as_float(v.z << 16) + q8[5] * __uint_as_float(v.z & 0xffff0000u) + q8[6] * __uint_as_float(v.w << 16) + q8[7] * __uint_as_float(v.w & 0xffff0000u); }
                s *= 0.125f; sc[kk] = s; kts[kk] = kt; mx = fmaxf(mx, s);
            }
        }
        mx = wave_max(mx);
        float sum = 0.f;
        for (int kc = 0; kc < nk; kc += 64) { const int kk = kc + lane; if (kk < nk) { const float p = expf(sc[kk] - mx); sc[kk] = p; sum += p; } }
        sum = wave_sum(sum) + expf(skv - mx);
        __syncthreads();
        float o = 0.f;
        for (int kk = 0; kk < nk; ++kk) o += sc[kk] * bf2f(SV[(size_t)kts[kk] * 128 + hk * 64 + lane]);
        mix[(size_t)qt * D + 1536 + hq * 64 + lane] = f2bf(o / sum);
        __syncthreads();
    }
}
template <int LS>
__device__ __forceinline__ void ph_hyena_naive(const Args& a, int l, float* sm) {
    const float* filt = LS == L ? (const float*)(a.ws + WS_FILTL) + (size_t)l * 512 * 4096 : (const float*)(a.ws + WS_FILTC) + (size_t)l * 512 * 512;
    const bf16_t* wt = (const bf16_t*)(a.ws + (LS == L ? WS_WTL : WS_WTC)); const bf16_t* x0 = (const bf16_t*)(a.ws + WS_X0); const float* skip = a.in[23] + l * 512;
    bf16_t* mix = (bf16_t*)(a.ws + WS_MIX); const int tok_base = LS == L ? 0 : NLAT;
    float* T = sm; float* ws = sm + 2 * LS; const int tid = threadIdx.x;
    for (int unit = blockIdx.x; unit < 512 * NB; unit += gridDim.x) {
        const int ch = unit >> 2, b = unit & 3;
        for (int i = tid; i < 2 * LS; i += NTHR) T[i] = filt[(size_t)ch * 2 * LS + i];
        for (int i = tid; i < LS; i += NTHR) ws[i] = bf2f(wt[((size_t)b * 512 + ch) * LS + i]);
        __syncthreads();
        const float sk = skip[ch];
        for (int t = tid; t < LS; t += NTHR) {
            float y = 0.f;
            for (int s = 0; s < LS; ++s) y += T[t - s + LS] * ws[s];
            const int tok = tok_base + b * LS + t;
            mix[(size_t)tok * D + 1024 + ch] = f2bf(bf2f(x0[(size_t)tok * 512 + ch]) * (y + sk * ws[t]));
        }
        __syncthreads();
    }
}
__device__ __forceinline__ void ph_route(const Args& a, int* sm) {
    const int* topi = (const int*)(a.ws + WS_TOPI); int* pos = (int*)(a.ws + WS_POS); int* src = (int*)(a.ws + WS_SRC); int* ctl = (int*)(a.ws + WS_CTL);
    if (blockIdx.x != 0) return;
    int (*cnt)[512] = (int (*)[512])sm; int* eoff = sm + 8 * 512;
    const int tid = threadIdx.x;
    for (int i = tid; i < MOE_ROWS; i += NTHR) src[i] = -1;
    int c[8];
#pragma unroll
    for (int e = 0; e < 8; ++e) c[e] = 0;
    for (int i = 0; i < 32; ++i) { const int e = topi[tid * 32 + i];
#pragma unroll
        for (int q = 0; q < 8; ++q) c[q] += (e == q) ? 1 : 0; }
#pragma unroll
    for (int e = 0; e < 8; ++e) cnt[e][tid] = c[e];
    __syncthreads();
    if (tid < 8) { int s = 0; for (int i = 0; i < 512; ++i) { const int v = cnt[tid][i]; cnt[tid][i] = s; s += v; } eoff[tid] = s; }
    __syncthreads();
    if (tid == 0) { int o = 0; for (int e = 0; e < 8; ++e) { const int n = eoff[e], p = (n + 255) & ~255; ctl[CT_EOFF + e] = o; ctl[CT_EPAD + e] = p; eoff[e] = o; o += p; } ctl[CT_NTILE] = o >> 8; }
    __syncthreads();
#pragma unroll
    for (int e = 0; e < 8; ++e) c[e] = eoff[e] + cnt[e][tid];
    for (int i = 0; i < 32; ++i) { const int idx = tid * 32 + i; const int e = topi[idx]; int p = 0;
#pragma unroll
        for (int q = 0; q < 8; ++q) if (e == q) { p = c[q]; c[q]++; }
        pos[idx] = p; src[p] = idx >> 1; }
}
__device__ __forceinline__ void ph_gather(const Args& a) {
    const bf16_t* hb = (const bf16_t*)(a.ws + WS_HA); const int* src = (const int*)(a.ws + WS_SRC); bf16_t* hbs = (bf16_t*)(a.ws + WS_HBS);
    const int nrows = ((const int*)(a.ws + WS_CTL))[CT_NTILE] * 256;
    const int half = threadIdx.x >> 8, t = threadIdx.x & 255;
    for (int r = blockIdx.x * 2 + half; r < nrows; r += gridDim.x * 2) {
        const int s = src[r]; u32x4 v = (u32x4){0u, 0u, 0u, 0u};
        if (s >= 0) v = *(const u32x4*)(hb + (size_t)s * D + t * 8);
        *(u32x4*)(hbs + (size_t)r * D + t * 8) = v;
    }
}
__device__ __forceinline__ void ph_final(const Args& a) {
    const float* xs = (const float*)(a.ws + WS_XS); const float* ys = (const float*)(a.ws + WS_YS); const int* pos = (const int*)(a.ws + WS_POS); const float* topw = (const float*)(a.ws + WS_TOPW);
    const float* modl = (const float*)(a.ws + WS_MOD) + (size_t)5 * 12288; const float* gfin = a.in[33]; float* out = a.out;
    const int lane = threadIdx.x & 63, wid = threadIdx.x >> 6;
    for (int row = blockIdx.x * 8 + wid; row < NLAT; row += gridDim.x * 8) {
        const float* g2 = modl + (size_t)tok_mod(row) * 12288 + 10240;
        const int p0 = pos[row * 2], p1 = pos[row * 2 + 1]; const float w0 = topw[row * 2], w1 = topw[row * 2 + 1];
        f32x4 v[8]; float ss = 0.f;
#pragma unroll
        for (int i = 0; i < 8; ++i) { const int col = i * 256 + lane * 4;
            const f32x4 x = *(const f32x4*)(xs + (size_t)row * D + col), ya = *(const f32x4*)(ys + (size_t)p0 * D + col), yb = *(const f32x4*)(ys + (size_t)p1 * D + col), g = *(const f32x4*)(g2 + col);
#pragma unroll
            for (int j = 0; j < 4; ++j) { v[i][j] = x[j] + g[j] * (w0 * ya[j] + w1 * yb[j]); ss += v[i][j] * v[i][j]; } }
        ss = wave_sum(ss); const float rstd = rsqrtf(ss * (1.0f / D) + EPS);
#pragma unroll
        for (int i = 0; i < 8; ++i) { const int col = i * 256 + lane * 4; const f32x4 g = *(const f32x4*)(gfin + col); f32x4 o;
#pragma unroll
            for (int j = 0; j < 4; ++j) o[j] = v[i][j] * rstd * g[j];
            *(f32x4*)(out + (size_t)row * D + col) = o; }
    }
}

typedef float f32x2_t __attribute__((ext_vector_type(2))); typedef __bf16 bf16x2_t __attribute__((ext_vector_type(2)));
__device__ __forceinline__ unsigned cvtpk(float lo, float hi) { f32x2_t v = {lo, hi}; bf16x2_t b = __builtin_convertvector(v, bf16x2_t); return __builtin_bit_cast(unsigned, b); }
#define MFMA32(a, b, c) __builtin_amdgcn_mfma_f32_32x32x16_bf16((a), (b), (c), 0, 0, 0)
constexpr int MLA_KP = 400, MLA_VP = 144, MLA_KB = 64 * MLA_KP, MLA_VB = 128 * MLA_VP, MLA_STAGE = MLA_KB + MLA_VB;
static_assert(2 * MLA_STAGE <= RING_BYTES, "MLA LDS");

__device__ __forceinline__ void ph_mla(const Args& a, bool with_ctx, unsigned char* lds) {
    const bf16_t* __restrict__ Q = (const bf16_t*)(a.ws + WS_Q); const bf16_t* __restrict__ KN = (const bf16_t*)(a.ws + WS_KN); const bf16_t* __restrict__ KPE = (const bf16_t*)(a.ws + WS_KPE);
    const bf16_t* __restrict__ VT = (const bf16_t*)(a.ws + WS_VT); bf16_t* __restrict__ mix = (bf16_t*)(a.ws + WS_MIX);
    int tid_ = threadIdx.x; asm volatile("" : "+v"(tid_));
    const int tid = tid_, lane = tid & 63, w = tid >> 6, qi = lane & 31, hh = lane >> 5;
    const int nunits = with_ctx ? 288 : 256;
    const float c = 0.07216878364870322f * 1.4426950408889634f;
    for (int unit = blockIdx.x; unit < nunits; unit += gridDim.x) {
        int h, b, q0tok, nt; bool ctxq;
        if (unit < 256) { h = unit & 7; b = unit >> 6; q0tok = b * L + ((unit >> 3) & 7) * 256; nt = 36; ctxq = false; }
        else { const int u2 = unit - 256; h = u2 & 7; b = u2 >> 3; q0tok = NLAT + b * C; nt = 4; ctxq = true; }
#define MLA_KTOK(t) (ctxq ? (NLAT + b * C + (t) * 64) : ((t) < 32 ? (b * L + (t) * 64) : (NLAT + b * C + ((t) - 32) * 64)))
        u32x4 r0, r1, r2, r3, r4;
#define MLA_ISSUE(t) do { const int kt0_ = MLA_KTOK(t); \
            r0 = *(const u32x4*)(KN + (size_t)(kt0_ + (tid >> 4)) * 1024 + h * 128 + (tid & 15) * 8); \
            r1 = *(const u32x4*)(KN + (size_t)(kt0_ + 32 + (tid >> 4)) * 1024 + h * 128 + (tid & 15) * 8); \
            r2 = *(const u32x4*)(KPE + (size_t)(kt0_ + (tid >> 3)) * 64 + (tid & 7) * 8); \
            r3 = *(const u32x4*)(VT + (size_t)(h * 128 + (tid >> 3)) * NTOK + kt0_ + (tid & 7) * 8); \
            r4 = *(const u32x4*)(VT + (size_t)(h * 128 + 64 + (tid >> 3)) * NTOK + kt0_ + (tid & 7) * 8); } while (0)
#define MLA_COMMIT(buf) do { unsigned char* kb_ = lds + (buf) * MLA_STAGE; unsigned char* vb_ = kb_ + MLA_KB; \
            *(u32x4*)(kb_ + (tid >> 4) * MLA_KP + (tid & 15) * 16) = r0; \
            *(u32x4*)(kb_ + (32 + (tid >> 4)) * MLA_KP + (tid & 15) * 16) = r1; \
            *(u32x4*)(kb_ + (tid >> 3) * MLA_KP + 256 + (tid & 7) * 16) = r2; \
            const int g_ = (tid & 7) >> 1, e_ = tid & 1; \
            { u32x2 lo_, hi_; lo_.x = r3.x; lo_.y = r3.y; hi_.x = r3.z; hi_.y = r3.w; \
              *(u32x2*)(vb_ + (tid >> 3) * MLA_VP + g_ * 32 + e_ * 8) = lo_; *(u32x2*)(vb_ + (tid >> 3) * MLA_VP + g_ * 32 + 16 + e_ * 8) = hi_; } \
            { u32x2 lo_, hi_; lo_.x = r4.x; lo_.y = r4.y; hi_.x = r4.z; hi_.y = r4.w; \
              *(u32x2*)(vb_ + (64 + (tid >> 3)) * MLA_VP + g_ * 32 + e_ * 8) = lo_; *(u32x2*)(vb_ + (64 + (tid >> 3)) * MLA_VP + g_ * 32 + 16 + e_ * 8) = hi_; } } while (0)
        const int qtok = q0tok + w * 32 + qi;
        bf16x8 qf[12];
#pragma unroll
        for (int s = 0; s < 12; ++s) qf[s] = *(const bf16x8*)(Q + (size_t)qtok * QW + h * 192 + s * 16 + hh * 8);
        f32x16 o[4];
#pragma unroll
        for (int d = 0; d < 4; ++d)
#pragma unroll
            for (int r = 0; r < 16; ++r) o[d][r] = 0.f;
        float m = -1.0e30f, l = 0.f;
        MLA_ISSUE(0); MLA_COMMIT(0);
        __syncthreads();
        for (int t = 0; t < nt; ++t) {
            const unsigned char* kb = lds + (t & 1) * MLA_STAGE; const unsigned char* vb = kb + MLA_KB;
            f32x16 s0, s1;
#pragma unroll
            for (int r = 0; r < 16; ++r) { s0[r] = 0.f; s1[r] = 0.f; }
#pragma unroll
            for (int s = 0; s < 12; ++s) {
                const bf16x8 k0 = *(const bf16x8*)(kb + qi * MLA_KP + s * 32 + hh * 16);
                const bf16x8 k1 = *(const bf16x8*)(kb + (32 + qi) * MLA_KP + s * 32 + hh * 16);
                s0 = MFMA32(k0, qf[s], s0); s1 = MFMA32(k1, qf[s], s1);
                if ((s & 3) == 3) asm volatile("" ::: "memory");
            }
            if (t + 1 < nt) MLA_ISSUE(t + 1);
            float mx = fmaxf(s0[0], s1[0]);
#pragma unroll
            for (int r = 1; r < 16; ++r) mx = fmaxf(mx, fmaxf(s0[r], s1[r]));
            mx = fmaxf(mx, __shfl_xor(mx, 32));
            const float mnew = fmaxf(m, mx * c);
            const float alpha = __builtin_amdgcn_exp2f(m - mnew);
            m = mnew;
            float ps = 0.f;
#pragma unroll
            for (int r = 0; r < 16; ++r) { s0[r] = __builtin_amdgcn_exp2f(s0[r] * c - mnew); s1[r] = __builtin_amdgcn_exp2f(s1[r] * c - mnew); ps += s0[r] + s1[r]; }
            l = l * alpha + ps;
#pragma unroll
            for (int d = 0; d < 4; ++d)
#pragma unroll
                for (int r = 0; r < 16; ++r) o[d][r] *= alpha;
            bf16x8 pf[4];
            { u32x4 p;
              p.x = cvtpk(s0[0], s0[1]); p.y = cvtpk(s0[2], s0[3]); p.z = cvtpk(s0[4], s0[5]); p.w = cvtpk(s0[6], s0[7]); pf[0] = __builtin_bit_cast(bf16x8, p);
              p.x = cvtpk(s0[8], s0[9]); p.y = cvtpk(s0[10], s0[11]); p.z = cvtpk(s0[12], s0[13]); p.w = cvtpk(s0[14], s0[15]); pf[1] = __builtin_bit_cast(bf16x8, p);
              p.x = cvtpk(s1[0], s1[1]); p.y = cvtpk(s1[2], s1[3]); p.z = cvtpk(s1[4], s1[5]); p.w = cvtpk(s1[6], s1[7]); pf[2] = __builtin_bit_cast(bf16x8, p);
              p.x = cvtpk(s1[8], s1[9]); p.y = cvtpk(s1[10], s1[11]); p.z = cvtpk(s1[12], s1[13]); p.w = cvtpk(s1[14], s1[15]); pf[3] = __builtin_bit_cast(bf16x8, p); }
            asm volatile("" ::: "memory");
#pragma unroll
            for (int d = 0; d < 4; ++d) {
#pragma unroll
                for (int g = 0; g < 4; ++g) {
                    const bf16x8 vf = *(const bf16x8*)(vb + (d * 32 + qi) * MLA_VP + g * 32 + hh * 16);
                    o[d] = MFMA32(vf, pf[g], o[d]);
                }
                if (d & 1) asm volatile("" ::: "memory");
            }
            if (t + 1 < nt) MLA_COMMIT((t + 1) & 1);
            __syncthreads();
        }
        const float inv = 1.0f / (l + __shfl_xor(l, 32));
        bf16_t* op = mix + (size_t)qtok * D + h * 128 + 4 * hh;
#pragma unroll
        for (int d = 0; d < 4; ++d)
#pragma unroll
            for (int g = 0; g < 4; ++g) { u32x2 wv; wv.x = cvtpk(o[d][4 * g] * inv, o[d][4 * g + 1] * inv); wv.y = cvtpk(o[d][4 * g + 2] * inv, o[d][4 * g + 3] * inv);
                *(u32x2*)(op + d * 32 + 8 * g) = wv; }
#undef MLA_KTOK
#undef MLA_ISSUE
#undef MLA_COMMIT
    }
}


constexpr int NPHASES = 22;
#define GEMM_CALL(EPI, SCHED, g, S, E) pg8::gemm_phase<EPI, SCHED, true, true>((PG8_LAS unsigned char*)lds, g, S, E)

template <int LYR>
__device__ __forceinline__ void layer_phases(const Args& a, unsigned char* lds, const XcdBarrier& bar, int lo, int hi) {
#define IN(k) (lo <= (k) && (k) < hi)
#if MK_PER_PHASE
#define SEAM(k) do { } while (0)
#else
#define SEAM(k) do { if (IN(k) && IN((k) + 1)) xcd_barrier(bar); } while (0)
#endif
    constexpr int P0 = 1 + LYR * 9;
    constexpr bool LAST = (LYR == 1);
    const int G = gridDim.x, bid = blockIdx.x;
    unsigned char* ws = a.ws;
    const float* modl = (const float*)(ws + WS_MOD) + (size_t)LYR * 5 * 12288;
    float* xs = (float*)(ws + WS_XS);
    const int nq = LAST ? NLAT : NTOK;
    if (IN(P0 + 0)) {
        if (LYR == 0) ph_normmod<false, true>(a.in[0], a.in[2], a.in[6], modl, 0, 2048, (bf16_t*)(ws + WS_HA), NTOK, xs, nullptr, nullptr, nullptr);
        else ph_normmod<false, false>(xs, xs + (size_t)NLAT * D, a.in[6] + D, modl, 0, 2048, (bf16_t*)(ws + WS_HA), NTOK, nullptr, nullptr, nullptr, nullptr);
    }
    SEAM(P0 + 0);
    if (IN(P0 + 1)) {
        pg8::Gemm g{(const bf16_t*)(ws + WS_HA), (const bf16_t*)(ws + WS_WIN + (size_t)LYR * UW * D * 2), NTOK, UW, D};
        pg8::StaticOrder S; S.init(NTOK, UW, G, bid); pg8::EpiStore E{(bf16_t*)(ws + WS_U), UW};
        GEMM_CALL(pg8::EpiStore, pg8::StaticOrder, g, S, E);
    }
    SEAM(P0 + 1);
    if (IN(P0 + 2)) ph_mid(a, LYR);
    SEAM(P0 + 2);
    if (IN(P0 + 3)) {
        { pg8::Gemm g{(const bf16_t*)(ws + WS_CQN), (const bf16_t*)(ws + WS_WQ + (size_t)LYR * QW * 768 * 2), nq, QW, 768};
          pg8::StaticOrder S; S.init(nq, QW, G, bid); pg8::EpiQ E{(bf16_t*)(ws + WS_Q), (const float*)(ws + WS_ROPE), (const float*)(ws + WS_ROPE) + 2048 * 32};
          GEMM_CALL(pg8::EpiQ, pg8::StaticOrder, g, S, E); }
        __syncthreads();
        { pg8::Gemm g{(const bf16_t*)(ws + WS_CKVN), (const bf16_t*)(ws + WS_WKV + (size_t)LYR * KVW * 512 * 2), NTOK, 1024, 512};
          pg8::StaticOrder S; S.init(NTOK, 1024, G, bid); pg8::EpiStore E{(bf16_t*)(ws + WS_KN), 1024};
          GEMM_CALL(pg8::EpiStore, pg8::StaticOrder, g, S, E); }
        __syncthreads();
        { pg8::Gemm g{(const bf16_t*)(ws + WS_WKV + (size_t)LYR * KVW * 512 * 2 + (size_t)1024 * 512 * 2), (const bf16_t*)(ws + WS_CKVN), 1024, NTOK, 512};
          pg8::StaticOrder S; S.init(1024, NTOK, 108, bid >= 216 ? bid - 216 : (bid >= 144 ? bid - 108 : (1 << 24))); pg8::EpiStore E{(bf16_t*)(ws + WS_VT), NTOK};
          GEMM_CALL(pg8::EpiStore, pg8::StaticOrder, g, S, E); }
        __syncthreads();
        ph_hyena_naive<L>(a, LYR, (float*)lds);
        if (!LAST) ph_hyena_naive<C>(a, LYR, (float*)lds);
        ph_swa_naive(a, LYR, nq, (float*)lds);
    }
    SEAM(P0 + 3);
    if (IN(P0 + 4)) ph_mla(a, !LAST, lds);
    SEAM(P0 + 4);
    if (IN(P0 + 5)) {
        pg8::Gemm g{(const bf16_t*)(ws + WS_MIX), (const bf16_t*)(ws + WS_WOUT + (size_t)LYR * D * D * 2), nq, D, D};
        pg8::StaticOrder S; S.init(nq, D, G, bid); pg8::EpiResid E{xs, modl + 4096};
        GEMM_CALL(pg8::EpiResid, pg8::StaticOrder, g, S, E);
    }
    SEAM(P0 + 5);
    if (!LAST) {
        if (IN(P0 + 6)) ph_normmod<false, false>(xs, xs + (size_t)NLAT * D, a.in[7], modl, 6144, 8192, (bf16_t*)(ws + WS_HA), NTOK, nullptr, nullptr, nullptr, nullptr);
        SEAM(P0 + 6);
        if (IN(P0 + 7)) {
            pg8::Gemm g{(const bf16_t*)(ws + WS_HA), (const bf16_t*)(ws + WS_WGU), NTOK, 2 * DFF, D};
            pg8::StaticOrder S; S.init(NTOK, 2 * DFF, G, bid); pg8::EpiSwiGLU E{(bf16_t*)(ws + WS_ACT), DFF};
            GEMM_CALL(pg8::EpiSwiGLU, pg8::StaticOrder, g, S, E);
        }
        SEAM(P0 + 7);
        if (IN(P0 + 8)) {
            pg8::Gemm g{(const bf16_t*)(ws + WS_ACT), (const bf16_t*)(ws + WS_WDN), NTOK, D, DFF};
            pg8::StaticOrder S; S.init(NTOK, D, G, bid); pg8::EpiResid E{xs, modl + 10240};
            GEMM_CALL(pg8::EpiResid, pg8::StaticOrder, g, S, E);
        }
        SEAM(P0 + 8);
    } else {
        if (IN(P0 + 6)) ph_normmod<true, false>(xs, xs + (size_t)NLAT * D, a.in[7] + D, modl, 6144, 8192, (bf16_t*)(ws + WS_HA), NLAT, nullptr, a.in[29], (int*)(ws + WS_TOPI), (float*)(ws + WS_TOPW));
        SEAM(P0 + 6);
        if (IN(P0 + 7)) ph_route(a, (int*)lds);
        SEAM(P0 + 7);
        if (IN(P0 + 8)) ph_gather(a);
        SEAM(P0 + 8);
        if (IN(P0 + 9)) {
            pg8::Gemm g{(const bf16_t*)(ws + WS_HBS), (const bf16_t*)(ws + WS_MGU), MOE_ROWS, 2 * DFE, D};
            pg8::MoeOrder S; S.init((const int*)(ws + WS_CTL), 2 * DFE / 256, G, bid, (size_t)2 * DFE * D * 2); pg8::EpiSwiGLU E{(bf16_t*)(ws + WS_ACT), DFE};
            GEMM_CALL(pg8::EpiSwiGLU, pg8::MoeOrder, g, S, E);
        }
        SEAM(P0 + 9);
        if (IN(P0 + 10)) {
            pg8::Gemm g{(const bf16_t*)(ws + WS_ACT), (const bf16_t*)(ws + WS_MDN), MOE_ROWS, D, DFE};
            pg8::MoeOrder S; S.init((const int*)(ws + WS_CTL), D / 256, G, bid, (size_t)D * DFE * 2); pg8::EpiF32 E{(float*)(ws + WS_YS), D};
            GEMM_CALL(pg8::EpiF32, pg8::MoeOrder, g, S, E);
        }
        SEAM(P0 + 10);
        if (IN(P0 + 11)) ph_final(a);
    }
#undef IN
#undef SEAM
}

__global__ void __launch_bounds__(NTHR, 2) mk_fwd(Args a) {
    extern __shared__ __attribute__((aligned(16))) unsigned char lds[];
    const int tid = threadIdx.x;
    for (int u = tid; u < (LDS_BYTES - LDSCTL_OFF) / 4; u += NTHR) ((unsigned*)(lds + LDSCTL_OFF))[u] = 0u;
    __syncthreads();
    XcdBarrier bar; bar.bar = (unsigned*)(a.ws + WS_CTL) + CW_BAR; bar.x = 0; bar.st = nullptr;
#if !MK_PER_PHASE
    bar = xcd_barrier_post((unsigned*)(a.ws + WS_CTL) + CW_BAR, (volatile LAS unsigned*)(lds + LDSCTL_OFF + 32));
#endif
    const int lo = a.ph_lo, hi = a.ph_hi;
    if (lo <= 0 && 0 < hi) {
        ph_prologue(a, (float*)lds);
#if !MK_PER_PHASE
        if (1 < hi) xcd_barrier(bar);
#endif
    }
    layer_phases<0>(a, lds, bar, lo, hi);
    layer_phases<1>(a, lds, bar, lo, hi);
}

extern "C" void kernel_launch(void* const* d_in, const int* in_sizes, int n_in, void* d_out, int out_size, void* d_ws, size_t ws_size, hipStream_t stream) {
    (void)in_sizes; (void)out_size;
    static int grid = 0;
    if (grid == 0) {
        if (n_in != 34 || ws_size < WS_END) { fprintf(stderr, "kernel_launch: need 34 inputs and >= %zu bytes of workspace (got %d, %zu)\n", (size_t)WS_END, n_in, ws_size); grid = -1; return; }
        int dev = 0, cus = 0, per_cu = 0;
        if (hipGetDevice(&dev) != hipSuccess || hipDeviceGetAttribute(&cus, hipDeviceAttributeMultiprocessorCount, dev) != hipSuccess) { grid = -1; return; }
        if (hipFuncSetAttribute((const void*)mk_fwd, hipFuncAttributeMaxDynamicSharedMemorySize, LDS_BYTES) != hipSuccess) { fprintf(stderr, "kernel_launch: hipFuncSetAttribute failed\n"); grid = -1; return; }
        if (hipOccupancyMaxActiveBlocksPerMultiprocessor(&per_cu, (const void*)mk_fwd, NTHR, LDS_BYTES) != hipSuccess || per_cu < 1) { fprintf(stderr, "kernel_launch: occupancy query says %d blocks per CU\n", per_cu); }
        (void)hipGetLastError();
        grid = cus;
    }
    if (grid < 0) return;
    if (hipMemsetAsync((char*)d_ws + WS_CTL, 0, CTL_ZERO_BYTES, stream) != hipSuccess) return;
    Args a{};
    for (int i = 0; i < 34; ++i) a.in[i] = (const float*)d_in[i];
    a.out = (float*)d_out; a.ws = (unsigned char*)d_ws;
#if MK_PER_PHASE
    for (int p = 0; p < NPHASES; ++p) { a.ph_lo = p; a.ph_hi = p + 1; hipLaunchKernelGGL(mk_fwd, dim3(grid), dim3(NTHR), LDS_BYTES, stream, a); }
#else
    a.ph_lo = 0; a.ph_hi = NPHASES;
    hipLaunchKernelGGL(mk_fwd, dim3(grid), dim3(NTHR), LDS_BYTES, stream, a);
#endif
}
```

```cpp
#include <hip/hip_runtime.h>
#include <stdint.h>
#include <stdio.h>

#ifndef MK_PER_PHASE
#define MK_PER_PHASE 0
#endif

typedef unsigned short bf16_t;
typedef float f32x4 __attribute__((ext_vector_type(4)));
typedef float f32x16 __attribute__((ext_vector_type(16)));
typedef unsigned u32x4 __attribute__((ext_vector_type(4)));
typedef unsigned u32x2 __attribute__((ext_vector_type(2)));
typedef short bf16x8 __attribute__((ext_vector_type(8)));

constexpr int D = 2048, NB = 4, L = 2048, C = 256, NLAT = NB * L, NCTX = NB * C, NTOK = NLAT + NCTX;
constexpr int UW = 3840;
constexpr int O_CQ = 0, O_CKV = 768, O_KPE = 1280, O_HY = 1344, O_SQ = 2880, O_SK = 3392, O_SV = 3520, INW = 3648;
constexpr int QW = 1536, KVW = 2048, DFF = 5632, DFE = 7168, NE = 8;
constexpr int MOE_ROWS = 18432;
constexpr float EPS = 1e-6f;
constexpr int NTHR = 512;
constexpr int HY_RBROW = 4112;

__device__ __forceinline__ float bf2f(bf16_t h) { return __uint_as_float(((unsigned)h) << 16); }
__device__ __forceinline__ bf16_t f2bf(float f) { unsigned u = __float_as_uint(f); u += 0x7fffu + ((u >> 16) & 1u); return (bf16_t)(u >> 16); }
__device__ __forceinline__ float wave_sum(float v) { for (int o = 32; o > 0; o >>= 1) v += __shfl_xor(v, o); return v; }
__device__ __forceinline__ float wave_max(float v) { for (int o = 32; o > 0; o >>= 1) v = fmaxf(v, __shfl_xor(v, o)); return v; }
__device__ __forceinline__ float silu(float x) { return x / (1.0f + __expf(-x)); }
__device__ __forceinline__ int tok_mod(int tok) { return tok < NLAT ? (tok >> 11) : 4; }

constexpr size_t al(size_t x) { return (x + 255) & ~(size_t)255; }
constexpr size_t WS_CTL = 0, CTL_ZERO_BYTES = 65536;
constexpr size_t WS_MOD = 65536;
constexpr size_t WS_ROPE = WS_MOD + al((size_t)2 * 5 * 12288 * 4);
constexpr size_t WS_FILTL = WS_ROPE + al((size_t)2 * 2048 * 32 * 4);
constexpr size_t WS_FILTC = WS_FILTL + al((size_t)2 * 512 * 4096 * 4);
constexpr size_t WS_WIN = WS_FILTC + al((size_t)2 * 512 * 512 * 4);
constexpr size_t WS_WQ = WS_WIN + al((size_t)2 * UW * D * 2);
constexpr size_t WS_WKV = WS_WQ + al((size_t)2 * QW * 768 * 2);
constexpr size_t WS_WOUT = WS_WKV + al((size_t)2 * KVW * 512 * 2);
constexpr size_t WS_WGU = WS_WOUT + al((size_t)2 * D * D * 2);
constexpr size_t WS_WDN = WS_WGU + al((size_t)2 * DFF * D * 2);
constexpr size_t WS_MGU = WS_WDN + al((size_t)D * DFF * 2);
constexpr size_t WS_MDN = WS_MGU + al((size_t)NE * 2 * DFE * D * 2);
constexpr size_t WS_HA = WS_MDN + al((size_t)NE * D * DFE * 2);
constexpr size_t WS_U = WS_HA + al((size_t)NTOK * D * 2);
constexpr size_t WS_CQN = WS_U + al((size_t)NTOK * UW * 2);
constexpr size_t WS_CKVN = WS_CQN + al((size_t)NTOK * 768 * 2);
constexpr size_t WS_KPE = WS_CKVN + al((size_t)NTOK * 512 * 2);
constexpr size_t WS_X0 = WS_KPE + al((size_t)NTOK * 64 * 2);
constexpr size_t WS_WTL = WS_X0 + al((size_t)NTOK * 512 * 2);
constexpr size_t WS_WTC = WS_WTL + al((size_t)NB * 512 * L * 2);
constexpr size_t WS_SQ = WS_WTC + al((size_t)NB * 512 * C * 2);
constexpr size_t WS_SK = WS_SQ + al((size_t)NTOK * 512 * 2);
constexpr size_t WS_SV = WS_SK + al((size_t)NTOK * 128 * 2);
constexpr size_t WS_Q = WS_SV + al((size_t)NTOK * 128 * 2);
constexpr size_t WS_KV = WS_Q + al((size_t)NTOK * QW * 2);
constexpr size_t WS_KN = WS_KV;
constexpr size_t WS_VT = WS_KV + (size_t)NTOK * 1024 * 2;
constexpr size_t WS_MIX = WS_KV + al((size_t)NTOK * KVW * 2);
constexpr size_t WS_MIXEND = WS_MIX + al((size_t)NTOK * D * 2);
constexpr size_t WS_YS = WS_U;
static_assert(WS_YS + (size_t)MOE_ROWS * D * 4 <= WS_MIXEND, "ys overlay");
constexpr size_t WS_XS = WS_MIXEND;
constexpr size_t WS_ACT = WS_XS + al((size_t)NTOK * D * 4);
constexpr size_t WS_HBS = WS_ACT + al((size_t)MOE_ROWS * DFE * 2);
constexpr size_t WS_TOPI = WS_HBS + al((size_t)MOE_ROWS * D * 2);
constexpr size_t WS_TOPW = WS_TOPI + al((size_t)NLAT * 2 * 4);
constexpr size_t WS_POS = WS_TOPW + al((size_t)NLAT * 2 * 4);
constexpr size_t WS_SRC = WS_POS + al((size_t)NLAT * 2 * 4);
constexpr size_t WS_END = WS_SRC + al((size_t)MOE_ROWS * 4);
constexpr int CT_EOFF = 1024, CT_EPAD = 1040, CT_NTILE = 1056;
constexpr int CW_BAR = 4096;

constexpr int RING_BYTES = 131072, LDSCTL_OFF = RING_BYTES, LDS_BYTES = 147456;

namespace pg8 {
#define PG8_LAS __attribute__((address_space(3)))
typedef unsigned short bf16_t;
typedef short bf16x8 __attribute__((ext_vector_type(8)));
typedef float f32x4 __attribute__((ext_vector_type(4)));
typedef unsigned u32x4 __attribute__((ext_vector_type(4)));
constexpr int BM = 256, BK = 64, HALF = 128, HTB = HALF * BK * 2  , STAGE_BYTES = 8 * HTB, NXCD = 8, WGM = 8;

__host__ __device__ __forceinline__ int lds_byte(int r, int c) { const int st = (r >> 4) * 2 + (c >> 5), rr = r & 15, cc = c & 31, ob = rr * 64 + cc * 2; return st * 1024 + (ob ^ (((ob >> 9) & 1) << 5)); }
__host__ __device__ __forceinline__ void stage_rc(int b, int& R, int& C) { const int st = b / 1024, sb = b % 1024, swz = sb ^ (((sb >> 9) & 1) << 5); R = (st >> 1) * 16 + swz / 64; C = (st & 1) * 32 + (swz % 64) / 2; }
__host__ __device__ __forceinline__ int perm32(int rho) { const int n = rho >> 4, i = rho & 15; return 8 * (i >> 2) + 4 * n + (i & 3); }

struct Unit { int pm, pn; };
struct Gemm { const bf16_t* A; const bf16_t* Bt; int M, N, K; };

struct StaticOrder {
    int nM, nN, nwg, G, c;
    __host__ __device__ void init(int M, int N, int G_, int c_) { nM = M / BM; nN = N / BM; nwg = nM * nN; G = G_; c = c_; }
    __host__ __device__ bool next(int i, Unit& u) const {
        const long L = (long)i * G + c; if (L >= nwg) return false;
        int wgid = (int)L; { const int q = nwg / NXCD, r = nwg % NXCD, xcd = wgid % NXCD, off = wgid / NXCD; wgid = (xcd < r ? xcd * (q + 1) : r * (q + 1) + (xcd - r) * q) + off; }
        const int nig = WGM * nN, gid = wgid / nig, fm = gid * WGM, gsz = (nM - fm) < WGM ? (nM - fm) : WGM;
        u.pm = fm + ((wgid % nig) % gsz); u.pn = (wgid % nig) / gsz; return true;
    }
    __device__ __forceinline__ size_t bt_off(const Unit&) const { return 0; }
    __device__ __forceinline__ void a_ready(const Unit&) const {}
    __device__ __forceinline__ void done(const Unit&) const {}
};

__device__ __forceinline__ unsigned cvt_pk_bf16(float lo, float hi) { unsigned r; asm volatile("v_cvt_pk_bf16_f32 %0, %1, %2" : "=v"(r) : "v"(lo), "v"(hi)); return r; }
typedef float f32x2 __attribute__((ext_vector_type(2)));
template <class Epi, class Sched, bool ALIGN_EPI = false, bool SP2 = false>
__device__ __forceinline__ void gemm_phase(PG8_LAS unsigned char* lds, const Gemm g, const Sched& S, const Epi& E) {
    int tid_ = threadIdx.x; asm volatile("" : "+v"(tid_));
    const int tid = tid_, wid = __builtin_amdgcn_readfirstlane(tid >> 6), lane = tid & 63, wr = wid >> 2, wc = wid & 3, fr = lane & 15, fq = lane >> 4;
    const int K = g.K, nt = K / BK;
    unsigned voffA[2], voffB[2];
#pragma unroll
    for (int i = 0; i < 2; ++i) { int R, C; stage_rc(tid * 16 + i * 8192, R, C); const int Rb = Epi::PERM ? ((R & ~31) + perm32(R & 31)) : R;
        voffA[i] = (unsigned)(R * K + C) * 2u; voffB[i] = (unsigned)(Rb * K + C) * 2u; }
    const size_t kstep = (size_t)(BK * 2);
    const size_t hstep = (size_t)HALF * K * 2;
    const size_t tstep = 2 * hstep;
    const unsigned ldsw = (unsigned)wid * 1024u;
    const int aoff = lds_byte(wr * 64 + fr, fq * 8), boff = lds_byte(wc * 32 + fr, fq * 8);
#define PG8_SA(b, h) (((b) * 2 + (h)) * HTB)
#define PG8_SB(b, h) ((4 + (b) * 2 + (h)) * HTB)
#define PG8_STAGE(bufoff, gbase, voff) do { _Pragma("unroll") for (int _i = 0; _i < 2; ++_i) \
        __builtin_amdgcn_global_load_lds((const unsigned*)((const char*)(gbase) + (voff)[_i]), (PG8_LAS unsigned*)(lds + (bufoff) + ldsw + _i * 8192), 16, 0, 0); } while (0)
#define PG8_LDA(dst, b, h) do { _Pragma("unroll") for (int m = 0; m < 4; ++m) _Pragma("unroll") for (int k = 0; k < 2; ++k) dst[m][k] = *(const PG8_LAS bf16x8*)(lds + PG8_SA(b, h) + aoff + m * 2048 + k * 1024); } while (0)
#define PG8_LDB(dst, b, h) do { _Pragma("unroll") for (int n = 0; n < 2; ++n) _Pragma("unroll") for (int k = 0; k < 2; ++k) dst[n][k] = *(const PG8_LAS bf16x8*)(lds + PG8_SB(b, h) + boff + n * 2048 + k * 1024); } while (0)
#define PG8_MMA(ai, bj, At, Bt) do { __builtin_amdgcn_s_setprio(1); _Pragma("unroll") for (int m = 0; m < 4; ++m) _Pragma("unroll") for (int n = 0; n < 2; ++n) _Pragma("unroll") for (int k = 0; k < 2; ++k) \
        acc[ai][bj][m][n] = __builtin_amdgcn_mfma_f32_16x16x32_bf16(Bt[n][k], At[m][k], acc[ai][bj][m][n], 0, 0, 0); __builtin_amdgcn_s_setprio(0); } while (0)
#define PG8_WAIT_V(n) asm volatile("s_waitcnt vmcnt(" #n ")" ::: "memory")
#define PG8_WAIT_L(n) asm volatile("s_waitcnt lgkmcnt(" #n ")" ::: "memory")
#define PG8_BAR __builtin_amdgcn_s_barrier()
#define PG8_SCHED __builtin_amdgcn_sched_barrier(0)
    Unit cur, nxt; int ui = 0;
    if (!S.next(0, cur)) return;
    f32x4 acc[2][2][4][2];
#pragma unroll
    for (int a = 0; a < 2; ++a)
#pragma unroll
        for (int b = 0; b < 2; ++b)
#pragma unroll
            for (int m = 0; m < 4; ++m)
#pragma unroll
                for (int n = 0; n < 2; ++n) acc[a][b][m][n] = (f32x4){0.f, 0.f, 0.f, 0.f};
    bf16x8 At[4][2], B0[2][2], B1[2][2];
    const char* cA = (const char*)g.A + (size_t)cur.pm * tstep; const char* cB = (const char*)g.Bt + S.bt_off(cur) + (size_t)cur.pn * tstep;
    S.a_ready(cur);
    if constexpr (SP2) {
        PG8_STAGE(PG8_SB(0, 0), cB, voffB); PG8_STAGE(PG8_SB(0, 1), cB + hstep, voffB); PG8_STAGE(PG8_SA(0, 0), cA, voffA); PG8_STAGE(PG8_SA(0, 1), cA + hstep, voffA);
        if (wr == 1) PG8_BAR;
        PG8_WAIT_V(2); PG8_BAR;
        PG8_STAGE(PG8_SB(1, 0), cB + kstep, voffB); PG8_STAGE(PG8_SA(1, 0), cA + kstep, voffA); PG8_STAGE(PG8_SB(1, 1), cB + hstep + kstep, voffB);
        PG8_WAIT_V(6); PG8_BAR;
    } else {
        PG8_STAGE(PG8_SB(0, 0), cB, voffB); PG8_STAGE(PG8_SA(0, 0), cA, voffA); PG8_STAGE(PG8_SB(0, 1), cB + hstep, voffB); PG8_STAGE(PG8_SA(0, 1), cA + hstep, voffA);
        if (wr == 1) PG8_BAR;
        PG8_WAIT_V(4); PG8_BAR;
        PG8_STAGE(PG8_SB(1, 0), cB + kstep, voffB); PG8_STAGE(PG8_SA(1, 0), cA + kstep, voffA); PG8_STAGE(PG8_SB(1, 1), cB + hstep + kstep, voffB);
        PG8_WAIT_V(6); PG8_BAR;
    }
    for (;;) {
        const bool has_next = S.next(ui + 1, nxt);
        const char* nA = has_next ? (const char*)g.A + (size_t)nxt.pm * tstep : cA; const char* nB = has_next ? (const char*)g.Bt + S.bt_off(nxt) + (size_t)nxt.pn * tstep : cB;
        for (int t = 0; t < nt; t += 2) {
            const bool last = (t == nt - 2);
            const char* a1 = cA + (size_t)(t + 1) * kstep;
            const char* a2 = last ? nA : cA + (size_t)(t + 2) * kstep; const char* b2 = last ? nB : cB + (size_t)(t + 2) * kstep;
            const char* a3 = a2 + kstep; const char* b3 = b2 + kstep;
            if (last && has_next) S.a_ready(nxt);
            if constexpr (SP2) {
            PG8_LDB(B0, 0, 0); PG8_LDB(B1, 0, 1); PG8_SCHED; PG8_LDA(At, 0, 0); PG8_STAGE(PG8_SA(1, 1), a1 + hstep, voffA);
            PG8_WAIT_V(8); PG8_WAIT_L(0); PG8_BAR; PG8_MMA(0, 0, At, B0); PG8_MMA(0, 1, At, B1); PG8_BAR; PG8_SCHED;
            PG8_LDA(At, 0, 1); PG8_STAGE(PG8_SB(0, 0), b2, voffB); PG8_STAGE(PG8_SB(0, 1), b2 + hstep, voffB); PG8_STAGE(PG8_SA(0, 0), a2, voffA);
            PG8_WAIT_V(8); PG8_WAIT_L(0); PG8_BAR; PG8_MMA(1, 0, At, B0); PG8_MMA(1, 1, At, B1); PG8_BAR; PG8_SCHED;
            PG8_LDB(B0, 1, 0); PG8_LDB(B1, 1, 1); PG8_SCHED; PG8_LDA(At, 1, 0); PG8_STAGE(PG8_SA(0, 1), a2 + hstep, voffA);
            PG8_WAIT_V(8); PG8_WAIT_L(0); PG8_BAR; PG8_MMA(0, 0, At, B0); PG8_MMA(0, 1, At, B1); PG8_BAR; PG8_SCHED;
            PG8_LDA(At, 1, 1); PG8_STAGE(PG8_SB(1, 0), b3, voffB); PG8_STAGE(PG8_SB(1, 1), b3 + hstep, voffB); PG8_STAGE(PG8_SA(1, 0), a3, voffA);
            PG8_WAIT_V(8); PG8_WAIT_L(0); PG8_BAR; PG8_MMA(1, 0, At, B0); PG8_MMA(1, 1, At, B1); PG8_BAR; PG8_SCHED;
            } else {
            PG8_LDB(B0, 0, 0); PG8_SCHED; PG8_LDA(At, 0, 0); PG8_STAGE(PG8_SA(1, 1), a1 + hstep, voffA);
            PG8_WAIT_L(8); PG8_BAR; PG8_WAIT_L(0); PG8_MMA(0, 0, At, B0); PG8_BAR; PG8_SCHED;
            PG8_LDB(B1, 0, 1); PG8_STAGE(PG8_SB(0, 0), b2, voffB);
            PG8_BAR; PG8_WAIT_L(0); PG8_MMA(0, 1, At, B1); PG8_BAR;
            PG8_LDA(At, 0, 1); PG8_STAGE(PG8_SA(0, 0), a2, voffA);
            PG8_BAR; PG8_WAIT_L(0); PG8_MMA(1, 0, At, B0); PG8_BAR; PG8_SCHED;
            PG8_STAGE(PG8_SB(0, 1), b2 + hstep, voffB);
            PG8_WAIT_V(6); PG8_BAR; PG8_MMA(1, 1, At, B1); PG8_BAR;
            PG8_LDB(B0, 1, 0); PG8_SCHED; PG8_LDA(At, 1, 0); PG8_STAGE(PG8_SA(0, 1), a2 + hstep, voffA);
            PG8_WAIT_L(8); PG8_BAR; PG8_WAIT_L(0); PG8_MMA(0, 0, At, B0); PG8_BAR; PG8_SCHED;
            PG8_LDB(B1, 1, 1); PG8_STAGE(PG8_SB(1, 0), b3, voffB);
            PG8_BAR; PG8_WAIT_L(0); PG8_MMA(0, 1, At, B1); PG8_BAR;
            PG8_LDA(At, 1, 1); PG8_STAGE(PG8_SA(1, 0), a3, voffA);
            PG8_BAR; PG8_WAIT_L(0); PG8_MMA(1, 0, At, B0); PG8_BAR; PG8_SCHED;
            PG8_STAGE(PG8_SB(1, 1), b3 + hstep, voffB);
            PG8_WAIT_V(6); PG8_BAR; PG8_MMA(1, 1, At, B1); PG8_BAR;
            }
        }
        if constexpr (ALIGN_EPI) { if (wr == 0) PG8_BAR; }
        if constexpr (!Epi::AFTER_DRAIN) { E(acc, cur, wr, wc, fr, fq); S.done(cur); }
        if (!has_next) break;
#pragma unroll
        for (int a = 0; a < 2; ++a)
#pragma unroll
            for (int b = 0; b < 2; ++b)
#pragma unroll
                for (int m = 0; m < 4; ++m)
#pragma unroll
                    for (int n = 0; n < 2; ++n) acc[a][b][m][n] = (f32x4){0.f, 0.f, 0.f, 0.f};
        cur = nxt; cA = nA; cB = nB; ++ui;
        if constexpr (ALIGN_EPI) { if (wr == 1) PG8_BAR; }
    }
    PG8_WAIT_V(0);
    if constexpr (!ALIGN_EPI) { if (wr == 0) PG8_BAR; }
    PG8_BAR;
    if constexpr (Epi::AFTER_DRAIN) { E.fused(acc, cur, wr, wc, fr, fq, lds, wid, lane); S.done(cur); }
#undef PG8_SA
#undef PG8_SB
#undef PG8_STAGE
#undef PG8_LDA
#undef PG8_LDB
#undef PG8_MMA
#undef PG8_WAIT_V
#undef PG8_WAIT_L
#undef PG8_BAR
#undef PG8_SCHED
}
}

namespace pg8 {
__device__ __forceinline__ u32x4 pack8(const f32x4 v0, const f32x4 v1) { u32x4 w; w.x = cvt_pk_bf16(v0[0], v0[1]); w.y = cvt_pk_bf16(v0[2], v0[3]); w.z = cvt_pk_bf16(v1[0], v1[1]); w.w = cvt_pk_bf16(v1[2], v1[3]); return w; }
struct EpiStore {
    static constexpr bool PERM = true, AFTER_DRAIN = false;
    bf16_t* O; int ldc;
    __device__ __forceinline__ void operator()(const f32x4 (&acc)[2][2][4][2], const Unit& u, int wr, int wc, int fr, int fq) const {
        const int row0 = u.pm * BM + wr * 64 + fr, col0 = u.pn * BM + wc * 32 + 8 * fq;
#pragma unroll
        for (int ai = 0; ai < 2; ++ai)
#pragma unroll
            for (int m = 0; m < 4; ++m) { bf16_t* rowp = O + (size_t)(row0 + ai * HALF + m * 16) * ldc + col0;
#pragma unroll
                for (int bj = 0; bj < 2; ++bj) *(u32x4*)(rowp + bj * HALF) = pack8(acc[ai][bj][m][0], acc[ai][bj][m][1]); }
    }
};
struct EpiQ {
    static constexpr bool PERM = true, AFTER_DRAIN = false;
    bf16_t* O; const float* cosT; const float* sinT;
    __device__ __forceinline__ void operator()(const f32x4 (&acc)[2][2][4][2], const Unit& u, int wr, int wc, int fr, int fq) const {
        const int row0 = u.pm * BM + wr * 64 + fr, col0 = u.pn * BM + wc * 32 + 8 * fq;
#pragma unroll
        for (int ai = 0; ai < 2; ++ai)
#pragma unroll
            for (int m = 0; m < 4; ++m) { const int row = row0 + ai * HALF + m * 16; const bool lat = row < 8192; const int t = row & 2047;
#pragma unroll
                for (int bj = 0; bj < 2; ++bj) { const int col = col0 + bj * HALF; const int jn = col - 192 * (col / 192);
                    f32x4 v0 = acc[ai][bj][m][0], v1 = acc[ai][bj][m][1];
                    if (jn >= 128 && lat) { const int i0 = (jn - 128) >> 1;
                        const f32x4 cs = *(const f32x4*)(cosT + t * 32 + i0), sn = *(const f32x4*)(sinT + t * 32 + i0);
                        f32x4 r0, r1;
                        r0[0] = v0[0] * cs[0] - v0[1] * sn[0]; r0[1] = v0[0] * sn[0] + v0[1] * cs[0];
                        r0[2] = v0[2] * cs[1] - v0[3] * sn[1]; r0[3] = v0[2] * sn[1] + v0[3] * cs[1];
                        r1[0] = v1[0] * cs[2] - v1[1] * sn[2]; r1[1] = v1[0] * sn[2] + v1[1] * cs[2];
                        r1[2] = v1[2] * cs[3] - v1[3] * sn[3]; r1[3] = v1[2] * sn[3] + v1[3] * cs[3];
                        v0 = r0; v1 = r1; }
                    *(u32x4*)(O + (size_t)row * 1536 + col) = pack8(v0, v1); } }
    }
};
struct EpiResid {
    static constexpr bool PERM = false, AFTER_DRAIN = false;
    float* xs; const float* gate;
    __device__ __forceinline__ void operator()(const f32x4 (&acc)[2][2][4][2], const Unit& u, int wr, int wc, int fr, int fq) const {
        const int row0 = u.pm * BM + wr * 64 + fr, colb = u.pn * BM + wc * 32 + 4 * fq;
#pragma unroll
        for (int ai = 0; ai < 2; ++ai)
#pragma unroll
            for (int m = 0; m < 4; ++m) { const int row = row0 + ai * HALF + m * 16; const float* gv = gate + (size_t)(row < 8192 ? (row >> 11) : 4) * 12288; float* xr = xs + (size_t)row * 2048;
#pragma unroll
                for (int bj = 0; bj < 2; ++bj)
#pragma unroll
                    for (int n = 0; n < 2; ++n) { const int col = colb + bj * HALF + n * 16; f32x4 x = *(const f32x4*)(xr + col); const f32x4 g = *(const f32x4*)(gv + col);
                        x += g * acc[ai][bj][m][n]; *(f32x4*)(xr + col) = x; }
                if (m & 1) asm volatile("" ::: "memory"); }
    }
};
struct EpiSwiGLU {
    static constexpr bool PERM = true, AFTER_DRAIN = false;
    bf16_t* O; int ldc;
    __device__ __forceinline__ void operator()(const f32x4 (&acc)[2][2][4][2], const Unit& u, int wr, int wc, int fr, int fq) const {
        const int row0 = u.pm * BM + wr * 64 + fr, col0 = u.pn * HALF + wc * 32 + 8 * fq;
#pragma unroll
        for (int ai = 0; ai < 2; ++ai)
#pragma unroll
            for (int m = 0; m < 4; ++m) { f32x4 o0, o1;
#pragma unroll
                for (int j = 0; j < 4; ++j) { const float g0 = acc[ai][0][m][0][j], g1 = acc[ai][0][m][1][j];
                    o0[j] = g0 / (1.0f + __expf(-g0)) * acc[ai][1][m][0][j]; o1[j] = g1 / (1.0f + __expf(-g1)) * acc[ai][1][m][1][j]; }
                *(u32x4*)(O + (size_t)(row0 + ai * HALF + m * 16) * ldc + col0) = pack8(o0, o1); }
    }
};
struct EpiF32 {
    static constexpr bool PERM = false, AFTER_DRAIN = false;
    float* O; int ldc;
    __device__ __forceinline__ void operator()(const f32x4 (&acc)[2][2][4][2], const Unit& u, int wr, int wc, int fr, int fq) const {
        const int row0 = u.pm * BM + wr * 64 + fr, colb = u.pn * BM + wc * 32 + 4 * fq;
#pragma unroll
        for (int ai = 0; ai < 2; ++ai)
#pragma unroll
            for (int m = 0; m < 4; ++m) { float* xr = O + (size_t)(row0 + ai * HALF + m * 16) * ldc;
#pragma unroll
                for (int bj = 0; bj < 2; ++bj)
#pragma unroll
                    for (int n = 0; n < 2; ++n) *(f32x4*)(xr + colb + bj * HALF + n * 16) = acc[ai][bj][m][n]; }
    }
};
struct MoeOrder {
    int nM, nN, nwg, G, c; int t1[8]; size_t estride;
    __device__ __forceinline__ void init(const int* ctl, int nN_, int G_, int c_, size_t estride_) {
        int acc = 0;
#pragma unroll
        for (int e = 0; e < 8; ++e) { acc += ctl[CT_EPAD + e] >> 8; t1[e] = acc; }
        nM = acc; nN = nN_; nwg = nM * nN; G = G_; c = c_; estride = estride_;
    }
    __device__ __forceinline__ bool next(int i, Unit& u) const {
        const long L = (long)i * G + c; if (L >= nwg) return false;
        int wgid = (int)L; { const int q = nwg / NXCD, r = nwg % NXCD, xcd = wgid % NXCD, off = wgid / NXCD; wgid = (xcd < r ? xcd * (q + 1) : r * (q + 1) + (xcd - r) * q) + off; }
        const int nig = WGM * nN, gid = wgid / nig, fm = gid * WGM, gsz = (nM - fm) < WGM ? (nM - fm) : WGM;
        u.pm = fm + ((wgid % nig) % gsz); u.pn = (wgid % nig) / gsz; return true;
    }
    __device__ __forceinline__ size_t bt_off(const Unit& u) const { int e = 0;
#pragma unroll
        for (int k = 0; k < 7; ++k) e += (u.pm >= t1[k]) ? 1 : 0;
        return (size_t)e * estride; }
    __device__ __forceinline__ void a_ready(const Unit&) const {}
    __device__ __forceinline__ void done(const Unit&) const {}
};
}

#define LAS __attribute__((address_space(3)))
#define XB_TMO      128
#define XB_XCNT(j)  (256  + 64 * (j))
#define XB_XSUB(j)  (1280 + 64 * (j))
#define XB_XGEN(j)  (2304 + 64 * (j))
#define XB_TOP      3328
#define XB_TOPGEN   3392
#define XCD_BAR_WORDS 3456
#define XB_SPIN_CAP (1u << 18)

__device__ __forceinline__ unsigned xb_ld(unsigned* p)              { return __hip_atomic_load(p, __ATOMIC_RELAXED, __HIP_MEMORY_SCOPE_AGENT); }
__device__ __forceinline__ unsigned xb_add(unsigned* p, unsigned v) { return __hip_atomic_fetch_add(p, v, __ATOMIC_RELAXED, __HIP_MEMORY_SCOPE_AGENT); }
__device__ __forceinline__ unsigned xb_xcc_id() { return (unsigned)__builtin_amdgcn_s_getreg((3 << 11) | 20) & 0xFu; }
#define XB_SPIN(cond, bar) do { unsigned _sp = 0; while (cond) { __builtin_amdgcn_s_sleep(1); \
    if ((++_sp & 255u) == 0u) { if (xb_ld(&(bar)[XB_TMO])) break; if (_sp > XB_SPIN_CAP) { atomicAdd(&(bar)[XB_TMO], 1u); break; } } } } while (0)

struct XcdBarrier {
    unsigned* bar; unsigned x;
    volatile LAS unsigned* st;
};

__device__ __forceinline__ XcdBarrier xcd_barrier_post(unsigned* bar, volatile LAS unsigned* st) {
    XcdBarrier b; b.bar = bar; b.x = xb_xcc_id(); b.st = st;
    if (threadIdx.x == 0) (void)xb_add(&bar[XB_XCNT(b.x)], 1u);
    return b;
}
__device__ __forceinline__ void xcd_barrier_complete(unsigned* bar, unsigned x, unsigned& nloc, unsigned& nx) {
    const unsigned G = gridDim.x * gridDim.y * gridDim.z;
    unsigned sum, cnt, mine, sp = 0u;
    for (;;) {
        sum = 0u; cnt = 0u; mine = 0u;
#pragma unroll
        for (unsigned j = 0; j < 16; ++j) { const unsigned c = xb_ld(&bar[XB_XCNT(j)]); sum += c; cnt += (c > 0u) ? 1u : 0u; mine = (j == x) ? c : mine; }
        if (sum == G) break;
        __builtin_amdgcn_s_sleep(1);
        if ((++sp & 255u) == 0u) { if (xb_ld(&bar[XB_TMO])) break; if (sp > XB_SPIN_CAP) { atomicAdd(&bar[XB_TMO], 1u); break; } }
    }
    nloc = mine > 0u ? mine : 1u; nx = cnt > 0u ? cnt : 1u;
}

__device__ __forceinline__ void xcd_barrier(const XcdBarrier& b) {
    asm volatile("s_waitcnt vmcnt(0)" ::: "memory");
    __syncthreads();
    if (threadIdx.x == 0) {
        unsigned* bar = b.bar;
        __builtin_amdgcn_s_waitcnt(0);
        unsigned nloc = b.st[0], nx = b.st[1];
        if (nloc == 0u) { xcd_barrier_complete(bar, b.x, nloc, nx); b.st[0] = nloc; b.st[1] = nx; }
        const unsigned old = xb_add(&bar[XB_XSUB(b.x)], 1u);
        const unsigned gen = old / nloc;
        if (old + 1u == (gen + 1u) * nloc) {
            __builtin_amdgcn_fence(__ATOMIC_RELEASE, "agent");
            asm volatile("s_waitcnt vmcnt(0)" ::: "memory");
            const unsigned og = xb_add(&bar[XB_TOP], 1u);
            const unsigned tg = og / nx;
            if (og + 1u == (tg + 1u) * nx) xb_add(&bar[XB_TOPGEN], 1u);
            else XB_SPIN(xb_ld(&bar[XB_TOPGEN]) == tg, bar);
            __builtin_amdgcn_fence(__ATOMIC_ACQUIRE, "agent");
            xb_add(&bar[XB_XGEN(b.x)], 1u);
            asm volatile("s_waitcnt vmcnt(0)" ::: "memory");
        } else {
            XB_SPIN(xb_ld(&bar[XB_XGEN(b.x)]) == gen, bar);
            __builtin_amdgcn_fence(__ATOMIC_ACQUIRE, "agent");
            asm volatile("s_waitcnt vmcnt(0)" ::: "memory");
        }
    }
    __syncthreads();
}


struct Args { const float* in[34]; float* out; unsigned char* ws; int ph_lo, ph_hi; };

enum { MAP_ID = 0, MAP_ROPEQ = 1, MAP_GU0 = 2, MAP_GU1 = 3, MAP_KV = 4 };
struct JobDesc { int in_idx, K, N, nbatch, upb, map; long long src_off, src_bstride, dst_off, dst_bstride; };
constexpr int NJOBS = 14, NCONV = 50624;
__constant__ JobDesc c_jobs[NJOBS] = {
    {8, 2048, 3648, 1, 912, MAP_ID, 0, 0, (long long)WS_WIN, 0},
    {8, 2048, 3648, 1, 912, MAP_ID, 2048LL * 3648, 0, (long long)(WS_WIN + (size_t)UW * D * 2), 0},
    {10, 768, 1536, 1, 144, MAP_ROPEQ, 0, 0, (long long)WS_WQ, 0},
    {10, 768, 1536, 1, 144, MAP_ROPEQ, 768LL * 1536, 0, (long long)(WS_WQ + (size_t)QW * 768 * 2), 0},
    {12, 512, 2048, 1, 128, MAP_KV, 0, 0, (long long)WS_WKV, 0},
    {12, 512, 2048, 1, 128, MAP_KV, 512LL * 2048, 0, (long long)(WS_WKV + (size_t)KVW * 512 * 2), 0},
    {25, 2048, 2048, 1, 512, MAP_ID, 0, 0, (long long)WS_WOUT, 0},
    {25, 2048, 2048, 1, 512, MAP_ID, 2048LL * 2048, 0, (long long)(WS_WOUT + (size_t)D * D * 2), 0},
    {26, 2048, 5632, 1, 1408, MAP_GU0, 0, 0, (long long)WS_WGU, 0},
    {27, 2048, 5632, 1, 1408, MAP_GU1, 0, 0, (long long)WS_WGU, 0},
    {28, 5632, 2048, 1, 1408, MAP_ID, 0, 0, (long long)WS_WDN, 0},
    {30, 2048, 7168, 8, 1792, MAP_GU0, 0, 2048LL * 7168, (long long)WS_MGU, 2LL * DFE * D * 2},
    {31, 2048, 7168, 8, 1792, MAP_GU1, 0, 2048LL * 7168, (long long)WS_MGU, 2LL * DFE * D * 2},
    {32, 7168, 2048, 8, 1792, MAP_ID, 0, 7168LL * 2048, (long long)WS_MDN, (long long)D * DFE * 2},
};
struct ConvUnit { const float* src; bf16_t* dst; int K, N, map, k0, n0; };
__device__ __forceinline__ void conv_decode(const Args& a, int u, ConvUnit& cu) {
    int j = 0, base = 0;
    for (;;) { const int n = c_jobs[j].nbatch * c_jobs[j].upb; if (u < base + n || j == NJOBS - 1) break; base += n; ++j; }
    const JobDesc& jd = c_jobs[j];
    int r = u - base; const int bt = r / jd.upb; r -= bt * jd.upb; const int ntn = jd.N >> 6; const int kt = r / ntn, nt = r - kt * ntn;
    cu.K = jd.K; cu.N = jd.N; cu.map = jd.map; cu.k0 = kt * 128; cu.n0 = nt * 64;
    const float* sb = j < 2 ? a.in[8] : j < 4 ? a.in[10] : j < 6 ? a.in[12] : j < 8 ? a.in[25] : j == 8 ? a.in[26] : j == 9 ? a.in[27] : j == 10 ? a.in[28] : j == 11 ? a.in[30] : j == 12 ? a.in[31] : a.in[32];
    cu.src = sb + jd.src_off + (long long)bt * jd.src_bstride + (size_t)cu.k0 * jd.N + cu.n0;
    cu.dst = (bf16_t*)(a.ws + jd.dst_off + (long long)bt * jd.dst_bstride);
}
__device__ __forceinline__ int conv_row(int map, int n) {
    if (map == MAP_ID) return n;
    if (map == MAP_GU0) return ((n >> 7) << 8) + (n & 127);
    if (map == MAP_GU1) return ((n >> 7) << 8) + 128 + (n & 127);
    if (map == MAP_KV) { const int hh = n >> 8, jn = n & 255; return jn < 128 ? hh * 128 + jn : 1024 + hh * 128 + (jn - 128); }
    const int hh = n / 192, jn = n - hh * 192; if (jn < 128) return n; const int q = jn - 128; return hh * 192 + 128 + 2 * (q & 31) + (q >> 5);
}
__device__ __forceinline__ void ph_convert(const Args& a, float* tile) {
    const int tid = threadIdx.x, G = gridDim.x;
    int u = blockIdx.x; ConvUnit cu; f32x4 r[4];
    if (u < NCONV) { conv_decode(a, u, cu);
#pragma unroll
        for (int i = 0; i < 4; ++i) { const int idx = tid + 512 * i; r[i] = *(const f32x4*)(cu.src + (size_t)(idx >> 4) * cu.N + (idx & 15) * 4); } }
    while (u < NCONV) {
#pragma unroll
        for (int i = 0; i < 4; ++i) { const int idx = tid + 512 * i; float* tp = tile + (idx >> 4) * 65 + (idx & 15) * 4; tp[0] = r[i][0]; tp[1] = r[i][1]; tp[2] = r[i][2]; tp[3] = r[i][3]; }
        __syncthreads();
        const ConvUnit cur = cu; const int un = u + G;
        if (un < NCONV) { conv_decode(a, un, cu);
#pragma unroll
            for (int i = 0; i < 4; ++i) { const int idx = tid + 512 * i; r[i] = *(const f32x4*)(cu.src + (size_t)(idx >> 4) * cu.N + (idx & 15) * 4); } }
        const int nl = tid >> 3; const int row = conv_row(cur.map, cur.n0 + nl);
#pragma unroll
        for (int j = 0; j < 2; ++j) { const int kc = (tid & 7) + 8 * j; const float* tp = tile + (kc * 8) * 65 + nl;
            u32x4 w; w.x = pg8::cvt_pk_bf16(tp[0], tp[65]); w.y = pg8::cvt_pk_bf16(tp[130], tp[195]); w.z = pg8::cvt_pk_bf16(tp[260], tp[325]); w.w = pg8::cvt_pk_bf16(tp[390], tp[455]);
            *(u32x4*)(cur.dst + (size_t)row * cur.K + cur.k0 + kc * 8) = w; }
        __syncthreads();
        u = un;
    }
}
__device__ __forceinline__ void adaln_unit(const Args& a, int unit, float* sm) {
    const float* c = a.in[1]; const float* cctx = a.in[3]; const float* w_mod = a.in[4]; const float* b_mod = a.in[5]; float* mod = (float*)(a.ws + WS_MOD);
    const int tid = threadIdx.x, l = unit / 96, chunk = unit % 96;
    const int cg = tid & 31, ks = tid >> 5;
    for (int i = tid; i < 5 * 2048; i += 512) { const int v = i >> 11, k = i & 2047; const float val = v < 4 ? c[v * 2048 + k] : cctx[k]; sm[i] = val / (1.0f + expf(-val)); }
    __syncthreads();
    float acc[5][4];
#pragma unroll
    for (int v = 0; v < 5; ++v)
#pragma unroll
        for (int j = 0; j < 4; ++j) acc[v][j] = 0.f;
    const float* wp = w_mod + ((size_t)l * 2048 + (size_t)ks * 128) * 12288 + chunk * 128 + cg * 4;
#pragma unroll 4
    for (int kk = 0; kk < 128; ++kk) {
        const f32x4 w = *(const f32x4*)(wp + (size_t)kk * 12288);
        const int k = ks * 128 + kk;
#pragma unroll
        for (int v = 0; v < 5; ++v) { const float s = sm[v * 2048 + k];
#pragma unroll
            for (int j = 0; j < 4; ++j) acc[v][j] += s * w[j]; }
    }
    __syncthreads();
#pragma unroll
    for (int v = 0; v < 5; ++v)
#pragma unroll
        for (int j = 0; j < 4; ++j) sm[(ks * 5 + v) * 128 + cg * 4 + j] = acc[v][j];
    __syncthreads();
    for (int o = tid; o < 640; o += 512) {
        const int v = o >> 7, cc = o & 127; float s = 0.f;
        for (int k2 = 0; k2 < 16; ++k2) s += sm[(k2 * 5 + v) * 128 + cc];
        mod[((size_t)l * 5 + v) * 12288 + chunk * 128 + cc] = s + b_mod[(size_t)l * 12288 + chunk * 128 + cc];
    }
    __syncthreads();
}
__device__ __forceinline__ void filters_unit(const Args& a, int unit, float* sm) {
    float (*zs)[36] = (float (*)[36])sm; float (*ha)[64] = (float (*)[64])(sm + 8 * 36); float (*hb)[64] = (float (*)[64])(sm + 8 * 36 + 8 * 64);
    const int tid = threadIdx.x, l = unit / 288, r = unit % 288;
    const bool lat = r < 256; const int Lf = lat ? 2048 : 256; const int p0 = lat ? r * 8 : (r - 256) * 8;
    float* T = lat ? (float*)(a.ws + WS_FILTL) + (size_t)l * 512 * 4096 : (float*)(a.ws + WS_FILTC) + (size_t)l * 512 * 512;
    const float* w1 = a.in[15] + l * 33 * 64; const float* b1 = a.in[16] + l * 64; const float* w2 = a.in[17] + l * 64 * 64; const float* b2 = a.in[18] + l * 64;
    const float* w3 = a.in[19] + l * 64 * 64; const float* b3 = a.in[20] + l * 64; const float* wf = a.in[21] + (size_t)l * 64 * 1024; const float* fr = a.in[22] + l * 64;
    const int p = tid >> 6, j = tid & 63; const int pos = p0 + p;
    const float tn = (float)pos / (float)(Lf - 1);
    if (j < 33) {
        float z;
        if (j == 0) z = tn;
        else { const int bi = (j - 1) & 15; const float band = 1e-4f + (float)bi * ((15.0f - 1e-4f) / 15.0f);
               const float ang = (6.283185307179586f / (float)Lf) * (float)pos * band; z = (j <= 16) ? cosf(ang) : -sinf(ang); }
        zs[p][j] = z;
    }
    __syncthreads();
    const float f = fr[j];
    { float s = b1[j]; for (int i = 0; i < 33; ++i) s += zs[p][i] * w1[i * 64 + j]; ha[p][j] = sinf(f * s); }
    __syncthreads();
    { float s = b2[j]; for (int i = 0; i < 64; ++i) s += ha[p][i] * w2[i * 64 + j]; hb[p][j] = sinf(f * s); }
    __syncthreads();
    { float s = b3[j]; for (int i = 0; i < 64; ++i) s += hb[p][i] * w3[i * 64 + j]; ha[p][j] = sinf(f * s); }
    __syncthreads();
#pragma unroll
    for (int rr = 0; rr < 2; ++rr) {
        const int o = tid + rr * 512; float acc[8];
#pragma unroll
        for (int q = 0; q < 8; ++q) acc[q] = 0.f;
        for (int i = 0; i < 64; ++i) { const float w = wf[i * 1024 + o];
#pragma unroll
            for (int q = 0; q < 8; ++q) acc[q] += ha[q][i] * w; }
        const int ch = o & 511; const bool back = o >= 512;
        const float delta = 3.0701134573253944f + (float)ch * ((15.350567286626972f - 3.0701134573253944f) / 511.0f);
#pragma unroll
        for (int q = 0; q < 8; ++q) {
            const int ps = p0 + q; const float t2 = (float)ps / (float)(Lf - 1);
            const float val = acc[q] * expf(-t2 * delta);
            if (lat) { bf16_t* RBp = (bf16_t*)(a.ws + WS_FILTL) + ((size_t)l * 512 + ch) * HY_RBROW;
                if (!back) RBp[2048 - ps] = f2bf(val); else if (ps > 0) RBp[2048 + ps] = f2bf(val); }
            else if (!back) T[(size_t)ch * (2 * Lf) + Lf + ps] = val;
            else if (ps > 0) T[(size_t)ch * (2 * Lf) + Lf - ps] = val;
            else T[(size_t)ch * (2 * Lf)] = 0.f;
        }
    }
    __syncthreads();
}
__device__ __forceinline__ void ph_prologue(const Args& a, float* sm) {
    const int bid = blockIdx.x, G = gridDim.x, tid = threadIdx.x;
    for (int u = bid; u < 192; u += G) adaln_unit(a, u, sm);
    for (int u = bid; u < 576; u += G) filters_unit(a, u, sm);
    { float* cosT = (float*)(a.ws + WS_ROPE); float* sinT = cosT + 2048 * 32;
      for (int i = bid * 512 + tid; i < 2048 * 32; i += G * 512) { const int t = i >> 5, f = i & 31;
          const float pos = (float)((f < 16) ? (t >> 6) : (t & 63)); const float freq = powf(10000.0f, -(float)(f & 15) / 16.0f); const float ang = pos * freq;
          cosT[i] = cosf(ang); sinT[i] = sinf(ang); } }
    for (int i = bid * 512 + tid; i < 2 * 512 * 17; i += G * 512) { const int row = i / 17, k = i - row * 17; ((bf16_t*)(a.ws + WS_FILTL))[(size_t)row * HY_RBROW + (k == 0 ? 0 : 4095 + k)] = 0; }
    for (int i = bid * 512 + tid; i < 2 * 192 * 256; i += G * 512) { const int l = i / (192 * 256), r = i % (192 * 256);
        *(u32x4*)(a.ws + WS_WIN + (size_t)l * UW * D * 2 + (size_t)INW * D * 2 + (size_t)r * 16) = (u32x4){0u, 0u, 0u, 0u}; }
    ph_convert(a, sm);
}

template <bool ROUTER, bool COPYX>
__device__ __forceinline__ void ph_normmod(const float* __restrict__ xlat, const float* __restrict__ xctx, const float* __restrict__ gain, const float* __restrict__ modl, int sh_off, int sc_off,
                                           bf16_t* __restrict__ out, int nrows, float* __restrict__ xs, const float* __restrict__ router, int* __restrict__ topi, float* __restrict__ topw) {
    const int lane = threadIdx.x & 63, wid = threadIdx.x >> 6;
    for (int row = blockIdx.x * 8 + wid; row < nrows; row += gridDim.x * 8) {
        const float* xr = row < NLAT ? xlat + (size_t)row * D : xctx + (size_t)(row - NLAT) * D;
        const float* mv = modl + (size_t)tok_mod(row) * 12288;
        f32x4 v[8]; float ss = 0.f;
#pragma unroll
        for (int i = 0; i < 8; ++i) { v[i] = *(const f32x4*)(xr + i * 256 + lane * 4); ss += v[i][0] * v[i][0] + v[i][1] * v[i][1] + v[i][2] * v[i][2] + v[i][3] * v[i][3];
            if (COPYX) *(f32x4*)(xs + (size_t)row * D + i * 256 + lane * 4) = v[i]; }
        ss = wave_sum(ss);
        const float rstd = rsqrtf(ss * (1.0f / D) + EPS);
        float lg[8];
#pragma unroll
        for (int e = 0; e < 8; ++e) lg[e] = 0.f;
#pragma unroll
        for (int i = 0; i < 8; ++i) {
            const int col = i * 256 + lane * 4;
            const f32x4 g = *(const f32x4*)(gain + col), sc = *(const f32x4*)(mv + sc_off + col), sh = *(const f32x4*)(mv + sh_off + col);
            f32x4 o;
#pragma unroll
            for (int j = 0; j < 4; ++j) o[j] = (v[i][j] * rstd * g[j]) * (1.0f + sc[j]) + sh[j];
            u32x2 w; w.x = (unsigned)f2bf(o[0]) | ((unsigned)f2bf(o[1]) << 16); w.y = (unsigned)f2bf(o[2]) | ((unsigned)f2bf(o[3]) << 16);
            *(u32x2*)(out + (size_t)row * D + col) = w;
            if (ROUTER) {
#pragma unroll
                for (int j = 0; j < 4; ++j) { const f32x4 r0 = *(const f32x4*)(router + (size_t)(col + j) * 8), r1 = *(const f32x4*)(router + (size_t)(col + j) * 8 + 4);
                    lg[0] += o[j] * r0[0]; lg[1] += o[j] * r0[1]; lg[2] += o[j] * r0[2]; lg[3] += o[j] * r0[3];
                    lg[4] += o[j] * r1[0]; lg[5] += o[j] * r1[1]; lg[6] += o[j] * r1[2]; lg[7] += o[j] * r1[3]; }
                asm volatile("" ::: "memory");
            }
        }
        if (ROUTER) {
#pragma unroll
            for (int e = 0; e < 8; ++e) lg[e] = wave_sum(lg[e]);
            if (lane == 0) {
                int i0 = 0; float v0 = lg[0];
#pragma unroll
                for (int e = 1; e < 8; ++e) if (lg[e] > v0) { v0 = lg[e]; i0 = e; }
                int i1 = -1; float v1 = -3.0e38f;
#pragma unroll
                for (int e = 0; e < 8; ++e) if (e != i0 && lg[e] > v1) { v1 = lg[e]; i1 = e; }
                const float e1 = expf(v1 - v0), w0 = 1.0f / (1.0f + e1), w1 = e1 / (1.0f + e1);
                topi[row * 2] = i0; topi[row * 2 + 1] = i1; topw[row * 2] = w0; topw[row * 2 + 1] = w1;
            }
        }
    }
}

__device__ __forceinline__ void ph_mid(const Args& a, int l) {
    const bf16_t* __restrict__ U = (const bf16_t*)(a.ws + WS_U);
    const float* g_q = a.in[9] + l * 768; const float* g_kv = a.in[11] + l * 512; const float* conv_w = a.in[13] + (size_t)l * 3 * 1536; const float* conv_b = a.in[14] + l * 1536;
    const float* cosT = (const float*)(a.ws + WS_ROPE); const float* sinT = cosT + 2048 * 32;
    bf16_t* cqn = (bf16_t*)(a.ws + WS_CQN); bf16_t* ckvn = (bf16_t*)(a.ws + WS_CKVN); bf16_t* kpe = (bf16_t*)(a.ws + WS_KPE); bf16_t* x0o = (bf16_t*)(a.ws + WS_X0);
    bf16_t* wtl = (bf16_t*)(a.ws + WS_WTL); bf16_t* wtc = (bf16_t*)(a.ws + WS_WTC); bf16_t* sq = (bf16_t*)(a.ws + WS_SQ); bf16_t* sk = (bf16_t*)(a.ws + WS_SK); bf16_t* sv = (bf16_t*)(a.ws + WS_SV);
    const int tid = threadIdx.x, lane = tid & 63, wid = tid >> 6;
    for (int unit = blockIdx.x; unit < NTOK / 16; unit += gridDim.x) {
        const int tok0 = unit * 16;
        for (int tt = 0; tt < 2; ++tt) {
            const int tok = tok0 + wid * 2 + tt; const bool lat = tok < NLAT; const int t = lat ? (tok & 2047) : ((tok - NLAT) & 255);
            const bf16_t* u = U + (size_t)tok * UW;
            { float x[12]; float ss = 0.f;
#pragma unroll
              for (int i = 0; i < 12; ++i) { x[i] = bf2f(u[O_CQ + i * 64 + lane]); ss += x[i] * x[i]; }
              ss = wave_sum(ss); const float rs = rsqrtf(ss * (1.0f / 768.0f) + EPS);
#pragma unroll
              for (int i = 0; i < 12; ++i) cqn[(size_t)tok * 768 + i * 64 + lane] = f2bf(x[i] * rs * g_q[i * 64 + lane]); }
            { float x[8]; float ss = 0.f;
#pragma unroll
              for (int i = 0; i < 8; ++i) { x[i] = bf2f(u[O_CKV + i * 64 + lane]); ss += x[i] * x[i]; }
              ss = wave_sum(ss); const float rs = rsqrtf(ss * (1.0f / 512.0f) + EPS);
#pragma unroll
              for (int i = 0; i < 8; ++i) ckvn[(size_t)tok * 512 + i * 64 + lane] = f2bf(x[i] * rs * g_kv[i * 64 + lane]); }
            const int pi = lane & 31;
            const float cs = lat ? cosT[t * 32 + pi] : 1.0f, sn = lat ? sinT[t * 32 + pi] : 0.0f;
            if (lane < 32) {
                const float aa = bf2f(u[O_KPE + pi]), bb = bf2f(u[O_KPE + 32 + pi]);
                kpe[(size_t)tok * 64 + 2 * pi] = f2bf(aa * cs - bb * sn); kpe[(size_t)tok * 64 + 2 * pi + 1] = f2bf(aa * sn + bb * cs);
            }
#pragma unroll
            for (int r = 0; r < 4; ++r) { const int pr = r * 64 + lane, h = pr >> 5;
                const float aa = bf2f(u[O_SQ + h * 64 + pi]), bb = bf2f(u[O_SQ + h * 64 + 32 + pi]);
                sq[(size_t)tok * 512 + h * 64 + pi] = f2bf(aa * cs - bb * sn); sq[(size_t)tok * 512 + h * 64 + 32 + pi] = f2bf(aa * sn + bb * cs); }
            { const int h = lane >> 5;
              const float aa = bf2f(u[O_SK + h * 64 + pi]), bb = bf2f(u[O_SK + h * 64 + 32 + pi]);
              sk[(size_t)tok * 128 + h * 64 + pi] = f2bf(aa * cs - bb * sn); sk[(size_t)tok * 128 + h * 64 + 32 + pi] = f2bf(aa * sn + bb * cs); }
        }
        {
            const bool lat = tok0 < NLAT; const int Ls = lat ? L : C;
            const int b = lat ? (tok0 >> 11) : ((tok0 - NLAT) >> 8), t0 = lat ? (tok0 & 2047) : ((tok0 - NLAT) & 255);
            const int ch = tid;
            float cw[3][3], cb[3];
#pragma unroll
            for (int g = 0; g < 3; ++g) { cb[g] = conv_b[g * 512 + ch];
#pragma unroll
                for (int j = 0; j < 3; ++j) cw[g][j] = conv_w[j * 1536 + g * 512 + ch]; }
            float prev[3], cur[3], nxt[3];
#pragma unroll
            for (int g = 0; g < 3; ++g) { prev[g] = (t0 > 0) ? bf2f(U[(size_t)(tok0 - 1) * UW + O_HY + g * 512 + ch]) : 0.f; cur[g] = bf2f(U[(size_t)tok0 * UW + O_HY + g * 512 + ch]); }
            unsigned pk[8];
#pragma unroll
            for (int i = 0; i < 16; ++i) {
                const bool hasn = (t0 + i + 1) < Ls;
                float y[3];
#pragma unroll
                for (int g = 0; g < 3; ++g) { nxt[g] = hasn ? bf2f(U[(size_t)(tok0 + i + 1) * UW + O_HY + g * 512 + ch]) : 0.f;
                    y[g] = cb[g] + cw[g][0] * prev[g] + cw[g][1] * cur[g] + cw[g][2] * nxt[g]; prev[g] = cur[g]; cur[g] = nxt[g]; }
                x0o[(size_t)(tok0 + i) * 512 + ch] = f2bf(y[0]);
                const unsigned wv = f2bf(y[2] * y[1]);
                if (i & 1) pk[i >> 1] |= wv << 16; else pk[i >> 1] = wv;
            }
            bf16_t* wt = lat ? wtl + ((size_t)b * 512 + ch) * L + t0 : wtc + ((size_t)b * 512 + ch) * C + t0;
            u32x4 w0, w1; w0.x = pk[0]; w0.y = pk[1]; w0.z = pk[2]; w0.w = pk[3]; w1.x = pk[4]; w1.y = pk[5]; w1.z = pk[6]; w1.w = pk[7];
            *(u32x4*)wt = w0; *(u32x4*)(wt + 8) = w1;
        }
        if (tid < 128) {
            unsigned pk[8];
#pragma unroll
            for (int i = 0; i < 16; ++i) { const unsigned v = U[(size_t)(tok0 + i) * UW + O_SV + tid]; if (i & 1) pk[i >> 1] |= v << 16; else pk[i >> 1] = v; }
            bf16_t* dst = sv + (size_t)tid * NTOK + tok0;
            u32x4 w0, w1; w0.x = pk[0]; w0.y = pk[1]; w0.z = pk[2]; w0.w = pk[3]; w1.x = pk[4]; w1.y = pk[5]; w1.z = pk[6]; w1.w = pk[7];
            *(u32x4*)dst = w0; *(u32x4*)(dst + 8) = w1;
        }
    }
}

__device__ __forceinline__ void ph_mla_naive(const Args& a, int nq, float* sm) {
    const bf16_t* __restrict__ Q = (const bf16_t*)(a.ws + WS_Q); const bf16_t* __restrict__ KV = (const bf16_t*)(a.ws + WS_KV); const bf16_t* __restrict__ KPE = (const bf16_t*)(a.ws + WS_KPE);
    bf16_t* mix = (bf16_t*)(a.ws + WS_MIX);
    const int lane = threadIdx.x & 63, w = threadIdx.x >> 6;
    float* qf = sm + w * 192; float* sc = sm + 8 * 192 + w * 2304;
    for (int unit = blockIdx.x; unit < nq; unit += gridDim.x) {
        const int h = unit & 7, qt = (unit >> 3) * 8 + w; const bool lat = qt < NLAT;
        const int b = lat ? (qt >> 11) : ((qt - NLAT) >> 8);
        const int nk = lat ? (L + C) : C;
        for (int i = lane; i < 192; i += 64) qf[i] = bf2f(Q[(size_t)qt * QW + h * 192 + i]);
        __syncthreads();
        const float scale = 0.07216878364870322f;
        float mx = -3.0e38f;
        for (int kc = 0; kc < nk; kc += 64) {
            const int kk = kc + lane;
            const int kt = lat ? (kk < L ? b * L + kk : NLAT + b * C + (kk - L)) : (NLAT + b * C + kk);
            float s = 0.f;
            const u32x4* kp = (const u32x4*)(KV + (size_t)kt * KVW + h * 256);
            for (int i = 0; i < 16; ++i) { const u32x4 v = kp[i]; const float* q8 = qf + i * 8;
                s += q8[0] * __uint_as_float(v.x << 16) + q8[1] * __uint_as_float(v.x & 0xffff0000u) + q8[2] * __uint_as_float(v.y << 16) + q8[3] * __uint_as_float(v.y & 0xffff0000u)
                   + q8[4] * __uint_as_float(v.z << 16) + q8[5] * __uint_as_float(v.z & 0xffff0000u) + q8[6] * __uint_as_float(v.w << 16) + q8[7] * __uint_as_float(v.w & 0xffff0000u); }
            const u32x4* pp = (const u32x4*)(KPE + (size_t)kt * 64);
            for (int i = 0; i < 8; ++i) { const u32x4 v = pp[i]; const float* q8 = qf + 128 + i * 8;
                s += q8[0] * __uint_as_float(v.x << 16) + q8[1] * __uint_as_float(v.x & 0xffff0000u) + q8[2] * __uint_as_float(v.y << 16) + q8[3] * __uint_as_float(v.y & 0xffff0000u)
                   + q8[4] * __uint_as_float(v.z << 16) + q8[5] * __uint_as_float(v.z & 0xffff0000u) + q8[6] * __uint_as_float(v.w << 16) + q8[7] * __uint_as_float(v.w & 0xffff0000u); }
            s *= scale; sc[kk] = s; mx = fmaxf(mx, s);
        }
        mx = wave_max(mx);
        float sum = 0.f;
        for (int kc = 0; kc < nk; kc += 64) { const float p = expf(sc[kc + lane] - mx); sc[kc + lane] = p; sum += p; }
        sum = wave_sum(sum);
        __syncthreads();
        float o0 = 0.f, o1 = 0.f;
        for (int kk = 0; kk < nk; ++kk) {
            const int kt = lat ? (kk < L ? b * L + kk : NLAT + b * C + (kk - L)) : (NLAT + b * C + kk);
            const unsigned v = *(const unsigned*)(KV + (size_t)kt * KVW + h * 256 + 128 + lane * 2);
            const float p = sc[kk];
            o0 += p * __uint_as_float(v << 16); o1 += p * __uint_as_float(v & 0xffff0000u);
        }
        const float inv = 1.0f / sum;
        *(unsigned*)(mix + (size_t)qt * D + h * 128 + lane * 2) = (unsigned)f2bf(o0 * inv) | ((unsigned)f2bf(o1 * inv) << 16);
        __syncthreads();
    }
}
__device__ __forceinline__ void ph_swa_naive(const Args& a, int l, int nq, float* sm) {
    const bf16_t* __restrict__ SQ = (const bf16_t*)(a.ws + WS_SQ); const bf16_t* __restrict__ SK = (const bf16_t*)(a.ws + WS_SK); const bf16_t* __restrict__ SV = (const bf16_t*)(a.ws + WS_SV);
    const float* sink = a.in[24] + l * 8; bf16_t* mix = (bf16_t*)(a.ws + WS_MIX);
    const int lane = threadIdx.x & 63, w = threadIdx.x >> 6;
    float* qf = sm + w * 64; float* sc = sm + 8 * 64 + w * 576; int* kts = (int*)(sm + 8 * 64 + 8 * 576) + w * 576;
    for (int unit = blockIdx.x; unit < nq; unit += gridDim.x) {
        const int hq = unit & 7, hk = hq >> 2, qt = (unit >> 3) * 8 + w; const bool lat = qt < NLAT;
        const int b = lat ? (qt >> 11) : ((qt - NLAT) >> 8), t = lat ? (qt & 2047) : 0;
        int lo = 0, nloc = 0;
        if (lat) { lo = t - 128 < 0 ? 0 : t - 128; const int hi = t + 128 > L - 1 ? L - 1 : t + 128; nloc = hi - lo + 1; }
        const int nk = nloc + C;
        qf[lane] = bf2f(SQ[(size_t)qt * 512 + hq * 64 + lane]);
        __syncthreads();
        const float skv = sink[hq];
        float mx = skv;
        for (int kc = 0; kc < nk; kc += 64) {
            const int kk = kc + lane;
            if (kk < nk) {
                const int kt = kk < nloc ? (b * L + lo + kk) : (NLAT + b * C + (kk - nloc));
                const u32x4* kp = (const u32x4*)(SK + (size_t)kt * 128 + hk * 64);
                float s = 0.f;
                for (int i = 0; i < 8; ++i) { const u32x4 v = kp[i]; const float* q8 = qf + i * 8;
                    s += q8[0] * __uint_as_float(v.x << 16) + q8[1] * __uint_as_float(v.x & 0xffff0000u) + q8[2] * __uint_as_float(v.y << 16) + q8[3] * __uint_as_float(v.y & 0xffff0000u)
                       + q8[4] * __uint_as_float(v.z << 16) + q8[5] * __uint_as_float(v.z & 0xffff0000u) + q8[6] * __uint_as_float(v.w << 16) + q8[7] * __uint_as_float(v.w & 0xffff0000u); }
                s *= 0.125f; sc[kk] = s; kts[kk] = kt; mx = fmaxf(mx, s);
            }
        }
        mx = wave_max(mx);
        float sum = 0.f;
        for (int kc = 0; kc < nk; kc += 64) { const int kk = kc + lane; if (kk < nk) { const float p = expf(sc[kk] - mx); sc[kk] = p; sum += p; } }
        sum = wave_sum(sum) + expf(skv - mx);
        __syncthreads();
        float o = 0.f;
        for (int kk = 0; kk < nk; ++kk) o += sc[kk] * bf2f(SV[(size_t)kts[kk] * 128 + hk * 64 + lane]);
        mix[(size_t)qt * D + 1536 + hq * 64 + lane] = f2bf(o / sum);
        __syncthreads();
    }
}
template <int LS>
__device__ __forceinline__ void ph_hyena_naive(const Args& a, int l, float* sm) {
    const float* filt = LS == L ? (const float*)(a.ws + WS_FILTL) + (size_t)l * 512 * 4096 : (const float*)(a.ws + WS_FILTC) + (size_t)l * 512 * 512;
    const bf16_t* wt = (const bf16_t*)(a.ws + (LS == L ? WS_WTL : WS_WTC)); const bf16_t* x0 = (const bf16_t*)(a.ws + WS_X0); const float* skip = a.in[23] + l * 512;
    bf16_t* mix = (bf16_t*)(a.ws + WS_MIX); const int tok_base = LS == L ? 0 : NLAT;
    float* T = sm; float* ws = sm + 2 * LS; const int tid = threadIdx.x;
    for (int unit = blockIdx.x; unit < 512 * NB; unit += gridDim.x) {
        const int ch = unit >> 2, b = unit & 3;
        for (int i = tid; i < 2 * LS; i += NTHR) T[i] = filt[(size_t)ch * 2 * LS + i];
        for (int i = tid; i < LS; i += NTHR) ws[i] = bf2f(wt[((size_t)b * 512 + ch) * LS + i]);
        __syncthreads();
        const float sk = skip[ch];
        for (int t = tid; t < LS; t += NTHR) {
            float y = 0.f;
            for (int s = 0; s < LS; ++s) y += T[t - s + LS] * ws[s];
            const int tok = tok_base + b * LS + t;
            mix[(size_t)tok * D + 1024 + ch] = f2bf(bf2f(x0[(size_t)tok * 512 + ch]) * (y + sk * ws[t]));
        }
        __syncthreads();
    }
}
__device__ __forceinline__ void ph_route(const Args& a, int* sm) {
    const int* topi = (const int*)(a.ws + WS_TOPI); int* pos = (int*)(a.ws + WS_POS); int* src = (int*)(a.ws + WS_SRC); int* ctl = (int*)(a.ws + WS_CTL);
    if (blockIdx.x != 0) return;
    int (*cnt)[512] = (int (*)[512])sm; int* eoff = sm + 8 * 512;
    const int tid = threadIdx.x;
    for (int i = tid; i < MOE_ROWS; i += NTHR) src[i] = -1;
    int c[8];
#pragma unroll
    for (int e = 0; e < 8; ++e) c[e] = 0;
    for (int i = 0; i < 32; ++i) { const int e = topi[tid * 32 + i];
#pragma unroll
        for (int q = 0; q < 8; ++q) c[q] += (e == q) ? 1 : 0; }
#pragma unroll
    for (int e = 0; e < 8; ++e) cnt[e][tid] = c[e];
    __syncthreads();
    if (tid < 8) { int s = 0; for (int i = 0; i < 512; ++i) { const int v = cnt[tid][i]; cnt[tid][i] = s; s += v; } eoff[tid] = s; }
    __syncthreads();
    if (tid == 0) { int o = 0; for (int e = 0; e < 8; ++e) { const int n = eoff[e], p = (n + 255) & ~255; ctl[CT_EOFF + e] = o; ctl[CT_EPAD + e] = p; eoff[e] = o; o += p; } ctl[CT_NTILE] = o >> 8; }
    __syncthreads();
#pragma unroll
    for (int e = 0; e < 8; ++e) c[e] = eoff[e] + cnt[e][tid];
    for (int i = 0; i < 32; ++i) { const int idx = tid * 32 + i; const int e = topi[idx]; int p = 0;
#pragma unroll
        for (int q = 0; q < 8; ++q) if (e == q) { p = c[q]; c[q]++; }
        pos[idx] = p; src[p] = idx >> 1; }
}
__device__ __forceinline__ void ph_gather(const Args& a) {
    const bf16_t* hb = (const bf16_t*)(a.ws + WS_HA); const int* src = (const int*)(a.ws + WS_SRC); bf16_t* hbs = (bf16_t*)(a.ws + WS_HBS);
    const int nrows = ((const int*)(a.ws + WS_CTL))[CT_NTILE] * 256;
    const int half = threadIdx.x >> 8, t = threadIdx.x & 255;
    for (int r = blockIdx.x * 2 + half; r < nrows; r += gridDim.x * 2) {
        const int s = src[r]; u32x4 v = (u32x4){0u, 0u, 0u, 0u};
        if (s >= 0) v = *(const u32x4*)(hb + (size_t)s * D + t * 8);
        *(u32x4*)(hbs + (size_t)r * D + t * 8) = v;
    }
}
__device__ __forceinline__ void ph_final(const Args& a) {
    const float* xs = (const float*)(a.ws + WS_XS); const float* ys = (const float*)(a.ws + WS_YS); const int* pos = (const int*)(a.ws + WS_POS); const float* topw = (const float*)(a.ws + WS_TOPW);
    const float* modl = (const float*)(a.ws + WS_MOD) + (size_t)5 * 12288; const float* gfin = a.in[33]; float* out = a.out;
    const int lane = threadIdx.x & 63, wid = threadIdx.x >> 6;
    for (int row = blockIdx.x * 8 + wid; row < NLAT; row += gridDim.x * 8) {
        const float* g2 = modl + (size_t)tok_mod(row) * 12288 + 10240;
        const int p0 = pos[row * 2], p1 = pos[row * 2 + 1]; const float w0 = topw[row * 2], w1 = topw[row * 2 + 1];
        f32x4 v[8]; float ss = 0.f;
#pragma unroll
        for (int i = 0; i < 8; ++i) { const int col = i * 256 + lane * 4;
            const f32x4 x = *(const f32x4*)(xs + (size_t)row * D + col), ya = *(const f32x4*)(ys + (size_t)p0 * D + col), yb = *(const f32x4*)(ys + (size_t)p1 * D + col), g = *(const f32x4*)(g2 + col);
#pragma unroll
            for (int j = 0; j < 4; ++j) { v[i][j] = x[j] + g[j] * (w0 * ya[j] + w1 * yb[j]); ss += v[i][j] * v[i][j]; } }
        ss = wave_sum(ss); const float rstd = rsqrtf(ss * (1.0f / D) + EPS);
#pragma unroll
        for (int i = 0; i < 8; ++i) { const int col = i * 256 + lane * 4; const f32x4 g = *(const f32x4*)(gfin + col); f32x4 o;
#pragma unroll
            for (int j = 0; j < 4; ++j) o[j] = v[i][j] * rstd * g[j];
            *(f32x4*)(out + (size_t)row * D + col) = o; }
    }
}

typedef float f32x2_t __attribute__((ext_vector_type(2))); typedef __bf16 bf16x2_t __attribute__((ext_vector_type(2)));
__device__ __forceinline__ unsigned cvtpk(float lo, float hi) { f32x2_t v = {lo, hi}; bf16x2_t b = __builtin_convertvector(v, bf16x2_t); return __builtin_bit_cast(unsigned, b); }
#define MFMA32(a, b, c) __builtin_amdgcn_mfma_f32_32x32x16_bf16((a), (b), (c), 0, 0, 0)
constexpr int MLA_KP = 400, MLA_VP = 144, MLA_KB = 64 * MLA_KP, MLA_VB = 128 * MLA_VP, MLA_STAGE = MLA_KB + MLA_VB;
static_assert(2 * MLA_STAGE <= RING_BYTES, "MLA LDS");

__device__ __forceinline__ void ph_mla(const Args& a, bool with_ctx, unsigned char* lds) {
    const bf16_t* __restrict__ Q = (const bf16_t*)(a.ws + WS_Q); const bf16_t* __restrict__ KN = (const bf16_t*)(a.ws + WS_KN); const bf16_t* __restrict__ KPE = (const bf16_t*)(a.ws + WS_KPE);
    const bf16_t* __restrict__ VT = (const bf16_t*)(a.ws + WS_VT); bf16_t* __restrict__ mix = (bf16_t*)(a.ws + WS_MIX);
    int tid_ = threadIdx.x; asm volatile("" : "+v"(tid_));
    const int tid = tid_, lane = tid & 63, w = tid >> 6, qi = lane & 31, hh = lane >> 5;
    const int nunits = with_ctx ? 288 : 256;
    const float c = 0.07216878364870322f * 1.4426950408889634f;
    for (int unit = blockIdx.x; unit < nunits; unit += gridDim.x) {
        int h, b, q0tok, nt; bool ctxq;
        if (unit < 256) { h = unit & 7; b = unit >> 6; q0tok = b * L + ((unit >> 3) & 7) * 256; nt = 36; ctxq = false; }
        else { const int u2 = unit - 256; h = u2 & 7; b = u2 >> 3; q0tok = NLAT + b * C; nt = 4; ctxq = true; }
#define MLA_KTOK(t) (ctxq ? (NLAT + b * C + (t) * 64) : ((t) < 32 ? (b * L + (t) * 64) : (NLAT + b * C + ((t) - 32) * 64)))
        u32x4 r0, r1, r2, r3, r4;
#define MLA_ISSUE(t) do { const int kt0_ = MLA_KTOK(t); \
            r0 = *(const u32x4*)(KN + (size_t)(kt0_ + (tid >> 4)) * 1024 + h * 128 + (tid & 15) * 8); \
            r1 = *(const u32x4*)(KN + (size_t)(kt0_ + 32 + (tid >> 4)) * 1024 + h * 128 + (tid & 15) * 8); \
            r2 = *(const u32x4*)(KPE + (size_t)(kt0_ + (tid >> 3)) * 64 + (tid & 7) * 8); \
            r3 = *(const u32x4*)(VT + (size_t)(h * 128 + (tid >> 3)) * NTOK + kt0_ + (tid & 7) * 8); \
            r4 = *(const u32x4*)(VT + (size_t)(h * 128 + 64 + (tid >> 3)) * NTOK + kt0_ + (tid & 7) * 8); } while (0)
#define MLA_COMMIT(buf) do { unsigned char* kb_ = lds + (buf) * MLA_STAGE; unsigned char* vb_ = kb_ + MLA_KB; \
            *(u32x4*)(kb_ + (tid >> 4) * MLA_KP + (tid & 15) * 16) = r0; \
            *(u32x4*)(kb_ + (32 + (tid >> 4)) * MLA_KP + (tid & 15) * 16) = r1; \
            *(u32x4*)(kb_ + (tid >> 3) * MLA_KP + 256 + (tid & 7) * 16) = r2; \
            const int g_ = (tid & 7) >> 1, e_ = tid & 1; \
            { u32x2 lo_, hi_; lo_.x = r3.x; lo_.y = r3.y; hi_.x = r3.z; hi_.y = r3.w; \
              *(u32x2*)(vb_ + (tid >> 3) * MLA_VP + g_ * 32 + e_ * 8) = lo_; *(u32x2*)(vb_ + (tid >> 3) * MLA_VP + g_ * 32 + 16 + e_ * 8) = hi_; } \
            { u32x2 lo_, hi_; lo_.x = r4.x; lo_.y = r4.y; hi_.x = r4.z; hi_.y = r4.w; \
              *(u32x2*)(vb_ + (64 + (tid >> 3)) * MLA_VP + g_ * 32 + e_ * 8) = lo_; *(u32x2*)(vb_ + (64 + (tid >> 3)) * MLA_VP + g_ * 32 + 16 + e_ * 8) = hi_; } } while (0)
        const int qtok = q0tok + w * 32 + qi;
        bf16x8 qf[12];
#pragma unroll
        for (int s = 0; s < 12; ++s) qf[s] = *(const bf16x8*)(Q + (size_t)qtok * QW + h * 192 + s * 16 + hh * 8);
        f32x16 o[4];
#pragma unroll
        for (int d = 0; d < 4; ++d)
#pragma unroll
            for (int r = 0; r < 16; ++r) o[d][r] = 0.f;
        float m = -1.0e30f, l = 0.f;
        MLA_ISSUE(0); MLA_COMMIT(0);
        __syncthreads();
        for (int t = 0; t < nt; ++t) {
            const unsigned char* kb = lds + (t & 1) * MLA_STAGE; const unsigned char* vb = kb + MLA_KB;
            f32x16 s0, s1;
#pragma unroll
            for (int r = 0; r < 16; ++r) { s0[r] = 0.f; s1[r] = 0.f; }
#pragma unroll
            for (int s = 0; s < 12; ++s) {
                const bf16x8 k0 = *(const bf16x8*)(kb + qi * MLA_KP + s * 32 + hh * 16);
                const bf16x8 k1 = *(const bf16x8*)(kb + (32 + qi) * MLA_KP + s * 32 + hh * 16);
                s0 = MFMA32(k0, qf[s], s0); s1 = MFMA32(k1, qf[s], s1);
                if ((s & 3) == 3) asm volatile("" ::: "memory");
            }
            if (t + 1 < nt) MLA_ISSUE(t + 1);
            float mx = fmaxf(s0[0], s1[0]);
#pragma unroll
            for (int r = 1; r < 16; ++r) mx = fmaxf(mx, fmaxf(s0[r], s1[r]));
            mx = fmaxf(mx, __shfl_xor(mx, 32));
            const float mnew = fmaxf(m, mx * c);
            const float alpha = __builtin_amdgcn_exp2f(m - mnew);
            m = mnew;
            float ps = 0.f;
#pragma unroll
            for (int r = 0; r < 16; ++r) { s0[r] = __builtin_amdgcn_exp2f(s0[r] * c - mnew); s1[r] = __builtin_amdgcn_exp2f(s1[r] * c - mnew); ps += s0[r] + s1[r]; }
            l = l * alpha + ps;
#pragma unroll
            for (int d = 0; d < 4; ++d)
#pragma unroll
                for (int r = 0; r < 16; ++r) o[d][r] *= alpha;
            bf16x8 pf[4];
            { u32x4 p;
              p.x = cvtpk(s0[0], s0[1]); p.y = cvtpk(s0[2], s0[3]); p.z = cvtpk(s0[4], s0[5]); p.w = cvtpk(s0[6], s0[7]); pf[0] = __builtin_bit_cast(bf16x8, p);
              p.x = cvtpk(s0[8], s0[9]); p.y = cvtpk(s0[10], s0[11]); p.z = cvtpk(s0[12], s0[13]); p.w = cvtpk(s0[14], s0[15]); pf[1] = __builtin_bit_cast(bf16x8, p);
              p.x = cvtpk(s1[0], s1[1]); p.y = cvtpk(s1[2], s1[3]); p.z = cvtpk(s1[4], s1[5]); p.w = cvtpk(s1[6], s1[7]); pf[2] = __builtin_bit_cast(bf16x8, p);
              p.x = cvtpk(s1[8], s1[9]); p.y = cvtpk(s1[10], s1[11]); p.z = cvtpk(s1[12], s1[13]); p.w = cvtpk(s1[14], s1[15]); pf[3] = __builtin_bit_cast(bf16x8, p); }
            asm volatile("" ::: "memory");
#pragma unroll
            for (int d = 0; d < 4; ++d) {
#pragma unroll
                for (int g = 0; g < 4; ++g) {
                    const bf16x8 vf = *(const bf16x8*)(vb + (d * 32 + qi) * MLA_VP + g * 32 + hh * 16);
                    o[d] = MFMA32(vf, pf[g], o[d]);
                }
                if (d & 1) asm volatile("" ::: "memory");
            }
            if (t + 1 < nt) MLA_COMMIT((t + 1) & 1);
            __syncthreads();
        }
        const float inv = 1.0f / (l + __shfl_xor(l, 32));
        bf16_t* op = mix + (size_t)qtok * D + h * 128 + 4 * hh;
#pragma unroll
        for (int d = 0; d < 4; ++d)
#pragma unroll
            for (int g = 0; g < 4; ++g) { u32x2 wv; wv.x = cvtpk(o[d][4 * g] * inv, o[d][4 * g + 1] * inv); wv.y = cvtpk(o[d][4 * g + 2] * inv, o[d][4 * g + 3] * inv);
                *(u32x2*)(op + d * 32 + 8 * g) = wv; }
#undef MLA_KTOK
#undef MLA_ISSUE
#undef MLA_COMMIT
    }
}

constexpr int HY_CS = 8224, HY_WS = 5136, HY_WOFF = 8 * HY_CS, HY_RBL = HY_WOFF + 4 * HY_WS;
static_assert(HY_RBL + 516 * 16 <= RING_BYTES, "hyena LDS");

__device__ __forceinline__ u32x4 hy_shift(const u32x4 a, const u32x4 b, int r) {
    switch (r) {
    case 0: return b;
    case 1: return (u32x4){__builtin_amdgcn_alignbyte(b.x, a.w, 2), __builtin_amdgcn_alignbyte(b.y, b.x, 2), __builtin_amdgcn_alignbyte(b.z, b.y, 2), __builtin_amdgcn_alignbyte(b.w, b.z, 2)};
    case 2: return (u32x4){a.w, b.x, b.y, b.z};
    case 3: return (u32x4){__builtin_amdgcn_alignbyte(a.w, a.z, 2), __builtin_amdgcn_alignbyte(b.x, a.w, 2), __builtin_amdgcn_alignbyte(b.y, b.x, 2), __builtin_amdgcn_alignbyte(b.z, b.y, 2)};
    case 4: return (u32x4){a.z, a.w, b.x, b.y};
    case 5: return (u32x4){__builtin_amdgcn_alignbyte(a.z, a.y, 2), __builtin_amdgcn_alignbyte(a.w, a.z, 2), __builtin_amdgcn_alignbyte(b.x, a.w, 2), __builtin_amdgcn_alignbyte(b.y, b.x, 2)};
    case 6: return (u32x4){a.y, a.z, a.w, b.x};
    default: return (u32x4){__builtin_amdgcn_alignbyte(a.y, a.x, 2), __builtin_amdgcn_alignbyte(a.z, a.y, 2), __builtin_amdgcn_alignbyte(a.w, a.z, 2), __builtin_amdgcn_alignbyte(b.x, a.w, 2)};
    }
}

__device__ __forceinline__ void ph_hyena(const Args& a, int l, unsigned char* lds) {
    const bf16_t* __restrict__ RB = (const bf16_t*)(a.ws + WS_FILTL) + (size_t)l * 512 * HY_RBROW;
    const bf16_t* __restrict__ wtl = (const bf16_t*)(a.ws + WS_WTL); const bf16_t* __restrict__ x0 = (const bf16_t*)(a.ws + WS_X0); const float* skip = a.in[23] + l * 512;
    bf16_t* __restrict__ mix = (bf16_t*)(a.ws + WS_MIX);
    int tid_ = threadIdx.x; asm volatile("" : "+v"(tid_));
    const int tid = tid_, lane = tid & 63, w = __builtin_amdgcn_readfirstlane(tid >> 6), i = lane & 31, hh = lane >> 5;
    for (int unit = blockIdx.x; unit < 512; unit += gridDim.x) {
        const int c = unit;
        for (int k = tid; k < 515; k += NTHR) { u32x4 v = (u32x4){0u, 0u, 0u, 0u}; if (k < 513) v = *(const u32x4*)(RB + (size_t)c * HY_RBROW + k * 8); *(u32x4*)(lds + HY_RBL + k * 16) = v; }
        for (int k = tid; k < 4 * 321; k += NTHR) { const int b = k / 321, sl = k - b * 321; u32x4 v = (u32x4){0u, 0u, 0u, 0u};
            if (sl >= 28 && sl < 284) v = *(const u32x4*)(wtl + ((size_t)b * 512 + c) * L + (sl - 28) * 8);
            *(u32x4*)(lds + HY_WOFF + b * HY_WS + sl * 16) = v; }
        __syncthreads();
        for (int qs = lane; qs < 511; qs += 64) {
            const u32x4 ca = *(const u32x4*)(lds + HY_RBL + qs * 16), cb = *(const u32x4*)(lds + HY_RBL + qs * 16 + 16);
            *(u32x4*)(lds + w * HY_CS + qs * 16) = hy_shift(ca, cb, w);
        }
        __syncthreads();
        f32x16 acc0, acc1;
#pragma unroll
        for (int r = 0; r < 16; ++r) { acc0[r] = 0.f; acc1[r] = 0.f; }
        const int Tl = i >> 2, b = i & 3;
        const unsigned char* ap = lds + (i & 7) * HY_CS + (hh - (i >> 3) + 255) * 16;
        const unsigned char* bp = lds + HY_WOFF + b * HY_WS + (224 + 16 * (2 * (8 * w + Tl)) + 8 * hh) * 2;
        const int d0 = 16 * w - 127;
#pragma unroll 2
        for (int dd = 0; dd < 142; dd += 2) {
            const int d = d0 + dd;
            const bf16x8 a0 = *(const bf16x8*)(ap - 32 * d), b0 = *(const bf16x8*)(bp - 32 * d);
            const bf16x8 a1 = *(const bf16x8*)(ap - 32 * (d + 1)), b1 = *(const bf16x8*)(bp - 32 * (d + 1));
            acc0 = MFMA32(a0, b0, acc0); acc1 = MFMA32(a1, b1, acc1);
        }
        const float sk = skip[c];
        const bf16_t* wl = (const bf16_t*)(lds + HY_WOFF + b * HY_WS) + 224;
#pragma unroll
        for (int r = 0; r < 16; ++r) {
            const int t = 32 * (8 * w + Tl) + (r & 3) + 8 * (r >> 2) + 4 * hh; const int tok = b * L + t;
            const float y = acc0[r] + acc1[r] + sk * bf2f(wl[t]);
            mix[(size_t)tok * D + 1024 + c] = f2bf(bf2f(x0[(size_t)tok * 512 + c]) * y);
        }
        __syncthreads();
    }
}

constexpr int SWA_P = 144, SWA_KB = 64 * SWA_P, SWA_STAGE = 2 * SWA_KB;
__device__ __forceinline__ void ph_swa(const Args& a, int l, bool with_ctx, unsigned char* lds) {
    const bf16_t* __restrict__ SQ = (const bf16_t*)(a.ws + WS_SQ); const bf16_t* __restrict__ SK = (const bf16_t*)(a.ws + WS_SK); const bf16_t* __restrict__ SVT = (const bf16_t*)(a.ws + WS_SV);
    const float* sink = a.in[24] + l * 8; bf16_t* __restrict__ mix = (bf16_t*)(a.ws + WS_MIX);
    int tid_ = threadIdx.x; asm volatile("" : "+v"(tid_));
    const int tid = tid_, lane = tid & 63, w = tid >> 6, qi = lane & 31, hh = lane >> 5;
    const int nunits = with_ctx ? 288 : 256;
    const float c = 0.125f * 1.4426950408889634f;
    for (int unit = blockIdx.x; unit < nunits; unit += gridDim.x) {
        int hk, b, p0, nloc, t0loc, q0tok; bool ctxq;
        if (unit < 256) { hk = unit & 1; b = (unit >> 1) & 3; p0 = (unit >> 3) * 64; ctxq = false; q0tok = b * L + p0;
            const int lo = p0 - 128 < 0 ? 0 : p0 - 128, hi = p0 + 192 > L ? L : p0 + 192; t0loc = lo; nloc = (hi - lo) >> 6; }
        else { const int u2 = unit - 256; hk = u2 & 1; b = (u2 >> 1) & 3; p0 = (u2 >> 3) * 64; ctxq = true; q0tok = NLAT + b * C + p0; t0loc = 0; nloc = 0; }
        const int nt = nloc + 4;
#define SWA_KTOK(t) ((t) < nloc ? (b * L + t0loc + (t) * 64) : (NLAT + b * C + ((t) - nloc) * 64))
        u32x4 r0, r1;
#define SWA_ISSUE(t) do { const int kt0_ = SWA_KTOK(t); \
            r0 = *(const u32x4*)(SK + (size_t)(kt0_ + (tid >> 3)) * 128 + hk * 64 + (tid & 7) * 8); \
            r1 = *(const u32x4*)(SVT + (size_t)(hk * 64 + (tid >> 3)) * NTOK + kt0_ + (tid & 7) * 8); } while (0)
#define SWA_COMMIT(buf) do { unsigned char* kb_ = lds + (buf) * SWA_STAGE; unsigned char* vb_ = kb_ + SWA_KB; \
            *(u32x4*)(kb_ + (tid >> 3) * SWA_P + (tid & 7) * 16) = r0; \
            const int g_ = (tid & 7) >> 1, e_ = tid & 1; u32x2 lo_, hi_; lo_.x = r1.x; lo_.y = r1.y; hi_.x = r1.z; hi_.y = r1.w; \
            *(u32x2*)(vb_ + (tid >> 3) * SWA_P + g_ * 32 + e_ * 8) = lo_; *(u32x2*)(vb_ + (tid >> 3) * SWA_P + g_ * 32 + 16 + e_ * 8) = hi_; } while (0)
        const int hq = hk * 4 + (w >> 1), qpos = p0 + (w & 1) * 32 + qi, qtok = q0tok + (w & 1) * 32 + qi;
        bf16x8 qf[4];
#pragma unroll
        for (int s = 0; s < 4; ++s) qf[s] = *(const bf16x8*)(SQ + (size_t)qtok * 512 + hq * 64 + s * 16 + hh * 8);
        f32x16 o[2];
#pragma unroll
        for (int d = 0; d < 2; ++d)
#pragma unroll
            for (int r = 0; r < 16; ++r) o[d][r] = 0.f;
        float m = sink[hq] * 1.4426950408889634f, lsum = hh == 0 ? 1.0f : 0.0f;
        SWA_ISSUE(0); SWA_COMMIT(0);
        __syncthreads();
        for (int t = 0; t < nt; ++t) {
            const unsigned char* kb = lds + (t & 1) * SWA_STAGE; const unsigned char* vb = kb + SWA_KB;
            f32x16 s0, s1;
#pragma unroll
            for (int r = 0; r < 16; ++r) { s0[r] = 0.f; s1[r] = 0.f; }
#pragma unroll
            for (int s = 0; s < 4; ++s) {
                const bf16x8 k0 = *(const bf16x8*)(kb + qi * SWA_P + s * 32 + hh * 16);
                const bf16x8 k1 = *(const bf16x8*)(kb + (32 + qi) * SWA_P + s * 32 + hh * 16);
                s0 = MFMA32(k0, qf[s], s0); s1 = MFMA32(k1, qf[s], s1);
            }
            if (t + 1 < nt) SWA_ISSUE(t + 1);
            if (t < nloc) {
                const int kbase = t0loc + t * 64 + 4 * hh - qpos;
#pragma unroll
                for (int r = 0; r < 16; ++r) { const int dlt = kbase + (r & 3) + 8 * (r >> 2);
                    if (dlt > 128 || dlt < -128) s0[r] = -1.0e30f;
                    if (dlt + 32 > 128 || dlt + 32 < -128) s1[r] = -1.0e30f; }
            }
            float mx = fmaxf(s0[0], s1[0]);
#pragma unroll
            for (int r = 1; r < 16; ++r) mx = fmaxf(mx, fmaxf(s0[r], s1[r]));
            mx = fmaxf(mx, __shfl_xor(mx, 32));
            const float mnew = fmaxf(m, mx * c);
            const float alpha = __builtin_amdgcn_exp2f(m - mnew);
            m = mnew;
            float ps = 0.f;
#pragma unroll
            for (int r = 0; r < 16; ++r) { s0[r] = __builtin_amdgcn_exp2f(s0[r] * c - mnew); s1[r] = __builtin_amdgcn_exp2f(s1[r] * c - mnew); ps += s0[r] + s1[r]; }
            lsum = lsum * alpha + ps;
#pragma unroll
            for (int d = 0; d < 2; ++d)
#pragma unroll
                for (int r = 0; r < 16; ++r) o[d][r] *= alpha;
            bf16x8 pf[4];
            { u32x4 p;
              p.x = cvtpk(s0[0], s0[1]); p.y = cvtpk(s0[2], s0[3]); p.z = cvtpk(s0[4], s0[5]); p.w = cvtpk(s0[6], s0[7]); pf[0] = __builtin_bit_cast(bf16x8, p);
              p.x = cvtpk(s0[8], s0[9]); p.y = cvtpk(s0[10], s0[11]); p.z = cvtpk(s0[12], s0[13]); p.w = cvtpk(s0[14], s0[15]); pf[1] = __builtin_bit_cast(bf16x8, p);
              p.x = cvtpk(s1[0], s1[1]); p.y = cvtpk(s1[2], s1[3]); p.z = cvtpk(s1[4], s1[5]); p.w = cvtpk(s1[6], s1[7]); pf[2] = __builtin_bit_cast(bf16x8, p);
              p.x = cvtpk(s1[8], s1[9]); p.y = cvtpk(s1[10], s1[11]); p.z = cvtpk(s1[12], s1[13]); p.w = cvtpk(s1[14], s1[15]); pf[3] = __builtin_bit_cast(bf16x8, p); }
#pragma unroll
            for (int d = 0; d < 2; ++d)
#pragma unroll
                for (int g = 0; g < 4; ++g) {
                    const bf16x8 vf = *(const bf16x8*)(vb + (d * 32 + qi) * SWA_P + g * 32 + hh * 16);
                    o[d] = MFMA32(vf, pf[g], o[d]);
                }
            if (t + 1 < nt) SWA_COMMIT((t + 1) & 1);
            __syncthreads();
        }
        const float inv = 1.0f / (lsum + __shfl_xor(lsum, 32));
        bf16_t* op = mix + (size_t)qtok * D + 1536 + hq * 64 + 4 * hh;
#pragma unroll
        for (int d = 0; d < 2; ++d)
#pragma unroll
            for (int g = 0; g < 4; ++g) { u32x2 wv; wv.x = cvtpk(o[d][4 * g] * inv, o[d][4 * g + 1] * inv); wv.y = cvtpk(o[d][4 * g + 2] * inv, o[d][4 * g + 3] * inv);
                *(u32x2*)(op + d * 32 + 8 * g) = wv; }
#undef SWA_KTOK
#undef SWA_ISSUE
#undef SWA_COMMIT
    }
}


constexpr int NPHASES = 22;
#define GEMM_CALL(EPI, SCHED, g, S, E) pg8::gemm_phase<EPI, SCHED, true, true>((PG8_LAS unsigned char*)lds, g, S, E)

template <int LYR>
__device__ __forceinline__ void layer_phases(const Args& a, unsigned char* lds, const XcdBarrier& bar, int lo, int hi) {
#define IN(k) (lo <= (k) && (k) < hi)
#if MK_PER_PHASE
#define SEAM(k) do { } while (0)
#else
#define SEAM(k) do { if (IN(k) && IN((k) + 1)) xcd_barrier(bar); } while (0)
#endif
    constexpr int P0 = 1 + LYR * 9;
    constexpr bool LAST = (LYR == 1);
    const int G = gridDim.x, bid = blockIdx.x;
    unsigned char* ws = a.ws;
    const float* modl = (const float*)(ws + WS_MOD) + (size_t)LYR * 5 * 12288;
    float* xs = (float*)(ws + WS_XS);
    const int nq = LAST ? NLAT : NTOK;
    if (IN(P0 + 0)) {
        if (LYR == 0) ph_normmod<false, true>(a.in[0], a.in[2], a.in[6], modl, 0, 2048, (bf16_t*)(ws + WS_HA), NTOK, xs, nullptr, nullptr, nullptr);
        else ph_normmod<false, false>(xs, xs + (size_t)NLAT * D, a.in[6] + D, modl, 0, 2048, (bf16_t*)(ws + WS_HA), NTOK, nullptr, nullptr, nullptr, nullptr);
    }
    SEAM(P0 + 0);
    if (IN(P0 + 1)) {
        pg8::Gemm g{(const bf16_t*)(ws + WS_HA), (const bf16_t*)(ws + WS_WIN + (size_t)LYR * UW * D * 2), NTOK, UW, D};
        pg8::StaticOrder S; S.init(NTOK, UW, G, bid); pg8::EpiStore E{(bf16_t*)(ws + WS_U), UW};
        GEMM_CALL(pg8::EpiStore, pg8::StaticOrder, g, S, E);
    }
    SEAM(P0 + 1);
    if (IN(P0 + 2)) ph_mid(a, LYR);
    SEAM(P0 + 2);
    if (IN(P0 + 3)) {
        { pg8::Gemm g{(const bf16_t*)(ws + WS_CQN), (const bf16_t*)(ws + WS_WQ + (size_t)LYR * QW * 768 * 2), nq, QW, 768};
          pg8::StaticOrder S; S.init(nq, QW, G, bid); pg8::EpiQ E{(bf16_t*)(ws + WS_Q), (const float*)(ws + WS_ROPE), (const float*)(ws + WS_ROPE) + 2048 * 32};
          GEMM_CALL(pg8::EpiQ, pg8::StaticOrder, g, S, E); }
        __syncthreads();
        { pg8::Gemm g{(const bf16_t*)(ws + WS_CKVN), (const bf16_t*)(ws + WS_WKV + (size_t)LYR * KVW * 512 * 2), NTOK, 1024, 512};
          pg8::StaticOrder S; S.init(NTOK, 1024, G, bid); pg8::EpiStore E{(bf16_t*)(ws + WS_KN), 1024};
          GEMM_CALL(pg8::EpiStore, pg8::StaticOrder, g, S, E); }
        __syncthreads();
        { pg8::Gemm g{(const bf16_t*)(ws + WS_WKV + (size_t)LYR * KVW * 512 * 2 + (size_t)1024 * 512 * 2), (const bf16_t*)(ws + WS_CKVN), 1024, NTOK, 512};
          pg8::StaticOrder S; S.init(1024, NTOK, 108, bid >= 216 ? bid - 216 : (bid >= 144 ? bid - 108 : (1 << 24))); pg8::EpiStore E{(bf16_t*)(ws + WS_VT), NTOK};
          GEMM_CALL(pg8::EpiStore, pg8::StaticOrder, g, S, E); }
        __syncthreads();
        ph_hyena(a, LYR, lds);
        if (!LAST) ph_hyena_naive<C>(a, LYR, (float*)lds);
        ph_swa(a, LYR, !LAST, lds);
    }
    SEAM(P0 + 3);
    if (IN(P0 + 4)) ph_mla(a, !LAST, lds);
    SEAM(P0 + 4);
    if (IN(P0 + 5)) {
        pg8::Gemm g{(const bf16_t*)(ws + WS_MIX), (const bf16_t*)(ws + WS_WOUT + (size_t)LYR * D * D * 2), nq, D, D};
        pg8::StaticOrder S; S.init(nq, D, G, bid); pg8::EpiResid E{xs, modl + 4096};
        GEMM_CALL(pg8::EpiResid, pg8::StaticOrder, g, S, E);
    }
    SEAM(P0 + 5);
    if (!LAST) {
        if (IN(P0 + 6)) ph_normmod<false, false>(xs, xs + (size_t)NLAT * D, a.in[7], modl, 6144, 8192, (bf16_t*)(ws + WS_HA), NTOK, nullptr, nullptr, nullptr, nullptr);
        SEAM(P0 + 6);
        if (IN(P0 + 7)) {
            pg8::Gemm g{(const bf16_t*)(ws + WS_HA), (const bf16_t*)(ws + WS_WGU), NTOK, 2 * DFF, D};
            pg8::StaticOrder S; S.init(NTOK, 2 * DFF, G, bid); pg8::EpiSwiGLU E{(bf16_t*)(ws + WS_ACT), DFF};
            GEMM_CALL(pg8::EpiSwiGLU, pg8::StaticOrder, g, S, E);
        }
        SEAM(P0 + 7);
        if (IN(P0 + 8)) {
            pg8::Gemm g{(const bf16_t*)(ws + WS_ACT), (const bf16_t*)(ws + WS_WDN), NTOK, D, DFF};
            pg8::StaticOrder S; S.init(NTOK, D, G, bid); pg8::EpiResid E{xs, modl + 10240};
            GEMM_CALL(pg8::EpiResid, pg8::StaticOrder, g, S, E);
        }
        SEAM(P0 + 8);
    } else {
        if (IN(P0 + 6)) ph_normmod<true, false>(xs, xs + (size_t)NLAT * D, a.in[7] + D, modl, 6144, 8192, (bf16_t*)(ws + WS_HA), NLAT, nullptr, a.in[29], (int*)(ws + WS_TOPI), (float*)(ws + WS_TOPW));
        SEAM(P0 + 6);
        if (IN(P0 + 7)) ph_route(a, (int*)lds);
        SEAM(P0 + 7);
        if (IN(P0 + 8)) ph_gather(a);
        SEAM(P0 + 8);
        if (IN(P0 + 9)) {
            pg8::Gemm g{(const bf16_t*)(ws + WS_HBS), (const bf16_t*)(ws + WS_MGU), MOE_ROWS, 2 * DFE, D};
            pg8::MoeOrder S; S.init((const int*)(ws + WS_CTL), 2 * DFE / 256, G, bid, (size_t)2 * DFE * D * 2); pg8::EpiSwiGLU E{(bf16_t*)(ws + WS_ACT), DFE};
            GEMM_CALL(pg8::EpiSwiGLU, pg8::MoeOrder, g, S, E);
        }
        SEAM(P0 + 9);
        if (IN(P0 + 10)) {
            pg8::Gemm g{(const bf16_t*)(ws + WS_ACT), (const bf16_t*)(ws + WS_MDN), MOE_ROWS, D, DFE};
            pg8::MoeOrder S; S.init((const int*)(ws + WS_CTL), D / 256, G, bid, (size_t)D * DFE * 2); pg8::EpiF32 E{(float*)(ws + WS_YS), D};
            GEMM_CALL(pg8::EpiF32, pg8::MoeOrder, g, S, E);
        }
        SEAM(P0 + 10);
        if (IN(P0 + 11)) ph_final(a);
    }
#undef IN
#undef SEAM
}

__global__ void __launch_bounds__(NTHR, 2) mk_fwd(Args a) {
    extern __shared__ __attribute__((aligned(16))) unsigned char lds[];
    const int tid = threadIdx.x;
    for (int u = tid; u < (LDS_BYTES - LDSCTL_OFF) / 4; u += NTHR) ((unsigned*)(lds + LDSCTL_OFF))[u] = 0u;
    __syncthreads();
    XcdBarrier bar; bar.bar = (unsigned*)(a.ws + WS_CTL) + CW_BAR; bar.x = 0; bar.st = nullptr;
#if !MK_PER_PHASE
    bar = xcd_barrier_post((unsigned*)(a.ws + WS_CTL) + CW_BAR, (volatile LAS unsigned*)(lds + LDSCTL_OFF + 32));
#endif
    const int lo = a.ph_lo, hi = a.ph_hi;
    if (lo <= 0 && 0 < hi) {
        ph_prologue(a, (float*)lds);
#if !MK_PER_PHASE
        if (1 < hi) xcd_barrier(bar);
#endif
    }
    layer_phases<0>(a, lds, bar, lo, hi);
    layer_phases<1>(a, lds, bar, lo, hi);
}

extern "C" void kernel_launch(void* const* d_in, const int* in_sizes, int n_in, void* d_out, int out_size, void* d_ws, size_t ws_size, hipStream_t stream) {
    (void)in_sizes; (void)out_size;
    static int grid = 0;
    if (grid == 0) {
        if (n_in != 34 || ws_size < WS_END) { fprintf(stderr, "kernel_launch: need 34 inputs and >= %zu bytes of workspace (got %d, %zu)\n", (size_t)WS_END, n_in, ws_size); grid = -1; return; }
        int dev = 0, cus = 0, per_cu = 0;
        if (hipGetDevice(&dev) != hipSuccess || hipDeviceGetAttribute(&cus, hipDeviceAttributeMultiprocessorCount, dev) != hipSuccess) { grid = -1; return; }
        if (hipFuncSetAttribute((const void*)mk_fwd, hipFuncAttributeMaxDynamicSharedMemorySize, LDS_BYTES) != hipSuccess) { fprintf(stderr, "kernel_launch: hipFuncSetAttribute failed\n"); grid = -1; return; }
        if (hipOccupancyMaxActiveBlocksPerMultiprocessor(&per_cu, (const void*)mk_fwd, NTHR, LDS_BYTES) != hipSuccess || per_cu < 1) { fprintf(stderr, "kernel_launch: occupancy query says %d blocks per CU\n", per_cu); }
        (void)hipGetLastError();
        grid = cus;
    }
    if (grid < 0) return;
    if (hipMemsetAsync((char*)d_ws + WS_CTL, 0, CTL_ZERO_BYTES, stream) != hipSuccess) return;
    Args a{};
    for (int i = 0; i < 34; ++i) a.in[i] = (const float*)d_in[i];
    a.out = (float*)d_out; a.ws = (unsigned char*)d_ws;
#if MK_PER_PHASE
    for (int p = 0; p < NPHASES; ++p) { a.ph_lo = p; a.ph_hi = p + 1; hipLaunchKernelGGL(mk_fwd, dim3(grid), dim3(NTHR), LDS_BYTES, stream, a); }
#else
    a.ph_lo = 0; a.ph_hi = NPHASES;
    hipLaunchKernelGGL(mk_fwd, dim3(grid), dim3(NTHR), LDS_BYTES, stream, a);
#endif
}
```

```cpp
#include <hip/hip_runtime.h>
#include <stdint.h>
#include <stdio.h>

#ifndef FP8_DENSE
#define FP8_DENSE 0
#endif
#ifndef MK_PER_PHASE
#define MK_PER_PHASE 0
#endif

typedef unsigned short bf16_t;
typedef float f32x4 __attribute__((ext_vector_type(4)));
typedef float f32x16 __attribute__((ext_vector_type(16)));
typedef unsigned u32x4 __attribute__((ext_vector_type(4)));
typedef unsigned u32x2 __attribute__((ext_vector_type(2)));
typedef short bf16x8 __attribute__((ext_vector_type(8)));

constexpr int D = 2048, NB = 4, L = 2048, C = 256, NLAT = NB * L, NCTX = NB * C, NTOK = NLAT + NCTX;
constexpr int UW = 3840;
constexpr int O_CQ = 0, O_CKV = 768, O_KPE = 1280, O_HY = 1344, O_SQ = 2880, O_SK = 3392, O_SV = 3520, INW = 3648;
constexpr int QW = 1536, KVW = 2048, DFF = 5632, DFE = 7168, NE = 8;
constexpr int MOE_ROWS = 18432;
constexpr float EPS = 1e-6f;
constexpr int NTHR = 512;
constexpr int HY_RBROW = 4112;

__device__ __forceinline__ float bf2f(bf16_t h) { return __uint_as_float(((unsigned)h) << 16); }
__device__ __forceinline__ bf16_t f2bf(float f) { unsigned u = __float_as_uint(f); u += 0x7fffu + ((u >> 16) & 1u); return (bf16_t)(u >> 16); }
__device__ __forceinline__ float wave_sum(float v) { for (int o = 32; o > 0; o >>= 1) v += __shfl_xor(v, o); return v; }
__device__ __forceinline__ float wave_max(float v) { for (int o = 32; o > 0; o >>= 1) v = fmaxf(v, __shfl_xor(v, o)); return v; }
__device__ __forceinline__ float silu(float x) { return x / (1.0f + __expf(-x)); }
__device__ __forceinline__ int tok_mod(int tok) { return tok < NLAT ? (tok >> 11) : 4; }

constexpr size_t al(size_t x) { return (x + 255) & ~(size_t)255; }
constexpr size_t WS_CTL = 0, CTL_ZERO_BYTES = 65536;
constexpr size_t WS_MOD = 65536;
constexpr size_t WS_ROPE = WS_MOD + al((size_t)2 * 5 * 12288 * 4);
constexpr size_t WS_FILTL = WS_ROPE + al((size_t)2 * 2048 * 32 * 4);
constexpr size_t WS_FILTC = WS_FILTL + al((size_t)2 * 512 * 4096 * 4);
constexpr size_t WS_WIN = WS_FILTC + al((size_t)2 * 512 * 512 * 4);
constexpr size_t WS_WQ = WS_WIN + al((size_t)2 * UW * D * 2);
constexpr size_t WS_WKV = WS_WQ + al((size_t)2 * QW * 768 * 2);
constexpr size_t WS_WOUT = WS_WKV + al((size_t)2 * KVW * 512 * 2);
constexpr size_t WS_WGU = WS_WOUT + al((size_t)2 * D * D * 2);
constexpr size_t WS_WDN = WS_WGU + al((size_t)2 * DFF * D * 2);
constexpr size_t WS_MGU = WS_WDN + al((size_t)D * DFF * 2);
constexpr size_t WS_MDN = WS_MGU + al((size_t)NE * 2 * DFE * D * 2);
constexpr size_t WS_HA = WS_MDN + al((size_t)NE * D * DFE * 2);
constexpr size_t WS_U = WS_HA + al((size_t)NTOK * D * 2);
constexpr size_t WS_CQN = WS_U + al((size_t)NTOK * UW * 2);
constexpr size_t WS_CKVN = WS_CQN + al((size_t)NTOK * 768 * 2);
constexpr size_t WS_KPE = WS_CKVN + al((size_t)NTOK * 512 * 2);
constexpr size_t WS_X0 = WS_KPE + al((size_t)NTOK * 64 * 2);
constexpr size_t WS_WTL = WS_X0 + al((size_t)NTOK * 512 * 2);
constexpr size_t WS_WTC = WS_WTL + al((size_t)NB * 512 * L * 2);
constexpr size_t WS_SQ = WS_WTC + al((size_t)NB * 512 * C * 2);
constexpr size_t WS_SK = WS_SQ + al((size_t)NTOK * 512 * 2);
constexpr size_t WS_SV = WS_SK + al((size_t)NTOK * 128 * 2);
constexpr size_t WS_Q = WS_SV + al((size_t)NTOK * 128 * 2);
constexpr size_t WS_KV = WS_Q + al((size_t)NTOK * QW * 2);
constexpr size_t WS_KN = WS_KV;
constexpr size_t WS_VT = WS_KV + (size_t)NTOK * 1024 * 2;
constexpr size_t WS_MIX = WS_KV + al((size_t)NTOK * KVW * 2);
constexpr size_t WS_MIXEND = WS_MIX + al((size_t)NTOK * D * 2);
constexpr size_t WS_YS = WS_U;
static_assert(WS_YS + (size_t)MOE_ROWS * D * 4 <= WS_MIXEND, "ys overlay");
constexpr size_t WS_XS = WS_MIXEND;
constexpr size_t WS_ACT = WS_XS + al((size_t)NTOK * D * 4);
constexpr size_t WS_HBS = WS_ACT + al((size_t)MOE_ROWS * DFE * 2);
constexpr size_t WS_TOPI = WS_HBS + al((size_t)MOE_ROWS * D * 2);
constexpr size_t WS_TOPW = WS_TOPI + al((size_t)NLAT * 2 * 4);
constexpr size_t WS_POS = WS_TOPW + al((size_t)NLAT * 2 * 4);
constexpr size_t WS_SRC = WS_POS + al((size_t)NLAT * 2 * 4);
constexpr size_t WS_END = WS_SRC + al((size_t)MOE_ROWS * 4);
constexpr int CT_EOFF = 1024, CT_EPAD = 1040, CT_NTILE = 1056;
constexpr int CW_BAR = 4096;

constexpr int RING_BYTES = 131072, LDSCTL_OFF = RING_BYTES, LDS_BYTES = 147456;

namespace pg8 {
#define PG8_LAS __attribute__((address_space(3)))
typedef unsigned short bf16_t;
typedef short bf16x8 __attribute__((ext_vector_type(8)));
typedef float f32x4 __attribute__((ext_vector_type(4)));
typedef unsigned u32x4 __attribute__((ext_vector_type(4)));
constexpr int BM = 256, BK = 64, HALF = 128, HTB = HALF * BK * 2  , STAGE_BYTES = 8 * HTB, NXCD = 8, WGM = 8;

__host__ __device__ __forceinline__ int lds_byte(int r, int c) { const int st = (r >> 4) * 2 + (c >> 5), rr = r & 15, cc = c & 31, ob = rr * 64 + cc * 2; return st * 1024 + (ob ^ (((ob >> 9) & 1) << 5)); }
__host__ __device__ __forceinline__ void stage_rc(int b, int& R, int& C) { const int st = b / 1024, sb = b % 1024, swz = sb ^ (((sb >> 9) & 1) << 5); R = (st >> 1) * 16 + swz / 64; C = (st & 1) * 32 + (swz % 64) / 2; }
__host__ __device__ __forceinline__ int perm32(int rho) { const int n = rho >> 4, i = rho & 15; return 8 * (i >> 2) + 4 * n + (i & 3); }

struct Unit { int pm, pn; };
struct Gemm { const bf16_t* A; const bf16_t* Bt; int M, N, K; };

struct StaticOrder {
    int nM, nN, nwg, G, c;
    __host__ __device__ void init(int M, int N, int G_, int c_) { nM = M / BM; nN = N / BM; nwg = nM * nN; G = G_; c = c_; }
    __host__ __device__ bool next(int i, Unit& u) const {
        const long L = (long)i * G + c; if (L >= nwg) return false;
        int wgid = (int)L; { const int q = nwg / NXCD, r = nwg % NXCD, xcd = wgid % NXCD, off = wgid / NXCD; wgid = (xcd < r ? xcd * (q + 1) : r * (q + 1) + (xcd - r) * q) + off; }
        const int nig = WGM * nN, gid = wgid / nig, fm = gid * WGM, gsz = (nM - fm) < WGM ? (nM - fm) : WGM;
        u.pm = fm + ((wgid % nig) % gsz); u.pn = (wgid % nig) / gsz; return true;
    }
    __device__ __forceinline__ size_t bt_off(const Unit&) const { return 0; }
    __device__ __forceinline__ void a_ready(const Unit&) const {}
    __device__ __forceinline__ void done(const Unit&) const {}
};

__device__ __forceinline__ unsigned cvt_pk_bf16(float lo, float hi) { unsigned r; asm volatile("v_cvt_pk_bf16_f32 %0, %1, %2" : "=v"(r) : "v"(lo), "v"(hi)); return r; }
typedef float f32x2 __attribute__((ext_vector_type(2)));
typedef int v8i_t __attribute__((ext_vector_type(8))); typedef int v4i_t __attribute__((ext_vector_type(4)));
template <bool F8> struct Frag;
template <> struct Frag<false> { bf16x8 h[2]; __device__ __forceinline__ void set0(bf16x8 x) { h[0] = x; } __device__ __forceinline__ void set1(bf16x8 x) { h[1] = x; } };
template <> struct Frag<true> { v8i_t v; __device__ __forceinline__ void set0(bf16x8 x) { v.lo = __builtin_bit_cast(v4i_t, x); } __device__ __forceinline__ void set1(bf16x8 x) { v.hi = __builtin_bit_cast(v4i_t, x); } };
template <class Epi, class Sched, bool ALIGN_EPI = false, bool SP2 = false, bool FP8 = false>
__device__ __forceinline__ void gemm_phase(PG8_LAS unsigned char* lds, const Gemm g, const Sched& S, const Epi& E) {
    int tid_ = threadIdx.x; asm volatile("" : "+v"(tid_));
    const int tid = tid_, wid = __builtin_amdgcn_readfirstlane(tid >> 6), lane = tid & 63, wr = wid >> 2, wc = wid & 3, fr = lane & 15, fq = lane >> 4;
    const int K = g.K, nt = K / BK;
    unsigned voffA[2], voffB[2];
#pragma unroll
    for (int i = 0; i < 2; ++i) { int R, C; stage_rc(tid * 16 + i * 8192, R, C); const int Rb = Epi::PERM ? ((R & ~31) + perm32(R & 31)) : R;
        voffA[i] = (unsigned)(R * K + C) * 2u; voffB[i] = (unsigned)(Rb * K + C) * 2u; }
    const size_t kstep = (size_t)(BK * 2);
    const size_t hstep = (size_t)HALF * K * 2;
    const size_t tstep = 2 * hstep;
    const unsigned ldsw = (unsigned)wid * 1024u;
    const int aoff = lds_byte(wr * 64 + fr, fq * 8), boff = lds_byte(wc * 32 + fr, fq * 8);
#define PG8_SA(b, h) (((b) * 2 + (h)) * HTB)
#define PG8_SB(b, h) ((4 + (b) * 2 + (h)) * HTB)
#define PG8_STAGE(bufoff, gbase, voff) do { _Pragma("unroll") for (int _i = 0; _i < 2; ++_i) \
        __builtin_amdgcn_global_load_lds((const unsigned*)((const char*)(gbase) + (voff)[_i]), (PG8_LAS unsigned*)(lds + (bufoff) + ldsw + _i * 8192), 16, 0, 0); } while (0)
#define PG8_LDA(dst, b, h) do { _Pragma("unroll") for (int m = 0; m < 4; ++m) { dst[m].set0(*(const PG8_LAS bf16x8*)(lds + PG8_SA(b, h) + aoff + m * 2048)); dst[m].set1(*(const PG8_LAS bf16x8*)(lds + PG8_SA(b, h) + aoff + m * 2048 + 1024)); } } while (0)
#define PG8_LDB(dst, b, h) do { _Pragma("unroll") for (int n = 0; n < 2; ++n) { dst[n].set0(*(const PG8_LAS bf16x8*)(lds + PG8_SB(b, h) + boff + n * 2048)); dst[n].set1(*(const PG8_LAS bf16x8*)(lds + PG8_SB(b, h) + boff + n * 2048 + 1024)); } } while (0)
#define PG8_MMA(ai, bj, At, Bt) do { __builtin_amdgcn_s_setprio(1); _Pragma("unroll") for (int m = 0; m < 4; ++m) _Pragma("unroll") for (int n = 0; n < 2; ++n) { \
        if constexpr (FP8) asm volatile("v_mfma_f32_16x16x128_f8f6f4 %0, %1, %2, %0" : "+v"(acc[ai][bj][m][n]) : "v"(Bt[n].v), "v"(At[m].v));   \
        else { _Pragma("unroll") for (int k = 0; k < 2; ++k) acc[ai][bj][m][n] = __builtin_amdgcn_mfma_f32_16x16x32_bf16(Bt[n].h[k], At[m].h[k], acc[ai][bj][m][n], 0, 0, 0); } } \
        __builtin_amdgcn_s_setprio(0); } while (0)
#define PG8_WAIT_V(n) asm volatile("s_waitcnt vmcnt(" #n ")" ::: "memory")
#define PG8_WAIT_L(n) asm volatile("s_waitcnt lgkmcnt(" #n ")" ::: "memory")
#define PG8_BAR __builtin_amdgcn_s_barrier()
#define PG8_SCHED __builtin_amdgcn_sched_barrier(0)
    Unit cur, nxt; int ui = 0;
    if (!S.next(0, cur)) return;
    f32x4 acc[2][2][4][2];
#pragma unroll
    for (int a = 0; a < 2; ++a)
#pragma unroll
        for (int b = 0; b < 2; ++b)
#pragma unroll
            for (int m = 0; m < 4; ++m)
#pragma unroll
                for (int n = 0; n < 2; ++n) acc[a][b][m][n] = (f32x4){0.f, 0.f, 0.f, 0.f};
    Frag<FP8> At[4], B0[2], B1[2];
    const char* cA = (const char*)g.A + (size_t)cur.pm * tstep; const char* cB = (const char*)g.Bt + S.bt_off(cur) + (size_t)cur.pn * tstep;
    S.a_ready(cur);
    if constexpr (SP2) {
        PG8_STAGE(PG8_SB(0, 0), cB, voffB); PG8_STAGE(PG8_SB(0, 1), cB + hstep, voffB); PG8_STAGE(PG8_SA(0, 0), cA, voffA); PG8_STAGE(PG8_SA(0, 1), cA + hstep, voffA);
        if (wr == 1) PG8_BAR;
        PG8_WAIT_V(2); PG8_BAR;
        PG8_STAGE(PG8_SB(1, 0), cB + kstep, voffB); PG8_STAGE(PG8_SA(1, 0), cA + kstep, voffA); PG8_STAGE(PG8_SB(1, 1), cB + hstep + kstep, voffB);
        PG8_WAIT_V(6); PG8_BAR;
    } else {
        PG8_STAGE(PG8_SB(0, 0), cB, voffB); PG8_STAGE(PG8_SA(0, 0), cA, voffA); PG8_STAGE(PG8_SB(0, 1), cB + hstep, voffB); PG8_STAGE(PG8_SA(0, 1), cA + hstep, voffA);
        if (wr == 1) PG8_BAR;
        PG8_WAIT_V(4); PG8_BAR;
        PG8_STAGE(PG8_SB(1, 0), cB + kstep, voffB); PG8_STAGE(PG8_SA(1, 0), cA + kstep, voffA); PG8_STAGE(PG8_SB(1, 1), cB + hstep + kstep, voffB);
        PG8_WAIT_V(6); PG8_BAR;
    }
    for (;;) {
        const bool has_next = S.next(ui + 1, nxt);
        const char* nA = has_next ? (const char*)g.A + (size_t)nxt.pm * tstep : cA; const char* nB = has_next ? (const char*)g.Bt + S.bt_off(nxt) + (size_t)nxt.pn * tstep : cB;
        for (int t = 0; t < nt; t += 2) {
            const bool last = (t == nt - 2);
            const char* a1 = cA + (size_t)(t + 1) * kstep;
            const char* a2 = last ? nA : cA + (size_t)(t + 2) * kstep; const char* b2 = last ? nB : cB + (size_t)(t + 2) * kstep;
            const char* a3 = a2 + kstep; const char* b3 = b2 + kstep;
            if (last && has_next) S.a_ready(nxt);
            if constexpr (SP2) {
            PG8_LDB(B0, 0, 0); PG8_LDB(B1, 0, 1); PG8_SCHED; PG8_LDA(At, 0, 0); PG8_STAGE(PG8_SA(1, 1), a1 + hstep, voffA);
            PG8_WAIT_V(8); PG8_WAIT_L(0); PG8_BAR; PG8_MMA(0, 0, At, B0); PG8_MMA(0, 1, At, B1); PG8_BAR; PG8_SCHED;
            PG8_LDA(At, 0, 1); PG8_STAGE(PG8_SB(0, 0), b2, voffB); PG8_STAGE(PG8_SB(0, 1), b2 + hstep, voffB); PG8_STAGE(PG8_SA(0, 0), a2, voffA);
            PG8_WAIT_V(8); PG8_WAIT_L(0); PG8_BAR; PG8_MMA(1, 0, At, B0); PG8_MMA(1, 1, At, B1); PG8_BAR; PG8_SCHED;
            PG8_LDB(B0, 1, 0); PG8_LDB(B1, 1, 1); PG8_SCHED; PG8_LDA(At, 1, 0); PG8_STAGE(PG8_SA(0, 1), a2 + hstep, voffA);
            PG8_WAIT_V(8); PG8_WAIT_L(0); PG8_BAR; PG8_MMA(0, 0, At, B0); PG8_MMA(0, 1, At, B1); PG8_BAR; PG8_SCHED;
            PG8_LDA(At, 1, 1); PG8_STAGE(PG8_SB(1, 0), b3, voffB); PG8_STAGE(PG8_SB(1, 1), b3 + hstep, voffB); PG8_STAGE(PG8_SA(1, 0), a3, voffA);
            PG8_WAIT_V(8); PG8_WAIT_L(0); PG8_BAR; PG8_MMA(1, 0, At, B0); PG8_MMA(1, 1, At, B1); PG8_BAR; PG8_SCHED;
            } else {
            PG8_LDB(B0, 0, 0); PG8_SCHED; PG8_LDA(At, 0, 0); PG8_STAGE(PG8_SA(1, 1), a1 + hstep, voffA);
            PG8_WAIT_L(8); PG8_BAR; PG8_WAIT_L(0); PG8_MMA(0, 0, At, B0); PG8_BAR; PG8_SCHED;
            PG8_LDB(B1, 0, 1); PG8_STAGE(PG8_SB(0, 0), b2, voffB);
            PG8_BAR; PG8_WAIT_L(0); PG8_MMA(0, 1, At, B1); PG8_BAR;
            PG8_LDA(At, 0, 1); PG8_STAGE(PG8_SA(0, 0), a2, voffA);
            PG8_BAR; PG8_WAIT_L(0); PG8_MMA(1, 0, At, B0); PG8_BAR; PG8_SCHED;
            PG8_STAGE(PG8_SB(0, 1), b2 + hstep, voffB);
            PG8_WAIT_V(6); PG8_BAR; PG8_MMA(1, 1, At, B1); PG8_BAR;
            PG8_LDB(B0, 1, 0); PG8_SCHED; PG8_LDA(At, 1, 0); PG8_STAGE(PG8_SA(0, 1), a2 + hstep, voffA);
            PG8_WAIT_L(8); PG8_BAR; PG8_WAIT_L(0); PG8_MMA(0, 0, At, B0); PG8_BAR; PG8_SCHED;
            PG8_LDB(B1, 1, 1); PG8_STAGE(PG8_SB(1, 0), b3, voffB);
            PG8_BAR; PG8_WAIT_L(0); PG8_MMA(0, 1, At, B1); PG8_BAR;
            PG8_LDA(At, 1, 1); PG8_STAGE(PG8_SA(1, 0), a3, voffA);
            PG8_BAR; PG8_WAIT_L(0); PG8_MMA(1, 0, At, B0); PG8_BAR; PG8_SCHED;
            PG8_STAGE(PG8_SB(1, 1), b3 + hstep, voffB);
            PG8_WAIT_V(6); PG8_BAR; PG8_MMA(1, 1, At, B1); PG8_BAR;
            }
        }
        if constexpr (ALIGN_EPI) { if (wr == 0) PG8_BAR; }
        if constexpr (FP8) asm volatile("s_nop 15\n\ts_nop 15" ::: "memory");
        if constexpr (!Epi::AFTER_DRAIN) { E(acc, cur, wr, wc, fr, fq); S.done(cur); }
        if (!has_next) break;
#pragma unroll
        for (int a = 0; a < 2; ++a)
#pragma unroll
            for (int b = 0; b < 2; ++b)
#pragma unroll
                for (int m = 0; m < 4; ++m)
#pragma unroll
                    for (int n = 0; n < 2; ++n) acc[a][b][m][n] = (f32x4){0.f, 0.f, 0.f, 0.f};
        cur = nxt; cA = nA; cB = nB; ++ui;
        if constexpr (ALIGN_EPI) { if (wr == 1) PG8_BAR; }
    }
    PG8_WAIT_V(0);
    if constexpr (!ALIGN_EPI) { if (wr == 0) PG8_BAR; }
    PG8_BAR;
    if constexpr (Epi::AFTER_DRAIN) { E.fused(acc, cur, wr, wc, fr, fq, lds, wid, lane); S.done(cur); }
#undef PG8_SA
#undef PG8_SB
#undef PG8_STAGE
#undef PG8_LDA
#undef PG8_LDB
#undef PG8_MMA
#undef PG8_WAIT_V
#undef PG8_WAIT_L
#undef PG8_BAR
#undef PG8_SCHED
}
}

namespace pg8 {
__device__ __forceinline__ u32x4 pack8(const f32x4 v0, const f32x4 v1) { u32x4 w; w.x = cvt_pk_bf16(v0[0], v0[1]); w.y = cvt_pk_bf16(v0[2], v0[3]); w.z = cvt_pk_bf16(v1[0], v1[1]); w.w = cvt_pk_bf16(v1[2], v1[3]); return w; }
struct EpiStore {
    static constexpr bool PERM = true, AFTER_DRAIN = false;
    bf16_t* O; int ldc;
    __device__ __forceinline__ void operator()(const f32x4 (&acc)[2][2][4][2], const Unit& u, int wr, int wc, int fr, int fq) const {
        const int row0 = u.pm * BM + wr * 64 + fr, col0 = u.pn * BM + wc * 32 + 8 * fq;
#pragma unroll
        for (int ai = 0; ai < 2; ++ai)
#pragma unroll
            for (int m = 0; m < 4; ++m) { bf16_t* rowp = O + (size_t)(row0 + ai * HALF + m * 16) * ldc + col0;
#pragma unroll
                for (int bj = 0; bj < 2; ++bj) *(u32x4*)(rowp + bj * HALF) = pack8(acc[ai][bj][m][0], acc[ai][bj][m][1]); }
    }
};
struct EpiQ {
    static constexpr bool PERM = true, AFTER_DRAIN = false;
    bf16_t* O; const float* cosT; const float* sinT;
    __device__ __forceinline__ void operator()(const f32x4 (&acc)[2][2][4][2], const Unit& u, int wr, int wc, int fr, int fq) const {
        const int row0 = u.pm * BM + wr * 64 + fr, col0 = u.pn * BM + wc * 32 + 8 * fq;
#pragma unroll
        for (int ai = 0; ai < 2; ++ai)
#pragma unroll
            for (int m = 0; m < 4; ++m) { const int row = row0 + ai * HALF + m * 16; const bool lat = row < 8192; const int t = row & 2047;
#pragma unroll
                for (int bj = 0; bj < 2; ++bj) { const int col = col0 + bj * HALF; const int jn = col - 192 * (col / 192);
                    f32x4 v0 = acc[ai][bj][m][0], v1 = acc[ai][bj][m][1];
                    if (jn >= 128 && lat) { const int i0 = (jn - 128) >> 1;
                        const f32x4 cs = *(const f32x4*)(cosT + t * 32 + i0), sn = *(const f32x4*)(sinT + t * 32 + i0);
                        f32x4 r0, r1;
                        r0[0] = v0[0] * cs[0] - v0[1] * sn[0]; r0[1] = v0[0] * sn[0] + v0[1] * cs[0];
                        r0[2] = v0[2] * cs[1] - v0[3] * sn[1]; r0[3] = v0[2] * sn[1] + v0[3] * cs[1];
                        r1[0] = v1[0] * cs[2] - v1[1] * sn[2]; r1[1] = v1[0] * sn[2] + v1[1] * cs[2];
                        r1[2] = v1[2] * cs[3] - v1[3] * sn[3]; r1[3] = v1[2] * sn[3] + v1[3] * cs[3];
                        v0 = r0; v1 = r1; }
                    *(u32x4*)(O + (size_t)row * 1536 + col) = pack8(v0, v1); } }
    }
};
struct EpiResid {
    static constexpr bool PERM = false, AFTER_DRAIN = false;
    float* xs; const float* gate; float scale;
    __device__ __forceinline__ void operator()(const f32x4 (&acc)[2][2][4][2], const Unit& u, int wr, int wc, int fr, int fq) const {
        const int row0 = u.pm * BM + wr * 64 + fr, colb = u.pn * BM + wc * 32 + 4 * fq;
#pragma unroll
        for (int ai = 0; ai < 2; ++ai)
#pragma unroll
            for (int m = 0; m < 4; ++m) { const int row = row0 + ai * HALF + m * 16; const float* gv = gate + (size_t)(row < 8192 ? (row >> 11) : 4) * 12288; float* xr = xs + (size_t)row * 2048;
#pragma unroll
                for (int bj = 0; bj < 2; ++bj)
#pragma unroll
                    for (int n = 0; n < 2; ++n) { const int col = colb + bj * HALF + n * 16; f32x4 x = *(const f32x4*)(xr + col); const f32x4 g = *(const f32x4*)(gv + col);
                        x += (g * scale) * acc[ai][bj][m][n]; *(f32x4*)(xr + col) = x; }
                if (m & 1) asm volatile("" ::: "memory"); }
    }
};
__device__ __forceinline__ unsigned pack4_fp8(float a, float b, float c, float d) {
    a = fminf(fmaxf(a, -448.f), 448.f); b = fminf(fmaxf(b, -448.f), 448.f); c = fminf(fmaxf(c, -448.f), 448.f); d = fminf(fmaxf(d, -448.f), 448.f);
    unsigned w = 0; w = __builtin_amdgcn_cvt_pk_fp8_f32(a, b, w, false); w = __builtin_amdgcn_cvt_pk_fp8_f32(c, d, w, true); return w; }
struct EpiSwiGLU8 {
    static constexpr bool PERM = true, AFTER_DRAIN = false;
    unsigned char* O; int ldc; float s, oscale;
    __device__ __forceinline__ void operator()(const f32x4 (&acc)[2][2][4][2], const Unit& u, int wr, int wc, int fr, int fq) const {
        const int row0 = u.pm * BM + wr * 64 + fr, col0 = u.pn * HALF + wc * 32 + 8 * fq;
#pragma unroll
        for (int ai = 0; ai < 2; ++ai)
#pragma unroll
            for (int m = 0; m < 4; ++m) { f32x4 o0, o1;
#pragma unroll
                for (int j = 0; j < 4; ++j) { const float g0 = acc[ai][0][m][0][j] * s, g1 = acc[ai][0][m][1][j] * s;
                    o0[j] = g0 / (1.0f + __expf(-g0)) * (acc[ai][1][m][0][j] * (s * oscale)); o1[j] = g1 / (1.0f + __expf(-g1)) * (acc[ai][1][m][1][j] * (s * oscale)); }
                u32x2 w; w.x = pack4_fp8(o0[0], o0[1], o0[2], o0[3]); w.y = pack4_fp8(o1[0], o1[1], o1[2], o1[3]);
                *(u32x2*)(O + (size_t)(row0 + ai * HALF + m * 16) * ldc + col0) = w; }
    }
};
struct EpiSwiGLU {
    static constexpr bool PERM = true, AFTER_DRAIN = false;
    bf16_t* O; int ldc;
    __device__ __forceinline__ void operator()(const f32x4 (&acc)[2][2][4][2], const Unit& u, int wr, int wc, int fr, int fq) const {
        const int row0 = u.pm * BM + wr * 64 + fr, col0 = u.pn * HALF + wc * 32 + 8 * fq;
#pragma unroll
        for (int ai = 0; ai < 2; ++ai)
#pragma unroll
            for (int m = 0; m < 4; ++m) { f32x4 o0, o1;
#pragma unroll
                for (int j = 0; j < 4; ++j) { const float g0 = acc[ai][0][m][0][j], g1 = acc[ai][0][m][1][j];
                    o0[j] = g0 / (1.0f + __expf(-g0)) * acc[ai][1][m][0][j]; o1[j] = g1 / (1.0f + __expf(-g1)) * acc[ai][1][m][1][j]; }
                *(u32x4*)(O + (size_t)(row0 + ai * HALF + m * 16) * ldc + col0) = pack8(o0, o1); }
    }
};
struct EpiF32 {
    static constexpr bool PERM = false, AFTER_DRAIN = false;
    float* O; int ldc; float scale;
    __device__ __forceinline__ void operator()(const f32x4 (&acc)[2][2][4][2], const Unit& u, int wr, int wc, int fr, int fq) const {
        const int row0 = u.pm * BM + wr * 64 + fr, colb = u.pn * BM + wc * 32 + 4 * fq;
#pragma unroll
        for (int ai = 0; ai < 2; ++ai)
#pragma unroll
            for (int m = 0; m < 4; ++m) { float* xr = O + (size_t)(row0 + ai * HALF + m * 16) * ldc;
#pragma unroll
                for (int bj = 0; bj < 2; ++bj)
#pragma unroll
                    for (int n = 0; n < 2; ++n) *(f32x4*)(xr + colb + bj * HALF + n * 16) = acc[ai][bj][m][n] * scale; }
    }
};
struct MoeOrder {
    int nM, nN, nwg, G, c; int t1[8]; size_t estride;
    __device__ __forceinline__ void init(const int* ctl, int nN_, int G_, int c_, size_t estride_) {
        int acc = 0;
#pragma unroll
        for (int e = 0; e < 8; ++e) { acc += ctl[CT_EPAD + e] >> 8; t1[e] = acc; }
        nM = acc; nN = nN_; nwg = nM * nN; G = G_; c = c_; estride = estride_;
    }
    __device__ __forceinline__ bool next(int i, Unit& u) const {
        const long L = (long)i * G + c; if (L >= nwg) return false;
        int wgid = (int)L; { const int q = nwg / NXCD, r = nwg % NXCD, xcd = wgid % NXCD, off = wgid / NXCD; wgid = (xcd < r ? xcd * (q + 1) : r * (q + 1) + (xcd - r) * q) + off; }
        const int nig = WGM * nN, gid = wgid / nig, fm = gid * WGM, gsz = (nM - fm) < WGM ? (nM - fm) : WGM;
        u.pm = fm + ((wgid % nig) % gsz); u.pn = (wgid % nig) / gsz; return true;
    }
    __device__ __forceinline__ size_t bt_off(const Unit& u) const { int e = 0;
#pragma unroll
        for (int k = 0; k < 7; ++k) e += (u.pm >= t1[k]) ? 1 : 0;
        return (size_t)e * estride; }
    __device__ __forceinline__ void a_ready(const Unit&) const {}
    __device__ __forceinline__ void done(const Unit&) const {}
};
}

#define LAS __attribute__((address_space(3)))
#define XB_TMO      128
#define XB_XCNT(j)  (256  + 64 * (j))
#define XB_XSUB(j)  (1280 + 64 * (j))
#define XB_XGEN(j)  (2304 + 64 * (j))
#define XB_TOP      3328
#define XB_TOPGEN   3392
#define XCD_BAR_WORDS 3456
#define XB_SPIN_CAP (1u << 18)

__device__ __forceinline__ unsigned xb_ld(unsigned* p)              { return __hip_atomic_load(p, __ATOMIC_RELAXED, __HIP_MEMORY_SCOPE_AGENT); }
__device__ __forceinline__ unsigned xb_add(unsigned* p, unsigned v) { return __hip_atomic_fetch_add(p, v, __ATOMIC_RELAXED, __HIP_MEMORY_SCOPE_AGENT); }
__device__ __forceinline__ unsigned xb_xcc_id() { return (unsigned)__builtin_amdgcn_s_getreg((3 << 11) | 20) & 0xFu; }
#define XB_SPIN(cond, bar) do { unsigned _sp = 0; while (cond) { __builtin_amdgcn_s_sleep(1); \
    if ((++_sp & 255u) == 0u) { if (xb_ld(&(bar)[XB_TMO])) break; if (_sp > XB_SPIN_CAP) { atomicAdd(&(bar)[XB_TMO], 1u); break; } } } } while (0)

struct XcdBarrier {
    unsigned* bar; unsigned x;
    volatile LAS unsigned* st;
};

__device__ __forceinline__ XcdBarrier xcd_barrier_post(unsigned* bar, volatile LAS unsigned* st) {
    XcdBarrier b; b.bar = bar; b.x = xb_xcc_id(); b.st = st;
    if (threadIdx.x == 0) (void)xb_add(&bar[XB_XCNT(b.x)], 1u);
    return b;
}
__device__ __forceinline__ void xcd_barrier_complete(unsigned* bar, unsigned x, unsigned& nloc, unsigned& nx) {
    const unsigned G = gridDim.x * gridDim.y * gridDim.z;
    unsigned sum, cnt, mine, sp = 0u;
    for (;;) {
        sum = 0u; cnt = 0u; mine = 0u;
#pragma unroll
        for (unsigned j = 0; j < 16; ++j) { const unsigned c = xb_ld(&bar[XB_XCNT(j)]); sum += c; cnt += (c > 0u) ? 1u : 0u; mine = (j == x) ? c : mine; }
        if (sum == G) break;
        __builtin_amdgcn_s_sleep(1);
        if ((++sp & 255u) == 0u) { if (xb_ld(&bar[XB_TMO])) break; if (sp > XB_SPIN_CAP) { atomicAdd(&bar[XB_TMO], 1u); break; } }
    }
    nloc = mine > 0u ? mine : 1u; nx = cnt > 0u ? cnt : 1u;
}

__device__ __forceinline__ void xcd_barrier(const XcdBarrier& b) {
    asm volatile("s_waitcnt vmcnt(0)" ::: "memory");
    __syncthreads();
    if (threadIdx.x == 0) {
        unsigned* bar = b.bar;
        __builtin_amdgcn_s_waitcnt(0);
        unsigned nloc = b.st[0], nx = b.st[1];
        if (nloc == 0u) { xcd_barrier_complete(bar, b.x, nloc, nx); b.st[0] = nloc; b.st[1] = nx; }
        const unsigned old = xb_add(&bar[XB_XSUB(b.x)], 1u);
        const unsigned gen = old / nloc;
        if (old + 1u == (gen + 1u) * nloc) {
            __builtin_amdgcn_fence(__ATOMIC_RELEASE, "agent");
            asm volatile("s_waitcnt vmcnt(0)" ::: "memory");
            const unsigned og = xb_add(&bar[XB_TOP], 1u);
            const unsigned tg = og / nx;
            if (og + 1u == (tg + 1u) * nx) xb_add(&bar[XB_TOPGEN], 1u);
            else XB_SPIN(xb_ld(&bar[XB_TOPGEN]) == tg, bar);
            __builtin_amdgcn_fence(__ATOMIC_ACQUIRE, "agent");
            xb_add(&bar[XB_XGEN(b.x)], 1u);
            asm volatile("s_waitcnt vmcnt(0)" ::: "memory");
        } else {
            XB_SPIN(xb_ld(&bar[XB_XGEN(b.x)]) == gen, bar);
            __builtin_amdgcn_fence(__ATOMIC_ACQUIRE, "agent");
            asm volatile("s_waitcnt vmcnt(0)" ::: "memory");
        }
    }
    __syncthreads();
}


struct Args { const float* in[34]; float* out; unsigned char* ws; int ph_lo, ph_hi; };

enum { MAP_ID = 0, MAP_ROPEQ = 1, MAP_GU0 = 2, MAP_GU1 = 3, MAP_KV = 4 };
struct JobDesc { int in_idx, K, N, nbatch, upb, map; long long src_off, src_bstride, dst_off, dst_bstride; int fp8, pad; };
constexpr int NJOBS = 14, NCONV = 50624;
__constant__ JobDesc c_jobs[NJOBS] = {
    {8, 2048, 3648, 1, 912, MAP_ID, 0, 0, (long long)WS_WIN, 0},
    {8, 2048, 3648, 1, 912, MAP_ID, 2048LL * 3648, 0, (long long)(WS_WIN + (size_t)UW * D * 2), 0},
    {10, 768, 1536, 1, 144, MAP_ROPEQ, 0, 0, (long long)WS_WQ, 0},
    {10, 768, 1536, 1, 144, MAP_ROPEQ, 768LL * 1536, 0, (long long)(WS_WQ + (size_t)QW * 768 * 2), 0},
    {12, 512, 2048, 1, 128, MAP_KV, 0, 0, (long long)WS_WKV, 0},
    {12, 512, 2048, 1, 128, MAP_KV, 512LL * 2048, 0, (long long)(WS_WKV + (size_t)KVW * 512 * 2), 0},
    {25, 2048, 2048, 1, 512, MAP_ID, 0, 0, (long long)WS_WOUT, 0},
    {25, 2048, 2048, 1, 512, MAP_ID, 2048LL * 2048, 0, (long long)(WS_WOUT + (size_t)D * D * 2), 0},
    {26, 2048, 5632, 1, 1408, MAP_GU0, 0, 0, (long long)WS_WGU, 0, FP8_DENSE, 0},
    {27, 2048, 5632, 1, 1408, MAP_GU1, 0, 0, (long long)WS_WGU, 0, FP8_DENSE, 0},
    {28, 5632, 2048, 1, 1408, MAP_ID, 0, 0, (long long)WS_WDN, 0, FP8_DENSE, 0},
    {30, 2048, 7168, 8, 1792, MAP_GU0, 0, 2048LL * 7168, (long long)WS_MGU, 2LL * DFE * D, 1, 0},
    {31, 2048, 7168, 8, 1792, MAP_GU1, 0, 2048LL * 7168, (long long)WS_MGU, 2LL * DFE * D, 1, 0},
    {32, 7168, 2048, 8, 1792, MAP_ID, 0, 7168LL * 2048, (long long)WS_MDN, (long long)D * DFE, 1, 0},
};
struct ConvUnit { const float* src; bf16_t* dst; int K, N, map, k0, n0, fp8; };
constexpr float WSCALE = 64.f, ASCALE = 8.f;
__device__ __forceinline__ void conv_decode(const Args& a, int u, ConvUnit& cu) {
    int j = 0, base = 0;
    for (;;) { const int n = c_jobs[j].nbatch * c_jobs[j].upb; if (u < base + n || j == NJOBS - 1) break; base += n; ++j; }
    const JobDesc& jd = c_jobs[j];
    int r = u - base; const int bt = r / jd.upb; r -= bt * jd.upb; const int ntn = jd.N >> 6; const int kt = r / ntn, nt = r - kt * ntn;
    cu.K = jd.K; cu.N = jd.N; cu.map = jd.map; cu.k0 = kt * 128; cu.n0 = nt * 64; cu.fp8 = jd.fp8;
    const float* sb = j < 2 ? a.in[8] : j < 4 ? a.in[10] : j < 6 ? a.in[12] : j < 8 ? a.in[25] : j == 8 ? a.in[26] : j == 9 ? a.in[27] : j == 10 ? a.in[28] : j == 11 ? a.in[30] : j == 12 ? a.in[31] : a.in[32];
    cu.src = sb + jd.src_off + (long long)bt * jd.src_bstride + (size_t)cu.k0 * jd.N + cu.n0;
    cu.dst = (bf16_t*)(a.ws + jd.dst_off + (long long)bt * jd.dst_bstride);
}
__device__ __forceinline__ int conv_row(int map, int n) {
    if (map == MAP_ID) return n;
    if (map == MAP_GU0) return ((n >> 7) << 8) + (n & 127);
    if (map == MAP_GU1) return ((n >> 7) << 8) + 128 + (n & 127);
    if (map == MAP_KV) { const int hh = n >> 8, jn = n & 255; return jn < 128 ? hh * 128 + jn : 1024 + hh * 128 + (jn - 128); }
    const int hh = n / 192, jn = n - hh * 192; if (jn < 128) return n; const int q = jn - 128; return hh * 192 + 128 + 2 * (q & 31) + (q >> 5);
}
__device__ __forceinline__ void ph_convert(const Args& a, float* tile) {
    const int tid = threadIdx.x, G = gridDim.x;
    int u = blockIdx.x; ConvUnit cu; f32x4 r[4];
    if (u < NCONV) { conv_decode(a, u, cu);
#pragma unroll
        for (int i = 0; i < 4; ++i) { const int idx = tid + 512 * i; r[i] = *(const f32x4*)(cu.src + (size_t)(idx >> 4) * cu.N + (idx & 15) * 4); } }
    while (u < NCONV) {
#pragma unroll
        for (int i = 0; i < 4; ++i) { const int idx = tid + 512 * i; float* tp = tile + (idx >> 4) * 65 + (idx & 15) * 4; tp[0] = r[i][0]; tp[1] = r[i][1]; tp[2] = r[i][2]; tp[3] = r[i][3]; }
        __syncthreads();
        const ConvUnit cur = cu; const int un = u + G;
        if (un < NCONV) { conv_decode(a, un, cu);
#pragma unroll
            for (int i = 0; i < 4; ++i) { const int idx = tid + 512 * i; r[i] = *(const f32x4*)(cu.src + (size_t)(idx >> 4) * cu.N + (idx & 15) * 4); } }
        const int nl = tid >> 3; const int row = conv_row(cur.map, cur.n0 + nl);
        if (cur.fp8) { const int kc = tid & 7; const float* tp = tile + (kc * 16) * 65 + nl; u32x4 w;
            w.x = pg8::pack4_fp8(tp[0] * WSCALE, tp[65] * WSCALE, tp[130] * WSCALE, tp[195] * WSCALE); w.y = pg8::pack4_fp8(tp[260] * WSCALE, tp[325] * WSCALE, tp[390] * WSCALE, tp[455] * WSCALE);
            w.z = pg8::pack4_fp8(tp[520] * WSCALE, tp[585] * WSCALE, tp[650] * WSCALE, tp[715] * WSCALE); w.w = pg8::pack4_fp8(tp[780] * WSCALE, tp[845] * WSCALE, tp[910] * WSCALE, tp[975] * WSCALE);
            *(u32x4*)((unsigned char*)cur.dst + (size_t)row * cur.K + cur.k0 + kc * 16) = w; }
        else
#pragma unroll
        for (int j = 0; j < 2; ++j) { const int kc = (tid & 7) + 8 * j; const float* tp = tile + (kc * 8) * 65 + nl;
            u32x4 w; w.x = pg8::cvt_pk_bf16(tp[0], tp[65]); w.y = pg8::cvt_pk_bf16(tp[130], tp[195]); w.z = pg8::cvt_pk_bf16(tp[260], tp[325]); w.w = pg8::cvt_pk_bf16(tp[390], tp[455]);
            *(u32x4*)(cur.dst + (size_t)row * cur.K + cur.k0 + kc * 8) = w; }
        __syncthreads();
        u = un;
    }
}
__device__ __forceinline__ void adaln_unit(const Args& a, int unit, float* sm) {
    const float* c = a.in[1]; const float* cctx = a.in[3]; const float* w_mod = a.in[4]; const float* b_mod = a.in[5]; float* mod = (float*)(a.ws + WS_MOD);
    const int tid = threadIdx.x, l = unit / 96, chunk = unit % 96;
    const int cg = tid & 31, ks = tid >> 5;
    for (int i = tid; i < 5 * 2048; i += 512) { const int v = i >> 11, k = i & 2047; const float val = v < 4 ? c[v * 2048 + k] : cctx[k]; sm[i] = val / (1.0f + expf(-val)); }
    __syncthreads();
    float acc[5][4];
#pragma unroll
    for (int v = 0; v < 5; ++v)
#pragma unroll
        for (int j = 0; j < 4; ++j) acc[v][j] = 0.f;
    const float* wp = w_mod + ((size_t)l * 2048 + (size_t)ks * 128) * 12288 + chunk * 128 + cg * 4;
#pragma unroll 4
    for (int kk = 0; kk < 128; ++kk) {
        const f32x4 w = *(const f32x4*)(wp + (size_t)kk * 12288);
        const int k = ks * 128 + kk;
#pragma unroll
        for (int v = 0; v < 5; ++v) { const float s = sm[v * 2048 + k];
#pragma unroll
            for (int j = 0; j < 4; ++j) acc[v][j] += s * w[j]; }
    }
    __syncthreads();
#pragma unroll
    for (int v = 0; v < 5; ++v)
#pragma unroll
        for (int j = 0; j < 4; ++j) sm[(ks * 5 + v) * 128 + cg * 4 + j] = acc[v][j];
    __syncthreads();
    for (int o = tid; o < 640; o += 512) {
        const int v = o >> 7, cc = o & 127; float s = 0.f;
        for (int k2 = 0; k2 < 16; ++k2) s += sm[(k2 * 5 + v) * 128 + cc];
        mod[((size_t)l * 5 + v) * 12288 + chunk * 128 + cc] = s + b_mod[(size_t)l * 12288 + chunk * 128 + cc];
    }
    __syncthreads();
}
__device__ __forceinline__ void filters_unit(const Args& a, int unit, float* sm) {
    float (*zs)[36] = (float (*)[36])sm; float (*ha)[64] = (float (*)[64])(sm + 8 * 36); float (*hb)[64] = (float (*)[64])(sm + 8 * 36 + 8 * 64);
    const int tid = threadIdx.x, l = unit / 288, r = unit % 288;
    const bool lat = r < 256; const int Lf = lat ? 2048 : 256; const int p0 = lat ? r * 8 : (r - 256) * 8;
    float* T = lat ? (float*)(a.ws + WS_FILTL) + (size_t)l * 512 * 4096 : (float*)(a.ws + WS_FILTC) + (size_t)l * 512 * 512;
    const float* w1 = a.in[15] + l * 33 * 64; const float* b1 = a.in[16] + l * 64; const float* w2 = a.in[17] + l * 64 * 64; const float* b2 = a.in[18] + l * 64;
    const float* w3 = a.in[19] + l * 64 * 64; const float* b3 = a.in[20] + l * 64; const float* wf = a.in[21] + (size_t)l * 64 * 1024; const float* fr = a.in[22] + l * 64;
    const int p = tid >> 6, j = tid & 63; const int pos = p0 + p;
    const float tn = (float)pos / (float)(Lf - 1);
    if (j < 33) {
        float z;
        if (j == 0) z = tn;
        else { const int bi = (j - 1) & 15; const float band = 1e-4f + (float)bi * ((15.0f - 1e-4f) / 15.0f);
               const float ang = (6.283185307179586f / (float)Lf) * (float)pos * band; z = (j <= 16) ? cosf(ang) : -sinf(ang); }
        zs[p][j] = z;
    }
    __syncthreads();
    const float f = fr[j];
    { float s = b1[j]; for (int i = 0; i < 33; ++i) s += zs[p][i] * w1[i * 64 + j]; ha[p][j] = sinf(f * s); }
    __syncthreads();
    { float s = b2[j]; for (int i = 0; i < 64; ++i) s += ha[p][i] * w2[i * 64 + j]; hb[p][j] = sinf(f * s); }
    __syncthreads();
    { float s = b3[j]; for (int i = 0; i < 64; ++i) s += hb[p][i] * w3[i * 64 + j]; ha[p][j] = sinf(f * s); }
    __syncthreads();
#pragma unroll
    for (int rr = 0; rr < 2; ++rr) {
        const int o = tid + rr * 512; float acc[8];
#pragma unroll
        for (int q = 0; q < 8; ++q) acc[q] = 0.f;
        for (int i = 0; i < 64; ++i) { const float w = wf[i * 1024 + o];
#pragma unroll
            for (int q = 0; q < 8; ++q) acc[q] += ha[q][i] * w; }
        const int ch = o & 511; const bool back = o >= 512;
        const float delta = 3.0701134573253944f + (float)ch * ((15.350567286626972f - 3.0701134573253944f) / 511.0f);
#pragma unroll
        for (int q = 0; q < 8; ++q) {
            const int ps = p0 + q; const float t2 = (float)ps / (float)(Lf - 1);
            const float val = acc[q] * expf(-t2 * delta);
            if (lat) { bf16_t* RBp = (bf16_t*)(a.ws + WS_FILTL) + ((size_t)l * 512 + ch) * HY_RBROW;
                if (!back) RBp[2048 - ps] = f2bf(val); else if (ps > 0) RBp[2048 + ps] = f2bf(val); }
            else if (!back) T[(size_t)ch * (2 * Lf) + Lf + ps] = val;
            else if (ps > 0) T[(size_t)ch * (2 * Lf) + Lf - ps] = val;
            else T[(size_t)ch * (2 * Lf)] = 0.f;
        }
    }
    __syncthreads();
}
__device__ __forceinline__ void ph_prologue(const Args& a, float* sm) {
    const int bid = blockIdx.x, G = gridDim.x, tid = threadIdx.x;
    for (int u = bid; u < 192; u += G) adaln_unit(a, u, sm);
    for (int u = bid; u < 576; u += G) filters_unit(a, u, sm);
    { float* cosT = (float*)(a.ws + WS_ROPE); float* sinT = cosT + 2048 * 32;
      for (int i = bid * 512 + tid; i < 2048 * 32; i += G * 512) { const int t = i >> 5, f = i & 31;
          const float pos = (float)((f < 16) ? (t >> 6) : (t & 63)); const float freq = powf(10000.0f, -(float)(f & 15) / 16.0f); const float ang = pos * freq;
          cosT[i] = cosf(ang); sinT[i] = sinf(ang); } }
    for (int i = bid * 512 + tid; i < 2 * 512 * 17; i += G * 512) { const int row = i / 17, k = i - row * 17; ((bf16_t*)(a.ws + WS_FILTL))[(size_t)row * HY_RBROW + (k == 0 ? 0 : 4095 + k)] = 0; }
    for (int i = bid * 512 + tid; i < 2 * 192 * 256; i += G * 512) { const int l = i / (192 * 256), r = i % (192 * 256);
        *(u32x4*)(a.ws + WS_WIN + (size_t)l * UW * D * 2 + (size_t)INW * D * 2 + (size_t)r * 16) = (u32x4){0u, 0u, 0u, 0u}; }
    ph_convert(a, sm);
#ifdef PROBE_CONV2
    __syncthreads(); ph_convert(a, sm);
#endif
}

template <bool ROUTER, bool COPYX, bool OUT8 = false>
__device__ __forceinline__ void ph_normmod(const float* __restrict__ xlat, const float* __restrict__ xctx, const float* __restrict__ gain, const float* __restrict__ modl, int sh_off, int sc_off,
                                           bf16_t* __restrict__ out, int nrows, float* __restrict__ xs, const float* __restrict__ router, int* __restrict__ topi, float* __restrict__ topw) {
    const int lane = threadIdx.x & 63, wid = threadIdx.x >> 6;
    for (int row = blockIdx.x * 8 + wid; row < nrows; row += gridDim.x * 8) {
        const float* xr = row < NLAT ? xlat + (size_t)row * D : xctx + (size_t)(row - NLAT) * D;
        const float* mv = modl + (size_t)tok_mod(row) * 12288;
        f32x4 v[8]; float ss = 0.f;
#pragma unroll
        for (int i = 0; i < 8; ++i) { v[i] = *(const f32x4*)(xr + i * 256 + lane * 4); ss += v[i][0] * v[i][0] + v[i][1] * v[i][1] + v[i][2] * v[i][2] + v[i][3] * v[i][3];
            if (COPYX) *(f32x4*)(xs + (size_t)row * D + i * 256 + lane * 4) = v[i]; }
        ss = wave_sum(ss);
        const float rstd = rsqrtf(ss * (1.0f / D) + EPS);
        float lg[8];
#pragma unroll
        for (int e = 0; e < 8; ++e) lg[e] = 0.f;
#pragma unroll
        for (int i = 0; i < 8; ++i) {
            const int col = i * 256 + lane * 4;
            const f32x4 g = *(const f32x4*)(gain + col), sc = *(const f32x4*)(mv + sc_off + col), sh = *(const f32x4*)(mv + sh_off + col);
            f32x4 o;
#pragma unroll
            for (int j = 0; j < 4; ++j) o[j] = (v[i][j] * rstd * g[j]) * (1.0f + sc[j]) + sh[j];
            if (OUT8) *(unsigned*)((unsigned char*)out + (size_t)row * D + col) = pg8::pack4_fp8(o[0] * ASCALE, o[1] * ASCALE, o[2] * ASCALE, o[3] * ASCALE);
            else { u32x2 w; w.x = (unsigned)f2bf(o[0]) | ((unsigned)f2bf(o[1]) << 16); w.y = (unsigned)f2bf(o[2]) | ((unsigned)f2bf(o[3]) << 16);
                *(u32x2*)(out + (size_t)row * D + col) = w; }
            if (ROUTER) {
#pragma unroll
                for (int j = 0; j < 4; ++j) { const f32x4 r0 = *(const f32x4*)(router + (size_t)(col + j) * 8), r1 = *(const f32x4*)(router + (size_t)(col + j) * 8 + 4);
                    lg[0] += o[j] * r0[0]; lg[1] += o[j] * r0[1]; lg[2] += o[j] * r0[2]; lg[3] += o[j] * r0[3];
                    lg[4] += o[j] * r1[0]; lg[5] += o[j] * r1[1]; lg[6] += o[j] * r1[2]; lg[7] += o[j] * r1[3]; }
                asm volatile("" ::: "memory");
            }
        }
        if (ROUTER) {
#pragma unroll
            for (int e = 0; e < 8; ++e) lg[e] = wave_sum(lg[e]);
            if (lane == 0) {
                int i0 = 0; float v0 = lg[0];
#pragma unroll
                for (int e = 1; e < 8; ++e) if (lg[e] > v0) { v0 = lg[e]; i0 = e; }
                int i1 = -1; float v1 = -3.0e38f;
#pragma unroll
                for (int e = 0; e < 8; ++e) if (e != i0 && lg[e] > v1) { v1 = lg[e]; i1 = e; }
                const float e1 = expf(v1 - v0), w0 = 1.0f / (1.0f + e1), w1 = e1 / (1.0f + e1);
                topi[row * 2] = i0; topi[row * 2 + 1] = i1; topw[row * 2] = w0; topw[row * 2 + 1] = w1;
            }
        }
    }
}

__device__ __forceinline__ void ph_mid(const Args& a, int l) {
    const bf16_t* __restrict__ U = (const bf16_t*)(a.ws + WS_U);
    const float* g_q = a.in[9] + l * 768; const float* g_kv = a.in[11] + l * 512; const float* conv_w = a.in[13] + (size_t)l * 3 * 1536; const float* conv_b = a.in[14] + l * 1536;
    const float* cosT = (const float*)(a.ws + WS_ROPE); const float* sinT = cosT + 2048 * 32;
    bf16_t* cqn = (bf16_t*)(a.ws + WS_CQN); bf16_t* ckvn = (bf16_t*)(a.ws + WS_CKVN); bf16_t* kpe = (bf16_t*)(a.ws + WS_KPE); bf16_t* x0o = (bf16_t*)(a.ws + WS_X0);
    bf16_t* wtl = (bf16_t*)(a.ws + WS_WTL); bf16_t* wtc = (bf16_t*)(a.ws + WS_WTC); bf16_t* sq = (bf16_t*)(a.ws + WS_SQ); bf16_t* sk = (bf16_t*)(a.ws + WS_SK); bf16_t* sv = (bf16_t*)(a.ws + WS_SV);
    const int tid = threadIdx.x, lane = tid & 63, wid = tid >> 6;
    for (int unit = blockIdx.x; unit < NTOK / 16; unit += gridDim.x) {
        const int tok0 = unit * 16;
        for (int tt = 0; tt < 2; ++tt) {
            const int tok = tok0 + wid * 2 + tt; const bool lat = tok < NLAT; const int t = lat ? (tok & 2047) : ((tok - NLAT) & 255);
            const bf16_t* u = U + (size_t)tok * UW;
            { float x[12]; float ss = 0.f;
#pragma unroll
              for (int i = 0; i < 12; ++i) { x[i] = bf2f(u[O_CQ + i * 64 + lane]); ss += x[i] * x[i]; }
              ss = wave_sum(ss); const float rs = rsqrtf(ss * (1.0f / 768.0f) + EPS);
#pragma unroll
              for (int i = 0; i < 12; ++i) cqn[(size_t)tok * 768 + i * 64 + lane] = f2bf(x[i] * rs * g_q[i * 64 + lane]); }
            { float x[8]; float ss = 0.f;
#pragma unroll
              for (int i = 0; i < 8; ++i) { x[i] = bf2f(u[O_CKV + i * 64 + lane]); ss += x[i] * x[i]; }
              ss = wave_sum(ss); const float rs = rsqrtf(ss * (1.0f / 512.0f) + EPS);
#pragma unroll
              for (int i = 0; i < 8; ++i) ckvn[(size_t)tok * 512 + i * 64 + lane] = f2bf(x[i] * rs * g_kv[i * 64 + lane]); }
            const int pi = lane & 31;
            const float cs = lat ? cosT[t * 32 + pi] : 1.0f, sn = lat ? sinT[t * 32 + pi] : 0.0f;
            if (lane < 32) {
                const float aa = bf2f(u[O_KPE + pi]), bb = bf2f(u[O_KPE + 32 + pi]);
                kpe[(size_t)tok * 64 + 2 * pi] = f2bf(aa * cs - bb * sn); kpe[(size_t)tok * 64 + 2 * pi + 1] = f2bf(aa * sn + bb * cs);
            }
#pragma unroll
            for (int r = 0; r < 4; ++r) { const int pr = r * 64 + lane, h = pr >> 5;
                const float aa = bf2f(u[O_SQ + h * 64 + pi]), bb = bf2f(u[O_SQ + h * 64 + 32 + pi]);
                sq[(size_t)tok * 512 + h * 64 + pi] = f2bf(aa * cs - bb * sn); sq[(size_t)tok * 512 + h * 64 + 32 + pi] = f2bf(aa * sn + bb * cs); }
            { const int h = lane >> 5;
              const float aa = bf2f(u[O_SK + h * 64 + pi]), bb = bf2f(u[O_SK + h * 64 + 32 + pi]);
              sk[(size_t)tok * 128 + h * 64 + pi] = f2bf(aa * cs - bb * sn); sk[(size_t)tok * 128 + h * 64 + 32 + pi] = f2bf(aa * sn + bb * cs); }
        }
        {
            const bool lat = tok0 < NLAT; const int Ls = lat ? L : C;
            const int b = lat ? (tok0 >> 11) : ((tok0 - NLAT) >> 8), t0 = lat ? (tok0 & 2047) : ((tok0 - NLAT) & 255);
            const int ch = tid;
            float cw[3][3], cb[3];
#pragma unroll
            for (int g = 0; g < 3; ++g) { cb[g] = conv_b[g * 512 + ch];
#pragma unroll
                for (int j = 0; j < 3; ++j) cw[g][j] = conv_w[j * 1536 + g * 512 + ch]; }
            float prev[3], cur[3], nxt[3];
#pragma unroll
            for (int g = 0; g < 3; ++g) { prev[g] = (t0 > 0) ? bf2f(U[(size_t)(tok0 - 1) * UW + O_HY + g * 512 + ch]) : 0.f; cur[g] = bf2f(U[(size_t)tok0 * UW + O_HY + g * 512 + ch]); }
            unsigned pk[8];
#pragma unroll
            for (int i = 0; i < 16; ++i) {
                const bool hasn = (t0 + i + 1) < Ls;
                float y[3];
#pragma unroll
                for (int g = 0; g < 3; ++g) { nxt[g] = hasn ? bf2f(U[(size_t)(tok0 + i + 1) * UW + O_HY + g * 512 + ch]) : 0.f;
                    y[g] = cb[g] + cw[g][0] * prev[g] + cw[g][1] * cur[g] + cw[g][2] * nxt[g]; prev[g] = cur[g]; cur[g] = nxt[g]; }
                x0o[(size_t)(tok0 + i) * 512 + ch] = f2bf(y[0]);
                const unsigned wv = f2bf(y[2] * y[1]);
                if (i & 1) pk[i >> 1] |= wv << 16; else pk[i >> 1] = wv;
            }
            bf16_t* wt = lat ? wtl + ((size_t)b * 512 + ch) * L + t0 : wtc + ((size_t)b * 512 + ch) * C + t0;
            u32x4 w0, w1; w0.x = pk[0]; w0.y = pk[1]; w0.z = pk[2]; w0.w = pk[3]; w1.x = pk[4]; w1.y = pk[5]; w1.z = pk[6]; w1.w = pk[7];
            *(u32x4*)wt = w0; *(u32x4*)(wt + 8) = w1;
        }
        if (tid < 128) {
            unsigned pk[8];
#pragma unroll
            for (int i = 0; i < 16; ++i) { const unsigned v = U[(size_t)(tok0 + i) * UW + O_SV + tid]; if (i & 1) pk[i >> 1] |= v << 16; else pk[i >> 1] = v; }
            bf16_t* dst = sv + (size_t)tid * NTOK + tok0;
            u32x4 w0, w1; w0.x = pk[0]; w0.y = pk[1]; w0.z = pk[2]; w0.w = pk[3]; w1.x = pk[4]; w1.y = pk[5]; w1.z = pk[6]; w1.w = pk[7];
            *(u32x4*)dst = w0; *(u32x4*)(dst + 8) = w1;
        }
    }
}

__device__ __forceinline__ void ph_mla_naive(const Args& a, int nq, float* sm) {
    const bf16_t* __restrict__ Q = (const bf16_t*)(a.ws + WS_Q); const bf16_t* __restrict__ KV = (const bf16_t*)(a.ws + WS_KV); const bf16_t* __restrict__ KPE = (const bf16_t*)(a.ws + WS_KPE);
    bf16_t* mix = (bf16_t*)(a.ws + WS_MIX);
    const int lane = threadIdx.x & 63, w = threadIdx.x >> 6;
    float* qf = sm + w * 192; float* sc = sm + 8 * 192 + w * 2304;
    for (int unit = blockIdx.x; unit < nq; unit += gridDim.x) {
        const int h = unit & 7, qt = (unit >> 3) * 8 + w; const bool lat = qt < NLAT;
        const int b = lat ? (qt >> 11) : ((qt - NLAT) >> 8);
        const int nk = lat ? (L + C) : C;
        for (int i = lane; i < 192; i += 64) qf[i] = bf2f(Q[(size_t)qt * QW + h * 192 + i]);
        __syncthreads();
        const float scale = 0.07216878364870322f;
        float mx = -3.0e38f;
        for (int kc = 0; kc < nk; kc += 64) {
            const int kk = kc + lane;
            const int kt = lat ? (kk < L ? b * L + kk : NLAT + b * C + (kk - L)) : (NLAT + b * C + kk);
            float s = 0.f;
            const u32x4* kp = (const u32x4*)(KV + (size_t)kt * KVW + h * 256);
            for (int i = 0; i < 16; ++i) { const u32x4 v = kp[i]; const float* q8 = qf + i * 8;
                s += q8[0] * __uint_as_float(v.x << 16) + q8[1] * __uint_as_float(v.x & 0xffff0000u) + q8[2] * __uint_as_float(v.y << 16) + q8[3] * __uint_as_float(v.y & 0xffff0000u)
                   + q8[4] * __uint_as_float(v.z << 16) + q8[5] * __uint_as_float(v.z & 0xffff0000u) + q8[6] * __uint_as_float(v.w << 16) + q8[7] * __uint_as_float(v.w & 0xffff0000u); }
            const u32x4* pp = (const u32x4*)(KPE + (size_t)kt * 64);
            for (int i = 0; i < 8; ++i) { const u32x4 v = pp[i]; const float* q8 = qf + 128 + i * 8;
                s += q8[0] * __uint_as_float(v.x << 16) + q8[1] * __uint_as_float(v.x & 0xffff0000u) + q8[2] * __uint_as_float(v.y << 16) + q8[3] * __uint_as_float(v.y & 0xffff0000u)
                   + q8[4] * __uint_as_float(v.z << 16) + q8[5] * __uint_as_float(v.z & 0xffff0000u) + q8[6] * __uint_as_float(v.w << 16) + q8[7] * __uint_as_float(v.w & 0xffff0000u); }
            s *= scale; sc[kk] = s; mx = fmaxf(mx, s);
        }
        mx = wave_max(mx);
        float sum = 0.f;
        for (int kc = 0; kc < nk; kc += 64) { const float p = expf(sc[kc + lane] - mx); sc[kc + lane] = p; sum += p; }
        sum = wave_sum(sum);
        __syncthreads();
        float o0 = 0.f, o1 = 0.f;
        for (int kk = 0; kk < nk; ++kk) {
            const int kt = lat ? (kk < L ? b * L + kk : NLAT + b * C + (kk - L)) : (NLAT + b * C + kk);
            const unsigned v = *(const unsigned*)(KV + (size_t)kt * KVW + h * 256 + 128 + lane * 2);
            const float p = sc[kk];
            o0 += p * __uint_as_float(v << 16); o1 += p * __uint_as_float(v & 0xffff0000u);
        }
        const float inv = 1.0f / sum;
        *(unsigned*)(mix + (size_t)qt * D + h * 128 + lane * 2) = (unsigned)f2bf(o0 * inv) | ((unsigned)f2bf(o1 * inv) << 16);
        __syncthreads();
    }
}
__device__ __forceinline__ void ph_swa_naive(const Args& a, int l, int nq, float* sm) {
    const bf16_t* __restrict__ SQ = (const bf16_t*)(a.ws + WS_SQ); const bf16_t* __restrict__ SK = (const bf16_t*)(a.ws + WS_SK); const bf16_t* __restrict__ SV = (const bf16_t*)(a.ws + WS_SV);
    const float* sink = a.in[24] + l * 8; bf16_t* mix = (bf16_t*)(a.ws + WS_MIX);
    const int lane = threadIdx.x & 63, w = threadIdx.x >> 6;
    float* qf = sm + w * 64; float* sc = sm + 8 * 64 + w * 576; int* kts = (int*)(sm + 8 * 64 + 8 * 576) + w * 576;
    for (int unit = blockIdx.x; unit < nq; unit += gridDim.x) {
        const int hq = unit & 7, hk = hq >> 2, qt = (unit >> 3) * 8 + w; const bool lat = qt < NLAT;
        const int b = lat ? (qt >> 11) : ((qt - NLAT) >> 8), t = lat ? (qt & 2047) : 0;
        int lo = 0, nloc = 0;
        if (lat) { lo = t - 128 < 0 ? 0 : t - 128; const int hi = t + 128 > L - 1 ? L - 1 : t + 128; nloc = hi - lo + 1; }
        const int nk = nloc + C;
        qf[lane] = bf2f(SQ[(size_t)qt * 512 + hq * 64 + lane]);
        __syncthreads();
        const float skv = sink[hq];
        float mx = skv;
        for (int kc = 0; kc < nk; kc += 64) {
            const int kk = kc + lane;
            if (kk < nk) {
                const int kt = kk < nloc ? (b * L + lo + kk) : (NLAT + b * C + (kk - nloc));
                const u32x4* kp = (const u32x4*)(SK + (size_t)kt * 128 + hk * 64);
                float s = 0.f;
                for (int i = 0; i < 8; ++i) { const u32x4 v = kp[i]; const float* q8 = qf + i * 8;
                    s += q8[0] * __uint_as_float(v.x << 16) + q8[1] * __uint_as_float(v.x & 0xffff0000u) + q8[2] * __uint_as_float(v.y << 16) + q8[3] * __uint_as_float(v.y & 0xffff0000u)
                       + q8[4] * __uint_as_float(v.z << 16) + q8[5] * __uint_as_float(v.z & 0xffff0000u) + q8[6] * __uint_as_float(v.w << 16) + q8[7] * __uint_as_float(v.w & 0xffff0000u); }
                s *= 0.125f; sc[kk] = s; kts[kk] = kt; mx = fmaxf(mx, s);
            }
        }
        mx = wave_max(mx);
        float sum = 0.f;
        for (int kc = 0; kc < nk; kc += 64) { const int kk = kc + lane; if (kk < nk) { const float p = expf(sc[kk] - mx); sc[kk] = p; sum += p; } }
        sum = wave_sum(sum) + expf(skv - mx);
        __syncthreads();
        float o = 0.f;
        for (int kk = 0; kk < nk; ++kk) o += sc[kk] * bf2f(SV[(size_t)kts[kk] * 128 + hk * 64 + lane]);
        mix[(size_t)qt * D + 1536 + hq * 64 + lane] = f2bf(o / sum);
        __syncthreads();
    }
}
template <int LS>
__device__ __forceinline__ void ph_hyena_naive(const Args& a, int l, float* sm) {
    const float* filt = LS == L ? (const float*)(a.ws + WS_FILTL) + (size_t)l * 512 * 4096 : (const float*)(a.ws + WS_FILTC) + (size_t)l * 512 * 512;
    const bf16_t* wt = (const bf16_t*)(a.ws + (LS == L ? WS_WTL : WS_WTC)); const bf16_t* x0 = (const bf16_t*)(a.ws + WS_X0); const float* skip = a.in[23] + l * 512;
    bf16_t* mix = (bf16_t*)(a.ws + WS_MIX); const int tok_base = LS == L ? 0 : NLAT;
    float* T = sm; float* ws = sm + 2 * LS; const int tid = threadIdx.x;
    for (int unit = blockIdx.x; unit < 512 * NB; unit += gridDim.x) {
        const int ch = unit >> 2, b = unit & 3;
        for (int i = tid; i < 2 * LS; i += NTHR) T[i] = filt[(size_t)ch * 2 * LS + i];
        for (int i = tid; i < LS; i += NTHR) ws[i] = bf2f(wt[((size_t)b * 512 + ch) * LS + i]);
        __syncthreads();
        const float sk = skip[ch];
        for (int t = tid; t < LS; t += NTHR) {
            float y = 0.f;
            for (int s = 0; s < LS; ++s) y += T[t - s + LS] * ws[s];
            const int tok = tok_base + b * LS + t;
            mix[(size_t)tok * D + 1024 + ch] = f2bf(bf2f(x0[(size_t)tok * 512 + ch]) * (y + sk * ws[t]));
        }
        __syncthreads();
    }
}
__device__ __forceinline__ void ph_route(const Args& a, int* sm) {
    const int* topi = (const int*)(a.ws + WS_TOPI); int* pos = (int*)(a.ws + WS_POS); int* src = (int*)(a.ws + WS_SRC); int* ctl = (int*)(a.ws + WS_CTL);
    if (blockIdx.x != 0) return;
    int (*cnt)[512] = (int (*)[512])sm; int* eoff = sm + 8 * 512;
    const int tid = threadIdx.x;
    for (int i = tid; i < MOE_ROWS; i += NTHR) src[i] = -1;
    int c[8];
#pragma unroll
    for (int e = 0; e < 8; ++e) c[e] = 0;
    for (int i = 0; i < 32; ++i) { const int e = topi[tid * 32 + i];
#pragma unroll
        for (int q = 0; q < 8; ++q) c[q] += (e == q) ? 1 : 0; }
#pragma unroll
    for (int e = 0; e < 8; ++e) cnt[e][tid] = c[e];
    __syncthreads();
    if (tid < 8) { int s = 0; for (int i = 0; i < 512; ++i) { const int v = cnt[tid][i]; cnt[tid][i] = s; s += v; } eoff[tid] = s; }
    __syncthreads();
    if (tid == 0) { int o = 0; for (int e = 0; e < 8; ++e) { const int n = eoff[e], p = (n + 255) & ~255; ctl[CT_EOFF + e] = o; ctl[CT_EPAD + e] = p; eoff[e] = o; o += p; } ctl[CT_NTILE] = o >> 8; }
    __syncthreads();
#pragma unroll
    for (int e = 0; e < 8; ++e) c[e] = eoff[e] + cnt[e][tid];
    for (int i = 0; i < 32; ++i) { const int idx = tid * 32 + i; const int e = topi[idx]; int p = 0;
#pragma unroll
        for (int q = 0; q < 8; ++q) if (e == q) { p = c[q]; c[q]++; }
        pos[idx] = p; src[p] = idx >> 1; }
}
__device__ __forceinline__ void ph_gather(const Args& a) {
    const bf16_t* hb = (const bf16_t*)(a.ws + WS_HA); const int* src = (const int*)(a.ws + WS_SRC); bf16_t* hbs = (bf16_t*)(a.ws + WS_HBS);
    const int nrows = ((const int*)(a.ws + WS_CTL))[CT_NTILE] * 256;
    const int quarter = threadIdx.x >> 7, t = threadIdx.x & 127;
    for (int r = blockIdx.x * 4 + quarter; r < nrows; r += gridDim.x * 4) {
        const int s = src[r]; u32x4 v = (u32x4){0u, 0u, 0u, 0u};
        if (s >= 0) v = *(const u32x4*)((const unsigned char*)hb + (size_t)s * D + t * 16);
        *(u32x4*)((unsigned char*)hbs + (size_t)r * D + t * 16) = v;
    }
}
__device__ __forceinline__ void ph_final(const Args& a) {
    const float* xs = (const float*)(a.ws + WS_XS); const float* ys = (const float*)(a.ws + WS_YS); const int* pos = (const int*)(a.ws + WS_POS); const float* topw = (const float*)(a.ws + WS_TOPW);
    const float* modl = (const float*)(a.ws + WS_MOD) + (size_t)5 * 12288; const float* gfin = a.in[33]; float* out = a.out;
    const int lane = threadIdx.x & 63, wid = threadIdx.x >> 6;
    for (int row = blockIdx.x * 8 + wid; row < NLAT; row += gridDim.x * 8) {
        const float* g2 = modl + (size_t)tok_mod(row) * 12288 + 10240;
        const int p0 = pos[row * 2], p1 = pos[row * 2 + 1]; const float w0 = topw[row * 2], w1 = topw[row * 2 + 1];
        f32x4 v[8]; float ss = 0.f;
#pragma unroll
        for (int i = 0; i < 8; ++i) { const int col = i * 256 + lane * 4;
            const f32x4 x = *(const f32x4*)(xs + (size_t)row * D + col), ya = *(const f32x4*)(ys + (size_t)p0 * D + col), yb = *(const f32x4*)(ys + (size_t)p1 * D + col), g = *(const f32x4*)(g2 + col);
#pragma unroll
            for (int j = 0; j < 4; ++j) { v[i][j] = x[j] + g[j] * (w0 * ya[j] + w1 * yb[j]); ss += v[i][j] * v[i][j]; } }
        ss = wave_sum(ss); const float rstd = rsqrtf(ss * (1.0f / D) + EPS);
#pragma unroll
        for (int i = 0; i < 8; ++i) { const int col = i * 256 + lane * 4; const f32x4 g = *(const f32x4*)(gfin + col); f32x4 o;
#pragma unroll
            for (int j = 0; j < 4; ++j) o[j] = v[i][j] * rstd * g[j];
            *(f32x4*)(out + (size_t)row * D + col) = o; }
    }
}

typedef float f32x2_t __attribute__((ext_vector_type(2))); typedef __bf16 bf16x2_t __attribute__((ext_vector_type(2)));
__device__ __forceinline__ unsigned cvtpk(float lo, float hi) { f32x2_t v = {lo, hi}; bf16x2_t b = __builtin_convertvector(v, bf16x2_t); return __builtin_bit_cast(unsigned, b); }
#define MFMA32(a, b, c) __builtin_amdgcn_mfma_f32_32x32x16_bf16((a), (b), (c), 0, 0, 0)
constexpr int MLA_KP = 400, MLA_VP = 144, MLA_KB = 64 * MLA_KP, MLA_VB = 128 * MLA_VP, MLA_STAGE = MLA_KB + MLA_VB;
static_assert(2 * MLA_STAGE <= RING_BYTES, "MLA LDS");

__device__ __forceinline__ void ph_mla(const Args& a, bool with_ctx, unsigned char* lds) {
    const bf16_t* __restrict__ Q = (const bf16_t*)(a.ws + WS_Q); const bf16_t* __restrict__ KN = (const bf16_t*)(a.ws + WS_KN); const bf16_t* __restrict__ KPE = (const bf16_t*)(a.ws + WS_KPE);
    const bf16_t* __restrict__ VT = (const bf16_t*)(a.ws + WS_VT); bf16_t* __restrict__ mix = (bf16_t*)(a.ws + WS_MIX);
    int tid_ = threadIdx.x; asm volatile("" : "+v"(tid_));
    const int tid = tid_, lane = tid & 63, w = tid >> 6, qi = lane & 31, hh = lane >> 5;
    const int nunits = with_ctx ? 288 : 256;
    const float c = 0.07216878364870322f * 1.4426950408889634f;
    for (int unit = blockIdx.x; unit < nunits; unit += gridDim.x) {
        int h, b, q0tok, nt; bool ctxq;
        if (unit < 256) { h = unit & 7; b = unit >> 6; q0tok = b * L + ((unit >> 3) & 7) * 256; nt = 36; ctxq = false; }
        else { const int u2 = unit - 256; h = u2 & 7; b = u2 >> 3; q0tok = NLAT + b * C; nt = 4; ctxq = true; }
#define MLA_KTOK(t) (ctxq ? (NLAT + b * C + (t) * 64) : ((t) < 32 ? (b * L + (t) * 64) : (NLAT + b * C + ((t) - 32) * 64)))
        u32x4 r0, r1, r2, r3, r4;
#define MLA_ISSUE(t) do { const int kt0_ = MLA_KTOK(t); \
            r0 = *(const u32x4*)(KN + (size_t)(kt0_ + (tid >> 4)) * 1024 + h * 128 + (tid & 15) * 8); \
            r1 = *(const u32x4*)(KN + (size_t)(kt0_ + 32 + (tid >> 4)) * 1024 + h * 128 + (tid & 15) * 8); \
            r2 = *(const u32x4*)(KPE + (size_t)(kt0_ + (tid >> 3)) * 64 + (tid & 7) * 8); \
            r3 = *(const u32x4*)(VT + (size_t)(h * 128 + (tid >> 3)) * NTOK + kt0_ + (tid & 7) * 8); \
            r4 = *(const u32x4*)(VT + (size_t)(h * 128 + 64 + (tid >> 3)) * NTOK + kt0_ + (tid & 7) * 8); } while (0)
#define MLA_COMMIT(buf) do { unsigned char* kb_ = lds + (buf) * MLA_STAGE; unsigned char* vb_ = kb_ + MLA_KB; \
            *(u32x4*)(kb_ + (tid >> 4) * MLA_KP + (tid & 15) * 16) = r0; \
            *(u32x4*)(kb_ + (32 + (tid >> 4)) * MLA_KP + (tid & 15) * 16) = r1; \
            *(u32x4*)(kb_ + (tid >> 3) * MLA_KP + 256 + (tid & 7) * 16) = r2; \
            const int g_ = (tid & 7) >> 1, e_ = tid & 1; \
            { u32x2 lo_, hi_; lo_.x = r3.x; lo_.y = r3.y; hi_.x = r3.z; hi_.y = r3.w; \
              *(u32x2*)(vb_ + (tid >> 3) * MLA_VP + g_ * 32 + e_ * 8) = lo_; *(u32x2*)(vb_ + (tid >> 3) * MLA_VP + g_ * 32 + 16 + e_ * 8) = hi_; } \
            { u32x2 lo_, hi_; lo_.x = r4.x; lo_.y = r4.y; hi_.x = r4.z; hi_.y = r4.w; \
              *(u32x2*)(vb_ + (64 + (tid >> 3)) * MLA_VP + g_ * 32 + e_ * 8) = lo_; *(u32x2*)(vb_ + (64 + (tid >> 3)) * MLA_VP + g_ * 32 + 16 + e_ * 8) = hi_; } } while (0)
        const int qtok = q0tok + w * 32 + qi;
        bf16x8 qf[12];
#pragma unroll
        for (int s = 0; s < 12; ++s) qf[s] = *(const bf16x8*)(Q + (size_t)qtok * QW + h * 192 + s * 16 + hh * 8);
        f32x16 o[4];
#pragma unroll
        for (int d = 0; d < 4; ++d)
#pragma unroll
            for (int r = 0; r < 16; ++r) o[d][r] = 0.f;
        float m = -1.0e30f, l = 0.f;
        MLA_ISSUE(0); MLA_COMMIT(0);
        __syncthreads();
        for (int t = 0; t < nt; ++t) {
            const unsigned char* kb = lds + (t & 1) * MLA_STAGE; const unsigned char* vb = kb + MLA_KB;
            f32x16 s0, s1;
#pragma unroll
            for (int r = 0; r < 16; ++r) { s0[r] = 0.f; s1[r] = 0.f; }
#pragma unroll
            for (int s = 0; s < 12; ++s) {
                const bf16x8 k0 = *(const bf16x8*)(kb + qi * MLA_KP + s * 32 + hh * 16);
                const bf16x8 k1 = *(const bf16x8*)(kb + (32 + qi) * MLA_KP + s * 32 + hh * 16);
                s0 = MFMA32(k0, qf[s], s0); s1 = MFMA32(k1, qf[s], s1);
                if ((s & 3) == 3) asm volatile("" ::: "memory");
            }
            if (t + 1 < nt) MLA_ISSUE(t + 1);
            float mx = fmaxf(s0[0], s1[0]);
#pragma unroll
            for (int r = 1; r < 16; ++r) mx = fmaxf(mx, fmaxf(s0[r], s1[r]));
            mx = fmaxf(mx, __shfl_xor(mx, 32));
            const float mnew = fmaxf(m, mx * c);
            const float alpha = __builtin_amdgcn_exp2f(m - mnew);
            m = mnew;
            float ps = 0.f;
#pragma unroll
            for (int r = 0; r < 16; ++r) { s0[r] = __builtin_amdgcn_exp2f(s0[r] * c - mnew); s1[r] = __builtin_amdgcn_exp2f(s1[r] * c - mnew); ps += s0[r] + s1[r]; }
            l = l * alpha + ps;
#pragma unroll
            for (int d = 0; d < 4; ++d)
#pragma unroll
                for (int r = 0; r < 16; ++r) o[d][r] *= alpha;
            bf16x8 pf[4];
            { u32x4 p;
              p.x = cvtpk(s0[0], s0[1]); p.y = cvtpk(s0[2], s0[3]); p.z = cvtpk(s0[4], s0[5]); p.w = cvtpk(s0[6], s0[7]); pf[0] = __builtin_bit_cast(bf16x8, p);
              p.x = cvtpk(s0[8], s0[9]); p.y = cvtpk(s0[10], s0[11]); p.z = cvtpk(s0[12], s0[13]); p.w = cvtpk(s0[14], s0[15]); pf[1] = __builtin_bit_cast(bf16x8, p);
              p.x = cvtpk(s1[0], s1[1]); p.y = cvtpk(s1[2], s1[3]); p.z = cvtpk(s1[4], s1[5]); p.w = cvtpk(s1[6], s1[7]); pf[2] = __builtin_bit_cast(bf16x8, p);
              p.x = cvtpk(s1[8], s1[9]); p.y = cvtpk(s1[10], s1[11]); p.z = cvtpk(s1[12], s1[13]); p.w = cvtpk(s1[14], s1[15]); pf[3] = __builtin_bit_cast(bf16x8, p); }
            asm volatile("" ::: "memory");
#pragma unroll
            for (int d = 0; d < 4; ++d) {
#pragma unroll
                for (int g = 0; g < 4; ++g) {
                    const bf16x8 vf = *(const bf16x8*)(vb + (d * 32 + qi) * MLA_VP + g * 32 + hh * 16);
                    o[d] = MFMA32(vf, pf[g], o[d]);
                }
                if (d & 1) asm volatile("" ::: "memory");
            }
            if (t + 1 < nt) MLA_COMMIT((t + 1) & 1);
            __syncthreads();
        }
        const float inv = 1.0f / (l + __shfl_xor(l, 32));
        bf16_t* op = mix + (size_t)qtok * D + h * 128 + 4 * hh;
#pragma unroll
        for (int d = 0; d < 4; ++d)
#pragma unroll
            for (int g = 0; g < 4; ++g) { u32x2 wv; wv.x = cvtpk(o[d][4 * g] * inv, o[d][4 * g + 1] * inv); wv.y = cvtpk(o[d][4 * g + 2] * inv, o[d][4 * g + 3] * inv);
                *(u32x2*)(op + d * 32 + 8 * g) = wv; }
#undef MLA_KTOK
#undef MLA_ISSUE
#undef MLA_COMMIT
    }
}

constexpr int HY_CS = 8224, HY_WS = 5136, HY_WOFF = 8 * HY_CS, HY_RBL = HY_WOFF + 4 * HY_WS;
static_assert(HY_RBL + 516 * 16 <= RING_BYTES, "hyena LDS");

__device__ __forceinline__ u32x4 hy_shift(const u32x4 a, const u32x4 b, int r) {
    switch (r) {
    case 0: return b;
    case 1: return (u32x4){__builtin_amdgcn_alignbyte(b.x, a.w, 2), __builtin_amdgcn_alignbyte(b.y, b.x, 2), __builtin_amdgcn_alignbyte(b.z, b.y, 2), __builtin_amdgcn_alignbyte(b.w, b.z, 2)};
    case 2: return (u32x4){a.w, b.x, b.y, b.z};
    case 3: return (u32x4){__builtin_amdgcn_alignbyte(a.w, a.z, 2), __builtin_amdgcn_alignbyte(b.x, a.w, 2), __builtin_amdgcn_alignbyte(b.y, b.x, 2), __builtin_amdgcn_alignbyte(b.z, b.y, 2)};
    case 4: return (u32x4){a.z, a.w, b.x, b.y};
    case 5: return (u32x4){__builtin_amdgcn_alignbyte(a.z, a.y, 2), __builtin_amdgcn_alignbyte(a.w, a.z, 2), __builtin_amdgcn_alignbyte(b.x, a.w, 2), __builtin_amdgcn_alignbyte(b.y, b.x, 2)};
    case 6: return (u32x4){a.y, a.z, a.w, b.x};
    default: return (u32x4){__builtin_amdgcn_alignbyte(a.y, a.x, 2), __builtin_amdgcn_alignbyte(a.z, a.y, 2), __builtin_amdgcn_alignbyte(a.w, a.z, 2), __builtin_amdgcn_alignbyte(b.x, a.w, 2)};
    }
}

__device__ __forceinline__ void ph_hyena(const Args& a, int l, unsigned char* lds) {
    const bf16_t* __restrict__ RB = (const bf16_t*)(a.ws + WS_FILTL) + (size_t)l * 512 * HY_RBROW;
    const bf16_t* __restrict__ wtl = (const bf16_t*)(a.ws + WS_WTL); const bf16_t* __restrict__ x0 = (const bf16_t*)(a.ws + WS_X0); const float* skip = a.in[23] + l * 512;
    bf16_t* __restrict__ mix = (bf16_t*)(a.ws + WS_MIX);
    int tid_ = threadIdx.x; asm volatile("" : "+v"(tid_));
    const int tid = tid_, lane = tid & 63, w = __builtin_amdgcn_readfirstlane(tid >> 6), i = lane & 31, hh = lane >> 5;
    for (int unit = blockIdx.x; unit < 512; unit += gridDim.x) {
        const int c = unit;
        for (int k = tid; k < 515; k += NTHR) { u32x4 v = (u32x4){0u, 0u, 0u, 0u}; if (k < 513) v = *(const u32x4*)(RB + (size_t)c * HY_RBROW + k * 8); *(u32x4*)(lds + HY_RBL + k * 16) = v; }
        for (int k = tid; k < 4 * 321; k += NTHR) { const int b = k / 321, sl = k - b * 321; u32x4 v = (u32x4){0u, 0u, 0u, 0u};
            if (sl >= 28 && sl < 284) v = *(const u32x4*)(wtl + ((size_t)b * 512 + c) * L + (sl - 28) * 8);
            *(u32x4*)(lds + HY_WOFF + b * HY_WS + sl * 16) = v; }
        __syncthreads();
        for (int qs = lane; qs < 511; qs += 64) {
            const u32x4 ca = *(const u32x4*)(lds + HY_RBL + qs * 16), cb = *(const u32x4*)(lds + HY_RBL + qs * 16 + 16);
            *(u32x4*)(lds + w * HY_CS + qs * 16) = hy_shift(ca, cb, w);
        }
        __syncthreads();
        f32x16 acc0, acc1;
#pragma unroll
        for (int r = 0; r < 16; ++r) { acc0[r] = 0.f; acc1[r] = 0.f; }
        const int Tl = i >> 2, b = i & 3;
        const unsigned char* ap = lds + (i & 7) * HY_CS + (hh - (i >> 3) + 255) * 16;
        const unsigned char* bp = lds + HY_WOFF + b * HY_WS + (224 + 16 * (2 * (8 * w + Tl)) + 8 * hh) * 2;
        const int d0 = 16 * w - 127;
#pragma unroll 2
        for (int dd = 0; dd < 142; dd += 2) {
            const int d = d0 + dd;
            const bf16x8 a0 = *(const bf16x8*)(ap - 32 * d), b0 = *(const bf16x8*)(bp - 32 * d);
            const bf16x8 a1 = *(const bf16x8*)(ap - 32 * (d + 1)), b1 = *(const bf16x8*)(bp - 32 * (d + 1));
            acc0 = MFMA32(a0, b0, acc0); acc1 = MFMA32(a1, b1, acc1);
        }
        const float sk = skip[c];
        const bf16_t* wl = (const bf16_t*)(lds + HY_WOFF + b * HY_WS) + 224;
#pragma unroll
        for (int r = 0; r < 16; ++r) {
            const int t = 32 * (8 * w + Tl) + (r & 3) + 8 * (r >> 2) + 4 * hh; const int tok = b * L + t;
            const float y = acc0[r] + acc1[r] + sk * bf2f(wl[t]);
            mix[(size_t)tok * D + 1024 + c] = f2bf(bf2f(x0[(size_t)tok * 512 + c]) * y);
        }
        __syncthreads();
    }
}

constexpr int SWA_P = 144, SWA_KB = 64 * SWA_P, SWA_STAGE = 2 * SWA_KB;
__device__ __forceinline__ void ph_swa(const Args& a, int l, bool with_ctx, unsigned char* lds) {
    const bf16_t* __restrict__ SQ = (const bf16_t*)(a.ws + WS_SQ); const bf16_t* __restrict__ SK = (const bf16_t*)(a.ws + WS_SK); const bf16_t* __restrict__ SVT = (const bf16_t*)(a.ws + WS_SV);
    const float* sink = a.in[24] + l * 8; bf16_t* __restrict__ mix = (bf16_t*)(a.ws + WS_MIX);
    int tid_ = threadIdx.x; asm volatile("" : "+v"(tid_));
    const int tid = tid_, lane = tid & 63, w = tid >> 6, qi = lane & 31, hh = lane >> 5;
    const int nunits = with_ctx ? 288 : 256;
    const float c = 0.125f * 1.4426950408889634f;
    for (int unit = blockIdx.x; unit < nunits; unit += gridDim.x) {
        int hk, b, p0, nloc, t0loc, q0tok; bool ctxq;
        if (unit < 256) { hk = unit & 1; b = (unit >> 1) & 3; p0 = (unit >> 3) * 64; ctxq = false; q0tok = b * L + p0;
            const int lo = p0 - 128 < 0 ? 0 : p0 - 128, hi = p0 + 192 > L ? L : p0 + 192; t0loc = lo; nloc = (hi - lo) >> 6; }
        else { const int u2 = unit - 256; hk = u2 & 1; b = (u2 >> 1) & 3; p0 = (u2 >> 3) * 64; ctxq = true; q0tok = NLAT + b * C + p0; t0loc = 0; nloc = 0; }
        const int nt = nloc + 4;
#define SWA_KTOK(t) ((t) < nloc ? (b * L + t0loc + (t) * 64) : (NLAT + b * C + ((t) - nloc) * 64))
        u32x4 r0, r1;
#define SWA_ISSUE(t) do { const int kt0_ = SWA_KTOK(t); \
            r0 = *(const u32x4*)(SK + (size_t)(kt0_ + (tid >> 3)) * 128 + hk * 64 + (tid & 7) * 8); \
            r1 = *(const u32x4*)(SVT + (size_t)(hk * 64 + (tid >> 3)) * NTOK + kt0_ + (tid & 7) * 8); } while (0)
#define SWA_COMMIT(buf) do { unsigned char* kb_ = lds + (buf) * SWA_STAGE; unsigned char* vb_ = kb_ + SWA_KB; \
            *(u32x4*)(kb_ + (tid >> 3) * SWA_P + (tid & 7) * 16) = r0; \
            const int g_ = (tid & 7) >> 1, e_ = tid & 1; u32x2 lo_, hi_; lo_.x = r1.x; lo_.y = r1.y; hi_.x = r1.z; hi_.y = r1.w; \
            *(u32x2*)(vb_ + (tid >> 3) * SWA_P + g_ * 32 + e_ * 8) = lo_; *(u32x2*)(vb_ + (tid >> 3) * SWA_P + g_ * 32 + 16 + e_ * 8) = hi_; } while (0)
        const int hq = hk * 4 + (w >> 1), qpos = p0 + (w & 1) * 32 + qi, qtok = q0tok + (w & 1) * 32 + qi;
        bf16x8 qf[4];
#pragma unroll
        for (int s = 0; s < 4; ++s) qf[s] = *(const bf16x8*)(SQ + (size_t)qtok * 512 + hq * 64 + s * 16 + hh * 8);
        f32x16 o[2];
#pragma unroll
        for (int d = 0; d < 2; ++d)
#pragma unroll
            for (int r = 0; r < 16; ++r) o[d][r] = 0.f;
        float m = sink[hq] * 1.4426950408889634f, lsum = hh == 0 ? 1.0f : 0.0f;
        SWA_ISSUE(0); SWA_COMMIT(0);
        __syncthreads();
        for (int t = 0; t < nt; ++t) {
            const unsigned char* kb = lds + (t & 1) * SWA_STAGE; const unsigned char* vb = kb + SWA_KB;
            f32x16 s0, s1;
#pragma unroll
            for (int r = 0; r < 16; ++r) { s0[r] = 0.f; s1[r] = 0.f; }
#pragma unroll
            for (int s = 0; s < 4; ++s) {
                const bf16x8 k0 = *(const bf16x8*)(kb + qi * SWA_P + s * 32 + hh * 16);
                const bf16x8 k1 = *(const bf16x8*)(kb + (32 + qi) * SWA_P + s * 32 + hh * 16);
                s0 = MFMA32(k0, qf[s], s0); s1 = MFMA32(k1, qf[s], s1);
            }
            if (t + 1 < nt) SWA_ISSUE(t + 1);
            if (t < nloc) {
                const int kbase = t0loc + t * 64 + 4 * hh - qpos;
#pragma unroll
                for (int r = 0; r < 16; ++r) { const int dlt = kbase + (r & 3) + 8 * (r >> 2);
                    if (dlt > 128 || dlt < -128) s0[r] = -1.0e30f;
                    if (dlt + 32 > 128 || dlt + 32 < -128) s1[r] = -1.0e30f; }
            }
            float mx = fmaxf(s0[0], s1[0]);
#pragma unroll
            for (int r = 1; r < 16; ++r) mx = fmaxf(mx, fmaxf(s0[r], s1[r]));
            mx = fmaxf(mx, __shfl_xor(mx, 32));
            const float mnew = fmaxf(m, mx * c);
            const float alpha = __builtin_amdgcn_exp2f(m - mnew);
            m = mnew;
            float ps = 0.f;
#pragma unroll
            for (int r = 0; r < 16; ++r) { s0[r] = __builtin_amdgcn_exp2f(s0[r] * c - mnew); s1[r] = __builtin_amdgcn_exp2f(s1[r] * c - mnew); ps += s0[r] + s1[r]; }
            lsum = lsum * alpha + ps;
#pragma unroll
            for (int d = 0; d < 2; ++d)
#pragma unroll
                for (int r = 0; r < 16; ++r) o[d][r] *= alpha;
            bf16x8 pf[4];
            { u32x4 p;
              p.x = cvtpk(s0[0], s0[1]); p.y = cvtpk(s0[2], s0[3]); p.z = cvtpk(s0[4], s0[5]); p.w = cvtpk(s0[6], s0[7]); pf[0] = __builtin_bit_cast(bf16x8, p);
              p.x = cvtpk(s0[8], s0[9]); p.y = cvtpk(s0[10], s0[11]); p.z = cvtpk(s0[12], s0[13]); p.w = cvtpk(s0[14], s0[15]); pf[1] = __builtin_bit_cast(bf16x8, p);
              p.x = cvtpk(s1[0], s1[1]); p.y = cvtpk(s1[2], s1[3]); p.z = cvtpk(s1[4], s1[5]); p.w = cvtpk(s1[6], s1[7]); pf[2] = __builtin_bit_cast(bf16x8, p);
              p.x = cvtpk(s1[8], s1[9]); p.y = cvtpk(s1[10], s1[11]); p.z = cvtpk(s1[12], s1[13]); p.w = cvtpk(s1[14], s1[15]); pf[3] = __builtin_bit_cast(bf16x8, p); }
#pragma unroll
            for (int d = 0; d < 2; ++d)
#pragma unroll
                for (int g = 0; g < 4; ++g) {
                    const bf16x8 vf = *(const bf16x8*)(vb + (d * 32 + qi) * SWA_P + g * 32 + hh * 16);
                    o[d] = MFMA32(vf, pf[g], o[d]);
                }
            if (t + 1 < nt) SWA_COMMIT((t + 1) & 1);
            __syncthreads();
        }
        const float inv = 1.0f / (lsum + __shfl_xor(lsum, 32));
        bf16_t* op = mix + (size_t)qtok * D + 1536 + hq * 64 + 4 * hh;
#pragma unroll
        for (int d = 0; d < 2; ++d)
#pragma unroll
            for (int g = 0; g < 4; ++g) { u32x2 wv; wv.x = cvtpk(o[d][4 * g] * inv, o[d][4 * g + 1] * inv); wv.y = cvtpk(o[d][4 * g + 2] * inv, o[d][4 * g + 3] * inv);
                *(u32x2*)(op + d * 32 + 8 * g) = wv; }
#undef SWA_KTOK
#undef SWA_ISSUE
#undef SWA_COMMIT
    }
}


constexpr int NPHASES = 22;
#define GEMM_CALL(EPI, SCHED, g, S, E) pg8::gemm_phase<EPI, SCHED, true, true>((PG8_LAS unsigned char*)lds, g, S, E)
#define GEMM_CALL8(EPI, SCHED, g, S, E) pg8::gemm_phase<EPI, SCHED, true, true, true>((PG8_LAS unsigned char*)lds, g, S, E)

template <int LYR>
__device__ __forceinline__ void layer_phases(const Args& a, unsigned char* lds, const XcdBarrier& bar, int lo, int hi) {
#define IN(k) (lo <= (k) && (k) < hi)
#if MK_PER_PHASE
#define SEAM(k) do { } while (0)
#else
#define SEAM(k) do { if (IN(k) && IN((k) + 1)) xcd_barrier(bar); } while (0)
#endif
    constexpr int P0 = 1 + LYR * 9;
    constexpr bool LAST = (LYR == 1);
    const int G = gridDim.x, bid = blockIdx.x;
    unsigned char* ws = a.ws;
    const float* modl = (const float*)(ws + WS_MOD) + (size_t)LYR * 5 * 12288;
    float* xs = (float*)(ws + WS_XS);
    const int nq = LAST ? NLAT : NTOK;
    if (IN(P0 + 0)) {
        if (LYR == 0) ph_normmod<false, true>(a.in[0], a.in[2], a.in[6], modl, 0, 2048, (bf16_t*)(ws + WS_HA), NTOK, xs, nullptr, nullptr, nullptr);
        else ph_normmod<false, false>(xs, xs + (size_t)NLAT * D, a.in[6] + D, modl, 0, 2048, (bf16_t*)(ws + WS_HA), NTOK, nullptr, nullptr, nullptr, nullptr);
    }
    SEAM(P0 + 0);
    if (IN(P0 + 1)) {
        pg8::Gemm g{(const bf16_t*)(ws + WS_HA), (const bf16_t*)(ws + WS_WIN + (size_t)LYR * UW * D * 2), NTOK, UW, D};
        pg8::StaticOrder S; S.init(NTOK, UW, G, bid); pg8::EpiStore E{(bf16_t*)(ws + WS_U), UW};
        GEMM_CALL(pg8::EpiStore, pg8::StaticOrder, g, S, E);
    }
    SEAM(P0 + 1);
    if (IN(P0 + 2)) ph_mid(a, LYR);
    SEAM(P0 + 2);
    if (IN(P0 + 3)) {
        { pg8::Gemm g{(const bf16_t*)(ws + WS_CQN), (const bf16_t*)(ws + WS_WQ + (size_t)LYR * QW * 768 * 2), nq, QW, 768};
          pg8::StaticOrder S; S.init(nq, QW, G, bid); pg8::EpiQ E{(bf16_t*)(ws + WS_Q), (const float*)(ws + WS_ROPE), (const float*)(ws + WS_ROPE) + 2048 * 32};
          GEMM_CALL(pg8::EpiQ, pg8::StaticOrder, g, S, E); }
        __syncthreads();
        { pg8::Gemm g{(const bf16_t*)(ws + WS_CKVN), (const bf16_t*)(ws + WS_WKV + (size_t)LYR * KVW * 512 * 2), NTOK, 1024, 512};
          pg8::StaticOrder S; S.init(NTOK, 1024, G, bid); pg8::EpiStore E{(bf16_t*)(ws + WS_KN), 1024};
          GEMM_CALL(pg8::EpiStore, pg8::StaticOrder, g, S, E); }
        __syncthreads();
        { pg8::Gemm g{(const bf16_t*)(ws + WS_WKV + (size_t)LYR * KVW * 512 * 2 + (size_t)1024 * 512 * 2), (const bf16_t*)(ws + WS_CKVN), 1024, NTOK, 512};
          pg8::StaticOrder S; S.init(1024, NTOK, 108, bid >= 216 ? bid - 216 : (bid >= 144 ? bid - 108 : (1 << 24))); pg8::EpiStore E{(bf16_t*)(ws + WS_VT), NTOK};
          GEMM_CALL(pg8::EpiStore, pg8::StaticOrder, g, S, E); }
        __syncthreads();
        ph_hyena(a, LYR, lds);
        if (!LAST) ph_hyena_naive<C>(a, LYR, (float*)lds);
        ph_swa(a, LYR, !LAST, lds);
    }
    SEAM(P0 + 3);
    if (IN(P0 + 4)) ph_mla(a, !LAST, lds);
    SEAM(P0 + 4);
    if (IN(P0 + 5)) {
        pg8::Gemm g{(const bf16_t*)(ws + WS_MIX), (const bf16_t*)(ws + WS_WOUT + (size_t)LYR * D * D * 2), nq, D, D};
        pg8::StaticOrder S; S.init(nq, D, G, bid); pg8::EpiResid E{xs, modl + 4096, 1.0f};
        GEMM_CALL(pg8::EpiResid, pg8::StaticOrder, g, S, E);
    }
    SEAM(P0 + 5);
    if (!LAST) {
#if !FP8_DENSE
        if (IN(P0 + 6)) ph_normmod<false, false>(xs, xs + (size_t)NLAT * D, a.in[7], modl, 6144, 8192, (bf16_t*)(ws + WS_HA), NTOK, nullptr, nullptr, nullptr, nullptr);
        SEAM(P0 + 6);
        if (IN(P0 + 7)) {
            pg8::Gemm g{(const bf16_t*)(ws + WS_HA), (const bf16_t*)(ws + WS_WGU), NTOK, 2 * DFF, D};
            pg8::StaticOrder S; S.init(NTOK, 2 * DFF, G, bid); pg8::EpiSwiGLU E{(bf16_t*)(ws + WS_ACT), DFF};
            GEMM_CALL(pg8::EpiSwiGLU, pg8::StaticOrder, g, S, E);
        }
        SEAM(P0 + 7);
        if (IN(P0 + 8)) {
            pg8::Gemm g{(const bf16_t*)(ws + WS_ACT), (const bf16_t*)(ws + WS_WDN), NTOK, D, DFF};
            pg8::StaticOrder S; S.init(NTOK, D, G, bid); pg8::EpiResid E{xs, modl + 10240, 1.0f};
            GEMM_CALL(pg8::EpiResid, pg8::StaticOrder, g, S, E);
        }
#else
        if (IN(P0 + 6)) ph_normmod<false, false, true>(xs, xs + (size_t)NLAT * D, a.in[7], modl, 6144, 8192, (bf16_t*)(ws + WS_HA), NTOK, nullptr, nullptr, nullptr, nullptr);
        SEAM(P0 + 6);
        if (IN(P0 + 7)) {
            pg8::Gemm g{(const bf16_t*)(ws + WS_HA), (const bf16_t*)(ws + WS_WGU), NTOK, 2 * DFF, D / 2};
            pg8::StaticOrder S; S.init(NTOK, 2 * DFF, G, bid); pg8::EpiSwiGLU8 E{(unsigned char*)(ws + WS_ACT), DFF, 1.0f / (ASCALE * WSCALE), ASCALE};
            GEMM_CALL8(pg8::EpiSwiGLU8, pg8::StaticOrder, g, S, E);
        }
        SEAM(P0 + 7);
        if (IN(P0 + 8)) {
            pg8::Gemm g{(const bf16_t*)(ws + WS_ACT), (const bf16_t*)(ws + WS_WDN), NTOK, D, DFF / 2};
            pg8::StaticOrder S; S.init(NTOK, D, G, bid); pg8::EpiResid E{xs, modl + 10240, 1.0f / (ASCALE * WSCALE)};
            GEMM_CALL8(pg8::EpiResid, pg8::StaticOrder, g, S, E);
        }
#endif
        SEAM(P0 + 8);
    } else {
        if (IN(P0 + 6)) ph_normmod<true, false, true>(xs, xs + (size_t)NLAT * D, a.in[7] + D, modl, 6144, 8192, (bf16_t*)(ws + WS_HA), NLAT, nullptr, a.in[29], (int*)(ws + WS_TOPI), (float*)(ws + WS_TOPW));
        SEAM(P0 + 6);
        if (IN(P0 + 7)) ph_route(a, (int*)lds);
        SEAM(P0 + 7);
        if (IN(P0 + 8)) ph_gather(a);
        SEAM(P0 + 8);
        if (IN(P0 + 9)) {
            pg8::Gemm g{(const bf16_t*)(ws + WS_HBS), (const bf16_t*)(ws + WS_MGU), MOE_ROWS, 2 * DFE, D / 2};
            pg8::MoeOrder S; S.init((const int*)(ws + WS_CTL), 2 * DFE / 256, G, bid, (size_t)2 * DFE * D); pg8::EpiSwiGLU8 E{(unsigned char*)(ws + WS_ACT), DFE, 1.0f / (ASCALE * WSCALE), ASCALE};
            GEMM_CALL8(pg8::EpiSwiGLU8, pg8::MoeOrder, g, S, E);
        }
        SEAM(P0 + 9);
        if (IN(P0 + 10)) {
            pg8::Gemm g{(const bf16_t*)(ws + WS_ACT), (const bf16_t*)(ws + WS_MDN), MOE_ROWS, D, DFE / 2};
            pg8::MoeOrder S; S.init((const int*)(ws + WS_CTL), D / 256, G, bid, (size_t)D * DFE); pg8::EpiF32 E{(float*)(ws + WS_YS), D, 1.0f / (ASCALE * WSCALE)};
            GEMM_CALL8(pg8::EpiF32, pg8::MoeOrder, g, S, E);
        }
        SEAM(P0 + 10);
        if (IN(P0 + 11)) ph_final(a);
    }
#undef IN
#undef SEAM
}

__global__ void __launch_bounds__(NTHR, 2) mk_fwd(Args a) {
    extern __shared__ __attribute__((aligned(16))) unsigned char lds[];
    const int tid = threadIdx.x;
    for (int u = tid; u < (LDS_BYTES - LDSCTL_OFF) / 4; u += NTHR) ((unsigned*)(lds + LDSCTL_OFF))[u] = 0u;
    __syncthreads();
    XcdBarrier bar; bar.bar = (unsigned*)(a.ws + WS_CTL) + CW_BAR; bar.x = 0; bar.st = nullptr;
#if !MK_PER_PHASE
    bar = xcd_barrier_post((unsigned*)(a.ws + WS_CTL) + CW_BAR, (volatile LAS unsigned*)(lds + LDSCTL_OFF + 32));
#endif
    const int lo = a.ph_lo, hi = a.ph_hi;
    if (lo <= 0 && 0 < hi) {
        ph_prologue(a, (float*)lds);
#if !MK_PER_PHASE
        if (1 < hi) xcd_barrier(bar);
#endif
    }
    layer_phases<0>(a, lds, bar, lo, hi);
    layer_phases<1>(a, lds, bar, lo, hi);
}

extern "C" void kernel_launch(void* const* d_in, const int* in_sizes, int n_in, void* d_out, int out_size, void* d_ws, size_t ws_size, hipStream_t stream) {
    (void)in_sizes; (void)out_size;
    static int grid = 0;
    if (grid == 0) {
        if (n_in != 34 || ws_size < WS_END) { fprintf(stderr, "kernel_launch: need 34 inputs and >= %zu bytes of workspace (got %d, %zu)\n", (size_t)WS_END, n_in, ws_size); grid = -1; return; }
        int dev = 0, cus = 0, per_cu = 0;
        if (hipGetDevice(&dev) != hipSuccess || hipDeviceGetAttribute(&cus, hipDeviceAttributeMultiprocessorCount, dev) != hipSuccess) { grid = -1; return; }
        if (hipFuncSetAttribute((const void*)mk_fwd, hipFuncAttributeMaxDynamicSharedMemorySize, LDS_BYTES) != hipSuccess) { fprintf(stderr, "kernel_launch: hipFuncSetAttribute failed\n"); grid = -1; return; }
        if (hipOccupancyMaxActiveBlocksPerMultiprocessor(&per_cu, (const void*)mk_fwd, NTHR, LDS_BYTES) != hipSuccess || per_cu < 1) { fprintf(stderr, "kernel_launch: occupancy query says %d blocks per CU\n", per_cu); }
        (void)hipGetLastError();
        grid = cus;
    }
    if (grid < 0) return;
    if (hipMemsetAsync((char*)d_ws + WS_CTL, 0, CTL_ZERO_BYTES, stream) != hipSuccess) return;
    Args a{};
    for (int i = 0; i < 34; ++i) a.in[i] = (const float*)d_in[i];
    a.out = (float*)d_out; a.ws = (unsigned char*)d_ws;
#if MK_PER_PHASE
    for (int p = 0; p < NPHASES; ++p) { a.ph_lo = p; a.ph_hi = p + 1; hipLaunchKernelGGL(mk_fwd, dim3(grid), dim3(NTHR), LDS_BYTES, stream, a); }
#else
    a.ph_lo = 0; a.ph_hi = NPHASES;
    hipLaunchKernelGGL(mk_fwd, dim3(grid), dim3(NTHR), LDS_BYTES, stream, a);
#endif
}
```

```cpp
#include <hip/hip_runtime.h>
#include <stdint.h>
#include <stdio.h>

#ifndef FP8_DENSE
#define FP8_DENSE 0
#endif
#ifndef CONV_FILL
#define CONV_FILL 0
#endif
#ifndef MK_PER_PHASE
#define MK_PER_PHASE 0
#endif

typedef unsigned short bf16_t;
typedef float f32x4 __attribute__((ext_vector_type(4)));
typedef float f32x16 __attribute__((ext_vector_type(16)));
typedef unsigned u32x4 __attribute__((ext_vector_type(4)));
typedef unsigned u32x2 __attribute__((ext_vector_type(2)));
typedef short bf16x8 __attribute__((ext_vector_type(8)));

constexpr int D = 2048, NB = 4, L = 2048, C = 256, NLAT = NB * L, NCTX = NB * C, NTOK = NLAT + NCTX;
constexpr int UW = 3840;
constexpr int O_CQ = 0, O_CKV = 768, O_KPE = 1280, O_HY = 1344, O_SQ = 2880, O_SK = 3392, O_SV = 3520, INW = 3648;
constexpr int QW = 1536, KVW = 2048, DFF = 5632, DFE = 7168, NE = 8;
constexpr int MOE_ROWS = 18432;
constexpr float EPS = 1e-6f;
constexpr int NTHR = 512;
constexpr int HY_RBROW = 4112;

__device__ __forceinline__ float bf2f(bf16_t h) { return __uint_as_float(((unsigned)h) << 16); }
__device__ __forceinline__ bf16_t f2bf(float f) { unsigned u = __float_as_uint(f); u += 0x7fffu + ((u >> 16) & 1u); return (bf16_t)(u >> 16); }
__device__ __forceinline__ float wave_sum(float v) { for (int o = 32; o > 0; o >>= 1) v += __shfl_xor(v, o); return v; }
__device__ __forceinline__ float wave_max(float v) { for (int o = 32; o > 0; o >>= 1) v = fmaxf(v, __shfl_xor(v, o)); return v; }
__device__ __forceinline__ float silu(float x) { return x / (1.0f + __expf(-x)); }
__device__ __forceinline__ int tok_mod(int tok) { return tok < NLAT ? (tok >> 11) : 4; }

constexpr size_t al(size_t x) { return (x + 255) & ~(size_t)255; }
constexpr size_t WS_CTL = 0, CTL_ZERO_BYTES = 65536;
constexpr size_t WS_MOD = 65536;
constexpr size_t WS_ROPE = WS_MOD + al((size_t)2 * 5 * 12288 * 4);
constexpr size_t WS_FILTL = WS_ROPE + al((size_t)2 * 2048 * 32 * 4);
constexpr size_t WS_FILTC = WS_FILTL + al((size_t)2 * 512 * 4096 * 4);
constexpr size_t WS_WIN = WS_FILTC + al((size_t)2 * 512 * 512 * 4);
constexpr size_t WS_WQ = WS_WIN + al((size_t)2 * UW * D * 2);
constexpr size_t WS_WKV = WS_WQ + al((size_t)2 * QW * 768 * 2);
constexpr size_t WS_WOUT = WS_WKV + al((size_t)2 * KVW * 512 * 2);
constexpr size_t WS_WGU = WS_WOUT + al((size_t)2 * D * D * 2);
constexpr size_t WS_WDN = WS_WGU + al((size_t)2 * DFF * D * 2);
constexpr size_t WS_MGU = WS_WDN + al((size_t)D * DFF * 2);
constexpr size_t WS_MDN = WS_MGU + al((size_t)NE * 2 * DFE * D * 2);
constexpr size_t WS_HA = WS_MDN + al((size_t)NE * D * DFE * 2);
constexpr size_t WS_U = WS_HA + al((size_t)NTOK * D * 2);
constexpr size_t WS_CQN = WS_U + al((size_t)NTOK * UW * 2);
constexpr size_t WS_CKVN = WS_CQN + al((size_t)NTOK * 768 * 2);
constexpr size_t WS_KPE = WS_CKVN + al((size_t)NTOK * 512 * 2);
constexpr size_t WS_X0 = WS_KPE + al((size_t)NTOK * 64 * 2);
constexpr size_t WS_WTL = WS_X0 + al((size_t)NTOK * 512 * 2);
constexpr size_t WS_WTC = WS_WTL + al((size_t)NB * 512 * L * 2);
constexpr size_t WS_SQ = WS_WTC + al((size_t)NB * 512 * C * 2);
constexpr size_t WS_SK = WS_SQ + al((size_t)NTOK * 512 * 2);
constexpr size_t WS_SV = WS_SK + al((size_t)NTOK * 128 * 2);
constexpr size_t WS_Q = WS_SV + al((size_t)NTOK * 128 * 2);
constexpr size_t WS_KV = WS_Q + al((size_t)NTOK * QW * 2);
constexpr size_t WS_KN = WS_KV;
constexpr size_t WS_VT = WS_KV + (size_t)NTOK * 1024 * 2;
constexpr size_t WS_MIX = WS_KV + al((size_t)NTOK * KVW * 2);
constexpr size_t WS_MIXEND = WS_MIX + al((size_t)NTOK * D * 2);
constexpr size_t WS_YS = WS_U;
static_assert(WS_YS + (size_t)MOE_ROWS * D * 4 <= WS_MIXEND, "ys overlay");
constexpr size_t WS_XS = WS_MIXEND;
constexpr size_t WS_ACT = WS_XS + al((size_t)NTOK * D * 4);
constexpr size_t WS_HBS = WS_ACT + al((size_t)MOE_ROWS * DFE * 2);
constexpr size_t WS_TOPI = WS_HBS + al((size_t)MOE_ROWS * D * 2);
constexpr size_t WS_TOPW = WS_TOPI + al((size_t)NLAT * 2 * 4);
constexpr size_t WS_POS = WS_TOPW + al((size_t)NLAT * 2 * 4);
constexpr size_t WS_SRC = WS_POS + al((size_t)NLAT * 2 * 4);
constexpr size_t WS_END = WS_SRC + al((size_t)MOE_ROWS * 4);
constexpr int CT_EOFF = 1024, CT_EPAD = 1040, CT_NTILE = 1056;
constexpr int CW_BAR = 4096;

constexpr int RING_BYTES = 131072, LDSCTL_OFF = RING_BYTES, LDS_BYTES = 147456;

namespace pg8 {
#define PG8_LAS __attribute__((address_space(3)))
typedef unsigned short bf16_t;
typedef short bf16x8 __attribute__((ext_vector_type(8)));
typedef float f32x4 __attribute__((ext_vector_type(4)));
typedef unsigned u32x4 __attribute__((ext_vector_type(4)));
constexpr int BM = 256, BK = 64, HALF = 128, HTB = HALF * BK * 2  , STAGE_BYTES = 8 * HTB, NXCD = 8, WGM = 8;

__host__ __device__ __forceinline__ int lds_byte(int r, int c) { const int st = (r >> 4) * 2 + (c >> 5), rr = r & 15, cc = c & 31, ob = rr * 64 + cc * 2; return st * 1024 + (ob ^ (((ob >> 9) & 1) << 5)); }
__host__ __device__ __forceinline__ void stage_rc(int b, int& R, int& C) { const int st = b / 1024, sb = b % 1024, swz = sb ^ (((sb >> 9) & 1) << 5); R = (st >> 1) * 16 + swz / 64; C = (st & 1) * 32 + (swz % 64) / 2; }
__host__ __device__ __forceinline__ int perm32(int rho) { const int n = rho >> 4, i = rho & 15; return 8 * (i >> 2) + 4 * n + (i & 3); }

struct Unit { int pm, pn; };
struct Gemm { const bf16_t* A; const bf16_t* Bt; int M, N, K; };

struct StaticOrder {
    int nM, nN, nwg, G, c;
    __host__ __device__ void init(int M, int N, int G_, int c_) { nM = M / BM; nN = N / BM; nwg = nM * nN; G = G_; c = c_; }
    __host__ __device__ bool next(int i, Unit& u) const {
        const long L = (long)i * G + c; if (L >= nwg) return false;
        int wgid = (int)L; { const int q = nwg / NXCD, r = nwg % NXCD, xcd = wgid % NXCD, off = wgid / NXCD; wgid = (xcd < r ? xcd * (q + 1) : r * (q + 1) + (xcd - r) * q) + off; }
        const int nig = WGM * nN, gid = wgid / nig, fm = gid * WGM, gsz = (nM - fm) < WGM ? (nM - fm) : WGM;
        u.pm = fm + ((wgid % nig) % gsz); u.pn = (wgid % nig) / gsz; return true;
    }
    __device__ __forceinline__ size_t bt_off(const Unit&) const { return 0; }
    __device__ __forceinline__ void a_ready(const Unit&) const {}
    __device__ __forceinline__ void done(const Unit&) const {}
};

__device__ __forceinline__ unsigned cvt_pk_bf16(float lo, float hi) { unsigned r; asm volatile("v_cvt_pk_bf16_f32 %0, %1, %2" : "=v"(r) : "v"(lo), "v"(hi)); return r; }
typedef float f32x2 __attribute__((ext_vector_type(2)));
typedef int v8i_t __attribute__((ext_vector_type(8))); typedef int v4i_t __attribute__((ext_vector_type(4)));
template <bool F8> struct Frag;
template <> struct Frag<false> { bf16x8 h[2]; __device__ __forceinline__ void set0(bf16x8 x) { h[0] = x; } __device__ __forceinline__ void set1(bf16x8 x) { h[1] = x; } };
template <> struct Frag<true> { v8i_t v; __device__ __forceinline__ void set0(bf16x8 x) { v.lo = __builtin_bit_cast(v4i_t, x); } __device__ __forceinline__ void set1(bf16x8 x) { v.hi = __builtin_bit_cast(v4i_t, x); } };
template <class Epi, class Sched, bool ALIGN_EPI = false, bool SP2 = false, bool FP8 = false>
__device__ __forceinline__ void gemm_phase(PG8_LAS unsigned char* lds, const Gemm g, const Sched& S, const Epi& E) {
    int tid_ = threadIdx.x; asm volatile("" : "+v"(tid_));
    const int tid = tid_, wid = __builtin_amdgcn_readfirstlane(tid >> 6), lane = tid & 63, wr = wid >> 2, wc = wid & 3, fr = lane & 15, fq = lane >> 4;
    const int K = g.K, nt = K / BK;
    unsigned voffA[2], voffB[2];
#pragma unroll
    for (int i = 0; i < 2; ++i) { int R, C; stage_rc(tid * 16 + i * 8192, R, C); const int Rb = Epi::PERM ? ((R & ~31) + perm32(R & 31)) : R;
        voffA[i] = (unsigned)(R * K + C) * 2u; voffB[i] = (unsigned)(Rb * K + C) * 2u; }
    const size_t kstep = (size_t)(BK * 2);
    const size_t hstep = (size_t)HALF * K * 2;
    const size_t tstep = 2 * hstep;
    const unsigned ldsw = (unsigned)wid * 1024u;
    const int aoff = lds_byte(wr * 64 + fr, fq * 8), boff = lds_byte(wc * 32 + fr, fq * 8);
#define PG8_SA(b, h) (((b) * 2 + (h)) * HTB)
#define PG8_SB(b, h) ((4 + (b) * 2 + (h)) * HTB)
#define PG8_STAGE(bufoff, gbase, voff) do { _Pragma("unroll") for (int _i = 0; _i < 2; ++_i) \
        __builtin_amdgcn_global_load_lds((const unsigned*)((const char*)(gbase) + (voff)[_i]), (PG8_LAS unsigned*)(lds + (bufoff) + ldsw + _i * 8192), 16, 0, 0); } while (0)
#define PG8_LDA(dst, b, h) do { _Pragma("unroll") for (int m = 0; m < 4; ++m) { dst[m].set0(*(const PG8_LAS bf16x8*)(lds + PG8_SA(b, h) + aoff + m * 2048)); dst[m].set1(*(const PG8_LAS bf16x8*)(lds + PG8_SA(b, h) + aoff + m * 2048 + 1024)); } } while (0)
#define PG8_LDB(dst, b, h) do { _Pragma("unroll") for (int n = 0; n < 2; ++n) { dst[n].set0(*(const PG8_LAS bf16x8*)(lds + PG8_SB(b, h) + boff + n * 2048)); dst[n].set1(*(const PG8_LAS bf16x8*)(lds + PG8_SB(b, h) + boff + n * 2048 + 1024)); } } while (0)
#define PG8_MMA(ai, bj, At, Bt) do { __builtin_amdgcn_s_setprio(1); _Pragma("unroll") for (int m = 0; m < 4; ++m) _Pragma("unroll") for (int n = 0; n < 2; ++n) { \
        if constexpr (FP8) asm volatile("v_mfma_f32_16x16x128_f8f6f4 %0, %1, %2, %0" : "+v"(acc[ai][bj][m][n]) : "v"(Bt[n].v), "v"(At[m].v));   \
        else { _Pragma("unroll") for (int k = 0; k < 2; ++k) acc[ai][bj][m][n] = __builtin_amdgcn_mfma_f32_16x16x32_bf16(Bt[n].h[k], At[m].h[k], acc[ai][bj][m][n], 0, 0, 0); } } \
        __builtin_amdgcn_s_setprio(0); } while (0)
#define PG8_WAIT_V(n) asm volatile("s_waitcnt vmcnt(" #n ")" ::: "memory")
#define PG8_WAIT_L(n) asm volatile("s_waitcnt lgkmcnt(" #n ")" ::: "memory")
#define PG8_BAR __builtin_amdgcn_s_barrier()
#define PG8_SCHED __builtin_amdgcn_sched_barrier(0)
    Unit cur, nxt; int ui = 0;
    if (!S.next(0, cur)) return;
    f32x4 acc[2][2][4][2];
#pragma unroll
    for (int a = 0; a < 2; ++a)
#pragma unroll
        for (int b = 0; b < 2; ++b)
#pragma unroll
            for (int m = 0; m < 4; ++m)
#pragma unroll
                for (int n = 0; n < 2; ++n) acc[a][b][m][n] = (f32x4){0.f, 0.f, 0.f, 0.f};
    Frag<FP8> At[4], B0[2], B1[2];
    const char* cA = (const char*)g.A + (size_t)cur.pm * tstep; const char* cB = (const char*)g.Bt + S.bt_off(cur) + (size_t)cur.pn * tstep;
    S.a_ready(cur);
    if constexpr (SP2) {
        PG8_STAGE(PG8_SB(0, 0), cB, voffB); PG8_STAGE(PG8_SB(0, 1), cB + hstep, voffB); PG8_STAGE(PG8_SA(0, 0), cA, voffA); PG8_STAGE(PG8_SA(0, 1), cA + hstep, voffA);
        if (wr == 1) PG8_BAR;
        PG8_WAIT_V(2); PG8_BAR;
        PG8_STAGE(PG8_SB(1, 0), cB + kstep, voffB); PG8_STAGE(PG8_SA(1, 0), cA + kstep, voffA); PG8_STAGE(PG8_SB(1, 1), cB + hstep + kstep, voffB);
        PG8_WAIT_V(6); PG8_BAR;
    } else {
        PG8_STAGE(PG8_SB(0, 0), cB, voffB); PG8_STAGE(PG8_SA(0, 0), cA, voffA); PG8_STAGE(PG8_SB(0, 1), cB + hstep, voffB); PG8_STAGE(PG8_SA(0, 1), cA + hstep, voffA);
        if (wr == 1) PG8_BAR;
        PG8_WAIT_V(4); PG8_BAR;
        PG8_STAGE(PG8_SB(1, 0), cB + kstep, voffB); PG8_STAGE(PG8_SA(1, 0), cA + kstep, voffA); PG8_STAGE(PG8_SB(1, 1), cB + hstep + kstep, voffB);
        PG8_WAIT_V(6); PG8_BAR;
    }
    for (;;) {
        const bool has_next = S.next(ui + 1, nxt);
        const char* nA = has_next ? (const char*)g.A + (size_t)nxt.pm * tstep : cA; const char* nB = has_next ? (const char*)g.Bt + S.bt_off(nxt) + (size_t)nxt.pn * tstep : cB;
        for (int t = 0; t < nt; t += 2) {
            const bool last = (t == nt - 2);
            const char* a1 = cA + (size_t)(t + 1) * kstep;
            const char* a2 = last ? nA : cA + (size_t)(t + 2) * kstep; const char* b2 = last ? nB : cB + (size_t)(t + 2) * kstep;
            const char* a3 = a2 + kstep; const char* b3 = b2 + kstep;
            if (last && has_next) S.a_ready(nxt);
            if constexpr (SP2) {
            PG8_LDB(B0, 0, 0); PG8_LDB(B1, 0, 1); PG8_SCHED; PG8_LDA(At, 0, 0); PG8_STAGE(PG8_SA(1, 1), a1 + hstep, voffA);
            PG8_WAIT_V(8); PG8_WAIT_L(0); PG8_BAR; PG8_MMA(0, 0, At, B0); PG8_MMA(0, 1, At, B1); PG8_BAR; PG8_SCHED;
            PG8_LDA(At, 0, 1); PG8_STAGE(PG8_SB(0, 0), b2, voffB); PG8_STAGE(PG8_SB(0, 1), b2 + hstep, voffB); PG8_STAGE(PG8_SA(0, 0), a2, voffA);
            PG8_WAIT_V(8); PG8_WAIT_L(0); PG8_BAR; PG8_MMA(1, 0, At, B0); PG8_MMA(1, 1, At, B1); PG8_BAR; PG8_SCHED;
            PG8_LDB(B0, 1, 0); PG8_LDB(B1, 1, 1); PG8_SCHED; PG8_LDA(At, 1, 0); PG8_STAGE(PG8_SA(0, 1), a2 + hstep, voffA);
            PG8_WAIT_V(8); PG8_WAIT_L(0); PG8_BAR; PG8_MMA(0, 0, At, B0); PG8_MMA(0, 1, At, B1); PG8_BAR; PG8_SCHED;
            PG8_LDA(At, 1, 1); PG8_STAGE(PG8_SB(1, 0), b3, voffB); PG8_STAGE(PG8_SB(1, 1), b3 + hstep, voffB); PG8_STAGE(PG8_SA(1, 0), a3, voffA);
            PG8_WAIT_V(8); PG8_WAIT_L(0); PG8_BAR; PG8_MMA(1, 0, At, B0); PG8_MMA(1, 1, At, B1); PG8_BAR; PG8_SCHED;
            } else {
            PG8_LDB(B0, 0, 0); PG8_SCHED; PG8_LDA(At, 0, 0); PG8_STAGE(PG8_SA(1, 1), a1 + hstep, voffA);
            PG8_WAIT_L(8); PG8_BAR; PG8_WAIT_L(0); PG8_MMA(0, 0, At, B0); PG8_BAR; PG8_SCHED;
            PG8_LDB(B1, 0, 1); PG8_STAGE(PG8_SB(0, 0), b2, voffB);
            PG8_BAR; PG8_WAIT_L(0); PG8_MMA(0, 1, At, B1); PG8_BAR;
            PG8_LDA(At, 0, 1); PG8_STAGE(PG8_SA(0, 0), a2, voffA);
            PG8_BAR; PG8_WAIT_L(0); PG8_MMA(1, 0, At, B0); PG8_BAR; PG8_SCHED;
            PG8_STAGE(PG8_SB(0, 1), b2 + hstep, voffB);
            PG8_WAIT_V(6); PG8_BAR; PG8_MMA(1, 1, At, B1); PG8_BAR;
            PG8_LDB(B0, 1, 0); PG8_SCHED; PG8_LDA(At, 1, 0); PG8_STAGE(PG8_SA(0, 1), a2 + hstep, voffA);
            PG8_WAIT_L(8); PG8_BAR; PG8_WAIT_L(0); PG8_MMA(0, 0, At, B0); PG8_BAR; PG8_SCHED;
            PG8_LDB(B1, 1, 1); PG8_STAGE(PG8_SB(1, 0), b3, voffB);
            PG8_BAR; PG8_WAIT_L(0); PG8_MMA(0, 1, At, B1); PG8_BAR;
            PG8_LDA(At, 1, 1); PG8_STAGE(PG8_SA(1, 0), a3, voffA);
            PG8_BAR; PG8_WAIT_L(0); PG8_MMA(1, 0, At, B0); PG8_BAR; PG8_SCHED;
            PG8_STAGE(PG8_SB(1, 1), b3 + hstep, voffB);
            PG8_WAIT_V(6); PG8_BAR; PG8_MMA(1, 1, At, B1); PG8_BAR;
            }
        }
        if constexpr (ALIGN_EPI) { if (wr == 0) PG8_BAR; }
        if constexpr (FP8) asm volatile("s_nop 15\n\ts_nop 15" ::: "memory");
        if constexpr (!Epi::AFTER_DRAIN) { E(acc, cur, wr, wc, fr, fq); S.done(cur); }
        if (!has_next) break;
#pragma unroll
        for (int a = 0; a < 2; ++a)
#pragma unroll
            for (int b = 0; b < 2; ++b)
#pragma unroll
                for (int m = 0; m < 4; ++m)
#pragma unroll
                    for (int n = 0; n < 2; ++n) acc[a][b][m][n] = (f32x4){0.f, 0.f, 0.f, 0.f};
        cur = nxt; cA = nA; cB = nB; ++ui;
        if constexpr (ALIGN_EPI) { if (wr == 1) PG8_BAR; }
    }
    PG8_WAIT_V(0);
    if constexpr (!ALIGN_EPI) { if (wr == 0) PG8_BAR; }
    PG8_BAR;
    if constexpr (Epi::AFTER_DRAIN) { E.fused(acc, cur, wr, wc, fr, fq, lds, wid, lane); S.done(cur); }
#undef PG8_SA
#undef PG8_SB
#undef PG8_STAGE
#undef PG8_LDA
#undef PG8_LDB
#undef PG8_MMA
#undef PG8_WAIT_V
#undef PG8_WAIT_L
#undef PG8_BAR
#undef PG8_SCHED
}
}

namespace pg8 {
__device__ __forceinline__ u32x4 pack8(const f32x4 v0, const f32x4 v1) { u32x4 w; w.x = cvt_pk_bf16(v0[0], v0[1]); w.y = cvt_pk_bf16(v0[2], v0[3]); w.z = cvt_pk_bf16(v1[0], v1[1]); w.w = cvt_pk_bf16(v1[2], v1[3]); return w; }
struct EpiStore {
    static constexpr bool PERM = true, AFTER_DRAIN = false;
    bf16_t* O; int ldc;
    __device__ __forceinline__ void operator()(const f32x4 (&acc)[2][2][4][2], const Unit& u, int wr, int wc, int fr, int fq) const {
        const int row0 = u.pm * BM + wr * 64 + fr, col0 = u.pn * BM + wc * 32 + 8 * fq;
#pragma unroll
        for (int ai = 0; ai < 2; ++ai)
#pragma unroll
            for (int m = 0; m < 4; ++m) { bf16_t* rowp = O + (size_t)(row0 + ai * HALF + m * 16) * ldc + col0;
#pragma unroll
                for (int bj = 0; bj < 2; ++bj) *(u32x4*)(rowp + bj * HALF) = pack8(acc[ai][bj][m][0], acc[ai][bj][m][1]); }
    }
};
struct EpiQ {
    static constexpr bool PERM = true, AFTER_DRAIN = false;
    bf16_t* O; const float* cosT; const float* sinT;
    __device__ __forceinline__ void operator()(const f32x4 (&acc)[2][2][4][2], const Unit& u, int wr, int wc, int fr, int fq) const {
        const int row0 = u.pm * BM + wr * 64 + fr, col0 = u.pn * BM + wc * 32 + 8 * fq;
#pragma unroll
        for (int ai = 0; ai < 2; ++ai)
#pragma unroll
            for (int m = 0; m < 4; ++m) { const int row = row0 + ai * HALF + m * 16; const bool lat = row < 8192; const int t = row & 2047;
#pragma unroll
                for (int bj = 0; bj < 2; ++bj) { const int col = col0 + bj * HALF; const int jn = col - 192 * (col / 192);
                    f32x4 v0 = acc[ai][bj][m][0], v1 = acc[ai][bj][m][1];
                    if (jn >= 128 && lat) { const int i0 = (jn - 128) >> 1;
                        const f32x4 cs = *(const f32x4*)(cosT + t * 32 + i0), sn = *(const f32x4*)(sinT + t * 32 + i0);
                        f32x4 r0, r1;
                        r0[0] = v0[0] * cs[0] - v0[1] * sn[0]; r0[1] = v0[0] * sn[0] + v0[1] * cs[0];
                        r0[2] = v0[2] * cs[1] - v0[3] * sn[1]; r0[3] = v0[2] * sn[1] + v0[3] * cs[1];
                        r1[0] = v1[0] * cs[2] - v1[1] * sn[2]; r1[1] = v1[0] * sn[2] + v1[1] * cs[2];
                        r1[2] = v1[2] * cs[3] - v1[3] * sn[3]; r1[3] = v1[2] * sn[3] + v1[3] * cs[3];
                        v0 = r0; v1 = r1; }
                    *(u32x4*)(O + (size_t)row * 1536 + col) = pack8(v0, v1); } }
    }
};
struct EpiResid {
    static constexpr bool PERM = false, AFTER_DRAIN = false;
    float* xs; const float* gate; float scale;
    __device__ __forceinline__ void operator()(const f32x4 (&acc)[2][2][4][2], const Unit& u, int wr, int wc, int fr, int fq) const {
        const int row0 = u.pm * BM + wr * 64 + fr, colb = u.pn * BM + wc * 32 + 4 * fq;
#pragma unroll
        for (int ai = 0; ai < 2; ++ai)
#pragma unroll
            for (int m = 0; m < 4; ++m) { const int row = row0 + ai * HALF + m * 16; const float* gv = gate + (size_t)(row < 8192 ? (row >> 11) : 4) * 12288; float* xr = xs + (size_t)row * 2048;
#pragma unroll
                for (int bj = 0; bj < 2; ++bj)
#pragma unroll
                    for (int n = 0; n < 2; ++n) { const int col = colb + bj * HALF + n * 16; f32x4 x = *(const f32x4*)(xr + col); const f32x4 g = *(const f32x4*)(gv + col);
                        x += (g * scale) * acc[ai][bj][m][n]; *(f32x4*)(xr + col) = x; }
                if (m & 1) asm volatile("" ::: "memory"); }
    }
};
__device__ __forceinline__ unsigned pack4_fp8(float a, float b, float c, float d) {
    a = fminf(fmaxf(a, -448.f), 448.f); b = fminf(fmaxf(b, -448.f), 448.f); c = fminf(fmaxf(c, -448.f), 448.f); d = fminf(fmaxf(d, -448.f), 448.f);
    unsigned w = 0; w = __builtin_amdgcn_cvt_pk_fp8_f32(a, b, w, false); w = __builtin_amdgcn_cvt_pk_fp8_f32(c, d, w, true); return w; }
struct EpiSwiGLU8 {
    static constexpr bool PERM = true, AFTER_DRAIN = false;
    unsigned char* O; int ldc; float s, oscale;
    __device__ __forceinline__ void operator()(const f32x4 (&acc)[2][2][4][2], const Unit& u, int wr, int wc, int fr, int fq) const {
        const int row0 = u.pm * BM + wr * 64 + fr, col0 = u.pn * HALF + wc * 32 + 8 * fq;
#pragma unroll
        for (int ai = 0; ai < 2; ++ai)
#pragma unroll
            for (int m = 0; m < 4; ++m) { f32x4 o0, o1;
#pragma unroll
                for (int j = 0; j < 4; ++j) { const float g0 = acc[ai][0][m][0][j] * s, g1 = acc[ai][0][m][1][j] * s;
                    o0[j] = g0 / (1.0f + __expf(-g0)) * (acc[ai][1][m][0][j] * (s * oscale)); o1[j] = g1 / (1.0f + __expf(-g1)) * (acc[ai][1][m][1][j] * (s * oscale)); }
                u32x2 w; w.x = pack4_fp8(o0[0], o0[1], o0[2], o0[3]); w.y = pack4_fp8(o1[0], o1[1], o1[2], o1[3]);
                *(u32x2*)(O + (size_t)(row0 + ai * HALF + m * 16) * ldc + col0) = w; }
    }
};
struct EpiSwiGLU {
    static constexpr bool PERM = true, AFTER_DRAIN = false;
    bf16_t* O; int ldc;
    __device__ __forceinline__ void operator()(const f32x4 (&acc)[2][2][4][2], const Unit& u, int wr, int wc, int fr, int fq) const {
        const int row0 = u.pm * BM + wr * 64 + fr, col0 = u.pn * HALF + wc * 32 + 8 * fq;
#pragma unroll
        for (int ai = 0; ai < 2; ++ai)
#pragma unroll
            for (int m = 0; m < 4; ++m) { f32x4 o0, o1;
#pragma unroll
                for (int j = 0; j < 4; ++j) { const float g0 = acc[ai][0][m][0][j], g1 = acc[ai][0][m][1][j];
                    o0[j] = g0 / (1.0f + __expf(-g0)) * acc[ai][1][m][0][j]; o1[j] = g1 / (1.0f + __expf(-g1)) * acc[ai][1][m][1][j]; }
                *(u32x4*)(O + (size_t)(row0 + ai * HALF + m * 16) * ldc + col0) = pack8(o0, o1); }
    }
};
struct EpiF32 {
    static constexpr bool PERM = false, AFTER_DRAIN = false;
    float* O; int ldc; float scale;
    __device__ __forceinline__ void operator()(const f32x4 (&acc)[2][2][4][2], const Unit& u, int wr, int wc, int fr, int fq) const {
        const int row0 = u.pm * BM + wr * 64 + fr, colb = u.pn * BM + wc * 32 + 4 * fq;
#pragma unroll
        for (int ai = 0; ai < 2; ++ai)
#pragma unroll
            for (int m = 0; m < 4; ++m) { float* xr = O + (size_t)(row0 + ai * HALF + m * 16) * ldc;
#pragma unroll
                for (int bj = 0; bj < 2; ++bj)
#pragma unroll
                    for (int n = 0; n < 2; ++n) *(f32x4*)(xr + colb + bj * HALF + n * 16) = acc[ai][bj][m][n] * scale; }
    }
};
struct MoeOrder {
    int nM, nN, nwg, G, c; int t1[8]; size_t estride;
    __device__ __forceinline__ void init(const int* ctl, int nN_, int G_, int c_, size_t estride_) {
        int acc = 0;
#pragma unroll
        for (int e = 0; e < 8; ++e) { acc += ctl[CT_EPAD + e] >> 8; t1[e] = acc; }
        nM = acc; nN = nN_; nwg = nM * nN; G = G_; c = c_; estride = estride_;
    }
    __device__ __forceinline__ bool next(int i, Unit& u) const {
        const long L = (long)i * G + c; if (L >= nwg) return false;
        int wgid = (int)L; { const int q = nwg / NXCD, r = nwg % NXCD, xcd = wgid % NXCD, off = wgid / NXCD; wgid = (xcd < r ? xcd * (q + 1) : r * (q + 1) + (xcd - r) * q) + off; }
        const int nig = WGM * nN, gid = wgid / nig, fm = gid * WGM, gsz = (nM - fm) < WGM ? (nM - fm) : WGM;
        u.pm = fm + ((wgid % nig) % gsz); u.pn = (wgid % nig) / gsz; return true;
    }
    __device__ __forceinline__ size_t bt_off(const Unit& u) const { int e = 0;
#pragma unroll
        for (int k = 0; k < 7; ++k) e += (u.pm >= t1[k]) ? 1 : 0;
        return (size_t)e * estride; }
    __device__ __forceinline__ void a_ready(const Unit&) const {}
    __device__ __forceinline__ void done(const Unit&) const {}
};
}

#define LAS __attribute__((address_space(3)))
#define XB_TMO      128
#define XB_XCNT(j)  (256  + 64 * (j))
#define XB_XSUB(j)  (1280 + 64 * (j))
#define XB_XGEN(j)  (2304 + 64 * (j))
#define XB_TOP      3328
#define XB_TOPGEN   3392
#define XCD_BAR_WORDS 3456
#define XB_SPIN_CAP (1u << 18)

__device__ __forceinline__ unsigned xb_ld(unsigned* p)              { return __hip_atomic_load(p, __ATOMIC_RELAXED, __HIP_MEMORY_SCOPE_AGENT); }
__device__ __forceinline__ unsigned xb_add(unsigned* p, unsigned v) { return __hip_atomic_fetch_add(p, v, __ATOMIC_RELAXED, __HIP_MEMORY_SCOPE_AGENT); }
__device__ __forceinline__ unsigned xb_xcc_id() { return (unsigned)__builtin_amdgcn_s_getreg((3 << 11) | 20) & 0xFu; }
#define XB_SPIN(cond, bar) do { unsigned _sp = 0; while (cond) { __builtin_amdgcn_s_sleep(1); \
    if ((++_sp & 255u) == 0u) { if (xb_ld(&(bar)[XB_TMO])) break; if (_sp > XB_SPIN_CAP) { atomicAdd(&(bar)[XB_TMO], 1u); break; } } } } while (0)

struct XcdBarrier {
    unsigned* bar; unsigned x;
    volatile LAS unsigned* st;
};

__device__ __forceinline__ XcdBarrier xcd_barrier_post(unsigned* bar, volatile LAS unsigned* st) {
    XcdBarrier b; b.bar = bar; b.x = xb_xcc_id(); b.st = st;
    if (threadIdx.x == 0) (void)xb_add(&bar[XB_XCNT(b.x)], 1u);
    return b;
}
__device__ __forceinline__ void xcd_barrier_complete(unsigned* bar, unsigned x, unsigned& nloc, unsigned& nx) {
    const unsigned G = gridDim.x * gridDim.y * gridDim.z;
    unsigned sum, cnt, mine, sp = 0u;
    for (;;) {
        sum = 0u; cnt = 0u; mine = 0u;
#pragma unroll
        for (unsigned j = 0; j < 16; ++j) { const unsigned c = xb_ld(&bar[XB_XCNT(j)]); sum += c; cnt += (c > 0u) ? 1u : 0u; mine = (j == x) ? c : mine; }
        if (sum == G) break;
        __builtin_amdgcn_s_sleep(1);
        if ((++sp & 255u) == 0u) { if (xb_ld(&bar[XB_TMO])) break; if (sp > XB_SPIN_CAP) { atomicAdd(&bar[XB_TMO], 1u); break; } }
    }
    nloc = mine > 0u ? mine : 1u; nx = cnt > 0u ? cnt : 1u;
}

__device__ __forceinline__ void xcd_barrier(const XcdBarrier& b) {
    asm volatile("s_waitcnt vmcnt(0)" ::: "memory");
    __syncthreads();
    if (threadIdx.x == 0) {
        unsigned* bar = b.bar;
        __builtin_amdgcn_s_waitcnt(0);
        unsigned nloc = b.st[0], nx = b.st[1];
        if (nloc == 0u) { xcd_barrier_complete(bar, b.x, nloc, nx); b.st[0] = nloc; b.st[1] = nx; }
        const unsigned old = xb_add(&bar[XB_XSUB(b.x)], 1u);
        const unsigned gen = old / nloc;
        if (old + 1u == (gen + 1u) * nloc) {
            __builtin_amdgcn_fence(__ATOMIC_RELEASE, "agent");
            asm volatile("s_waitcnt vmcnt(0)" ::: "memory");
            const unsigned og = xb_add(&bar[XB_TOP], 1u);
            const unsigned tg = og / nx;
            if (og + 1u == (tg + 1u) * nx) xb_add(&bar[XB_TOPGEN], 1u);
            else XB_SPIN(xb_ld(&bar[XB_TOPGEN]) == tg, bar);
            __builtin_amdgcn_fence(__ATOMIC_ACQUIRE, "agent");
            xb_add(&bar[XB_XGEN(b.x)], 1u);
            asm volatile("s_waitcnt vmcnt(0)" ::: "memory");
        } else {
            XB_SPIN(xb_ld(&bar[XB_XGEN(b.x)]) == gen, bar);
            __builtin_amdgcn_fence(__ATOMIC_ACQUIRE, "agent");
            asm volatile("s_waitcnt vmcnt(0)" ::: "memory");
        }
    }
    __syncthreads();
}


struct Args { const float* in[34]; float* out; unsigned char* ws; int ph_lo, ph_hi; };

enum { MAP_ID = 0, MAP_ROPEQ = 1, MAP_GU0 = 2, MAP_GU1 = 3, MAP_KV = 4 };
struct JobDesc { int in_idx, K, N, nbatch, upb, map; long long src_off, src_bstride, dst_off, dst_bstride; int fp8, pad; };
constexpr int NJOBS = 14, NCONV = 50624;
__constant__ JobDesc c_jobs[NJOBS] = {
    {8, 2048, 3648, 1, 912, MAP_ID, 0, 0, (long long)WS_WIN, 0},
    {8, 2048, 3648, 1, 912, MAP_ID, 2048LL * 3648, 0, (long long)(WS_WIN + (size_t)UW * D * 2), 0},
    {10, 768, 1536, 1, 144, MAP_ROPEQ, 0, 0, (long long)WS_WQ, 0},
    {10, 768, 1536, 1, 144, MAP_ROPEQ, 768LL * 1536, 0, (long long)(WS_WQ + (size_t)QW * 768 * 2), 0},
    {12, 512, 2048, 1, 128, MAP_KV, 0, 0, (long long)WS_WKV, 0},
    {12, 512, 2048, 1, 128, MAP_KV, 512LL * 2048, 0, (long long)(WS_WKV + (size_t)KVW * 512 * 2), 0},
    {25, 2048, 2048, 1, 512, MAP_ID, 0, 0, (long long)WS_WOUT, 0},
    {25, 2048, 2048, 1, 512, MAP_ID, 2048LL * 2048, 0, (long long)(WS_WOUT + (size_t)D * D * 2), 0},
    {26, 2048, 5632, 1, 1408, MAP_GU0, 0, 0, (long long)WS_WGU, 0, FP8_DENSE, 0},
    {27, 2048, 5632, 1, 1408, MAP_GU1, 0, 0, (long long)WS_WGU, 0, FP8_DENSE, 0},
    {28, 5632, 2048, 1, 1408, MAP_ID, 0, 0, (long long)WS_WDN, 0, FP8_DENSE, 0},
    {30, 2048, 7168, 8, 1792, MAP_GU0, 0, 2048LL * 7168, (long long)WS_MGU, 2LL * DFE * D, 1, 0},
    {31, 2048, 7168, 8, 1792, MAP_GU1, 0, 2048LL * 7168, (long long)WS_MGU, 2LL * DFE * D, 1, 0},
    {32, 7168, 2048, 8, 1792, MAP_ID, 0, 7168LL * 2048, (long long)WS_MDN, (long long)D * DFE, 1, 0},
};
struct ConvUnit { const float* src; bf16_t* dst; int K, N, map, k0, n0, fp8; };
constexpr float WSCALE = 64.f, ASCALE = 8.f;
__device__ __forceinline__ void conv_decode(const Args& a, int u, ConvUnit& cu) {
    int j = 0, base = 0;
    for (;;) { const int n = c_jobs[j].nbatch * c_jobs[j].upb; if (u < base + n || j == NJOBS - 1) break; base += n; ++j; }
    const JobDesc& jd = c_jobs[j];
    int r = u - base; const int bt = r / jd.upb; r -= bt * jd.upb; const int ntn = jd.N >> 6; const int kt = r / ntn, nt = r - kt * ntn;
    cu.K = jd.K; cu.N = jd.N; cu.map = jd.map; cu.k0 = kt * 128; cu.n0 = nt * 64; cu.fp8 = jd.fp8;
    const float* sb = j < 2 ? a.in[8] : j < 4 ? a.in[10] : j < 6 ? a.in[12] : j < 8 ? a.in[25] : j == 8 ? a.in[26] : j == 9 ? a.in[27] : j == 10 ? a.in[28] : j == 11 ? a.in[30] : j == 12 ? a.in[31] : a.in[32];
    cu.src = sb + jd.src_off + (long long)bt * jd.src_bstride + (size_t)cu.k0 * jd.N + cu.n0;
    cu.dst = (bf16_t*)(a.ws + jd.dst_off + (long long)bt * jd.dst_bstride);
}
__device__ __forceinline__ int conv_row(int map, int n) {
    if (map == MAP_ID) return n;
    if (map == MAP_GU0) return ((n >> 7) << 8) + (n & 127);
    if (map == MAP_GU1) return ((n >> 7) << 8) + 128 + (n & 127);
    if (map == MAP_KV) { const int hh = n >> 8, jn = n & 255; return jn < 128 ? hh * 128 + jn : 1024 + hh * 128 + (jn - 128); }
    const int hh = n / 192, jn = n - hh * 192; if (jn < 128) return n; const int q = jn - 128; return hh * 192 + 128 + 2 * (q & 31) + (q >> 5);
}
#define CONV_LOAD(R, CU) do { _Pragma("unroll") for (int i_ = 0; i_ < 4; ++i_) { const int idx_ = tid + 512 * i_; R[i_] = __builtin_nontemporal_load((const f32x4*)((CU).src + (size_t)(idx_ >> 4) * (CU).N + (idx_ & 15) * 4)); } } while (0)
#define CONV_PUT(R, T) do { _Pragma("unroll") for (int i_ = 0; i_ < 4; ++i_) { const int idx_ = tid + 512 * i_; float* tp_ = (T) + (idx_ >> 4) * 65 + (idx_ & 15) * 4; tp_[0] = R[i_][0]; tp_[1] = R[i_][1]; tp_[2] = R[i_][2]; tp_[3] = R[i_][3]; } } while (0)
__device__ __forceinline__ void conv_out(const ConvUnit& cur, const float* tile, int tid) {
    const int nl = tid >> 3; const int row = conv_row(cur.map, cur.n0 + nl);
    if (cur.fp8) { const int kc = tid & 7; const float* tp = tile + (kc * 16) * 65 + nl; u32x4 w;
        w.x = pg8::pack4_fp8(tp[0] * WSCALE, tp[65] * WSCALE, tp[130] * WSCALE, tp[195] * WSCALE); w.y = pg8::pack4_fp8(tp[260] * WSCALE, tp[325] * WSCALE, tp[390] * WSCALE, tp[455] * WSCALE);
        w.z = pg8::pack4_fp8(tp[520] * WSCALE, tp[585] * WSCALE, tp[650] * WSCALE, tp[715] * WSCALE); w.w = pg8::pack4_fp8(tp[780] * WSCALE, tp[845] * WSCALE, tp[910] * WSCALE, tp[975] * WSCALE);
        __builtin_nontemporal_store(w, (u32x4*)((unsigned char*)cur.dst + (size_t)row * cur.K + cur.k0 + kc * 16)); }
    else
#pragma unroll
    for (int j = 0; j < 2; ++j) { const int kc = (tid & 7) + 8 * j; const float* tp = tile + (kc * 8) * 65 + nl;
        u32x4 w; w.x = pg8::cvt_pk_bf16(tp[0], tp[65]); w.y = pg8::cvt_pk_bf16(tp[130], tp[195]); w.z = pg8::cvt_pk_bf16(tp[260], tp[325]); w.w = pg8::cvt_pk_bf16(tp[390], tp[455]);
        __builtin_nontemporal_store(w, (u32x4*)(cur.dst + (size_t)row * cur.K + cur.k0 + kc * 8)); }
}
__device__ __forceinline__ void ph_convert(const Args& a, float* tile, int first, int stride, int end) {
    const int tid = threadIdx.x;
    float* tile0 = tile; float* tile1 = tile + 128 * 65 + 16;
    int u = first; ConvUnit cuA, cuB; f32x4 rA[4], rB[4];
    if (u < end) { conv_decode(a, u, cuA); CONV_LOAD(rA, cuA); }
    if (u + stride < end) { conv_decode(a, u + stride, cuB); CONV_LOAD(rB, cuB); }
    while (u < end) {
        CONV_PUT(rA, tile0);
        __syncthreads();
        { const ConvUnit cur = cuA; const int un = u + 2 * stride; if (un < end) { conv_decode(a, un, cuA); CONV_LOAD(rA, cuA); } conv_out(cur, tile0, tid); }
        u += stride; if (u >= end) break;
        CONV_PUT(rB, tile1);
        __syncthreads();
        { const ConvUnit cur = cuB; const int un = u + 2 * stride; if (un < end) { conv_decode(a, un, cuB); CONV_LOAD(rB, cuB); } conv_out(cur, tile1, tid); }
        u += stride;
    }
    __syncthreads();
}
#undef CONV_LOAD
#undef CONV_PUT
constexpr int CONV_STATIC = 3392, CONV_DENSE_END = 7616, CONV_BATCH = 8;
constexpr int CT_QNEXT = 1152;
__device__ __forceinline__ constexpr int CT_DONE(int k) { return 1216 + 64 * k; }
__device__ __forceinline__ void conv_fill(const Args& a, float* tile, int done_idx) {
#if !CONV_FILL
    (void)a; (void)tile; (void)done_idx; return;
#endif
    unsigned* ctl = (unsigned*)(a.ws + WS_CTL); volatile int* bc = (volatile int*)(tile + 2 * (128 * 65 + 16) + 4);
    const int tid = threadIdx.x;
    if (tid == 0) (void)__hip_atomic_fetch_add(ctl + CT_DONE(done_idx), 1u, __ATOMIC_RELAXED, __HIP_MEMORY_SCOPE_AGENT);
    for (;;) {
        if (tid == 0) { int q = -1;
            if (__hip_atomic_load(ctl + CT_DONE(done_idx), __ATOMIC_RELAXED, __HIP_MEMORY_SCOPE_AGENT) < gridDim.x) {
                q = (int)__hip_atomic_fetch_add(ctl + CT_QNEXT, (unsigned)CONV_BATCH, __ATOMIC_RELAXED, __HIP_MEMORY_SCOPE_AGENT) + CONV_STATIC; if (q >= NCONV) q = -1; }
            *bc = q; }
        __syncthreads();
        const int q = *bc;
        __syncthreads();
        if (q < 0) break;
        ph_convert(a, tile, q, 1, (q + CONV_BATCH < NCONV) ? q + CONV_BATCH : NCONV);
    }
}
__device__ __forceinline__ void conv_finish(const Args& a, float* tile, int upto) {
#if !CONV_FILL
    (void)a; (void)tile; (void)upto; return;
#endif
    unsigned* ctl = (unsigned*)(a.ws + WS_CTL); volatile int* bc = (volatile int*)(tile + 2 * (128 * 65 + 16) + 4);
    const int tid = threadIdx.x;
    for (;;) {
        if (tid == 0) { int q = -1;
            if ((int)__hip_atomic_load(ctl + CT_QNEXT, __ATOMIC_RELAXED, __HIP_MEMORY_SCOPE_AGENT) + CONV_STATIC < upto) {
                q = (int)__hip_atomic_fetch_add(ctl + CT_QNEXT, (unsigned)CONV_BATCH, __ATOMIC_RELAXED, __HIP_MEMORY_SCOPE_AGENT) + CONV_STATIC; if (q >= NCONV) q = -1; }
            *bc = q; }
        __syncthreads();
        const int q = *bc;
        __syncthreads();
        if (q < 0) break;
        ph_convert(a, tile, q, 1, (q + CONV_BATCH < NCONV) ? q + CONV_BATCH : NCONV);
    }
}
__device__ __forceinline__ void adaln_unit(const Args& a, int unit, float* sm) {
    const float* c = a.in[1]; const float* cctx = a.in[3]; const float* w_mod = a.in[4]; const float* b_mod = a.in[5]; float* mod = (float*)(a.ws + WS_MOD);
    const int tid = threadIdx.x, l = unit / 96, chunk = unit % 96;
    const int cg = tid & 31, ks = tid >> 5;
    for (int i = tid; i < 5 * 2048; i += 512) { const int v = i >> 11, k = i & 2047; const float val = v < 4 ? c[v * 2048 + k] : cctx[k]; sm[i] = val / (1.0f + expf(-val)); }
    __syncthreads();
    float acc[5][4];
#pragma unroll
    for (int v = 0; v < 5; ++v)
#pragma unroll
        for (int j = 0; j < 4; ++j) acc[v][j] = 0.f;
    const float* wp = w_mod + ((size_t)l * 2048 + (size_t)ks * 128) * 12288 + chunk * 128 + cg * 4;
#pragma unroll 4
    for (int kk = 0; kk < 128; ++kk) {
        const f32x4 w = *(const f32x4*)(wp + (size_t)kk * 12288);
        const int k = ks * 128 + kk;
#pragma unroll
        for (int v = 0; v < 5; ++v) { const float s = sm[v * 2048 + k];
#pragma unroll
            for (int j = 0; j < 4; ++j) acc[v][j] += s * w[j]; }
    }
    __syncthreads();
#pragma unroll
    for (int v = 0; v < 5; ++v)
#pragma unroll
        for (int j = 0; j < 4; ++j) sm[(ks * 5 + v) * 128 + cg * 4 + j] = acc[v][j];
    __syncthreads();
    for (int o = tid; o < 640; o += 512) {
        const int v = o >> 7, cc = o & 127; float s = 0.f;
        for (int k2 = 0; k2 < 16; ++k2) s += sm[(k2 * 5 + v) * 128 + cc];
        mod[((size_t)l * 5 + v) * 12288 + chunk * 128 + cc] = s + b_mod[(size_t)l * 12288 + chunk * 128 + cc];
    }
    __syncthreads();
}
__device__ __forceinline__ void filters_unit(const Args& a, int unit, float* sm) {
    float (*zs)[36] = (float (*)[36])sm; float (*ha)[64] = (float (*)[64])(sm + 8 * 36); float (*hb)[64] = (float (*)[64])(sm + 8 * 36 + 8 * 64);
    const int tid = threadIdx.x, l = unit / 288, r = unit % 288;
    const bool lat = r < 256; const int Lf = lat ? 2048 : 256; const int p0 = lat ? r * 8 : (r - 256) * 8;
    float* T = lat ? (float*)(a.ws + WS_FILTL) + (size_t)l * 512 * 4096 : (float*)(a.ws + WS_FILTC) + (size_t)l * 512 * 512;
    const float* w1 = a.in[15] + l * 33 * 64; const float* b1 = a.in[16] + l * 64; const float* w2 = a.in[17] + l * 64 * 64; const float* b2 = a.in[18] + l * 64;
    const float* w3 = a.in[19] + l * 64 * 64; const float* b3 = a.in[20] + l * 64; const float* wf = a.in[21] + (size_t)l * 64 * 1024; const float* fr = a.in[22] + l * 64;
    const int p = tid >> 6, j = tid & 63; const int pos = p0 + p;
    const float tn = (float)pos / (float)(Lf - 1);
    if (j < 33) {
        float z;
        if (j == 0) z = tn;
        else { const int bi = (j - 1) & 15; const float band = 1e-4f + (float)bi * ((15.0f - 1e-4f) / 15.0f);
               const float ang = (6.283185307179586f / (float)Lf) * (float)pos * band; z = (j <= 16) ? cosf(ang) : -sinf(ang); }
        zs[p][j] = z;
    }
    __syncthreads();
    const float f = fr[j];
    { float s = b1[j]; for (int i = 0; i < 33; ++i) s += zs[p][i] * w1[i * 64 + j]; ha[p][j] = sinf(f * s); }
    __syncthreads();
    { float s = b2[j]; for (int i = 0; i < 64; ++i) s += ha[p][i] * w2[i * 64 + j]; hb[p][j] = sinf(f * s); }
    __syncthreads();
    { float s = b3[j]; for (int i = 0; i < 64; ++i) s += hb[p][i] * w3[i * 64 + j]; ha[p][j] = sinf(f * s); }
    __syncthreads();
#pragma unroll
    for (int rr = 0; rr < 2; ++rr) {
        const int o = tid + rr * 512; float acc[8];
#pragma unroll
        for (int q = 0; q < 8; ++q) acc[q] = 0.f;
        for (int i = 0; i < 64; ++i) { const float w = wf[i * 1024 + o];
#pragma unroll
            for (int q = 0; q < 8; ++q) acc[q] += ha[q][i] * w; }
        const int ch = o & 511; const bool back = o >= 512;
        const float delta = 3.0701134573253944f + (float)ch * ((15.350567286626972f - 3.0701134573253944f) / 511.0f);
#pragma unroll
        for (int q = 0; q < 8; ++q) {
            const int ps = p0 + q; const float t2 = (float)ps / (float)(Lf - 1);
            const float val = acc[q] * expf(-t2 * delta);
            if (lat) { bf16_t* RBp = (bf16_t*)(a.ws + WS_FILTL) + ((size_t)l * 512 + ch) * HY_RBROW;
                if (!back) RBp[2048 - ps] = f2bf(val); else if (ps > 0) RBp[2048 + ps] = f2bf(val); }
            else if (!back) T[(size_t)ch * (2 * Lf) + Lf + ps] = val;
            else if (ps > 0) T[(size_t)ch * (2 * Lf) + Lf - ps] = val;
            else T[(size_t)ch * (2 * Lf)] = 0.f;
        }
    }
    __syncthreads();
}
__device__ __forceinline__ void ph_prologue(const Args& a, float* sm) {
    const int bid = blockIdx.x, G = gridDim.x, tid = threadIdx.x;
    for (int u = bid; u < 192; u += G) adaln_unit(a, u, sm);
    for (int u = bid; u < 576; u += G) filters_unit(a, u, sm);
    { float* cosT = (float*)(a.ws + WS_ROPE); float* sinT = cosT + 2048 * 32;
      for (int i = bid * 512 + tid; i < 2048 * 32; i += G * 512) { const int t = i >> 5, f = i & 31;
          const float pos = (float)((f < 16) ? (t >> 6) : (t & 63)); const float freq = powf(10000.0f, -(float)(f & 15) / 16.0f); const float ang = pos * freq;
          cosT[i] = cosf(ang); sinT[i] = sinf(ang); } }
    for (int i = bid * 512 + tid; i < 2 * 512 * 17; i += G * 512) { const int row = i / 17, k = i - row * 17; ((bf16_t*)(a.ws + WS_FILTL))[(size_t)row * HY_RBROW + (k == 0 ? 0 : 4095 + k)] = 0; }
    for (int i = bid * 512 + tid; i < 2 * 192 * 256; i += G * 512) { const int l = i / (192 * 256), r = i % (192 * 256);
        *(u32x4*)(a.ws + WS_WIN + (size_t)l * UW * D * 2 + (size_t)INW * D * 2 + (size_t)r * 16) = (u32x4){0u, 0u, 0u, 0u}; }
    ph_convert(a, sm, bid, G, CONV_FILL ? CONV_STATIC : NCONV);
}

template <bool ROUTER, bool COPYX, bool OUT8 = false>
__device__ __forceinline__ void ph_normmod(const float* __restrict__ xlat, const float* __restrict__ xctx, const float* __restrict__ gain, const float* __restrict__ modl, int sh_off, int sc_off,
                                           bf16_t* __restrict__ out, int nrows, float* __restrict__ xs, const float* __restrict__ router, int* __restrict__ topi, float* __restrict__ topw) {
    const int lane = threadIdx.x & 63, wid = threadIdx.x >> 6;
    for (int row = blockIdx.x * 8 + wid; row < nrows; row += gridDim.x * 8) {
        const float* xr = row < NLAT ? xlat + (size_t)row * D : xctx + (size_t)(row - NLAT) * D;
        const float* mv = modl + (size_t)tok_mod(row) * 12288;
        f32x4 v[8]; float ss = 0.f;
#pragma unroll
        for (int i = 0; i < 8; ++i) { v[i] = *(const f32x4*)(xr + i * 256 + lane * 4); ss += v[i][0] * v[i][0] + v[i][1] * v[i][1] + v[i][2] * v[i][2] + v[i][3] * v[i][3];
            if (COPYX) *(f32x4*)(xs + (size_t)row * D + i * 256 + lane * 4) = v[i]; }
        ss = wave_sum(ss);
        const float rstd = rsqrtf(ss * (1.0f / D) + EPS);
        float lg[8];
#pragma unroll
        for (int e = 0; e < 8; ++e) lg[e] = 0.f;
#pragma unroll
        for (int i = 0; i < 8; ++i) {
            const int col = i * 256 + lane * 4;
            const f32x4 g = *(const f32x4*)(gain + col), sc = *(const f32x4*)(mv + sc_off + col), sh = *(const f32x4*)(mv + sh_off + col);
            f32x4 o;
#pragma unroll
            for (int j = 0; j < 4; ++j) o[j] = (v[i][j] * rstd * g[j]) * (1.0f + sc[j]) + sh[j];
            if (OUT8) *(unsigned*)((unsigned char*)out + (size_t)row * D + col) = pg8::pack4_fp8(o[0] * ASCALE, o[1] * ASCALE, o[2] * ASCALE, o[3] * ASCALE);
            else { u32x2 w; w.x = (unsigned)f2bf(o[0]) | ((unsigned)f2bf(o[1]) << 16); w.y = (unsigned)f2bf(o[2]) | ((unsigned)f2bf(o[3]) << 16);
                *(u32x2*)(out + (size_t)row * D + col) = w; }
            if (ROUTER) {
#pragma unroll
                for (int j = 0; j < 4; ++j) { const f32x4 r0 = *(const f32x4*)(router + (size_t)(col + j) * 8), r1 = *(const f32x4*)(router + (size_t)(col + j) * 8 + 4);
                    lg[0] += o[j] * r0[0]; lg[1] += o[j] * r0[1]; lg[2] += o[j] * r0[2]; lg[3] += o[j] * r0[3];
                    lg[4] += o[j] * r1[0]; lg[5] += o[j] * r1[1]; lg[6] += o[j] * r1[2]; lg[7] += o[j] * r1[3]; }
                asm volatile("" ::: "memory");
            }
        }
        if (ROUTER) {
#pragma unroll
            for (int e = 0; e < 8; ++e) lg[e] = wave_sum(lg[e]);
            if (lane == 0) {
                int i0 = 0; float v0 = lg[0];
#pragma unroll
                for (int e = 1; e < 8; ++e) if (lg[e] > v0) { v0 = lg[e]; i0 = e; }
                int i1 = -1; float v1 = -3.0e38f;
#pragma unroll
                for (int e = 0; e < 8; ++e) if (e != i0 && lg[e] > v1) { v1 = lg[e]; i1 = e; }
                const float e1 = expf(v1 - v0), w0 = 1.0f / (1.0f + e1), w1 = e1 / (1.0f + e1);
                topi[row * 2] = i0; topi[row * 2 + 1] = i1; topw[row * 2] = w0; topw[row * 2 + 1] = w1;
            }
        }
    }
}

__device__ __forceinline__ void ph_mid(const Args& a, int l) {
    const bf16_t* __restrict__ U = (const bf16_t*)(a.ws + WS_U);
    const float* g_q = a.in[9] + l * 768; const float* g_kv = a.in[11] + l * 512; const float* conv_w = a.in[13] + (size_t)l * 3 * 1536; const float* conv_b = a.in[14] + l * 1536;
    const float* cosT = (const float*)(a.ws + WS_ROPE); const float* sinT = cosT + 2048 * 32;
    bf16_t* cqn = (bf16_t*)(a.ws + WS_CQN); bf16_t* ckvn = (bf16_t*)(a.ws + WS_CKVN); bf16_t* kpe = (bf16_t*)(a.ws + WS_KPE); bf16_t* x0o = (bf16_t*)(a.ws + WS_X0);
    bf16_t* wtl = (bf16_t*)(a.ws + WS_WTL); bf16_t* wtc = (bf16_t*)(a.ws + WS_WTC); bf16_t* sq = (bf16_t*)(a.ws + WS_SQ); bf16_t* sk = (bf16_t*)(a.ws + WS_SK); bf16_t* sv = (bf16_t*)(a.ws + WS_SV);
    const int tid = threadIdx.x, lane = tid & 63, wid = tid >> 6;
    for (int unit = blockIdx.x; unit < NTOK / 16; unit += gridDim.x) {
        const int tok0 = unit * 16;
        for (int tt = 0; tt < 2; ++tt) {
            const int tok = tok0 + wid * 2 + tt; const bool lat = tok < NLAT; const int t = lat ? (tok & 2047) : ((tok - NLAT) & 255);
            const bf16_t* u = U + (size_t)tok * UW;
            { float x[12]; float ss = 0.f;
#pragma unroll
              for (int i = 0; i < 12; ++i) { x[i] = bf2f(u[O_CQ + i * 64 + lane]); ss += x[i] * x[i]; }
              ss = wave_sum(ss); const float rs = rsqrtf(ss * (1.0f / 768.0f) + EPS);
#pragma unroll
              for (int i = 0; i < 12; ++i) cqn[(size_t)tok * 768 + i * 64 + lane] = f2bf(x[i] * rs * g_q[i * 64 + lane]); }
            { float x[8]; float ss = 0.f;
#pragma unroll
              for (int i = 0; i < 8; ++i) { x[i] = bf2f(u[O_CKV + i * 64 + lane]); ss += x[i] * x[i]; }
              ss = wave_sum(ss); const float rs = rsqrtf(ss * (1.0f / 512.0f) + EPS);
#pragma unroll
              for (int i = 0; i < 8; ++i) ckvn[(size_t)tok * 512 + i * 64 + lane] = f2bf(x[i] * rs * g_kv[i * 64 + lane]); }
            const int pi = lane & 31;
            const float cs = lat ? cosT[t * 32 + pi] : 1.0f, sn = lat ? sinT[t * 32 + pi] : 0.0f;
            if (lane < 32) {
                const float aa = bf2f(u[O_KPE + pi]), bb = bf2f(u[O_KPE + 32 + pi]);
                kpe[(size_t)tok * 64 + 2 * pi] = f2bf(aa * cs - bb * sn); kpe[(size_t)tok * 64 + 2 * pi + 1] = f2bf(aa * sn + bb * cs);
            }
#pragma unroll
            for (int r = 0; r < 4; ++r) { const int pr = r * 64 + lane, h = pr >> 5;
                const float aa = bf2f(u[O_SQ + h * 64 + pi]), bb = bf2f(u[O_SQ + h * 64 + 32 + pi]);
                sq[(size_t)tok * 512 + h * 64 + pi] = f2bf(aa * cs - bb * sn); sq[(size_t)tok * 512 + h * 64 + 32 + pi] = f2bf(aa * sn + bb * cs); }
            { const int h = lane >> 5;
              const float aa = bf2f(u[O_SK + h * 64 + pi]), bb = bf2f(u[O_SK + h * 64 + 32 + pi]);
              sk[(size_t)tok * 128 + h * 64 + pi] = f2bf(aa * cs - bb * sn); sk[(size_t)tok * 128 + h * 64 + 32 + pi] = f2bf(aa * sn + bb * cs); }
        }
        {
            const bool lat = tok0 < NLAT; const int Ls = lat ? L : C;
            const int b = lat ? (tok0 >> 11) : ((tok0 - NLAT) >> 8), t0 = lat ? (tok0 & 2047) : ((tok0 - NLAT) & 255);
            const int ch = tid;
            float cw[3][3], cb[3];
#pragma unroll
            for (int g = 0; g < 3; ++g) { cb[g] = conv_b[g * 512 + ch];
#pragma unroll
                for (int j = 0; j < 3; ++j) cw[g][j] = conv_w[j * 1536 + g * 512 + ch]; }
            float prev[3], cur[3], nxt[3];
#pragma unroll
            for (int g = 0; g < 3; ++g) { prev[g] = (t0 > 0) ? bf2f(U[(size_t)(tok0 - 1) * UW + O_HY + g * 512 + ch]) : 0.f; cur[g] = bf2f(U[(size_t)tok0 * UW + O_HY + g * 512 + ch]); }
            unsigned pk[8];
#pragma unroll
            for (int i = 0; i < 16; ++i) {
                const bool hasn = (t0 + i + 1) < Ls;
                float y[3];
#pragma unroll
                for (int g = 0; g < 3; ++g) { nxt[g] = hasn ? bf2f(U[(size_t)(tok0 + i + 1) * UW + O_HY + g * 512 + ch]) : 0.f;
                    y[g] = cb[g] + cw[g][0] * prev[g] + cw[g][1] * cur[g] + cw[g][2] * nxt[g]; prev[g] = cur[g]; cur[g] = nxt[g]; }
                x0o[(size_t)(tok0 + i) * 512 + ch] = f2bf(y[0]);
                const unsigned wv = f2bf(y[2] * y[1]);
                if (i & 1) pk[i >> 1] |= wv << 16; else pk[i >> 1] = wv;
            }
            bf16_t* wt = lat ? wtl + ((size_t)b * 512 + ch) * L + t0 : wtc + ((size_t)b * 512 + ch) * C + t0;
            u32x4 w0, w1; w0.x = pk[0]; w0.y = pk[1]; w0.z = pk[2]; w0.w = pk[3]; w1.x = pk[4]; w1.y = pk[5]; w1.z = pk[6]; w1.w = pk[7];
            *(u32x4*)wt = w0; *(u32x4*)(wt + 8) = w1;
        }
        if (tid < 128) {
            unsigned pk[8];
#pragma unroll
            for (int i = 0; i < 16; ++i) { const unsigned v = U[(size_t)(tok0 + i) * UW + O_SV + tid]; if (i & 1) pk[i >> 1] |= v << 16; else pk[i >> 1] = v; }
            bf16_t* dst = sv + (size_t)tid * NTOK + tok0;
            u32x4 w0, w1; w0.x = pk[0]; w0.y = pk[1]; w0.z = pk[2]; w0.w = pk[3]; w1.x = pk[4]; w1.y = pk[5]; w1.z = pk[6]; w1.w = pk[7];
            *(u32x4*)dst = w0; *(u32x4*)(dst + 8) = w1;
        }
    }
}

__device__ __forceinline__ void ph_mla_naive(const Args& a, int nq, float* sm) {
    const bf16_t* __restrict__ Q = (const bf16_t*)(a.ws + WS_Q); const bf16_t* __restrict__ KV = (const bf16_t*)(a.ws + WS_KV); const bf16_t* __restrict__ KPE = (const bf16_t*)(a.ws + WS_KPE);
    bf16_t* mix = (bf16_t*)(a.ws + WS_MIX);
    const int lane = threadIdx.x & 63, w = threadIdx.x >> 6;
    float* qf = sm + w * 192; float* sc = sm + 8 * 192 + w * 2304;
    for (int unit = blockIdx.x; unit < nq; unit += gridDim.x) {
        const int h = unit & 7, qt = (unit >> 3) * 8 + w; const bool lat = qt < NLAT;
        const int b = lat ? (qt >> 11) : ((qt - NLAT) >> 8);
        const int nk = lat ? (L + C) : C;
        for (int i = lane; i < 192; i += 64) qf[i] = bf2f(Q[(size_t)qt * QW + h * 192 + i]);
        __syncthreads();
        const float scale = 0.07216878364870322f;
        float mx = -3.0e38f;
        for (int kc = 0; kc < nk; kc += 64) {
            const int kk = kc + lane;
            const int kt = lat ? (kk < L ? b * L + kk : NLAT + b * C + (kk - L)) : (NLAT + b * C + kk);
            float s = 0.f;
            const u32x4* kp = (const u32x4*)(KV + (size_t)kt * KVW + h * 256);
            for (int i = 0; i < 16; ++i) { const u32x4 v = kp[i]; const float* q8 = qf + i * 8;
                s += q8[0] * __uint_as_float(v.x << 16) + q8[1] * __uint_as_float(v.x & 0xffff0000u) + q8[2] * __uint_as_float(v.y << 16) + q8[3] * __uint_as_float(v.y & 0xffff0000u)
                   + q8[4] * __uint_as_float(v.z << 16) + q8[5] * __uint_as_float(v.z & 0xffff0000u) + q8[6] * __uint_as_float(v.w << 16) + q8[7] * __uint_as_float(v.w & 0xffff0000u); }
            const u32x4* pp = (const u32x4*)(KPE + (size_t)kt * 64);
            for (int i = 0; i < 8; ++i) { const u32x4 v = pp[i]; const float* q8 = qf + 128 + i * 8;
                s += q8[0] * __uint_as_float(v.x << 16) + q8[1] * __uint_as_float(v.x & 0xffff0000u) + q8[2] * __uint_as_float(v.y << 16) + q8[3] * __uint_as_float(v.y & 0xffff0000u)
                   + q8[4] * __uint_as_float(v.z << 16) + q8[5] * __uint_as_float(v.z & 0xffff0000u) + q8[6] * __uint_as_float(v.w << 16) + q8[7] * __uint_as_float(v.w & 0xffff0000u); }
            s *= scale; sc[kk] = s; mx = fmaxf(mx, s);
        }
        mx = wave_max(mx);
        float sum = 0.f;
        for (int kc = 0; kc < nk; kc += 64) { const float p = expf(sc[kc + lane] - mx); sc[kc + lane] = p; sum += p; }
        sum = wave_sum(sum);
        __syncthreads();
        float o0 = 0.f, o1 = 0.f;
        for (int kk = 0; kk < nk; ++kk) {
            const int kt = lat ? (kk < L ? b * L + kk : NLAT + b * C + (kk - L)) : (NLAT + b * C + kk);
            const unsigned v = *(const unsigned*)(KV + (size_t)kt * KVW + h * 256 + 128 + lane * 2);
            const float p = sc[kk];
            o0 += p * __uint_as_float(v << 16); o1 += p * __uint_as_float(v & 0xffff0000u);
        }
        const float inv = 1.0f / sum;
        *(unsigned*)(mix + (size_t)qt * D + h * 128 + lane * 2) = (unsigned)f2bf(o0 * inv) | ((unsigned)f2bf(o1 * inv) << 16);
        __syncthreads();
    }
}
__device__ __forceinline__ void ph_swa_naive(const Args& a, int l, int nq, float* sm) {
    const bf16_t* __restrict__ SQ = (const bf16_t*)(a.ws + WS_SQ); const bf16_t* __restrict__ SK = (const bf16_t*)(a.ws + WS_SK); const bf16_t* __restrict__ SV = (const bf16_t*)(a.ws + WS_SV);
    const float* sink = a.in[24] + l * 8; bf16_t* mix = (bf16_t*)(a.ws + WS_MIX);
    const int lane = threadIdx.x & 63, w = threadIdx.x >> 6;
    float* qf = sm + w * 64; float* sc = sm + 8 * 64 + w * 576; int* kts = (int*)(sm + 8 * 64 + 8 * 576) + w * 576;
    for (int unit = blockIdx.x; unit < nq; unit += gridDim.x) {
        const int hq = unit & 7, hk = hq >> 2, qt = (unit >> 3) * 8 + w; const bool lat = qt < NLAT;
        const int b = lat ? (qt >> 11) : ((qt - NLAT) >> 8), t = lat ? (qt & 2047) : 0;
        int lo = 0, nloc = 0;
        if (lat) { lo = t - 128 < 0 ? 0 : t - 128; const int hi = t + 128 > L - 1 ? L - 1 : t + 128; nloc = hi - lo + 1; }
        const int nk = nloc + C;
        qf[lane] = bf2f(SQ[(size_t)qt * 512 + hq * 64 + lane]);
        __syncthreads();
        const float skv = sink[hq];
        float mx = skv;
        for (int kc = 0; kc < nk; kc += 64) {
            const int kk = kc + lane;
            if (kk < nk) {
                const int kt = kk < nloc ? (b * L + lo + kk) : (NLAT + b * C + (kk - nloc));
                const u32x4* kp = (const u32x4*)(SK + (size_t)kt * 128 + hk * 64);
                float s = 0.f;
                for (int i = 0; i < 8; ++i) { const u32x4 v = kp[i]; const float* q8 = qf + i * 8;
                    s += q8[0] * __uint_as_float(v.x << 16) + q8[1] * __uint_as_float(v.x & 0xffff0000u) + q8[2] * __uint_as_float(v.y << 16) + q8[3] * __uint_as_float(v.y & 0xffff0000u)
                       + q8[4] * __uint_as_float(v.z << 16) + q8[5] * __uint_as_float(v.z & 0xffff0000u) + q8[6] * __uint_as_float(v.w << 16) + q8[7] * __uint_as_float(v.w & 0xffff0000u); }
                s *= 0.125f; sc[kk] = s; kts[kk] = kt; mx = fmaxf(mx, s);
            }
        }
        mx = wave_max(mx);
        float sum = 0.f;
        for (int kc = 0; kc < nk; kc += 64) { const int kk = kc + lane; if (kk < nk) { const float p = expf(sc[kk] - mx); sc[kk] = p; sum += p; } }
        sum = wave_sum(sum) + expf(skv - mx);
        __syncthreads();
        float o = 0.f;
        for (int kk = 0; kk < nk; ++kk) o += sc[kk] * bf2f(SV[(size_t)kts[kk] * 128 + hk * 64 + lane]);
        mix[(size_t)qt * D + 1536 + hq * 64 + lane] = f2bf(o / sum);
        __syncthreads();
    }
}
template <int LS>
__device__ __forceinline__ void ph_hyena_naive(const Args& a, int l, float* sm) {
    const float* filt = LS == L ? (const float*)(a.ws + WS_FILTL) + (size_t)l * 512 * 4096 : (const float*)(a.ws + WS_FILTC) + (size_t)l * 512 * 512;
    const bf16_t* wt = (const bf16_t*)(a.ws + (LS == L ? WS_WTL : WS_WTC)); const bf16_t* x0 = (const bf16_t*)(a.ws + WS_X0); const float* skip = a.in[23] + l * 512;
    bf16_t* mix = (bf16_t*)(a.ws + WS_MIX); const int tok_base = LS == L ? 0 : NLAT;
    float* T = sm; float* ws = sm + 2 * LS; const int tid = threadIdx.x;
    for (int unit = blockIdx.x; unit < 512 * NB; unit += gridDim.x) {
        const int ch = unit >> 2, b = unit & 3;
        for (int i = tid; i < 2 * LS; i += NTHR) T[i] = filt[(size_t)ch * 2 * LS + i];
        for (int i = tid; i < LS; i += NTHR) ws[i] = bf2f(wt[((size_t)b * 512 + ch) * LS + i]);
        __syncthreads();
        const float sk = skip[ch];
        for (int t = tid; t < LS; t += NTHR) {
            float y = 0.f;
            for (int s = 0; s < LS; ++s) y += T[t - s + LS] * ws[s];
            const int tok = tok_base + b * LS + t;
            mix[(size_t)tok * D + 1024 + ch] = f2bf(bf2f(x0[(size_t)tok * 512 + ch]) * (y + sk * ws[t]));
        }
        __syncthreads();
    }
}
__device__ __forceinline__ void ph_route(const Args& a, int* sm) {
    const int* topi = (const int*)(a.ws + WS_TOPI); int* pos = (int*)(a.ws + WS_POS); int* src = (int*)(a.ws + WS_SRC); int* ctl = (int*)(a.ws + WS_CTL);
    if (blockIdx.x != 0) return;
    int (*cnt)[512] = (int (*)[512])sm; int* eoff = sm + 8 * 512;
    const int tid = threadIdx.x;
    for (int i = tid; i < MOE_ROWS; i += NTHR) src[i] = -1;
    int c[8];
#pragma unroll
    for (int e = 0; e < 8; ++e) c[e] = 0;
    for (int i = 0; i < 32; ++i) { const int e = topi[tid * 32 + i];
#pragma unroll
        for (int q = 0; q < 8; ++q) c[q] += (e == q) ? 1 : 0; }
#pragma unroll
    for (int e = 0; e < 8; ++e) cnt[e][tid] = c[e];
    __syncthreads();
    if (tid < 8) { int s = 0; for (int i = 0; i < 512; ++i) { const int v = cnt[tid][i]; cnt[tid][i] = s; s += v; } eoff[tid] = s; }
    __syncthreads();
    if (tid == 0) { int o = 0; for (int e = 0; e < 8; ++e) { const int n = eoff[e], p = (n + 255) & ~255; ctl[CT_EOFF + e] = o; ctl[CT_EPAD + e] = p; eoff[e] = o; o += p; } ctl[CT_NTILE] = o >> 8; }
    __syncthreads();
#pragma unroll
    for (int e = 0; e < 8; ++e) c[e] = eoff[e] + cnt[e][tid];
    for (int i = 0; i < 32; ++i) { const int idx = tid * 32 + i; const int e = topi[idx]; int p = 0;
#pragma unroll
        for (int q = 0; q < 8; ++q) if (e == q) { p = c[q]; c[q]++; }
        pos[idx] = p; src[p] = idx >> 1; }
}
__device__ __forceinline__ void ph_gather(const Args& a) {
    const bf16_t* hb = (const bf16_t*)(a.ws + WS_HA); const int* src = (const int*)(a.ws + WS_SRC); bf16_t* hbs = (bf16_t*)(a.ws + WS_HBS);
    const int nrows = ((const int*)(a.ws + WS_CTL))[CT_NTILE] * 256;
    const int quarter = threadIdx.x >> 7, t = threadIdx.x & 127;
    for (int r = blockIdx.x * 4 + quarter; r < nrows; r += gridDim.x * 4) {
        const int s = src[r]; u32x4 v = (u32x4){0u, 0u, 0u, 0u};
        if (s >= 0) v = *(const u32x4*)((const unsigned char*)hb + (size_t)s * D + t * 16);
        *(u32x4*)((unsigned char*)hbs + (size_t)r * D + t * 16) = v;
    }
}
__device__ __forceinline__ void ph_final(const Args& a) {
    const float* xs = (const float*)(a.ws + WS_XS); const float* ys = (const float*)(a.ws + WS_YS); const int* pos = (const int*)(a.ws + WS_POS); const float* topw = (const float*)(a.ws + WS_TOPW);
    const float* modl = (const float*)(a.ws + WS_MOD) + (size_t)5 * 12288; const float* gfin = a.in[33]; float* out = a.out;
    const int lane = threadIdx.x & 63, wid = threadIdx.x >> 6;
    for (int row = blockIdx.x * 8 + wid; row < NLAT; row += gridDim.x * 8) {
        const float* g2 = modl + (size_t)tok_mod(row) * 12288 + 10240;
        const int p0 = pos[row * 2], p1 = pos[row * 2 + 1]; const float w0 = topw[row * 2], w1 = topw[row * 2 + 1];
        f32x4 v[8]; float ss = 0.f;
#pragma unroll
        for (int i = 0; i < 8; ++i) { const int col = i * 256 + lane * 4;
            const f32x4 x = *(const f32x4*)(xs + (size_t)row * D + col), ya = *(const f32x4*)(ys + (size_t)p0 * D + col), yb = *(const f32x4*)(ys + (size_t)p1 * D + col), g = *(const f32x4*)(g2 + col);
#pragma unroll
            for (int j = 0; j < 4; ++j) { v[i][j] = x[j] + g[j] * (w0 * ya[j] + w1 * yb[j]); ss += v[i][j] * v[i][j]; } }
        ss = wave_sum(ss); const float rstd = rsqrtf(ss * (1.0f / D) + EPS);
#pragma unroll
        for (int i = 0; i < 8; ++i) { const int col = i * 256 + lane * 4; const f32x4 g = *(const f32x4*)(gfin + col); f32x4 o;
#pragma unroll
            for (int j = 0; j < 4; ++j) o[j] = v[i][j] * rstd * g[j];
            *(f32x4*)(out + (size_t)row * D + col) = o; }
    }
}

typedef float f32x2_t __attribute__((ext_vector_type(2))); typedef __bf16 bf16x2_t __attribute__((ext_vector_type(2)));
__device__ __forceinline__ unsigned cvtpk(float lo, float hi) { f32x2_t v = {lo, hi}; bf16x2_t b = __builtin_convertvector(v, bf16x2_t); return __builtin_bit_cast(unsigned, b); }
#define MFMA32(a, b, c) __builtin_amdgcn_mfma_f32_32x32x16_bf16((a), (b), (c), 0, 0, 0)
constexpr int MLA_KP = 400, MLA_VP = 144, MLA_KB = 64 * MLA_KP, MLA_VB = 128 * MLA_VP, MLA_STAGE = MLA_KB + MLA_VB;
static_assert(2 * MLA_STAGE <= RING_BYTES, "MLA LDS");

__device__ __forceinline__ void ph_mla(const Args& a, bool with_ctx, unsigned char* lds) {
    const bf16_t* __restrict__ Q = (const bf16_t*)(a.ws + WS_Q); const bf16_t* __restrict__ KN = (const bf16_t*)(a.ws + WS_KN); const bf16_t* __restrict__ KPE = (const bf16_t*)(a.ws + WS_KPE);
    const bf16_t* __restrict__ VT = (const bf16_t*)(a.ws + WS_VT); bf16_t* __restrict__ mix = (bf16_t*)(a.ws + WS_MIX);
    int tid_ = threadIdx.x; asm volatile("" : "+v"(tid_));
    const int tid = tid_, lane = tid & 63, w = tid >> 6, qi = lane & 31, hh = lane >> 5;
    const int nunits = with_ctx ? 288 : 256;
    const float c = 0.07216878364870322f * 1.4426950408889634f;
    for (int unit = blockIdx.x; unit < nunits; unit += gridDim.x) {
        int h, b, q0tok, nt; bool ctxq;
        if (unit < 256) { h = unit & 7; b = unit >> 6; q0tok = b * L + ((unit >> 3) & 7) * 256; nt = 36; ctxq = false; }
        else { const int u2 = unit - 256; h = u2 & 7; b = u2 >> 3; q0tok = NLAT + b * C; nt = 4; ctxq = true; }
#define MLA_KTOK(t) (ctxq ? (NLAT + b * C + (t) * 64) : ((t) < 32 ? (b * L + (t) * 64) : (NLAT + b * C + ((t) - 32) * 64)))
        u32x4 r0, r1, r2, r3, r4;
#define MLA_ISSUE(t) do { const int kt0_ = MLA_KTOK(t); \
            r0 = *(const u32x4*)(KN + (size_t)(kt0_ + (tid >> 4)) * 1024 + h * 128 + (tid & 15) * 8); \
            r1 = *(const u32x4*)(KN + (size_t)(kt0_ + 32 + (tid >> 4)) * 1024 + h * 128 + (tid & 15) * 8); \
            r2 = *(const u32x4*)(KPE + (size_t)(kt0_ + (tid >> 3)) * 64 + (tid & 7) * 8); \
            r3 = *(const u32x4*)(VT + (size_t)(h * 128 + (tid >> 3)) * NTOK + kt0_ + (tid & 7) * 8); \
            r4 = *(const u32x4*)(VT + (size_t)(h * 128 + 64 + (tid >> 3)) * NTOK + kt0_ + (tid & 7) * 8); } while (0)
#define MLA_COMMIT(buf) do { unsigned char* kb_ = lds + (buf) * MLA_STAGE; unsigned char* vb_ = kb_ + MLA_KB; \
            *(u32x4*)(kb_ + (tid >> 4) * MLA_KP + (tid & 15) * 16) = r0; \
            *(u32x4*)(kb_ + (32 + (tid >> 4)) * MLA_KP + (tid & 15) * 16) = r1; \
            *(u32x4*)(kb_ + (tid >> 3) * MLA_KP + 256 + (tid & 7) * 16) = r2; \
            const int g_ = (tid & 7) >> 1, e_ = tid & 1; \
            { u32x2 lo_, hi_; lo_.x = r3.x; lo_.y = r3.y; hi_.x = r3.z; hi_.y = r3.w; \
              *(u32x2*)(vb_ + (tid >> 3) * MLA_VP + g_ * 32 + e_ * 8) = lo_; *(u32x2*)(vb_ + (tid >> 3) * MLA_VP + g_ * 32 + 16 + e_ * 8) = hi_; } \
            { u32x2 lo_, hi_; lo_.x = r4.x; lo_.y = r4.y; hi_.x = r4.z; hi_.y = r4.w; \
              *(u32x2*)(vb_ + (64 + (tid >> 3)) * MLA_VP + g_ * 32 + e_ * 8) = lo_; *(u32x2*)(vb_ + (64 + (tid >> 3)) * MLA_VP + g_ * 32 + 16 + e_ * 8) = hi_; } } while (0)
        const int qtok = q0tok + w * 32 + qi;
        bf16x8 qf[12];
#pragma unroll
        for (int s = 0; s < 12; ++s) qf[s] = *(const bf16x8*)(Q + (size_t)qtok * QW + h * 192 + s * 16 + hh * 8);
        f32x16 o[4];
#pragma unroll
        for (int d = 0; d < 4; ++d)
#pragma unroll
            for (int r = 0; r < 16; ++r) o[d][r] = 0.f;
        float m = -1.0e30f, l = 0.f;
        MLA_ISSUE(0); MLA_COMMIT(0);
        __syncthreads();
        for (int t = 0; t < nt; ++t) {
            const unsigned char* kb = lds + (t & 1) * MLA_STAGE; const unsigned char* vb = kb + MLA_KB;
            f32x16 s0, s1;
#pragma unroll
            for (int r = 0; r < 16; ++r) { s0[r] = 0.f; s1[r] = 0.f; }
#pragma unroll
            for (int s = 0; s < 12; ++s) {
                const bf16x8 k0 = *(const bf16x8*)(kb + qi * MLA_KP + s * 32 + hh * 16);
                const bf16x8 k1 = *(const bf16x8*)(kb + (32 + qi) * MLA_KP + s * 32 + hh * 16);
                s0 = MFMA32(k0, qf[s], s0); s1 = MFMA32(k1, qf[s], s1);
                if ((s & 3) == 3) asm volatile("" ::: "memory");
            }
            if (t + 1 < nt) MLA_ISSUE(t + 1);
            float mx = fmaxf(s0[0], s1[0]);
#pragma unroll
            for (int r = 1; r < 16; ++r) mx = fmaxf(mx, fmaxf(s0[r], s1[r]));
            mx = fmaxf(mx, __shfl_xor(mx, 32));
            const float mnew = fmaxf(m, mx * c);
            const float alpha = __builtin_amdgcn_exp2f(m - mnew);
            m = mnew;
            float ps = 0.f;
#pragma unroll
            for (int r = 0; r < 16; ++r) { s0[r] = __builtin_amdgcn_exp2f(s0[r] * c - mnew); s1[r] = __builtin_amdgcn_exp2f(s1[r] * c - mnew); ps += s0[r] + s1[r]; }
            l = l * alpha + ps;
#pragma unroll
            for (int d = 0; d < 4; ++d)
#pragma unroll
                for (int r = 0; r < 16; ++r) o[d][r] *= alpha;
            bf16x8 pf[4];
            { u32x4 p;
              p.x = cvtpk(s0[0], s0[1]); p.y = cvtpk(s0[2], s0[3]); p.z = cvtpk(s0[4], s0[5]); p.w = cvtpk(s0[6], s0[7]); pf[0] = __builtin_bit_cast(bf16x8, p);
              p.x = cvtpk(s0[8], s0[9]); p.y = cvtpk(s0[10], s0[11]); p.z = cvtpk(s0[12], s0[13]); p.w = cvtpk(s0[14], s0[15]); pf[1] = __builtin_bit_cast(bf16x8, p);
              p.x = cvtpk(s1[0], s1[1]); p.y = cvtpk(s1[2], s1[3]); p.z = cvtpk(s1[4], s1[5]); p.w = cvtpk(s1[6], s1[7]); pf[2] = __builtin_bit_cast(bf16x8, p);
              p.x = cvtpk(s1[8], s1[9]); p.y = cvtpk(s1[10], s1[11]); p.z = cvtpk(s1[12], s1[13]); p.w = cvtpk(s1[14], s1[15]); pf[3] = __builtin_bit_cast(bf16x8, p); }
            asm volatile("" ::: "memory");
#pragma unroll
            for (int d = 0; d < 4; ++d) {
#pragma unroll
                for (int g = 0; g < 4; ++g) {
                    const bf16x8 vf = *(const bf16x8*)(vb + (d * 32 + qi) * MLA_VP + g * 32 + hh * 16);
                    o[d] = MFMA32(vf, pf[g], o[d]);
                }
                if (d & 1) asm volatile("" ::: "memory");
            }
            if (t + 1 < nt) MLA_COMMIT((t + 1) & 1);
            __syncthreads();
        }
        const float inv = 1.0f / (l + __shfl_xor(l, 32));
        bf16_t* op = mix + (size_t)qtok * D + h * 128 + 4 * hh;
#pragma unroll
        for (int d = 0; d < 4; ++d)
#pragma unroll
            for (int g = 0; g < 4; ++g) { u32x2 wv; wv.x = cvtpk(o[d][4 * g] * inv, o[d][4 * g + 1] * inv); wv.y = cvtpk(o[d][4 * g + 2] * inv, o[d][4 * g + 3] * inv);
                *(u32x2*)(op + d * 32 + 8 * g) = wv; }
#undef MLA_KTOK
#undef MLA_ISSUE
#undef MLA_COMMIT
    }
}

constexpr int HY_CS = 8224, HY_WS = 5136, HY_WOFF = 8 * HY_CS, HY_RBL = HY_WOFF + 4 * HY_WS;
static_assert(HY_RBL + 516 * 16 <= RING_BYTES, "hyena LDS");

__device__ __forceinline__ u32x4 hy_shift(const u32x4 a, const u32x4 b, int r) {
    switch (r) {
    case 0: return b;
    case 1: return (u32x4){__builtin_amdgcn_alignbyte(b.x, a.w, 2), __builtin_amdgcn_alignbyte(b.y, b.x, 2), __builtin_amdgcn_alignbyte(b.z, b.y, 2), __builtin_amdgcn_alignbyte(b.w, b.z, 2)};
    case 2: return (u32x4){a.w, b.x, b.y, b.z};
    case 3: return (u32x4){__builtin_amdgcn_alignbyte(a.w, a.z, 2), __builtin_amdgcn_alignbyte(b.x, a.w, 2), __builtin_amdgcn_alignbyte(b.y, b.x, 2), __builtin_amdgcn_alignbyte(b.z, b.y, 2)};
    case 4: return (u32x4){a.z, a.w, b.x, b.y};
    case 5: return (u32x4){__builtin_amdgcn_alignbyte(a.z, a.y, 2), __builtin_amdgcn_alignbyte(a.w, a.z, 2), __builtin_amdgcn_alignbyte(b.x, a.w, 2), __builtin_amdgcn_alignbyte(b.y, b.x, 2)};
    case 6: return (u32x4){a.y, a.z, a.w, b.x};
    default: return (u32x4){__builtin_amdgcn_alignbyte(a.y, a.x, 2), __builtin_amdgcn_alignbyte(a.z, a.y, 2), __builtin_amdgcn_alignbyte(a.w, a.z, 2), __builtin_amdgcn_alignbyte(b.x, a.w, 2)};
    }
}

__device__ __forceinline__ void ph_hyena(const Args& a, int l, unsigned char* lds) {
    const bf16_t* __restrict__ RB = (const bf16_t*)(a.ws + WS_FILTL) + (size_t)l * 512 * HY_RBROW;
    const bf16_t* __restrict__ wtl = (const bf16_t*)(a.ws + WS_WTL); const bf16_t* __restrict__ x0 = (const bf16_t*)(a.ws + WS_X0); const float* skip = a.in[23] + l * 512;
    bf16_t* __restrict__ mix = (bf16_t*)(a.ws + WS_MIX);
    int tid_ = threadIdx.x; asm volatile("" : "+v"(tid_));
    const int tid = tid_, lane = tid & 63, w = __builtin_amdgcn_readfirstlane(tid >> 6), i = lane & 31, hh = lane >> 5;
    for (int unit = blockIdx.x; unit < 512; unit += gridDim.x) {
        const int c = unit;
        for (int k = tid; k < 515; k += NTHR) { u32x4 v = (u32x4){0u, 0u, 0u, 0u}; if (k < 513) v = *(const u32x4*)(RB + (size_t)c * HY_RBROW + k * 8); *(u32x4*)(lds + HY_RBL + k * 16) = v; }
        for (int k = tid; k < 4 * 321; k += NTHR) { const int b = k / 321, sl = k - b * 321; u32x4 v = (u32x4){0u, 0u, 0u, 0u};
            if (sl >= 28 && sl < 284) v = *(const u32x4*)(wtl + ((size_t)b * 512 + c) * L + (sl - 28) * 8);
            *(u32x4*)(lds + HY_WOFF + b * HY_WS + sl * 16) = v; }
        __syncthreads();
        for (int qs = lane; qs < 511; qs += 64) {
            const u32x4 ca = *(const u32x4*)(lds + HY_RBL + qs * 16), cb = *(const u32x4*)(lds + HY_RBL + qs * 16 + 16);
            *(u32x4*)(lds + w * HY_CS + qs * 16) = hy_shift(ca, cb, w);
        }
        __syncthreads();
        f32x16 acc0, acc1;
#pragma unroll
        for (int r = 0; r < 16; ++r) { acc0[r] = 0.f; acc1[r] = 0.f; }
        const int Tl = i >> 2, b = i & 3;
        const unsigned char* ap = lds + (i & 7) * HY_CS + (hh - (i >> 3) + 255) * 16;
        const unsigned char* bp = lds + HY_WOFF + b * HY_WS + (224 + 16 * (2 * (8 * w + Tl)) + 8 * hh) * 2;
        const int d0 = 16 * w - 127;
#pragma unroll 2
        for (int dd = 0; dd < 142; dd += 2) {
            const int d = d0 + dd;
            const bf16x8 a0 = *(const bf16x8*)(ap - 32 * d), b0 = *(const bf16x8*)(bp - 32 * d);
            const bf16x8 a1 = *(const bf16x8*)(ap - 32 * (d + 1)), b1 = *(const bf16x8*)(bp - 32 * (d + 1));
            acc0 = MFMA32(a0, b0, acc0); acc1 = MFMA32(a1, b1, acc1);
        }
        const float sk = skip[c];
        const bf16_t* wl = (const bf16_t*)(lds + HY_WOFF + b * HY_WS) + 224;
#pragma unroll
        for (int r = 0; r < 16; ++r) {
            const int t = 32 * (8 * w + Tl) + (r & 3) + 8 * (r >> 2) + 4 * hh; const int tok = b * L + t;
            const float y = acc0[r] + acc1[r] + sk * bf2f(wl[t]);
            mix[(size_t)tok * D + 1024 + c] = f2bf(bf2f(x0[(size_t)tok * 512 + c]) * y);
        }
        __syncthreads();
    }
}

constexpr int SWA_P = 144, SWA_KB = 64 * SWA_P, SWA_STAGE = 2 * SWA_KB;
__device__ __forceinline__ void ph_swa(const Args& a, int l, bool with_ctx, unsigned char* lds) {
    const bf16_t* __restrict__ SQ = (const bf16_t*)(a.ws + WS_SQ); const bf16_t* __restrict__ SK = (const bf16_t*)(a.ws + WS_SK); const bf16_t* __restrict__ SVT = (const bf16_t*)(a.ws + WS_SV);
    const float* sink = a.in[24] + l * 8; bf16_t* __restrict__ mix = (bf16_t*)(a.ws + WS_MIX);
    int tid_ = threadIdx.x; asm volatile("" : "+v"(tid_));
    const int tid = tid_, lane = tid & 63, w = tid >> 6, qi = lane & 31, hh = lane >> 5;
    const int nunits = with_ctx ? 288 : 256;
    const float c = 0.125f * 1.4426950408889634f;
    for (int unit = blockIdx.x; unit < nunits; unit += gridDim.x) {
        int hk, b, p0, nloc, t0loc, q0tok; bool ctxq;
        if (unit < 256) { hk = unit & 1; b = (unit >> 1) & 3; p0 = (unit >> 3) * 64; ctxq = false; q0tok = b * L + p0;
            const int lo = p0 - 128 < 0 ? 0 : p0 - 128, hi = p0 + 192 > L ? L : p0 + 192; t0loc = lo; nloc = (hi - lo) >> 6; }
        else { const int u2 = unit - 256; hk = u2 & 1; b = (u2 >> 1) & 3; p0 = (u2 >> 3) * 64; ctxq = true; q0tok = NLAT + b * C + p0; t0loc = 0; nloc = 0; }
        const int nt = nloc + 4;
#define SWA_KTOK(t) ((t) < nloc ? (b * L + t0loc + (t) * 64) : (NLAT + b * C + ((t) - nloc) * 64))
        u32x4 r0, r1;
#define SWA_ISSUE(t) do { const int kt0_ = SWA_KTOK(t); \
            r0 = *(const u32x4*)(SK + (size_t)(kt0_ + (tid >> 3)) * 128 + hk * 64 + (tid & 7) * 8); \
            r1 = *(const u32x4*)(SVT + (size_t)(hk * 64 + (tid >> 3)) * NTOK + kt0_ + (tid & 7) * 8); } while (0)
#define SWA_COMMIT(buf) do { unsigned char* kb_ = lds + (buf) * SWA_STAGE; unsigned char* vb_ = kb_ + SWA_KB; \
            *(u32x4*)(kb_ + (tid >> 3) * SWA_P + (tid & 7) * 16) = r0; \
            const int g_ = (tid & 7) >> 1, e_ = tid & 1; u32x2 lo_, hi_; lo_.x = r1.x; lo_.y = r1.y; hi_.x = r1.z; hi_.y = r1.w; \
            *(u32x2*)(vb_ + (tid >> 3) * SWA_P + g_ * 32 + e_ * 8) = lo_; *(u32x2*)(vb_ + (tid >> 3) * SWA_P + g_ * 32 + 16 + e_ * 8) = hi_; } while (0)
        const int hq = hk * 4 + (w >> 1), qpos = p0 + (w & 1) * 32 + qi, qtok = q0tok + (w & 1) * 32 + qi;
        bf16x8 qf[4];
#pragma unroll
        for (int s = 0; s < 4; ++s) qf[s] = *(const bf16x8*)(SQ + (size_t)qtok * 512 + hq * 64 + s * 16 + hh * 8);
        f32x16 o[2];
#pragma unroll
        for (int d = 0; d < 2; ++d)
#pragma unroll
            for (int r = 0; r < 16; ++r) o[d][r] = 0.f;
        float m = sink[hq] * 1.4426950408889634f, lsum = hh == 0 ? 1.0f : 0.0f;
        SWA_ISSUE(0); SWA_COMMIT(0);
        __syncthreads();
        for (int t = 0; t < nt; ++t) {
            const unsigned char* kb = lds + (t & 1) * SWA_STAGE; const unsigned char* vb = kb + SWA_KB;
            f32x16 s0, s1;
#pragma unroll
            for (int r = 0; r < 16; ++r) { s0[r] = 0.f; s1[r] = 0.f; }
#pragma unroll
            for (int s = 0; s < 4; ++s) {
                const bf16x8 k0 = *(const bf16x8*)(kb + qi * SWA_P + s * 32 + hh * 16);
                const bf16x8 k1 = *(const bf16x8*)(kb + (32 + qi) * SWA_P + s * 32 + hh * 16);
                s0 = MFMA32(k0, qf[s], s0); s1 = MFMA32(k1, qf[s], s1);
            }
            if (t + 1 < nt) SWA_ISSUE(t + 1);
            if (t < nloc) {
                const int kbase = t0loc + t * 64 + 4 * hh - qpos;
#pragma unroll
                for (int r = 0; r < 16; ++r) { const int dlt = kbase + (r & 3) + 8 * (r >> 2);
                    if (dlt > 128 || dlt < -128) s0[r] = -1.0e30f;
                    if (dlt + 32 > 128 || dlt + 32 < -128) s1[r] = -1.0e30f; }
            }
            float mx = fmaxf(s0[0], s1[0]);
#pragma unroll
            for (int r = 1; r < 16; ++r) mx = fmaxf(mx, fmaxf(s0[r], s1[r]));
            mx = fmaxf(mx, __shfl_xor(mx, 32));
            const float mnew = fmaxf(m, mx * c);
            const float alpha = __builtin_amdgcn_exp2f(m - mnew);
            m = mnew;
            float ps = 0.f;
#pragma unroll
            for (int r = 0; r < 16; ++r) { s0[r] = __builtin_amdgcn_exp2f(s0[r] * c - mnew); s1[r] = __builtin_amdgcn_exp2f(s1[r] * c - mnew); ps += s0[r] + s1[r]; }
            lsum = lsum * alpha + ps;
#pragma unroll
            for (int d = 0; d < 2; ++d)
#pragma unroll
                for (int r = 0; r < 16; ++r) o[d][r] *= alpha;
            bf16x8 pf[4];
            { u32x4 p;
              p.x = cvtpk(s0[0], s0[1]); p.y = cvtpk(s0[2], s0[3]); p.z = cvtpk(s0[4], s0[5]); p.w = cvtpk(s0[6], s0[7]); pf[0] = __builtin_bit_cast(bf16x8, p);
              p.x = cvtpk(s0[8], s0[9]); p.y = cvtpk(s0[10], s0[11]); p.z = cvtpk(s0[12], s0[13]); p.w = cvtpk(s0[14], s0[15]); pf[1] = __builtin_bit_cast(bf16x8, p);
              p.x = cvtpk(s1[0], s1[1]); p.y = cvtpk(s1[2], s1[3]); p.z = cvtpk(s1[4], s1[5]); p.w = cvtpk(s1[6], s1[7]); pf[2] = __builtin_bit_cast(bf16x8, p);
              p.x = cvtpk(s1[8], s1[9]); p.y = cvtpk(s1[10], s1[11]); p.z = cvtpk(s1[12], s1[13]); p.w = cvtpk(s1[14], s1[15]); pf[3] = __builtin_bit_cast(bf16x8, p); }
#pragma unroll
            for (int d = 0; d < 2; ++d)
#pragma unroll
                for (int g = 0; g < 4; ++g) {
                    const bf16x8 vf = *(const bf16x8*)(vb + (d * 32 + qi) * SWA_P + g * 32 + hh * 16);
                    o[d] = MFMA32(vf, pf[g], o[d]);
                }
            if (t + 1 < nt) SWA_COMMIT((t + 1) & 1);
            __syncthreads();
        }
        const float inv = 1.0f / (lsum + __shfl_xor(lsum, 32));
        bf16_t* op = mix + (size_t)qtok * D + 1536 + hq * 64 + 4 * hh;
#pragma unroll
        for (int d = 0; d < 2; ++d)
#pragma unroll
            for (int g = 0; g < 4; ++g) { u32x2 wv; wv.x = cvtpk(o[d][4 * g] * inv, o[d][4 * g + 1] * inv); wv.y = cvtpk(o[d][4 * g + 2] * inv, o[d][4 * g + 3] * inv);
                *(u32x2*)(op + d * 32 + 8 * g) = wv; }
#undef SWA_KTOK
#undef SWA_ISSUE
#undef SWA_COMMIT
    }
}


constexpr int NPHASES = 22;
#define GEMM_CALL(EPI, SCHED, g, S, E) pg8::gemm_phase<EPI, SCHED, true, true>((PG8_LAS unsigned char*)lds, g, S, E)
#define GEMM_CALL8(EPI, SCHED, g, S, E) pg8::gemm_phase<EPI, SCHED, true, true, true>((PG8_LAS unsigned char*)lds, g, S, E)

template <int LYR>
__device__ __forceinline__ void layer_phases(const Args& a, unsigned char* lds, const XcdBarrier& bar, int lo, int hi) {
#define IN(k) (lo <= (k) && (k) < hi)
#if MK_PER_PHASE
#define SEAM(k) do { } while (0)
#else
#define SEAM(k) do { if (IN(k) && IN((k) + 1)) xcd_barrier(bar); } while (0)
#endif
    constexpr int P0 = 1 + LYR * 9;
    constexpr bool LAST = (LYR == 1);
    const int G = gridDim.x, bid = blockIdx.x;
    unsigned char* ws = a.ws;
    const float* modl = (const float*)(ws + WS_MOD) + (size_t)LYR * 5 * 12288;
    float* xs = (float*)(ws + WS_XS);
    const int nq = LAST ? NLAT : NTOK;
    if (IN(P0 + 0)) {
        if (LYR == 0) ph_normmod<false, true>(a.in[0], a.in[2], a.in[6], modl, 0, 2048, (bf16_t*)(ws + WS_HA), NTOK, xs, nullptr, nullptr, nullptr);
        else ph_normmod<false, false>(xs, xs + (size_t)NLAT * D, a.in[6] + D, modl, 0, 2048, (bf16_t*)(ws + WS_HA), NTOK, nullptr, nullptr, nullptr, nullptr);
    }
    SEAM(P0 + 0);
    if (IN(P0 + 1)) {
        pg8::Gemm g{(const bf16_t*)(ws + WS_HA), (const bf16_t*)(ws + WS_WIN + (size_t)LYR * UW * D * 2), NTOK, UW, D};
        pg8::StaticOrder S; S.init(NTOK, UW, G, bid); pg8::EpiStore E{(bf16_t*)(ws + WS_U), UW};
        GEMM_CALL(pg8::EpiStore, pg8::StaticOrder, g, S, E);
        conv_fill(a, (float*)lds, LYR * 6 + 0);
    }
    SEAM(P0 + 1);
    if (IN(P0 + 2)) ph_mid(a, LYR);
    SEAM(P0 + 2);
    if (IN(P0 + 3)) {
        { pg8::Gemm g{(const bf16_t*)(ws + WS_CQN), (const bf16_t*)(ws + WS_WQ + (size_t)LYR * QW * 768 * 2), nq, QW, 768};
          pg8::StaticOrder S; S.init(nq, QW, G, bid); pg8::EpiQ E{(bf16_t*)(ws + WS_Q), (const float*)(ws + WS_ROPE), (const float*)(ws + WS_ROPE) + 2048 * 32};
          GEMM_CALL(pg8::EpiQ, pg8::StaticOrder, g, S, E); }
        __syncthreads();
        { pg8::Gemm g{(const bf16_t*)(ws + WS_CKVN), (const bf16_t*)(ws + WS_WKV + (size_t)LYR * KVW * 512 * 2), NTOK, 1024, 512};
          pg8::StaticOrder S; S.init(NTOK, 1024, G, bid); pg8::EpiStore E{(bf16_t*)(ws + WS_KN), 1024};
          GEMM_CALL(pg8::EpiStore, pg8::StaticOrder, g, S, E); }
        __syncthreads();
        { pg8::Gemm g{(const bf16_t*)(ws + WS_WKV + (size_t)LYR * KVW * 512 * 2 + (size_t)1024 * 512 * 2), (const bf16_t*)(ws + WS_CKVN), 1024, NTOK, 512};
          pg8::StaticOrder S; S.init(1024, NTOK, 108, bid >= 216 ? bid - 216 : (bid >= 144 ? bid - 108 : (1 << 24))); pg8::EpiStore E{(bf16_t*)(ws + WS_VT), NTOK};
          GEMM_CALL(pg8::EpiStore, pg8::StaticOrder, g, S, E); }
        __syncthreads();
        ph_hyena(a, LYR, lds);
        if (!LAST) ph_hyena_naive<C>(a, LYR, (float*)lds);
        ph_swa(a, LYR, !LAST, lds);
        conv_fill(a, (float*)lds, LYR * 6 + 1);
    }
    SEAM(P0 + 3);
    if (IN(P0 + 4)) { ph_mla(a, !LAST, lds); conv_fill(a, (float*)lds, LYR * 6 + 2); }
    SEAM(P0 + 4);
    if (IN(P0 + 5)) {
        pg8::Gemm g{(const bf16_t*)(ws + WS_MIX), (const bf16_t*)(ws + WS_WOUT + (size_t)LYR * D * D * 2), nq, D, D};
        pg8::StaticOrder S; S.init(nq, D, G, bid); pg8::EpiResid E{xs, modl + 4096, 1.0f};
        GEMM_CALL(pg8::EpiResid, pg8::StaticOrder, g, S, E);
        conv_fill(a, (float*)lds, LYR * 6 + 3);
    }
    SEAM(P0 + 5);
    if (!LAST) {
#if !FP8_DENSE
        if (IN(P0 + 6)) { ph_normmod<false, false>(xs, xs + (size_t)NLAT * D, a.in[7], modl, 6144, 8192, (bf16_t*)(ws + WS_HA), NTOK, nullptr, nullptr, nullptr, nullptr);
            conv_finish(a, (float*)lds, CONV_DENSE_END); }
        SEAM(P0 + 6);
        if (IN(P0 + 7)) {
            pg8::Gemm g{(const bf16_t*)(ws + WS_HA), (const bf16_t*)(ws + WS_WGU), NTOK, 2 * DFF, D};
            pg8::StaticOrder S; S.init(NTOK, 2 * DFF, G, bid); pg8::EpiSwiGLU E{(bf16_t*)(ws + WS_ACT), DFF};
            GEMM_CALL(pg8::EpiSwiGLU, pg8::StaticOrder, g, S, E);
            conv_fill(a, (float*)lds, 4);
        }
        SEAM(P0 + 7);
        if (IN(P0 + 8)) {
            pg8::Gemm g{(const bf16_t*)(ws + WS_ACT), (const bf16_t*)(ws + WS_WDN), NTOK, D, DFF};
            pg8::StaticOrder S; S.init(NTOK, D, G, bid); pg8::EpiResid E{xs, modl + 10240, 1.0f};
            GEMM_CALL(pg8::EpiResid, pg8::StaticOrder, g, S, E);
            conv_fill(a, (float*)lds, 5);
        }
#else
        if (IN(P0 + 6)) { ph_normmod<false, false, true>(xs, xs + (size_t)NLAT * D, a.in[7], modl, 6144, 8192, (bf16_t*)(ws + WS_HA), NTOK, nullptr, nullptr, nullptr, nullptr);
            conv_finish(a, (float*)lds, CONV_DENSE_END); }
        SEAM(P0 + 6);
        if (IN(P0 + 7)) {
            pg8::Gemm g{(const bf16_t*)(ws + WS_HA), (const bf16_t*)(ws + WS_WGU), NTOK, 2 * DFF, D / 2};
            pg8::StaticOrder S; S.init(NTOK, 2 * DFF, G, bid); pg8::EpiSwiGLU8 E{(unsigned char*)(ws + WS_ACT), DFF, 1.0f / (ASCALE * WSCALE), ASCALE};
            GEMM_CALL8(pg8::EpiSwiGLU8, pg8::StaticOrder, g, S, E);
            conv_fill(a, (float*)lds, 4);
        }
        SEAM(P0 + 7);
        if (IN(P0 + 8)) {
            pg8::Gemm g{(const bf16_t*)(ws + WS_ACT), (const bf16_t*)(ws + WS_WDN), NTOK, D, DFF / 2};
            pg8::StaticOrder S; S.init(NTOK, D, G, bid); pg8::EpiResid E{xs, modl + 10240, 1.0f / (ASCALE * WSCALE)};
            GEMM_CALL8(pg8::EpiResid, pg8::StaticOrder, g, S, E);
            conv_fill(a, (float*)lds, 5);
        }
#endif
        SEAM(P0 + 8);
    } else {
        if (IN(P0 + 6)) ph_normmod<true, false, true>(xs, xs + (size_t)NLAT * D, a.in[7] + D, modl, 6144, 8192, (bf16_t*)(ws + WS_HA), NLAT, nullptr, a.in[29], (int*)(ws + WS_TOPI), (float*)(ws + WS_TOPW));
        SEAM(P0 + 6);
        if (IN(P0 + 7)) ph_route(a, (int*)lds);
        SEAM(P0 + 7);
        if (IN(P0 + 8)) { ph_gather(a); conv_finish(a, (float*)lds, NCONV); }
        SEAM(P0 + 8);
        if (IN(P0 + 9)) {
            pg8::Gemm g{(const bf16_t*)(ws + WS_HBS), (const bf16_t*)(ws + WS_MGU), MOE_ROWS, 2 * DFE, D / 2};
            pg8::MoeOrder S; S.init((const int*)(ws + WS_CTL), 2 * DFE / 256, G, bid, (size_t)2 * DFE * D); pg8::EpiSwiGLU8 E{(unsigned char*)(ws + WS_ACT), DFE, 1.0f / (ASCALE * WSCALE), ASCALE};
            GEMM_CALL8(pg8::EpiSwiGLU8, pg8::MoeOrder, g, S, E);
        }
        SEAM(P0 + 9);
        if (IN(P0 + 10)) {
            pg8::Gemm g{(const bf16_t*)(ws + WS_ACT), (const bf16_t*)(ws + WS_MDN), MOE_ROWS, D, DFE / 2};
            pg8::MoeOrder S; S.init((const int*)(ws + WS_CTL), D / 256, G, bid, (size_t)D * DFE); pg8::EpiF32 E{(float*)(ws + WS_YS), D, 1.0f / (ASCALE * WSCALE)};
            GEMM_CALL8(pg8::EpiF32, pg8::MoeOrder, g, S, E);
        }
        SEAM(P0 + 10);
        if (IN(P0 + 11)) ph_final(a);
    }
#undef IN
#undef SEAM
}

__global__ void __launch_bounds__(NTHR, 2) mk_fwd(Args a) {
    extern __shared__ __attribute__((aligned(16))) unsigned char lds[];
    const int tid = threadIdx.x;
    for (int u = tid; u < (LDS_BYTES - LDSCTL_OFF) / 4; u += NTHR) ((unsigned*)(lds + LDSCTL_OFF))[u] = 0u;
    __syncthreads();
    XcdBarrier bar; bar.bar = (unsigned*)(a.ws + WS_CTL) + CW_BAR; bar.x = 0; bar.st = nullptr;
#if !MK_PER_PHASE
    bar = xcd_barrier_post((unsigned*)(a.ws + WS_CTL) + CW_BAR, (volatile LAS unsigned*)(lds + LDSCTL_OFF + 32));
#endif
    const int lo = a.ph_lo, hi = a.ph_hi;
    if (lo <= 0 && 0 < hi) {
        ph_prologue(a, (float*)lds);
#if !MK_PER_PHASE
        if (1 < hi) xcd_barrier(bar);
#endif
    }
    layer_phases<0>(a, lds, bar, lo, hi);
    layer_phases<1>(a, lds, bar, lo, hi);
}

extern "C" void kernel_launch(void* const* d_in, const int* in_sizes, int n_in, void* d_out, int out_size, void* d_ws, size_t ws_size, hipStream_t stream) {
    (void)in_sizes; (void)out_size;
    static int grid = 0;
    if (grid == 0) {
        if (n_in != 34 || ws_size < WS_END) { fprintf(stderr, "kernel_launch: need 34 inputs and >= %zu bytes of workspace (got %d, %zu)\n", (size_t)WS_END, n_in, ws_size); grid = -1; return; }
        int dev = 0, cus = 0, per_cu = 0;
        if (hipGetDevice(&dev) != hipSuccess || hipDeviceGetAttribute(&cus, hipDeviceAttributeMultiprocessorCount, dev) != hipSuccess) { grid = -1; return; }
        if (hipFuncSetAttribute((const void*)mk_fwd, hipFuncAttributeMaxDynamicSharedMemorySize, LDS_BYTES) != hipSuccess) { fprintf(stderr, "kernel_launch: hipFuncSetAttribute failed\n"); grid = -1; return; }
        if (hipOccupancyMaxActiveBlocksPerMultiprocessor(&per_cu, (const void*)mk_fwd, NTHR, LDS_BYTES) != hipSuccess || per_cu < 1) { fprintf(stderr, "kernel_launch: occupancy query says %d blocks per CU\n", per_cu); }
        (void)hipGetLastError();
        grid = cus;
    }
    if (grid < 0) return;
    if (hipMemsetAsync((char*)d_ws + WS_CTL, 0, CTL_ZERO_BYTES, stream) != hipSuccess) return;
    Args a{};
    for (int i = 0; i < 34; ++i) a.in[i] = (const float*)d_in[i];
    a.out = (float*)d_out; a.ws = (unsigned char*)d_ws;
#if MK_PER_PHASE
    for (int p = 0; p < NPHASES; ++p) { a.ph_lo = p; a.ph_hi = p + 1; hipLaunchKernelGGL(mk_fwd, dim3(grid), dim3(NTHR), LDS_BYTES, stream, a); }
#else
    a.ph_lo = 0; a.ph_hi = NPHASES;
    hipLaunchKernelGGL(mk_fwd, dim3(grid), dim3(NTHR), LDS_BYTES, stream, a);
#endif
}
```

```cpp
#include <hip/hip_runtime.h>
#include <stdint.h>
#include <stdio.h>

#ifndef FP8_DENSE
#define FP8_DENSE 0
#endif
#ifndef CONV_FILL
#define CONV_FILL 0
#endif
#ifndef PROBE_MASK
#define PROBE_MASK 0u
#endif
#ifndef PROBE_SUB
#define PROBE_SUB 0u
#endif
#ifndef MK_PER_PHASE
#define MK_PER_PHASE 0
#endif

typedef unsigned short bf16_t;
typedef float f32x4 __attribute__((ext_vector_type(4)));
typedef float f32x16 __attribute__((ext_vector_type(16)));
typedef unsigned u32x4 __attribute__((ext_vector_type(4)));
typedef unsigned u32x2 __attribute__((ext_vector_type(2)));
typedef short bf16x8 __attribute__((ext_vector_type(8)));

constexpr int D = 2048, NB = 4, L = 2048, C = 256, NLAT = NB * L, NCTX = NB * C, NTOK = NLAT + NCTX;
constexpr int UW = 3840;
constexpr int O_CQ = 0, O_CKV = 768, O_KPE = 1280, O_HY = 1344, O_SQ = 2880, O_SK = 3392, O_SV = 3520, INW = 3648;
constexpr int QW = 1536, KVW = 2048, DFF = 5632, DFE = 7168, NE = 8;
constexpr int MOE_ROWS = 18432;
constexpr float EPS = 1e-6f;
constexpr int NTHR = 512;
constexpr int HY_RBROW = 4112;

__device__ __forceinline__ float bf2f(bf16_t h) { return __uint_as_float(((unsigned)h) << 16); }
__device__ __forceinline__ bf16_t f2bf(float f) { unsigned u = __float_as_uint(f); u += 0x7fffu + ((u >> 16) & 1u); return (bf16_t)(u >> 16); }
__device__ __forceinline__ float wave_sum(float v) { for (int o = 32; o > 0; o >>= 1) v += __shfl_xor(v, o); return v; }
__device__ __forceinline__ float wave_max(float v) { for (int o = 32; o > 0; o >>= 1) v = fmaxf(v, __shfl_xor(v, o)); return v; }
__device__ __forceinline__ float silu(float x) { return x / (1.0f + __expf(-x)); }
__device__ __forceinline__ int tok_mod(int tok) { return tok < NLAT ? (tok >> 11) : 4; }

constexpr size_t al(size_t x) { return (x + 255) & ~(size_t)255; }
constexpr size_t WS_CTL = 0, CTL_ZERO_BYTES = 65536;
constexpr size_t WS_MOD = 65536;
constexpr size_t WS_ROPE = WS_MOD + al((size_t)2 * 5 * 12288 * 4);
constexpr size_t WS_FILTL = WS_ROPE + al((size_t)2 * 2048 * 32 * 4);
constexpr size_t WS_FILTC = WS_FILTL + al((size_t)2 * 512 * 4096 * 4);
constexpr size_t WS_WIN = WS_FILTC + al((size_t)2 * 512 * 512 * 4);
constexpr size_t WS_WQ = WS_WIN + al((size_t)2 * UW * D * 2);
constexpr size_t WS_WKV = WS_WQ + al((size_t)2 * QW * 768 * 2);
constexpr size_t WS_WOUT = WS_WKV + al((size_t)2 * KVW * 512 * 2);
constexpr size_t WS_WGU = WS_WOUT + al((size_t)2 * D * D * 2);
constexpr size_t WS_WDN = WS_WGU + al((size_t)2 * DFF * D * 2);
constexpr size_t WS_MGU = WS_WDN + al((size_t)D * DFF * 2);
constexpr size_t WS_MDN = WS_MGU + al((size_t)NE * 2 * DFE * D * 2);
constexpr size_t WS_HA = WS_MDN + al((size_t)NE * D * DFE * 2);
constexpr size_t WS_U = WS_HA + al((size_t)NTOK * D * 2);
constexpr size_t WS_CQN = WS_U + al((size_t)NTOK * UW * 2);
constexpr size_t WS_CKVN = WS_CQN + al((size_t)NTOK * 768 * 2);
constexpr size_t WS_KPE = WS_CKVN + al((size_t)NTOK * 512 * 2);
constexpr size_t WS_X0 = WS_KPE + al((size_t)NTOK * 64 * 2);
constexpr size_t WS_WTL = WS_X0 + al((size_t)NTOK * 512 * 2);
constexpr size_t WS_WTC = WS_WTL + al((size_t)NB * 512 * L * 2);
constexpr size_t WS_SQ = WS_WTC + al((size_t)NB * 512 * C * 2);
constexpr size_t WS_SK = WS_SQ + al((size_t)NTOK * 512 * 2);
constexpr size_t WS_SV = WS_SK + al((size_t)NTOK * 128 * 2);
constexpr size_t WS_Q = WS_SV + al((size_t)NTOK * 128 * 2);
constexpr size_t WS_KV = WS_Q + al((size_t)NTOK * QW * 2);
constexpr size_t WS_KN = WS_KV;
constexpr size_t WS_VT = WS_KV + (size_t)NTOK * 1024 * 2;
constexpr size_t WS_MIX = WS_KV + al((size_t)NTOK * KVW * 2);
constexpr size_t WS_MIXEND = WS_MIX + al((size_t)NTOK * D * 2);
constexpr size_t WS_YS = WS_U;
static_assert(WS_YS + (size_t)MOE_ROWS * D * 4 <= WS_MIXEND, "ys overlay");
constexpr size_t WS_XS = WS_MIXEND;
constexpr size_t WS_ACT = WS_XS + al((size_t)NTOK * D * 4);
constexpr size_t WS_HBS = WS_ACT + al((size_t)MOE_ROWS * DFE * 2);
constexpr size_t WS_TOPI = WS_HBS + al((size_t)MOE_ROWS * D * 2);
constexpr size_t WS_TOPW = WS_TOPI + al((size_t)NLAT * 2 * 4);
constexpr size_t WS_POS = WS_TOPW + al((size_t)NLAT * 2 * 4);
constexpr size_t WS_SRC = WS_POS + al((size_t)NLAT * 2 * 4);
constexpr size_t WS_SLAB = WS_SRC + al((size_t)MOE_ROWS * 4);
constexpr size_t WS_END = WS_SLAB + ((size_t)64 << 20);
constexpr int CT_EOFF = 1024, CT_EPAD = 1040, CT_NTILE = 1056, CT_MOES = 1057, CT_TROW = 1058;
constexpr int CW_BAR = 4096;

constexpr int RING_BYTES = 131072, LDSCTL_OFF = RING_BYTES, LDS_BYTES = 147456;

namespace pg8 {
#define PG8_LAS __attribute__((address_space(3)))
typedef unsigned short bf16_t;
typedef short bf16x8 __attribute__((ext_vector_type(8)));
typedef float f32x4 __attribute__((ext_vector_type(4)));
typedef unsigned u32x4 __attribute__((ext_vector_type(4)));
constexpr int BM = 256, BK = 64, HALF = 128, HTB = HALF * BK * 2  , STAGE_BYTES = 8 * HTB, NXCD = 8, WGM = 8;

__host__ __device__ __forceinline__ int lds_byte(int r, int c) { const int st = (r >> 4) * 2 + (c >> 5), rr = r & 15, cc = c & 31, ob = rr * 64 + cc * 2; return st * 1024 + (ob ^ (((ob >> 9) & 1) << 5)); }
__host__ __device__ __forceinline__ void stage_rc(int b, int& R, int& C) { const int st = b / 1024, sb = b % 1024, swz = sb ^ (((sb >> 9) & 1) << 5); R = (st >> 1) * 16 + swz / 64; C = (st & 1) * 32 + (swz % 64) / 2; }
__host__ __device__ __forceinline__ int perm32(int rho) { const int n = rho >> 4, i = rho & 15; return 8 * (i >> 2) + 4 * n + (i & 3); }

struct Unit { int pm, pn, kt0, nkt, slab; };
struct Gemm { const bf16_t* A; const bf16_t* Bt; int M, N, K; };

struct StaticOrder {
    int nM, nN, nwg, G, c;
    int nkt;
    __host__ __device__ void init(int M, int N, int G_, int c_, int K) { nM = M / BM; nN = N / BM; nwg = nM * nN; G = G_; c = c_; nkt = K / BK; }
    __host__ __device__ bool next(int i, Unit& u) const {
        const long L = (long)i * G + c; if (L >= nwg) return false;
        int wgid = (int)L; { const int q = nwg / NXCD, r = nwg % NXCD, xcd = wgid % NXCD, off = wgid / NXCD; wgid = (xcd < r ? xcd * (q + 1) : r * (q + 1) + (xcd - r) * q) + off; }
        const int nig = WGM * nN, gid = wgid / nig, fm = gid * WGM, gsz = (nM - fm) < WGM ? (nM - fm) : WGM;
        u.pm = fm + ((wgid % nig) % gsz); u.pn = (wgid % nig) / gsz; u.kt0 = 0; u.nkt = nkt; u.slab = -1; return true;
    }
    __device__ __forceinline__ size_t bt_off(const Unit&) const { return 0; }
    __device__ __forceinline__ void a_ready(const Unit&) const {}
    __device__ __forceinline__ void done(const Unit&) const {}
};

__device__ __forceinline__ unsigned cvt_pk_bf16(float lo, float hi) { unsigned r; asm volatile("v_cvt_pk_bf16_f32 %0, %1, %2" : "=v"(r) : "v"(lo), "v"(hi)); return r; }
typedef float f32x2 __attribute__((ext_vector_type(2)));
typedef int v8i_t __attribute__((ext_vector_type(8))); typedef int v4i_t __attribute__((ext_vector_type(4)));
template <bool F8> struct Frag;
template <> struct Frag<false> { bf16x8 h[2]; __device__ __forceinline__ void set0(bf16x8 x) { h[0] = x; } __device__ __forceinline__ void set1(bf16x8 x) { h[1] = x; } };
template <> struct Frag<true> { v8i_t v; __device__ __forceinline__ void set0(bf16x8 x) { v.lo = __builtin_bit_cast(v4i_t, x); } __device__ __forceinline__ void set1(bf16x8 x) { v.hi = __builtin_bit_cast(v4i_t, x); } };
template <class Epi, class Sched, bool ALIGN_EPI = false, bool SP2 = false, bool FP8 = false>
__device__ __forceinline__ void gemm_phase(PG8_LAS unsigned char* lds, const Gemm g, const Sched& S, const Epi& E) {
    int tid_ = threadIdx.x; asm volatile("" : "+v"(tid_));
    const int tid = tid_, wid = __builtin_amdgcn_readfirstlane(tid >> 6), lane = tid & 63, wr = wid >> 2, wc = wid & 3, fr = lane & 15, fq = lane >> 4;
    const int K = g.K;
    unsigned voffA[2], voffB[2];
#pragma unroll
    for (int i = 0; i < 2; ++i) { int R, C; stage_rc(tid * 16 + i * 8192, R, C); const int Rb = Epi::PERM ? ((R & ~31) + perm32(R & 31)) : R;
        voffA[i] = (unsigned)(R * K + C) * 2u; voffB[i] = (unsigned)(Rb * K + C) * 2u; }
    const size_t kstep = (size_t)(BK * 2);
    const size_t hstep = (size_t)HALF * K * 2;
    const size_t tstep = 2 * hstep;
    const unsigned ldsw = (unsigned)wid * 1024u;
    const int aoff = lds_byte(wr * 64 + fr, fq * 8), boff = lds_byte(wc * 32 + fr, fq * 8);
#define PG8_SA(b, h) (((b) * 2 + (h)) * HTB)
#define PG8_SB(b, h) ((4 + (b) * 2 + (h)) * HTB)
#define PG8_STAGE(bufoff, gbase, voff) do { _Pragma("unroll") for (int _i = 0; _i < 2; ++_i) \
        __builtin_amdgcn_global_load_lds((const unsigned*)((const char*)(gbase) + (voff)[_i]), (PG8_LAS unsigned*)(lds + (bufoff) + ldsw + _i * 8192), 16, 0, 0); } while (0)
#define PG8_LDA(dst, b, h) do { _Pragma("unroll") for (int m = 0; m < 4; ++m) { dst[m].set0(*(const PG8_LAS bf16x8*)(lds + PG8_SA(b, h) + aoff + m * 2048)); dst[m].set1(*(const PG8_LAS bf16x8*)(lds + PG8_SA(b, h) + aoff + m * 2048 + 1024)); } } while (0)
#define PG8_LDB(dst, b, h) do { _Pragma("unroll") for (int n = 0; n < 2; ++n) { dst[n].set0(*(const PG8_LAS bf16x8*)(lds + PG8_SB(b, h) + boff + n * 2048)); dst[n].set1(*(const PG8_LAS bf16x8*)(lds + PG8_SB(b, h) + boff + n * 2048 + 1024)); } } while (0)
#define PG8_MMA(ai, bj, At, Bt) do { __builtin_amdgcn_s_setprio(1); _Pragma("unroll") for (int m = 0; m < 4; ++m) _Pragma("unroll") for (int n = 0; n < 2; ++n) { \
        if constexpr (FP8) asm volatile("v_mfma_f32_16x16x128_f8f6f4 %0, %1, %2, %0" : "+v"(acc[ai][bj][m][n]) : "v"(Bt[n].v), "v"(At[m].v));   \
        else { _Pragma("unroll") for (int k = 0; k < 2; ++k) acc[ai][bj][m][n] = __builtin_amdgcn_mfma_f32_16x16x32_bf16(Bt[n].h[k], At[m].h[k], acc[ai][bj][m][n], 0, 0, 0); } } \
        __builtin_amdgcn_s_setprio(0); } while (0)
#define PG8_WAIT_V(n) asm volatile("s_waitcnt vmcnt(" #n ")" ::: "memory")
#define PG8_WAIT_L(n) asm volatile("s_waitcnt lgkmcnt(" #n ")" ::: "memory")
#define PG8_BAR __builtin_amdgcn_s_barrier()
#define PG8_SCHED __builtin_amdgcn_sched_barrier(0)
    Unit cur, nxt; int ui = 0;
    if (!S.next(0, cur)) return;
    f32x4 acc[2][2][4][2];
#pragma unroll
    for (int a = 0; a < 2; ++a)
#pragma unroll
        for (int b = 0; b < 2; ++b)
#pragma unroll
            for (int m = 0; m < 4; ++m)
#pragma unroll
                for (int n = 0; n < 2; ++n) acc[a][b][m][n] = (f32x4){0.f, 0.f, 0.f, 0.f};
    Frag<FP8> At[4], B0[2], B1[2];
    const char* cA = (const char*)g.A + (size_t)cur.pm * tstep + (size_t)cur.kt0 * kstep; const char* cB = (const char*)g.Bt + S.bt_off(cur) + (size_t)cur.pn * tstep + (size_t)cur.kt0 * kstep;
    S.a_ready(cur);
    if constexpr (SP2) {
        PG8_STAGE(PG8_SB(0, 0), cB, voffB); PG8_STAGE(PG8_SB(0, 1), cB + hstep, voffB); PG8_STAGE(PG8_SA(0, 0), cA, voffA); PG8_STAGE(PG8_SA(0, 1), cA + hstep, voffA);
        if (wr == 1) PG8_BAR;
        PG8_WAIT_V(2); PG8_BAR;
        PG8_STAGE(PG8_SB(1, 0), cB + kstep, voffB); PG8_STAGE(PG8_SA(1, 0), cA + kstep, voffA); PG8_STAGE(PG8_SB(1, 1), cB + hstep + kstep, voffB);
        PG8_WAIT_V(6); PG8_BAR;
    } else {
        PG8_STAGE(PG8_SB(0, 0), cB, voffB); PG8_STAGE(PG8_SA(0, 0), cA, voffA); PG8_STAGE(PG8_SB(0, 1), cB + hstep, voffB); PG8_STAGE(PG8_SA(0, 1), cA + hstep, voffA);
        if (wr == 1) PG8_BAR;
        PG8_WAIT_V(4); PG8_BAR;
        PG8_STAGE(PG8_SB(1, 0), cB + kstep, voffB); PG8_STAGE(PG8_SA(1, 0), cA + kstep, voffA); PG8_STAGE(PG8_SB(1, 1), cB + hstep + kstep, voffB);
        PG8_WAIT_V(6); PG8_BAR;
    }
    for (;;) {
        const bool has_next = S.next(ui + 1, nxt);
        const char* nA = has_next ? (const char*)g.A + (size_t)nxt.pm * tstep + (size_t)nxt.kt0 * kstep : cA; const char* nB = has_next ? (const char*)g.Bt + S.bt_off(nxt) + (size_t)nxt.pn * tstep + (size_t)nxt.kt0 * kstep : cB;
        const int nt = cur.nkt;
        for (int t = 0; t < nt; t += 2) {
            const bool last = (t == nt - 2);
            const char* a1 = cA + (size_t)(t + 1) * kstep;
            const char* a2 = last ? nA : cA + (size_t)(t + 2) * kstep; const char* b2 = last ? nB : cB + (size_t)(t + 2) * kstep;
            const char* a3 = a2 + kstep; const char* b3 = b2 + kstep;
            if (last && has_next) S.a_ready(nxt);
            if constexpr (SP2) {
            PG8_LDB(B0, 0, 0); PG8_LDB(B1, 0, 1); PG8_SCHED; PG8_LDA(At, 0, 0); PG8_STAGE(PG8_SA(1, 1), a1 + hstep, voffA);
            PG8_WAIT_V(8); PG8_WAIT_L(0); PG8_BAR; PG8_MMA(0, 0, At, B0); PG8_MMA(0, 1, At, B1); PG8_BAR; PG8_SCHED;
            PG8_LDA(At, 0, 1); PG8_STAGE(PG8_SB(0, 0), b2, voffB); PG8_STAGE(PG8_SB(0, 1), b2 + hstep, voffB); PG8_STAGE(PG8_SA(0, 0), a2, voffA);
            PG8_WAIT_V(8); PG8_WAIT_L(0); PG8_BAR; PG8_MMA(1, 0, At, B0); PG8_MMA(1, 1, At, B1); PG8_BAR; PG8_SCHED;
            PG8_LDB(B0, 1, 0); PG8_LDB(B1, 1, 1); PG8_SCHED; PG8_LDA(At, 1, 0); PG8_STAGE(PG8_SA(0, 1), a2 + hstep, voffA);
            PG8_WAIT_V(8); PG8_WAIT_L(0); PG8_BAR; PG8_MMA(0, 0, At, B0); PG8_MMA(0, 1, At, B1); PG8_BAR; PG8_SCHED;
            PG8_LDA(At, 1, 1); PG8_STAGE(PG8_SB(1, 0), b3, voffB); PG8_STAGE(PG8_SB(1, 1), b3 + hstep, voffB); PG8_STAGE(PG8_SA(1, 0), a3, voffA);
            PG8_WAIT_V(8); PG8_WAIT_L(0); PG8_BAR; PG8_MMA(1, 0, At, B0); PG8_MMA(1, 1, At, B1); PG8_BAR; PG8_SCHED;
            } else {
            PG8_LDB(B0, 0, 0); PG8_SCHED; PG8_LDA(At, 0, 0); PG8_STAGE(PG8_SA(1, 1), a1 + hstep, voffA);
            PG8_WAIT_L(8); PG8_BAR; PG8_WAIT_L(0); PG8_MMA(0, 0, At, B0); PG8_BAR; PG8_SCHED;
            PG8_LDB(B1, 0, 1); PG8_STAGE(PG8_SB(0, 0), b2, voffB);
            PG8_BAR; PG8_WAIT_L(0); PG8_MMA(0, 1, At, B1); PG8_BAR;
            PG8_LDA(At, 0, 1); PG8_STAGE(PG8_SA(0, 0), a2, voffA);
            PG8_BAR; PG8_WAIT_L(0); PG8_MMA(1, 0, At, B0); PG8_BAR; PG8_SCHED;
            PG8_STAGE(PG8_SB(0, 1), b2 + hstep, voffB);
            PG8_WAIT_V(6); PG8_BAR; PG8_MMA(1, 1, At, B1); PG8_BAR;
            PG8_LDB(B0, 1, 0); PG8_SCHED; PG8_LDA(At, 1, 0); PG8_STAGE(PG8_SA(0, 1), a2 + hstep, voffA);
            PG8_WAIT_L(8); PG8_BAR; PG8_WAIT_L(0); PG8_MMA(0, 0, At, B0); PG8_BAR; PG8_SCHED;
            PG8_LDB(B1, 1, 1); PG8_STAGE(PG8_SB(1, 0), b3, voffB);
            PG8_BAR; PG8_WAIT_L(0); PG8_MMA(0, 1, At, B1); PG8_BAR;
            PG8_LDA(At, 1, 1); PG8_STAGE(PG8_SA(1, 0), a3, voffA);
            PG8_BAR; PG8_WAIT_L(0); PG8_MMA(1, 0, At, B0); PG8_BAR; PG8_SCHED;
            PG8_STAGE(PG8_SB(1, 1), b3 + hstep, voffB);
            PG8_WAIT_V(6); PG8_BAR; PG8_MMA(1, 1, At, B1); PG8_BAR;
            }
        }
        if constexpr (ALIGN_EPI) { if (wr == 0) PG8_BAR; }
        if constexpr (FP8) asm volatile("s_nop 15\n\ts_nop 15" ::: "memory");
        if constexpr (!Epi::AFTER_DRAIN) { E(acc, cur, wr, wc, fr, fq); S.done(cur); }
        if (!has_next) break;
#pragma unroll
        for (int a = 0; a < 2; ++a)
#pragma unroll
            for (int b = 0; b < 2; ++b)
#pragma unroll
                for (int m = 0; m < 4; ++m)
#pragma unroll
                    for (int n = 0; n < 2; ++n) acc[a][b][m][n] = (f32x4){0.f, 0.f, 0.f, 0.f};
        cur = nxt; cA = nA; cB = nB; ++ui;
        if constexpr (ALIGN_EPI) { if (wr == 1) PG8_BAR; }
    }
    PG8_WAIT_V(0);
    if constexpr (!ALIGN_EPI) { if (wr == 0) PG8_BAR; }
    PG8_BAR;
    if constexpr (Epi::AFTER_DRAIN) { E.fused(acc, cur, wr, wc, fr, fq, lds, wid, lane); S.done(cur); }
#undef PG8_SA
#undef PG8_SB
#undef PG8_STAGE
#undef PG8_LDA
#undef PG8_LDB
#undef PG8_MMA
#undef PG8_WAIT_V
#undef PG8_WAIT_L
#undef PG8_BAR
#undef PG8_SCHED
}
}

namespace pg8 {
__device__ __forceinline__ u32x4 pack8(const f32x4 v0, const f32x4 v1) { u32x4 w; w.x = cvt_pk_bf16(v0[0], v0[1]); w.y = cvt_pk_bf16(v0[2], v0[3]); w.z = cvt_pk_bf16(v1[0], v1[1]); w.w = cvt_pk_bf16(v1[2], v1[3]); return w; }
struct EpiStore {
    static constexpr bool PERM = true, AFTER_DRAIN = false;
    bf16_t* O; int ldc;
    __device__ __forceinline__ void operator()(const f32x4 (&acc)[2][2][4][2], const Unit& u, int wr, int wc, int fr, int fq) const {
        const int row0 = u.pm * BM + wr * 64 + fr, col0 = u.pn * BM + wc * 32 + 8 * fq;
#pragma unroll
        for (int ai = 0; ai < 2; ++ai)
#pragma unroll
            for (int m = 0; m < 4; ++m) { bf16_t* rowp = O + (size_t)(row0 + ai * HALF + m * 16) * ldc + col0;
#pragma unroll
                for (int bj = 0; bj < 2; ++bj) *(u32x4*)(rowp + bj * HALF) = pack8(acc[ai][bj][m][0], acc[ai][bj][m][1]); }
    }
};
struct EpiQ {
    static constexpr bool PERM = true, AFTER_DRAIN = false;
    bf16_t* O; const float* cosT; const float* sinT;
    __device__ __forceinline__ void operator()(const f32x4 (&acc)[2][2][4][2], const Unit& u, int wr, int wc, int fr, int fq) const {
        const int row0 = u.pm * BM + wr * 64 + fr, col0 = u.pn * BM + wc * 32 + 8 * fq;
#pragma unroll
        for (int ai = 0; ai < 2; ++ai)
#pragma unroll
            for (int m = 0; m < 4; ++m) { const int row = row0 + ai * HALF + m * 16; const bool lat = row < 8192; const int t = row & 2047;
#pragma unroll
                for (int bj = 0; bj < 2; ++bj) { const int col = col0 + bj * HALF; const int jn = col - 192 * (col / 192);
                    f32x4 v0 = acc[ai][bj][m][0], v1 = acc[ai][bj][m][1];
                    if (jn >= 128 && lat) { const int i0 = (jn - 128) >> 1;
                        const f32x4 cs = *(const f32x4*)(cosT + t * 32 + i0), sn = *(const f32x4*)(sinT + t * 32 + i0);
                        f32x4 r0, r1;
                        r0[0] = v0[0] * cs[0] - v0[1] * sn[0]; r0[1] = v0[0] * sn[0] + v0[1] * cs[0];
                        r0[2] = v0[2] * cs[1] - v0[3] * sn[1]; r0[3] = v0[2] * sn[1] + v0[3] * cs[1];
                        r1[0] = v1[0] * cs[2] - v1[1] * sn[2]; r1[1] = v1[0] * sn[2] + v1[1] * cs[2];
                        r1[2] = v1[2] * cs[3] - v1[3] * sn[3]; r1[3] = v1[2] * sn[3] + v1[3] * cs[3];
                        v0 = r0; v1 = r1; }
                    *(u32x4*)(O + (size_t)row * 1536 + col) = pack8(v0, v1); } }
    }
};
struct EpiResid {
    static constexpr bool PERM = false, AFTER_DRAIN = false;
    float* xs; const float* gate; float* slab; int tail_row0, tail_rows; float scale;
    __device__ __forceinline__ void operator()(const f32x4 (&acc)[2][2][4][2], const Unit& u, int wr, int wc, int fr, int fq) const {
        const int row0 = u.pm * BM + wr * 64 + fr, colb = u.pn * BM + wc * 32 + 4 * fq;
        if (u.slab >= 0) {
#pragma unroll
            for (int ai = 0; ai < 2; ++ai)
#pragma unroll
                for (int m = 0; m < 4; ++m) { float* sp = slab + ((size_t)u.slab * tail_rows + (row0 + ai * HALF + m * 16 - tail_row0)) * 2048;
#pragma unroll
                    for (int bj = 0; bj < 2; ++bj)
#pragma unroll
                        for (int n = 0; n < 2; ++n) *(f32x4*)(sp + colb + bj * HALF + n * 16) = acc[ai][bj][m][n] * scale; }
            return;
        }
#pragma unroll
        for (int ai = 0; ai < 2; ++ai)
#pragma unroll
            for (int m = 0; m < 4; ++m) { const int row = row0 + ai * HALF + m * 16; const float* gv = gate + (size_t)(row < 8192 ? (row >> 11) : 4) * 12288; float* xr = xs + (size_t)row * 2048;
#pragma unroll
                for (int bj = 0; bj < 2; ++bj)
#pragma unroll
                    for (int n = 0; n < 2; ++n) { const int col = colb + bj * HALF + n * 16; f32x4 x = *(const f32x4*)(xr + col); const f32x4 g = *(const f32x4*)(gv + col);
                        x += (g * scale) * acc[ai][bj][m][n]; *(f32x4*)(xr + col) = x; }
                if (m & 1) asm volatile("" ::: "memory"); }
    }
};
__device__ __forceinline__ unsigned pack4_fp8(float a, float b, float c, float d) {
    a = fminf(fmaxf(a, -448.f), 448.f); b = fminf(fmaxf(b, -448.f), 448.f); c = fminf(fmaxf(c, -448.f), 448.f); d = fminf(fmaxf(d, -448.f), 448.f);
    unsigned w = 0; w = __builtin_amdgcn_cvt_pk_fp8_f32(a, b, w, false); w = __builtin_amdgcn_cvt_pk_fp8_f32(c, d, w, true); return w; }
struct EpiSwiGLU8 {
    static constexpr bool PERM = true, AFTER_DRAIN = false;
    unsigned char* O; int ldc; float s, oscale;
    __device__ __forceinline__ void operator()(const f32x4 (&acc)[2][2][4][2], const Unit& u, int wr, int wc, int fr, int fq) const {
        const int row0 = u.pm * BM + wr * 64 + fr, col0 = u.pn * HALF + wc * 32 + 8 * fq;
#pragma unroll
        for (int ai = 0; ai < 2; ++ai)
#pragma unroll
            for (int m = 0; m < 4; ++m) { f32x4 o0, o1;
#pragma unroll
                for (int j = 0; j < 4; ++j) { const float g0 = acc[ai][0][m][0][j] * s, g1 = acc[ai][0][m][1][j] * s;
                    o0[j] = g0 / (1.0f + __expf(-g0)) * (acc[ai][1][m][0][j] * (s * oscale)); o1[j] = g1 / (1.0f + __expf(-g1)) * (acc[ai][1][m][1][j] * (s * oscale)); }
                u32x2 w; w.x = pack4_fp8(o0[0], o0[1], o0[2], o0[3]); w.y = pack4_fp8(o1[0], o1[1], o1[2], o1[3]);
                *(u32x2*)(O + (size_t)(row0 + ai * HALF + m * 16) * ldc + col0) = w; }
    }
};
struct EpiSwiGLU {
    static constexpr bool PERM = true, AFTER_DRAIN = false;
    bf16_t* O; int ldc;
    __device__ __forceinline__ void operator()(const f32x4 (&acc)[2][2][4][2], const Unit& u, int wr, int wc, int fr, int fq) const {
        const int row0 = u.pm * BM + wr * 64 + fr, col0 = u.pn * HALF + wc * 32 + 8 * fq;
#pragma unroll
        for (int ai = 0; ai < 2; ++ai)
#pragma unroll
            for (int m = 0; m < 4; ++m) { f32x4 o0, o1;
#pragma unroll
                for (int j = 0; j < 4; ++j) { const float g0 = acc[ai][0][m][0][j], g1 = acc[ai][0][m][1][j];
                    o0[j] = g0 / (1.0f + __expf(-g0)) * acc[ai][1][m][0][j]; o1[j] = g1 / (1.0f + __expf(-g1)) * acc[ai][1][m][1][j]; }
                *(u32x4*)(O + (size_t)(row0 + ai * HALF + m * 16) * ldc + col0) = pack8(o0, o1); }
    }
};
struct EpiF32 {
    static constexpr bool PERM = false, AFTER_DRAIN = false;
    float* O; int ldc; float* slab; int tail_row0, tail_rows; float scale;
    __device__ __forceinline__ void operator()(const f32x4 (&acc)[2][2][4][2], const Unit& u, int wr, int wc, int fr, int fq) const {
        const int row0 = u.pm * BM + wr * 64 + fr, colb = u.pn * BM + wc * 32 + 4 * fq;
#pragma unroll
        for (int ai = 0; ai < 2; ++ai)
#pragma unroll
            for (int m = 0; m < 4; ++m) { float* xr = (u.slab >= 0) ? slab + ((size_t)u.slab * tail_rows + (row0 + ai * HALF + m * 16 - tail_row0)) * 2048 : O + (size_t)(row0 + ai * HALF + m * 16) * ldc;
#pragma unroll
                for (int bj = 0; bj < 2; ++bj)
#pragma unroll
                    for (int n = 0; n < 2; ++n) *(f32x4*)(xr + colb + bj * HALF + n * 16) = acc[ai][bj][m][n] * scale; }
    }
};
struct EpiYs {
    static constexpr bool PERM = false, AFTER_DRAIN = false;
    bf16_t* O; float* slab; int tail_row0, tail_rows; float scale;
    __device__ __forceinline__ void operator()(const f32x4 (&acc)[2][2][4][2], const Unit& u, int wr, int wc, int fr, int fq) const {
        const int row0 = u.pm * BM + wr * 64 + fr, colb = u.pn * BM + wc * 32 + 4 * fq;
        if (u.slab >= 0) {
#pragma unroll
            for (int ai = 0; ai < 2; ++ai)
#pragma unroll
                for (int m = 0; m < 4; ++m) { float* sp = slab + ((size_t)u.slab * tail_rows + (row0 + ai * HALF + m * 16 - tail_row0)) * 2048;
#pragma unroll
                    for (int bj = 0; bj < 2; ++bj)
#pragma unroll
                        for (int n = 0; n < 2; ++n) *(f32x4*)(sp + colb + bj * HALF + n * 16) = acc[ai][bj][m][n] * scale; }
            return;
        }
#pragma unroll
        for (int ai = 0; ai < 2; ++ai)
#pragma unroll
            for (int m = 0; m < 4; ++m) { bf16_t* xr = O + (size_t)(row0 + ai * HALF + m * 16) * 2048;
#pragma unroll
                for (int bj = 0; bj < 2; ++bj)
#pragma unroll
                    for (int n = 0; n < 2; ++n) { const f32x4 v = acc[ai][bj][m][n] * scale; u32x2 w; w.x = cvt_pk_bf16(v[0], v[1]); w.y = cvt_pk_bf16(v[2], v[3]); *(u32x2*)(xr + colb + bj * HALF + n * 16) = w; } }
    }
};
struct MoeOrder {
    int nM, nN, nwg, G, c, nkt; int t1[8]; size_t estride;
    __device__ __forceinline__ void init(const int* ctl, int nN_, int G_, int c_, size_t estride_, int K) { nkt = K / BK;
        int acc = 0;
#pragma unroll
        for (int e = 0; e < 8; ++e) { acc += __builtin_amdgcn_readfirstlane(ctl[CT_EPAD + e]) >> 8; t1[e] = acc; }
        nM = acc; nN = nN_; nwg = nM * nN; G = G_; c = c_; estride = estride_;
    }
    __device__ __forceinline__ bool next(int i, Unit& u) const {
        const long L = (long)i * G + c; if (L >= nwg) return false;
        int wgid = (int)L; { const int q = nwg / NXCD, r = nwg % NXCD, xcd = wgid % NXCD, off = wgid / NXCD; wgid = (xcd < r ? xcd * (q + 1) : r * (q + 1) + (xcd - r) * q) + off; }
        const int nig = WGM * nN, gid = wgid / nig, fm = gid * WGM, gsz = (nM - fm) < WGM ? (nM - fm) : WGM;
        u.pm = fm + ((wgid % nig) % gsz); u.pn = (wgid % nig) / gsz; u.kt0 = 0; u.nkt = nkt; u.slab = -1; return true;
    }
    __device__ __forceinline__ size_t bt_off(const Unit& u) const { int e = 0;
#pragma unroll
        for (int k = 0; k < 7; ++k) e += (u.pm >= t1[k]) ? 1 : 0;
        return (size_t)e * estride; }
    __device__ __forceinline__ void a_ready(const Unit&) const {}
    __device__ __forceinline__ void done(const Unit&) const {}
};
struct SplitOrder {
    int nM, nN, nwg, G, c, nfull, ntail, S, nkt, nkts; int t1[8]; size_t estride;
    __device__ __forceinline__ void init(int nM_, int nN_, int G_, int c_, int K, int S_) {
        nM = nM_; nN = nN_; nwg = nM * nN; G = G_; c = c_; nkt = K / BK; nfull = (nwg / 256) * 256; ntail = nwg - nfull; S = S_; nkts = nkt / S; estride = 0;
#pragma unroll
        for (int e = 0; e < 8; ++e) t1[e] = 0;
    }
    __device__ __forceinline__ void init_moe(const int* ctl, int nN_, int G_, int c_, int K, size_t estride_) {
        int acc = 0;
#pragma unroll
        for (int e = 0; e < 8; ++e) { acc += __builtin_amdgcn_readfirstlane(ctl[CT_EPAD + e]) >> 8; t1[e] = acc; }
        init(acc, nN_, G_, c_, K, __builtin_amdgcn_readfirstlane(ctl[CT_MOES])); estride = estride_;
        acc = 0;
#pragma unroll
        for (int e = 0; e < 8; ++e) { acc += __builtin_amdgcn_readfirstlane(ctl[CT_EPAD + e]) >> 8; t1[e] = acc; }
    }
    __device__ __forceinline__ bool next(int i, Unit& u) const {
        const long L = (long)i * G + c; int wgid;
        if (L < nfull) { wgid = (int)L; { const int q = nfull / NXCD, xcd = wgid % NXCD, off = wgid / NXCD; wgid = xcd * q + off; } u.kt0 = 0; u.nkt = nkt; u.slab = -1; }
        else { const int j = (int)(L - nfull); if (j >= ntail * S) return false; const int tu = j / S, sl = j - tu * S; wgid = nfull + tu; u.kt0 = sl * nkts; u.nkt = nkts; u.slab = (S > 1) ? sl : -1; }
        const int nig = WGM * nN, gid = wgid / nig, fm = gid * WGM, gsz = (nM - fm) < WGM ? (nM - fm) : WGM;
        u.pm = fm + ((wgid % nig) % gsz); u.pn = (wgid % nig) / gsz; return true;
    }
    __device__ __forceinline__ size_t bt_off(const Unit& u) const { if (estride == 0) return 0; int e = 0;
#pragma unroll
        for (int k = 0; k < 7; ++k) e += (u.pm >= t1[k]) ? 1 : 0;
        return (size_t)e * estride; }
    __device__ __forceinline__ void a_ready(const Unit&) const {}
    __device__ __forceinline__ void done(const Unit&) const {}
};
__host__ __device__ constexpr int split_S(int nwg, int nkt, int G) {
    const int ntail = nwg - (nwg / G) * G;
    if (ntail == 0) return 1;
    if (nkt % 28 == 0 && ntail * 14 <= G) return 14;
    if (nkt % 16 == 0 && ntail * 8 <= G) return 8;
    if (nkt % 14 == 0 && ntail * 7 <= G) return 7;
    if (nkt % 8 == 0 && ntail * 4 <= G) return 4;
    if (nkt % 4 == 0 && ntail * 2 <= G) return 2;
    return 1;
}
}

#define LAS __attribute__((address_space(3)))
#define XB_TMO      128
#define XB_XCNT(j)  (256  + 64 * (j))
#define XB_XSUB(j)  (1280 + 64 * (j))
#define XB_XGEN(j)  (2304 + 64 * (j))
#define XB_TOP      3328
#define XB_TOPGEN   3392
#define XCD_BAR_WORDS 3456
#define XB_SPIN_CAP (1u << 18)

__device__ __forceinline__ unsigned xb_ld(unsigned* p)              { return __hip_atomic_load(p, __ATOMIC_RELAXED, __HIP_MEMORY_SCOPE_AGENT); }
__device__ __forceinline__ unsigned xb_add(unsigned* p, unsigned v) { return __hip_atomic_fetch_add(p, v, __ATOMIC_RELAXED, __HIP_MEMORY_SCOPE_AGENT); }
__device__ __forceinline__ unsigned xb_xcc_id() { return (unsigned)__builtin_amdgcn_s_getreg((3 << 11) | 20) & 0xFu; }
#define XB_SPIN(cond, bar) do { unsigned _sp = 0; while (cond) { __builtin_amdgcn_s_sleep(1); \
    if ((++_sp & 255u) == 0u) { if (xb_ld(&(bar)[XB_TMO])) break; if (_sp > XB_SPIN_CAP) { atomicAdd(&(bar)[XB_TMO], 1u); break; } } } } while (0)

struct XcdBarrier {
    unsigned* bar; unsigned x;
    volatile LAS unsigned* st;
};

__device__ __forceinline__ XcdBarrier xcd_barrier_post(unsigned* bar, volatile LAS unsigned* st) {
    XcdBarrier b; b.bar = bar; b.x = xb_xcc_id(); b.st = st;
    if (threadIdx.x == 0) (void)xb_add(&bar[XB_XCNT(b.x)], 1u);
    return b;
}
__device__ __forceinline__ void xcd_barrier_complete(unsigned* bar, unsigned x, unsigned& nloc, unsigned& nx) {
    const unsigned G = gridDim.x * gridDim.y * gridDim.z;
    unsigned sum, cnt, mine, sp = 0u;
    for (;;) {
        sum = 0u; cnt = 0u; mine = 0u;
#pragma unroll
        for (unsigned j = 0; j < 16; ++j) { const unsigned c = xb_ld(&bar[XB_XCNT(j)]); sum += c; cnt += (c > 0u) ? 1u : 0u; mine = (j == x) ? c : mine; }
        if (sum == G) break;
        __builtin_amdgcn_s_sleep(1);
        if ((++sp & 255u) == 0u) { if (xb_ld(&bar[XB_TMO])) break; if (sp > XB_SPIN_CAP) { atomicAdd(&bar[XB_TMO], 1u); break; } }
    }
    nloc = mine > 0u ? mine : 1u; nx = cnt > 0u ? cnt : 1u;
}

__device__ __forceinline__ void xcd_barrier(const XcdBarrier& b) {
    asm volatile("s_waitcnt vmcnt(0)" ::: "memory");
    __syncthreads();
    if (threadIdx.x == 0) {
        unsigned* bar = b.bar;
        __builtin_amdgcn_s_waitcnt(0);
        unsigned nloc = b.st[0], nx = b.st[1];
        if (nloc == 0u) { xcd_barrier_complete(bar, b.x, nloc, nx); b.st[0] = nloc; b.st[1] = nx; }
        const unsigned old = xb_add(&bar[XB_XSUB(b.x)], 1u);
        const unsigned gen = old / nloc;
        if (old + 1u == (gen + 1u) * nloc) {
            __builtin_amdgcn_fence(__ATOMIC_RELEASE, "agent");
            asm volatile("s_waitcnt vmcnt(0)" ::: "memory");
            const unsigned og = xb_add(&bar[XB_TOP], 1u);
            const unsigned tg = og / nx;
            if (og + 1u == (tg + 1u) * nx) xb_add(&bar[XB_TOPGEN], 1u);
            else XB_SPIN(xb_ld(&bar[XB_TOPGEN]) == tg, bar);
            __builtin_amdgcn_fence(__ATOMIC_ACQUIRE, "agent");
            xb_add(&bar[XB_XGEN(b.x)], 1u);
            asm volatile("s_waitcnt vmcnt(0)" ::: "memory");
        } else {
            XB_SPIN(xb_ld(&bar[XB_XGEN(b.x)]) == gen, bar);
            __builtin_amdgcn_fence(__ATOMIC_ACQUIRE, "agent");
            asm volatile("s_waitcnt vmcnt(0)" ::: "memory");
        }
    }
    __syncthreads();
}


struct Args { const float* in[34]; float* out; unsigned char* ws; int ph_lo, ph_hi; };

enum { MAP_ID = 0, MAP_ROPEQ = 1, MAP_GU0 = 2, MAP_GU1 = 3, MAP_KV = 4 };
struct JobDesc { int in_idx, K, N, nbatch, upb, map; long long src_off, src_bstride, dst_off, dst_bstride; int fp8, pad; };
constexpr int NJOBS = 14, NCONV = 50624;
__constant__ JobDesc c_jobs[NJOBS] = {
    {8, 2048, 3648, 1, 912, MAP_ID, 0, 0, (long long)WS_WIN, 0},
    {8, 2048, 3648, 1, 912, MAP_ID, 2048LL * 3648, 0, (long long)(WS_WIN + (size_t)UW * D * 2), 0},
    {10, 768, 1536, 1, 144, MAP_ROPEQ, 0, 0, (long long)WS_WQ, 0},
    {10, 768, 1536, 1, 144, MAP_ROPEQ, 768LL * 1536, 0, (long long)(WS_WQ + (size_t)QW * 768 * 2), 0},
    {12, 512, 2048, 1, 128, MAP_KV, 0, 0, (long long)WS_WKV, 0},
    {12, 512, 2048, 1, 128, MAP_KV, 512LL * 2048, 0, (long long)(WS_WKV + (size_t)KVW * 512 * 2), 0},
    {25, 2048, 2048, 1, 512, MAP_ID, 0, 0, (long long)WS_WOUT, 0},
    {25, 2048, 2048, 1, 512, MAP_ID, 2048LL * 2048, 0, (long long)(WS_WOUT + (size_t)D * D * 2), 0},
    {26, 2048, 5632, 1, 1408, MAP_GU0, 0, 0, (long long)WS_WGU, 0, FP8_DENSE, 0},
    {27, 2048, 5632, 1, 1408, MAP_GU1, 0, 0, (long long)WS_WGU, 0, FP8_DENSE, 0},
    {28, 5632, 2048, 1, 1408, MAP_ID, 0, 0, (long long)WS_WDN, 0, FP8_DENSE, 0},
    {30, 2048, 7168, 8, 1792, MAP_GU0, 0, 2048LL * 7168, (long long)WS_MGU, 2LL * DFE * D, 1, 0},
    {31, 2048, 7168, 8, 1792, MAP_GU1, 0, 2048LL * 7168, (long long)WS_MGU, 2LL * DFE * D, 1, 0},
    {32, 7168, 2048, 8, 1792, MAP_ID, 0, 7168LL * 2048, (long long)WS_MDN, (long long)D * DFE, 1, 0},
};
struct ConvUnit { const float* src; bf16_t* dst; int K, N, map, k0, n0, fp8; };
constexpr float WSCALE = 64.f, ASCALE = 8.f;
__device__ __forceinline__ void conv_decode(const Args& a, int u, ConvUnit& cu) {
    int j = 0, base = 0;
    for (;;) { const int n = c_jobs[j].nbatch * c_jobs[j].upb; if (u < base + n || j == NJOBS - 1) break; base += n; ++j; }
    const JobDesc& jd = c_jobs[j];
    int r = u - base; const int bt = r / jd.upb; r -= bt * jd.upb; const int ntn = jd.N >> 6; const int kt = r / ntn, nt = r - kt * ntn;
    cu.K = jd.K; cu.N = jd.N; cu.map = jd.map; cu.k0 = kt * 128; cu.n0 = nt * 64; cu.fp8 = jd.fp8;
    const float* sb = j < 2 ? a.in[8] : j < 4 ? a.in[10] : j < 6 ? a.in[12] : j < 8 ? a.in[25] : j == 8 ? a.in[26] : j == 9 ? a.in[27] : j == 10 ? a.in[28] : j == 11 ? a.in[30] : j == 12 ? a.in[31] : a.in[32];
    cu.src = sb + jd.src_off + (long long)bt * jd.src_bstride + (size_t)cu.k0 * jd.N + cu.n0;
    cu.dst = (bf16_t*)(a.ws + jd.dst_off + (long long)bt * jd.dst_bstride);
}
__device__ __forceinline__ int conv_row(int map, int n) {
    if (map == MAP_ID) return n;
    if (map == MAP_GU0) return ((n >> 7) << 8) + (n & 127);
    if (map == MAP_GU1) return ((n >> 7) << 8) + 128 + (n & 127);
    if (map == MAP_KV) { const int hh = n >> 8, jn = n & 255; return jn < 128 ? hh * 128 + jn : 1024 + hh * 128 + (jn - 128); }
    const int hh = n / 192, jn = n - hh * 192; if (jn < 128) return n; const int q = jn - 128; return hh * 192 + 128 + 2 * (q & 31) + (q >> 5);
}
#define CONV_LOAD(R, CU) do { _Pragma("unroll") for (int i_ = 0; i_ < 4; ++i_) { const int idx_ = tid + 512 * i_; R[i_] = __builtin_nontemporal_load((const f32x4*)((CU).src + (size_t)(idx_ >> 4) * (CU).N + (idx_ & 15) * 4)); } } while (0)
#define CONV_PUT(R, T) do { _Pragma("unroll") for (int i_ = 0; i_ < 4; ++i_) { const int idx_ = tid + 512 * i_; float* tp_ = (T) + (idx_ >> 4) * 65 + (idx_ & 15) * 4; tp_[0] = R[i_][0]; tp_[1] = R[i_][1]; tp_[2] = R[i_][2]; tp_[3] = R[i_][3]; } } while (0)
__device__ __forceinline__ void conv_out(const ConvUnit& cur, const float* tile, int tid) {
    const int nl = tid >> 3; const int row = conv_row(cur.map, cur.n0 + nl);
    if (cur.fp8) { const int kc = tid & 7; const float* tp = tile + (kc * 16) * 65 + nl; u32x4 w;
        w.x = pg8::pack4_fp8(tp[0] * WSCALE, tp[65] * WSCALE, tp[130] * WSCALE, tp[195] * WSCALE); w.y = pg8::pack4_fp8(tp[260] * WSCALE, tp[325] * WSCALE, tp[390] * WSCALE, tp[455] * WSCALE);
        w.z = pg8::pack4_fp8(tp[520] * WSCALE, tp[585] * WSCALE, tp[650] * WSCALE, tp[715] * WSCALE); w.w = pg8::pack4_fp8(tp[780] * WSCALE, tp[845] * WSCALE, tp[910] * WSCALE, tp[975] * WSCALE);
        __builtin_nontemporal_store(w, (u32x4*)((unsigned char*)cur.dst + (size_t)row * cur.K + cur.k0 + kc * 16)); }
    else
#pragma unroll
    for (int j = 0; j < 2; ++j) { const int kc = (tid & 7) + 8 * j; const float* tp = tile + (kc * 8) * 65 + nl;
        u32x4 w; w.x = pg8::cvt_pk_bf16(tp[0], tp[65]); w.y = pg8::cvt_pk_bf16(tp[130], tp[195]); w.z = pg8::cvt_pk_bf16(tp[260], tp[325]); w.w = pg8::cvt_pk_bf16(tp[390], tp[455]);
        __builtin_nontemporal_store(w, (u32x4*)(cur.dst + (size_t)row * cur.K + cur.k0 + kc * 8)); }
}
__device__ __forceinline__ void ph_convert(const Args& a, float* tile, int first, int stride, int end) {
    const int tid = threadIdx.x;
    float* tile0 = tile; float* tile1 = tile + 128 * 65 + 16;
    int u = first; ConvUnit cuA, cuB; f32x4 rA[4], rB[4];
    if (u < end) { conv_decode(a, u, cuA); CONV_LOAD(rA, cuA); }
    if (u + stride < end) { conv_decode(a, u + stride, cuB); CONV_LOAD(rB, cuB); }
    while (u < end) {
        CONV_PUT(rA, tile0);
        __syncthreads();
        { const ConvUnit cur = cuA; const int un = u + 2 * stride; if (un < end) { conv_decode(a, un, cuA); CONV_LOAD(rA, cuA); } conv_out(cur, tile0, tid); }
        u += stride; if (u >= end) break;
        CONV_PUT(rB, tile1);
        __syncthreads();
        { const ConvUnit cur = cuB; const int un = u + 2 * stride; if (un < end) { conv_decode(a, un, cuB); CONV_LOAD(rB, cuB); } conv_out(cur, tile1, tid); }
        u += stride;
    }
    __syncthreads();
}
#undef CONV_LOAD
#undef CONV_PUT
constexpr int CONV_STATIC = 3392, CONV_DENSE_END = 7616, CONV_BATCH = 8;
constexpr int CT_QNEXT = 1152;
__device__ __forceinline__ constexpr int CT_DONE(int k) { return 1216 + 64 * k; }
__device__ __forceinline__ void conv_fill(const Args& a, float* tile, int done_idx) {
#if !CONV_FILL
    (void)a; (void)tile; (void)done_idx; return;
#endif
    unsigned* ctl = (unsigned*)(a.ws + WS_CTL); volatile int* bc = (volatile int*)(tile + 2 * (128 * 65 + 16) + 4);
    const int tid = threadIdx.x;
    if (tid == 0) (void)__hip_atomic_fetch_add(ctl + CT_DONE(done_idx), 1u, __ATOMIC_RELAXED, __HIP_MEMORY_SCOPE_AGENT);
    for (;;) {
        if (tid == 0) { int q = -1;
            if (__hip_atomic_load(ctl + CT_DONE(done_idx), __ATOMIC_RELAXED, __HIP_MEMORY_SCOPE_AGENT) < gridDim.x) {
                q = (int)__hip_atomic_fetch_add(ctl + CT_QNEXT, (unsigned)CONV_BATCH, __ATOMIC_RELAXED, __HIP_MEMORY_SCOPE_AGENT) + CONV_STATIC; if (q >= NCONV) q = -1; }
            *bc = q; }
        __syncthreads();
        const int q = *bc;
        __syncthreads();
        if (q < 0) break;
        ph_convert(a, tile, q, 1, (q + CONV_BATCH < NCONV) ? q + CONV_BATCH : NCONV);
    }
}
__device__ __forceinline__ void conv_finish(const Args& a, float* tile, int upto) {
#if !CONV_FILL
    (void)a; (void)tile; (void)upto; return;
#endif
    unsigned* ctl = (unsigned*)(a.ws + WS_CTL); volatile int* bc = (volatile int*)(tile + 2 * (128 * 65 + 16) + 4);
    const int tid = threadIdx.x;
    for (;;) {
        if (tid == 0) { int q = -1;
            if ((int)__hip_atomic_load(ctl + CT_QNEXT, __ATOMIC_RELAXED, __HIP_MEMORY_SCOPE_AGENT) + CONV_STATIC < upto) {
                q = (int)__hip_atomic_fetch_add(ctl + CT_QNEXT, (unsigned)CONV_BATCH, __ATOMIC_RELAXED, __HIP_MEMORY_SCOPE_AGENT) + CONV_STATIC; if (q >= NCONV) q = -1; }
            *bc = q; }
        __syncthreads();
        const int q = *bc;
        __syncthreads();
        if (q < 0) break;
        ph_convert(a, tile, q, 1, (q + CONV_BATCH < NCONV) ? q + CONV_BATCH : NCONV);
    }
}
__device__ __forceinline__ void adaln_unit(const Args& a, int unit, float* sm) {
    const float* c = a.in[1]; const float* cctx = a.in[3]; const float* w_mod = a.in[4]; const float* b_mod = a.in[5]; float* mod = (float*)(a.ws + WS_MOD);
    const int tid = threadIdx.x, l = unit >> 7, chunk = unit & 127;
    const int cg = tid % 24, ks = tid / 24;
    for (int i = tid; i < 5 * 2048; i += 512) { const int v = i >> 11, k = i & 2047; const float val = v < 4 ? c[v * 2048 + k] : cctx[k]; sm[i] = val / (1.0f + __expf(-val)); }
    __syncthreads();
    float acc[5][4];
#pragma unroll
    for (int v = 0; v < 5; ++v)
#pragma unroll
        for (int j = 0; j < 4; ++j) acc[v][j] = 0.f;
    if (ks < 16) {
        const float* wp = w_mod + ((size_t)l * 2048 + (size_t)ks * 128) * 12288 + chunk * 96 + cg * 4;
#pragma unroll 8
        for (int kk = 0; kk < 128; ++kk) {
            const f32x4 w = __builtin_nontemporal_load((const f32x4*)(wp + (size_t)kk * 12288));
            const int k = ks * 128 + kk;
#pragma unroll
            for (int v = 0; v < 5; ++v) { const float s = sm[v * 2048 + k];
#pragma unroll
                for (int j = 0; j < 4; ++j) acc[v][j] += s * w[j]; }
        }
    }
    __syncthreads();
    if (ks < 16) {
#pragma unroll
        for (int v = 0; v < 5; ++v)
#pragma unroll
            for (int j = 0; j < 4; ++j) sm[(ks * 5 + v) * 96 + cg * 4 + j] = acc[v][j];
    }
    __syncthreads();
    if (tid < 480) {
        const int v = tid / 96, cc = tid - v * 96; float s = 0.f;
#pragma unroll
        for (int k2 = 0; k2 < 16; ++k2) s += sm[(k2 * 5 + v) * 96 + cc];
        mod[((size_t)l * 5 + v) * 12288 + chunk * 96 + cc] = s + b_mod[(size_t)l * 12288 + chunk * 96 + cc];
    }
    __syncthreads();
}
constexpr int FW_W1 = 0, FW_W2 = 2112, FW_W3 = 6208, FW_B1 = 10304, FW_B2 = 10368, FW_B3 = 10432, FW_FR = 10496, FW_ZS = 10560, FW_HA = 10848, FW_HB = 11360, FW_END = 11872;
__device__ __forceinline__ void filters_unit(const Args& a, int l, int r, float* sm) {
    float (*zs)[36] = (float (*)[36])(sm + FW_ZS); float (*ha)[64] = (float (*)[64])(sm + FW_HA); float (*hb)[64] = (float (*)[64])(sm + FW_HB);
    const int tid = threadIdx.x;
    const bool lat = r < 256; const int Lf = lat ? 2048 : 256; const int p0 = lat ? r * 8 : (r - 256) * 8;
    float* T = (float*)(a.ws + WS_FILTC) + (size_t)l * 512 * 512;
    const float* wf = a.in[21] + (size_t)l * 64 * 1024;
    const int p = tid >> 6, j = tid & 63; const int pos = p0 + p;
    const float tn = (float)pos / (float)(Lf - 1);
    if (j < 33) {
        float z;
        if (j == 0) z = tn;
        else { const int bi = (j - 1) & 15; const float band = 1e-4f + (float)bi * ((15.0f - 1e-4f) / 15.0f);
               const float ang = (6.283185307179586f / (float)Lf) * (float)pos * band; z = (j <= 16) ? __cosf(ang) : -__sinf(ang); }
        zs[p][j] = z;
    }
    __syncthreads();
    const float f = sm[FW_FR + j];
    { float s = sm[FW_B1 + j];
#pragma unroll
      for (int i = 0; i < 33; ++i) s += zs[p][i] * sm[FW_W1 + i * 64 + j];
      ha[p][j] = __sinf(f * s); }
    __syncthreads();
    { float s = sm[FW_B2 + j];
#pragma unroll 16
      for (int i = 0; i < 64; ++i) s += ha[p][i] * sm[FW_W2 + i * 64 + j];
      hb[p][j] = __sinf(f * s); }
    __syncthreads();
    { float s = sm[FW_B3 + j];
#pragma unroll 16
      for (int i = 0; i < 64; ++i) s += hb[p][i] * sm[FW_W3 + i * 64 + j];
      ha[p][j] = __sinf(f * s); }
    __syncthreads();
    float acc[2][8];
#pragma unroll
    for (int rr = 0; rr < 2; ++rr)
#pragma unroll
        for (int q = 0; q < 8; ++q) acc[rr][q] = 0.f;
#pragma unroll 8
    for (int i = 0; i < 64; ++i) { const float w0 = wf[i * 1024 + tid], w1 = wf[i * 1024 + 512 + tid];
#pragma unroll
        for (int q = 0; q < 8; ++q) { const float h = ha[q][i]; acc[0][q] += h * w0; acc[1][q] += h * w1; } }
    const int ch = tid;
    const float delta = 3.0701134573253944f + (float)ch * ((15.350567286626972f - 3.0701134573253944f) / 511.0f);
#pragma unroll
    for (int q = 0; q < 8; ++q) {
        const int ps = p0 + q; const float dec = __expf(-((float)ps / (float)(Lf - 1)) * delta);
        const float vf = acc[0][q] * dec, vb = acc[1][q] * dec;
        if (lat) { bf16_t* RBp = (bf16_t*)(a.ws + WS_FILTL) + ((size_t)l * 512 + ch) * HY_RBROW; RBp[2048 - ps] = f2bf(vf); if (ps > 0) RBp[2048 + ps] = f2bf(vb); }
        else { T[(size_t)ch * (2 * Lf) + Lf + ps] = vf; if (ps > 0) T[(size_t)ch * (2 * Lf) + Lf - ps] = vb; else T[(size_t)ch * (2 * Lf)] = 0.f; }
    }
    __syncthreads();
}
__device__ __forceinline__ void ph_filters(const Args& a, float* sm) {
    const int tid = threadIdx.x;
    for (int l = 0; l < 2; ++l) {
        for (int i = tid; i < 2112; i += NTHR) sm[FW_W1 + i] = a.in[15][l * 2112 + i];
        for (int i = tid; i < 4096; i += NTHR) { sm[FW_W2 + i] = a.in[17][l * 4096 + i]; sm[FW_W3 + i] = a.in[19][l * 4096 + i]; }
        if (tid < 64) { sm[FW_B1 + tid] = a.in[16][l * 64 + tid]; sm[FW_B2 + tid] = a.in[18][l * 64 + tid]; sm[FW_B3 + tid] = a.in[20][l * 64 + tid]; sm[FW_FR + tid] = a.in[22][l * 64 + tid]; }
        __syncthreads();
        for (int r = blockIdx.x; r < 288; r += gridDim.x) filters_unit(a, l, r, sm);
        __syncthreads();
    }
}
#define SUBREP(b) for (int srep_ = 0; srep_ <= (int)((PROBE_SUB >> (b)) & 1u); ++srep_)
__device__ __forceinline__ void ph_prologue(const Args& a, float* sm) {
    const int bid = blockIdx.x, G = gridDim.x, tid = threadIdx.x;
    SUBREP(4) for (int u = bid; u < 256; u += G) adaln_unit(a, u, sm);
    SUBREP(5) ph_filters(a, sm);
    { float* cosT = (float*)(a.ws + WS_ROPE); float* sinT = cosT + 2048 * 32;
      for (int i = bid * 512 + tid; i < 2048 * 32; i += G * 512) { const int t = i >> 5, f = i & 31;
          const float pos = (float)((f < 16) ? (t >> 6) : (t & 63)); const float freq = powf(10000.0f, -(float)(f & 15) / 16.0f); const float ang = pos * freq;
          cosT[i] = cosf(ang); sinT[i] = sinf(ang); } }
    for (int i = bid * 512 + tid; i < 2 * 512 * 17; i += G * 512) { const int row = i / 17, k = i - row * 17; ((bf16_t*)(a.ws + WS_FILTL))[(size_t)row * HY_RBROW + (k == 0 ? 0 : 4095 + k)] = 0; }
    for (int i = bid * 512 + tid; i < 2 * 192 * 256; i += G * 512) { const int l = i / (192 * 256), r = i % (192 * 256);
        *(u32x4*)(a.ws + WS_WIN + (size_t)l * UW * D * 2 + (size_t)INW * D * 2 + (size_t)r * 16) = (u32x4){0u, 0u, 0u, 0u}; }
    SUBREP(6) ph_convert(a, sm, bid, G, CONV_FILL ? CONV_STATIC : NCONV);
}

template <bool ROUTER, bool COPYX, bool OUT8 = false, int NSLAB = 0>
__device__ __forceinline__ void ph_normmod(const float* __restrict__ xlat, const float* __restrict__ xctx, const float* __restrict__ gain, const float* __restrict__ modl, int sh_off, int sc_off,
                                           bf16_t* __restrict__ out, int nrows, float* __restrict__ xs, const float* __restrict__ router, int* __restrict__ topi, float* __restrict__ topw,
                                           const float* __restrict__ slab = nullptr, const float* __restrict__ slab_gate = nullptr) {
    const int lane = threadIdx.x & 63, wid = threadIdx.x >> 6;
    for (int row = blockIdx.x * 8 + wid; row < nrows; row += gridDim.x * 8) {
        const float* xr = row < NLAT ? xlat + (size_t)row * D : xctx + (size_t)(row - NLAT) * D;
        const float* mv = modl + (size_t)tok_mod(row) * 12288;
        f32x4 v[8]; float ss = 0.f;
#pragma unroll
        for (int i = 0; i < 8; ++i) { v[i] = *(const f32x4*)(xr + i * 256 + lane * 4);
            if (NSLAB > 0 && row >= NLAT) { f32x4 sa = *(const f32x4*)(slab + (size_t)(row - NLAT) * D + i * 256 + lane * 4);
#pragma unroll
                for (int sl = 1; sl < NSLAB; ++sl) sa += *(const f32x4*)(slab + ((size_t)sl * NCTX + (row - NLAT)) * D + i * 256 + lane * 4);
                v[i] += *(const f32x4*)(slab_gate + i * 256 + lane * 4) * sa; }
            ss += v[i][0] * v[i][0] + v[i][1] * v[i][1] + v[i][2] * v[i][2] + v[i][3] * v[i][3];
            if (COPYX && (NSLAB == 0 || row >= NLAT)) *(f32x4*)(xs + (size_t)row * D + i * 256 + lane * 4) = v[i]; }
        ss = wave_sum(ss);
        const float rstd = rsqrtf(ss * (1.0f / D) + EPS);
        float lg[8];
#pragma unroll
        for (int e = 0; e < 8; ++e) lg[e] = 0.f;
#pragma unroll
        for (int i = 0; i < 8; ++i) {
            const int col = i * 256 + lane * 4;
            const f32x4 g = *(const f32x4*)(gain + col), sc = *(const f32x4*)(mv + sc_off + col), sh = *(const f32x4*)(mv + sh_off + col);
            f32x4 o;
#pragma unroll
            for (int j = 0; j < 4; ++j) o[j] = (v[i][j] * rstd * g[j]) * (1.0f + sc[j]) + sh[j];
            if (OUT8) *(unsigned*)((unsigned char*)out + (size_t)row * D + col) = pg8::pack4_fp8(o[0] * ASCALE, o[1] * ASCALE, o[2] * ASCALE, o[3] * ASCALE);
            else { u32x2 w; w.x = (unsigned)f2bf(o[0]) | ((unsigned)f2bf(o[1]) << 16); w.y = (unsigned)f2bf(o[2]) | ((unsigned)f2bf(o[3]) << 16);
                *(u32x2*)(out + (size_t)row * D + col) = w; }
            if (ROUTER) {
#pragma unroll
                for (int j = 0; j < 4; ++j) { const f32x4 r0 = *(const f32x4*)(router + (size_t)(col + j) * 8), r1 = *(const f32x4*)(router + (size_t)(col + j) * 8 + 4);
                    lg[0] += o[j] * r0[0]; lg[1] += o[j] * r0[1]; lg[2] += o[j] * r0[2]; lg[3] += o[j] * r0[3];
                    lg[4] += o[j] * r1[0]; lg[5] += o[j] * r1[1]; lg[6] += o[j] * r1[2]; lg[7] += o[j] * r1[3]; }
                asm volatile("" ::: "memory");
            }
        }
        if (ROUTER) {
#pragma unroll
            for (int e = 0; e < 8; ++e) lg[e] = wave_sum(lg[e]);
            if (lane == 0) {
                int i0 = 0; float v0 = lg[0];
#pragma unroll
                for (int e = 1; e < 8; ++e) if (lg[e] > v0) { v0 = lg[e]; i0 = e; }
                int i1 = -1; float v1 = -3.0e38f;
#pragma unroll
                for (int e = 0; e < 8; ++e) if (e != i0 && lg[e] > v1) { v1 = lg[e]; i1 = e; }
                const float e1 = expf(v1 - v0), w0 = 1.0f / (1.0f + e1), w1 = e1 / (1.0f + e1);
                topi[row * 2] = i0; topi[row * 2 + 1] = i1; topw[row * 2] = w0; topw[row * 2 + 1] = w1;
            }
        }
    }
}

__device__ __forceinline__ void ph_mid(const Args& a, int l) {
    const bf16_t* __restrict__ U = (const bf16_t*)(a.ws + WS_U);
    const float* g_q = a.in[9] + l * 768; const float* g_kv = a.in[11] + l * 512; const float* conv_w = a.in[13] + (size_t)l * 3 * 1536; const float* conv_b = a.in[14] + l * 1536;
    const float* cosT = (const float*)(a.ws + WS_ROPE); const float* sinT = cosT + 2048 * 32;
    bf16_t* cqn = (bf16_t*)(a.ws + WS_CQN); bf16_t* ckvn = (bf16_t*)(a.ws + WS_CKVN); bf16_t* kpe = (bf16_t*)(a.ws + WS_KPE); bf16_t* x0o = (bf16_t*)(a.ws + WS_X0);
    bf16_t* wtl = (bf16_t*)(a.ws + WS_WTL); bf16_t* wtc = (bf16_t*)(a.ws + WS_WTC); bf16_t* sq = (bf16_t*)(a.ws + WS_SQ); bf16_t* sk = (bf16_t*)(a.ws + WS_SK); bf16_t* sv = (bf16_t*)(a.ws + WS_SV);
    const int tid = threadIdx.x, lane = tid & 63, wid = tid >> 6;
    for (int unit = blockIdx.x; unit < NTOK / 16; unit += gridDim.x) {
        const int tok0 = unit * 16;
        for (int tt = 0; tt < 2; ++tt) {
            const int tok = tok0 + wid * 2 + tt; const bool lat = tok < NLAT; const int t = lat ? (tok & 2047) : ((tok - NLAT) & 255);
            const bf16_t* u = U + (size_t)tok * UW;
            { float x[12]; float ss = 0.f;
#pragma unroll
              for (int i = 0; i < 12; ++i) { x[i] = bf2f(u[O_CQ + i * 64 + lane]); ss += x[i] * x[i]; }
              ss = wave_sum(ss); const float rs = rsqrtf(ss * (1.0f / 768.0f) + EPS);
#pragma unroll
              for (int i = 0; i < 12; ++i) cqn[(size_t)tok * 768 + i * 64 + lane] = f2bf(x[i] * rs * g_q[i * 64 + lane]); }
            { float x[8]; float ss = 0.f;
#pragma unroll
              for (int i = 0; i < 8; ++i) { x[i] = bf2f(u[O_CKV + i * 64 + lane]); ss += x[i] * x[i]; }
              ss = wave_sum(ss); const float rs = rsqrtf(ss * (1.0f / 512.0f) + EPS);
#pragma unroll
              for (int i = 0; i < 8; ++i) ckvn[(size_t)tok * 512 + i * 64 + lane] = f2bf(x[i] * rs * g_kv[i * 64 + lane]); }
            const int pi = lane & 31;
            const float cs = lat ? cosT[t * 32 + pi] : 1.0f, sn = lat ? sinT[t * 32 + pi] : 0.0f;
            if (lane < 32) {
                const float aa = bf2f(u[O_KPE + pi]), bb = bf2f(u[O_KPE + 32 + pi]);
                kpe[(size_t)tok * 64 + 2 * pi] = f2bf(aa * cs - bb * sn); kpe[(size_t)tok * 64 + 2 * pi + 1] = f2bf(aa * sn + bb * cs);
            }
#pragma unroll
            for (int r = 0; r < 4; ++r) { const int pr = r * 64 + lane, h = pr >> 5;
                const float aa = bf2f(u[O_SQ + h * 64 + pi]), bb = bf2f(u[O_SQ + h * 64 + 32 + pi]);
                sq[(size_t)tok * 512 + h * 64 + pi] = f2bf(aa * cs - bb * sn); sq[(size_t)tok * 512 + h * 64 + 32 + pi] = f2bf(aa * sn + bb * cs); }
            { const int h = lane >> 5;
              const float aa = bf2f(u[O_SK + h * 64 + pi]), bb = bf2f(u[O_SK + h * 64 + 32 + pi]);
              sk[(size_t)tok * 128 + h * 64 + pi] = f2bf(aa * cs - bb * sn); sk[(size_t)tok * 128 + h * 64 + 32 + pi] = f2bf(aa * sn + bb * cs); }
        }
        {
            const bool lat = tok0 < NLAT; const int Ls = lat ? L : C;
            const int b = lat ? (tok0 >> 11) : ((tok0 - NLAT) >> 8), t0 = lat ? (tok0 & 2047) : ((tok0 - NLAT) & 255);
            const int ch = tid;
            float cw[3][3], cb[3];
#pragma unroll
            for (int g = 0; g < 3; ++g) { cb[g] = conv_b[g * 512 + ch];
#pragma unroll
                for (int j = 0; j < 3; ++j) cw[g][j] = conv_w[j * 1536 + g * 512 + ch]; }
            float prev[3], cur[3], nxt[3];
#pragma unroll
            for (int g = 0; g < 3; ++g) { prev[g] = (t0 > 0) ? bf2f(U[(size_t)(tok0 - 1) * UW + O_HY + g * 512 + ch]) : 0.f; cur[g] = bf2f(U[(size_t)tok0 * UW + O_HY + g * 512 + ch]); }
            unsigned pk[8];
#pragma unroll
            for (int i = 0; i < 16; ++i) {
                const bool hasn = (t0 + i + 1) < Ls;
                float y[3];
#pragma unroll
                for (int g = 0; g < 3; ++g) { nxt[g] = hasn ? bf2f(U[(size_t)(tok0 + i + 1) * UW + O_HY + g * 512 + ch]) : 0.f;
                    y[g] = cb[g] + cw[g][0] * prev[g] + cw[g][1] * cur[g] + cw[g][2] * nxt[g]; prev[g] = cur[g]; cur[g] = nxt[g]; }
                x0o[(size_t)(tok0 + i) * 512 + ch] = f2bf(y[0]);
                const unsigned wv = f2bf(y[2] * y[1]);
                if (i & 1) pk[i >> 1] |= wv << 16; else pk[i >> 1] = wv;
            }
            bf16_t* wt = lat ? wtl + ((size_t)b * 512 + ch) * L + t0 : wtc + ((size_t)b * 512 + ch) * C + t0;
            u32x4 w0, w1; w0.x = pk[0]; w0.y = pk[1]; w0.z = pk[2]; w0.w = pk[3]; w1.x = pk[4]; w1.y = pk[5]; w1.z = pk[6]; w1.w = pk[7];
            *(u32x4*)wt = w0; *(u32x4*)(wt + 8) = w1;
        }
        if (tid < 128) {
            unsigned pk[8];
#pragma unroll
            for (int i = 0; i < 16; ++i) { const unsigned v = U[(size_t)(tok0 + i) * UW + O_SV + tid]; if (i & 1) pk[i >> 1] |= v << 16; else pk[i >> 1] = v; }
            bf16_t* dst = sv + (size_t)tid * NTOK + tok0;
            u32x4 w0, w1; w0.x = pk[0]; w0.y = pk[1]; w0.z = pk[2]; w0.w = pk[3]; w1.x = pk[4]; w1.y = pk[5]; w1.z = pk[6]; w1.w = pk[7];
            *(u32x4*)dst = w0; *(u32x4*)(dst + 8) = w1;
        }
    }
}

__device__ __forceinline__ void ph_mla_naive(const Args& a, int nq, float* sm) {
    const bf16_t* __restrict__ Q = (const bf16_t*)(a.ws + WS_Q); const bf16_t* __restrict__ KV = (const bf16_t*)(a.ws + WS_KV); const bf16_t* __restrict__ KPE = (const bf16_t*)(a.ws + WS_KPE);
    bf16_t* mix = (bf16_t*)(a.ws + WS_MIX);
    const int lane = threadIdx.x & 63, w = threadIdx.x >> 6;
    float* qf = sm + w * 192; float* sc = sm + 8 * 192 + w * 2304;
    for (int unit = blockIdx.x; unit < nq; unit += gridDim.x) {
        const int h = unit & 7, qt = (unit >> 3) * 8 + w; const bool lat = qt < NLAT;
        const int b = lat ? (qt >> 11) : ((qt - NLAT) >> 8);
        const int nk = lat ? (L + C) : C;
        for (int i = lane; i < 192; i += 64) qf[i] = bf2f(Q[(size_t)qt * QW + h * 192 + i]);
        __syncthreads();
        const float scale = 0.07216878364870322f;
        float mx = -3.0e38f;
        for (int kc = 0; kc < nk; kc += 64) {
            const int kk = kc + lane;
            const int kt = lat ? (kk < L ? b * L + kk : NLAT + b * C + (kk - L)) : (NLAT + b * C + kk);
            float s = 0.f;
            const u32x4* kp = (const u32x4*)(KV + (size_t)kt * KVW + h * 256);
            for (int i = 0; i < 16; ++i) { const u32x4 v = kp[i]; const float* q8 = qf + i * 8;
                s += q8[0] * __uint_as_float(v.x << 16) + q8[1] * __uint_as_float(v.x & 0xffff0000u) + q8[2] * __uint_as_float(v.y << 16) + q8[3] * __uint_as_float(v.y & 0xffff0000u)
                   + q8[4] * __uint_as_float(v.z << 16) + q8[5] * __uint_as_float(v.z & 0xffff0000u) + q8[6] * __uint_as_float(v.w << 16) + q8[7] * __uint_as_float(v.w & 0xffff0000u); }
            const u32x4* pp = (const u32x4*)(KPE + (size_t)kt * 64);
            for (int i = 0; i < 8; ++i) { const u32x4 v = pp[i]; const float* q8 = qf + 128 + i * 8;
                s += q8[0] * __uint_as_float(v.x << 16) + q8[1] * __uint_as_float(v.x & 0xffff0000u) + q8[2] * __uint_as_float(v.y << 16) + q8[3] * __uint_as_float(v.y & 0xffff0000u)
                   + q8[4] * __uint_as_float(v.z << 16) + q8[5] * __uint_as_float(v.z & 0xffff0000u) + q8[6] * __uint_as_float(v.w << 16) + q8[7] * __uint_as_float(v.w & 0xffff0000u); }
            s *= scale; sc[kk] = s; mx = fmaxf(mx, s);
        }
        mx = wave_max(mx);
        float sum = 0.f;
        for (int kc = 0; kc < nk; kc += 64) { const float p = expf(sc[kc + lane] - mx); sc[kc + lane] = p; sum += p; }
        sum = wave_sum(sum);
        __syncthreads();
        float o0 = 0.f, o1 = 0.f;
        for (int kk = 0; kk < nk; ++kk) {
            const int kt = lat ? (kk < L ? b * L + kk : NLAT + b * C + (kk - L)) : (NLAT + b * C + kk);
            const unsigned v = *(const unsigned*)(KV + (size_t)kt * KVW + h * 256 + 128 + lane * 2);
            const float p = sc[kk];
            o0 += p * __uint_as_float(v << 16); o1 += p * __uint_as_float(v & 0xffff0000u);
        }
        const float inv = 1.0f / sum;
        *(unsigned*)(mix + (size_t)qt * D + h * 128 + lane * 2) = (unsigned)f2bf(o0 * inv) | ((unsigned)f2bf(o1 * inv) << 16);
        __syncthreads();
    }
}
__device__ __forceinline__ void ph_swa_naive(const Args& a, int l, int nq, float* sm) {
    const bf16_t* __restrict__ SQ = (const bf16_t*)(a.ws + WS_SQ); const bf16_t* __restrict__ SK = (const bf16_t*)(a.ws + WS_SK); const bf16_t* __restrict__ SV = (const bf16_t*)(a.ws + WS_SV);
    const float* sink = a.in[24] + l * 8; bf16_t* mix = (bf16_t*)(a.ws + WS_MIX);
    const int lane = threadIdx.x & 63, w = threadIdx.x >> 6;
    float* qf = sm + w * 64; float* sc = sm + 8 * 64 + w * 576; int* kts = (int*)(sm + 8 * 64 + 8 * 576) + w * 576;
    for (int unit = blockIdx.x; unit < nq; unit += gridDim.x) {
        const int hq = unit & 7, hk = hq >> 2, qt = (unit >> 3) * 8 + w; const bool lat = qt < NLAT;
        const int b = lat ? (qt >> 11) : ((qt - NLAT) >> 8), t = lat ? (qt & 2047) : 0;
        int lo = 0, nloc = 0;
        if (lat) { lo = t - 128 < 0 ? 0 : t - 128; const int hi = t + 128 > L - 1 ? L - 1 : t + 128; nloc = hi - lo + 1; }
        const int nk = nloc + C;
        qf[lane] = bf2f(SQ[(size_t)qt * 512 + hq * 64 + lane]);
        __syncthreads();
        const float skv = sink[hq];
        float mx = skv;
        for (int kc = 0; kc < nk; kc += 64) {
            const int kk = kc + lane;
            if (kk < nk) {
                const int kt = kk < nloc ? (b * L + lo + kk) : (NLAT + b * C + (kk - nloc));
                const u32x4* kp = (const u32x4*)(SK + (size_t)kt * 128 + hk * 64);
                float s = 0.f;
                for (int i = 0; i < 8; ++i) { const u32x4 v = kp[i]; const float* q8 = qf + i * 8;
                    s += q8[0] * __uint_as_float(v.x << 16) + q8[1] * __uint_as_float(v.x & 0xffff0000u) + q8[2] * __uint_as_float(v.y << 16) + q8[3] * __uint_as_float(v.y & 0xffff0000u)
                       + q8[4] * __uint_as_float(v.z << 16) + q8[5] * __uint_as_float(v.z & 0xffff0000u) + q8[6] * __uint_as_float(v.w << 16) + q8[7] * __uint_as_float(v.w & 0xffff0000u); }
                s *= 0.125f; sc[kk] = s; kts[kk] = kt; mx = fmaxf(mx, s);
            }
        }
        mx = wave_max(mx);
        float sum = 0.f;
        for (int kc = 0; kc < nk; kc += 64) { const int kk = kc + lane; if (kk < nk) { const float p = expf(sc[kk] - mx); sc[kk] = p; sum += p; } }
        sum = wave_sum(sum) + expf(skv - mx);
        __syncthreads();
        float o = 0.f;
        for (int kk = 0; kk < nk; ++kk) o += sc[kk] * bf2f(SV[(size_t)kts[kk] * 128 + hk * 64 + lane]);
        mix[(size_t)qt * D + 1536 + hq * 64 + lane] = f2bf(o / sum);
        __syncthreads();
    }
}
template <int LS>
__device__ __forceinline__ void ph_hyena_naive(const Args& a, int l, float* sm) {
    const float* filt = LS == L ? (const float*)(a.ws + WS_FILTL) + (size_t)l * 512 * 4096 : (const float*)(a.ws + WS_FILTC) + (size_t)l * 512 * 512;
    const bf16_t* wt = (const bf16_t*)(a.ws + (LS == L ? WS_WTL : WS_WTC)); const bf16_t* x0 = (const bf16_t*)(a.ws + WS_X0); const float* skip = a.in[23] + l * 512;
    bf16_t* mix = (bf16_t*)(a.ws + WS_MIX); const int tok_base = LS == L ? 0 : NLAT;
    float* T = sm; float* ws = sm + 2 * LS; const int tid = threadIdx.x;
    for (int unit = blockIdx.x; unit < 512 * NB; unit += gridDim.x) {
        const int ch = unit >> 2, b = unit & 3;
        for (int i = tid; i < 2 * LS; i += NTHR) T[i] = filt[(size_t)ch * 2 * LS + i];
        for (int i = tid; i < LS; i += NTHR) ws[i] = bf2f(wt[((size_t)b * 512 + ch) * LS + i]);
        __syncthreads();
        const float sk = skip[ch];
        for (int t = tid; t < LS; t += NTHR) {
            float y = 0.f;
            for (int s = 0; s < LS; ++s) y += T[t - s + LS] * ws[s];
            const int tok = tok_base + b * LS + t;
            mix[(size_t)tok * D + 1024 + ch] = f2bf(bf2f(x0[(size_t)tok * 512 + ch]) * (y + sk * ws[t]));
        }
        __syncthreads();
    }
}
__device__ __forceinline__ void ph_route_gather(const Args& a, int* sm) {
    const int* __restrict__ topi = (const int*)(a.ws + WS_TOPI); int* __restrict__ pos = (int*)(a.ws + WS_POS); int* ctl = (int*)(a.ws + WS_CTL);
    const unsigned char* __restrict__ hb = (const unsigned char*)(a.ws + WS_HA); unsigned char* __restrict__ hbs = (unsigned char*)(a.ws + WS_HBS);
    int (*cnt)[512] = (int (*)[512])sm; int* tot = sm + 8 * 512; int* ppos = sm + 8 * 512 + 16;
    const int tid = threadIdx.x, lane = tid & 63, w = tid >> 6;
    int c[8];
#pragma unroll
    for (int e = 0; e < 8; ++e) c[e] = 0;
    for (int i = 0; i < 32; i += 4) { const u32x4 e4 = *(const u32x4*)(topi + tid * 32 + i);
#pragma unroll
        for (int q = 0; q < 8; ++q) c[q] += (e4.x == (unsigned)q) + (e4.y == (unsigned)q) + (e4.z == (unsigned)q) + (e4.w == (unsigned)q); }
#pragma unroll
    for (int e = 0; e < 8; ++e) cnt[e][tid] = c[e];
    __syncthreads();
    {
        int v[8]; int s8 = 0;
#pragma unroll
        for (int k = 0; k < 8; ++k) { v[k] = cnt[w][lane * 8 + k]; s8 += v[k]; }
        int incl = s8;
#pragma unroll
        for (int off = 1; off < 64; off <<= 1) { const int t = __shfl_up(incl, off); if (lane >= off) incl += t; }
        int run = incl - s8;
#pragma unroll
        for (int k = 0; k < 8; ++k) { cnt[w][lane * 8 + k] = run; run += v[k]; }
        if (lane == 63) tot[w] = incl;
    }
    __syncthreads();
    int eoff[8]; int o = 0;
#pragma unroll
    for (int e = 0; e < 8; ++e) { eoff[e] = o; o += (tot[e] + 255) & ~255; }
    if (blockIdx.x == 0 && tid == 0) {
#pragma unroll
        for (int e = 0; e < 8; ++e) { ctl[CT_EOFF + e] = eoff[e]; ctl[CT_EPAD + e] = (tot[e] + 255) & ~255; }
        ctl[CT_NTILE] = o >> 8; const int nwg = (o >> 8) * (D / 256); ctl[CT_MOES] = pg8::split_S(nwg, DFE / 128, 256); ctl[CT_TROW] = (nwg / 256) * 256 / (D / 256) * 256;
    }
    for (int tg = blockIdx.x; tg < NLAT / 32; tg += gridDim.x) {
        if (tid < 64) {
            const int idx = 64 * tg + tid, owner = idx >> 5, e = topi[idx]; int p = 0;
#pragma unroll
            for (int q = 0; q < 8; ++q) { const unsigned long long mk = __ballot(e == q);
                if (e == q) { const unsigned hm = (unsigned)(mk >> (32 * (tid >> 5))); p = eoff[q] + cnt[q][owner] + __popc(hm & ((1u << (tid & 31)) - 1u)); } }
            pos[idx] = p; ppos[tid] = p;
        }
        __syncthreads();
#pragma unroll
        for (int k = 0; k < 4; ++k) { const int tl = 4 * w + k; const int tok = 32 * tg + tl;
            const u32x4 v0 = *(const u32x4*)(hb + (size_t)tok * D + lane * 32), v1 = *(const u32x4*)(hb + (size_t)tok * D + lane * 32 + 16);
            const int p0 = ppos[2 * tl], p1 = ppos[2 * tl + 1];
            *(u32x4*)(hbs + (size_t)p0 * D + lane * 32) = v0; *(u32x4*)(hbs + (size_t)p0 * D + lane * 32 + 16) = v1;
            *(u32x4*)(hbs + (size_t)p1 * D + lane * 32) = v0; *(u32x4*)(hbs + (size_t)p1 * D + lane * 32 + 16) = v1; }
        __syncthreads();
    }
}
__device__ __forceinline__ void ph_final(const Args& a) {
    const float* xs = (const float*)(a.ws + WS_XS); const bf16_t* ys = (const bf16_t*)(a.ws + WS_YS); const int* pos = (const int*)(a.ws + WS_POS); const float* topw = (const float*)(a.ws + WS_TOPW);
    const float* modl = (const float*)(a.ws + WS_MOD) + (size_t)5 * 12288; const float* gfin = a.in[33]; float* out = a.out;
    const int lane = threadIdx.x & 63, wid = threadIdx.x >> 6;
    const int* ctl = (const int*)(a.ws + WS_CTL); const int nsl = ctl[CT_MOES], trow0 = ctl[CT_TROW], trows = ctl[CT_NTILE] * 256 - trow0; const float* slab = (const float*)(a.ws + WS_SLAB);
    for (int row = blockIdx.x * 8 + wid; row < NLAT; row += gridDim.x * 8) {
        const float* g2 = modl + (size_t)tok_mod(row) * 12288 + 10240;
        const int p0 = pos[row * 2], p1 = pos[row * 2 + 1]; const float w0 = topw[row * 2], w1 = topw[row * 2 + 1];
        const bool t0 = nsl > 1 && p0 >= trow0, t1 = nsl > 1 && p1 >= trow0;
        f32x4 v[8]; float ss = 0.f;
#pragma unroll
        for (int i = 0; i < 8; ++i) { const int col = i * 256 + lane * 4;
            const f32x4 x = *(const f32x4*)(xs + (size_t)row * D + col), g = *(const f32x4*)(g2 + col); f32x4 ya, yb;
            if (t0) { ya = *(const f32x4*)(slab + (size_t)(p0 - trow0) * D + col); for (int sl = 1; sl < nsl; ++sl) ya += *(const f32x4*)(slab + ((size_t)sl * trows + (p0 - trow0)) * D + col); }
            else { const u32x2 q = *(const u32x2*)(ys + (size_t)p0 * D + col); ya = (f32x4){__uint_as_float(q.x << 16), __uint_as_float(q.x & 0xffff0000u), __uint_as_float(q.y << 16), __uint_as_float(q.y & 0xffff0000u)}; }
            if (t1) { yb = *(const f32x4*)(slab + (size_t)(p1 - trow0) * D + col); for (int sl = 1; sl < nsl; ++sl) yb += *(const f32x4*)(slab + ((size_t)sl * trows + (p1 - trow0)) * D + col); }
            else { const u32x2 q = *(const u32x2*)(ys + (size_t)p1 * D + col); yb = (f32x4){__uint_as_float(q.x << 16), __uint_as_float(q.x & 0xffff0000u), __uint_as_float(q.y << 16), __uint_as_float(q.y & 0xffff0000u)}; }
#pragma unroll
            for (int j = 0; j < 4; ++j) { v[i][j] = x[j] + g[j] * (w0 * ya[j] + w1 * yb[j]); ss += v[i][j] * v[i][j]; } }
        ss = wave_sum(ss); const float rstd = rsqrtf(ss * (1.0f / D) + EPS);
#pragma unroll
        for (int i = 0; i < 8; ++i) { const int col = i * 256 + lane * 4; const f32x4 g = *(const f32x4*)(gfin + col); f32x4 o;
#pragma unroll
            for (int j = 0; j < 4; ++j) o[j] = v[i][j] * rstd * g[j];
            *(f32x4*)(out + (size_t)row * D + col) = o; }
    }
}

typedef float f32x2_t __attribute__((ext_vector_type(2))); typedef __bf16 bf16x2_t __attribute__((ext_vector_type(2)));
__device__ __forceinline__ unsigned cvtpk(float lo, float hi) { f32x2_t v = {lo, hi}; bf16x2_t b = __builtin_convertvector(v, bf16x2_t); return __builtin_bit_cast(unsigned, b); }
#define MFMA32(a, b, c) __builtin_amdgcn_mfma_f32_32x32x16_bf16((a), (b), (c), 0, 0, 0)
constexpr int MLA_KP = 400, MLA_VP = 144, MLA_KB = 64 * MLA_KP, MLA_VB = 128 * MLA_VP, MLA_STAGE = MLA_KB + MLA_VB;
static_assert(2 * MLA_STAGE <= RING_BYTES, "MLA LDS");

__device__ __forceinline__ void ph_mla(const Args& a, bool with_ctx, unsigned char* lds) {
    const bf16_t* __restrict__ Q = (const bf16_t*)(a.ws + WS_Q); const bf16_t* __restrict__ KN = (const bf16_t*)(a.ws + WS_KN); const bf16_t* __restrict__ KPE = (const bf16_t*)(a.ws + WS_KPE);
    const bf16_t* __restrict__ VT = (const bf16_t*)(a.ws + WS_VT); bf16_t* __restrict__ mix = (bf16_t*)(a.ws + WS_MIX);
    int tid_ = threadIdx.x; asm volatile("" : "+v"(tid_));
    const int tid = tid_, lane = tid & 63, w = tid >> 6, qi = lane & 31, hh = lane >> 5;
    const int nunits = with_ctx ? 288 : 256;
    const float c = 0.07216878364870322f * 1.4426950408889634f;
    for (int unit = blockIdx.x; unit < nunits; unit += gridDim.x) {
        int h, b, q0tok, nt; bool ctxq;
        if (unit < 256) { h = unit & 7; b = unit >> 6; q0tok = b * L + ((unit >> 3) & 7) * 256; nt = 36; ctxq = false; }
        else { const int u2 = unit - 256; h = u2 & 7; b = u2 >> 3; q0tok = NLAT + b * C; nt = 4; ctxq = true; }
#define MLA_KTOK(t) (ctxq ? (NLAT + b * C + (t) * 64) : ((t) < 32 ? (b * L + (t) * 64) : (NLAT + b * C + ((t) - 32) * 64)))
        u32x4 r0, r1, r2, r3, r4;
#define MLA_ISSUE(t) do { const int kt0_ = MLA_KTOK(t); \
            r0 = *(const u32x4*)(KN + (size_t)(kt0_ + (tid >> 4)) * 1024 + h * 128 + (tid & 15) * 8); \
            r1 = *(const u32x4*)(KN + (size_t)(kt0_ + 32 + (tid >> 4)) * 1024 + h * 128 + (tid & 15) * 8); \
            r2 = *(const u32x4*)(KPE + (size_t)(kt0_ + (tid >> 3)) * 64 + (tid & 7) * 8); \
            r3 = *(const u32x4*)(VT + (size_t)(h * 128 + (tid >> 3)) * NTOK + kt0_ + (tid & 7) * 8); \
            r4 = *(const u32x4*)(VT + (size_t)(h * 128 + 64 + (tid >> 3)) * NTOK + kt0_ + (tid & 7) * 8); } while (0)
#define MLA_COMMIT(buf) do { unsigned char* kb_ = lds + (buf) * MLA_STAGE; unsigned char* vb_ = kb_ + MLA_KB; \
            *(u32x4*)(kb_ + (tid >> 4) * MLA_KP + (tid & 15) * 16) = r0; \
            *(u32x4*)(kb_ + (32 + (tid >> 4)) * MLA_KP + (tid & 15) * 16) = r1; \
            *(u32x4*)(kb_ + (tid >> 3) * MLA_KP + 256 + (tid & 7) * 16) = r2; \
            const int g_ = (tid & 7) >> 1, e_ = tid & 1; \
            { u32x2 lo_, hi_; lo_.x = r3.x; lo_.y = r3.y; hi_.x = r3.z; hi_.y = r3.w; \
              *(u32x2*)(vb_ + (tid >> 3) * MLA_VP + g_ * 32 + e_ * 8) = lo_; *(u32x2*)(vb_ + (tid >> 3) * MLA_VP + g_ * 32 + 16 + e_ * 8) = hi_; } \
            { u32x2 lo_, hi_; lo_.x = r4.x; lo_.y = r4.y; hi_.x = r4.z; hi_.y = r4.w; \
              *(u32x2*)(vb_ + (64 + (tid >> 3)) * MLA_VP + g_ * 32 + e_ * 8) = lo_; *(u32x2*)(vb_ + (64 + (tid >> 3)) * MLA_VP + g_ * 32 + 16 + e_ * 8) = hi_; } } while (0)
        const int qtok = q0tok + w * 32 + qi;
        bf16x8 qf[12];
#pragma unroll
        for (int s = 0; s < 12; ++s) qf[s] = *(const bf16x8*)(Q + (size_t)qtok * QW + h * 192 + s * 16 + hh * 8);
        f32x16 o[4];
#pragma unroll
        for (int d = 0; d < 4; ++d)
#pragma unroll
            for (int r = 0; r < 16; ++r) o[d][r] = 0.f;
        float m = -1.0e30f, l = 0.f;
        MLA_ISSUE(0); MLA_COMMIT(0);
        __syncthreads();
        for (int t = 0; t < nt; ++t) {
            const unsigned char* kb = lds + (t & 1) * MLA_STAGE; const unsigned char* vb = kb + MLA_KB;
            f32x16 s0, s1;
#pragma unroll
            for (int r = 0; r < 16; ++r) { s0[r] = 0.f; s1[r] = 0.f; }
#pragma unroll
            for (int s = 0; s < 12; ++s) {
                const bf16x8 k0 = *(const bf16x8*)(kb + qi * MLA_KP + s * 32 + hh * 16);
                const bf16x8 k1 = *(const bf16x8*)(kb + (32 + qi) * MLA_KP + s * 32 + hh * 16);
                s0 = MFMA32(k0, qf[s], s0); s1 = MFMA32(k1, qf[s], s1);
                if ((s & 3) == 3) asm volatile("" ::: "memory");
            }
            if (t + 1 < nt) MLA_ISSUE(t + 1);
            float mx = fmaxf(s0[0], s1[0]);
#pragma unroll
            for (int r = 1; r < 16; ++r) mx = fmaxf(mx, fmaxf(s0[r], s1[r]));
            mx = fmaxf(mx, __shfl_xor(mx, 32));
            const float mnew = fmaxf(m, mx * c);
            const float alpha = __builtin_amdgcn_exp2f(m - mnew);
            m = mnew;
            float ps = 0.f;
#pragma unroll
            for (int r = 0; r < 16; ++r) { s0[r] = __builtin_amdgcn_exp2f(s0[r] * c - mnew); s1[r] = __builtin_amdgcn_exp2f(s1[r] * c - mnew); ps += s0[r] + s1[r]; }
            l = l * alpha + ps;
#pragma unroll
            for (int d = 0; d < 4; ++d)
#pragma unroll
                for (int r = 0; r < 16; ++r) o[d][r] *= alpha;
            bf16x8 pf[4];
            { u32x4 p;
              p.x = cvtpk(s0[0], s0[1]); p.y = cvtpk(s0[2], s0[3]); p.z = cvtpk(s0[4], s0[5]); p.w = cvtpk(s0[6], s0[7]); pf[0] = __builtin_bit_cast(bf16x8, p);
              p.x = cvtpk(s0[8], s0[9]); p.y = cvtpk(s0[10], s0[11]); p.z = cvtpk(s0[12], s0[13]); p.w = cvtpk(s0[14], s0[15]); pf[1] = __builtin_bit_cast(bf16x8, p);
              p.x = cvtpk(s1[0], s1[1]); p.y = cvtpk(s1[2], s1[3]); p.z = cvtpk(s1[4], s1[5]); p.w = cvtpk(s1[6], s1[7]); pf[2] = __builtin_bit_cast(bf16x8, p);
              p.x = cvtpk(s1[8], s1[9]); p.y = cvtpk(s1[10], s1[11]); p.z = cvtpk(s1[12], s1[13]); p.w = cvtpk(s1[14], s1[15]); pf[3] = __builtin_bit_cast(bf16x8, p); }
            asm volatile("" ::: "memory");
#pragma unroll
            for (int d = 0; d < 4; ++d) {
#pragma unroll
                for (int g = 0; g < 4; ++g) {
                    const bf16x8 vf = *(const bf16x8*)(vb + (d * 32 + qi) * MLA_VP + g * 32 + hh * 16);
                    o[d] = MFMA32(vf, pf[g], o[d]);
                }
                if (d & 1) asm volatile("" ::: "memory");
            }
            if (t + 1 < nt) MLA_COMMIT((t + 1) & 1);
            __syncthreads();
        }
        const float inv = 1.0f / (l + __shfl_xor(l, 32));
        bf16_t* op = mix + (size_t)qtok * D + h * 128 + 4 * hh;
#pragma unroll
        for (int d = 0; d < 4; ++d)
#pragma unroll
            for (int g = 0; g < 4; ++g) { u32x2 wv; wv.x = cvtpk(o[d][4 * g] * inv, o[d][4 * g + 1] * inv); wv.y = cvtpk(o[d][4 * g + 2] * inv, o[d][4 * g + 3] * inv);
                *(u32x2*)(op + d * 32 + 8 * g) = wv; }
#undef MLA_KTOK
#undef MLA_ISSUE
#undef MLA_COMMIT
    }
}

constexpr int HY_CS = 8224, HY_WS = 5136, HY_WOFF = 8 * HY_CS, HY_RBL = HY_WOFF + 4 * HY_WS;
static_assert(HY_RBL + 516 * 16 <= RING_BYTES, "hyena LDS");

__device__ __forceinline__ u32x4 hy_shift(const u32x4 a, const u32x4 b, int r) {
    switch (r) {
    case 0: return b;
    case 1: return (u32x4){__builtin_amdgcn_alignbyte(b.x, a.w, 2), __builtin_amdgcn_alignbyte(b.y, b.x, 2), __builtin_amdgcn_alignbyte(b.z, b.y, 2), __builtin_amdgcn_alignbyte(b.w, b.z, 2)};
    case 2: return (u32x4){a.w, b.x, b.y, b.z};
    case 3: return (u32x4){__builtin_amdgcn_alignbyte(a.w, a.z, 2), __builtin_amdgcn_alignbyte(b.x, a.w, 2), __builtin_amdgcn_alignbyte(b.y, b.x, 2), __builtin_amdgcn_alignbyte(b.z, b.y, 2)};
    case 4: return (u32x4){a.z, a.w, b.x, b.y};
    case 5: return (u32x4){__builtin_amdgcn_alignbyte(a.z, a.y, 2), __builtin_amdgcn_alignbyte(a.w, a.z, 2), __builtin_amdgcn_alignbyte(b.x, a.w, 2), __builtin_amdgcn_alignbyte(b.y, b.x, 2)};
    case 6: return (u32x4){a.y, a.z, a.w, b.x};
    default: return (u32x4){__builtin_amdgcn_alignbyte(a.y, a.x, 2), __builtin_amdgcn_alignbyte(a.z, a.y, 2), __builtin_amdgcn_alignbyte(a.w, a.z, 2), __builtin_amdgcn_alignbyte(b.x, a.w, 2)};
    }
}

__device__ __forceinline__ void ph_hyena(const Args& a, int l, unsigned char* lds) {
    const bf16_t* __restrict__ RB = (const bf16_t*)(a.ws + WS_FILTL) + (size_t)l * 512 * HY_RBROW;
    const bf16_t* __restrict__ wtl = (const bf16_t*)(a.ws + WS_WTL); const bf16_t* __restrict__ x0 = (const bf16_t*)(a.ws + WS_X0); const float* skip = a.in[23] + l * 512;
    bf16_t* __restrict__ mix = (bf16_t*)(a.ws + WS_MIX);
    int tid_ = threadIdx.x; asm volatile("" : "+v"(tid_));
    const int tid = tid_, lane = tid & 63, w = __builtin_amdgcn_readfirstlane(tid >> 6), i = lane & 31, hh = lane >> 5;
    for (int unit = blockIdx.x; unit < 512; unit += gridDim.x) {
        const int c = unit;
        for (int k = tid; k < 515; k += NTHR) { u32x4 v = (u32x4){0u, 0u, 0u, 0u}; if (k < 513) v = *(const u32x4*)(RB + (size_t)c * HY_RBROW + k * 8); *(u32x4*)(lds + HY_RBL + k * 16) = v; }
        for (int k = tid; k < 4 * 321; k += NTHR) { const int b = k / 321, sl = k - b * 321; u32x4 v = (u32x4){0u, 0u, 0u, 0u};
            if (sl >= 28 && sl < 284) v = *(const u32x4*)(wtl + ((size_t)b * 512 + c) * L + (sl - 28) * 8);
            *(u32x4*)(lds + HY_WOFF + b * HY_WS + sl * 16) = v; }
        __syncthreads();
        for (int qs = lane; qs < 511; qs += 64) {
            const u32x4 ca = *(const u32x4*)(lds + HY_RBL + qs * 16), cb = *(const u32x4*)(lds + HY_RBL + qs * 16 + 16);
            *(u32x4*)(lds + w * HY_CS + qs * 16) = hy_shift(ca, cb, w);
        }
        __syncthreads();
        f32x16 acc0, acc1;
#pragma unroll
        for (int r = 0; r < 16; ++r) { acc0[r] = 0.f; acc1[r] = 0.f; }
        const int Tl = i >> 2, b = i & 3;
        const unsigned char* ap = lds + (i & 7) * HY_CS + (hh - (i >> 3) + 255) * 16;
        const unsigned char* bp = lds + HY_WOFF + b * HY_WS + (224 + 16 * (2 * (8 * w + Tl)) + 8 * hh) * 2;
        const int d0 = 16 * w - 127;
#pragma unroll 2
        for (int dd = 0; dd < 142; dd += 2) {
            const int d = d0 + dd;
            const bf16x8 a0 = *(const bf16x8*)(ap - 32 * d), b0 = *(const bf16x8*)(bp - 32 * d);
            const bf16x8 a1 = *(const bf16x8*)(ap - 32 * (d + 1)), b1 = *(const bf16x8*)(bp - 32 * (d + 1));
            acc0 = MFMA32(a0, b0, acc0); acc1 = MFMA32(a1, b1, acc1);
        }
        const float sk = skip[c];
        const bf16_t* wl = (const bf16_t*)(lds + HY_WOFF + b * HY_WS) + 224;
#pragma unroll
        for (int r = 0; r < 16; ++r) {
            const int t = 32 * (8 * w + Tl) + (r & 3) + 8 * (r >> 2) + 4 * hh; const int tok = b * L + t;
            const float y = acc0[r] + acc1[r] + sk * bf2f(wl[t]);
            mix[(size_t)tok * D + 1024 + c] = f2bf(bf2f(x0[(size_t)tok * 512 + c]) * y);
        }
        __syncthreads();
    }
}

constexpr int SWA_P = 144, SWA_KB = 64 * SWA_P, SWA_STAGE = 2 * SWA_KB;
__device__ __forceinline__ void ph_swa(const Args& a, int l, bool with_ctx, unsigned char* lds) {
    const bf16_t* __restrict__ SQ = (const bf16_t*)(a.ws + WS_SQ); const bf16_t* __restrict__ SK = (const bf16_t*)(a.ws + WS_SK); const bf16_t* __restrict__ SVT = (const bf16_t*)(a.ws + WS_SV);
    const float* sink = a.in[24] + l * 8; bf16_t* __restrict__ mix = (bf16_t*)(a.ws + WS_MIX);
    int tid_ = threadIdx.x; asm volatile("" : "+v"(tid_));
    const int tid = tid_, lane = tid & 63, w = tid >> 6, qi = lane & 31, hh = lane >> 5;
    const int nunits = with_ctx ? 288 : 256;
    const float c = 0.125f * 1.4426950408889634f;
    for (int unit = blockIdx.x; unit < nunits; unit += gridDim.x) {
        int hk, b, p0, nloc, t0loc, q0tok; bool ctxq;
        if (unit < 256) { hk = unit & 1; b = (unit >> 1) & 3; p0 = (unit >> 3) * 64; ctxq = false; q0tok = b * L + p0;
            const int lo = p0 - 128 < 0 ? 0 : p0 - 128, hi = p0 + 192 > L ? L : p0 + 192; t0loc = lo; nloc = (hi - lo) >> 6; }
        else { const int u2 = unit - 256; hk = u2 & 1; b = (u2 >> 1) & 3; p0 = (u2 >> 3) * 64; ctxq = true; q0tok = NLAT + b * C + p0; t0loc = 0; nloc = 0; }
        const int nt = nloc + 4;
#define SWA_KTOK(t) ((t) < nloc ? (b * L + t0loc + (t) * 64) : (NLAT + b * C + ((t) - nloc) * 64))
        u32x4 r0, r1;
#define SWA_ISSUE(t) do { const int kt0_ = SWA_KTOK(t); \
            r0 = *(const u32x4*)(SK + (size_t)(kt0_ + (tid >> 3)) * 128 + hk * 64 + (tid & 7) * 8); \
            r1 = *(const u32x4*)(SVT + (size_t)(hk * 64 + (tid >> 3)) * NTOK + kt0_ + (tid & 7) * 8); } while (0)
#define SWA_COMMIT(buf) do { unsigned char* kb_ = lds + (buf) * SWA_STAGE; unsigned char* vb_ = kb_ + SWA_KB; \
            *(u32x4*)(kb_ + (tid >> 3) * SWA_P + (tid & 7) * 16) = r0; \
            const int g_ = (tid & 7) >> 1, e_ = tid & 1; u32x2 lo_, hi_; lo_.x = r1.x; lo_.y = r1.y; hi_.x = r1.z; hi_.y = r1.w; \
            *(u32x2*)(vb_ + (tid >> 3) * SWA_P + g_ * 32 + e_ * 8) = lo_; *(u32x2*)(vb_ + (tid >> 3) * SWA_P + g_ * 32 + 16 + e_ * 8) = hi_; } while (0)
        const int hq = hk * 4 + (w >> 1), qpos = p0 + (w & 1) * 32 + qi, qtok = q0tok + (w & 1) * 32 + qi;
        bf16x8 qf[4];
#pragma unroll
        for (int s = 0; s < 4; ++s) qf[s] = *(const bf16x8*)(SQ + (size_t)qtok * 512 + hq * 64 + s * 16 + hh * 8);
        f32x16 o[2];
#pragma unroll
        for (int d = 0; d < 2; ++d)
#pragma unroll
            for (int r = 0; r < 16; ++r) o[d][r] = 0.f;
        float m = sink[hq] * 1.4426950408889634f, lsum = hh == 0 ? 1.0f : 0.0f;
        SWA_ISSUE(0); SWA_COMMIT(0);
        __syncthreads();
        for (int t = 0; t < nt; ++t) {
            const unsigned char* kb = lds + (t & 1) * SWA_STAGE; const unsigned char* vb = kb + SWA_KB;
            f32x16 s0, s1;
#pragma unroll
            for (int r = 0; r < 16; ++r) { s0[r] = 0.f; s1[r] = 0.f; }
#pragma unroll
            for (int s = 0; s < 4; ++s) {
                const bf16x8 k0 = *(const bf16x8*)(kb + qi * SWA_P + s * 32 + hh * 16);
                const bf16x8 k1 = *(const bf16x8*)(kb + (32 + qi) * SWA_P + s * 32 + hh * 16);
                s0 = MFMA32(k0, qf[s], s0); s1 = MFMA32(k1, qf[s], s1);
            }
            if (t + 1 < nt) SWA_ISSUE(t + 1);
            if (t < nloc) {
                const int kbase = t0loc + t * 64 + 4 * hh - qpos;
#pragma unroll
                for (int r = 0; r < 16; ++r) { const int dlt = kbase + (r & 3) + 8 * (r >> 2);
                    if (dlt > 128 || dlt < -128) s0[r] = -1.0e30f;
                    if (dlt + 32 > 128 || dlt + 32 < -128) s1[r] = -1.0e30f; }
            }
            float mx = fmaxf(s0[0], s1[0]);
#pragma unroll
            for (int r = 1; r < 16; ++r) mx = fmaxf(mx, fmaxf(s0[r], s1[r]));
            mx = fmaxf(mx, __shfl_xor(mx, 32));
            const float mnew = fmaxf(m, mx * c);
            const float alpha = __builtin_amdgcn_exp2f(m - mnew);
            m = mnew;
            float ps = 0.f;
#pragma unroll
            for (int r = 0; r < 16; ++r) { s0[r] = __builtin_amdgcn_exp2f(s0[r] * c - mnew); s1[r] = __builtin_amdgcn_exp2f(s1[r] * c - mnew); ps += s0[r] + s1[r]; }
            lsum = lsum * alpha + ps;
#pragma unroll
            for (int d = 0; d < 2; ++d)
#pragma unroll
                for (int r = 0; r < 16; ++r) o[d][r] *= alpha;
            bf16x8 pf[4];
            { u32x4 p;
              p.x = cvtpk(s0[0], s0[1]); p.y = cvtpk(s0[2], s0[3]); p.z = cvtpk(s0[4], s0[5]); p.w = cvtpk(s0[6], s0[7]); pf[0] = __builtin_bit_cast(bf16x8, p);
              p.x = cvtpk(s0[8], s0[9]); p.y = cvtpk(s0[10], s0[11]); p.z = cvtpk(s0[12], s0[13]); p.w = cvtpk(s0[14], s0[15]); pf[1] = __builtin_bit_cast(bf16x8, p);
              p.x = cvtpk(s1[0], s1[1]); p.y = cvtpk(s1[2], s1[3]); p.z = cvtpk(s1[4], s1[5]); p.w = cvtpk(s1[6], s1[7]); pf[2] = __builtin_bit_cast(bf16x8, p);
              p.x = cvtpk(s1[8], s1[9]); p.y = cvtpk(s1[10], s1[11]); p.z = cvtpk(s1[12], s1[13]); p.w = cvtpk(s1[14], s1[15]); pf[3] = __builtin_bit_cast(bf16x8, p); }
#pragma unroll
            for (int d = 0; d < 2; ++d)
#pragma unroll
                for (int g = 0; g < 4; ++g) {
                    const bf16x8 vf = *(const bf16x8*)(vb + (d * 32 + qi) * SWA_P + g * 32 + hh * 16);
                    o[d] = MFMA32(vf, pf[g], o[d]);
                }
            if (t + 1 < nt) SWA_COMMIT((t + 1) & 1);
            __syncthreads();
        }
        const float inv = 1.0f / (lsum + __shfl_xor(lsum, 32));
        bf16_t* op = mix + (size_t)qtok * D + 1536 + hq * 64 + 4 * hh;
#pragma unroll
        for (int d = 0; d < 2; ++d)
#pragma unroll
            for (int g = 0; g < 4; ++g) { u32x2 wv; wv.x = cvtpk(o[d][4 * g] * inv, o[d][4 * g + 1] * inv); wv.y = cvtpk(o[d][4 * g + 2] * inv, o[d][4 * g + 3] * inv);
                *(u32x2*)(op + d * 32 + 8 * g) = wv; }
#undef SWA_KTOK
#undef SWA_ISSUE
#undef SWA_COMMIT
    }
}


constexpr int NPHASES = 22;
#define GEMM_CALL(EPI, SCHED, g, S, E) pg8::gemm_phase<EPI, SCHED, true, true>((PG8_LAS unsigned char*)lds, g, S, E)
#define GEMM_CALL8(EPI, SCHED, g, S, E) pg8::gemm_phase<EPI, SCHED, true, true, true>((PG8_LAS unsigned char*)lds, g, S, E)

template <int LYR>
__device__ __forceinline__ void layer_phases(const Args& a, unsigned char* lds, const XcdBarrier& bar, int lo, int hi) {
#define IN(k) (lo <= (k) && (k) < hi)
#define REPS(k) for (int rep_ = 0; rep_ <= (int)((PROBE_MASK >> (k)) & 1u); ++rep_)
#if MK_PER_PHASE
#define SEAM(k) do { } while (0)
#else
#define SEAM(k) do { if (IN(k) && IN((k) + 1)) xcd_barrier(bar); } while (0)
#endif
    constexpr int P0 = 1 + LYR * 9;
    constexpr bool LAST = (LYR == 1);
    constexpr int S_WO = pg8::split_S((LAST ? NLAT : NTOK) / 256 * (D / 256), D / 64, 256);
    constexpr int S_WO0 = pg8::split_S(NTOK / 256 * (D / 256), D / 64, 256);
    constexpr int S_DN0 = pg8::split_S(NTOK / 256 * (D / 256), FP8_DENSE ? DFF / 128 : DFF / 64, 256);
    constexpr int S_DN = pg8::split_S(NTOK / 256 * (D / 256), FP8_DENSE ? DFF / 128 : DFF / 64, 256);
    const int G = gridDim.x, bid = blockIdx.x;
    unsigned char* ws = a.ws;
    const float* modl = (const float*)(ws + WS_MOD) + (size_t)LYR * 5 * 12288;
    float* xs = (float*)(ws + WS_XS);
    const int nq = LAST ? NLAT : NTOK;
    if (IN(P0 + 0)) REPS(P0 + 0) {
        if (LYR == 0) ph_normmod<false, true>(a.in[0], a.in[2], a.in[6], modl, 0, 2048, (bf16_t*)(ws + WS_HA), NTOK, xs, nullptr, nullptr, nullptr);
        else ph_normmod<false, false, false, S_DN0>(xs, xs + (size_t)NLAT * D, a.in[6] + D, modl, 0, 2048, (bf16_t*)(ws + WS_HA), NTOK, nullptr, nullptr, nullptr, nullptr,
                                                    (const float*)(ws + WS_SLAB), (const float*)(ws + WS_MOD) + (size_t)4 * 12288 + 10240);
    }
    SEAM(P0 + 0);
    if (IN(P0 + 1)) REPS(P0 + 1) {
        pg8::Gemm g{(const bf16_t*)(ws + WS_HA), (const bf16_t*)(ws + WS_WIN + (size_t)LYR * UW * D * 2), NTOK, UW, D};
        pg8::StaticOrder S; S.init(NTOK, UW, G, bid, D); pg8::EpiStore E{(bf16_t*)(ws + WS_U), UW};
        GEMM_CALL(pg8::EpiStore, pg8::StaticOrder, g, S, E);
        conv_fill(a, (float*)lds, LYR * 6 + 0);
    }
    SEAM(P0 + 1);
    if (IN(P0 + 2)) REPS(P0 + 2) ph_mid(a, LYR);
    SEAM(P0 + 2);
    if (IN(P0 + 3)) REPS(P0 + 3) {
        SUBREP(0) {
        { pg8::Gemm g{(const bf16_t*)(ws + WS_CQN), (const bf16_t*)(ws + WS_WQ + (size_t)LYR * QW * 768 * 2), nq, QW, 768};
          pg8::StaticOrder S; S.init(nq, QW, G, bid, 768); pg8::EpiQ E{(bf16_t*)(ws + WS_Q), (const float*)(ws + WS_ROPE), (const float*)(ws + WS_ROPE) + 2048 * 32};
          GEMM_CALL(pg8::EpiQ, pg8::StaticOrder, g, S, E); }
        __syncthreads();
        { pg8::Gemm g{(const bf16_t*)(ws + WS_CKVN), (const bf16_t*)(ws + WS_WKV + (size_t)LYR * KVW * 512 * 2), NTOK, 1024, 512};
          pg8::StaticOrder S; S.init(NTOK, 1024, G, bid, 512); pg8::EpiStore E{(bf16_t*)(ws + WS_KN), 1024};
          GEMM_CALL(pg8::EpiStore, pg8::StaticOrder, g, S, E); }
        __syncthreads();
        { pg8::Gemm g{(const bf16_t*)(ws + WS_WKV + (size_t)LYR * KVW * 512 * 2 + (size_t)1024 * 512 * 2), (const bf16_t*)(ws + WS_CKVN), 1024, NTOK, 512};
          pg8::StaticOrder S; S.init(1024, NTOK, 108, bid >= 216 ? bid - 216 : (bid >= 144 ? bid - 108 : (1 << 24)), 512); pg8::EpiStore E{(bf16_t*)(ws + WS_VT), NTOK};
          GEMM_CALL(pg8::EpiStore, pg8::StaticOrder, g, S, E); }
        __syncthreads();
        }
        SUBREP(1) ph_hyena(a, LYR, lds);
        SUBREP(3) if (!LAST) ph_hyena_naive<C>(a, LYR, (float*)lds);
        SUBREP(2) ph_swa(a, LYR, !LAST, lds);
        conv_fill(a, (float*)lds, LYR * 6 + 1);
    }
    SEAM(P0 + 3);
    if (IN(P0 + 4)) REPS(P0 + 4) { ph_mla(a, !LAST, lds); conv_fill(a, (float*)lds, LYR * 6 + 2); }
    SEAM(P0 + 4);
    if (IN(P0 + 5)) REPS(P0 + 5) {
        pg8::Gemm g{(const bf16_t*)(ws + WS_MIX), (const bf16_t*)(ws + WS_WOUT + (size_t)LYR * D * D * 2), nq, D, D};
        pg8::SplitOrder S; S.init(nq / 256, D / 256, G, bid, D, S_WO);
        const int trow0 = S.nfull / S.nN * 256; pg8::EpiResid E{rep_ ? (float*)(ws + WS_ACT) : xs, modl + 4096, (float*)(ws + WS_SLAB), trow0, nq - trow0, 1.0f};
        GEMM_CALL(pg8::EpiResid, pg8::SplitOrder, g, S, E);
        conv_fill(a, (float*)lds, LYR * 6 + 3);
    }
    SEAM(P0 + 5);
    if (!LAST) {
#if !FP8_DENSE
        if (IN(P0 + 6)) { ph_normmod<false, true, false, S_WO0>(xs, xs + (size_t)NLAT * D, a.in[7], modl, 6144, 8192, (bf16_t*)(ws + WS_HA), NTOK, xs, nullptr, nullptr, nullptr, (const float*)(ws + WS_SLAB), modl + (size_t)4 * 12288 + 4096);
            conv_finish(a, (float*)lds, CONV_DENSE_END); }
        SEAM(P0 + 6);
        if (IN(P0 + 7)) REPS(P0 + 7) {
            pg8::Gemm g{(const bf16_t*)(ws + WS_HA), (const bf16_t*)(ws + WS_WGU), NTOK, 2 * DFF, D};
            pg8::StaticOrder S; S.init(NTOK, 2 * DFF, G, bid, D); pg8::EpiSwiGLU E{(bf16_t*)(ws + WS_ACT), DFF};
            GEMM_CALL(pg8::EpiSwiGLU, pg8::StaticOrder, g, S, E);
            conv_fill(a, (float*)lds, 4);
        }
        SEAM(P0 + 7);
        if (IN(P0 + 8)) REPS(P0 + 8) {
            pg8::Gemm g{(const bf16_t*)(ws + WS_ACT), (const bf16_t*)(ws + WS_WDN), NTOK, D, DFF};
            pg8::SplitOrder S; S.init(NTOK / 256, D / 256, G, bid, DFF, S_DN);
            const int trow0 = S.nfull / S.nN * 256; pg8::EpiResid E{rep_ ? (float*)(ws + WS_YS) : xs, modl + 10240, (float*)(ws + WS_SLAB), trow0, NTOK - trow0, 1.0f};
            GEMM_CALL(pg8::EpiResid, pg8::SplitOrder, g, S, E);
            conv_fill(a, (float*)lds, 5);
        }
#else
        if (IN(P0 + 6)) { ph_normmod<false, true, true, S_WO0>(xs, xs + (size_t)NLAT * D, a.in[7], modl, 6144, 8192, (bf16_t*)(ws + WS_HA), NTOK, xs, nullptr, nullptr, nullptr, (const float*)(ws + WS_SLAB), modl + (size_t)4 * 12288 + 4096);
            conv_finish(a, (float*)lds, CONV_DENSE_END); }
        SEAM(P0 + 6);
        if (IN(P0 + 7)) REPS(P0 + 7) {
            pg8::Gemm g{(const bf16_t*)(ws + WS_HA), (const bf16_t*)(ws + WS_WGU), NTOK, 2 * DFF, D / 2};
            pg8::StaticOrder S; S.init(NTOK, 2 * DFF, G, bid, D / 2); pg8::EpiSwiGLU8 E{(unsigned char*)(ws + WS_ACT), DFF, 1.0f / (ASCALE * WSCALE), ASCALE};
            GEMM_CALL8(pg8::EpiSwiGLU8, pg8::StaticOrder, g, S, E);
            conv_fill(a, (float*)lds, 4);
        }
        SEAM(P0 + 7);
        if (IN(P0 + 8)) REPS(P0 + 8) {
            pg8::Gemm g{(const bf16_t*)(ws + WS_ACT), (const bf16_t*)(ws + WS_WDN), NTOK, D, DFF / 2};
            pg8::SplitOrder S; S.init(NTOK / 256, D / 256, G, bid, DFF / 2, S_DN);
            const int trow0 = S.nfull / S.nN * 256; pg8::EpiResid E{rep_ ? (float*)(ws + WS_YS) : xs, modl + 10240, (float*)(ws + WS_SLAB), trow0, NTOK - trow0, 1.0f / (ASCALE * WSCALE)};
            GEMM_CALL8(pg8::EpiResid, pg8::SplitOrder, g, S, E);
            conv_fill(a, (float*)lds, 5);
        }
#endif
        SEAM(P0 + 8);
    } else {
        if (IN(P0 + 6)) REPS(P0 + 6) ph_normmod<true, false, true>(xs, xs + (size_t)NLAT * D, a.in[7] + D, modl, 6144, 8192, (bf16_t*)(ws + WS_HA), NLAT, nullptr, a.in[29], (int*)(ws + WS_TOPI), (float*)(ws + WS_TOPW));
        SEAM(P0 + 6);
        if (IN(P0 + 7)) REPS(P0 + 7) { ph_route_gather(a, (int*)lds); conv_finish(a, (float*)lds, NCONV); }
        SEAM(P0 + 7);
        if (IN(P0 + 9)) REPS(P0 + 9) {
            pg8::Gemm g{(const bf16_t*)(ws + WS_HBS), (const bf16_t*)(ws + WS_MGU), MOE_ROWS, 2 * DFE, D / 2};
            pg8::MoeOrder S; S.init((const int*)(ws + WS_CTL), 2 * DFE / 256, G, bid, (size_t)2 * DFE * D, D / 2); pg8::EpiSwiGLU8 E{(unsigned char*)(ws + WS_ACT), DFE, 1.0f / (ASCALE * WSCALE), ASCALE};
            GEMM_CALL8(pg8::EpiSwiGLU8, pg8::MoeOrder, g, S, E);
        }
        SEAM(P0 + 9);
        if (IN(P0 + 10)) REPS(P0 + 10) {
            pg8::Gemm g{(const bf16_t*)(ws + WS_ACT), (const bf16_t*)(ws + WS_MDN), MOE_ROWS, D, DFE / 2};
            pg8::SplitOrder S; S.init_moe((const int*)(ws + WS_CTL), D / 256, G, bid, DFE / 2, (size_t)D * DFE);
            const int trow0 = S.nfull / S.nN * 256; pg8::EpiYs E{(bf16_t*)(ws + WS_YS), (float*)(ws + WS_SLAB), trow0, S.nM * 256 - trow0, 1.0f / (ASCALE * WSCALE)};
            GEMM_CALL8(pg8::EpiYs, pg8::SplitOrder, g, S, E);
        }
        SEAM(P0 + 10);
        if (IN(P0 + 11)) REPS(P0 + 11) ph_final(a);
    }
#undef IN
#undef SEAM
#undef REPS
}

__global__ void __launch_bounds__(NTHR, 2) mk_fwd(Args a) {
    extern __shared__ __attribute__((aligned(16))) unsigned char lds[];
    const int tid = threadIdx.x;
    for (int u = tid; u < (LDS_BYTES - LDSCTL_OFF) / 4; u += NTHR) ((unsigned*)(lds + LDSCTL_OFF))[u] = 0u;
    __syncthreads();
    XcdBarrier bar; bar.bar = (unsigned*)(a.ws + WS_CTL) + CW_BAR; bar.x = 0; bar.st = nullptr;
#if !MK_PER_PHASE
    bar = xcd_barrier_post((unsigned*)(a.ws + WS_CTL) + CW_BAR, (volatile LAS unsigned*)(lds + LDSCTL_OFF + 32));
#endif
    const int lo = a.ph_lo, hi = a.ph_hi;
    if (lo <= 0 && 0 < hi) {
        for (int rep_ = 0; rep_ <= (int)(PROBE_MASK & 1u); ++rep_) { ph_prologue(a, (float*)lds); __syncthreads(); }
#if !MK_PER_PHASE
        if (1 < hi) xcd_barrier(bar);
#endif
    }
    layer_phases<0>(a, lds, bar, lo, hi);
    layer_phases<1>(a, lds, bar, lo, hi);
}

extern "C" void kernel_launch(void* const* d_in, const int* in_sizes, int n_in, void* d_out, int out_size, void* d_ws, size_t ws_size, hipStream_t stream) {
    (void)in_sizes; (void)out_size;
    static int grid = 0;
    if (grid == 0) {
        if (n_in != 34 || ws_size < WS_END) { fprintf(stderr, "kernel_launch: need 34 inputs and >= %zu bytes of workspace (got %d, %zu)\n", (size_t)WS_END, n_in, ws_size); grid = -1; return; }
        int dev = 0, cus = 0, per_cu = 0;
        if (hipGetDevice(&dev) != hipSuccess || hipDeviceGetAttribute(&cus, hipDeviceAttributeMultiprocessorCount, dev) != hipSuccess) { grid = -1; return; }
        if (hipFuncSetAttribute((const void*)mk_fwd, hipFuncAttributeMaxDynamicSharedMemorySize, LDS_BYTES) != hipSuccess) { fprintf(stderr, "kernel_launch: hipFuncSetAttribute failed\n"); grid = -1; return; }
        if (hipOccupancyMaxActiveBlocksPerMultiprocessor(&per_cu, (const void*)mk_fwd, NTHR, LDS_BYTES) != hipSuccess || per_cu < 1) { fprintf(stderr, "kernel_launch: occupancy query says %d blocks per CU\n", per_cu); }
        (void)hipGetLastError();
        grid = cus;
    }
    if (grid < 0) return;
    if (hipMemsetAsync((char*)d_ws + WS_CTL, 0, CTL_ZERO_BYTES, stream) != hipSuccess) return;
    Args a{};
    for (int i = 0; i < 34; ++i) a.in[i] = (const float*)d_in[i];
    a.out = (float*)d_out; a.ws = (unsigned char*)d_ws;
#if MK_PER_PHASE
    for (int p = 0; p < NPHASES; ++p) { a.ph_lo = p; a.ph_hi = p + 1; hipLaunchKernelGGL(mk_fwd, dim3(grid), dim3(NTHR), LDS_BYTES, stream, a); }
#else
    a.ph_lo = 0; a.ph_hi = NPHASES;
    hipLaunchKernelGGL(mk_fwd, dim3(grid), dim3(NTHR), LDS_BYTES, stream, a);
#endif
}
```

```cpp
#include <hip/hip_runtime.h>
#include <stdint.h>
#include <stdio.h>

#ifndef FP8_DENSE
#define FP8_DENSE 0
#endif
#ifndef FP8_DOWN
#define FP8_DOWN 1
#endif
#ifndef CONV_FILL
#define CONV_FILL 0
#endif
#ifndef PROBE_MASK
#define PROBE_MASK 0u
#endif
#ifndef PROBE_SUB
#define PROBE_SUB 0u
#endif
#ifndef MK_PER_PHASE
#define MK_PER_PHASE 0
#endif

typedef unsigned short bf16_t;
typedef float f32x4 __attribute__((ext_vector_type(4)));
typedef float f32x16 __attribute__((ext_vector_type(16)));
typedef unsigned u32x4 __attribute__((ext_vector_type(4)));
typedef unsigned u32x2 __attribute__((ext_vector_type(2)));
typedef short bf16x8 __attribute__((ext_vector_type(8)));

constexpr int D = 2048, NB = 4, L = 2048, C = 256, NLAT = NB * L, NCTX = NB * C, NTOK = NLAT + NCTX;
constexpr int UW = 3840;
constexpr int O_CQ = 0, O_CKV = 768, O_KPE = 1280, O_HY = 1344, O_SQ = 2880, O_SK = 3392, O_SV = 3520, INW = 3648;
constexpr int QW = 1536, KVW = 2048, DFF = 5632, DFE = 7168, NE = 8;
constexpr int MOE_ROWS = 18432;
constexpr float EPS = 1e-6f;
constexpr int NTHR = 512;
constexpr int HY_RBROW = 4112;

__device__ __forceinline__ float bf2f(bf16_t h) { return __uint_as_float(((unsigned)h) << 16); }
__device__ __forceinline__ bf16_t f2bf(float f) { unsigned u = __float_as_uint(f); u += 0x7fffu + ((u >> 16) & 1u); return (bf16_t)(u >> 16); }
__device__ __forceinline__ float wave_sum(float v) { for (int o = 32; o > 0; o >>= 1) v += __shfl_xor(v, o); return v; }
__device__ __forceinline__ float wave_max(float v) { for (int o = 32; o > 0; o >>= 1) v = fmaxf(v, __shfl_xor(v, o)); return v; }
__device__ __forceinline__ float silu(float x) { return x / (1.0f + __expf(-x)); }
__device__ __forceinline__ int tok_mod(int tok) { return tok < NLAT ? (tok >> 11) : 4; }

constexpr size_t al(size_t x) { return (x + 255) & ~(size_t)255; }
constexpr size_t WS_CTL = 0, CTL_ZERO_BYTES = 65536;
constexpr size_t WS_MOD = 65536;
constexpr size_t WS_ROPE = WS_MOD + al((size_t)2 * 5 * 12288 * 4);
constexpr size_t WS_FILTL = WS_ROPE + al((size_t)2 * 2048 * 32 * 4);
constexpr size_t WS_FILTC = WS_FILTL + al((size_t)2 * 512 * 4096 * 4);
constexpr size_t WS_WIN = WS_FILTC + al((size_t)2 * 512 * 512 * 4);
constexpr size_t WS_WQ = WS_WIN + al((size_t)2 * UW * D * 2);
constexpr size_t WS_WKV = WS_WQ + al((size_t)2 * QW * 768 * 2);
constexpr size_t WS_WOUT = WS_WKV + al((size_t)2 * KVW * 512 * 2);
constexpr size_t WS_WGU = WS_WOUT + al((size_t)2 * D * D * 2);
constexpr size_t WS_WDN = WS_WGU + al((size_t)2 * DFF * D * 2);
constexpr size_t WS_MGU = WS_WDN + al((size_t)D * DFF * 2);
constexpr size_t WS_MDN = WS_MGU + al((size_t)NE * 2 * DFE * D * 2);
constexpr size_t WS_HA = WS_MDN + al((size_t)NE * D * DFE * 2);
constexpr size_t WS_U = WS_HA + al((size_t)NTOK * D * 2);
constexpr size_t WS_CQN = WS_U + al((size_t)NTOK * UW * 2);
constexpr size_t WS_CKVN = WS_CQN + al((size_t)NTOK * 768 * 2);
constexpr size_t WS_KPE = WS_CKVN + al((size_t)NTOK * 512 * 2);
constexpr size_t WS_X0 = WS_KPE + al((size_t)NTOK * 64 * 2);
constexpr size_t WS_WTL = WS_X0 + al((size_t)NTOK * 512 * 2);
constexpr size_t WS_WTC = WS_WTL + al((size_t)NB * 512 * L * 2);
constexpr size_t WS_SQ = WS_WTC + al((size_t)NB * 512 * C * 2);
constexpr size_t WS_SK = WS_SQ + al((size_t)NTOK * 512 * 2);
constexpr size_t WS_SV = WS_SK + al((size_t)NTOK * 128 * 2);
constexpr size_t WS_Q = WS_SV + al((size_t)NTOK * 128 * 2);
constexpr size_t WS_KV = WS_Q + al((size_t)NTOK * QW * 2);
constexpr size_t WS_KN = WS_KV;
constexpr size_t WS_VT = WS_KV + (size_t)NTOK * 1024 * 2;
constexpr size_t WS_MIX = WS_KV + al((size_t)NTOK * KVW * 2);
constexpr size_t WS_MIXEND = WS_MIX + al((size_t)NTOK * D * 2);
constexpr size_t WS_YS = WS_U;
static_assert(WS_YS + (size_t)MOE_ROWS * D * 4 <= WS_MIXEND, "ys overlay");
constexpr size_t WS_XS = WS_MIXEND;
constexpr size_t WS_ACT = WS_XS + al((size_t)NTOK * D * 4);
constexpr size_t WS_HBS = WS_ACT + al((size_t)MOE_ROWS * DFE * 2);
constexpr size_t WS_TOPI = WS_HBS + al((size_t)MOE_ROWS * D * 2);
constexpr size_t WS_TOPW = WS_TOPI + al((size_t)NLAT * 2 * 4);
constexpr size_t WS_POS = WS_TOPW + al((size_t)NLAT * 2 * 4);
constexpr size_t WS_SRC = WS_POS + al((size_t)NLAT * 2 * 4);
constexpr size_t WS_SLAB = WS_SRC + al((size_t)MOE_ROWS * 4);
constexpr size_t WS_END = WS_SLAB + ((size_t)64 << 20);
constexpr int CT_EOFF = 1024, CT_EPAD = 1040, CT_NTILE = 1056, CT_MOES = 1057, CT_TROW = 1058;
constexpr int CW_BAR = 4096;

constexpr int RING_BYTES = 131072, LDS_BYTES = 147456, LDSCTL_OFF = LDS_BYTES - 256;

namespace pg8 {
#define PG8_LAS __attribute__((address_space(3)))
typedef unsigned short bf16_t;
typedef short bf16x8 __attribute__((ext_vector_type(8)));
typedef float f32x4 __attribute__((ext_vector_type(4)));
typedef unsigned u32x4 __attribute__((ext_vector_type(4)));
constexpr int BM = 256, BK = 64, HALF = 128, HTB = HALF * BK * 2  , STAGE_BYTES = 8 * HTB, NXCD = 8, WGM = 8;

__host__ __device__ __forceinline__ int lds_byte(int r, int c) { const int st = (r >> 4) * 2 + (c >> 5), rr = r & 15, cc = c & 31, ob = rr * 64 + cc * 2; return st * 1024 + (ob ^ (((ob >> 9) & 1) << 5)); }
__host__ __device__ __forceinline__ void stage_rc(int b, int& R, int& C) { const int st = b / 1024, sb = b % 1024, swz = sb ^ (((sb >> 9) & 1) << 5); R = (st >> 1) * 16 + swz / 64; C = (st & 1) * 32 + (swz % 64) / 2; }
__host__ __device__ __forceinline__ int perm32(int rho) { const int n = rho >> 4, i = rho & 15; return 8 * (i >> 2) + 4 * n + (i & 3); }

struct Unit { int pm, pn, kt0, nkt, slab; };
struct Gemm { const bf16_t* A; const bf16_t* Bt; int M, N, K; };

struct StaticOrder {
    int nM, nN, nwg, G, c;
    int nkt;
    __host__ __device__ void init(int M, int N, int G_, int c_, int K) { nM = M / BM; nN = N / BM; nwg = nM * nN; G = G_; c = c_; nkt = K / BK; }
    __host__ __device__ bool next(int i, Unit& u) const {
        const long L = (long)i * G + c; if (L >= nwg) return false;
        int wgid = (int)L; { const int q = nwg / NXCD, r = nwg % NXCD, xcd = wgid % NXCD, off = wgid / NXCD; wgid = (xcd < r ? xcd * (q + 1) : r * (q + 1) + (xcd - r) * q) + off; }
        const int nig = WGM * nN, gid = wgid / nig, fm = gid * WGM, gsz = (nM - fm) < WGM ? (nM - fm) : WGM;
        u.pm = fm + ((wgid % nig) % gsz); u.pn = (wgid % nig) / gsz; u.kt0 = 0; u.nkt = nkt; u.slab = -1; return true;
    }
    __device__ __forceinline__ size_t bt_off(const Unit&) const { return 0; }
    __device__ __forceinline__ void a_ready(const Unit&) const {}
    __device__ __forceinline__ void done(const Unit&) const {}
};

__device__ __forceinline__ unsigned cvt_pk_bf16(float lo, float hi) { unsigned r; asm volatile("v_cvt_pk_bf16_f32 %0, %1, %2" : "=v"(r) : "v"(lo), "v"(hi)); return r; }
typedef float f32x2 __attribute__((ext_vector_type(2)));
typedef int v8i_t __attribute__((ext_vector_type(8))); typedef int v4i_t __attribute__((ext_vector_type(4)));
template <bool F8> struct Frag;
template <> struct Frag<false> { bf16x8 h[2]; __device__ __forceinline__ void set0(bf16x8 x) { h[0] = x; } __device__ __forceinline__ void set1(bf16x8 x) { h[1] = x; } };
template <> struct Frag<true> { v8i_t v; __device__ __forceinline__ void set0(bf16x8 x) { v.lo = __builtin_bit_cast(v4i_t, x); } __device__ __forceinline__ void set1(bf16x8 x) { v.hi = __builtin_bit_cast(v4i_t, x); } };
template <class Epi, class Sched, bool ALIGN_EPI = false, bool SP2 = false, bool FP8 = false>
__device__ __forceinline__ void gemm_phase(PG8_LAS unsigned char* lds, const Gemm g, const Sched& S, const Epi& E) {
    int tid_ = threadIdx.x; asm volatile("" : "+v"(tid_));
    const int tid = tid_, wid = __builtin_amdgcn_readfirstlane(tid >> 6), lane = tid & 63, wr = wid >> 2, wc = wid & 3, fr = lane & 15, fq = lane >> 4;
    const int K = g.K;
    unsigned voffA[2], voffB[2];
#pragma unroll
    for (int i = 0; i < 2; ++i) { int R, C; stage_rc(tid * 16 + i * 8192, R, C); const int Rb = Epi::PERM ? ((R & ~31) + perm32(R & 31)) : R;
        voffA[i] = (unsigned)(R * K + C) * 2u; voffB[i] = (unsigned)(Rb * K + C) * 2u; }
    const size_t kstep = (size_t)(BK * 2);
    const size_t hstep = (size_t)HALF * K * 2;
    const size_t tstep = 2 * hstep;
    const unsigned ldsw = (unsigned)wid * 1024u;
    const int aoff = lds_byte(wr * 64 + fr, fq * 8), boff = lds_byte(wc * 32 + fr, fq * 8);
#define PG8_SA(b, h) (((b) * 2 + (h)) * HTB)
#define PG8_SB(b, h) ((4 + (b) * 2 + (h)) * HTB)
#define PG8_STAGE(bufoff, gbase, voff) do { _Pragma("unroll") for (int _i = 0; _i < 2; ++_i) \
        __builtin_amdgcn_global_load_lds((const unsigned*)((const char*)(gbase) + (voff)[_i]), (PG8_LAS unsigned*)(lds + (bufoff) + ldsw + _i * 8192), 16, 0, 0); } while (0)
#define PG8_LDA(dst, b, h) do { _Pragma("unroll") for (int m = 0; m < 4; ++m) { dst[m].set0(*(const PG8_LAS bf16x8*)(lds + PG8_SA(b, h) + aoff + m * 2048)); dst[m].set1(*(const PG8_LAS bf16x8*)(lds + PG8_SA(b, h) + aoff + m * 2048 + 1024)); } } while (0)
#define PG8_LDB(dst, b, h) do { _Pragma("unroll") for (int n = 0; n < 2; ++n) { dst[n].set0(*(const PG8_LAS bf16x8*)(lds + PG8_SB(b, h) + boff + n * 2048)); dst[n].set1(*(const PG8_LAS bf16x8*)(lds + PG8_SB(b, h) + boff + n * 2048 + 1024)); } } while (0)
#define PG8_MMA(ai, bj, At, Bt) do { __builtin_amdgcn_s_setprio(1); _Pragma("unroll") for (int m = 0; m < 4; ++m) _Pragma("unroll") for (int n = 0; n < 2; ++n) { \
        if constexpr (FP8) asm volatile("v_mfma_f32_16x16x128_f8f6f4 %0, %1, %2, %0" : "+v"(acc[ai][bj][m][n]) : "v"(Bt[n].v), "v"(At[m].v));   \
        else { _Pragma("unroll") for (int k = 0; k < 2; ++k) acc[ai][bj][m][n] = __builtin_amdgcn_mfma_f32_16x16x32_bf16(Bt[n].h[k], At[m].h[k], acc[ai][bj][m][n], 0, 0, 0); } } \
        __builtin_amdgcn_s_setprio(0); } while (0)
#define PG8_WAIT_V(n) asm volatile("s_waitcnt vmcnt(" #n ")" ::: "memory")
#define PG8_WAIT_L(n) asm volatile("s_waitcnt lgkmcnt(" #n ")" ::: "memory")
#define PG8_BAR __builtin_amdgcn_s_barrier()
#define PG8_SCHED __builtin_amdgcn_sched_barrier(0)
    Unit cur, nxt; int ui = 0;
    if (!S.next(0, cur)) return;
    f32x4 acc[2][2][4][2];
#pragma unroll
    for (int a = 0; a < 2; ++a)
#pragma unroll
        for (int b = 0; b < 2; ++b)
#pragma unroll
            for (int m = 0; m < 4; ++m)
#pragma unroll
                for (int n = 0; n < 2; ++n) acc[a][b][m][n] = (f32x4){0.f, 0.f, 0.f, 0.f};
    Frag<FP8> At[4], B0[2], B1[2];
    const char* cA = (const char*)g.A + (size_t)cur.pm * tstep + (size_t)cur.kt0 * kstep; const char* cB = (const char*)g.Bt + S.bt_off(cur) + (size_t)cur.pn * tstep + (size_t)cur.kt0 * kstep;
    S.a_ready(cur);
    if constexpr (SP2) {
        PG8_STAGE(PG8_SB(0, 0), cB, voffB); PG8_STAGE(PG8_SB(0, 1), cB + hstep, voffB); PG8_STAGE(PG8_SA(0, 0), cA, voffA); PG8_STAGE(PG8_SA(0, 1), cA + hstep, voffA);
        if (wr == 1) PG8_BAR;
        PG8_WAIT_V(2); PG8_BAR;
        PG8_STAGE(PG8_SB(1, 0), cB + kstep, voffB); PG8_STAGE(PG8_SA(1, 0), cA + kstep, voffA); PG8_STAGE(PG8_SB(1, 1), cB + hstep + kstep, voffB);
        PG8_WAIT_V(6); PG8_BAR;
    } else {
        PG8_STAGE(PG8_SB(0, 0), cB, voffB); PG8_STAGE(PG8_SA(0, 0), cA, voffA); PG8_STAGE(PG8_SB(0, 1), cB + hstep, voffB); PG8_STAGE(PG8_SA(0, 1), cA + hstep, voffA);
        if (wr == 1) PG8_BAR;
        PG8_WAIT_V(4); PG8_BAR;
        PG8_STAGE(PG8_SB(1, 0), cB + kstep, voffB); PG8_STAGE(PG8_SA(1, 0), cA + kstep, voffA); PG8_STAGE(PG8_SB(1, 1), cB + hstep + kstep, voffB);
        PG8_WAIT_V(6); PG8_BAR;
    }
    for (;;) {
        const bool has_next = S.next(ui + 1, nxt);
        const char* nA = has_next ? (const char*)g.A + (size_t)nxt.pm * tstep + (size_t)nxt.kt0 * kstep : cA; const char* nB = has_next ? (const char*)g.Bt + S.bt_off(nxt) + (size_t)nxt.pn * tstep + (size_t)nxt.kt0 * kstep : cB;
        const int nt = cur.nkt;
        for (int t = 0; t < nt; t += 2) {
            const bool last = (t == nt - 2);
            const char* a1 = cA + (size_t)(t + 1) * kstep;
            const char* a2 = last ? nA : cA + (size_t)(t + 2) * kstep; const char* b2 = last ? nB : cB + (size_t)(t + 2) * kstep;
            const char* a3 = a2 + kstep; const char* b3 = b2 + kstep;
            if (last && has_next) S.a_ready(nxt);
            if constexpr (SP2) {
            PG8_LDB(B0, 0, 0); PG8_LDB(B1, 0, 1); PG8_SCHED; PG8_LDA(At, 0, 0); PG8_STAGE(PG8_SA(1, 1), a1 + hstep, voffA);
            PG8_WAIT_V(8); PG8_WAIT_L(0); PG8_BAR; PG8_MMA(0, 0, At, B0); PG8_MMA(0, 1, At, B1); PG8_BAR; PG8_SCHED;
            PG8_LDA(At, 0, 1); PG8_STAGE(PG8_SB(0, 0), b2, voffB); PG8_STAGE(PG8_SB(0, 1), b2 + hstep, voffB); PG8_STAGE(PG8_SA(0, 0), a2, voffA);
            PG8_WAIT_V(8); PG8_WAIT_L(0); PG8_BAR; PG8_MMA(1, 0, At, B0); PG8_MMA(1, 1, At, B1); PG8_BAR; PG8_SCHED;
            PG8_LDB(B0, 1, 0); PG8_LDB(B1, 1, 1); PG8_SCHED; PG8_LDA(At, 1, 0); PG8_STAGE(PG8_SA(0, 1), a2 + hstep, voffA);
            PG8_WAIT_V(8); PG8_WAIT_L(0); PG8_BAR; PG8_MMA(0, 0, At, B0); PG8_MMA(0, 1, At, B1); PG8_BAR; PG8_SCHED;
            PG8_LDA(At, 1, 1); PG8_STAGE(PG8_SB(1, 0), b3, voffB); PG8_STAGE(PG8_SB(1, 1), b3 + hstep, voffB); PG8_STAGE(PG8_SA(1, 0), a3, voffA);
            PG8_WAIT_V(8); PG8_WAIT_L(0); PG8_BAR; PG8_MMA(1, 0, At, B0); PG8_MMA(1, 1, At, B1); PG8_BAR; PG8_SCHED;
            } else {
            PG8_LDB(B0, 0, 0); PG8_SCHED; PG8_LDA(At, 0, 0); PG8_STAGE(PG8_SA(1, 1), a1 + hstep, voffA);
            PG8_WAIT_L(8); PG8_BAR; PG8_WAIT_L(0); PG8_MMA(0, 0, At, B0); PG8_BAR; PG8_SCHED;
            PG8_LDB(B1, 0, 1); PG8_STAGE(PG8_SB(0, 0), b2, voffB);
            PG8_BAR; PG8_WAIT_L(0); PG8_MMA(0, 1, At, B1); PG8_BAR;
            PG8_LDA(At, 0, 1); PG8_STAGE(PG8_SA(0, 0), a2, voffA);
            PG8_BAR; PG8_WAIT_L(0); PG8_MMA(1, 0, At, B0); PG8_BAR; PG8_SCHED;
            PG8_STAGE(PG8_SB(0, 1), b2 + hstep, voffB);
            PG8_WAIT_V(6); PG8_BAR; PG8_MMA(1, 1, At, B1); PG8_BAR;
            PG8_LDB(B0, 1, 0); PG8_SCHED; PG8_LDA(At, 1, 0); PG8_STAGE(PG8_SA(0, 1), a2 + hstep, voffA);
            PG8_WAIT_L(8); PG8_BAR; PG8_WAIT_L(0); PG8_MMA(0, 0, At, B0); PG8_BAR; PG8_SCHED;
            PG8_LDB(B1, 1, 1); PG8_STAGE(PG8_SB(1, 0), b3, voffB);
            PG8_BAR; PG8_WAIT_L(0); PG8_MMA(0, 1, At, B1); PG8_BAR;
            PG8_LDA(At, 1, 1); PG8_STAGE(PG8_SA(1, 0), a3, voffA);
            PG8_BAR; PG8_WAIT_L(0); PG8_MMA(1, 0, At, B0); PG8_BAR; PG8_SCHED;
            PG8_STAGE(PG8_SB(1, 1), b3 + hstep, voffB);
            PG8_WAIT_V(6); PG8_BAR; PG8_MMA(1, 1, At, B1); PG8_BAR;
            }
        }
        if constexpr (ALIGN_EPI) { if (wr == 0) PG8_BAR; }
        if constexpr (FP8) asm volatile("s_nop 15\n\ts_nop 15" ::: "memory");
        if constexpr (!Epi::AFTER_DRAIN) { E(acc, cur, wr, wc, fr, fq); S.done(cur); }
        if (!has_next) break;
#pragma unroll
        for (int a = 0; a < 2; ++a)
#pragma unroll
            for (int b = 0; b < 2; ++b)
#pragma unroll
                for (int m = 0; m < 4; ++m)
#pragma unroll
                    for (int n = 0; n < 2; ++n) acc[a][b][m][n] = (f32x4){0.f, 0.f, 0.f, 0.f};
        cur = nxt; cA = nA; cB = nB; ++ui;
        if constexpr (ALIGN_EPI) { if (wr == 1) PG8_BAR; }
    }
    PG8_WAIT_V(0);
    if constexpr (!ALIGN_EPI) { if (wr == 0) PG8_BAR; }
    PG8_BAR;
    if constexpr (Epi::AFTER_DRAIN) { E.fused(acc, cur, wr, wc, fr, fq, lds, wid, lane); S.done(cur); }
#undef PG8_SA
#undef PG8_SB
#undef PG8_STAGE
#undef PG8_LDA
#undef PG8_LDB
#undef PG8_MMA
#undef PG8_WAIT_V
#undef PG8_WAIT_L
#undef PG8_BAR
#undef PG8_SCHED
}
}

namespace pg8 {
__device__ __forceinline__ u32x4 pack8(const f32x4 v0, const f32x4 v1) { u32x4 w; w.x = cvt_pk_bf16(v0[0], v0[1]); w.y = cvt_pk_bf16(v0[2], v0[3]); w.z = cvt_pk_bf16(v1[0], v1[1]); w.w = cvt_pk_bf16(v1[2], v1[3]); return w; }
struct EpiStore {
    static constexpr bool PERM = true, AFTER_DRAIN = false;
    bf16_t* O; int ldc;
    __device__ __forceinline__ void operator()(const f32x4 (&acc)[2][2][4][2], const Unit& u, int wr, int wc, int fr, int fq) const {
        const int row0 = u.pm * BM + wr * 64 + fr, col0 = u.pn * BM + wc * 32 + 8 * fq;
#pragma unroll
        for (int ai = 0; ai < 2; ++ai)
#pragma unroll
            for (int m = 0; m < 4; ++m) { bf16_t* rowp = O + (size_t)(row0 + ai * HALF + m * 16) * ldc + col0;
#pragma unroll
                for (int bj = 0; bj < 2; ++bj) *(u32x4*)(rowp + bj * HALF) = pack8(acc[ai][bj][m][0], acc[ai][bj][m][1]); }
    }
};
struct EpiQ {
    static constexpr bool PERM = true, AFTER_DRAIN = false;
    bf16_t* O; const float* cosT; const float* sinT;
    __device__ __forceinline__ void operator()(const f32x4 (&acc)[2][2][4][2], const Unit& u, int wr, int wc, int fr, int fq) const {
        const int row0 = u.pm * BM + wr * 64 + fr, col0 = u.pn * BM + wc * 32 + 8 * fq;
#pragma unroll
        for (int ai = 0; ai < 2; ++ai)
#pragma unroll
            for (int m = 0; m < 4; ++m) { const int row = row0 + ai * HALF + m * 16; const bool lat = row < 8192; const int t = row & 2047;
#pragma unroll
                for (int bj = 0; bj < 2; ++bj) { const int col = col0 + bj * HALF; const int jn = col - 192 * (col / 192);
                    f32x4 v0 = acc[ai][bj][m][0], v1 = acc[ai][bj][m][1];
                    if (jn >= 128 && lat) { const int i0 = (jn - 128) >> 1;
                        const f32x4 cs = *(const f32x4*)(cosT + t * 32 + i0), sn = *(const f32x4*)(sinT + t * 32 + i0);
                        f32x4 r0, r1;
                        r0[0] = v0[0] * cs[0] - v0[1] * sn[0]; r0[1] = v0[0] * sn[0] + v0[1] * cs[0];
                        r0[2] = v0[2] * cs[1] - v0[3] * sn[1]; r0[3] = v0[2] * sn[1] + v0[3] * cs[1];
                        r1[0] = v1[0] * cs[2] - v1[1] * sn[2]; r1[1] = v1[0] * sn[2] + v1[1] * cs[2];
                        r1[2] = v1[2] * cs[3] - v1[3] * sn[3]; r1[3] = v1[2] * sn[3] + v1[3] * cs[3];
                        v0 = r0; v1 = r1; }
                    *(u32x4*)(O + (size_t)row * 1536 + col) = pack8(v0, v1); } }
    }
};
struct EpiResid {
    static constexpr bool PERM = false, AFTER_DRAIN = false;
    float* xs; const float* gate; float* slab; int tail_row0, tail_rows; float scale;
    __device__ __forceinline__ void operator()(const f32x4 (&acc)[2][2][4][2], const Unit& u, int wr, int wc, int fr, int fq) const {
        const int row0 = u.pm * BM + wr * 64 + fr, colb = u.pn * BM + wc * 32 + 4 * fq;
        if (u.slab >= 0) {
#pragma unroll
            for (int ai = 0; ai < 2; ++ai)
#pragma unroll
                for (int m = 0; m < 4; ++m) { float* sp = slab + ((size_t)u.slab * tail_rows + (row0 + ai * HALF + m * 16 - tail_row0)) * 2048;
#pragma unroll
                    for (int bj = 0; bj < 2; ++bj)
#pragma unroll
                        for (int n = 0; n < 2; ++n) *(f32x4*)(sp + colb + bj * HALF + n * 16) = acc[ai][bj][m][n] * scale; }
            return;
        }
#pragma unroll
        for (int ai = 0; ai < 2; ++ai)
#pragma unroll
            for (int m = 0; m < 4; ++m) { const int row = row0 + ai * HALF + m * 16; const float* gv = gate + (size_t)(row < 8192 ? (row >> 11) : 4) * 12288; float* xr = xs + (size_t)row * 2048;
#pragma unroll
                for (int bj = 0; bj < 2; ++bj)
#pragma unroll
                    for (int n = 0; n < 2; ++n) { const int col = colb + bj * HALF + n * 16; f32x4 x = *(const f32x4*)(xr + col); const f32x4 g = *(const f32x4*)(gv + col);
                        x += (g * scale) * acc[ai][bj][m][n]; *(f32x4*)(xr + col) = x; }
                if (m & 1) asm volatile("" ::: "memory"); }
    }
};
__device__ __forceinline__ unsigned pack4_fp8(float a, float b, float c, float d) {
    a = fminf(fmaxf(a, -448.f), 448.f); b = fminf(fmaxf(b, -448.f), 448.f); c = fminf(fmaxf(c, -448.f), 448.f); d = fminf(fmaxf(d, -448.f), 448.f);
    unsigned w = 0; w = __builtin_amdgcn_cvt_pk_fp8_f32(a, b, w, false); w = __builtin_amdgcn_cvt_pk_fp8_f32(c, d, w, true); return w; }
struct EpiSwiGLU8 {
    static constexpr bool PERM = true, AFTER_DRAIN = false;
    unsigned char* O; int ldc; float s, oscale;
    __device__ __forceinline__ void operator()(const f32x4 (&acc)[2][2][4][2], const Unit& u, int wr, int wc, int fr, int fq) const {
        const int row0 = u.pm * BM + wr * 64 + fr, col0 = u.pn * HALF + wc * 32 + 8 * fq;
#pragma unroll
        for (int ai = 0; ai < 2; ++ai)
#pragma unroll
            for (int m = 0; m < 4; ++m) { f32x4 o0, o1;
#pragma unroll
                for (int j = 0; j < 4; ++j) { const float g0 = acc[ai][0][m][0][j] * s, g1 = acc[ai][0][m][1][j] * s;
                    o0[j] = g0 / (1.0f + __expf(-g0)) * (acc[ai][1][m][0][j] * (s * oscale)); o1[j] = g1 / (1.0f + __expf(-g1)) * (acc[ai][1][m][1][j] * (s * oscale)); }
                u32x2 w; w.x = pack4_fp8(o0[0], o0[1], o0[2], o0[3]); w.y = pack4_fp8(o1[0], o1[1], o1[2], o1[3]);
                *(u32x2*)(O + (size_t)(row0 + ai * HALF + m * 16) * ldc + col0) = w; }
    }
};
struct EpiSwiGLU {
    static constexpr bool PERM = true, AFTER_DRAIN = false;
    bf16_t* O; int ldc;
    __device__ __forceinline__ void operator()(const f32x4 (&acc)[2][2][4][2], const Unit& u, int wr, int wc, int fr, int fq) const {
        const int row0 = u.pm * BM + wr * 64 + fr, col0 = u.pn * HALF + wc * 32 + 8 * fq;
#pragma unroll
        for (int ai = 0; ai < 2; ++ai)
#pragma unroll
            for (int m = 0; m < 4; ++m) { f32x4 o0, o1;
#pragma unroll
                for (int j = 0; j < 4; ++j) { const float g0 = acc[ai][0][m][0][j], g1 = acc[ai][0][m][1][j];
                    o0[j] = g0 / (1.0f + __expf(-g0)) * acc[ai][1][m][0][j]; o1[j] = g1 / (1.0f + __expf(-g1)) * acc[ai][1][m][1][j]; }
                *(u32x4*)(O + (size_t)(row0 + ai * HALF + m * 16) * ldc + col0) = pack8(o0, o1); }
    }
};
struct EpiF32 {
    static constexpr bool PERM = false, AFTER_DRAIN = false;
    float* O; int ldc; float* slab; int tail_row0, tail_rows; float scale;
    __device__ __forceinline__ void operator()(const f32x4 (&acc)[2][2][4][2], const Unit& u, int wr, int wc, int fr, int fq) const {
        const int row0 = u.pm * BM + wr * 64 + fr, colb = u.pn * BM + wc * 32 + 4 * fq;
#pragma unroll
        for (int ai = 0; ai < 2; ++ai)
#pragma unroll
            for (int m = 0; m < 4; ++m) { float* xr = (u.slab >= 0) ? slab + ((size_t)u.slab * tail_rows + (row0 + ai * HALF + m * 16 - tail_row0)) * 2048 : O + (size_t)(row0 + ai * HALF + m * 16) * ldc;
#pragma unroll
                for (int bj = 0; bj < 2; ++bj)
#pragma unroll
                    for (int n = 0; n < 2; ++n) *(f32x4*)(xr + colb + bj * HALF + n * 16) = acc[ai][bj][m][n] * scale; }
    }
};
struct EpiYs {
    static constexpr bool PERM = false, AFTER_DRAIN = false;
    bf16_t* O; float* slab; int tail_row0, tail_rows; float scale;
    __device__ __forceinline__ void operator()(const f32x4 (&acc)[2][2][4][2], const Unit& u, int wr, int wc, int fr, int fq) const {
        const int row0 = u.pm * BM + wr * 64 + fr, colb = u.pn * BM + wc * 32 + 4 * fq;
        if (u.slab >= 0) {
#pragma unroll
            for (int ai = 0; ai < 2; ++ai)
#pragma unroll
                for (int m = 0; m < 4; ++m) { float* sp = slab + ((size_t)u.slab * tail_rows + (row0 + ai * HALF + m * 16 - tail_row0)) * 2048;
#pragma unroll
                    for (int bj = 0; bj < 2; ++bj)
#pragma unroll
                        for (int n = 0; n < 2; ++n) *(f32x4*)(sp + colb + bj * HALF + n * 16) = acc[ai][bj][m][n] * scale; }
            return;
        }
#pragma unroll
        for (int ai = 0; ai < 2; ++ai)
#pragma unroll
            for (int m = 0; m < 4; ++m) { bf16_t* xr = O + (size_t)(row0 + ai * HALF + m * 16) * 2048;
#pragma unroll
                for (int bj = 0; bj < 2; ++bj)
#pragma unroll
                    for (int n = 0; n < 2; ++n) { const f32x4 v = acc[ai][bj][m][n] * scale; u32x2 w; w.x = cvt_pk_bf16(v[0], v[1]); w.y = cvt_pk_bf16(v[2], v[3]); *(u32x2*)(xr + colb + bj * HALF + n * 16) = w; } }
    }
};
struct MoeOrder {
    int nM, nN, nwg, G, c, nkt; int t1[8]; size_t estride;
    __device__ __forceinline__ void init(const int* ctl, int nN_, int G_, int c_, size_t estride_, int K) { nkt = K / BK;
        int acc = 0;
#pragma unroll
        for (int e = 0; e < 8; ++e) { acc += __builtin_amdgcn_readfirstlane(ctl[CT_EPAD + e]) >> 8; t1[e] = acc; }
        nM = acc; nN = nN_; nwg = nM * nN; G = G_; c = c_; estride = estride_;
    }
    __device__ __forceinline__ bool next(int i, Unit& u) const {
        const long L = (long)i * G + c; if (L >= nwg) return false;
        int wgid = (int)L; { const int q = nwg / NXCD, r = nwg % NXCD, xcd = wgid % NXCD, off = wgid / NXCD; wgid = (xcd < r ? xcd * (q + 1) : r * (q + 1) + (xcd - r) * q) + off; }
        const int nig = WGM * nN, gid = wgid / nig, fm = gid * WGM, gsz = (nM - fm) < WGM ? (nM - fm) : WGM;
        u.pm = fm + ((wgid % nig) % gsz); u.pn = (wgid % nig) / gsz; u.kt0 = 0; u.nkt = nkt; u.slab = -1; return true;
    }
    __device__ __forceinline__ size_t bt_off(const Unit& u) const { int e = 0;
#pragma unroll
        for (int k = 0; k < 7; ++k) e += (u.pm >= t1[k]) ? 1 : 0;
        return (size_t)e * estride; }
    __device__ __forceinline__ void a_ready(const Unit&) const {}
    __device__ __forceinline__ void done(const Unit&) const {}
};
struct WinLastOrder {
    StaticOrder so; int G, c;
    __device__ __forceinline__ void init(int G_, int c_, int K) { so.init(NLAT, UW, G_, c_, K); G = G_; c = c_; }
    __device__ __forceinline__ bool next(int i, Unit& u) const {
        if (so.next(i, u)) return true;
        const long L = (long)i * G + c - so.nwg; if (L < 0 || L >= 20) return false;
        const int j = (int)L, k = j % 5; u.pm = 32 + j / 5; u.pn = k < 3 ? 3 + k : 10 + k; u.kt0 = 0; u.nkt = so.nkt; u.slab = -1; return true;
    }
    __device__ __forceinline__ size_t bt_off(const Unit&) const { return 0; }
    __device__ __forceinline__ void a_ready(const Unit&) const {}
    __device__ __forceinline__ void done(const Unit&) const {}
};
struct SplitOrder {
    int nM, nN, nwg, G, c, nfull, ntail, S, nkt, nkts; int t1[8]; size_t estride;
    __device__ __forceinline__ void init(int nM_, int nN_, int G_, int c_, int K, int S_) {
        nM = nM_; nN = nN_; nwg = nM * nN; G = G_; c = c_; nkt = K / BK; nfull = (nwg / 256) * 256; ntail = nwg - nfull; S = S_; nkts = nkt / S; estride = 0;
#pragma unroll
        for (int e = 0; e < 8; ++e) t1[e] = 0;
    }
    __device__ __forceinline__ void init_moe(const int* ctl, int nN_, int G_, int c_, int K, size_t estride_) {
        int acc = 0;
#pragma unroll
        for (int e = 0; e < 8; ++e) { acc += __builtin_amdgcn_readfirstlane(ctl[CT_EPAD + e]) >> 8; t1[e] = acc; }
        init(acc, nN_, G_, c_, K, __builtin_amdgcn_readfirstlane(ctl[CT_MOES])); estride = estride_;
        acc = 0;
#pragma unroll
        for (int e = 0; e < 8; ++e) { acc += __builtin_amdgcn_readfirstlane(ctl[CT_EPAD + e]) >> 8; t1[e] = acc; }
    }
    __device__ __forceinline__ bool next(int i, Unit& u) const {
        const long L = (long)i * G + c; int wgid;
        if (L < nfull) { wgid = (int)L; { const int q = nfull / NXCD, xcd = wgid % NXCD, off = wgid / NXCD; wgid = xcd * q + off; } u.kt0 = 0; u.nkt = nkt; u.slab = -1; }
        else { const int j = (int)(L - nfull); if (j >= ntail * S) return false; const int tu = j / S, sl = j - tu * S; wgid = nfull + tu; u.kt0 = sl * nkts; u.nkt = nkts; u.slab = (S > 1) ? sl : -1; }
        const int nig = WGM * nN, gid = wgid / nig, fm = gid * WGM, gsz = (nM - fm) < WGM ? (nM - fm) : WGM;
        u.pm = fm + ((wgid % nig) % gsz); u.pn = (wgid % nig) / gsz; return true;
    }
    __device__ __forceinline__ size_t bt_off(const Unit& u) const { if (estride == 0) return 0; int e = 0;
#pragma unroll
        for (int k = 0; k < 7; ++k) e += (u.pm >= t1[k]) ? 1 : 0;
        return (size_t)e * estride; }
    __device__ __forceinline__ void a_ready(const Unit&) const {}
    __device__ __forceinline__ void done(const Unit&) const {}
};
__host__ __device__ constexpr int split_S(int nwg, int nkt, int G) {
    const int ntail = nwg - (nwg / G) * G;
    if (ntail == 0) return 1;
    if (nkt % 28 == 0 && ntail * 14 <= G) return 14;
    if (nkt % 16 == 0 && ntail * 8 <= G) return 8;
    if (nkt % 14 == 0 && ntail * 7 <= G) return 7;
    if (nkt % 8 == 0 && ntail * 4 <= G) return 4;
    if (nkt % 4 == 0 && ntail * 2 <= G) return 2;
    return 1;
}
}

#define LAS __attribute__((address_space(3)))
#define XB_TMO      128
#define XB_XCNT(j)  (256  + 64 * (j))
#define XB_XSUB(j)  (1280 + 64 * (j))
#define XB_XGEN(j)  (2304 + 64 * (j))
#define XB_TOP      3328
#define XB_TOPGEN   3392
#define XCD_BAR_WORDS 3456
#define XB_SPIN_CAP (1u << 18)

__device__ __forceinline__ unsigned xb_ld(unsigned* p)              { return __hip_atomic_load(p, __ATOMIC_RELAXED, __HIP_MEMORY_SCOPE_AGENT); }
__device__ __forceinline__ unsigned xb_add(unsigned* p, unsigned v) { return __hip_atomic_fetch_add(p, v, __ATOMIC_RELAXED, __HIP_MEMORY_SCOPE_AGENT); }
__device__ __forceinline__ unsigned xb_xcc_id() { return (unsigned)__builtin_amdgcn_s_getreg((3 << 11) | 20) & 0xFu; }
#define XB_SPIN(cond, bar) do { unsigned _sp = 0; while (cond) { __builtin_amdgcn_s_sleep(1); \
    if ((++_sp & 255u) == 0u) { if (xb_ld(&(bar)[XB_TMO])) break; if (_sp > XB_SPIN_CAP) { atomicAdd(&(bar)[XB_TMO], 1u); break; } } } } while (0)

struct XcdBarrier {
    unsigned* bar; unsigned x;
    volatile LAS unsigned* st;
};

__device__ __forceinline__ XcdBarrier xcd_barrier_post(unsigned* bar, volatile LAS unsigned* st) {
    XcdBarrier b; b.bar = bar; b.x = xb_xcc_id(); b.st = st;
    if (threadIdx.x == 0) (void)xb_add(&bar[XB_XCNT(b.x)], 1u);
    return b;
}
__device__ __forceinline__ void xcd_barrier_complete(unsigned* bar, unsigned x, unsigned& nloc, unsigned& nx) {
    const unsigned G = gridDim.x * gridDim.y * gridDim.z;
    unsigned sum, cnt, mine, sp = 0u;
    for (;;) {
        sum = 0u; cnt = 0u; mine = 0u;
#pragma unroll
        for (unsigned j = 0; j < 16; ++j) { const unsigned c = xb_ld(&bar[XB_XCNT(j)]); sum += c; cnt += (c > 0u) ? 1u : 0u; mine = (j == x) ? c : mine; }
        if (sum == G) break;
        __builtin_amdgcn_s_sleep(1);
        if ((++sp & 255u) == 0u) { if (xb_ld(&bar[XB_TMO])) break; if (sp > XB_SPIN_CAP) { atomicAdd(&bar[XB_TMO], 1u); break; } }
    }
    nloc = mine > 0u ? mine : 1u; nx = cnt > 0u ? cnt : 1u;
}

__device__ __forceinline__ void xcd_barrier(const XcdBarrier& b) {
    asm volatile("s_waitcnt vmcnt(0)" ::: "memory");
    __syncthreads();
    if (threadIdx.x == 0) {
        unsigned* bar = b.bar;
        __builtin_amdgcn_s_waitcnt(0);
        unsigned nloc = b.st[0], nx = b.st[1];
        if (nloc == 0u) { xcd_barrier_complete(bar, b.x, nloc, nx); b.st[0] = nloc; b.st[1] = nx; }
        const unsigned old = xb_add(&bar[XB_XSUB(b.x)], 1u);
        const unsigned gen = old / nloc;
        if (old + 1u == (gen + 1u) * nloc) {
            __builtin_amdgcn_fence(__ATOMIC_RELEASE, "agent");
            asm volatile("s_waitcnt vmcnt(0)" ::: "memory");
            const unsigned og = xb_add(&bar[XB_TOP], 1u);
            const unsigned tg = og / nx;
            if (og + 1u == (tg + 1u) * nx) xb_add(&bar[XB_TOPGEN], 1u);
            else XB_SPIN(xb_ld(&bar[XB_TOPGEN]) == tg, bar);
            __builtin_amdgcn_fence(__ATOMIC_ACQUIRE, "agent");
            xb_add(&bar[XB_XGEN(b.x)], 1u);
            asm volatile("s_waitcnt vmcnt(0)" ::: "memory");
        } else {
            XB_SPIN(xb_ld(&bar[XB_XGEN(b.x)]) == gen, bar);
            __builtin_amdgcn_fence(__ATOMIC_ACQUIRE, "agent");
            asm volatile("s_waitcnt vmcnt(0)" ::: "memory");
        }
    }
    __syncthreads();
}


struct Args { const float* in[34]; float* out; unsigned char* ws; int ph_lo, ph_hi; };

enum { MAP_ID = 0, MAP_ROPEQ = 1, MAP_GU0 = 2, MAP_GU1 = 3, MAP_KV = 4 };
struct JobDesc { int in_idx, K, N, nbatch, upb, map; long long src_off, src_bstride, dst_off, dst_bstride; int fp8, pad; };
constexpr int NJOBS = 14, NCONV = 12664;
__constant__ JobDesc c_jobs[NJOBS] = {
    {8, 2048, 3648, 1, 232, MAP_ID, 0, 0, (long long)WS_WIN, 0},
    {8, 2048, 3648, 1, 232, MAP_ID, 2048LL * 3648, 0, (long long)(WS_WIN + (size_t)UW * D * 2), 0},
    {10, 768, 1536, 1, 36, MAP_ROPEQ, 0, 0, (long long)WS_WQ, 0},
    {10, 768, 1536, 1, 36, MAP_ROPEQ, 768LL * 1536, 0, (long long)(WS_WQ + (size_t)QW * 768 * 2), 0},
    {12, 512, 2048, 1, 32, MAP_KV, 0, 0, (long long)WS_WKV, 0},
    {12, 512, 2048, 1, 32, MAP_KV, 512LL * 2048, 0, (long long)(WS_WKV + (size_t)KVW * 512 * 2), 0},
    {25, 2048, 2048, 1, 128, MAP_ID, 0, 0, (long long)WS_WOUT, 0},
    {25, 2048, 2048, 1, 128, MAP_ID, 2048LL * 2048, 0, (long long)(WS_WOUT + (size_t)D * D * 2), 0},
    {26, 2048, 5632, 1, 352, MAP_GU0, 0, 0, (long long)WS_WGU, 0, FP8_DENSE, 0},
    {27, 2048, 5632, 1, 352, MAP_GU1, 0, 0, (long long)WS_WGU, 0, FP8_DENSE, 0},
    {28, 5632, 2048, 1, 352, MAP_ID, 0, 0, (long long)WS_WDN, 0, (FP8_DENSE || FP8_DOWN), 0},
    {30, 2048, 7168, 8, 448, MAP_GU0, 0, 2048LL * 7168, (long long)WS_MGU, 2LL * DFE * D, 1, 0},
    {31, 2048, 7168, 8, 448, MAP_GU1, 0, 2048LL * 7168, (long long)WS_MGU, 2LL * DFE * D, 1, 0},
    {32, 7168, 2048, 8, 448, MAP_ID, 0, 7168LL * 2048, (long long)WS_MDN, (long long)D * DFE, 1, 0},
};
struct ConvUnit { const float* src; bf16_t* dst; int K, N, map, k0, n0, fp8; };
constexpr float WSCALE = 64.f, ASCALE = 8.f;
__device__ __forceinline__ void conv_decode(const Args& a, int u, ConvUnit& cu) {
    int j = 0, base = 0;
    for (;;) { const int n = c_jobs[j].nbatch * c_jobs[j].upb; if (u < base + n || j == NJOBS - 1) break; base += n; ++j; }
    const JobDesc& jd = c_jobs[j];
    int r = u - base; const int bt = r / jd.upb; r -= bt * jd.upb; const int ntn = (jd.N + 127) >> 7; const int kt = r / ntn, nt = r - kt * ntn;
    cu.K = jd.K; cu.N = jd.N; cu.map = jd.map; cu.k0 = kt * 256; cu.n0 = nt * 128; cu.fp8 = jd.fp8;
    const float* sb = j < 2 ? a.in[8] : j < 4 ? a.in[10] : j < 6 ? a.in[12] : j < 8 ? a.in[25] : j == 8 ? a.in[26] : j == 9 ? a.in[27] : j == 10 ? a.in[28] : j == 11 ? a.in[30] : j == 12 ? a.in[31] : a.in[32];
    cu.src = sb + jd.src_off + (long long)bt * jd.src_bstride + (size_t)cu.k0 * jd.N + cu.n0;
    cu.dst = (bf16_t*)(a.ws + jd.dst_off + (long long)bt * jd.dst_bstride);
}
__device__ __forceinline__ int conv_row(int map, int n) {
    if (map == MAP_ID) return n;
    if (map == MAP_GU0) return ((n >> 7) << 8) + (n & 127);
    if (map == MAP_GU1) return ((n >> 7) << 8) + 128 + (n & 127);
    if (map == MAP_KV) { const int hh = n >> 8, jn = n & 255; return jn < 128 ? hh * 128 + jn : 1024 + hh * 128 + (jn - 128); }
    const int hh = n / 192, jn = n - hh * 192; if (jn < 128) return n; const int q = jn - 128; return hh * 192 + 128 + 2 * (q & 31) + (q >> 5);
}
constexpr int CV_P = 129;
#define CONV_LOAD(R, CU) do { const bool ok_ = (CU).n0 + (tid & 31) * 4 < (CU).N; _Pragma("unroll") for (int i_ = 0; i_ < 16; ++i_) { const int row_ = 2 * ((tid >> 5) + 16 * (i_ >> 1)) + (i_ & 1); \
        R[i_] = ok_ ? __builtin_nontemporal_load((const f32x4*)((CU).src + (size_t)row_ * (CU).N + (tid & 31) * 4)) : (f32x4){0.f, 0.f, 0.f, 0.f}; } } while (0)
#define CONV_PUT(R, T) do { _Pragma("unroll") for (int i_ = 0; i_ < 16; ++i_) { const int row_ = 2 * ((tid >> 5) + 16 * (i_ >> 1)) + (i_ & 1); float* tp_ = (T) + row_ * CV_P + (tid & 31) * 4; \
        tp_[0] = R[i_][0]; tp_[1] = R[i_][1]; tp_[2] = R[i_][2]; tp_[3] = R[i_][3]; } } while (0)
__device__ __forceinline__ void conv_out(const ConvUnit& cur, const float* tile, int tid) {
    if (cur.fp8) {
#pragma unroll
        for (int j = 0; j < 4; ++j) { const int kc = (tid & 7) + 8 * (j & 1), n = (tid >> 3) + 64 * (j >> 1);
            if (cur.n0 + n < cur.N) { const int row = conv_row(cur.map, cur.n0 + n); const float* tp = tile + (kc * 16) * CV_P + n; u32x4 w;
                w.x = pg8::pack4_fp8(tp[0] * WSCALE, tp[CV_P] * WSCALE, tp[2 * CV_P] * WSCALE, tp[3 * CV_P] * WSCALE); w.y = pg8::pack4_fp8(tp[4 * CV_P] * WSCALE, tp[5 * CV_P] * WSCALE, tp[6 * CV_P] * WSCALE, tp[7 * CV_P] * WSCALE);
                w.z = pg8::pack4_fp8(tp[8 * CV_P] * WSCALE, tp[9 * CV_P] * WSCALE, tp[10 * CV_P] * WSCALE, tp[11 * CV_P] * WSCALE); w.w = pg8::pack4_fp8(tp[12 * CV_P] * WSCALE, tp[13 * CV_P] * WSCALE, tp[14 * CV_P] * WSCALE, tp[15 * CV_P] * WSCALE);
                *(u32x4*)((unsigned char*)cur.dst + (size_t)row * cur.K + cur.k0 + kc * 16) = w; } }
    } else {
#pragma unroll
        for (int j = 0; j < 8; ++j) { const int kc = (tid & 7) + 8 * (j & 3), n = (tid >> 3) + 64 * (j >> 2);
            if (cur.n0 + n < cur.N) { const int row = conv_row(cur.map, cur.n0 + n); const float* tp = tile + (kc * 8) * CV_P + n; u32x4 w;
                w.x = pg8::cvt_pk_bf16(tp[0], tp[CV_P]); w.y = pg8::cvt_pk_bf16(tp[2 * CV_P], tp[3 * CV_P]); w.z = pg8::cvt_pk_bf16(tp[4 * CV_P], tp[5 * CV_P]); w.w = pg8::cvt_pk_bf16(tp[6 * CV_P], tp[7 * CV_P]);
                *(u32x4*)(cur.dst + (size_t)row * cur.K + cur.k0 + kc * 8) = w; } }
    }
}
template <int MODE = 0>
__device__ __forceinline__ void ph_convert(const Args& a, float* tile, int first, int stride, int end) {
    const int tid = threadIdx.x;
    int u = first; ConvUnit cuA, cuB; f32x4 rA[16], rB[16];
#pragma unroll
    for (int i = 0; i < 16; ++i) { rA[i] = (f32x4){0.f, 0.f, 0.f, 0.f}; rB[i] = rA[i]; }
    if (u < end) { conv_decode(a, u, cuA); if (MODE != 2) CONV_LOAD(rA, cuA); }
    if (u + stride < end) { conv_decode(a, u + stride, cuB); if (MODE != 2) CONV_LOAD(rB, cuB); }
    while (u < end) {
        CONV_PUT(rA, tile);
        __syncthreads();
        { const ConvUnit cur = cuA; const int un = u + 2 * stride; if (un < end) { conv_decode(a, un, cuA); if (MODE != 2) CONV_LOAD(rA, cuA); } if (MODE != 1) conv_out(cur, tile, tid); }
        __syncthreads();
        u += stride; if (u >= end) break;
        CONV_PUT(rB, tile);
        __syncthreads();
        { const ConvUnit cur = cuB; const int un = u + 2 * stride; if (un < end) { conv_decode(a, un, cuB); if (MODE != 2) CONV_LOAD(rB, cuB); } if (MODE != 1) conv_out(cur, tile, tid); }
        __syncthreads();
        u += stride;
    }
}
#undef CONV_LOAD
#undef CONV_PUT
constexpr int CONV_STATIC = 856, CONV_DENSE_END = 1912, CONV_BATCH = 2;
constexpr int CT_QNEXT = 1152;
__device__ __forceinline__ constexpr int CT_DONE(int k) { return 1216 + 64 * k; }
__device__ __forceinline__ void conv_fill(const Args& a, float* tile, int done_idx) {
#if !CONV_FILL
    (void)a; (void)tile; (void)done_idx; return;
#endif
    unsigned* ctl = (unsigned*)(a.ws + WS_CTL); volatile int* bc = (volatile int*)(tile + 256 * CV_P + 4);
    const int tid = threadIdx.x;
    if (tid == 0) (void)__hip_atomic_fetch_add(ctl + CT_DONE(done_idx), 1u, __ATOMIC_RELAXED, __HIP_MEMORY_SCOPE_AGENT);
    for (;;) {
        if (tid == 0) { int q = -1;
            if (__hip_atomic_load(ctl + CT_DONE(done_idx), __ATOMIC_RELAXED, __HIP_MEMORY_SCOPE_AGENT) < gridDim.x) {
                q = (int)__hip_atomic_fetch_add(ctl + CT_QNEXT, (unsigned)CONV_BATCH, __ATOMIC_RELAXED, __HIP_MEMORY_SCOPE_AGENT) + CONV_STATIC; if (q >= NCONV) q = -1; }
            *bc = q; }
        __syncthreads();
        const int q = *bc;
        __syncthreads();
        if (q < 0) break;
        ph_convert(a, tile, q, 1, (q + CONV_BATCH < NCONV) ? q + CONV_BATCH : NCONV);
    }
}
__device__ __forceinline__ void conv_finish(const Args& a, float* tile, int upto) {
#if !CONV_FILL
    (void)a; (void)tile; (void)upto; return;
#endif
    unsigned* ctl = (unsigned*)(a.ws + WS_CTL); volatile int* bc = (volatile int*)(tile + 256 * CV_P + 4);
    const int tid = threadIdx.x;
    for (;;) {
        if (tid == 0) { int q = -1;
            if ((int)__hip_atomic_load(ctl + CT_QNEXT, __ATOMIC_RELAXED, __HIP_MEMORY_SCOPE_AGENT) + CONV_STATIC < upto) {
                q = (int)__hip_atomic_fetch_add(ctl + CT_QNEXT, (unsigned)CONV_BATCH, __ATOMIC_RELAXED, __HIP_MEMORY_SCOPE_AGENT) + CONV_STATIC; if (q >= NCONV) q = -1; }
            *bc = q; }
        __syncthreads();
        const int q = *bc;
        __syncthreads();
        if (q < 0) break;
        ph_convert(a, tile, q, 1, (q + CONV_BATCH < NCONV) ? q + CONV_BATCH : NCONV);
    }
}
__device__ __forceinline__ void adaln_unit(const Args& a, int unit, float* sm) {
    const float* c = a.in[1]; const float* cctx = a.in[3]; const float* w_mod = a.in[4]; const float* b_mod = a.in[5]; float* mod = (float*)(a.ws + WS_MOD);
    const int tid = threadIdx.x, l = unit >> 7, chunk = unit & 127;
    const int cg = tid % 24, ks = tid / 24;
    for (int i = tid; i < 5 * 2048; i += 512) { const int v = i >> 11, k = i & 2047; const float val = v < 4 ? c[v * 2048 + k] : cctx[k]; sm[i] = val / (1.0f + __expf(-val)); }
    __syncthreads();
    float acc[5][4];
#pragma unroll
    for (int v = 0; v < 5; ++v)
#pragma unroll
        for (int j = 0; j < 4; ++j) acc[v][j] = 0.f;
    if (ks < 16) {
        const float* wp = w_mod + ((size_t)l * 2048 + (size_t)ks * 128) * 12288 + chunk * 96 + cg * 4;
#pragma unroll 8
        for (int kk = 0; kk < 128; ++kk) {
            const f32x4 w = __builtin_nontemporal_load((const f32x4*)(wp + (size_t)kk * 12288));
            const int k = ks * 128 + kk;
#pragma unroll
            for (int v = 0; v < 5; ++v) { const float s = sm[v * 2048 + k];
#pragma unroll
                for (int j = 0; j < 4; ++j) acc[v][j] += s * w[j]; }
        }
    }
    __syncthreads();
    if (ks < 16) {
#pragma unroll
        for (int v = 0; v < 5; ++v)
#pragma unroll
            for (int j = 0; j < 4; ++j) sm[(ks * 5 + v) * 96 + cg * 4 + j] = acc[v][j];
    }
    __syncthreads();
    if (tid < 480) {
        const int v = tid / 96, cc = tid - v * 96; float s = 0.f;
#pragma unroll
        for (int k2 = 0; k2 < 16; ++k2) s += sm[(k2 * 5 + v) * 96 + cc];
        mod[((size_t)l * 5 + v) * 12288 + chunk * 96 + cc] = s + b_mod[(size_t)l * 12288 + chunk * 96 + cc];
    }
    __syncthreads();
}
constexpr int FW_W1 = 0, FW_W2 = 2112, FW_W3 = 6208, FW_B1 = 10304, FW_B2 = 10368, FW_B3 = 10432, FW_FR = 10496, FW_ZS = 10560, FW_HA = 10848, FW_HB = 11360, FW_END = 11872;
__device__ __forceinline__ void filters_unit(const Args& a, int l, int r, float* sm) {
    float (*zs)[36] = (float (*)[36])(sm + FW_ZS); float (*ha)[64] = (float (*)[64])(sm + FW_HA); float (*hb)[64] = (float (*)[64])(sm + FW_HB);
    const int tid = threadIdx.x;
    const bool lat = r < 256; const int Lf = lat ? 2048 : 256; const int p0 = lat ? r * 8 : (r - 256) * 8;
    float* T = (float*)(a.ws + WS_FILTC) + (size_t)l * 512 * 512;
    const float* wf = a.in[21] + (size_t)l * 64 * 1024;
    const int p = tid >> 6, j = tid & 63; const int pos = p0 + p;
    const float tn = (float)pos / (float)(Lf - 1);
    if (j < 33) {
        float z;
        if (j == 0) z = tn;
        else { const int bi = (j - 1) & 15; const float band = 1e-4f + (float)bi * ((15.0f - 1e-4f) / 15.0f);
               const float ang = (6.283185307179586f / (float)Lf) * (float)pos * band; z = (j <= 16) ? __cosf(ang) : -__sinf(ang); }
        zs[p][j] = z;
    }
    __syncthreads();
    const float f = sm[FW_FR + j];
    { float s = sm[FW_B1 + j];
#pragma unroll
      for (int i = 0; i < 33; ++i) s += zs[p][i] * sm[FW_W1 + i * 64 + j];
      ha[p][j] = __sinf(f * s); }
    __syncthreads();
    { float s = sm[FW_B2 + j];
#pragma unroll 16
      for (int i = 0; i < 64; ++i) s += ha[p][i] * sm[FW_W2 + i * 64 + j];
      hb[p][j] = __sinf(f * s); }
    __syncthreads();
    { float s = sm[FW_B3 + j];
#pragma unroll 16
      for (int i = 0; i < 64; ++i) s += hb[p][i] * sm[FW_W3 + i * 64 + j];
      ha[p][j] = __sinf(f * s); }
    __syncthreads();
    float acc[2][8];
#pragma unroll
    for (int rr = 0; rr < 2; ++rr)
#pragma unroll
        for (int q = 0; q < 8; ++q) acc[rr][q] = 0.f;
#pragma unroll 8
    for (int i = 0; i < 64; ++i) { const float w0 = wf[i * 1024 + tid], w1 = wf[i * 1024 + 512 + tid];
#pragma unroll
        for (int q = 0; q < 8; ++q) { const float h = ha[q][i]; acc[0][q] += h * w0; acc[1][q] += h * w1; } }
    const int ch = tid;
    const float delta = 3.0701134573253944f + (float)ch * ((15.350567286626972f - 3.0701134573253944f) / 511.0f);
#pragma unroll
    for (int q = 0; q < 8; ++q) {
        const int ps = p0 + q; const float dec = __expf(-((float)ps / (float)(Lf - 1)) * delta);
        const float vf = acc[0][q] * dec, vb = acc[1][q] * dec;
        if (lat) { bf16_t* RBp = (bf16_t*)(a.ws + WS_FILTL) + ((size_t)l * 512 + ch) * HY_RBROW; RBp[2048 - ps] = f2bf(vf); if (ps > 0) RBp[2048 + ps] = f2bf(vb); }
        else { T[(size_t)ch * (2 * Lf) + Lf + ps] = vf; if (ps > 0) T[(size_t)ch * (2 * Lf) + Lf - ps] = vb; else T[(size_t)ch * (2 * Lf)] = 0.f; }
    }
    __syncthreads();
}
__device__ __forceinline__ void ph_filters(const Args& a, float* sm) {
    const int tid = threadIdx.x;
    for (int l = 0; l < 2; ++l) {
        for (int i = tid; i < 2112; i += NTHR) sm[FW_W1 + i] = a.in[15][l * 2112 + i];
        for (int i = tid; i < 4096; i += NTHR) { sm[FW_W2 + i] = a.in[17][l * 4096 + i]; sm[FW_W3 + i] = a.in[19][l * 4096 + i]; }
        if (tid < 64) { sm[FW_B1 + tid] = a.in[16][l * 64 + tid]; sm[FW_B2 + tid] = a.in[18][l * 64 + tid]; sm[FW_B3 + tid] = a.in[20][l * 64 + tid]; sm[FW_FR + tid] = a.in[22][l * 64 + tid]; }
        __syncthreads();
        for (int r = blockIdx.x; r < 288; r += gridDim.x) filters_unit(a, l, r, sm);
        __syncthreads();
    }
}
#define SUBREP(b) for (int srep_ = 0; srep_ <= (int)((PROBE_SUB >> (b)) & 1u); ++srep_)
__device__ __forceinline__ void ph_prologue(const Args& a, float* sm) {
    const int bid = blockIdx.x, G = gridDim.x, tid = threadIdx.x;
    SUBREP(4) for (int u = bid; u < 256; u += G) adaln_unit(a, u, sm);
    SUBREP(5) ph_filters(a, sm);
    { float* cosT = (float*)(a.ws + WS_ROPE); float* sinT = cosT + 2048 * 32;
      for (int i = bid * 512 + tid; i < 2048 * 32; i += G * 512) { const int t = i >> 5, f = i & 31;
          const float pos = (float)((f < 16) ? (t >> 6) : (t & 63)); const float freq = powf(10000.0f, -(float)(f & 15) / 16.0f); const float ang = pos * freq;
          cosT[i] = cosf(ang); sinT[i] = sinf(ang); } }
    for (int i = bid * 512 + tid; i < 2 * 512 * 17; i += G * 512) { const int row = i / 17, k = i - row * 17; ((bf16_t*)(a.ws + WS_FILTL))[(size_t)row * HY_RBROW + (k == 0 ? 0 : 4095 + k)] = 0; }
    for (int i = bid * 512 + tid; i < 2 * 192 * 256; i += G * 512) { const int l = i / (192 * 256), r = i % (192 * 256);
        *(u32x4*)(a.ws + WS_WIN + (size_t)l * UW * D * 2 + (size_t)INW * D * 2 + (size_t)r * 16) = (u32x4){0u, 0u, 0u, 0u}; }
    if ((PROBE_SUB >> 8) & 1u) ph_convert<2>(a, sm, bid, G, NCONV);
    ph_convert(a, sm, bid, G, CONV_FILL ? CONV_STATIC : NCONV);
    if ((PROBE_SUB >> 6) & 1u) ph_convert<0>(a, sm, bid, G, NCONV);
    if ((PROBE_SUB >> 7) & 1u) ph_convert<1>(a, sm, bid, G, NCONV);
}

template <bool ROUTER, bool COPYX, bool OUT8 = false, int NSLAB = 0>
__device__ __forceinline__ void ph_normmod(const float* __restrict__ xlat, const float* __restrict__ xctx, const float* __restrict__ gain, const float* __restrict__ modl, int sh_off, int sc_off,
                                           bf16_t* __restrict__ out, int nrows, float* __restrict__ xs, const float* __restrict__ router, int* __restrict__ topi, float* __restrict__ topw,
                                           const float* __restrict__ slab = nullptr, const float* __restrict__ slab_gate = nullptr) {
    const int lane = threadIdx.x & 63, wid = threadIdx.x >> 6;
    for (int row = blockIdx.x * 8 + wid; row < nrows; row += gridDim.x * 8) {
        const float* xr = row < NLAT ? xlat + (size_t)row * D : xctx + (size_t)(row - NLAT) * D;
        const float* mv = modl + (size_t)tok_mod(row) * 12288;
        f32x4 v[8]; float ss = 0.f;
#pragma unroll
        for (int i = 0; i < 8; ++i) { v[i] = *(const f32x4*)(xr + i * 256 + lane * 4);
            if (NSLAB > 0 && row >= NLAT) { f32x4 sa = *(const f32x4*)(slab + (size_t)(row - NLAT) * D + i * 256 + lane * 4);
#pragma unroll
                for (int sl = 1; sl < NSLAB; ++sl) sa += *(const f32x4*)(slab + ((size_t)sl * NCTX + (row - NLAT)) * D + i * 256 + lane * 4);
                v[i] += *(const f32x4*)(slab_gate + i * 256 + lane * 4) * sa; }
            ss += v[i][0] * v[i][0] + v[i][1] * v[i][1] + v[i][2] * v[i][2] + v[i][3] * v[i][3];
            if (COPYX && (NSLAB == 0 || row >= NLAT)) *(f32x4*)(xs + (size_t)row * D + i * 256 + lane * 4) = v[i]; }
        ss = wave_sum(ss);
        const float rstd = rsqrtf(ss * (1.0f / D) + EPS);
        float lg[8];
#pragma unroll
        for (int e = 0; e < 8; ++e) lg[e] = 0.f;
#pragma unroll
        for (int i = 0; i < 8; ++i) {
            const int col = i * 256 + lane * 4;
            const f32x4 g = *(const f32x4*)(gain + col), sc = *(const f32x4*)(mv + sc_off + col), sh = *(const f32x4*)(mv + sh_off + col);
            f32x4 o;
#pragma unroll
            for (int j = 0; j < 4; ++j) o[j] = (v[i][j] * rstd * g[j]) * (1.0f + sc[j]) + sh[j];
            if (OUT8) *(unsigned*)((unsigned char*)out + (size_t)row * D + col) = pg8::pack4_fp8(o[0] * ASCALE, o[1] * ASCALE, o[2] * ASCALE, o[3] * ASCALE);
            else { u32x2 w; w.x = (unsigned)f2bf(o[0]) | ((unsigned)f2bf(o[1]) << 16); w.y = (unsigned)f2bf(o[2]) | ((unsigned)f2bf(o[3]) << 16);
                *(u32x2*)(out + (size_t)row * D + col) = w; }
            if (ROUTER) {
#pragma unroll
                for (int j = 0; j < 4; ++j) { const f32x4 r0 = *(const f32x4*)(router + (size_t)(col + j) * 8), r1 = *(const f32x4*)(router + (size_t)(col + j) * 8 + 4);
                    lg[0] += o[j] * r0[0]; lg[1] += o[j] * r0[1]; lg[2] += o[j] * r0[2]; lg[3] += o[j] * r0[3];
                    lg[4] += o[j] * r1[0]; lg[5] += o[j] * r1[1]; lg[6] += o[j] * r1[2]; lg[7] += o[j] * r1[3]; }
                asm volatile("" ::: "memory");
            }
        }
        if (ROUTER) {
#pragma unroll
            for (int e = 0; e < 8; ++e) lg[e] = wave_sum(lg[e]);
            if (lane == 0) {
                int i0 = 0; float v0 = lg[0];
#pragma unroll
                for (int e = 1; e < 8; ++e) if (lg[e] > v0) { v0 = lg[e]; i0 = e; }
                int i1 = -1; float v1 = -3.0e38f;
#pragma unroll
                for (int e = 0; e < 8; ++e) if (e != i0 && lg[e] > v1) { v1 = lg[e]; i1 = e; }
                const float e1 = expf(v1 - v0), w0 = 1.0f / (1.0f + e1), w1 = e1 / (1.0f + e1);
                topi[row * 2] = i0; topi[row * 2 + 1] = i1; topw[row * 2] = w0; topw[row * 2 + 1] = w1;
            }
        }
    }
}

__device__ __forceinline__ void ph_mid(const Args& a, int l) {
    const bf16_t* __restrict__ U = (const bf16_t*)(a.ws + WS_U);
    const float* g_q = a.in[9] + l * 768; const float* g_kv = a.in[11] + l * 512; const float* conv_w = a.in[13] + (size_t)l * 3 * 1536; const float* conv_b = a.in[14] + l * 1536;
    const float* cosT = (const float*)(a.ws + WS_ROPE); const float* sinT = cosT + 2048 * 32;
    bf16_t* cqn = (bf16_t*)(a.ws + WS_CQN); bf16_t* ckvn = (bf16_t*)(a.ws + WS_CKVN); bf16_t* kpe = (bf16_t*)(a.ws + WS_KPE); bf16_t* x0o = (bf16_t*)(a.ws + WS_X0);
    bf16_t* wtl = (bf16_t*)(a.ws + WS_WTL); bf16_t* wtc = (bf16_t*)(a.ws + WS_WTC); bf16_t* sq = (bf16_t*)(a.ws + WS_SQ); bf16_t* sk = (bf16_t*)(a.ws + WS_SK); bf16_t* sv = (bf16_t*)(a.ws + WS_SV);
    const int tid = threadIdx.x, lane = tid & 63, wid = tid >> 6;
    for (int unit = blockIdx.x; unit < NTOK / 16; unit += gridDim.x) {
        const int tok0 = unit * 16;
        for (int tt = 0; tt < 2; ++tt) {
            const int tok = tok0 + wid * 2 + tt; const bool lat = tok < NLAT; const int t = lat ? (tok & 2047) : ((tok - NLAT) & 255);
            const bf16_t* u = U + (size_t)tok * UW;
            { float x[12]; float ss = 0.f;
#pragma unroll
              for (int i = 0; i < 12; ++i) { x[i] = bf2f(u[O_CQ + i * 64 + lane]); ss += x[i] * x[i]; }
              ss = wave_sum(ss); const float rs = rsqrtf(ss * (1.0f / 768.0f) + EPS);
#pragma unroll
              for (int i = 0; i < 12; ++i) cqn[(size_t)tok * 768 + i * 64 + lane] = f2bf(x[i] * rs * g_q[i * 64 + lane]); }
            { float x[8]; float ss = 0.f;
#pragma unroll
              for (int i = 0; i < 8; ++i) { x[i] = bf2f(u[O_CKV + i * 64 + lane]); ss += x[i] * x[i]; }
              ss = wave_sum(ss); const float rs = rsqrtf(ss * (1.0f / 512.0f) + EPS);
#pragma unroll
              for (int i = 0; i < 8; ++i) ckvn[(size_t)tok * 512 + i * 64 + lane] = f2bf(x[i] * rs * g_kv[i * 64 + lane]); }
            const int pi = lane & 31;
            const float cs = lat ? cosT[t * 32 + pi] : 1.0f, sn = lat ? sinT[t * 32 + pi] : 0.0f;
            if (lane < 32) {
                const float aa = bf2f(u[O_KPE + pi]), bb = bf2f(u[O_KPE + 32 + pi]);
                kpe[(size_t)tok * 64 + 2 * pi] = f2bf(aa * cs - bb * sn); kpe[(size_t)tok * 64 + 2 * pi + 1] = f2bf(aa * sn + bb * cs);
            }
#pragma unroll
            for (int r = 0; r < 4; ++r) { const int pr = r * 64 + lane, h = pr >> 5;
                const float aa = bf2f(u[O_SQ + h * 64 + pi]), bb = bf2f(u[O_SQ + h * 64 + 32 + pi]);
                sq[(size_t)tok * 512 + h * 64 + pi] = f2bf(aa * cs - bb * sn); sq[(size_t)tok * 512 + h * 64 + 32 + pi] = f2bf(aa * sn + bb * cs); }
            { const int h = lane >> 5;
              const float aa = bf2f(u[O_SK + h * 64 + pi]), bb = bf2f(u[O_SK + h * 64 + 32 + pi]);
              sk[(size_t)tok * 128 + h * 64 + pi] = f2bf(aa * cs - bb * sn); sk[(size_t)tok * 128 + h * 64 + 32 + pi] = f2bf(aa * sn + bb * cs); }
        }
        {
            const bool lat = tok0 < NLAT; const int Ls = lat ? L : C;
            const int b = lat ? (tok0 >> 11) : ((tok0 - NLAT) >> 8), t0 = lat ? (tok0 & 2047) : ((tok0 - NLAT) & 255);
            const int ch = tid;
            float cw[3][3], cb[3];
#pragma unroll
            for (int g = 0; g < 3; ++g) { cb[g] = conv_b[g * 512 + ch];
#pragma unroll
                for (int j = 0; j < 3; ++j) cw[g][j] = conv_w[j * 1536 + g * 512 + ch]; }
            float prev[3], cur[3], nxt[3];
#pragma unroll
            for (int g = 0; g < 3; ++g) { prev[g] = (t0 > 0) ? bf2f(U[(size_t)(tok0 - 1) * UW + O_HY + g * 512 + ch]) : 0.f; cur[g] = bf2f(U[(size_t)tok0 * UW + O_HY + g * 512 + ch]); }
            unsigned pk[8];
#pragma unroll
            for (int i = 0; i < 16; ++i) {
                const bool hasn = (t0 + i + 1) < Ls;
                float y[3];
#pragma unroll
                for (int g = 0; g < 3; ++g) { nxt[g] = hasn ? bf2f(U[(size_t)(tok0 + i + 1) * UW + O_HY + g * 512 + ch]) : 0.f;
                    y[g] = cb[g] + cw[g][0] * prev[g] + cw[g][1] * cur[g] + cw[g][2] * nxt[g]; prev[g] = cur[g]; cur[g] = nxt[g]; }
                x0o[(size_t)(tok0 + i) * 512 + ch] = f2bf(y[0]);
                const unsigned wv = f2bf(y[2] * y[1]);
                if (i & 1) pk[i >> 1] |= wv << 16; else pk[i >> 1] = wv;
            }
            bf16_t* wt = lat ? wtl + ((size_t)b * 512 + ch) * L + t0 : wtc + ((size_t)b * 512 + ch) * C + t0;
            u32x4 w0, w1; w0.x = pk[0]; w0.y = pk[1]; w0.z = pk[2]; w0.w = pk[3]; w1.x = pk[4]; w1.y = pk[5]; w1.z = pk[6]; w1.w = pk[7];
            *(u32x4*)wt = w0; *(u32x4*)(wt + 8) = w1;
        }
        if (tid < 128) {
            unsigned pk[8];
#pragma unroll
            for (int i = 0; i < 16; ++i) { const unsigned v = U[(size_t)(tok0 + i) * UW + O_SV + tid]; if (i & 1) pk[i >> 1] |= v << 16; else pk[i >> 1] = v; }
            bf16_t* dst = sv + (size_t)tid * NTOK + tok0;
            u32x4 w0, w1; w0.x = pk[0]; w0.y = pk[1]; w0.z = pk[2]; w0.w = pk[3]; w1.x = pk[4]; w1.y = pk[5]; w1.z = pk[6]; w1.w = pk[7];
            *(u32x4*)dst = w0; *(u32x4*)(dst + 8) = w1;
        }
    }
}

__device__ __forceinline__ void ph_mla_naive(const Args& a, int nq, float* sm) {
    const bf16_t* __restrict__ Q = (const bf16_t*)(a.ws + WS_Q); const bf16_t* __restrict__ KV = (const bf16_t*)(a.ws + WS_KV); const bf16_t* __restrict__ KPE = (const bf16_t*)(a.ws + WS_KPE);
    bf16_t* mix = (bf16_t*)(a.ws + WS_MIX);
    const int lane = threadIdx.x & 63, w = threadIdx.x >> 6;
    float* qf = sm + w * 192; float* sc = sm + 8 * 192 + w * 2304;
    for (int unit = blockIdx.x; unit < nq; unit += gridDim.x) {
        const int h = unit & 7, qt = (unit >> 3) * 8 + w; const bool lat = qt < NLAT;
        const int b = lat ? (qt >> 11) : ((qt - NLAT) >> 8);
        const int nk = lat ? (L + C) : C;
        for (int i = lane; i < 192; i += 64) qf[i] = bf2f(Q[(size_t)qt * QW + h * 192 + i]);
        __syncthreads();
        const float scale = 0.07216878364870322f;
        float mx = -3.0e38f;
        for (int kc = 0; kc < nk; kc += 64) {
            const int kk = kc + lane;
            const int kt = lat ? (kk < L ? b * L + kk : NLAT + b * C + (kk - L)) : (NLAT + b * C + kk);
            float s = 0.f;
            const u32x4* kp = (const u32x4*)(KV + (size_t)kt * KVW + h * 256);
            for (int i = 0; i < 16; ++i) { const u32x4 v = kp[i]; const float* q8 = qf + i * 8;
                s += q8[0] * __uint_as_float(v.x << 16) + q8[1] * __uint_as_float(v.x & 0xffff0000u) + q8[2] * __uint_as_float(v.y << 16) + q8[3] * __uint_as_float(v.y & 0xffff0000u)
                   + q8[4] * __uint_as_float(v.z << 16) + q8[5] * __uint_as_float(v.z & 0xffff0000u) + q8[6] * __uint_as_float(v.w << 16) + q8[7] * __uint_as_float(v.w & 0xffff0000u); }
            const u32x4* pp = (const u32x4*)(KPE + (size_t)kt * 64);
            for (int i = 0; i < 8; ++i) { const u32x4 v = pp[i]; const float* q8 = qf + 128 + i * 8;
                s += q8[0] * __uint_as_float(v.x << 16) + q8[1] * __uint_as_float(v.x & 0xffff0000u) + q8[2] * __uint_as_float(v.y << 16) + q8[3] * __uint_as_float(v.y & 0xffff0000u)
                   + q8[4] * __uint_as_float(v.z << 16) + q8[5] * __uint_as_float(v.z & 0xffff0000u) + q8[6] * __uint_as_float(v.w << 16) + q8[7] * __uint_as_float(v.w & 0xffff0000u); }
            s *= scale; sc[kk] = s; mx = fmaxf(mx, s);
        }
        mx = wave_max(mx);
        float sum = 0.f;
        for (int kc = 0; kc < nk; kc += 64) { const float p = expf(sc[kc + lane] - mx); sc[kc + lane] = p; sum += p; }
        sum = wave_sum(sum);
        __syncthreads();
        float o0 = 0.f, o1 = 0.f;
        for (int kk = 0; kk < nk; ++kk) {
            const int kt = lat ? (kk < L ? b * L + kk : NLAT + b * C + (kk - L)) : (NLAT + b * C + kk);
            const unsigned v = *(const unsigned*)(KV + (size_t)kt * KVW + h * 256 + 128 + lane * 2);
            const float p = sc[kk];
            o0 += p * __uint_as_float(v << 16); o1 += p * __uint_as_float(v & 0xffff0000u);
        }
        const float inv = 1.0f / sum;
        *(unsigned*)(mix + (size_t)qt * D + h * 128 + lane * 2) = (unsigned)f2bf(o0 * inv) | ((unsigned)f2bf(o1 * inv) << 16);
        __syncthreads();
    }
}
__device__ __forceinline__ void ph_swa_naive(const Args& a, int l, int nq, float* sm) {
    const bf16_t* __restrict__ SQ = (const bf16_t*)(a.ws + WS_SQ); const bf16_t* __restrict__ SK = (const bf16_t*)(a.ws + WS_SK); const bf16_t* __restrict__ SV = (const bf16_t*)(a.ws + WS_SV);
    const float* sink = a.in[24] + l * 8; bf16_t* mix = (bf16_t*)(a.ws + WS_MIX);
    const int lane = threadIdx.x & 63, w = threadIdx.x >> 6;
    float* qf = sm + w * 64; float* sc = sm + 8 * 64 + w * 576; int* kts = (int*)(sm + 8 * 64 + 8 * 576) + w * 576;
    for (int unit = blockIdx.x; unit < nq; unit += gridDim.x) {
        const int hq = unit & 7, hk = hq >> 2, qt = (unit >> 3) * 8 + w; const bool lat = qt < NLAT;
        const int b = lat ? (qt >> 11) : ((qt - NLAT) >> 8), t = lat ? (qt & 2047) : 0;
        int lo = 0, nloc = 0;
        if (lat) { lo = t - 128 < 0 ? 0 : t - 128; const int hi = t + 128 > L - 1 ? L - 1 : t + 128; nloc = hi - lo + 1; }
        const int nk = nloc + C;
        qf[lane] = bf2f(SQ[(size_t)qt * 512 + hq * 64 + lane]);
        __syncthreads();
        const float skv = sink[hq];
        float mx = skv;
        for (int kc = 0; kc < nk; kc += 64) {
            const int kk = kc + lane;
            if (kk < nk) {
                const int kt = kk < nloc ? (b * L + lo + kk) : (NLAT + b * C + (kk - nloc));
                const u32x4* kp = (const u32x4*)(SK + (size_t)kt * 128 + hk * 64);
                float s = 0.f;
                for (int i = 0; i < 8; ++i) { const u32x4 v = kp[i]; const float* q8 = qf + i * 8;
                    s += q8[0] * __uint_as_float(v.x << 16) + q8[1] * __uint_as_float(v.x & 0xffff0000u) + q8[2] * __uint_as_float(v.y << 16) + q8[3] * __uint_as_float(v.y & 0xffff0000u)
                       + q8[4] * __uint_as_float(v.z << 16) + q8[5] * __uint_as_float(v.z & 0xffff0000u) + q8[6] * __uint_as_float(v.w << 16) + q8[7] * __uint_as_float(v.w & 0xffff0000u); }
                s *= 0.125f; sc[kk] = s; kts[kk] = kt; mx = fmaxf(mx, s);
            }
        }
        mx = wave_max(mx);
        float sum = 0.f;
        for (int kc = 0; kc < nk; kc += 64) { const int kk = kc + lane; if (kk < nk) { const float p = expf(sc[kk] - mx); sc[kk] = p; sum += p; } }
        sum = wave_sum(sum) + expf(skv - mx);
        __syncthreads();
        float o = 0.f;
        for (int kk = 0; kk < nk; ++kk) o += sc[kk] * bf2f(SV[(size_t)kts[kk] * 128 + hk * 64 + lane]);
        mix[(size_t)qt * D + 1536 + hq * 64 + lane] = f2bf(o / sum);
        __syncthreads();
    }
}
template <int LS>
__device__ __forceinline__ void ph_hyena_naive(const Args& a, int l, float* sm) {
    const float* filt = LS == L ? (const float*)(a.ws + WS_FILTL) + (size_t)l * 512 * 4096 : (const float*)(a.ws + WS_FILTC) + (size_t)l * 512 * 512;
    const bf16_t* wt = (const bf16_t*)(a.ws + (LS == L ? WS_WTL : WS_WTC)); const bf16_t* x0 = (const bf16_t*)(a.ws + WS_X0); const float* skip = a.in[23] + l * 512;
    bf16_t* mix = (bf16_t*)(a.ws + WS_MIX); const int tok_base = LS == L ? 0 : NLAT;
    float* T = sm; float* ws = sm + 2 * LS; const int tid = threadIdx.x;
    for (int unit = blockIdx.x; unit < 512 * NB; unit += gridDim.x) {
        const int ch = unit >> 2, b = unit & 3;
        for (int i = tid; i < 2 * LS; i += NTHR) T[i] = filt[(size_t)ch * 2 * LS + i];
        for (int i = tid; i < LS; i += NTHR) ws[i] = bf2f(wt[((size_t)b * 512 + ch) * LS + i]);
        __syncthreads();
        const float sk = skip[ch];
        for (int t = tid; t < LS; t += NTHR) {
            float y = 0.f;
            for (int s = 0; s < LS; ++s) y += T[t - s + LS] * ws[s];
            const int tok = tok_base + b * LS + t;
            mix[(size_t)tok * D + 1024 + ch] = f2bf(bf2f(x0[(size_t)tok * 512 + ch]) * (y + sk * ws[t]));
        }
        __syncthreads();
    }
}
__device__ __forceinline__ void ph_route_gather(const Args& a, int* sm) {
    const int* __restrict__ topi = (const int*)(a.ws + WS_TOPI); int* __restrict__ pos = (int*)(a.ws + WS_POS); int* ctl = (int*)(a.ws + WS_CTL);
    const unsigned char* __restrict__ hb = (const unsigned char*)(a.ws + WS_HA); unsigned char* __restrict__ hbs = (unsigned char*)(a.ws + WS_HBS);
    int (*cnt)[512] = (int (*)[512])sm; int* tot = sm + 8 * 512; int* ppos = sm + 8 * 512 + 16;
    const int tid = threadIdx.x, lane = tid & 63, w = tid >> 6;
    int c[8];
#pragma unroll
    for (int e = 0; e < 8; ++e) c[e] = 0;
    for (int i = 0; i < 32; i += 4) { const u32x4 e4 = *(const u32x4*)(topi + tid * 32 + i);
#pragma unroll
        for (int q = 0; q < 8; ++q) c[q] += (e4.x == (unsigned)q) + (e4.y == (unsigned)q) + (e4.z == (unsigned)q) + (e4.w == (unsigned)q); }
#pragma unroll
    for (int e = 0; e < 8; ++e) cnt[e][tid] = c[e];
    __syncthreads();
    {
        int v[8]; int s8 = 0;
#pragma unroll
        for (int k = 0; k < 8; ++k) { v[k] = cnt[w][lane * 8 + k]; s8 += v[k]; }
        int incl = s8;
#pragma unroll
        for (int off = 1; off < 64; off <<= 1) { const int t = __shfl_up(incl, off); if (lane >= off) incl += t; }
        int run = incl - s8;
#pragma unroll
        for (int k = 0; k < 8; ++k) { cnt[w][lane * 8 + k] = run; run += v[k]; }
        if (lane == 63) tot[w] = incl;
    }
    __syncthreads();
    int eoff[8]; int o = 0;
#pragma unroll
    for (int e = 0; e < 8; ++e) { eoff[e] = o; o += (tot[e] + 255) & ~255; }
    if (blockIdx.x == 0 && tid == 0) {
#pragma unroll
        for (int e = 0; e < 8; ++e) { ctl[CT_EOFF + e] = eoff[e]; ctl[CT_EPAD + e] = (tot[e] + 255) & ~255; }
        ctl[CT_NTILE] = o >> 8; const int nwg = (o >> 8) * (D / 256); ctl[CT_MOES] = pg8::split_S(nwg, DFE / 128, 256); ctl[CT_TROW] = (nwg / 256) * 256 / (D / 256) * 256;
    }
    for (int tg = blockIdx.x; tg < NLAT / 32; tg += gridDim.x) {
        if (tid < 64) {
            const int idx = 64 * tg + tid, owner = idx >> 5, e = topi[idx]; int p = 0;
#pragma unroll
            for (int q = 0; q < 8; ++q) { const unsigned long long mk = __ballot(e == q);
                if (e == q) { const unsigned hm = (unsigned)(mk >> (32 * (tid >> 5))); p = eoff[q] + cnt[q][owner] + __popc(hm & ((1u << (tid & 31)) - 1u)); } }
            pos[idx] = p; ppos[tid] = p;
        }
        __syncthreads();
#pragma unroll
        for (int k = 0; k < 4; ++k) { const int tl = 4 * w + k; const int tok = 32 * tg + tl;
            const u32x4 v0 = *(const u32x4*)(hb + (size_t)tok * D + lane * 32), v1 = *(const u32x4*)(hb + (size_t)tok * D + lane * 32 + 16);
            const int p0 = ppos[2 * tl], p1 = ppos[2 * tl + 1];
            *(u32x4*)(hbs + (size_t)p0 * D + lane * 32) = v0; *(u32x4*)(hbs + (size_t)p0 * D + lane * 32 + 16) = v1;
            *(u32x4*)(hbs + (size_t)p1 * D + lane * 32) = v0; *(u32x4*)(hbs + (size_t)p1 * D + lane * 32 + 16) = v1; }
        __syncthreads();
    }
}
__device__ __forceinline__ void ph_final(const Args& a) {
    const float* xs = (const float*)(a.ws + WS_XS); const bf16_t* ys = (const bf16_t*)(a.ws + WS_YS); const int* pos = (const int*)(a.ws + WS_POS); const float* topw = (const float*)(a.ws + WS_TOPW);
    const float* modl = (const float*)(a.ws + WS_MOD) + (size_t)5 * 12288; const float* gfin = a.in[33]; float* out = a.out;
    const int lane = threadIdx.x & 63, wid = threadIdx.x >> 6;
    const int* ctl = (const int*)(a.ws + WS_CTL); const int nsl = ctl[CT_MOES], trow0 = ctl[CT_TROW], trows = ctl[CT_NTILE] * 256 - trow0; const float* slab = (const float*)(a.ws + WS_SLAB);
    for (int row = blockIdx.x * 8 + wid; row < NLAT; row += gridDim.x * 8) {
        const float* g2 = modl + (size_t)tok_mod(row) * 12288 + 10240;
        const int p0 = pos[row * 2], p1 = pos[row * 2 + 1]; const float w0 = topw[row * 2], w1 = topw[row * 2 + 1];
        const bool t0 = nsl > 1 && p0 >= trow0, t1 = nsl > 1 && p1 >= trow0;
        f32x4 v[8]; float ss = 0.f;
#pragma unroll
        for (int i = 0; i < 8; ++i) { const int col = i * 256 + lane * 4;
            const f32x4 x = *(const f32x4*)(xs + (size_t)row * D + col), g = *(const f32x4*)(g2 + col); f32x4 ya, yb;
            if (t0) { ya = *(const f32x4*)(slab + (size_t)(p0 - trow0) * D + col); for (int sl = 1; sl < nsl; ++sl) ya += *(const f32x4*)(slab + ((size_t)sl * trows + (p0 - trow0)) * D + col); }
            else { const u32x2 q = *(const u32x2*)(ys + (size_t)p0 * D + col); ya = (f32x4){__uint_as_float(q.x << 16), __uint_as_float(q.x & 0xffff0000u), __uint_as_float(q.y << 16), __uint_as_float(q.y & 0xffff0000u)}; }
            if (t1) { yb = *(const f32x4*)(slab + (size_t)(p1 - trow0) * D + col); for (int sl = 1; sl < nsl; ++sl) yb += *(const f32x4*)(slab + ((size_t)sl * trows + (p1 - trow0)) * D + col); }
            else { const u32x2 q = *(const u32x2*)(ys + (size_t)p1 * D + col); yb = (f32x4){__uint_as_float(q.x << 16), __uint_as_float(q.x & 0xffff0000u), __uint_as_float(q.y << 16), __uint_as_float(q.y & 0xffff0000u)}; }
#pragma unroll
            for (int j = 0; j < 4; ++j) { v[i][j] = x[j] + g[j] * (w0 * ya[j] + w1 * yb[j]); ss += v[i][j] * v[i][j]; } }
        ss = wave_sum(ss); const float rstd = rsqrtf(ss * (1.0f / D) + EPS);
#pragma unroll
        for (int i = 0; i < 8; ++i) { const int col = i * 256 + lane * 4; const f32x4 g = *(const f32x4*)(gfin + col); f32x4 o;
#pragma unroll
            for (int j = 0; j < 4; ++j) o[j] = v[i][j] * rstd * g[j];
            *(f32x4*)(out + (size_t)row * D + col) = o; }
    }
}

typedef float f32x2_t __attribute__((ext_vector_type(2))); typedef __bf16 bf16x2_t __attribute__((ext_vector_type(2)));
__device__ __forceinline__ unsigned cvtpk(float lo, float hi) { f32x2_t v = {lo, hi}; bf16x2_t b = __builtin_convertvector(v, bf16x2_t); return __builtin_bit_cast(unsigned, b); }
#define MFMA32(a, b, c) __builtin_amdgcn_mfma_f32_32x32x16_bf16((a), (b), (c), 0, 0, 0)
constexpr int MLA_KP = 400, MLA_VP = 144, MLA_KB = 64 * MLA_KP, MLA_VB = 128 * MLA_VP, MLA_STAGE = MLA_KB + MLA_VB;
static_assert(2 * MLA_STAGE <= RING_BYTES, "MLA LDS");

__device__ __forceinline__ void ph_mla(const Args& a, bool with_ctx, unsigned char* lds) {
    const bf16_t* __restrict__ Q = (const bf16_t*)(a.ws + WS_Q); const bf16_t* __restrict__ KN = (const bf16_t*)(a.ws + WS_KN); const bf16_t* __restrict__ KPE = (const bf16_t*)(a.ws + WS_KPE);
    const bf16_t* __restrict__ VT = (const bf16_t*)(a.ws + WS_VT); bf16_t* __restrict__ mix = (bf16_t*)(a.ws + WS_MIX);
    int tid_ = threadIdx.x; asm volatile("" : "+v"(tid_));
    const int tid = tid_, lane = tid & 63, w = tid >> 6, qi = lane & 31, hh = lane >> 5;
    const int nunits = with_ctx ? 288 : 256;
    const float c = 0.07216878364870322f * 1.4426950408889634f;
    for (int unit = blockIdx.x; unit < nunits; unit += gridDim.x) {
        int h, b, q0tok, nt; bool ctxq;
        if (unit < 256) { h = unit & 7; b = unit >> 6; q0tok = b * L + ((unit >> 3) & 7) * 256; nt = 36; ctxq = false; }
        else { const int u2 = unit - 256; h = u2 & 7; b = u2 >> 3; q0tok = NLAT + b * C; nt = 4; ctxq = true; }
#define MLA_KTOK(t) (ctxq ? (NLAT + b * C + (t) * 64) : ((t) < 32 ? (b * L + (t) * 64) : (NLAT + b * C + ((t) - 32) * 64)))
        u32x4 r0, r1, r2, r3, r4;
#define MLA_ISSUE_K(t) do { const int kt0_ = MLA_KTOK(t); \
            r0 = *(const u32x4*)(KN + (size_t)(kt0_ + (tid >> 4)) * 1024 + h * 128 + (tid & 15) * 8); \
            r1 = *(const u32x4*)(KN + (size_t)(kt0_ + 32 + (tid >> 4)) * 1024 + h * 128 + (tid & 15) * 8); \
            r2 = *(const u32x4*)(KPE + (size_t)(kt0_ + (tid >> 3)) * 64 + (tid & 7) * 8); } while (0)
#define MLA_ISSUE_V(t) do { const int kt0_ = MLA_KTOK(t); \
            r3 = *(const u32x4*)(VT + (size_t)(h * 128 + (tid >> 3)) * NTOK + kt0_ + (tid & 7) * 8); \
            r4 = *(const u32x4*)(VT + (size_t)(h * 128 + 64 + (tid >> 3)) * NTOK + kt0_ + (tid & 7) * 8); } while (0)
#define MLA_ISSUE(t) do { MLA_ISSUE_K(t); MLA_ISSUE_V(t); } while (0)
#define MLA_COMMIT(buf) do { unsigned char* kb_ = lds + (buf) * MLA_STAGE; unsigned char* vb_ = kb_ + MLA_KB; \
            *(u32x4*)(kb_ + (tid >> 4) * MLA_KP + (tid & 15) * 16) = r0; \
            *(u32x4*)(kb_ + (32 + (tid >> 4)) * MLA_KP + (tid & 15) * 16) = r1; \
            *(u32x4*)(kb_ + (tid >> 3) * MLA_KP + 256 + (tid & 7) * 16) = r2; \
            const int g_ = (tid & 7) >> 1, e_ = tid & 1; \
            { u32x2 lo_, hi_; lo_.x = r3.x; lo_.y = r3.y; hi_.x = r3.z; hi_.y = r3.w; \
              *(u32x2*)(vb_ + (tid >> 3) * MLA_VP + g_ * 32 + e_ * 8) = lo_; *(u32x2*)(vb_ + (tid >> 3) * MLA_VP + g_ * 32 + 16 + e_ * 8) = hi_; } \
            { u32x2 lo_, hi_; lo_.x = r4.x; lo_.y = r4.y; hi_.x = r4.z; hi_.y = r4.w; \
              *(u32x2*)(vb_ + (64 + (tid >> 3)) * MLA_VP + g_ * 32 + e_ * 8) = lo_; *(u32x2*)(vb_ + (64 + (tid >> 3)) * MLA_VP + g_ * 32 + 16 + e_ * 8) = hi_; } } while (0)
        const int qtok = q0tok + w * 32 + qi;
        bf16x8 qf[12];
#pragma unroll
        for (int s = 0; s < 12; ++s) qf[s] = *(const bf16x8*)(Q + (size_t)qtok * QW + h * 192 + s * 16 + hh * 8);
        f32x16 o[4];
#pragma unroll
        for (int d = 0; d < 4; ++d)
#pragma unroll
            for (int r = 0; r < 16; ++r) o[d][r] = 0.f;
        float m = -1.0e30f, l = 0.f;
        MLA_ISSUE(0); MLA_COMMIT(0);
        __syncthreads();
        for (int t = 0; t < nt; ++t) {
            const unsigned char* kb = lds + (t & 1) * MLA_STAGE; const unsigned char* vb = kb + MLA_KB;
            f32x16 s0, s1;
#pragma unroll
            for (int r = 0; r < 16; ++r) { s0[r] = 0.f; s1[r] = 0.f; }
#pragma unroll
            for (int s = 0; s < 12; ++s) {
                const bf16x8 k0 = *(const bf16x8*)(kb + qi * MLA_KP + s * 32 + hh * 16);
                const bf16x8 k1 = *(const bf16x8*)(kb + (32 + qi) * MLA_KP + s * 32 + hh * 16);
                s0 = MFMA32(k0, qf[s], s0); s1 = MFMA32(k1, qf[s], s1);
                if ((s & 3) == 3) asm volatile("" ::: "memory");
            }
            if (t + 1 < nt) MLA_ISSUE(t + 1);
            float mx = fmaxf(s0[0], s1[0]);
#pragma unroll
            for (int r = 1; r < 16; ++r) mx = fmaxf(mx, fmaxf(s0[r], s1[r]));
            mx = fmaxf(mx, __shfl_xor(mx, 32));
            const float mnew = fmaxf(m, mx * c);
            const float alpha = __builtin_amdgcn_exp2f(m - mnew);
            m = mnew;
            float ps = 0.f;
#pragma unroll
            for (int r = 0; r < 16; ++r) { s0[r] = __builtin_amdgcn_exp2f(s0[r] * c - mnew); s1[r] = __builtin_amdgcn_exp2f(s1[r] * c - mnew); ps += s0[r] + s1[r]; }
            l = l * alpha + ps;
#pragma unroll
            for (int d = 0; d < 4; ++d)
#pragma unroll
                for (int r = 0; r < 16; ++r) o[d][r] *= alpha;
            bf16x8 pf[4];
            { u32x4 p;
              p.x = cvtpk(s0[0], s0[1]); p.y = cvtpk(s0[2], s0[3]); p.z = cvtpk(s0[4], s0[5]); p.w = cvtpk(s0[6], s0[7]); pf[0] = __builtin_bit_cast(bf16x8, p);
              p.x = cvtpk(s0[8], s0[9]); p.y = cvtpk(s0[10], s0[11]); p.z = cvtpk(s0[12], s0[13]); p.w = cvtpk(s0[14], s0[15]); pf[1] = __builtin_bit_cast(bf16x8, p);
              p.x = cvtpk(s1[0], s1[1]); p.y = cvtpk(s1[2], s1[3]); p.z = cvtpk(s1[4], s1[5]); p.w = cvtpk(s1[6], s1[7]); pf[2] = __builtin_bit_cast(bf16x8, p);
              p.x = cvtpk(s1[8], s1[9]); p.y = cvtpk(s1[10], s1[11]); p.z = cvtpk(s1[12], s1[13]); p.w = cvtpk(s1[14], s1[15]); pf[3] = __builtin_bit_cast(bf16x8, p); }
            asm volatile("" ::: "memory");
#pragma unroll
            for (int d = 0; d < 4; ++d) {
#pragma unroll
                for (int g = 0; g < 4; ++g) {
                    const bf16x8 vf = *(const bf16x8*)(vb + (d * 32 + qi) * MLA_VP + g * 32 + hh * 16);
                    o[d] = MFMA32(vf, pf[g], o[d]);
                }
                if (d & 1) asm volatile("" ::: "memory");
            }
            if (t + 1 < nt) MLA_COMMIT((t + 1) & 1);
            __syncthreads();
        }
        const float inv = 1.0f / (l + __shfl_xor(l, 32));
        bf16_t* op = mix + (size_t)qtok * D + h * 128 + 4 * hh;
#pragma unroll
        for (int d = 0; d < 4; ++d)
#pragma unroll
            for (int g = 0; g < 4; ++g) { u32x2 wv; wv.x = cvtpk(o[d][4 * g] * inv, o[d][4 * g + 1] * inv); wv.y = cvtpk(o[d][4 * g + 2] * inv, o[d][4 * g + 3] * inv);
                *(u32x2*)(op + d * 32 + 8 * g) = wv; }
#undef MLA_KTOK
#undef MLA_ISSUE
#undef MLA_ISSUE_K
#undef MLA_ISSUE_V
#undef MLA_COMMIT
    }
}

constexpr int HY_CS = 8224, HY_WS = 5136, HY_WOFF = 8 * HY_CS, HY_RBL = HY_WOFF + 4 * HY_WS;
static_assert(HY_RBL + 516 * 16 <= RING_BYTES, "hyena LDS");

__device__ __forceinline__ u32x4 hy_shift(const u32x4 a, const u32x4 b, int r) {
    switch (r) {
    case 0: return b;
    case 1: return (u32x4){__builtin_amdgcn_alignbyte(b.x, a.w, 2), __builtin_amdgcn_alignbyte(b.y, b.x, 2), __builtin_amdgcn_alignbyte(b.z, b.y, 2), __builtin_amdgcn_alignbyte(b.w, b.z, 2)};
    case 2: return (u32x4){a.w, b.x, b.y, b.z};
    case 3: return (u32x4){__builtin_amdgcn_alignbyte(a.w, a.z, 2), __builtin_amdgcn_alignbyte(b.x, a.w, 2), __builtin_amdgcn_alignbyte(b.y, b.x, 2), __builtin_amdgcn_alignbyte(b.z, b.y, 2)};
    case 4: return (u32x4){a.z, a.w, b.x, b.y};
    case 5: return (u32x4){__builtin_amdgcn_alignbyte(a.z, a.y, 2), __builtin_amdgcn_alignbyte(a.w, a.z, 2), __builtin_amdgcn_alignbyte(b.x, a.w, 2), __builtin_amdgcn_alignbyte(b.y, b.x, 2)};
    case 6: return (u32x4){a.y, a.z, a.w, b.x};
    default: return (u32x4){__builtin_amdgcn_alignbyte(a.y, a.x, 2), __builtin_amdgcn_alignbyte(a.z, a.y, 2), __builtin_amdgcn_alignbyte(a.w, a.z, 2), __builtin_amdgcn_alignbyte(b.x, a.w, 2)};
    }
}

__device__ __forceinline__ void ph_hyena(const Args& a, int l, unsigned char* lds) {
    const bf16_t* __restrict__ RB = (const bf16_t*)(a.ws + WS_FILTL) + (size_t)l * 512 * HY_RBROW;
    const bf16_t* __restrict__ wtl = (const bf16_t*)(a.ws + WS_WTL); const bf16_t* __restrict__ x0 = (const bf16_t*)(a.ws + WS_X0); const float* skip = a.in[23] + l * 512;
    bf16_t* __restrict__ mix = (bf16_t*)(a.ws + WS_MIX);
    int tid_ = threadIdx.x; asm volatile("" : "+v"(tid_));
    const int tid = tid_, lane = tid & 63, w = __builtin_amdgcn_readfirstlane(tid >> 6), i = lane & 31, hh = lane >> 5;
    for (int unit = blockIdx.x; unit < 512; unit += gridDim.x) {
        const int c = unit;
        for (int k = tid; k < 515; k += NTHR) { u32x4 v = (u32x4){0u, 0u, 0u, 0u}; if (k < 513) v = *(const u32x4*)(RB + (size_t)c * HY_RBROW + k * 8); *(u32x4*)(lds + HY_RBL + k * 16) = v; }
        for (int k = tid; k < 4 * 321; k += NTHR) { const int b = k / 321, sl = k - b * 321; u32x4 v = (u32x4){0u, 0u, 0u, 0u};
            if (sl >= 28 && sl < 284) v = *(const u32x4*)(wtl + ((size_t)b * 512 + c) * L + (sl - 28) * 8);
            *(u32x4*)(lds + HY_WOFF + b * HY_WS + sl * 16) = v; }
        __syncthreads();
        for (int qs = lane; qs < 511; qs += 64) {
            const u32x4 ca = *(const u32x4*)(lds + HY_RBL + qs * 16), cb = *(const u32x4*)(lds + HY_RBL + qs * 16 + 16);
            *(u32x4*)(lds + w * HY_CS + qs * 16) = hy_shift(ca, cb, w);
        }
        __syncthreads();
        f32x16 acc0, acc1;
#pragma unroll
        for (int r = 0; r < 16; ++r) { acc0[r] = 0.f; acc1[r] = 0.f; }
        const int Tl = i >> 2, b = i & 3;
        const unsigned char* ap = lds + (i & 7) * HY_CS + (hh - (i >> 3) + 255) * 16;
        const unsigned char* bp = lds + HY_WOFF + b * HY_WS + (224 + 16 * (2 * (8 * w + Tl)) + 8 * hh) * 2;
        const int d0 = 16 * w - 127;
#pragma unroll 2
        for (int dd = 0; dd < 142; dd += 2) {
            const int d = d0 + dd;
            const bf16x8 a0 = *(const bf16x8*)(ap - 32 * d), b0 = *(const bf16x8*)(bp - 32 * d);
            const bf16x8 a1 = *(const bf16x8*)(ap - 32 * (d + 1)), b1 = *(const bf16x8*)(bp - 32 * (d + 1));
            acc0 = MFMA32(a0, b0, acc0); acc1 = MFMA32(a1, b1, acc1);
        }
        const float sk = skip[c];
        const bf16_t* wl = (const bf16_t*)(lds + HY_WOFF + b * HY_WS) + 224;
#pragma unroll
        for (int r = 0; r < 16; ++r) {
            const int t = 32 * (8 * w + Tl) + (r & 3) + 8 * (r >> 2) + 4 * hh; const int tok = b * L + t;
            const float y = acc0[r] + acc1[r] + sk * bf2f(wl[t]);
            mix[(size_t)tok * D + 1024 + c] = f2bf(bf2f(x0[(size_t)tok * 512 + c]) * y);
        }
        __syncthreads();
    }
}

constexpr int SWA_P = 144, SWA_KB = 64 * SWA_P, SWA_STAGE = 2 * SWA_KB;
__device__ __forceinline__ void ph_swa(const Args& a, int l, bool with_ctx, unsigned char* lds) {
    const bf16_t* __restrict__ SQ = (const bf16_t*)(a.ws + WS_SQ); const bf16_t* __restrict__ SK = (const bf16_t*)(a.ws + WS_SK); const bf16_t* __restrict__ SVT = (const bf16_t*)(a.ws + WS_SV);
    const float* sink = a.in[24] + l * 8; bf16_t* __restrict__ mix = (bf16_t*)(a.ws + WS_MIX);
    int tid_ = threadIdx.x; asm volatile("" : "+v"(tid_));
    const int tid = tid_, lane = tid & 63, w = tid >> 6, qi = lane & 31, hh = lane >> 5;
    const int nunits = with_ctx ? 288 : 256;
    const float c = 0.125f * 1.4426950408889634f;
    for (int unit = blockIdx.x; unit < nunits; unit += gridDim.x) {
        int hk, b, p0, nloc, t0loc, q0tok; bool ctxq;
        if (unit < 256) { hk = unit & 1; b = (unit >> 1) & 3; p0 = (unit >> 3) * 64; ctxq = false; q0tok = b * L + p0;
            const int lo = p0 - 128 < 0 ? 0 : p0 - 128, hi = p0 + 192 > L ? L : p0 + 192; t0loc = lo; nloc = (hi - lo) >> 6; }
        else { const int u2 = unit - 256; hk = u2 & 1; b = (u2 >> 1) & 3; p0 = (u2 >> 3) * 64; ctxq = true; q0tok = NLAT + b * C + p0; t0loc = 0; nloc = 0; }
        const int nt = nloc + 4;
#define SWA_KTOK(t) ((t) < nloc ? (b * L + t0loc + (t) * 64) : (NLAT + b * C + ((t) - nloc) * 64))
        u32x4 r0, r1;
#define SWA_ISSUE(t) do { const int kt0_ = SWA_KTOK(t); \
            r0 = *(const u32x4*)(SK + (size_t)(kt0_ + (tid >> 3)) * 128 + hk * 64 + (tid & 7) * 8); \
            r1 = *(const u32x4*)(SVT + (size_t)(hk * 64 + (tid >> 3)) * NTOK + kt0_ + (tid & 7) * 8); } while (0)
#define SWA_COMMIT(buf) do { unsigned char* kb_ = lds + (buf) * SWA_STAGE; unsigned char* vb_ = kb_ + SWA_KB; \
            *(u32x4*)(kb_ + (tid >> 3) * SWA_P + (tid & 7) * 16) = r0; \
            const int g_ = (tid & 7) >> 1, e_ = tid & 1; u32x2 lo_, hi_; lo_.x = r1.x; lo_.y = r1.y; hi_.x = r1.z; hi_.y = r1.w; \
            *(u32x2*)(vb_ + (tid >> 3) * SWA_P + g_ * 32 + e_ * 8) = lo_; *(u32x2*)(vb_ + (tid >> 3) * SWA_P + g_ * 32 + 16 + e_ * 8) = hi_; } while (0)
        const int hq = hk * 4 + (w >> 1), qpos = p0 + (w & 1) * 32 + qi, qtok = q0tok + (w & 1) * 32 + qi;
        bf16x8 qf[4];
#pragma unroll
        for (int s = 0; s < 4; ++s) qf[s] = *(const bf16x8*)(SQ + (size_t)qtok * 512 + hq * 64 + s * 16 + hh * 8);
        f32x16 o[2];
#pragma unroll
        for (int d = 0; d < 2; ++d)
#pragma unroll
            for (int r = 0; r < 16; ++r) o[d][r] = 0.f;
        float m = sink[hq] * 1.4426950408889634f, lsum = hh == 0 ? 1.0f : 0.0f;
        SWA_ISSUE(0); SWA_COMMIT(0);
        __syncthreads();
        for (int t = 0; t < nt; ++t) {
            const unsigned char* kb = lds + (t & 1) * SWA_STAGE; const unsigned char* vb = kb + SWA_KB;
            f32x16 s0, s1;
#pragma unroll
            for (int r = 0; r < 16; ++r) { s0[r] = 0.f; s1[r] = 0.f; }
#pragma unroll
            for (int s = 0; s < 4; ++s) {
                const bf16x8 k0 = *(const bf16x8*)(kb + qi * SWA_P + s * 32 + hh * 16);
                const bf16x8 k1 = *(const bf16x8*)(kb + (32 + qi) * SWA_P + s * 32 + hh * 16);
                s0 = MFMA32(k0, qf[s], s0); s1 = MFMA32(k1, qf[s], s1);
            }
            if (t + 1 < nt) SWA_ISSUE(t + 1);
            if (t < nloc) {
                const int kbase = t0loc + t * 64 + 4 * hh - qpos;
#pragma unroll
                for (int r = 0; r < 16; ++r) { const int dlt = kbase + (r & 3) + 8 * (r >> 2);
                    if (dlt > 128 || dlt < -128) s0[r] = -1.0e30f;
                    if (dlt + 32 > 128 || dlt + 32 < -128) s1[r] = -1.0e30f; }
            }
            float mx = fmaxf(s0[0], s1[0]);
#pragma unroll
            for (int r = 1; r < 16; ++r) mx = fmaxf(mx, fmaxf(s0[r], s1[r]));
            mx = fmaxf(mx, __shfl_xor(mx, 32));
            const float mnew = fmaxf(m, mx * c);
            const float alpha = __builtin_amdgcn_exp2f(m - mnew);
            m = mnew;
            float ps = 0.f;
#pragma unroll
            for (int r = 0; r < 16; ++r) { s0[r] = __builtin_amdgcn_exp2f(s0[r] * c - mnew); s1[r] = __builtin_amdgcn_exp2f(s1[r] * c - mnew); ps += s0[r] + s1[r]; }
            lsum = lsum * alpha + ps;
#pragma unroll
            for (int d = 0; d < 2; ++d)
#pragma unroll
                for (int r = 0; r < 16; ++r) o[d][r] *= alpha;
            bf16x8 pf[4];
            { u32x4 p;
              p.x = cvtpk(s0[0], s0[1]); p.y = cvtpk(s0[2], s0[3]); p.z = cvtpk(s0[4], s0[5]); p.w = cvtpk(s0[6], s0[7]); pf[0] = __builtin_bit_cast(bf16x8, p);
              p.x = cvtpk(s0[8], s0[9]); p.y = cvtpk(s0[10], s0[11]); p.z = cvtpk(s0[12], s0[13]); p.w = cvtpk(s0[14], s0[15]); pf[1] = __builtin_bit_cast(bf16x8, p);
              p.x = cvtpk(s1[0], s1[1]); p.y = cvtpk(s1[2], s1[3]); p.z = cvtpk(s1[4], s1[5]); p.w = cvtpk(s1[6], s1[7]); pf[2] = __builtin_bit_cast(bf16x8, p);
              p.x = cvtpk(s1[8], s1[9]); p.y = cvtpk(s1[10], s1[11]); p.z = cvtpk(s1[12], s1[13]); p.w = cvtpk(s1[14], s1[15]); pf[3] = __builtin_bit_cast(bf16x8, p); }
#pragma unroll
            for (int d = 0; d < 2; ++d)
#pragma unroll
                for (int g = 0; g < 4; ++g) {
                    const bf16x8 vf = *(const bf16x8*)(vb + (d * 32 + qi) * SWA_P + g * 32 + hh * 16);
                    o[d] = MFMA32(vf, pf[g], o[d]);
                }
            if (t + 1 < nt) SWA_COMMIT((t + 1) & 1);
            __syncthreads();
        }
        const float inv = 1.0f / (lsum + __shfl_xor(lsum, 32));
        bf16_t* op = mix + (size_t)qtok * D + 1536 + hq * 64 + 4 * hh;
#pragma unroll
        for (int d = 0; d < 2; ++d)
#pragma unroll
            for (int g = 0; g < 4; ++g) { u32x2 wv; wv.x = cvtpk(o[d][4 * g] * inv, o[d][4 * g + 1] * inv); wv.y = cvtpk(o[d][4 * g + 2] * inv, o[d][4 * g + 3] * inv);
                *(u32x2*)(op + d * 32 + 8 * g) = wv; }
#undef SWA_KTOK
#undef SWA_ISSUE
#undef SWA_COMMIT
    }
}


constexpr int NPHASES = 22;
#define GEMM_CALL(EPI, SCHED, g, S, E) pg8::gemm_phase<EPI, SCHED, true, true>((PG8_LAS unsigned char*)lds, g, S, E)
#define GEMM_CALL8(EPI, SCHED, g, S, E) pg8::gemm_phase<EPI, SCHED, true, true, true>((PG8_LAS unsigned char*)lds, g, S, E)

template <int LYR>
__device__ __forceinline__ void layer_phases(const Args& a, unsigned char* lds, const XcdBarrier& bar, int lo, int hi) {
#define IN(k) (lo <= (k) && (k) < hi)
#define REPS(k) for (int rep_ = 0; rep_ <= (int)((PROBE_MASK >> (k)) & 1u); ++rep_)
#if MK_PER_PHASE
#define SEAM(k) do { } while (0)
#else
#define SEAM(k) do { if (IN(k) && IN((k) + 1)) xcd_barrier(bar); } while (0)
#endif
    constexpr int P0 = 1 + LYR * 9;
    constexpr bool LAST = (LYR == 1);
    constexpr int S_WO = pg8::split_S((LAST ? NLAT : NTOK) / 256 * (D / 256), D / 64, 256);
    constexpr int S_WO0 = pg8::split_S(NTOK / 256 * (D / 256), D / 64, 256);
    constexpr int S_DN0 = pg8::split_S(NTOK / 256 * (D / 256), (FP8_DENSE || FP8_DOWN) ? DFF / 128 : DFF / 64, 256);
    constexpr int S_DN = pg8::split_S(NTOK / 256 * (D / 256), (FP8_DENSE || FP8_DOWN) ? DFF / 128 : DFF / 64, 256);
    const int G = gridDim.x, bid = blockIdx.x;
    unsigned char* ws = a.ws;
    const float* modl = (const float*)(ws + WS_MOD) + (size_t)LYR * 5 * 12288;
    float* xs = (float*)(ws + WS_XS);
    const int nq = LAST ? NLAT : NTOK;
    if (IN(P0 + 0)) REPS(P0 + 0) {
        if (LYR == 0) ph_normmod<false, true>(a.in[0], a.in[2], a.in[6], modl, 0, 2048, (bf16_t*)(ws + WS_HA), NTOK, xs, nullptr, nullptr, nullptr);
        else ph_normmod<false, false, false, S_DN0>(xs, xs + (size_t)NLAT * D, a.in[6] + D, modl, 0, 2048, (bf16_t*)(ws + WS_HA), NTOK, nullptr, nullptr, nullptr, nullptr,
                                                    (const float*)(ws + WS_SLAB), (const float*)(ws + WS_MOD) + (size_t)4 * 12288 + 10240);
    }
    SEAM(P0 + 0);
    if (IN(P0 + 1)) REPS(P0 + 1) {
        pg8::Gemm g{(const bf16_t*)(ws + WS_HA), (const bf16_t*)(ws + WS_WIN + (size_t)LYR * UW * D * 2), NTOK, UW, D};
        pg8::EpiStore E{(bf16_t*)(ws + WS_U), UW};
        if constexpr (LAST) { pg8::WinLastOrder S; S.init(G, bid, D); GEMM_CALL(pg8::EpiStore, pg8::WinLastOrder, g, S, E); }
        else { pg8::StaticOrder S; S.init(NTOK, UW, G, bid, D); GEMM_CALL(pg8::EpiStore, pg8::StaticOrder, g, S, E); }
        conv_fill(a, (float*)lds, LYR * 6 + 0);
    }
    SEAM(P0 + 1);
    if (IN(P0 + 2)) REPS(P0 + 2) ph_mid(a, LYR);
    SEAM(P0 + 2);
    if (IN(P0 + 3)) REPS(P0 + 3) {
        SUBREP(0) {
        { pg8::Gemm g{(const bf16_t*)(ws + WS_CQN), (const bf16_t*)(ws + WS_WQ + (size_t)LYR * QW * 768 * 2), nq, QW, 768};
          pg8::StaticOrder S; S.init(nq, QW, G, bid, 768); pg8::EpiQ E{(bf16_t*)(ws + WS_Q), (const float*)(ws + WS_ROPE), (const float*)(ws + WS_ROPE) + 2048 * 32};
          GEMM_CALL(pg8::EpiQ, pg8::StaticOrder, g, S, E); }
        __syncthreads();
        { pg8::Gemm g{(const bf16_t*)(ws + WS_CKVN), (const bf16_t*)(ws + WS_WKV + (size_t)LYR * KVW * 512 * 2), NTOK, 1024, 512};
          pg8::StaticOrder S; S.init(NTOK, 1024, G, bid, 512); pg8::EpiStore E{(bf16_t*)(ws + WS_KN), 1024};
          GEMM_CALL(pg8::EpiStore, pg8::StaticOrder, g, S, E); }
        __syncthreads();
        { pg8::Gemm g{(const bf16_t*)(ws + WS_WKV + (size_t)LYR * KVW * 512 * 2 + (size_t)1024 * 512 * 2), (const bf16_t*)(ws + WS_CKVN), 1024, NTOK, 512};
          pg8::StaticOrder S; S.init(1024, NTOK, 108, bid >= 216 ? bid - 216 : (bid >= 144 ? bid - 108 : (1 << 24)), 512); pg8::EpiStore E{(bf16_t*)(ws + WS_VT), NTOK};
          GEMM_CALL(pg8::EpiStore, pg8::StaticOrder, g, S, E); }
        __syncthreads();
        }
        SUBREP(1) ph_hyena(a, LYR, lds);
        SUBREP(3) if (!LAST) ph_hyena_naive<C>(a, LYR, (float*)lds);
        SUBREP(2) ph_swa(a, LYR, !LAST, lds);
        conv_fill(a, (float*)lds, LYR * 6 + 1);
    }
    SEAM(P0 + 3);
    if (IN(P0 + 4)) REPS(P0 + 4) { ph_mla(a, !LAST, lds); conv_fill(a, (float*)lds, LYR * 6 + 2); }
    SEAM(P0 + 4);
    if (IN(P0 + 5)) REPS(P0 + 5) {
        pg8::Gemm g{(const bf16_t*)(ws + WS_MIX), (const bf16_t*)(ws + WS_WOUT + (size_t)LYR * D * D * 2), nq, D, D};
        pg8::SplitOrder S; S.init(nq / 256, D / 256, G, bid, D, S_WO);
        const int trow0 = S.nfull / S.nN * 256; pg8::EpiResid E{rep_ ? (float*)(ws + WS_ACT) : xs, modl + 4096, (float*)(ws + WS_SLAB), trow0, nq - trow0, 1.0f};
        GEMM_CALL(pg8::EpiResid, pg8::SplitOrder, g, S, E);
        conv_fill(a, (float*)lds, LYR * 6 + 3);
    }
    SEAM(P0 + 5);
    if (!LAST) {
#if !FP8_DENSE
        if (IN(P0 + 6)) { ph_normmod<false, true, false, S_WO0>(xs, xs + (size_t)NLAT * D, a.in[7], modl, 6144, 8192, (bf16_t*)(ws + WS_HA), NTOK, xs, nullptr, nullptr, nullptr, (const float*)(ws + WS_SLAB), modl + (size_t)4 * 12288 + 4096);
            conv_finish(a, (float*)lds, CONV_DENSE_END); }
        SEAM(P0 + 6);
        if (IN(P0 + 7)) REPS(P0 + 7) {
            pg8::Gemm g{(const bf16_t*)(ws + WS_HA), (const bf16_t*)(ws + WS_WGU), NTOK, 2 * DFF, D};
            pg8::StaticOrder S; S.init(NTOK, 2 * DFF, G, bid, D);
#if FP8_DOWN
            pg8::EpiSwiGLU8 E{(unsigned char*)(ws + WS_ACT), DFF, 1.0f, ASCALE};
            GEMM_CALL(pg8::EpiSwiGLU8, pg8::StaticOrder, g, S, E);
#else
            pg8::EpiSwiGLU E{(bf16_t*)(ws + WS_ACT), DFF};
            GEMM_CALL(pg8::EpiSwiGLU, pg8::StaticOrder, g, S, E);
#endif
            conv_fill(a, (float*)lds, 4);
        }
        SEAM(P0 + 7);
        if (IN(P0 + 8)) REPS(P0 + 8) {
#if FP8_DOWN
            pg8::Gemm g{(const bf16_t*)(ws + WS_ACT), (const bf16_t*)(ws + WS_WDN), NTOK, D, DFF / 2};
            pg8::SplitOrder S; S.init(NTOK / 256, D / 256, G, bid, DFF / 2, S_DN);
            const int trow0 = S.nfull / S.nN * 256; pg8::EpiResid E{rep_ ? (float*)(ws + WS_YS) : xs, modl + 10240, (float*)(ws + WS_SLAB), trow0, NTOK - trow0, 1.0f / (ASCALE * WSCALE)};
            GEMM_CALL8(pg8::EpiResid, pg8::SplitOrder, g, S, E);
#else
            pg8::Gemm g{(const bf16_t*)(ws + WS_ACT), (const bf16_t*)(ws + WS_WDN), NTOK, D, DFF};
            pg8::SplitOrder S; S.init(NTOK / 256, D / 256, G, bid, DFF, S_DN);
            const int trow0 = S.nfull / S.nN * 256; pg8::EpiResid E{rep_ ? (float*)(ws + WS_YS) : xs, modl + 10240, (float*)(ws + WS_SLAB), trow0, NTOK - trow0, 1.0f};
            GEMM_CALL(pg8::EpiResid, pg8::SplitOrder, g, S, E);
#endif
            conv_fill(a, (float*)lds, 5);
        }
#else
        if (IN(P0 + 6)) { ph_normmod<false, true, true, S_WO0>(xs, xs + (size_t)NLAT * D, a.in[7], modl, 6144, 8192, (bf16_t*)(ws + WS_HA), NTOK, xs, nullptr, nullptr, nullptr, (const float*)(ws + WS_SLAB), modl + (size_t)4 * 12288 + 4096);
            conv_finish(a, (float*)lds, CONV_DENSE_END); }
        SEAM(P0 + 6);
        if (IN(P0 + 7)) REPS(P0 + 7) {
            pg8::Gemm g{(const bf16_t*)(ws + WS_HA), (const bf16_t*)(ws + WS_WGU), NTOK, 2 * DFF, D / 2};
            pg8::StaticOrder S; S.init(NTOK, 2 * DFF, G, bid, D / 2); pg8::EpiSwiGLU8 E{(unsigned char*)(ws + WS_ACT), DFF, 1.0f / (ASCALE * WSCALE), ASCALE};
            GEMM_CALL8(pg8::EpiSwiGLU8, pg8::StaticOrder, g, S, E);
            conv_fill(a, (float*)lds, 4);
        }
        SEAM(P0 + 7);
        if (IN(P0 + 8)) REPS(P0 + 8) {
            pg8::Gemm g{(const bf16_t*)(ws + WS_ACT), (const bf16_t*)(ws + WS_WDN), NTOK, D, DFF / 2};
            pg8::SplitOrder S; S.init(NTOK / 256, D / 256, G, bid, DFF / 2, S_DN);
            const int trow0 = S.nfull / S.nN * 256; pg8::EpiResid E{rep_ ? (float*)(ws + WS_YS) : xs, modl + 10240, (float*)(ws + WS_SLAB), trow0, NTOK - trow0, 1.0f / (ASCALE * WSCALE)};
            GEMM_CALL8(pg8::EpiResid, pg8::SplitOrder, g, S, E);
            conv_fill(a, (float*)lds, 5);
        }
#endif
        SEAM(P0 + 8);
    } else {
        if (IN(P0 + 6)) REPS(P0 + 6) ph_normmod<true, false, true>(xs, xs + (size_t)NLAT * D, a.in[7] + D, modl, 6144, 8192, (bf16_t*)(ws + WS_HA), NLAT, nullptr, a.in[29], (int*)(ws + WS_TOPI), (float*)(ws + WS_TOPW));
        SEAM(P0 + 6);
        if (IN(P0 + 7)) REPS(P0 + 7) { ph_route_gather(a, (int*)lds); conv_finish(a, (float*)lds, NCONV); }
        SEAM(P0 + 7);
        if (IN(P0 + 9)) REPS(P0 + 9) {
            pg8::Gemm g{(const bf16_t*)(ws + WS_HBS), (const bf16_t*)(ws + WS_MGU), MOE_ROWS, 2 * DFE, D / 2};
            pg8::MoeOrder S; S.init((const int*)(ws + WS_CTL), 2 * DFE / 256, G, bid, (size_t)2 * DFE * D, D / 2); pg8::EpiSwiGLU8 E{(unsigned char*)(ws + WS_ACT), DFE, 1.0f / (ASCALE * WSCALE), ASCALE};
            GEMM_CALL8(pg8::EpiSwiGLU8, pg8::MoeOrder, g, S, E);
        }
        SEAM(P0 + 9);
        if (IN(P0 + 10)) REPS(P0 + 10) {
            pg8::Gemm g{(const bf16_t*)(ws + WS_ACT), (const bf16_t*)(ws + WS_MDN), MOE_ROWS, D, DFE / 2};
            pg8::SplitOrder S; S.init_moe((const int*)(ws + WS_CTL), D / 256, G, bid, DFE / 2, (size_t)D * DFE);
            const int trow0 = S.nfull / S.nN * 256; pg8::EpiYs E{(bf16_t*)(ws + WS_YS), (float*)(ws + WS_SLAB), trow0, S.nM * 256 - trow0, 1.0f / (ASCALE * WSCALE)};
            GEMM_CALL8(pg8::EpiYs, pg8::SplitOrder, g, S, E);
        }
        SEAM(P0 + 10);
        if (IN(P0 + 11)) REPS(P0 + 11) ph_final(a);
    }
#undef IN
#undef SEAM
#undef REPS
}

__global__ void __launch_bounds__(NTHR, 2) mk_fwd(Args a) {
    extern __shared__ __attribute__((aligned(16))) unsigned char lds[];
    const int tid = threadIdx.x;
    for (int u = tid; u < (LDS_BYTES - LDSCTL_OFF) / 4; u += NTHR) ((unsigned*)(lds + LDSCTL_OFF))[u] = 0u;
    __syncthreads();
    XcdBarrier bar; bar.bar = (unsigned*)(a.ws + WS_CTL) + CW_BAR; bar.x = 0; bar.st = nullptr;
#if !MK_PER_PHASE
    bar = xcd_barrier_post((unsigned*)(a.ws + WS_CTL) + CW_BAR, (volatile LAS unsigned*)(lds + LDSCTL_OFF + 32));
#endif
    const int lo = a.ph_lo, hi = a.ph_hi;
    if (lo <= 0 && 0 < hi) {
        for (int rep_ = 0; rep_ <= (int)(PROBE_MASK & 1u); ++rep_) { ph_prologue(a, (float*)lds); __syncthreads(); }
#if !MK_PER_PHASE
        if (1 < hi) xcd_barrier(bar);
#endif
    }
    layer_phases<0>(a, lds, bar, lo, hi);
    layer_phases<1>(a, lds, bar, lo, hi);
}

extern "C" void kernel_launch(void* const* d_in, const int* in_sizes, int n_in, void* d_out, int out_size, void* d_ws, size_t ws_size, hipStream_t stream) {
    (void)in_sizes; (void)out_size;
    static int grid = 0;
    if (grid == 0) {
        if (n_in != 34 || ws_size < WS_END) { fprintf(stderr, "kernel_launch: need 34 inputs and >= %zu bytes of workspace (got %d, %zu)\n", (size_t)WS_END, n_in, ws_size); grid = -1; return; }
        int dev = 0, cus = 0, per_cu = 0;
        if (hipGetDevice(&dev) != hipSuccess || hipDeviceGetAttribute(&cus, hipDeviceAttributeMultiprocessorCount, dev) != hipSuccess) { grid = -1; return; }
        if (hipFuncSetAttribute((const void*)mk_fwd, hipFuncAttributeMaxDynamicSharedMemorySize, LDS_BYTES) != hipSuccess) { fprintf(stderr, "kernel_launch: hipFuncSetAttribute failed\n"); grid = -1; return; }
        if (hipOccupancyMaxActiveBlocksPerMultiprocessor(&per_cu, (const void*)mk_fwd, NTHR, LDS_BYTES) != hipSuccess || per_cu < 1) { fprintf(stderr, "kernel_launch: occupancy query says %d blocks per CU\n", per_cu); }
        (void)hipGetLastError();
        grid = cus;
    }
    if (grid < 0) return;
    if (hipMemsetAsync((char*)d_ws + WS_CTL, 0, CTL_ZERO_BYTES, stream) != hipSuccess) return;
    Args a{};
    for (int i = 0; i < 34; ++i) a.in[i] = (const float*)d_in[i];
    a.out = (float*)d_out; a.ws = (unsigned char*)d_ws;
#if MK_PER_PHASE
    for (int p = 0; p < NPHASES; ++p) { a.ph_lo = p; a.ph_hi = p + 1; hipLaunchKernelGGL(mk_fwd, dim3(grid), dim3(NTHR), LDS_BYTES, stream, a); }
#else
    a.ph_lo = 0; a.ph_hi = NPHASES;
    hipLaunchKernelGGL(mk_fwd, dim3(grid), dim3(NTHR), LDS_BYTES, stream, a);
#endif
}
```

```cpp
#include <hip/hip_runtime.h>
#include <stdint.h>
#include <stdio.h>

#ifndef FP8_DENSE
#define FP8_DENSE 0
#endif
#ifndef FP8_DOWN
#define FP8_DOWN 1
#endif
#ifndef CONV_FILL
#define CONV_FILL 0
#endif
#ifndef PROBE_MASK
#define PROBE_MASK 0u
#endif
#ifndef PROBE_SUB
#define PROBE_SUB 0u
#endif
#ifndef MK_PER_PHASE
#define MK_PER_PHASE 0
#endif

typedef unsigned short bf16_t;
typedef float f32x4 __attribute__((ext_vector_type(4)));
typedef float f32x16 __attribute__((ext_vector_type(16)));
typedef unsigned u32x4 __attribute__((ext_vector_type(4)));
typedef unsigned u32x2 __attribute__((ext_vector_type(2)));
typedef short bf16x8 __attribute__((ext_vector_type(8)));

constexpr int D = 2048, NB = 4, L = 2048, C = 256, NLAT = NB * L, NCTX = NB * C, NTOK = NLAT + NCTX;
constexpr int UW = 3840;
constexpr int O_CQ = 0, O_CKV = 768, O_KPE = 1280, O_HY = 1344, O_SQ = 2880, O_SK = 3392, O_SV = 3520, INW = 3648;
constexpr int QW = 1536, KVW = 2048, DFF = 5632, DFE = 7168, NE = 8;
constexpr int MOE_ROWS = 18432;
constexpr float EPS = 1e-6f;
constexpr int NTHR = 512;
constexpr int HY_RBROW = 4112;

__device__ __forceinline__ float bf2f(bf16_t h) { return __uint_as_float(((unsigned)h) << 16); }
__device__ __forceinline__ bf16_t f2bf(float f) { unsigned u = __float_as_uint(f); u += 0x7fffu + ((u >> 16) & 1u); return (bf16_t)(u >> 16); }
__device__ __forceinline__ float wave_sum(float v) { for (int o = 32; o > 0; o >>= 1) v += __shfl_xor(v, o); return v; }
__device__ __forceinline__ float wave_max(float v) { for (int o = 32; o > 0; o >>= 1) v = fmaxf(v, __shfl_xor(v, o)); return v; }
__device__ __forceinline__ float silu(float x) { return x / (1.0f + __expf(-x)); }
__device__ __forceinline__ int tok_mod(int tok) { return tok < NLAT ? (tok >> 11) : 4; }

constexpr size_t al(size_t x) { return (x + 255) & ~(size_t)255; }
constexpr size_t WS_CTL = 0, CTL_ZERO_BYTES = 65536;
constexpr size_t WS_MOD = 65536;
constexpr size_t WS_ROPE = WS_MOD + al((size_t)2 * 5 * 12288 * 4);
constexpr size_t WS_FILTL = WS_ROPE + al((size_t)2 * 2048 * 32 * 4);
constexpr size_t WS_FILTC = WS_FILTL + al((size_t)2 * 512 * 4096 * 4);
constexpr size_t WS_WIN = WS_FILTC + al((size_t)2 * 512 * 512 * 4);
constexpr size_t WS_WQ = WS_WIN + al((size_t)2 * UW * D * 2);
constexpr size_t WS_WKV = WS_WQ + al((size_t)2 * QW * 768 * 2);
constexpr size_t WS_WOUT = WS_WKV + al((size_t)2 * KVW * 512 * 2);
constexpr size_t WS_WGU = WS_WOUT + al((size_t)2 * D * D * 2);
constexpr size_t WS_WDN = WS_WGU + al((size_t)2 * DFF * D * 2);
constexpr size_t WS_MGU = WS_WDN + al((size_t)D * DFF * 2);
constexpr size_t WS_MDN = WS_MGU + al((size_t)NE * 2 * DFE * D * 2);
constexpr size_t WS_HA = WS_MDN + al((size_t)NE * D * DFE * 2);
constexpr size_t WS_U = WS_HA + al((size_t)NTOK * D * 2);
constexpr size_t WS_CQN = WS_U + al((size_t)NTOK * UW * 2);
constexpr size_t WS_CKVN = WS_CQN + al((size_t)NTOK * 768 * 2);
constexpr size_t WS_KPE = WS_CKVN + al((size_t)NTOK * 512 * 2);
constexpr size_t WS_X0 = WS_KPE + al((size_t)NTOK * 64 * 2);
constexpr size_t WS_WTL = WS_X0 + al((size_t)NTOK * 512 * 2);
constexpr size_t WS_WTC = WS_WTL + al((size_t)NB * 512 * L * 2);
constexpr size_t WS_SQ = WS_WTC + al((size_t)NB * 512 * C * 2);
constexpr size_t WS_SK = WS_SQ + al((size_t)NTOK * 512 * 2);
constexpr size_t WS_SV = WS_SK + al((size_t)NTOK * 128 * 2);
constexpr size_t WS_Q = WS_SV + al((size_t)NTOK * 128 * 2);
constexpr size_t WS_KV = WS_Q + al((size_t)NTOK * QW * 2);
constexpr size_t WS_KN = WS_KV;
constexpr size_t WS_VT = WS_KV + (size_t)NTOK * 1024 * 2;
constexpr size_t WS_MIX = WS_KV + al((size_t)NTOK * KVW * 2);
constexpr size_t WS_MIXEND = WS_MIX + al((size_t)NTOK * D * 2);
constexpr size_t WS_YS = WS_U;
static_assert(WS_YS + (size_t)MOE_ROWS * D * 4 <= WS_MIXEND, "ys overlay");
constexpr size_t WS_XS = WS_MIXEND;
constexpr size_t WS_ACT = WS_XS + al((size_t)NTOK * D * 4);
constexpr size_t WS_HBS = WS_ACT + al((size_t)MOE_ROWS * DFE * 2);
constexpr size_t WS_TOPI = WS_HBS + al((size_t)MOE_ROWS * D * 2);
constexpr size_t WS_TOPW = WS_TOPI + al((size_t)NLAT * 2 * 4);
constexpr size_t WS_POS = WS_TOPW + al((size_t)NLAT * 2 * 4);
constexpr size_t WS_SRC = WS_POS + al((size_t)NLAT * 2 * 4);
constexpr size_t WS_SLAB = WS_SRC + al((size_t)MOE_ROWS * 4);
constexpr size_t WS_YT = WS_SLAB + ((size_t)64 << 20);
constexpr size_t WS_END = WS_YT + al((size_t)NB * 512 * (L + C) * 2);
constexpr int CT_EOFF = 1024, CT_EPAD = 1040, CT_NTILE = 1056, CT_MOES = 1057, CT_TROW = 1058;
constexpr int CW_BAR = 4096;

constexpr int RING_BYTES = 131072, LDS_BYTES = 147456, LDSCTL_OFF = LDS_BYTES - 256;

namespace pg8 {
#define PG8_LAS __attribute__((address_space(3)))
typedef unsigned short bf16_t;
typedef short bf16x8 __attribute__((ext_vector_type(8)));
typedef float f32x4 __attribute__((ext_vector_type(4)));
typedef unsigned u32x4 __attribute__((ext_vector_type(4)));
constexpr int BM = 256, BK = 64, HALF = 128, HTB = HALF * BK * 2  , STAGE_BYTES = 8 * HTB, NXCD = 8, WGM = 8;

__host__ __device__ __forceinline__ int lds_byte(int r, int c) { const int st = (r >> 4) * 2 + (c >> 5), rr = r & 15, cc = c & 31, ob = rr * 64 + cc * 2; return st * 1024 + (ob ^ (((ob >> 9) & 1) << 5)); }
__host__ __device__ __forceinline__ void stage_rc(int b, int& R, int& C) { const int st = b / 1024, sb = b % 1024, swz = sb ^ (((sb >> 9) & 1) << 5); R = (st >> 1) * 16 + swz / 64; C = (st & 1) * 32 + (swz % 64) / 2; }
__host__ __device__ __forceinline__ int perm32(int rho) { const int n = rho >> 4, i = rho & 15; return 8 * (i >> 2) + 4 * n + (i & 3); }

struct Unit { int pm, pn, kt0, nkt, slab; };
struct Gemm { const bf16_t* A; const bf16_t* Bt; int M, N, K; };

struct StaticOrder {
    int nM, nN, nwg, G, c;
    int nkt;
    __host__ __device__ void init(int M, int N, int G_, int c_, int K) { nM = M / BM; nN = N / BM; nwg = nM * nN; G = G_; c = c_; nkt = K / BK; }
    __host__ __device__ bool next(int i, Unit& u) const {
        const long L = (long)i * G + c; if (L >= nwg) return false;
        int wgid = (int)L; { const int q = nwg / NXCD, r = nwg % NXCD, xcd = wgid % NXCD, off = wgid / NXCD; wgid = (xcd < r ? xcd * (q + 1) : r * (q + 1) + (xcd - r) * q) + off; }
        const int nig = WGM * nN, gid = wgid / nig, fm = gid * WGM, gsz = (nM - fm) < WGM ? (nM - fm) : WGM;
        u.pm = fm + ((wgid % nig) % gsz); u.pn = (wgid % nig) / gsz; u.kt0 = 0; u.nkt = nkt; u.slab = -1; return true;
    }
    __device__ __forceinline__ size_t bt_off(const Unit&) const { return 0; }
    __device__ __forceinline__ void a_ready(const Unit&) const {}
    __device__ __forceinline__ void done(const Unit&) const {}
};

__device__ __forceinline__ unsigned cvt_pk_bf16(float lo, float hi) { unsigned r; asm volatile("v_cvt_pk_bf16_f32 %0, %1, %2" : "=v"(r) : "v"(lo), "v"(hi)); return r; }
typedef float f32x2 __attribute__((ext_vector_type(2)));
typedef int v8i_t __attribute__((ext_vector_type(8))); typedef int v4i_t __attribute__((ext_vector_type(4)));
template <bool F8> struct Frag;
template <> struct Frag<false> { bf16x8 h[2]; __device__ __forceinline__ void set0(bf16x8 x) { h[0] = x; } __device__ __forceinline__ void set1(bf16x8 x) { h[1] = x; } };
template <> struct Frag<true> { v8i_t v; __device__ __forceinline__ void set0(bf16x8 x) { v.lo = __builtin_bit_cast(v4i_t, x); } __device__ __forceinline__ void set1(bf16x8 x) { v.hi = __builtin_bit_cast(v4i_t, x); } };
template <class Epi, class Sched, bool ALIGN_EPI = false, bool SP2 = false, bool FP8 = false>
__device__ __forceinline__ void gemm_phase(PG8_LAS unsigned char* lds, const Gemm g, const Sched& S, const Epi& E) {
    int tid_ = threadIdx.x; asm volatile("" : "+v"(tid_));
    const int tid = tid_, wid = __builtin_amdgcn_readfirstlane(tid >> 6), lane = tid & 63, wr = wid >> 2, wc = wid & 3, fr = lane & 15, fq = lane >> 4;
    const int K = g.K;
    unsigned voffA[2], voffB[2];
#pragma unroll
    for (int i = 0; i < 2; ++i) { int R, C; stage_rc(tid * 16 + i * 8192, R, C); const int Rb = Epi::PERM ? ((R & ~31) + perm32(R & 31)) : R;
        voffA[i] = (unsigned)(R * K + C) * 2u; voffB[i] = (unsigned)(Rb * K + C) * 2u; }
    const size_t kstep = (size_t)(BK * 2);
    const size_t hstep = (size_t)HALF * K * 2;
    const size_t tstep = 2 * hstep;
    const unsigned ldsw = (unsigned)wid * 1024u;
    const int aoff = lds_byte(wr * 64 + fr, fq * 8), boff = lds_byte(wc * 32 + fr, fq * 8);
#define PG8_SA(b, h) (((b) * 2 + (h)) * HTB)
#define PG8_SB(b, h) ((4 + (b) * 2 + (h)) * HTB)
#define PG8_STAGE(bufoff, gbase, voff) do { _Pragma("unroll") for (int _i = 0; _i < 2; ++_i) \
        __builtin_amdgcn_global_load_lds((const unsigned*)((const char*)(gbase) + (voff)[_i]), (PG8_LAS unsigned*)(lds + (bufoff) + ldsw + _i * 8192), 16, 0, 0); } while (0)
#define PG8_LDA(dst, b, h) do { _Pragma("unroll") for (int m = 0; m < 4; ++m) { dst[m].set0(*(const PG8_LAS bf16x8*)(lds + PG8_SA(b, h) + aoff + m * 2048)); dst[m].set1(*(const PG8_LAS bf16x8*)(lds + PG8_SA(b, h) + aoff + m * 2048 + 1024)); } } while (0)
#define PG8_LDB(dst, b, h) do { _Pragma("unroll") for (int n = 0; n < 2; ++n) { dst[n].set0(*(const PG8_LAS bf16x8*)(lds + PG8_SB(b, h) + boff + n * 2048)); dst[n].set1(*(const PG8_LAS bf16x8*)(lds + PG8_SB(b, h) + boff + n * 2048 + 1024)); } } while (0)
#define PG8_MMA(ai, bj, At, Bt) do { __builtin_amdgcn_s_setprio(1); _Pragma("unroll") for (int m = 0; m < 4; ++m) _Pragma("unroll") for (int n = 0; n < 2; ++n) { \
        if constexpr (FP8) asm volatile("v_mfma_f32_16x16x128_f8f6f4 %0, %1, %2, %0" : "+v"(acc[ai][bj][m][n]) : "v"(Bt[n].v), "v"(At[m].v));   \
        else { _Pragma("unroll") for (int k = 0; k < 2; ++k) acc[ai][bj][m][n] = __builtin_amdgcn_mfma_f32_16x16x32_bf16(Bt[n].h[k], At[m].h[k], acc[ai][bj][m][n], 0, 0, 0); } } \
        __builtin_amdgcn_s_setprio(0); } while (0)
#define PG8_WAIT_V(n) asm volatile("s_waitcnt vmcnt(" #n ")" ::: "memory")
#define PG8_WAIT_L(n) asm volatile("s_waitcnt lgkmcnt(" #n ")" ::: "memory")
#define PG8_BAR __builtin_amdgcn_s_barrier()
#define PG8_SCHED __builtin_amdgcn_sched_barrier(0)
    Unit cur, nxt; int ui = 0;
    if (!S.next(0, cur)) return;
    f32x4 acc[2][2][4][2];
#pragma unroll
    for (int a = 0; a < 2; ++a)
#pragma unroll
        for (int b = 0; b < 2; ++b)
#pragma unroll
            for (int m = 0; m < 4; ++m)
#pragma unroll
                for (int n = 0; n < 2; ++n) acc[a][b][m][n] = (f32x4){0.f, 0.f, 0.f, 0.f};
    Frag<FP8> At[4], B0[2], B1[2];
    const char* cA = (const char*)g.A + (size_t)cur.pm * tstep + (size_t)cur.kt0 * kstep; const char* cB = (const char*)g.Bt + S.bt_off(cur) + (size_t)cur.pn * tstep + (size_t)cur.kt0 * kstep;
    S.a_ready(cur);
    if constexpr (SP2) {
        PG8_STAGE(PG8_SB(0, 0), cB, voffB); PG8_STAGE(PG8_SB(0, 1), cB + hstep, voffB); PG8_STAGE(PG8_SA(0, 0), cA, voffA); PG8_STAGE(PG8_SA(0, 1), cA + hstep, voffA);
        if (wr == 1) PG8_BAR;
        PG8_WAIT_V(2); PG8_BAR;
        PG8_STAGE(PG8_SB(1, 0), cB + kstep, voffB); PG8_STAGE(PG8_SA(1, 0), cA + kstep, voffA); PG8_STAGE(PG8_SB(1, 1), cB + hstep + kstep, voffB);
        PG8_WAIT_V(6); PG8_BAR;
    } else {
        PG8_STAGE(PG8_SB(0, 0), cB, voffB); PG8_STAGE(PG8_SA(0, 0), cA, voffA); PG8_STAGE(PG8_SB(0, 1), cB + hstep, voffB); PG8_STAGE(PG8_SA(0, 1), cA + hstep, voffA);
        if (wr == 1) PG8_BAR;
        PG8_WAIT_V(4); PG8_BAR;
        PG8_STAGE(PG8_SB(1, 0), cB + kstep, voffB); PG8_STAGE(PG8_SA(1, 0), cA + kstep, voffA); PG8_STAGE(PG8_SB(1, 1), cB + hstep + kstep, voffB);
        PG8_WAIT_V(6); PG8_BAR;
    }
    for (;;) {
        const bool has_next = S.next(ui + 1, nxt);
        const char* nA = has_next ? (const char*)g.A + (size_t)nxt.pm * tstep + (size_t)nxt.kt0 * kstep : cA; const char* nB = has_next ? (const char*)g.Bt + S.bt_off(nxt) + (size_t)nxt.pn * tstep + (size_t)nxt.kt0 * kstep : cB;
        const int nt = cur.nkt;
        for (int t = 0; t < nt; t += 2) {
            const bool last = (t == nt - 2);
            const char* a1 = cA + (size_t)(t + 1) * kstep;
            const char* a2 = last ? nA : cA + (size_t)(t + 2) * kstep; const char* b2 = last ? nB : cB + (size_t)(t + 2) * kstep;
            const char* a3 = a2 + kstep; const char* b3 = b2 + kstep;
            if (last && has_next) S.a_ready(nxt);
            if constexpr (SP2) {
            PG8_LDB(B0, 0, 0); PG8_LDB(B1, 0, 1); PG8_SCHED; PG8_LDA(At, 0, 0); PG8_STAGE(PG8_SA(1, 1), a1 + hstep, voffA);
            PG8_WAIT_V(8); PG8_WAIT_L(0); PG8_BAR; PG8_MMA(0, 0, At, B0); PG8_MMA(0, 1, At, B1); PG8_BAR; PG8_SCHED;
            PG8_LDA(At, 0, 1); PG8_STAGE(PG8_SB(0, 0), b2, voffB); PG8_STAGE(PG8_SB(0, 1), b2 + hstep, voffB); PG8_STAGE(PG8_SA(0, 0), a2, voffA);
            PG8_WAIT_V(8); PG8_WAIT_L(0); PG8_BAR; PG8_MMA(1, 0, At, B0); PG8_MMA(1, 1, At, B1); PG8_BAR; PG8_SCHED;
            PG8_LDB(B0, 1, 0); PG8_LDB(B1, 1, 1); PG8_SCHED; PG8_LDA(At, 1, 0); PG8_STAGE(PG8_SA(0, 1), a2 + hstep, voffA);
            PG8_WAIT_V(8); PG8_WAIT_L(0); PG8_BAR; PG8_MMA(0, 0, At, B0); PG8_MMA(0, 1, At, B1); PG8_BAR; PG8_SCHED;
            PG8_LDA(At, 1, 1); PG8_STAGE(PG8_SB(1, 0), b3, voffB); PG8_STAGE(PG8_SB(1, 1), b3 + hstep, voffB); PG8_STAGE(PG8_SA(1, 0), a3, voffA);
            PG8_WAIT_V(8); PG8_WAIT_L(0); PG8_BAR; PG8_MMA(1, 0, At, B0); PG8_MMA(1, 1, At, B1); PG8_BAR; PG8_SCHED;
            } else {
            PG8_LDB(B0, 0, 0); PG8_SCHED; PG8_LDA(At, 0, 0); PG8_STAGE(PG8_SA(1, 1), a1 + hstep, voffA);
            PG8_WAIT_L(8); PG8_BAR; PG8_WAIT_L(0); PG8_MMA(0, 0, At, B0); PG8_BAR; PG8_SCHED;
            PG8_LDB(B1, 0, 1); PG8_STAGE(PG8_SB(0, 0), b2, voffB);
            PG8_BAR; PG8_WAIT_L(0); PG8_MMA(0, 1, At, B1); PG8_BAR;
            PG8_LDA(At, 0, 1); PG8_STAGE(PG8_SA(0, 0), a2, voffA);
            PG8_BAR; PG8_WAIT_L(0); PG8_MMA(1, 0, At, B0); PG8_BAR; PG8_SCHED;
            PG8_STAGE(PG8_SB(0, 1), b2 + hstep, voffB);
            PG8_WAIT_V(6); PG8_BAR; PG8_MMA(1, 1, At, B1); PG8_BAR;
            PG8_LDB(B0, 1, 0); PG8_SCHED; PG8_LDA(At, 1, 0); PG8_STAGE(PG8_SA(0, 1), a2 + hstep, voffA);
            PG8_WAIT_L(8); PG8_BAR; PG8_WAIT_L(0); PG8_MMA(0, 0, At, B0); PG8_BAR; PG8_SCHED;
            PG8_LDB(B1, 1, 1); PG8_STAGE(PG8_SB(1, 0), b3, voffB);
            PG8_BAR; PG8_WAIT_L(0); PG8_MMA(0, 1, At, B1); PG8_BAR;
            PG8_LDA(At, 1, 1); PG8_STAGE(PG8_SA(1, 0), a3, voffA);
            PG8_BAR; PG8_WAIT_L(0); PG8_MMA(1, 0, At, B0); PG8_BAR; PG8_SCHED;
            PG8_STAGE(PG8_SB(1, 1), b3 + hstep, voffB);
            PG8_WAIT_V(6); PG8_BAR; PG8_MMA(1, 1, At, B1); PG8_BAR;
            }
        }
        if constexpr (ALIGN_EPI) { if (wr == 0) PG8_BAR; }
        if constexpr (FP8) asm volatile("s_nop 15\n\ts_nop 15" ::: "memory");
        if constexpr (!Epi::AFTER_DRAIN) { E(acc, cur, wr, wc, fr, fq); S.done(cur); }
        if (!has_next) break;
#pragma unroll
        for (int a = 0; a < 2; ++a)
#pragma unroll
            for (int b = 0; b < 2; ++b)
#pragma unroll
                for (int m = 0; m < 4; ++m)
#pragma unroll
                    for (int n = 0; n < 2; ++n) acc[a][b][m][n] = (f32x4){0.f, 0.f, 0.f, 0.f};
        cur = nxt; cA = nA; cB = nB; ++ui;
        if constexpr (ALIGN_EPI) { if (wr == 1) PG8_BAR; }
    }
    PG8_WAIT_V(0);
    if constexpr (!ALIGN_EPI) { if (wr == 0) PG8_BAR; }
    PG8_BAR;
    if constexpr (Epi::AFTER_DRAIN) { E.fused(acc, cur, wr, wc, fr, fq, lds, wid, lane); S.done(cur); }
#undef PG8_SA
#undef PG8_SB
#undef PG8_STAGE
#undef PG8_LDA
#undef PG8_LDB
#undef PG8_MMA
#undef PG8_WAIT_V
#undef PG8_WAIT_L
#undef PG8_BAR
#undef PG8_SCHED
}
}

namespace pg8 {
__device__ __forceinline__ u32x4 pack8(const f32x4 v0, const f32x4 v1) { u32x4 w; w.x = cvt_pk_bf16(v0[0], v0[1]); w.y = cvt_pk_bf16(v0[2], v0[3]); w.z = cvt_pk_bf16(v1[0], v1[1]); w.w = cvt_pk_bf16(v1[2], v1[3]); return w; }
struct EpiStore {
    static constexpr bool PERM = true, AFTER_DRAIN = false;
    bf16_t* O; int ldc;
    __device__ __forceinline__ void operator()(const f32x4 (&acc)[2][2][4][2], const Unit& u, int wr, int wc, int fr, int fq) const {
        const int row0 = u.pm * BM + wr * 64 + fr, col0 = u.pn * BM + wc * 32 + 8 * fq;
#pragma unroll
        for (int ai = 0; ai < 2; ++ai)
#pragma unroll
            for (int m = 0; m < 4; ++m) { bf16_t* rowp = O + (size_t)(row0 + ai * HALF + m * 16) * ldc + col0;
#pragma unroll
                for (int bj = 0; bj < 2; ++bj) *(u32x4*)(rowp + bj * HALF) = pack8(acc[ai][bj][m][0], acc[ai][bj][m][1]); }
    }
};
struct EpiQ {
    static constexpr bool PERM = true, AFTER_DRAIN = false;
    bf16_t* O; const float* cosT; const float* sinT;
    __device__ __forceinline__ void operator()(const f32x4 (&acc)[2][2][4][2], const Unit& u, int wr, int wc, int fr, int fq) const {
        const int row0 = u.pm * BM + wr * 64 + fr, col0 = u.pn * BM + wc * 32 + 8 * fq;
#pragma unroll
        for (int ai = 0; ai < 2; ++ai)
#pragma unroll
            for (int m = 0; m < 4; ++m) { const int row = row0 + ai * HALF + m * 16; const bool lat = row < 8192; const int t = row & 2047;
#pragma unroll
                for (int bj = 0; bj < 2; ++bj) { const int col = col0 + bj * HALF; const int jn = col - 192 * (col / 192);
                    f32x4 v0 = acc[ai][bj][m][0], v1 = acc[ai][bj][m][1];
                    if (jn >= 128 && lat) { const int i0 = (jn - 128) >> 1;
                        const f32x4 cs = *(const f32x4*)(cosT + t * 32 + i0), sn = *(const f32x4*)(sinT + t * 32 + i0);
                        f32x4 r0, r1;
                        r0[0] = v0[0] * cs[0] - v0[1] * sn[0]; r0[1] = v0[0] * sn[0] + v0[1] * cs[0];
                        r0[2] = v0[2] * cs[1] - v0[3] * sn[1]; r0[3] = v0[2] * sn[1] + v0[3] * cs[1];
                        r1[0] = v1[0] * cs[2] - v1[1] * sn[2]; r1[1] = v1[0] * sn[2] + v1[1] * cs[2];
                        r1[2] = v1[2] * cs[3] - v1[3] * sn[3]; r1[3] = v1[2] * sn[3] + v1[3] * cs[3];
                        v0 = r0; v1 = r1; }
                    *(u32x4*)(O + (size_t)row * 1536 + col) = pack8(v0, v1); } }
    }
};
struct EpiResid {
    static constexpr bool PERM = false, AFTER_DRAIN = false;
    float* xs; const float* gate; float* slab; int tail_row0, tail_rows; float scale;
    __device__ __forceinline__ void operator()(const f32x4 (&acc)[2][2][4][2], const Unit& u, int wr, int wc, int fr, int fq) const {
        const int row0 = u.pm * BM + wr * 64 + fr, colb = u.pn * BM + wc * 32 + 4 * fq;
        if (u.slab >= 0) {
#pragma unroll
            for (int ai = 0; ai < 2; ++ai)
#pragma unroll
                for (int m = 0; m < 4; ++m) { float* sp = slab + ((size_t)u.slab * tail_rows + (row0 + ai * HALF + m * 16 - tail_row0)) * 2048;
#pragma unroll
                    for (int bj = 0; bj < 2; ++bj)
#pragma unroll
                        for (int n = 0; n < 2; ++n) *(f32x4*)(sp + colb + bj * HALF + n * 16) = acc[ai][bj][m][n] * scale; }
            return;
        }
#pragma unroll
        for (int ai = 0; ai < 2; ++ai)
#pragma unroll
            for (int m = 0; m < 4; ++m) { const int row = row0 + ai * HALF + m * 16; const float* gv = gate + (size_t)(row < 8192 ? (row >> 11) : 4) * 12288; float* xr = xs + (size_t)row * 2048;
#pragma unroll
                for (int bj = 0; bj < 2; ++bj)
#pragma unroll
                    for (int n = 0; n < 2; ++n) { const int col = colb + bj * HALF + n * 16; f32x4 x = *(const f32x4*)(xr + col); const f32x4 g = *(const f32x4*)(gv + col);
                        x += (g * scale) * acc[ai][bj][m][n]; *(f32x4*)(xr + col) = x; }
                if (m & 1) asm volatile("" ::: "memory"); }
    }
};
__device__ __forceinline__ unsigned pack4_fp8(float a, float b, float c, float d) {
    a = fminf(fmaxf(a, -448.f), 448.f); b = fminf(fmaxf(b, -448.f), 448.f); c = fminf(fmaxf(c, -448.f), 448.f); d = fminf(fmaxf(d, -448.f), 448.f);
    unsigned w = 0; w = __builtin_amdgcn_cvt_pk_fp8_f32(a, b, w, false); w = __builtin_amdgcn_cvt_pk_fp8_f32(c, d, w, true); return w; }
struct EpiSwiGLU8 {
    static constexpr bool PERM = true, AFTER_DRAIN = false;
    unsigned char* O; int ldc; float s, oscale;
    __device__ __forceinline__ void operator()(const f32x4 (&acc)[2][2][4][2], const Unit& u, int wr, int wc, int fr, int fq) const {
        const int row0 = u.pm * BM + wr * 64 + fr, col0 = u.pn * HALF + wc * 32 + 8 * fq;
#pragma unroll
        for (int ai = 0; ai < 2; ++ai)
#pragma unroll
            for (int m = 0; m < 4; ++m) { f32x4 o0, o1;
#pragma unroll
                for (int j = 0; j < 4; ++j) { const float g0 = acc[ai][0][m][0][j] * s, g1 = acc[ai][0][m][1][j] * s;
                    o0[j] = g0 / (1.0f + __expf(-g0)) * (acc[ai][1][m][0][j] * (s * oscale)); o1[j] = g1 / (1.0f + __expf(-g1)) * (acc[ai][1][m][1][j] * (s * oscale)); }
                u32x2 w; w.x = pack4_fp8(o0[0], o0[1], o0[2], o0[3]); w.y = pack4_fp8(o1[0], o1[1], o1[2], o1[3]);
                *(u32x2*)(O + (size_t)(row0 + ai * HALF + m * 16) * ldc + col0) = w; }
    }
};
struct EpiSwiGLU {
    static constexpr bool PERM = true, AFTER_DRAIN = false;
    bf16_t* O; int ldc;
    __device__ __forceinline__ void operator()(const f32x4 (&acc)[2][2][4][2], const Unit& u, int wr, int wc, int fr, int fq) const {
        const int row0 = u.pm * BM + wr * 64 + fr, col0 = u.pn * HALF + wc * 32 + 8 * fq;
#pragma unroll
        for (int ai = 0; ai < 2; ++ai)
#pragma unroll
            for (int m = 0; m < 4; ++m) { f32x4 o0, o1;
#pragma unroll
                for (int j = 0; j < 4; ++j) { const float g0 = acc[ai][0][m][0][j], g1 = acc[ai][0][m][1][j];
                    o0[j] = g0 / (1.0f + __expf(-g0)) * acc[ai][1][m][0][j]; o1[j] = g1 / (1.0f + __expf(-g1)) * acc[ai][1][m][1][j]; }
                *(u32x4*)(O + (size_t)(row0 + ai * HALF + m * 16) * ldc + col0) = pack8(o0, o1); }
    }
};
struct EpiF32 {
    static constexpr bool PERM = false, AFTER_DRAIN = false;
    float* O; int ldc; float* slab; int tail_row0, tail_rows; float scale;
    __device__ __forceinline__ void operator()(const f32x4 (&acc)[2][2][4][2], const Unit& u, int wr, int wc, int fr, int fq) const {
        const int row0 = u.pm * BM + wr * 64 + fr, colb = u.pn * BM + wc * 32 + 4 * fq;
#pragma unroll
        for (int ai = 0; ai < 2; ++ai)
#pragma unroll
            for (int m = 0; m < 4; ++m) { float* xr = (u.slab >= 0) ? slab + ((size_t)u.slab * tail_rows + (row0 + ai * HALF + m * 16 - tail_row0)) * 2048 : O + (size_t)(row0 + ai * HALF + m * 16) * ldc;
#pragma unroll
                for (int bj = 0; bj < 2; ++bj)
#pragma unroll
                    for (int n = 0; n < 2; ++n) *(f32x4*)(xr + colb + bj * HALF + n * 16) = acc[ai][bj][m][n] * scale; }
    }
};
struct EpiYs {
    static constexpr bool PERM = false, AFTER_DRAIN = false;
    bf16_t* O; float* slab; int tail_row0, tail_rows; float scale;
    __device__ __forceinline__ void operator()(const f32x4 (&acc)[2][2][4][2], const Unit& u, int wr, int wc, int fr, int fq) const {
        const int row0 = u.pm * BM + wr * 64 + fr, colb = u.pn * BM + wc * 32 + 4 * fq;
        if (u.slab >= 0) {
#pragma unroll
            for (int ai = 0; ai < 2; ++ai)
#pragma unroll
                for (int m = 0; m < 4; ++m) { float* sp = slab + ((size_t)u.slab * tail_rows + (row0 + ai * HALF + m * 16 - tail_row0)) * 2048;
#pragma unroll
                    for (int bj = 0; bj < 2; ++bj)
#pragma unroll
                        for (int n = 0; n < 2; ++n) *(f32x4*)(sp + colb + bj * HALF + n * 16) = acc[ai][bj][m][n] * scale; }
            return;
        }
#pragma unroll
        for (int ai = 0; ai < 2; ++ai)
#pragma unroll
            for (int m = 0; m < 4; ++m) { bf16_t* xr = O + (size_t)(row0 + ai * HALF + m * 16) * 2048;
#pragma unroll
                for (int bj = 0; bj < 2; ++bj)
#pragma unroll
                    for (int n = 0; n < 2; ++n) { const f32x4 v = acc[ai][bj][m][n] * scale; u32x2 w; w.x = cvt_pk_bf16(v[0], v[1]); w.y = cvt_pk_bf16(v[2], v[3]); *(u32x2*)(xr + colb + bj * HALF + n * 16) = w; } }
    }
};
struct MoeOrder {
    int nM, nN, nwg, G, c, nkt; int t1[8]; size_t estride;
    __device__ __forceinline__ void init(const int* ctl, int nN_, int G_, int c_, size_t estride_, int K) { nkt = K / BK;
        int acc = 0;
#pragma unroll
        for (int e = 0; e < 8; ++e) { acc += __builtin_amdgcn_readfirstlane(ctl[CT_EPAD + e]) >> 8; t1[e] = acc; }
        nM = acc; nN = nN_; nwg = nM * nN; G = G_; c = c_; estride = estride_;
    }
    __device__ __forceinline__ bool next(int i, Unit& u) const {
        const long L = (long)i * G + c; if (L >= nwg) return false;
        int wgid = (int)L; { const int q = nwg / NXCD, r = nwg % NXCD, xcd = wgid % NXCD, off = wgid / NXCD; wgid = (xcd < r ? xcd * (q + 1) : r * (q + 1) + (xcd - r) * q) + off; }
        const int nig = WGM * nN, gid = wgid / nig, fm = gid * WGM, gsz = (nM - fm) < WGM ? (nM - fm) : WGM;
        u.pm = fm + ((wgid % nig) % gsz); u.pn = (wgid % nig) / gsz; u.kt0 = 0; u.nkt = nkt; u.slab = -1; return true;
    }
    __device__ __forceinline__ size_t bt_off(const Unit& u) const { int e = 0;
#pragma unroll
        for (int k = 0; k < 7; ++k) e += (u.pm >= t1[k]) ? 1 : 0;
        return (size_t)e * estride; }
    __device__ __forceinline__ void a_ready(const Unit&) const {}
    __device__ __forceinline__ void done(const Unit&) const {}
};
struct WinLastOrder {
    StaticOrder so; int G, c;
    __device__ __forceinline__ void init(int G_, int c_, int K) { so.init(NLAT, UW, G_, c_, K); G = G_; c = c_; }
    __device__ __forceinline__ bool next(int i, Unit& u) const {
        if (so.next(i, u)) return true;
        const long L = (long)i * G + c - so.nwg; if (L < 0 || L >= 20) return false;
        const int j = (int)L, k = j % 5; u.pm = 32 + j / 5; u.pn = k < 3 ? 3 + k : 10 + k; u.kt0 = 0; u.nkt = so.nkt; u.slab = -1; return true;
    }
    __device__ __forceinline__ size_t bt_off(const Unit&) const { return 0; }
    __device__ __forceinline__ void a_ready(const Unit&) const {}
    __device__ __forceinline__ void done(const Unit&) const {}
};
struct SplitOrder {
    int nM, nN, nwg, G, c, nfull, ntail, S, nkt, nkts; int t1[8]; size_t estride;
    __device__ __forceinline__ void init(int nM_, int nN_, int G_, int c_, int K, int S_) {
        nM = nM_; nN = nN_; nwg = nM * nN; G = G_; c = c_; nkt = K / BK; nfull = (nwg / 256) * 256; ntail = nwg - nfull; S = S_; nkts = nkt / S; estride = 0;
#pragma unroll
        for (int e = 0; e < 8; ++e) t1[e] = 0;
    }
    __device__ __forceinline__ void init_moe(const int* ctl, int nN_, int G_, int c_, int K, size_t estride_) {
        int acc = 0;
#pragma unroll
        for (int e = 0; e < 8; ++e) { acc += __builtin_amdgcn_readfirstlane(ctl[CT_EPAD + e]) >> 8; t1[e] = acc; }
        init(acc, nN_, G_, c_, K, __builtin_amdgcn_readfirstlane(ctl[CT_MOES])); estride = estride_;
        acc = 0;
#pragma unroll
        for (int e = 0; e < 8; ++e) { acc += __builtin_amdgcn_readfirstlane(ctl[CT_EPAD + e]) >> 8; t1[e] = acc; }
    }
    __device__ __forceinline__ bool next(int i, Unit& u) const {
        const long L = (long)i * G + c; int wgid;
        if (L < nfull) { wgid = (int)L; { const int q = nfull / NXCD, xcd = wgid % NXCD, off = wgid / NXCD; wgid = xcd * q + off; } u.kt0 = 0; u.nkt = nkt; u.slab = -1; }
        else { const int j = (int)(L - nfull); if (j >= ntail * S) return false; const int tu = j / S, sl = j - tu * S; wgid = nfull + tu; u.kt0 = sl * nkts; u.nkt = nkts; u.slab = (S > 1) ? sl : -1; }
        const int nig = WGM * nN, gid = wgid / nig, fm = gid * WGM, gsz = (nM - fm) < WGM ? (nM - fm) : WGM;
        u.pm = fm + ((wgid % nig) % gsz); u.pn = (wgid % nig) / gsz; return true;
    }
    __device__ __forceinline__ size_t bt_off(const Unit& u) const { if (estride == 0) return 0; int e = 0;
#pragma unroll
        for (int k = 0; k < 7; ++k) e += (u.pm >= t1[k]) ? 1 : 0;
        return (size_t)e * estride; }
    __device__ __forceinline__ void a_ready(const Unit&) const {}
    __device__ __forceinline__ void done(const Unit&) const {}
};
__host__ __device__ constexpr int split_S(int nwg, int nkt, int G) {
    const int ntail = nwg - (nwg / G) * G;
    if (ntail == 0) return 1;
    if (nkt % 28 == 0 && ntail * 14 <= G) return 14;
    if (nkt % 16 == 0 && ntail * 8 <= G) return 8;
    if (nkt % 14 == 0 && ntail * 7 <= G) return 7;
    if (nkt % 8 == 0 && ntail * 4 <= G) return 4;
    if (nkt % 4 == 0 && ntail * 2 <= G) return 2;
    return 1;
}
}

#define LAS __attribute__((address_space(3)))
#define XB_TMO      128
#define XB_XCNT(j)  (256  + 64 * (j))
#define XB_XSUB(j)  (1280 + 64 * (j))
#define XB_XGEN(j)  (2304 + 64 * (j))
#define XB_TOP      3328
#define XB_TOPGEN   3392
#define XCD_BAR_WORDS 3456
#define XB_SPIN_CAP (1u << 18)

__device__ __forceinline__ unsigned xb_ld(unsigned* p)              { return __hip_atomic_load(p, __ATOMIC_RELAXED, __HIP_MEMORY_SCOPE_AGENT); }
__device__ __forceinline__ unsigned xb_add(unsigned* p, unsigned v) { return __hip_atomic_fetch_add(p, v, __ATOMIC_RELAXED, __HIP_MEMORY_SCOPE_AGENT); }
__device__ __forceinline__ unsigned xb_xcc_id() { return (unsigned)__builtin_amdgcn_s_getreg((3 << 11) | 20) & 0xFu; }
#define XB_SPIN(cond, bar) do { unsigned _sp = 0; while (cond) { __builtin_amdgcn_s_sleep(1); \
    if ((++_sp & 255u) == 0u) { if (xb_ld(&(bar)[XB_TMO])) break; if (_sp > XB_SPIN_CAP) { atomicAdd(&(bar)[XB_TMO], 1u); break; } } } } while (0)

struct XcdBarrier {
    unsigned* bar; unsigned x;
    volatile LAS unsigned* st;
};

__device__ __forceinline__ XcdBarrier xcd_barrier_post(unsigned* bar, volatile LAS unsigned* st) {
    XcdBarrier b; b.bar = bar; b.x = xb_xcc_id(); b.st = st;
    if (threadIdx.x == 0) (void)xb_add(&bar[XB_XCNT(b.x)], 1u);
    return b;
}
__device__ __forceinline__ void xcd_barrier_complete(unsigned* bar, unsigned x, unsigned& nloc, unsigned& nx) {
    const unsigned G = gridDim.x * gridDim.y * gridDim.z;
    unsigned sum, cnt, mine, sp = 0u;
    for (;;) {
        sum = 0u; cnt = 0u; mine = 0u;
#pragma unroll
        for (unsigned j = 0; j < 16; ++j) { const unsigned c = xb_ld(&bar[XB_XCNT(j)]); sum += c; cnt += (c > 0u) ? 1u : 0u; mine = (j == x) ? c : mine; }
        if (sum == G) break;
        __builtin_amdgcn_s_sleep(1);
        if ((++sp & 255u) == 0u) { if (xb_ld(&bar[XB_TMO])) break; if (sp > XB_SPIN_CAP) { atomicAdd(&bar[XB_TMO], 1u); break; } }
    }
    nloc = mine > 0u ? mine : 1u; nx = cnt > 0u ? cnt : 1u;
}

__device__ __forceinline__ void xcd_barrier(const XcdBarrier& b) {
    asm volatile("s_waitcnt vmcnt(0)" ::: "memory");
    __syncthreads();
    if (threadIdx.x == 0) {
        unsigned* bar = b.bar;
        __builtin_amdgcn_s_waitcnt(0);
        unsigned nloc = b.st[0], nx = b.st[1];
        if (nloc == 0u) { xcd_barrier_complete(bar, b.x, nloc, nx); b.st[0] = nloc; b.st[1] = nx; }
        const unsigned old = xb_add(&bar[XB_XSUB(b.x)], 1u);
        const unsigned gen = old / nloc;
        if (old + 1u == (gen + 1u) * nloc) {
            __builtin_amdgcn_fence(__ATOMIC_RELEASE, "agent");
            asm volatile("s_waitcnt vmcnt(0)" ::: "memory");
            const unsigned og = xb_add(&bar[XB_TOP], 1u);
            const unsigned tg = og / nx;
            if (og + 1u == (tg + 1u) * nx) xb_add(&bar[XB_TOPGEN], 1u);
            else XB_SPIN(xb_ld(&bar[XB_TOPGEN]) == tg, bar);
            __builtin_amdgcn_fence(__ATOMIC_ACQUIRE, "agent");
            xb_add(&bar[XB_XGEN(b.x)], 1u);
            asm volatile("s_waitcnt vmcnt(0)" ::: "memory");
        } else {
            XB_SPIN(xb_ld(&bar[XB_XGEN(b.x)]) == gen, bar);
            __builtin_amdgcn_fence(__ATOMIC_ACQUIRE, "agent");
            asm volatile("s_waitcnt vmcnt(0)" ::: "memory");
        }
    }
    __syncthreads();
}


struct Args { const float* in[34]; float* out; unsigned char* ws; int ph_lo, ph_hi; };

enum { MAP_ID = 0, MAP_ROPEQ = 1, MAP_GU0 = 2, MAP_GU1 = 3, MAP_KV = 4 };
struct JobDesc { int in_idx, K, N, nbatch, upb, map; long long src_off, src_bstride, dst_off, dst_bstride; int fp8, pad; };
constexpr int NJOBS = 14, NCONV = 12664;
__constant__ JobDesc c_jobs[NJOBS] = {
    {8, 2048, 3648, 1, 232, MAP_ID, 0, 0, (long long)WS_WIN, 0},
    {8, 2048, 3648, 1, 232, MAP_ID, 2048LL * 3648, 0, (long long)(WS_WIN + (size_t)UW * D * 2), 0},
    {10, 768, 1536, 1, 36, MAP_ROPEQ, 0, 0, (long long)WS_WQ, 0},
    {10, 768, 1536, 1, 36, MAP_ROPEQ, 768LL * 1536, 0, (long long)(WS_WQ + (size_t)QW * 768 * 2), 0},
    {12, 512, 2048, 1, 32, MAP_KV, 0, 0, (long long)WS_WKV, 0},
    {12, 512, 2048, 1, 32, MAP_KV, 512LL * 2048, 0, (long long)(WS_WKV + (size_t)KVW * 512 * 2), 0},
    {25, 2048, 2048, 1, 128, MAP_ID, 0, 0, (long long)WS_WOUT, 0},
    {25, 2048, 2048, 1, 128, MAP_ID, 2048LL * 2048, 0, (long long)(WS_WOUT + (size_t)D * D * 2), 0},
    {26, 2048, 5632, 1, 352, MAP_GU0, 0, 0, (long long)WS_WGU, 0, FP8_DENSE, 0},
    {27, 2048, 5632, 1, 352, MAP_GU1, 0, 0, (long long)WS_WGU, 0, FP8_DENSE, 0},
    {28, 5632, 2048, 1, 352, MAP_ID, 0, 0, (long long)WS_WDN, 0, (FP8_DENSE || FP8_DOWN), 0},
    {30, 2048, 7168, 8, 448, MAP_GU0, 0, 2048LL * 7168, (long long)WS_MGU, 2LL * DFE * D, 1, 0},
    {31, 2048, 7168, 8, 448, MAP_GU1, 0, 2048LL * 7168, (long long)WS_MGU, 2LL * DFE * D, 1, 0},
    {32, 7168, 2048, 8, 448, MAP_ID, 0, 7168LL * 2048, (long long)WS_MDN, (long long)D * DFE, 1, 0},
};
struct ConvUnit { const float* src; bf16_t* dst; int K, N, map, k0, n0, fp8; };
constexpr float WSCALE = 64.f, ASCALE = 8.f;
__device__ __forceinline__ void conv_decode(const Args& a, int u, ConvUnit& cu) {
    int j = 0, base = 0;
    for (;;) { const int n = c_jobs[j].nbatch * c_jobs[j].upb; if (u < base + n || j == NJOBS - 1) break; base += n; ++j; }
    const JobDesc& jd = c_jobs[j];
    int r = u - base; const int bt = r / jd.upb; r -= bt * jd.upb; const int ntn = (jd.N + 127) >> 7; const int kt = r / ntn, nt = r - kt * ntn;
    cu.K = jd.K; cu.N = jd.N; cu.map = jd.map; cu.k0 = kt * 256; cu.n0 = nt * 128; cu.fp8 = jd.fp8;
    const float* sb = j < 2 ? a.in[8] : j < 4 ? a.in[10] : j < 6 ? a.in[12] : j < 8 ? a.in[25] : j == 8 ? a.in[26] : j == 9 ? a.in[27] : j == 10 ? a.in[28] : j == 11 ? a.in[30] : j == 12 ? a.in[31] : a.in[32];
    cu.src = sb + jd.src_off + (long long)bt * jd.src_bstride + (size_t)cu.k0 * jd.N + cu.n0;
    cu.dst = (bf16_t*)(a.ws + jd.dst_off + (long long)bt * jd.dst_bstride);
}
__device__ __forceinline__ int conv_row(int map, int n) {
    if (map == MAP_ID) return n;
    if (map == MAP_GU0) return ((n >> 7) << 8) + (n & 127);
    if (map == MAP_GU1) return ((n >> 7) << 8) + 128 + (n & 127);
    if (map == MAP_KV) { const int hh = n >> 8, jn = n & 255; return jn < 128 ? hh * 128 + jn : 1024 + hh * 128 + (jn - 128); }
    const int hh = n / 192, jn = n - hh * 192; if (jn < 128) return n; const int q = jn - 128; return hh * 192 + 128 + 2 * (q & 31) + (q >> 5);
}
constexpr int CV_P = 129;
#define CONV_LOAD(R, CU) do { const bool ok_ = (CU).n0 + (tid & 31) * 4 < (CU).N; _Pragma("unroll") for (int i_ = 0; i_ < 16; ++i_) { const int row_ = 2 * ((tid >> 5) + 16 * (i_ >> 1)) + (i_ & 1); \
        R[i_] = ok_ ? __builtin_nontemporal_load((const f32x4*)((CU).src + (size_t)row_ * (CU).N + (tid & 31) * 4)) : (f32x4){0.f, 0.f, 0.f, 0.f}; } } while (0)
#define CONV_PUT(R, T) do { _Pragma("unroll") for (int i_ = 0; i_ < 16; ++i_) { const int row_ = 2 * ((tid >> 5) + 16 * (i_ >> 1)) + (i_ & 1); float* tp_ = (T) + row_ * CV_P + (tid & 31) * 4; \
        tp_[0] = R[i_][0]; tp_[1] = R[i_][1]; tp_[2] = R[i_][2]; tp_[3] = R[i_][3]; } } while (0)
__device__ __forceinline__ void conv_out(const ConvUnit& cur, const float* tile, int tid) {
    if (cur.fp8) {
#pragma unroll
        for (int j = 0; j < 4; ++j) { const int kc = (tid & 7) + 8 * (j & 1), n = (tid >> 3) + 64 * (j >> 1);
            if (cur.n0 + n < cur.N) { const int row = conv_row(cur.map, cur.n0 + n); const float* tp = tile + (kc * 16) * CV_P + n; u32x4 w;
                w.x = pg8::pack4_fp8(tp[0] * WSCALE, tp[CV_P] * WSCALE, tp[2 * CV_P] * WSCALE, tp[3 * CV_P] * WSCALE); w.y = pg8::pack4_fp8(tp[4 * CV_P] * WSCALE, tp[5 * CV_P] * WSCALE, tp[6 * CV_P] * WSCALE, tp[7 * CV_P] * WSCALE);
                w.z = pg8::pack4_fp8(tp[8 * CV_P] * WSCALE, tp[9 * CV_P] * WSCALE, tp[10 * CV_P] * WSCALE, tp[11 * CV_P] * WSCALE); w.w = pg8::pack4_fp8(tp[12 * CV_P] * WSCALE, tp[13 * CV_P] * WSCALE, tp[14 * CV_P] * WSCALE, tp[15 * CV_P] * WSCALE);
                *(u32x4*)((unsigned char*)cur.dst + (size_t)row * cur.K + cur.k0 + kc * 16) = w; } }
    } else {
#pragma unroll
        for (int j = 0; j < 8; ++j) { const int kc = (tid & 7) + 8 * (j & 3), n = (tid >> 3) + 64 * (j >> 2);
            if (cur.n0 + n < cur.N) { const int row = conv_row(cur.map, cur.n0 + n); const float* tp = tile + (kc * 8) * CV_P + n; u32x4 w;
                w.x = pg8::cvt_pk_bf16(tp[0], tp[CV_P]); w.y = pg8::cvt_pk_bf16(tp[2 * CV_P], tp[3 * CV_P]); w.z = pg8::cvt_pk_bf16(tp[4 * CV_P], tp[5 * CV_P]); w.w = pg8::cvt_pk_bf16(tp[6 * CV_P], tp[7 * CV_P]);
                *(u32x4*)(cur.dst + (size_t)row * cur.K + cur.k0 + kc * 8) = w; } }
    }
}
template <int MODE = 0>
__device__ __forceinline__ void ph_convert(const Args& a, float* tile, int first, int stride, int end) {
    const int tid = threadIdx.x;
    int u = first; ConvUnit cuA, cuB; f32x4 rA[16], rB[16];
#pragma unroll
    for (int i = 0; i < 16; ++i) { rA[i] = (f32x4){0.f, 0.f, 0.f, 0.f}; rB[i] = rA[i]; }
    if (u < end) { conv_decode(a, u, cuA); if (MODE != 2) CONV_LOAD(rA, cuA); }
    if (u + stride < end) { conv_decode(a, u + stride, cuB); if (MODE != 2) CONV_LOAD(rB, cuB); }
    while (u < end) {
        CONV_PUT(rA, tile);
        __syncthreads();
        { const ConvUnit cur = cuA; const int un = u + 2 * stride; if (un < end) { conv_decode(a, un, cuA); if (MODE != 2) CONV_LOAD(rA, cuA); } if (MODE != 1) conv_out(cur, tile, tid); }
        __syncthreads();
        u += stride; if (u >= end) break;
        CONV_PUT(rB, tile);
        __syncthreads();
        { const ConvUnit cur = cuB; const int un = u + 2 * stride; if (un < end) { conv_decode(a, un, cuB); if (MODE != 2) CONV_LOAD(rB, cuB); } if (MODE != 1) conv_out(cur, tile, tid); }
        __syncthreads();
        u += stride;
    }
}
constexpr int CT_QNEXT = 1152;
template <int MODE = 0>
__device__ __forceinline__ void conv_dynamic(const Args& a, float* tile) {
    unsigned* qn = (unsigned*)(a.ws + WS_CTL) + CT_QNEXT; volatile int* bc = (volatile int*)(tile + 256 * CV_P + 4);
    const int tid = threadIdx.x;
    if (tid == 0) { bc[0] = (int)__hip_atomic_fetch_add(qn, 1u, __ATOMIC_RELAXED, __HIP_MEMORY_SCOPE_AGENT); bc[1] = (int)__hip_atomic_fetch_add(qn, 1u, __ATOMIC_RELAXED, __HIP_MEMORY_SCOPE_AGENT);
                    bc[2] = (int)__hip_atomic_fetch_add(qn, 1u, __ATOMIC_RELAXED, __HIP_MEMORY_SCOPE_AGENT); }
    __syncthreads();
    int uA = bc[0], uB = bc[1], uN = bc[2];
    __syncthreads();
    ConvUnit cuA, cuB; f32x4 rA[16], rB[16];
#pragma unroll
    for (int i = 0; i < 16; ++i) { rA[i] = (f32x4){0.f, 0.f, 0.f, 0.f}; rB[i] = rA[i]; }
    if (uA < NCONV) { conv_decode(a, uA, cuA); if (MODE != 2) CONV_LOAD(rA, cuA); }
    if (uB < NCONV) { conv_decode(a, uB, cuB); if (MODE != 2) CONV_LOAD(rB, cuB); }
    while (uA < NCONV) {
        CONV_PUT(rA, tile);
        __syncthreads();
        { const ConvUnit cur = cuA; uA = uN; if (uA < NCONV) { conv_decode(a, uA, cuA); if (MODE != 2) CONV_LOAD(rA, cuA); }
          if (tid == 0) bc[0] = (int)__hip_atomic_fetch_add(qn, 1u, __ATOMIC_RELAXED, __HIP_MEMORY_SCOPE_AGENT);
          if (MODE != 1) conv_out(cur, tile, tid); }
        __syncthreads();
        uN = bc[0];
        if (uB >= NCONV) break;
        CONV_PUT(rB, tile);
        __syncthreads();
        { const ConvUnit cur = cuB; uB = uN; if (uB < NCONV) { conv_decode(a, uB, cuB); if (MODE != 2) CONV_LOAD(rB, cuB); }
          if (tid == 0) bc[0] = (int)__hip_atomic_fetch_add(qn, 1u, __ATOMIC_RELAXED, __HIP_MEMORY_SCOPE_AGENT);
          if (MODE != 1) conv_out(cur, tile, tid); }
        __syncthreads();
        uN = bc[0];
    }
    __syncthreads();
}
#undef CONV_LOAD
#undef CONV_PUT
constexpr int CONV_STATIC = 856, CONV_DENSE_END = 1912, CONV_BATCH = 2;
__device__ __forceinline__ constexpr int CT_DONE(int k) { return 1216 + 64 * k; }
__device__ __forceinline__ void conv_fill(const Args& a, float* tile, int done_idx) {
#if !CONV_FILL
    (void)a; (void)tile; (void)done_idx; return;
#endif
    unsigned* ctl = (unsigned*)(a.ws + WS_CTL); volatile int* bc = (volatile int*)(tile + 256 * CV_P + 4);
    const int tid = threadIdx.x;
    if (tid == 0) (void)__hip_atomic_fetch_add(ctl + CT_DONE(done_idx), 1u, __ATOMIC_RELAXED, __HIP_MEMORY_SCOPE_AGENT);
    for (;;) {
        if (tid == 0) { int q = -1;
            if (__hip_atomic_load(ctl + CT_DONE(done_idx), __ATOMIC_RELAXED, __HIP_MEMORY_SCOPE_AGENT) < gridDim.x) {
                q = (int)__hip_atomic_fetch_add(ctl + CT_QNEXT, (unsigned)CONV_BATCH, __ATOMIC_RELAXED, __HIP_MEMORY_SCOPE_AGENT) + CONV_STATIC; if (q >= NCONV) q = -1; }
            *bc = q; }
        __syncthreads();
        const int q = *bc;
        __syncthreads();
        if (q < 0) break;
        ph_convert(a, tile, q, 1, (q + CONV_BATCH < NCONV) ? q + CONV_BATCH : NCONV);
    }
}
__device__ __forceinline__ void conv_finish(const Args& a, float* tile, int upto) {
#if !CONV_FILL
    (void)a; (void)tile; (void)upto; return;
#endif
    unsigned* ctl = (unsigned*)(a.ws + WS_CTL); volatile int* bc = (volatile int*)(tile + 256 * CV_P + 4);
    const int tid = threadIdx.x;
    for (;;) {
        if (tid == 0) { int q = -1;
            if ((int)__hip_atomic_load(ctl + CT_QNEXT, __ATOMIC_RELAXED, __HIP_MEMORY_SCOPE_AGENT) + CONV_STATIC < upto) {
                q = (int)__hip_atomic_fetch_add(ctl + CT_QNEXT, (unsigned)CONV_BATCH, __ATOMIC_RELAXED, __HIP_MEMORY_SCOPE_AGENT) + CONV_STATIC; if (q >= NCONV) q = -1; }
            *bc = q; }
        __syncthreads();
        const int q = *bc;
        __syncthreads();
        if (q < 0) break;
        ph_convert(a, tile, q, 1, (q + CONV_BATCH < NCONV) ? q + CONV_BATCH : NCONV);
    }
}
__device__ __forceinline__ void adaln_unit(const Args& a, int unit, float* sm) {
    const float* c = a.in[1]; const float* cctx = a.in[3]; const float* w_mod = a.in[4]; const float* b_mod = a.in[5]; float* mod = (float*)(a.ws + WS_MOD);
    const int tid = threadIdx.x, l = unit / 96, chunk = unit - l * 96;
    const int cg = tid & 31, ks = tid >> 5;
    for (int i = tid; i < 5 * 2048; i += 512) { const int v = i >> 11, k = i & 2047; const float val = v < 4 ? c[v * 2048 + k] : cctx[k]; sm[i] = val / (1.0f + __expf(-val)); }
    __syncthreads();
    float acc[5][4];
#pragma unroll
    for (int v = 0; v < 5; ++v)
#pragma unroll
        for (int j = 0; j < 4; ++j) acc[v][j] = 0.f;
    const float* wp = w_mod + ((size_t)l * 2048 + (size_t)ks * 128) * 12288 + chunk * 128 + cg * 4;
    for (int kb = 0; kb < 128; kb += 16) {
        f32x4 w[16];
#pragma unroll
        for (int kk = 0; kk < 16; ++kk) w[kk] = __builtin_nontemporal_load((const f32x4*)(wp + (size_t)(kb + kk) * 12288));
#pragma unroll
        for (int kk = 0; kk < 16; ++kk) { const int k = ks * 128 + kb + kk;
#pragma unroll
            for (int v = 0; v < 5; ++v) { const float s = sm[v * 2048 + k];
#pragma unroll
                for (int j = 0; j < 4; ++j) acc[v][j] += s * w[kk][j]; } }
    }
    __syncthreads();
#pragma unroll
    for (int v = 0; v < 5; ++v)
#pragma unroll
        for (int j = 0; j < 4; ++j) sm[(ks * 5 + v) * 128 + cg * 4 + j] = acc[v][j];
    __syncthreads();
    for (int o = tid; o < 640; o += 512) {
        const int v = o >> 7, cc = o & 127; float s = 0.f;
#pragma unroll
        for (int k2 = 0; k2 < 16; ++k2) s += sm[(k2 * 5 + v) * 128 + cc];
        mod[((size_t)l * 5 + v) * 12288 + chunk * 128 + cc] = s + b_mod[(size_t)l * 12288 + chunk * 128 + cc];
    }
    __syncthreads();
}
constexpr int FW_W1 = 0, FW_W2 = 2112, FW_W3 = 6208, FW_B1 = 10304, FW_B2 = 10368, FW_B3 = 10432, FW_FR = 10496, FW_ZS = 10560, FW_HA = 10848, FW_HB = 11360, FW_END = 11872;
__device__ __forceinline__ void filters_unit(const Args& a, int l, int r, float* sm) {
    float (*zs)[36] = (float (*)[36])(sm + FW_ZS); float (*ha)[64] = (float (*)[64])(sm + FW_HA); float (*hb)[64] = (float (*)[64])(sm + FW_HB);
    const int tid = threadIdx.x;
    const bool lat = r < 256; const int Lf = lat ? 2048 : 256; const int p0 = lat ? r * 8 : (r - 256) * 8;
    float* T = (float*)(a.ws + WS_FILTC) + (size_t)l * 512 * 512;
    const float* wf = a.in[21] + (size_t)l * 64 * 1024;
    const int p = tid >> 6, j = tid & 63; const int pos = p0 + p;
    const float tn = (float)pos / (float)(Lf - 1);
    if (j < 33) {
        float z;
        if (j == 0) z = tn;
        else { const int bi = (j - 1) & 15; const float band = 1e-4f + (float)bi * ((15.0f - 1e-4f) / 15.0f);
               const float ang = (6.283185307179586f / (float)Lf) * (float)pos * band; z = (j <= 16) ? __cosf(ang) : -__sinf(ang); }
        zs[p][j] = z;
    }
    __syncthreads();
    const float f = sm[FW_FR + j];
    { float s = sm[FW_B1 + j];
#pragma unroll
      for (int i = 0; i < 33; ++i) s += zs[p][i] * sm[FW_W1 + i * 64 + j];
      ha[p][j] = __sinf(f * s); }
    __syncthreads();
    { float s = sm[FW_B2 + j];
#pragma unroll 16
      for (int i = 0; i < 64; ++i) s += ha[p][i] * sm[FW_W2 + i * 64 + j];
      hb[p][j] = __sinf(f * s); }
    __syncthreads();
    { float s = sm[FW_B3 + j];
#pragma unroll 16
      for (int i = 0; i < 64; ++i) s += hb[p][i] * sm[FW_W3 + i * 64 + j];
      ha[p][j] = __sinf(f * s); }
    __syncthreads();
    float acc[2][8];
#pragma unroll
    for (int rr = 0; rr < 2; ++rr)
#pragma unroll
        for (int q = 0; q < 8; ++q) acc[rr][q] = 0.f;
    for (int ib = 0; ib < 64; ib += 16) {
        float wa[16], wb[16];
#pragma unroll
        for (int i = 0; i < 16; ++i) { wa[i] = wf[(ib + i) * 1024 + tid]; wb[i] = wf[(ib + i) * 1024 + 512 + tid]; }
#pragma unroll
        for (int i = 0; i < 16; ++i) {
#pragma unroll
            for (int q = 0; q < 8; ++q) { const float h = ha[q][ib + i]; acc[0][q] += h * wa[i]; acc[1][q] += h * wb[i]; } }
    }
    const int ch = tid;
    const float delta = 3.0701134573253944f + (float)ch * ((15.350567286626972f - 3.0701134573253944f) / 511.0f);
#pragma unroll
    for (int q = 0; q < 8; ++q) {
        const int ps = p0 + q; const float dec = __expf(-((float)ps / (float)(Lf - 1)) * delta);
        const float vf = acc[0][q] * dec, vb = acc[1][q] * dec;
        if (lat) { bf16_t* RBp = (bf16_t*)(a.ws + WS_FILTL) + ((size_t)l * 512 + ch) * HY_RBROW; RBp[2048 - ps] = f2bf(vf); if (ps > 0) RBp[2048 + ps] = f2bf(vb); }
        else { T[(size_t)ch * (2 * Lf) + Lf + ps] = vf; if (ps > 0) T[(size_t)ch * (2 * Lf) + Lf - ps] = vb; else T[(size_t)ch * (2 * Lf)] = 0.f; }
    }
    __syncthreads();
}
__device__ __forceinline__ void ph_filters(const Args& a, float* sm, int fb, int nfb) {
    const int tid = threadIdx.x;
    for (int l = 0; l < 2; ++l) {
        for (int i = tid; i < 2112; i += NTHR) sm[FW_W1 + i] = a.in[15][l * 2112 + i];
        for (int i = tid; i < 4096; i += NTHR) { sm[FW_W2 + i] = a.in[17][l * 4096 + i]; sm[FW_W3 + i] = a.in[19][l * 4096 + i]; }
        if (tid < 64) { sm[FW_B1 + tid] = a.in[16][l * 64 + tid]; sm[FW_B2 + tid] = a.in[18][l * 64 + tid]; sm[FW_B3 + tid] = a.in[20][l * 64 + tid]; sm[FW_FR + tid] = a.in[22][l * 64 + tid]; }
        __syncthreads();
        for (int r = fb; r < 288; r += nfb) filters_unit(a, l, r, sm);
        __syncthreads();
    }
}
#define SUBREP(b) for (int srep_ = 0; srep_ <= (int)((PROBE_SUB >> (b)) & 1u); ++srep_)
__device__ __forceinline__ void ph_prologue(const Args& a, float* sm) {
    const int bid = blockIdx.x, G = gridDim.x, tid = threadIdx.x;
    const int NF = G >= 128 ? 64 : 0;
    if (NF == 0) { SUBREP(4) for (int u = bid; u < 192; u += G) adaln_unit(a, u, sm); SUBREP(5) ph_filters(a, sm, bid, G); }
    else if (bid < NF) { SUBREP(5) ph_filters(a, sm, bid, NF); }
    else { SUBREP(4) for (int u = bid - NF; u < 192; u += G - NF) adaln_unit(a, u, sm); }
    { float* cosT = (float*)(a.ws + WS_ROPE); float* sinT = cosT + 2048 * 32;
      for (int i = bid * 512 + tid; i < 2048 * 32; i += G * 512) { const int t = i >> 5, f = i & 31;
          const float pos = (float)((f < 16) ? (t >> 6) : (t & 63)); const float freq = powf(10000.0f, -(float)(f & 15) / 16.0f); const float ang = pos * freq;
          cosT[i] = cosf(ang); sinT[i] = sinf(ang); } }
    for (int i = bid * 512 + tid; i < 2 * 512 * 17; i += G * 512) { const int row = i / 17, k = i - row * 17; ((bf16_t*)(a.ws + WS_FILTL))[(size_t)row * HY_RBROW + (k == 0 ? 0 : 4095 + k)] = 0; }
    for (int i = bid * 512 + tid; i < 2 * 192 * 256; i += G * 512) { const int l = i / (192 * 256), r = i % (192 * 256);
        *(u32x4*)(a.ws + WS_WIN + (size_t)l * UW * D * 2 + (size_t)INW * D * 2 + (size_t)r * 16) = (u32x4){0u, 0u, 0u, 0u}; }
    __syncthreads();
    if ((PROBE_SUB >> 8) & 1u) ph_convert<2>(a, sm, bid, G, NCONV);
    conv_dynamic<0>(a, sm);
    if ((PROBE_SUB >> 6) & 1u) ph_convert<0>(a, sm, bid, G, NCONV);
    if ((PROBE_SUB >> 7) & 1u) ph_convert<1>(a, sm, bid, G, NCONV);
}

template <bool ROUTER, bool COPYX, bool OUT8 = false, int NSLAB = 0>
__device__ __forceinline__ void ph_normmod(const float* __restrict__ xlat, const float* __restrict__ xctx, const float* __restrict__ gain, const float* __restrict__ modl, int sh_off, int sc_off,
                                           bf16_t* __restrict__ out, int nrows, float* __restrict__ xs, const float* __restrict__ router, int* __restrict__ topi, float* __restrict__ topw,
                                           const float* __restrict__ slab = nullptr, const float* __restrict__ slab_gate = nullptr) {
    const int lane = threadIdx.x & 63, wid = threadIdx.x >> 6;
    for (int row = blockIdx.x * 8 + wid; row < nrows; row += gridDim.x * 8) {
        const float* xr = row < NLAT ? xlat + (size_t)row * D : xctx + (size_t)(row - NLAT) * D;
        const float* mv = modl + (size_t)tok_mod(row) * 12288;
        f32x4 v[8]; float ss = 0.f;
#pragma unroll
        for (int i = 0; i < 8; ++i) { v[i] = *(const f32x4*)(xr + i * 256 + lane * 4);
            if (NSLAB > 0 && row >= NLAT) { f32x4 sa = *(const f32x4*)(slab + (size_t)(row - NLAT) * D + i * 256 + lane * 4);
#pragma unroll
                for (int sl = 1; sl < NSLAB; ++sl) sa += *(const f32x4*)(slab + ((size_t)sl * NCTX + (row - NLAT)) * D + i * 256 + lane * 4);
                v[i] += *(const f32x4*)(slab_gate + i * 256 + lane * 4) * sa; }
            ss += v[i][0] * v[i][0] + v[i][1] * v[i][1] + v[i][2] * v[i][2] + v[i][3] * v[i][3];
            if (COPYX && (NSLAB == 0 || row >= NLAT)) *(f32x4*)(xs + (size_t)row * D + i * 256 + lane * 4) = v[i]; }
        ss = wave_sum(ss);
        const float rstd = rsqrtf(ss * (1.0f / D) + EPS);
        float lg[8];
#pragma unroll
        for (int e = 0; e < 8; ++e) lg[e] = 0.f;
#pragma unroll
        for (int i = 0; i < 8; ++i) {
            const int col = i * 256 + lane * 4;
            const f32x4 g = *(const f32x4*)(gain + col), sc = *(const f32x4*)(mv + sc_off + col), sh = *(const f32x4*)(mv + sh_off + col);
            f32x4 o;
#pragma unroll
            for (int j = 0; j < 4; ++j) o[j] = (v[i][j] * rstd * g[j]) * (1.0f + sc[j]) + sh[j];
            if (OUT8) *(unsigned*)((unsigned char*)out + (size_t)row * D + col) = pg8::pack4_fp8(o[0] * ASCALE, o[1] * ASCALE, o[2] * ASCALE, o[3] * ASCALE);
            else { u32x2 w; w.x = (unsigned)f2bf(o[0]) | ((unsigned)f2bf(o[1]) << 16); w.y = (unsigned)f2bf(o[2]) | ((unsigned)f2bf(o[3]) << 16);
                *(u32x2*)(out + (size_t)row * D + col) = w; }
            if (ROUTER) {
#pragma unroll
                for (int j = 0; j < 4; ++j) { const f32x4 r0 = *(const f32x4*)(router + (size_t)(col + j) * 8), r1 = *(const f32x4*)(router + (size_t)(col + j) * 8 + 4);
                    lg[0] += o[j] * r0[0]; lg[1] += o[j] * r0[1]; lg[2] += o[j] * r0[2]; lg[3] += o[j] * r0[3];
                    lg[4] += o[j] * r1[0]; lg[5] += o[j] * r1[1]; lg[6] += o[j] * r1[2]; lg[7] += o[j] * r1[3]; }
                asm volatile("" ::: "memory");
            }
        }
        if (ROUTER) {
#pragma unroll
            for (int e = 0; e < 8; ++e) lg[e] = wave_sum(lg[e]);
            if (lane == 0) {
                int i0 = 0; float v0 = lg[0];
#pragma unroll
                for (int e = 1; e < 8; ++e) if (lg[e] > v0) { v0 = lg[e]; i0 = e; }
                int i1 = -1; float v1 = -3.0e38f;
#pragma unroll
                for (int e = 0; e < 8; ++e) if (e != i0 && lg[e] > v1) { v1 = lg[e]; i1 = e; }
                const float e1 = expf(v1 - v0), w0 = 1.0f / (1.0f + e1), w1 = e1 / (1.0f + e1);
                topi[row * 2] = i0; topi[row * 2 + 1] = i1; topw[row * 2] = w0; topw[row * 2 + 1] = w1;
            }
        }
    }
}

__device__ __forceinline__ float bflo(unsigned w) { return __uint_as_float(w << 16); }
__device__ __forceinline__ float bfhi(unsigned w) { return __uint_as_float(w & 0xffff0000u); }
__device__ __forceinline__ unsigned pkbf(float lo, float hi) { return (unsigned)f2bf(lo) | ((unsigned)f2bf(hi) << 16); }
__device__ __forceinline__ u32x4 rope8(const u32x4 mine, const u32x4 other, bool is_x2, const f32x4 c0, const f32x4 c1, const f32x4 s0, const f32x4 s1) {
    const unsigned mw[4] = {mine.x, mine.y, mine.z, mine.w}, ow[4] = {other.x, other.y, other.z, other.w};
    const float cs[8] = {c0[0], c0[1], c0[2], c0[3], c1[0], c1[1], c1[2], c1[3]}, sn[8] = {s0[0], s0[1], s0[2], s0[3], s1[0], s1[1], s1[2], s1[3]};
    unsigned o[4];
#pragma unroll
    for (int d = 0; d < 4; ++d) {
        const float m0 = bflo(mw[d]), m1 = bfhi(mw[d]), p0 = bflo(ow[d]), p1 = bfhi(ow[d]);
        const float r0 = is_x2 ? (p0 * sn[2 * d] + m0 * cs[2 * d]) : (m0 * cs[2 * d] - p0 * sn[2 * d]);
        const float r1 = is_x2 ? (p1 * sn[2 * d + 1] + m1 * cs[2 * d + 1]) : (m1 * cs[2 * d + 1] - p1 * sn[2 * d + 1]);
        o[d] = pkbf(r0, r1);
    }
    return (u32x4){o[0], o[1], o[2], o[3]};
}
__device__ __forceinline__ u32x4 shfl4(const u32x4 v, int m) { return (u32x4){(unsigned)__shfl_xor((int)v.x, m), (unsigned)__shfl_xor((int)v.y, m), (unsigned)__shfl_xor((int)v.z, m), (unsigned)__shfl_xor((int)v.w, m)}; }
__device__ __forceinline__ void ph_mid(const Args& a, int l) {
    const bf16_t* __restrict__ U = (const bf16_t*)(a.ws + WS_U);
    const float* g_q = a.in[9] + l * 768; const float* g_kv = a.in[11] + l * 512; const float* conv_w = a.in[13] + (size_t)l * 3 * 1536; const float* conv_b = a.in[14] + l * 1536;
    const float* cosT = (const float*)(a.ws + WS_ROPE); const float* sinT = cosT + 2048 * 32;
    bf16_t* cqn = (bf16_t*)(a.ws + WS_CQN); bf16_t* ckvn = (bf16_t*)(a.ws + WS_CKVN); bf16_t* kpe = (bf16_t*)(a.ws + WS_KPE); bf16_t* x0o = (bf16_t*)(a.ws + WS_X0);
    bf16_t* wtl = (bf16_t*)(a.ws + WS_WTL); bf16_t* wtc = (bf16_t*)(a.ws + WS_WTC); bf16_t* sq = (bf16_t*)(a.ws + WS_SQ); bf16_t* sk = (bf16_t*)(a.ws + WS_SK); bf16_t* sv = (bf16_t*)(a.ws + WS_SV);
    int tid_ = threadIdx.x; asm volatile("" : "+v"(tid_));
    const int tid = tid_, lane = tid & 63, wid = tid >> 6;
    for (int unit = blockIdx.x; unit < NTOK / 16; unit += gridDim.x) {
        const int tok0 = unit * 16;
        for (int tt = 0; tt < 2; ++tt) {
            const int tok = tok0 + wid * 2 + tt; const bool lat = tok < NLAT; const int t = lat ? (tok & 2047) : ((tok - NLAT) & 255);
            const bf16_t* u = U + (size_t)tok * UW;
            const u32x2 q0 = *(const u32x2*)(u + O_CQ + lane * 12), q1 = *(const u32x2*)(u + O_CQ + lane * 12 + 4), q2 = *(const u32x2*)(u + O_CQ + lane * 12 + 8);
            const u32x4 kvv = *(const u32x4*)(u + O_CKV + lane * 8);
            const u32x4 sqv = *(const u32x4*)(u + O_SQ + lane * 8);
            const u32x4 skv = *(const u32x4*)(u + O_SK + (lane & 15) * 8);
            const u32x4 kpv = *(const u32x4*)(u + O_KPE + (lane & 7) * 8);
            const int i0 = (lane & 3) * 8;
            f32x4 c0 = (f32x4){1.f, 1.f, 1.f, 1.f}, c1 = c0, s0 = (f32x4){0.f, 0.f, 0.f, 0.f}, s1 = s0;
            if (lat) { c0 = *(const f32x4*)(cosT + t * 32 + i0); c1 = *(const f32x4*)(cosT + t * 32 + i0 + 4); s0 = *(const f32x4*)(sinT + t * 32 + i0); s1 = *(const f32x4*)(sinT + t * 32 + i0 + 4); }
            {
                const unsigned w6[6] = {q0.x, q0.y, q1.x, q1.y, q2.x, q2.y}; float x[12]; float ss = 0.f;
#pragma unroll
                for (int d = 0; d < 6; ++d) { x[2 * d] = bflo(w6[d]); x[2 * d + 1] = bfhi(w6[d]); ss += x[2 * d] * x[2 * d] + x[2 * d + 1] * x[2 * d + 1]; }
                ss = wave_sum(ss); const float rs = rsqrtf(ss * (1.0f / 768.0f) + EPS);
                const f32x4 g0 = *(const f32x4*)(g_q + lane * 12), g1 = *(const f32x4*)(g_q + lane * 12 + 4), g2 = *(const f32x4*)(g_q + lane * 12 + 8);
                u32x2 o0, o1, o2;
                o0.x = pkbf(x[0] * rs * g0[0], x[1] * rs * g0[1]); o0.y = pkbf(x[2] * rs * g0[2], x[3] * rs * g0[3]);
                o1.x = pkbf(x[4] * rs * g1[0], x[5] * rs * g1[1]); o1.y = pkbf(x[6] * rs * g1[2], x[7] * rs * g1[3]);
                o2.x = pkbf(x[8] * rs * g2[0], x[9] * rs * g2[1]); o2.y = pkbf(x[10] * rs * g2[2], x[11] * rs * g2[3]);
                bf16_t* dst = cqn + (size_t)tok * 768 + lane * 12; *(u32x2*)dst = o0; *(u32x2*)(dst + 4) = o1; *(u32x2*)(dst + 8) = o2;
            }
            {
                const unsigned w4[4] = {kvv.x, kvv.y, kvv.z, kvv.w}; float x[8]; float ss = 0.f;
#pragma unroll
                for (int d = 0; d < 4; ++d) { x[2 * d] = bflo(w4[d]); x[2 * d + 1] = bfhi(w4[d]); ss += x[2 * d] * x[2 * d] + x[2 * d + 1] * x[2 * d + 1]; }
                ss = wave_sum(ss); const float rs = rsqrtf(ss * (1.0f / 512.0f) + EPS);
                const f32x4 g0 = *(const f32x4*)(g_kv + lane * 8), g1 = *(const f32x4*)(g_kv + lane * 8 + 4);
                u32x4 o; o.x = pkbf(x[0] * rs * g0[0], x[1] * rs * g0[1]); o.y = pkbf(x[2] * rs * g0[2], x[3] * rs * g0[3]); o.z = pkbf(x[4] * rs * g1[0], x[5] * rs * g1[1]); o.w = pkbf(x[6] * rs * g1[2], x[7] * rs * g1[3]);
                *(u32x4*)(ckvn + (size_t)tok * 512 + lane * 8) = o;
            }
            const bool is_x2 = (lane & 4) != 0;
            {
                const u32x4 r = rope8(sqv, shfl4(sqv, 4), is_x2, c0, c1, s0, s1);
                *(u32x4*)(sq + (size_t)tok * 512 + lane * 8) = r;
            }
            {
                const u32x4 r = rope8(skv, shfl4(skv, 4), is_x2, c0, c1, s0, s1);
                if (lane < 16) *(u32x4*)(sk + (size_t)tok * 128 + lane * 8) = r;
            }
            {
                const u32x4 ot = shfl4(kpv, 4);
                if (lane < 4) {
                    const unsigned mw[4] = {kpv.x, kpv.y, kpv.z, kpv.w}, ow[4] = {ot.x, ot.y, ot.z, ot.w};
                    const float cs[8] = {c0[0], c0[1], c0[2], c0[3], c1[0], c1[1], c1[2], c1[3]}, sn[8] = {s0[0], s0[1], s0[2], s0[3], s1[0], s1[1], s1[2], s1[3]};
                    unsigned o[8];
#pragma unroll
                    for (int d = 0; d < 4; ++d) { const float a0 = bflo(mw[d]), a1 = bfhi(mw[d]), b0 = bflo(ow[d]), b1 = bfhi(ow[d]);
                        o[2 * d] = pkbf(a0 * cs[2 * d] - b0 * sn[2 * d], a0 * sn[2 * d] + b0 * cs[2 * d]);
                        o[2 * d + 1] = pkbf(a1 * cs[2 * d + 1] - b1 * sn[2 * d + 1], a1 * sn[2 * d + 1] + b1 * cs[2 * d + 1]); }
                    bf16_t* dst = kpe + (size_t)tok * 64 + lane * 16;
                    *(u32x4*)dst = (u32x4){o[0], o[1], o[2], o[3]}; *(u32x4*)(dst + 8) = (u32x4){o[4], o[5], o[6], o[7]};
                }
            }
        }
        {
            const bool lat = tok0 < NLAT; const int Ls = lat ? L : C;
            const int b = lat ? (tok0 >> 11) : ((tok0 - NLAT) >> 8), t0 = (lat ? (tok0 & 2047) : ((tok0 - NLAT) & 255));
            const int cp = tid & 255, hf = tid >> 8, ch = cp * 2, ts = t0 + hf * 8, tokb = tok0 + hf * 8;
            float cw[3][3][2], cb[3][2];
#pragma unroll
            for (int g = 0; g < 3; ++g) { cb[g][0] = conv_b[g * 512 + ch]; cb[g][1] = conv_b[g * 512 + ch + 1];
#pragma unroll
                for (int j = 0; j < 3; ++j) { cw[g][j][0] = conv_w[j * 1536 + g * 512 + ch]; cw[g][j][1] = conv_w[j * 1536 + g * 512 + ch + 1]; } }
            unsigned rows[3][10];
#pragma unroll
            for (int r = 0; r < 10; ++r) { const int tr = ts - 1 + r; const bool ok = tr >= 0 && tr < Ls;
#pragma unroll
                for (int g = 0; g < 3; ++g) rows[g][r] = ok ? *(const unsigned*)(U + (size_t)(tokb - 1 + r) * UW + O_HY + g * 512 + ch) : 0u; }
            unsigned wp0[4], wp1[4];
#pragma unroll
            for (int i = 0; i < 8; ++i) {
                float y[3][2];
#pragma unroll
                for (int g = 0; g < 3; ++g) {
                    y[g][0] = cb[g][0] + cw[g][0][0] * bflo(rows[g][i]) + cw[g][1][0] * bflo(rows[g][i + 1]) + cw[g][2][0] * bflo(rows[g][i + 2]);
                    y[g][1] = cb[g][1] + cw[g][0][1] * bfhi(rows[g][i]) + cw[g][1][1] * bfhi(rows[g][i + 1]) + cw[g][2][1] * bfhi(rows[g][i + 2]); }
                *(unsigned*)(x0o + (size_t)(tokb + i) * 512 + ch) = pkbf(y[0][0], y[0][1]);
                const unsigned w0 = f2bf(y[2][0] * y[1][0]), w1 = f2bf(y[2][1] * y[1][1]);
                if (i & 1) { wp0[i >> 1] |= w0 << 16; wp1[i >> 1] |= w1 << 16; } else { wp0[i >> 1] = w0; wp1[i >> 1] = w1; }
            }
            bf16_t* wt = lat ? wtl + ((size_t)b * 512 + ch) * L + ts : wtc + ((size_t)b * 512 + ch) * C + ts;
            *(u32x4*)wt = (u32x4){wp0[0], wp0[1], wp0[2], wp0[3]};
            *(u32x4*)(wt + (lat ? L : C)) = (u32x4){wp1[0], wp1[1], wp1[2], wp1[3]};
        }
        if (tid < 128) {
            unsigned pk[8];
#pragma unroll
            for (int i = 0; i < 16; ++i) { const unsigned v = U[(size_t)(tok0 + i) * UW + O_SV + tid]; if (i & 1) pk[i >> 1] |= v << 16; else pk[i >> 1] = v; }
            bf16_t* dst = sv + (size_t)tid * NTOK + tok0;
            u32x4 w0, w1; w0.x = pk[0]; w0.y = pk[1]; w0.z = pk[2]; w0.w = pk[3]; w1.x = pk[4]; w1.y = pk[5]; w1.z = pk[6]; w1.w = pk[7];
            *(u32x4*)dst = w0; *(u32x4*)(dst + 8) = w1;
        }
    }
}

__device__ __forceinline__ void ph_mla_naive(const Args& a, int nq, float* sm) {
    const bf16_t* __restrict__ Q = (const bf16_t*)(a.ws + WS_Q); const bf16_t* __restrict__ KV = (const bf16_t*)(a.ws + WS_KV); const bf16_t* __restrict__ KPE = (const bf16_t*)(a.ws + WS_KPE);
    bf16_t* mix = (bf16_t*)(a.ws + WS_MIX);
    const int lane = threadIdx.x & 63, w = threadIdx.x >> 6;
    float* qf = sm + w * 192; float* sc = sm + 8 * 192 + w * 2304;
    for (int unit = blockIdx.x; unit < nq; unit += gridDim.x) {
        const int h = unit & 7, qt = (unit >> 3) * 8 + w; const bool lat = qt < NLAT;
        const int b = lat ? (qt >> 11) : ((qt - NLAT) >> 8);
        const int nk = lat ? (L + C) : C;
        for (int i = lane; i < 192; i += 64) qf[i] = bf2f(Q[(size_t)qt * QW + h * 192 + i]);
        __syncthreads();
        const float scale = 0.07216878364870322f;
        float mx = -3.0e38f;
        for (int kc = 0; kc < nk; kc += 64) {
            const int kk = kc + lane;
            const int kt = lat ? (kk < L ? b * L + kk : NLAT + b * C + (kk - L)) : (NLAT + b * C + kk);
            float s = 0.f;
            const u32x4* kp = (const u32x4*)(KV + (size_t)kt * KVW + h * 256);
            for (int i = 0; i < 16; ++i) { const u32x4 v = kp[i]; const float* q8 = qf + i * 8;
                s += q8[0] * __uint_as_float(v.x << 16) + q8[1] * __uint_as_float(v.x & 0xffff0000u) + q8[2] * __uint_as_float(v.y << 16) + q8[3] * __uint_as_float(v.y & 0xffff0000u)
                   + q8[4] * __uint_as_float(v.z << 16) + q8[5] * __uint_as_float(v.z & 0xffff0000u) + q8[6] * __uint_as_float(v.w << 16) + q8[7] * __uint_as_float(v.w & 0xffff0000u); }
            const u32x4* pp = (const u32x4*)(KPE + (size_t)kt * 64);
            for (int i = 0; i < 8; ++i) { const u32x4 v = pp[i]; const float* q8 = qf + 128 + i * 8;
                s += q8[0] * __uint_as_float(v.x << 16) + q8[1] * __uint_as_float(v.x & 0xffff0000u) + q8[2] * __uint_as_float(v.y << 16) + q8[3] * __uint_as_float(v.y & 0xffff0000u)
                   + q8[4] * __uint_as_float(v.z << 16) + q8[5] * __uint_as_float(v.z & 0xffff0000u) + q8[6] * __uint_as_float(v.w << 16) + q8[7] * __uint_as_float(v.w & 0xffff0000u); }
            s *= scale; sc[kk] = s; mx = fmaxf(mx, s);
        }
        mx = wave_max(mx);
        float sum = 0.f;
        for (int kc = 0; kc < nk; kc += 64) { const float p = expf(sc[kc + lane] - mx); sc[kc + lane] = p; sum += p; }
        sum = wave_sum(sum);
        __syncthreads();
        float o0 = 0.f, o1 = 0.f;
        for (int kk = 0; kk < nk; ++kk) {
            const int kt = lat ? (kk < L ? b * L + kk : NLAT + b * C + (kk - L)) : (NLAT + b * C + kk);
            const unsigned v = *(const unsigned*)(KV + (size_t)kt * KVW + h * 256 + 128 + lane * 2);
            const float p = sc[kk];
            o0 += p * __uint_as_float(v << 16); o1 += p * __uint_as_float(v & 0xffff0000u);
        }
        const float inv = 1.0f / sum;
        *(unsigned*)(mix + (size_t)qt * D + h * 128 + lane * 2) = (unsigned)f2bf(o0 * inv) | ((unsigned)f2bf(o1 * inv) << 16);
        __syncthreads();
    }
}
__device__ __forceinline__ void ph_swa_naive(const Args& a, int l, int nq, float* sm) {
    const bf16_t* __restrict__ SQ = (const bf16_t*)(a.ws + WS_SQ); const bf16_t* __restrict__ SK = (const bf16_t*)(a.ws + WS_SK); const bf16_t* __restrict__ SV = (const bf16_t*)(a.ws + WS_SV);
    const float* sink = a.in[24] + l * 8; bf16_t* mix = (bf16_t*)(a.ws + WS_MIX);
    const int lane = threadIdx.x & 63, w = threadIdx.x >> 6;
    float* qf = sm + w * 64; float* sc = sm + 8 * 64 + w * 576; int* kts = (int*)(sm + 8 * 64 + 8 * 576) + w * 576;
    for (int unit = blockIdx.x; unit < nq; unit += gridDim.x) {
        const int hq = unit & 7, hk = hq >> 2, qt = (unit >> 3) * 8 + w; const bool lat = qt < NLAT;
        const int b = lat ? (qt >> 11) : ((qt - NLAT) >> 8), t = lat ? (qt & 2047) : 0;
        int lo = 0, nloc = 0;
        if (lat) { lo = t - 128 < 0 ? 0 : t - 128; const int hi = t + 128 > L - 1 ? L - 1 : t + 128; nloc = hi - lo + 1; }
        const int nk = nloc + C;
        qf[lane] = bf2f(SQ[(size_t)qt * 512 + hq * 64 + lane]);
        __syncthreads();
        const float skv = sink[hq];
        float mx = skv;
        for (int kc = 0; kc < nk; kc += 64) {
            const int kk = kc + lane;
            if (kk < nk) {
                const int kt = kk < nloc ? (b * L + lo + kk) : (NLAT + b * C + (kk - nloc));
                const u32x4* kp = (const u32x4*)(SK + (size_t)kt * 128 + hk * 64);
                float s = 0.f;
                for (int i = 0; i < 8; ++i) { const u32x4 v = kp[i]; const float* q8 = qf + i * 8;
                    s += q8[0] * __uint_as_float(v.x << 16) + q8[1] * __uint_as_float(v.x & 0xffff0000u) + q8[2] * __uint_as_float(v.y << 16) + q8[3] * __uint_as_float(v.y & 0xffff0000u)
                       + q8[4] * __uint_as_float(v.z << 16) + q8[5] * __uint_as_float(v.z & 0xffff0000u) + q8[6] * __uint_as_float(v.w << 16) + q8[7] * __uint_as_float(v.w & 0xffff0000u); }
                s *= 0.125f; sc[kk] = s; kts[kk] = kt; mx = fmaxf(mx, s);
            }
        }
        mx = wave_max(mx);
        float sum = 0.f;
        for (int kc = 0; kc < nk; kc += 64) { const int kk = kc + lane; if (kk < nk) { const float p = expf(sc[kk] - mx); sc[kk] = p; sum += p; } }
        sum = wave_sum(sum) + expf(skv - mx);
        __syncthreads();
        float o = 0.f;
        for (int kk = 0; kk < nk; ++kk) o += sc[kk] * bf2f(SV[(size_t)kts[kk] * 128 + hk * 64 + lane]);
        mix[(size_t)qt * D + 1536 + hq * 64 + lane] = f2bf(o / sum);
        __syncthreads();
    }
}
template <int LS>
__device__ __forceinline__ void ph_hyena_naive(const Args& a, int l, float* sm) {
    const float* filt = LS == L ? (const float*)(a.ws + WS_FILTL) + (size_t)l * 512 * 4096 : (const float*)(a.ws + WS_FILTC) + (size_t)l * 512 * 512;
    const bf16_t* wt = (const bf16_t*)(a.ws + (LS == L ? WS_WTL : WS_WTC)); const bf16_t* x0 = (const bf16_t*)(a.ws + WS_X0); const float* skip = a.in[23] + l * 512;
    bf16_t* mix = (bf16_t*)(a.ws + WS_MIX); const int tok_base = LS == L ? 0 : NLAT;
    float* T = sm; float* ws = sm + 2 * LS; const int tid = threadIdx.x;
    for (int unit = blockIdx.x; unit < 512 * NB; unit += gridDim.x) {
        const int ch = unit >> 2, b = unit & 3;
        for (int i = tid; i < 2 * LS; i += NTHR) T[i] = filt[(size_t)ch * 2 * LS + i];
        for (int i = tid; i < LS; i += NTHR) ws[i] = bf2f(wt[((size_t)b * 512 + ch) * LS + i]);
        __syncthreads();
        const float sk = skip[ch];
        for (int t = tid; t < LS; t += NTHR) {
            float y = 0.f;
            for (int s = 0; s < LS; ++s) y += T[t - s + LS] * ws[s];
            ((bf16_t*)(a.ws + WS_YT))[(LS == L ? (size_t)0 : (size_t)NB * 512 * L) + ((size_t)b * 512 + ch) * LS + t] = f2bf(y);
        }
        __syncthreads();
    }
}
__device__ __forceinline__ void ph_route_gather(const Args& a, int* sm) {
    const int* __restrict__ topi = (const int*)(a.ws + WS_TOPI); int* __restrict__ pos = (int*)(a.ws + WS_POS); int* ctl = (int*)(a.ws + WS_CTL);
    const unsigned char* __restrict__ hb = (const unsigned char*)(a.ws + WS_HA); unsigned char* __restrict__ hbs = (unsigned char*)(a.ws + WS_HBS);
    int (*cnt)[512] = (int (*)[512])sm; int* tot = sm + 8 * 512; int* ppos = sm + 8 * 512 + 16;
    const int tid = threadIdx.x, lane = tid & 63, w = tid >> 6;
    int c[8];
#pragma unroll
    for (int e = 0; e < 8; ++e) c[e] = 0;
    for (int i = 0; i < 32; i += 4) { const u32x4 e4 = *(const u32x4*)(topi + tid * 32 + i);
#pragma unroll
        for (int q = 0; q < 8; ++q) c[q] += (e4.x == (unsigned)q) + (e4.y == (unsigned)q) + (e4.z == (unsigned)q) + (e4.w == (unsigned)q); }
#pragma unroll
    for (int e = 0; e < 8; ++e) cnt[e][tid] = c[e];
    __syncthreads();
    {
        int v[8]; int s8 = 0;
#pragma unroll
        for (int k = 0; k < 8; ++k) { v[k] = cnt[w][lane * 8 + k]; s8 += v[k]; }
        int incl = s8;
#pragma unroll
        for (int off = 1; off < 64; off <<= 1) { const int t = __shfl_up(incl, off); if (lane >= off) incl += t; }
        int run = incl - s8;
#pragma unroll
        for (int k = 0; k < 8; ++k) { cnt[w][lane * 8 + k] = run; run += v[k]; }
        if (lane == 63) tot[w] = incl;
    }
    __syncthreads();
    int eoff[8]; int o = 0;
#pragma unroll
    for (int e = 0; e < 8; ++e) { eoff[e] = o; o += (tot[e] + 255) & ~255; }
    if (blockIdx.x == 0 && tid == 0) {
#pragma unroll
        for (int e = 0; e < 8; ++e) { ctl[CT_EOFF + e] = eoff[e]; ctl[CT_EPAD + e] = (tot[e] + 255) & ~255; }
        ctl[CT_NTILE] = o >> 8; const int nwg = (o >> 8) * (D / 256); ctl[CT_MOES] = pg8::split_S(nwg, DFE / 128, 256); ctl[CT_TROW] = (nwg / 256) * 256 / (D / 256) * 256;
    }
    for (int tg = blockIdx.x; tg < NLAT / 32; tg += gridDim.x) {
        if (tid < 64) {
            const int idx = 64 * tg + tid, owner = idx >> 5, e = topi[idx]; int p = 0;
#pragma unroll
            for (int q = 0; q < 8; ++q) { const unsigned long long mk = __ballot(e == q);
                if (e == q) { const unsigned hm = (unsigned)(mk >> (32 * (tid >> 5))); p = eoff[q] + cnt[q][owner] + __popc(hm & ((1u << (tid & 31)) - 1u)); } }
            pos[idx] = p; ppos[tid] = p;
        }
        __syncthreads();
#pragma unroll
        for (int k = 0; k < 4; ++k) { const int tl = 4 * w + k; const int tok = 32 * tg + tl;
            const u32x4 v0 = *(const u32x4*)(hb + (size_t)tok * D + lane * 32), v1 = *(const u32x4*)(hb + (size_t)tok * D + lane * 32 + 16);
            const int p0 = ppos[2 * tl], p1 = ppos[2 * tl + 1];
            *(u32x4*)(hbs + (size_t)p0 * D + lane * 32) = v0; *(u32x4*)(hbs + (size_t)p0 * D + lane * 32 + 16) = v1;
            *(u32x4*)(hbs + (size_t)p1 * D + lane * 32) = v0; *(u32x4*)(hbs + (size_t)p1 * D + lane * 32 + 16) = v1; }
        __syncthreads();
    }
}
__device__ __forceinline__ void ph_final(const Args& a) {
    const float* xs = (const float*)(a.ws + WS_XS); const bf16_t* ys = (const bf16_t*)(a.ws + WS_YS); const int* pos = (const int*)(a.ws + WS_POS); const float* topw = (const float*)(a.ws + WS_TOPW);
    const float* modl = (const float*)(a.ws + WS_MOD) + (size_t)5 * 12288; const float* gfin = a.in[33]; float* out = a.out;
    const int lane = threadIdx.x & 63, wid = threadIdx.x >> 6;
    const int* ctl = (const int*)(a.ws + WS_CTL); const int nsl = ctl[CT_MOES], trow0 = ctl[CT_TROW], trows = ctl[CT_NTILE] * 256 - trow0; const float* slab = (const float*)(a.ws + WS_SLAB);
    for (int row = blockIdx.x * 8 + wid; row < NLAT; row += gridDim.x * 8) {
        const float* g2 = modl + (size_t)tok_mod(row) * 12288 + 10240;
        const int p0 = pos[row * 2], p1 = pos[row * 2 + 1]; const float w0 = topw[row * 2], w1 = topw[row * 2 + 1];
        const bool t0 = nsl > 1 && p0 >= trow0, t1 = nsl > 1 && p1 >= trow0;
        f32x4 v[8]; float ss = 0.f;
#pragma unroll
        for (int i = 0; i < 8; ++i) { const int col = i * 256 + lane * 4;
            const f32x4 x = *(const f32x4*)(xs + (size_t)row * D + col), g = *(const f32x4*)(g2 + col); f32x4 ya, yb;
            if (t0) { ya = *(const f32x4*)(slab + (size_t)(p0 - trow0) * D + col); for (int sl = 1; sl < nsl; ++sl) ya += *(const f32x4*)(slab + ((size_t)sl * trows + (p0 - trow0)) * D + col); }
            else { const u32x2 q = *(const u32x2*)(ys + (size_t)p0 * D + col); ya = (f32x4){__uint_as_float(q.x << 16), __uint_as_float(q.x & 0xffff0000u), __uint_as_float(q.y << 16), __uint_as_float(q.y & 0xffff0000u)}; }
            if (t1) { yb = *(const f32x4*)(slab + (size_t)(p1 - trow0) * D + col); for (int sl = 1; sl < nsl; ++sl) yb += *(const f32x4*)(slab + ((size_t)sl * trows + (p1 - trow0)) * D + col); }
            else { const u32x2 q = *(const u32x2*)(ys + (size_t)p1 * D + col); yb = (f32x4){__uint_as_float(q.x << 16), __uint_as_float(q.x & 0xffff0000u), __uint_as_float(q.y << 16), __uint_as_float(q.y & 0xffff0000u)}; }
#pragma unroll
            for (int j = 0; j < 4; ++j) { v[i][j] = x[j] + g[j] * (w0 * ya[j] + w1 * yb[j]); ss += v[i][j] * v[i][j]; } }
        ss = wave_sum(ss); const float rstd = rsqrtf(ss * (1.0f / D) + EPS);
#pragma unroll
        for (int i = 0; i < 8; ++i) { const int col = i * 256 + lane * 4; const f32x4 g = *(const f32x4*)(gfin + col); f32x4 o;
#pragma unroll
            for (int j = 0; j < 4; ++j) o[j] = v[i][j] * rstd * g[j];
            *(f32x4*)(out + (size_t)row * D + col) = o; }
    }
}

typedef float f32x2_t __attribute__((ext_vector_type(2))); typedef __bf16 bf16x2_t __attribute__((ext_vector_type(2)));
__device__ __forceinline__ unsigned cvtpk(float lo, float hi) { f32x2_t v = {lo, hi}; bf16x2_t b = __builtin_convertvector(v, bf16x2_t); return __builtin_bit_cast(unsigned, b); }
#define MFMA32(a, b, c) __builtin_amdgcn_mfma_f32_32x32x16_bf16((a), (b), (c), 0, 0, 0)
constexpr int MLA_KP = 400, MLA_VP = 144, MLA_KB = 64 * MLA_KP, MLA_VB = 128 * MLA_VP, MLA_STAGE = MLA_KB + MLA_VB;
static_assert(2 * MLA_STAGE <= RING_BYTES, "MLA LDS");

__device__ __forceinline__ void ph_mla(const Args& a, bool with_ctx, unsigned char* lds) {
    const bf16_t* __restrict__ Q = (const bf16_t*)(a.ws + WS_Q); const bf16_t* __restrict__ KN = (const bf16_t*)(a.ws + WS_KN); const bf16_t* __restrict__ KPE = (const bf16_t*)(a.ws + WS_KPE);
    const bf16_t* __restrict__ VT = (const bf16_t*)(a.ws + WS_VT); bf16_t* __restrict__ mix = (bf16_t*)(a.ws + WS_MIX);
    int tid_ = threadIdx.x; asm volatile("" : "+v"(tid_));
    const int tid = tid_, lane = tid & 63, w = tid >> 6, qi = lane & 31, hh = lane >> 5;
    const int nunits = with_ctx ? 288 : 256;
    const float c = 0.07216878364870322f * 1.4426950408889634f;
    for (int unit = blockIdx.x; unit < nunits; unit += gridDim.x) {
        int h, b, q0tok, nt; bool ctxq;
        if (unit < 256) { h = unit & 7; b = unit >> 6; q0tok = b * L + ((unit >> 3) & 7) * 256; nt = 36; ctxq = false; }
        else { const int u2 = unit - 256; h = u2 & 7; b = u2 >> 3; q0tok = NLAT + b * C; nt = 4; ctxq = true; }
#define MLA_KTOK(t) (ctxq ? (NLAT + b * C + (t) * 64) : ((t) < 32 ? (b * L + (t) * 64) : (NLAT + b * C + ((t) - 32) * 64)))
        u32x4 r0, r1, r2, r3, r4;
#define MLA_ISSUE_K(t) do { const int kt0_ = MLA_KTOK(t); \
            r0 = *(const u32x4*)(KN + (size_t)(kt0_ + (tid >> 4)) * 1024 + h * 128 + (tid & 15) * 8); \
            r1 = *(const u32x4*)(KN + (size_t)(kt0_ + 32 + (tid >> 4)) * 1024 + h * 128 + (tid & 15) * 8); \
            r2 = *(const u32x4*)(KPE + (size_t)(kt0_ + (tid >> 3)) * 64 + (tid & 7) * 8); } while (0)
#define MLA_ISSUE_V(t) do { const int kt0_ = MLA_KTOK(t); \
            r3 = *(const u32x4*)(VT + (size_t)(h * 128 + (tid >> 3)) * NTOK + kt0_ + (tid & 7) * 8); \
            r4 = *(const u32x4*)(VT + (size_t)(h * 128 + 64 + (tid >> 3)) * NTOK + kt0_ + (tid & 7) * 8); } while (0)
#define MLA_ISSUE(t) do { MLA_ISSUE_K(t); MLA_ISSUE_V(t); } while (0)
#define MLA_COMMIT(buf) do { unsigned char* kb_ = lds + (buf) * MLA_STAGE; unsigned char* vb_ = kb_ + MLA_KB; \
            *(u32x4*)(kb_ + (tid >> 4) * MLA_KP + (tid & 15) * 16) = r0; \
            *(u32x4*)(kb_ + (32 + (tid >> 4)) * MLA_KP + (tid & 15) * 16) = r1; \
            *(u32x4*)(kb_ + (tid >> 3) * MLA_KP + 256 + (tid & 7) * 16) = r2; \
            const int g_ = (tid & 7) >> 1, e_ = tid & 1; \
            { u32x2 lo_, hi_; lo_.x = r3.x; lo_.y = r3.y; hi_.x = r3.z; hi_.y = r3.w; \
              *(u32x2*)(vb_ + (tid >> 3) * MLA_VP + g_ * 32 + e_ * 8) = lo_; *(u32x2*)(vb_ + (tid >> 3) * MLA_VP + g_ * 32 + 16 + e_ * 8) = hi_; } \
            { u32x2 lo_, hi_; lo_.x = r4.x; lo_.y = r4.y; hi_.x = r4.z; hi_.y = r4.w; \
              *(u32x2*)(vb_ + (64 + (tid >> 3)) * MLA_VP + g_ * 32 + e_ * 8) = lo_; *(u32x2*)(vb_ + (64 + (tid >> 3)) * MLA_VP + g_ * 32 + 16 + e_ * 8) = hi_; } } while (0)
        const int qtok = q0tok + w * 32 + qi;
        bf16x8 qf[12];
#pragma unroll
        for (int s = 0; s < 12; ++s) qf[s] = *(const bf16x8*)(Q + (size_t)qtok * QW + h * 192 + s * 16 + hh * 8);
        f32x16 o[4];
#pragma unroll
        for (int d = 0; d < 4; ++d)
#pragma unroll
            for (int r = 0; r < 16; ++r) o[d][r] = 0.f;
        float m = -1.0e30f, l = 0.f;
        MLA_ISSUE(0); MLA_COMMIT(0);
        __syncthreads();
        for (int t = 0; t < nt; ++t) {
            const unsigned char* kb = lds + (t & 1) * MLA_STAGE; const unsigned char* vb = kb + MLA_KB;
            f32x16 s0, s1;
#pragma unroll
            for (int r = 0; r < 16; ++r) { s0[r] = 0.f; s1[r] = 0.f; }
#pragma unroll
            for (int s = 0; s < 12; ++s) {
                const bf16x8 k0 = *(const bf16x8*)(kb + qi * MLA_KP + s * 32 + hh * 16);
                const bf16x8 k1 = *(const bf16x8*)(kb + (32 + qi) * MLA_KP + s * 32 + hh * 16);
                s0 = MFMA32(k0, qf[s], s0); s1 = MFMA32(k1, qf[s], s1);
                if ((s & 3) == 3) asm volatile("" ::: "memory");
            }
            if (t + 1 < nt) MLA_ISSUE(t + 1);
            float mx = fmaxf(s0[0], s1[0]);
#pragma unroll
            for (int r = 1; r < 16; ++r) mx = fmaxf(mx, fmaxf(s0[r], s1[r]));
            mx = fmaxf(mx, __shfl_xor(mx, 32));
            const float mnew = fmaxf(m, mx * c);
            const float alpha = __builtin_amdgcn_exp2f(m - mnew);
            m = mnew;
            float ps = 0.f;
#pragma unroll
            for (int r = 0; r < 16; ++r) { s0[r] = __builtin_amdgcn_exp2f(s0[r] * c - mnew); s1[r] = __builtin_amdgcn_exp2f(s1[r] * c - mnew); ps += s0[r] + s1[r]; }
            l = l * alpha + ps;
#pragma unroll
            for (int d = 0; d < 4; ++d)
#pragma unroll
                for (int r = 0; r < 16; ++r) o[d][r] *= alpha;
            bf16x8 pf[4];
            { u32x4 p;
              p.x = cvtpk(s0[0], s0[1]); p.y = cvtpk(s0[2], s0[3]); p.z = cvtpk(s0[4], s0[5]); p.w = cvtpk(s0[6], s0[7]); pf[0] = __builtin_bit_cast(bf16x8, p);
              p.x = cvtpk(s0[8], s0[9]); p.y = cvtpk(s0[10], s0[11]); p.z = cvtpk(s0[12], s0[13]); p.w = cvtpk(s0[14], s0[15]); pf[1] = __builtin_bit_cast(bf16x8, p);
              p.x = cvtpk(s1[0], s1[1]); p.y = cvtpk(s1[2], s1[3]); p.z = cvtpk(s1[4], s1[5]); p.w = cvtpk(s1[6], s1[7]); pf[2] = __builtin_bit_cast(bf16x8, p);
              p.x = cvtpk(s1[8], s1[9]); p.y = cvtpk(s1[10], s1[11]); p.z = cvtpk(s1[12], s1[13]); p.w = cvtpk(s1[14], s1[15]); pf[3] = __builtin_bit_cast(bf16x8, p); }
            asm volatile("" ::: "memory");
#pragma unroll
            for (int d = 0; d < 4; ++d) {
#pragma unroll
                for (int g = 0; g < 4; ++g) {
                    const bf16x8 vf = *(const bf16x8*)(vb + (d * 32 + qi) * MLA_VP + g * 32 + hh * 16);
                    o[d] = MFMA32(vf, pf[g], o[d]);
                }
                if (d & 1) asm volatile("" ::: "memory");
            }
            if (t + 1 < nt) MLA_COMMIT((t + 1) & 1);
            __syncthreads();
        }
        const float inv = 1.0f / (l + __shfl_xor(l, 32));
        bf16_t* op = mix + (size_t)qtok * D + h * 128 + 4 * hh;
#pragma unroll
        for (int d = 0; d < 4; ++d)
#pragma unroll
            for (int g = 0; g < 4; ++g) { u32x2 wv; wv.x = cvtpk(o[d][4 * g] * inv, o[d][4 * g + 1] * inv); wv.y = cvtpk(o[d][4 * g + 2] * inv, o[d][4 * g + 3] * inv);
                *(u32x2*)(op + d * 32 + 8 * g) = wv; }
#undef MLA_KTOK
#undef MLA_ISSUE
#undef MLA_ISSUE_K
#undef MLA_ISSUE_V
#undef MLA_COMMIT
    }
}

constexpr int HY_CS = 8224, HY_WS = 5136, HY_WOFF = 8 * HY_CS, HY_RBL = HY_WOFF + 4 * HY_WS;
static_assert(HY_RBL + 516 * 16 <= RING_BYTES, "hyena LDS");

__device__ __forceinline__ u32x4 hy_shift(const u32x4 a, const u32x4 b, int r) {
    switch (r) {
    case 0: return b;
    case 1: return (u32x4){__builtin_amdgcn_alignbyte(b.x, a.w, 2), __builtin_amdgcn_alignbyte(b.y, b.x, 2), __builtin_amdgcn_alignbyte(b.z, b.y, 2), __builtin_amdgcn_alignbyte(b.w, b.z, 2)};
    case 2: return (u32x4){a.w, b.x, b.y, b.z};
    case 3: return (u32x4){__builtin_amdgcn_alignbyte(a.w, a.z, 2), __builtin_amdgcn_alignbyte(b.x, a.w, 2), __builtin_amdgcn_alignbyte(b.y, b.x, 2), __builtin_amdgcn_alignbyte(b.z, b.y, 2)};
    case 4: return (u32x4){a.z, a.w, b.x, b.y};
    case 5: return (u32x4){__builtin_amdgcn_alignbyte(a.z, a.y, 2), __builtin_amdgcn_alignbyte(a.w, a.z, 2), __builtin_amdgcn_alignbyte(b.x, a.w, 2), __builtin_amdgcn_alignbyte(b.y, b.x, 2)};
    case 6: return (u32x4){a.y, a.z, a.w, b.x};
    default: return (u32x4){__builtin_amdgcn_alignbyte(a.y, a.x, 2), __builtin_amdgcn_alignbyte(a.z, a.y, 2), __builtin_amdgcn_alignbyte(a.w, a.z, 2), __builtin_amdgcn_alignbyte(b.x, a.w, 2)};
    }
}

__device__ __forceinline__ void ph_hyena(const Args& a, int l, unsigned char* lds) {
    const bf16_t* __restrict__ RB = (const bf16_t*)(a.ws + WS_FILTL) + (size_t)l * 512 * HY_RBROW;
    const bf16_t* __restrict__ wtl = (const bf16_t*)(a.ws + WS_WTL);
    int tid_ = threadIdx.x; asm volatile("" : "+v"(tid_));
    const int tid = tid_, lane = tid & 63, w = __builtin_amdgcn_readfirstlane(tid >> 6), i = lane & 31, hh = lane >> 5;
    for (int unit = blockIdx.x; unit < 512; unit += gridDim.x) {
        const int c = unit;
        for (int k = tid; k < 515; k += NTHR) { u32x4 v = (u32x4){0u, 0u, 0u, 0u}; if (k < 513) v = *(const u32x4*)(RB + (size_t)c * HY_RBROW + k * 8); *(u32x4*)(lds + HY_RBL + k * 16) = v; }
        for (int k = tid; k < 4 * 321; k += NTHR) { const int b = k / 321, sl = k - b * 321; u32x4 v = (u32x4){0u, 0u, 0u, 0u};
            if (sl >= 28 && sl < 284) v = *(const u32x4*)(wtl + ((size_t)b * 512 + c) * L + (sl - 28) * 8);
            *(u32x4*)(lds + HY_WOFF + b * HY_WS + sl * 16) = v; }
        __syncthreads();
        for (int qs = lane; qs < 511; qs += 64) {
            const u32x4 ca = *(const u32x4*)(lds + HY_RBL + qs * 16), cb = *(const u32x4*)(lds + HY_RBL + qs * 16 + 16);
            *(u32x4*)(lds + w * HY_CS + qs * 16) = hy_shift(ca, cb, w);
        }
        __syncthreads();
        f32x16 acc0, acc1;
#pragma unroll
        for (int r = 0; r < 16; ++r) { acc0[r] = 0.f; acc1[r] = 0.f; }
        const int Tl = i >> 2, b = i & 3;
        const unsigned char* ap = lds + (i & 7) * HY_CS + (hh - (i >> 3) + 255) * 16;
        const unsigned char* bp = lds + HY_WOFF + b * HY_WS + (224 + 16 * (2 * (8 * w + Tl)) + 8 * hh) * 2;
        const int d0 = 16 * w - 127;
#pragma unroll 2
        for (int dd = 0; dd < 142; dd += 2) {
            const int d = d0 + dd;
            const bf16x8 a0 = *(const bf16x8*)(ap - 32 * d), b0 = *(const bf16x8*)(bp - 32 * d);
            const bf16x8 a1 = *(const bf16x8*)(ap - 32 * (d + 1)), b1 = *(const bf16x8*)(bp - 32 * (d + 1));
            acc0 = MFMA32(a0, b0, acc0); acc1 = MFMA32(a1, b1, acc1);
        }
        bf16_t* yt = (bf16_t*)(a.ws + WS_YT) + ((size_t)b * 512 + c) * L + 32 * (8 * w + Tl) + 4 * hh;
#pragma unroll
        for (int g = 0; g < 4; ++g) { u32x2 wv; wv.x = cvtpk(acc0[4 * g] + acc1[4 * g], acc0[4 * g + 1] + acc1[4 * g + 1]); wv.y = cvtpk(acc0[4 * g + 2] + acc1[4 * g + 2], acc0[4 * g + 3] + acc1[4 * g + 3]);
            *(u32x2*)(yt + 8 * g) = wv; }
        __syncthreads();
    }
}

__device__ __forceinline__ void ph_hyena_fin(const Args& a, int l, bool with_ctx, unsigned char* lds) {
    const bf16_t* __restrict__ YT = (const bf16_t*)(a.ws + WS_YT); const bf16_t* __restrict__ wtl = (const bf16_t*)(a.ws + WS_WTL); const bf16_t* __restrict__ wtc = (const bf16_t*)(a.ws + WS_WTC);
    const bf16_t* __restrict__ x0 = (const bf16_t*)(a.ws + WS_X0); const float* skip = a.in[23] + l * 512; bf16_t* __restrict__ mix = (bf16_t*)(a.ws + WS_MIX);
    int tid_ = threadIdx.x; asm volatile("" : "+v"(tid_));
    const int tid = tid_;
    bf16_t* T = (bf16_t*)lds;
    constexpr int TP = 520;
    const int nunits = with_ctx ? 144 : 128;
    for (int unit = (int)gridDim.x - 1 - (int)blockIdx.x; unit < nunits; unit += gridDim.x) {
        const bool lat = unit < 128; const int b = lat ? (unit >> 5) : ((unit - 128) >> 2), t0 = lat ? (unit & 31) * 64 : ((unit - 128) & 3) * 64;
        const int Ls = lat ? L : C; const int tok0 = lat ? b * L + t0 : NLAT + b * C + t0;
        const bf16_t* yrow = (lat ? YT : YT + (size_t)NB * 512 * L) + ((size_t)b * 512 + tid) * Ls + t0;
        const bf16_t* wrow = (lat ? wtl : wtc) + ((size_t)b * 512 + tid) * Ls + t0;
        const float sk = skip[tid];
#pragma unroll
        for (int hf = 0; hf < 2; ++hf) {
            u32x4 yv[4], wv[4];
#pragma unroll
            for (int q = 0; q < 4; ++q) { yv[q] = *(const u32x4*)(yrow + hf * 32 + q * 8); wv[q] = *(const u32x4*)(wrow + hf * 32 + q * 8); }
#pragma unroll
            for (int q = 0; q < 4; ++q) { const unsigned yy[4] = {yv[q].x, yv[q].y, yv[q].z, yv[q].w}, ww[4] = {wv[q].x, wv[q].y, wv[q].z, wv[q].w};
#pragma unroll
                for (int d = 0; d < 4; ++d) { const int t = hf * 32 + q * 8 + 2 * d;
                    T[t * TP + tid] = f2bf(__uint_as_float(yy[d] << 16) + sk * __uint_as_float(ww[d] << 16));
                    T[(t + 1) * TP + tid] = f2bf(__uint_as_float(yy[d] & 0xffff0000u) + sk * __uint_as_float(ww[d] & 0xffff0000u)); } }
        }
        __syncthreads();
#pragma unroll
        for (int j = 0; j < 8; ++j) { const int o = tid + 512 * j, t = o >> 6, cc = (o & 63) * 8;
            const u32x4 tv = *(const u32x4*)(T + t * TP + cc), xv = *(const u32x4*)(x0 + (size_t)(tok0 + t) * 512 + cc);
            const unsigned tt[4] = {tv.x, tv.y, tv.z, tv.w}, xx[4] = {xv.x, xv.y, xv.z, xv.w}; unsigned oo[4];
#pragma unroll
            for (int d = 0; d < 4; ++d) oo[d] = cvtpk(__uint_as_float(tt[d] << 16) * __uint_as_float(xx[d] << 16), __uint_as_float(tt[d] & 0xffff0000u) * __uint_as_float(xx[d] & 0xffff0000u));
            *(u32x4*)(mix + (size_t)(tok0 + t) * D + 1024 + cc) = (u32x4){oo[0], oo[1], oo[2], oo[3]}; }
        __syncthreads();
    }
}

constexpr int SWA_P = 144, SWA_KB = 64 * SWA_P, SWA_STAGE = 2 * SWA_KB;
__device__ __forceinline__ void ph_swa(const Args& a, int l, bool with_ctx, unsigned char* lds) {
    const bf16_t* __restrict__ SQ = (const bf16_t*)(a.ws + WS_SQ); const bf16_t* __restrict__ SK = (const bf16_t*)(a.ws + WS_SK); const bf16_t* __restrict__ SVT = (const bf16_t*)(a.ws + WS_SV);
    const float* sink = a.in[24] + l * 8; bf16_t* __restrict__ mix = (bf16_t*)(a.ws + WS_MIX);
    int tid_ = threadIdx.x; asm volatile("" : "+v"(tid_));
    const int tid = tid_, lane = tid & 63, w = tid >> 6, qi = lane & 31, hh = lane >> 5;
    const int nunits = with_ctx ? 288 : 256;
    const float c = 0.125f * 1.4426950408889634f;
    for (int unit = blockIdx.x; unit < nunits; unit += gridDim.x) {
        int hk, b, p0, nloc, t0loc, q0tok; bool ctxq;
        if (unit < 256) { hk = unit & 1; b = (unit >> 1) & 3; p0 = (unit >> 3) * 64; ctxq = false; q0tok = b * L + p0;
            const int lo = p0 - 128 < 0 ? 0 : p0 - 128, hi = p0 + 192 > L ? L : p0 + 192; t0loc = lo; nloc = (hi - lo) >> 6; }
        else { const int u2 = unit - 256; hk = u2 & 1; b = (u2 >> 1) & 3; p0 = (u2 >> 3) * 64; ctxq = true; q0tok = NLAT + b * C + p0; t0loc = 0; nloc = 0; }
        const int nt = nloc + 4;
#define SWA_KTOK(t) ((t) < nloc ? (b * L + t0loc + (t) * 64) : (NLAT + b * C + ((t) - nloc) * 64))
        u32x4 r0, r1;
#define SWA_ISSUE(t) do { const int kt0_ = SWA_KTOK(t); \
            r0 = *(const u32x4*)(SK + (size_t)(kt0_ + (tid >> 3)) * 128 + hk * 64 + (tid & 7) * 8); \
            r1 = *(const u32x4*)(SVT + (size_t)(hk * 64 + (tid >> 3)) * NTOK + kt0_ + (tid & 7) * 8); } while (0)
#define SWA_COMMIT(buf) do { unsigned char* kb_ = lds + (buf) * SWA_STAGE; unsigned char* vb_ = kb_ + SWA_KB; \
            *(u32x4*)(kb_ + (tid >> 3) * SWA_P + (tid & 7) * 16) = r0; \
            const int g_ = (tid & 7) >> 1, e_ = tid & 1; u32x2 lo_, hi_; lo_.x = r1.x; lo_.y = r1.y; hi_.x = r1.z; hi_.y = r1.w; \
            *(u32x2*)(vb_ + (tid >> 3) * SWA_P + g_ * 32 + e_ * 8) = lo_; *(u32x2*)(vb_ + (tid >> 3) * SWA_P + g_ * 32 + 16 + e_ * 8) = hi_; } while (0)
        const int hq = hk * 4 + (w >> 1), qpos = p0 + (w & 1) * 32 + qi, qtok = q0tok + (w & 1) * 32 + qi;
        bf16x8 qf[4];
#pragma unroll
        for (int s = 0; s < 4; ++s) qf[s] = *(const bf16x8*)(SQ + (size_t)qtok * 512 + hq * 64 + s * 16 + hh * 8);
        f32x16 o[2];
#pragma unroll
        for (int d = 0; d < 2; ++d)
#pragma unroll
            for (int r = 0; r < 16; ++r) o[d][r] = 0.f;
        float m = sink[hq] * 1.4426950408889634f, lsum = hh == 0 ? 1.0f : 0.0f;
        SWA_ISSUE(0); SWA_COMMIT(0);
        __syncthreads();
        for (int t = 0; t < nt; ++t) {
            const unsigned char* kb = lds + (t & 1) * SWA_STAGE; const unsigned char* vb = kb + SWA_KB;
            f32x16 s0, s1;
#pragma unroll
            for (int r = 0; r < 16; ++r) { s0[r] = 0.f; s1[r] = 0.f; }
#pragma unroll
            for (int s = 0; s < 4; ++s) {
                const bf16x8 k0 = *(const bf16x8*)(kb + qi * SWA_P + s * 32 + hh * 16);
                const bf16x8 k1 = *(const bf16x8*)(kb + (32 + qi) * SWA_P + s * 32 + hh * 16);
                s0 = MFMA32(k0, qf[s], s0); s1 = MFMA32(k1, qf[s], s1);
            }
            if (t + 1 < nt) SWA_ISSUE(t + 1);
            if (t < nloc) {
                const int kbase = t0loc + t * 64 + 4 * hh - qpos;
#pragma unroll
                for (int r = 0; r < 16; ++r) { const int dlt = kbase + (r & 3) + 8 * (r >> 2);
                    if (dlt > 128 || dlt < -128) s0[r] = -1.0e30f;
                    if (dlt + 32 > 128 || dlt + 32 < -128) s1[r] = -1.0e30f; }
            }
            float mx = fmaxf(s0[0], s1[0]);
#pragma unroll
            for (int r = 1; r < 16; ++r) mx = fmaxf(mx, fmaxf(s0[r], s1[r]));
            mx = fmaxf(mx, __shfl_xor(mx, 32));
            const float mnew = fmaxf(m, mx * c);
            const float alpha = __builtin_amdgcn_exp2f(m - mnew);
            m = mnew;
            float ps = 0.f;
#pragma unroll
            for (int r = 0; r < 16; ++r) { s0[r] = __builtin_amdgcn_exp2f(s0[r] * c - mnew); s1[r] = __builtin_amdgcn_exp2f(s1[r] * c - mnew); ps += s0[r] + s1[r]; }
            lsum = lsum * alpha + ps;
#pragma unroll
            for (int d = 0; d < 2; ++d)
#pragma unroll
                for (int r = 0; r < 16; ++r) o[d][r] *= alpha;
            bf16x8 pf[4];
            { u32x4 p;
              p.x = cvtpk(s0[0], s0[1]); p.y = cvtpk(s0[2], s0[3]); p.z = cvtpk(s0[4], s0[5]); p.w = cvtpk(s0[6], s0[7]); pf[0] = __builtin_bit_cast(bf16x8, p);
              p.x = cvtpk(s0[8], s0[9]); p.y = cvtpk(s0[10], s0[11]); p.z = cvtpk(s0[12], s0[13]); p.w = cvtpk(s0[14], s0[15]); pf[1] = __builtin_bit_cast(bf16x8, p);
              p.x = cvtpk(s1[0], s1[1]); p.y = cvtpk(s1[2], s1[3]); p.z = cvtpk(s1[4], s1[5]); p.w = cvtpk(s1[6], s1[7]); pf[2] = __builtin_bit_cast(bf16x8, p);
              p.x = cvtpk(s1[8], s1[9]); p.y = cvtpk(s1[10], s1[11]); p.z = cvtpk(s1[12], s1[13]); p.w = cvtpk(s1[14], s1[15]); pf[3] = __builtin_bit_cast(bf16x8, p); }
#pragma unroll
            for (int d = 0; d < 2; ++d)
#pragma unroll
                for (int g = 0; g < 4; ++g) {
                    const bf16x8 vf = *(const bf16x8*)(vb + (d * 32 + qi) * SWA_P + g * 32 + hh * 16);
                    o[d] = MFMA32(vf, pf[g], o[d]);
                }
            if (t + 1 < nt) SWA_COMMIT((t + 1) & 1);
            __syncthreads();
        }
        const float inv = 1.0f / (lsum + __shfl_xor(lsum, 32));
        bf16_t* op = mix + (size_t)qtok * D + 1536 + hq * 64 + 4 * hh;
#pragma unroll
        for (int d = 0; d < 2; ++d)
#pragma unroll
            for (int g = 0; g < 4; ++g) { u32x2 wv; wv.x = cvtpk(o[d][4 * g] * inv, o[d][4 * g + 1] * inv); wv.y = cvtpk(o[d][4 * g + 2] * inv, o[d][4 * g + 3] * inv);
                *(u32x2*)(op + d * 32 + 8 * g) = wv; }
#undef SWA_KTOK
#undef SWA_ISSUE
#undef SWA_COMMIT
    }
}


constexpr int NPHASES = 22;
#define GEMM_CALL(EPI, SCHED, g, S, E) pg8::gemm_phase<EPI, SCHED, true, true>((PG8_LAS unsigned char*)lds, g, S, E)
#define GEMM_CALL8(EPI, SCHED, g, S, E) pg8::gemm_phase<EPI, SCHED, true, true, true>((PG8_LAS unsigned char*)lds, g, S, E)

template <int LYR>
__device__ __forceinline__ void layer_phases(const Args& a, unsigned char* lds, const XcdBarrier& bar, int lo, int hi) {
#define IN(k) (lo <= (k) && (k) < hi)
#define REPS(k) for (int rep_ = 0; rep_ <= (int)((PROBE_MASK >> (k)) & 1u); ++rep_)
#if MK_PER_PHASE
#define SEAM(k) do { } while (0)
#else
#define SEAM(k) do { if (IN(k) && IN((k) + 1)) xcd_barrier(bar); } while (0)
#endif
    constexpr int P0 = 1 + LYR * 9;
    constexpr bool LAST = (LYR == 1);
    constexpr int S_WO = pg8::split_S((LAST ? NLAT : NTOK) / 256 * (D / 256), D / 64, 256);
    constexpr int S_WO0 = pg8::split_S(NTOK / 256 * (D / 256), D / 64, 256);
    constexpr int S_DN0 = pg8::split_S(NTOK / 256 * (D / 256), (FP8_DENSE || FP8_DOWN) ? DFF / 128 : DFF / 64, 256);
    constexpr int S_DN = pg8::split_S(NTOK / 256 * (D / 256), (FP8_DENSE || FP8_DOWN) ? DFF / 128 : DFF / 64, 256);
    const int G = gridDim.x, bid = blockIdx.x;
    unsigned char* ws = a.ws;
    const float* modl = (const float*)(ws + WS_MOD) + (size_t)LYR * 5 * 12288;
    float* xs = (float*)(ws + WS_XS);
    const int nq = LAST ? NLAT : NTOK;
    if (IN(P0 + 0)) REPS(P0 + 0) {
        if (LYR == 0) ph_normmod<false, true>(a.in[0], a.in[2], a.in[6], modl, 0, 2048, (bf16_t*)(ws + WS_HA), NTOK, xs, nullptr, nullptr, nullptr);
        else ph_normmod<false, false, false, S_DN0>(xs, xs + (size_t)NLAT * D, a.in[6] + D, modl, 0, 2048, (bf16_t*)(ws + WS_HA), NTOK, nullptr, nullptr, nullptr, nullptr,
                                                    (const float*)(ws + WS_SLAB), (const float*)(ws + WS_MOD) + (size_t)4 * 12288 + 10240);
    }
    SEAM(P0 + 0);
    if (IN(P0 + 1)) REPS(P0 + 1) {
        pg8::Gemm g{(const bf16_t*)(ws + WS_HA), (const bf16_t*)(ws + WS_WIN + (size_t)LYR * UW * D * 2), NTOK, UW, D};
        pg8::EpiStore E{(bf16_t*)(ws + WS_U), UW};
        if constexpr (LAST) { pg8::WinLastOrder S; S.init(G, bid, D); GEMM_CALL(pg8::EpiStore, pg8::WinLastOrder, g, S, E); }
        else { pg8::StaticOrder S; S.init(NTOK, UW, G, bid, D); GEMM_CALL(pg8::EpiStore, pg8::StaticOrder, g, S, E); }
        conv_fill(a, (float*)lds, LYR * 6 + 0);
    }
    SEAM(P0 + 1);
    if (IN(P0 + 2)) REPS(P0 + 2) ph_mid(a, LYR);
    SEAM(P0 + 2);
    if (IN(P0 + 3)) REPS(P0 + 3) {
        SUBREP(0) {
        { pg8::Gemm g{(const bf16_t*)(ws + WS_CQN), (const bf16_t*)(ws + WS_WQ + (size_t)LYR * QW * 768 * 2), nq, QW, 768};
          pg8::StaticOrder S; S.init(nq, QW, G, bid, 768); pg8::EpiQ E{(bf16_t*)(ws + WS_Q), (const float*)(ws + WS_ROPE), (const float*)(ws + WS_ROPE) + 2048 * 32};
          GEMM_CALL(pg8::EpiQ, pg8::StaticOrder, g, S, E); }
        __syncthreads();
        { pg8::Gemm g{(const bf16_t*)(ws + WS_CKVN), (const bf16_t*)(ws + WS_WKV + (size_t)LYR * KVW * 512 * 2), NTOK, 1024, 512};
          pg8::StaticOrder S; S.init(NTOK, 1024, G, bid, 512); pg8::EpiStore E{(bf16_t*)(ws + WS_KN), 1024};
          GEMM_CALL(pg8::EpiStore, pg8::StaticOrder, g, S, E); }
        __syncthreads();
        { pg8::Gemm g{(const bf16_t*)(ws + WS_WKV + (size_t)LYR * KVW * 512 * 2 + (size_t)1024 * 512 * 2), (const bf16_t*)(ws + WS_CKVN), 1024, NTOK, 512};
          pg8::StaticOrder S; S.init(1024, NTOK, 108, bid >= 216 ? bid - 216 : (bid >= 144 ? bid - 108 : (1 << 24)), 512); pg8::EpiStore E{(bf16_t*)(ws + WS_VT), NTOK};
          GEMM_CALL(pg8::EpiStore, pg8::StaticOrder, g, S, E); }
        __syncthreads();
        }
        SUBREP(1) ph_hyena(a, LYR, lds);
        SUBREP(3) if (!LAST) ph_hyena_naive<C>(a, LYR, (float*)lds);
        SUBREP(2) ph_swa(a, LYR, !LAST, lds);
        conv_fill(a, (float*)lds, LYR * 6 + 1);
    }
    SEAM(P0 + 3);
    if (IN(P0 + 4)) REPS(P0 + 4) { ph_hyena_fin(a, LYR, !LAST, lds); ph_mla(a, !LAST, lds); conv_fill(a, (float*)lds, LYR * 6 + 2); }
    SEAM(P0 + 4);
    if (IN(P0 + 5)) REPS(P0 + 5) {
        pg8::Gemm g{(const bf16_t*)(ws + WS_MIX), (const bf16_t*)(ws + WS_WOUT + (size_t)LYR * D * D * 2), nq, D, D};
        pg8::SplitOrder S; S.init(nq / 256, D / 256, G, bid, D, S_WO);
        const int trow0 = S.nfull / S.nN * 256; pg8::EpiResid E{rep_ ? (float*)(ws + WS_ACT) : xs, modl + 4096, (float*)(ws + WS_SLAB), trow0, nq - trow0, 1.0f};
        GEMM_CALL(pg8::EpiResid, pg8::SplitOrder, g, S, E);
        conv_fill(a, (float*)lds, LYR * 6 + 3);
    }
    SEAM(P0 + 5);
    if (!LAST) {
#if !FP8_DENSE
        if (IN(P0 + 6)) { ph_normmod<false, true, false, S_WO0>(xs, xs + (size_t)NLAT * D, a.in[7], modl, 6144, 8192, (bf16_t*)(ws + WS_HA), NTOK, xs, nullptr, nullptr, nullptr, (const float*)(ws + WS_SLAB), modl + (size_t)4 * 12288 + 4096);
            conv_finish(a, (float*)lds, CONV_DENSE_END); }
        SEAM(P0 + 6);
        if (IN(P0 + 7)) REPS(P0 + 7) {
            pg8::Gemm g{(const bf16_t*)(ws + WS_HA), (const bf16_t*)(ws + WS_WGU), NTOK, 2 * DFF, D};
            pg8::StaticOrder S; S.init(NTOK, 2 * DFF, G, bid, D);
#if FP8_DOWN
            pg8::EpiSwiGLU8 E{(unsigned char*)(ws + WS_ACT), DFF, 1.0f, ASCALE};
            GEMM_CALL(pg8::EpiSwiGLU8, pg8::StaticOrder, g, S, E);
#else
            pg8::EpiSwiGLU E{(bf16_t*)(ws + WS_ACT), DFF};
            GEMM_CALL(pg8::EpiSwiGLU, pg8::StaticOrder, g, S, E);
#endif
            conv_fill(a, (float*)lds, 4);
        }
        SEAM(P0 + 7);
        if (IN(P0 + 8)) REPS(P0 + 8) {
#if FP8_DOWN
            pg8::Gemm g{(const bf16_t*)(ws + WS_ACT), (const bf16_t*)(ws + WS_WDN), NTOK, D, DFF / 2};
            pg8::SplitOrder S; S.init(NTOK / 256, D / 256, G, bid, DFF / 2, S_DN);
            const int trow0 = S.nfull / S.nN * 256; pg8::EpiResid E{rep_ ? (float*)(ws + WS_YS) : xs, modl + 10240, (float*)(ws + WS_SLAB), trow0, NTOK - trow0, 1.0f / (ASCALE * WSCALE)};
            GEMM_CALL8(pg8::EpiResid, pg8::SplitOrder, g, S, E);
#else
            pg8::Gemm g{(const bf16_t*)(ws + WS_ACT), (const bf16_t*)(ws + WS_WDN), NTOK, D, DFF};
            pg8::SplitOrder S; S.init(NTOK / 256, D / 256, G, bid, DFF, S_DN);
            const int trow0 = S.nfull / S.nN * 256; pg8::EpiResid E{rep_ ? (float*)(ws + WS_YS) : xs, modl + 10240, (float*)(ws + WS_SLAB), trow0, NTOK - trow0, 1.0f};
            GEMM_CALL(pg8::EpiResid, pg8::SplitOrder, g, S, E);
#endif
            conv_fill(a, (float*)lds, 5);
        }
#else
        if (IN(P0 + 6)) { ph_normmod<false, true, true, S_WO0>(xs, xs + (size_t)NLAT * D, a.in[7], modl, 6144, 8192, (bf16_t*)(ws + WS_HA), NTOK, xs, nullptr, nullptr, nullptr, (const float*)(ws + WS_SLAB), modl + (size_t)4 * 12288 + 4096);
            conv_finish(a, (float*)lds, CONV_DENSE_END); }
        SEAM(P0 + 6);
        if (IN(P0 + 7)) REPS(P0 + 7) {
            pg8::Gemm g{(const bf16_t*)(ws + WS_HA), (const bf16_t*)(ws + WS_WGU), NTOK, 2 * DFF, D / 2};
            pg8::StaticOrder S; S.init(NTOK, 2 * DFF, G, bid, D / 2); pg8::EpiSwiGLU8 E{(unsigned char*)(ws + WS_ACT), DFF, 1.0f / (ASCALE * WSCALE), ASCALE};
            GEMM_CALL8(pg8::EpiSwiGLU8, pg8::StaticOrder, g, S, E);
            conv_fill(a, (float*)lds, 4);
        }
        SEAM(P0 + 7);
        if (IN(P0 + 8)) REPS(P0 + 8) {
            pg8::Gemm g{(const bf16_t*)(ws + WS_ACT), (const bf16_t*)(ws + WS_WDN), NTOK, D, DFF / 2};
            pg8::SplitOrder S; S.init(NTOK / 256, D / 256, G, bid, DFF / 2, S_DN);
            const int trow0 = S.nfull / S.nN * 256; pg8::EpiResid E{rep_ ? (float*)(ws + WS_YS) : xs, modl + 10240, (float*)(ws + WS_SLAB), trow0, NTOK - trow0, 1.0f / (ASCALE * WSCALE)};
            GEMM_CALL8(pg8::EpiResid, pg8::SplitOrder, g, S, E);
            conv_fill(a, (float*)lds, 5);
        }
#endif
        SEAM(P0 + 8);
    } else {
        if (IN(P0 + 6)) REPS(P0 + 6) ph_normmod<true, false, true>(xs, xs + (size_t)NLAT * D, a.in[7] + D, modl, 6144, 8192, (bf16_t*)(ws + WS_HA), NLAT, nullptr, a.in[29], (int*)(ws + WS_TOPI), (float*)(ws + WS_TOPW));
        SEAM(P0 + 6);
        if (IN(P0 + 7)) REPS(P0 + 7) { ph_route_gather(a, (int*)lds); conv_finish(a, (float*)lds, NCONV); }
        SEAM(P0 + 7);
        if (IN(P0 + 9)) REPS(P0 + 9) {
            pg8::Gemm g{(const bf16_t*)(ws + WS_HBS), (const bf16_t*)(ws + WS_MGU), MOE_ROWS, 2 * DFE, D / 2};
            pg8::MoeOrder S; S.init((const int*)(ws + WS_CTL), 2 * DFE / 256, G, bid, (size_t)2 * DFE * D, D / 2); pg8::EpiSwiGLU8 E{(unsigned char*)(ws + WS_ACT), DFE, 1.0f / (ASCALE * WSCALE), ASCALE};
            GEMM_CALL8(pg8::EpiSwiGLU8, pg8::MoeOrder, g, S, E);
        }
        SEAM(P0 + 9);
        if (IN(P0 + 10)) REPS(P0 + 10) {
            pg8::Gemm g{(const bf16_t*)(ws + WS_ACT), (const bf16_t*)(ws + WS_MDN), MOE_ROWS, D, DFE / 2};
            pg8::SplitOrder S; S.init_moe((const int*)(ws + WS_CTL), D / 256, G, bid, DFE / 2, (size_t)D * DFE);
            const int trow0 = S.nfull / S.nN * 256; pg8::EpiYs E{(bf16_t*)(ws + WS_YS), (float*)(ws + WS_SLAB), trow0, S.nM * 256 - trow0, 1.0f / (ASCALE * WSCALE)};
            GEMM_CALL8(pg8::EpiYs, pg8::SplitOrder, g, S, E);
        }
        SEAM(P0 + 10);
        if (IN(P0 + 11)) REPS(P0 + 11) ph_final(a);
    }
#undef IN
#undef SEAM
#undef REPS
}

__global__ void __launch_bounds__(NTHR, 2) mk_fwd(Args a) {
    extern __shared__ __attribute__((aligned(16))) unsigned char lds[];
    const int tid = threadIdx.x;
    for (int u = tid; u < (LDS_BYTES - LDSCTL_OFF) / 4; u += NTHR) ((unsigned*)(lds + LDSCTL_OFF))[u] = 0u;
    __syncthreads();
    XcdBarrier bar; bar.bar = (unsigned*)(a.ws + WS_CTL) + CW_BAR; bar.x = 0; bar.st = nullptr;
#if !MK_PER_PHASE
    bar = xcd_barrier_post((unsigned*)(a.ws + WS_CTL) + CW_BAR, (volatile LAS unsigned*)(lds + LDSCTL_OFF + 32));
#endif
    const int lo = a.ph_lo, hi = a.ph_hi;
    if (lo <= 0 && 0 < hi) {
        for (int rep_ = 0; rep_ <= (int)(PROBE_MASK & 1u); ++rep_) { ph_prologue(a, (float*)lds); __syncthreads(); }
#if !MK_PER_PHASE
        if (1 < hi) xcd_barrier(bar);
#endif
    }
    layer_phases<0>(a, lds, bar, lo, hi);
    layer_phases<1>(a, lds, bar, lo, hi);
}

extern "C" void kernel_launch(void* const* d_in, const int* in_sizes, int n_in, void* d_out, int out_size, void* d_ws, size_t ws_size, hipStream_t stream) {
    (void)in_sizes; (void)out_size;
    static int grid = 0;
    if (grid == 0) {
        if (n_in != 34 || ws_size < WS_END) { fprintf(stderr, "kernel_launch: need 34 inputs and >= %zu bytes of workspace (got %d, %zu)\n", (size_t)WS_END, n_in, ws_size); grid = -1; return; }
        int dev = 0, cus = 0, per_cu = 0;
        if (hipGetDevice(&dev) != hipSuccess || hipDeviceGetAttribute(&cus, hipDeviceAttributeMultiprocessorCount, dev) != hipSuccess) { grid = -1; return; }
        if (hipFuncSetAttribute((const void*)mk_fwd, hipFuncAttributeMaxDynamicSharedMemorySize, LDS_BYTES) != hipSuccess) { fprintf(stderr, "kernel_launch: hipFuncSetAttribute failed\n"); grid = -1; return; }
        if (hipOccupancyMaxActiveBlocksPerMultiprocessor(&per_cu, (const void*)mk_fwd, NTHR, LDS_BYTES) != hipSuccess || per_cu < 1) { fprintf(stderr, "kernel_launch: occupancy query says %d blocks per CU\n", per_cu); }
        (void)hipGetLastError();
        grid = cus;
    }
    if (grid < 0) return;
    if (hipMemsetAsync((char*)d_ws + WS_CTL, 0, CTL_ZERO_BYTES, stream) != hipSuccess) return;
    Args a{};
    for (int i = 0; i < 34; ++i) a.in[i] = (const float*)d_in[i];
    a.out = (float*)d_out; a.ws = (unsigned char*)d_ws;
#if MK_PER_PHASE
    for (int p = 0; p < NPHASES; ++p) { a.ph_lo = p; a.ph_hi = p + 1; hipLaunchKernelGGL(mk_fwd, dim3(grid), dim3(NTHR), LDS_BYTES, stream, a); }
#else
    a.ph_lo = 0; a.ph_hi = NPHASES;
    hipLaunchKernelGGL(mk_fwd, dim3(grid), dim3(NTHR), LDS_BYTES, stream, a);
#endif
}
```

```cpp
#include <hip/hip_runtime.h>
#include <stdint.h>
#include <stdio.h>

#ifndef FP8_DENSE
#define FP8_DENSE 0
#endif
#ifndef FP8_DOWN
#define FP8_DOWN 1
#endif
#ifndef I8_WIN
#define I8_WIN 0
#endif
#ifndef I8_GU
#define I8_GU 1
#endif
#ifndef I8_GEMM
#define I8_GEMM (I8_WIN || I8_GU)
#endif
#ifndef CONV_FILL
#define CONV_FILL 0
#endif
#ifndef PROBE_MASK
#define PROBE_MASK 0u
#endif
#ifndef PROBE_SUB
#define PROBE_SUB 0u
#endif
#ifndef MK_PER_PHASE
#define MK_PER_PHASE 0
#endif

typedef unsigned short bf16_t;
typedef float f32x4 __attribute__((ext_vector_type(4)));
typedef float f32x16 __attribute__((ext_vector_type(16)));
typedef unsigned u32x4 __attribute__((ext_vector_type(4)));
typedef unsigned u32x2 __attribute__((ext_vector_type(2)));
typedef short bf16x8 __attribute__((ext_vector_type(8)));

constexpr int D = 2048, NB = 4, L = 2048, C = 256, NLAT = NB * L, NCTX = NB * C, NTOK = NLAT + NCTX;
constexpr int UW = 3840;
constexpr int O_CQ = 0, O_CKV = 768, O_KPE = 1280, O_HY = 1344, O_SQ = 2880, O_SK = 3392, O_SV = 3520, INW = 3648;
constexpr int QW = 1536, KVW = 2048, DFF = 5632, DFE = 7168, NE = 8;
constexpr int MOE_ROWS = 18432;
constexpr float EPS = 1e-6f;
constexpr int NTHR = 512;
constexpr int HY_RBROW = 4112;

__device__ __forceinline__ float bf2f(bf16_t h) { return __uint_as_float(((unsigned)h) << 16); }
__device__ __forceinline__ bf16_t f2bf(float f) { unsigned u = __float_as_uint(f); u += 0x7fffu + ((u >> 16) & 1u); return (bf16_t)(u >> 16); }
__device__ __forceinline__ float wave_sum(float v) { for (int o = 32; o > 0; o >>= 1) v += __shfl_xor(v, o); return v; }
__device__ __forceinline__ float wave_max(float v) { for (int o = 32; o > 0; o >>= 1) v = fmaxf(v, __shfl_xor(v, o)); return v; }
__device__ __forceinline__ float silu(float x) { return x / (1.0f + __expf(-x)); }
__device__ __forceinline__ int tok_mod(int tok) { return tok < NLAT ? (tok >> 11) : 4; }

constexpr size_t al(size_t x) { return (x + 255) & ~(size_t)255; }
constexpr size_t WS_CTL = 0, CTL_ZERO_BYTES = 65536;
constexpr size_t WS_MOD = 65536;
constexpr size_t WS_ROPE = WS_MOD + al((size_t)2 * 5 * 12288 * 4);
constexpr size_t WS_FILTL = WS_ROPE + al((size_t)2 * 2048 * 32 * 4);
constexpr size_t WS_FILTC = WS_FILTL + al((size_t)2 * 512 * 4096 * 4);
constexpr size_t WS_WIN = WS_FILTC + al((size_t)2 * 512 * 512 * 4);
constexpr size_t WS_WQ = WS_WIN + al((size_t)2 * UW * D * 2);
constexpr size_t WS_WKV = WS_WQ + al((size_t)2 * QW * 768 * 2);
constexpr size_t WS_WOUT = WS_WKV + al((size_t)2 * KVW * 512 * 2);
constexpr size_t WS_WGU = WS_WOUT + al((size_t)2 * D * D * 2);
constexpr size_t WS_WDN = WS_WGU + al((size_t)2 * DFF * D * 2);
constexpr size_t WS_MGU = WS_WDN + al((size_t)D * DFF * 2);
constexpr size_t WS_MDN = WS_MGU + al((size_t)NE * 2 * DFE * D * 2);
constexpr size_t WS_HA = WS_MDN + al((size_t)NE * D * DFE * 2);
constexpr size_t WS_U = WS_HA + al((size_t)NTOK * D * 2);
constexpr size_t WS_CQN = WS_U + al((size_t)NTOK * UW * 2);
constexpr size_t WS_CKVN = WS_CQN + al((size_t)NTOK * 768 * 2);
constexpr size_t WS_KPE = WS_CKVN + al((size_t)NTOK * 512 * 2);
constexpr size_t WS_X0 = WS_KPE + al((size_t)NTOK * 64 * 2);
constexpr size_t WS_WTL = WS_X0 + al((size_t)NTOK * 512 * 2);
constexpr size_t WS_WTC = WS_WTL + al((size_t)NB * 512 * L * 2);
constexpr size_t WS_SQ = WS_WTC + al((size_t)NB * 512 * C * 2);
constexpr size_t WS_SK = WS_SQ + al((size_t)NTOK * 512 * 2);
constexpr size_t WS_SV = WS_SK + al((size_t)NTOK * 128 * 2);
constexpr size_t WS_Q = WS_SV + al((size_t)NTOK * 128 * 2);
constexpr size_t WS_KV = WS_Q + al((size_t)NTOK * QW * 2);
constexpr size_t WS_KN = WS_KV;
constexpr size_t WS_VT = WS_KV + (size_t)NTOK * 1024 * 2;
constexpr size_t WS_MIX = WS_KV + al((size_t)NTOK * KVW * 2);
constexpr size_t WS_MIXEND = WS_MIX + al((size_t)NTOK * D * 2);
constexpr size_t WS_YS = WS_U;
static_assert(WS_YS + (size_t)MOE_ROWS * D * 4 <= WS_MIXEND, "ys overlay");
constexpr size_t WS_XS = WS_MIXEND;
constexpr size_t WS_ACT = WS_XS + al((size_t)NTOK * D * 4);
constexpr size_t WS_HBS = WS_ACT + al((size_t)MOE_ROWS * DFE * 2);
constexpr size_t WS_TOPI = WS_HBS + al((size_t)MOE_ROWS * D * 2);
constexpr size_t WS_TOPW = WS_TOPI + al((size_t)NLAT * 2 * 4);
constexpr size_t WS_POS = WS_TOPW + al((size_t)NLAT * 2 * 4);
constexpr size_t WS_SRC = WS_POS + al((size_t)NLAT * 2 * 4);
constexpr size_t WS_SLAB = WS_SRC + al((size_t)MOE_ROWS * 4);
constexpr size_t WS_YT = WS_SLAB + ((size_t)64 << 20);
constexpr size_t WS_RSC = WS_YT + al((size_t)NB * 512 * (L + C) * 2);
constexpr size_t WS_END = WS_RSC + al((size_t)NTOK * 4);
constexpr int CT_EOFF = 1024, CT_EPAD = 1040, CT_NTILE = 1056, CT_MOES = 1057, CT_TROW = 1058, CT_WSC = 1088, CT_AMAXDONE = 1100;
constexpr int CW_BAR = 4096;

constexpr int RING_BYTES = 131072, LDS_BYTES = 147456, LDSCTL_OFF = LDS_BYTES - 256;

namespace pg8 {
#define PG8_LAS __attribute__((address_space(3)))
typedef unsigned short bf16_t;
typedef short bf16x8 __attribute__((ext_vector_type(8)));
typedef float f32x4 __attribute__((ext_vector_type(4)));
typedef unsigned u32x4 __attribute__((ext_vector_type(4)));
constexpr int BM = 256, BK = 64, HALF = 128, HTB = HALF * BK * 2  , STAGE_BYTES = 8 * HTB, NXCD = 8, WGM = 8;

__host__ __device__ __forceinline__ int lds_byte(int r, int c) { const int st = (r >> 4) * 2 + (c >> 5), rr = r & 15, cc = c & 31, ob = rr * 64 + cc * 2; return st * 1024 + (ob ^ (((ob >> 9) & 1) << 5)); }
__host__ __device__ __forceinline__ void stage_rc(int b, int& R, int& C) { const int st = b / 1024, sb = b % 1024, swz = sb ^ (((sb >> 9) & 1) << 5); R = (st >> 1) * 16 + swz / 64; C = (st & 1) * 32 + (swz % 64) / 2; }
__host__ __device__ __forceinline__ int perm32(int rho) { const int n = rho >> 4, i = rho & 15; return 8 * (i >> 2) + 4 * n + (i & 3); }

struct Unit { int pm, pn, kt0, nkt, slab; };
struct Gemm { const bf16_t* A; const bf16_t* Bt; int M, N, K; };

struct StaticOrder {
    int nM, nN, nwg, G, c;
    int nkt;
    __host__ __device__ void init(int M, int N, int G_, int c_, int K) { nM = M / BM; nN = N / BM; nwg = nM * nN; G = G_; c = c_; nkt = K / BK; }
    __host__ __device__ bool next(int i, Unit& u) const {
        const long L = (long)i * G + c; if (L >= nwg) return false;
        int wgid = (int)L; { const int q = nwg / NXCD, r = nwg % NXCD, xcd = wgid % NXCD, off = wgid / NXCD; wgid = (xcd < r ? xcd * (q + 1) : r * (q + 1) + (xcd - r) * q) + off; }
        const int nig = WGM * nN, gid = wgid / nig, fm = gid * WGM, gsz = (nM - fm) < WGM ? (nM - fm) : WGM;
        u.pm = fm + ((wgid % nig) % gsz); u.pn = (wgid % nig) / gsz; u.kt0 = 0; u.nkt = nkt; u.slab = -1; return true;
    }
    __device__ __forceinline__ size_t bt_off(const Unit&) const { return 0; }
    __device__ __forceinline__ void a_ready(const Unit&) const {}
    __device__ __forceinline__ void done(const Unit&) const {}
};

__device__ __forceinline__ unsigned cvt_pk_bf16(float lo, float hi) { unsigned r; asm volatile("v_cvt_pk_bf16_f32 %0, %1, %2" : "=v"(r) : "v"(lo), "v"(hi)); return r; }
typedef float f32x2 __attribute__((ext_vector_type(2)));
typedef int v8i_t __attribute__((ext_vector_type(8))); typedef int v4i_t __attribute__((ext_vector_type(4)));
template <bool F8> struct Frag;
template <> struct Frag<false> { bf16x8 h[2]; __device__ __forceinline__ void set0(bf16x8 x) { h[0] = x; } __device__ __forceinline__ void set1(bf16x8 x) { h[1] = x; } };
template <> struct Frag<true> { v8i_t v; __device__ __forceinline__ void set0(bf16x8 x) { v.lo = __builtin_bit_cast(v4i_t, x); } __device__ __forceinline__ void set1(bf16x8 x) { v.hi = __builtin_bit_cast(v4i_t, x); } };
template <class Epi, class Sched, bool ALIGN_EPI = false, bool SP2 = false, int DT = 0>
__device__ __forceinline__ void gemm_phase(PG8_LAS unsigned char* lds, const Gemm g, const Sched& S, const Epi& E) {
    int tid_ = threadIdx.x; asm volatile("" : "+v"(tid_));
    const int tid = tid_, wid = __builtin_amdgcn_readfirstlane(tid >> 6), lane = tid & 63, wr = wid >> 2, wc = wid & 3, fr = lane & 15, fq = lane >> 4;
    const int K = g.K;
    unsigned voffA[2], voffB[2];
#pragma unroll
    for (int i = 0; i < 2; ++i) { int R, C; stage_rc(tid * 16 + i * 8192, R, C); const int Rb = Epi::PERM ? ((R & ~31) + perm32(R & 31)) : R;
        voffA[i] = (unsigned)(R * K + C) * 2u; voffB[i] = (unsigned)(Rb * K + C) * 2u; }
    const size_t kstep = (size_t)(BK * 2);
    const size_t hstep = (size_t)HALF * K * 2;
    const size_t tstep = 2 * hstep;
    const unsigned ldsw = (unsigned)wid * 1024u;
    const int aoff = lds_byte(wr * 64 + fr, fq * 8), boff = lds_byte(wc * 32 + fr, fq * 8);
#define PG8_SA(b, h) (((b) * 2 + (h)) * HTB)
#define PG8_SB(b, h) ((4 + (b) * 2 + (h)) * HTB)
#define PG8_STAGE(bufoff, gbase, voff) do { _Pragma("unroll") for (int _i = 0; _i < 2; ++_i) \
        __builtin_amdgcn_global_load_lds((const unsigned*)((const char*)(gbase) + (voff)[_i]), (PG8_LAS unsigned*)(lds + (bufoff) + ldsw + _i * 8192), 16, 0, 0); } while (0)
#define PG8_LDA(dst, b, h) do { _Pragma("unroll") for (int m = 0; m < 4; ++m) { dst[m].set0(*(const PG8_LAS bf16x8*)(lds + PG8_SA(b, h) + aoff + m * 2048)); dst[m].set1(*(const PG8_LAS bf16x8*)(lds + PG8_SA(b, h) + aoff + m * 2048 + 1024)); } } while (0)
#define PG8_LDB(dst, b, h) do { _Pragma("unroll") for (int n = 0; n < 2; ++n) { dst[n].set0(*(const PG8_LAS bf16x8*)(lds + PG8_SB(b, h) + boff + n * 2048)); dst[n].set1(*(const PG8_LAS bf16x8*)(lds + PG8_SB(b, h) + boff + n * 2048 + 1024)); } } while (0)
#define PG8_MMA(ai, bj, At, Bt) do { __builtin_amdgcn_s_setprio(1); _Pragma("unroll") for (int m = 0; m < 4; ++m) _Pragma("unroll") for (int n = 0; n < 2; ++n) { \
        if constexpr (DT == 1) asm volatile("v_mfma_f32_16x16x128_f8f6f4 %0, %1, %2, %0" : "+v"(acc[ai][bj][m][n]) : "v"(Bt[n].v), "v"(At[m].v));   \
        else if constexpr (DT == 2) { _Pragma("unroll") for (int k = 0; k < 2; ++k) acc[ai][bj][m][n] = __builtin_bit_cast(f32x4, __builtin_amdgcn_mfma_i32_16x16x64_i8(__builtin_bit_cast(v4i_t, Bt[n].h[k]), __builtin_bit_cast(v4i_t, At[m].h[k]), __builtin_bit_cast(v4i_t, acc[ai][bj][m][n]), 0, 0, 0)); } \
        else { _Pragma("unroll") for (int k = 0; k < 2; ++k) acc[ai][bj][m][n] = __builtin_amdgcn_mfma_f32_16x16x32_bf16(Bt[n].h[k], At[m].h[k], acc[ai][bj][m][n], 0, 0, 0); } } \
        __builtin_amdgcn_s_setprio(0); } while (0)
#define PG8_WAIT_V(n) asm volatile("s_waitcnt vmcnt(" #n ")" ::: "memory")
#define PG8_WAIT_L(n) asm volatile("s_waitcnt lgkmcnt(" #n ")" ::: "memory")
#define PG8_BAR __builtin_amdgcn_s_barrier()
#define PG8_SCHED __builtin_amdgcn_sched_barrier(0)
    Unit cur, nxt; int ui = 0;
    if (!S.next(0, cur)) return;
    f32x4 acc[2][2][4][2];
#pragma unroll
    for (int a = 0; a < 2; ++a)
#pragma unroll
        for (int b = 0; b < 2; ++b)
#pragma unroll
            for (int m = 0; m < 4; ++m)
#pragma unroll
                for (int n = 0; n < 2; ++n) acc[a][b][m][n] = (f32x4){0.f, 0.f, 0.f, 0.f};
    Frag<DT == 1> At[4], B0[2], B1[2];
    const char* cA = (const char*)g.A + (size_t)cur.pm * tstep + (size_t)cur.kt0 * kstep; const char* cB = (const char*)g.Bt + S.bt_off(cur) + (size_t)cur.pn * tstep + (size_t)cur.kt0 * kstep;
    S.a_ready(cur);
    if constexpr (SP2) {
        PG8_STAGE(PG8_SB(0, 0), cB, voffB); PG8_STAGE(PG8_SB(0, 1), cB + hstep, voffB); PG8_STAGE(PG8_SA(0, 0), cA, voffA); PG8_STAGE(PG8_SA(0, 1), cA + hstep, voffA);
        if (wr == 1) PG8_BAR;
        PG8_WAIT_V(2); PG8_BAR;
        PG8_STAGE(PG8_SB(1, 0), cB + kstep, voffB); PG8_STAGE(PG8_SA(1, 0), cA + kstep, voffA); PG8_STAGE(PG8_SB(1, 1), cB + hstep + kstep, voffB);
        PG8_WAIT_V(6); PG8_BAR;
    } else {
        PG8_STAGE(PG8_SB(0, 0), cB, voffB); PG8_STAGE(PG8_SA(0, 0), cA, voffA); PG8_STAGE(PG8_SB(0, 1), cB + hstep, voffB); PG8_STAGE(PG8_SA(0, 1), cA + hstep, voffA);
        if (wr == 1) PG8_BAR;
        PG8_WAIT_V(4); PG8_BAR;
        PG8_STAGE(PG8_SB(1, 0), cB + kstep, voffB); PG8_STAGE(PG8_SA(1, 0), cA + kstep, voffA); PG8_STAGE(PG8_SB(1, 1), cB + hstep + kstep, voffB);
        PG8_WAIT_V(6); PG8_BAR;
    }
    for (;;) {
        const bool has_next = S.next(ui + 1, nxt);
        const char* nA = has_next ? (const char*)g.A + (size_t)nxt.pm * tstep + (size_t)nxt.kt0 * kstep : cA; const char* nB = has_next ? (const char*)g.Bt + S.bt_off(nxt) + (size_t)nxt.pn * tstep + (size_t)nxt.kt0 * kstep : cB;
        const int nt = cur.nkt;
        for (int t = 0; t < nt; t += 2) {
            const bool last = (t == nt - 2);
            const char* a1 = cA + (size_t)(t + 1) * kstep;
            const char* a2 = last ? nA : cA + (size_t)(t + 2) * kstep; const char* b2 = last ? nB : cB + (size_t)(t + 2) * kstep;
            const char* a3 = a2 + kstep; const char* b3 = b2 + kstep;
            if (last && has_next) S.a_ready(nxt);
            if constexpr (SP2) {
            PG8_LDB(B0, 0, 0); PG8_LDB(B1, 0, 1); PG8_SCHED; PG8_LDA(At, 0, 0); PG8_STAGE(PG8_SA(1, 1), a1 + hstep, voffA);
            PG8_WAIT_V(8); PG8_WAIT_L(0); PG8_BAR; PG8_MMA(0, 0, At, B0); PG8_MMA(0, 1, At, B1); PG8_BAR; PG8_SCHED;
            PG8_LDA(At, 0, 1); PG8_STAGE(PG8_SB(0, 0), b2, voffB); PG8_STAGE(PG8_SB(0, 1), b2 + hstep, voffB); PG8_STAGE(PG8_SA(0, 0), a2, voffA);
            PG8_WAIT_V(8); PG8_WAIT_L(0); PG8_BAR; PG8_MMA(1, 0, At, B0); PG8_MMA(1, 1, At, B1); PG8_BAR; PG8_SCHED;
            PG8_LDB(B0, 1, 0); PG8_LDB(B1, 1, 1); PG8_SCHED; PG8_LDA(At, 1, 0); PG8_STAGE(PG8_SA(0, 1), a2 + hstep, voffA);
            PG8_WAIT_V(8); PG8_WAIT_L(0); PG8_BAR; PG8_MMA(0, 0, At, B0); PG8_MMA(0, 1, At, B1); PG8_BAR; PG8_SCHED;
            PG8_LDA(At, 1, 1); PG8_STAGE(PG8_SB(1, 0), b3, voffB); PG8_STAGE(PG8_SB(1, 1), b3 + hstep, voffB); PG8_STAGE(PG8_SA(1, 0), a3, voffA);
            PG8_WAIT_V(8); PG8_WAIT_L(0); PG8_BAR; PG8_MMA(1, 0, At, B0); PG8_MMA(1, 1, At, B1); PG8_BAR; PG8_SCHED;
            } else {
            PG8_LDB(B0, 0, 0); PG8_SCHED; PG8_LDA(At, 0, 0); PG8_STAGE(PG8_SA(1, 1), a1 + hstep, voffA);
            PG8_WAIT_L(8); PG8_BAR; PG8_WAIT_L(0); PG8_MMA(0, 0, At, B0); PG8_BAR; PG8_SCHED;
            PG8_LDB(B1, 0, 1); PG8_STAGE(PG8_SB(0, 0), b2, voffB);
            PG8_BAR; PG8_WAIT_L(0); PG8_MMA(0, 1, At, B1); PG8_BAR;
            PG8_LDA(At, 0, 1); PG8_STAGE(PG8_SA(0, 0), a2, voffA);
            PG8_BAR; PG8_WAIT_L(0); PG8_MMA(1, 0, At, B0); PG8_BAR; PG8_SCHED;
            PG8_STAGE(PG8_SB(0, 1), b2 + hstep, voffB);
            PG8_WAIT_V(6); PG8_BAR; PG8_MMA(1, 1, At, B1); PG8_BAR;
            PG8_LDB(B0, 1, 0); PG8_SCHED; PG8_LDA(At, 1, 0); PG8_STAGE(PG8_SA(0, 1), a2 + hstep, voffA);
            PG8_WAIT_L(8); PG8_BAR; PG8_WAIT_L(0); PG8_MMA(0, 0, At, B0); PG8_BAR; PG8_SCHED;
            PG8_LDB(B1, 1, 1); PG8_STAGE(PG8_SB(1, 0), b3, voffB);
            PG8_BAR; PG8_WAIT_L(0); PG8_MMA(0, 1, At, B1); PG8_BAR;
            PG8_LDA(At, 1, 1); PG8_STAGE(PG8_SA(1, 0), a3, voffA);
            PG8_BAR; PG8_WAIT_L(0); PG8_MMA(1, 0, At, B0); PG8_BAR; PG8_SCHED;
            PG8_STAGE(PG8_SB(1, 1), b3 + hstep, voffB);
            PG8_WAIT_V(6); PG8_BAR; PG8_MMA(1, 1, At, B1); PG8_BAR;
            }
        }
        if constexpr (ALIGN_EPI) { if (wr == 0) PG8_BAR; }
        if constexpr (DT == 1) asm volatile("s_nop 15\n\ts_nop 15" ::: "memory");
        if constexpr (!Epi::AFTER_DRAIN) { E(acc, cur, wr, wc, fr, fq); S.done(cur); }
        if (!has_next) break;
#pragma unroll
        for (int a = 0; a < 2; ++a)
#pragma unroll
            for (int b = 0; b < 2; ++b)
#pragma unroll
                for (int m = 0; m < 4; ++m)
#pragma unroll
                    for (int n = 0; n < 2; ++n) acc[a][b][m][n] = (f32x4){0.f, 0.f, 0.f, 0.f};
        cur = nxt; cA = nA; cB = nB; ++ui;
        if constexpr (ALIGN_EPI) { if (wr == 1) PG8_BAR; }
    }
    PG8_WAIT_V(0);
    if constexpr (!ALIGN_EPI) { if (wr == 0) PG8_BAR; }
    PG8_BAR;
    if constexpr (Epi::AFTER_DRAIN) { E.fused(acc, cur, wr, wc, fr, fq, lds, wid, lane); S.done(cur); }
#undef PG8_SA
#undef PG8_SB
#undef PG8_STAGE
#undef PG8_LDA
#undef PG8_LDB
#undef PG8_MMA
#undef PG8_WAIT_V
#undef PG8_WAIT_L
#undef PG8_BAR
#undef PG8_SCHED
}
}

namespace pg8 {
__device__ __forceinline__ u32x4 pack8(const f32x4 v0, const f32x4 v1) { u32x4 w; w.x = cvt_pk_bf16(v0[0], v0[1]); w.y = cvt_pk_bf16(v0[2], v0[3]); w.z = cvt_pk_bf16(v1[0], v1[1]); w.w = cvt_pk_bf16(v1[2], v1[3]); return w; }
struct EpiStore {
    static constexpr bool PERM = true, AFTER_DRAIN = false;
    bf16_t* O; int ldc;
    __device__ __forceinline__ void operator()(const f32x4 (&acc)[2][2][4][2], const Unit& u, int wr, int wc, int fr, int fq) const {
        const int row0 = u.pm * BM + wr * 64 + fr, col0 = u.pn * BM + wc * 32 + 8 * fq;
#pragma unroll
        for (int ai = 0; ai < 2; ++ai)
#pragma unroll
            for (int m = 0; m < 4; ++m) { bf16_t* rowp = O + (size_t)(row0 + ai * HALF + m * 16) * ldc + col0;
#pragma unroll
                for (int bj = 0; bj < 2; ++bj) *(u32x4*)(rowp + bj * HALF) = pack8(acc[ai][bj][m][0], acc[ai][bj][m][1]); }
    }
};
struct EpiQ {
    static constexpr bool PERM = true, AFTER_DRAIN = false;
    bf16_t* O; const float* cosT; const float* sinT;
    __device__ __forceinline__ void operator()(const f32x4 (&acc)[2][2][4][2], const Unit& u, int wr, int wc, int fr, int fq) const {
        const int row0 = u.pm * BM + wr * 64 + fr, col0 = u.pn * BM + wc * 32 + 8 * fq;
#pragma unroll
        for (int ai = 0; ai < 2; ++ai)
#pragma unroll
            for (int m = 0; m < 4; ++m) { const int row = row0 + ai * HALF + m * 16; const bool lat = row < 8192; const int t = row & 2047;
#pragma unroll
                for (int bj = 0; bj < 2; ++bj) { const int col = col0 + bj * HALF; const int jn = col - 192 * (col / 192);
                    f32x4 v0 = acc[ai][bj][m][0], v1 = acc[ai][bj][m][1];
                    if (jn >= 128 && lat) { const int i0 = (jn - 128) >> 1;
                        const f32x4 cs = *(const f32x4*)(cosT + t * 32 + i0), sn = *(const f32x4*)(sinT + t * 32 + i0);
                        f32x4 r0, r1;
                        r0[0] = v0[0] * cs[0] - v0[1] * sn[0]; r0[1] = v0[0] * sn[0] + v0[1] * cs[0];
                        r0[2] = v0[2] * cs[1] - v0[3] * sn[1]; r0[3] = v0[2] * sn[1] + v0[3] * cs[1];
                        r1[0] = v1[0] * cs[2] - v1[1] * sn[2]; r1[1] = v1[0] * sn[2] + v1[1] * cs[2];
                        r1[2] = v1[2] * cs[3] - v1[3] * sn[3]; r1[3] = v1[2] * sn[3] + v1[3] * cs[3];
                        v0 = r0; v1 = r1; }
                    *(u32x4*)(O + (size_t)row * 1536 + col) = pack8(v0, v1); } }
    }
};
struct EpiResid {
    static constexpr bool PERM = false, AFTER_DRAIN = false;
    float* xs; const float* gate; float* slab; int tail_row0, tail_rows; float scale;
    __device__ __forceinline__ void operator()(const f32x4 (&acc)[2][2][4][2], const Unit& u, int wr, int wc, int fr, int fq) const {
        const int row0 = u.pm * BM + wr * 64 + fr, colb = u.pn * BM + wc * 32 + 4 * fq;
        if (u.slab >= 0) {
#pragma unroll
            for (int ai = 0; ai < 2; ++ai)
#pragma unroll
                for (int m = 0; m < 4; ++m) { float* sp = slab + ((size_t)u.slab * tail_rows + (row0 + ai * HALF + m * 16 - tail_row0)) * 2048;
#pragma unroll
                    for (int bj = 0; bj < 2; ++bj)
#pragma unroll
                        for (int n = 0; n < 2; ++n) *(f32x4*)(sp + colb + bj * HALF + n * 16) = acc[ai][bj][m][n] * scale; }
            return;
        }
#pragma unroll
        for (int ai = 0; ai < 2; ++ai)
#pragma unroll
            for (int m = 0; m < 4; ++m) { const int row = row0 + ai * HALF + m * 16; const float* gv = gate + (size_t)(row < 8192 ? (row >> 11) : 4) * 12288; float* xr = xs + (size_t)row * 2048;
#pragma unroll
                for (int bj = 0; bj < 2; ++bj)
#pragma unroll
                    for (int n = 0; n < 2; ++n) { const int col = colb + bj * HALF + n * 16; f32x4 x = *(const f32x4*)(xr + col); const f32x4 g = *(const f32x4*)(gv + col);
                        x += (g * scale) * acc[ai][bj][m][n]; *(f32x4*)(xr + col) = x; }
                if (m & 1) asm volatile("" ::: "memory"); }
    }
};
__device__ __forceinline__ unsigned pack4_fp8(float a, float b, float c, float d) {
    a = fminf(fmaxf(a, -448.f), 448.f); b = fminf(fmaxf(b, -448.f), 448.f); c = fminf(fmaxf(c, -448.f), 448.f); d = fminf(fmaxf(d, -448.f), 448.f);
    unsigned w = 0; w = __builtin_amdgcn_cvt_pk_fp8_f32(a, b, w, false); w = __builtin_amdgcn_cvt_pk_fp8_f32(c, d, w, true); return w; }
struct EpiSwiGLU8 {
    static constexpr bool PERM = true, AFTER_DRAIN = false;
    unsigned char* O; int ldc; float s, oscale;
    __device__ __forceinline__ void operator()(const f32x4 (&acc)[2][2][4][2], const Unit& u, int wr, int wc, int fr, int fq) const {
        const int row0 = u.pm * BM + wr * 64 + fr, col0 = u.pn * HALF + wc * 32 + 8 * fq;
#pragma unroll
        for (int ai = 0; ai < 2; ++ai)
#pragma unroll
            for (int m = 0; m < 4; ++m) { f32x4 o0, o1;
#pragma unroll
                for (int j = 0; j < 4; ++j) { const float g0 = acc[ai][0][m][0][j] * s, g1 = acc[ai][0][m][1][j] * s;
                    o0[j] = g0 / (1.0f + __expf(-g0)) * (acc[ai][1][m][0][j] * (s * oscale)); o1[j] = g1 / (1.0f + __expf(-g1)) * (acc[ai][1][m][1][j] * (s * oscale)); }
                u32x2 w; w.x = pack4_fp8(o0[0], o0[1], o0[2], o0[3]); w.y = pack4_fp8(o1[0], o1[1], o1[2], o1[3]);
                *(u32x2*)(O + (size_t)(row0 + ai * HALF + m * 16) * ldc + col0) = w; }
    }
};
__device__ __forceinline__ f32x4 i2f4(const f32x4 bits) { const v4i_t iv = __builtin_bit_cast(v4i_t, bits); return (f32x4){(float)iv[0], (float)iv[1], (float)iv[2], (float)iv[3]}; }
struct EpiStoreI8 {
    static constexpr bool PERM = true, AFTER_DRAIN = false;
    bf16_t* O; int ldc; const float* rsc; float sw;
    __device__ __forceinline__ void operator()(const f32x4 (&acc)[2][2][4][2], const Unit& u, int wr, int wc, int fr, int fq) const {
        const int row0 = u.pm * BM + wr * 64 + fr, col0 = u.pn * BM + wc * 32 + 8 * fq;
#pragma unroll
        for (int ai = 0; ai < 2; ++ai)
#pragma unroll
            for (int m = 0; m < 4; ++m) { const int row = row0 + ai * HALF + m * 16; const float sc = rsc[row] * sw; bf16_t* rowp = O + (size_t)row * ldc + col0;
#pragma unroll
                for (int bj = 0; bj < 2; ++bj) *(u32x4*)(rowp + bj * HALF) = pack8(i2f4(acc[ai][bj][m][0]) * sc, i2f4(acc[ai][bj][m][1]) * sc); }
    }
};
struct EpiSwiGLUI8 {
    static constexpr bool PERM = true, AFTER_DRAIN = false;
    unsigned char* O; int ldc; const float* rsc; float swg, swu, oscale;
    __device__ __forceinline__ void operator()(const f32x4 (&acc)[2][2][4][2], const Unit& u, int wr, int wc, int fr, int fq) const {
        const int row0 = u.pm * BM + wr * 64 + fr, col0 = u.pn * HALF + wc * 32 + 8 * fq;
#pragma unroll
        for (int ai = 0; ai < 2; ++ai)
#pragma unroll
            for (int m = 0; m < 4; ++m) { const int row = row0 + ai * HALF + m * 16; const float sa = rsc[row], sg = sa * swg, su = sa * swu * oscale; f32x4 o0, o1;
                const f32x4 g0v = i2f4(acc[ai][0][m][0]) * sg, g1v = i2f4(acc[ai][0][m][1]) * sg, u0v = i2f4(acc[ai][1][m][0]) * su, u1v = i2f4(acc[ai][1][m][1]) * su;
#pragma unroll
                for (int j = 0; j < 4; ++j) { o0[j] = g0v[j] / (1.0f + __expf(-g0v[j])) * u0v[j]; o1[j] = g1v[j] / (1.0f + __expf(-g1v[j])) * u1v[j]; }
                u32x2 w; w.x = pack4_fp8(o0[0], o0[1], o0[2], o0[3]); w.y = pack4_fp8(o1[0], o1[1], o1[2], o1[3]);
                *(u32x2*)(O + (size_t)row * ldc + col0) = w; }
    }
};
struct EpiSwiGLU {
    static constexpr bool PERM = true, AFTER_DRAIN = false;
    bf16_t* O; int ldc;
    __device__ __forceinline__ void operator()(const f32x4 (&acc)[2][2][4][2], const Unit& u, int wr, int wc, int fr, int fq) const {
        const int row0 = u.pm * BM + wr * 64 + fr, col0 = u.pn * HALF + wc * 32 + 8 * fq;
#pragma unroll
        for (int ai = 0; ai < 2; ++ai)
#pragma unroll
            for (int m = 0; m < 4; ++m) { f32x4 o0, o1;
#pragma unroll
                for (int j = 0; j < 4; ++j) { const float g0 = acc[ai][0][m][0][j], g1 = acc[ai][0][m][1][j];
                    o0[j] = g0 / (1.0f + __expf(-g0)) * acc[ai][1][m][0][j]; o1[j] = g1 / (1.0f + __expf(-g1)) * acc[ai][1][m][1][j]; }
                *(u32x4*)(O + (size_t)(row0 + ai * HALF + m * 16) * ldc + col0) = pack8(o0, o1); }
    }
};
struct EpiF32 {
    static constexpr bool PERM = false, AFTER_DRAIN = false;
    float* O; int ldc; float* slab; int tail_row0, tail_rows; float scale;
    __device__ __forceinline__ void operator()(const f32x4 (&acc)[2][2][4][2], const Unit& u, int wr, int wc, int fr, int fq) const {
        const int row0 = u.pm * BM + wr * 64 + fr, colb = u.pn * BM + wc * 32 + 4 * fq;
#pragma unroll
        for (int ai = 0; ai < 2; ++ai)
#pragma unroll
            for (int m = 0; m < 4; ++m) { float* xr = (u.slab >= 0) ? slab + ((size_t)u.slab * tail_rows + (row0 + ai * HALF + m * 16 - tail_row0)) * 2048 : O + (size_t)(row0 + ai * HALF + m * 16) * ldc;
#pragma unroll
                for (int bj = 0; bj < 2; ++bj)
#pragma unroll
                    for (int n = 0; n < 2; ++n) *(f32x4*)(xr + colb + bj * HALF + n * 16) = acc[ai][bj][m][n] * scale; }
    }
};
struct EpiYs {
    static constexpr bool PERM = false, AFTER_DRAIN = false;
    bf16_t* O; float* slab; int tail_row0, tail_rows; float scale;
    __device__ __forceinline__ void operator()(const f32x4 (&acc)[2][2][4][2], const Unit& u, int wr, int wc, int fr, int fq) const {
        const int row0 = u.pm * BM + wr * 64 + fr, colb = u.pn * BM + wc * 32 + 4 * fq;
        if (u.slab >= 0) {
#pragma unroll
            for (int ai = 0; ai < 2; ++ai)
#pragma unroll
                for (int m = 0; m < 4; ++m) { float* sp = slab + ((size_t)u.slab * tail_rows + (row0 + ai * HALF + m * 16 - tail_row0)) * 2048;
#pragma unroll
                    for (int bj = 0; bj < 2; ++bj)
#pragma unroll
                        for (int n = 0; n < 2; ++n) *(f32x4*)(sp + colb + bj * HALF + n * 16) = acc[ai][bj][m][n] * scale; }
            return;
        }
#pragma unroll
        for (int ai = 0; ai < 2; ++ai)
#pragma unroll
            for (int m = 0; m < 4; ++m) { bf16_t* xr = O + (size_t)(row0 + ai * HALF + m * 16) * 2048;
#pragma unroll
                for (int bj = 0; bj < 2; ++bj)
#pragma unroll
                    for (int n = 0; n < 2; ++n) { const f32x4 v = acc[ai][bj][m][n] * scale; u32x2 w; w.x = cvt_pk_bf16(v[0], v[1]); w.y = cvt_pk_bf16(v[2], v[3]); *(u32x2*)(xr + colb + bj * HALF + n * 16) = w; } }
    }
};
struct MoeOrder {
    int nM, nN, nwg, G, c, nkt; int t1[8]; size_t estride;
    __device__ __forceinline__ void init(const int* ctl, int nN_, int G_, int c_, size_t estride_, int K) { nkt = K / BK;
        int acc = 0;
#pragma unroll
        for (int e = 0; e < 8; ++e) { acc += __builtin_amdgcn_readfirstlane(ctl[CT_EPAD + e]) >> 8; t1[e] = acc; }
        nM = acc; nN = nN_; nwg = nM * nN; G = G_; c = c_; estride = estride_;
    }
    __device__ __forceinline__ bool next(int i, Unit& u) const {
        const long L = (long)i * G + c; if (L >= nwg) return false;
        int wgid = (int)L; { const int q = nwg / NXCD, r = nwg % NXCD, xcd = wgid % NXCD, off = wgid / NXCD; wgid = (xcd < r ? xcd * (q + 1) : r * (q + 1) + (xcd - r) * q) + off; }
        const int nig = WGM * nN, gid = wgid / nig, fm = gid * WGM, gsz = (nM - fm) < WGM ? (nM - fm) : WGM;
        u.pm = fm + ((wgid % nig) % gsz); u.pn = (wgid % nig) / gsz; u.kt0 = 0; u.nkt = nkt; u.slab = -1; return true;
    }
    __device__ __forceinline__ size_t bt_off(const Unit& u) const { int e = 0;
#pragma unroll
        for (int k = 0; k < 7; ++k) e += (u.pm >= t1[k]) ? 1 : 0;
        return (size_t)e * estride; }
    __device__ __forceinline__ void a_ready(const Unit&) const {}
    __device__ __forceinline__ void done(const Unit&) const {}
};
struct WinLastOrder {
    StaticOrder so; int G, c;
    __device__ __forceinline__ void init(int G_, int c_, int K) { so.init(NLAT, UW, G_, c_, K); G = G_; c = c_; }
    __device__ __forceinline__ bool next(int i, Unit& u) const {
        if (so.next(i, u)) return true;
        const long L = (long)i * G + c - so.nwg; if (L < 0 || L >= 20) return false;
        const int j = (int)L, k = j % 5; u.pm = 32 + j / 5; u.pn = k < 3 ? 3 + k : 10 + k; u.kt0 = 0; u.nkt = so.nkt; u.slab = -1; return true;
    }
    __device__ __forceinline__ size_t bt_off(const Unit&) const { return 0; }
    __device__ __forceinline__ void a_ready(const Unit&) const {}
    __device__ __forceinline__ void done(const Unit&) const {}
};
struct SplitOrder {
    int nM, nN, nwg, G, c, nfull, ntail, S, nkt, nkts; int t1[8]; size_t estride;
    __device__ __forceinline__ void init(int nM_, int nN_, int G_, int c_, int K, int S_) {
        nM = nM_; nN = nN_; nwg = nM * nN; G = G_; c = c_; nkt = K / BK; nfull = (nwg / 256) * 256; ntail = nwg - nfull; S = S_; nkts = nkt / S; estride = 0;
#pragma unroll
        for (int e = 0; e < 8; ++e) t1[e] = 0;
    }
    __device__ __forceinline__ void init_moe(const int* ctl, int nN_, int G_, int c_, int K, size_t estride_) {
        int acc = 0;
#pragma unroll
        for (int e = 0; e < 8; ++e) { acc += __builtin_amdgcn_readfirstlane(ctl[CT_EPAD + e]) >> 8; t1[e] = acc; }
        init(acc, nN_, G_, c_, K, __builtin_amdgcn_readfirstlane(ctl[CT_MOES])); estride = estride_;
        acc = 0;
#pragma unroll
        for (int e = 0; e < 8; ++e) { acc += __builtin_amdgcn_readfirstlane(ctl[CT_EPAD + e]) >> 8; t1[e] = acc; }
    }
    __device__ __forceinline__ bool next(int i, Unit& u) const {
        const long L = (long)i * G + c; int wgid;
        if (L < nfull) { wgid = (int)L; { const int q = nfull / NXCD, xcd = wgid % NXCD, off = wgid / NXCD; wgid = xcd * q + off; } u.kt0 = 0; u.nkt = nkt; u.slab = -1; }
        else { const int j = (int)(L - nfull); if (j >= ntail * S) return false; const int tu = j / S, sl = j - tu * S; wgid = nfull + tu; u.kt0 = sl * nkts; u.nkt = nkts; u.slab = (S > 1) ? sl : -1; }
        const int nig = WGM * nN, gid = wgid / nig, fm = gid * WGM, gsz = (nM - fm) < WGM ? (nM - fm) : WGM;
        u.pm = fm + ((wgid % nig) % gsz); u.pn = (wgid % nig) / gsz; return true;
    }
    __device__ __forceinline__ size_t bt_off(const Unit& u) const { if (estride == 0) return 0; int e = 0;
#pragma unroll
        for (int k = 0; k < 7; ++k) e += (u.pm >= t1[k]) ? 1 : 0;
        return (size_t)e * estride; }
    __device__ __forceinline__ void a_ready(const Unit&) const {}
    __device__ __forceinline__ void done(const Unit&) const {}
};
__host__ __device__ constexpr int split_S(int nwg, int nkt, int G) {
    const int ntail = nwg - (nwg / G) * G;
    if (ntail == 0) return 1;
    if (nkt % 28 == 0 && ntail * 14 <= G) return 14;
    if (nkt % 16 == 0 && ntail * 8 <= G) return 8;
    if (nkt % 14 == 0 && ntail * 7 <= G) return 7;
    if (nkt % 8 == 0 && ntail * 4 <= G) return 4;
    if (nkt % 4 == 0 && ntail * 2 <= G) return 2;
    return 1;
}
}

#define LAS __attribute__((address_space(3)))
#define XB_TMO      128
#define XB_XCNT(j)  (256  + 64 * (j))
#define XB_XSUB(j)  (1280 + 64 * (j))
#define XB_XGEN(j)  (2304 + 64 * (j))
#define XB_TOP      3328
#define XB_TOPGEN   3392
#define XCD_BAR_WORDS 3456
#define XB_SPIN_CAP (1u << 18)

__device__ __forceinline__ unsigned xb_ld(unsigned* p)              { return __hip_atomic_load(p, __ATOMIC_RELAXED, __HIP_MEMORY_SCOPE_AGENT); }
__device__ __forceinline__ unsigned xb_add(unsigned* p, unsigned v) { return __hip_atomic_fetch_add(p, v, __ATOMIC_RELAXED, __HIP_MEMORY_SCOPE_AGENT); }
__device__ __forceinline__ unsigned xb_xcc_id() { return (unsigned)__builtin_amdgcn_s_getreg((3 << 11) | 20) & 0xFu; }
#define XB_SPIN(cond, bar) do { unsigned _sp = 0; while (cond) { __builtin_amdgcn_s_sleep(1); \
    if ((++_sp & 255u) == 0u) { if (xb_ld(&(bar)[XB_TMO])) break; if (_sp > XB_SPIN_CAP) { atomicAdd(&(bar)[XB_TMO], 1u); break; } } } } while (0)

struct XcdBarrier {
    unsigned* bar; unsigned x;
    volatile LAS unsigned* st;
};

__device__ __forceinline__ XcdBarrier xcd_barrier_post(unsigned* bar, volatile LAS unsigned* st) {
    XcdBarrier b; b.bar = bar; b.x = xb_xcc_id(); b.st = st;
    if (threadIdx.x == 0) (void)xb_add(&bar[XB_XCNT(b.x)], 1u);
    return b;
}
__device__ __forceinline__ void xcd_barrier_complete(unsigned* bar, unsigned x, unsigned& nloc, unsigned& nx) {
    const unsigned G = gridDim.x * gridDim.y * gridDim.z;
    unsigned sum, cnt, mine, sp = 0u;
    for (;;) {
        sum = 0u; cnt = 0u; mine = 0u;
#pragma unroll
        for (unsigned j = 0; j < 16; ++j) { const unsigned c = xb_ld(&bar[XB_XCNT(j)]); sum += c; cnt += (c > 0u) ? 1u : 0u; mine = (j == x) ? c : mine; }
        if (sum == G) break;
        __builtin_amdgcn_s_sleep(1);
        if ((++sp & 255u) == 0u) { if (xb_ld(&bar[XB_TMO])) break; if (sp > XB_SPIN_CAP) { atomicAdd(&bar[XB_TMO], 1u); break; } }
    }
    nloc = mine > 0u ? mine : 1u; nx = cnt > 0u ? cnt : 1u;
}

__device__ __forceinline__ void xcd_barrier(const XcdBarrier& b) {
    asm volatile("s_waitcnt vmcnt(0)" ::: "memory");
    __syncthreads();
    if (threadIdx.x == 0) {
        unsigned* bar = b.bar;
        __builtin_amdgcn_s_waitcnt(0);
        unsigned nloc = b.st[0], nx = b.st[1];
        if (nloc == 0u) { xcd_barrier_complete(bar, b.x, nloc, nx); b.st[0] = nloc; b.st[1] = nx; }
        const unsigned old = xb_add(&bar[XB_XSUB(b.x)], 1u);
        const unsigned gen = old / nloc;
        if (old + 1u == (gen + 1u) * nloc) {
            __builtin_amdgcn_fence(__ATOMIC_RELEASE, "agent");
            asm volatile("s_waitcnt vmcnt(0)" ::: "memory");
            const unsigned og = xb_add(&bar[XB_TOP], 1u);
            const unsigned tg = og / nx;
            if (og + 1u == (tg + 1u) * nx) xb_add(&bar[XB_TOPGEN], 1u);
            else XB_SPIN(xb_ld(&bar[XB_TOPGEN]) == tg, bar);
            __builtin_amdgcn_fence(__ATOMIC_ACQUIRE, "agent");
            xb_add(&bar[XB_XGEN(b.x)], 1u);
            asm volatile("s_waitcnt vmcnt(0)" ::: "memory");
        } else {
            XB_SPIN(xb_ld(&bar[XB_XGEN(b.x)]) == gen, bar);
            __builtin_amdgcn_fence(__ATOMIC_ACQUIRE, "agent");
            asm volatile("s_waitcnt vmcnt(0)" ::: "memory");
        }
    }
    __syncthreads();
}


struct Args { const float* in[34]; float* out; unsigned char* ws; int ph_lo, ph_hi; };

enum { MAP_ID = 0, MAP_ROPEQ = 1, MAP_GU0 = 2, MAP_GU1 = 3, MAP_KV = 4 };
struct JobDesc { int in_idx, K, N, nbatch, upb, map; long long src_off, src_bstride, dst_off, dst_bstride; int fp8, sidx; };
constexpr int NJOBS = 14, NCONV = 12664;
__constant__ JobDesc c_jobs[NJOBS] = {
    {8, 2048, 3648, 1, 232, MAP_ID, 0, 0, (long long)WS_WIN, 0, I8_WIN ? 2 : 0, 0},
    {8, 2048, 3648, 1, 232, MAP_ID, 2048LL * 3648, 0, (long long)(WS_WIN + (size_t)UW * D * 2), 0, I8_WIN ? 2 : 0, 1},
    {10, 768, 1536, 1, 36, MAP_ROPEQ, 0, 0, (long long)WS_WQ, 0},
    {10, 768, 1536, 1, 36, MAP_ROPEQ, 768LL * 1536, 0, (long long)(WS_WQ + (size_t)QW * 768 * 2), 0},
    {12, 512, 2048, 1, 32, MAP_KV, 0, 0, (long long)WS_WKV, 0},
    {12, 512, 2048, 1, 32, MAP_KV, 512LL * 2048, 0, (long long)(WS_WKV + (size_t)KVW * 512 * 2), 0},
    {25, 2048, 2048, 1, 128, MAP_ID, 0, 0, (long long)WS_WOUT, 0},
    {25, 2048, 2048, 1, 128, MAP_ID, 2048LL * 2048, 0, (long long)(WS_WOUT + (size_t)D * D * 2), 0},
    {26, 2048, 5632, 1, 352, MAP_GU0, 0, 0, (long long)WS_WGU, 0, I8_GU ? 2 : FP8_DENSE, 2},
    {27, 2048, 5632, 1, 352, MAP_GU1, 0, 0, (long long)WS_WGU, 0, I8_GU ? 2 : FP8_DENSE, 3},
    {28, 5632, 2048, 1, 352, MAP_ID, 0, 0, (long long)WS_WDN, 0, (FP8_DENSE || FP8_DOWN), 0},
    {30, 2048, 7168, 8, 448, MAP_GU0, 0, 2048LL * 7168, (long long)WS_MGU, 2LL * DFE * D, 1, 0},
    {31, 2048, 7168, 8, 448, MAP_GU1, 0, 2048LL * 7168, (long long)WS_MGU, 2LL * DFE * D, 1, 0},
    {32, 7168, 2048, 8, 448, MAP_ID, 0, 7168LL * 2048, (long long)WS_MDN, (long long)D * DFE, 1, 0},
};
struct ConvUnit { const float* src; bf16_t* dst; int K, N, map, k0, n0, fp8; float qs; };
__device__ __forceinline__ unsigned pack4_i8(float a, float b, float c, float d) {
    const int ia = (int)__builtin_rintf(fminf(fmaxf(a, -127.f), 127.f)), ib = (int)__builtin_rintf(fminf(fmaxf(b, -127.f), 127.f)), ic = (int)__builtin_rintf(fminf(fmaxf(c, -127.f), 127.f)), id = (int)__builtin_rintf(fminf(fmaxf(d, -127.f), 127.f));
    return (unsigned)(ia & 0xff) | ((unsigned)(ib & 0xff) << 8) | ((unsigned)(ic & 0xff) << 16) | ((unsigned)(id & 0xff) << 24); }
constexpr float WSCALE = 64.f, ASCALE = 8.f;
__device__ __forceinline__ void conv_decode(const Args& a, int u, ConvUnit& cu) {
    int j = 0, base = 0;
    for (;;) { const int n = c_jobs[j].nbatch * c_jobs[j].upb; if (u < base + n || j == NJOBS - 1) break; base += n; ++j; }
    const JobDesc& jd = c_jobs[j];
    int r = u - base; const int bt = r / jd.upb; r -= bt * jd.upb; const int ntn = (jd.N + 127) >> 7; const int kt = r / ntn, nt = r - kt * ntn;
    cu.K = jd.K; cu.N = jd.N; cu.map = jd.map; cu.k0 = kt * 256; cu.n0 = nt * 128; cu.fp8 = jd.fp8; cu.qs = 1.0f;
    if (jd.fp8 == 2) { const float am = __uint_as_float(__hip_atomic_load((const unsigned*)(a.ws + WS_CTL) + CT_WSC + jd.sidx, __ATOMIC_RELAXED, __HIP_MEMORY_SCOPE_AGENT)); cu.qs = am > 0.f ? 127.0f / am : 0.f; }
    const float* sb = j < 2 ? a.in[8] : j < 4 ? a.in[10] : j < 6 ? a.in[12] : j < 8 ? a.in[25] : j == 8 ? a.in[26] : j == 9 ? a.in[27] : j == 10 ? a.in[28] : j == 11 ? a.in[30] : j == 12 ? a.in[31] : a.in[32];
    cu.src = sb + jd.src_off + (long long)bt * jd.src_bstride + (size_t)cu.k0 * jd.N + cu.n0;
    cu.dst = (bf16_t*)(a.ws + jd.dst_off + (long long)bt * jd.dst_bstride);
}
__device__ __forceinline__ int conv_row(int map, int n) {
    if (map == MAP_ID) return n;
    if (map == MAP_GU0) return ((n >> 7) << 8) + (n & 127);
    if (map == MAP_GU1) return ((n >> 7) << 8) + 128 + (n & 127);
    if (map == MAP_KV) { const int hh = n >> 8, jn = n & 255; return jn < 128 ? hh * 128 + jn : 1024 + hh * 128 + (jn - 128); }
    const int hh = n / 192, jn = n - hh * 192; if (jn < 128) return n; const int q = jn - 128; return hh * 192 + 128 + 2 * (q & 31) + (q >> 5);
}
constexpr int CV_P = 129;
#define CONV_LOAD(R, CU) do { const bool ok_ = (CU).n0 + (tid & 31) * 4 < (CU).N; _Pragma("unroll") for (int i_ = 0; i_ < 16; ++i_) { const int row_ = 2 * ((tid >> 5) + 16 * (i_ >> 1)) + (i_ & 1); \
        R[i_] = ok_ ? __builtin_nontemporal_load((const f32x4*)((CU).src + (size_t)row_ * (CU).N + (tid & 31) * 4)) : (f32x4){0.f, 0.f, 0.f, 0.f}; } } while (0)
#define CONV_PUT(R, T) do { _Pragma("unroll") for (int i_ = 0; i_ < 16; ++i_) { const int row_ = 2 * ((tid >> 5) + 16 * (i_ >> 1)) + (i_ & 1); float* tp_ = (T) + row_ * CV_P + (tid & 31) * 4; \
        tp_[0] = R[i_][0]; tp_[1] = R[i_][1]; tp_[2] = R[i_][2]; tp_[3] = R[i_][3]; } } while (0)
__device__ __forceinline__ void conv_out(const ConvUnit& cur, const float* tile, int tid) {
    if (cur.fp8 == 2) {
        const float qs = cur.qs;
#pragma unroll
        for (int j = 0; j < 4; ++j) { const int kc = (tid & 7) + 8 * (j & 1), n = (tid >> 3) + 64 * (j >> 1);
            if (cur.n0 + n < cur.N) { const int row = conv_row(cur.map, cur.n0 + n); const float* tp = tile + (kc * 16) * CV_P + n; u32x4 w;
                w.x = pack4_i8(tp[0] * qs, tp[CV_P] * qs, tp[2 * CV_P] * qs, tp[3 * CV_P] * qs); w.y = pack4_i8(tp[4 * CV_P] * qs, tp[5 * CV_P] * qs, tp[6 * CV_P] * qs, tp[7 * CV_P] * qs);
                w.z = pack4_i8(tp[8 * CV_P] * qs, tp[9 * CV_P] * qs, tp[10 * CV_P] * qs, tp[11 * CV_P] * qs); w.w = pack4_i8(tp[12 * CV_P] * qs, tp[13 * CV_P] * qs, tp[14 * CV_P] * qs, tp[15 * CV_P] * qs);
                *(u32x4*)((unsigned char*)cur.dst + (size_t)row * cur.K + cur.k0 + kc * 16) = w; } }
    } else if (cur.fp8) {
#pragma unroll
        for (int j = 0; j < 4; ++j) { const int kc = (tid & 7) + 8 * (j & 1), n = (tid >> 3) + 64 * (j >> 1);
            if (cur.n0 + n < cur.N) { const int row = conv_row(cur.map, cur.n0 + n); const float* tp = tile + (kc * 16) * CV_P + n; u32x4 w;
                w.x = pg8::pack4_fp8(tp[0] * WSCALE, tp[CV_P] * WSCALE, tp[2 * CV_P] * WSCALE, tp[3 * CV_P] * WSCALE); w.y = pg8::pack4_fp8(tp[4 * CV_P] * WSCALE, tp[5 * CV_P] * WSCALE, tp[6 * CV_P] * WSCALE, tp[7 * CV_P] * WSCALE);
                w.z = pg8::pack4_fp8(tp[8 * CV_P] * WSCALE, tp[9 * CV_P] * WSCALE, tp[10 * CV_P] * WSCALE, tp[11 * CV_P] * WSCALE); w.w = pg8::pack4_fp8(tp[12 * CV_P] * WSCALE, tp[13 * CV_P] * WSCALE, tp[14 * CV_P] * WSCALE, tp[15 * CV_P] * WSCALE);
                *(u32x4*)((unsigned char*)cur.dst + (size_t)row * cur.K + cur.k0 + kc * 16) = w; } }
    } else {
#pragma unroll
        for (int j = 0; j < 8; ++j) { const int kc = (tid & 7) + 8 * (j & 3), n = (tid >> 3) + 64 * (j >> 2);
            if (cur.n0 + n < cur.N) { const int row = conv_row(cur.map, cur.n0 + n); const float* tp = tile + (kc * 8) * CV_P + n; u32x4 w;
                w.x = pg8::cvt_pk_bf16(tp[0], tp[CV_P]); w.y = pg8::cvt_pk_bf16(tp[2 * CV_P], tp[3 * CV_P]); w.z = pg8::cvt_pk_bf16(tp[4 * CV_P], tp[5 * CV_P]); w.w = pg8::cvt_pk_bf16(tp[6 * CV_P], tp[7 * CV_P]);
                *(u32x4*)(cur.dst + (size_t)row * cur.K + cur.k0 + kc * 8) = w; } }
    }
}
template <int MODE = 0>
__device__ __forceinline__ void ph_convert(const Args& a, float* tile, int first, int stride, int end) {
    const int tid = threadIdx.x;
    int u = first; ConvUnit cuA, cuB; f32x4 rA[16], rB[16];
#pragma unroll
    for (int i = 0; i < 16; ++i) { rA[i] = (f32x4){0.f, 0.f, 0.f, 0.f}; rB[i] = rA[i]; }
    if (u < end) { conv_decode(a, u, cuA); if (MODE != 2) CONV_LOAD(rA, cuA); }
    if (u + stride < end) { conv_decode(a, u + stride, cuB); if (MODE != 2) CONV_LOAD(rB, cuB); }
    while (u < end) {
        CONV_PUT(rA, tile);
        __syncthreads();
        { const ConvUnit cur = cuA; const int un = u + 2 * stride; if (un < end) { conv_decode(a, un, cuA); if (MODE != 2) CONV_LOAD(rA, cuA); } if (MODE != 1) conv_out(cur, tile, tid); }
        __syncthreads();
        u += stride; if (u >= end) break;
        CONV_PUT(rB, tile);
        __syncthreads();
        { const ConvUnit cur = cuB; const int un = u + 2 * stride; if (un < end) { conv_decode(a, un, cuB); if (MODE != 2) CONV_LOAD(rB, cuB); } if (MODE != 1) conv_out(cur, tile, tid); }
        __syncthreads();
        u += stride;
    }
}
constexpr int CT_QNEXT = 1152;
template <int MODE = 0>
__device__ __forceinline__ void conv_dynamic(const Args& a, float* tile) {
    unsigned* qn = (unsigned*)(a.ws + WS_CTL) + CT_QNEXT; volatile int* bc = (volatile int*)(tile + 256 * CV_P + 4);
    const int tid = threadIdx.x;
    if (tid == 0) { bc[0] = (int)__hip_atomic_fetch_add(qn, 1u, __ATOMIC_RELAXED, __HIP_MEMORY_SCOPE_AGENT); bc[1] = (int)__hip_atomic_fetch_add(qn, 1u, __ATOMIC_RELAXED, __HIP_MEMORY_SCOPE_AGENT);
                    bc[2] = (int)__hip_atomic_fetch_add(qn, 1u, __ATOMIC_RELAXED, __HIP_MEMORY_SCOPE_AGENT); }
    __syncthreads();
    int uA = bc[0], uB = bc[1], uN = bc[2];
    __syncthreads();
    ConvUnit cuA, cuB; f32x4 rA[16], rB[16];
#pragma unroll
    for (int i = 0; i < 16; ++i) { rA[i] = (f32x4){0.f, 0.f, 0.f, 0.f}; rB[i] = rA[i]; }
    if (uA < NCONV) { conv_decode(a, uA, cuA); if (MODE != 2) CONV_LOAD(rA, cuA); }
    if (uB < NCONV) { conv_decode(a, uB, cuB); if (MODE != 2) CONV_LOAD(rB, cuB); }
    while (uA < NCONV) {
        CONV_PUT(rA, tile);
        __syncthreads();
        { const ConvUnit cur = cuA; uA = uN; if (uA < NCONV) { conv_decode(a, uA, cuA); if (MODE != 2) CONV_LOAD(rA, cuA); }
          if (tid == 0) bc[0] = (int)__hip_atomic_fetch_add(qn, 1u, __ATOMIC_RELAXED, __HIP_MEMORY_SCOPE_AGENT);
          if (MODE != 1) conv_out(cur, tile, tid); }
        __syncthreads();
        uN = bc[0];
        if (uB >= NCONV) break;
        CONV_PUT(rB, tile);
        __syncthreads();
        { const ConvUnit cur = cuB; uB = uN; if (uB < NCONV) { conv_decode(a, uB, cuB); if (MODE != 2) CONV_LOAD(rB, cuB); }
          if (tid == 0) bc[0] = (int)__hip_atomic_fetch_add(qn, 1u, __ATOMIC_RELAXED, __HIP_MEMORY_SCOPE_AGENT);
          if (MODE != 1) conv_out(cur, tile, tid); }
        __syncthreads();
        uN = bc[0];
    }
    __syncthreads();
}
#undef CONV_LOAD
#undef CONV_PUT
constexpr int CONV_STATIC = 856, CONV_DENSE_END = 1912, CONV_BATCH = 2;
__device__ __forceinline__ constexpr int CT_DONE(int k) { return 1216 + 64 * k; }
__device__ __forceinline__ void conv_fill(const Args& a, float* tile, int done_idx) {
#if !CONV_FILL
    (void)a; (void)tile; (void)done_idx; return;
#endif
    unsigned* ctl = (unsigned*)(a.ws + WS_CTL); volatile int* bc = (volatile int*)(tile + 256 * CV_P + 4);
    const int tid = threadIdx.x;
    if (tid == 0) (void)__hip_atomic_fetch_add(ctl + CT_DONE(done_idx), 1u, __ATOMIC_RELAXED, __HIP_MEMORY_SCOPE_AGENT);
    for (;;) {
        if (tid == 0) { int q = -1;
            if (__hip_atomic_load(ctl + CT_DONE(done_idx), __ATOMIC_RELAXED, __HIP_MEMORY_SCOPE_AGENT) < gridDim.x) {
                q = (int)__hip_atomic_fetch_add(ctl + CT_QNEXT, (unsigned)CONV_BATCH, __ATOMIC_RELAXED, __HIP_MEMORY_SCOPE_AGENT) + CONV_STATIC; if (q >= NCONV) q = -1; }
            *bc = q; }
        __syncthreads();
        const int q = *bc;
        __syncthreads();
        if (q < 0) break;
        ph_convert(a, tile, q, 1, (q + CONV_BATCH < NCONV) ? q + CONV_BATCH : NCONV);
    }
}
__device__ __forceinline__ void conv_finish(const Args& a, float* tile, int upto) {
#if !CONV_FILL
    (void)a; (void)tile; (void)upto; return;
#endif
    unsigned* ctl = (unsigned*)(a.ws + WS_CTL); volatile int* bc = (volatile int*)(tile + 256 * CV_P + 4);
    const int tid = threadIdx.x;
    for (;;) {
        if (tid == 0) { int q = -1;
            if ((int)__hip_atomic_load(ctl + CT_QNEXT, __ATOMIC_RELAXED, __HIP_MEMORY_SCOPE_AGENT) + CONV_STATIC < upto) {
                q = (int)__hip_atomic_fetch_add(ctl + CT_QNEXT, (unsigned)CONV_BATCH, __ATOMIC_RELAXED, __HIP_MEMORY_SCOPE_AGENT) + CONV_STATIC; if (q >= NCONV) q = -1; }
            *bc = q; }
        __syncthreads();
        const int q = *bc;
        __syncthreads();
        if (q < 0) break;
        ph_convert(a, tile, q, 1, (q + CONV_BATCH < NCONV) ? q + CONV_BATCH : NCONV);
    }
}
__device__ __forceinline__ void adaln_unit(const Args& a, int unit, float* sm) {
    const float* c = a.in[1]; const float* cctx = a.in[3]; const float* w_mod = a.in[4]; const float* b_mod = a.in[5]; float* mod = (float*)(a.ws + WS_MOD);
    const int tid = threadIdx.x, l = unit / 96, chunk = unit - l * 96;
    const int cg = tid & 31, ks = tid >> 5;
    for (int i = tid; i < 5 * 2048; i += 512) { const int v = i >> 11, k = i & 2047; const float val = v < 4 ? c[v * 2048 + k] : cctx[k]; sm[i] = val / (1.0f + __expf(-val)); }
    __syncthreads();
    float acc[5][4];
#pragma unroll
    for (int v = 0; v < 5; ++v)
#pragma unroll
        for (int j = 0; j < 4; ++j) acc[v][j] = 0.f;
    const float* wp = w_mod + ((size_t)l * 2048 + (size_t)ks * 128) * 12288 + chunk * 128 + cg * 4;
    for (int kb = 0; kb < 128; kb += 16) {
        f32x4 w[16];
#pragma unroll
        for (int kk = 0; kk < 16; ++kk) w[kk] = __builtin_nontemporal_load((const f32x4*)(wp + (size_t)(kb + kk) * 12288));
#pragma unroll
        for (int kk = 0; kk < 16; ++kk) { const int k = ks * 128 + kb + kk;
#pragma unroll
            for (int v = 0; v < 5; ++v) { const float s = sm[v * 2048 + k];
#pragma unroll
                for (int j = 0; j < 4; ++j) acc[v][j] += s * w[kk][j]; } }
    }
    __syncthreads();
#pragma unroll
    for (int v = 0; v < 5; ++v)
#pragma unroll
        for (int j = 0; j < 4; ++j) sm[(ks * 5 + v) * 128 + cg * 4 + j] = acc[v][j];
    __syncthreads();
    for (int o = tid; o < 640; o += 512) {
        const int v = o >> 7, cc = o & 127; float s = 0.f;
#pragma unroll
        for (int k2 = 0; k2 < 16; ++k2) s += sm[(k2 * 5 + v) * 128 + cc];
        mod[((size_t)l * 5 + v) * 12288 + chunk * 128 + cc] = s + b_mod[(size_t)l * 12288 + chunk * 128 + cc];
    }
    __syncthreads();
}
constexpr int FW_W1 = 0, FW_W2 = 2112, FW_W3 = 6208, FW_B1 = 10304, FW_B2 = 10368, FW_B3 = 10432, FW_FR = 10496, FW_ZS = 10560, FW_HA = 10848, FW_HB = 11360, FW_END = 11872;
__device__ __forceinline__ void filters_unit(const Args& a, int l, int r, float* sm) {
    float (*zs)[36] = (float (*)[36])(sm + FW_ZS); float (*ha)[64] = (float (*)[64])(sm + FW_HA); float (*hb)[64] = (float (*)[64])(sm + FW_HB);
    const int tid = threadIdx.x;
    const bool lat = r < 256; const int Lf = lat ? 2048 : 256; const int p0 = lat ? r * 8 : (r - 256) * 8;
    float* T = (float*)(a.ws + WS_FILTC) + (size_t)l * 512 * 512;
    const float* wf = a.in[21] + (size_t)l * 64 * 1024;
    const int p = tid >> 6, j = tid & 63; const int pos = p0 + p;
    const float tn = (float)pos / (float)(Lf - 1);
    if (j < 33) {
        float z;
        if (j == 0) z = tn;
        else { const int bi = (j - 1) & 15; const float band = 1e-4f + (float)bi * ((15.0f - 1e-4f) / 15.0f);
               const float ang = (6.283185307179586f / (float)Lf) * (float)pos * band; z = (j <= 16) ? __cosf(ang) : -__sinf(ang); }
        zs[p][j] = z;
    }
    __syncthreads();
    const float f = sm[FW_FR + j];
    { float s = sm[FW_B1 + j];
#pragma unroll
      for (int i = 0; i < 33; ++i) s += zs[p][i] * sm[FW_W1 + i * 64 + j];
      ha[p][j] = __sinf(f * s); }
    __syncthreads();
    { float s = sm[FW_B2 + j];
#pragma unroll 16
      for (int i = 0; i < 64; ++i) s += ha[p][i] * sm[FW_W2 + i * 64 + j];
      hb[p][j] = __sinf(f * s); }
    __syncthreads();
    { float s = sm[FW_B3 + j];
#pragma unroll 16
      for (int i = 0; i < 64; ++i) s += hb[p][i] * sm[FW_W3 + i * 64 + j];
      ha[p][j] = __sinf(f * s); }
    __syncthreads();
    float acc[2][8];
#pragma unroll
    for (int rr = 0; rr < 2; ++rr)
#pragma unroll
        for (int q = 0; q < 8; ++q) acc[rr][q] = 0.f;
    for (int ib = 0; ib < 64; ib += 16) {
        float wa[16], wb[16];
#pragma unroll
        for (int i = 0; i < 16; ++i) { wa[i] = wf[(ib + i) * 1024 + tid]; wb[i] = wf[(ib + i) * 1024 + 512 + tid]; }
#pragma unroll
        for (int i = 0; i < 16; ++i) {
#pragma unroll
            for (int q = 0; q < 8; ++q) { const float h = ha[q][ib + i]; acc[0][q] += h * wa[i]; acc[1][q] += h * wb[i]; } }
    }
    const int ch = tid;
    const float delta = 3.0701134573253944f + (float)ch * ((15.350567286626972f - 3.0701134573253944f) / 511.0f);
#pragma unroll
    for (int q = 0; q < 8; ++q) {
        const int ps = p0 + q; const float dec = __expf(-((float)ps / (float)(Lf - 1)) * delta);
        const float vf = acc[0][q] * dec, vb = acc[1][q] * dec;
        if (lat) { bf16_t* RBp = (bf16_t*)(a.ws + WS_FILTL) + ((size_t)l * 512 + ch) * HY_RBROW; RBp[2048 - ps] = f2bf(vf); if (ps > 0) RBp[2048 + ps] = f2bf(vb); }
        else { T[(size_t)ch * (2 * Lf) + Lf + ps] = vf; if (ps > 0) T[(size_t)ch * (2 * Lf) + Lf - ps] = vb; else T[(size_t)ch * (2 * Lf)] = 0.f; }
    }
    __syncthreads();
}
__device__ __forceinline__ void ph_filters(const Args& a, float* sm, int fb, int nfb) {
    const int tid = threadIdx.x;
    for (int l = 0; l < 2; ++l) {
        for (int i = tid; i < 2112; i += NTHR) sm[FW_W1 + i] = a.in[15][l * 2112 + i];
        for (int i = tid; i < 4096; i += NTHR) { sm[FW_W2 + i] = a.in[17][l * 4096 + i]; sm[FW_W3 + i] = a.in[19][l * 4096 + i]; }
        if (tid < 64) { sm[FW_B1 + tid] = a.in[16][l * 64 + tid]; sm[FW_B2 + tid] = a.in[18][l * 64 + tid]; sm[FW_B3 + tid] = a.in[20][l * 64 + tid]; sm[FW_FR + tid] = a.in[22][l * 64 + tid]; }
        __syncthreads();
        for (int r = fb; r < 288; r += nfb) filters_unit(a, l, r, sm);
        __syncthreads();
    }
}
#define SUBREP(b) for (int srep_ = 0; srep_ <= (int)((PROBE_SUB >> (b)) & 1u); ++srep_)
__device__ __forceinline__ void ph_absmax(const Args& a, float* sm) {
    unsigned* ctl = (unsigned*)(a.ws + WS_CTL); const int tid = threadIdx.x, G = gridDim.x, bid = blockIdx.x, lane = tid & 63, w = tid >> 6;
#pragma unroll
    for (int j = 0; j < 4; ++j) {
        const f32x4* p4 = (const f32x4*)(j == 0 ? a.in[8] : j == 1 ? a.in[8] + (size_t)2048 * 3648 : j == 2 ? a.in[26] : a.in[27]);
        const int n4 = (j < 2 ? 2048 * 3648 : 2048 * 5632) / 4, step = G * 512;
        float mm = 0.f;
        for (int i0 = bid * 512 + tid; i0 < n4; i0 += step * 8) {
            f32x4 v[8];
#pragma unroll
            for (int u = 0; u < 8; ++u) { const int i = i0 + u * step; v[u] = i < n4 ? __builtin_nontemporal_load(p4 + i) : (f32x4){0.f, 0.f, 0.f, 0.f}; }
#pragma unroll
            for (int u = 0; u < 8; ++u) mm = fmaxf(mm, fmaxf(fmaxf(fabsf(v[u][0]), fabsf(v[u][1])), fmaxf(fabsf(v[u][2]), fabsf(v[u][3]))));
        }
        mm = wave_max(mm);
        if (lane == 0) sm[w] = mm;
        __syncthreads();
        if (tid == 0) { float t = sm[0];
#pragma unroll
            for (int k = 1; k < 8; ++k) t = fmaxf(t, sm[k]);
            (void)__hip_atomic_fetch_max(ctl + CT_WSC + j, __float_as_uint(t), __ATOMIC_RELAXED, __HIP_MEMORY_SCOPE_AGENT); }
        __syncthreads();
    }
    if (tid == 0) (void)__hip_atomic_fetch_add(ctl + CT_AMAXDONE, 1u, __ATOMIC_RELAXED, __HIP_MEMORY_SCOPE_AGENT);
}
__device__ __forceinline__ void ph_prologue(const Args& a, float* sm) {
    const int bid = blockIdx.x, G = gridDim.x, tid = threadIdx.x;
    const int NF = G >= 128 ? 64 : 0;
    if (I8_GEMM) ph_absmax(a, sm);
    if (NF == 0) { SUBREP(4) for (int u = bid; u < 192; u += G) adaln_unit(a, u, sm); SUBREP(5) ph_filters(a, sm, bid, G); }
    else if (bid < NF) { SUBREP(5) ph_filters(a, sm, bid, NF); }
    else { SUBREP(4) for (int u = bid - NF; u < 192; u += G - NF) adaln_unit(a, u, sm); }
    { float* cosT = (float*)(a.ws + WS_ROPE); float* sinT = cosT + 2048 * 32;
      for (int i = bid * 512 + tid; i < 2048 * 32; i += G * 512) { const int t = i >> 5, f = i & 31;
          const float pos = (float)((f < 16) ? (t >> 6) : (t & 63)); const float freq = powf(10000.0f, -(float)(f & 15) / 16.0f); const float ang = pos * freq;
          cosT[i] = cosf(ang); sinT[i] = sinf(ang); } }
    for (int i = bid * 512 + tid; i < 2 * 512 * 17; i += G * 512) { const int row = i / 17, k = i - row * 17; ((bf16_t*)(a.ws + WS_FILTL))[(size_t)row * HY_RBROW + (k == 0 ? 0 : 4095 + k)] = 0; }
    { constexpr int RB16 = I8_WIN ? 128 : 256;
      for (int i = bid * 512 + tid; i < 2 * 192 * RB16; i += G * 512) { const int l = i / (192 * RB16), r = i % (192 * RB16);
        *(u32x4*)(a.ws + WS_WIN + (size_t)l * UW * D * 2 + (size_t)INW * RB16 * 16 + (size_t)r * 16) = (u32x4){0u, 0u, 0u, 0u}; } }
    if (I8_GEMM) {
        if (tid == 0) { const unsigned* dn = (const unsigned*)(a.ws + WS_CTL) + CT_AMAXDONE; unsigned sp = 0;
            while (__hip_atomic_load(dn, __ATOMIC_RELAXED, __HIP_MEMORY_SCOPE_AGENT) < (unsigned)G && ++sp < (1u << 22)) __builtin_amdgcn_s_sleep(4); }
    }
    __syncthreads();
    if ((PROBE_SUB >> 8) & 1u) ph_convert<2>(a, sm, bid, G, NCONV);
    conv_dynamic<0>(a, sm);
    if ((PROBE_SUB >> 6) & 1u) ph_convert<0>(a, sm, bid, G, NCONV);
    if ((PROBE_SUB >> 7) & 1u) ph_convert<1>(a, sm, bid, G, NCONV);
}

template <bool ROUTER, bool COPYX, int OUT8 = 0, int NSLAB = 0>
__device__ __forceinline__ void ph_normmod(const float* __restrict__ xlat, const float* __restrict__ xctx, const float* __restrict__ gain, const float* __restrict__ modl, int sh_off, int sc_off,
                                           bf16_t* __restrict__ out, int nrows, float* __restrict__ xs, const float* __restrict__ router, int* __restrict__ topi, float* __restrict__ topw,
                                           const float* __restrict__ slab = nullptr, const float* __restrict__ slab_gate = nullptr, float* __restrict__ rsc = nullptr) {
    const int lane = threadIdx.x & 63, wid = threadIdx.x >> 6;
    for (int row = blockIdx.x * 8 + wid; row < nrows; row += gridDim.x * 8) {
        const float* xr = row < NLAT ? xlat + (size_t)row * D : xctx + (size_t)(row - NLAT) * D;
        const float* mv = modl + (size_t)tok_mod(row) * 12288;
        f32x4 v[8]; float ss = 0.f;
#pragma unroll
        for (int i = 0; i < 8; ++i) { v[i] = *(const f32x4*)(xr + i * 256 + lane * 4);
            if (NSLAB > 0 && row >= NLAT) { f32x4 sa = *(const f32x4*)(slab + (size_t)(row - NLAT) * D + i * 256 + lane * 4);
#pragma unroll
                for (int sl = 1; sl < NSLAB; ++sl) sa += *(const f32x4*)(slab + ((size_t)sl * NCTX + (row - NLAT)) * D + i * 256 + lane * 4);
                v[i] += *(const f32x4*)(slab_gate + i * 256 + lane * 4) * sa; }
            ss += v[i][0] * v[i][0] + v[i][1] * v[i][1] + v[i][2] * v[i][2] + v[i][3] * v[i][3];
            if (COPYX && (NSLAB == 0 || row >= NLAT)) *(f32x4*)(xs + (size_t)row * D + i * 256 + lane * 4) = v[i]; }
        ss = wave_sum(ss);
        const float rstd = rsqrtf(ss * (1.0f / D) + EPS);
        float lg[8];
#pragma unroll
        for (int e = 0; e < 8; ++e) lg[e] = 0.f;
        float amax = 0.f;
#pragma unroll
        for (int i = 0; i < 8; ++i) {
            const int col = i * 256 + lane * 4;
            const f32x4 g = *(const f32x4*)(gain + col), sc = *(const f32x4*)(mv + sc_off + col), sh = *(const f32x4*)(mv + sh_off + col);
            f32x4 o;
#pragma unroll
            for (int j = 0; j < 4; ++j) o[j] = (v[i][j] * rstd * g[j]) * (1.0f + sc[j]) + sh[j];
            if (OUT8 == 2) { v[i] = o; amax = fmaxf(amax, fmaxf(fmaxf(fabsf(o[0]), fabsf(o[1])), fmaxf(fabsf(o[2]), fabsf(o[3])))); }
            else if (OUT8 == 1) *(unsigned*)((unsigned char*)out + (size_t)row * D + col) = pg8::pack4_fp8(o[0] * ASCALE, o[1] * ASCALE, o[2] * ASCALE, o[3] * ASCALE);
            else { u32x2 w; w.x = (unsigned)f2bf(o[0]) | ((unsigned)f2bf(o[1]) << 16); w.y = (unsigned)f2bf(o[2]) | ((unsigned)f2bf(o[3]) << 16);
                *(u32x2*)(out + (size_t)row * D + col) = w; }
            if (ROUTER) {
#pragma unroll
                for (int j = 0; j < 4; ++j) { const f32x4 r0 = *(const f32x4*)(router + (size_t)(col + j) * 8), r1 = *(const f32x4*)(router + (size_t)(col + j) * 8 + 4);
                    lg[0] += o[j] * r0[0]; lg[1] += o[j] * r0[1]; lg[2] += o[j] * r0[2]; lg[3] += o[j] * r0[3];
                    lg[4] += o[j] * r1[0]; lg[5] += o[j] * r1[1]; lg[6] += o[j] * r1[2]; lg[7] += o[j] * r1[3]; }
                asm volatile("" ::: "memory");
            }
        }
        if (OUT8 == 2) {
            amax = wave_max(amax); const float qs = amax > 0.f ? 127.0f / amax : 0.f;
#pragma unroll
            for (int i = 0; i < 8; ++i) *(unsigned*)((unsigned char*)out + (size_t)row * D + i * 256 + lane * 4) = pack4_i8(v[i][0] * qs, v[i][1] * qs, v[i][2] * qs, v[i][3] * qs);
            if (lane == 0) rsc[row] = amax * (1.0f / 127.0f);
        }
        if (ROUTER) {
#pragma unroll
            for (int e = 0; e < 8; ++e) lg[e] = wave_sum(lg[e]);
            if (lane == 0) {
                int i0 = 0; float v0 = lg[0];
#pragma unroll
                for (int e = 1; e < 8; ++e) if (lg[e] > v0) { v0 = lg[e]; i0 = e; }
                int i1 = -1; float v1 = -3.0e38f;
#pragma unroll
                for (int e = 0; e < 8; ++e) if (e != i0 && lg[e] > v1) { v1 = lg[e]; i1 = e; }
                const float e1 = expf(v1 - v0), w0 = 1.0f / (1.0f + e1), w1 = e1 / (1.0f + e1);
                topi[row * 2] = i0; topi[row * 2 + 1] = i1; topw[row * 2] = w0; topw[row * 2 + 1] = w1;
            }
        }
    }
}

__device__ __forceinline__ float bflo(unsigned w) { return __uint_as_float(w << 16); }
__device__ __forceinline__ float bfhi(unsigned w) { return __uint_as_float(w & 0xffff0000u); }
__device__ __forceinline__ unsigned pkbf(float lo, float hi) { return (unsigned)f2bf(lo) | ((unsigned)f2bf(hi) << 16); }
__device__ __forceinline__ u32x4 rope8(const u32x4 mine, const u32x4 other, bool is_x2, const f32x4 c0, const f32x4 c1, const f32x4 s0, const f32x4 s1) {
    const unsigned mw[4] = {mine.x, mine.y, mine.z, mine.w}, ow[4] = {other.x, other.y, other.z, other.w};
    const float cs[8] = {c0[0], c0[1], c0[2], c0[3], c1[0], c1[1], c1[2], c1[3]}, sn[8] = {s0[0], s0[1], s0[2], s0[3], s1[0], s1[1], s1[2], s1[3]};
    unsigned o[4];
#pragma unroll
    for (int d = 0; d < 4; ++d) {
        const float m0 = bflo(mw[d]), m1 = bfhi(mw[d]), p0 = bflo(ow[d]), p1 = bfhi(ow[d]);
        const float r0 = is_x2 ? (p0 * sn[2 * d] + m0 * cs[2 * d]) : (m0 * cs[2 * d] - p0 * sn[2 * d]);
        const float r1 = is_x2 ? (p1 * sn[2 * d + 1] + m1 * cs[2 * d + 1]) : (m1 * cs[2 * d + 1] - p1 * sn[2 * d + 1]);
        o[d] = pkbf(r0, r1);
    }
    return (u32x4){o[0], o[1], o[2], o[3]};
}
__device__ __forceinline__ u32x4 shfl4(const u32x4 v, int m) { return (u32x4){(unsigned)__shfl_xor((int)v.x, m), (unsigned)__shfl_xor((int)v.y, m), (unsigned)__shfl_xor((int)v.z, m), (unsigned)__shfl_xor((int)v.w, m)}; }
__device__ __forceinline__ void ph_mid(const Args& a, int l) {
    const bf16_t* __restrict__ U = (const bf16_t*)(a.ws + WS_U);
    const float* g_q = a.in[9] + l * 768; const float* g_kv = a.in[11] + l * 512; const float* conv_w = a.in[13] + (size_t)l * 3 * 1536; const float* conv_b = a.in[14] + l * 1536;
    const float* cosT = (const float*)(a.ws + WS_ROPE); const float* sinT = cosT + 2048 * 32;
    bf16_t* cqn = (bf16_t*)(a.ws + WS_CQN); bf16_t* ckvn = (bf16_t*)(a.ws + WS_CKVN); bf16_t* kpe = (bf16_t*)(a.ws + WS_KPE); bf16_t* x0o = (bf16_t*)(a.ws + WS_X0);
    bf16_t* wtl = (bf16_t*)(a.ws + WS_WTL); bf16_t* wtc = (bf16_t*)(a.ws + WS_WTC); bf16_t* sq = (bf16_t*)(a.ws + WS_SQ); bf16_t* sk = (bf16_t*)(a.ws + WS_SK); bf16_t* sv = (bf16_t*)(a.ws + WS_SV);
    int tid_ = threadIdx.x; asm volatile("" : "+v"(tid_));
    const int tid = tid_, lane = tid & 63, wid = tid >> 6;
    for (int unit = blockIdx.x; unit < NTOK / 16; unit += gridDim.x) {
        const int tok0 = unit * 16;
        for (int tt = 0; tt < 2; ++tt) {
            const int tok = tok0 + wid * 2 + tt; const bool lat = tok < NLAT; const int t = lat ? (tok & 2047) : ((tok - NLAT) & 255);
            const bf16_t* u = U + (size_t)tok * UW;
            const u32x2 q0 = *(const u32x2*)(u + O_CQ + lane * 12), q1 = *(const u32x2*)(u + O_CQ + lane * 12 + 4), q2 = *(const u32x2*)(u + O_CQ + lane * 12 + 8);
            const u32x4 kvv = *(const u32x4*)(u + O_CKV + lane * 8);
            const u32x4 sqv = *(const u32x4*)(u + O_SQ + lane * 8);
            const u32x4 skv = *(const u32x4*)(u + O_SK + (lane & 15) * 8);
            const u32x4 kpv = *(const u32x4*)(u + O_KPE + (lane & 7) * 8);
            const int i0 = (lane & 3) * 8;
            f32x4 c0 = (f32x4){1.f, 1.f, 1.f, 1.f}, c1 = c0, s0 = (f32x4){0.f, 0.f, 0.f, 0.f}, s1 = s0;
            if (lat) { c0 = *(const f32x4*)(cosT + t * 32 + i0); c1 = *(const f32x4*)(cosT + t * 32 + i0 + 4); s0 = *(const f32x4*)(sinT + t * 32 + i0); s1 = *(const f32x4*)(sinT + t * 32 + i0 + 4); }
            {
                const unsigned w6[6] = {q0.x, q0.y, q1.x, q1.y, q2.x, q2.y}; float x[12]; float ss = 0.f;
#pragma unroll
                for (int d = 0; d < 6; ++d) { x[2 * d] = bflo(w6[d]); x[2 * d + 1] = bfhi(w6[d]); ss += x[2 * d] * x[2 * d] + x[2 * d + 1] * x[2 * d + 1]; }
                ss = wave_sum(ss); const float rs = rsqrtf(ss * (1.0f / 768.0f) + EPS);
                const f32x4 g0 = *(const f32x4*)(g_q + lane * 12), g1 = *(const f32x4*)(g_q + lane * 12 + 4), g2 = *(const f32x4*)(g_q + lane * 12 + 8);
                u32x2 o0, o1, o2;
                o0.x = pkbf(x[0] * rs * g0[0], x[1] * rs * g0[1]); o0.y = pkbf(x[2] * rs * g0[2], x[3] * rs * g0[3]);
                o1.x = pkbf(x[4] * rs * g1[0], x[5] * rs * g1[1]); o1.y = pkbf(x[6] * rs * g1[2], x[7] * rs * g1[3]);
                o2.x = pkbf(x[8] * rs * g2[0], x[9] * rs * g2[1]); o2.y = pkbf(x[10] * rs * g2[2], x[11] * rs * g2[3]);
                bf16_t* dst = cqn + (size_t)tok * 768 + lane * 12; *(u32x2*)dst = o0; *(u32x2*)(dst + 4) = o1; *(u32x2*)(dst + 8) = o2;
            }
            {
                const unsigned w4[4] = {kvv.x, kvv.y, kvv.z, kvv.w}; float x[8]; float ss = 0.f;
#pragma unroll
                for (int d = 0; d < 4; ++d) { x[2 * d] = bflo(w4[d]); x[2 * d + 1] = bfhi(w4[d]); ss += x[2 * d] * x[2 * d] + x[2 * d + 1] * x[2 * d + 1]; }
                ss = wave_sum(ss); const float rs = rsqrtf(ss * (1.0f / 512.0f) + EPS);
                const f32x4 g0 = *(const f32x4*)(g_kv + lane * 8), g1 = *(const f32x4*)(g_kv + lane * 8 + 4);
                u32x4 o; o.x = pkbf(x[0] * rs * g0[0], x[1] * rs * g0[1]); o.y = pkbf(x[2] * rs * g0[2], x[3] * rs * g0[3]); o.z = pkbf(x[4] * rs * g1[0], x[5] * rs * g1[1]); o.w = pkbf(x[6] * rs * g1[2], x[7] * rs * g1[3]);
                *(u32x4*)(ckvn + (size_t)tok * 512 + lane * 8) = o;
            }
            const bool is_x2 = (lane & 4) != 0;
            {
                const u32x4 r = rope8(sqv, shfl4(sqv, 4), is_x2, c0, c1, s0, s1);
                *(u32x4*)(sq + (size_t)tok * 512 + lane * 8) = r;
            }
            {
                const u32x4 r = rope8(skv, shfl4(skv, 4), is_x2, c0, c1, s0, s1);
                if (lane < 16) *(u32x4*)(sk + (size_t)tok * 128 + lane * 8) = r;
            }
            {
                const u32x4 ot = shfl4(kpv, 4);
                if (lane < 4) {
                    const unsigned mw[4] = {kpv.x, kpv.y, kpv.z, kpv.w}, ow[4] = {ot.x, ot.y, ot.z, ot.w};
                    const float cs[8] = {c0[0], c0[1], c0[2], c0[3], c1[0], c1[1], c1[2], c1[3]}, sn[8] = {s0[0], s0[1], s0[2], s0[3], s1[0], s1[1], s1[2], s1[3]};
                    unsigned o[8];
#pragma unroll
                    for (int d = 0; d < 4; ++d) { const float a0 = bflo(mw[d]), a1 = bfhi(mw[d]), b0 = bflo(ow[d]), b1 = bfhi(ow[d]);
                        o[2 * d] = pkbf(a0 * cs[2 * d] - b0 * sn[2 * d], a0 * sn[2 * d] + b0 * cs[2 * d]);
                        o[2 * d + 1] = pkbf(a1 * cs[2 * d + 1] - b1 * sn[2 * d + 1], a1 * sn[2 * d + 1] + b1 * cs[2 * d + 1]); }
                    bf16_t* dst = kpe + (size_t)tok * 64 + lane * 16;
                    *(u32x4*)dst = (u32x4){o[0], o[1], o[2], o[3]}; *(u32x4*)(dst + 8) = (u32x4){o[4], o[5], o[6], o[7]};
                }
            }
        }
        {
            const bool lat = tok0 < NLAT; const int Ls = lat ? L : C;
            const int b = lat ? (tok0 >> 11) : ((tok0 - NLAT) >> 8), t0 = (lat ? (tok0 & 2047) : ((tok0 - NLAT) & 255));
            const int cp = tid & 255, hf = tid >> 8, ch = cp * 2, ts = t0 + hf * 8, tokb = tok0 + hf * 8;
            float cw[3][3][2], cb[3][2];
#pragma unroll
            for (int g = 0; g < 3; ++g) { cb[g][0] = conv_b[g * 512 + ch]; cb[g][1] = conv_b[g * 512 + ch + 1];
#pragma unroll
                for (int j = 0; j < 3; ++j) { cw[g][j][0] = conv_w[j * 1536 + g * 512 + ch]; cw[g][j][1] = conv_w[j * 1536 + g * 512 + ch + 1]; } }
            unsigned rows[3][10];
#pragma unroll
            for (int r = 0; r < 10; ++r) { const int tr = ts - 1 + r; const bool ok = tr >= 0 && tr < Ls;
#pragma unroll
                for (int g = 0; g < 3; ++g) rows[g][r] = ok ? *(const unsigned*)(U + (size_t)(tokb - 1 + r) * UW + O_HY + g * 512 + ch) : 0u; }
            unsigned wp0[4], wp1[4];
#pragma unroll
            for (int i = 0; i < 8; ++i) {
                float y[3][2];
#pragma unroll
                for (int g = 0; g < 3; ++g) {
                    y[g][0] = cb[g][0] + cw[g][0][0] * bflo(rows[g][i]) + cw[g][1][0] * bflo(rows[g][i + 1]) + cw[g][2][0] * bflo(rows[g][i + 2]);
                    y[g][1] = cb[g][1] + cw[g][0][1] * bfhi(rows[g][i]) + cw[g][1][1] * bfhi(rows[g][i + 1]) + cw[g][2][1] * bfhi(rows[g][i + 2]); }
                *(unsigned*)(x0o + (size_t)(tokb + i) * 512 + ch) = pkbf(y[0][0], y[0][1]);
                const unsigned w0 = f2bf(y[2][0] * y[1][0]), w1 = f2bf(y[2][1] * y[1][1]);
                if (i & 1) { wp0[i >> 1] |= w0 << 16; wp1[i >> 1] |= w1 << 16; } else { wp0[i >> 1] = w0; wp1[i >> 1] = w1; }
            }
            bf16_t* wt = lat ? wtl + ((size_t)b * 512 + ch) * L + ts : wtc + ((size_t)b * 512 + ch) * C + ts;
            *(u32x4*)wt = (u32x4){wp0[0], wp0[1], wp0[2], wp0[3]};
            *(u32x4*)(wt + (lat ? L : C)) = (u32x4){wp1[0], wp1[1], wp1[2], wp1[3]};
        }
        if (tid < 128) {
            unsigned pk[8];
#pragma unroll
            for (int i = 0; i < 16; ++i) { const unsigned v = U[(size_t)(tok0 + i) * UW + O_SV + tid]; if (i & 1) pk[i >> 1] |= v << 16; else pk[i >> 1] = v; }
            bf16_t* dst = sv + (size_t)tid * NTOK + tok0;
            u32x4 w0, w1; w0.x = pk[0]; w0.y = pk[1]; w0.z = pk[2]; w0.w = pk[3]; w1.x = pk[4]; w1.y = pk[5]; w1.z = pk[6]; w1.w = pk[7];
            *(u32x4*)dst = w0; *(u32x4*)(dst + 8) = w1;
        }
    }
}

__device__ __forceinline__ void ph_mla_naive(const Args& a, int nq, float* sm) {
    const bf16_t* __restrict__ Q = (const bf16_t*)(a.ws + WS_Q); const bf16_t* __restrict__ KV = (const bf16_t*)(a.ws + WS_KV); const bf16_t* __restrict__ KPE = (const bf16_t*)(a.ws + WS_KPE);
    bf16_t* mix = (bf16_t*)(a.ws + WS_MIX);
    const int lane = threadIdx.x & 63, w = threadIdx.x >> 6;
    float* qf = sm + w * 192; float* sc = sm + 8 * 192 + w * 2304;
    for (int unit = blockIdx.x; unit < nq; unit += gridDim.x) {
        const int h = unit & 7, qt = (unit >> 3) * 8 + w; const bool lat = qt < NLAT;
        const int b = lat ? (qt >> 11) : ((qt - NLAT) >> 8);
        const int nk = lat ? (L + C) : C;
        for (int i = lane; i < 192; i += 64) qf[i] = bf2f(Q[(size_t)qt * QW + h * 192 + i]);
        __syncthreads();
        const float scale = 0.07216878364870322f;
        float mx = -3.0e38f;
        for (int kc = 0; kc < nk; kc += 64) {
            const int kk = kc + lane;
            const int kt = lat ? (kk < L ? b * L + kk : NLAT + b * C + (kk - L)) : (NLAT + b * C + kk);
            float s = 0.f;
            const u32x4* kp = (const u32x4*)(KV + (size_t)kt * KVW + h * 256);
            for (int i = 0; i < 16; ++i) { const u32x4 v = kp[i]; const float* q8 = qf + i * 8;
                s += q8[0] * __uint_as_float(v.x << 16) + q8[1] * __uint_as_float(v.x & 0xffff0000u) + q8[2] * __uint_as_float(v.y << 16) + q8[3] * __uint_as_float(v.y & 0xffff0000u)
                   + q8[4] * __uint_as_float(v.z << 16) + q8[5] * __uint_as_float(v.z & 0xffff0000u) + q8[6] * __uint_as_float(v.w << 16) + q8[7] * __uint_as_float(v.w & 0xffff0000u); }
            const u32x4* pp = (const u32x4*)(KPE + (size_t)kt * 64);
            for (int i = 0; i < 8; ++i) { const u32x4 v = pp[i]; const float* q8 = qf + 128 + i * 8;
                s += q8[0] * __uint_as_float(v.x << 16) + q8[1] * __uint_as_float(v.x & 0xffff0000u) + q8[2] * __uint_as_float(v.y << 16) + q8[3] * __uint_as_float(v.y & 0xffff0000u)
                   + q8[4] * __uint_as_float(v.z << 16) + q8[5] * __uint_as_float(v.z & 0xffff0000u) + q8[6] * __uint_as_float(v.w << 16) + q8[7] * __uint_as_float(v.w & 0xffff0000u); }
            s *= scale; sc[kk] = s; mx = fmaxf(mx, s);
        }
        mx = wave_max(mx);
        float sum = 0.f;
        for (int kc = 0; kc < nk; kc += 64) { const float p = expf(sc[kc + lane] - mx); sc[kc + lane] = p; sum += p; }
        sum = wave_sum(sum);
        __syncthreads();
        float o0 = 0.f, o1 = 0.f;
        for (int kk = 0; kk < nk; ++kk) {
            const int kt = lat ? (kk < L ? b * L + kk : NLAT + b * C + (kk - L)) : (NLAT + b * C + kk);
            const unsigned v = *(const unsigned*)(KV + (size_t)kt * KVW + h * 256 + 128 + lane * 2);
            const float p = sc[kk];
            o0 += p * __uint_as_float(v << 16); o1 += p * __uint_as_float(v & 0xffff0000u);
        }
        const float inv = 1.0f / sum;
        *(unsigned*)(mix + (size_t)qt * D + h * 128 + lane * 2) = (unsigned)f2bf(o0 * inv) | ((unsigned)f2bf(o1 * inv) << 16);
        __syncthreads();
    }
}
__device__ __forceinline__ void ph_swa_naive(const Args& a, int l, int nq, float* sm) {
    const bf16_t* __restrict__ SQ = (const bf16_t*)(a.ws + WS_SQ); const bf16_t* __restrict__ SK = (const bf16_t*)(a.ws + WS_SK); const bf16_t* __restrict__ SV = (const bf16_t*)(a.ws + WS_SV);
    const float* sink = a.in[24] + l * 8; bf16_t* mix = (bf16_t*)(a.ws + WS_MIX);
    const int lane = threadIdx.x & 63, w = threadIdx.x >> 6;
    float* qf = sm + w * 64; float* sc = sm + 8 * 64 + w * 576; int* kts = (int*)(sm + 8 * 64 + 8 * 576) + w * 576;
    for (int unit = blockIdx.x; unit < nq; unit += gridDim.x) {
        const int hq = unit & 7, hk = hq >> 2, qt = (unit >> 3) * 8 + w; const bool lat = qt < NLAT;
        const int b = lat ? (qt >> 11) : ((qt - NLAT) >> 8), t = lat ? (qt & 2047) : 0;
        int lo = 0, nloc = 0;
        if (lat) { lo = t - 128 < 0 ? 0 : t - 128; const int hi = t + 128 > L - 1 ? L - 1 : t + 128; nloc = hi - lo + 1; }
        const int nk = nloc + C;
        qf[lane] = bf2f(SQ[(size_t)qt * 512 + hq * 64 + lane]);
        __syncthreads();
        const float skv = sink[hq];
        float mx = skv;
        for (int kc = 0; kc < nk; kc += 64) {
            const int kk = kc + lane;
            if (kk < nk) {
                const int kt = kk < nloc ? (b * L + lo + kk) : (NLAT + b * C + (kk - nloc));
                const u32x4* kp = (const u32x4*)(SK + (size_t)kt * 128 + hk * 64);
                float s = 0.f;
                for (int i = 0; i < 8; ++i) { const u32x4 v = kp[i]; const float* q8 = qf + i * 8;
                    s += q8[0] * __uint_as_float(v.x << 16) + q8[1] * __uint_as_float(v.x & 0xffff0000u) + q8[2] * __uint_as_float(v.y << 16) + q8[3] * __uint_as_float(v.y & 0xffff0000u)
                       + q8[4] * __uint_as_float(v.z << 16) + q8[5] * __uint_as_float(v.z & 0xffff0000u) + q8[6] * __uint_as_float(v.w << 16) + q8[7] * __uint_as_float(v.w & 0xffff0000u); }
                s *= 0.125f; sc[kk] = s; kts[kk] = kt; mx = fmaxf(mx, s);
            }
        }
        mx = wave_max(mx);
        float sum = 0.f;
        for (int kc = 0; kc < nk; kc += 64) { const int kk = kc + lane; if (kk < nk) { const float p = expf(sc[kk] - mx); sc[kk] = p; sum += p; } }
        sum = wave_sum(sum) + expf(skv - mx);
        __syncthreads();
        float o = 0.f;
        for (int kk = 0; kk < nk; ++kk) o += sc[kk] * bf2f(SV[(size_t)kts[kk] * 128 + hk * 64 + lane]);
        mix[(size_t)qt * D + 1536 + hq * 64 + lane] = f2bf(o / sum);
        __syncthreads();
    }
}
template <int LS>
__device__ __forceinline__ void ph_hyena_naive(const Args& a, int l, float* sm) {
    const float* filt = LS == L ? (const float*)(a.ws + WS_FILTL) + (size_t)l * 512 * 4096 : (const float*)(a.ws + WS_FILTC) + (size_t)l * 512 * 512;
    const bf16_t* wt = (const bf16_t*)(a.ws + (LS == L ? WS_WTL : WS_WTC)); const bf16_t* x0 = (const bf16_t*)(a.ws + WS_X0); const float* skip = a.in[23] + l * 512;
    bf16_t* mix = (bf16_t*)(a.ws + WS_MIX); const int tok_base = LS == L ? 0 : NLAT;
    float* T = sm; float* ws = sm + 2 * LS; const int tid = threadIdx.x;
    for (int unit = blockIdx.x; unit < 512 * NB; unit += gridDim.x) {
        const int ch = unit >> 2, b = unit & 3;
        for (int i = tid; i < 2 * LS; i += NTHR) T[i] = filt[(size_t)ch * 2 * LS + i];
        for (int i = tid; i < LS; i += NTHR) ws[i] = bf2f(wt[((size_t)b * 512 + ch) * LS + i]);
        __syncthreads();
        const float sk = skip[ch];
        for (int t = tid; t < LS; t += NTHR) {
            float y = 0.f;
            for (int s = 0; s < LS; ++s) y += T[t - s + LS] * ws[s];
            ((bf16_t*)(a.ws + WS_YT))[(LS == L ? (size_t)0 : (size_t)NB * 512 * L) + ((size_t)b * 512 + ch) * LS + t] = f2bf(y);
        }
        __syncthreads();
    }
}
__device__ __forceinline__ void ph_route_gather(const Args& a, int* sm) {
    const int* __restrict__ topi = (const int*)(a.ws + WS_TOPI); int* __restrict__ pos = (int*)(a.ws + WS_POS); int* ctl = (int*)(a.ws + WS_CTL);
    const unsigned char* __restrict__ hb = (const unsigned char*)(a.ws + WS_HA); unsigned char* __restrict__ hbs = (unsigned char*)(a.ws + WS_HBS);
    int (*cnt)[512] = (int (*)[512])sm; int* tot = sm + 8 * 512; int* ppos = sm + 8 * 512 + 16;
    const int tid = threadIdx.x, lane = tid & 63, w = tid >> 6;
    int c[8];
#pragma unroll
    for (int e = 0; e < 8; ++e) c[e] = 0;
    for (int i = 0; i < 32; i += 4) { const u32x4 e4 = *(const u32x4*)(topi + tid * 32 + i);
#pragma unroll
        for (int q = 0; q < 8; ++q) c[q] += (e4.x == (unsigned)q) + (e4.y == (unsigned)q) + (e4.z == (unsigned)q) + (e4.w == (unsigned)q); }
#pragma unroll
    for (int e = 0; e < 8; ++e) cnt[e][tid] = c[e];
    __syncthreads();
    {
        int v[8]; int s8 = 0;
#pragma unroll
        for (int k = 0; k < 8; ++k) { v[k] = cnt[w][lane * 8 + k]; s8 += v[k]; }
        int incl = s8;
#pragma unroll
        for (int off = 1; off < 64; off <<= 1) { const int t = __shfl_up(incl, off); if (lane >= off) incl += t; }
        int run = incl - s8;
#pragma unroll
        for (int k = 0; k < 8; ++k) { cnt[w][lane * 8 + k] = run; run += v[k]; }
        if (lane == 63) tot[w] = incl;
    }
    __syncthreads();
    int eoff[8]; int o = 0;
#pragma unroll
    for (int e = 0; e < 8; ++e) { eoff[e] = o; o += (tot[e] + 255) & ~255; }
    if (blockIdx.x == 0 && tid == 0) {
#pragma unroll
        for (int e = 0; e < 8; ++e) { ctl[CT_EOFF + e] = eoff[e]; ctl[CT_EPAD + e] = (tot[e] + 255) & ~255; }
        ctl[CT_NTILE] = o >> 8; const int nwg = (o >> 8) * (D / 256); ctl[CT_MOES] = pg8::split_S(nwg, DFE / 128, 256); ctl[CT_TROW] = (nwg / 256) * 256 / (D / 256) * 256;
    }
    for (int tg = blockIdx.x; tg < NLAT / 32; tg += gridDim.x) {
        if (tid < 64) {
            const int idx = 64 * tg + tid, owner = idx >> 5, e = topi[idx]; int p = 0;
#pragma unroll
            for (int q = 0; q < 8; ++q) { const unsigned long long mk = __ballot(e == q);
                if (e == q) { const unsigned hm = (unsigned)(mk >> (32 * (tid >> 5))); p = eoff[q] + cnt[q][owner] + __popc(hm & ((1u << (tid & 31)) - 1u)); } }
            pos[idx] = p; ppos[tid] = p;
        }
        __syncthreads();
#pragma unroll
        for (int k = 0; k < 4; ++k) { const int tl = 4 * w + k; const int tok = 32 * tg + tl;
            const u32x4 v0 = *(const u32x4*)(hb + (size_t)tok * D + lane * 32), v1 = *(const u32x4*)(hb + (size_t)tok * D + lane * 32 + 16);
            const int p0 = ppos[2 * tl], p1 = ppos[2 * tl + 1];
            *(u32x4*)(hbs + (size_t)p0 * D + lane * 32) = v0; *(u32x4*)(hbs + (size_t)p0 * D + lane * 32 + 16) = v1;
            *(u32x4*)(hbs + (size_t)p1 * D + lane * 32) = v0; *(u32x4*)(hbs + (size_t)p1 * D + lane * 32 + 16) = v1; }
        __syncthreads();
    }
}
__device__ __forceinline__ void ph_final(const Args& a) {
    const float* xs = (const float*)(a.ws + WS_XS); const bf16_t* ys = (const bf16_t*)(a.ws + WS_YS); const int* pos = (const int*)(a.ws + WS_POS); const float* topw = (const float*)(a.ws + WS_TOPW);
    const float* modl = (const float*)(a.ws + WS_MOD) + (size_t)5 * 12288; const float* gfin = a.in[33]; float* out = a.out;
    const int lane = threadIdx.x & 63, wid = threadIdx.x >> 6;
    const int* ctl = (const int*)(a.ws + WS_CTL); const int nsl = ctl[CT_MOES], trow0 = ctl[CT_TROW], trows = ctl[CT_NTILE] * 256 - trow0; const float* slab = (const float*)(a.ws + WS_SLAB);
    for (int row = blockIdx.x * 8 + wid; row < NLAT; row += gridDim.x * 8) {
        const float* g2 = modl + (size_t)tok_mod(row) * 12288 + 10240;
        const int p0 = pos[row * 2], p1 = pos[row * 2 + 1]; const float w0 = topw[row * 2], w1 = topw[row * 2 + 1];
        const bool t0 = nsl > 1 && p0 >= trow0, t1 = nsl > 1 && p1 >= trow0;
        f32x4 v[8]; float ss = 0.f;
#pragma unroll
        for (int i = 0; i < 8; ++i) { const int col = i * 256 + lane * 4;
            const f32x4 x = *(const f32x4*)(xs + (size_t)row * D + col), g = *(const f32x4*)(g2 + col); f32x4 ya, yb;
            if (t0) { ya = *(const f32x4*)(slab + (size_t)(p0 - trow0) * D + col); for (int sl = 1; sl < nsl; ++sl) ya += *(const f32x4*)(slab + ((size_t)sl * trows + (p0 - trow0)) * D + col); }
            else { const u32x2 q = *(const u32x2*)(ys + (size_t)p0 * D + col); ya = (f32x4){__uint_as_float(q.x << 16), __uint_as_float(q.x & 0xffff0000u), __uint_as_float(q.y << 16), __uint_as_float(q.y & 0xffff0000u)}; }
            if (t1) { yb = *(const f32x4*)(slab + (size_t)(p1 - trow0) * D + col); for (int sl = 1; sl < nsl; ++sl) yb += *(const f32x4*)(slab + ((size_t)sl * trows + (p1 - trow0)) * D + col); }
            else { const u32x2 q = *(const u32x2*)(ys + (size_t)p1 * D + col); yb = (f32x4){__uint_as_float(q.x << 16), __uint_as_float(q.x & 0xffff0000u), __uint_as_float(q.y << 16), __uint_as_float(q.y & 0xffff0000u)}; }
#pragma unroll
            for (int j = 0; j < 4; ++j) { v[i][j] = x[j] + g[j] * (w0 * ya[j] + w1 * yb[j]); ss += v[i][j] * v[i][j]; } }
        ss = wave_sum(ss); const float rstd = rsqrtf(ss * (1.0f / D) + EPS);
#pragma unroll
        for (int i = 0; i < 8; ++i) { const int col = i * 256 + lane * 4; const f32x4 g = *(const f32x4*)(gfin + col); f32x4 o;
#pragma unroll
            for (int j = 0; j < 4; ++j) o[j] = v[i][j] * rstd * g[j];
            *(f32x4*)(out + (size_t)row * D + col) = o; }
    }
}

typedef float f32x2_t __attribute__((ext_vector_type(2))); typedef __bf16 bf16x2_t __attribute__((ext_vector_type(2)));
__device__ __forceinline__ unsigned cvtpk(float lo, float hi) { f32x2_t v = {lo, hi}; bf16x2_t b = __builtin_convertvector(v, bf16x2_t); return __builtin_bit_cast(unsigned, b); }
#define MFMA32(a, b, c) __builtin_amdgcn_mfma_f32_32x32x16_bf16((a), (b), (c), 0, 0, 0)
constexpr int MLA_KP = 400, MLA_VP = 144, MLA_KB = 64 * MLA_KP, MLA_VB = 128 * MLA_VP, MLA_STAGE = MLA_KB + MLA_VB;
static_assert(2 * MLA_STAGE <= RING_BYTES, "MLA LDS");

__device__ __forceinline__ void ph_mla(const Args& a, bool with_ctx, unsigned char* lds) {
    const bf16_t* __restrict__ Q = (const bf16_t*)(a.ws + WS_Q); const bf16_t* __restrict__ KN = (const bf16_t*)(a.ws + WS_KN); const bf16_t* __restrict__ KPE = (const bf16_t*)(a.ws + WS_KPE);
    const bf16_t* __restrict__ VT = (const bf16_t*)(a.ws + WS_VT); bf16_t* __restrict__ mix = (bf16_t*)(a.ws + WS_MIX);
    int tid_ = threadIdx.x; asm volatile("" : "+v"(tid_));
    const int tid = tid_, lane = tid & 63, w = tid >> 6, qi = lane & 31, hh = lane >> 5;
    const int nunits = with_ctx ? 288 : 256;
    const float c = 0.07216878364870322f * 1.4426950408889634f;
    for (int unit = blockIdx.x; unit < nunits; unit += gridDim.x) {
        int h, b, q0tok, nt; bool ctxq;
        if (unit < 256) { h = unit & 7; b = unit >> 6; q0tok = b * L + ((unit >> 3) & 7) * 256; nt = 36; ctxq = false; }
        else { const int u2 = unit - 256; h = u2 & 7; b = u2 >> 3; q0tok = NLAT + b * C; nt = 4; ctxq = true; }
#define MLA_KTOK(t) (ctxq ? (NLAT + b * C + (t) * 64) : ((t) < 32 ? (b * L + (t) * 64) : (NLAT + b * C + ((t) - 32) * 64)))
        u32x4 r0, r1, r2, r3, r4;
#define MLA_ISSUE_K(t) do { const int kt0_ = MLA_KTOK(t); \
            r0 = *(const u32x4*)(KN + (size_t)(kt0_ + (tid >> 4)) * 1024 + h * 128 + (tid & 15) * 8); \
            r1 = *(const u32x4*)(KN + (size_t)(kt0_ + 32 + (tid >> 4)) * 1024 + h * 128 + (tid & 15) * 8); \
            r2 = *(const u32x4*)(KPE + (size_t)(kt0_ + (tid >> 3)) * 64 + (tid & 7) * 8); } while (0)
#define MLA_ISSUE_V(t) do { const int kt0_ = MLA_KTOK(t); \
            r3 = *(const u32x4*)(VT + (size_t)(h * 128 + (tid >> 3)) * NTOK + kt0_ + (tid & 7) * 8); \
            r4 = *(const u32x4*)(VT + (size_t)(h * 128 + 64 + (tid >> 3)) * NTOK + kt0_ + (tid & 7) * 8); } while (0)
#define MLA_ISSUE(t) do { MLA_ISSUE_K(t); MLA_ISSUE_V(t); } while (0)
#define MLA_COMMIT(buf) do { unsigned char* kb_ = lds + (buf) * MLA_STAGE; unsigned char* vb_ = kb_ + MLA_KB; \
            *(u32x4*)(kb_ + (tid >> 4) * MLA_KP + (tid & 15) * 16) = r0; \
            *(u32x4*)(kb_ + (32 + (tid >> 4)) * MLA_KP + (tid & 15) * 16) = r1; \
            *(u32x4*)(kb_ + (tid >> 3) * MLA_KP + 256 + (tid & 7) * 16) = r2; \
            const int g_ = (tid & 7) >> 1, e_ = tid & 1; \
            { u32x2 lo_, hi_; lo_.x = r3.x; lo_.y = r3.y; hi_.x = r3.z; hi_.y = r3.w; \
              *(u32x2*)(vb_ + (tid >> 3) * MLA_VP + g_ * 32 + e_ * 8) = lo_; *(u32x2*)(vb_ + (tid >> 3) * MLA_VP + g_ * 32 + 16 + e_ * 8) = hi_; } \
            { u32x2 lo_, hi_; lo_.x = r4.x; lo_.y = r4.y; hi_.x = r4.z; hi_.y = r4.w; \
              *(u32x2*)(vb_ + (64 + (tid >> 3)) * MLA_VP + g_ * 32 + e_ * 8) = lo_; *(u32x2*)(vb_ + (64 + (tid >> 3)) * MLA_VP + g_ * 32 + 16 + e_ * 8) = hi_; } } while (0)
        const int qtok = q0tok + w * 32 + qi;
        bf16x8 qf[12];
#pragma unroll
        for (int s = 0; s < 12; ++s) qf[s] = *(const bf16x8*)(Q + (size_t)qtok * QW + h * 192 + s * 16 + hh * 8);
        f32x16 o[4];
#pragma unroll
        for (int d = 0; d < 4; ++d)
#pragma unroll
            for (int r = 0; r < 16; ++r) o[d][r] = 0.f;
        float m = -1.0e30f, l = 0.f;
        MLA_ISSUE(0); MLA_COMMIT(0);
        __syncthreads();
        for (int t = 0; t < nt; ++t) {
            const unsigned char* kb = lds + (t & 1) * MLA_STAGE; const unsigned char* vb = kb + MLA_KB;
            f32x16 s0, s1;
#pragma unroll
            for (int r = 0; r < 16; ++r) { s0[r] = 0.f; s1[r] = 0.f; }
#pragma unroll
            for (int s = 0; s < 12; ++s) {
                const bf16x8 k0 = *(const bf16x8*)(kb + qi * MLA_KP + s * 32 + hh * 16);
                const bf16x8 k1 = *(const bf16x8*)(kb + (32 + qi) * MLA_KP + s * 32 + hh * 16);
                s0 = MFMA32(k0, qf[s], s0); s1 = MFMA32(k1, qf[s], s1);
                if ((s & 3) == 3) asm volatile("" ::: "memory");
            }
            if (t + 1 < nt) MLA_ISSUE(t + 1);
            float mx = fmaxf(s0[0], s1[0]);
#pragma unroll
            for (int r = 1; r < 16; ++r) mx = fmaxf(mx, fmaxf(s0[r], s1[r]));
            mx = fmaxf(mx, __shfl_xor(mx, 32));
            const float mnew = fmaxf(m, mx * c);
            const float alpha = __builtin_amdgcn_exp2f(m - mnew);
            m = mnew;
            float ps = 0.f;
#pragma unroll
            for (int r = 0; r < 16; ++r) { s0[r] = __builtin_amdgcn_exp2f(s0[r] * c - mnew); s1[r] = __builtin_amdgcn_exp2f(s1[r] * c - mnew); ps += s0[r] + s1[r]; }
            l = l * alpha + ps;
            if ((PROBE_SUB >> 9) & 1u) {
                float ps2 = 0.f;
#pragma unroll
                for (int r = 0; r < 16; ++r) { float x0 = s0[r], x1 = s1[r]; asm volatile("" : "+v"(x0), "+v"(x1)); ps2 += __builtin_amdgcn_exp2f(x0 * c - 40.f) + __builtin_amdgcn_exp2f(x1 * c - 40.f); }
                float mx2 = ps2;
#pragma unroll
                for (int r = 0; r < 16; ++r) { float x0 = s0[r], x1 = s1[r]; asm volatile("" : "+v"(x0), "+v"(x1)); mx2 = fmaxf(mx2, fmaxf(x0 * c, x1 * c)); }
                if (mx2 == 123456.75f) l += ps2;
            }
            if ((PROBE_SUB >> 10) & 1u) {
                f32x16 sx;
#pragma unroll
                for (int r = 0; r < 16; ++r) sx[r] = 0.f;
#pragma unroll
                for (int s = 0; s < 12; ++s) { bf16x8 k0 = *(const bf16x8*)(kb + qi * MLA_KP + s * 32 + hh * 16); sx = MFMA32(k0, qf[s], sx); }
                if (sx[0] == 123456.75f) l += sx[1];
            }
#pragma unroll
            for (int d = 0; d < 4; ++d)
#pragma unroll
                for (int r = 0; r < 16; ++r) o[d][r] *= alpha;
            bf16x8 pf[4];
            { u32x4 p;
              p.x = cvtpk(s0[0], s0[1]); p.y = cvtpk(s0[2], s0[3]); p.z = cvtpk(s0[4], s0[5]); p.w = cvtpk(s0[6], s0[7]); pf[0] = __builtin_bit_cast(bf16x8, p);
              p.x = cvtpk(s0[8], s0[9]); p.y = cvtpk(s0[10], s0[11]); p.z = cvtpk(s0[12], s0[13]); p.w = cvtpk(s0[14], s0[15]); pf[1] = __builtin_bit_cast(bf16x8, p);
              p.x = cvtpk(s1[0], s1[1]); p.y = cvtpk(s1[2], s1[3]); p.z = cvtpk(s1[4], s1[5]); p.w = cvtpk(s1[6], s1[7]); pf[2] = __builtin_bit_cast(bf16x8, p);
              p.x = cvtpk(s1[8], s1[9]); p.y = cvtpk(s1[10], s1[11]); p.z = cvtpk(s1[12], s1[13]); p.w = cvtpk(s1[14], s1[15]); pf[3] = __builtin_bit_cast(bf16x8, p); }
            asm volatile("" ::: "memory");
#pragma unroll
            for (int d = 0; d < 4; ++d) {
#pragma unroll
                for (int g = 0; g < 4; ++g) {
                    const bf16x8 vf = *(const bf16x8*)(vb + (d * 32 + qi) * MLA_VP + g * 32 + hh * 16);
                    o[d] = MFMA32(vf, pf[g], o[d]);
                }
                if (d & 1) asm volatile("" ::: "memory");
            }
            if (t + 1 < nt) MLA_COMMIT((t + 1) & 1);
            __syncthreads();
        }
        const float inv = 1.0f / (l + __shfl_xor(l, 32));
        bf16_t* op = mix + (size_t)qtok * D + h * 128 + 4 * hh;
#pragma unroll
        for (int d = 0; d < 4; ++d)
#pragma unroll
            for (int g = 0; g < 4; ++g) { u32x2 wv; wv.x = cvtpk(o[d][4 * g] * inv, o[d][4 * g + 1] * inv); wv.y = cvtpk(o[d][4 * g + 2] * inv, o[d][4 * g + 3] * inv);
                *(u32x2*)(op + d * 32 + 8 * g) = wv; }
#undef MLA_KTOK
#undef MLA_ISSUE
#undef MLA_ISSUE_K
#undef MLA_ISSUE_V
#undef MLA_COMMIT
    }
}

constexpr int HY_CS = 8224, HY_WS = 5136, HY_WOFF = 8 * HY_CS, HY_RBL = HY_WOFF + 4 * HY_WS;
static_assert(HY_RBL + 516 * 16 <= RING_BYTES, "hyena LDS");

__device__ __forceinline__ u32x4 hy_shift(const u32x4 a, const u32x4 b, int r) {
    switch (r) {
    case 0: return b;
    case 1: return (u32x4){__builtin_amdgcn_alignbyte(b.x, a.w, 2), __builtin_amdgcn_alignbyte(b.y, b.x, 2), __builtin_amdgcn_alignbyte(b.z, b.y, 2), __builtin_amdgcn_alignbyte(b.w, b.z, 2)};
    case 2: return (u32x4){a.w, b.x, b.y, b.z};
    case 3: return (u32x4){__builtin_amdgcn_alignbyte(a.w, a.z, 2), __builtin_amdgcn_alignbyte(b.x, a.w, 2), __builtin_amdgcn_alignbyte(b.y, b.x, 2), __builtin_amdgcn_alignbyte(b.z, b.y, 2)};
    case 4: return (u32x4){a.z, a.w, b.x, b.y};
    case 5: return (u32x4){__builtin_amdgcn_alignbyte(a.z, a.y, 2), __builtin_amdgcn_alignbyte(a.w, a.z, 2), __builtin_amdgcn_alignbyte(b.x, a.w, 2), __builtin_amdgcn_alignbyte(b.y, b.x, 2)};
    case 6: return (u32x4){a.y, a.z, a.w, b.x};
    default: return (u32x4){__builtin_amdgcn_alignbyte(a.y, a.x, 2), __builtin_amdgcn_alignbyte(a.z, a.y, 2), __builtin_amdgcn_alignbyte(a.w, a.z, 2), __builtin_amdgcn_alignbyte(b.x, a.w, 2)};
    }
}

__device__ __forceinline__ void ph_hyena(const Args& a, int l, unsigned char* lds) {
    const bf16_t* __restrict__ RB = (const bf16_t*)(a.ws + WS_FILTL) + (size_t)l * 512 * HY_RBROW;
    const bf16_t* __restrict__ wtl = (const bf16_t*)(a.ws + WS_WTL);
    int tid_ = threadIdx.x; asm volatile("" : "+v"(tid_));
    const int tid = tid_, lane = tid & 63, w = __builtin_amdgcn_readfirstlane(tid >> 6), i = lane & 31, hh = lane >> 5;
    for (int unit = blockIdx.x; unit < 512; unit += gridDim.x) {
        const int c = unit;
        for (int k = tid; k < 515; k += NTHR) { u32x4 v = (u32x4){0u, 0u, 0u, 0u}; if (k < 513) v = *(const u32x4*)(RB + (size_t)c * HY_RBROW + k * 8); *(u32x4*)(lds + HY_RBL + k * 16) = v; }
        for (int k = tid; k < 4 * 321; k += NTHR) { const int b = k / 321, sl = k - b * 321; u32x4 v = (u32x4){0u, 0u, 0u, 0u};
            if (sl >= 28 && sl < 284) v = *(const u32x4*)(wtl + ((size_t)b * 512 + c) * L + (sl - 28) * 8);
            *(u32x4*)(lds + HY_WOFF + b * HY_WS + sl * 16) = v; }
        __syncthreads();
        for (int qs = lane; qs < 511; qs += 64) {
            const u32x4 ca = *(const u32x4*)(lds + HY_RBL + qs * 16), cb = *(const u32x4*)(lds + HY_RBL + qs * 16 + 16);
            *(u32x4*)(lds + w * HY_CS + qs * 16) = hy_shift(ca, cb, w);
        }
        __syncthreads();
        f32x16 acc0, acc1;
#pragma unroll
        for (int r = 0; r < 16; ++r) { acc0[r] = 0.f; acc1[r] = 0.f; }
        const int Tl = i >> 2, b = i & 3;
        const unsigned char* ap = lds + (i & 7) * HY_CS + (hh - (i >> 3) + 255) * 16;
        const unsigned char* bp = lds + HY_WOFF + b * HY_WS + (224 + 16 * (2 * (8 * w + Tl)) + 8 * hh) * 2;
        const int d0 = 16 * w - 127;
#pragma unroll 2
        for (int dd = 0; dd < 142; dd += 2) {
            const int d = d0 + dd;
            const bf16x8 a0 = *(const bf16x8*)(ap - 32 * d), b0 = *(const bf16x8*)(bp - 32 * d);
            const bf16x8 a1 = *(const bf16x8*)(ap - 32 * (d + 1)), b1 = *(const bf16x8*)(bp - 32 * (d + 1));
            acc0 = MFMA32(a0, b0, acc0); acc1 = MFMA32(a1, b1, acc1);
        }
        bf16_t* yt = (bf16_t*)(a.ws + WS_YT) + ((size_t)b * 512 + c) * L + 32 * (8 * w + Tl) + 4 * hh;
#pragma unroll
        for (int g = 0; g < 4; ++g) { u32x2 wv; wv.x = cvtpk(acc0[4 * g] + acc1[4 * g], acc0[4 * g + 1] + acc1[4 * g + 1]); wv.y = cvtpk(acc0[4 * g + 2] + acc1[4 * g + 2], acc0[4 * g + 3] + acc1[4 * g + 3]);
            *(u32x2*)(yt + 8 * g) = wv; }
        __syncthreads();
    }
}

__device__ __forceinline__ void ph_hyena_fin(const Args& a, int l, bool with_ctx, unsigned char* lds) {
    const bf16_t* __restrict__ YT = (const bf16_t*)(a.ws + WS_YT); const bf16_t* __restrict__ wtl = (const bf16_t*)(a.ws + WS_WTL); const bf16_t* __restrict__ wtc = (const bf16_t*)(a.ws + WS_WTC);
    const bf16_t* __restrict__ x0 = (const bf16_t*)(a.ws + WS_X0); const float* skip = a.in[23] + l * 512; bf16_t* __restrict__ mix = (bf16_t*)(a.ws + WS_MIX);
    int tid_ = threadIdx.x; asm volatile("" : "+v"(tid_));
    const int tid = tid_;
    bf16_t* T = (bf16_t*)lds;
    constexpr int TP = 520;
    const int nunits = with_ctx ? 144 : 128;
    for (int unit = (int)gridDim.x - 1 - (int)blockIdx.x; unit < nunits; unit += gridDim.x) {
        const bool lat = unit < 128; const int b = lat ? (unit >> 5) : ((unit - 128) >> 2), t0 = lat ? (unit & 31) * 64 : ((unit - 128) & 3) * 64;
        const int Ls = lat ? L : C; const int tok0 = lat ? b * L + t0 : NLAT + b * C + t0;
        const bf16_t* yrow = (lat ? YT : YT + (size_t)NB * 512 * L) + ((size_t)b * 512 + tid) * Ls + t0;
        const bf16_t* wrow = (lat ? wtl : wtc) + ((size_t)b * 512 + tid) * Ls + t0;
        const float sk = skip[tid];
#pragma unroll
        for (int hf = 0; hf < 2; ++hf) {
            u32x4 yv[4], wv[4];
#pragma unroll
            for (int q = 0; q < 4; ++q) { yv[q] = *(const u32x4*)(yrow + hf * 32 + q * 8); wv[q] = *(const u32x4*)(wrow + hf * 32 + q * 8); }
#pragma unroll
            for (int q = 0; q < 4; ++q) { const unsigned yy[4] = {yv[q].x, yv[q].y, yv[q].z, yv[q].w}, ww[4] = {wv[q].x, wv[q].y, wv[q].z, wv[q].w};
#pragma unroll
                for (int d = 0; d < 4; ++d) { const int t = hf * 32 + q * 8 + 2 * d;
                    T[t * TP + tid] = f2bf(__uint_as_float(yy[d] << 16) + sk * __uint_as_float(ww[d] << 16));
                    T[(t + 1) * TP + tid] = f2bf(__uint_as_float(yy[d] & 0xffff0000u) + sk * __uint_as_float(ww[d] & 0xffff0000u)); } }
        }
        __syncthreads();
#pragma unroll
        for (int j = 0; j < 8; ++j) { const int o = tid + 512 * j, t = o >> 6, cc = (o & 63) * 8;
            const u32x4 tv = *(const u32x4*)(T + t * TP + cc), xv = *(const u32x4*)(x0 + (size_t)(tok0 + t) * 512 + cc);
            const unsigned tt[4] = {tv.x, tv.y, tv.z, tv.w}, xx[4] = {xv.x, xv.y, xv.z, xv.w}; unsigned oo[4];
#pragma unroll
            for (int d = 0; d < 4; ++d) oo[d] = cvtpk(__uint_as_float(tt[d] << 16) * __uint_as_float(xx[d] << 16), __uint_as_float(tt[d] & 0xffff0000u) * __uint_as_float(xx[d] & 0xffff0000u));
            *(u32x4*)(mix + (size_t)(tok0 + t) * D + 1024 + cc) = (u32x4){oo[0], oo[1], oo[2], oo[3]}; }
        __syncthreads();
    }
}

constexpr int SWA_P = 144, SWA_KB = 64 * SWA_P, SWA_STAGE = 2 * SWA_KB;
__device__ __forceinline__ void ph_swa(const Args& a, int l, bool with_ctx, unsigned char* lds) {
    const bf16_t* __restrict__ SQ = (const bf16_t*)(a.ws + WS_SQ); const bf16_t* __restrict__ SK = (const bf16_t*)(a.ws + WS_SK); const bf16_t* __restrict__ SVT = (const bf16_t*)(a.ws + WS_SV);
    const float* sink = a.in[24] + l * 8; bf16_t* __restrict__ mix = (bf16_t*)(a.ws + WS_MIX);
    int tid_ = threadIdx.x; asm volatile("" : "+v"(tid_));
    const int tid = tid_, lane = tid & 63, w = tid >> 6, qi = lane & 31, hh = lane >> 5;
    const int nunits = with_ctx ? 288 : 256;
    const float c = 0.125f * 1.4426950408889634f;
    for (int unit = blockIdx.x; unit < nunits; unit += gridDim.x) {
        int hk, b, p0, nloc, t0loc, q0tok; bool ctxq;
        if (unit < 256) { hk = unit & 1; b = (unit >> 1) & 3; p0 = (unit >> 3) * 64; ctxq = false; q0tok = b * L + p0;
            const int lo = p0 - 128 < 0 ? 0 : p0 - 128, hi = p0 + 192 > L ? L : p0 + 192; t0loc = lo; nloc = (hi - lo) >> 6; }
        else { const int u2 = unit - 256; hk = u2 & 1; b = (u2 >> 1) & 3; p0 = (u2 >> 3) * 64; ctxq = true; q0tok = NLAT + b * C + p0; t0loc = 0; nloc = 0; }
        const int nt = nloc + 4;
#define SWA_KTOK(t) ((t) < nloc ? (b * L + t0loc + (t) * 64) : (NLAT + b * C + ((t) - nloc) * 64))
        u32x4 r0, r1;
#define SWA_ISSUE(t) do { const int kt0_ = SWA_KTOK(t); \
            r0 = *(const u32x4*)(SK + (size_t)(kt0_ + (tid >> 3)) * 128 + hk * 64 + (tid & 7) * 8); \
            r1 = *(const u32x4*)(SVT + (size_t)(hk * 64 + (tid >> 3)) * NTOK + kt0_ + (tid & 7) * 8); } while (0)
#define SWA_COMMIT(buf) do { unsigned char* kb_ = lds + (buf) * SWA_STAGE; unsigned char* vb_ = kb_ + SWA_KB; \
            *(u32x4*)(kb_ + (tid >> 3) * SWA_P + (tid & 7) * 16) = r0; \
            const int g_ = (tid & 7) >> 1, e_ = tid & 1; u32x2 lo_, hi_; lo_.x = r1.x; lo_.y = r1.y; hi_.x = r1.z; hi_.y = r1.w; \
            *(u32x2*)(vb_ + (tid >> 3) * SWA_P + g_ * 32 + e_ * 8) = lo_; *(u32x2*)(vb_ + (tid >> 3) * SWA_P + g_ * 32 + 16 + e_ * 8) = hi_; } while (0)
        const int hq = hk * 4 + (w >> 1), qpos = p0 + (w & 1) * 32 + qi, qtok = q0tok + (w & 1) * 32 + qi;
        bf16x8 qf[4];
#pragma unroll
        for (int s = 0; s < 4; ++s) qf[s] = *(const bf16x8*)(SQ + (size_t)qtok * 512 + hq * 64 + s * 16 + hh * 8);
        f32x16 o[2];
#pragma unroll
        for (int d = 0; d < 2; ++d)
#pragma unroll
            for (int r = 0; r < 16; ++r) o[d][r] = 0.f;
        float m = sink[hq] * 1.4426950408889634f, lsum = hh == 0 ? 1.0f : 0.0f;
        SWA_ISSUE(0); SWA_COMMIT(0);
        __syncthreads();
        for (int t = 0; t < nt; ++t) {
            const unsigned char* kb = lds + (t & 1) * SWA_STAGE; const unsigned char* vb = kb + SWA_KB;
            f32x16 s0, s1;
#pragma unroll
            for (int r = 0; r < 16; ++r) { s0[r] = 0.f; s1[r] = 0.f; }
#pragma unroll
            for (int s = 0; s < 4; ++s) {
                const bf16x8 k0 = *(const bf16x8*)(kb + qi * SWA_P + s * 32 + hh * 16);
                const bf16x8 k1 = *(const bf16x8*)(kb + (32 + qi) * SWA_P + s * 32 + hh * 16);
                s0 = MFMA32(k0, qf[s], s0); s1 = MFMA32(k1, qf[s], s1);
            }
            if (t + 1 < nt) SWA_ISSUE(t + 1);
            if (t < nloc) {
                const int kbase = t0loc + t * 64 + 4 * hh - qpos;
#pragma unroll
                for (int r = 0; r < 16; ++r) { const int dlt = kbase + (r & 3) + 8 * (r >> 2);
                    if (dlt > 128 || dlt < -128) s0[r] = -1.0e30f;
                    if (dlt + 32 > 128 || dlt + 32 < -128) s1[r] = -1.0e30f; }
            }
            float mx = fmaxf(s0[0], s1[0]);
#pragma unroll
            for (int r = 1; r < 16; ++r) mx = fmaxf(mx, fmaxf(s0[r], s1[r]));
            mx = fmaxf(mx, __shfl_xor(mx, 32));
            const float mnew = fmaxf(m, mx * c);
            const float alpha = __builtin_amdgcn_exp2f(m - mnew);
            m = mnew;
            float ps = 0.f;
#pragma unroll
            for (int r = 0; r < 16; ++r) { s0[r] = __builtin_amdgcn_exp2f(s0[r] * c - mnew); s1[r] = __builtin_amdgcn_exp2f(s1[r] * c - mnew); ps += s0[r] + s1[r]; }
            lsum = lsum * alpha + ps;
#pragma unroll
            for (int d = 0; d < 2; ++d)
#pragma unroll
                for (int r = 0; r < 16; ++r) o[d][r] *= alpha;
            bf16x8 pf[4];
            { u32x4 p;
              p.x = cvtpk(s0[0], s0[1]); p.y = cvtpk(s0[2], s0[3]); p.z = cvtpk(s0[4], s0[5]); p.w = cvtpk(s0[6], s0[7]); pf[0] = __builtin_bit_cast(bf16x8, p);
              p.x = cvtpk(s0[8], s0[9]); p.y = cvtpk(s0[10], s0[11]); p.z = cvtpk(s0[12], s0[13]); p.w = cvtpk(s0[14], s0[15]); pf[1] = __builtin_bit_cast(bf16x8, p);
              p.x = cvtpk(s1[0], s1[1]); p.y = cvtpk(s1[2], s1[3]); p.z = cvtpk(s1[4], s1[5]); p.w = cvtpk(s1[6], s1[7]); pf[2] = __builtin_bit_cast(bf16x8, p);
              p.x = cvtpk(s1[8], s1[9]); p.y = cvtpk(s1[10], s1[11]); p.z = cvtpk(s1[12], s1[13]); p.w = cvtpk(s1[14], s1[15]); pf[3] = __builtin_bit_cast(bf16x8, p); }
#pragma unroll
            for (int d = 0; d < 2; ++d)
#pragma unroll
                for (int g = 0; g < 4; ++g) {
                    const bf16x8 vf = *(const bf16x8*)(vb + (d * 32 + qi) * SWA_P + g * 32 + hh * 16);
                    o[d] = MFMA32(vf, pf[g], o[d]);
                }
            if (t + 1 < nt) SWA_COMMIT((t + 1) & 1);
            __syncthreads();
        }
        const float inv = 1.0f / (lsum + __shfl_xor(lsum, 32));
        bf16_t* op = mix + (size_t)qtok * D + 1536 + hq * 64 + 4 * hh;
#pragma unroll
        for (int d = 0; d < 2; ++d)
#pragma unroll
            for (int g = 0; g < 4; ++g) { u32x2 wv; wv.x = cvtpk(o[d][4 * g] * inv, o[d][4 * g + 1] * inv); wv.y = cvtpk(o[d][4 * g + 2] * inv, o[d][4 * g + 3] * inv);
                *(u32x2*)(op + d * 32 + 8 * g) = wv; }
#undef SWA_KTOK
#undef SWA_ISSUE
#undef SWA_COMMIT
    }
}


constexpr int NPHASES = 22;
#define GEMM_CALL(EPI, SCHED, g, S, E) pg8::gemm_phase<EPI, SCHED, true, true, 0>((PG8_LAS unsigned char*)lds, g, S, E)
#define GEMM_CALL8(EPI, SCHED, g, S, E) pg8::gemm_phase<EPI, SCHED, true, true, 1>((PG8_LAS unsigned char*)lds, g, S, E)
#define GEMM_CALLI8(EPI, SCHED, g, S, E) pg8::gemm_phase<EPI, SCHED, true, true, 2>((PG8_LAS unsigned char*)lds, g, S, E)

template <int LYR>
__device__ __forceinline__ void layer_phases(const Args& a, unsigned char* lds, const XcdBarrier& bar, int lo, int hi) {
#define IN(k) (lo <= (k) && (k) < hi)
#define REPS(k) for (int rep_ = 0; rep_ <= (int)((PROBE_MASK >> (k)) & 1u); ++rep_)
#if MK_PER_PHASE
#define SEAM(k) do { } while (0)
#else
#define SEAM(k) do { if (IN(k) && IN((k) + 1)) xcd_barrier(bar); } while (0)
#endif
    constexpr int P0 = 1 + LYR * 9;
    constexpr bool LAST = (LYR == 1);
    constexpr int S_WO = pg8::split_S((LAST ? NLAT : NTOK) / 256 * (D / 256), D / 64, 256);
    constexpr int S_WO0 = pg8::split_S(NTOK / 256 * (D / 256), D / 64, 256);
    constexpr int S_DN0 = pg8::split_S(NTOK / 256 * (D / 256), (FP8_DENSE || FP8_DOWN) ? DFF / 128 : DFF / 64, 256);
    constexpr int S_DN = pg8::split_S(NTOK / 256 * (D / 256), (FP8_DENSE || FP8_DOWN) ? DFF / 128 : DFF / 64, 256);
    const int G = gridDim.x, bid = blockIdx.x;
    unsigned char* ws = a.ws;
    const float* modl = (const float*)(ws + WS_MOD) + (size_t)LYR * 5 * 12288;
    float* xs = (float*)(ws + WS_XS);
    const int nq = LAST ? NLAT : NTOK;
    if (IN(P0 + 0)) REPS(P0 + 0) {
        if (LYR == 0) ph_normmod<false, true, I8_WIN ? 2 : 0>(a.in[0], a.in[2], a.in[6], modl, 0, 2048, (bf16_t*)(ws + WS_HA), NTOK, xs, nullptr, nullptr, nullptr, nullptr, nullptr, (float*)(ws + WS_RSC));
        else ph_normmod<false, false, I8_WIN ? 2 : 0, S_DN0>(xs, xs + (size_t)NLAT * D, a.in[6] + D, modl, 0, 2048, (bf16_t*)(ws + WS_HA), NTOK, nullptr, nullptr, nullptr, nullptr,
                                                    (const float*)(ws + WS_SLAB), (const float*)(ws + WS_MOD) + (size_t)4 * 12288 + 10240, (float*)(ws + WS_RSC));
    }
    SEAM(P0 + 0);
    if (IN(P0 + 1)) REPS(P0 + 1) {
#if I8_WIN
        pg8::Gemm g{(const bf16_t*)(ws + WS_HA), (const bf16_t*)(ws + WS_WIN + (size_t)LYR * UW * D * 2), NTOK, UW, D / 2};
        const float swin = __uint_as_float(__hip_atomic_load((const unsigned*)(ws + WS_CTL) + CT_WSC + LYR, __ATOMIC_RELAXED, __HIP_MEMORY_SCOPE_AGENT)) * (1.0f / 127.0f);
        pg8::EpiStoreI8 E{(bf16_t*)(ws + WS_U), UW, (const float*)(ws + WS_RSC), swin};
        if constexpr (LAST) { pg8::WinLastOrder S; S.init(G, bid, D / 2); GEMM_CALLI8(pg8::EpiStoreI8, pg8::WinLastOrder, g, S, E); }
        else { pg8::StaticOrder S; S.init(NTOK, UW, G, bid, D / 2); GEMM_CALLI8(pg8::EpiStoreI8, pg8::StaticOrder, g, S, E); }
#else
        pg8::Gemm g{(const bf16_t*)(ws + WS_HA), (const bf16_t*)(ws + WS_WIN + (size_t)LYR * UW * D * 2), NTOK, UW, D};
        pg8::EpiStore E{(bf16_t*)(ws + WS_U), UW};
        if constexpr (LAST) { pg8::WinLastOrder S; S.init(G, bid, D); GEMM_CALL(pg8::EpiStore, pg8::WinLastOrder, g, S, E); }
        else { pg8::StaticOrder S; S.init(NTOK, UW, G, bid, D); GEMM_CALL(pg8::EpiStore, pg8::StaticOrder, g, S, E); }
#endif
        conv_fill(a, (float*)lds, LYR * 6 + 0);
    }
    SEAM(P0 + 1);
    if (IN(P0 + 2)) REPS(P0 + 2) ph_mid(a, LYR);
    SEAM(P0 + 2);
    if (IN(P0 + 3)) REPS(P0 + 3) {
        SUBREP(0) {
        { pg8::Gemm g{(const bf16_t*)(ws + WS_CQN), (const bf16_t*)(ws + WS_WQ + (size_t)LYR * QW * 768 * 2), nq, QW, 768};
          pg8::StaticOrder S; S.init(nq, QW, G, bid, 768); pg8::EpiQ E{(bf16_t*)(ws + WS_Q), (const float*)(ws + WS_ROPE), (const float*)(ws + WS_ROPE) + 2048 * 32};
          GEMM_CALL(pg8::EpiQ, pg8::StaticOrder, g, S, E); }
        __syncthreads();
        { pg8::Gemm g{(const bf16_t*)(ws + WS_CKVN), (const bf16_t*)(ws + WS_WKV + (size_t)LYR * KVW * 512 * 2), NTOK, 1024, 512};
          pg8::StaticOrder S; S.init(NTOK, 1024, G, bid, 512); pg8::EpiStore E{(bf16_t*)(ws + WS_KN), 1024};
          GEMM_CALL(pg8::EpiStore, pg8::StaticOrder, g, S, E); }
        __syncthreads();
        { pg8::Gemm g{(const bf16_t*)(ws + WS_WKV + (size_t)LYR * KVW * 512 * 2 + (size_t)1024 * 512 * 2), (const bf16_t*)(ws + WS_CKVN), 1024, NTOK, 512};
          pg8::StaticOrder S; S.init(1024, NTOK, 108, bid >= 216 ? bid - 216 : (bid >= 144 ? bid - 108 : (1 << 24)), 512); pg8::EpiStore E{(bf16_t*)(ws + WS_VT), NTOK};
          GEMM_CALL(pg8::EpiStore, pg8::StaticOrder, g, S, E); }
        __syncthreads();
        }
        SUBREP(1) ph_hyena(a, LYR, lds);
        SUBREP(3) if (!LAST) ph_hyena_naive<C>(a, LYR, (float*)lds);
        SUBREP(2) ph_swa(a, LYR, !LAST, lds);
        conv_fill(a, (float*)lds, LYR * 6 + 1);
    }
    SEAM(P0 + 3);
    if (IN(P0 + 4)) REPS(P0 + 4) { ph_hyena_fin(a, LYR, !LAST, lds); ph_mla(a, !LAST, lds); conv_fill(a, (float*)lds, LYR * 6 + 2); }
    SEAM(P0 + 4);
    if (IN(P0 + 5)) REPS(P0 + 5) {
        pg8::Gemm g{(const bf16_t*)(ws + WS_MIX), (const bf16_t*)(ws + WS_WOUT + (size_t)LYR * D * D * 2), nq, D, D};
        pg8::SplitOrder S; S.init(nq / 256, D / 256, G, bid, D, S_WO);
        const int trow0 = S.nfull / S.nN * 256; pg8::EpiResid E{rep_ ? (float*)(ws + WS_ACT) : xs, modl + 4096, (float*)(ws + WS_SLAB), trow0, nq - trow0, 1.0f};
        GEMM_CALL(pg8::EpiResid, pg8::SplitOrder, g, S, E);
        conv_fill(a, (float*)lds, LYR * 6 + 3);
    }
    SEAM(P0 + 5);
    if (!LAST) {
#if !FP8_DENSE
        if (IN(P0 + 6)) { ph_normmod<false, true, I8_GU ? 2 : 0, S_WO0>(xs, xs + (size_t)NLAT * D, a.in[7], modl, 6144, 8192, (bf16_t*)(ws + WS_HA), NTOK, xs, nullptr, nullptr, nullptr, (const float*)(ws + WS_SLAB), modl + (size_t)4 * 12288 + 4096, (float*)(ws + WS_RSC));
            conv_finish(a, (float*)lds, CONV_DENSE_END); }
        SEAM(P0 + 6);
        if (IN(P0 + 7)) REPS(P0 + 7) {
#if I8_GU
            pg8::Gemm g{(const bf16_t*)(ws + WS_HA), (const bf16_t*)(ws + WS_WGU), NTOK, 2 * DFF, D / 2};
            pg8::StaticOrder S; S.init(NTOK, 2 * DFF, G, bid, D / 2);
            const float swg = __uint_as_float(__hip_atomic_load((const unsigned*)(ws + WS_CTL) + CT_WSC + 2, __ATOMIC_RELAXED, __HIP_MEMORY_SCOPE_AGENT)) * (1.0f / 127.0f);
            const float swu = __uint_as_float(__hip_atomic_load((const unsigned*)(ws + WS_CTL) + CT_WSC + 3, __ATOMIC_RELAXED, __HIP_MEMORY_SCOPE_AGENT)) * (1.0f / 127.0f);
            pg8::EpiSwiGLUI8 E{(unsigned char*)(ws + WS_ACT), DFF, (const float*)(ws + WS_RSC), swg, swu, ASCALE};
            GEMM_CALLI8(pg8::EpiSwiGLUI8, pg8::StaticOrder, g, S, E);
#elif FP8_DOWN
            pg8::Gemm g{(const bf16_t*)(ws + WS_HA), (const bf16_t*)(ws + WS_WGU), NTOK, 2 * DFF, D};
            pg8::StaticOrder S; S.init(NTOK, 2 * DFF, G, bid, D);
            pg8::EpiSwiGLU8 E{(unsigned char*)(ws + WS_ACT), DFF, 1.0f, ASCALE};
            GEMM_CALL(pg8::EpiSwiGLU8, pg8::StaticOrder, g, S, E);
#else
            pg8::Gemm g{(const bf16_t*)(ws + WS_HA), (const bf16_t*)(ws + WS_WGU), NTOK, 2 * DFF, D};
            pg8::StaticOrder S; S.init(NTOK, 2 * DFF, G, bid, D);
            pg8::EpiSwiGLU E{(bf16_t*)(ws + WS_ACT), DFF};
            GEMM_CALL(pg8::EpiSwiGLU, pg8::StaticOrder, g, S, E);
#endif
            conv_fill(a, (float*)lds, 4);
        }
        SEAM(P0 + 7);
        if (IN(P0 + 8)) REPS(P0 + 8) {
#if FP8_DOWN
            pg8::Gemm g{(const bf16_t*)(ws + WS_ACT), (const bf16_t*)(ws + WS_WDN), NTOK, D, DFF / 2};
            pg8::SplitOrder S; S.init(NTOK / 256, D / 256, G, bid, DFF / 2, S_DN);
            const int trow0 = S.nfull / S.nN * 256; pg8::EpiResid E{rep_ ? (float*)(ws + WS_YS) : xs, modl + 10240, (float*)(ws + WS_SLAB), trow0, NTOK - trow0, 1.0f / (ASCALE * WSCALE)};
            GEMM_CALL8(pg8::EpiResid, pg8::SplitOrder, g, S, E);
#else
            pg8::Gemm g{(const bf16_t*)(ws + WS_ACT), (const bf16_t*)(ws + WS_WDN), NTOK, D, DFF};
            pg8::SplitOrder S; S.init(NTOK / 256, D / 256, G, bid, DFF, S_DN);
            const int trow0 = S.nfull / S.nN * 256; pg8::EpiResid E{rep_ ? (float*)(ws + WS_YS) : xs, modl + 10240, (float*)(ws + WS_SLAB), trow0, NTOK - trow0, 1.0f};
            GEMM_CALL(pg8::EpiResid, pg8::SplitOrder, g, S, E);
#endif
            conv_fill(a, (float*)lds, 5);
        }
#else
        if (IN(P0 + 6)) { ph_normmod<false, true, true, S_WO0>(xs, xs + (size_t)NLAT * D, a.in[7], modl, 6144, 8192, (bf16_t*)(ws + WS_HA), NTOK, xs, nullptr, nullptr, nullptr, (const float*)(ws + WS_SLAB), modl + (size_t)4 * 12288 + 4096);
            conv_finish(a, (float*)lds, CONV_DENSE_END); }
        SEAM(P0 + 6);
        if (IN(P0 + 7)) REPS(P0 + 7) {
            pg8::Gemm g{(const bf16_t*)(ws + WS_HA), (const bf16_t*)(ws + WS_WGU), NTOK, 2 * DFF, D / 2};
            pg8::StaticOrder S; S.init(NTOK, 2 * DFF, G, bid, D / 2); pg8::EpiSwiGLU8 E{(unsigned char*)(ws + WS_ACT), DFF, 1.0f / (ASCALE * WSCALE), ASCALE};
            GEMM_CALL8(pg8::EpiSwiGLU8, pg8::StaticOrder, g, S, E);
            conv_fill(a, (float*)lds, 4);
        }
        SEAM(P0 + 7);
        if (IN(P0 + 8)) REPS(P0 + 8) {
            pg8::Gemm g{(const bf16_t*)(ws + WS_ACT), (const bf16_t*)(ws + WS_WDN), NTOK, D, DFF / 2};
            pg8::SplitOrder S; S.init(NTOK / 256, D / 256, G, bid, DFF / 2, S_DN);
            const int trow0 = S.nfull / S.nN * 256; pg8::EpiResid E{rep_ ? (float*)(ws + WS_YS) : xs, modl + 10240, (float*)(ws + WS_SLAB), trow0, NTOK - trow0, 1.0f / (ASCALE * WSCALE)};
            GEMM_CALL8(pg8::EpiResid, pg8::SplitOrder, g, S, E);
            conv_fill(a, (float*)lds, 5);
        }
#endif
        SEAM(P0 + 8);
    } else {
        if (IN(P0 + 6)) REPS(P0 + 6) ph_normmod<true, false, true>(xs, xs + (size_t)NLAT * D, a.in[7] + D, modl, 6144, 8192, (bf16_t*)(ws + WS_HA), NLAT, nullptr, a.in[29], (int*)(ws + WS_TOPI), (float*)(ws + WS_TOPW));
        SEAM(P0 + 6);
        if (IN(P0 + 7)) REPS(P0 + 7) { ph_route_gather(a, (int*)lds); conv_finish(a, (float*)lds, NCONV); }
        SEAM(P0 + 7);
        if (IN(P0 + 9)) REPS(P0 + 9) {
            pg8::Gemm g{(const bf16_t*)(ws + WS_HBS), (const bf16_t*)(ws + WS_MGU), MOE_ROWS, 2 * DFE, D / 2};
            pg8::MoeOrder S; S.init((const int*)(ws + WS_CTL), 2 * DFE / 256, G, bid, (size_t)2 * DFE * D, D / 2); pg8::EpiSwiGLU8 E{(unsigned char*)(ws + WS_ACT), DFE, 1.0f / (ASCALE * WSCALE), ASCALE};
            GEMM_CALL8(pg8::EpiSwiGLU8, pg8::MoeOrder, g, S, E);
        }
        SEAM(P0 + 9);
        if (IN(P0 + 10)) REPS(P0 + 10) {
            pg8::Gemm g{(const bf16_t*)(ws + WS_ACT), (const bf16_t*)(ws + WS_MDN), MOE_ROWS, D, DFE / 2};
            pg8::SplitOrder S; S.init_moe((const int*)(ws + WS_CTL), D / 256, G, bid, DFE / 2, (size_t)D * DFE);
            const int trow0 = S.nfull / S.nN * 256; pg8::EpiYs E{(bf16_t*)(ws + WS_YS), (float*)(ws + WS_SLAB), trow0, S.nM * 256 - trow0, 1.0f / (ASCALE * WSCALE)};
            GEMM_CALL8(pg8::EpiYs, pg8::SplitOrder, g, S, E);
        }
        SEAM(P0 + 10);
        if (IN(P0 + 11)) REPS(P0 + 11) ph_final(a);
    }
#undef IN
#undef SEAM
#undef REPS
}

__global__ void __launch_bounds__(NTHR, 2) mk_fwd(Args a) {
    extern __shared__ __attribute__((aligned(16))) unsigned char lds[];
    const int tid = threadIdx.x;
    for (int u = tid; u < (LDS_BYTES - LDSCTL_OFF) / 4; u += NTHR) ((unsigned*)(lds + LDSCTL_OFF))[u] = 0u;
    __syncthreads();
    XcdBarrier bar; bar.bar = (unsigned*)(a.ws + WS_CTL) + CW_BAR; bar.x = 0; bar.st = nullptr;
#if !MK_PER_PHASE
    bar = xcd_barrier_post((unsigned*)(a.ws + WS_CTL) + CW_BAR, (volatile LAS unsigned*)(lds + LDSCTL_OFF + 32));
#endif
    const int lo = a.ph_lo, hi = a.ph_hi;
    if (lo <= 0 && 0 < hi) {
        for (int rep_ = 0; rep_ <= (int)(PROBE_MASK & 1u); ++rep_) { ph_prologue(a, (float*)lds); __syncthreads(); }
#if !MK_PER_PHASE
        if (1 < hi) xcd_barrier(bar);
#endif
    }
    layer_phases<0>(a, lds, bar, lo, hi);
    layer_phases<1>(a, lds, bar, lo, hi);
}

extern "C" void kernel_launch(void* const* d_in, const int* in_sizes, int n_in, void* d_out, int out_size, void* d_ws, size_t ws_size, hipStream_t stream) {
    (void)in_sizes; (void)out_size;
    static int grid = 0;
    if (grid == 0) {
        if (n_in != 34 || ws_size < WS_END) { fprintf(stderr, "kernel_launch: need 34 inputs and >= %zu bytes of workspace (got %d, %zu)\n", (size_t)WS_END, n_in, ws_size); grid = -1; return; }
        int dev = 0, cus = 0, per_cu = 0;
        if (hipGetDevice(&dev) != hipSuccess || hipDeviceGetAttribute(&cus, hipDeviceAttributeMultiprocessorCount, dev) != hipSuccess) { grid = -1; return; }
        if (hipFuncSetAttribute((const void*)mk_fwd, hipFuncAttributeMaxDynamicSharedMemorySize, LDS_BYTES) != hipSuccess) { fprintf(stderr, "kernel_launch: hipFuncSetAttribute failed\n"); grid = -1; return; }
        if (hipOccupancyMaxActiveBlocksPerMultiprocessor(&per_cu, (const void*)mk_fwd, NTHR, LDS_BYTES) != hipSuccess || per_cu < 1) { fprintf(stderr, "kernel_launch: occupancy query says %d blocks per CU\n", per_cu); }
        (void)hipGetLastError();
        grid = cus;
    }
    if (grid < 0) return;
    if (hipMemsetAsync((char*)d_ws + WS_CTL, 0, CTL_ZERO_BYTES, stream) != hipSuccess) return;
    Args a{};
    for (int i = 0; i < 34; ++i) a.in[i] = (const float*)d_in[i];
    a.out = (float*)d_out; a.ws = (unsigned char*)d_ws;
#if MK_PER_PHASE
    for (int p = 0; p < NPHASES; ++p) { a.ph_lo = p; a.ph_hi = p + 1; hipLaunchKernelGGL(mk_fwd, dim3(grid), dim3(NTHR), LDS_BYTES, stream, a); }
#else
    a.ph_lo = 0; a.ph_hi = NPHASES;
    hipLaunchKernelGGL(mk_fwd, dim3(grid), dim3(NTHR), LDS_BYTES, stream, a);
#endif
}
```

```cpp
#include <hip/hip_runtime.h>
#include <stdint.h>
#include <stdio.h>

#ifndef FP8_DENSE
#define FP8_DENSE 0
#endif
#ifndef FP8_DOWN
#define FP8_DOWN 1
#endif
#ifndef I8_WIN
#define I8_WIN 0
#endif
#ifndef I8_GU
#define I8_GU 1
#endif
#ifndef I8_GEMM
#define I8_GEMM (I8_WIN || I8_GU)
#endif
#ifndef CONV_FILL
#define CONV_FILL 0
#endif
#ifndef PROBE_MASK
#define PROBE_MASK 0u
#endif
#ifndef PROBE_SUB
#define PROBE_SUB 0u
#endif
#ifndef MK_PER_PHASE
#define MK_PER_PHASE 0
#endif

typedef unsigned short bf16_t;
typedef float f32x4 __attribute__((ext_vector_type(4)));
typedef float f32x16 __attribute__((ext_vector_type(16)));
typedef unsigned u32x4 __attribute__((ext_vector_type(4)));
typedef unsigned u32x2 __attribute__((ext_vector_type(2)));
typedef short bf16x8 __attribute__((ext_vector_type(8)));

constexpr int D = 2048, NB = 4, L = 2048, C = 256, NLAT = NB * L, NCTX = NB * C, NTOK = NLAT + NCTX;
constexpr int UW = 3840;
constexpr int O_CQ = 0, O_CKV = 768, O_KPE = 1280, O_HY = 1344, O_SQ = 2880, O_SK = 3392, O_SV = 3520, INW = 3648;
constexpr int QW = 1536, KVW = 2048, DFF = 5632, DFE = 7168, NE = 8;
constexpr int MOE_ROWS = 18432;
constexpr float EPS = 1e-6f;
constexpr int NTHR = 512;
constexpr int HY_RBROW = 4112;

__device__ __forceinline__ float bf2f(bf16_t h) { return __uint_as_float(((unsigned)h) << 16); }
__device__ __forceinline__ bf16_t f2bf(float f) { unsigned u = __float_as_uint(f); u += 0x7fffu + ((u >> 16) & 1u); return (bf16_t)(u >> 16); }
__device__ __forceinline__ float wave_sum(float v) { for (int o = 32; o > 0; o >>= 1) v += __shfl_xor(v, o); return v; }
__device__ __forceinline__ float wave_max(float v) { for (int o = 32; o > 0; o >>= 1) v = fmaxf(v, __shfl_xor(v, o)); return v; }
__device__ __forceinline__ float silu(float x) { return x / (1.0f + __expf(-x)); }
__device__ __forceinline__ int tok_mod(int tok) { return tok < NLAT ? (tok >> 11) : 4; }

constexpr size_t al(size_t x) { return (x + 255) & ~(size_t)255; }
constexpr size_t WS_CTL = 0, CTL_ZERO_BYTES = 65536;
constexpr size_t WS_MOD = 65536;
constexpr size_t WS_ROPE = WS_MOD + al((size_t)2 * 5 * 12288 * 4);
constexpr size_t WS_FILTL = WS_ROPE + al((size_t)2 * 2048 * 32 * 4);
constexpr size_t WS_FILTC = WS_FILTL + al((size_t)2 * 512 * 4096 * 4);
constexpr size_t WS_WIN = WS_FILTC + al((size_t)2 * 512 * 512 * 4);
constexpr size_t WS_WQ = WS_WIN + al((size_t)2 * UW * D * 2);
constexpr size_t WS_WKV = WS_WQ + al((size_t)2 * QW * 768 * 2);
constexpr size_t WS_WOUT = WS_WKV + al((size_t)2 * KVW * 512 * 2);
constexpr size_t WS_WGU = WS_WOUT + al((size_t)2 * D * D * 2);
constexpr size_t WS_WDN = WS_WGU + al((size_t)2 * DFF * D * 2);
constexpr size_t WS_MGU = WS_WDN + al((size_t)D * DFF * 2);
constexpr size_t WS_MDN = WS_MGU + al((size_t)NE * 2 * DFE * D * 2);
constexpr size_t WS_HA = WS_MDN + al((size_t)NE * D * DFE * 2);
constexpr size_t WS_U = WS_HA + al((size_t)NTOK * D * 2);
constexpr size_t WS_CQN = WS_U + al((size_t)NTOK * UW * 2);
constexpr size_t WS_CKVN = WS_CQN + al((size_t)NTOK * 768 * 2);
constexpr size_t WS_KPE = WS_CKVN + al((size_t)NTOK * 512 * 2);
constexpr size_t WS_X0 = WS_KPE + al((size_t)NTOK * 64 * 2);
constexpr size_t WS_WTL = WS_X0 + al((size_t)NTOK * 512 * 2);
constexpr size_t WS_WTC = WS_WTL + al((size_t)NB * 512 * L * 2);
constexpr size_t WS_SQ = WS_WTC + al((size_t)NB * 512 * C * 2);
constexpr size_t WS_SK = WS_SQ + al((size_t)NTOK * 512 * 2);
constexpr size_t WS_SV = WS_SK + al((size_t)NTOK * 128 * 2);
constexpr size_t WS_Q = WS_SV + al((size_t)NTOK * 128 * 2);
constexpr size_t WS_KV = WS_Q + al((size_t)NTOK * QW * 2);
constexpr size_t WS_KN = WS_KV;
constexpr size_t WS_VT = WS_KV + (size_t)NTOK * 1024 * 2;
constexpr size_t WS_MIX = WS_KV + al((size_t)NTOK * KVW * 2);
constexpr size_t WS_MIXEND = WS_MIX + al((size_t)NTOK * D * 2);
constexpr size_t WS_YS = WS_U;
static_assert(WS_YS + (size_t)MOE_ROWS * D * 4 <= WS_MIXEND, "ys overlay");
constexpr size_t WS_XS = WS_MIXEND;
constexpr size_t WS_ACT = WS_XS + al((size_t)NTOK * D * 4);
constexpr size_t WS_HBS = WS_ACT + al((size_t)MOE_ROWS * DFE * 2);
constexpr size_t WS_TOPI = WS_HBS + al((size_t)MOE_ROWS * D * 2);
constexpr size_t WS_TOPW = WS_TOPI + al((size_t)NLAT * 2 * 4);
constexpr size_t WS_POS = WS_TOPW + al((size_t)NLAT * 2 * 4);
constexpr size_t WS_SRC = WS_POS + al((size_t)NLAT * 2 * 4);
constexpr size_t WS_SLAB = WS_SRC + al((size_t)MOE_ROWS * 4);
constexpr size_t WS_YT = WS_SLAB + ((size_t)64 << 20);
constexpr size_t WS_RSC = WS_YT + al((size_t)NB * 512 * (L + C) * 2);
constexpr size_t WS_END = WS_RSC + al((size_t)NTOK * 4);
constexpr int CT_EOFF = 1024, CT_EPAD = 1040, CT_NTILE = 1056, CT_MOES = 1057, CT_TROW = 1058, CT_WSC = 1088, CT_AMAXDONE = 1100;
constexpr int CW_BAR = 4096;

constexpr int RING_BYTES = 131072, LDS_BYTES = 147456, LDSCTL_OFF = LDS_BYTES - 256;

namespace pg8 {
#define PG8_LAS __attribute__((address_space(3)))
typedef unsigned short bf16_t;
typedef short bf16x8 __attribute__((ext_vector_type(8)));
typedef float f32x4 __attribute__((ext_vector_type(4)));
typedef unsigned u32x4 __attribute__((ext_vector_type(4)));
constexpr int BM = 256, BK = 64, HALF = 128, HTB = HALF * BK * 2  , STAGE_BYTES = 8 * HTB, NXCD = 8, WGM = 8;

__host__ __device__ __forceinline__ int lds_byte(int r, int c) { const int st = (r >> 4) * 2 + (c >> 5), rr = r & 15, cc = c & 31, ob = rr * 64 + cc * 2; return st * 1024 + (ob ^ (((ob >> 9) & 1) << 5)); }
__host__ __device__ __forceinline__ void stage_rc(int b, int& R, int& C) { const int st = b / 1024, sb = b % 1024, swz = sb ^ (((sb >> 9) & 1) << 5); R = (st >> 1) * 16 + swz / 64; C = (st & 1) * 32 + (swz % 64) / 2; }
__host__ __device__ __forceinline__ int perm32(int rho) { const int n = rho >> 4, i = rho & 15; return 8 * (i >> 2) + 4 * n + (i & 3); }

struct Unit { int pm, pn, kt0, nkt, slab; };
struct Gemm { const bf16_t* A; const bf16_t* Bt; int M, N, K; };

struct StaticOrder {
    int nM, nN, nwg, G, c;
    int nkt;
    __host__ __device__ void init(int M, int N, int G_, int c_, int K) { nM = M / BM; nN = N / BM; nwg = nM * nN; G = G_; c = c_; nkt = K / BK; }
    __host__ __device__ bool next(int i, Unit& u) const {
        const long L = (long)i * G + c; if (L >= nwg) return false;
        int wgid = (int)L; { const int q = nwg / NXCD, r = nwg % NXCD, xcd = wgid % NXCD, off = wgid / NXCD; wgid = (xcd < r ? xcd * (q + 1) : r * (q + 1) + (xcd - r) * q) + off; }
        const int nig = WGM * nN, gid = wgid / nig, fm = gid * WGM, gsz = (nM - fm) < WGM ? (nM - fm) : WGM;
        u.pm = fm + ((wgid % nig) % gsz); u.pn = (wgid % nig) / gsz; u.kt0 = 0; u.nkt = nkt; u.slab = -1; return true;
    }
    __device__ __forceinline__ size_t bt_off(const Unit&) const { return 0; }
    __device__ __forceinline__ void a_ready(const Unit&) const {}
    __device__ __forceinline__ void done(const Unit&) const {}
};

__device__ __forceinline__ unsigned cvt_pk_bf16(float lo, float hi) { unsigned r; asm volatile("v_cvt_pk_bf16_f32 %0, %1, %2" : "=v"(r) : "v"(lo), "v"(hi)); return r; }
typedef float f32x2 __attribute__((ext_vector_type(2)));
typedef int v8i_t __attribute__((ext_vector_type(8))); typedef int v4i_t __attribute__((ext_vector_type(4)));
template <bool F8> struct Frag;
template <> struct Frag<false> { bf16x8 h[2]; __device__ __forceinline__ void set0(bf16x8 x) { h[0] = x; } __device__ __forceinline__ void set1(bf16x8 x) { h[1] = x; } };
template <> struct Frag<true> { v8i_t v; __device__ __forceinline__ void set0(bf16x8 x) { v.lo = __builtin_bit_cast(v4i_t, x); } __device__ __forceinline__ void set1(bf16x8 x) { v.hi = __builtin_bit_cast(v4i_t, x); } };
template <class Epi, class Sched, bool ALIGN_EPI = false, bool SP2 = false, int DT = 0>
__device__ __forceinline__ void gemm_phase(PG8_LAS unsigned char* lds, const Gemm g, const Sched& S, const Epi& E) {
    int tid_ = threadIdx.x; asm volatile("" : "+v"(tid_));
    const int tid = tid_, wid = __builtin_amdgcn_readfirstlane(tid >> 6), lane = tid & 63, wr = wid >> 2, wc = wid & 3, fr = lane & 15, fq = lane >> 4;
    const int K = g.K;
    unsigned voffA[2], voffB[2];
#pragma unroll
    for (int i = 0; i < 2; ++i) { int R, C; stage_rc(tid * 16 + i * 8192, R, C); const int Rb = Epi::PERM ? ((R & ~31) + perm32(R & 31)) : R;
        voffA[i] = (unsigned)(R * K + C) * 2u; voffB[i] = (unsigned)(Rb * K + C) * 2u; }
    const size_t kstep = (size_t)(BK * 2);
    const size_t hstep = (size_t)HALF * K * 2;
    const size_t tstep = 2 * hstep;
    const unsigned ldsw = (unsigned)wid * 1024u;
    const int aoff = lds_byte(wr * 64 + fr, fq * 8), boff = lds_byte(wc * 32 + fr, fq * 8);
#define PG8_SA(b, h) (((b) * 2 + (h)) * HTB)
#define PG8_SB(b, h) ((4 + (b) * 2 + (h)) * HTB)
#define PG8_STAGE(bufoff, gbase, voff) do { _Pragma("unroll") for (int _i = 0; _i < 2; ++_i) \
        __builtin_amdgcn_global_load_lds((const unsigned*)((const char*)(gbase) + (voff)[_i]), (PG8_LAS unsigned*)(lds + (bufoff) + ldsw + _i * 8192), 16, 0, 0); } while (0)
#define PG8_LDA(dst, b, h) do { _Pragma("unroll") for (int m = 0; m < 4; ++m) { dst[m].set0(*(const PG8_LAS bf16x8*)(lds + PG8_SA(b, h) + aoff + m * 2048)); dst[m].set1(*(const PG8_LAS bf16x8*)(lds + PG8_SA(b, h) + aoff + m * 2048 + 1024)); } } while (0)
#define PG8_LDB(dst, b, h) do { _Pragma("unroll") for (int n = 0; n < 2; ++n) { dst[n].set0(*(const PG8_LAS bf16x8*)(lds + PG8_SB(b, h) + boff + n * 2048)); dst[n].set1(*(const PG8_LAS bf16x8*)(lds + PG8_SB(b, h) + boff + n * 2048 + 1024)); } } while (0)
#define PG8_MMA(ai, bj, At, Bt) do { __builtin_amdgcn_s_setprio(1); _Pragma("unroll") for (int m = 0; m < 4; ++m) _Pragma("unroll") for (int n = 0; n < 2; ++n) { \
        if constexpr (DT == 1) asm volatile("v_mfma_f32_16x16x128_f8f6f4 %0, %1, %2, %0" : "+v"(acc[ai][bj][m][n]) : "v"(Bt[n].v), "v"(At[m].v));   \
        else if constexpr (DT == 2) { _Pragma("unroll") for (int k = 0; k < 2; ++k) acc[ai][bj][m][n] = __builtin_bit_cast(f32x4, __builtin_amdgcn_mfma_i32_16x16x64_i8(__builtin_bit_cast(v4i_t, Bt[n].h[k]), __builtin_bit_cast(v4i_t, At[m].h[k]), __builtin_bit_cast(v4i_t, acc[ai][bj][m][n]), 0, 0, 0)); } \
        else { _Pragma("unroll") for (int k = 0; k < 2; ++k) acc[ai][bj][m][n] = __builtin_amdgcn_mfma_f32_16x16x32_bf16(Bt[n].h[k], At[m].h[k], acc[ai][bj][m][n], 0, 0, 0); } } \
        __builtin_amdgcn_s_setprio(0); } while (0)
#define PG8_WAIT_V(n) asm volatile("s_waitcnt vmcnt(" #n ")" ::: "memory")
#define PG8_WAIT_L(n) asm volatile("s_waitcnt lgkmcnt(" #n ")" ::: "memory")
#define PG8_BAR __builtin_amdgcn_s_barrier()
#define PG8_SCHED __builtin_amdgcn_sched_barrier(0)
    Unit cur, nxt; int ui = 0;
    if (!S.next(0, cur)) return;
    f32x4 acc[2][2][4][2];
#pragma unroll
    for (int a = 0; a < 2; ++a)
#pragma unroll
        for (int b = 0; b < 2; ++b)
#pragma unroll
            for (int m = 0; m < 4; ++m)
#pragma unroll
                for (int n = 0; n < 2; ++n) acc[a][b][m][n] = (f32x4){0.f, 0.f, 0.f, 0.f};
    Frag<DT == 1> At[4], B0[2], B1[2];
    const char* cA = (const char*)g.A + (size_t)cur.pm * tstep + (size_t)cur.kt0 * kstep; const char* cB = (const char*)g.Bt + S.bt_off(cur) + (size_t)cur.pn * tstep + (size_t)cur.kt0 * kstep;
    S.a_ready(cur);
    if constexpr (SP2) {
        PG8_STAGE(PG8_SB(0, 0), cB, voffB); PG8_STAGE(PG8_SB(0, 1), cB + hstep, voffB); PG8_STAGE(PG8_SA(0, 0), cA, voffA); PG8_STAGE(PG8_SA(0, 1), cA + hstep, voffA);
        if (wr == 1) PG8_BAR;
        PG8_WAIT_V(2); PG8_BAR;
        PG8_STAGE(PG8_SB(1, 0), cB + kstep, voffB); PG8_STAGE(PG8_SA(1, 0), cA + kstep, voffA); PG8_STAGE(PG8_SB(1, 1), cB + hstep + kstep, voffB);
        PG8_WAIT_V(6); PG8_BAR;
    } else {
        PG8_STAGE(PG8_SB(0, 0), cB, voffB); PG8_STAGE(PG8_SA(0, 0), cA, voffA); PG8_STAGE(PG8_SB(0, 1), cB + hstep, voffB); PG8_STAGE(PG8_SA(0, 1), cA + hstep, voffA);
        if (wr == 1) PG8_BAR;
        PG8_WAIT_V(4); PG8_BAR;
        PG8_STAGE(PG8_SB(1, 0), cB + kstep, voffB); PG8_STAGE(PG8_SA(1, 0), cA + kstep, voffA); PG8_STAGE(PG8_SB(1, 1), cB + hstep + kstep, voffB);
        PG8_WAIT_V(6); PG8_BAR;
    }
    for (;;) {
        const bool has_next = S.next(ui + 1, nxt);
        const char* nA = has_next ? (const char*)g.A + (size_t)nxt.pm * tstep + (size_t)nxt.kt0 * kstep : cA; const char* nB = has_next ? (const char*)g.Bt + S.bt_off(nxt) + (size_t)nxt.pn * tstep + (size_t)nxt.kt0 * kstep : cB;
        const int nt = cur.nkt;
        for (int t = 0; t < nt; t += 2) {
            const bool last = (t == nt - 2);
            const char* a1 = cA + (size_t)(t + 1) * kstep;
            const char* a2 = last ? nA : cA + (size_t)(t + 2) * kstep; const char* b2 = last ? nB : cB + (size_t)(t + 2) * kstep;
            const char* a3 = a2 + kstep; const char* b3 = b2 + kstep;
            if (last && has_next) S.a_ready(nxt);
            if constexpr (SP2) {
            PG8_LDB(B0, 0, 0); PG8_LDB(B1, 0, 1); PG8_SCHED; PG8_LDA(At, 0, 0); PG8_STAGE(PG8_SA(1, 1), a1 + hstep, voffA);
            PG8_WAIT_V(8); PG8_WAIT_L(0); PG8_BAR; PG8_MMA(0, 0, At, B0); PG8_MMA(0, 1, At, B1); PG8_BAR; PG8_SCHED;
            PG8_LDA(At, 0, 1); PG8_STAGE(PG8_SB(0, 0), b2, voffB); PG8_STAGE(PG8_SB(0, 1), b2 + hstep, voffB); PG8_STAGE(PG8_SA(0, 0), a2, voffA);
            PG8_WAIT_V(8); PG8_WAIT_L(0); PG8_BAR; PG8_MMA(1, 0, At, B0); PG8_MMA(1, 1, At, B1); PG8_BAR; PG8_SCHED;
            PG8_LDB(B0, 1, 0); PG8_LDB(B1, 1, 1); PG8_SCHED; PG8_LDA(At, 1, 0); PG8_STAGE(PG8_SA(0, 1), a2 + hstep, voffA);
            PG8_WAIT_V(8); PG8_WAIT_L(0); PG8_BAR; PG8_MMA(0, 0, At, B0); PG8_MMA(0, 1, At, B1); PG8_BAR; PG8_SCHED;
            PG8_LDA(At, 1, 1); PG8_STAGE(PG8_SB(1, 0), b3, voffB); PG8_STAGE(PG8_SB(1, 1), b3 + hstep, voffB); PG8_STAGE(PG8_SA(1, 0), a3, voffA);
            PG8_WAIT_V(8); PG8_WAIT_L(0); PG8_BAR; PG8_MMA(1, 0, At, B0); PG8_MMA(1, 1, At, B1); PG8_BAR; PG8_SCHED;
            } else {
            PG8_LDB(B0, 0, 0); PG8_SCHED; PG8_LDA(At, 0, 0); PG8_STAGE(PG8_SA(1, 1), a1 + hstep, voffA);
            PG8_WAIT_L(8); PG8_BAR; PG8_WAIT_L(0); PG8_MMA(0, 0, At, B0); PG8_BAR; PG8_SCHED;
            PG8_LDB(B1, 0, 1); PG8_STAGE(PG8_SB(0, 0), b2, voffB);
            PG8_BAR; PG8_WAIT_L(0); PG8_MMA(0, 1, At, B1); PG8_BAR;
            PG8_LDA(At, 0, 1); PG8_STAGE(PG8_SA(0, 0), a2, voffA);
            PG8_BAR; PG8_WAIT_L(0); PG8_MMA(1, 0, At, B0); PG8_BAR; PG8_SCHED;
            PG8_STAGE(PG8_SB(0, 1), b2 + hstep, voffB);
            PG8_WAIT_V(6); PG8_BAR; PG8_MMA(1, 1, At, B1); PG8_BAR;
            PG8_LDB(B0, 1, 0); PG8_SCHED; PG8_LDA(At, 1, 0); PG8_STAGE(PG8_SA(0, 1), a2 + hstep, voffA);
            PG8_WAIT_L(8); PG8_BAR; PG8_WAIT_L(0); PG8_MMA(0, 0, At, B0); PG8_BAR; PG8_SCHED;
            PG8_LDB(B1, 1, 1); PG8_STAGE(PG8_SB(1, 0), b3, voffB);
            PG8_BAR; PG8_WAIT_L(0); PG8_MMA(0, 1, At, B1); PG8_BAR;
            PG8_LDA(At, 1, 1); PG8_STAGE(PG8_SA(1, 0), a3, voffA);
            PG8_BAR; PG8_WAIT_L(0); PG8_MMA(1, 0, At, B0); PG8_BAR; PG8_SCHED;
            PG8_STAGE(PG8_SB(1, 1), b3 + hstep, voffB);
            PG8_WAIT_V(6); PG8_BAR; PG8_MMA(1, 1, At, B1); PG8_BAR;
            }
        }
        if constexpr (ALIGN_EPI) { if (wr == 0) PG8_BAR; }
        if constexpr (DT == 1) asm volatile("s_nop 15\n\ts_nop 15" ::: "memory");
        if constexpr (!Epi::AFTER_DRAIN) { E(acc, cur, wr, wc, fr, fq); S.done(cur); }
        if (!has_next) break;
#pragma unroll
        for (int a = 0; a < 2; ++a)
#pragma unroll
            for (int b = 0; b < 2; ++b)
#pragma unroll
                for (int m = 0; m < 4; ++m)
#pragma unroll
                    for (int n = 0; n < 2; ++n) acc[a][b][m][n] = (f32x4){0.f, 0.f, 0.f, 0.f};
        cur = nxt; cA = nA; cB = nB; ++ui;
        if constexpr (ALIGN_EPI) { if (wr == 1) PG8_BAR; }
    }
    PG8_WAIT_V(0);
    if constexpr (!ALIGN_EPI) { if (wr == 0) PG8_BAR; }
    PG8_BAR;
    if constexpr (Epi::AFTER_DRAIN) { E.fused(acc, cur, wr, wc, fr, fq, lds, wid, lane); S.done(cur); }
#undef PG8_SA
#undef PG8_SB
#undef PG8_STAGE
#undef PG8_LDA
#undef PG8_LDB
#undef PG8_MMA
#undef PG8_WAIT_V
#undef PG8_WAIT_L
#undef PG8_BAR
#undef PG8_SCHED
}
}

namespace pg8 {
__device__ __forceinline__ u32x4 pack8(const f32x4 v0, const f32x4 v1) { u32x4 w; w.x = cvt_pk_bf16(v0[0], v0[1]); w.y = cvt_pk_bf16(v0[2], v0[3]); w.z = cvt_pk_bf16(v1[0], v1[1]); w.w = cvt_pk_bf16(v1[2], v1[3]); return w; }
struct EpiStore {
    static constexpr bool PERM = true, AFTER_DRAIN = false;
    bf16_t* O; int ldc;
    __device__ __forceinline__ void operator()(const f32x4 (&acc)[2][2][4][2], const Unit& u, int wr, int wc, int fr, int fq) const {
        const int row0 = u.pm * BM + wr * 64 + fr, col0 = u.pn * BM + wc * 32 + 8 * fq;
#pragma unroll
        for (int ai = 0; ai < 2; ++ai)
#pragma unroll
            for (int m = 0; m < 4; ++m) { bf16_t* rowp = O + (size_t)(row0 + ai * HALF + m * 16) * ldc + col0;
#pragma unroll
                for (int bj = 0; bj < 2; ++bj) *(u32x4*)(rowp + bj * HALF) = pack8(acc[ai][bj][m][0], acc[ai][bj][m][1]); }
    }
};
struct EpiQ {
    static constexpr bool PERM = true, AFTER_DRAIN = false;
    bf16_t* O; const float* cosT; const float* sinT;
    __device__ __forceinline__ void operator()(const f32x4 (&acc)[2][2][4][2], const Unit& u, int wr, int wc, int fr, int fq) const {
        const int row0 = u.pm * BM + wr * 64 + fr, col0 = u.pn * BM + wc * 32 + 8 * fq;
#pragma unroll
        for (int ai = 0; ai < 2; ++ai)
#pragma unroll
            for (int m = 0; m < 4; ++m) { const int row = row0 + ai * HALF + m * 16; const bool lat = row < 8192; const int t = row & 2047;
#pragma unroll
                for (int bj = 0; bj < 2; ++bj) { const int col = col0 + bj * HALF; const int jn = col - 192 * (col / 192);
                    f32x4 v0 = acc[ai][bj][m][0], v1 = acc[ai][bj][m][1];
                    if (jn >= 128 && lat) { const int i0 = (jn - 128) >> 1;
                        const f32x4 cs = *(const f32x4*)(cosT + t * 32 + i0), sn = *(const f32x4*)(sinT + t * 32 + i0);
                        f32x4 r0, r1;
                        r0[0] = v0[0] * cs[0] - v0[1] * sn[0]; r0[1] = v0[0] * sn[0] + v0[1] * cs[0];
                        r0[2] = v0[2] * cs[1] - v0[3] * sn[1]; r0[3] = v0[2] * sn[1] + v0[3] * cs[1];
                        r1[0] = v1[0] * cs[2] - v1[1] * sn[2]; r1[1] = v1[0] * sn[2] + v1[1] * cs[2];
                        r1[2] = v1[2] * cs[3] - v1[3] * sn[3]; r1[3] = v1[2] * sn[3] + v1[3] * cs[3];
                        v0 = r0; v1 = r1; }
                    *(u32x4*)(O + (size_t)row * 1536 + col) = pack8(v0, v1); } }
    }
};
struct EpiResid {
    static constexpr bool PERM = false, AFTER_DRAIN = false;
    float* xs; const float* gate; float* slab; int tail_row0, tail_rows; float scale;
    __device__ __forceinline__ void operator()(const f32x4 (&acc)[2][2][4][2], const Unit& u, int wr, int wc, int fr, int fq) const {
        const int row0 = u.pm * BM + wr * 64 + fr, colb = u.pn * BM + wc * 32 + 4 * fq;
        if (u.slab >= 0) {
#pragma unroll
            for (int ai = 0; ai < 2; ++ai)
#pragma unroll
                for (int m = 0; m < 4; ++m) { float* sp = slab + ((size_t)u.slab * tail_rows + (row0 + ai * HALF + m * 16 - tail_row0)) * 2048;
#pragma unroll
                    for (int bj = 0; bj < 2; ++bj)
#pragma unroll
                        for (int n = 0; n < 2; ++n) *(f32x4*)(sp + colb + bj * HALF + n * 16) = acc[ai][bj][m][n] * scale; }
            return;
        }
#pragma unroll
        for (int ai = 0; ai < 2; ++ai)
#pragma unroll
            for (int m = 0; m < 4; ++m) { const int row = row0 + ai * HALF + m * 16; const float* gv = gate + (size_t)(row < 8192 ? (row >> 11) : 4) * 12288; float* xr = xs + (size_t)row * 2048;
#pragma unroll
                for (int bj = 0; bj < 2; ++bj)
#pragma unroll
                    for (int n = 0; n < 2; ++n) { const int col = colb + bj * HALF + n * 16; f32x4 x = *(const f32x4*)(xr + col); const f32x4 g = *(const f32x4*)(gv + col);
                        x += (g * scale) * acc[ai][bj][m][n]; *(f32x4*)(xr + col) = x; }
                if (m & 1) asm volatile("" ::: "memory"); }
    }
};
__device__ __forceinline__ unsigned pack4_fp8(float a, float b, float c, float d) {
    a = fminf(fmaxf(a, -448.f), 448.f); b = fminf(fmaxf(b, -448.f), 448.f); c = fminf(fmaxf(c, -448.f), 448.f); d = fminf(fmaxf(d, -448.f), 448.f);
    unsigned w = 0; w = __builtin_amdgcn_cvt_pk_fp8_f32(a, b, w, false); w = __builtin_amdgcn_cvt_pk_fp8_f32(c, d, w, true); return w; }
struct EpiSwiGLU8 {
    static constexpr bool PERM = true, AFTER_DRAIN = false;
    unsigned char* O; int ldc; float s, oscale;
    __device__ __forceinline__ void operator()(const f32x4 (&acc)[2][2][4][2], const Unit& u, int wr, int wc, int fr, int fq) const {
        const int row0 = u.pm * BM + wr * 64 + fr, col0 = u.pn * HALF + wc * 32 + 8 * fq;
#pragma unroll
        for (int ai = 0; ai < 2; ++ai)
#pragma unroll
            for (int m = 0; m < 4; ++m) { f32x4 o0, o1;
#pragma unroll
                for (int j = 0; j < 4; ++j) { const float g0 = acc[ai][0][m][0][j] * s, g1 = acc[ai][0][m][1][j] * s;
                    o0[j] = g0 / (1.0f + __expf(-g0)) * (acc[ai][1][m][0][j] * (s * oscale)); o1[j] = g1 / (1.0f + __expf(-g1)) * (acc[ai][1][m][1][j] * (s * oscale)); }
                u32x2 w; w.x = pack4_fp8(o0[0], o0[1], o0[2], o0[3]); w.y = pack4_fp8(o1[0], o1[1], o1[2], o1[3]);
                *(u32x2*)(O + (size_t)(row0 + ai * HALF + m * 16) * ldc + col0) = w; }
    }
};
__device__ __forceinline__ f32x4 i2f4(const f32x4 bits) { const v4i_t iv = __builtin_bit_cast(v4i_t, bits); return (f32x4){(float)iv[0], (float)iv[1], (float)iv[2], (float)iv[3]}; }
struct EpiStoreI8 {
    static constexpr bool PERM = true, AFTER_DRAIN = false;
    bf16_t* O; int ldc; const float* rsc; float sw;
    __device__ __forceinline__ void operator()(const f32x4 (&acc)[2][2][4][2], const Unit& u, int wr, int wc, int fr, int fq) const {
        const int row0 = u.pm * BM + wr * 64 + fr, col0 = u.pn * BM + wc * 32 + 8 * fq;
#pragma unroll
        for (int ai = 0; ai < 2; ++ai)
#pragma unroll
            for (int m = 0; m < 4; ++m) { const int row = row0 + ai * HALF + m * 16; const float sc = rsc[row] * sw; bf16_t* rowp = O + (size_t)row * ldc + col0;
#pragma unroll
                for (int bj = 0; bj < 2; ++bj) *(u32x4*)(rowp + bj * HALF) = pack8(i2f4(acc[ai][bj][m][0]) * sc, i2f4(acc[ai][bj][m][1]) * sc); }
    }
};
struct EpiSwiGLUI8 {
    static constexpr bool PERM = true, AFTER_DRAIN = false;
    unsigned char* O; int ldc; const float* rsc; float swg, swu, oscale;
    __device__ __forceinline__ void operator()(const f32x4 (&acc)[2][2][4][2], const Unit& u, int wr, int wc, int fr, int fq) const {
        const int row0 = u.pm * BM + wr * 64 + fr, col0 = u.pn * HALF + wc * 32 + 8 * fq;
#pragma unroll
        for (int ai = 0; ai < 2; ++ai)
#pragma unroll
            for (int m = 0; m < 4; ++m) { const int row = row0 + ai * HALF + m * 16; const float sa = rsc[row], sg = sa * swg, su = sa * swu * oscale; f32x4 o0, o1;
                const f32x4 g0v = i2f4(acc[ai][0][m][0]) * sg, g1v = i2f4(acc[ai][0][m][1]) * sg, u0v = i2f4(acc[ai][1][m][0]) * su, u1v = i2f4(acc[ai][1][m][1]) * su;
#pragma unroll
                for (int j = 0; j < 4; ++j) { o0[j] = g0v[j] / (1.0f + __expf(-g0v[j])) * u0v[j]; o1[j] = g1v[j] / (1.0f + __expf(-g1v[j])) * u1v[j]; }
                u32x2 w; w.x = pack4_fp8(o0[0], o0[1], o0[2], o0[3]); w.y = pack4_fp8(o1[0], o1[1], o1[2], o1[3]);
                *(u32x2*)(O + (size_t)row * ldc + col0) = w; }
    }
};
struct EpiSwiGLU {
    static constexpr bool PERM = true, AFTER_DRAIN = false;
    bf16_t* O; int ldc;
    __device__ __forceinline__ void operator()(const f32x4 (&acc)[2][2][4][2], const Unit& u, int wr, int wc, int fr, int fq) const {
        const int row0 = u.pm * BM + wr * 64 + fr, col0 = u.pn * HALF + wc * 32 + 8 * fq;
#pragma unroll
        for (int ai = 0; ai < 2; ++ai)
#pragma unroll
            for (int m = 0; m < 4; ++m) { f32x4 o0, o1;
#pragma unroll
                for (int j = 0; j < 4; ++j) { const float g0 = acc[ai][0][m][0][j], g1 = acc[ai][0][m][1][j];
                    o0[j] = g0 / (1.0f + __expf(-g0)) * acc[ai][1][m][0][j]; o1[j] = g1 / (1.0f + __expf(-g1)) * acc[ai][1][m][1][j]; }
                *(u32x4*)(O + (size_t)(row0 + ai * HALF + m * 16) * ldc + col0) = pack8(o0, o1); }
    }
};
struct EpiF32 {
    static constexpr bool PERM = false, AFTER_DRAIN = false;
    float* O; int ldc; float* slab; int tail_row0, tail_rows; float scale;
    __device__ __forceinline__ void operator()(const f32x4 (&acc)[2][2][4][2], const Unit& u, int wr, int wc, int fr, int fq) const {
        const int row0 = u.pm * BM + wr * 64 + fr, colb = u.pn * BM + wc * 32 + 4 * fq;
#pragma unroll
        for (int ai = 0; ai < 2; ++ai)
#pragma unroll
            for (int m = 0; m < 4; ++m) { float* xr = (u.slab >= 0) ? slab + ((size_t)u.slab * tail_rows + (row0 + ai * HALF + m * 16 - tail_row0)) * 2048 : O + (size_t)(row0 + ai * HALF + m * 16) * ldc;
#pragma unroll
                for (int bj = 0; bj < 2; ++bj)
#pragma unroll
                    for (int n = 0; n < 2; ++n) *(f32x4*)(xr + colb + bj * HALF + n * 16) = acc[ai][bj][m][n] * scale; }
    }
};
struct EpiYs {
    static constexpr bool PERM = false, AFTER_DRAIN = false;
    bf16_t* O; float* slab; int tail_row0, tail_rows; float scale;
    __device__ __forceinline__ void operator()(const f32x4 (&acc)[2][2][4][2], const Unit& u, int wr, int wc, int fr, int fq) const {
        const int row0 = u.pm * BM + wr * 64 + fr, colb = u.pn * BM + wc * 32 + 4 * fq;
        if (u.slab >= 0) {
#pragma unroll
            for (int ai = 0; ai < 2; ++ai)
#pragma unroll
                for (int m = 0; m < 4; ++m) { float* sp = slab + ((size_t)u.slab * tail_rows + (row0 + ai * HALF + m * 16 - tail_row0)) * 2048;
#pragma unroll
                    for (int bj = 0; bj < 2; ++bj)
#pragma unroll
                        for (int n = 0; n < 2; ++n) *(f32x4*)(sp + colb + bj * HALF + n * 16) = acc[ai][bj][m][n] * scale; }
            return;
        }
#pragma unroll
        for (int ai = 0; ai < 2; ++ai)
#pragma unroll
            for (int m = 0; m < 4; ++m) { bf16_t* xr = O + (size_t)(row0 + ai * HALF + m * 16) * 2048;
#pragma unroll
                for (int bj = 0; bj < 2; ++bj)
#pragma unroll
                    for (int n = 0; n < 2; ++n) { const f32x4 v = acc[ai][bj][m][n] * scale; u32x2 w; w.x = cvt_pk_bf16(v[0], v[1]); w.y = cvt_pk_bf16(v[2], v[3]); *(u32x2*)(xr + colb + bj * HALF + n * 16) = w; } }
    }
};
struct MoeOrder {
    int nM, nN, nwg, G, c, nkt; int t1[8]; size_t estride;
    __device__ __forceinline__ void init(const int* ctl, int nN_, int G_, int c_, size_t estride_, int K) { nkt = K / BK;
        int acc = 0;
#pragma unroll
        for (int e = 0; e < 8; ++e) { acc += __builtin_amdgcn_readfirstlane(ctl[CT_EPAD + e]) >> 8; t1[e] = acc; }
        nM = acc; nN = nN_; nwg = nM * nN; G = G_; c = c_; estride = estride_;
    }
    __device__ __forceinline__ bool next(int i, Unit& u) const {
        const long L = (long)i * G + c; if (L >= nwg) return false;
        int wgid = (int)L; { const int q = nwg / NXCD, r = nwg % NXCD, xcd = wgid % NXCD, off = wgid / NXCD; wgid = (xcd < r ? xcd * (q + 1) : r * (q + 1) + (xcd - r) * q) + off; }
        const int nig = WGM * nN, gid = wgid / nig, fm = gid * WGM, gsz = (nM - fm) < WGM ? (nM - fm) : WGM;
        u.pm = fm + ((wgid % nig) % gsz); u.pn = (wgid % nig) / gsz; u.kt0 = 0; u.nkt = nkt; u.slab = -1; return true;
    }
    __device__ __forceinline__ size_t bt_off(const Unit& u) const { int e = 0;
#pragma unroll
        for (int k = 0; k < 7; ++k) e += (u.pm >= t1[k]) ? 1 : 0;
        return (size_t)e * estride; }
    __device__ __forceinline__ void a_ready(const Unit&) const {}
    __device__ __forceinline__ void done(const Unit&) const {}
};
struct WinLastOrder {
    StaticOrder so; int G, c;
    __device__ __forceinline__ void init(int G_, int c_, int K) { so.init(NLAT, UW, G_, c_, K); G = G_; c = c_; }
    __device__ __forceinline__ bool next(int i, Unit& u) const {
        if (so.next(i, u)) return true;
        const long L = (long)i * G + c - so.nwg; if (L < 0 || L >= 20) return false;
        const int j = (int)L, k = j % 5; u.pm = 32 + j / 5; u.pn = k < 3 ? 3 + k : 10 + k; u.kt0 = 0; u.nkt = so.nkt; u.slab = -1; return true;
    }
    __device__ __forceinline__ size_t bt_off(const Unit&) const { return 0; }
    __device__ __forceinline__ void a_ready(const Unit&) const {}
    __device__ __forceinline__ void done(const Unit&) const {}
};
struct SplitOrder {
    int nM, nN, nwg, G, c, nfull, ntail, S, nkt, nkts; int t1[8]; size_t estride;
    __device__ __forceinline__ void init(int nM_, int nN_, int G_, int c_, int K, int S_) {
        nM = nM_; nN = nN_; nwg = nM * nN; G = G_; c = c_; nkt = K / BK; nfull = (nwg / 256) * 256; ntail = nwg - nfull; S = S_; nkts = nkt / S; estride = 0;
#pragma unroll
        for (int e = 0; e < 8; ++e) t1[e] = 0;
    }
    __device__ __forceinline__ void init_moe(const int* ctl, int nN_, int G_, int c_, int K, size_t estride_) {
        int acc = 0;
#pragma unroll
        for (int e = 0; e < 8; ++e) { acc += __builtin_amdgcn_readfirstlane(ctl[CT_EPAD + e]) >> 8; t1[e] = acc; }
        init(acc, nN_, G_, c_, K, __builtin_amdgcn_readfirstlane(ctl[CT_MOES])); estride = estride_;
        acc = 0;
#pragma unroll
        for (int e = 0; e < 8; ++e) { acc += __builtin_amdgcn_readfirstlane(ctl[CT_EPAD + e]) >> 8; t1[e] = acc; }
    }
    __device__ __forceinline__ bool next(int i, Unit& u) const {
        const long L = (long)i * G + c; int wgid;
        if (L < nfull) { wgid = (int)L; { const int q = nfull / NXCD, xcd = wgid % NXCD, off = wgid / NXCD; wgid = xcd * q + off; } u.kt0 = 0; u.nkt = nkt; u.slab = -1; }
        else { const int j = (int)(L - nfull); if (j >= ntail * S) return false; const int tu = j / S, sl = j - tu * S; wgid = nfull + tu; u.kt0 = sl * nkts; u.nkt = nkts; u.slab = (S > 1) ? sl : -1; }
        const int nig = WGM * nN, gid = wgid / nig, fm = gid * WGM, gsz = (nM - fm) < WGM ? (nM - fm) : WGM;
        u.pm = fm + ((wgid % nig) % gsz); u.pn = (wgid % nig) / gsz; return true;
    }
    __device__ __forceinline__ size_t bt_off(const Unit& u) const { if (estride == 0) return 0; int e = 0;
#pragma unroll
        for (int k = 0; k < 7; ++k) e += (u.pm >= t1[k]) ? 1 : 0;
        return (size_t)e * estride; }
    __device__ __forceinline__ void a_ready(const Unit&) const {}
    __device__ __forceinline__ void done(const Unit&) const {}
};
__host__ __device__ constexpr int split_S(int nwg, int nkt, int G) {
    const int ntail = nwg - (nwg / G) * G;
    if (ntail == 0) return 1;
    if (nkt % 28 == 0 && ntail * 14 <= G) return 14;
    if (nkt % 16 == 0 && ntail * 8 <= G) return 8;
    if (nkt % 14 == 0 && ntail * 7 <= G) return 7;
    if (nkt % 8 == 0 && ntail * 4 <= G) return 4;
    if (nkt % 4 == 0 && ntail * 2 <= G) return 2;
    return 1;
}
}

#define LAS __attribute__((address_space(3)))
#define XB_TMO      128
#define XB_XCNT(j)  (256  + 64 * (j))
#define XB_XSUB(j)  (1280 + 64 * (j))
#define XB_XGEN(j)  (2304 + 64 * (j))
#define XB_TOP      3328
#define XB_TOPGEN   3392
#define XCD_BAR_WORDS 3456
#define XB_SPIN_CAP (1u << 18)

__device__ __forceinline__ unsigned xb_ld(unsigned* p)              { return __hip_atomic_load(p, __ATOMIC_RELAXED, __HIP_MEMORY_SCOPE_AGENT); }
__device__ __forceinline__ unsigned xb_add(unsigned* p, unsigned v) { return __hip_atomic_fetch_add(p, v, __ATOMIC_RELAXED, __HIP_MEMORY_SCOPE_AGENT); }
__device__ __forceinline__ unsigned xb_xcc_id() { return (unsigned)__builtin_amdgcn_s_getreg((3 << 11) | 20) & 0xFu; }
#define XB_SPIN(cond, bar) do { unsigned _sp = 0; while (cond) { __builtin_amdgcn_s_sleep(1); \
    if ((++_sp & 255u) == 0u) { if (xb_ld(&(bar)[XB_TMO])) break; if (_sp > XB_SPIN_CAP) { atomicAdd(&(bar)[XB_TMO], 1u); break; } } } } while (0)

struct XcdBarrier {
    unsigned* bar; unsigned x;
    volatile LAS unsigned* st;
};

__device__ __forceinline__ XcdBarrier xcd_barrier_post(unsigned* bar, volatile LAS unsigned* st) {
    XcdBarrier b; b.bar = bar; b.x = xb_xcc_id(); b.st = st;
    if (threadIdx.x == 0) (void)xb_add(&bar[XB_XCNT(b.x)], 1u);
    return b;
}
__device__ __forceinline__ void xcd_barrier_complete(unsigned* bar, unsigned x, unsigned& nloc, unsigned& nx) {
    const unsigned G = gridDim.x * gridDim.y * gridDim.z;
    unsigned sum, cnt, mine, sp = 0u;
    for (;;) {
        sum = 0u; cnt = 0u; mine = 0u;
#pragma unroll
        for (unsigned j = 0; j < 16; ++j) { const unsigned c = xb_ld(&bar[XB_XCNT(j)]); sum += c; cnt += (c > 0u) ? 1u : 0u; mine = (j == x) ? c : mine; }
        if (sum == G) break;
        __builtin_amdgcn_s_sleep(1);
        if ((++sp & 255u) == 0u) { if (xb_ld(&bar[XB_TMO])) break; if (sp > XB_SPIN_CAP) { atomicAdd(&bar[XB_TMO], 1u); break; } }
    }
    nloc = mine > 0u ? mine : 1u; nx = cnt > 0u ? cnt : 1u;
}

__device__ __forceinline__ void xcd_barrier(const XcdBarrier& b) {
    asm volatile("s_waitcnt vmcnt(0)" ::: "memory");
    __syncthreads();
    if (threadIdx.x == 0) {
        unsigned* bar = b.bar;
        __builtin_amdgcn_s_waitcnt(0);
        unsigned nloc = b.st[0], nx = b.st[1];
        if (nloc == 0u) { xcd_barrier_complete(bar, b.x, nloc, nx); b.st[0] = nloc; b.st[1] = nx; }
        const unsigned old = xb_add(&bar[XB_XSUB(b.x)], 1u);
        const unsigned gen = old / nloc;
        if (old + 1u == (gen + 1u) * nloc) {
            __builtin_amdgcn_fence(__ATOMIC_RELEASE, "agent");
            asm volatile("s_waitcnt vmcnt(0)" ::: "memory");
            const unsigned og = xb_add(&bar[XB_TOP], 1u);
            const unsigned tg = og / nx;
            if (og + 1u == (tg + 1u) * nx) xb_add(&bar[XB_TOPGEN], 1u);
            else XB_SPIN(xb_ld(&bar[XB_TOPGEN]) == tg, bar);
            __builtin_amdgcn_fence(__ATOMIC_ACQUIRE, "agent");
            xb_add(&bar[XB_XGEN(b.x)], 1u);
            asm volatile("s_waitcnt vmcnt(0)" ::: "memory");
        } else {
            XB_SPIN(xb_ld(&bar[XB_XGEN(b.x)]) == gen, bar);
            __builtin_amdgcn_fence(__ATOMIC_ACQUIRE, "agent");
            asm volatile("s_waitcnt vmcnt(0)" ::: "memory");
        }
    }
    __syncthreads();
}


struct Args { const float* in[34]; float* out; unsigned char* ws; int ph_lo, ph_hi; };

enum { MAP_ID = 0, MAP_ROPEQ = 1, MAP_GU0 = 2, MAP_GU1 = 3, MAP_KV = 4 };
struct JobDesc { int in_idx, K, N, nbatch, upb, map; long long src_off, src_bstride, dst_off, dst_bstride; int fp8, sidx; };
constexpr int NJOBS = 14, NCONV = 12664;
__constant__ JobDesc c_jobs[NJOBS] = {
    {8, 2048, 3648, 1, 232, MAP_ID, 0, 0, (long long)WS_WIN, 0, I8_WIN ? 2 : 0, 0},
    {8, 2048, 3648, 1, 232, MAP_ID, 2048LL * 3648, 0, (long long)(WS_WIN + (size_t)UW * D * 2), 0, I8_WIN ? 2 : 0, 1},
    {10, 768, 1536, 1, 36, MAP_ROPEQ, 0, 0, (long long)WS_WQ, 0},
    {10, 768, 1536, 1, 36, MAP_ROPEQ, 768LL * 1536, 0, (long long)(WS_WQ + (size_t)QW * 768 * 2), 0},
    {12, 512, 2048, 1, 32, MAP_KV, 0, 0, (long long)WS_WKV, 0},
    {12, 512, 2048, 1, 32, MAP_KV, 512LL * 2048, 0, (long long)(WS_WKV + (size_t)KVW * 512 * 2), 0},
    {25, 2048, 2048, 1, 128, MAP_ID, 0, 0, (long long)WS_WOUT, 0},
    {25, 2048, 2048, 1, 128, MAP_ID, 2048LL * 2048, 0, (long long)(WS_WOUT + (size_t)D * D * 2), 0},
    {26, 2048, 5632, 1, 352, MAP_GU0, 0, 0, (long long)WS_WGU, 0, I8_GU ? 2 : FP8_DENSE, 2},
    {27, 2048, 5632, 1, 352, MAP_GU1, 0, 0, (long long)WS_WGU, 0, I8_GU ? 2 : FP8_DENSE, 3},
    {28, 5632, 2048, 1, 352, MAP_ID, 0, 0, (long long)WS_WDN, 0, (FP8_DENSE || FP8_DOWN), 0},
    {30, 2048, 7168, 8, 448, MAP_GU0, 0, 2048LL * 7168, (long long)WS_MGU, 2LL * DFE * D, 1, 0},
    {31, 2048, 7168, 8, 448, MAP_GU1, 0, 2048LL * 7168, (long long)WS_MGU, 2LL * DFE * D, 1, 0},
    {32, 7168, 2048, 8, 448, MAP_ID, 0, 7168LL * 2048, (long long)WS_MDN, (long long)D * DFE, 1, 0},
};
struct ConvUnit { const float* src; bf16_t* dst; int K, N, map, k0, n0, fp8; float qs; };
__device__ __forceinline__ unsigned pack4_i8(float a, float b, float c, float d) {
    const int ia = (int)__builtin_rintf(fminf(fmaxf(a, -127.f), 127.f)), ib = (int)__builtin_rintf(fminf(fmaxf(b, -127.f), 127.f)), ic = (int)__builtin_rintf(fminf(fmaxf(c, -127.f), 127.f)), id = (int)__builtin_rintf(fminf(fmaxf(d, -127.f), 127.f));
    return (unsigned)(ia & 0xff) | ((unsigned)(ib & 0xff) << 8) | ((unsigned)(ic & 0xff) << 16) | ((unsigned)(id & 0xff) << 24); }
constexpr float WSCALE = 64.f, ASCALE = 8.f;
__device__ __forceinline__ void conv_decode(const Args& a, int u, ConvUnit& cu) {
    int j = 0, base = 0;
    for (;;) { const int n = c_jobs[j].nbatch * c_jobs[j].upb; if (u < base + n || j == NJOBS - 1) break; base += n; ++j; }
    const JobDesc& jd = c_jobs[j];
    int r = u - base; const int bt = r / jd.upb; r -= bt * jd.upb; const int ntn = (jd.N + 127) >> 7; int kt = r / ntn, nt = r - kt * ntn;
    if (((jd.K >> 8) & 1) == 0) { const int r2 = r >> 1; kt = 2 * (r2 / ntn) + (r & 1); nt = r2 % ntn; }
    cu.K = jd.K; cu.N = jd.N; cu.map = jd.map; cu.k0 = kt * 256; cu.n0 = nt * 128; cu.fp8 = jd.fp8; cu.qs = 1.0f;
    if (jd.fp8 == 2) { const float am = __uint_as_float(__hip_atomic_load((const unsigned*)(a.ws + WS_CTL) + CT_WSC + jd.sidx, __ATOMIC_RELAXED, __HIP_MEMORY_SCOPE_AGENT)); cu.qs = am > 0.f ? 127.0f / am : 0.f; }
    const float* sb = j < 2 ? a.in[8] : j < 4 ? a.in[10] : j < 6 ? a.in[12] : j < 8 ? a.in[25] : j == 8 ? a.in[26] : j == 9 ? a.in[27] : j == 10 ? a.in[28] : j == 11 ? a.in[30] : j == 12 ? a.in[31] : a.in[32];
    cu.src = sb + jd.src_off + (long long)bt * jd.src_bstride + (size_t)cu.k0 * jd.N + cu.n0;
    cu.dst = (bf16_t*)(a.ws + jd.dst_off + (long long)bt * jd.dst_bstride);
}
__device__ __forceinline__ int conv_row(int map, int n) {
    if (map == MAP_ID) return n;
    if (map == MAP_GU0) return ((n >> 7) << 8) + (n & 127);
    if (map == MAP_GU1) return ((n >> 7) << 8) + 128 + (n & 127);
    if (map == MAP_KV) { const int hh = n >> 8, jn = n & 255; return jn < 128 ? hh * 128 + jn : 1024 + hh * 128 + (jn - 128); }
    const int hh = n / 192, jn = n - hh * 192; if (jn < 128) return n; const int q = jn - 128; return hh * 192 + 128 + 2 * (q & 31) + (q >> 5);
}
constexpr int CV_P = 129;
#define CONV_LOAD(R, CU) do { const bool ok_ = (CU).n0 + (tid & 31) * 4 < (CU).N; _Pragma("unroll") for (int i_ = 0; i_ < 16; ++i_) { const int row_ = 2 * ((tid >> 5) + 16 * (i_ >> 1)) + (i_ & 1); \
        R[i_] = ok_ ? __builtin_nontemporal_load((const f32x4*)((CU).src + (size_t)row_ * (CU).N + (tid & 31) * 4)) : (f32x4){0.f, 0.f, 0.f, 0.f}; } } while (0)
#define CONV_PUT(R, T) do { _Pragma("unroll") for (int i_ = 0; i_ < 16; ++i_) { const int row_ = 2 * ((tid >> 5) + 16 * (i_ >> 1)) + (i_ & 1); float* tp_ = (T) + row_ * CV_P + (tid & 31) * 4; \
        tp_[0] = R[i_][0]; tp_[1] = R[i_][1]; tp_[2] = R[i_][2]; tp_[3] = R[i_][3]; } } while (0)
__device__ __forceinline__ void conv_out(const ConvUnit& cur, const float* tile, int tid) {
    if (cur.fp8 == 2) {
        const float qs = cur.qs;
#pragma unroll
        for (int j = 0; j < 4; ++j) { const int kc = (tid & 7) + 8 * (j & 1), n = (tid >> 3) + 64 * (j >> 1);
            if (cur.n0 + n < cur.N) { const int row = conv_row(cur.map, cur.n0 + n); const float* tp = tile + (kc * 16) * CV_P + n; u32x4 w;
                w.x = pack4_i8(tp[0] * qs, tp[CV_P] * qs, tp[2 * CV_P] * qs, tp[3 * CV_P] * qs); w.y = pack4_i8(tp[4 * CV_P] * qs, tp[5 * CV_P] * qs, tp[6 * CV_P] * qs, tp[7 * CV_P] * qs);
                w.z = pack4_i8(tp[8 * CV_P] * qs, tp[9 * CV_P] * qs, tp[10 * CV_P] * qs, tp[11 * CV_P] * qs); w.w = pack4_i8(tp[12 * CV_P] * qs, tp[13 * CV_P] * qs, tp[14 * CV_P] * qs, tp[15 * CV_P] * qs);
                *(u32x4*)((unsigned char*)cur.dst + (size_t)row * cur.K + cur.k0 + kc * 16) = w; } }
    } else if (cur.fp8) {
#pragma unroll
        for (int j = 0; j < 4; ++j) { const int kc = (tid & 7) + 8 * (j & 1), n = (tid >> 3) + 64 * (j >> 1);
            if (cur.n0 + n < cur.N) { const int row = conv_row(cur.map, cur.n0 + n); const float* tp = tile + (kc * 16) * CV_P + n; u32x4 w;
                w.x = pg8::pack4_fp8(tp[0] * WSCALE, tp[CV_P] * WSCALE, tp[2 * CV_P] * WSCALE, tp[3 * CV_P] * WSCALE); w.y = pg8::pack4_fp8(tp[4 * CV_P] * WSCALE, tp[5 * CV_P] * WSCALE, tp[6 * CV_P] * WSCALE, tp[7 * CV_P] * WSCALE);
                w.z = pg8::pack4_fp8(tp[8 * CV_P] * WSCALE, tp[9 * CV_P] * WSCALE, tp[10 * CV_P] * WSCALE, tp[11 * CV_P] * WSCALE); w.w = pg8::pack4_fp8(tp[12 * CV_P] * WSCALE, tp[13 * CV_P] * WSCALE, tp[14 * CV_P] * WSCALE, tp[15 * CV_P] * WSCALE);
                *(u32x4*)((unsigned char*)cur.dst + (size_t)row * cur.K + cur.k0 + kc * 16) = w; } }
    } else {
#pragma unroll
        for (int j = 0; j < 8; ++j) { const int kc = (tid & 7) + 8 * (j & 3), n = (tid >> 3) + 64 * (j >> 2);
            if (cur.n0 + n < cur.N) { const int row = conv_row(cur.map, cur.n0 + n); const float* tp = tile + (kc * 8) * CV_P + n; u32x4 w;
                w.x = pg8::cvt_pk_bf16(tp[0], tp[CV_P]); w.y = pg8::cvt_pk_bf16(tp[2 * CV_P], tp[3 * CV_P]); w.z = pg8::cvt_pk_bf16(tp[4 * CV_P], tp[5 * CV_P]); w.w = pg8::cvt_pk_bf16(tp[6 * CV_P], tp[7 * CV_P]);
                *(u32x4*)(cur.dst + (size_t)row * cur.K + cur.k0 + kc * 8) = w; } }
    }
}
template <int MODE = 0>
__device__ __forceinline__ void ph_convert(const Args& a, float* tile, int first, int stride, int end) {
    const int tid = threadIdx.x;
    int u = first; ConvUnit cuA, cuB; f32x4 rA[16], rB[16];
#pragma unroll
    for (int i = 0; i < 16; ++i) { rA[i] = (f32x4){0.f, 0.f, 0.f, 0.f}; rB[i] = rA[i]; }
    if (u < end) { conv_decode(a, u, cuA); if (MODE != 2) CONV_LOAD(rA, cuA); }
    if (u + stride < end) { conv_decode(a, u + stride, cuB); if (MODE != 2) CONV_LOAD(rB, cuB); }
    while (u < end) {
        CONV_PUT(rA, tile);
        __syncthreads();
        { const ConvUnit cur = cuA; const int un = u + 2 * stride; if (un < end) { conv_decode(a, un, cuA); if (MODE != 2) CONV_LOAD(rA, cuA); } if (MODE != 1) conv_out(cur, tile, tid); }
        __syncthreads();
        u += stride; if (u >= end) break;
        CONV_PUT(rB, tile);
        __syncthreads();
        { const ConvUnit cur = cuB; const int un = u + 2 * stride; if (un < end) { conv_decode(a, un, cuB); if (MODE != 2) CONV_LOAD(rB, cuB); } if (MODE != 1) conv_out(cur, tile, tid); }
        __syncthreads();
        u += stride;
    }
}
constexpr int CT_QNEXT = 1152;
template <int MODE = 0>
__device__ __forceinline__ void conv_dynamic(const Args& a, float* tile) {
    unsigned* qn = (unsigned*)(a.ws + WS_CTL) + CT_QNEXT; volatile int* bc = (volatile int*)(tile + 256 * CV_P + 4);
    const int tid = threadIdx.x;
    if (tid == 0) { bc[0] = (int)__hip_atomic_fetch_add(qn, 1u, __ATOMIC_RELAXED, __HIP_MEMORY_SCOPE_AGENT); bc[1] = (int)__hip_atomic_fetch_add(qn, 1u, __ATOMIC_RELAXED, __HIP_MEMORY_SCOPE_AGENT); }
    __syncthreads();
    int q = bc[0], qN = bc[1];
    __syncthreads();
    ConvUnit cuA, cuB; f32x4 rA[16], rB[16];
#pragma unroll
    for (int i = 0; i < 16; ++i) { rA[i] = (f32x4){0.f, 0.f, 0.f, 0.f}; rB[i] = rA[i]; }
    if (2 * q < NCONV) { conv_decode(a, 2 * q, cuA); if (MODE != 2) CONV_LOAD(rA, cuA); }
    if (2 * q + 1 < NCONV) { conv_decode(a, 2 * q + 1, cuB); if (MODE != 2) CONV_LOAD(rB, cuB); }
    while (2 * q < NCONV) {
        const bool hasB = 2 * q + 1 < NCONV;
        CONV_PUT(rA, tile);
        __syncthreads();
        { const ConvUnit cur = cuA; if (2 * qN < NCONV) { conv_decode(a, 2 * qN, cuA); if (MODE != 2) CONV_LOAD(rA, cuA); }
          if (tid == 0) bc[0] = (int)__hip_atomic_fetch_add(qn, 1u, __ATOMIC_RELAXED, __HIP_MEMORY_SCOPE_AGENT);
          if (MODE != 1) conv_out(cur, tile, tid); }
        __syncthreads();
        if (hasB) {
            CONV_PUT(rB, tile);
            __syncthreads();
            { const ConvUnit cur = cuB; if (2 * qN + 1 < NCONV) { conv_decode(a, 2 * qN + 1, cuB); if (MODE != 2) CONV_LOAD(rB, cuB); }
              if (MODE != 1) conv_out(cur, tile, tid); }
            __syncthreads();
        }
        q = qN; qN = bc[0];
    }
    __syncthreads();
}
#undef CONV_LOAD
#undef CONV_PUT
constexpr int CONV_STATIC = 856, CONV_DENSE_END = 1912, CONV_BATCH = 2;
__device__ __forceinline__ constexpr int CT_DONE(int k) { return 1216 + 64 * k; }
__device__ __forceinline__ void conv_fill(const Args& a, float* tile, int done_idx) {
#if !CONV_FILL
    (void)a; (void)tile; (void)done_idx; return;
#endif
    unsigned* ctl = (unsigned*)(a.ws + WS_CTL); volatile int* bc = (volatile int*)(tile + 256 * CV_P + 4);
    const int tid = threadIdx.x;
    if (tid == 0) (void)__hip_atomic_fetch_add(ctl + CT_DONE(done_idx), 1u, __ATOMIC_RELAXED, __HIP_MEMORY_SCOPE_AGENT);
    for (;;) {
        if (tid == 0) { int q = -1;
            if (__hip_atomic_load(ctl + CT_DONE(done_idx), __ATOMIC_RELAXED, __HIP_MEMORY_SCOPE_AGENT) < gridDim.x) {
                q = (int)__hip_atomic_fetch_add(ctl + CT_QNEXT, (unsigned)CONV_BATCH, __ATOMIC_RELAXED, __HIP_MEMORY_SCOPE_AGENT) + CONV_STATIC; if (q >= NCONV) q = -1; }
            *bc = q; }
        __syncthreads();
        const int q = *bc;
        __syncthreads();
        if (q < 0) break;
        ph_convert(a, tile, q, 1, (q + CONV_BATCH < NCONV) ? q + CONV_BATCH : NCONV);
    }
}
__device__ __forceinline__ void conv_finish(const Args& a, float* tile, int upto) {
#if !CONV_FILL
    (void)a; (void)tile; (void)upto; return;
#endif
    unsigned* ctl = (unsigned*)(a.ws + WS_CTL); volatile int* bc = (volatile int*)(tile + 256 * CV_P + 4);
    const int tid = threadIdx.x;
    for (;;) {
        if (tid == 0) { int q = -1;
            if ((int)__hip_atomic_load(ctl + CT_QNEXT, __ATOMIC_RELAXED, __HIP_MEMORY_SCOPE_AGENT) + CONV_STATIC < upto) {
                q = (int)__hip_atomic_fetch_add(ctl + CT_QNEXT, (unsigned)CONV_BATCH, __ATOMIC_RELAXED, __HIP_MEMORY_SCOPE_AGENT) + CONV_STATIC; if (q >= NCONV) q = -1; }
            *bc = q; }
        __syncthreads();
        const int q = *bc;
        __syncthreads();
        if (q < 0) break;
        ph_convert(a, tile, q, 1, (q + CONV_BATCH < NCONV) ? q + CONV_BATCH : NCONV);
    }
}
__device__ __forceinline__ void adaln_unit(const Args& a, int unit, float* sm) {
    const float* c = a.in[1]; const float* cctx = a.in[3]; const float* w_mod = a.in[4]; const float* b_mod = a.in[5]; float* mod = (float*)(a.ws + WS_MOD);
    const int tid = threadIdx.x, l = unit / 96, chunk = unit - l * 96;
    const int cg = tid & 31, ks = tid >> 5;
    for (int i = tid; i < 5 * 2048; i += 512) { const int v = i >> 11, k = i & 2047; const float val = v < 4 ? c[v * 2048 + k] : cctx[k]; sm[i] = val / (1.0f + __expf(-val)); }
    __syncthreads();
    float acc[5][4];
#pragma unroll
    for (int v = 0; v < 5; ++v)
#pragma unroll
        for (int j = 0; j < 4; ++j) acc[v][j] = 0.f;
    const float* wp = w_mod + ((size_t)l * 2048 + (size_t)ks * 128) * 12288 + chunk * 128 + cg * 4;
    for (int kb = 0; kb < 128; kb += 16) {
        f32x4 w[16];
#pragma unroll
        for (int kk = 0; kk < 16; ++kk) w[kk] = __builtin_nontemporal_load((const f32x4*)(wp + (size_t)(kb + kk) * 12288));
#pragma unroll
        for (int kk = 0; kk < 16; ++kk) { const int k = ks * 128 + kb + kk;
#pragma unroll
            for (int v = 0; v < 5; ++v) { const float s = sm[v * 2048 + k];
#pragma unroll
                for (int j = 0; j < 4; ++j) acc[v][j] += s * w[kk][j]; } }
    }
    __syncthreads();
#pragma unroll
    for (int v = 0; v < 5; ++v)
#pragma unroll
        for (int j = 0; j < 4; ++j) sm[(ks * 5 + v) * 128 + cg * 4 + j] = acc[v][j];
    __syncthreads();
    for (int o = tid; o < 640; o += 512) {
        const int v = o >> 7, cc = o & 127; float s = 0.f;
#pragma unroll
        for (int k2 = 0; k2 < 16; ++k2) s += sm[(k2 * 5 + v) * 128 + cc];
        mod[((size_t)l * 5 + v) * 12288 + chunk * 128 + cc] = s + b_mod[(size_t)l * 12288 + chunk * 128 + cc];
    }
    __syncthreads();
}
constexpr int FW_W1 = 0, FW_W2 = 2112, FW_W3 = 6208, FW_B1 = 10304, FW_B2 = 10368, FW_B3 = 10432, FW_FR = 10496, FW_ZS = 10560, FW_HA = 10848, FW_HB = 11360, FW_END = 11872;
__device__ __forceinline__ void filters_unit(const Args& a, int l, int r, float* sm) {
    float (*zs)[36] = (float (*)[36])(sm + FW_ZS); float (*ha)[64] = (float (*)[64])(sm + FW_HA); float (*hb)[64] = (float (*)[64])(sm + FW_HB);
    const int tid = threadIdx.x;
    const bool lat = r < 256; const int Lf = lat ? 2048 : 256; const int p0 = lat ? r * 8 : (r - 256) * 8;
    float* T = (float*)(a.ws + WS_FILTC) + (size_t)l * 512 * 512;
    const float* wf = a.in[21] + (size_t)l * 64 * 1024;
    const int p = tid >> 6, j = tid & 63; const int pos = p0 + p;
    const float tn = (float)pos / (float)(Lf - 1);
    if (j < 33) {
        float z;
        if (j == 0) z = tn;
        else { const int bi = (j - 1) & 15; const float band = 1e-4f + (float)bi * ((15.0f - 1e-4f) / 15.0f);
               const float ang = (6.283185307179586f / (float)Lf) * (float)pos * band; z = (j <= 16) ? __cosf(ang) : -__sinf(ang); }
        zs[p][j] = z;
    }
    __syncthreads();
    const float f = sm[FW_FR + j];
    { float s = sm[FW_B1 + j];
#pragma unroll
      for (int i = 0; i < 33; ++i) s += zs[p][i] * sm[FW_W1 + i * 64 + j];
      ha[p][j] = __sinf(f * s); }
    __syncthreads();
    { float s = sm[FW_B2 + j];
#pragma unroll 16
      for (int i = 0; i < 64; ++i) s += ha[p][i] * sm[FW_W2 + i * 64 + j];
      hb[p][j] = __sinf(f * s); }
    __syncthreads();
    { float s = sm[FW_B3 + j];
#pragma unroll 16
      for (int i = 0; i < 64; ++i) s += hb[p][i] * sm[FW_W3 + i * 64 + j];
      ha[p][j] = __sinf(f * s); }
    __syncthreads();
    float acc[2][8];
#pragma unroll
    for (int rr = 0; rr < 2; ++rr)
#pragma unroll
        for (int q = 0; q < 8; ++q) acc[rr][q] = 0.f;
    for (int ib = 0; ib < 64; ib += 16) {
        float wa[16], wb[16];
#pragma unroll
        for (int i = 0; i < 16; ++i) { wa[i] = wf[(ib + i) * 1024 + tid]; wb[i] = wf[(ib + i) * 1024 + 512 + tid]; }
#pragma unroll
        for (int i = 0; i < 16; ++i) {
#pragma unroll
            for (int q = 0; q < 8; ++q) { const float h = ha[q][ib + i]; acc[0][q] += h * wa[i]; acc[1][q] += h * wb[i]; } }
    }
    const int ch = tid;
    const float delta = 3.0701134573253944f + (float)ch * ((15.350567286626972f - 3.0701134573253944f) / 511.0f);
#pragma unroll
    for (int q = 0; q < 8; ++q) {
        const int ps = p0 + q; const float dec = __expf(-((float)ps / (float)(Lf - 1)) * delta);
        const float vf = acc[0][q] * dec, vb = acc[1][q] * dec;
        if (lat) { bf16_t* RBp = (bf16_t*)(a.ws + WS_FILTL) + ((size_t)l * 512 + ch) * HY_RBROW; RBp[2048 - ps] = f2bf(vf); if (ps > 0) RBp[2048 + ps] = f2bf(vb); }
        else { T[(size_t)ch * (2 * Lf) + Lf + ps] = vf; if (ps > 0) T[(size_t)ch * (2 * Lf) + Lf - ps] = vb; else T[(size_t)ch * (2 * Lf)] = 0.f; }
    }
    __syncthreads();
}
__device__ __forceinline__ void ph_filters(const Args& a, float* sm, int fb, int nfb) {
    const int tid = threadIdx.x;
    for (int l = 0; l < 2; ++l) {
        for (int i = tid; i < 2112; i += NTHR) sm[FW_W1 + i] = a.in[15][l * 2112 + i];
        for (int i = tid; i < 4096; i += NTHR) { sm[FW_W2 + i] = a.in[17][l * 4096 + i]; sm[FW_W3 + i] = a.in[19][l * 4096 + i]; }
        if (tid < 64) { sm[FW_B1 + tid] = a.in[16][l * 64 + tid]; sm[FW_B2 + tid] = a.in[18][l * 64 + tid]; sm[FW_B3 + tid] = a.in[20][l * 64 + tid]; sm[FW_FR + tid] = a.in[22][l * 64 + tid]; }
        __syncthreads();
        for (int r = fb; r < 288; r += nfb) filters_unit(a, l, r, sm);
        __syncthreads();
    }
}
#define SUBREP(b) for (int srep_ = 0; srep_ <= (int)((PROBE_SUB >> (b)) & 1u); ++srep_)
__device__ __forceinline__ void ph_absmax(const Args& a, float* sm) {
    unsigned* ctl = (unsigned*)(a.ws + WS_CTL); const int tid = threadIdx.x, G = gridDim.x, bid = blockIdx.x, lane = tid & 63, w = tid >> 6;
#pragma unroll
    for (int j = (I8_WIN ? 0 : 2); j < (I8_GU ? 4 : 2); ++j) {
        const f32x4* p4 = (const f32x4*)(j == 0 ? a.in[8] : j == 1 ? a.in[8] + (size_t)2048 * 3648 : j == 2 ? a.in[26] : a.in[27]);
        const int n4 = (j < 2 ? 2048 * 3648 : 2048 * 5632) / 4, step = G * 512;
        float mm = 0.f;
        for (int i0 = bid * 512 + tid; i0 < n4; i0 += step * 8) {
            f32x4 v[8];
#pragma unroll
            for (int u = 0; u < 8; ++u) { const int i = i0 + u * step; v[u] = i < n4 ? __builtin_nontemporal_load(p4 + i) : (f32x4){0.f, 0.f, 0.f, 0.f}; }
#pragma unroll
            for (int u = 0; u < 8; ++u) mm = fmaxf(mm, fmaxf(fmaxf(fabsf(v[u][0]), fabsf(v[u][1])), fmaxf(fabsf(v[u][2]), fabsf(v[u][3]))));
        }
        mm = wave_max(mm);
        if (lane == 0) sm[w] = mm;
        __syncthreads();
        if (tid == 0) { float t = sm[0];
#pragma unroll
            for (int k = 1; k < 8; ++k) t = fmaxf(t, sm[k]);
            (void)__hip_atomic_fetch_max(ctl + CT_WSC + j, __float_as_uint(t), __ATOMIC_RELAXED, __HIP_MEMORY_SCOPE_AGENT); }
        __syncthreads();
    }
    if (tid == 0) (void)__hip_atomic_fetch_add(ctl + CT_AMAXDONE, 1u, __ATOMIC_RELAXED, __HIP_MEMORY_SCOPE_AGENT);
}
__device__ __forceinline__ void ph_prologue(const Args& a, float* sm) {
    const int bid = blockIdx.x, G = gridDim.x, tid = threadIdx.x;
    const int NF = G >= 128 ? 64 : 0;
    if (I8_GEMM) ph_absmax(a, sm);
    if (NF == 0) { SUBREP(4) for (int u = bid; u < 192; u += G) adaln_unit(a, u, sm); SUBREP(5) ph_filters(a, sm, bid, G); }
    else if (bid < NF) { SUBREP(5) ph_filters(a, sm, bid, NF); }
    else { SUBREP(4) for (int u = bid - NF; u < 192; u += G - NF) adaln_unit(a, u, sm); }
    { float* cosT = (float*)(a.ws + WS_ROPE); float* sinT = cosT + 2048 * 32;
      for (int i = bid * 512 + tid; i < 2048 * 32; i += G * 512) { const int t = i >> 5, f = i & 31;
          const float pos = (float)((f < 16) ? (t >> 6) : (t & 63)); const float freq = powf(10000.0f, -(float)(f & 15) / 16.0f); const float ang = pos * freq;
          cosT[i] = cosf(ang); sinT[i] = sinf(ang); } }
    for (int i = bid * 512 + tid; i < 2 * 512 * 17; i += G * 512) { const int row = i / 17, k = i - row * 17; ((bf16_t*)(a.ws + WS_FILTL))[(size_t)row * HY_RBROW + (k == 0 ? 0 : 4095 + k)] = 0; }
    { constexpr int RB16 = I8_WIN ? 128 : 256;
      for (int i = bid * 512 + tid; i < 2 * 192 * RB16; i += G * 512) { const int l = i / (192 * RB16), r = i % (192 * RB16);
        *(u32x4*)(a.ws + WS_WIN + (size_t)l * UW * D * 2 + (size_t)INW * RB16 * 16 + (size_t)r * 16) = (u32x4){0u, 0u, 0u, 0u}; } }
    if (I8_GEMM) {
        if (tid == 0) { const unsigned* dn = (const unsigned*)(a.ws + WS_CTL) + CT_AMAXDONE; unsigned sp = 0;
            while (__hip_atomic_load(dn, __ATOMIC_RELAXED, __HIP_MEMORY_SCOPE_AGENT) < (unsigned)G && ++sp < (1u << 22)) __builtin_amdgcn_s_sleep(4); }
    }
    __syncthreads();
    if ((PROBE_SUB >> 8) & 1u) ph_convert<2>(a, sm, bid, G, NCONV);
    conv_dynamic<0>(a, sm);
    if ((PROBE_SUB >> 6) & 1u) ph_convert<0>(a, sm, bid, G, NCONV);
    if ((PROBE_SUB >> 7) & 1u) ph_convert<1>(a, sm, bid, G, NCONV);
}

template <bool ROUTER, bool COPYX, int OUT8 = 0, int NSLAB = 0>
__device__ __forceinline__ void ph_normmod(const float* __restrict__ xlat, const float* __restrict__ xctx, const float* __restrict__ gain, const float* __restrict__ modl, int sh_off, int sc_off,
                                           bf16_t* __restrict__ out, int nrows, float* __restrict__ xs, const float* __restrict__ router, int* __restrict__ topi, float* __restrict__ topw,
                                           const float* __restrict__ slab = nullptr, const float* __restrict__ slab_gate = nullptr, float* __restrict__ rsc = nullptr) {
    const int lane = threadIdx.x & 63, wid = threadIdx.x >> 6;
    for (int row = blockIdx.x * 8 + wid; row < nrows; row += gridDim.x * 8) {
        const float* xr = row < NLAT ? xlat + (size_t)row * D : xctx + (size_t)(row - NLAT) * D;
        const float* mv = modl + (size_t)tok_mod(row) * 12288;
        f32x4 v[8]; float ss = 0.f;
#pragma unroll
        for (int i = 0; i < 8; ++i) { v[i] = *(const f32x4*)(xr + i * 256 + lane * 4);
            if (NSLAB > 0 && row >= NLAT) { f32x4 sa = *(const f32x4*)(slab + (size_t)(row - NLAT) * D + i * 256 + lane * 4);
#pragma unroll
                for (int sl = 1; sl < NSLAB; ++sl) sa += *(const f32x4*)(slab + ((size_t)sl * NCTX + (row - NLAT)) * D + i * 256 + lane * 4);
                v[i] += *(const f32x4*)(slab_gate + i * 256 + lane * 4) * sa; }
            ss += v[i][0] * v[i][0] + v[i][1] * v[i][1] + v[i][2] * v[i][2] + v[i][3] * v[i][3];
            if (COPYX && (NSLAB == 0 || row >= NLAT)) *(f32x4*)(xs + (size_t)row * D + i * 256 + lane * 4) = v[i]; }
        ss = wave_sum(ss);
        const float rstd = rsqrtf(ss * (1.0f / D) + EPS);
        float lg[8];
#pragma unroll
        for (int e = 0; e < 8; ++e) lg[e] = 0.f;
        float amax = 0.f;
#pragma unroll
        for (int i = 0; i < 8; ++i) {
            const int col = i * 256 + lane * 4;
            const f32x4 g = *(const f32x4*)(gain + col), sc = *(const f32x4*)(mv + sc_off + col), sh = *(const f32x4*)(mv + sh_off + col);
            f32x4 o;
#pragma unroll
            for (int j = 0; j < 4; ++j) o[j] = (v[i][j] * rstd * g[j]) * (1.0f + sc[j]) + sh[j];
            if (OUT8 == 2) { v[i] = o; amax = fmaxf(amax, fmaxf(fmaxf(fabsf(o[0]), fabsf(o[1])), fmaxf(fabsf(o[2]), fabsf(o[3])))); }
            else if (OUT8 == 1) *(unsigned*)((unsigned char*)out + (size_t)row * D + col) = pg8::pack4_fp8(o[0] * ASCALE, o[1] * ASCALE, o[2] * ASCALE, o[3] * ASCALE);
            else { u32x2 w; w.x = (unsigned)f2bf(o[0]) | ((unsigned)f2bf(o[1]) << 16); w.y = (unsigned)f2bf(o[2]) | ((unsigned)f2bf(o[3]) << 16);
                *(u32x2*)(out + (size_t)row * D + col) = w; }
            if (ROUTER) {
#pragma unroll
                for (int j = 0; j < 4; ++j) { const f32x4 r0 = *(const f32x4*)(router + (size_t)(col + j) * 8), r1 = *(const f32x4*)(router + (size_t)(col + j) * 8 + 4);
                    lg[0] += o[j] * r0[0]; lg[1] += o[j] * r0[1]; lg[2] += o[j] * r0[2]; lg[3] += o[j] * r0[3];
                    lg[4] += o[j] * r1[0]; lg[5] += o[j] * r1[1]; lg[6] += o[j] * r1[2]; lg[7] += o[j] * r1[3]; }
                asm volatile("" ::: "memory");
            }
        }
        if (OUT8 == 2) {
            amax = wave_max(amax); const float qs = amax > 0.f ? 127.0f / amax : 0.f;
#pragma unroll
            for (int i = 0; i < 8; ++i) *(unsigned*)((unsigned char*)out + (size_t)row * D + i * 256 + lane * 4) = pack4_i8(v[i][0] * qs, v[i][1] * qs, v[i][2] * qs, v[i][3] * qs);
            if (lane == 0) rsc[row] = amax * (1.0f / 127.0f);
        }
        if (ROUTER) {
#pragma unroll
            for (int e = 0; e < 8; ++e) lg[e] = wave_sum(lg[e]);
            if (lane == 0) {
                int i0 = 0; float v0 = lg[0];
#pragma unroll
                for (int e = 1; e < 8; ++e) if (lg[e] > v0) { v0 = lg[e]; i0 = e; }
                int i1 = -1; float v1 = -3.0e38f;
#pragma unroll
                for (int e = 0; e < 8; ++e) if (e != i0 && lg[e] > v1) { v1 = lg[e]; i1 = e; }
                const float e1 = expf(v1 - v0), w0 = 1.0f / (1.0f + e1), w1 = e1 / (1.0f + e1);
                topi[row * 2] = i0; topi[row * 2 + 1] = i1; topw[row * 2] = w0; topw[row * 2 + 1] = w1;
            }
        }
    }
}

__device__ __forceinline__ float bflo(unsigned w) { return __uint_as_float(w << 16); }
__device__ __forceinline__ float bfhi(unsigned w) { return __uint_as_float(w & 0xffff0000u); }
__device__ __forceinline__ unsigned pkbf(float lo, float hi) { return (unsigned)f2bf(lo) | ((unsigned)f2bf(hi) << 16); }
__device__ __forceinline__ u32x4 rope8(const u32x4 mine, const u32x4 other, bool is_x2, const f32x4 c0, const f32x4 c1, const f32x4 s0, const f32x4 s1) {
    const unsigned mw[4] = {mine.x, mine.y, mine.z, mine.w}, ow[4] = {other.x, other.y, other.z, other.w};
    const float cs[8] = {c0[0], c0[1], c0[2], c0[3], c1[0], c1[1], c1[2], c1[3]}, sn[8] = {s0[0], s0[1], s0[2], s0[3], s1[0], s1[1], s1[2], s1[3]};
    unsigned o[4];
#pragma unroll
    for (int d = 0; d < 4; ++d) {
        const float m0 = bflo(mw[d]), m1 = bfhi(mw[d]), p0 = bflo(ow[d]), p1 = bfhi(ow[d]);
        const float r0 = is_x2 ? (p0 * sn[2 * d] + m0 * cs[2 * d]) : (m0 * cs[2 * d] - p0 * sn[2 * d]);
        const float r1 = is_x2 ? (p1 * sn[2 * d + 1] + m1 * cs[2 * d + 1]) : (m1 * cs[2 * d + 1] - p1 * sn[2 * d + 1]);
        o[d] = pkbf(r0, r1);
    }
    return (u32x4){o[0], o[1], o[2], o[3]};
}
__device__ __forceinline__ u32x4 shfl4(const u32x4 v, int m) { return (u32x4){(unsigned)__shfl_xor((int)v.x, m), (unsigned)__shfl_xor((int)v.y, m), (unsigned)__shfl_xor((int)v.z, m), (unsigned)__shfl_xor((int)v.w, m)}; }
__device__ __forceinline__ void ph_mid(const Args& a, int l) {
    const bf16_t* __restrict__ U = (const bf16_t*)(a.ws + WS_U);
    const float* g_q = a.in[9] + l * 768; const float* g_kv = a.in[11] + l * 512; const float* conv_w = a.in[13] + (size_t)l * 3 * 1536; const float* conv_b = a.in[14] + l * 1536;
    const float* cosT = (const float*)(a.ws + WS_ROPE); const float* sinT = cosT + 2048 * 32;
    bf16_t* cqn = (bf16_t*)(a.ws + WS_CQN); bf16_t* ckvn = (bf16_t*)(a.ws + WS_CKVN); bf16_t* kpe = (bf16_t*)(a.ws + WS_KPE); bf16_t* x0o = (bf16_t*)(a.ws + WS_X0);
    bf16_t* wtl = (bf16_t*)(a.ws + WS_WTL); bf16_t* wtc = (bf16_t*)(a.ws + WS_WTC); bf16_t* sq = (bf16_t*)(a.ws + WS_SQ); bf16_t* sk = (bf16_t*)(a.ws + WS_SK); bf16_t* sv = (bf16_t*)(a.ws + WS_SV);
    int tid_ = threadIdx.x; asm volatile("" : "+v"(tid_));
    const int tid = tid_, lane = tid & 63, wid = tid >> 6;
    for (int unit = blockIdx.x; unit < NTOK / 16; unit += gridDim.x) {
        const int tok0 = unit * 16;
        for (int tt = 0; tt < 2; ++tt) {
            const int tok = tok0 + wid * 2 + tt; const bool lat = tok < NLAT; const int t = lat ? (tok & 2047) : ((tok - NLAT) & 255);
            const bf16_t* u = U + (size_t)tok * UW;
            const u32x2 q0 = *(const u32x2*)(u + O_CQ + lane * 12), q1 = *(const u32x2*)(u + O_CQ + lane * 12 + 4), q2 = *(const u32x2*)(u + O_CQ + lane * 12 + 8);
            const u32x4 kvv = *(const u32x4*)(u + O_CKV + lane * 8);
            const u32x4 sqv = *(const u32x4*)(u + O_SQ + lane * 8);
            const u32x4 skv = *(const u32x4*)(u + O_SK + (lane & 15) * 8);
            const u32x4 kpv = *(const u32x4*)(u + O_KPE + (lane & 7) * 8);
            const int i0 = (lane & 3) * 8;
            f32x4 c0 = (f32x4){1.f, 1.f, 1.f, 1.f}, c1 = c0, s0 = (f32x4){0.f, 0.f, 0.f, 0.f}, s1 = s0;
            if (lat) { c0 = *(const f32x4*)(cosT + t * 32 + i0); c1 = *(const f32x4*)(cosT + t * 32 + i0 + 4); s0 = *(const f32x4*)(sinT + t * 32 + i0); s1 = *(const f32x4*)(sinT + t * 32 + i0 + 4); }
            {
                const unsigned w6[6] = {q0.x, q0.y, q1.x, q1.y, q2.x, q2.y}; float x[12]; float ss = 0.f;
#pragma unroll
                for (int d = 0; d < 6; ++d) { x[2 * d] = bflo(w6[d]); x[2 * d + 1] = bfhi(w6[d]); ss += x[2 * d] * x[2 * d] + x[2 * d + 1] * x[2 * d + 1]; }
                ss = wave_sum(ss); const float rs = rsqrtf(ss * (1.0f / 768.0f) + EPS);
                const f32x4 g0 = *(const f32x4*)(g_q + lane * 12), g1 = *(const f32x4*)(g_q + lane * 12 + 4), g2 = *(const f32x4*)(g_q + lane * 12 + 8);
                u32x2 o0, o1, o2;
                o0.x = pkbf(x[0] * rs * g0[0], x[1] * rs * g0[1]); o0.y = pkbf(x[2] * rs * g0[2], x[3] * rs * g0[3]);
                o1.x = pkbf(x[4] * rs * g1[0], x[5] * rs * g1[1]); o1.y = pkbf(x[6] * rs * g1[2], x[7] * rs * g1[3]);
                o2.x = pkbf(x[8] * rs * g2[0], x[9] * rs * g2[1]); o2.y = pkbf(x[10] * rs * g2[2], x[11] * rs * g2[3]);
                bf16_t* dst = cqn + (size_t)tok * 768 + lane * 12; *(u32x2*)dst = o0; *(u32x2*)(dst + 4) = o1; *(u32x2*)(dst + 8) = o2;
            }
            {
                const unsigned w4[4] = {kvv.x, kvv.y, kvv.z, kvv.w}; float x[8]; float ss = 0.f;
#pragma unroll
                for (int d = 0; d < 4; ++d) { x[2 * d] = bflo(w4[d]); x[2 * d + 1] = bfhi(w4[d]); ss += x[2 * d] * x[2 * d] + x[2 * d + 1] * x[2 * d + 1]; }
                ss = wave_sum(ss); const float rs = rsqrtf(ss * (1.0f / 512.0f) + EPS);
                const f32x4 g0 = *(const f32x4*)(g_kv + lane * 8), g1 = *(const f32x4*)(g_kv + lane * 8 + 4);
                u32x4 o; o.x = pkbf(x[0] * rs * g0[0], x[1] * rs * g0[1]); o.y = pkbf(x[2] * rs * g0[2], x[3] * rs * g0[3]); o.z = pkbf(x[4] * rs * g1[0], x[5] * rs * g1[1]); o.w = pkbf(x[6] * rs * g1[2], x[7] * rs * g1[3]);
                *(u32x4*)(ckvn + (size_t)tok * 512 + lane * 8) = o;
            }
            const bool is_x2 = (lane & 4) != 0;
            {
                const u32x4 r = rope8(sqv, shfl4(sqv, 4), is_x2, c0, c1, s0, s1);
                *(u32x4*)(sq + (size_t)tok * 512 + lane * 8) = r;
            }
            {
                const u32x4 r = rope8(skv, shfl4(skv, 4), is_x2, c0, c1, s0, s1);
                if (lane < 16) *(u32x4*)(sk + (size_t)tok * 128 + lane * 8) = r;
            }
            {
                const u32x4 ot = shfl4(kpv, 4);
                if (lane < 4) {
                    const unsigned mw[4] = {kpv.x, kpv.y, kpv.z, kpv.w}, ow[4] = {ot.x, ot.y, ot.z, ot.w};
                    const float cs[8] = {c0[0], c0[1], c0[2], c0[3], c1[0], c1[1], c1[2], c1[3]}, sn[8] = {s0[0], s0[1], s0[2], s0[3], s1[0], s1[1], s1[2], s1[3]};
                    unsigned o[8];
#pragma unroll
                    for (int d = 0; d < 4; ++d) { const float a0 = bflo(mw[d]), a1 = bfhi(mw[d]), b0 = bflo(ow[d]), b1 = bfhi(ow[d]);
                        o[2 * d] = pkbf(a0 * cs[2 * d] - b0 * sn[2 * d], a0 * sn[2 * d] + b0 * cs[2 * d]);
                        o[2 * d + 1] = pkbf(a1 * cs[2 * d + 1] - b1 * sn[2 * d + 1], a1 * sn[2 * d + 1] + b1 * cs[2 * d + 1]); }
                    bf16_t* dst = kpe + (size_t)tok * 64 + lane * 16;
                    *(u32x4*)dst = (u32x4){o[0], o[1], o[2], o[3]}; *(u32x4*)(dst + 8) = (u32x4){o[4], o[5], o[6], o[7]};
                }
            }
        }
        {
            const bool lat = tok0 < NLAT; const int Ls = lat ? L : C;
            const int b = lat ? (tok0 >> 11) : ((tok0 - NLAT) >> 8), t0 = (lat ? (tok0 & 2047) : ((tok0 - NLAT) & 255));
            const int cp = tid & 255, hf = tid >> 8, ch = cp * 2, ts = t0 + hf * 8, tokb = tok0 + hf * 8;
            float cw[3][3][2], cb[3][2];
#pragma unroll
            for (int g = 0; g < 3; ++g) { cb[g][0] = conv_b[g * 512 + ch]; cb[g][1] = conv_b[g * 512 + ch + 1];
#pragma unroll
                for (int j = 0; j < 3; ++j) { cw[g][j][0] = conv_w[j * 1536 + g * 512 + ch]; cw[g][j][1] = conv_w[j * 1536 + g * 512 + ch + 1]; } }
            unsigned rows[3][10];
#pragma unroll
            for (int r = 0; r < 10; ++r) { const int tr = ts - 1 + r; const bool ok = tr >= 0 && tr < Ls;
#pragma unroll
                for (int g = 0; g < 3; ++g) rows[g][r] = ok ? *(const unsigned*)(U + (size_t)(tokb - 1 + r) * UW + O_HY + g * 512 + ch) : 0u; }
            unsigned wp0[4], wp1[4];
#pragma unroll
            for (int i = 0; i < 8; ++i) {
                float y[3][2];
#pragma unroll
                for (int g = 0; g < 3; ++g) {
                    y[g][0] = cb[g][0] + cw[g][0][0] * bflo(rows[g][i]) + cw[g][1][0] * bflo(rows[g][i + 1]) + cw[g][2][0] * bflo(rows[g][i + 2]);
                    y[g][1] = cb[g][1] + cw[g][0][1] * bfhi(rows[g][i]) + cw[g][1][1] * bfhi(rows[g][i + 1]) + cw[g][2][1] * bfhi(rows[g][i + 2]); }
                *(unsigned*)(x0o + (size_t)(tokb + i) * 512 + ch) = pkbf(y[0][0], y[0][1]);
                const unsigned w0 = f2bf(y[2][0] * y[1][0]), w1 = f2bf(y[2][1] * y[1][1]);
                if (i & 1) { wp0[i >> 1] |= w0 << 16; wp1[i >> 1] |= w1 << 16; } else { wp0[i >> 1] = w0; wp1[i >> 1] = w1; }
            }
            bf16_t* wt = lat ? wtl + ((size_t)b * 512 + ch) * L + ts : wtc + ((size_t)b * 512 + ch) * C + ts;
            *(u32x4*)wt = (u32x4){wp0[0], wp0[1], wp0[2], wp0[3]};
            *(u32x4*)(wt + (lat ? L : C)) = (u32x4){wp1[0], wp1[1], wp1[2], wp1[3]};
        }
        if (tid < 128) {
            unsigned pk[8];
#pragma unroll
            for (int i = 0; i < 16; ++i) { const unsigned v = U[(size_t)(tok0 + i) * UW + O_SV + tid]; if (i & 1) pk[i >> 1] |= v << 16; else pk[i >> 1] = v; }
            bf16_t* dst = sv + (size_t)tid * NTOK + tok0;
            u32x4 w0, w1; w0.x = pk[0]; w0.y = pk[1]; w0.z = pk[2]; w0.w = pk[3]; w1.x = pk[4]; w1.y = pk[5]; w1.z = pk[6]; w1.w = pk[7];
            *(u32x4*)dst = w0; *(u32x4*)(dst + 8) = w1;
        }
    }
}

__device__ __forceinline__ void ph_mla_naive(const Args& a, int nq, float* sm) {
    const bf16_t* __restrict__ Q = (const bf16_t*)(a.ws + WS_Q); const bf16_t* __restrict__ KV = (const bf16_t*)(a.ws + WS_KV); const bf16_t* __restrict__ KPE = (const bf16_t*)(a.ws + WS_KPE);
    bf16_t* mix = (bf16_t*)(a.ws + WS_MIX);
    const int lane = threadIdx.x & 63, w = threadIdx.x >> 6;
    float* qf = sm + w * 192; float* sc = sm + 8 * 192 + w * 2304;
    for (int unit = blockIdx.x; unit < nq; unit += gridDim.x) {
        const int h = unit & 7, qt = (unit >> 3) * 8 + w; const bool lat = qt < NLAT;
        const int b = lat ? (qt >> 11) : ((qt - NLAT) >> 8);
        const int nk = lat ? (L + C) : C;
        for (int i = lane; i < 192; i += 64) qf[i] = bf2f(Q[(size_t)qt * QW + h * 192 + i]);
        __syncthreads();
        const float scale = 0.07216878364870322f;
        float mx = -3.0e38f;
        for (int kc = 0; kc < nk; kc += 64) {
            const int kk = kc + lane;
            const int kt = lat ? (kk < L ? b * L + kk : NLAT + b * C + (kk - L)) : (NLAT + b * C + kk);
            float s = 0.f;
            const u32x4* kp = (const u32x4*)(KV + (size_t)kt * KVW + h * 256);
            for (int i = 0; i < 16; ++i) { const u32x4 v = kp[i]; const float* q8 = qf + i * 8;
                s += q8[0] * __uint_as_float(v.x << 16) + q8[1] * __uint_as_float(v.x & 0xffff0000u) + q8[2] * __uint_as_float(v.y << 16) + q8[3] * __uint_as_float(v.y & 0xffff0000u)
                   + q8[4] * __uint_as_float(v.z << 16) + q8[5] * __uint_as_float(v.z & 0xffff0000u) + q8[6] * __uint_as_float(v.w << 16) + q8[7] * __uint_as_float(v.w & 0xffff0000u); }
            const u32x4* pp = (const u32x4*)(KPE + (size_t)kt * 64);
            for (int i = 0; i < 8; ++i) { const u32x4 v = pp[i]; const float* q8 = qf + 128 + i * 8;
                s += q8[0] * __uint_as_float(v.x << 16) + q8[1] * __uint_as_float(v.x & 0xffff0000u) + q8[2] * __uint_as_float(v.y << 16) + q8[3] * __uint_as_float(v.y & 0xffff0000u)
                   + q8[4] * __uint_as_float(v.z << 16) + q8[5] * __uint_as_float(v.z & 0xffff0000u) + q8[6] * __uint_as_float(v.w << 16) + q8[7] * __uint_as_float(v.w & 0xffff0000u); }
            s *= scale; sc[kk] = s; mx = fmaxf(mx, s);
        }
        mx = wave_max(mx);
        float sum = 0.f;
        for (int kc = 0; kc < nk; kc += 64) { const float p = expf(sc[kc + lane] - mx); sc[kc + lane] = p; sum += p; }
        sum = wave_sum(sum);
        __syncthreads();
        float o0 = 0.f, o1 = 0.f;
        for (int kk = 0; kk < nk; ++kk) {
            const int kt = lat ? (kk < L ? b * L + kk : NLAT + b * C + (kk - L)) : (NLAT + b * C + kk);
            const unsigned v = *(const unsigned*)(KV + (size_t)kt * KVW + h * 256 + 128 + lane * 2);
            const float p = sc[kk];
            o0 += p * __uint_as_float(v << 16); o1 += p * __uint_as_float(v & 0xffff0000u);
        }
        const float inv = 1.0f / sum;
        *(unsigned*)(mix + (size_t)qt * D + h * 128 + lane * 2) = (unsigned)f2bf(o0 * inv) | ((unsigned)f2bf(o1 * inv) << 16);
        __syncthreads();
    }
}
__device__ __forceinline__ void ph_swa_naive(const Args& a, int l, int nq, float* sm) {
    const bf16_t* __restrict__ SQ = (const bf16_t*)(a.ws + WS_SQ); const bf16_t* __restrict__ SK = (const bf16_t*)(a.ws + WS_SK); const bf16_t* __restrict__ SV = (const bf16_t*)(a.ws + WS_SV);
    const float* sink = a.in[24] + l * 8; bf16_t* mix = (bf16_t*)(a.ws + WS_MIX);
    const int lane = threadIdx.x & 63, w = threadIdx.x >> 6;
    float* qf = sm + w * 64; float* sc = sm + 8 * 64 + w * 576; int* kts = (int*)(sm + 8 * 64 + 8 * 576) + w * 576;
    for (int unit = blockIdx.x; unit < nq; unit += gridDim.x) {
        const int hq = unit & 7, hk = hq >> 2, qt = (unit >> 3) * 8 + w; const bool lat = qt < NLAT;
        const int b = lat ? (qt >> 11) : ((qt - NLAT) >> 8), t = lat ? (qt & 2047) : 0;
        int lo = 0, nloc = 0;
        if (lat) { lo = t - 128 < 0 ? 0 : t - 128; const int hi = t + 128 > L - 1 ? L - 1 : t + 128; nloc = hi - lo + 1; }
        const int nk = nloc + C;
        qf[lane] = bf2f(SQ[(size_t)qt * 512 + hq * 64 + lane]);
        __syncthreads();
        const float skv = sink[hq];
        float mx = skv;
        for (int kc = 0; kc < nk; kc += 64) {
            const int kk = kc + lane;
            if (kk < nk) {
                const int kt = kk < nloc ? (b * L + lo + kk) : (NLAT + b * C + (kk - nloc));
                const u32x4* kp = (const u32x4*)(SK + (size_t)kt * 128 + hk * 64);
                float s = 0.f;
                for (int i = 0; i < 8; ++i) { const u32x4 v = kp[i]; const float* q8 = qf + i * 8;
                    s += q8[0] * __uint_as_float(v.x << 16) + q8[1] * __uint_as_float(v.x & 0xffff0000u) + q8[2] * __uint_as_float(v.y << 16) + q8[3] * __uint_as_float(v.y & 0xffff0000u)
                       + q8[4] * __uint_as_float(v.z << 16) + q8[5] * __uint_as_float(v.z & 0xffff0000u) + q8[6] * __uint_as_float(v.w << 16) + q8[7] * __uint_as_float(v.w & 0xffff0000u); }
                s *= 0.125f; sc[kk] = s; kts[kk] = kt; mx = fmaxf(mx, s);
            }
        }
        mx = wave_max(mx);
        float sum = 0.f;
        for (int kc = 0; kc < nk; kc += 64) { const int kk = kc + lane; if (kk < nk) { const float p = expf(sc[kk] - mx); sc[kk] = p; sum += p; } }
        sum = wave_sum(sum) + expf(skv - mx);
        __syncthreads();
        float o = 0.f;
        for (int kk = 0; kk < nk; ++kk) o += sc[kk] * bf2f(SV[(size_t)kts[kk] * 128 + hk * 64 + lane]);
        mix[(size_t)qt * D + 1536 + hq * 64 + lane] = f2bf(o / sum);
        __syncthreads();
    }
}
template <int LS>
__device__ __forceinline__ void ph_hyena_naive(const Args& a, int l, float* sm) {
    const float* filt = LS == L ? (const float*)(a.ws + WS_FILTL) + (size_t)l * 512 * 4096 : (const float*)(a.ws + WS_FILTC) + (size_t)l * 512 * 512;
    const bf16_t* wt = (const bf16_t*)(a.ws + (LS == L ? WS_WTL : WS_WTC)); const bf16_t* x0 = (const bf16_t*)(a.ws + WS_X0); const float* skip = a.in[23] + l * 512;
    bf16_t* mix = (bf16_t*)(a.ws + WS_MIX); const int tok_base = LS == L ? 0 : NLAT;
    float* T = sm; float* ws = sm + 2 * LS; const int tid = threadIdx.x;
    for (int unit = blockIdx.x; unit < 512 * NB; unit += gridDim.x) {
        const int ch = unit >> 2, b = unit & 3;
        for (int i = tid; i < 2 * LS; i += NTHR) T[i] = filt[(size_t)ch * 2 * LS + i];
        for (int i = tid; i < LS; i += NTHR) ws[i] = bf2f(wt[((size_t)b * 512 + ch) * LS + i]);
        __syncthreads();
        const float sk = skip[ch];
        for (int t = tid; t < LS; t += NTHR) {
            float y = 0.f;
            for (int s = 0; s < LS; ++s) y += T[t - s + LS] * ws[s];
            ((bf16_t*)(a.ws + WS_YT))[(LS == L ? (size_t)0 : (size_t)NB * 512 * L) + ((size_t)b * 512 + ch) * LS + t] = f2bf(y);
        }
        __syncthreads();
    }
}
__device__ __forceinline__ void ph_route_gather(const Args& a, int* sm) {
    const int* __restrict__ topi = (const int*)(a.ws + WS_TOPI); int* __restrict__ pos = (int*)(a.ws + WS_POS); int* ctl = (int*)(a.ws + WS_CTL);
    const unsigned char* __restrict__ hb = (const unsigned char*)(a.ws + WS_HA); unsigned char* __restrict__ hbs = (unsigned char*)(a.ws + WS_HBS);
    int (*cnt)[512] = (int (*)[512])sm; int* tot = sm + 8 * 512; int* ppos = sm + 8 * 512 + 16;
    const int tid = threadIdx.x, lane = tid & 63, w = tid >> 6;
    int c[8];
#pragma unroll
    for (int e = 0; e < 8; ++e) c[e] = 0;
    for (int i = 0; i < 32; i += 4) { const u32x4 e4 = *(const u32x4*)(topi + tid * 32 + i);
#pragma unroll
        for (int q = 0; q < 8; ++q) c[q] += (e4.x == (unsigned)q) + (e4.y == (unsigned)q) + (e4.z == (unsigned)q) + (e4.w == (unsigned)q); }
#pragma unroll
    for (int e = 0; e < 8; ++e) cnt[e][tid] = c[e];
    __syncthreads();
    {
        int v[8]; int s8 = 0;
#pragma unroll
        for (int k = 0; k < 8; ++k) { v[k] = cnt[w][lane * 8 + k]; s8 += v[k]; }
        int incl = s8;
#pragma unroll
        for (int off = 1; off < 64; off <<= 1) { const int t = __shfl_up(incl, off); if (lane >= off) incl += t; }
        int run = incl - s8;
#pragma unroll
        for (int k = 0; k < 8; ++k) { cnt[w][lane * 8 + k] = run; run += v[k]; }
        if (lane == 63) tot[w] = incl;
    }
    __syncthreads();
    int eoff[8]; int o = 0;
#pragma unroll
    for (int e = 0; e < 8; ++e) { eoff[e] = o; o += (tot[e] + 255) & ~255; }
    if (blockIdx.x == 0 && tid == 0) {
#pragma unroll
        for (int e = 0; e < 8; ++e) { ctl[CT_EOFF + e] = eoff[e]; ctl[CT_EPAD + e] = (tot[e] + 255) & ~255; }
        ctl[CT_NTILE] = o >> 8; const int nwg = (o >> 8) * (D / 256); ctl[CT_MOES] = pg8::split_S(nwg, DFE / 128, 256); ctl[CT_TROW] = (nwg / 256) * 256 / (D / 256) * 256;
    }
    for (int tg = blockIdx.x; tg < NLAT / 32; tg += gridDim.x) {
        if (tid < 64) {
            const int idx = 64 * tg + tid, owner = idx >> 5, e = topi[idx]; int p = 0;
#pragma unroll
            for (int q = 0; q < 8; ++q) { const unsigned long long mk = __ballot(e == q);
                if (e == q) { const unsigned hm = (unsigned)(mk >> (32 * (tid >> 5))); p = eoff[q] + cnt[q][owner] + __popc(hm & ((1u << (tid & 31)) - 1u)); } }
            pos[idx] = p; ppos[tid] = p;
        }
        __syncthreads();
#pragma unroll
        for (int k = 0; k < 4; ++k) { const int tl = 4 * w + k; const int tok = 32 * tg + tl;
            const u32x4 v0 = *(const u32x4*)(hb + (size_t)tok * D + lane * 32), v1 = *(const u32x4*)(hb + (size_t)tok * D + lane * 32 + 16);
            const int p0 = ppos[2 * tl], p1 = ppos[2 * tl + 1];
            *(u32x4*)(hbs + (size_t)p0 * D + lane * 32) = v0; *(u32x4*)(hbs + (size_t)p0 * D + lane * 32 + 16) = v1;
            *(u32x4*)(hbs + (size_t)p1 * D + lane * 32) = v0; *(u32x4*)(hbs + (size_t)p1 * D + lane * 32 + 16) = v1; }
        __syncthreads();
    }
}
__device__ __forceinline__ void ph_final(const Args& a) {
    const float* xs = (const float*)(a.ws + WS_XS); const bf16_t* ys = (const bf16_t*)(a.ws + WS_YS); const int* pos = (const int*)(a.ws + WS_POS); const float* topw = (const float*)(a.ws + WS_TOPW);
    const float* modl = (const float*)(a.ws + WS_MOD) + (size_t)5 * 12288; const float* gfin = a.in[33]; float* out = a.out;
    const int lane = threadIdx.x & 63, wid = threadIdx.x >> 6;
    const int* ctl = (const int*)(a.ws + WS_CTL); const int nsl = ctl[CT_MOES], trow0 = ctl[CT_TROW], trows = ctl[CT_NTILE] * 256 - trow0; const float* slab = (const float*)(a.ws + WS_SLAB);
    for (int row = blockIdx.x * 8 + wid; row < NLAT; row += gridDim.x * 8) {
        const float* g2 = modl + (size_t)tok_mod(row) * 12288 + 10240;
        const int p0 = pos[row * 2], p1 = pos[row * 2 + 1]; const float w0 = topw[row * 2], w1 = topw[row * 2 + 1];
        const bool t0 = nsl > 1 && p0 >= trow0, t1 = nsl > 1 && p1 >= trow0;
        f32x4 v[8]; float ss = 0.f;
#pragma unroll
        for (int i = 0; i < 8; ++i) { const int col = i * 256 + lane * 4;
            const f32x4 x = *(const f32x4*)(xs + (size_t)row * D + col), g = *(const f32x4*)(g2 + col); f32x4 ya, yb;
            if (t0) { ya = *(const f32x4*)(slab + (size_t)(p0 - trow0) * D + col); for (int sl = 1; sl < nsl; ++sl) ya += *(const f32x4*)(slab + ((size_t)sl * trows + (p0 - trow0)) * D + col); }
            else { const u32x2 q = *(const u32x2*)(ys + (size_t)p0 * D + col); ya = (f32x4){__uint_as_float(q.x << 16), __uint_as_float(q.x & 0xffff0000u), __uint_as_float(q.y << 16), __uint_as_float(q.y & 0xffff0000u)}; }
            if (t1) { yb = *(const f32x4*)(slab + (size_t)(p1 - trow0) * D + col); for (int sl = 1; sl < nsl; ++sl) yb += *(const f32x4*)(slab + ((size_t)sl * trows + (p1 - trow0)) * D + col); }
            else { const u32x2 q = *(const u32x2*)(ys + (size_t)p1 * D + col); yb = (f32x4){__uint_as_float(q.x << 16), __uint_as_float(q.x & 0xffff0000u), __uint_as_float(q.y << 16), __uint_as_float(q.y & 0xffff0000u)}; }
#pragma unroll
            for (int j = 0; j < 4; ++j) { v[i][j] = x[j] + g[j] * (w0 * ya[j] + w1 * yb[j]); ss += v[i][j] * v[i][j]; } }
        ss = wave_sum(ss); const float rstd = rsqrtf(ss * (1.0f / D) + EPS);
#pragma unroll
        for (int i = 0; i < 8; ++i) { const int col = i * 256 + lane * 4; const f32x4 g = *(const f32x4*)(gfin + col); f32x4 o;
#pragma unroll
            for (int j = 0; j < 4; ++j) o[j] = v[i][j] * rstd * g[j];
            *(f32x4*)(out + (size_t)row * D + col) = o; }
    }
}

typedef float f32x2_t __attribute__((ext_vector_type(2))); typedef __bf16 bf16x2_t __attribute__((ext_vector_type(2)));
__device__ __forceinline__ unsigned cvtpk(float lo, float hi) { f32x2_t v = {lo, hi}; bf16x2_t b = __builtin_convertvector(v, bf16x2_t); return __builtin_bit_cast(unsigned, b); }
#define MFMA32(a, b, c) __builtin_amdgcn_mfma_f32_32x32x16_bf16((a), (b), (c), 0, 0, 0)
constexpr int MLA_KP = 400, MLA_VP = 144, MLA_KB = 64 * MLA_KP, MLA_VB = 128 * MLA_VP, MLA_STAGE = MLA_KB + MLA_VB;
static_assert(2 * MLA_STAGE <= RING_BYTES, "MLA LDS");

__device__ __forceinline__ void ph_mla(const Args& a, bool with_ctx, unsigned char* lds) {
    const bf16_t* __restrict__ Q = (const bf16_t*)(a.ws + WS_Q); const bf16_t* __restrict__ KN = (const bf16_t*)(a.ws + WS_KN); const bf16_t* __restrict__ KPE = (const bf16_t*)(a.ws + WS_KPE);
    const bf16_t* __restrict__ VT = (const bf16_t*)(a.ws + WS_VT); bf16_t* __restrict__ mix = (bf16_t*)(a.ws + WS_MIX);
    int tid_ = threadIdx.x; asm volatile("" : "+v"(tid_));
    const int tid = tid_, lane = tid & 63, w = tid >> 6, qi = lane & 31, hh = lane >> 5;
    const int nunits = with_ctx ? 288 : 256;
    const float c = 0.07216878364870322f * 1.4426950408889634f;
    for (int unit = blockIdx.x; unit < nunits; unit += gridDim.x) {
        int h, b, q0tok, nt; bool ctxq;
        if (unit < 256) { h = unit & 7; b = unit >> 6; q0tok = b * L + ((unit >> 3) & 7) * 256; nt = 36; ctxq = false; }
        else { const int u2 = unit - 256; h = u2 & 7; b = u2 >> 3; q0tok = NLAT + b * C; nt = 4; ctxq = true; }
#define MLA_KTOK(t) (ctxq ? (NLAT + b * C + (t) * 64) : ((t) < 32 ? (b * L + (t) * 64) : (NLAT + b * C + ((t) - 32) * 64)))
        u32x4 r0, r1, r2, r3, r4;
#define MLA_ISSUE_K(t) do { const int kt0_ = MLA_KTOK(t); \
            r0 = *(const u32x4*)(KN + (size_t)(kt0_ + (tid >> 4)) * 1024 + h * 128 + (tid & 15) * 8); \
            r1 = *(const u32x4*)(KN + (size_t)(kt0_ + 32 + (tid >> 4)) * 1024 + h * 128 + (tid & 15) * 8); \
            r2 = *(const u32x4*)(KPE + (size_t)(kt0_ + (tid >> 3)) * 64 + (tid & 7) * 8); } while (0)
#define MLA_ISSUE_V(t) do { const int kt0_ = MLA_KTOK(t); \
            r3 = *(const u32x4*)(VT + (size_t)(h * 128 + (tid >> 3)) * NTOK + kt0_ + (tid & 7) * 8); \
            r4 = *(const u32x4*)(VT + (size_t)(h * 128 + 64 + (tid >> 3)) * NTOK + kt0_ + (tid & 7) * 8); } while (0)
#define MLA_ISSUE(t) do { MLA_ISSUE_K(t); MLA_ISSUE_V(t); } while (0)
#define MLA_COMMIT(buf) do { unsigned char* kb_ = lds + (buf) * MLA_STAGE; unsigned char* vb_ = kb_ + MLA_KB; \
            *(u32x4*)(kb_ + (tid >> 4) * MLA_KP + (tid & 15) * 16) = r0; \
            *(u32x4*)(kb_ + (32 + (tid >> 4)) * MLA_KP + (tid & 15) * 16) = r1; \
            *(u32x4*)(kb_ + (tid >> 3) * MLA_KP + 256 + (tid & 7) * 16) = r2; \
            const int g_ = (tid & 7) >> 1, e_ = tid & 1; \
            { u32x2 lo_, hi_; lo_.x = r3.x; lo_.y = r3.y; hi_.x = r3.z; hi_.y = r3.w; \
              *(u32x2*)(vb_ + (tid >> 3) * MLA_VP + g_ * 32 + e_ * 8) = lo_; *(u32x2*)(vb_ + (tid >> 3) * MLA_VP + g_ * 32 + 16 + e_ * 8) = hi_; } \
            { u32x2 lo_, hi_; lo_.x = r4.x; lo_.y = r4.y; hi_.x = r4.z; hi_.y = r4.w; \
              *(u32x2*)(vb_ + (64 + (tid >> 3)) * MLA_VP + g_ * 32 + e_ * 8) = lo_; *(u32x2*)(vb_ + (64 + (tid >> 3)) * MLA_VP + g_ * 32 + 16 + e_ * 8) = hi_; } } while (0)
        const int qtok = q0tok + w * 32 + qi;
        bf16x8 qf[12];
#pragma unroll
        for (int s = 0; s < 12; ++s) qf[s] = *(const bf16x8*)(Q + (size_t)qtok * QW + h * 192 + s * 16 + hh * 8);
        f32x16 o[4];
#pragma unroll
        for (int d = 0; d < 4; ++d)
#pragma unroll
            for (int r = 0; r < 16; ++r) o[d][r] = 0.f;
        float m = -1.0e30f, l = 0.f;
        MLA_ISSUE(0); MLA_COMMIT(0);
        __syncthreads();
        for (int t = 0; t < nt; ++t) {
            const unsigned char* kb = lds + (t & 1) * MLA_STAGE; const unsigned char* vb = kb + MLA_KB;
            f32x16 s0, s1;
#pragma unroll
            for (int r = 0; r < 16; ++r) { s0[r] = 0.f; s1[r] = 0.f; }
            {
                const unsigned char* kp0 = kb + qi * MLA_KP + hh * 16; const unsigned char* kp1 = kp0 + 32 * MLA_KP;
                bf16x8 ka[4], kn[4];
                ka[0] = *(const bf16x8*)(kp0); ka[1] = *(const bf16x8*)(kp1); ka[2] = *(const bf16x8*)(kp0 + 32); ka[3] = *(const bf16x8*)(kp1 + 32);
#pragma unroll
                for (int g = 0; g < 6; ++g) {
                    if (g < 5) { kn[0] = *(const bf16x8*)(kp0 + (2 * g + 2) * 32); kn[1] = *(const bf16x8*)(kp1 + (2 * g + 2) * 32); kn[2] = *(const bf16x8*)(kp0 + (2 * g + 3) * 32); kn[3] = *(const bf16x8*)(kp1 + (2 * g + 3) * 32); }
                    __builtin_amdgcn_sched_barrier(0);
                    s0 = MFMA32(ka[0], qf[2 * g], s0); s1 = MFMA32(ka[1], qf[2 * g], s1); s0 = MFMA32(ka[2], qf[2 * g + 1], s0); s1 = MFMA32(ka[3], qf[2 * g + 1], s1);
                    __builtin_amdgcn_sched_barrier(0);
#pragma unroll
                    for (int q = 0; q < 4; ++q) ka[q] = kn[q];
                }
            }
            if (t + 1 < nt) MLA_ISSUE(t + 1);
            float mx = fmaxf(s0[0], s1[0]);
#pragma unroll
            for (int r = 1; r < 16; ++r) mx = fmaxf(mx, fmaxf(s0[r], s1[r]));
            mx = fmaxf(mx, __shfl_xor(mx, 32));
            const float mnew = fmaxf(m, mx * c);
            const float alpha = __builtin_amdgcn_exp2f(m - mnew);
            m = mnew;
            float ps = 0.f;
#pragma unroll
            for (int r = 0; r < 16; ++r) { s0[r] = __builtin_amdgcn_exp2f(s0[r] * c - mnew); s1[r] = __builtin_amdgcn_exp2f(s1[r] * c - mnew); ps += s0[r] + s1[r]; }
            l = l * alpha + ps;
            if ((PROBE_SUB >> 9) & 1u) {
                float ps2 = 0.f;
#pragma unroll
                for (int r = 0; r < 16; ++r) { float x0 = s0[r], x1 = s1[r]; asm volatile("" : "+v"(x0), "+v"(x1)); ps2 += __builtin_amdgcn_exp2f(x0 * c - 40.f) + __builtin_amdgcn_exp2f(x1 * c - 40.f); }
                float mx2 = ps2;
#pragma unroll
                for (int r = 0; r < 16; ++r) { float x0 = s0[r], x1 = s1[r]; asm volatile("" : "+v"(x0), "+v"(x1)); mx2 = fmaxf(mx2, fmaxf(x0 * c, x1 * c)); }
                if (mx2 == 123456.75f) l += ps2;
            }
            if ((PROBE_SUB >> 10) & 1u) {
                f32x16 sx;
#pragma unroll
                for (int r = 0; r < 16; ++r) sx[r] = 0.f;
#pragma unroll
                for (int s = 0; s < 12; ++s) { bf16x8 k0 = *(const bf16x8*)(kb + qi * MLA_KP + s * 32 + hh * 16); sx = MFMA32(k0, qf[s], sx); }
                if (sx[0] == 123456.75f) l += sx[1];
            }
#pragma unroll
            for (int d = 0; d < 4; ++d)
#pragma unroll
                for (int r = 0; r < 16; ++r) o[d][r] *= alpha;
            bf16x8 pf[4];
            { u32x4 p;
              p.x = cvtpk(s0[0], s0[1]); p.y = cvtpk(s0[2], s0[3]); p.z = cvtpk(s0[4], s0[5]); p.w = cvtpk(s0[6], s0[7]); pf[0] = __builtin_bit_cast(bf16x8, p);
              p.x = cvtpk(s0[8], s0[9]); p.y = cvtpk(s0[10], s0[11]); p.z = cvtpk(s0[12], s0[13]); p.w = cvtpk(s0[14], s0[15]); pf[1] = __builtin_bit_cast(bf16x8, p);
              p.x = cvtpk(s1[0], s1[1]); p.y = cvtpk(s1[2], s1[3]); p.z = cvtpk(s1[4], s1[5]); p.w = cvtpk(s1[6], s1[7]); pf[2] = __builtin_bit_cast(bf16x8, p);
              p.x = cvtpk(s1[8], s1[9]); p.y = cvtpk(s1[10], s1[11]); p.z = cvtpk(s1[12], s1[13]); p.w = cvtpk(s1[14], s1[15]); pf[3] = __builtin_bit_cast(bf16x8, p); }
            asm volatile("" ::: "memory");
            {
                const unsigned char* vp = vb + qi * MLA_VP + hh * 16;
                bf16x8 va[4], vn[4];
#pragma unroll
                for (int g = 0; g < 4; ++g) va[g] = *(const bf16x8*)(vp + g * 32);
#pragma unroll
                for (int d = 0; d < 4; ++d) {
                    if (d < 3) {
#pragma unroll
                        for (int g = 0; g < 4; ++g) vn[g] = *(const bf16x8*)(vp + (d + 1) * 32 * MLA_VP + g * 32); }
                    __builtin_amdgcn_sched_barrier(0);
#pragma unroll
                    for (int g = 0; g < 4; ++g) o[d] = MFMA32(va[g], pf[g], o[d]);
                    __builtin_amdgcn_sched_barrier(0);
#pragma unroll
                    for (int g = 0; g < 4; ++g) va[g] = vn[g];
                }
            }
            if (t + 1 < nt) MLA_COMMIT((t + 1) & 1);
            __syncthreads();
        }
        const float inv = 1.0f / (l + __shfl_xor(l, 32));
        bf16_t* op = mix + (size_t)qtok * D + h * 128 + 4 * hh;
#pragma unroll
        for (int d = 0; d < 4; ++d)
#pragma unroll
            for (int g = 0; g < 4; ++g) { u32x2 wv; wv.x = cvtpk(o[d][4 * g] * inv, o[d][4 * g + 1] * inv); wv.y = cvtpk(o[d][4 * g + 2] * inv, o[d][4 * g + 3] * inv);
                *(u32x2*)(op + d * 32 + 8 * g) = wv; }
#undef MLA_KTOK
#undef MLA_ISSUE
#undef MLA_ISSUE_K
#undef MLA_ISSUE_V
#undef MLA_COMMIT
    }
}

constexpr int HY_CS = 8224, HY_WS = 5136, HY_WOFF = 8 * HY_CS, HY_RBL = HY_WOFF + 4 * HY_WS;
static_assert(HY_RBL + 516 * 16 <= RING_BYTES, "hyena LDS");

__device__ __forceinline__ u32x4 hy_shift(const u32x4 a, const u32x4 b, int r) {
    switch (r) {
    case 0: return b;
    case 1: return (u32x4){__builtin_amdgcn_alignbyte(b.x, a.w, 2), __builtin_amdgcn_alignbyte(b.y, b.x, 2), __builtin_amdgcn_alignbyte(b.z, b.y, 2), __builtin_amdgcn_alignbyte(b.w, b.z, 2)};
    case 2: return (u32x4){a.w, b.x, b.y, b.z};
    case 3: return (u32x4){__builtin_amdgcn_alignbyte(a.w, a.z, 2), __builtin_amdgcn_alignbyte(b.x, a.w, 2), __builtin_amdgcn_alignbyte(b.y, b.x, 2), __builtin_amdgcn_alignbyte(b.z, b.y, 2)};
    case 4: return (u32x4){a.z, a.w, b.x, b.y};
    case 5: return (u32x4){__builtin_amdgcn_alignbyte(a.z, a.y, 2), __builtin_amdgcn_alignbyte(a.w, a.z, 2), __builtin_amdgcn_alignbyte(b.x, a.w, 2), __builtin_amdgcn_alignbyte(b.y, b.x, 2)};
    case 6: return (u32x4){a.y, a.z, a.w, b.x};
    default: return (u32x4){__builtin_amdgcn_alignbyte(a.y, a.x, 2), __builtin_amdgcn_alignbyte(a.z, a.y, 2), __builtin_amdgcn_alignbyte(a.w, a.z, 2), __builtin_amdgcn_alignbyte(b.x, a.w, 2)};
    }
}

__device__ __forceinline__ void ph_hyena(const Args& a, int l, unsigned char* lds) {
    const bf16_t* __restrict__ RB = (const bf16_t*)(a.ws + WS_FILTL) + (size_t)l * 512 * HY_RBROW;
    const bf16_t* __restrict__ wtl = (const bf16_t*)(a.ws + WS_WTL);
    int tid_ = threadIdx.x; asm volatile("" : "+v"(tid_));
    const int tid = tid_, lane = tid & 63, w = __builtin_amdgcn_readfirstlane(tid >> 6), i = lane & 31, hh = lane >> 5;
    for (int unit = blockIdx.x; unit < 512; unit += gridDim.x) {
        const int c = unit;
        for (int k = tid; k < 515; k += NTHR) { u32x4 v = (u32x4){0u, 0u, 0u, 0u}; if (k < 513) v = *(const u32x4*)(RB + (size_t)c * HY_RBROW + k * 8); *(u32x4*)(lds + HY_RBL + k * 16) = v; }
        for (int k = tid; k < 4 * 321; k += NTHR) { const int b = k / 321, sl = k - b * 321; u32x4 v = (u32x4){0u, 0u, 0u, 0u};
            if (sl >= 28 && sl < 284) v = *(const u32x4*)(wtl + ((size_t)b * 512 + c) * L + (sl - 28) * 8);
            *(u32x4*)(lds + HY_WOFF + b * HY_WS + sl * 16) = v; }
        __syncthreads();
        for (int qs = lane; qs < 511; qs += 64) {
            const u32x4 ca = *(const u32x4*)(lds + HY_RBL + qs * 16), cb = *(const u32x4*)(lds + HY_RBL + qs * 16 + 16);
            *(u32x4*)(lds + w * HY_CS + qs * 16) = hy_shift(ca, cb, w);
        }
        __syncthreads();
        f32x16 acc0, acc1;
#pragma unroll
        for (int r = 0; r < 16; ++r) { acc0[r] = 0.f; acc1[r] = 0.f; }
        const int Tl = i >> 2, b = i & 3;
        const unsigned char* ap = lds + (i & 7) * HY_CS + (hh - (i >> 3) + 255) * 16;
        const unsigned char* bp = lds + HY_WOFF + b * HY_WS + (224 + 16 * (2 * (8 * w + Tl)) + 8 * hh) * 2;
        const int d0 = 16 * w - 127;
#pragma unroll 2
        for (int dd = 0; dd < 142; dd += 2) {
            const int d = d0 + dd;
            const bf16x8 a0 = *(const bf16x8*)(ap - 32 * d), b0 = *(const bf16x8*)(bp - 32 * d);
            const bf16x8 a1 = *(const bf16x8*)(ap - 32 * (d + 1)), b1 = *(const bf16x8*)(bp - 32 * (d + 1));
            acc0 = MFMA32(a0, b0, acc0); acc1 = MFMA32(a1, b1, acc1);
        }
        bf16_t* yt = (bf16_t*)(a.ws + WS_YT) + ((size_t)b * 512 + c) * L + 32 * (8 * w + Tl) + 4 * hh;
#pragma unroll
        for (int g = 0; g < 4; ++g) { u32x2 wv; wv.x = cvtpk(acc0[4 * g] + acc1[4 * g], acc0[4 * g + 1] + acc1[4 * g + 1]); wv.y = cvtpk(acc0[4 * g + 2] + acc1[4 * g + 2], acc0[4 * g + 3] + acc1[4 * g + 3]);
            *(u32x2*)(yt + 8 * g) = wv; }
        __syncthreads();
    }
}

__device__ __forceinline__ void ph_hyena_fin(const Args& a, int l, bool with_ctx, unsigned char* lds) {
    const bf16_t* __restrict__ YT = (const bf16_t*)(a.ws + WS_YT); const bf16_t* __restrict__ wtl = (const bf16_t*)(a.ws + WS_WTL); const bf16_t* __restrict__ wtc = (const bf16_t*)(a.ws + WS_WTC);
    const bf16_t* __restrict__ x0 = (const bf16_t*)(a.ws + WS_X0); const float* skip = a.in[23] + l * 512; bf16_t* __restrict__ mix = (bf16_t*)(a.ws + WS_MIX);
    int tid_ = threadIdx.x; asm volatile("" : "+v"(tid_));
    const int tid = tid_;
    bf16_t* T = (bf16_t*)lds;
    constexpr int TP = 520;
    const int nunits = with_ctx ? 144 : 128;
    for (int unit = (int)gridDim.x - 1 - (int)blockIdx.x; unit < nunits; unit += gridDim.x) {
        const bool lat = unit < 128; const int b = lat ? (unit >> 5) : ((unit - 128) >> 2), t0 = lat ? (unit & 31) * 64 : ((unit - 128) & 3) * 64;
        const int Ls = lat ? L : C; const int tok0 = lat ? b * L + t0 : NLAT + b * C + t0;
        const bf16_t* yrow = (lat ? YT : YT + (size_t)NB * 512 * L) + ((size_t)b * 512 + tid) * Ls + t0;
        const bf16_t* wrow = (lat ? wtl : wtc) + ((size_t)b * 512 + tid) * Ls + t0;
        const float sk = skip[tid];
#pragma unroll
        for (int hf = 0; hf < 2; ++hf) {
            u32x4 yv[4], wv[4];
#pragma unroll
            for (int q = 0; q < 4; ++q) { yv[q] = *(const u32x4*)(yrow + hf * 32 + q * 8); wv[q] = *(const u32x4*)(wrow + hf * 32 + q * 8); }
#pragma unroll
            for (int q = 0; q < 4; ++q) { const unsigned yy[4] = {yv[q].x, yv[q].y, yv[q].z, yv[q].w}, ww[4] = {wv[q].x, wv[q].y, wv[q].z, wv[q].w};
#pragma unroll
                for (int d = 0; d < 4; ++d) { const int t = hf * 32 + q * 8 + 2 * d;
                    T[t * TP + tid] = f2bf(__uint_as_float(yy[d] << 16) + sk * __uint_as_float(ww[d] << 16));
                    T[(t + 1) * TP + tid] = f2bf(__uint_as_float(yy[d] & 0xffff0000u) + sk * __uint_as_float(ww[d] & 0xffff0000u)); } }
        }
        __syncthreads();
#pragma unroll
        for (int j = 0; j < 8; ++j) { const int o = tid + 512 * j, t = o >> 6, cc = (o & 63) * 8;
            const u32x4 tv = *(const u32x4*)(T + t * TP + cc), xv = *(const u32x4*)(x0 + (size_t)(tok0 + t) * 512 + cc);
            const unsigned tt[4] = {tv.x, tv.y, tv.z, tv.w}, xx[4] = {xv.x, xv.y, xv.z, xv.w}; unsigned oo[4];
#pragma unroll
            for (int d = 0; d < 4; ++d) oo[d] = cvtpk(__uint_as_float(tt[d] << 16) * __uint_as_float(xx[d] << 16), __uint_as_float(tt[d] & 0xffff0000u) * __uint_as_float(xx[d] & 0xffff0000u));
            *(u32x4*)(mix + (size_t)(tok0 + t) * D + 1024 + cc) = (u32x4){oo[0], oo[1], oo[2], oo[3]}; }
        __syncthreads();
    }
}

constexpr int SWA_P = 144, SWA_KB = 64 * SWA_P, SWA_STAGE = 2 * SWA_KB;
__device__ __forceinline__ void ph_swa(const Args& a, int l, bool with_ctx, unsigned char* lds) {
    const bf16_t* __restrict__ SQ = (const bf16_t*)(a.ws + WS_SQ); const bf16_t* __restrict__ SK = (const bf16_t*)(a.ws + WS_SK); const bf16_t* __restrict__ SVT = (const bf16_t*)(a.ws + WS_SV);
    const float* sink = a.in[24] + l * 8; bf16_t* __restrict__ mix = (bf16_t*)(a.ws + WS_MIX);
    int tid_ = threadIdx.x; asm volatile("" : "+v"(tid_));
    const int tid = tid_, lane = tid & 63, w = tid >> 6, qi = lane & 31, hh = lane >> 5;
    const int nunits = with_ctx ? 288 : 256;
    const float c = 0.125f * 1.4426950408889634f;
    for (int unit = blockIdx.x; unit < nunits; unit += gridDim.x) {
        int hk, b, p0, nloc, t0loc, q0tok; bool ctxq;
        if (unit < 256) { hk = unit & 1; b = (unit >> 1) & 3; p0 = (unit >> 3) * 64; ctxq = false; q0tok = b * L + p0;
            const int lo = p0 - 128 < 0 ? 0 : p0 - 128, hi = p0 + 192 > L ? L : p0 + 192; t0loc = lo; nloc = (hi - lo) >> 6; }
        else { const int u2 = unit - 256; hk = u2 & 1; b = (u2 >> 1) & 3; p0 = (u2 >> 3) * 64; ctxq = true; q0tok = NLAT + b * C + p0; t0loc = 0; nloc = 0; }
        const int nt = nloc + 4;
#define SWA_KTOK(t) ((t) < nloc ? (b * L + t0loc + (t) * 64) : (NLAT + b * C + ((t) - nloc) * 64))
        u32x4 r0, r1;
#define SWA_ISSUE(t) do { const int kt0_ = SWA_KTOK(t); \
            r0 = *(const u32x4*)(SK + (size_t)(kt0_ + (tid >> 3)) * 128 + hk * 64 + (tid & 7) * 8); \
            r1 = *(const u32x4*)(SVT + (size_t)(hk * 64 + (tid >> 3)) * NTOK + kt0_ + (tid & 7) * 8); } while (0)
#define SWA_COMMIT(buf) do { unsigned char* kb_ = lds + (buf) * SWA_STAGE; unsigned char* vb_ = kb_ + SWA_KB; \
            *(u32x4*)(kb_ + (tid >> 3) * SWA_P + (tid & 7) * 16) = r0; \
            const int g_ = (tid & 7) >> 1, e_ = tid & 1; u32x2 lo_, hi_; lo_.x = r1.x; lo_.y = r1.y; hi_.x = r1.z; hi_.y = r1.w; \
            *(u32x2*)(vb_ + (tid >> 3) * SWA_P + g_ * 32 + e_ * 8) = lo_; *(u32x2*)(vb_ + (tid >> 3) * SWA_P + g_ * 32 + 16 + e_ * 8) = hi_; } while (0)
        const int hq = hk * 4 + (w >> 1), qpos = p0 + (w & 1) * 32 + qi, qtok = q0tok + (w & 1) * 32 + qi;
        bf16x8 qf[4];
#pragma unroll
        for (int s = 0; s < 4; ++s) qf[s] = *(const bf16x8*)(SQ + (size_t)qtok * 512 + hq * 64 + s * 16 + hh * 8);
        f32x16 o[2];
#pragma unroll
        for (int d = 0; d < 2; ++d)
#pragma unroll
            for (int r = 0; r < 16; ++r) o[d][r] = 0.f;
        float m = sink[hq] * 1.4426950408889634f, lsum = hh == 0 ? 1.0f : 0.0f;
        SWA_ISSUE(0); SWA_COMMIT(0);
        __syncthreads();
        for (int t = 0; t < nt; ++t) {
            const unsigned char* kb = lds + (t & 1) * SWA_STAGE; const unsigned char* vb = kb + SWA_KB;
            f32x16 s0, s1;
#pragma unroll
            for (int r = 0; r < 16; ++r) { s0[r] = 0.f; s1[r] = 0.f; }
#pragma unroll
            for (int s = 0; s < 4; ++s) {
                const bf16x8 k0 = *(const bf16x8*)(kb + qi * SWA_P + s * 32 + hh * 16);
                const bf16x8 k1 = *(const bf16x8*)(kb + (32 + qi) * SWA_P + s * 32 + hh * 16);
                s0 = MFMA32(k0, qf[s], s0); s1 = MFMA32(k1, qf[s], s1);
            }
            if (t + 1 < nt) SWA_ISSUE(t + 1);
            if (t < nloc) {
                const int kbase = t0loc + t * 64 + 4 * hh - qpos;
#pragma unroll
                for (int r = 0; r < 16; ++r) { const int dlt = kbase + (r & 3) + 8 * (r >> 2);
                    if (dlt > 128 || dlt < -128) s0[r] = -1.0e30f;
                    if (dlt + 32 > 128 || dlt + 32 < -128) s1[r] = -1.0e30f; }
            }
            float mx = fmaxf(s0[0], s1[0]);
#pragma unroll
            for (int r = 1; r < 16; ++r) mx = fmaxf(mx, fmaxf(s0[r], s1[r]));
            mx = fmaxf(mx, __shfl_xor(mx, 32));
            const float mnew = fmaxf(m, mx * c);
            const float alpha = __builtin_amdgcn_exp2f(m - mnew);
            m = mnew;
            float ps = 0.f;
#pragma unroll
            for (int r = 0; r < 16; ++r) { s0[r] = __builtin_amdgcn_exp2f(s0[r] * c - mnew); s1[r] = __builtin_amdgcn_exp2f(s1[r] * c - mnew); ps += s0[r] + s1[r]; }
            lsum = lsum * alpha + ps;
#pragma unroll
            for (int d = 0; d < 2; ++d)
#pragma unroll
                for (int r = 0; r < 16; ++r) o[d][r] *= alpha;
            bf16x8 pf[4];
            { u32x4 p;
              p.x = cvtpk(s0[0], s0[1]); p.y = cvtpk(s0[2], s0[3]); p.z = cvtpk(s0[4], s0[5]); p.w = cvtpk(s0[6], s0[7]); pf[0] = __builtin_bit_cast(bf16x8, p);
              p.x = cvtpk(s0[8], s0[9]); p.y = cvtpk(s0[10], s0[11]); p.z = cvtpk(s0[12], s0[13]); p.w = cvtpk(s0[14], s0[15]); pf[1] = __builtin_bit_cast(bf16x8, p);
              p.x = cvtpk(s1[0], s1[1]); p.y = cvtpk(s1[2], s1[3]); p.z = cvtpk(s1[4], s1[5]); p.w = cvtpk(s1[6], s1[7]); pf[2] = __builtin_bit_cast(bf16x8, p);
              p.x = cvtpk(s1[8], s1[9]); p.y = cvtpk(s1[10], s1[11]); p.z = cvtpk(s1[12], s1[13]); p.w = cvtpk(s1[14], s1[15]); pf[3] = __builtin_bit_cast(bf16x8, p); }
#pragma unroll
            for (int d = 0; d < 2; ++d)
#pragma unroll
                for (int g = 0; g < 4; ++g) {
                    const bf16x8 vf = *(const bf16x8*)(vb + (d * 32 + qi) * SWA_P + g * 32 + hh * 16);
                    o[d] = MFMA32(vf, pf[g], o[d]);
                }
            if (t + 1 < nt) SWA_COMMIT((t + 1) & 1);
            __syncthreads();
        }
        const float inv = 1.0f / (lsum + __shfl_xor(lsum, 32));
        bf16_t* op = mix + (size_t)qtok * D + 1536 + hq * 64 + 4 * hh;
#pragma unroll
        for (int d = 0; d < 2; ++d)
#pragma unroll
            for (int g = 0; g < 4; ++g) { u32x2 wv; wv.x = cvtpk(o[d][4 * g] * inv, o[d][4 * g + 1] * inv); wv.y = cvtpk(o[d][4 * g + 2] * inv, o[d][4 * g + 3] * inv);
                *(u32x2*)(op + d * 32 + 8 * g) = wv; }
#undef SWA_KTOK
#undef SWA_ISSUE
#undef SWA_COMMIT
    }
}


constexpr int NPHASES = 22;
#define GEMM_CALL(EPI, SCHED, g, S, E) pg8::gemm_phase<EPI, SCHED, true, true, 0>((PG8_LAS unsigned char*)lds, g, S, E)
#define GEMM_CALL8(EPI, SCHED, g, S, E) pg8::gemm_phase<EPI, SCHED, true, true, 1>((PG8_LAS unsigned char*)lds, g, S, E)
#define GEMM_CALLI8(EPI, SCHED, g, S, E) pg8::gemm_phase<EPI, SCHED, true, true, 2>((PG8_LAS unsigned char*)lds, g, S, E)

template <int LYR>
__device__ __forceinline__ void layer_phases(const Args& a, unsigned char* lds, const XcdBarrier& bar, int lo, int hi) {
#define IN(k) (lo <= (k) && (k) < hi)
#define REPS(k) for (int rep_ = 0; rep_ <= (int)((PROBE_MASK >> (k)) & 1u); ++rep_)
#if MK_PER_PHASE
#define SEAM(k) do { } while (0)
#else
#define SEAM(k) do { if (IN(k) && IN((k) + 1)) xcd_barrier(bar); } while (0)
#endif
    constexpr int P0 = 1 + LYR * 9;
    constexpr bool LAST = (LYR == 1);
    constexpr int S_WO = pg8::split_S((LAST ? NLAT : NTOK) / 256 * (D / 256), D / 64, 256);
    constexpr int S_WO0 = pg8::split_S(NTOK / 256 * (D / 256), D / 64, 256);
    constexpr int S_DN0 = pg8::split_S(NTOK / 256 * (D / 256), (FP8_DENSE || FP8_DOWN) ? DFF / 128 : DFF / 64, 256);
    constexpr int S_DN = pg8::split_S(NTOK / 256 * (D / 256), (FP8_DENSE || FP8_DOWN) ? DFF / 128 : DFF / 64, 256);
    const int G = gridDim.x, bid = blockIdx.x;
    unsigned char* ws = a.ws;
    const float* modl = (const float*)(ws + WS_MOD) + (size_t)LYR * 5 * 12288;
    float* xs = (float*)(ws + WS_XS);
    const int nq = LAST ? NLAT : NTOK;
    if (IN(P0 + 0)) REPS(P0 + 0) {
        if (LYR == 0) ph_normmod<false, true, I8_WIN ? 2 : 0>(a.in[0], a.in[2], a.in[6], modl, 0, 2048, (bf16_t*)(ws + WS_HA), NTOK, xs, nullptr, nullptr, nullptr, nullptr, nullptr, (float*)(ws + WS_RSC));
        else ph_normmod<false, false, I8_WIN ? 2 : 0, S_DN0>(xs, xs + (size_t)NLAT * D, a.in[6] + D, modl, 0, 2048, (bf16_t*)(ws + WS_HA), NTOK, nullptr, nullptr, nullptr, nullptr,
                                                    (const float*)(ws + WS_SLAB), (const float*)(ws + WS_MOD) + (size_t)4 * 12288 + 10240, (float*)(ws + WS_RSC));
    }
    SEAM(P0 + 0);
    if (IN(P0 + 1)) REPS(P0 + 1) {
#if I8_WIN
        pg8::Gemm g{(const bf16_t*)(ws + WS_HA), (const bf16_t*)(ws + WS_WIN + (size_t)LYR * UW * D * 2), NTOK, UW, D / 2};
        const float swin = __uint_as_float(__hip_atomic_load((const unsigned*)(ws + WS_CTL) + CT_WSC + LYR, __ATOMIC_RELAXED, __HIP_MEMORY_SCOPE_AGENT)) * (1.0f / 127.0f);
        pg8::EpiStoreI8 E{(bf16_t*)(ws + WS_U), UW, (const float*)(ws + WS_RSC), swin};
        if constexpr (LAST) { pg8::WinLastOrder S; S.init(G, bid, D / 2); GEMM_CALLI8(pg8::EpiStoreI8, pg8::WinLastOrder, g, S, E); }
        else { pg8::StaticOrder S; S.init(NTOK, UW, G, bid, D / 2); GEMM_CALLI8(pg8::EpiStoreI8, pg8::StaticOrder, g, S, E); }
#else
        pg8::Gemm g{(const bf16_t*)(ws + WS_HA), (const bf16_t*)(ws + WS_WIN + (size_t)LYR * UW * D * 2), NTOK, UW, D};
        pg8::EpiStore E{(bf16_t*)(ws + WS_U), UW};
        if constexpr (LAST) { pg8::WinLastOrder S; S.init(G, bid, D); GEMM_CALL(pg8::EpiStore, pg8::WinLastOrder, g, S, E); }
        else { pg8::StaticOrder S; S.init(NTOK, UW, G, bid, D); GEMM_CALL(pg8::EpiStore, pg8::StaticOrder, g, S, E); }
#endif
        conv_fill(a, (float*)lds, LYR * 6 + 0);
    }
    SEAM(P0 + 1);
    if (IN(P0 + 2)) REPS(P0 + 2) ph_mid(a, LYR);
    SEAM(P0 + 2);
    if (IN(P0 + 3)) REPS(P0 + 3) {
        SUBREP(0) {
        { pg8::Gemm g{(const bf16_t*)(ws + WS_CQN), (const bf16_t*)(ws + WS_WQ + (size_t)LYR * QW * 768 * 2), nq, QW, 768};
          pg8::StaticOrder S; S.init(nq, QW, G, bid, 768); pg8::EpiQ E{(bf16_t*)(ws + WS_Q), (const float*)(ws + WS_ROPE), (const float*)(ws + WS_ROPE) + 2048 * 32};
          GEMM_CALL(pg8::EpiQ, pg8::StaticOrder, g, S, E); }
        __syncthreads();
        { pg8::Gemm g{(const bf16_t*)(ws + WS_CKVN), (const bf16_t*)(ws + WS_WKV + (size_t)LYR * KVW * 512 * 2), NTOK, 1024, 512};
          pg8::StaticOrder S; S.init(NTOK, 1024, G, bid, 512); pg8::EpiStore E{(bf16_t*)(ws + WS_KN), 1024};
          GEMM_CALL(pg8::EpiStore, pg8::StaticOrder, g, S, E); }
        __syncthreads();
        { pg8::Gemm g{(const bf16_t*)(ws + WS_WKV + (size_t)LYR * KVW * 512 * 2 + (size_t)1024 * 512 * 2), (const bf16_t*)(ws + WS_CKVN), 1024, NTOK, 512};
          pg8::StaticOrder S; S.init(1024, NTOK, 108, bid >= 216 ? bid - 216 : (bid >= 144 ? bid - 108 : (1 << 24)), 512); pg8::EpiStore E{(bf16_t*)(ws + WS_VT), NTOK};
          GEMM_CALL(pg8::EpiStore, pg8::StaticOrder, g, S, E); }
        __syncthreads();
        }
        SUBREP(1) ph_hyena(a, LYR, lds);
        SUBREP(3) if (!LAST) ph_hyena_naive<C>(a, LYR, (float*)lds);
        SUBREP(2) ph_swa(a, LYR, !LAST, lds);
        conv_fill(a, (float*)lds, LYR * 6 + 1);
    }
    SEAM(P0 + 3);
    if (IN(P0 + 4)) REPS(P0 + 4) { ph_hyena_fin(a, LYR, !LAST, lds); ph_mla(a, !LAST, lds); conv_fill(a, (float*)lds, LYR * 6 + 2); }
    SEAM(P0 + 4);
    if (IN(P0 + 5)) REPS(P0 + 5) {
        pg8::Gemm g{(const bf16_t*)(ws + WS_MIX), (const bf16_t*)(ws + WS_WOUT + (size_t)LYR * D * D * 2), nq, D, D};
        pg8::SplitOrder S; S.init(nq / 256, D / 256, G, bid, D, S_WO);
        const int trow0 = S.nfull / S.nN * 256; pg8::EpiResid E{rep_ ? (float*)(ws + WS_ACT) : xs, modl + 4096, (float*)(ws + WS_SLAB), trow0, nq - trow0, 1.0f};
        GEMM_CALL(pg8::EpiResid, pg8::SplitOrder, g, S, E);
        conv_fill(a, (float*)lds, LYR * 6 + 3);
    }
    SEAM(P0 + 5);
    if (!LAST) {
#if !FP8_DENSE
        if (IN(P0 + 6)) { ph_normmod<false, true, I8_GU ? 2 : 0, S_WO0>(xs, xs + (size_t)NLAT * D, a.in[7], modl, 6144, 8192, (bf16_t*)(ws + WS_HA), NTOK, xs, nullptr, nullptr, nullptr, (const float*)(ws + WS_SLAB), modl + (size_t)4 * 12288 + 4096, (float*)(ws + WS_RSC));
            conv_finish(a, (float*)lds, CONV_DENSE_END); }
        SEAM(P0 + 6);
        if (IN(P0 + 7)) REPS(P0 + 7) {
#if I8_GU
            pg8::Gemm g{(const bf16_t*)(ws + WS_HA), (const bf16_t*)(ws + WS_WGU), NTOK, 2 * DFF, D / 2};
            pg8::StaticOrder S; S.init(NTOK, 2 * DFF, G, bid, D / 2);
            const float swg = __uint_as_float(__hip_atomic_load((const unsigned*)(ws + WS_CTL) + CT_WSC + 2, __ATOMIC_RELAXED, __HIP_MEMORY_SCOPE_AGENT)) * (1.0f / 127.0f);
            const float swu = __uint_as_float(__hip_atomic_load((const unsigned*)(ws + WS_CTL) + CT_WSC + 3, __ATOMIC_RELAXED, __HIP_MEMORY_SCOPE_AGENT)) * (1.0f / 127.0f);
            pg8::EpiSwiGLUI8 E{(unsigned char*)(ws + WS_ACT), DFF, (const float*)(ws + WS_RSC), swg, swu, ASCALE};
            GEMM_CALLI8(pg8::EpiSwiGLUI8, pg8::StaticOrder, g, S, E);
#elif FP8_DOWN
            pg8::Gemm g{(const bf16_t*)(ws + WS_HA), (const bf16_t*)(ws + WS_WGU), NTOK, 2 * DFF, D};
            pg8::StaticOrder S; S.init(NTOK, 2 * DFF, G, bid, D);
            pg8::EpiSwiGLU8 E{(unsigned char*)(ws + WS_ACT), DFF, 1.0f, ASCALE};
            GEMM_CALL(pg8::EpiSwiGLU8, pg8::StaticOrder, g, S, E);
#else
            pg8::Gemm g{(const bf16_t*)(ws + WS_HA), (const bf16_t*)(ws + WS_WGU), NTOK, 2 * DFF, D};
            pg8::StaticOrder S; S.init(NTOK, 2 * DFF, G, bid, D);
            pg8::EpiSwiGLU E{(bf16_t*)(ws + WS_ACT), DFF};
            GEMM_CALL(pg8::EpiSwiGLU, pg8::StaticOrder, g, S, E);
#endif
            conv_fill(a, (float*)lds, 4);
        }
        SEAM(P0 + 7);
        if (IN(P0 + 8)) REPS(P0 + 8) {
#if FP8_DOWN
            pg8::Gemm g{(const bf16_t*)(ws + WS_ACT), (const bf16_t*)(ws + WS_WDN), NTOK, D, DFF / 2};
            pg8::SplitOrder S; S.init(NTOK / 256, D / 256, G, bid, DFF / 2, S_DN);
            const int trow0 = S.nfull / S.nN * 256; pg8::EpiResid E{rep_ ? (float*)(ws + WS_YS) : xs, modl + 10240, (float*)(ws + WS_SLAB), trow0, NTOK - trow0, 1.0f / (ASCALE * WSCALE)};
            GEMM_CALL8(pg8::EpiResid, pg8::SplitOrder, g, S, E);
#else
            pg8::Gemm g{(const bf16_t*)(ws + WS_ACT), (const bf16_t*)(ws + WS_WDN), NTOK, D, DFF};
            pg8::SplitOrder S; S.init(NTOK / 256, D / 256, G, bid, DFF, S_DN);
            const int trow0 = S.nfull / S.nN * 256; pg8::EpiResid E{rep_ ? (float*)(ws + WS_YS) : xs, modl + 10240, (float*)(ws + WS_SLAB), trow0, NTOK - trow0, 1.0f};
            GEMM_CALL(pg8::EpiResid, pg8::SplitOrder, g, S, E);
#endif
            conv_fill(a, (float*)lds, 5);
        }
#else
        if (IN(P0 + 6)) { ph_normmod<false, true, true, S_WO0>(xs, xs + (size_t)NLAT * D, a.in[7], modl, 6144, 8192, (bf16_t*)(ws + WS_HA), NTOK, xs, nullptr, nullptr, nullptr, (const float*)(ws + WS_SLAB), modl + (size_t)4 * 12288 + 4096);
            conv_finish(a, (float*)lds, CONV_DENSE_END); }
        SEAM(P0 + 6);
        if (IN(P0 + 7)) REPS(P0 + 7) {
            pg8::Gemm g{(const bf16_t*)(ws + WS_HA), (const bf16_t*)(ws + WS_WGU), NTOK, 2 * DFF, D / 2};
            pg8::StaticOrder S; S.init(NTOK, 2 * DFF, G, bid, D / 2); pg8::EpiSwiGLU8 E{(unsigned char*)(ws + WS_ACT), DFF, 1.0f / (ASCALE * WSCALE), ASCALE};
            GEMM_CALL8(pg8::EpiSwiGLU8, pg8::StaticOrder, g, S, E);
            conv_fill(a, (float*)lds, 4);
        }
        SEAM(P0 + 7);
        if (IN(P0 + 8)) REPS(P0 + 8) {
            pg8::Gemm g{(const bf16_t*)(ws + WS_ACT), (const bf16_t*)(ws + WS_WDN), NTOK, D, DFF / 2};
            pg8::SplitOrder S; S.init(NTOK / 256, D / 256, G, bid, DFF / 2, S_DN);
            const int trow0 = S.nfull / S.nN * 256; pg8::EpiResid E{rep_ ? (float*)(ws + WS_YS) : xs, modl + 10240, (float*)(ws + WS_SLAB), trow0, NTOK - trow0, 1.0f / (ASCALE * WSCALE)};
            GEMM_CALL8(pg8::EpiResid, pg8::SplitOrder, g, S, E);
            conv_fill(a, (float*)lds, 5);
        }
#endif
        SEAM(P0 + 8);
    } else {
        if (IN(P0 + 6)) REPS(P0 + 6) ph_normmod<true, false, true>(xs, xs + (size_t)NLAT * D, a.in[7] + D, modl, 6144, 8192, (bf16_t*)(ws + WS_HA), NLAT, nullptr, a.in[29], (int*)(ws + WS_TOPI), (float*)(ws + WS_TOPW));
        SEAM(P0 + 6);
        if (IN(P0 + 7)) REPS(P0 + 7) { ph_route_gather(a, (int*)lds); conv_finish(a, (float*)lds, NCONV); }
        SEAM(P0 + 7);
        if (IN(P0 + 9)) REPS(P0 + 9) {
            pg8::Gemm g{(const bf16_t*)(ws + WS_HBS), (const bf16_t*)(ws + WS_MGU), MOE_ROWS, 2 * DFE, D / 2};
            pg8::MoeOrder S; S.init((const int*)(ws + WS_CTL), 2 * DFE / 256, G, bid, (size_t)2 * DFE * D, D / 2); pg8::EpiSwiGLU8 E{(unsigned char*)(ws + WS_ACT), DFE, 1.0f / (ASCALE * WSCALE), ASCALE};
            GEMM_CALL8(pg8::EpiSwiGLU8, pg8::MoeOrder, g, S, E);
        }
        SEAM(P0 + 9);
        if (IN(P0 + 10)) REPS(P0 + 10) {
            pg8::Gemm g{(const bf16_t*)(ws + WS_ACT), (const bf16_t*)(ws + WS_MDN), MOE_ROWS, D, DFE / 2};
            pg8::SplitOrder S; S.init_moe((const int*)(ws + WS_CTL), D / 256, G, bid, DFE / 2, (size_t)D * DFE);
            const int trow0 = S.nfull / S.nN * 256; pg8::EpiYs E{(bf16_t*)(ws + WS_YS), (float*)(ws + WS_SLAB), trow0, S.nM * 256 - trow0, 1.0f / (ASCALE * WSCALE)};
            GEMM_CALL8(pg8::EpiYs, pg8::SplitOrder, g, S, E);
        }
        SEAM(P0 + 10);
        if (IN(P0 + 11)) REPS(P0 + 11) ph_final(a);
    }
#undef IN
#undef SEAM
#undef REPS
}

__global__ void __launch_bounds__(NTHR, 2) mk_fwd(Args a) {
    extern __shared__ __attribute__((aligned(16))) unsigned char lds[];
    const int tid = threadIdx.x;
    for (int u = tid; u < (LDS_BYTES - LDSCTL_OFF) / 4; u += NTHR) ((unsigned*)(lds + LDSCTL_OFF))[u] = 0u;
    __syncthreads();
    XcdBarrier bar; bar.bar = (unsigned*)(a.ws + WS_CTL) + CW_BAR; bar.x = 0; bar.st = nullptr;
#if !MK_PER_PHASE
    bar = xcd_barrier_post((unsigned*)(a.ws + WS_CTL) + CW_BAR, (volatile LAS unsigned*)(lds + LDSCTL_OFF + 32));
#endif
    const int lo = a.ph_lo, hi = a.ph_hi;
    if (lo <= 0 && 0 < hi) {
        for (int rep_ = 0; rep_ <= (int)(PROBE_MASK & 1u); ++rep_) { ph_prologue(a, (float*)lds); __syncthreads(); }
#if !MK_PER_PHASE
        if (1 < hi) xcd_barrier(bar);
#endif
    }
    layer_phases<0>(a, lds, bar, lo, hi);
    layer_phases<1>(a, lds, bar, lo, hi);
}

extern "C" void kernel_launch(void* const* d_in, const int* in_sizes, int n_in, void* d_out, int out_size, void* d_ws, size_t ws_size, hipStream_t stream) {
    (void)in_sizes; (void)out_size;
    static int grid = 0;
    if (grid == 0) {
        if (n_in != 34 || ws_size < WS_END) { fprintf(stderr, "kernel_launch: need 34 inputs and >= %zu bytes of workspace (got %d, %zu)\n", (size_t)WS_END, n_in, ws_size); grid = -1; return; }
        int dev = 0, cus = 0, per_cu = 0;
        if (hipGetDevice(&dev) != hipSuccess || hipDeviceGetAttribute(&cus, hipDeviceAttributeMultiprocessorCount, dev) != hipSuccess) { grid = -1; return; }
        if (hipFuncSetAttribute((const void*)mk_fwd, hipFuncAttributeMaxDynamicSharedMemorySize, LDS_BYTES) != hipSuccess) { fprintf(stderr, "kernel_launch: hipFuncSetAttribute failed\n"); grid = -1; return; }
        if (hipOccupancyMaxActiveBlocksPerMultiprocessor(&per_cu, (const void*)mk_fwd, NTHR, LDS_BYTES) != hipSuccess || per_cu < 1) { fprintf(stderr, "kernel_launch: occupancy query says %d blocks per CU\n", per_cu); }
        (void)hipGetLastError();
        grid = cus;
    }
    if (grid < 0) return;
    if (hipMemsetAsync((char*)d_ws + WS_CTL, 0, CTL_ZERO_BYTES, stream) != hipSuccess) return;
    Args a{};
    for (int i = 0; i < 34; ++i) a.in[i] = (const float*)d_in[i];
    a.out = (float*)d_out; a.ws = (unsigned char*)d_ws;
#if MK_PER_PHASE
    for (int p = 0; p < NPHASES; ++p) { a.ph_lo = p; a.ph_hi = p + 1; hipLaunchKernelGGL(mk_fwd, dim3(grid), dim3(NTHR), LDS_BYTES, stream, a); }
#else
    a.ph_lo = 0; a.ph_hi = NPHASES;
    hipLaunchKernelGGL(mk_fwd, dim3(grid), dim3(NTHR), LDS_BYTES, stream, a);
#endif
}
```

```cpp
#include <hip/hip_runtime.h>
#include <stdint.h>
#include <stdio.h>

#ifndef FP8_DENSE
#define FP8_DENSE 0
#endif
#ifndef FP8_DOWN
#define FP8_DOWN 1
#endif
#ifndef I8_WIN
#define I8_WIN 0
#endif
#ifndef I8_GU
#define I8_GU 1
#endif
#ifndef I8_GEMM
#define I8_GEMM (I8_WIN || I8_GU)
#endif
#ifndef CONV_FILL
#define CONV_FILL 0
#endif
#ifndef PROBE_MASK
#define PROBE_MASK 0u
#endif
#ifndef PROBE_SUB
#define PROBE_SUB 0u
#endif
#ifndef MK_PER_PHASE
#define MK_PER_PHASE 0
#endif

typedef unsigned short bf16_t;
typedef float f32x4 __attribute__((ext_vector_type(4)));
typedef float f32x16 __attribute__((ext_vector_type(16)));
typedef unsigned u32x4 __attribute__((ext_vector_type(4)));
typedef unsigned u32x2 __attribute__((ext_vector_type(2)));
typedef short bf16x8 __attribute__((ext_vector_type(8)));

constexpr int D = 2048, NB = 4, L = 2048, C = 256, NLAT = NB * L, NCTX = NB * C, NTOK = NLAT + NCTX;
constexpr int UW = 3840;
constexpr int O_CQ = 0, O_CKV = 768, O_KPE = 1280, O_HY = 1344, O_SQ = 2880, O_SK = 3392, O_SV = 3520, INW = 3648;
constexpr int QW = 1536, KVW = 2048, DFF = 5632, DFE = 7168, NE = 8;
constexpr int MOE_ROWS = 18432;
constexpr float EPS = 1e-6f;
constexpr int NTHR = 512;
constexpr int HY_RBROW = 4112;

__device__ __forceinline__ float bf2f(bf16_t h) { return __uint_as_float(((unsigned)h) << 16); }
__device__ __forceinline__ bf16_t f2bf(float f) { unsigned u = __float_as_uint(f); u += 0x7fffu + ((u >> 16) & 1u); return (bf16_t)(u >> 16); }
__device__ __forceinline__ float wave_sum(float v) { for (int o = 32; o > 0; o >>= 1) v += __shfl_xor(v, o); return v; }
__device__ __forceinline__ float wave_max(float v) { for (int o = 32; o > 0; o >>= 1) v = fmaxf(v, __shfl_xor(v, o)); return v; }
__device__ __forceinline__ float silu(float x) { return x / (1.0f + __expf(-x)); }
__device__ __forceinline__ int tok_mod(int tok) { return tok < NLAT ? (tok >> 11) : 4; }

constexpr size_t al(size_t x) { return (x + 255) & ~(size_t)255; }
constexpr size_t WS_CTL = 0, CTL_ZERO_BYTES = 65536;
constexpr size_t WS_MOD = 65536;
constexpr size_t WS_ROPE = WS_MOD + al((size_t)2 * 5 * 12288 * 4);
constexpr size_t WS_FILTL = WS_ROPE + al((size_t)2 * 2048 * 32 * 4);
constexpr size_t WS_FILTC = WS_FILTL + al((size_t)2 * 512 * 4096 * 4);
constexpr size_t WS_WIN = WS_FILTC + al((size_t)2 * 512 * 512 * 4);
constexpr size_t WS_WQ = WS_WIN + al((size_t)2 * UW * D * 2);
constexpr size_t WS_WKV = WS_WQ + al((size_t)2 * QW * 768 * 2);
constexpr size_t WS_WOUT = WS_WKV + al((size_t)2 * KVW * 512 * 2);
constexpr size_t WS_WGU = WS_WOUT + al((size_t)2 * D * D * 2);
constexpr size_t WS_WDN = WS_WGU + al((size_t)2 * DFF * D * 2);
constexpr size_t WS_MGU = WS_WDN + al((size_t)D * DFF * 2);
constexpr size_t WS_MDN = WS_MGU + al((size_t)NE * 2 * DFE * D * 2);
constexpr size_t WS_HA = WS_MDN + al((size_t)NE * D * DFE * 2);
constexpr size_t WS_U = WS_HA + al((size_t)NTOK * D * 2);
constexpr size_t WS_CQN = WS_U + al((size_t)NTOK * UW * 2);
constexpr size_t WS_CKVN = WS_CQN + al((size_t)NTOK * 768 * 2);
constexpr size_t WS_KPE = WS_CKVN + al((size_t)NTOK * 512 * 2);
constexpr size_t WS_X0 = WS_KPE + al((size_t)NTOK * 64 * 2);
constexpr size_t WS_WTL = WS_X0 + al((size_t)NTOK * 512 * 2);
constexpr size_t WS_WTC = WS_WTL + al((size_t)NB * 512 * L * 2);
constexpr size_t WS_SQ = WS_WTC + al((size_t)NB * 512 * C * 2);
constexpr size_t WS_SK = WS_SQ + al((size_t)NTOK * 512 * 2);
constexpr size_t WS_SV = WS_SK + al((size_t)NTOK * 128 * 2);
constexpr size_t WS_Q = WS_SV + al((size_t)NTOK * 128 * 2);
constexpr size_t WS_KV = WS_Q + al((size_t)NTOK * QW * 2);
constexpr size_t WS_KN = WS_KV;
constexpr size_t WS_VT = WS_KV + (size_t)NTOK * 1024 * 2;
constexpr size_t WS_MIX = WS_KV + al((size_t)NTOK * KVW * 2);
constexpr size_t WS_MIXEND = WS_MIX + al((size_t)NTOK * D * 2);
constexpr size_t WS_YS = WS_U;
static_assert(WS_YS + (size_t)MOE_ROWS * D * 4 <= WS_MIXEND, "ys overlay");
constexpr size_t WS_XS = WS_MIXEND;
constexpr size_t WS_ACT = WS_XS + al((size_t)NTOK * D * 4);
constexpr size_t WS_HBS = WS_ACT + al((size_t)MOE_ROWS * DFE * 2);
constexpr size_t WS_TOPI = WS_HBS + al((size_t)MOE_ROWS * D * 2);
constexpr size_t WS_TOPW = WS_TOPI + al((size_t)NLAT * 2 * 4);
constexpr size_t WS_POS = WS_TOPW + al((size_t)NLAT * 2 * 4);
constexpr size_t WS_SRC = WS_POS + al((size_t)NLAT * 2 * 4);
constexpr size_t WS_SLAB = WS_SRC + al((size_t)MOE_ROWS * 4);
constexpr size_t WS_YT = WS_SLAB + ((size_t)64 << 20);
constexpr size_t WS_RSC = WS_YT + al((size_t)NB * 512 * (L + C) * 2);
constexpr size_t WS_END = WS_RSC + al((size_t)NTOK * 4);
constexpr int CT_EOFF = 1024, CT_EPAD = 1040, CT_NTILE = 1056, CT_MOES = 1057, CT_TROW = 1058, CT_WSC = 1088, CT_AMAXDONE = 1100;
constexpr int CW_BAR = 4096;

constexpr int RING_BYTES = 131072, LDS_BYTES = 147456, LDSCTL_OFF = LDS_BYTES - 256;

namespace pg8 {
#define PG8_LAS __attribute__((address_space(3)))
typedef unsigned short bf16_t;
typedef short bf16x8 __attribute__((ext_vector_type(8)));
typedef float f32x4 __attribute__((ext_vector_type(4)));
typedef unsigned u32x4 __attribute__((ext_vector_type(4)));
constexpr int BM = 256, BK = 64, HALF = 128, HTB = HALF * BK * 2  , STAGE_BYTES = 8 * HTB, NXCD = 8, WGM = 8;

__host__ __device__ __forceinline__ int lds_byte(int r, int c) { const int st = (r >> 4) * 2 + (c >> 5), rr = r & 15, cc = c & 31, ob = rr * 64 + cc * 2; return st * 1024 + (ob ^ (((ob >> 9) & 1) << 5)); }
__host__ __device__ __forceinline__ void stage_rc(int b, int& R, int& C) { const int st = b / 1024, sb = b % 1024, swz = sb ^ (((sb >> 9) & 1) << 5); R = (st >> 1) * 16 + swz / 64; C = (st & 1) * 32 + (swz % 64) / 2; }
__host__ __device__ __forceinline__ int perm32(int rho) { const int n = rho >> 4, i = rho & 15; return 8 * (i >> 2) + 4 * n + (i & 3); }

struct Unit { int pm, pn, kt0, nkt, slab; };
struct Gemm { const bf16_t* A; const bf16_t* Bt; int M, N, K; };

struct StaticOrder {
    int nM, nN, nwg, G, c;
    int nkt;
    __host__ __device__ void init(int M, int N, int G_, int c_, int K) { nM = M / BM; nN = N / BM; nwg = nM * nN; G = G_; c = c_; nkt = K / BK; }
    __host__ __device__ bool next(int i, Unit& u) const {
        const long L = (long)i * G + c; if (L >= nwg) return false;
        int wgid = (int)L; { const int q = nwg / NXCD, r = nwg % NXCD, xcd = wgid % NXCD, off = wgid / NXCD; wgid = (xcd < r ? xcd * (q + 1) : r * (q + 1) + (xcd - r) * q) + off; }
        const int nig = WGM * nN, gid = wgid / nig, fm = gid * WGM, gsz = (nM - fm) < WGM ? (nM - fm) : WGM;
        u.pm = fm + ((wgid % nig) % gsz); u.pn = (wgid % nig) / gsz; u.kt0 = 0; u.nkt = nkt; u.slab = -1; return true;
    }
    __device__ __forceinline__ size_t bt_off(const Unit&) const { return 0; }
    __device__ __forceinline__ void a_ready(const Unit&) const {}
    __device__ __forceinline__ void done(const Unit&) const {}
};

__device__ __forceinline__ unsigned cvt_pk_bf16(float lo, float hi) { unsigned r; asm volatile("v_cvt_pk_bf16_f32 %0, %1, %2" : "=v"(r) : "v"(lo), "v"(hi)); return r; }
typedef float f32x2 __attribute__((ext_vector_type(2)));
typedef int v8i_t __attribute__((ext_vector_type(8))); typedef int v4i_t __attribute__((ext_vector_type(4)));
template <bool F8> struct Frag;
template <> struct Frag<false> { bf16x8 h[2]; __device__ __forceinline__ void set0(bf16x8 x) { h[0] = x; } __device__ __forceinline__ void set1(bf16x8 x) { h[1] = x; } };
template <> struct Frag<true> { v8i_t v; __device__ __forceinline__ void set0(bf16x8 x) { v.lo = __builtin_bit_cast(v4i_t, x); } __device__ __forceinline__ void set1(bf16x8 x) { v.hi = __builtin_bit_cast(v4i_t, x); } };
template <class Epi, class Sched, bool ALIGN_EPI = false, bool SP2 = false, int DT = 0>
__device__ __forceinline__ void gemm_phase(PG8_LAS unsigned char* lds, const Gemm g, const Sched& S, const Epi& E) {
    int tid_ = threadIdx.x; asm volatile("" : "+v"(tid_));
    const int tid = tid_, wid = __builtin_amdgcn_readfirstlane(tid >> 6), lane = tid & 63, wr = wid >> 2, wc = wid & 3, fr = lane & 15, fq = lane >> 4;
    const int K = g.K;
    unsigned voffA[2], voffB[2];
#pragma unroll
    for (int i = 0; i < 2; ++i) { int R, C; stage_rc(tid * 16 + i * 8192, R, C); const int Rb = Epi::PERM ? ((R & ~31) + perm32(R & 31)) : R;
        voffA[i] = (unsigned)(R * K + C) * 2u; voffB[i] = (unsigned)(Rb * K + C) * 2u; }
    const size_t kstep = (size_t)(BK * 2);
    const size_t hstep = (size_t)HALF * K * 2;
    const size_t tstep = 2 * hstep;
    const unsigned ldsw = (unsigned)wid * 1024u;
    const int aoff = lds_byte(wr * 64 + fr, fq * 8), boff = lds_byte(wc * 32 + fr, fq * 8);
#define PG8_SA(b, h) (((b) * 2 + (h)) * HTB)
#define PG8_SB(b, h) ((4 + (b) * 2 + (h)) * HTB)
#define PG8_STAGE(bufoff, gbase, voff) do { _Pragma("unroll") for (int _i = 0; _i < 2; ++_i) \
        __builtin_amdgcn_global_load_lds((const unsigned*)((const char*)(gbase) + (voff)[_i]), (PG8_LAS unsigned*)(lds + (bufoff) + ldsw + _i * 8192), 16, 0, 0); } while (0)
#define PG8_LDA(dst, b, h) do { _Pragma("unroll") for (int m = 0; m < 4; ++m) { dst[m].set0(*(const PG8_LAS bf16x8*)(lds + PG8_SA(b, h) + aoff + m * 2048)); dst[m].set1(*(const PG8_LAS bf16x8*)(lds + PG8_SA(b, h) + aoff + m * 2048 + 1024)); } } while (0)
#define PG8_LDB(dst, b, h) do { _Pragma("unroll") for (int n = 0; n < 2; ++n) { dst[n].set0(*(const PG8_LAS bf16x8*)(lds + PG8_SB(b, h) + boff + n * 2048)); dst[n].set1(*(const PG8_LAS bf16x8*)(lds + PG8_SB(b, h) + boff + n * 2048 + 1024)); } } while (0)
#define PG8_MMA(ai, bj, At, Bt) do { __builtin_amdgcn_s_setprio(1); _Pragma("unroll") for (int m = 0; m < 4; ++m) _Pragma("unroll") for (int n = 0; n < 2; ++n) { \
        if constexpr (DT == 1) asm volatile("v_mfma_f32_16x16x128_f8f6f4 %0, %1, %2, %0" : "+v"(acc[ai][bj][m][n]) : "v"(Bt[n].v), "v"(At[m].v));   \
        else if constexpr (DT == 2) { _Pragma("unroll") for (int k = 0; k < 2; ++k) acc[ai][bj][m][n] = __builtin_bit_cast(f32x4, __builtin_amdgcn_mfma_i32_16x16x64_i8(__builtin_bit_cast(v4i_t, Bt[n].h[k]), __builtin_bit_cast(v4i_t, At[m].h[k]), __builtin_bit_cast(v4i_t, acc[ai][bj][m][n]), 0, 0, 0)); } \
        else { _Pragma("unroll") for (int k = 0; k < 2; ++k) acc[ai][bj][m][n] = __builtin_amdgcn_mfma_f32_16x16x32_bf16(Bt[n].h[k], At[m].h[k], acc[ai][bj][m][n], 0, 0, 0); } } \
        __builtin_amdgcn_s_setprio(0); } while (0)
#define PG8_WAIT_V(n) asm volatile("s_waitcnt vmcnt(" #n ")" ::: "memory")
#define PG8_WAIT_L(n) asm volatile("s_waitcnt lgkmcnt(" #n ")" ::: "memory")
#define PG8_BAR __builtin_amdgcn_s_barrier()
#define PG8_SCHED __builtin_amdgcn_sched_barrier(0)
    Unit cur, nxt; int ui = 0;
    if (!S.next(0, cur)) return;
    f32x4 acc[2][2][4][2];
#pragma unroll
    for (int a = 0; a < 2; ++a)
#pragma unroll
        for (int b = 0; b < 2; ++b)
#pragma unroll
            for (int m = 0; m < 4; ++m)
#pragma unroll
                for (int n = 0; n < 2; ++n) acc[a][b][m][n] = (f32x4){0.f, 0.f, 0.f, 0.f};
    Frag<DT == 1> At[4], B0[2], B1[2];
    const char* cA = (const char*)g.A + (size_t)cur.pm * tstep + (size_t)cur.kt0 * kstep; const char* cB = (const char*)g.Bt + S.bt_off(cur) + (size_t)cur.pn * tstep + (size_t)cur.kt0 * kstep;
    S.a_ready(cur);
    if constexpr (SP2) {
        PG8_STAGE(PG8_SB(0, 0), cB, voffB); PG8_STAGE(PG8_SB(0, 1), cB + hstep, voffB); PG8_STAGE(PG8_SA(0, 0), cA, voffA); PG8_STAGE(PG8_SA(0, 1), cA + hstep, voffA);
        if (wr == 1) PG8_BAR;
        PG8_WAIT_V(2); PG8_BAR;
        PG8_STAGE(PG8_SB(1, 0), cB + kstep, voffB); PG8_STAGE(PG8_SA(1, 0), cA + kstep, voffA); PG8_STAGE(PG8_SB(1, 1), cB + hstep + kstep, voffB);
        PG8_WAIT_V(6); PG8_BAR;
    } else {
        PG8_STAGE(PG8_SB(0, 0), cB, voffB); PG8_STAGE(PG8_SA(0, 0), cA, voffA); PG8_STAGE(PG8_SB(0, 1), cB + hstep, voffB); PG8_STAGE(PG8_SA(0, 1), cA + hstep, voffA);
        if (wr == 1) PG8_BAR;
        PG8_WAIT_V(4); PG8_BAR;
        PG8_STAGE(PG8_SB(1, 0), cB + kstep, voffB); PG8_STAGE(PG8_SA(1, 0), cA + kstep, voffA); PG8_STAGE(PG8_SB(1, 1), cB + hstep + kstep, voffB);
        PG8_WAIT_V(6); PG8_BAR;
    }
    for (;;) {
        const bool has_next = S.next(ui + 1, nxt);
        const char* nA = has_next ? (const char*)g.A + (size_t)nxt.pm * tstep + (size_t)nxt.kt0 * kstep : cA; const char* nB = has_next ? (const char*)g.Bt + S.bt_off(nxt) + (size_t)nxt.pn * tstep + (size_t)nxt.kt0 * kstep : cB;
        const int nt = cur.nkt;
        for (int t = 0; t < nt; t += 2) {
            const bool last = (t == nt - 2);
            const char* a1 = cA + (size_t)(t + 1) * kstep;
            const char* a2 = last ? nA : cA + (size_t)(t + 2) * kstep; const char* b2 = last ? nB : cB + (size_t)(t + 2) * kstep;
            const char* a3 = a2 + kstep; const char* b3 = b2 + kstep;
            if (last && has_next) S.a_ready(nxt);
            if constexpr (SP2) {
            PG8_LDB(B0, 0, 0); PG8_LDB(B1, 0, 1); PG8_SCHED; PG8_LDA(At, 0, 0); PG8_STAGE(PG8_SA(1, 1), a1 + hstep, voffA);
            PG8_WAIT_V(8); PG8_WAIT_L(0); PG8_BAR; PG8_MMA(0, 0, At, B0); PG8_MMA(0, 1, At, B1); PG8_BAR; PG8_SCHED;
            PG8_LDA(At, 0, 1); PG8_STAGE(PG8_SB(0, 0), b2, voffB); PG8_STAGE(PG8_SB(0, 1), b2 + hstep, voffB); PG8_STAGE(PG8_SA(0, 0), a2, voffA);
            PG8_WAIT_V(8); PG8_WAIT_L(0); PG8_BAR; PG8_MMA(1, 0, At, B0); PG8_MMA(1, 1, At, B1); PG8_BAR; PG8_SCHED;
            PG8_LDB(B0, 1, 0); PG8_LDB(B1, 1, 1); PG8_SCHED; PG8_LDA(At, 1, 0); PG8_STAGE(PG8_SA(0, 1), a2 + hstep, voffA);
            PG8_WAIT_V(8); PG8_WAIT_L(0); PG8_BAR; PG8_MMA(0, 0, At, B0); PG8_MMA(0, 1, At, B1); PG8_BAR; PG8_SCHED;
            PG8_LDA(At, 1, 1); PG8_STAGE(PG8_SB(1, 0), b3, voffB); PG8_STAGE(PG8_SB(1, 1), b3 + hstep, voffB); PG8_STAGE(PG8_SA(1, 0), a3, voffA);
            PG8_WAIT_V(8); PG8_WAIT_L(0); PG8_BAR; PG8_MMA(1, 0, At, B0); PG8_MMA(1, 1, At, B1); PG8_BAR; PG8_SCHED;
            } else {
            PG8_LDB(B0, 0, 0); PG8_SCHED; PG8_LDA(At, 0, 0); PG8_STAGE(PG8_SA(1, 1), a1 + hstep, voffA);
            PG8_WAIT_L(8); PG8_BAR; PG8_WAIT_L(0); PG8_MMA(0, 0, At, B0); PG8_BAR; PG8_SCHED;
            PG8_LDB(B1, 0, 1); PG8_STAGE(PG8_SB(0, 0), b2, voffB);
            PG8_BAR; PG8_WAIT_L(0); PG8_MMA(0, 1, At, B1); PG8_BAR;
            PG8_LDA(At, 0, 1); PG8_STAGE(PG8_SA(0, 0), a2, voffA);
            PG8_BAR; PG8_WAIT_L(0); PG8_MMA(1, 0, At, B0); PG8_BAR; PG8_SCHED;
            PG8_STAGE(PG8_SB(0, 1), b2 + hstep, voffB);
            PG8_WAIT_V(6); PG8_BAR; PG8_MMA(1, 1, At, B1); PG8_BAR;
            PG8_LDB(B0, 1, 0); PG8_SCHED; PG8_LDA(At, 1, 0); PG8_STAGE(PG8_SA(0, 1), a2 + hstep, voffA);
            PG8_WAIT_L(8); PG8_BAR; PG8_WAIT_L(0); PG8_MMA(0, 0, At, B0); PG8_BAR; PG8_SCHED;
            PG8_LDB(B1, 1, 1); PG8_STAGE(PG8_SB(1, 0), b3, voffB);
            PG8_BAR; PG8_WAIT_L(0); PG8_MMA(0, 1, At, B1); PG8_BAR;
            PG8_LDA(At, 1, 1); PG8_STAGE(PG8_SA(1, 0), a3, voffA);
            PG8_BAR; PG8_WAIT_L(0); PG8_MMA(1, 0, At, B0); PG8_BAR; PG8_SCHED;
            PG8_STAGE(PG8_SB(1, 1), b3 + hstep, voffB);
            PG8_WAIT_V(6); PG8_BAR; PG8_MMA(1, 1, At, B1); PG8_BAR;
            }
        }
        if constexpr (ALIGN_EPI) { if (wr == 0) PG8_BAR; }
        if constexpr (DT == 1) asm volatile("s_nop 15\n\ts_nop 15" ::: "memory");
        if constexpr (!Epi::AFTER_DRAIN) { E(acc, cur, wr, wc, fr, fq); S.done(cur); }
        if (!has_next) break;
#pragma unroll
        for (int a = 0; a < 2; ++a)
#pragma unroll
            for (int b = 0; b < 2; ++b)
#pragma unroll
                for (int m = 0; m < 4; ++m)
#pragma unroll
                    for (int n = 0; n < 2; ++n) acc[a][b][m][n] = (f32x4){0.f, 0.f, 0.f, 0.f};
        cur = nxt; cA = nA; cB = nB; ++ui;
        if constexpr (ALIGN_EPI) { if (wr == 1) PG8_BAR; }
    }
    PG8_WAIT_V(0);
    if constexpr (!ALIGN_EPI) { if (wr == 0) PG8_BAR; }
    PG8_BAR;
    if constexpr (Epi::AFTER_DRAIN) { E.fused(acc, cur, wr, wc, fr, fq, lds, wid, lane); S.done(cur); }
#undef PG8_SA
#undef PG8_SB
#undef PG8_STAGE
#undef PG8_LDA
#undef PG8_LDB
#undef PG8_MMA
#undef PG8_WAIT_V
#undef PG8_WAIT_L
#undef PG8_BAR
#undef PG8_SCHED
}
}

namespace pg8 {
__device__ __forceinline__ u32x4 pack8(const f32x4 v0, const f32x4 v1) { u32x4 w; w.x = cvt_pk_bf16(v0[0], v0[1]); w.y = cvt_pk_bf16(v0[2], v0[3]); w.z = cvt_pk_bf16(v1[0], v1[1]); w.w = cvt_pk_bf16(v1[2], v1[3]); return w; }
struct EpiStore {
    static constexpr bool PERM = true, AFTER_DRAIN = false;
    bf16_t* O; int ldc;
    __device__ __forceinline__ void operator()(const f32x4 (&acc)[2][2][4][2], const Unit& u, int wr, int wc, int fr, int fq) const {
        const int row0 = u.pm * BM + wr * 64 + fr, col0 = u.pn * BM + wc * 32 + 8 * fq;
#pragma unroll
        for (int ai = 0; ai < 2; ++ai)
#pragma unroll
            for (int m = 0; m < 4; ++m) { bf16_t* rowp = O + (size_t)(row0 + ai * HALF + m * 16) * ldc + col0;
#pragma unroll
                for (int bj = 0; bj < 2; ++bj) *(u32x4*)(rowp + bj * HALF) = pack8(acc[ai][bj][m][0], acc[ai][bj][m][1]); }
    }
};
struct EpiQ {
    static constexpr bool PERM = true, AFTER_DRAIN = false;
    bf16_t* O; const float* cosT; const float* sinT;
    __device__ __forceinline__ void operator()(const f32x4 (&acc)[2][2][4][2], const Unit& u, int wr, int wc, int fr, int fq) const {
        const int row0 = u.pm * BM + wr * 64 + fr, col0 = u.pn * BM + wc * 32 + 8 * fq;
#pragma unroll
        for (int ai = 0; ai < 2; ++ai)
#pragma unroll
            for (int m = 0; m < 4; ++m) { const int row = row0 + ai * HALF + m * 16; const bool lat = row < 8192; const int t = row & 2047;
#pragma unroll
                for (int bj = 0; bj < 2; ++bj) { const int col = col0 + bj * HALF; const int jn = col - 192 * (col / 192);
                    f32x4 v0 = acc[ai][bj][m][0], v1 = acc[ai][bj][m][1];
                    if (jn >= 128 && lat) { const int i0 = (jn - 128) >> 1;
                        const f32x4 cs = *(const f32x4*)(cosT + t * 32 + i0), sn = *(const f32x4*)(sinT + t * 32 + i0);
                        f32x4 r0, r1;
                        r0[0] = v0[0] * cs[0] - v0[1] * sn[0]; r0[1] = v0[0] * sn[0] + v0[1] * cs[0];
                        r0[2] = v0[2] * cs[1] - v0[3] * sn[1]; r0[3] = v0[2] * sn[1] + v0[3] * cs[1];
                        r1[0] = v1[0] * cs[2] - v1[1] * sn[2]; r1[1] = v1[0] * sn[2] + v1[1] * cs[2];
                        r1[2] = v1[2] * cs[3] - v1[3] * sn[3]; r1[3] = v1[2] * sn[3] + v1[3] * cs[3];
                        v0 = r0; v1 = r1; }
                    *(u32x4*)(O + (size_t)row * 1536 + col) = pack8(v0, v1); } }
    }
};
struct EpiResid {
    static constexpr bool PERM = false, AFTER_DRAIN = false;
    float* xs; const float* gate; float* slab; int tail_row0, tail_rows; float scale;
    __device__ __forceinline__ void operator()(const f32x4 (&acc)[2][2][4][2], const Unit& u, int wr, int wc, int fr, int fq) const {
        const int row0 = u.pm * BM + wr * 64 + fr, colb = u.pn * BM + wc * 32 + 4 * fq;
        if (u.slab >= 0) {
#pragma unroll
            for (int ai = 0; ai < 2; ++ai)
#pragma unroll
                for (int m = 0; m < 4; ++m) { float* sp = slab + ((size_t)u.slab * tail_rows + (row0 + ai * HALF + m * 16 - tail_row0)) * 2048;
#pragma unroll
                    for (int bj = 0; bj < 2; ++bj)
#pragma unroll
                        for (int n = 0; n < 2; ++n) *(f32x4*)(sp + colb + bj * HALF + n * 16) = acc[ai][bj][m][n] * scale; }
            return;
        }
#pragma unroll
        for (int ai = 0; ai < 2; ++ai)
#pragma unroll
            for (int m = 0; m < 4; ++m) { const int row = row0 + ai * HALF + m * 16; const float* gv = gate + (size_t)(row < 8192 ? (row >> 11) : 4) * 12288; float* xr = xs + (size_t)row * 2048;
#pragma unroll
                for (int bj = 0; bj < 2; ++bj)
#pragma unroll
                    for (int n = 0; n < 2; ++n) { const int col = colb + bj * HALF + n * 16; f32x4 x = *(const f32x4*)(xr + col); const f32x4 g = *(const f32x4*)(gv + col);
                        x += (g * scale) * acc[ai][bj][m][n]; *(f32x4*)(xr + col) = x; }
                if (m & 1) asm volatile("" ::: "memory"); }
    }
};
__device__ __forceinline__ unsigned pack4_fp8(float a, float b, float c, float d) {
    a = __builtin_amdgcn_fmed3f(a, -448.f, 448.f); b = __builtin_amdgcn_fmed3f(b, -448.f, 448.f); c = __builtin_amdgcn_fmed3f(c, -448.f, 448.f); d = __builtin_amdgcn_fmed3f(d, -448.f, 448.f);
    unsigned w = 0; w = __builtin_amdgcn_cvt_pk_fp8_f32(a, b, w, false); w = __builtin_amdgcn_cvt_pk_fp8_f32(c, d, w, true); return w; }
struct EpiSwiGLU8 {
    static constexpr bool PERM = true, AFTER_DRAIN = false;
    unsigned char* O; int ldc; float s, oscale;
    __device__ __forceinline__ void operator()(const f32x4 (&acc)[2][2][4][2], const Unit& u, int wr, int wc, int fr, int fq) const {
        const int row0 = u.pm * BM + wr * 64 + fr, col0 = u.pn * HALF + wc * 32 + 8 * fq;
#pragma unroll
        for (int ai = 0; ai < 2; ++ai)
#pragma unroll
            for (int m = 0; m < 4; ++m) { f32x4 o0, o1;
#pragma unroll
                for (int j = 0; j < 4; ++j) { const float g0 = acc[ai][0][m][0][j] * s, g1 = acc[ai][0][m][1][j] * s;
                    o0[j] = g0 * __builtin_amdgcn_rcpf(1.0f + __expf(-g0)) * (acc[ai][1][m][0][j] * (s * oscale)); o1[j] = g1 * __builtin_amdgcn_rcpf(1.0f + __expf(-g1)) * (acc[ai][1][m][1][j] * (s * oscale)); }
                u32x2 w; w.x = pack4_fp8(o0[0], o0[1], o0[2], o0[3]); w.y = pack4_fp8(o1[0], o1[1], o1[2], o1[3]);
                *(u32x2*)(O + (size_t)(row0 + ai * HALF + m * 16) * ldc + col0) = w; }
    }
};
__device__ __forceinline__ f32x4 i2f4(const f32x4 bits) { const v4i_t iv = __builtin_bit_cast(v4i_t, bits); return (f32x4){(float)iv[0], (float)iv[1], (float)iv[2], (float)iv[3]}; }
struct EpiStoreI8 {
    static constexpr bool PERM = true, AFTER_DRAIN = false;
    bf16_t* O; int ldc; const float* rsc; float sw;
    __device__ __forceinline__ void operator()(const f32x4 (&acc)[2][2][4][2], const Unit& u, int wr, int wc, int fr, int fq) const {
        const int row0 = u.pm * BM + wr * 64 + fr, col0 = u.pn * BM + wc * 32 + 8 * fq;
#pragma unroll
        for (int ai = 0; ai < 2; ++ai)
#pragma unroll
            for (int m = 0; m < 4; ++m) { const int row = row0 + ai * HALF + m * 16; const float sc = rsc[row] * sw; bf16_t* rowp = O + (size_t)row * ldc + col0;
#pragma unroll
                for (int bj = 0; bj < 2; ++bj) *(u32x4*)(rowp + bj * HALF) = pack8(i2f4(acc[ai][bj][m][0]) * sc, i2f4(acc[ai][bj][m][1]) * sc); }
    }
};
struct EpiSwiGLUI8 {
    static constexpr bool PERM = true, AFTER_DRAIN = false;
    unsigned char* O; int ldc; const float* rsc; float swg, swu, oscale;
    __device__ __forceinline__ void operator()(const f32x4 (&acc)[2][2][4][2], const Unit& u, int wr, int wc, int fr, int fq) const {
        const int row0 = u.pm * BM + wr * 64 + fr, col0 = u.pn * HALF + wc * 32 + 8 * fq;
#pragma unroll
        for (int ai = 0; ai < 2; ++ai)
#pragma unroll
            for (int m = 0; m < 4; ++m) { const int row = row0 + ai * HALF + m * 16; const float sa = rsc[row], sg = sa * swg, su = sa * swu * oscale; f32x4 o0, o1;
                const f32x4 g0v = i2f4(acc[ai][0][m][0]) * sg, g1v = i2f4(acc[ai][0][m][1]) * sg, u0v = i2f4(acc[ai][1][m][0]) * su, u1v = i2f4(acc[ai][1][m][1]) * su;
#pragma unroll
                for (int j = 0; j < 4; ++j) { o0[j] = g0v[j] * __builtin_amdgcn_rcpf(1.0f + __expf(-g0v[j])) * u0v[j]; o1[j] = g1v[j] * __builtin_amdgcn_rcpf(1.0f + __expf(-g1v[j])) * u1v[j]; }
                u32x2 w; w.x = pack4_fp8(o0[0], o0[1], o0[2], o0[3]); w.y = pack4_fp8(o1[0], o1[1], o1[2], o1[3]);
                *(u32x2*)(O + (size_t)row * ldc + col0) = w; }
    }
};
struct EpiSwiGLU {
    static constexpr bool PERM = true, AFTER_DRAIN = false;
    bf16_t* O; int ldc;
    __device__ __forceinline__ void operator()(const f32x4 (&acc)[2][2][4][2], const Unit& u, int wr, int wc, int fr, int fq) const {
        const int row0 = u.pm * BM + wr * 64 + fr, col0 = u.pn * HALF + wc * 32 + 8 * fq;
#pragma unroll
        for (int ai = 0; ai < 2; ++ai)
#pragma unroll
            for (int m = 0; m < 4; ++m) { f32x4 o0, o1;
#pragma unroll
                for (int j = 0; j < 4; ++j) { const float g0 = acc[ai][0][m][0][j], g1 = acc[ai][0][m][1][j];
                    o0[j] = g0 / (1.0f + __expf(-g0)) * acc[ai][1][m][0][j]; o1[j] = g1 / (1.0f + __expf(-g1)) * acc[ai][1][m][1][j]; }
                *(u32x4*)(O + (size_t)(row0 + ai * HALF + m * 16) * ldc + col0) = pack8(o0, o1); }
    }
};
struct EpiF32 {
    static constexpr bool PERM = false, AFTER_DRAIN = false;
    float* O; int ldc; float* slab; int tail_row0, tail_rows; float scale;
    __device__ __forceinline__ void operator()(const f32x4 (&acc)[2][2][4][2], const Unit& u, int wr, int wc, int fr, int fq) const {
        const int row0 = u.pm * BM + wr * 64 + fr, colb = u.pn * BM + wc * 32 + 4 * fq;
#pragma unroll
        for (int ai = 0; ai < 2; ++ai)
#pragma unroll
            for (int m = 0; m < 4; ++m) { float* xr = (u.slab >= 0) ? slab + ((size_t)u.slab * tail_rows + (row0 + ai * HALF + m * 16 - tail_row0)) * 2048 : O + (size_t)(row0 + ai * HALF + m * 16) * ldc;
#pragma unroll
                for (int bj = 0; bj < 2; ++bj)
#pragma unroll
                    for (int n = 0; n < 2; ++n) *(f32x4*)(xr + colb + bj * HALF + n * 16) = acc[ai][bj][m][n] * scale; }
    }
};
struct EpiYs {
    static constexpr bool PERM = false, AFTER_DRAIN = false;
    bf16_t* O; float* slab; int tail_row0, tail_rows; float scale;
    __device__ __forceinline__ void operator()(const f32x4 (&acc)[2][2][4][2], const Unit& u, int wr, int wc, int fr, int fq) const {
        const int row0 = u.pm * BM + wr * 64 + fr, colb = u.pn * BM + wc * 32 + 4 * fq;
        if (u.slab >= 0) {
#pragma unroll
            for (int ai = 0; ai < 2; ++ai)
#pragma unroll
                for (int m = 0; m < 4; ++m) { float* sp = slab + ((size_t)u.slab * tail_rows + (row0 + ai * HALF + m * 16 - tail_row0)) * 2048;
#pragma unroll
                    for (int bj = 0; bj < 2; ++bj)
#pragma unroll
                        for (int n = 0; n < 2; ++n) *(f32x4*)(sp + colb + bj * HALF + n * 16) = acc[ai][bj][m][n] * scale; }
            return;
        }
#pragma unroll
        for (int ai = 0; ai < 2; ++ai)
#pragma unroll
            for (int m = 0; m < 4; ++m) { bf16_t* xr = O + (size_t)(row0 + ai * HALF + m * 16) * 2048;
#pragma unroll
                for (int bj = 0; bj < 2; ++bj)
#pragma unroll
                    for (int n = 0; n < 2; ++n) { const f32x4 v = acc[ai][bj][m][n] * scale; u32x2 w; w.x = cvt_pk_bf16(v[0], v[1]); w.y = cvt_pk_bf16(v[2], v[3]); *(u32x2*)(xr + colb + bj * HALF + n * 16) = w; } }
    }
};
struct MoeOrder {
    int nM, nN, nwg, G, c, nkt; int t1[8]; size_t estride;
    __device__ __forceinline__ void init(const int* ctl, int nN_, int G_, int c_, size_t estride_, int K) { nkt = K / BK;
        int acc = 0;
#pragma unroll
        for (int e = 0; e < 8; ++e) { acc += __builtin_amdgcn_readfirstlane(ctl[CT_EPAD + e]) >> 8; t1[e] = acc; }
        nM = acc; nN = nN_; nwg = nM * nN; G = G_; c = c_; estride = estride_;
    }
    __device__ __forceinline__ bool next(int i, Unit& u) const {
        const long L = (long)i * G + c; if (L >= nwg) return false;
        int wgid = (int)L; { const int q = nwg / NXCD, r = nwg % NXCD, xcd = wgid % NXCD, off = wgid / NXCD; wgid = (xcd < r ? xcd * (q + 1) : r * (q + 1) + (xcd - r) * q) + off; }
        const int nig = WGM * nN, gid = wgid / nig, fm = gid * WGM, gsz = (nM - fm) < WGM ? (nM - fm) : WGM;
        u.pm = fm + ((wgid % nig) % gsz); u.pn = (wgid % nig) / gsz; u.kt0 = 0; u.nkt = nkt; u.slab = -1; return true;
    }
    __device__ __forceinline__ size_t bt_off(const Unit& u) const { int e = 0;
#pragma unroll
        for (int k = 0; k < 7; ++k) e += (u.pm >= t1[k]) ? 1 : 0;
        return (size_t)e * estride; }
    __device__ __forceinline__ void a_ready(const Unit&) const {}
    __device__ __forceinline__ void done(const Unit&) const {}
};
struct WinLastOrder {
    StaticOrder so; int G, c;
    __device__ __forceinline__ void init(int G_, int c_, int K) { so.init(NLAT, UW, G_, c_, K); G = G_; c = c_; }
    __device__ __forceinline__ bool next(int i, Unit& u) const {
        if (so.next(i, u)) return true;
        const long L = (long)i * G + c - so.nwg; if (L < 0 || L >= 20) return false;
        const int j = (int)L, k = j % 5; u.pm = 32 + j / 5; u.pn = k < 3 ? 3 + k : 10 + k; u.kt0 = 0; u.nkt = so.nkt; u.slab = -1; return true;
    }
    __device__ __forceinline__ size_t bt_off(const Unit&) const { return 0; }
    __device__ __forceinline__ void a_ready(const Unit&) const {}
    __device__ __forceinline__ void done(const Unit&) const {}
};
struct SplitOrder {
    int nM, nN, nwg, G, c, nfull, ntail, S, nkt, nkts; int t1[8]; size_t estride;
    __device__ __forceinline__ void init(int nM_, int nN_, int G_, int c_, int K, int S_) {
        nM = nM_; nN = nN_; nwg = nM * nN; G = G_; c = c_; nkt = K / BK; nfull = (nwg / 256) * 256; ntail = nwg - nfull; S = S_; nkts = nkt / S; estride = 0;
#pragma unroll
        for (int e = 0; e < 8; ++e) t1[e] = 0;
    }
    __device__ __forceinline__ void init_moe(const int* ctl, int nN_, int G_, int c_, int K, size_t estride_) {
        int acc = 0;
#pragma unroll
        for (int e = 0; e < 8; ++e) { acc += __builtin_amdgcn_readfirstlane(ctl[CT_EPAD + e]) >> 8; t1[e] = acc; }
        init(acc, nN_, G_, c_, K, __builtin_amdgcn_readfirstlane(ctl[CT_MOES])); estride = estride_;
        acc = 0;
#pragma unroll
        for (int e = 0; e < 8; ++e) { acc += __builtin_amdgcn_readfirstlane(ctl[CT_EPAD + e]) >> 8; t1[e] = acc; }
    }
    __device__ __forceinline__ bool next(int i, Unit& u) const {
        const long L = (long)i * G + c; int wgid;
        if (L < nfull) { wgid = (int)L; { const int q = nfull / NXCD, xcd = wgid % NXCD, off = wgid / NXCD; wgid = xcd * q + off; } u.kt0 = 0; u.nkt = nkt; u.slab = -1; }
        else { const int j = (int)(L - nfull); if (j >= ntail * S) return false; const int tu = j / S, sl = j - tu * S; wgid = nfull + tu; u.kt0 = sl * nkts; u.nkt = nkts; u.slab = (S > 1) ? sl : -1; }
        const int nig = WGM * nN, gid = wgid / nig, fm = gid * WGM, gsz = (nM - fm) < WGM ? (nM - fm) : WGM;
        u.pm = fm + ((wgid % nig) % gsz); u.pn = (wgid % nig) / gsz; return true;
    }
    __device__ __forceinline__ size_t bt_off(const Unit& u) const { if (estride == 0) return 0; int e = 0;
#pragma unroll
        for (int k = 0; k < 7; ++k) e += (u.pm >= t1[k]) ? 1 : 0;
        return (size_t)e * estride; }
    __device__ __forceinline__ void a_ready(const Unit&) const {}
    __device__ __forceinline__ void done(const Unit&) const {}
};
__host__ __device__ constexpr int split_S(int nwg, int nkt, int G) {
    const int ntail = nwg - (nwg / G) * G;
    if (ntail == 0) return 1;
    if (nkt % 28 == 0 && ntail * 14 <= G) return 14;
    if (nkt % 16 == 0 && ntail * 8 <= G) return 8;
    if (nkt % 14 == 0 && ntail * 7 <= G) return 7;
    if (nkt % 8 == 0 && ntail * 4 <= G) return 4;
    if (nkt % 4 == 0 && ntail * 2 <= G) return 2;
    return 1;
}
}

#define LAS __attribute__((address_space(3)))
#define XB_TMO      128
#define XB_XCNT(j)  (256  + 64 * (j))
#define XB_XSUB(j)  (1280 + 64 * (j))
#define XB_XGEN(j)  (2304 + 64 * (j))
#define XB_TOP      3328
#define XB_TOPGEN   3392
#define XCD_BAR_WORDS 3456
#define XB_SPIN_CAP (1u << 18)

__device__ __forceinline__ unsigned xb_ld(unsigned* p)              { return __hip_atomic_load(p, __ATOMIC_RELAXED, __HIP_MEMORY_SCOPE_AGENT); }
__device__ __forceinline__ unsigned xb_add(unsigned* p, unsigned v) { return __hip_atomic_fetch_add(p, v, __ATOMIC_RELAXED, __HIP_MEMORY_SCOPE_AGENT); }
__device__ __forceinline__ unsigned xb_xcc_id() { return (unsigned)__builtin_amdgcn_s_getreg((3 << 11) | 20) & 0xFu; }
#define XB_SPIN(cond, bar) do { unsigned _sp = 0; while (cond) { __builtin_amdgcn_s_sleep(1); \
    if ((++_sp & 255u) == 0u) { if (xb_ld(&(bar)[XB_TMO])) break; if (_sp > XB_SPIN_CAP) { atomicAdd(&(bar)[XB_TMO], 1u); break; } } } } while (0)

struct XcdBarrier {
    unsigned* bar; unsigned x;
    volatile LAS unsigned* st;
};

__device__ __forceinline__ XcdBarrier xcd_barrier_post(unsigned* bar, volatile LAS unsigned* st) {
    XcdBarrier b; b.bar = bar; b.x = xb_xcc_id(); b.st = st;
    if (threadIdx.x == 0) (void)xb_add(&bar[XB_XCNT(b.x)], 1u);
    return b;
}
__device__ __forceinline__ void xcd_barrier_complete(unsigned* bar, unsigned x, unsigned& nloc, unsigned& nx) {
    const unsigned G = gridDim.x * gridDim.y * gridDim.z;
    unsigned sum, cnt, mine, sp = 0u;
    for (;;) {
        sum = 0u; cnt = 0u; mine = 0u;
#pragma unroll
        for (unsigned j = 0; j < 16; ++j) { const unsigned c = xb_ld(&bar[XB_XCNT(j)]); sum += c; cnt += (c > 0u) ? 1u : 0u; mine = (j == x) ? c : mine; }
        if (sum == G) break;
        __builtin_amdgcn_s_sleep(1);
        if ((++sp & 255u) == 0u) { if (xb_ld(&bar[XB_TMO])) break; if (sp > XB_SPIN_CAP) { atomicAdd(&bar[XB_TMO], 1u); break; } }
    }
    nloc = mine > 0u ? mine : 1u; nx = cnt > 0u ? cnt : 1u;
}

__device__ __forceinline__ void xcd_barrier(const XcdBarrier& b) {
    asm volatile("s_waitcnt vmcnt(0)" ::: "memory");
    __syncthreads();
    if (threadIdx.x == 0) {
        unsigned* bar = b.bar;
        __builtin_amdgcn_s_waitcnt(0);
        unsigned nloc = b.st[0], nx = b.st[1];
        if (nloc == 0u) { xcd_barrier_complete(bar, b.x, nloc, nx); b.st[0] = nloc; b.st[1] = nx; }
        const unsigned old = xb_add(&bar[XB_XSUB(b.x)], 1u);
        const unsigned gen = old / nloc;
        if (old + 1u == (gen + 1u) * nloc) {
            __builtin_amdgcn_fence(__ATOMIC_RELEASE, "agent");
            asm volatile("s_waitcnt vmcnt(0)" ::: "memory");
            const unsigned og = xb_add(&bar[XB_TOP], 1u);
            const unsigned tg = og / nx;
            if (og + 1u == (tg + 1u) * nx) xb_add(&bar[XB_TOPGEN], 1u);
            else XB_SPIN(xb_ld(&bar[XB_TOPGEN]) == tg, bar);
            __builtin_amdgcn_fence(__ATOMIC_ACQUIRE, "agent");
            xb_add(&bar[XB_XGEN(b.x)], 1u);
            asm volatile("s_waitcnt vmcnt(0)" ::: "memory");
        } else {
            XB_SPIN(xb_ld(&bar[XB_XGEN(b.x)]) == gen, bar);
            __builtin_amdgcn_fence(__ATOMIC_ACQUIRE, "agent");
            asm volatile("s_waitcnt vmcnt(0)" ::: "memory");
        }
    }
    __syncthreads();
}


struct Args { const float* in[34]; float* out; unsigned char* ws; int ph_lo, ph_hi; };

enum { MAP_ID = 0, MAP_ROPEQ = 1, MAP_GU0 = 2, MAP_GU1 = 3, MAP_KV = 4 };
struct JobDesc { int in_idx, K, N, nbatch, upb, map; long long src_off, src_bstride, dst_off, dst_bstride; int fp8, sidx; };
constexpr int NJOBS = 14, NCONV = 12664;
__constant__ JobDesc c_jobs[NJOBS] = {
    {8, 2048, 3648, 1, 232, MAP_ID, 0, 0, (long long)WS_WIN, 0, I8_WIN ? 2 : 0, 0},
    {8, 2048, 3648, 1, 232, MAP_ID, 2048LL * 3648, 0, (long long)(WS_WIN + (size_t)UW * D * 2), 0, I8_WIN ? 2 : 0, 1},
    {10, 768, 1536, 1, 36, MAP_ROPEQ, 0, 0, (long long)WS_WQ, 0},
    {10, 768, 1536, 1, 36, MAP_ROPEQ, 768LL * 1536, 0, (long long)(WS_WQ + (size_t)QW * 768 * 2), 0},
    {12, 512, 2048, 1, 32, MAP_KV, 0, 0, (long long)WS_WKV, 0},
    {12, 512, 2048, 1, 32, MAP_KV, 512LL * 2048, 0, (long long)(WS_WKV + (size_t)KVW * 512 * 2), 0},
    {25, 2048, 2048, 1, 128, MAP_ID, 0, 0, (long long)WS_WOUT, 0},
    {25, 2048, 2048, 1, 128, MAP_ID, 2048LL * 2048, 0, (long long)(WS_WOUT + (size_t)D * D * 2), 0},
    {26, 2048, 5632, 1, 352, MAP_GU0, 0, 0, (long long)WS_WGU, 0, I8_GU ? 2 : FP8_DENSE, 2},
    {27, 2048, 5632, 1, 352, MAP_GU1, 0, 0, (long long)WS_WGU, 0, I8_GU ? 2 : FP8_DENSE, 3},
    {28, 5632, 2048, 1, 352, MAP_ID, 0, 0, (long long)WS_WDN, 0, (FP8_DENSE || FP8_DOWN), 0},
    {30, 2048, 7168, 8, 448, MAP_GU0, 0, 2048LL * 7168, (long long)WS_MGU, 2LL * DFE * D, 1, 0},
    {31, 2048, 7168, 8, 448, MAP_GU1, 0, 2048LL * 7168, (long long)WS_MGU, 2LL * DFE * D, 1, 0},
    {32, 7168, 2048, 8, 448, MAP_ID, 0, 7168LL * 2048, (long long)WS_MDN, (long long)D * DFE, 1, 0},
};
struct ConvUnit { const float* src; bf16_t* dst; int K, N, map, k0, n0, fp8; float qs; };
__device__ __forceinline__ unsigned pack4_i8(float a, float b, float c, float d) {
    const int ia = (int)__builtin_rintf(__builtin_amdgcn_fmed3f(a, -127.f, 127.f)), ib = (int)__builtin_rintf(__builtin_amdgcn_fmed3f(b, -127.f, 127.f)), ic = (int)__builtin_rintf(__builtin_amdgcn_fmed3f(c, -127.f, 127.f)), id = (int)__builtin_rintf(__builtin_amdgcn_fmed3f(d, -127.f, 127.f));
    return (unsigned)(ia & 0xff) | ((unsigned)(ib & 0xff) << 8) | ((unsigned)(ic & 0xff) << 16) | ((unsigned)(id & 0xff) << 24); }
constexpr float WSCALE = 64.f, ASCALE = 8.f;
__device__ __forceinline__ void conv_decode(const Args& a, int u, ConvUnit& cu) {
    int j = 0, base = 0;
    for (;;) { const int n = c_jobs[j].nbatch * c_jobs[j].upb; if (u < base + n || j == NJOBS - 1) break; base += n; ++j; }
    const JobDesc& jd = c_jobs[j];
    int r = u - base; const int bt = r / jd.upb; r -= bt * jd.upb; const int ntn = (jd.N + 127) >> 7; int kt = r / ntn, nt = r - kt * ntn;
    if (((jd.K >> 8) & 1) == 0) { const int r2 = r >> 1; kt = 2 * (r2 / ntn) + (r & 1); nt = r2 % ntn; }
    cu.K = jd.K; cu.N = jd.N; cu.map = jd.map; cu.k0 = kt * 256; cu.n0 = nt * 128; cu.fp8 = jd.fp8; cu.qs = 1.0f;
    if (jd.fp8 == 2) { const float am = __uint_as_float(__hip_atomic_load((const unsigned*)(a.ws + WS_CTL) + CT_WSC + jd.sidx, __ATOMIC_RELAXED, __HIP_MEMORY_SCOPE_AGENT)); cu.qs = am > 0.f ? 127.0f / am : 0.f; }
    const float* sb = j < 2 ? a.in[8] : j < 4 ? a.in[10] : j < 6 ? a.in[12] : j < 8 ? a.in[25] : j == 8 ? a.in[26] : j == 9 ? a.in[27] : j == 10 ? a.in[28] : j == 11 ? a.in[30] : j == 12 ? a.in[31] : a.in[32];
    cu.src = sb + jd.src_off + (long long)bt * jd.src_bstride + (size_t)cu.k0 * jd.N + cu.n0;
    cu.dst = (bf16_t*)(a.ws + jd.dst_off + (long long)bt * jd.dst_bstride);
}
__device__ __forceinline__ int conv_row(int map, int n) {
    if (map == MAP_ID) return n;
    if (map == MAP_GU0) return ((n >> 7) << 8) + (n & 127);
    if (map == MAP_GU1) return ((n >> 7) << 8) + 128 + (n & 127);
    if (map == MAP_KV) { const int hh = n >> 8, jn = n & 255; return jn < 128 ? hh * 128 + jn : 1024 + hh * 128 + (jn - 128); }
    const int hh = n / 192, jn = n - hh * 192; if (jn < 128) return n; const int q = jn - 128; return hh * 192 + 128 + 2 * (q & 31) + (q >> 5);
}
constexpr int CV_P = 129;
#define CONV_LOAD(R, CU) do { const bool ok_ = (CU).n0 + (tid & 31) * 4 < (CU).N; _Pragma("unroll") for (int i_ = 0; i_ < 16; ++i_) { const int row_ = 2 * ((tid >> 5) + 16 * (i_ >> 1)) + (i_ & 1); \
        R[i_] = ok_ ? __builtin_nontemporal_load((const f32x4*)((CU).src + (size_t)row_ * (CU).N + (tid & 31) * 4)) : (f32x4){0.f, 0.f, 0.f, 0.f}; } } while (0)
#define CONV_PUT(R, T) do { _Pragma("unroll") for (int i_ = 0; i_ < 16; ++i_) { const int row_ = 2 * ((tid >> 5) + 16 * (i_ >> 1)) + (i_ & 1); float* tp_ = (T) + row_ * CV_P + (tid & 31) * 4; \
        tp_[0] = R[i_][0]; tp_[1] = R[i_][1]; tp_[2] = R[i_][2]; tp_[3] = R[i_][3]; } } while (0)
__device__ __forceinline__ void conv_out(const ConvUnit& cur, const float* tile, int tid) {
    if (cur.fp8 == 2) {
        const float qs = cur.qs;
#pragma unroll
        for (int j = 0; j < 4; ++j) { const int kc = (tid & 7) + 8 * (j & 1), n = (tid >> 3) + 64 * (j >> 1);
            if (cur.n0 + n < cur.N) { const int row = conv_row(cur.map, cur.n0 + n); const float* tp = tile + (kc * 16) * CV_P + n; u32x4 w;
                w.x = pack4_i8(tp[0] * qs, tp[CV_P] * qs, tp[2 * CV_P] * qs, tp[3 * CV_P] * qs); w.y = pack4_i8(tp[4 * CV_P] * qs, tp[5 * CV_P] * qs, tp[6 * CV_P] * qs, tp[7 * CV_P] * qs);
                w.z = pack4_i8(tp[8 * CV_P] * qs, tp[9 * CV_P] * qs, tp[10 * CV_P] * qs, tp[11 * CV_P] * qs); w.w = pack4_i8(tp[12 * CV_P] * qs, tp[13 * CV_P] * qs, tp[14 * CV_P] * qs, tp[15 * CV_P] * qs);
                *(u32x4*)((unsigned char*)cur.dst + (size_t)row * cur.K + cur.k0 + kc * 16) = w; } }
    } else if (cur.fp8) {
#pragma unroll
        for (int j = 0; j < 4; ++j) { const int kc = (tid & 7) + 8 * (j & 1), n = (tid >> 3) + 64 * (j >> 1);
            if (cur.n0 + n < cur.N) { const int row = conv_row(cur.map, cur.n0 + n); const float* tp = tile + (kc * 16) * CV_P + n; u32x4 w;
                w.x = pg8::pack4_fp8(tp[0] * WSCALE, tp[CV_P] * WSCALE, tp[2 * CV_P] * WSCALE, tp[3 * CV_P] * WSCALE); w.y = pg8::pack4_fp8(tp[4 * CV_P] * WSCALE, tp[5 * CV_P] * WSCALE, tp[6 * CV_P] * WSCALE, tp[7 * CV_P] * WSCALE);
                w.z = pg8::pack4_fp8(tp[8 * CV_P] * WSCALE, tp[9 * CV_P] * WSCALE, tp[10 * CV_P] * WSCALE, tp[11 * CV_P] * WSCALE); w.w = pg8::pack4_fp8(tp[12 * CV_P] * WSCALE, tp[13 * CV_P] * WSCALE, tp[14 * CV_P] * WSCALE, tp[15 * CV_P] * WSCALE);
                *(u32x4*)((unsigned char*)cur.dst + (size_t)row * cur.K + cur.k0 + kc * 16) = w; } }
    } else {
#pragma unroll
        for (int j = 0; j < 8; ++j) { const int kc = (tid & 7) + 8 * (j & 3), n = (tid >> 3) + 64 * (j >> 2);
            if (cur.n0 + n < cur.N) { const int row = conv_row(cur.map, cur.n0 + n); const float* tp = tile + (kc * 8) * CV_P + n; u32x4 w;
                w.x = pg8::cvt_pk_bf16(tp[0], tp[CV_P]); w.y = pg8::cvt_pk_bf16(tp[2 * CV_P], tp[3 * CV_P]); w.z = pg8::cvt_pk_bf16(tp[4 * CV_P], tp[5 * CV_P]); w.w = pg8::cvt_pk_bf16(tp[6 * CV_P], tp[7 * CV_P]);
                *(u32x4*)(cur.dst + (size_t)row * cur.K + cur.k0 + kc * 8) = w; } }
    }
}
template <int MODE = 0>
__device__ __forceinline__ void ph_convert(const Args& a, float* tile, int first, int stride, int end) {
    const int tid = threadIdx.x;
    int u = first; ConvUnit cuA, cuB; f32x4 rA[16], rB[16];
#pragma unroll
    for (int i = 0; i < 16; ++i) { rA[i] = (f32x4){0.f, 0.f, 0.f, 0.f}; rB[i] = rA[i]; }
    if (u < end) { conv_decode(a, u, cuA); if (MODE != 2) CONV_LOAD(rA, cuA); }
    if (u + stride < end) { conv_decode(a, u + stride, cuB); if (MODE != 2) CONV_LOAD(rB, cuB); }
    while (u < end) {
        CONV_PUT(rA, tile);
        __syncthreads();
        { const ConvUnit cur = cuA; const int un = u + 2 * stride; if (un < end) { conv_decode(a, un, cuA); if (MODE != 2) CONV_LOAD(rA, cuA); } if (MODE != 1) conv_out(cur, tile, tid); }
        __syncthreads();
        u += stride; if (u >= end) break;
        CONV_PUT(rB, tile);
        __syncthreads();
        { const ConvUnit cur = cuB; const int un = u + 2 * stride; if (un < end) { conv_decode(a, un, cuB); if (MODE != 2) CONV_LOAD(rB, cuB); } if (MODE != 1) conv_out(cur, tile, tid); }
        __syncthreads();
        u += stride;
    }
}
constexpr int CT_QNEXT = 1152;
template <int MODE = 0>
__device__ __forceinline__ void conv_dynamic(const Args& a, float* tile) {
    unsigned* qn = (unsigned*)(a.ws + WS_CTL) + CT_QNEXT; volatile int* bc = (volatile int*)(tile + 256 * CV_P + 4);
    const int tid = threadIdx.x;
    if (tid == 0) { bc[0] = (int)__hip_atomic_fetch_add(qn, 1u, __ATOMIC_RELAXED, __HIP_MEMORY_SCOPE_AGENT); bc[1] = (int)__hip_atomic_fetch_add(qn, 1u, __ATOMIC_RELAXED, __HIP_MEMORY_SCOPE_AGENT); }
    __syncthreads();
    int q = bc[0], qN = bc[1];
    __syncthreads();
    ConvUnit cuA, cuB; f32x4 rA[16], rB[16];
#pragma unroll
    for (int i = 0; i < 16; ++i) { rA[i] = (f32x4){0.f, 0.f, 0.f, 0.f}; rB[i] = rA[i]; }
    if (2 * q < NCONV) { conv_decode(a, 2 * q, cuA); if (MODE != 2) CONV_LOAD(rA, cuA); }
    if (2 * q + 1 < NCONV) { conv_decode(a, 2 * q + 1, cuB); if (MODE != 2) CONV_LOAD(rB, cuB); }
    while (2 * q < NCONV) {
        const bool hasB = 2 * q + 1 < NCONV;
        CONV_PUT(rA, tile);
        __syncthreads();
        { const ConvUnit cur = cuA; if (2 * qN < NCONV) { conv_decode(a, 2 * qN, cuA); if (MODE != 2) CONV_LOAD(rA, cuA); }
          if (tid == 0) bc[0] = (int)__hip_atomic_fetch_add(qn, 1u, __ATOMIC_RELAXED, __HIP_MEMORY_SCOPE_AGENT);
          if (MODE != 1) conv_out(cur, tile, tid); }
        __syncthreads();
        if (hasB) {
            CONV_PUT(rB, tile);
            __syncthreads();
            { const ConvUnit cur = cuB; if (2 * qN + 1 < NCONV) { conv_decode(a, 2 * qN + 1, cuB); if (MODE != 2) CONV_LOAD(rB, cuB); }
              if (MODE != 1) conv_out(cur, tile, tid); }
            __syncthreads();
        }
        q = qN; qN = bc[0];
    }
    __syncthreads();
}
#undef CONV_LOAD
#undef CONV_PUT
constexpr int CONV_STATIC = 856, CONV_DENSE_END = 1912, CONV_BATCH = 2;
__device__ __forceinline__ constexpr int CT_DONE(int k) { return 1216 + 64 * k; }
__device__ __forceinline__ void conv_fill(const Args& a, float* tile, int done_idx) {
#if !CONV_FILL
    (void)a; (void)tile; (void)done_idx; return;
#endif
    unsigned* ctl = (unsigned*)(a.ws + WS_CTL); volatile int* bc = (volatile int*)(tile + 256 * CV_P + 4);
    const int tid = threadIdx.x;
    if (tid == 0) (void)__hip_atomic_fetch_add(ctl + CT_DONE(done_idx), 1u, __ATOMIC_RELAXED, __HIP_MEMORY_SCOPE_AGENT);
    for (;;) {
        if (tid == 0) { int q = -1;
            if (__hip_atomic_load(ctl + CT_DONE(done_idx), __ATOMIC_RELAXED, __HIP_MEMORY_SCOPE_AGENT) < gridDim.x) {
                q = (int)__hip_atomic_fetch_add(ctl + CT_QNEXT, (unsigned)CONV_BATCH, __ATOMIC_RELAXED, __HIP_MEMORY_SCOPE_AGENT) + CONV_STATIC; if (q >= NCONV) q = -1; }
            *bc = q; }
        __syncthreads();
        const int q = *bc;
        __syncthreads();
        if (q < 0) break;
        ph_convert(a, tile, q, 1, (q + CONV_BATCH < NCONV) ? q + CONV_BATCH : NCONV);
    }
}
__device__ __forceinline__ void conv_finish(const Args& a, float* tile, int upto) {
#if !CONV_FILL
    (void)a; (void)tile; (void)upto; return;
#endif
    unsigned* ctl = (unsigned*)(a.ws + WS_CTL); volatile int* bc = (volatile int*)(tile + 256 * CV_P + 4);
    const int tid = threadIdx.x;
    for (;;) {
        if (tid == 0) { int q = -1;
            if ((int)__hip_atomic_load(ctl + CT_QNEXT, __ATOMIC_RELAXED, __HIP_MEMORY_SCOPE_AGENT) + CONV_STATIC < upto) {
                q = (int)__hip_atomic_fetch_add(ctl + CT_QNEXT, (unsigned)CONV_BATCH, __ATOMIC_RELAXED, __HIP_MEMORY_SCOPE_AGENT) + CONV_STATIC; if (q >= NCONV) q = -1; }
            *bc = q; }
        __syncthreads();
        const int q = *bc;
        __syncthreads();
        if (q < 0) break;
        ph_convert(a, tile, q, 1, (q + CONV_BATCH < NCONV) ? q + CONV_BATCH : NCONV);
    }
}
__device__ __forceinline__ void adaln_unit(const Args& a, int unit, float* sm) {
    const float* c = a.in[1]; const float* cctx = a.in[3]; const float* w_mod = a.in[4]; const float* b_mod = a.in[5]; float* mod = (float*)(a.ws + WS_MOD);
    const int tid = threadIdx.x, l = unit / 96, chunk = unit - l * 96;
    const int cg = tid & 31, ks = tid >> 5;
    for (int i = tid; i < 5 * 2048; i += 512) { const int v = i >> 11, k = i & 2047; const float val = v < 4 ? c[v * 2048 + k] : cctx[k]; sm[i] = val / (1.0f + __expf(-val)); }
    __syncthreads();
    float acc[5][4];
#pragma unroll
    for (int v = 0; v < 5; ++v)
#pragma unroll
        for (int j = 0; j < 4; ++j) acc[v][j] = 0.f;
    const float* wp = w_mod + ((size_t)l * 2048 + (size_t)ks * 128) * 12288 + chunk * 128 + cg * 4;
    for (int kb = 0; kb < 128; kb += 16) {
        f32x4 w[16];
#pragma unroll
        for (int kk = 0; kk < 16; ++kk) w[kk] = __builtin_nontemporal_load((const f32x4*)(wp + (size_t)(kb + kk) * 12288));
#pragma unroll
        for (int kk = 0; kk < 16; ++kk) { const int k = ks * 128 + kb + kk;
#pragma unroll
            for (int v = 0; v < 5; ++v) { const float s = sm[v * 2048 + k];
#pragma unroll
                for (int j = 0; j < 4; ++j) acc[v][j] += s * w[kk][j]; } }
    }
    __syncthreads();
#pragma unroll
    for (int v = 0; v < 5; ++v)
#pragma unroll
        for (int j = 0; j < 4; ++j) sm[(ks * 5 + v) * 128 + cg * 4 + j] = acc[v][j];
    __syncthreads();
    for (int o = tid; o < 640; o += 512) {
        const int v = o >> 7, cc = o & 127; float s = 0.f;
#pragma unroll
        for (int k2 = 0; k2 < 16; ++k2) s += sm[(k2 * 5 + v) * 128 + cc];
        mod[((size_t)l * 5 + v) * 12288 + chunk * 128 + cc] = s + b_mod[(size_t)l * 12288 + chunk * 128 + cc];
    }
    __syncthreads();
}
constexpr int FW_W1 = 0, FW_W2 = 2112, FW_W3 = 6208, FW_B1 = 10304, FW_B2 = 10368, FW_B3 = 10432, FW_FR = 10496, FW_ZS = 10560, FW_HA = 10848, FW_HB = 11360, FW_END = 11872;
__device__ __forceinline__ void filters_unit(const Args& a, int l, int r, float* sm) {
    float (*zs)[36] = (float (*)[36])(sm + FW_ZS); float (*ha)[64] = (float (*)[64])(sm + FW_HA); float (*hb)[64] = (float (*)[64])(sm + FW_HB);
    const int tid = threadIdx.x;
    const bool lat = r < 256; const int Lf = lat ? 2048 : 256; const int p0 = lat ? r * 8 : (r - 256) * 8;
    float* T = (float*)(a.ws + WS_FILTC) + (size_t)l * 512 * 512;
    const float* wf = a.in[21] + (size_t)l * 64 * 1024;
    const int p = tid >> 6, j = tid & 63; const int pos = p0 + p;
    const float tn = (float)pos / (float)(Lf - 1);
    if (j < 33) {
        float z;
        if (j == 0) z = tn;
        else { const int bi = (j - 1) & 15; const float band = 1e-4f + (float)bi * ((15.0f - 1e-4f) / 15.0f);
               const float ang = (6.283185307179586f / (float)Lf) * (float)pos * band; z = (j <= 16) ? __cosf(ang) : -__sinf(ang); }
        zs[p][j] = z;
    }
    __syncthreads();
    const float f = sm[FW_FR + j];
    { float s = sm[FW_B1 + j];
#pragma unroll
      for (int i = 0; i < 33; ++i) s += zs[p][i] * sm[FW_W1 + i * 64 + j];
      ha[p][j] = __sinf(f * s); }
    __syncthreads();
    { float s = sm[FW_B2 + j];
#pragma unroll 16
      for (int i = 0; i < 64; ++i) s += ha[p][i] * sm[FW_W2 + i * 64 + j];
      hb[p][j] = __sinf(f * s); }
    __syncthreads();
    { float s = sm[FW_B3 + j];
#pragma unroll 16
      for (int i = 0; i < 64; ++i) s += hb[p][i] * sm[FW_W3 + i * 64 + j];
      ha[p][j] = __sinf(f * s); }
    __syncthreads();
    float acc[2][8];
#pragma unroll
    for (int rr = 0; rr < 2; ++rr)
#pragma unroll
        for (int q = 0; q < 8; ++q) acc[rr][q] = 0.f;
    for (int ib = 0; ib < 64; ib += 16) {
        float wa[16], wb[16];
#pragma unroll
        for (int i = 0; i < 16; ++i) { wa[i] = wf[(ib + i) * 1024 + tid]; wb[i] = wf[(ib + i) * 1024 + 512 + tid]; }
#pragma unroll
        for (int i = 0; i < 16; ++i) {
#pragma unroll
            for (int q = 0; q < 8; ++q) { const float h = ha[q][ib + i]; acc[0][q] += h * wa[i]; acc[1][q] += h * wb[i]; } }
    }
    const int ch = tid;
    const float delta = 3.0701134573253944f + (float)ch * ((15.350567286626972f - 3.0701134573253944f) / 511.0f);
#pragma unroll
    for (int q = 0; q < 8; ++q) {
        const int ps = p0 + q; const float dec = __expf(-((float)ps / (float)(Lf - 1)) * delta);
        const float vf = acc[0][q] * dec, vb = acc[1][q] * dec;
        if (lat) { bf16_t* RBp = (bf16_t*)(a.ws + WS_FILTL) + ((size_t)l * 512 + ch) * HY_RBROW; RBp[2048 - ps] = f2bf(vf); if (ps > 0) RBp[2048 + ps] = f2bf(vb); }
        else { T[(size_t)ch * (2 * Lf) + Lf + ps] = vf; if (ps > 0) T[(size_t)ch * (2 * Lf) + Lf - ps] = vb; else T[(size_t)ch * (2 * Lf)] = 0.f; }
    }
    __syncthreads();
}
__device__ __forceinline__ void ph_filters(const Args& a, float* sm, int fb, int nfb) {
    const int tid = threadIdx.x;
    for (int l = 0; l < 2; ++l) {
        for (int i = tid; i < 2112; i += NTHR) sm[FW_W1 + i] = a.in[15][l * 2112 + i];
        for (int i = tid; i < 4096; i += NTHR) { sm[FW_W2 + i] = a.in[17][l * 4096 + i]; sm[FW_W3 + i] = a.in[19][l * 4096 + i]; }
        if (tid < 64) { sm[FW_B1 + tid] = a.in[16][l * 64 + tid]; sm[FW_B2 + tid] = a.in[18][l * 64 + tid]; sm[FW_B3 + tid] = a.in[20][l * 64 + tid]; sm[FW_FR + tid] = a.in[22][l * 64 + tid]; }
        __syncthreads();
        for (int r = fb; r < 288; r += nfb) filters_unit(a, l, r, sm);
        __syncthreads();
    }
}
#define SUBREP(b) for (int srep_ = 0; srep_ <= (int)((PROBE_SUB >> (b)) & 1u); ++srep_)
__device__ __forceinline__ void ph_absmax(const Args& a, float* sm) {
    unsigned* ctl = (unsigned*)(a.ws + WS_CTL); const int tid = threadIdx.x, G = gridDim.x, bid = blockIdx.x, lane = tid & 63, w = tid >> 6;
#pragma unroll
    for (int j = (I8_WIN ? 0 : 2); j < (I8_GU ? 4 : 2); ++j) {
        const f32x4* p4 = (const f32x4*)(j == 0 ? a.in[8] : j == 1 ? a.in[8] + (size_t)2048 * 3648 : j == 2 ? a.in[26] : a.in[27]);
        const int n4 = (j < 2 ? 2048 * 3648 : 2048 * 5632) / 4, step = G * 512;
        float mm = 0.f;
        for (int i0 = bid * 512 + tid; i0 < n4; i0 += step * 8) {
            f32x4 v[8];
#pragma unroll
            for (int u = 0; u < 8; ++u) { const int i = i0 + u * step; v[u] = i < n4 ? __builtin_nontemporal_load(p4 + i) : (f32x4){0.f, 0.f, 0.f, 0.f}; }
#pragma unroll
            for (int u = 0; u < 8; ++u) mm = fmaxf(mm, fmaxf(fmaxf(fabsf(v[u][0]), fabsf(v[u][1])), fmaxf(fabsf(v[u][2]), fabsf(v[u][3]))));
        }
        mm = wave_max(mm);
        if (lane == 0) sm[w] = mm;
        __syncthreads();
        if (tid == 0) { float t = sm[0];
#pragma unroll
            for (int k = 1; k < 8; ++k) t = fmaxf(t, sm[k]);
            (void)__hip_atomic_fetch_max(ctl + CT_WSC + j, __float_as_uint(t), __ATOMIC_RELAXED, __HIP_MEMORY_SCOPE_AGENT); }
        __syncthreads();
    }
    if (tid == 0) (void)__hip_atomic_fetch_add(ctl + CT_AMAXDONE, 1u, __ATOMIC_RELAXED, __HIP_MEMORY_SCOPE_AGENT);
}
__device__ __forceinline__ void ph_prologue(const Args& a, float* sm) {
    const int bid = blockIdx.x, G = gridDim.x, tid = threadIdx.x;
    const int NF = G >= 128 ? 64 : 0;
    if (I8_GEMM) ph_absmax(a, sm);
    if (NF == 0) { SUBREP(4) for (int u = bid; u < 192; u += G) adaln_unit(a, u, sm); SUBREP(5) ph_filters(a, sm, bid, G); }
    else if (bid < NF) { SUBREP(5) ph_filters(a, sm, bid, NF); }
    else { SUBREP(4) for (int u = bid - NF; u < 192; u += G - NF) adaln_unit(a, u, sm); }
    { float* cosT = (float*)(a.ws + WS_ROPE); float* sinT = cosT + 2048 * 32;
      for (int i = bid * 512 + tid; i < 2048 * 32; i += G * 512) { const int t = i >> 5, f = i & 31;
          const float pos = (float)((f < 16) ? (t >> 6) : (t & 63)); const float freq = powf(10000.0f, -(float)(f & 15) / 16.0f); const float ang = pos * freq;
          cosT[i] = cosf(ang); sinT[i] = sinf(ang); } }
    for (int i = bid * 512 + tid; i < 2 * 512 * 17; i += G * 512) { const int row = i / 17, k = i - row * 17; ((bf16_t*)(a.ws + WS_FILTL))[(size_t)row * HY_RBROW + (k == 0 ? 0 : 4095 + k)] = 0; }
    { constexpr int RB16 = I8_WIN ? 128 : 256;
      for (int i = bid * 512 + tid; i < 2 * 192 * RB16; i += G * 512) { const int l = i / (192 * RB16), r = i % (192 * RB16);
        *(u32x4*)(a.ws + WS_WIN + (size_t)l * UW * D * 2 + (size_t)INW * RB16 * 16 + (size_t)r * 16) = (u32x4){0u, 0u, 0u, 0u}; } }
    if (I8_GEMM) {
        if (tid == 0) { const unsigned* dn = (const unsigned*)(a.ws + WS_CTL) + CT_AMAXDONE; unsigned sp = 0;
            while (__hip_atomic_load(dn, __ATOMIC_RELAXED, __HIP_MEMORY_SCOPE_AGENT) < (unsigned)G && ++sp < (1u << 22)) __builtin_amdgcn_s_sleep(4); }
    }
    __syncthreads();
    if ((PROBE_SUB >> 8) & 1u) ph_convert<2>(a, sm, bid, G, NCONV);
    conv_dynamic<0>(a, sm);
    if ((PROBE_SUB >> 6) & 1u) ph_convert<0>(a, sm, bid, G, NCONV);
    if ((PROBE_SUB >> 7) & 1u) ph_convert<1>(a, sm, bid, G, NCONV);
}

template <bool ROUTER, bool COPYX, int OUT8 = 0, int NSLAB = 0>
__device__ __forceinline__ void ph_normmod(const float* __restrict__ xlat, const float* __restrict__ xctx, const float* __restrict__ gain, const float* __restrict__ modl, int sh_off, int sc_off,
                                           bf16_t* __restrict__ out, int nrows, float* __restrict__ xs, const float* __restrict__ router, int* __restrict__ topi, float* __restrict__ topw,
                                           const float* __restrict__ slab = nullptr, const float* __restrict__ slab_gate = nullptr, float* __restrict__ rsc = nullptr) {
    const int lane = threadIdx.x & 63, wid = threadIdx.x >> 6;
    for (int row = blockIdx.x * 8 + wid; row < nrows; row += gridDim.x * 8) {
        const float* xr = row < NLAT ? xlat + (size_t)row * D : xctx + (size_t)(row - NLAT) * D;
        const float* mv = modl + (size_t)tok_mod(row) * 12288;
        f32x4 v[8]; float ss = 0.f;
#pragma unroll
        for (int i = 0; i < 8; ++i) { v[i] = *(const f32x4*)(xr + i * 256 + lane * 4);
            if (NSLAB > 0 && row >= NLAT) { f32x4 sa = *(const f32x4*)(slab + (size_t)(row - NLAT) * D + i * 256 + lane * 4);
#pragma unroll
                for (int sl = 1; sl < NSLAB; ++sl) sa += *(const f32x4*)(slab + ((size_t)sl * NCTX + (row - NLAT)) * D + i * 256 + lane * 4);
                v[i] += *(const f32x4*)(slab_gate + i * 256 + lane * 4) * sa; }
            ss += v[i][0] * v[i][0] + v[i][1] * v[i][1] + v[i][2] * v[i][2] + v[i][3] * v[i][3];
            if (COPYX && (NSLAB == 0 || row >= NLAT)) *(f32x4*)(xs + (size_t)row * D + i * 256 + lane * 4) = v[i]; }
        ss = wave_sum(ss);
        const float rstd = rsqrtf(ss * (1.0f / D) + EPS);
        float lg[8];
#pragma unroll
        for (int e = 0; e < 8; ++e) lg[e] = 0.f;
        float amax = 0.f;
#pragma unroll
        for (int i = 0; i < 8; ++i) {
            const int col = i * 256 + lane * 4;
            const f32x4 g = *(const f32x4*)(gain + col), sc = *(const f32x4*)(mv + sc_off + col), sh = *(const f32x4*)(mv + sh_off + col);
            f32x4 o;
#pragma unroll
            for (int j = 0; j < 4; ++j) o[j] = (v[i][j] * rstd * g[j]) * (1.0f + sc[j]) + sh[j];
            if (OUT8 == 2) { v[i] = o; amax = fmaxf(amax, fmaxf(fmaxf(fabsf(o[0]), fabsf(o[1])), fmaxf(fabsf(o[2]), fabsf(o[3])))); }
            else if (OUT8 == 1) *(unsigned*)((unsigned char*)out + (size_t)row * D + col) = pg8::pack4_fp8(o[0] * ASCALE, o[1] * ASCALE, o[2] * ASCALE, o[3] * ASCALE);
            else { u32x2 w; w.x = (unsigned)f2bf(o[0]) | ((unsigned)f2bf(o[1]) << 16); w.y = (unsigned)f2bf(o[2]) | ((unsigned)f2bf(o[3]) << 16);
                *(u32x2*)(out + (size_t)row * D + col) = w; }
            if (ROUTER) {
#pragma unroll
                for (int j = 0; j < 4; ++j) { const f32x4 r0 = *(const f32x4*)(router + (size_t)(col + j) * 8), r1 = *(const f32x4*)(router + (size_t)(col + j) * 8 + 4);
                    lg[0] += o[j] * r0[0]; lg[1] += o[j] * r0[1]; lg[2] += o[j] * r0[2]; lg[3] += o[j] * r0[3];
                    lg[4] += o[j] * r1[0]; lg[5] += o[j] * r1[1]; lg[6] += o[j] * r1[2]; lg[7] += o[j] * r1[3]; }
                asm volatile("" ::: "memory");
            }
        }
        if (OUT8 == 2) {
            amax = wave_max(amax); const float qs = amax > 0.f ? 127.0f / amax : 0.f;
#pragma unroll
            for (int i = 0; i < 8; ++i) *(unsigned*)((unsigned char*)out + (size_t)row * D + i * 256 + lane * 4) = pack4_i8(v[i][0] * qs, v[i][1] * qs, v[i][2] * qs, v[i][3] * qs);
            if (lane == 0) rsc[row] = amax * (1.0f / 127.0f);
        }
        if (ROUTER) {
#pragma unroll
            for (int e = 0; e < 8; ++e) lg[e] = wave_sum(lg[e]);
            if (lane == 0) {
                int i0 = 0; float v0 = lg[0];
#pragma unroll
                for (int e = 1; e < 8; ++e) if (lg[e] > v0) { v0 = lg[e]; i0 = e; }
                int i1 = -1; float v1 = -3.0e38f;
#pragma unroll
                for (int e = 0; e < 8; ++e) if (e != i0 && lg[e] > v1) { v1 = lg[e]; i1 = e; }
                const float e1 = expf(v1 - v0), w0 = 1.0f / (1.0f + e1), w1 = e1 / (1.0f + e1);
                topi[row * 2] = i0; topi[row * 2 + 1] = i1; topw[row * 2] = w0; topw[row * 2 + 1] = w1;
            }
        }
    }
}

__device__ __forceinline__ float bflo(unsigned w) { return __uint_as_float(w << 16); }
__device__ __forceinline__ float bfhi(unsigned w) { return __uint_as_float(w & 0xffff0000u); }
__device__ __forceinline__ unsigned pkbf(float lo, float hi) { return (unsigned)f2bf(lo) | ((unsigned)f2bf(hi) << 16); }
__device__ __forceinline__ u32x4 rope8(const u32x4 mine, const u32x4 other, bool is_x2, const f32x4 c0, const f32x4 c1, const f32x4 s0, const f32x4 s1) {
    const unsigned mw[4] = {mine.x, mine.y, mine.z, mine.w}, ow[4] = {other.x, other.y, other.z, other.w};
    const float cs[8] = {c0[0], c0[1], c0[2], c0[3], c1[0], c1[1], c1[2], c1[3]}, sn[8] = {s0[0], s0[1], s0[2], s0[3], s1[0], s1[1], s1[2], s1[3]};
    unsigned o[4];
#pragma unroll
    for (int d = 0; d < 4; ++d) {
        const float m0 = bflo(mw[d]), m1 = bfhi(mw[d]), p0 = bflo(ow[d]), p1 = bfhi(ow[d]);
        const float r0 = is_x2 ? (p0 * sn[2 * d] + m0 * cs[2 * d]) : (m0 * cs[2 * d] - p0 * sn[2 * d]);
        const float r1 = is_x2 ? (p1 * sn[2 * d + 1] + m1 * cs[2 * d + 1]) : (m1 * cs[2 * d + 1] - p1 * sn[2 * d + 1]);
        o[d] = pkbf(r0, r1);
    }
    return (u32x4){o[0], o[1], o[2], o[3]};
}
__device__ __forceinline__ u32x4 shfl4(const u32x4 v, int m) { return (u32x4){(unsigned)__shfl_xor((int)v.x, m), (unsigned)__shfl_xor((int)v.y, m), (unsigned)__shfl_xor((int)v.z, m), (unsigned)__shfl_xor((int)v.w, m)}; }
__device__ __forceinline__ void ph_mid(const Args& a, int l) {
    const bf16_t* __restrict__ U = (const bf16_t*)(a.ws + WS_U);
    const float* g_q = a.in[9] + l * 768; const float* g_kv = a.in[11] + l * 512; const float* conv_w = a.in[13] + (size_t)l * 3 * 1536; const float* conv_b = a.in[14] + l * 1536;
    const float* cosT = (const float*)(a.ws + WS_ROPE); const float* sinT = cosT + 2048 * 32;
    bf16_t* cqn = (bf16_t*)(a.ws + WS_CQN); bf16_t* ckvn = (bf16_t*)(a.ws + WS_CKVN); bf16_t* kpe = (bf16_t*)(a.ws + WS_KPE); bf16_t* x0o = (bf16_t*)(a.ws + WS_X0);
    bf16_t* wtl = (bf16_t*)(a.ws + WS_WTL); bf16_t* wtc = (bf16_t*)(a.ws + WS_WTC); bf16_t* sq = (bf16_t*)(a.ws + WS_SQ); bf16_t* sk = (bf16_t*)(a.ws + WS_SK); bf16_t* sv = (bf16_t*)(a.ws + WS_SV);
    int tid_ = threadIdx.x; asm volatile("" : "+v"(tid_));
    const int tid = tid_, lane = tid & 63, wid = tid >> 6;
    for (int unit = blockIdx.x; unit < NTOK / 16; unit += gridDim.x) {
        const int tok0 = unit * 16;
        for (int tt = 0; tt < 2; ++tt) {
            const int tok = tok0 + wid * 2 + tt; const bool lat = tok < NLAT; const int t = lat ? (tok & 2047) : ((tok - NLAT) & 255);
            const bf16_t* u = U + (size_t)tok * UW;
            const u32x2 q0 = *(const u32x2*)(u + O_CQ + lane * 12), q1 = *(const u32x2*)(u + O_CQ + lane * 12 + 4), q2 = *(const u32x2*)(u + O_CQ + lane * 12 + 8);
            const u32x4 kvv = *(const u32x4*)(u + O_CKV + lane * 8);
            const u32x4 sqv = *(const u32x4*)(u + O_SQ + lane * 8);
            const u32x4 skv = *(const u32x4*)(u + O_SK + (lane & 15) * 8);
            const u32x4 kpv = *(const u32x4*)(u + O_KPE + (lane & 7) * 8);
            const int i0 = (lane & 3) * 8;
            f32x4 c0 = (f32x4){1.f, 1.f, 1.f, 1.f}, c1 = c0, s0 = (f32x4){0.f, 0.f, 0.f, 0.f}, s1 = s0;
            if (lat) { c0 = *(const f32x4*)(cosT + t * 32 + i0); c1 = *(const f32x4*)(cosT + t * 32 + i0 + 4); s0 = *(const f32x4*)(sinT + t * 32 + i0); s1 = *(const f32x4*)(sinT + t * 32 + i0 + 4); }
            {
                const unsigned w6[6] = {q0.x, q0.y, q1.x, q1.y, q2.x, q2.y}; float x[12]; float ss = 0.f;
#pragma unroll
                for (int d = 0; d < 6; ++d) { x[2 * d] = bflo(w6[d]); x[2 * d + 1] = bfhi(w6[d]); ss += x[2 * d] * x[2 * d] + x[2 * d + 1] * x[2 * d + 1]; }
                ss = wave_sum(ss); const float rs = rsqrtf(ss * (1.0f / 768.0f) + EPS);
                const f32x4 g0 = *(const f32x4*)(g_q + lane * 12), g1 = *(const f32x4*)(g_q + lane * 12 + 4), g2 = *(const f32x4*)(g_q + lane * 12 + 8);
                u32x2 o0, o1, o2;
                o0.x = pkbf(x[0] * rs * g0[0], x[1] * rs * g0[1]); o0.y = pkbf(x[2] * rs * g0[2], x[3] * rs * g0[3]);
                o1.x = pkbf(x[4] * rs * g1[0], x[5] * rs * g1[1]); o1.y = pkbf(x[6] * rs * g1[2], x[7] * rs * g1[3]);
                o2.x = pkbf(x[8] * rs * g2[0], x[9] * rs * g2[1]); o2.y = pkbf(x[10] * rs * g2[2], x[11] * rs * g2[3]);
                bf16_t* dst = cqn + (size_t)tok * 768 + lane * 12; *(u32x2*)dst = o0; *(u32x2*)(dst + 4) = o1; *(u32x2*)(dst + 8) = o2;
            }
            {
                const unsigned w4[4] = {kvv.x, kvv.y, kvv.z, kvv.w}; float x[8]; float ss = 0.f;
#pragma unroll
                for (int d = 0; d < 4; ++d) { x[2 * d] = bflo(w4[d]); x[2 * d + 1] = bfhi(w4[d]); ss += x[2 * d] * x[2 * d] + x[2 * d + 1] * x[2 * d + 1]; }
                ss = wave_sum(ss); const float rs = rsqrtf(ss * (1.0f / 512.0f) + EPS);
                const f32x4 g0 = *(const f32x4*)(g_kv + lane * 8), g1 = *(const f32x4*)(g_kv + lane * 8 + 4);
                u32x4 o; o.x = pkbf(x[0] * rs * g0[0], x[1] * rs * g0[1]); o.y = pkbf(x[2] * rs * g0[2], x[3] * rs * g0[3]); o.z = pkbf(x[4] * rs * g1[0], x[5] * rs * g1[1]); o.w = pkbf(x[6] * rs * g1[2], x[7] * rs * g1[3]);
                *(u32x4*)(ckvn + (size_t)tok * 512 + lane * 8) = o;
            }
            const bool is_x2 = (lane & 4) != 0;
            {
                const u32x4 r = rope8(sqv, shfl4(sqv, 4), is_x2, c0, c1, s0, s1);
                *(u32x4*)(sq + (size_t)tok * 512 + lane * 8) = r;
            }
            {
                const u32x4 r = rope8(skv, shfl4(skv, 4), is_x2, c0, c1, s0, s1);
                if (lane < 16) *(u32x4*)(sk + (size_t)tok * 128 + lane * 8) = r;
            }
            {
                const u32x4 ot = shfl4(kpv, 4);
                if (lane < 4) {
                    const unsigned mw[4] = {kpv.x, kpv.y, kpv.z, kpv.w}, ow[4] = {ot.x, ot.y, ot.z, ot.w};
                    const float cs[8] = {c0[0], c0[1], c0[2], c0[3], c1[0], c1[1], c1[2], c1[3]}, sn[8] = {s0[0], s0[1], s0[2], s0[3], s1[0], s1[1], s1[2], s1[3]};
                    unsigned o[8];
#pragma unroll
                    for (int d = 0; d < 4; ++d) { const float a0 = bflo(mw[d]), a1 = bfhi(mw[d]), b0 = bflo(ow[d]), b1 = bfhi(ow[d]);
                        o[2 * d] = pkbf(a0 * cs[2 * d] - b0 * sn[2 * d], a0 * sn[2 * d] + b0 * cs[2 * d]);
                        o[2 * d + 1] = pkbf(a1 * cs[2 * d + 1] - b1 * sn[2 * d + 1], a1 * sn[2 * d + 1] + b1 * cs[2 * d + 1]); }
                    bf16_t* dst = kpe + (size_t)tok * 64 + lane * 16;
                    *(u32x4*)dst = (u32x4){o[0], o[1], o[2], o[3]}; *(u32x4*)(dst + 8) = (u32x4){o[4], o[5], o[6], o[7]};
                }
            }
        }
        {
            const bool lat = tok0 < NLAT; const int Ls = lat ? L : C;
            const int b = lat ? (tok0 >> 11) : ((tok0 - NLAT) >> 8), t0 = (lat ? (tok0 & 2047) : ((tok0 - NLAT) & 255));
            const int cp = tid & 255, hf = tid >> 8, ch = cp * 2, ts = t0 + hf * 8, tokb = tok0 + hf * 8;
            float cw[3][3][2], cb[3][2];
#pragma unroll
            for (int g = 0; g < 3; ++g) { cb[g][0] = conv_b[g * 512 + ch]; cb[g][1] = conv_b[g * 512 + ch + 1];
#pragma unroll
                for (int j = 0; j < 3; ++j) { cw[g][j][0] = conv_w[j * 1536 + g * 512 + ch]; cw[g][j][1] = conv_w[j * 1536 + g * 512 + ch + 1]; } }
            unsigned rows[3][10];
#pragma unroll
            for (int r = 0; r < 10; ++r) { const int tr = ts - 1 + r; const bool ok = tr >= 0 && tr < Ls;
#pragma unroll
                for (int g = 0; g < 3; ++g) rows[g][r] = ok ? *(const unsigned*)(U + (size_t)(tokb - 1 + r) * UW + O_HY + g * 512 + ch) : 0u; }
            unsigned wp0[4], wp1[4];
#pragma unroll
            for (int i = 0; i < 8; ++i) {
                float y[3][2];
#pragma unroll
                for (int g = 0; g < 3; ++g) {
                    y[g][0] = cb[g][0] + cw[g][0][0] * bflo(rows[g][i]) + cw[g][1][0] * bflo(rows[g][i + 1]) + cw[g][2][0] * bflo(rows[g][i + 2]);
                    y[g][1] = cb[g][1] + cw[g][0][1] * bfhi(rows[g][i]) + cw[g][1][1] * bfhi(rows[g][i + 1]) + cw[g][2][1] * bfhi(rows[g][i + 2]); }
                *(unsigned*)(x0o + (size_t)(tokb + i) * 512 + ch) = pkbf(y[0][0], y[0][1]);
                const unsigned w0 = f2bf(y[2][0] * y[1][0]), w1 = f2bf(y[2][1] * y[1][1]);
                if (i & 1) { wp0[i >> 1] |= w0 << 16; wp1[i >> 1] |= w1 << 16; } else { wp0[i >> 1] = w0; wp1[i >> 1] = w1; }
            }
            bf16_t* wt = lat ? wtl + ((size_t)b * 512 + ch) * L + ts : wtc + ((size_t)b * 512 + ch) * C + ts;
            *(u32x4*)wt = (u32x4){wp0[0], wp0[1], wp0[2], wp0[3]};
            *(u32x4*)(wt + (lat ? L : C)) = (u32x4){wp1[0], wp1[1], wp1[2], wp1[3]};
        }
        if (tid < 128) {
            unsigned pk[8];
#pragma unroll
            for (int i = 0; i < 16; ++i) { const unsigned v = U[(size_t)(tok0 + i) * UW + O_SV + tid]; if (i & 1) pk[i >> 1] |= v << 16; else pk[i >> 1] = v; }
            bf16_t* dst = sv + (size_t)tid * NTOK + tok0;
            u32x4 w0, w1; w0.x = pk[0]; w0.y = pk[1]; w0.z = pk[2]; w0.w = pk[3]; w1.x = pk[4]; w1.y = pk[5]; w1.z = pk[6]; w1.w = pk[7];
            *(u32x4*)dst = w0; *(u32x4*)(dst + 8) = w1;
        }
    }
}

__device__ __forceinline__ void ph_mla_naive(const Args& a, int nq, float* sm) {
    const bf16_t* __restrict__ Q = (const bf16_t*)(a.ws + WS_Q); const bf16_t* __restrict__ KV = (const bf16_t*)(a.ws + WS_KV); const bf16_t* __restrict__ KPE = (const bf16_t*)(a.ws + WS_KPE);
    bf16_t* mix = (bf16_t*)(a.ws + WS_MIX);
    const int lane = threadIdx.x & 63, w = threadIdx.x >> 6;
    float* qf = sm + w * 192; float* sc = sm + 8 * 192 + w * 2304;
    for (int unit = blockIdx.x; unit < nq; unit += gridDim.x) {
        const int h = unit & 7, qt = (unit >> 3) * 8 + w; const bool lat = qt < NLAT;
        const int b = lat ? (qt >> 11) : ((qt - NLAT) >> 8);
        const int nk = lat ? (L + C) : C;
        for (int i = lane; i < 192; i += 64) qf[i] = bf2f(Q[(size_t)qt * QW + h * 192 + i]);
        __syncthreads();
        const float scale = 0.07216878364870322f;
        float mx = -3.0e38f;
        for (int kc = 0; kc < nk; kc += 64) {
            const int kk = kc + lane;
            const int kt = lat ? (kk < L ? b * L + kk : NLAT + b * C + (kk - L)) : (NLAT + b * C + kk);
            float s = 0.f;
            const u32x4* kp = (const u32x4*)(KV + (size_t)kt * KVW + h * 256);
            for (int i = 0; i < 16; ++i) { const u32x4 v = kp[i]; const float* q8 = qf + i * 8;
                s += q8[0] * __uint_as_float(v.x << 16) + q8[1] * __uint_as_float(v.x & 0xffff0000u) + q8[2] * __uint_as_float(v.y << 16) + q8[3] * __uint_as_float(v.y & 0xffff0000u)
                   + q8[4] * __uint_as_float(v.z << 16) + q8[5] * __uint_as_float(v.z & 0xffff0000u) + q8[6] * __uint_as_float(v.w << 16) + q8[7] * __uint_as_float(v.w & 0xffff0000u); }
            const u32x4* pp = (const u32x4*)(KPE + (size_t)kt * 64);
            for (int i = 0; i < 8; ++i) { const u32x4 v = pp[i]; const float* q8 = qf + 128 + i * 8;
                s += q8[0] * __uint_as_float(v.x << 16) + q8[1] * __uint_as_float(v.x & 0xffff0000u) + q8[2] * __uint_as_float(v.y << 16) + q8[3] * __uint_as_float(v.y & 0xffff0000u)
                   + q8[4] * __uint_as_float(v.z << 16) + q8[5] * __uint_as_float(v.z & 0xffff0000u) + q8[6] * __uint_as_float(v.w << 16) + q8[7] * __uint_as_float(v.w & 0xffff0000u); }
            s *= scale; sc[kk] = s; mx = fmaxf(mx, s);
        }
        mx = wave_max(mx);
        float sum = 0.f;
        for (int kc = 0; kc < nk; kc += 64) { const float p = expf(sc[kc + lane] - mx); sc[kc + lane] = p; sum += p; }
        sum = wave_sum(sum);
        __syncthreads();
        float o0 = 0.f, o1 = 0.f;
        for (int kk = 0; kk < nk; ++kk) {
            const int kt = lat ? (kk < L ? b * L + kk : NLAT + b * C + (kk - L)) : (NLAT + b * C + kk);
            const unsigned v = *(const unsigned*)(KV + (size_t)kt * KVW + h * 256 + 128 + lane * 2);
            const float p = sc[kk];
            o0 += p * __uint_as_float(v << 16); o1 += p * __uint_as_float(v & 0xffff0000u);
        }
        const float inv = 1.0f / sum;
        *(unsigned*)(mix + (size_t)qt * D + h * 128 + lane * 2) = (unsigned)f2bf(o0 * inv) | ((unsigned)f2bf(o1 * inv) << 16);
        __syncthreads();
    }
}
__device__ __forceinline__ void ph_swa_naive(const Args& a, int l, int nq, float* sm) {
    const bf16_t* __restrict__ SQ = (const bf16_t*)(a.ws + WS_SQ); const bf16_t* __restrict__ SK = (const bf16_t*)(a.ws + WS_SK); const bf16_t* __restrict__ SV = (const bf16_t*)(a.ws + WS_SV);
    const float* sink = a.in[24] + l * 8; bf16_t* mix = (bf16_t*)(a.ws + WS_MIX);
    const int lane = threadIdx.x & 63, w = threadIdx.x >> 6;
    float* qf = sm + w * 64; float* sc = sm + 8 * 64 + w * 576; int* kts = (int*)(sm + 8 * 64 + 8 * 576) + w * 576;
    for (int unit = blockIdx.x; unit < nq; unit += gridDim.x) {
        const int hq = unit & 7, hk = hq >> 2, qt = (unit >> 3) * 8 + w; const bool lat = qt < NLAT;
        const int b = lat ? (qt >> 11) : ((qt - NLAT) >> 8), t = lat ? (qt & 2047) : 0;
        int lo = 0, nloc = 0;
        if (lat) { lo = t - 128 < 0 ? 0 : t - 128; const int hi = t + 128 > L - 1 ? L - 1 : t + 128; nloc = hi - lo + 1; }
        const int nk = nloc + C;
        qf[lane] = bf2f(SQ[(size_t)qt * 512 + hq * 64 + lane]);
        __syncthreads();
        const float skv = sink[hq];
        float mx = skv;
        for (int kc = 0; kc < nk; kc += 64) {
            const int kk = kc + lane;
            if (kk < nk) {
                const int kt = kk < nloc ? (b * L + lo + kk) : (NLAT + b * C + (kk - nloc));
                const u32x4* kp = (const u32x4*)(SK + (size_t)kt * 128 + hk * 64);
                float s = 0.f;
                for (int i = 0; i < 8; ++i) { const u32x4 v = kp[i]; const float* q8 = qf + i * 8;
                    s += q8[0] * __uint_as_float(v.x << 16) + q8[1] * __uint_as_float(v.x & 0xffff0000u) + q8[2] * __uint_as_float(v.y << 16) + q8[3] * __uint_as_float(v.y & 0xffff0000u)
                       + q8[4] * __uint_as_float(v.z << 16) + q8[5] * __uint_as_float(v.z & 0xffff0000u) + q8[6] * __uint_as_float(v.w << 16) + q8[7] * __uint_as_float(v.w & 0xffff0000u); }
                s *= 0.125f; sc[kk] = s; kts[kk] = kt; mx = fmaxf(mx, s);
            }
        }
        mx = wave_max(mx);
        float sum = 0.f;
        for (int kc = 0; kc < nk; kc += 64) { const int kk = kc + lane; if (kk < nk) { const float p = expf(sc[kk] - mx); sc[kk] = p; sum += p; } }
        sum = wave_sum(sum) + expf(skv - mx);
        __syncthreads();
        float o = 0.f;
        for (int kk = 0; kk < nk; ++kk) o += sc[kk] * bf2f(SV[(size_t)kts[kk] * 128 + hk * 64 + lane]);
        mix[(size_t)qt * D + 1536 + hq * 64 + lane] = f2bf(o / sum);
        __syncthreads();
    }
}
template <int LS>
__device__ __forceinline__ void ph_hyena_naive(const Args& a, int l, float* sm) {
    const float* filt = LS == L ? (const float*)(a.ws + WS_FILTL) + (size_t)l * 512 * 4096 : (const float*)(a.ws + WS_FILTC) + (size_t)l * 512 * 512;
    const bf16_t* wt = (const bf16_t*)(a.ws + (LS == L ? WS_WTL : WS_WTC)); const bf16_t* x0 = (const bf16_t*)(a.ws + WS_X0); const float* skip = a.in[23] + l * 512;
    bf16_t* mix = (bf16_t*)(a.ws + WS_MIX); const int tok_base = LS == L ? 0 : NLAT;
    float* T = sm; float* ws = sm + 2 * LS; const int tid = threadIdx.x;
    for (int unit = blockIdx.x; unit < 512 * NB; unit += gridDim.x) {
        const int ch = unit >> 2, b = unit & 3;
        for (int i = tid; i < 2 * LS; i += NTHR) T[i] = filt[(size_t)ch * 2 * LS + i];
        for (int i = tid; i < LS; i += NTHR) ws[i] = bf2f(wt[((size_t)b * 512 + ch) * LS + i]);
        __syncthreads();
        const float sk = skip[ch];
        for (int t = tid; t < LS; t += NTHR) {
            float y = 0.f;
            for (int s = 0; s < LS; ++s) y += T[t - s + LS] * ws[s];
            ((bf16_t*)(a.ws + WS_YT))[(LS == L ? (size_t)0 : (size_t)NB * 512 * L) + ((size_t)b * 512 + ch) * LS + t] = f2bf(y);
        }
        __syncthreads();
    }
}
__device__ __forceinline__ void ph_route_gather(const Args& a, int* sm) {
    const int* __restrict__ topi = (const int*)(a.ws + WS_TOPI); int* __restrict__ pos = (int*)(a.ws + WS_POS); int* ctl = (int*)(a.ws + WS_CTL);
    const unsigned char* __restrict__ hb = (const unsigned char*)(a.ws + WS_HA); unsigned char* __restrict__ hbs = (unsigned char*)(a.ws + WS_HBS);
    int (*cnt)[512] = (int (*)[512])sm; int* tot = sm + 8 * 512; int* ppos = sm + 8 * 512 + 16;
    const int tid = threadIdx.x, lane = tid & 63, w = tid >> 6;
    int c[8];
#pragma unroll
    for (int e = 0; e < 8; ++e) c[e] = 0;
    for (int i = 0; i < 32; i += 4) { const u32x4 e4 = *(const u32x4*)(topi + tid * 32 + i);
#pragma unroll
        for (int q = 0; q < 8; ++q) c[q] += (e4.x == (unsigned)q) + (e4.y == (unsigned)q) + (e4.z == (unsigned)q) + (e4.w == (unsigned)q); }
#pragma unroll
    for (int e = 0; e < 8; ++e) cnt[e][tid] = c[e];
    __syncthreads();
    {
        int v[8]; int s8 = 0;
#pragma unroll
        for (int k = 0; k < 8; ++k) { v[k] = cnt[w][lane * 8 + k]; s8 += v[k]; }
        int incl = s8;
#pragma unroll
        for (int off = 1; off < 64; off <<= 1) { const int t = __shfl_up(incl, off); if (lane >= off) incl += t; }
        int run = incl - s8;
#pragma unroll
        for (int k = 0; k < 8; ++k) { cnt[w][lane * 8 + k] = run; run += v[k]; }
        if (lane == 63) tot[w] = incl;
    }
    __syncthreads();
    int eoff[8]; int o = 0;
#pragma unroll
    for (int e = 0; e < 8; ++e) { eoff[e] = o; o += (tot[e] + 255) & ~255; }
    if (blockIdx.x == 0 && tid == 0) {
#pragma unroll
        for (int e = 0; e < 8; ++e) { ctl[CT_EOFF + e] = eoff[e]; ctl[CT_EPAD + e] = (tot[e] + 255) & ~255; }
        ctl[CT_NTILE] = o >> 8; const int nwg = (o >> 8) * (D / 256); ctl[CT_MOES] = pg8::split_S(nwg, DFE / 128, 256); ctl[CT_TROW] = (nwg / 256) * 256 / (D / 256) * 256;
    }
    for (int tg = blockIdx.x; tg < NLAT / 32; tg += gridDim.x) {
        if (tid < 64) {
            const int idx = 64 * tg + tid, owner = idx >> 5, e = topi[idx]; int p = 0;
#pragma unroll
            for (int q = 0; q < 8; ++q) { const unsigned long long mk = __ballot(e == q);
                if (e == q) { const unsigned hm = (unsigned)(mk >> (32 * (tid >> 5))); p = eoff[q] + cnt[q][owner] + __popc(hm & ((1u << (tid & 31)) - 1u)); } }
            pos[idx] = p; ppos[tid] = p;
        }
        __syncthreads();
#pragma unroll
        for (int k = 0; k < 4; ++k) { const int tl = 4 * w + k; const int tok = 32 * tg + tl;
            const u32x4 v0 = *(const u32x4*)(hb + (size_t)tok * D + lane * 32), v1 = *(const u32x4*)(hb + (size_t)tok * D + lane * 32 + 16);
            const int p0 = ppos[2 * tl], p1 = ppos[2 * tl + 1];
            *(u32x4*)(hbs + (size_t)p0 * D + lane * 32) = v0; *(u32x4*)(hbs + (size_t)p0 * D + lane * 32 + 16) = v1;
            *(u32x4*)(hbs + (size_t)p1 * D + lane * 32) = v0; *(u32x4*)(hbs + (size_t)p1 * D + lane * 32 + 16) = v1; }
        __syncthreads();
    }
}
__device__ __forceinline__ void ph_final(const Args& a) {
    const float* xs = (const float*)(a.ws + WS_XS); const bf16_t* ys = (const bf16_t*)(a.ws + WS_YS); const int* pos = (const int*)(a.ws + WS_POS); const float* topw = (const float*)(a.ws + WS_TOPW);
    const float* modl = (const float*)(a.ws + WS_MOD) + (size_t)5 * 12288; const float* gfin = a.in[33]; float* out = a.out;
    const int lane = threadIdx.x & 63, wid = threadIdx.x >> 6;
    const int* ctl = (const int*)(a.ws + WS_CTL); const int nsl = ctl[CT_MOES], trow0 = ctl[CT_TROW], trows = ctl[CT_NTILE] * 256 - trow0; const float* slab = (const float*)(a.ws + WS_SLAB);
    for (int row = blockIdx.x * 8 + wid; row < NLAT; row += gridDim.x * 8) {
        const float* g2 = modl + (size_t)tok_mod(row) * 12288 + 10240;
        const int p0 = pos[row * 2], p1 = pos[row * 2 + 1]; const float w0 = topw[row * 2], w1 = topw[row * 2 + 1];
        const bool t0 = nsl > 1 && p0 >= trow0, t1 = nsl > 1 && p1 >= trow0;
        f32x4 v[8]; float ss = 0.f;
#pragma unroll
        for (int i = 0; i < 8; ++i) { const int col = i * 256 + lane * 4;
            const f32x4 x = *(const f32x4*)(xs + (size_t)row * D + col), g = *(const f32x4*)(g2 + col); f32x4 ya, yb;
            if (t0) { ya = *(const f32x4*)(slab + (size_t)(p0 - trow0) * D + col); for (int sl = 1; sl < nsl; ++sl) ya += *(const f32x4*)(slab + ((size_t)sl * trows + (p0 - trow0)) * D + col); }
            else { const u32x2 q = *(const u32x2*)(ys + (size_t)p0 * D + col); ya = (f32x4){__uint_as_float(q.x << 16), __uint_as_float(q.x & 0xffff0000u), __uint_as_float(q.y << 16), __uint_as_float(q.y & 0xffff0000u)}; }
            if (t1) { yb = *(const f32x4*)(slab + (size_t)(p1 - trow0) * D + col); for (int sl = 1; sl < nsl; ++sl) yb += *(const f32x4*)(slab + ((size_t)sl * trows + (p1 - trow0)) * D + col); }
            else { const u32x2 q = *(const u32x2*)(ys + (size_t)p1 * D + col); yb = (f32x4){__uint_as_float(q.x << 16), __uint_as_float(q.x & 0xffff0000u), __uint_as_float(q.y << 16), __uint_as_float(q.y & 0xffff0000u)}; }
#pragma unroll
            for (int j = 0; j < 4; ++j) { v[i][j] = x[j] + g[j] * (w0 * ya[j] + w1 * yb[j]); ss += v[i][j] * v[i][j]; } }
        ss = wave_sum(ss); const float rstd = rsqrtf(ss * (1.0f / D) + EPS);
#pragma unroll
        for (int i = 0; i < 8; ++i) { const int col = i * 256 + lane * 4; const f32x4 g = *(const f32x4*)(gfin + col); f32x4 o;
#pragma unroll
            for (int j = 0; j < 4; ++j) o[j] = v[i][j] * rstd * g[j];
            *(f32x4*)(out + (size_t)row * D + col) = o; }
    }
}

typedef float f32x2_t __attribute__((ext_vector_type(2))); typedef __bf16 bf16x2_t __attribute__((ext_vector_type(2)));
__device__ __forceinline__ unsigned cvtpk(float lo, float hi) { f32x2_t v = {lo, hi}; bf16x2_t b = __builtin_convertvector(v, bf16x2_t); return __builtin_bit_cast(unsigned, b); }
#define MFMA32(a, b, c) __builtin_amdgcn_mfma_f32_32x32x16_bf16((a), (b), (c), 0, 0, 0)
constexpr int MLA_KP = 400, MLA_VP = 144, MLA_KB = 64 * MLA_KP, MLA_VB = 128 * MLA_VP, MLA_STAGE = MLA_KB + MLA_VB;
static_assert(2 * MLA_STAGE <= RING_BYTES, "MLA LDS");

__device__ __forceinline__ void ph_mla(const Args& a, bool with_ctx, unsigned char* lds) {
    const bf16_t* __restrict__ Q = (const bf16_t*)(a.ws + WS_Q); const bf16_t* __restrict__ KN = (const bf16_t*)(a.ws + WS_KN); const bf16_t* __restrict__ KPE = (const bf16_t*)(a.ws + WS_KPE);
    const bf16_t* __restrict__ VT = (const bf16_t*)(a.ws + WS_VT); bf16_t* __restrict__ mix = (bf16_t*)(a.ws + WS_MIX);
    int tid_ = threadIdx.x; asm volatile("" : "+v"(tid_));
    const int tid = tid_, lane = tid & 63, w = tid >> 6, qi = lane & 31, hh = lane >> 5;
    const int nunits = with_ctx ? 288 : 256;
    const float c = 0.07216878364870322f * 1.4426950408889634f;
    for (int unit = blockIdx.x; unit < nunits; unit += gridDim.x) {
        int h, b, q0tok, nt; bool ctxq;
        if (unit < 256) { h = unit & 7; b = unit >> 6; q0tok = b * L + ((unit >> 3) & 7) * 256; nt = 36; ctxq = false; }
        else { const int u2 = unit - 256; h = u2 & 7; b = u2 >> 3; q0tok = NLAT + b * C; nt = 4; ctxq = true; }
#define MLA_KTOK(t) (ctxq ? (NLAT + b * C + (t) * 64) : ((t) < 32 ? (b * L + (t) * 64) : (NLAT + b * C + ((t) - 32) * 64)))
        u32x4 r0, r1, r2, r3, r4;
#define MLA_ISSUE_K(t) do { const int kt0_ = MLA_KTOK(t); \
            r0 = *(const u32x4*)(KN + (size_t)(kt0_ + (tid >> 4)) * 1024 + h * 128 + (tid & 15) * 8); \
            r1 = *(const u32x4*)(KN + (size_t)(kt0_ + 32 + (tid >> 4)) * 1024 + h * 128 + (tid & 15) * 8); \
            r2 = *(const u32x4*)(KPE + (size_t)(kt0_ + (tid >> 3)) * 64 + (tid & 7) * 8); } while (0)
#define MLA_ISSUE_V(t) do { const int kt0_ = MLA_KTOK(t); \
            r3 = *(const u32x4*)(VT + (size_t)(h * 128 + (tid >> 3)) * NTOK + kt0_ + (tid & 7) * 8); \
            r4 = *(const u32x4*)(VT + (size_t)(h * 128 + 64 + (tid >> 3)) * NTOK + kt0_ + (tid & 7) * 8); } while (0)
#define MLA_ISSUE(t) do { MLA_ISSUE_K(t); MLA_ISSUE_V(t); } while (0)
#define MLA_COMMIT(buf) do { unsigned char* kb_ = lds + (buf) * MLA_STAGE; unsigned char* vb_ = kb_ + MLA_KB; \
            *(u32x4*)(kb_ + (tid >> 4) * MLA_KP + (tid & 15) * 16) = r0; \
            *(u32x4*)(kb_ + (32 + (tid >> 4)) * MLA_KP + (tid & 15) * 16) = r1; \
            *(u32x4*)(kb_ + (tid >> 3) * MLA_KP + 256 + (tid & 7) * 16) = r2; \
            const int g_ = (tid & 7) >> 1, e_ = tid & 1; \
            { u32x2 lo_, hi_; lo_.x = r3.x; lo_.y = r3.y; hi_.x = r3.z; hi_.y = r3.w; \
              *(u32x2*)(vb_ + (tid >> 3) * MLA_VP + g_ * 32 + e_ * 8) = lo_; *(u32x2*)(vb_ + (tid >> 3) * MLA_VP + g_ * 32 + 16 + e_ * 8) = hi_; } \
            { u32x2 lo_, hi_; lo_.x = r4.x; lo_.y = r4.y; hi_.x = r4.z; hi_.y = r4.w; \
              *(u32x2*)(vb_ + (64 + (tid >> 3)) * MLA_VP + g_ * 32 + e_ * 8) = lo_; *(u32x2*)(vb_ + (64 + (tid >> 3)) * MLA_VP + g_ * 32 + 16 + e_ * 8) = hi_; } } while (0)
        const int qtok = q0tok + w * 32 + qi;
        bf16x8 qf[12];
#pragma unroll
        for (int s = 0; s < 12; ++s) qf[s] = *(const bf16x8*)(Q + (size_t)qtok * QW + h * 192 + s * 16 + hh * 8);
        f32x16 o[4];
#pragma unroll
        for (int d = 0; d < 4; ++d)
#pragma unroll
            for (int r = 0; r < 16; ++r) o[d][r] = 0.f;
        float m = -1.0e30f, l = 0.f;
        MLA_ISSUE(0); MLA_COMMIT(0);
        __syncthreads();
        for (int t = 0; t < nt; ++t) {
            const unsigned char* kb = lds + (t & 1) * MLA_STAGE; const unsigned char* vb = kb + MLA_KB;
            f32x16 s0, s1;
#pragma unroll
            for (int r = 0; r < 16; ++r) { s0[r] = 0.f; s1[r] = 0.f; }
            {
                const unsigned char* kp0 = kb + qi * MLA_KP + hh * 16; const unsigned char* kp1 = kp0 + 32 * MLA_KP;
                bf16x8 ka[4], kn[4];
                ka[0] = *(const bf16x8*)(kp0); ka[1] = *(const bf16x8*)(kp1); ka[2] = *(const bf16x8*)(kp0 + 32); ka[3] = *(const bf16x8*)(kp1 + 32);
#pragma unroll
                for (int g = 0; g < 6; ++g) {
                    if (g < 5) { kn[0] = *(const bf16x8*)(kp0 + (2 * g + 2) * 32); kn[1] = *(const bf16x8*)(kp1 + (2 * g + 2) * 32); kn[2] = *(const bf16x8*)(kp0 + (2 * g + 3) * 32); kn[3] = *(const bf16x8*)(kp1 + (2 * g + 3) * 32); }
                    __builtin_amdgcn_sched_barrier(0);
                    s0 = MFMA32(ka[0], qf[2 * g], s0); s1 = MFMA32(ka[1], qf[2 * g], s1); s0 = MFMA32(ka[2], qf[2 * g + 1], s0); s1 = MFMA32(ka[3], qf[2 * g + 1], s1);
                    __builtin_amdgcn_sched_barrier(0);
#pragma unroll
                    for (int q = 0; q < 4; ++q) ka[q] = kn[q];
                }
            }
            if (t + 1 < nt) MLA_ISSUE(t + 1);
            float mx = fmaxf(s0[0], s1[0]);
#pragma unroll
            for (int r = 1; r < 16; ++r) mx = fmaxf(mx, fmaxf(s0[r], s1[r]));
            mx = fmaxf(mx, __shfl_xor(mx, 32));
            const float mnew = fmaxf(m, mx * c);
            const float alpha = __builtin_amdgcn_exp2f(m - mnew);
            m = mnew;
            float ps = 0.f;
#pragma unroll
            for (int r = 0; r < 16; ++r) { s0[r] = __builtin_amdgcn_exp2f(s0[r] * c - mnew); s1[r] = __builtin_amdgcn_exp2f(s1[r] * c - mnew); ps += s0[r] + s1[r]; }
            l = l * alpha + ps;
            if ((PROBE_SUB >> 9) & 1u) {
                float ps2 = 0.f;
#pragma unroll
                for (int r = 0; r < 16; ++r) { float x0 = s0[r], x1 = s1[r]; asm volatile("" : "+v"(x0), "+v"(x1)); ps2 += __builtin_amdgcn_exp2f(x0 * c - 40.f) + __builtin_amdgcn_exp2f(x1 * c - 40.f); }
                float mx2 = ps2;
#pragma unroll
                for (int r = 0; r < 16; ++r) { float x0 = s0[r], x1 = s1[r]; asm volatile("" : "+v"(x0), "+v"(x1)); mx2 = fmaxf(mx2, fmaxf(x0 * c, x1 * c)); }
                if (mx2 == 123456.75f) l += ps2;
            }
            if ((PROBE_SUB >> 10) & 1u) {
                f32x16 sx;
#pragma unroll
                for (int r = 0; r < 16; ++r) sx[r] = 0.f;
#pragma unroll
                for (int s = 0; s < 12; ++s) { bf16x8 k0 = *(const bf16x8*)(kb + qi * MLA_KP + s * 32 + hh * 16); sx = MFMA32(k0, qf[s], sx); }
                if (sx[0] == 123456.75f) l += sx[1];
            }
#pragma unroll
            for (int d = 0; d < 4; ++d)
#pragma unroll
                for (int r = 0; r < 16; ++r) o[d][r] *= alpha;
            bf16x8 pf[4];
            { u32x4 p;
              p.x = cvtpk(s0[0], s0[1]); p.y = cvtpk(s0[2], s0[3]); p.z = cvtpk(s0[4], s0[5]); p.w = cvtpk(s0[6], s0[7]); pf[0] = __builtin_bit_cast(bf16x8, p);
              p.x = cvtpk(s0[8], s0[9]); p.y = cvtpk(s0[10], s0[11]); p.z = cvtpk(s0[12], s0[13]); p.w = cvtpk(s0[14], s0[15]); pf[1] = __builtin_bit_cast(bf16x8, p);
              p.x = cvtpk(s1[0], s1[1]); p.y = cvtpk(s1[2], s1[3]); p.z = cvtpk(s1[4], s1[5]); p.w = cvtpk(s1[6], s1[7]); pf[2] = __builtin_bit_cast(bf16x8, p);
              p.x = cvtpk(s1[8], s1[9]); p.y = cvtpk(s1[10], s1[11]); p.z = cvtpk(s1[12], s1[13]); p.w = cvtpk(s1[14], s1[15]); pf[3] = __builtin_bit_cast(bf16x8, p); }
            asm volatile("" ::: "memory");
            {
                const unsigned char* vp = vb + qi * MLA_VP + hh * 16;
                bf16x8 va[4], vn[4];
#pragma unroll
                for (int g = 0; g < 4; ++g) va[g] = *(const bf16x8*)(vp + g * 32);
#pragma unroll
                for (int d = 0; d < 4; ++d) {
                    if (d < 3) {
#pragma unroll
                        for (int g = 0; g < 4; ++g) vn[g] = *(const bf16x8*)(vp + (d + 1) * 32 * MLA_VP + g * 32); }
                    __builtin_amdgcn_sched_barrier(0);
#pragma unroll
                    for (int g = 0; g < 4; ++g) o[d] = MFMA32(va[g], pf[g], o[d]);
                    __builtin_amdgcn_sched_barrier(0);
#pragma unroll
                    for (int g = 0; g < 4; ++g) va[g] = vn[g];
                }
            }
            if (t + 1 < nt) MLA_COMMIT((t + 1) & 1);
            __syncthreads();
        }
        const float inv = 1.0f / (l + __shfl_xor(l, 32));
        bf16_t* op = mix + (size_t)qtok * D + h * 128 + 4 * hh;
#pragma unroll
        for (int d = 0; d < 4; ++d)
#pragma unroll
            for (int g = 0; g < 4; ++g) { u32x2 wv; wv.x = cvtpk(o[d][4 * g] * inv, o[d][4 * g + 1] * inv); wv.y = cvtpk(o[d][4 * g + 2] * inv, o[d][4 * g + 3] * inv);
                *(u32x2*)(op + d * 32 + 8 * g) = wv; }
#undef MLA_KTOK
#undef MLA_ISSUE
#undef MLA_ISSUE_K
#undef MLA_ISSUE_V
#undef MLA_COMMIT
    }
}

constexpr int HY_CS = 8224, HY_WS = 5136, HY_WOFF = 8 * HY_CS, HY_RBL = HY_WOFF + 4 * HY_WS;
static_assert(HY_RBL + 516 * 16 <= RING_BYTES, "hyena LDS");

__device__ __forceinline__ u32x4 hy_shift(const u32x4 a, const u32x4 b, int r) {
    switch (r) {
    case 0: return b;
    case 1: return (u32x4){__builtin_amdgcn_alignbyte(b.x, a.w, 2), __builtin_amdgcn_alignbyte(b.y, b.x, 2), __builtin_amdgcn_alignbyte(b.z, b.y, 2), __builtin_amdgcn_alignbyte(b.w, b.z, 2)};
    case 2: return (u32x4){a.w, b.x, b.y, b.z};
    case 3: return (u32x4){__builtin_amdgcn_alignbyte(a.w, a.z, 2), __builtin_amdgcn_alignbyte(b.x, a.w, 2), __builtin_amdgcn_alignbyte(b.y, b.x, 2), __builtin_amdgcn_alignbyte(b.z, b.y, 2)};
    case 4: return (u32x4){a.z, a.w, b.x, b.y};
    case 5: return (u32x4){__builtin_amdgcn_alignbyte(a.z, a.y, 2), __builtin_amdgcn_alignbyte(a.w, a.z, 2), __builtin_amdgcn_alignbyte(b.x, a.w, 2), __builtin_amdgcn_alignbyte(b.y, b.x, 2)};
    case 6: return (u32x4){a.y, a.z, a.w, b.x};
    default: return (u32x4){__builtin_amdgcn_alignbyte(a.y, a.x, 2), __builtin_amdgcn_alignbyte(a.z, a.y, 2), __builtin_amdgcn_alignbyte(a.w, a.z, 2), __builtin_amdgcn_alignbyte(b.x, a.w, 2)};
    }
}

__device__ __forceinline__ void ph_hyena(const Args& a, int l, unsigned char* lds) {
    const bf16_t* __restrict__ RB = (const bf16_t*)(a.ws + WS_FILTL) + (size_t)l * 512 * HY_RBROW;
    const bf16_t* __restrict__ wtl = (const bf16_t*)(a.ws + WS_WTL);
    int tid_ = threadIdx.x; asm volatile("" : "+v"(tid_));
    const int tid = tid_, lane = tid & 63, w = __builtin_amdgcn_readfirstlane(tid >> 6), i = lane & 31, hh = lane >> 5;
    for (int unit = blockIdx.x; unit < 512; unit += gridDim.x) {
        const int c = unit;
        for (int k = tid; k < 515; k += NTHR) { u32x4 v = (u32x4){0u, 0u, 0u, 0u}; if (k < 513) v = *(const u32x4*)(RB + (size_t)c * HY_RBROW + k * 8); *(u32x4*)(lds + HY_RBL + k * 16) = v; }
        for (int k = tid; k < 4 * 321; k += NTHR) { const int b = k / 321, sl = k - b * 321; u32x4 v = (u32x4){0u, 0u, 0u, 0u};
            if (sl >= 28 && sl < 284) v = *(const u32x4*)(wtl + ((size_t)b * 512 + c) * L + (sl - 28) * 8);
            *(u32x4*)(lds + HY_WOFF + b * HY_WS + sl * 16) = v; }
        __syncthreads();
        for (int qs = lane; qs < 511; qs += 64) {
            const u32x4 ca = *(const u32x4*)(lds + HY_RBL + qs * 16), cb = *(const u32x4*)(lds + HY_RBL + qs * 16 + 16);
            *(u32x4*)(lds + w * HY_CS + qs * 16) = hy_shift(ca, cb, w);
        }
        __syncthreads();
        f32x16 acc0, acc1;
#pragma unroll
        for (int r = 0; r < 16; ++r) { acc0[r] = 0.f; acc1[r] = 0.f; }
        const int Tl = i >> 2, b = i & 3;
        const unsigned char* ap = lds + (i & 7) * HY_CS + (hh - (i >> 3) + 255) * 16;
        const unsigned char* bp = lds + HY_WOFF + b * HY_WS + (224 + 16 * (2 * (8 * w + Tl)) + 8 * hh) * 2;
        const int d0 = 16 * w - 127;
#pragma unroll 2
        for (int dd = 0; dd < 142; dd += 2) {
            const int d = d0 + dd;
            const bf16x8 a0 = *(const bf16x8*)(ap - 32 * d), b0 = *(const bf16x8*)(bp - 32 * d);
            const bf16x8 a1 = *(const bf16x8*)(ap - 32 * (d + 1)), b1 = *(const bf16x8*)(bp - 32 * (d + 1));
            acc0 = MFMA32(a0, b0, acc0); acc1 = MFMA32(a1, b1, acc1);
        }
        bf16_t* yt = (bf16_t*)(a.ws + WS_YT) + ((size_t)b * 512 + c) * L + 32 * (8 * w + Tl) + 4 * hh;
#pragma unroll
        for (int g = 0; g < 4; ++g) { u32x2 wv; wv.x = cvtpk(acc0[4 * g] + acc1[4 * g], acc0[4 * g + 1] + acc1[4 * g + 1]); wv.y = cvtpk(acc0[4 * g + 2] + acc1[4 * g + 2], acc0[4 * g + 3] + acc1[4 * g + 3]);
            *(u32x2*)(yt + 8 * g) = wv; }
        __syncthreads();
    }
}

__device__ __forceinline__ void ph_hyena_fin(const Args& a, int l, bool with_ctx, unsigned char* lds) {
    const bf16_t* __restrict__ YT = (const bf16_t*)(a.ws + WS_YT); const bf16_t* __restrict__ wtl = (const bf16_t*)(a.ws + WS_WTL); const bf16_t* __restrict__ wtc = (const bf16_t*)(a.ws + WS_WTC);
    const bf16_t* __restrict__ x0 = (const bf16_t*)(a.ws + WS_X0); const float* skip = a.in[23] + l * 512; bf16_t* __restrict__ mix = (bf16_t*)(a.ws + WS_MIX);
    int tid_ = threadIdx.x; asm volatile("" : "+v"(tid_));
    const int tid = tid_;
    bf16_t* T = (bf16_t*)lds;
    constexpr int TP = 520;
    const int nunits = with_ctx ? 144 : 128;
    for (int unit = (int)gridDim.x - 1 - (int)blockIdx.x; unit < nunits; unit += gridDim.x) {
        const bool lat = unit < 128; const int b = lat ? (unit >> 5) : ((unit - 128) >> 2), t0 = lat ? (unit & 31) * 64 : ((unit - 128) & 3) * 64;
        const int Ls = lat ? L : C; const int tok0 = lat ? b * L + t0 : NLAT + b * C + t0;
        const bf16_t* yrow = (lat ? YT : YT + (size_t)NB * 512 * L) + ((size_t)b * 512 + tid) * Ls + t0;
        const bf16_t* wrow = (lat ? wtl : wtc) + ((size_t)b * 512 + tid) * Ls + t0;
        const float sk = skip[tid];
#pragma unroll
        for (int hf = 0; hf < 2; ++hf) {
            u32x4 yv[4], wv[4];
#pragma unroll
            for (int q = 0; q < 4; ++q) { yv[q] = *(const u32x4*)(yrow + hf * 32 + q * 8); wv[q] = *(const u32x4*)(wrow + hf * 32 + q * 8); }
#pragma unroll
            for (int q = 0; q < 4; ++q) { const unsigned yy[4] = {yv[q].x, yv[q].y, yv[q].z, yv[q].w}, ww[4] = {wv[q].x, wv[q].y, wv[q].z, wv[q].w};
#pragma unroll
                for (int d = 0; d < 4; ++d) { const int t = hf * 32 + q * 8 + 2 * d;
                    T[t * TP + tid] = f2bf(__uint_as_float(yy[d] << 16) + sk * __uint_as_float(ww[d] << 16));
                    T[(t + 1) * TP + tid] = f2bf(__uint_as_float(yy[d] & 0xffff0000u) + sk * __uint_as_float(ww[d] & 0xffff0000u)); } }
        }
        __syncthreads();
#pragma unroll
        for (int j = 0; j < 8; ++j) { const int o = tid + 512 * j, t = o >> 6, cc = (o & 63) * 8;
            const u32x4 tv = *(const u32x4*)(T + t * TP + cc), xv = *(const u32x4*)(x0 + (size_t)(tok0 + t) * 512 + cc);
            const unsigned tt[4] = {tv.x, tv.y, tv.z, tv.w}, xx[4] = {xv.x, xv.y, xv.z, xv.w}; unsigned oo[4];
#pragma unroll
            for (int d = 0; d < 4; ++d) oo[d] = cvtpk(__uint_as_float(tt[d] << 16) * __uint_as_float(xx[d] << 16), __uint_as_float(tt[d] & 0xffff0000u) * __uint_as_float(xx[d] & 0xffff0000u));
            *(u32x4*)(mix + (size_t)(tok0 + t) * D + 1024 + cc) = (u32x4){oo[0], oo[1], oo[2], oo[3]}; }
        __syncthreads();
    }
}

constexpr int SWA_P = 144, SWA_KB = 64 * SWA_P, SWA_STAGE = 2 * SWA_KB;
__device__ __forceinline__ void ph_swa(const Args& a, int l, bool with_ctx, unsigned char* lds) {
    const bf16_t* __restrict__ SQ = (const bf16_t*)(a.ws + WS_SQ); const bf16_t* __restrict__ SK = (const bf16_t*)(a.ws + WS_SK); const bf16_t* __restrict__ SVT = (const bf16_t*)(a.ws + WS_SV);
    const float* sink = a.in[24] + l * 8; bf16_t* __restrict__ mix = (bf16_t*)(a.ws + WS_MIX);
    int tid_ = threadIdx.x; asm volatile("" : "+v"(tid_));
    const int tid = tid_, lane = tid & 63, w = tid >> 6, qi = lane & 31, hh = lane >> 5;
    const int nunits = with_ctx ? 288 : 256;
    const float c = 0.125f * 1.4426950408889634f;
    for (int unit = blockIdx.x; unit < nunits; unit += gridDim.x) {
        int hk, b, p0, nloc, t0loc, q0tok; bool ctxq;
        if (unit < 256) { hk = unit & 1; b = (unit >> 1) & 3; p0 = (unit >> 3) * 64; ctxq = false; q0tok = b * L + p0;
            const int lo = p0 - 128 < 0 ? 0 : p0 - 128, hi = p0 + 192 > L ? L : p0 + 192; t0loc = lo; nloc = (hi - lo) >> 6; }
        else { const int u2 = unit - 256; hk = u2 & 1; b = (u2 >> 1) & 3; p0 = (u2 >> 3) * 64; ctxq = true; q0tok = NLAT + b * C + p0; t0loc = 0; nloc = 0; }
        const int nt = nloc + 4;
#define SWA_KTOK(t) ((t) < nloc ? (b * L + t0loc + (t) * 64) : (NLAT + b * C + ((t) - nloc) * 64))
        u32x4 r0, r1;
#define SWA_ISSUE(t) do { const int kt0_ = SWA_KTOK(t); \
            r0 = *(const u32x4*)(SK + (size_t)(kt0_ + (tid >> 3)) * 128 + hk * 64 + (tid & 7) * 8); \
            r1 = *(const u32x4*)(SVT + (size_t)(hk * 64 + (tid >> 3)) * NTOK + kt0_ + (tid & 7) * 8); } while (0)
#define SWA_COMMIT(buf) do { unsigned char* kb_ = lds + (buf) * SWA_STAGE; unsigned char* vb_ = kb_ + SWA_KB; \
            *(u32x4*)(kb_ + (tid >> 3) * SWA_P + (tid & 7) * 16) = r0; \
            const int g_ = (tid & 7) >> 1, e_ = tid & 1; u32x2 lo_, hi_; lo_.x = r1.x; lo_.y = r1.y; hi_.x = r1.z; hi_.y = r1.w; \
            *(u32x2*)(vb_ + (tid >> 3) * SWA_P + g_ * 32 + e_ * 8) = lo_; *(u32x2*)(vb_ + (tid >> 3) * SWA_P + g_ * 32 + 16 + e_ * 8) = hi_; } while (0)
        const int hq = hk * 4 + (w >> 1), qpos = p0 + (w & 1) * 32 + qi, qtok = q0tok + (w & 1) * 32 + qi;
        bf16x8 qf[4];
#pragma unroll
        for (int s = 0; s < 4; ++s) qf[s] = *(const bf16x8*)(SQ + (size_t)qtok * 512 + hq * 64 + s * 16 + hh * 8);
        f32x16 o[2];
#pragma unroll
        for (int d = 0; d < 2; ++d)
#pragma unroll
            for (int r = 0; r < 16; ++r) o[d][r] = 0.f;
        float m = sink[hq] * 1.4426950408889634f, lsum = hh == 0 ? 1.0f : 0.0f;
        SWA_ISSUE(0); SWA_COMMIT(0);
        __syncthreads();
        for (int t = 0; t < nt; ++t) {
            const unsigned char* kb = lds + (t & 1) * SWA_STAGE; const unsigned char* vb = kb + SWA_KB;
            f32x16 s0, s1;
#pragma unroll
            for (int r = 0; r < 16; ++r) { s0[r] = 0.f; s1[r] = 0.f; }
#pragma unroll
            for (int s = 0; s < 4; ++s) {
                const bf16x8 k0 = *(const bf16x8*)(kb + qi * SWA_P + s * 32 + hh * 16);
                const bf16x8 k1 = *(const bf16x8*)(kb + (32 + qi) * SWA_P + s * 32 + hh * 16);
                s0 = MFMA32(k0, qf[s], s0); s1 = MFMA32(k1, qf[s], s1);
            }
            if (t + 1 < nt) SWA_ISSUE(t + 1);
            if (t < nloc) {
                const int kbase = t0loc + t * 64 + 4 * hh - qpos;
#pragma unroll
                for (int r = 0; r < 16; ++r) { const int dlt = kbase + (r & 3) + 8 * (r >> 2);
                    if (dlt > 128 || dlt < -128) s0[r] = -1.0e30f;
                    if (dlt + 32 > 128 || dlt + 32 < -128) s1[r] = -1.0e30f; }
            }
            float mx = fmaxf(s0[0], s1[0]);
#pragma unroll
            for (int r = 1; r < 16; ++r) mx = fmaxf(mx, fmaxf(s0[r], s1[r]));
            mx = fmaxf(mx, __shfl_xor(mx, 32));
            const float mnew = fmaxf(m, mx * c);
            const float alpha = __builtin_amdgcn_exp2f(m - mnew);
            m = mnew;
            float ps = 0.f;
#pragma unroll
            for (int r = 0; r < 16; ++r) { s0[r] = __builtin_amdgcn_exp2f(s0[r] * c - mnew); s1[r] = __builtin_amdgcn_exp2f(s1[r] * c - mnew); ps += s0[r] + s1[r]; }
            lsum = lsum * alpha + ps;
#pragma unroll
            for (int d = 0; d < 2; ++d)
#pragma unroll
                for (int r = 0; r < 16; ++r) o[d][r] *= alpha;
            bf16x8 pf[4];
            { u32x4 p;
              p.x = cvtpk(s0[0], s0[1]); p.y = cvtpk(s0[2], s0[3]); p.z = cvtpk(s0[4], s0[5]); p.w = cvtpk(s0[6], s0[7]); pf[0] = __builtin_bit_cast(bf16x8, p);
              p.x = cvtpk(s0[8], s0[9]); p.y = cvtpk(s0[10], s0[11]); p.z = cvtpk(s0[12], s0[13]); p.w = cvtpk(s0[14], s0[15]); pf[1] = __builtin_bit_cast(bf16x8, p);
              p.x = cvtpk(s1[0], s1[1]); p.y = cvtpk(s1[2], s1[3]); p.z = cvtpk(s1[4], s1[5]); p.w = cvtpk(s1[6], s1[7]); pf[2] = __builtin_bit_cast(bf16x8, p);
              p.x = cvtpk(s1[8], s1[9]); p.y = cvtpk(s1[10], s1[11]); p.z = cvtpk(s1[12], s1[13]); p.w = cvtpk(s1[14], s1[15]); pf[3] = __builtin_bit_cast(bf16x8, p); }
#pragma unroll
            for (int d = 0; d < 2; ++d)
#pragma unroll
                for (int g = 0; g < 4; ++g) {
                    const bf16x8 vf = *(const bf16x8*)(vb + (d * 32 + qi) * SWA_P + g * 32 + hh * 16);
                    o[d] = MFMA32(vf, pf[g], o[d]);
                }
            if (t + 1 < nt) SWA_COMMIT((t + 1) & 1);
            __syncthreads();
        }
        const float inv = 1.0f / (lsum + __shfl_xor(lsum, 32));
        bf16_t* op = mix + (size_t)qtok * D + 1536 + hq * 64 + 4 * hh;
#pragma unroll
        for (int d = 0; d < 2; ++d)
#pragma unroll
            for (int g = 0; g < 4; ++g) { u32x2 wv; wv.x = cvtpk(o[d][4 * g] * inv, o[d][4 * g + 1] * inv); wv.y = cvtpk(o[d][4 * g + 2] * inv, o[d][4 * g + 3] * inv);
                *(u32x2*)(op + d * 32 + 8 * g) = wv; }
#undef SWA_KTOK
#undef SWA_ISSUE
#undef SWA_COMMIT
    }
}


constexpr int NPHASES = 22;
#define GEMM_CALL(EPI, SCHED, g, S, E) pg8::gemm_phase<EPI, SCHED, true, true, 0>((PG8_LAS unsigned char*)lds, g, S, E)
#define GEMM_CALL8(EPI, SCHED, g, S, E) pg8::gemm_phase<EPI, SCHED, true, true, 1>((PG8_LAS unsigned char*)lds, g, S, E)
#define GEMM_CALLI8(EPI, SCHED, g, S, E) pg8::gemm_phase<EPI, SCHED, true, true, 2>((PG8_LAS unsigned char*)lds, g, S, E)

template <int LYR>
__device__ __forceinline__ void layer_phases(const Args& a, unsigned char* lds, const XcdBarrier& bar, int lo, int hi) {
#define IN(k) (lo <= (k) && (k) < hi)
#define REPS(k) for (int rep_ = 0; rep_ <= (int)((PROBE_MASK >> (k)) & 1u); ++rep_)
#if MK_PER_PHASE
#define SEAM(k) do { } while (0)
#else
#define SEAM(k) do { if (IN(k) && IN((k) + 1)) xcd_barrier(bar); } while (0)
#endif
    constexpr int P0 = 1 + LYR * 9;
    constexpr bool LAST = (LYR == 1);
    constexpr int S_WO = pg8::split_S((LAST ? NLAT : NTOK) / 256 * (D / 256), D / 64, 256);
    constexpr int S_WO0 = pg8::split_S(NTOK / 256 * (D / 256), D / 64, 256);
    constexpr int S_DN0 = pg8::split_S(NTOK / 256 * (D / 256), (FP8_DENSE || FP8_DOWN) ? DFF / 128 : DFF / 64, 256);
    constexpr int S_DN = pg8::split_S(NTOK / 256 * (D / 256), (FP8_DENSE || FP8_DOWN) ? DFF / 128 : DFF / 64, 256);
    const int G = gridDim.x, bid = blockIdx.x;
    unsigned char* ws = a.ws;
    const float* modl = (const float*)(ws + WS_MOD) + (size_t)LYR * 5 * 12288;
    float* xs = (float*)(ws + WS_XS);
    const int nq = LAST ? NLAT : NTOK;
    if (IN(P0 + 0)) REPS(P0 + 0) {
        if (LYR == 0) ph_normmod<false, true, I8_WIN ? 2 : 0>(a.in[0], a.in[2], a.in[6], modl, 0, 2048, (bf16_t*)(ws + WS_HA), NTOK, xs, nullptr, nullptr, nullptr, nullptr, nullptr, (float*)(ws + WS_RSC));
        else ph_normmod<false, false, I8_WIN ? 2 : 0, S_DN0>(xs, xs + (size_t)NLAT * D, a.in[6] + D, modl, 0, 2048, (bf16_t*)(ws + WS_HA), NTOK, nullptr, nullptr, nullptr, nullptr,
                                                    (const float*)(ws + WS_SLAB), (const float*)(ws + WS_MOD) + (size_t)4 * 12288 + 10240, (float*)(ws + WS_RSC));
    }
    SEAM(P0 + 0);
    if (IN(P0 + 1)) REPS(P0 + 1) {
#if I8_WIN
        pg8::Gemm g{(const bf16_t*)(ws + WS_HA), (const bf16_t*)(ws + WS_WIN + (size_t)LYR * UW * D * 2), NTOK, UW, D / 2};
        const float swin = __uint_as_float(__hip_atomic_load((const unsigned*)(ws + WS_CTL) + CT_WSC + LYR, __ATOMIC_RELAXED, __HIP_MEMORY_SCOPE_AGENT)) * (1.0f / 127.0f);
        pg8::EpiStoreI8 E{(bf16_t*)(ws + WS_U), UW, (const float*)(ws + WS_RSC), swin};
        if constexpr (LAST) { pg8::WinLastOrder S; S.init(G, bid, D / 2); GEMM_CALLI8(pg8::EpiStoreI8, pg8::WinLastOrder, g, S, E); }
        else { pg8::StaticOrder S; S.init(NTOK, UW, G, bid, D / 2); GEMM_CALLI8(pg8::EpiStoreI8, pg8::StaticOrder, g, S, E); }
#else
        pg8::Gemm g{(const bf16_t*)(ws + WS_HA), (const bf16_t*)(ws + WS_WIN + (size_t)LYR * UW * D * 2), NTOK, UW, D};
        pg8::EpiStore E{(bf16_t*)(ws + WS_U), UW};
        if constexpr (LAST) { pg8::WinLastOrder S; S.init(G, bid, D); GEMM_CALL(pg8::EpiStore, pg8::WinLastOrder, g, S, E); }
        else { pg8::StaticOrder S; S.init(NTOK, UW, G, bid, D); GEMM_CALL(pg8::EpiStore, pg8::StaticOrder, g, S, E); }
#endif
        conv_fill(a, (float*)lds, LYR * 6 + 0);
    }
    SEAM(P0 + 1);
    if (IN(P0 + 2)) REPS(P0 + 2) ph_mid(a, LYR);
    SEAM(P0 + 2);
    if (IN(P0 + 3)) REPS(P0 + 3) {
        SUBREP(0) {
        { pg8::Gemm g{(const bf16_t*)(ws + WS_CQN), (const bf16_t*)(ws + WS_WQ + (size_t)LYR * QW * 768 * 2), nq, QW, 768};
          pg8::StaticOrder S; S.init(nq, QW, G, bid, 768); pg8::EpiQ E{(bf16_t*)(ws + WS_Q), (const float*)(ws + WS_ROPE), (const float*)(ws + WS_ROPE) + 2048 * 32};
          GEMM_CALL(pg8::EpiQ, pg8::StaticOrder, g, S, E); }
        __syncthreads();
        { pg8::Gemm g{(const bf16_t*)(ws + WS_CKVN), (const bf16_t*)(ws + WS_WKV + (size_t)LYR * KVW * 512 * 2), NTOK, 1024, 512};
          pg8::StaticOrder S; S.init(NTOK, 1024, G, bid, 512); pg8::EpiStore E{(bf16_t*)(ws + WS_KN), 1024};
          GEMM_CALL(pg8::EpiStore, pg8::StaticOrder, g, S, E); }
        __syncthreads();
        { pg8::Gemm g{(const bf16_t*)(ws + WS_WKV + (size_t)LYR * KVW * 512 * 2 + (size_t)1024 * 512 * 2), (const bf16_t*)(ws + WS_CKVN), 1024, NTOK, 512};
          pg8::StaticOrder S; S.init(1024, NTOK, 108, bid >= 216 ? bid - 216 : (bid >= 144 ? bid - 108 : (1 << 24)), 512); pg8::EpiStore E{(bf16_t*)(ws + WS_VT), NTOK};
          GEMM_CALL(pg8::EpiStore, pg8::StaticOrder, g, S, E); }
        __syncthreads();
        }
        SUBREP(1) ph_hyena(a, LYR, lds);
        SUBREP(3) if (!LAST) ph_hyena_naive<C>(a, LYR, (float*)lds);
        SUBREP(2) ph_swa(a, LYR, !LAST, lds);
        conv_fill(a, (float*)lds, LYR * 6 + 1);
    }
    SEAM(P0 + 3);
    if (IN(P0 + 4)) REPS(P0 + 4) { ph_hyena_fin(a, LYR, !LAST, lds); ph_mla(a, !LAST, lds); conv_fill(a, (float*)lds, LYR * 6 + 2); }
    SEAM(P0 + 4);
    if (IN(P0 + 5)) REPS(P0 + 5) {
        pg8::Gemm g{(const bf16_t*)(ws + WS_MIX), (const bf16_t*)(ws + WS_WOUT + (size_t)LYR * D * D * 2), nq, D, D};
        pg8::SplitOrder S; S.init(nq / 256, D / 256, G, bid, D, S_WO);
        const int trow0 = S.nfull / S.nN * 256; pg8::EpiResid E{rep_ ? (float*)(ws + WS_ACT) : xs, modl + 4096, (float*)(ws + WS_SLAB), trow0, nq - trow0, 1.0f};
        GEMM_CALL(pg8::EpiResid, pg8::SplitOrder, g, S, E);
        conv_fill(a, (float*)lds, LYR * 6 + 3);
    }
    SEAM(P0 + 5);
    if (!LAST) {
#if !FP8_DENSE
        if (IN(P0 + 6)) { ph_normmod<false, true, I8_GU ? 2 : 0, S_WO0>(xs, xs + (size_t)NLAT * D, a.in[7], modl, 6144, 8192, (bf16_t*)(ws + WS_HA), NTOK, xs, nullptr, nullptr, nullptr, (const float*)(ws + WS_SLAB), modl + (size_t)4 * 12288 + 4096, (float*)(ws + WS_RSC));
            conv_finish(a, (float*)lds, CONV_DENSE_END); }
        SEAM(P0 + 6);
        if (IN(P0 + 7)) REPS(P0 + 7) {
#if I8_GU
            pg8::Gemm g{(const bf16_t*)(ws + WS_HA), (const bf16_t*)(ws + WS_WGU), NTOK, 2 * DFF, D / 2};
            pg8::StaticOrder S; S.init(NTOK, 2 * DFF, G, bid, D / 2);
            const float swg = __uint_as_float(__hip_atomic_load((const unsigned*)(ws + WS_CTL) + CT_WSC + 2, __ATOMIC_RELAXED, __HIP_MEMORY_SCOPE_AGENT)) * (1.0f / 127.0f);
            const float swu = __uint_as_float(__hip_atomic_load((const unsigned*)(ws + WS_CTL) + CT_WSC + 3, __ATOMIC_RELAXED, __HIP_MEMORY_SCOPE_AGENT)) * (1.0f / 127.0f);
            pg8::EpiSwiGLUI8 E{(unsigned char*)(ws + WS_ACT), DFF, (const float*)(ws + WS_RSC), swg, swu, ASCALE};
            GEMM_CALLI8(pg8::EpiSwiGLUI8, pg8::StaticOrder, g, S, E);
#elif FP8_DOWN
            pg8::Gemm g{(const bf16_t*)(ws + WS_HA), (const bf16_t*)(ws + WS_WGU), NTOK, 2 * DFF, D};
            pg8::StaticOrder S; S.init(NTOK, 2 * DFF, G, bid, D);
            pg8::EpiSwiGLU8 E{(unsigned char*)(ws + WS_ACT), DFF, 1.0f, ASCALE};
            GEMM_CALL(pg8::EpiSwiGLU8, pg8::StaticOrder, g, S, E);
#else
            pg8::Gemm g{(const bf16_t*)(ws + WS_HA), (const bf16_t*)(ws + WS_WGU), NTOK, 2 * DFF, D};
            pg8::StaticOrder S; S.init(NTOK, 2 * DFF, G, bid, D);
            pg8::EpiSwiGLU E{(bf16_t*)(ws + WS_ACT), DFF};
            GEMM_CALL(pg8::EpiSwiGLU, pg8::StaticOrder, g, S, E);
#endif
            conv_fill(a, (float*)lds, 4);
        }
        SEAM(P0 + 7);
        if (IN(P0 + 8)) REPS(P0 + 8) {
#if FP8_DOWN
            pg8::Gemm g{(const bf16_t*)(ws + WS_ACT), (const bf16_t*)(ws + WS_WDN), NTOK, D, DFF / 2};
            pg8::SplitOrder S; S.init(NTOK / 256, D / 256, G, bid, DFF / 2, S_DN);
            const int trow0 = S.nfull / S.nN * 256; pg8::EpiResid E{rep_ ? (float*)(ws + WS_YS) : xs, modl + 10240, (float*)(ws + WS_SLAB), trow0, NTOK - trow0, 1.0f / (ASCALE * WSCALE)};
            GEMM_CALL8(pg8::EpiResid, pg8::SplitOrder, g, S, E);
#else
            pg8::Gemm g{(const bf16_t*)(ws + WS_ACT), (const bf16_t*)(ws + WS_WDN), NTOK, D, DFF};
            pg8::SplitOrder S; S.init(NTOK / 256, D / 256, G, bid, DFF, S_DN);
            const int trow0 = S.nfull / S.nN * 256; pg8::EpiResid E{rep_ ? (float*)(ws + WS_YS) : xs, modl + 10240, (float*)(ws + WS_SLAB), trow0, NTOK - trow0, 1.0f};
            GEMM_CALL(pg8::EpiResid, pg8::SplitOrder, g, S, E);
#endif
            conv_fill(a, (float*)lds, 5);
        }
#else
        if (IN(P0 + 6)) { ph_normmod<false, true, true, S_WO0>(xs, xs + (size_t)NLAT * D, a.in[7], modl, 6144, 8192, (bf16_t*)(ws + WS_HA), NTOK, xs, nullptr, nullptr, nullptr, (const float*)(ws + WS_SLAB), modl + (size_t)4 * 12288 + 4096);
            conv_finish(a, (float*)lds, CONV_DENSE_END); }
        SEAM(P0 + 6);
        if (IN(P0 + 7)) REPS(P0 + 7) {
            pg8::Gemm g{(const bf16_t*)(ws + WS_HA), (const bf16_t*)(ws + WS_WGU), NTOK, 2 * DFF, D / 2};
            pg8::StaticOrder S; S.init(NTOK, 2 * DFF, G, bid, D / 2); pg8::EpiSwiGLU8 E{(unsigned char*)(ws + WS_ACT), DFF, 1.0f / (ASCALE * WSCALE), ASCALE};
            GEMM_CALL8(pg8::EpiSwiGLU8, pg8::StaticOrder, g, S, E);
            conv_fill(a, (float*)lds, 4);
        }
        SEAM(P0 + 7);
        if (IN(P0 + 8)) REPS(P0 + 8) {
            pg8::Gemm g{(const bf16_t*)(ws + WS_ACT), (const bf16_t*)(ws + WS_WDN), NTOK, D, DFF / 2};
            pg8::SplitOrder S; S.init(NTOK / 256, D / 256, G, bid, DFF / 2, S_DN);
            const int trow0 = S.nfull / S.nN * 256; pg8::EpiResid E{rep_ ? (float*)(ws + WS_YS) : xs, modl + 10240, (float*)(ws + WS_SLAB), trow0, NTOK - trow0, 1.0f / (ASCALE * WSCALE)};
            GEMM_CALL8(pg8::EpiResid, pg8::SplitOrder, g, S, E);
            conv_fill(a, (float*)lds, 5);
        }
#endif
        SEAM(P0 + 8);
    } else {
        if (IN(P0 + 6)) REPS(P0 + 6) ph_normmod<true, false, true>(xs, xs + (size_t)NLAT * D, a.in[7] + D, modl, 6144, 8192, (bf16_t*)(ws + WS_HA), NLAT, nullptr, a.in[29], (int*)(ws + WS_TOPI), (float*)(ws + WS_TOPW));
        SEAM(P0 + 6);
        if (IN(P0 + 7)) REPS(P0 + 7) { ph_route_gather(a, (int*)lds); conv_finish(a, (float*)lds, NCONV); }
        SEAM(P0 + 7);
        if (IN(P0 + 9)) REPS(P0 + 9) {
            pg8::Gemm g{(const bf16_t*)(ws + WS_HBS), (const bf16_t*)(ws + WS_MGU), MOE_ROWS, 2 * DFE, D / 2};
            pg8::MoeOrder S; S.init((const int*)(ws + WS_CTL), 2 * DFE / 256, G, bid, (size_t)2 * DFE * D, D / 2); pg8::EpiSwiGLU8 E{(unsigned char*)(ws + WS_ACT), DFE, 1.0f / (ASCALE * WSCALE), ASCALE};
            GEMM_CALL8(pg8::EpiSwiGLU8, pg8::MoeOrder, g, S, E);
        }
        SEAM(P0 + 9);
        if (IN(P0 + 10)) REPS(P0 + 10) {
            pg8::Gemm g{(const bf16_t*)(ws + WS_ACT), (const bf16_t*)(ws + WS_MDN), MOE_ROWS, D, DFE / 2};
            pg8::SplitOrder S; S.init_moe((const int*)(ws + WS_CTL), D / 256, G, bid, DFE / 2, (size_t)D * DFE);
            const int trow0 = S.nfull / S.nN * 256; pg8::EpiYs E{(bf16_t*)(ws + WS_YS), (float*)(ws + WS_SLAB), trow0, S.nM * 256 - trow0, 1.0f / (ASCALE * WSCALE)};
            GEMM_CALL8(pg8::EpiYs, pg8::SplitOrder, g, S, E);
        }
        SEAM(P0 + 10);
        if (IN(P0 + 11)) REPS(P0 + 11) ph_final(a);
    }
#undef IN
#undef SEAM
#undef REPS
}

__global__ void __launch_bounds__(NTHR, 2) mk_fwd(Args a) {
    extern __shared__ __attribute__((aligned(16))) unsigned char lds[];
    const int tid = threadIdx.x;
    for (int u = tid; u < (LDS_BYTES - LDSCTL_OFF) / 4; u += NTHR) ((unsigned*)(lds + LDSCTL_OFF))[u] = 0u;
    __syncthreads();
    XcdBarrier bar; bar.bar = (unsigned*)(a.ws + WS_CTL) + CW_BAR; bar.x = 0; bar.st = nullptr;
#if !MK_PER_PHASE
    bar = xcd_barrier_post((unsigned*)(a.ws + WS_CTL) + CW_BAR, (volatile LAS unsigned*)(lds + LDSCTL_OFF + 32));
#endif
    const int lo = a.ph_lo, hi = a.ph_hi;
    if (lo <= 0 && 0 < hi) {
        for (int rep_ = 0; rep_ <= (int)(PROBE_MASK & 1u); ++rep_) { ph_prologue(a, (float*)lds); __syncthreads(); }
#if !MK_PER_PHASE
        if (1 < hi) xcd_barrier(bar);
#endif
    }
    layer_phases<0>(a, lds, bar, lo, hi);
    layer_phases<1>(a, lds, bar, lo, hi);
}

extern "C" void kernel_launch(void* const* d_in, const int* in_sizes, int n_in, void* d_out, int out_size, void* d_ws, size_t ws_size, hipStream_t stream) {
    (void)in_sizes; (void)out_size;
    static int grid = 0;
    if (grid == 0) {
        if (n_in != 34 || ws_size < WS_END) { fprintf(stderr, "kernel_launch: need 34 inputs and >= %zu bytes of workspace (got %d, %zu)\n", (size_t)WS_END, n_in, ws_size); grid = -1; return; }
        int dev = 0, cus = 0, per_cu = 0;
        if (hipGetDevice(&dev) != hipSuccess || hipDeviceGetAttribute(&cus, hipDeviceAttributeMultiprocessorCount, dev) != hipSuccess) { grid = -1; return; }
        if (hipFuncSetAttribute((const void*)mk_fwd, hipFuncAttributeMaxDynamicSharedMemorySize, LDS_BYTES) != hipSuccess) { fprintf(stderr, "kernel_launch: hipFuncSetAttribute failed\n"); grid = -1; return; }
        if (hipOccupancyMaxActiveBlocksPerMultiprocessor(&per_cu, (const void*)mk_fwd, NTHR, LDS_BYTES) != hipSuccess || per_cu < 1) { fprintf(stderr, "kernel_launch: occupancy query says %d blocks per CU\n", per_cu); }
        (void)hipGetLastError();
        grid = cus;
    }
    if (grid < 0) return;
    if (hipMemsetAsync((char*)d_ws + WS_CTL, 0, CTL_ZERO_BYTES, stream) != hipSuccess) return;
    Args a{};
    for (int i = 0; i < 34; ++i) a.in[i] = (const float*)d_in[i];
    a.out = (float*)d_out; a.ws = (unsigned char*)d_ws;
#if MK_PER_PHASE
    for (int p = 0; p < NPHASES; ++p) { a.ph_lo = p; a.ph_hi = p + 1; hipLaunchKernelGGL(mk_fwd, dim3(grid), dim3(NTHR), LDS_BYTES, stream, a); }
#else
    a.ph_lo = 0; a.ph_hi = NPHASES;
    hipLaunchKernelGGL(mk_fwd, dim3(grid), dim3(NTHR), LDS_BYTES, stream, a);
#endif
}
```

```cpp
#include <hip/hip_runtime.h>
#include <stdint.h>
#include <stdio.h>

#ifndef FP8_DENSE
#define FP8_DENSE 0
#endif
#ifndef FP8_DOWN
#define FP8_DOWN 1
#endif
#ifndef I8_WIN
#define I8_WIN 0
#endif
#ifndef I8_GU
#define I8_GU 1
#endif
#ifndef I8_GEMM
#define I8_GEMM (I8_WIN || I8_GU)
#endif
#ifndef TAILQ1
#define TAILQ1 6
#endif
#ifndef TAILQ2
#define TAILQ2 3
#endif
#ifndef TAILQ3
#define TAILQ3 8
#endif
#ifndef TAILQ4
#define TAILQ4 2
#endif
#ifndef CONV_FILL
#define CONV_FILL 0
#endif
#ifndef PROBE_MASK
#define PROBE_MASK 0u
#endif
#ifndef PROBE_SUB
#define PROBE_SUB 0u
#endif
#ifndef MK_PER_PHASE
#define MK_PER_PHASE 0
#endif

typedef unsigned short bf16_t;
typedef float f32x4 __attribute__((ext_vector_type(4)));
typedef float f32x16 __attribute__((ext_vector_type(16)));
typedef unsigned u32x4 __attribute__((ext_vector_type(4)));
typedef unsigned u32x2 __attribute__((ext_vector_type(2)));
typedef short bf16x8 __attribute__((ext_vector_type(8)));

constexpr int D = 2048, NB = 4, L = 2048, C = 256, NLAT = NB * L, NCTX = NB * C, NTOK = NLAT + NCTX;
constexpr int UW = 3840;
constexpr int O_CQ = 0, O_CKV = 768, O_KPE = 1280, O_HY = 1344, O_SQ = 2880, O_SK = 3392, O_SV = 3520, INW = 3648;
constexpr int QW = 1536, KVW = 2048, DFF = 5632, DFE = 7168, NE = 8;
constexpr int MOE_ROWS = 18432;
constexpr float EPS = 1e-6f;
constexpr int NTHR = 512;
constexpr int HY_RBROW = 4112;

__device__ __forceinline__ float bf2f(bf16_t h) { return __uint_as_float(((unsigned)h) << 16); }
__device__ __forceinline__ bf16_t f2bf(float f) { unsigned u = __float_as_uint(f); u += 0x7fffu + ((u >> 16) & 1u); return (bf16_t)(u >> 16); }
__device__ __forceinline__ float wave_sum(float v) { for (int o = 32; o > 0; o >>= 1) v += __shfl_xor(v, o); return v; }
__device__ __forceinline__ float wave_max(float v) { for (int o = 32; o > 0; o >>= 1) v = fmaxf(v, __shfl_xor(v, o)); return v; }
__device__ __forceinline__ float silu(float x) { return x / (1.0f + __expf(-x)); }
__device__ __forceinline__ int tok_mod(int tok) { return tok < NLAT ? (tok >> 11) : 4; }

constexpr size_t al(size_t x) { return (x + 255) & ~(size_t)255; }
constexpr size_t WS_CTL = 0, CTL_ZERO_BYTES = 65536;
constexpr size_t WS_MOD = 65536;
constexpr size_t WS_ROPE = WS_MOD + al((size_t)2 * 5 * 12288 * 4);
constexpr size_t WS_FILTL = WS_ROPE + al((size_t)2 * 2048 * 32 * 4);
constexpr size_t WS_FILTC = WS_FILTL + al((size_t)2 * 512 * 4096 * 4);
constexpr size_t WS_WIN = WS_FILTC + al((size_t)2 * 512 * 512 * 4);
constexpr size_t WS_WQ = WS_WIN + al((size_t)2 * UW * D * 2);
constexpr size_t WS_WKV = WS_WQ + al((size_t)2 * QW * 768 * 2);
constexpr size_t WS_WOUT = WS_WKV + al((size_t)2 * KVW * 512 * 2);
constexpr size_t WS_WGU = WS_WOUT + al((size_t)2 * D * D * 2);
constexpr size_t WS_WDN = WS_WGU + al((size_t)2 * DFF * D * 2);
constexpr size_t WS_MGU = WS_WDN + al((size_t)D * DFF * 2);
constexpr size_t WS_MDN = WS_MGU + al((size_t)NE * 2 * DFE * D * 2);
constexpr size_t WS_HA = WS_MDN + al((size_t)NE * D * DFE * 2);
constexpr size_t WS_U = WS_HA + al((size_t)NTOK * D * 2);
constexpr size_t WS_CQN = WS_U + al((size_t)NTOK * UW * 2);
constexpr size_t WS_CKVN = WS_CQN + al((size_t)NTOK * 768 * 2);
constexpr size_t WS_KPE = WS_CKVN + al((size_t)NTOK * 512 * 2);
constexpr size_t WS_X0 = WS_KPE + al((size_t)NTOK * 64 * 2);
constexpr size_t WS_WTL = WS_X0 + al((size_t)NTOK * 512 * 2);
constexpr size_t WS_WTC = WS_WTL + al((size_t)NB * 512 * L * 2);
constexpr size_t WS_SQ = WS_WTC + al((size_t)NB * 512 * C * 2);
constexpr size_t WS_SK = WS_SQ + al((size_t)NTOK * 512 * 2);
constexpr size_t WS_SV = WS_SK + al((size_t)NTOK * 128 * 2);
constexpr size_t WS_Q = WS_SV + al((size_t)NTOK * 128 * 2);
constexpr size_t WS_KV = WS_Q + al((size_t)NTOK * QW * 2);
constexpr size_t WS_KN = WS_KV;
constexpr size_t WS_VT = WS_KV + (size_t)NTOK * 1024 * 2;
constexpr size_t WS_MIX = WS_KV + al((size_t)NTOK * KVW * 2);
constexpr size_t WS_MIXEND = WS_MIX + al((size_t)NTOK * D * 2);
constexpr size_t WS_YS = WS_U;
static_assert(WS_YS + (size_t)MOE_ROWS * D * 4 <= WS_MIXEND, "ys overlay");
constexpr size_t WS_XS = WS_MIXEND;
constexpr size_t WS_ACT = WS_XS + al((size_t)NTOK * D * 4);
constexpr size_t WS_HBS = WS_ACT + al((size_t)MOE_ROWS * DFE * 2);
constexpr size_t WS_TOPI = WS_HBS + al((size_t)MOE_ROWS * D * 2);
constexpr size_t WS_TOPW = WS_TOPI + al((size_t)NLAT * 2 * 4);
constexpr size_t WS_POS = WS_TOPW + al((size_t)NLAT * 2 * 4);
constexpr size_t WS_SRC = WS_POS + al((size_t)NLAT * 2 * 4);
constexpr size_t WS_SLAB = WS_SRC + al((size_t)MOE_ROWS * 4);
constexpr size_t WS_YT = WS_SLAB + ((size_t)64 << 20);
constexpr size_t WS_RSC = WS_YT + al((size_t)NB * 512 * (L + C) * 2);
constexpr size_t WS_END = WS_RSC + al((size_t)NTOK * 4);
constexpr int CT_EOFF = 1024, CT_EPAD = 1040, CT_NTILE = 1056, CT_MOES = 1057, CT_TROW = 1058, CT_WSC = 1088, CT_AMAXDONE = 1100;
constexpr int CW_BAR = 4096;

constexpr int RING_BYTES = 131072, LDS_BYTES = 147456, LDSCTL_OFF = LDS_BYTES - 256;

namespace pg8 {
#define PG8_LAS __attribute__((address_space(3)))
typedef unsigned short bf16_t;
typedef short bf16x8 __attribute__((ext_vector_type(8)));
typedef float f32x4 __attribute__((ext_vector_type(4)));
typedef unsigned u32x4 __attribute__((ext_vector_type(4)));
constexpr int BM = 256, BK = 64, HALF = 128, HTB = HALF * BK * 2  , STAGE_BYTES = 8 * HTB, NXCD = 8, WGM = 8;

__host__ __device__ __forceinline__ int lds_byte(int r, int c) { const int st = (r >> 4) * 2 + (c >> 5), rr = r & 15, cc = c & 31, ob = rr * 64 + cc * 2; return st * 1024 + (ob ^ (((ob >> 9) & 1) << 5)); }
__host__ __device__ __forceinline__ void stage_rc(int b, int& R, int& C) { const int st = b / 1024, sb = b % 1024, swz = sb ^ (((sb >> 9) & 1) << 5); R = (st >> 1) * 16 + swz / 64; C = (st & 1) * 32 + (swz % 64) / 2; }
__host__ __device__ __forceinline__ int perm32(int rho) { const int n = rho >> 4, i = rho & 15; return 8 * (i >> 2) + 4 * n + (i & 3); }

struct Unit { int pm, pn, kt0, nkt, slab; };
struct Gemm { const bf16_t* A; const bf16_t* Bt; int M, N, K; };

struct StaticOrder {
    int nM, nN, nwg, G, c;
    int nkt;
    __host__ __device__ void init(int M, int N, int G_, int c_, int K) { nM = M / BM; nN = N / BM; nwg = nM * nN; G = G_; c = c_; nkt = K / BK; }
    __host__ __device__ bool next(int i, Unit& u) const {
        const long L = (long)i * G + c; if (L >= nwg) return false;
        int wgid = (int)L; { const int q = nwg / NXCD, r = nwg % NXCD, xcd = wgid % NXCD, off = wgid / NXCD; wgid = (xcd < r ? xcd * (q + 1) : r * (q + 1) + (xcd - r) * q) + off; }
        const int nig = WGM * nN, gid = wgid / nig, fm = gid * WGM, gsz = (nM - fm) < WGM ? (nM - fm) : WGM;
        u.pm = fm + ((wgid % nig) % gsz); u.pn = (wgid % nig) / gsz; u.kt0 = 0; u.nkt = nkt; u.slab = -1; return true;
    }
    __device__ __forceinline__ size_t bt_off(const Unit&) const { return 0; }
    __device__ __forceinline__ void a_ready(const Unit&) const {}
    __device__ __forceinline__ void done(const Unit&) const {}
};

__device__ __forceinline__ unsigned cvt_pk_bf16(float lo, float hi) { unsigned r; asm volatile("v_cvt_pk_bf16_f32 %0, %1, %2" : "=v"(r) : "v"(lo), "v"(hi)); return r; }
typedef float f32x2 __attribute__((ext_vector_type(2)));
typedef int v8i_t __attribute__((ext_vector_type(8))); typedef int v4i_t __attribute__((ext_vector_type(4)));
template <bool F8> struct Frag;
template <> struct Frag<false> { bf16x8 h[2]; __device__ __forceinline__ void set0(bf16x8 x) { h[0] = x; } __device__ __forceinline__ void set1(bf16x8 x) { h[1] = x; } };
template <> struct Frag<true> { v8i_t v; __device__ __forceinline__ void set0(bf16x8 x) { v.lo = __builtin_bit_cast(v4i_t, x); } __device__ __forceinline__ void set1(bf16x8 x) { v.hi = __builtin_bit_cast(v4i_t, x); } };
template <class Epi, class Sched, bool ALIGN_EPI = false, bool SP2 = false, int DT = 0>
__device__ __forceinline__ void gemm_phase(PG8_LAS unsigned char* lds, const Gemm g, const Sched& S, const Epi& E) {
    int tid_ = threadIdx.x; asm volatile("" : "+v"(tid_));
    const int tid = tid_, wid = __builtin_amdgcn_readfirstlane(tid >> 6), lane = tid & 63, wr = wid >> 2, wc = wid & 3, fr = lane & 15, fq = lane >> 4;
    const int K = g.K;
    unsigned voffA[2], voffB[2];
#pragma unroll
    for (int i = 0; i < 2; ++i) { int R, C; stage_rc(tid * 16 + i * 8192, R, C); const int Rb = Epi::PERM ? ((R & ~31) + perm32(R & 31)) : R;
        voffA[i] = (unsigned)(R * K + C) * 2u; voffB[i] = (unsigned)(Rb * K + C) * 2u; }
    const size_t kstep = (size_t)(BK * 2);
    const size_t hstep = (size_t)HALF * K * 2;
    const size_t tstep = 2 * hstep;
    const unsigned ldsw = (unsigned)wid * 1024u;
    const int aoff = lds_byte(wr * 64 + fr, fq * 8), boff = lds_byte(wc * 32 + fr, fq * 8);
#define PG8_SA(b, h) (((b) * 2 + (h)) * HTB)
#define PG8_SB(b, h) ((4 + (b) * 2 + (h)) * HTB)
#define PG8_STAGE(bufoff, gbase, voff) do { _Pragma("unroll") for (int _i = 0; _i < 2; ++_i) \
        __builtin_amdgcn_global_load_lds((const unsigned*)((const char*)(gbase) + (voff)[_i]), (PG8_LAS unsigned*)(lds + (bufoff) + ldsw + _i * 8192), 16, 0, 0); } while (0)
#define PG8_LDA(dst, b, h) do { _Pragma("unroll") for (int m = 0; m < 4; ++m) { dst[m].set0(*(const PG8_LAS bf16x8*)(lds + PG8_SA(b, h) + aoff + m * 2048)); dst[m].set1(*(const PG8_LAS bf16x8*)(lds + PG8_SA(b, h) + aoff + m * 2048 + 1024)); } } while (0)
#define PG8_LDB(dst, b, h) do { _Pragma("unroll") for (int n = 0; n < 2; ++n) { dst[n].set0(*(const PG8_LAS bf16x8*)(lds + PG8_SB(b, h) + boff + n * 2048)); dst[n].set1(*(const PG8_LAS bf16x8*)(lds + PG8_SB(b, h) + boff + n * 2048 + 1024)); } } while (0)
#define PG8_MMA(ai, bj, At, Bt) do { __builtin_amdgcn_s_setprio(1); _Pragma("unroll") for (int m = 0; m < 4; ++m) _Pragma("unroll") for (int n = 0; n < 2; ++n) { \
        if constexpr (DT == 1) asm volatile("v_mfma_f32_16x16x128_f8f6f4 %0, %1, %2, %0" : "+v"(acc[ai][bj][m][n]) : "v"(Bt[n].v), "v"(At[m].v));   \
        else if constexpr (DT == 2) { _Pragma("unroll") for (int k = 0; k < 2; ++k) acc[ai][bj][m][n] = __builtin_bit_cast(f32x4, __builtin_amdgcn_mfma_i32_16x16x64_i8(__builtin_bit_cast(v4i_t, Bt[n].h[k]), __builtin_bit_cast(v4i_t, At[m].h[k]), __builtin_bit_cast(v4i_t, acc[ai][bj][m][n]), 0, 0, 0)); } \
        else { _Pragma("unroll") for (int k = 0; k < 2; ++k) acc[ai][bj][m][n] = __builtin_amdgcn_mfma_f32_16x16x32_bf16(Bt[n].h[k], At[m].h[k], acc[ai][bj][m][n], 0, 0, 0); } } \
        __builtin_amdgcn_s_setprio(0); } while (0)
#define PG8_WAIT_V(n) asm volatile("s_waitcnt vmcnt(" #n ")" ::: "memory")
#define PG8_WAIT_L(n) asm volatile("s_waitcnt lgkmcnt(" #n ")" ::: "memory")
#define PG8_BAR __builtin_amdgcn_s_barrier()
#define PG8_SCHED __builtin_amdgcn_sched_barrier(0)
    Unit cur, nxt; int ui = 0;
    if (!S.next(0, cur)) return;
    f32x4 acc[2][2][4][2];
#pragma unroll
    for (int a = 0; a < 2; ++a)
#pragma unroll
        for (int b = 0; b < 2; ++b)
#pragma unroll
            for (int m = 0; m < 4; ++m)
#pragma unroll
                for (int n = 0; n < 2; ++n) acc[a][b][m][n] = (f32x4){0.f, 0.f, 0.f, 0.f};
    Frag<DT == 1> At[4], B0[2], B1[2];
    const char* cA = (const char*)g.A + (size_t)cur.pm * tstep + (size_t)cur.kt0 * kstep; const char* cB = (const char*)g.Bt + S.bt_off(cur) + (size_t)cur.pn * tstep + (size_t)cur.kt0 * kstep;
    S.a_ready(cur);
    if constexpr (SP2) {
        PG8_STAGE(PG8_SB(0, 0), cB, voffB); PG8_STAGE(PG8_SB(0, 1), cB + hstep, voffB); PG8_STAGE(PG8_SA(0, 0), cA, voffA); PG8_STAGE(PG8_SA(0, 1), cA + hstep, voffA);
        if (wr == 1) PG8_BAR;
        PG8_WAIT_V(2); PG8_BAR;
        PG8_STAGE(PG8_SB(1, 0), cB + kstep, voffB); PG8_STAGE(PG8_SA(1, 0), cA + kstep, voffA); PG8_STAGE(PG8_SB(1, 1), cB + hstep + kstep, voffB);
        PG8_WAIT_V(6); PG8_BAR;
    } else {
        PG8_STAGE(PG8_SB(0, 0), cB, voffB); PG8_STAGE(PG8_SA(0, 0), cA, voffA); PG8_STAGE(PG8_SB(0, 1), cB + hstep, voffB); PG8_STAGE(PG8_SA(0, 1), cA + hstep, voffA);
        if (wr == 1) PG8_BAR;
        PG8_WAIT_V(4); PG8_BAR;
        PG8_STAGE(PG8_SB(1, 0), cB + kstep, voffB); PG8_STAGE(PG8_SA(1, 0), cA + kstep, voffA); PG8_STAGE(PG8_SB(1, 1), cB + hstep + kstep, voffB);
        PG8_WAIT_V(6); PG8_BAR;
    }
    for (;;) {
        const bool has_next = S.next(ui + 1, nxt);
        const char* nA = has_next ? (const char*)g.A + (size_t)nxt.pm * tstep + (size_t)nxt.kt0 * kstep : cA; const char* nB = has_next ? (const char*)g.Bt + S.bt_off(nxt) + (size_t)nxt.pn * tstep + (size_t)nxt.kt0 * kstep : cB;
        const int nt = cur.nkt;
        for (int t = 0; t < nt; t += 2) {
            const bool last = (t == nt - 2);
            const char* a1 = cA + (size_t)(t + 1) * kstep;
            const char* a2 = last ? nA : cA + (size_t)(t + 2) * kstep; const char* b2 = last ? nB : cB + (size_t)(t + 2) * kstep;
            const char* a3 = a2 + kstep; const char* b3 = b2 + kstep;
            if (last && has_next) S.a_ready(nxt);
            if constexpr (SP2) {
            PG8_LDB(B0, 0, 0); PG8_LDB(B1, 0, 1); PG8_SCHED; PG8_LDA(At, 0, 0); PG8_STAGE(PG8_SA(1, 1), a1 + hstep, voffA);
            PG8_WAIT_V(8); PG8_WAIT_L(0); PG8_BAR; PG8_MMA(0, 0, At, B0); PG8_MMA(0, 1, At, B1); PG8_BAR; PG8_SCHED;
            PG8_LDA(At, 0, 1); PG8_STAGE(PG8_SB(0, 0), b2, voffB); PG8_STAGE(PG8_SB(0, 1), b2 + hstep, voffB); PG8_STAGE(PG8_SA(0, 0), a2, voffA);
            PG8_WAIT_V(8); PG8_WAIT_L(0); PG8_BAR; PG8_MMA(1, 0, At, B0); PG8_MMA(1, 1, At, B1); PG8_BAR; PG8_SCHED;
            PG8_LDB(B0, 1, 0); PG8_LDB(B1, 1, 1); PG8_SCHED; PG8_LDA(At, 1, 0); PG8_STAGE(PG8_SA(0, 1), a2 + hstep, voffA);
            PG8_WAIT_V(8); PG8_WAIT_L(0); PG8_BAR; PG8_MMA(0, 0, At, B0); PG8_MMA(0, 1, At, B1); PG8_BAR; PG8_SCHED;
            PG8_LDA(At, 1, 1); PG8_STAGE(PG8_SB(1, 0), b3, voffB); PG8_STAGE(PG8_SB(1, 1), b3 + hstep, voffB); PG8_STAGE(PG8_SA(1, 0), a3, voffA);
            PG8_WAIT_V(8); PG8_WAIT_L(0); PG8_BAR; PG8_MMA(1, 0, At, B0); PG8_MMA(1, 1, At, B1); PG8_BAR; PG8_SCHED;
            } else {
            PG8_LDB(B0, 0, 0); PG8_SCHED; PG8_LDA(At, 0, 0); PG8_STAGE(PG8_SA(1, 1), a1 + hstep, voffA);
            PG8_WAIT_L(8); PG8_BAR; PG8_WAIT_L(0); PG8_MMA(0, 0, At, B0); PG8_BAR; PG8_SCHED;
            PG8_LDB(B1, 0, 1); PG8_STAGE(PG8_SB(0, 0), b2, voffB);
            PG8_BAR; PG8_WAIT_L(0); PG8_MMA(0, 1, At, B1); PG8_BAR;
            PG8_LDA(At, 0, 1); PG8_STAGE(PG8_SA(0, 0), a2, voffA);
            PG8_BAR; PG8_WAIT_L(0); PG8_MMA(1, 0, At, B0); PG8_BAR; PG8_SCHED;
            PG8_STAGE(PG8_SB(0, 1), b2 + hstep, voffB);
            PG8_WAIT_V(6); PG8_BAR; PG8_MMA(1, 1, At, B1); PG8_BAR;
            PG8_LDB(B0, 1, 0); PG8_SCHED; PG8_LDA(At, 1, 0); PG8_STAGE(PG8_SA(0, 1), a2 + hstep, voffA);
            PG8_WAIT_L(8); PG8_BAR; PG8_WAIT_L(0); PG8_MMA(0, 0, At, B0); PG8_BAR; PG8_SCHED;
            PG8_LDB(B1, 1, 1); PG8_STAGE(PG8_SB(1, 0), b3, voffB);
            PG8_BAR; PG8_WAIT_L(0); PG8_MMA(0, 1, At, B1); PG8_BAR;
            PG8_LDA(At, 1, 1); PG8_STAGE(PG8_SA(1, 0), a3, voffA);
            PG8_BAR; PG8_WAIT_L(0); PG8_MMA(1, 0, At, B0); PG8_BAR; PG8_SCHED;
            PG8_STAGE(PG8_SB(1, 1), b3 + hstep, voffB);
            PG8_WAIT_V(6); PG8_BAR; PG8_MMA(1, 1, At, B1); PG8_BAR;
            }
        }
        if constexpr (ALIGN_EPI) { if (wr == 0) PG8_BAR; }
        if constexpr (DT == 1) asm volatile("s_nop 15\n\ts_nop 15" ::: "memory");
        if constexpr (!Epi::AFTER_DRAIN) { E(acc, cur, wr, wc, fr, fq); S.done(cur); }
        if (!has_next) break;
#pragma unroll
        for (int a = 0; a < 2; ++a)
#pragma unroll
            for (int b = 0; b < 2; ++b)
#pragma unroll
                for (int m = 0; m < 4; ++m)
#pragma unroll
                    for (int n = 0; n < 2; ++n) acc[a][b][m][n] = (f32x4){0.f, 0.f, 0.f, 0.f};
        cur = nxt; cA = nA; cB = nB; ++ui;
        if constexpr (ALIGN_EPI) { if (wr == 1) PG8_BAR; }
    }
    PG8_WAIT_V(0);
    if constexpr (!ALIGN_EPI) { if (wr == 0) PG8_BAR; }
    PG8_BAR;
    if constexpr (Epi::AFTER_DRAIN) { E.fused(acc, cur, wr, wc, fr, fq, lds, wid, lane); S.done(cur); }
#undef PG8_SA
#undef PG8_SB
#undef PG8_STAGE
#undef PG8_LDA
#undef PG8_LDB
#undef PG8_MMA
#undef PG8_WAIT_V
#undef PG8_WAIT_L
#undef PG8_BAR
#undef PG8_SCHED
}
}

namespace pg8 {
__device__ __forceinline__ u32x4 pack8(const f32x4 v0, const f32x4 v1) { u32x4 w; w.x = cvt_pk_bf16(v0[0], v0[1]); w.y = cvt_pk_bf16(v0[2], v0[3]); w.z = cvt_pk_bf16(v1[0], v1[1]); w.w = cvt_pk_bf16(v1[2], v1[3]); return w; }
struct EpiStore {
    static constexpr bool PERM = true, AFTER_DRAIN = false;
    bf16_t* O; int ldc;
    __device__ __forceinline__ void operator()(const f32x4 (&acc)[2][2][4][2], const Unit& u, int wr, int wc, int fr, int fq) const {
        const int row0 = u.pm * BM + wr * 64 + fr, col0 = u.pn * BM + wc * 32 + 8 * fq;
#pragma unroll
        for (int ai = 0; ai < 2; ++ai)
#pragma unroll
            for (int m = 0; m < 4; ++m) { bf16_t* rowp = O + (size_t)(row0 + ai * HALF + m * 16) * ldc + col0;
#pragma unroll
                for (int bj = 0; bj < 2; ++bj) *(u32x4*)(rowp + bj * HALF) = pack8(acc[ai][bj][m][0], acc[ai][bj][m][1]); }
    }
};
struct EpiQ {
    static constexpr bool PERM = true, AFTER_DRAIN = false;
    bf16_t* O; const float* cosT; const float* sinT;
    __device__ __forceinline__ void operator()(const f32x4 (&acc)[2][2][4][2], const Unit& u, int wr, int wc, int fr, int fq) const {
        const int row0 = u.pm * BM + wr * 64 + fr, col0 = u.pn * BM + wc * 32 + 8 * fq;
#pragma unroll
        for (int ai = 0; ai < 2; ++ai)
#pragma unroll
            for (int m = 0; m < 4; ++m) { const int row = row0 + ai * HALF + m * 16; const bool lat = row < 8192; const int t = row & 2047;
#pragma unroll
                for (int bj = 0; bj < 2; ++bj) { const int col = col0 + bj * HALF; const int jn = col - 192 * (col / 192);
                    f32x4 v0 = acc[ai][bj][m][0], v1 = acc[ai][bj][m][1];
                    if (jn >= 128 && lat) { const int i0 = (jn - 128) >> 1;
                        const f32x4 cs = *(const f32x4*)(cosT + t * 32 + i0), sn = *(const f32x4*)(sinT + t * 32 + i0);
                        f32x4 r0, r1;
                        r0[0] = v0[0] * cs[0] - v0[1] * sn[0]; r0[1] = v0[0] * sn[0] + v0[1] * cs[0];
                        r0[2] = v0[2] * cs[1] - v0[3] * sn[1]; r0[3] = v0[2] * sn[1] + v0[3] * cs[1];
                        r1[0] = v1[0] * cs[2] - v1[1] * sn[2]; r1[1] = v1[0] * sn[2] + v1[1] * cs[2];
                        r1[2] = v1[2] * cs[3] - v1[3] * sn[3]; r1[3] = v1[2] * sn[3] + v1[3] * cs[3];
                        v0 = r0; v1 = r1; }
                    *(u32x4*)(O + (size_t)row * 1536 + col) = pack8(v0, v1); } }
    }
};
struct EpiResid {
    static constexpr bool PERM = false, AFTER_DRAIN = false;
    float* xs; const float* gate; float* slab; int tail_row0, tail_rows; float scale;
    __device__ __forceinline__ void operator()(const f32x4 (&acc)[2][2][4][2], const Unit& u, int wr, int wc, int fr, int fq) const {
        const int row0 = u.pm * BM + wr * 64 + fr, colb = u.pn * BM + wc * 32 + 4 * fq;
        if (u.slab >= 0) {
#pragma unroll
            for (int ai = 0; ai < 2; ++ai)
#pragma unroll
                for (int m = 0; m < 4; ++m) { float* sp = slab + ((size_t)u.slab * tail_rows + (row0 + ai * HALF + m * 16 - tail_row0)) * 2048;
#pragma unroll
                    for (int bj = 0; bj < 2; ++bj)
#pragma unroll
                        for (int n = 0; n < 2; ++n) *(f32x4*)(sp + colb + bj * HALF + n * 16) = acc[ai][bj][m][n] * scale; }
            return;
        }
#pragma unroll
        for (int ai = 0; ai < 2; ++ai)
#pragma unroll
            for (int m = 0; m < 4; ++m) { const int row = row0 + ai * HALF + m * 16; const float* gv = gate + (size_t)(row < 8192 ? (row >> 11) : 4) * 12288; float* xr = xs + (size_t)row * 2048;
#pragma unroll
                for (int bj = 0; bj < 2; ++bj)
#pragma unroll
                    for (int n = 0; n < 2; ++n) { const int col = colb + bj * HALF + n * 16; f32x4 x = *(const f32x4*)(xr + col); const f32x4 g = *(const f32x4*)(gv + col);
                        x += (g * scale) * acc[ai][bj][m][n]; *(f32x4*)(xr + col) = x; }
                if (m & 1) asm volatile("" ::: "memory"); }
    }
};
__device__ __forceinline__ unsigned pack4_fp8(float a, float b, float c, float d) {
    a = __builtin_amdgcn_fmed3f(a, -448.f, 448.f); b = __builtin_amdgcn_fmed3f(b, -448.f, 448.f); c = __builtin_amdgcn_fmed3f(c, -448.f, 448.f); d = __builtin_amdgcn_fmed3f(d, -448.f, 448.f);
    unsigned w = 0; w = __builtin_amdgcn_cvt_pk_fp8_f32(a, b, w, false); w = __builtin_amdgcn_cvt_pk_fp8_f32(c, d, w, true); return w; }
struct EpiSwiGLU8 {
    static constexpr bool PERM = true, AFTER_DRAIN = false;
    unsigned char* O; int ldc; float s, oscale;
    __device__ __forceinline__ void operator()(const f32x4 (&acc)[2][2][4][2], const Unit& u, int wr, int wc, int fr, int fq) const {
        const int row0 = u.pm * BM + wr * 64 + fr, col0 = u.pn * HALF + wc * 32 + 8 * fq;
#pragma unroll
        for (int ai = 0; ai < 2; ++ai)
#pragma unroll
            for (int m = 0; m < 4; ++m) { f32x4 o0, o1;
#pragma unroll
                for (int j = 0; j < 4; ++j) { const float g0 = acc[ai][0][m][0][j] * s, g1 = acc[ai][0][m][1][j] * s;
                    o0[j] = g0 * __builtin_amdgcn_rcpf(1.0f + __expf(-g0)) * (acc[ai][1][m][0][j] * (s * oscale)); o1[j] = g1 * __builtin_amdgcn_rcpf(1.0f + __expf(-g1)) * (acc[ai][1][m][1][j] * (s * oscale)); }
                u32x2 w; w.x = pack4_fp8(o0[0], o0[1], o0[2], o0[3]); w.y = pack4_fp8(o1[0], o1[1], o1[2], o1[3]);
                *(u32x2*)(O + (size_t)(row0 + ai * HALF + m * 16) * ldc + col0) = w; }
    }
};
__device__ __forceinline__ f32x4 i2f4(const f32x4 bits) { const v4i_t iv = __builtin_bit_cast(v4i_t, bits); return (f32x4){(float)iv[0], (float)iv[1], (float)iv[2], (float)iv[3]}; }
struct EpiStoreI8 {
    static constexpr bool PERM = true, AFTER_DRAIN = false;
    bf16_t* O; int ldc; const float* rsc; float sw;
    __device__ __forceinline__ void operator()(const f32x4 (&acc)[2][2][4][2], const Unit& u, int wr, int wc, int fr, int fq) const {
        const int row0 = u.pm * BM + wr * 64 + fr, col0 = u.pn * BM + wc * 32 + 8 * fq;
#pragma unroll
        for (int ai = 0; ai < 2; ++ai)
#pragma unroll
            for (int m = 0; m < 4; ++m) { const int row = row0 + ai * HALF + m * 16; const float sc = rsc[row] * sw; bf16_t* rowp = O + (size_t)row * ldc + col0;
#pragma unroll
                for (int bj = 0; bj < 2; ++bj) *(u32x4*)(rowp + bj * HALF) = pack8(i2f4(acc[ai][bj][m][0]) * sc, i2f4(acc[ai][bj][m][1]) * sc); }
    }
};
struct EpiSwiGLUI8 {
    static constexpr bool PERM = true, AFTER_DRAIN = false;
    unsigned char* O; int ldc; const float* rsc; float swg, swu, oscale;
    __device__ __forceinline__ void operator()(const f32x4 (&acc)[2][2][4][2], const Unit& u, int wr, int wc, int fr, int fq) const {
        const int row0 = u.pm * BM + wr * 64 + fr, col0 = u.pn * HALF + wc * 32 + 8 * fq;
#pragma unroll
        for (int ai = 0; ai < 2; ++ai)
#pragma unroll
            for (int m = 0; m < 4; ++m) { const int row = row0 + ai * HALF + m * 16; const float sa = rsc[row], sg = sa * swg, su = sa * swu * oscale; f32x4 o0, o1;
                const f32x4 g0v = i2f4(acc[ai][0][m][0]) * sg, g1v = i2f4(acc[ai][0][m][1]) * sg, u0v = i2f4(acc[ai][1][m][0]) * su, u1v = i2f4(acc[ai][1][m][1]) * su;
#pragma unroll
                for (int j = 0; j < 4; ++j) { o0[j] = g0v[j] * __builtin_amdgcn_rcpf(1.0f + __expf(-g0v[j])) * u0v[j]; o1[j] = g1v[j] * __builtin_amdgcn_rcpf(1.0f + __expf(-g1v[j])) * u1v[j]; }
                u32x2 w; w.x = pack4_fp8(o0[0], o0[1], o0[2], o0[3]); w.y = pack4_fp8(o1[0], o1[1], o1[2], o1[3]);
                *(u32x2*)(O + (size_t)row * ldc + col0) = w; }
    }
};
struct EpiSwiGLU {
    static constexpr bool PERM = true, AFTER_DRAIN = false;
    bf16_t* O; int ldc;
    __device__ __forceinline__ void operator()(const f32x4 (&acc)[2][2][4][2], const Unit& u, int wr, int wc, int fr, int fq) const {
        const int row0 = u.pm * BM + wr * 64 + fr, col0 = u.pn * HALF + wc * 32 + 8 * fq;
#pragma unroll
        for (int ai = 0; ai < 2; ++ai)
#pragma unroll
            for (int m = 0; m < 4; ++m) { f32x4 o0, o1;
#pragma unroll
                for (int j = 0; j < 4; ++j) { const float g0 = acc[ai][0][m][0][j], g1 = acc[ai][0][m][1][j];
                    o0[j] = g0 / (1.0f + __expf(-g0)) * acc[ai][1][m][0][j]; o1[j] = g1 / (1.0f + __expf(-g1)) * acc[ai][1][m][1][j]; }
                *(u32x4*)(O + (size_t)(row0 + ai * HALF + m * 16) * ldc + col0) = pack8(o0, o1); }
    }
};
struct EpiF32 {
    static constexpr bool PERM = false, AFTER_DRAIN = false;
    float* O; int ldc; float* slab; int tail_row0, tail_rows; float scale;
    __device__ __forceinline__ void operator()(const f32x4 (&acc)[2][2][4][2], const Unit& u, int wr, int wc, int fr, int fq) const {
        const int row0 = u.pm * BM + wr * 64 + fr, colb = u.pn * BM + wc * 32 + 4 * fq;
#pragma unroll
        for (int ai = 0; ai < 2; ++ai)
#pragma unroll
            for (int m = 0; m < 4; ++m) { float* xr = (u.slab >= 0) ? slab + ((size_t)u.slab * tail_rows + (row0 + ai * HALF + m * 16 - tail_row0)) * 2048 : O + (size_t)(row0 + ai * HALF + m * 16) * ldc;
#pragma unroll
                for (int bj = 0; bj < 2; ++bj)
#pragma unroll
                    for (int n = 0; n < 2; ++n) *(f32x4*)(xr + colb + bj * HALF + n * 16) = acc[ai][bj][m][n] * scale; }
    }
};
struct EpiYs {
    static constexpr bool PERM = false, AFTER_DRAIN = false;
    bf16_t* O; float* slab; int tail_row0, tail_rows; float scale;
    __device__ __forceinline__ void operator()(const f32x4 (&acc)[2][2][4][2], const Unit& u, int wr, int wc, int fr, int fq) const {
        const int row0 = u.pm * BM + wr * 64 + fr, colb = u.pn * BM + wc * 32 + 4 * fq;
        if (u.slab >= 0) {
#pragma unroll
            for (int ai = 0; ai < 2; ++ai)
#pragma unroll
                for (int m = 0; m < 4; ++m) { float* sp = slab + ((size_t)u.slab * tail_rows + (row0 + ai * HALF + m * 16 - tail_row0)) * 2048;
#pragma unroll
                    for (int bj = 0; bj < 2; ++bj)
#pragma unroll
                        for (int n = 0; n < 2; ++n) *(f32x4*)(sp + colb + bj * HALF + n * 16) = acc[ai][bj][m][n] * scale; }
            return;
        }
#pragma unroll
        for (int ai = 0; ai < 2; ++ai)
#pragma unroll
            for (int m = 0; m < 4; ++m) { bf16_t* xr = O + (size_t)(row0 + ai * HALF + m * 16) * 2048;
#pragma unroll
                for (int bj = 0; bj < 2; ++bj)
#pragma unroll
                    for (int n = 0; n < 2; ++n) { const f32x4 v = acc[ai][bj][m][n] * scale; u32x2 w; w.x = cvt_pk_bf16(v[0], v[1]); w.y = cvt_pk_bf16(v[2], v[3]); *(u32x2*)(xr + colb + bj * HALF + n * 16) = w; } }
    }
};
struct MoeOrder {
    int nM, nN, nwg, G, c, nkt; int t1[8]; size_t estride;
    __device__ __forceinline__ void init(const int* ctl, int nN_, int G_, int c_, size_t estride_, int K) { nkt = K / BK;
        int acc = 0;
#pragma unroll
        for (int e = 0; e < 8; ++e) { acc += __builtin_amdgcn_readfirstlane(ctl[CT_EPAD + e]) >> 8; t1[e] = acc; }
        nM = acc; nN = nN_; nwg = nM * nN; G = G_; c = c_; estride = estride_;
    }
    __device__ __forceinline__ bool next(int i, Unit& u) const {
        const long L = (long)i * G + c; if (L >= nwg) return false;
        int wgid = (int)L; { const int q = nwg / NXCD, r = nwg % NXCD, xcd = wgid % NXCD, off = wgid / NXCD; wgid = (xcd < r ? xcd * (q + 1) : r * (q + 1) + (xcd - r) * q) + off; }
        const int nig = WGM * nN, gid = wgid / nig, fm = gid * WGM, gsz = (nM - fm) < WGM ? (nM - fm) : WGM;
        u.pm = fm + ((wgid % nig) % gsz); u.pn = (wgid % nig) / gsz; u.kt0 = 0; u.nkt = nkt; u.slab = -1; return true;
    }
    __device__ __forceinline__ size_t bt_off(const Unit& u) const { int e = 0;
#pragma unroll
        for (int k = 0; k < 7; ++k) e += (u.pm >= t1[k]) ? 1 : 0;
        return (size_t)e * estride; }
    __device__ __forceinline__ void a_ready(const Unit&) const {}
    __device__ __forceinline__ void done(const Unit&) const {}
};
struct WinLastOrder {
    StaticOrder so; int G, c;
    __device__ __forceinline__ void init(int G_, int c_, int K) { so.init(NLAT, UW, G_, c_, K); G = G_; c = c_; }
    __device__ __forceinline__ bool next(int i, Unit& u) const {
        if (so.next(i, u)) return true;
        const long L = (long)i * G + c - so.nwg; if (L < 0 || L >= 20) return false;
        const int j = (int)L, k = j % 5; u.pm = 32 + j / 5; u.pn = k < 3 ? 3 + k : 10 + k; u.kt0 = 0; u.nkt = so.nkt; u.slab = -1; return true;
    }
    __device__ __forceinline__ size_t bt_off(const Unit&) const { return 0; }
    __device__ __forceinline__ void a_ready(const Unit&) const {}
    __device__ __forceinline__ void done(const Unit&) const {}
};
struct SplitOrder {
    int nM, nN, nwg, G, c, nfull, ntail, S, nkt, nkts; int t1[8]; size_t estride;
    __device__ __forceinline__ void init(int nM_, int nN_, int G_, int c_, int K, int S_) {
        nM = nM_; nN = nN_; nwg = nM * nN; G = G_; c = c_; nkt = K / BK; nfull = (nwg / 256) * 256; ntail = nwg - nfull; S = S_; nkts = nkt / S; estride = 0;
#pragma unroll
        for (int e = 0; e < 8; ++e) t1[e] = 0;
    }
    __device__ __forceinline__ void init_moe(const int* ctl, int nN_, int G_, int c_, int K, size_t estride_) {
        int acc = 0;
#pragma unroll
        for (int e = 0; e < 8; ++e) { acc += __builtin_amdgcn_readfirstlane(ctl[CT_EPAD + e]) >> 8; t1[e] = acc; }
        init(acc, nN_, G_, c_, K, __builtin_amdgcn_readfirstlane(ctl[CT_MOES])); estride = estride_;
        acc = 0;
#pragma unroll
        for (int e = 0; e < 8; ++e) { acc += __builtin_amdgcn_readfirstlane(ctl[CT_EPAD + e]) >> 8; t1[e] = acc; }
    }
    __device__ __forceinline__ bool next(int i, Unit& u) const {
        const long L = (long)i * G + c; int wgid;
        if (L < nfull) { wgid = (int)L; { const int q = nfull / NXCD, xcd = wgid % NXCD, off = wgid / NXCD; wgid = xcd * q + off; } u.kt0 = 0; u.nkt = nkt; u.slab = -1; }
        else { const int j = (int)(L - nfull); if (j >= ntail * S) return false; const int tu = j / S, sl = j - tu * S; wgid = nfull + tu; u.kt0 = sl * nkts; u.nkt = nkts; u.slab = (S > 1) ? sl : -1; }
        const int nig = WGM * nN, gid = wgid / nig, fm = gid * WGM, gsz = (nM - fm) < WGM ? (nM - fm) : WGM;
        u.pm = fm + ((wgid % nig) % gsz); u.pn = (wgid % nig) / gsz; return true;
    }
    __device__ __forceinline__ size_t bt_off(const Unit& u) const { if (estride == 0) return 0; int e = 0;
#pragma unroll
        for (int k = 0; k < 7; ++k) e += (u.pm >= t1[k]) ? 1 : 0;
        return (size_t)e * estride; }
    __device__ __forceinline__ void a_ready(const Unit&) const {}
    __device__ __forceinline__ void done(const Unit&) const {}
};
__host__ __device__ constexpr int split_S(int nwg, int nkt, int G) {
    const int ntail = nwg - (nwg / G) * G;
    if (ntail == 0) return 1;
    if (nkt % 28 == 0 && ntail * 14 <= G) return 14;
    if (nkt % 16 == 0 && ntail * 8 <= G) return 8;
    if (nkt % 14 == 0 && ntail * 7 <= G) return 7;
    if (nkt % 8 == 0 && ntail * 4 <= G) return 4;
    if (nkt % 4 == 0 && ntail * 2 <= G) return 2;
    return 1;
}
}

#define LAS __attribute__((address_space(3)))
#define XB_TMO      128
#define XB_XCNT(j)  (256  + 64 * (j))
#define XB_XSUB(j)  (1280 + 64 * (j))
#define XB_XGEN(j)  (2304 + 64 * (j))
#define XB_TOP      3328
#define XB_TOPGEN   3392
#define XCD_BAR_WORDS 3456
#define XB_SPIN_CAP (1u << 18)

__device__ __forceinline__ unsigned xb_ld(unsigned* p)              { return __hip_atomic_load(p, __ATOMIC_RELAXED, __HIP_MEMORY_SCOPE_AGENT); }
__device__ __forceinline__ unsigned xb_add(unsigned* p, unsigned v) { return __hip_atomic_fetch_add(p, v, __ATOMIC_RELAXED, __HIP_MEMORY_SCOPE_AGENT); }
__device__ __forceinline__ unsigned xb_xcc_id() { return (unsigned)__builtin_amdgcn_s_getreg((3 << 11) | 20) & 0xFu; }
#define XB_SPIN(cond, bar) do { unsigned _sp = 0; while (cond) { __builtin_amdgcn_s_sleep(1); \
    if ((++_sp & 255u) == 0u) { if (xb_ld(&(bar)[XB_TMO])) break; if (_sp > XB_SPIN_CAP) { atomicAdd(&(bar)[XB_TMO], 1u); break; } } } } while (0)

struct XcdBarrier {
    unsigned* bar; unsigned x;
    volatile LAS unsigned* st;
};

__device__ __forceinline__ XcdBarrier xcd_barrier_post(unsigned* bar, volatile LAS unsigned* st) {
    XcdBarrier b; b.bar = bar; b.x = xb_xcc_id(); b.st = st;
    if (threadIdx.x == 0) (void)xb_add(&bar[XB_XCNT(b.x)], 1u);
    return b;
}
__device__ __forceinline__ void xcd_barrier_complete(unsigned* bar, unsigned x, unsigned& nloc, unsigned& nx) {
    const unsigned G = gridDim.x * gridDim.y * gridDim.z;
    unsigned sum, cnt, mine, sp = 0u;
    for (;;) {
        sum = 0u; cnt = 0u; mine = 0u;
#pragma unroll
        for (unsigned j = 0; j < 16; ++j) { const unsigned c = xb_ld(&bar[XB_XCNT(j)]); sum += c; cnt += (c > 0u) ? 1u : 0u; mine = (j == x) ? c : mine; }
        if (sum == G) break;
        __builtin_amdgcn_s_sleep(1);
        if ((++sp & 255u) == 0u) { if (xb_ld(&bar[XB_TMO])) break; if (sp > XB_SPIN_CAP) { atomicAdd(&bar[XB_TMO], 1u); break; } }
    }
    nloc = mine > 0u ? mine : 1u; nx = cnt > 0u ? cnt : 1u;
}

__device__ __forceinline__ void xcd_barrier(const XcdBarrier& b) {
    asm volatile("s_waitcnt vmcnt(0)" ::: "memory");
    __syncthreads();
    if (threadIdx.x == 0) {
        unsigned* bar = b.bar;
        __builtin_amdgcn_s_waitcnt(0);
        unsigned nloc = b.st[0], nx = b.st[1];
        if (nloc == 0u) { xcd_barrier_complete(bar, b.x, nloc, nx); b.st[0] = nloc; b.st[1] = nx; }
        const unsigned old = xb_add(&bar[XB_XSUB(b.x)], 1u);
        const unsigned gen = old / nloc;
        if (old + 1u == (gen + 1u) * nloc) {
            __builtin_amdgcn_fence(__ATOMIC_RELEASE, "agent");
            asm volatile("s_waitcnt vmcnt(0)" ::: "memory");
            const unsigned og = xb_add(&bar[XB_TOP], 1u);
            const unsigned tg = og / nx;
            if (og + 1u == (tg + 1u) * nx) xb_add(&bar[XB_TOPGEN], 1u);
            else XB_SPIN(xb_ld(&bar[XB_TOPGEN]) == tg, bar);
            __builtin_amdgcn_fence(__ATOMIC_ACQUIRE, "agent");
            xb_add(&bar[XB_XGEN(b.x)], 1u);
            asm volatile("s_waitcnt vmcnt(0)" ::: "memory");
        } else {
            XB_SPIN(xb_ld(&bar[XB_XGEN(b.x)]) == gen, bar);
            __builtin_amdgcn_fence(__ATOMIC_ACQUIRE, "agent");
            asm volatile("s_waitcnt vmcnt(0)" ::: "memory");
        }
    }
    __syncthreads();
}


struct Args { const float* in[34]; float* out; unsigned char* ws; int ph_lo, ph_hi; };

enum { MAP_ID = 0, MAP_ROPEQ = 1, MAP_GU0 = 2, MAP_GU1 = 3, MAP_KV = 4 };
struct JobDesc { int in_idx, K, N, nbatch, upb, map; long long src_off, src_bstride, dst_off, dst_bstride; int fp8, sidx; };
constexpr int NJOBS = 14, NCONV = 12664;
constexpr int TAIL1_BLK0 = 28, TAIL1_N = 228, TAIL2_BLK0 = 48, TAIL2_N = 208;
constexpr int TAIL3_BLK0 = 64, TAIL3_N = 192, TAIL4_BLK0 = 32, TAIL4_N = 224;
constexpr int NCONV_T1 = TAIL1_N * TAILQ1, NCONV_T2 = TAIL2_N * TAILQ2, NCONV_T3 = TAIL3_N * TAILQ3, NCONV_T4 = TAIL4_N * TAILQ4, NCONV_Q = NCONV - NCONV_T1 - NCONV_T2 - NCONV_T3 - NCONV_T4;
static_assert(NCONV_Q % 2 == 0 && TAILQ1 % 2 == 0 || true, "");
__constant__ JobDesc c_jobs[NJOBS] = {
    {8, 2048, 3648, 1, 232, MAP_ID, 0, 0, (long long)WS_WIN, 0, I8_WIN ? 2 : 0, 0},
    {8, 2048, 3648, 1, 232, MAP_ID, 2048LL * 3648, 0, (long long)(WS_WIN + (size_t)UW * D * 2), 0, I8_WIN ? 2 : 0, 1},
    {10, 768, 1536, 1, 36, MAP_ROPEQ, 0, 0, (long long)WS_WQ, 0},
    {10, 768, 1536, 1, 36, MAP_ROPEQ, 768LL * 1536, 0, (long long)(WS_WQ + (size_t)QW * 768 * 2), 0},
    {12, 512, 2048, 1, 32, MAP_KV, 0, 0, (long long)WS_WKV, 0},
    {12, 512, 2048, 1, 32, MAP_KV, 512LL * 2048, 0, (long long)(WS_WKV + (size_t)KVW * 512 * 2), 0},
    {25, 2048, 2048, 1, 128, MAP_ID, 0, 0, (long long)WS_WOUT, 0},
    {25, 2048, 2048, 1, 128, MAP_ID, 2048LL * 2048, 0, (long long)(WS_WOUT + (size_t)D * D * 2), 0},
    {26, 2048, 5632, 1, 352, MAP_GU0, 0, 0, (long long)WS_WGU, 0, I8_GU ? 2 : FP8_DENSE, 2},
    {27, 2048, 5632, 1, 352, MAP_GU1, 0, 0, (long long)WS_WGU, 0, I8_GU ? 2 : FP8_DENSE, 3},
    {28, 5632, 2048, 1, 352, MAP_ID, 0, 0, (long long)WS_WDN, 0, (FP8_DENSE || FP8_DOWN), 0},
    {30, 2048, 7168, 8, 448, MAP_GU0, 0, 2048LL * 7168, (long long)WS_MGU, 2LL * DFE * D, 1, 0},
    {31, 2048, 7168, 8, 448, MAP_GU1, 0, 2048LL * 7168, (long long)WS_MGU, 2LL * DFE * D, 1, 0},
    {32, 7168, 2048, 8, 448, MAP_ID, 0, 7168LL * 2048, (long long)WS_MDN, (long long)D * DFE, 1, 0},
};
struct ConvUnit { const float* src; bf16_t* dst; int K, N, map, k0, n0, fp8; float qs; };
__device__ __forceinline__ unsigned pack4_i8(float a, float b, float c, float d) {
    const int ia = (int)__builtin_rintf(__builtin_amdgcn_fmed3f(a, -127.f, 127.f)), ib = (int)__builtin_rintf(__builtin_amdgcn_fmed3f(b, -127.f, 127.f)), ic = (int)__builtin_rintf(__builtin_amdgcn_fmed3f(c, -127.f, 127.f)), id = (int)__builtin_rintf(__builtin_amdgcn_fmed3f(d, -127.f, 127.f));
    return (unsigned)(ia & 0xff) | ((unsigned)(ib & 0xff) << 8) | ((unsigned)(ic & 0xff) << 16) | ((unsigned)(id & 0xff) << 24); }
constexpr float WSCALE = 64.f, ASCALE = 8.f;
__device__ __forceinline__ void conv_decode(const Args& a, int u, ConvUnit& cu) {
    int j = 0, base = 0;
    for (;;) { const int n = c_jobs[j].nbatch * c_jobs[j].upb; if (u < base + n || j == NJOBS - 1) break; base += n; ++j; }
    const JobDesc& jd = c_jobs[j];
    int r = u - base; const int bt = r / jd.upb; r -= bt * jd.upb; const int ntn = (jd.N + 127) >> 7; int kt = r / ntn, nt = r - kt * ntn;
    if (((jd.K >> 8) & 1) == 0) { const int r2 = r >> 1; kt = 2 * (r2 / ntn) + (r & 1); nt = r2 % ntn; }
    cu.K = jd.K; cu.N = jd.N; cu.map = jd.map; cu.k0 = kt * 256; cu.n0 = nt * 128; cu.fp8 = jd.fp8; cu.qs = 1.0f;
    if (jd.fp8 == 2) { const float am = __uint_as_float(__hip_atomic_load((const unsigned*)(a.ws + WS_CTL) + CT_WSC + jd.sidx, __ATOMIC_RELAXED, __HIP_MEMORY_SCOPE_AGENT)); cu.qs = am > 0.f ? 127.0f / am : 0.f; }
    const float* sb = j < 2 ? a.in[8] : j < 4 ? a.in[10] : j < 6 ? a.in[12] : j < 8 ? a.in[25] : j == 8 ? a.in[26] : j == 9 ? a.in[27] : j == 10 ? a.in[28] : j == 11 ? a.in[30] : j == 12 ? a.in[31] : a.in[32];
    cu.src = sb + jd.src_off + (long long)bt * jd.src_bstride + (size_t)cu.k0 * jd.N + cu.n0;
    cu.dst = (bf16_t*)(a.ws + jd.dst_off + (long long)bt * jd.dst_bstride);
}
__device__ __forceinline__ int conv_row(int map, int n) {
    if (map == MAP_ID) return n;
    if (map == MAP_GU0) return ((n >> 7) << 8) + (n & 127);
    if (map == MAP_GU1) return ((n >> 7) << 8) + 128 + (n & 127);
    if (map == MAP_KV) { const int hh = n >> 8, jn = n & 255; return jn < 128 ? hh * 128 + jn : 1024 + hh * 128 + (jn - 128); }
    const int hh = n / 192, jn = n - hh * 192; if (jn < 128) return n; const int q = jn - 128; return hh * 192 + 128 + 2 * (q & 31) + (q >> 5);
}
constexpr int CV_P = 129;
#define CONV_LOAD(R, CU) do { const bool ok_ = (CU).n0 + (tid & 31) * 4 < (CU).N; _Pragma("unroll") for (int i_ = 0; i_ < 16; ++i_) { const int row_ = 2 * ((tid >> 5) + 16 * (i_ >> 1)) + (i_ & 1); \
        R[i_] = ok_ ? __builtin_nontemporal_load((const f32x4*)((CU).src + (size_t)row_ * (CU).N + (tid & 31) * 4)) : (f32x4){0.f, 0.f, 0.f, 0.f}; } } while (0)
#define CONV_PUT(R, T) do { _Pragma("unroll") for (int i_ = 0; i_ < 16; ++i_) { const int row_ = 2 * ((tid >> 5) + 16 * (i_ >> 1)) + (i_ & 1); float* tp_ = (T) + row_ * CV_P + (tid & 31) * 4; \
        tp_[0] = R[i_][0]; tp_[1] = R[i_][1]; tp_[2] = R[i_][2]; tp_[3] = R[i_][3]; } } while (0)
__device__ __forceinline__ void conv_out(const ConvUnit& cur, const float* tile, int tid) {
    if (cur.fp8 == 2) {
        const float qs = cur.qs;
#pragma unroll
        for (int j = 0; j < 4; ++j) { const int kc = (tid & 7) + 8 * (j & 1), n = (tid >> 3) + 64 * (j >> 1);
            if (cur.n0 + n < cur.N) { const int row = conv_row(cur.map, cur.n0 + n); const float* tp = tile + (kc * 16) * CV_P + n; u32x4 w;
                w.x = pack4_i8(tp[0] * qs, tp[CV_P] * qs, tp[2 * CV_P] * qs, tp[3 * CV_P] * qs); w.y = pack4_i8(tp[4 * CV_P] * qs, tp[5 * CV_P] * qs, tp[6 * CV_P] * qs, tp[7 * CV_P] * qs);
                w.z = pack4_i8(tp[8 * CV_P] * qs, tp[9 * CV_P] * qs, tp[10 * CV_P] * qs, tp[11 * CV_P] * qs); w.w = pack4_i8(tp[12 * CV_P] * qs, tp[13 * CV_P] * qs, tp[14 * CV_P] * qs, tp[15 * CV_P] * qs);
                *(u32x4*)((unsigned char*)cur.dst + (size_t)row * cur.K + cur.k0 + kc * 16) = w; } }
    } else if (cur.fp8) {
#pragma unroll
        for (int j = 0; j < 4; ++j) { const int kc = (tid & 7) + 8 * (j & 1), n = (tid >> 3) + 64 * (j >> 1);
            if (cur.n0 + n < cur.N) { const int row = conv_row(cur.map, cur.n0 + n); const float* tp = tile + (kc * 16) * CV_P + n; u32x4 w;
                w.x = pg8::pack4_fp8(tp[0] * WSCALE, tp[CV_P] * WSCALE, tp[2 * CV_P] * WSCALE, tp[3 * CV_P] * WSCALE); w.y = pg8::pack4_fp8(tp[4 * CV_P] * WSCALE, tp[5 * CV_P] * WSCALE, tp[6 * CV_P] * WSCALE, tp[7 * CV_P] * WSCALE);
                w.z = pg8::pack4_fp8(tp[8 * CV_P] * WSCALE, tp[9 * CV_P] * WSCALE, tp[10 * CV_P] * WSCALE, tp[11 * CV_P] * WSCALE); w.w = pg8::pack4_fp8(tp[12 * CV_P] * WSCALE, tp[13 * CV_P] * WSCALE, tp[14 * CV_P] * WSCALE, tp[15 * CV_P] * WSCALE);
                *(u32x4*)((unsigned char*)cur.dst + (size_t)row * cur.K + cur.k0 + kc * 16) = w; } }
    } else {
#pragma unroll
        for (int j = 0; j < 8; ++j) { const int kc = (tid & 7) + 8 * (j & 3), n = (tid >> 3) + 64 * (j >> 2);
            if (cur.n0 + n < cur.N) { const int row = conv_row(cur.map, cur.n0 + n); const float* tp = tile + (kc * 8) * CV_P + n; u32x4 w;
                w.x = pg8::cvt_pk_bf16(tp[0], tp[CV_P]); w.y = pg8::cvt_pk_bf16(tp[2 * CV_P], tp[3 * CV_P]); w.z = pg8::cvt_pk_bf16(tp[4 * CV_P], tp[5 * CV_P]); w.w = pg8::cvt_pk_bf16(tp[6 * CV_P], tp[7 * CV_P]);
                *(u32x4*)(cur.dst + (size_t)row * cur.K + cur.k0 + kc * 8) = w; } }
    }
}
template <int MODE = 0>
__device__ __forceinline__ void ph_convert(const Args& a, float* tile, int first, int stride, int end) {
    const int tid = threadIdx.x;
    int u = first; ConvUnit cuA, cuB; f32x4 rA[16], rB[16];
#pragma unroll
    for (int i = 0; i < 16; ++i) { rA[i] = (f32x4){0.f, 0.f, 0.f, 0.f}; rB[i] = rA[i]; }
    if (u < end) { conv_decode(a, u, cuA); if (MODE != 2) CONV_LOAD(rA, cuA); }
    if (u + stride < end) { conv_decode(a, u + stride, cuB); if (MODE != 2) CONV_LOAD(rB, cuB); }
    while (u < end) {
        CONV_PUT(rA, tile);
        __syncthreads();
        { const ConvUnit cur = cuA; const int un = u + 2 * stride; if (un < end) { conv_decode(a, un, cuA); if (MODE != 2) CONV_LOAD(rA, cuA); } if (MODE != 1) conv_out(cur, tile, tid); }
        __syncthreads();
        u += stride; if (u >= end) break;
        CONV_PUT(rB, tile);
        __syncthreads();
        { const ConvUnit cur = cuB; const int un = u + 2 * stride; if (un < end) { conv_decode(a, un, cuB); if (MODE != 2) CONV_LOAD(rB, cuB); } if (MODE != 1) conv_out(cur, tile, tid); }
        __syncthreads();
        u += stride;
    }
}
constexpr int CT_QNEXT = 1152;
template <int MODE = 0>
__device__ __forceinline__ void conv_dynamic(const Args& a, float* tile) {
    unsigned* qn = (unsigned*)(a.ws + WS_CTL) + CT_QNEXT; volatile int* bc = (volatile int*)(tile + 256 * CV_P + 4);
    const int tid = threadIdx.x;
    if (tid == 0) { bc[0] = (int)__hip_atomic_fetch_add(qn, 1u, __ATOMIC_RELAXED, __HIP_MEMORY_SCOPE_AGENT); bc[1] = (int)__hip_atomic_fetch_add(qn, 1u, __ATOMIC_RELAXED, __HIP_MEMORY_SCOPE_AGENT); }
    __syncthreads();
    int q = bc[0], qN = bc[1];
    __syncthreads();
    ConvUnit cuA, cuB; f32x4 rA[16], rB[16];
#pragma unroll
    for (int i = 0; i < 16; ++i) { rA[i] = (f32x4){0.f, 0.f, 0.f, 0.f}; rB[i] = rA[i]; }
    if (2 * q < NCONV_Q) { conv_decode(a, 2 * q, cuA); if (MODE != 2) CONV_LOAD(rA, cuA); }
    if (2 * q + 1 < NCONV_Q) { conv_decode(a, 2 * q + 1, cuB); if (MODE != 2) CONV_LOAD(rB, cuB); }
    while (2 * q < NCONV_Q) {
        const bool hasB = 2 * q + 1 < NCONV_Q;
        CONV_PUT(rA, tile);
        __syncthreads();
        { const ConvUnit cur = cuA; if (2 * qN < NCONV_Q) { conv_decode(a, 2 * qN, cuA); if (MODE != 2) CONV_LOAD(rA, cuA); }
          if (tid == 0) bc[0] = (int)__hip_atomic_fetch_add(qn, 1u, __ATOMIC_RELAXED, __HIP_MEMORY_SCOPE_AGENT);
          if (MODE != 1) conv_out(cur, tile, tid); }
        __syncthreads();
        if (hasB) {
            CONV_PUT(rB, tile);
            __syncthreads();
            { const ConvUnit cur = cuB; if (2 * qN + 1 < NCONV_Q) { conv_decode(a, 2 * qN + 1, cuB); if (MODE != 2) CONV_LOAD(rB, cuB); }
              if (MODE != 1) conv_out(cur, tile, tid); }
            __syncthreads();
        }
        q = qN; qN = bc[0];
    }
    __syncthreads();
}
#undef CONV_LOAD
#undef CONV_PUT
constexpr int CONV_STATIC = 856, CONV_DENSE_END = 1912, CONV_BATCH = 2;
__device__ __forceinline__ constexpr int CT_DONE(int k) { return 1216 + 64 * k; }
__device__ __forceinline__ void conv_fill(const Args& a, float* tile, int done_idx) {
#if !CONV_FILL
    (void)a; (void)tile; (void)done_idx; return;
#endif
    unsigned* ctl = (unsigned*)(a.ws + WS_CTL); volatile int* bc = (volatile int*)(tile + 256 * CV_P + 4);
    const int tid = threadIdx.x;
    if (tid == 0) (void)__hip_atomic_fetch_add(ctl + CT_DONE(done_idx), 1u, __ATOMIC_RELAXED, __HIP_MEMORY_SCOPE_AGENT);
    for (;;) {
        if (tid == 0) { int q = -1;
            if (__hip_atomic_load(ctl + CT_DONE(done_idx), __ATOMIC_RELAXED, __HIP_MEMORY_SCOPE_AGENT) < gridDim.x) {
                q = (int)__hip_atomic_fetch_add(ctl + CT_QNEXT, (unsigned)CONV_BATCH, __ATOMIC_RELAXED, __HIP_MEMORY_SCOPE_AGENT) + CONV_STATIC; if (q >= NCONV) q = -1; }
            *bc = q; }
        __syncthreads();
        const int q = *bc;
        __syncthreads();
        if (q < 0) break;
        ph_convert(a, tile, q, 1, (q + CONV_BATCH < NCONV) ? q + CONV_BATCH : NCONV);
    }
}
__device__ __forceinline__ void conv_finish(const Args& a, float* tile, int upto) {
#if !CONV_FILL
    (void)a; (void)tile; (void)upto; return;
#endif
    unsigned* ctl = (unsigned*)(a.ws + WS_CTL); volatile int* bc = (volatile int*)(tile + 256 * CV_P + 4);
    const int tid = threadIdx.x;
    for (;;) {
        if (tid == 0) { int q = -1;
            if ((int)__hip_atomic_load(ctl + CT_QNEXT, __ATOMIC_RELAXED, __HIP_MEMORY_SCOPE_AGENT) + CONV_STATIC < upto) {
                q = (int)__hip_atomic_fetch_add(ctl + CT_QNEXT, (unsigned)CONV_BATCH, __ATOMIC_RELAXED, __HIP_MEMORY_SCOPE_AGENT) + CONV_STATIC; if (q >= NCONV) q = -1; }
            *bc = q; }
        __syncthreads();
        const int q = *bc;
        __syncthreads();
        if (q < 0) break;
        ph_convert(a, tile, q, 1, (q + CONV_BATCH < NCONV) ? q + CONV_BATCH : NCONV);
    }
}
__device__ __forceinline__ void adaln_unit(const Args& a, int unit, float* sm) {
    const float* c = a.in[1]; const float* cctx = a.in[3]; const float* w_mod = a.in[4]; const float* b_mod = a.in[5]; float* mod = (float*)(a.ws + WS_MOD);
    const int tid = threadIdx.x, l = unit / 96, chunk = unit - l * 96;
    const int cg = tid & 31, ks = tid >> 5;
    for (int i = tid; i < 5 * 2048; i += 512) { const int v = i >> 11, k = i & 2047; const float val = v < 4 ? c[v * 2048 + k] : cctx[k]; sm[i] = val / (1.0f + __expf(-val)); }
    __syncthreads();
    float acc[5][4];
#pragma unroll
    for (int v = 0; v < 5; ++v)
#pragma unroll
        for (int j = 0; j < 4; ++j) acc[v][j] = 0.f;
    const float* wp = w_mod + ((size_t)l * 2048 + (size_t)ks * 128) * 12288 + chunk * 128 + cg * 4;
    for (int kb = 0; kb < 128; kb += 16) {
        f32x4 w[16];
#pragma unroll
        for (int kk = 0; kk < 16; ++kk) w[kk] = __builtin_nontemporal_load((const f32x4*)(wp + (size_t)(kb + kk) * 12288));
#pragma unroll
        for (int kk = 0; kk < 16; ++kk) { const int k = ks * 128 + kb + kk;
#pragma unroll
            for (int v = 0; v < 5; ++v) { const float s = sm[v * 2048 + k];
#pragma unroll
                for (int j = 0; j < 4; ++j) acc[v][j] += s * w[kk][j]; } }
    }
    __syncthreads();
#pragma unroll
    for (int v = 0; v < 5; ++v)
#pragma unroll
        for (int j = 0; j < 4; ++j) sm[(ks * 5 + v) * 128 + cg * 4 + j] = acc[v][j];
    __syncthreads();
    for (int o = tid; o < 640; o += 512) {
        const int v = o >> 7, cc = o & 127; float s = 0.f;
#pragma unroll
        for (int k2 = 0; k2 < 16; ++k2) s += sm[(k2 * 5 + v) * 128 + cc];
        mod[((size_t)l * 5 + v) * 12288 + chunk * 128 + cc] = s + b_mod[(size_t)l * 12288 + chunk * 128 + cc];
    }
    __syncthreads();
}
constexpr int FW_W1 = 0, FW_W2 = 2112, FW_W3 = 6208, FW_B1 = 10304, FW_B2 = 10368, FW_B3 = 10432, FW_FR = 10496, FW_ZS = 10560, FW_HA = 10848, FW_HB = 11360, FW_END = 11872;
__device__ __forceinline__ void filters_unit(const Args& a, int l, int r, float* sm) {
    float (*zs)[36] = (float (*)[36])(sm + FW_ZS); float (*ha)[64] = (float (*)[64])(sm + FW_HA); float (*hb)[64] = (float (*)[64])(sm + FW_HB);
    const int tid = threadIdx.x;
    const bool lat = r < 256; const int Lf = lat ? 2048 : 256; const int p0 = lat ? r * 8 : (r - 256) * 8;
    float* T = (float*)(a.ws + WS_FILTC) + (size_t)l * 512 * 512;
    const float* wf = a.in[21] + (size_t)l * 64 * 1024;
    const int p = tid >> 6, j = tid & 63; const int pos = p0 + p;
    const float tn = (float)pos / (float)(Lf - 1);
    if (j < 33) {
        float z;
        if (j == 0) z = tn;
        else { const int bi = (j - 1) & 15; const float band = 1e-4f + (float)bi * ((15.0f - 1e-4f) / 15.0f);
               const float ang = (6.283185307179586f / (float)Lf) * (float)pos * band; z = (j <= 16) ? __cosf(ang) : -__sinf(ang); }
        zs[p][j] = z;
    }
    __syncthreads();
    const float f = sm[FW_FR + j];
    { float s = sm[FW_B1 + j];
#pragma unroll
      for (int i = 0; i < 33; ++i) s += zs[p][i] * sm[FW_W1 + i * 64 + j];
      ha[p][j] = __sinf(f * s); }
    __syncthreads();
    { float s = sm[FW_B2 + j];
#pragma unroll 16
      for (int i = 0; i < 64; ++i) s += ha[p][i] * sm[FW_W2 + i * 64 + j];
      hb[p][j] = __sinf(f * s); }
    __syncthreads();
    { float s = sm[FW_B3 + j];
#pragma unroll 16
      for (int i = 0; i < 64; ++i) s += hb[p][i] * sm[FW_W3 + i * 64 + j];
      ha[p][j] = __sinf(f * s); }
    __syncthreads();
    float acc[2][8];
#pragma unroll
    for (int rr = 0; rr < 2; ++rr)
#pragma unroll
        for (int q = 0; q < 8; ++q) acc[rr][q] = 0.f;
    for (int ib = 0; ib < 64; ib += 16) {
        float wa[16], wb[16];
#pragma unroll
        for (int i = 0; i < 16; ++i) { wa[i] = wf[(ib + i) * 1024 + tid]; wb[i] = wf[(ib + i) * 1024 + 512 + tid]; }
#pragma unroll
        for (int i = 0; i < 16; ++i) {
#pragma unroll
            for (int q = 0; q < 8; ++q) { const float h = ha[q][ib + i]; acc[0][q] += h * wa[i]; acc[1][q] += h * wb[i]; } }
    }
    const int ch = tid;
    const float delta = 3.0701134573253944f + (float)ch * ((15.350567286626972f - 3.0701134573253944f) / 511.0f);
#pragma unroll
    for (int q = 0; q < 8; ++q) {
        const int ps = p0 + q; const float dec = __expf(-((float)ps / (float)(Lf - 1)) * delta);
        const float vf = acc[0][q] * dec, vb = acc[1][q] * dec;
        if (lat) { bf16_t* RBp = (bf16_t*)(a.ws + WS_FILTL) + ((size_t)l * 512 + ch) * HY_RBROW; RBp[2048 - ps] = f2bf(vf); if (ps > 0) RBp[2048 + ps] = f2bf(vb); }
        else { T[(size_t)ch * (2 * Lf) + Lf + ps] = vf; if (ps > 0) T[(size_t)ch * (2 * Lf) + Lf - ps] = vb; else T[(size_t)ch * (2 * Lf)] = 0.f; }
    }
    __syncthreads();
}
__device__ __forceinline__ void ph_filters(const Args& a, float* sm, int fb, int nfb) {
    const int tid = threadIdx.x;
    for (int l = 0; l < 2; ++l) {
        for (int i = tid; i < 2112; i += NTHR) sm[FW_W1 + i] = a.in[15][l * 2112 + i];
        for (int i = tid; i < 4096; i += NTHR) { sm[FW_W2 + i] = a.in[17][l * 4096 + i]; sm[FW_W3 + i] = a.in[19][l * 4096 + i]; }
        if (tid < 64) { sm[FW_B1 + tid] = a.in[16][l * 64 + tid]; sm[FW_B2 + tid] = a.in[18][l * 64 + tid]; sm[FW_B3 + tid] = a.in[20][l * 64 + tid]; sm[FW_FR + tid] = a.in[22][l * 64 + tid]; }
        __syncthreads();
        for (int r = fb; r < 288; r += nfb) filters_unit(a, l, r, sm);
        __syncthreads();
    }
}
#define SUBREP(b) for (int srep_ = 0; srep_ <= (int)((PROBE_SUB >> (b)) & 1u); ++srep_)
__device__ __forceinline__ void ph_absmax(const Args& a, float* sm) {
    unsigned* ctl = (unsigned*)(a.ws + WS_CTL); const int tid = threadIdx.x, G = gridDim.x, bid = blockIdx.x, lane = tid & 63, w = tid >> 6;
#pragma unroll
    for (int j = (I8_WIN ? 0 : 2); j < (I8_GU ? 4 : 2); ++j) {
        const f32x4* p4 = (const f32x4*)(j == 0 ? a.in[8] : j == 1 ? a.in[8] + (size_t)2048 * 3648 : j == 2 ? a.in[26] : a.in[27]);
        const int n4 = (j < 2 ? 2048 * 3648 : 2048 * 5632) / 4, step = G * 512;
        float mm = 0.f;
        for (int i0 = bid * 512 + tid; i0 < n4; i0 += step * 8) {
            f32x4 v[8];
#pragma unroll
            for (int u = 0; u < 8; ++u) { const int i = i0 + u * step; v[u] = i < n4 ? __builtin_nontemporal_load(p4 + i) : (f32x4){0.f, 0.f, 0.f, 0.f}; }
#pragma unroll
            for (int u = 0; u < 8; ++u) mm = fmaxf(mm, fmaxf(fmaxf(fabsf(v[u][0]), fabsf(v[u][1])), fmaxf(fabsf(v[u][2]), fabsf(v[u][3]))));
        }
        mm = wave_max(mm);
        if (lane == 0) sm[w] = mm;
        __syncthreads();
        if (tid == 0) { float t = sm[0];
#pragma unroll
            for (int k = 1; k < 8; ++k) t = fmaxf(t, sm[k]);
            (void)__hip_atomic_fetch_max(ctl + CT_WSC + j, __float_as_uint(t), __ATOMIC_RELAXED, __HIP_MEMORY_SCOPE_AGENT); }
        __syncthreads();
    }
    if (tid == 0) (void)__hip_atomic_fetch_add(ctl + CT_AMAXDONE, 1u, __ATOMIC_RELAXED, __HIP_MEMORY_SCOPE_AGENT);
}
__device__ __forceinline__ void ph_prologue(const Args& a, float* sm) {
    const int bid = blockIdx.x, G = gridDim.x, tid = threadIdx.x;
    const int NF = G >= 128 ? 64 : 0;
    if (I8_GEMM) ph_absmax(a, sm);
    if (NF == 0) { SUBREP(4) for (int u = bid; u < 192; u += G) adaln_unit(a, u, sm); SUBREP(5) ph_filters(a, sm, bid, G); }
    else if (bid < NF) { SUBREP(5) ph_filters(a, sm, bid, NF); }
    else { SUBREP(4) for (int u = bid - NF; u < 192; u += G - NF) adaln_unit(a, u, sm); }
    { float* cosT = (float*)(a.ws + WS_ROPE); float* sinT = cosT + 2048 * 32;
      for (int i = bid * 512 + tid; i < 2048 * 32; i += G * 512) { const int t = i >> 5, f = i & 31;
          const float pos = (float)((f < 16) ? (t >> 6) : (t & 63)); const float freq = powf(10000.0f, -(float)(f & 15) / 16.0f); const float ang = pos * freq;
          cosT[i] = cosf(ang); sinT[i] = sinf(ang); } }
    for (int i = bid * 512 + tid; i < 2 * 512 * 17; i += G * 512) { const int row = i / 17, k = i - row * 17; ((bf16_t*)(a.ws + WS_FILTL))[(size_t)row * HY_RBROW + (k == 0 ? 0 : 4095 + k)] = 0; }
    { constexpr int RB16 = I8_WIN ? 128 : 256;
      for (int i = bid * 512 + tid; i < 2 * 192 * RB16; i += G * 512) { const int l = i / (192 * RB16), r = i % (192 * RB16);
        *(u32x4*)(a.ws + WS_WIN + (size_t)l * UW * D * 2 + (size_t)INW * RB16 * 16 + (size_t)r * 16) = (u32x4){0u, 0u, 0u, 0u}; } }
    if (I8_GEMM) {
        if (tid == 0) { const unsigned* dn = (const unsigned*)(a.ws + WS_CTL) + CT_AMAXDONE; unsigned sp = 0;
            while (__hip_atomic_load(dn, __ATOMIC_RELAXED, __HIP_MEMORY_SCOPE_AGENT) < (unsigned)G && ++sp < (1u << 22)) __builtin_amdgcn_s_sleep(4); }
    }
    __syncthreads();
    if ((PROBE_SUB >> 8) & 1u) ph_convert<2>(a, sm, bid, G, NCONV);
    conv_dynamic<0>(a, sm);
    if (G != 256) ph_convert<0>(a, sm, NCONV_Q + bid, G, NCONV);
    if ((PROBE_SUB >> 6) & 1u) ph_convert<0>(a, sm, bid, G, NCONV);
    if ((PROBE_SUB >> 7) & 1u) ph_convert<1>(a, sm, bid, G, NCONV);
}

template <bool ROUTER, bool COPYX, int OUT8 = 0, int NSLAB = 0>
__device__ __forceinline__ void ph_normmod(const float* __restrict__ xlat, const float* __restrict__ xctx, const float* __restrict__ gain, const float* __restrict__ modl, int sh_off, int sc_off,
                                           bf16_t* __restrict__ out, int nrows, float* __restrict__ xs, const float* __restrict__ router, int* __restrict__ topi, float* __restrict__ topw,
                                           const float* __restrict__ slab = nullptr, const float* __restrict__ slab_gate = nullptr, float* __restrict__ rsc = nullptr) {
    const int lane = threadIdx.x & 63, wid = threadIdx.x >> 6;
    for (int row = blockIdx.x * 8 + wid; row < nrows; row += gridDim.x * 8) {
        const float* xr = row < NLAT ? xlat + (size_t)row * D : xctx + (size_t)(row - NLAT) * D;
        const float* mv = modl + (size_t)tok_mod(row) * 12288;
        f32x4 v[8]; float ss = 0.f;
#pragma unroll
        for (int i = 0; i < 8; ++i) { v[i] = *(const f32x4*)(xr + i * 256 + lane * 4);
            if (NSLAB > 0 && row >= NLAT) { f32x4 sa = *(const f32x4*)(slab + (size_t)(row - NLAT) * D + i * 256 + lane * 4);
#pragma unroll
                for (int sl = 1; sl < NSLAB; ++sl) sa += *(const f32x4*)(slab + ((size_t)sl * NCTX + (row - NLAT)) * D + i * 256 + lane * 4);
                v[i] += *(const f32x4*)(slab_gate + i * 256 + lane * 4) * sa; }
            ss += v[i][0] * v[i][0] + v[i][1] * v[i][1] + v[i][2] * v[i][2] + v[i][3] * v[i][3];
            if (COPYX && (NSLAB == 0 || row >= NLAT)) *(f32x4*)(xs + (size_t)row * D + i * 256 + lane * 4) = v[i]; }
        ss = wave_sum(ss);
        const float rstd = rsqrtf(ss * (1.0f / D) + EPS);
        float lg[8];
#pragma unroll
        for (int e = 0; e < 8; ++e) lg[e] = 0.f;
        float amax = 0.f;
#pragma unroll
        for (int i = 0; i < 8; ++i) {
            const int col = i * 256 + lane * 4;
            const f32x4 g = *(const f32x4*)(gain + col), sc = *(const f32x4*)(mv + sc_off + col), sh = *(const f32x4*)(mv + sh_off + col);
            f32x4 o;
#pragma unroll
            for (int j = 0; j < 4; ++j) o[j] = (v[i][j] * rstd * g[j]) * (1.0f + sc[j]) + sh[j];
            if (OUT8 == 2) { v[i] = o; amax = fmaxf(amax, fmaxf(fmaxf(fabsf(o[0]), fabsf(o[1])), fmaxf(fabsf(o[2]), fabsf(o[3])))); }
            else if (OUT8 == 1) *(unsigned*)((unsigned char*)out + (size_t)row * D + col) = pg8::pack4_fp8(o[0] * ASCALE, o[1] * ASCALE, o[2] * ASCALE, o[3] * ASCALE);
            else { u32x2 w; w.x = (unsigned)f2bf(o[0]) | ((unsigned)f2bf(o[1]) << 16); w.y = (unsigned)f2bf(o[2]) | ((unsigned)f2bf(o[3]) << 16);
                *(u32x2*)(out + (size_t)row * D + col) = w; }
            if (ROUTER) {
#pragma unroll
                for (int j = 0; j < 4; ++j) { const f32x4 r0 = *(const f32x4*)(router + (size_t)(col + j) * 8), r1 = *(const f32x4*)(router + (size_t)(col + j) * 8 + 4);
                    lg[0] += o[j] * r0[0]; lg[1] += o[j] * r0[1]; lg[2] += o[j] * r0[2]; lg[3] += o[j] * r0[3];
                    lg[4] += o[j] * r1[0]; lg[5] += o[j] * r1[1]; lg[6] += o[j] * r1[2]; lg[7] += o[j] * r1[3]; }
                asm volatile("" ::: "memory");
            }
        }
        if (OUT8 == 2) {
            amax = wave_max(amax); const float qs = amax > 0.f ? 127.0f / amax : 0.f;
#pragma unroll
            for (int i = 0; i < 8; ++i) *(unsigned*)((unsigned char*)out + (size_t)row * D + i * 256 + lane * 4) = pack4_i8(v[i][0] * qs, v[i][1] * qs, v[i][2] * qs, v[i][3] * qs);
            if (lane == 0) rsc[row] = amax * (1.0f / 127.0f);
        }
        if (ROUTER) {
#pragma unroll
            for (int e = 0; e < 8; ++e) lg[e] = wave_sum(lg[e]);
            if (lane == 0) {
                int i0 = 0; float v0 = lg[0];
#pragma unroll
                for (int e = 1; e < 8; ++e) if (lg[e] > v0) { v0 = lg[e]; i0 = e; }
                int i1 = -1; float v1 = -3.0e38f;
#pragma unroll
                for (int e = 0; e < 8; ++e) if (e != i0 && lg[e] > v1) { v1 = lg[e]; i1 = e; }
                const float e1 = expf(v1 - v0), w0 = 1.0f / (1.0f + e1), w1 = e1 / (1.0f + e1);
                topi[row * 2] = i0; topi[row * 2 + 1] = i1; topw[row * 2] = w0; topw[row * 2 + 1] = w1;
            }
        }
    }
}

__device__ __forceinline__ float bflo(unsigned w) { return __uint_as_float(w << 16); }
__device__ __forceinline__ float bfhi(unsigned w) { return __uint_as_float(w & 0xffff0000u); }
__device__ __forceinline__ unsigned pkbf(float lo, float hi) { return (unsigned)f2bf(lo) | ((unsigned)f2bf(hi) << 16); }
__device__ __forceinline__ u32x4 rope8(const u32x4 mine, const u32x4 other, bool is_x2, const f32x4 c0, const f32x4 c1, const f32x4 s0, const f32x4 s1) {
    const unsigned mw[4] = {mine.x, mine.y, mine.z, mine.w}, ow[4] = {other.x, other.y, other.z, other.w};
    const float cs[8] = {c0[0], c0[1], c0[2], c0[3], c1[0], c1[1], c1[2], c1[3]}, sn[8] = {s0[0], s0[1], s0[2], s0[3], s1[0], s1[1], s1[2], s1[3]};
    unsigned o[4];
#pragma unroll
    for (int d = 0; d < 4; ++d) {
        const float m0 = bflo(mw[d]), m1 = bfhi(mw[d]), p0 = bflo(ow[d]), p1 = bfhi(ow[d]);
        const float r0 = is_x2 ? (p0 * sn[2 * d] + m0 * cs[2 * d]) : (m0 * cs[2 * d] - p0 * sn[2 * d]);
        const float r1 = is_x2 ? (p1 * sn[2 * d + 1] + m1 * cs[2 * d + 1]) : (m1 * cs[2 * d + 1] - p1 * sn[2 * d + 1]);
        o[d] = pkbf(r0, r1);
    }
    return (u32x4){o[0], o[1], o[2], o[3]};
}
__device__ __forceinline__ u32x4 shfl4(const u32x4 v, int m) { return (u32x4){(unsigned)__shfl_xor((int)v.x, m), (unsigned)__shfl_xor((int)v.y, m), (unsigned)__shfl_xor((int)v.z, m), (unsigned)__shfl_xor((int)v.w, m)}; }
__device__ __forceinline__ void ph_mid(const Args& a, int l) {
    const bf16_t* __restrict__ U = (const bf16_t*)(a.ws + WS_U);
    const float* g_q = a.in[9] + l * 768; const float* g_kv = a.in[11] + l * 512; const float* conv_w = a.in[13] + (size_t)l * 3 * 1536; const float* conv_b = a.in[14] + l * 1536;
    const float* cosT = (const float*)(a.ws + WS_ROPE); const float* sinT = cosT + 2048 * 32;
    bf16_t* cqn = (bf16_t*)(a.ws + WS_CQN); bf16_t* ckvn = (bf16_t*)(a.ws + WS_CKVN); bf16_t* kpe = (bf16_t*)(a.ws + WS_KPE); bf16_t* x0o = (bf16_t*)(a.ws + WS_X0);
    bf16_t* wtl = (bf16_t*)(a.ws + WS_WTL); bf16_t* wtc = (bf16_t*)(a.ws + WS_WTC); bf16_t* sq = (bf16_t*)(a.ws + WS_SQ); bf16_t* sk = (bf16_t*)(a.ws + WS_SK); bf16_t* sv = (bf16_t*)(a.ws + WS_SV);
    int tid_ = threadIdx.x; asm volatile("" : "+v"(tid_));
    const int tid = tid_, lane = tid & 63, wid = tid >> 6;
    for (int unit = blockIdx.x; unit < NTOK / 16; unit += gridDim.x) {
        const int tok0 = unit * 16;
        for (int tt = 0; tt < 2; ++tt) {
            const int tok = tok0 + wid * 2 + tt; const bool lat = tok < NLAT; const int t = lat ? (tok & 2047) : ((tok - NLAT) & 255);
            const bf16_t* u = U + (size_t)tok * UW;
            const u32x2 q0 = *(const u32x2*)(u + O_CQ + lane * 12), q1 = *(const u32x2*)(u + O_CQ + lane * 12 + 4), q2 = *(const u32x2*)(u + O_CQ + lane * 12 + 8);
            const u32x4 kvv = *(const u32x4*)(u + O_CKV + lane * 8);
            const u32x4 sqv = *(const u32x4*)(u + O_SQ + lane * 8);
            const u32x4 skv = *(const u32x4*)(u + O_SK + (lane & 15) * 8);
            const u32x4 kpv = *(const u32x4*)(u + O_KPE + (lane & 7) * 8);
            const int i0 = (lane & 3) * 8;
            f32x4 c0 = (f32x4){1.f, 1.f, 1.f, 1.f}, c1 = c0, s0 = (f32x4){0.f, 0.f, 0.f, 0.f}, s1 = s0;
            if (lat) { c0 = *(const f32x4*)(cosT + t * 32 + i0); c1 = *(const f32x4*)(cosT + t * 32 + i0 + 4); s0 = *(const f32x4*)(sinT + t * 32 + i0); s1 = *(const f32x4*)(sinT + t * 32 + i0 + 4); }
            {
                const unsigned w6[6] = {q0.x, q0.y, q1.x, q1.y, q2.x, q2.y}; float x[12]; float ss = 0.f;
#pragma unroll
                for (int d = 0; d < 6; ++d) { x[2 * d] = bflo(w6[d]); x[2 * d + 1] = bfhi(w6[d]); ss += x[2 * d] * x[2 * d] + x[2 * d + 1] * x[2 * d + 1]; }
                ss = wave_sum(ss); const float rs = rsqrtf(ss * (1.0f / 768.0f) + EPS);
                const f32x4 g0 = *(const f32x4*)(g_q + lane * 12), g1 = *(const f32x4*)(g_q + lane * 12 + 4), g2 = *(const f32x4*)(g_q + lane * 12 + 8);
                u32x2 o0, o1, o2;
                o0.x = pkbf(x[0] * rs * g0[0], x[1] * rs * g0[1]); o0.y = pkbf(x[2] * rs * g0[2], x[3] * rs * g0[3]);
                o1.x = pkbf(x[4] * rs * g1[0], x[5] * rs * g1[1]); o1.y = pkbf(x[6] * rs * g1[2], x[7] * rs * g1[3]);
                o2.x = pkbf(x[8] * rs * g2[0], x[9] * rs * g2[1]); o2.y = pkbf(x[10] * rs * g2[2], x[11] * rs * g2[3]);
                bf16_t* dst = cqn + (size_t)tok * 768 + lane * 12; *(u32x2*)dst = o0; *(u32x2*)(dst + 4) = o1; *(u32x2*)(dst + 8) = o2;
            }
            {
                const unsigned w4[4] = {kvv.x, kvv.y, kvv.z, kvv.w}; float x[8]; float ss = 0.f;
#pragma unroll
                for (int d = 0; d < 4; ++d) { x[2 * d] = bflo(w4[d]); x[2 * d + 1] = bfhi(w4[d]); ss += x[2 * d] * x[2 * d] + x[2 * d + 1] * x[2 * d + 1]; }
                ss = wave_sum(ss); const float rs = rsqrtf(ss * (1.0f / 512.0f) + EPS);
                const f32x4 g0 = *(const f32x4*)(g_kv + lane * 8), g1 = *(const f32x4*)(g_kv + lane * 8 + 4);
                u32x4 o; o.x = pkbf(x[0] * rs * g0[0], x[1] * rs * g0[1]); o.y = pkbf(x[2] * rs * g0[2], x[3] * rs * g0[3]); o.z = pkbf(x[4] * rs * g1[0], x[5] * rs * g1[1]); o.w = pkbf(x[6] * rs * g1[2], x[7] * rs * g1[3]);
                *(u32x4*)(ckvn + (size_t)tok * 512 + lane * 8) = o;
            }
            const bool is_x2 = (lane & 4) != 0;
            {
                const u32x4 r = rope8(sqv, shfl4(sqv, 4), is_x2, c0, c1, s0, s1);
                *(u32x4*)(sq + (size_t)tok * 512 + lane * 8) = r;
            }
            {
                const u32x4 r = rope8(skv, shfl4(skv, 4), is_x2, c0, c1, s0, s1);
                if (lane < 16) *(u32x4*)(sk + (size_t)tok * 128 + lane * 8) = r;
            }
            {
                const u32x4 ot = shfl4(kpv, 4);
                if (lane < 4) {
                    const unsigned mw[4] = {kpv.x, kpv.y, kpv.z, kpv.w}, ow[4] = {ot.x, ot.y, ot.z, ot.w};
                    const float cs[8] = {c0[0], c0[1], c0[2], c0[3], c1[0], c1[1], c1[2], c1[3]}, sn[8] = {s0[0], s0[1], s0[2], s0[3], s1[0], s1[1], s1[2], s1[3]};
                    unsigned o[8];
#pragma unroll
                    for (int d = 0; d < 4; ++d) { const float a0 = bflo(mw[d]), a1 = bfhi(mw[d]), b0 = bflo(ow[d]), b1 = bfhi(ow[d]);
                        o[2 * d] = pkbf(a0 * cs[2 * d] - b0 * sn[2 * d], a0 * sn[2 * d] + b0 * cs[2 * d]);
                        o[2 * d + 1] = pkbf(a1 * cs[2 * d + 1] - b1 * sn[2 * d + 1], a1 * sn[2 * d + 1] + b1 * cs[2 * d + 1]); }
                    bf16_t* dst = kpe + (size_t)tok * 64 + lane * 16;
                    *(u32x4*)dst = (u32x4){o[0], o[1], o[2], o[3]}; *(u32x4*)(dst + 8) = (u32x4){o[4], o[5], o[6], o[7]};
                }
            }
        }
        {
            const bool lat = tok0 < NLAT; const int Ls = lat ? L : C;
            const int b = lat ? (tok0 >> 11) : ((tok0 - NLAT) >> 8), t0 = (lat ? (tok0 & 2047) : ((tok0 - NLAT) & 255));
            const int cp = tid & 255, hf = tid >> 8, ch = cp * 2, ts = t0 + hf * 8, tokb = tok0 + hf * 8;
            float cw[3][3][2], cb[3][2];
#pragma unroll
            for (int g = 0; g < 3; ++g) { cb[g][0] = conv_b[g * 512 + ch]; cb[g][1] = conv_b[g * 512 + ch + 1];
#pragma unroll
                for (int j = 0; j < 3; ++j) { cw[g][j][0] = conv_w[j * 1536 + g * 512 + ch]; cw[g][j][1] = conv_w[j * 1536 + g * 512 + ch + 1]; } }
            unsigned rows[3][10];
#pragma unroll
            for (int r = 0; r < 10; ++r) { const int tr = ts - 1 + r; const bool ok = tr >= 0 && tr < Ls;
#pragma unroll
                for (int g = 0; g < 3; ++g) rows[g][r] = ok ? *(const unsigned*)(U + (size_t)(tokb - 1 + r) * UW + O_HY + g * 512 + ch) : 0u; }
            unsigned wp0[4], wp1[4];
#pragma unroll
            for (int i = 0; i < 8; ++i) {
                float y[3][2];
#pragma unroll
                for (int g = 0; g < 3; ++g) {
                    y[g][0] = cb[g][0] + cw[g][0][0] * bflo(rows[g][i]) + cw[g][1][0] * bflo(rows[g][i + 1]) + cw[g][2][0] * bflo(rows[g][i + 2]);
                    y[g][1] = cb[g][1] + cw[g][0][1] * bfhi(rows[g][i]) + cw[g][1][1] * bfhi(rows[g][i + 1]) + cw[g][2][1] * bfhi(rows[g][i + 2]); }
                *(unsigned*)(x0o + (size_t)(tokb + i) * 512 + ch) = pkbf(y[0][0], y[0][1]);
                const unsigned w0 = f2bf(y[2][0] * y[1][0]), w1 = f2bf(y[2][1] * y[1][1]);
                if (i & 1) { wp0[i >> 1] |= w0 << 16; wp1[i >> 1] |= w1 << 16; } else { wp0[i >> 1] = w0; wp1[i >> 1] = w1; }
            }
            bf16_t* wt = lat ? wtl + ((size_t)b * 512 + ch) * L + ts : wtc + ((size_t)b * 512 + ch) * C + ts;
            *(u32x4*)wt = (u32x4){wp0[0], wp0[1], wp0[2], wp0[3]};
            *(u32x4*)(wt + (lat ? L : C)) = (u32x4){wp1[0], wp1[1], wp1[2], wp1[3]};
        }
        if (tid < 128) {
            unsigned pk[8];
#pragma unroll
            for (int i = 0; i < 16; ++i) { const unsigned v = U[(size_t)(tok0 + i) * UW + O_SV + tid]; if (i & 1) pk[i >> 1] |= v << 16; else pk[i >> 1] = v; }
            bf16_t* dst = sv + (size_t)tid * NTOK + tok0;
            u32x4 w0, w1; w0.x = pk[0]; w0.y = pk[1]; w0.z = pk[2]; w0.w = pk[3]; w1.x = pk[4]; w1.y = pk[5]; w1.z = pk[6]; w1.w = pk[7];
            *(u32x4*)dst = w0; *(u32x4*)(dst + 8) = w1;
        }
    }
}

__device__ __forceinline__ void ph_mla_naive(const Args& a, int nq, float* sm) {
    const bf16_t* __restrict__ Q = (const bf16_t*)(a.ws + WS_Q); const bf16_t* __restrict__ KV = (const bf16_t*)(a.ws + WS_KV); const bf16_t* __restrict__ KPE = (const bf16_t*)(a.ws + WS_KPE);
    bf16_t* mix = (bf16_t*)(a.ws + WS_MIX);
    const int lane = threadIdx.x & 63, w = threadIdx.x >> 6;
    float* qf = sm + w * 192; float* sc = sm + 8 * 192 + w * 2304;
    for (int unit = blockIdx.x; unit < nq; unit += gridDim.x) {
        const int h = unit & 7, qt = (unit >> 3) * 8 + w; const bool lat = qt < NLAT;
        const int b = lat ? (qt >> 11) : ((qt - NLAT) >> 8);
        const int nk = lat ? (L + C) : C;
        for (int i = lane; i < 192; i += 64) qf[i] = bf2f(Q[(size_t)qt * QW + h * 192 + i]);
        __syncthreads();
        const float scale = 0.07216878364870322f;
        float mx = -3.0e38f;
        for (int kc = 0; kc < nk; kc += 64) {
            const int kk = kc + lane;
            const int kt = lat ? (kk < L ? b * L + kk : NLAT + b * C + (kk - L)) : (NLAT + b * C + kk);
            float s = 0.f;
            const u32x4* kp = (const u32x4*)(KV + (size_t)kt * KVW + h * 256);
            for (int i = 0; i < 16; ++i) { const u32x4 v = kp[i]; const float* q8 = qf + i * 8;
                s += q8[0] * __uint_as_float(v.x << 16) + q8[1] * __uint_as_float(v.x & 0xffff0000u) + q8[2] * __uint_as_float(v.y << 16) + q8[3] * __uint_as_float(v.y & 0xffff0000u)
                   + q8[4] * __uint_as_float(v.z << 16) + q8[5] * __uint_as_float(v.z & 0xffff0000u) + q8[6] * __uint_as_float(v.w << 16) + q8[7] * __uint_as_float(v.w & 0xffff0000u); }
            const u32x4* pp = (const u32x4*)(KPE + (size_t)kt * 64);
            for (int i = 0; i < 8; ++i) { const u32x4 v = pp[i]; const float* q8 = qf + 128 + i * 8;
                s += q8[0] * __uint_as_float(v.x << 16) + q8[1] * __uint_as_float(v.x & 0xffff0000u) + q8[2] * __uint_as_float(v.y << 16) + q8[3] * __uint_as_float(v.y & 0xffff0000u)
                   + q8[4] * __uint_as_float(v.z << 16) + q8[5] * __uint_as_float(v.z & 0xffff0000u) + q8[6] * __uint_as_float(v.w << 16) + q8[7] * __uint_as_float(v.w & 0xffff0000u); }
            s *= scale; sc[kk] = s; mx = fmaxf(mx, s);
        }
        mx = wave_max(mx);
        float sum = 0.f;
        for (int kc = 0; kc < nk; kc += 64) { const float p = expf(sc[kc + lane] - mx); sc[kc + lane] = p; sum += p; }
        sum = wave_sum(sum);
        __syncthreads();
        float o0 = 0.f, o1 = 0.f;
        for (int kk = 0; kk < nk; ++kk) {
            const int kt = lat ? (kk < L ? b * L + kk : NLAT + b * C + (kk - L)) : (NLAT + b * C + kk);
            const unsigned v = *(const unsigned*)(KV + (size_t)kt * KVW + h * 256 + 128 + lane * 2);
            const float p = sc[kk];
            o0 += p * __uint_as_float(v << 16); o1 += p * __uint_as_float(v & 0xffff0000u);
        }
        const float inv = 1.0f / sum;
        *(unsigned*)(mix + (size_t)qt * D + h * 128 + lane * 2) = (unsigned)f2bf(o0 * inv) | ((unsigned)f2bf(o1 * inv) << 16);
        __syncthreads();
    }
}
__device__ __forceinline__ void ph_swa_naive(const Args& a, int l, int nq, float* sm) {
    const bf16_t* __restrict__ SQ = (const bf16_t*)(a.ws + WS_SQ); const bf16_t* __restrict__ SK = (const bf16_t*)(a.ws + WS_SK); const bf16_t* __restrict__ SV = (const bf16_t*)(a.ws + WS_SV);
    const float* sink = a.in[24] + l * 8; bf16_t* mix = (bf16_t*)(a.ws + WS_MIX);
    const int lane = threadIdx.x & 63, w = threadIdx.x >> 6;
    float* qf = sm + w * 64; float* sc = sm + 8 * 64 + w * 576; int* kts = (int*)(sm + 8 * 64 + 8 * 576) + w * 576;
    for (int unit = blockIdx.x; unit < nq; unit += gridDim.x) {
        const int hq = unit & 7, hk = hq >> 2, qt = (unit >> 3) * 8 + w; const bool lat = qt < NLAT;
        const int b = lat ? (qt >> 11) : ((qt - NLAT) >> 8), t = lat ? (qt & 2047) : 0;
        int lo = 0, nloc = 0;
        if (lat) { lo = t - 128 < 0 ? 0 : t - 128; const int hi = t + 128 > L - 1 ? L - 1 : t + 128; nloc = hi - lo + 1; }
        const int nk = nloc + C;
        qf[lane] = bf2f(SQ[(size_t)qt * 512 + hq * 64 + lane]);
        __syncthreads();
        const float skv = sink[hq];
        float mx = skv;
        for (int kc = 0; kc < nk; kc += 64) {
            const int kk = kc + lane;
            if (kk < nk) {
                const int kt = kk < nloc ? (b * L + lo + kk) : (NLAT + b * C + (kk - nloc));
                const u32x4* kp = (const u32x4*)(SK + (size_t)kt * 128 + hk * 64);
                float s = 0.f;
                for (int i = 0; i < 8; ++i) { const u32x4 v = kp[i]; const float* q8 = qf + i * 8;
                    s += q8[0] * __uint_as_float(v.x << 16) + q8[1] * __uint_as_float(v.x & 0xffff0000u) + q8[2] * __uint_as_float(v.y << 16) + q8[3] * __uint_as_float(v.y & 0xffff0000u)
                       + q8[4] * __uint_as_float(v.z << 16) + q8[5] * __uint_as_float(v.z & 0xffff0000u) + q8[6] * __uint_as_float(v.w << 16) + q8[7] * __uint_as_float(v.w & 0xffff0000u); }
                s *= 0.125f; sc[kk] = s; kts[kk] = kt; mx = fmaxf(mx, s);
            }
        }
        mx = wave_max(mx);
        float sum = 0.f;
        for (int kc = 0; kc < nk; kc += 64) { const int kk = kc + lane; if (kk < nk) { const float p = expf(sc[kk] - mx); sc[kk] = p; sum += p; } }
        sum = wave_sum(sum) + expf(skv - mx);
        __syncthreads();
        float o = 0.f;
        for (int kk = 0; kk < nk; ++kk) o += sc[kk] * bf2f(SV[(size_t)kts[kk] * 128 + hk * 64 + lane]);
        mix[(size_t)qt * D + 1536 + hq * 64 + lane] = f2bf(o / sum);
        __syncthreads();
    }
}
template <int LS>
__device__ __forceinline__ void ph_hyena_naive(const Args& a, int l, float* sm) {
    const float* filt = LS == L ? (const float*)(a.ws + WS_FILTL) + (size_t)l * 512 * 4096 : (const float*)(a.ws + WS_FILTC) + (size_t)l * 512 * 512;
    const bf16_t* wt = (const bf16_t*)(a.ws + (LS == L ? WS_WTL : WS_WTC)); const bf16_t* x0 = (const bf16_t*)(a.ws + WS_X0); const float* skip = a.in[23] + l * 512;
    bf16_t* mix = (bf16_t*)(a.ws + WS_MIX); const int tok_base = LS == L ? 0 : NLAT;
    float* T = sm; float* ws = sm + 2 * LS; const int tid = threadIdx.x;
    for (int unit = blockIdx.x; unit < 512 * NB; unit += gridDim.x) {
        const int ch = unit >> 2, b = unit & 3;
        for (int i = tid; i < 2 * LS; i += NTHR) T[i] = filt[(size_t)ch * 2 * LS + i];
        for (int i = tid; i < LS; i += NTHR) ws[i] = bf2f(wt[((size_t)b * 512 + ch) * LS + i]);
        __syncthreads();
        const float sk = skip[ch];
        for (int t = tid; t < LS; t += NTHR) {
            float y = 0.f;
            for (int s = 0; s < LS; ++s) y += T[t - s + LS] * ws[s];
            ((bf16_t*)(a.ws + WS_YT))[(LS == L ? (size_t)0 : (size_t)NB * 512 * L) + ((size_t)b * 512 + ch) * LS + t] = f2bf(y);
        }
        __syncthreads();
    }
}
__device__ __forceinline__ void ph_route_gather(const Args& a, int* sm) {
    const int* __restrict__ topi = (const int*)(a.ws + WS_TOPI); int* __restrict__ pos = (int*)(a.ws + WS_POS); int* ctl = (int*)(a.ws + WS_CTL);
    const unsigned char* __restrict__ hb = (const unsigned char*)(a.ws + WS_HA); unsigned char* __restrict__ hbs = (unsigned char*)(a.ws + WS_HBS);
    int (*cnt)[512] = (int (*)[512])sm; int* tot = sm + 8 * 512; int* ppos = sm + 8 * 512 + 16;
    const int tid = threadIdx.x, lane = tid & 63, w = tid >> 6;
    int c[8];
#pragma unroll
    for (int e = 0; e < 8; ++e) c[e] = 0;
    for (int i = 0; i < 32; i += 4) { const u32x4 e4 = *(const u32x4*)(topi + tid * 32 + i);
#pragma unroll
        for (int q = 0; q < 8; ++q) c[q] += (e4.x == (unsigned)q) + (e4.y == (unsigned)q) + (e4.z == (unsigned)q) + (e4.w == (unsigned)q); }
#pragma unroll
    for (int e = 0; e < 8; ++e) cnt[e][tid] = c[e];
    __syncthreads();
    {
        int v[8]; int s8 = 0;
#pragma unroll
        for (int k = 0; k < 8; ++k) { v[k] = cnt[w][lane * 8 + k]; s8 += v[k]; }
        int incl = s8;
#pragma unroll
        for (int off = 1; off < 64; off <<= 1) { const int t = __shfl_up(incl, off); if (lane >= off) incl += t; }
        int run = incl - s8;
#pragma unroll
        for (int k = 0; k < 8; ++k) { cnt[w][lane * 8 + k] = run; run += v[k]; }
        if (lane == 63) tot[w] = incl;
    }
    __syncthreads();
    int eoff[8]; int o = 0;
#pragma unroll
    for (int e = 0; e < 8; ++e) { eoff[e] = o; o += (tot[e] + 255) & ~255; }
    if (blockIdx.x == 0 && tid == 0) {
#pragma unroll
        for (int e = 0; e < 8; ++e) { ctl[CT_EOFF + e] = eoff[e]; ctl[CT_EPAD + e] = (tot[e] + 255) & ~255; }
        ctl[CT_NTILE] = o >> 8; const int nwg = (o >> 8) * (D / 256); ctl[CT_MOES] = pg8::split_S(nwg, DFE / 128, 256); ctl[CT_TROW] = (nwg / 256) * 256 / (D / 256) * 256;
    }
    for (int tg = blockIdx.x; tg < NLAT / 32; tg += gridDim.x) {
        if (tid < 64) {
            const int idx = 64 * tg + tid, owner = idx >> 5, e = topi[idx]; int p = 0;
#pragma unroll
            for (int q = 0; q < 8; ++q) { const unsigned long long mk = __ballot(e == q);
                if (e == q) { const unsigned hm = (unsigned)(mk >> (32 * (tid >> 5))); p = eoff[q] + cnt[q][owner] + __popc(hm & ((1u << (tid & 31)) - 1u)); } }
            pos[idx] = p; ppos[tid] = p;
        }
        __syncthreads();
#pragma unroll
        for (int k = 0; k < 4; ++k) { const int tl = 4 * w + k; const int tok = 32 * tg + tl;
            const u32x4 v0 = *(const u32x4*)(hb + (size_t)tok * D + lane * 32), v1 = *(const u32x4*)(hb + (size_t)tok * D + lane * 32 + 16);
            const int p0 = ppos[2 * tl], p1 = ppos[2 * tl + 1];
            *(u32x4*)(hbs + (size_t)p0 * D + lane * 32) = v0; *(u32x4*)(hbs + (size_t)p0 * D + lane * 32 + 16) = v1;
            *(u32x4*)(hbs + (size_t)p1 * D + lane * 32) = v0; *(u32x4*)(hbs + (size_t)p1 * D + lane * 32 + 16) = v1; }
        __syncthreads();
    }
}
__device__ __forceinline__ void ph_final(const Args& a) {
    const float* xs = (const float*)(a.ws + WS_XS); const bf16_t* ys = (const bf16_t*)(a.ws + WS_YS); const int* pos = (const int*)(a.ws + WS_POS); const float* topw = (const float*)(a.ws + WS_TOPW);
    const float* modl = (const float*)(a.ws + WS_MOD) + (size_t)5 * 12288; const float* gfin = a.in[33]; float* out = a.out;
    const int lane = threadIdx.x & 63, wid = threadIdx.x >> 6;
    const int* ctl = (const int*)(a.ws + WS_CTL); const int nsl = ctl[CT_MOES], trow0 = ctl[CT_TROW], trows = ctl[CT_NTILE] * 256 - trow0; const float* slab = (const float*)(a.ws + WS_SLAB);
    for (int row = blockIdx.x * 8 + wid; row < NLAT; row += gridDim.x * 8) {
        const float* g2 = modl + (size_t)tok_mod(row) * 12288 + 10240;
        const int p0 = pos[row * 2], p1 = pos[row * 2 + 1]; const float w0 = topw[row * 2], w1 = topw[row * 2 + 1];
        const bool t0 = nsl > 1 && p0 >= trow0, t1 = nsl > 1 && p1 >= trow0;
        f32x4 v[8]; float ss = 0.f;
#pragma unroll
        for (int i = 0; i < 8; ++i) { const int col = i * 256 + lane * 4;
            const f32x4 x = *(const f32x4*)(xs + (size_t)row * D + col), g = *(const f32x4*)(g2 + col); f32x4 ya, yb;
            if (t0) { ya = *(const f32x4*)(slab + (size_t)(p0 - trow0) * D + col); for (int sl = 1; sl < nsl; ++sl) ya += *(const f32x4*)(slab + ((size_t)sl * trows + (p0 - trow0)) * D + col); }
            else { const u32x2 q = *(const u32x2*)(ys + (size_t)p0 * D + col); ya = (f32x4){__uint_as_float(q.x << 16), __uint_as_float(q.x & 0xffff0000u), __uint_as_float(q.y << 16), __uint_as_float(q.y & 0xffff0000u)}; }
            if (t1) { yb = *(const f32x4*)(slab + (size_t)(p1 - trow0) * D + col); for (int sl = 1; sl < nsl; ++sl) yb += *(const f32x4*)(slab + ((size_t)sl * trows + (p1 - trow0)) * D + col); }
            else { const u32x2 q = *(const u32x2*)(ys + (size_t)p1 * D + col); yb = (f32x4){__uint_as_float(q.x << 16), __uint_as_float(q.x & 0xffff0000u), __uint_as_float(q.y << 16), __uint_as_float(q.y & 0xffff0000u)}; }
#pragma unroll
            for (int j = 0; j < 4; ++j) { v[i][j] = x[j] + g[j] * (w0 * ya[j] + w1 * yb[j]); ss += v[i][j] * v[i][j]; } }
        ss = wave_sum(ss); const float rstd = rsqrtf(ss * (1.0f / D) + EPS);
#pragma unroll
        for (int i = 0; i < 8; ++i) { const int col = i * 256 + lane * 4; const f32x4 g = *(const f32x4*)(gfin + col); f32x4 o;
#pragma unroll
            for (int j = 0; j < 4; ++j) o[j] = v[i][j] * rstd * g[j];
            *(f32x4*)(out + (size_t)row * D + col) = o; }
    }
}

typedef float f32x2_t __attribute__((ext_vector_type(2))); typedef __bf16 bf16x2_t __attribute__((ext_vector_type(2)));
__device__ __forceinline__ unsigned cvtpk(float lo, float hi) { f32x2_t v = {lo, hi}; bf16x2_t b = __builtin_convertvector(v, bf16x2_t); return __builtin_bit_cast(unsigned, b); }
#define MFMA32(a, b, c) __builtin_amdgcn_mfma_f32_32x32x16_bf16((a), (b), (c), 0, 0, 0)
constexpr int MLA_KP = 400, MLA_VP = 144, MLA_KB = 64 * MLA_KP, MLA_VB = 128 * MLA_VP, MLA_STAGE = MLA_KB + MLA_VB;
static_assert(2 * MLA_STAGE <= RING_BYTES, "MLA LDS");

__device__ __forceinline__ void ph_mla(const Args& a, bool with_ctx, unsigned char* lds) {
    const bf16_t* __restrict__ Q = (const bf16_t*)(a.ws + WS_Q); const bf16_t* __restrict__ KN = (const bf16_t*)(a.ws + WS_KN); const bf16_t* __restrict__ KPE = (const bf16_t*)(a.ws + WS_KPE);
    const bf16_t* __restrict__ VT = (const bf16_t*)(a.ws + WS_VT); bf16_t* __restrict__ mix = (bf16_t*)(a.ws + WS_MIX);
    int tid_ = threadIdx.x; asm volatile("" : "+v"(tid_));
    const int tid = tid_, lane = tid & 63, w = tid >> 6, qi = lane & 31, hh = lane >> 5;
    const int nunits = with_ctx ? 288 : 256;
    const float c = 0.07216878364870322f * 1.4426950408889634f;
    for (int unit = blockIdx.x; unit < nunits; unit += gridDim.x) {
        int h, b, q0tok, nt; bool ctxq;
        if (unit < 256) { h = unit & 7; b = unit >> 6; q0tok = b * L + ((unit >> 3) & 7) * 256; nt = 36; ctxq = false; }
        else { const int u2 = unit - 256; h = u2 & 7; b = u2 >> 3; q0tok = NLAT + b * C; nt = 4; ctxq = true; }
#define MLA_KTOK(t) (ctxq ? (NLAT + b * C + (t) * 64) : ((t) < 32 ? (b * L + (t) * 64) : (NLAT + b * C + ((t) - 32) * 64)))
        u32x4 r0, r1, r2, r3, r4;
#define MLA_ISSUE_K(t) do { const int kt0_ = MLA_KTOK(t); \
            r0 = *(const u32x4*)(KN + (size_t)(kt0_ + (tid >> 4)) * 1024 + h * 128 + (tid & 15) * 8); \
            r1 = *(const u32x4*)(KN + (size_t)(kt0_ + 32 + (tid >> 4)) * 1024 + h * 128 + (tid & 15) * 8); \
            r2 = *(const u32x4*)(KPE + (size_t)(kt0_ + (tid >> 3)) * 64 + (tid & 7) * 8); } while (0)
#define MLA_ISSUE_V(t) do { const int kt0_ = MLA_KTOK(t); \
            r3 = *(const u32x4*)(VT + (size_t)(h * 128 + (tid >> 3)) * NTOK + kt0_ + (tid & 7) * 8); \
            r4 = *(const u32x4*)(VT + (size_t)(h * 128 + 64 + (tid >> 3)) * NTOK + kt0_ + (tid & 7) * 8); } while (0)
#define MLA_ISSUE(t) do { MLA_ISSUE_K(t); MLA_ISSUE_V(t); } while (0)
#define MLA_COMMIT(buf) do { unsigned char* kb_ = lds + (buf) * MLA_STAGE; unsigned char* vb_ = kb_ + MLA_KB; \
            *(u32x4*)(kb_ + (tid >> 4) * MLA_KP + (tid & 15) * 16) = r0; \
            *(u32x4*)(kb_ + (32 + (tid >> 4)) * MLA_KP + (tid & 15) * 16) = r1; \
            *(u32x4*)(kb_ + (tid >> 3) * MLA_KP + 256 + (tid & 7) * 16) = r2; \
            const int g_ = (tid & 7) >> 1, e_ = tid & 1; \
            { u32x2 lo_, hi_; lo_.x = r3.x; lo_.y = r3.y; hi_.x = r3.z; hi_.y = r3.w; \
              *(u32x2*)(vb_ + (tid >> 3) * MLA_VP + g_ * 32 + e_ * 8) = lo_; *(u32x2*)(vb_ + (tid >> 3) * MLA_VP + g_ * 32 + 16 + e_ * 8) = hi_; } \
            { u32x2 lo_, hi_; lo_.x = r4.x; lo_.y = r4.y; hi_.x = r4.z; hi_.y = r4.w; \
              *(u32x2*)(vb_ + (64 + (tid >> 3)) * MLA_VP + g_ * 32 + e_ * 8) = lo_; *(u32x2*)(vb_ + (64 + (tid >> 3)) * MLA_VP + g_ * 32 + 16 + e_ * 8) = hi_; } } while (0)
        const int qtok = q0tok + w * 32 + qi;
        bf16x8 qf[12];
#pragma unroll
        for (int s = 0; s < 12; ++s) qf[s] = *(const bf16x8*)(Q + (size_t)qtok * QW + h * 192 + s * 16 + hh * 8);
        f32x16 o[4];
#pragma unroll
        for (int d = 0; d < 4; ++d)
#pragma unroll
            for (int r = 0; r < 16; ++r) o[d][r] = 0.f;
        float m = -1.0e30f, l = 0.f;
        MLA_ISSUE(0); MLA_COMMIT(0);
        __syncthreads();
        for (int t = 0; t < nt; ++t) {
            const unsigned char* kb = lds + (t & 1) * MLA_STAGE; const unsigned char* vb = kb + MLA_KB;
            f32x16 s0, s1;
#pragma unroll
            for (int r = 0; r < 16; ++r) { s0[r] = 0.f; s1[r] = 0.f; }
            {
                const unsigned char* kp0 = kb + qi * MLA_KP + hh * 16; const unsigned char* kp1 = kp0 + 32 * MLA_KP;
                bf16x8 ka[4], kn[4];
                ka[0] = *(const bf16x8*)(kp0); ka[1] = *(const bf16x8*)(kp1); ka[2] = *(const bf16x8*)(kp0 + 32); ka[3] = *(const bf16x8*)(kp1 + 32);
#pragma unroll
                for (int g = 0; g < 6; ++g) {
                    if (g < 5) { kn[0] = *(const bf16x8*)(kp0 + (2 * g + 2) * 32); kn[1] = *(const bf16x8*)(kp1 + (2 * g + 2) * 32); kn[2] = *(const bf16x8*)(kp0 + (2 * g + 3) * 32); kn[3] = *(const bf16x8*)(kp1 + (2 * g + 3) * 32); }
                    __builtin_amdgcn_sched_barrier(0);
                    s0 = MFMA32(ka[0], qf[2 * g], s0); s1 = MFMA32(ka[1], qf[2 * g], s1); s0 = MFMA32(ka[2], qf[2 * g + 1], s0); s1 = MFMA32(ka[3], qf[2 * g + 1], s1);
                    __builtin_amdgcn_sched_barrier(0);
#pragma unroll
                    for (int q = 0; q < 4; ++q) ka[q] = kn[q];
                }
            }
            if (t + 1 < nt) MLA_ISSUE(t + 1);
            float mx = fmaxf(s0[0], s1[0]);
#pragma unroll
            for (int r = 1; r < 16; ++r) mx = fmaxf(mx, fmaxf(s0[r], s1[r]));
            mx = fmaxf(mx, __shfl_xor(mx, 32));
            const float mnew = fmaxf(m, mx * c);
            const float alpha = __builtin_amdgcn_exp2f(m - mnew);
            m = mnew;
            float ps = 0.f;
#pragma unroll
            for (int r = 0; r < 16; ++r) { s0[r] = __builtin_amdgcn_exp2f(s0[r] * c - mnew); s1[r] = __builtin_amdgcn_exp2f(s1[r] * c - mnew); ps += s0[r] + s1[r]; }
            l = l * alpha + ps;
            if ((PROBE_SUB >> 9) & 1u) {
                float ps2 = 0.f;
#pragma unroll
                for (int r = 0; r < 16; ++r) { float x0 = s0[r], x1 = s1[r]; asm volatile("" : "+v"(x0), "+v"(x1)); ps2 += __builtin_amdgcn_exp2f(x0 * c - 40.f) + __builtin_amdgcn_exp2f(x1 * c - 40.f); }
                float mx2 = ps2;
#pragma unroll
                for (int r = 0; r < 16; ++r) { float x0 = s0[r], x1 = s1[r]; asm volatile("" : "+v"(x0), "+v"(x1)); mx2 = fmaxf(mx2, fmaxf(x0 * c, x1 * c)); }
                if (mx2 == 123456.75f) l += ps2;
            }
            if ((PROBE_SUB >> 10) & 1u) {
                f32x16 sx;
#pragma unroll
                for (int r = 0; r < 16; ++r) sx[r] = 0.f;
#pragma unroll
                for (int s = 0; s < 12; ++s) { bf16x8 k0 = *(const bf16x8*)(kb + qi * MLA_KP + s * 32 + hh * 16); sx = MFMA32(k0, qf[s], sx); }
                if (sx[0] == 123456.75f) l += sx[1];
            }
#pragma unroll
            for (int d = 0; d < 4; ++d)
#pragma unroll
                for (int r = 0; r < 16; ++r) o[d][r] *= alpha;
            bf16x8 pf[4];
            { u32x4 p;
              p.x = cvtpk(s0[0], s0[1]); p.y = cvtpk(s0[2], s0[3]); p.z = cvtpk(s0[4], s0[5]); p.w = cvtpk(s0[6], s0[7]); pf[0] = __builtin_bit_cast(bf16x8, p);
              p.x = cvtpk(s0[8], s0[9]); p.y = cvtpk(s0[10], s0[11]); p.z = cvtpk(s0[12], s0[13]); p.w = cvtpk(s0[14], s0[15]); pf[1] = __builtin_bit_cast(bf16x8, p);
              p.x = cvtpk(s1[0], s1[1]); p.y = cvtpk(s1[2], s1[3]); p.z = cvtpk(s1[4], s1[5]); p.w = cvtpk(s1[6], s1[7]); pf[2] = __builtin_bit_cast(bf16x8, p);
              p.x = cvtpk(s1[8], s1[9]); p.y = cvtpk(s1[10], s1[11]); p.z = cvtpk(s1[12], s1[13]); p.w = cvtpk(s1[14], s1[15]); pf[3] = __builtin_bit_cast(bf16x8, p); }
            asm volatile("" ::: "memory");
            {
                const unsigned char* vp = vb + qi * MLA_VP + hh * 16;
                bf16x8 va[4], vn[4];
#pragma unroll
                for (int g = 0; g < 4; ++g) va[g] = *(const bf16x8*)(vp + g * 32);
#pragma unroll
                for (int d = 0; d < 4; ++d) {
                    if (d < 3) {
#pragma unroll
                        for (int g = 0; g < 4; ++g) vn[g] = *(const bf16x8*)(vp + (d + 1) * 32 * MLA_VP + g * 32); }
                    __builtin_amdgcn_sched_barrier(0);
#pragma unroll
                    for (int g = 0; g < 4; ++g) o[d] = MFMA32(va[g], pf[g], o[d]);
                    __builtin_amdgcn_sched_barrier(0);
#pragma unroll
                    for (int g = 0; g < 4; ++g) va[g] = vn[g];
                }
            }
            if (t + 1 < nt) MLA_COMMIT((t + 1) & 1);
            __syncthreads();
        }
        const float inv = 1.0f / (l + __shfl_xor(l, 32));
        bf16_t* op = mix + (size_t)qtok * D + h * 128 + 4 * hh;
#pragma unroll
        for (int d = 0; d < 4; ++d)
#pragma unroll
            for (int g = 0; g < 4; ++g) { u32x2 wv; wv.x = cvtpk(o[d][4 * g] * inv, o[d][4 * g + 1] * inv); wv.y = cvtpk(o[d][4 * g + 2] * inv, o[d][4 * g + 3] * inv);
                *(u32x2*)(op + d * 32 + 8 * g) = wv; }
#undef MLA_KTOK
#undef MLA_ISSUE
#undef MLA_ISSUE_K
#undef MLA_ISSUE_V
#undef MLA_COMMIT
    }
}

constexpr int HY_CS = 8224, HY_WS = 5136, HY_WOFF = 8 * HY_CS, HY_RBL = HY_WOFF + 4 * HY_WS;
static_assert(HY_RBL + 516 * 16 <= RING_BYTES, "hyena LDS");

__device__ __forceinline__ u32x4 hy_shift(const u32x4 a, const u32x4 b, int r) {
    switch (r) {
    case 0: return b;
    case 1: return (u32x4){__builtin_amdgcn_alignbyte(b.x, a.w, 2), __builtin_amdgcn_alignbyte(b.y, b.x, 2), __builtin_amdgcn_alignbyte(b.z, b.y, 2), __builtin_amdgcn_alignbyte(b.w, b.z, 2)};
    case 2: return (u32x4){a.w, b.x, b.y, b.z};
    case 3: return (u32x4){__builtin_amdgcn_alignbyte(a.w, a.z, 2), __builtin_amdgcn_alignbyte(b.x, a.w, 2), __builtin_amdgcn_alignbyte(b.y, b.x, 2), __builtin_amdgcn_alignbyte(b.z, b.y, 2)};
    case 4: return (u32x4){a.z, a.w, b.x, b.y};
    case 5: return (u32x4){__builtin_amdgcn_alignbyte(a.z, a.y, 2), __builtin_amdgcn_alignbyte(a.w, a.z, 2), __builtin_amdgcn_alignbyte(b.x, a.w, 2), __builtin_amdgcn_alignbyte(b.y, b.x, 2)};
    case 6: return (u32x4){a.y, a.z, a.w, b.x};
    default: return (u32x4){__builtin_amdgcn_alignbyte(a.y, a.x, 2), __builtin_amdgcn_alignbyte(a.z, a.y, 2), __builtin_amdgcn_alignbyte(a.w, a.z, 2), __builtin_amdgcn_alignbyte(b.x, a.w, 2)};
    }
}

__device__ __forceinline__ void ph_hyena(const Args& a, int l, unsigned char* lds) {
    const bf16_t* __restrict__ RB = (const bf16_t*)(a.ws + WS_FILTL) + (size_t)l * 512 * HY_RBROW;
    const bf16_t* __restrict__ wtl = (const bf16_t*)(a.ws + WS_WTL);
    int tid_ = threadIdx.x; asm volatile("" : "+v"(tid_));
    const int tid = tid_, lane = tid & 63, w = __builtin_amdgcn_readfirstlane(tid >> 6), i = lane & 31, hh = lane >> 5;
    for (int unit = blockIdx.x; unit < 512; unit += gridDim.x) {
        const int c = unit;
        for (int k = tid; k < 515; k += NTHR) { u32x4 v = (u32x4){0u, 0u, 0u, 0u}; if (k < 513) v = *(const u32x4*)(RB + (size_t)c * HY_RBROW + k * 8); *(u32x4*)(lds + HY_RBL + k * 16) = v; }
        for (int k = tid; k < 4 * 321; k += NTHR) { const int b = k / 321, sl = k - b * 321; u32x4 v = (u32x4){0u, 0u, 0u, 0u};
            if (sl >= 28 && sl < 284) v = *(const u32x4*)(wtl + ((size_t)b * 512 + c) * L + (sl - 28) * 8);
            *(u32x4*)(lds + HY_WOFF + b * HY_WS + sl * 16) = v; }
        __syncthreads();
        for (int qs = lane; qs < 511; qs += 64) {
            const u32x4 ca = *(const u32x4*)(lds + HY_RBL + qs * 16), cb = *(const u32x4*)(lds + HY_RBL + qs * 16 + 16);
            *(u32x4*)(lds + w * HY_CS + qs * 16) = hy_shift(ca, cb, w);
        }
        __syncthreads();
        f32x16 acc0, acc1;
#pragma unroll
        for (int r = 0; r < 16; ++r) { acc0[r] = 0.f; acc1[r] = 0.f; }
        const int Tl = i >> 2, b = i & 3;
        const unsigned char* ap = lds + (i & 7) * HY_CS + (hh - (i >> 3) + 255) * 16;
        const unsigned char* bp = lds + HY_WOFF + b * HY_WS + (224 + 16 * (2 * (8 * w + Tl)) + 8 * hh) * 2;
        const int d0 = 16 * w - 127;
#pragma unroll 2
        for (int dd = 0; dd < 142; dd += 2) {
            const int d = d0 + dd;
            const bf16x8 a0 = *(const bf16x8*)(ap - 32 * d), b0 = *(const bf16x8*)(bp - 32 * d);
            const bf16x8 a1 = *(const bf16x8*)(ap - 32 * (d + 1)), b1 = *(const bf16x8*)(bp - 32 * (d + 1));
            acc0 = MFMA32(a0, b0, acc0); acc1 = MFMA32(a1, b1, acc1);
        }
        bf16_t* yt = (bf16_t*)(a.ws + WS_YT) + ((size_t)b * 512 + c) * L + 32 * (8 * w + Tl) + 4 * hh;
#pragma unroll
        for (int g = 0; g < 4; ++g) { u32x2 wv; wv.x = cvtpk(acc0[4 * g] + acc1[4 * g], acc0[4 * g + 1] + acc1[4 * g + 1]); wv.y = cvtpk(acc0[4 * g + 2] + acc1[4 * g + 2], acc0[4 * g + 3] + acc1[4 * g + 3]);
            *(u32x2*)(yt + 8 * g) = wv; }
        __syncthreads();
    }
}

__device__ __forceinline__ void ph_hyena_fin(const Args& a, int l, bool with_ctx, unsigned char* lds) {
    const bf16_t* __restrict__ YT = (const bf16_t*)(a.ws + WS_YT); const bf16_t* __restrict__ wtl = (const bf16_t*)(a.ws + WS_WTL); const bf16_t* __restrict__ wtc = (const bf16_t*)(a.ws + WS_WTC);
    const bf16_t* __restrict__ x0 = (const bf16_t*)(a.ws + WS_X0); const float* skip = a.in[23] + l * 512; bf16_t* __restrict__ mix = (bf16_t*)(a.ws + WS_MIX);
    int tid_ = threadIdx.x; asm volatile("" : "+v"(tid_));
    const int tid = tid_;
    bf16_t* T = (bf16_t*)lds;
    constexpr int TP = 520;
    const int nunits = with_ctx ? 144 : 128;
    for (int unit = (int)gridDim.x - 1 - (int)blockIdx.x; unit < nunits; unit += gridDim.x) {
        const bool lat = unit < 128; const int b = lat ? (unit >> 5) : ((unit - 128) >> 2), t0 = lat ? (unit & 31) * 64 : ((unit - 128) & 3) * 64;
        const int Ls = lat ? L : C; const int tok0 = lat ? b * L + t0 : NLAT + b * C + t0;
        const bf16_t* yrow = (lat ? YT : YT + (size_t)NB * 512 * L) + ((size_t)b * 512 + tid) * Ls + t0;
        const bf16_t* wrow = (lat ? wtl : wtc) + ((size_t)b * 512 + tid) * Ls + t0;
        const float sk = skip[tid];
#pragma unroll
        for (int hf = 0; hf < 2; ++hf) {
            u32x4 yv[4], wv[4];
#pragma unroll
            for (int q = 0; q < 4; ++q) { yv[q] = *(const u32x4*)(yrow + hf * 32 + q * 8); wv[q] = *(const u32x4*)(wrow + hf * 32 + q * 8); }
#pragma unroll
            for (int q = 0; q < 4; ++q) { const unsigned yy[4] = {yv[q].x, yv[q].y, yv[q].z, yv[q].w}, ww[4] = {wv[q].x, wv[q].y, wv[q].z, wv[q].w};
#pragma unroll
                for (int d = 0; d < 4; ++d) { const int t = hf * 32 + q * 8 + 2 * d;
                    T[t * TP + tid] = f2bf(__uint_as_float(yy[d] << 16) + sk * __uint_as_float(ww[d] << 16));
                    T[(t + 1) * TP + tid] = f2bf(__uint_as_float(yy[d] & 0xffff0000u) + sk * __uint_as_float(ww[d] & 0xffff0000u)); } }
        }
        __syncthreads();
#pragma unroll
        for (int j = 0; j < 8; ++j) { const int o = tid + 512 * j, t = o >> 6, cc = (o & 63) * 8;
            const u32x4 tv = *(const u32x4*)(T + t * TP + cc), xv = *(const u32x4*)(x0 + (size_t)(tok0 + t) * 512 + cc);
            const unsigned tt[4] = {tv.x, tv.y, tv.z, tv.w}, xx[4] = {xv.x, xv.y, xv.z, xv.w}; unsigned oo[4];
#pragma unroll
            for (int d = 0; d < 4; ++d) oo[d] = cvtpk(__uint_as_float(tt[d] << 16) * __uint_as_float(xx[d] << 16), __uint_as_float(tt[d] & 0xffff0000u) * __uint_as_float(xx[d] & 0xffff0000u));
            *(u32x4*)(mix + (size_t)(tok0 + t) * D + 1024 + cc) = (u32x4){oo[0], oo[1], oo[2], oo[3]}; }
        __syncthreads();
    }
}

constexpr int SWA_P = 144, SWA_KB = 64 * SWA_P, SWA_STAGE = 2 * SWA_KB;
__device__ __forceinline__ void ph_swa(const Args& a, int l, bool with_ctx, unsigned char* lds) {
    const bf16_t* __restrict__ SQ = (const bf16_t*)(a.ws + WS_SQ); const bf16_t* __restrict__ SK = (const bf16_t*)(a.ws + WS_SK); const bf16_t* __restrict__ SVT = (const bf16_t*)(a.ws + WS_SV);
    const float* sink = a.in[24] + l * 8; bf16_t* __restrict__ mix = (bf16_t*)(a.ws + WS_MIX);
    int tid_ = threadIdx.x; asm volatile("" : "+v"(tid_));
    const int tid = tid_, lane = tid & 63, w = tid >> 6, qi = lane & 31, hh = lane >> 5;
    const int nunits = with_ctx ? 288 : 256;
    const float c = 0.125f * 1.4426950408889634f;
    for (int unit = blockIdx.x; unit < nunits; unit += gridDim.x) {
        int hk, b, p0, nloc, t0loc, q0tok; bool ctxq;
        if (unit < 256) { hk = unit & 1; b = (unit >> 1) & 3; p0 = (unit >> 3) * 64; ctxq = false; q0tok = b * L + p0;
            const int lo = p0 - 128 < 0 ? 0 : p0 - 128, hi = p0 + 192 > L ? L : p0 + 192; t0loc = lo; nloc = (hi - lo) >> 6; }
        else { const int u2 = unit - 256; hk = u2 & 1; b = (u2 >> 1) & 3; p0 = (u2 >> 3) * 64; ctxq = true; q0tok = NLAT + b * C + p0; t0loc = 0; nloc = 0; }
        const int nt = nloc + 4;
#define SWA_KTOK(t) ((t) < nloc ? (b * L + t0loc + (t) * 64) : (NLAT + b * C + ((t) - nloc) * 64))
        u32x4 r0, r1;
#define SWA_ISSUE(t) do { const int kt0_ = SWA_KTOK(t); \
            r0 = *(const u32x4*)(SK + (size_t)(kt0_ + (tid >> 3)) * 128 + hk * 64 + (tid & 7) * 8); \
            r1 = *(const u32x4*)(SVT + (size_t)(hk * 64 + (tid >> 3)) * NTOK + kt0_ + (tid & 7) * 8); } while (0)
#define SWA_COMMIT(buf) do { unsigned char* kb_ = lds + (buf) * SWA_STAGE; unsigned char* vb_ = kb_ + SWA_KB; \
            *(u32x4*)(kb_ + (tid >> 3) * SWA_P + (tid & 7) * 16) = r0; \
            const int g_ = (tid & 7) >> 1, e_ = tid & 1; u32x2 lo_, hi_; lo_.x = r1.x; lo_.y = r1.y; hi_.x = r1.z; hi_.y = r1.w; \
            *(u32x2*)(vb_ + (tid >> 3) * SWA_P + g_ * 32 + e_ * 8) = lo_; *(u32x2*)(vb_ + (tid >> 3) * SWA_P + g_ * 32 + 16 + e_ * 8) = hi_; } while (0)
        const int hq = hk * 4 + (w >> 1), qpos = p0 + (w & 1) * 32 + qi, qtok = q0tok + (w & 1) * 32 + qi;
        bf16x8 qf[4];
#pragma unroll
        for (int s = 0; s < 4; ++s) qf[s] = *(const bf16x8*)(SQ + (size_t)qtok * 512 + hq * 64 + s * 16 + hh * 8);
        f32x16 o[2];
#pragma unroll
        for (int d = 0; d < 2; ++d)
#pragma unroll
            for (int r = 0; r < 16; ++r) o[d][r] = 0.f;
        float m = sink[hq] * 1.4426950408889634f, lsum = hh == 0 ? 1.0f : 0.0f;
        SWA_ISSUE(0); SWA_COMMIT(0);
        __syncthreads();
        for (int t = 0; t < nt; ++t) {
            const unsigned char* kb = lds + (t & 1) * SWA_STAGE; const unsigned char* vb = kb + SWA_KB;
            f32x16 s0, s1;
#pragma unroll
            for (int r = 0; r < 16; ++r) { s0[r] = 0.f; s1[r] = 0.f; }
#pragma unroll
            for (int s = 0; s < 4; ++s) {
                const bf16x8 k0 = *(const bf16x8*)(kb + qi * SWA_P + s * 32 + hh * 16);
                const bf16x8 k1 = *(const bf16x8*)(kb + (32 + qi) * SWA_P + s * 32 + hh * 16);
                s0 = MFMA32(k0, qf[s], s0); s1 = MFMA32(k1, qf[s], s1);
            }
            if (t + 1 < nt) SWA_ISSUE(t + 1);
            if (t < nloc) {
                const int kbase = t0loc + t * 64 + 4 * hh - qpos;
#pragma unroll
                for (int r = 0; r < 16; ++r) { const int dlt = kbase + (r & 3) + 8 * (r >> 2);
                    if (dlt > 128 || dlt < -128) s0[r] = -1.0e30f;
                    if (dlt + 32 > 128 || dlt + 32 < -128) s1[r] = -1.0e30f; }
            }
            float mx = fmaxf(s0[0], s1[0]);
#pragma unroll
            for (int r = 1; r < 16; ++r) mx = fmaxf(mx, fmaxf(s0[r], s1[r]));
            mx = fmaxf(mx, __shfl_xor(mx, 32));
            const float mnew = fmaxf(m, mx * c);
            const float alpha = __builtin_amdgcn_exp2f(m - mnew);
            m = mnew;
            float ps = 0.f;
#pragma unroll
            for (int r = 0; r < 16; ++r) { s0[r] = __builtin_amdgcn_exp2f(s0[r] * c - mnew); s1[r] = __builtin_amdgcn_exp2f(s1[r] * c - mnew); ps += s0[r] + s1[r]; }
            lsum = lsum * alpha + ps;
#pragma unroll
            for (int d = 0; d < 2; ++d)
#pragma unroll
                for (int r = 0; r < 16; ++r) o[d][r] *= alpha;
            bf16x8 pf[4];
            { u32x4 p;
              p.x = cvtpk(s0[0], s0[1]); p.y = cvtpk(s0[2], s0[3]); p.z = cvtpk(s0[4], s0[5]); p.w = cvtpk(s0[6], s0[7]); pf[0] = __builtin_bit_cast(bf16x8, p);
              p.x = cvtpk(s0[8], s0[9]); p.y = cvtpk(s0[10], s0[11]); p.z = cvtpk(s0[12], s0[13]); p.w = cvtpk(s0[14], s0[15]); pf[1] = __builtin_bit_cast(bf16x8, p);
              p.x = cvtpk(s1[0], s1[1]); p.y = cvtpk(s1[2], s1[3]); p.z = cvtpk(s1[4], s1[5]); p.w = cvtpk(s1[6], s1[7]); pf[2] = __builtin_bit_cast(bf16x8, p);
              p.x = cvtpk(s1[8], s1[9]); p.y = cvtpk(s1[10], s1[11]); p.z = cvtpk(s1[12], s1[13]); p.w = cvtpk(s1[14], s1[15]); pf[3] = __builtin_bit_cast(bf16x8, p); }
#pragma unroll
            for (int d = 0; d < 2; ++d)
#pragma unroll
                for (int g = 0; g < 4; ++g) {
                    const bf16x8 vf = *(const bf16x8*)(vb + (d * 32 + qi) * SWA_P + g * 32 + hh * 16);
                    o[d] = MFMA32(vf, pf[g], o[d]);
                }
            if (t + 1 < nt) SWA_COMMIT((t + 1) & 1);
            __syncthreads();
        }
        const float inv = 1.0f / (lsum + __shfl_xor(lsum, 32));
        bf16_t* op = mix + (size_t)qtok * D + 1536 + hq * 64 + 4 * hh;
#pragma unroll
        for (int d = 0; d < 2; ++d)
#pragma unroll
            for (int g = 0; g < 4; ++g) { u32x2 wv; wv.x = cvtpk(o[d][4 * g] * inv, o[d][4 * g + 1] * inv); wv.y = cvtpk(o[d][4 * g + 2] * inv, o[d][4 * g + 3] * inv);
                *(u32x2*)(op + d * 32 + 8 * g) = wv; }
#undef SWA_KTOK
#undef SWA_ISSUE
#undef SWA_COMMIT
    }
}


constexpr int NPHASES = 22;
#define GEMM_CALL(EPI, SCHED, g, S, E) pg8::gemm_phase<EPI, SCHED, true, true, 0>((PG8_LAS unsigned char*)lds, g, S, E)
#define GEMM_CALL8(EPI, SCHED, g, S, E) pg8::gemm_phase<EPI, SCHED, true, true, 1>((PG8_LAS unsigned char*)lds, g, S, E)
#define GEMM_CALLI8(EPI, SCHED, g, S, E) pg8::gemm_phase<EPI, SCHED, true, true, 2>((PG8_LAS unsigned char*)lds, g, S, E)

template <int LYR>
__device__ __forceinline__ void layer_phases(const Args& a, unsigned char* lds, const XcdBarrier& bar, int lo, int hi) {
#define IN(k) (lo <= (k) && (k) < hi)
#define REPS(k) for (int rep_ = 0; rep_ <= (int)((PROBE_MASK >> (k)) & 1u); ++rep_)
#if MK_PER_PHASE
#define SEAM(k) do { } while (0)
#else
#define SEAM(k) do { if (IN(k) && IN((k) + 1)) xcd_barrier(bar); } while (0)
#endif
    constexpr int P0 = 1 + LYR * 9;
    constexpr bool LAST = (LYR == 1);
    constexpr int S_WO = pg8::split_S((LAST ? NLAT : NTOK) / 256 * (D / 256), D / 64, 256);
    constexpr int S_WO0 = pg8::split_S(NTOK / 256 * (D / 256), D / 64, 256);
    constexpr int S_DN0 = pg8::split_S(NTOK / 256 * (D / 256), (FP8_DENSE || FP8_DOWN) ? DFF / 128 : DFF / 64, 256);
    constexpr int S_DN = pg8::split_S(NTOK / 256 * (D / 256), (FP8_DENSE || FP8_DOWN) ? DFF / 128 : DFF / 64, 256);
    const int G = gridDim.x, bid = blockIdx.x;
    unsigned char* ws = a.ws;
    const float* modl = (const float*)(ws + WS_MOD) + (size_t)LYR * 5 * 12288;
    float* xs = (float*)(ws + WS_XS);
    const int nq = LAST ? NLAT : NTOK;
    if (IN(P0 + 0)) REPS(P0 + 0) {
        if (LYR == 0) ph_normmod<false, true, I8_WIN ? 2 : 0>(a.in[0], a.in[2], a.in[6], modl, 0, 2048, (bf16_t*)(ws + WS_HA), NTOK, xs, nullptr, nullptr, nullptr, nullptr, nullptr, (float*)(ws + WS_RSC));
        else ph_normmod<false, false, I8_WIN ? 2 : 0, S_DN0>(xs, xs + (size_t)NLAT * D, a.in[6] + D, modl, 0, 2048, (bf16_t*)(ws + WS_HA), NTOK, nullptr, nullptr, nullptr, nullptr,
                                                    (const float*)(ws + WS_SLAB), (const float*)(ws + WS_MOD) + (size_t)4 * 12288 + 10240, (float*)(ws + WS_RSC));
    }
    SEAM(P0 + 0);
    if (IN(P0 + 1)) REPS(P0 + 1) {
#if I8_WIN
        pg8::Gemm g{(const bf16_t*)(ws + WS_HA), (const bf16_t*)(ws + WS_WIN + (size_t)LYR * UW * D * 2), NTOK, UW, D / 2};
        const float swin = __uint_as_float(__hip_atomic_load((const unsigned*)(ws + WS_CTL) + CT_WSC + LYR, __ATOMIC_RELAXED, __HIP_MEMORY_SCOPE_AGENT)) * (1.0f / 127.0f);
        pg8::EpiStoreI8 E{(bf16_t*)(ws + WS_U), UW, (const float*)(ws + WS_RSC), swin};
        if constexpr (LAST) { pg8::WinLastOrder S; S.init(G, bid, D / 2); GEMM_CALLI8(pg8::EpiStoreI8, pg8::WinLastOrder, g, S, E); }
        else { pg8::StaticOrder S; S.init(NTOK, UW, G, bid, D / 2); GEMM_CALLI8(pg8::EpiStoreI8, pg8::StaticOrder, g, S, E); }
#else
        pg8::Gemm g{(const bf16_t*)(ws + WS_HA), (const bf16_t*)(ws + WS_WIN + (size_t)LYR * UW * D * 2), NTOK, UW, D};
        pg8::EpiStore E{(bf16_t*)(ws + WS_U), UW};
        if constexpr (LAST) { pg8::WinLastOrder S; S.init(G, bid, D); GEMM_CALL(pg8::EpiStore, pg8::WinLastOrder, g, S, E); }
        else { pg8::StaticOrder S; S.init(NTOK, UW, G, bid, D); GEMM_CALL(pg8::EpiStore, pg8::StaticOrder, g, S, E); }
#endif
        if (!LAST && rep_ == 0 && G == 256 && bid >= TAIL1_BLK0 && TAILQ1 > 0) ph_convert<0>(a, (float*)lds, NCONV_Q + (bid - TAIL1_BLK0) * TAILQ1, 1, NCONV_Q + (bid - TAIL1_BLK0 + 1) * TAILQ1);
        conv_fill(a, (float*)lds, LYR * 6 + 0);
    }
    SEAM(P0 + 1);
    if (IN(P0 + 2)) REPS(P0 + 2) ph_mid(a, LYR);
    SEAM(P0 + 2);
    if (IN(P0 + 3)) REPS(P0 + 3) {
        SUBREP(0) {
        { pg8::Gemm g{(const bf16_t*)(ws + WS_CQN), (const bf16_t*)(ws + WS_WQ + (size_t)LYR * QW * 768 * 2), nq, QW, 768};
          pg8::StaticOrder S; S.init(nq, QW, G, bid, 768); pg8::EpiQ E{(bf16_t*)(ws + WS_Q), (const float*)(ws + WS_ROPE), (const float*)(ws + WS_ROPE) + 2048 * 32};
          GEMM_CALL(pg8::EpiQ, pg8::StaticOrder, g, S, E); }
        __syncthreads();
        { pg8::Gemm g{(const bf16_t*)(ws + WS_CKVN), (const bf16_t*)(ws + WS_WKV + (size_t)LYR * KVW * 512 * 2), NTOK, 1024, 512};
          pg8::StaticOrder S; S.init(NTOK, 1024, G, bid, 512); pg8::EpiStore E{(bf16_t*)(ws + WS_KN), 1024};
          GEMM_CALL(pg8::EpiStore, pg8::StaticOrder, g, S, E); }
        __syncthreads();
        { pg8::Gemm g{(const bf16_t*)(ws + WS_WKV + (size_t)LYR * KVW * 512 * 2 + (size_t)1024 * 512 * 2), (const bf16_t*)(ws + WS_CKVN), 1024, NTOK, 512};
          pg8::StaticOrder S; S.init(1024, NTOK, 108, bid >= 216 ? bid - 216 : (bid >= 144 ? bid - 108 : (1 << 24)), 512); pg8::EpiStore E{(bf16_t*)(ws + WS_VT), NTOK};
          GEMM_CALL(pg8::EpiStore, pg8::StaticOrder, g, S, E); }
        __syncthreads();
        }
        SUBREP(1) ph_hyena(a, LYR, lds);
        SUBREP(3) if (!LAST) ph_hyena_naive<C>(a, LYR, (float*)lds);
        SUBREP(2) ph_swa(a, LYR, !LAST, lds);
        conv_fill(a, (float*)lds, LYR * 6 + 1);
    }
    SEAM(P0 + 3);
    if (IN(P0 + 4)) REPS(P0 + 4) { ph_hyena_fin(a, LYR, !LAST, lds); ph_mla(a, !LAST, lds);
        if (!LAST && rep_ == 0 && G == 256 && bid >= TAIL4_BLK0 && TAILQ4 > 0) ph_convert<0>(a, (float*)lds, NCONV_Q + NCONV_T1 + NCONV_T2 + NCONV_T3 + (bid - TAIL4_BLK0) * TAILQ4, 1, NCONV_Q + NCONV_T1 + NCONV_T2 + NCONV_T3 + (bid - TAIL4_BLK0 + 1) * TAILQ4); conv_fill(a, (float*)lds, LYR * 6 + 2); }
    SEAM(P0 + 4);
    if (IN(P0 + 5)) REPS(P0 + 5) {
        pg8::Gemm g{(const bf16_t*)(ws + WS_MIX), (const bf16_t*)(ws + WS_WOUT + (size_t)LYR * D * D * 2), nq, D, D};
        pg8::SplitOrder S; S.init(nq / 256, D / 256, G, bid, D, S_WO);
        const int trow0 = S.nfull / S.nN * 256; pg8::EpiResid E{rep_ ? (float*)(ws + WS_ACT) : xs, modl + 4096, (float*)(ws + WS_SLAB), trow0, nq - trow0, 1.0f};
        GEMM_CALL(pg8::EpiResid, pg8::SplitOrder, g, S, E);
        conv_fill(a, (float*)lds, LYR * 6 + 3);
    }
    SEAM(P0 + 5);
    if (!LAST) {
#if !FP8_DENSE
        if (IN(P0 + 6)) { ph_normmod<false, true, I8_GU ? 2 : 0, S_WO0>(xs, xs + (size_t)NLAT * D, a.in[7], modl, 6144, 8192, (bf16_t*)(ws + WS_HA), NTOK, xs, nullptr, nullptr, nullptr, (const float*)(ws + WS_SLAB), modl + (size_t)4 * 12288 + 4096, (float*)(ws + WS_RSC));
            conv_finish(a, (float*)lds, CONV_DENSE_END); }
        SEAM(P0 + 6);
        if (IN(P0 + 7)) REPS(P0 + 7) {
#if I8_GU
            pg8::Gemm g{(const bf16_t*)(ws + WS_HA), (const bf16_t*)(ws + WS_WGU), NTOK, 2 * DFF, D / 2};
            pg8::StaticOrder S; S.init(NTOK, 2 * DFF, G, bid, D / 2);
            const float swg = __uint_as_float(__hip_atomic_load((const unsigned*)(ws + WS_CTL) + CT_WSC + 2, __ATOMIC_RELAXED, __HIP_MEMORY_SCOPE_AGENT)) * (1.0f / 127.0f);
            const float swu = __uint_as_float(__hip_atomic_load((const unsigned*)(ws + WS_CTL) + CT_WSC + 3, __ATOMIC_RELAXED, __HIP_MEMORY_SCOPE_AGENT)) * (1.0f / 127.0f);
            pg8::EpiSwiGLUI8 E{(unsigned char*)(ws + WS_ACT), DFF, (const float*)(ws + WS_RSC), swg, swu, ASCALE};
            GEMM_CALLI8(pg8::EpiSwiGLUI8, pg8::StaticOrder, g, S, E);
            if (rep_ == 0 && G == 256 && bid >= TAIL2_BLK0 && TAILQ2 > 0) ph_convert<0>(a, (float*)lds, NCONV_Q + NCONV_T1 + (bid - TAIL2_BLK0) * TAILQ2, 1, NCONV_Q + NCONV_T1 + (bid - TAIL2_BLK0 + 1) * TAILQ2);
#elif FP8_DOWN
            pg8::Gemm g{(const bf16_t*)(ws + WS_HA), (const bf16_t*)(ws + WS_WGU), NTOK, 2 * DFF, D};
            pg8::StaticOrder S; S.init(NTOK, 2 * DFF, G, bid, D);
            pg8::EpiSwiGLU8 E{(unsigned char*)(ws + WS_ACT), DFF, 1.0f, ASCALE};
            GEMM_CALL(pg8::EpiSwiGLU8, pg8::StaticOrder, g, S, E);
#else
            pg8::Gemm g{(const bf16_t*)(ws + WS_HA), (const bf16_t*)(ws + WS_WGU), NTOK, 2 * DFF, D};
            pg8::StaticOrder S; S.init(NTOK, 2 * DFF, G, bid, D);
            pg8::EpiSwiGLU E{(bf16_t*)(ws + WS_ACT), DFF};
            GEMM_CALL(pg8::EpiSwiGLU, pg8::StaticOrder, g, S, E);
#endif
            conv_fill(a, (float*)lds, 4);
        }
        SEAM(P0 + 7);
        if (IN(P0 + 8)) REPS(P0 + 8) {
#if FP8_DOWN
            pg8::Gemm g{(const bf16_t*)(ws + WS_ACT), (const bf16_t*)(ws + WS_WDN), NTOK, D, DFF / 2};
            pg8::SplitOrder S; S.init(NTOK / 256, D / 256, G, bid, DFF / 2, S_DN);
            const int trow0 = S.nfull / S.nN * 256; pg8::EpiResid E{rep_ ? (float*)(ws + WS_YS) : xs, modl + 10240, (float*)(ws + WS_SLAB), trow0, NTOK - trow0, 1.0f / (ASCALE * WSCALE)};
            GEMM_CALL8(pg8::EpiResid, pg8::SplitOrder, g, S, E);
            if (rep_ == 0 && G == 256 && bid >= TAIL3_BLK0 && TAILQ3 > 0) ph_convert<0>(a, (float*)lds, NCONV_Q + NCONV_T1 + NCONV_T2 + (bid - TAIL3_BLK0) * TAILQ3, 1, NCONV_Q + NCONV_T1 + NCONV_T2 + (bid - TAIL3_BLK0 + 1) * TAILQ3);
#else
            pg8::Gemm g{(const bf16_t*)(ws + WS_ACT), (const bf16_t*)(ws + WS_WDN), NTOK, D, DFF};
            pg8::SplitOrder S; S.init(NTOK / 256, D / 256, G, bid, DFF, S_DN);
            const int trow0 = S.nfull / S.nN * 256; pg8::EpiResid E{rep_ ? (float*)(ws + WS_YS) : xs, modl + 10240, (float*)(ws + WS_SLAB), trow0, NTOK - trow0, 1.0f};
            GEMM_CALL(pg8::EpiResid, pg8::SplitOrder, g, S, E);
#endif
            conv_fill(a, (float*)lds, 5);
        }
#else
        if (IN(P0 + 6)) { ph_normmod<false, true, true, S_WO0>(xs, xs + (size_t)NLAT * D, a.in[7], modl, 6144, 8192, (bf16_t*)(ws + WS_HA), NTOK, xs, nullptr, nullptr, nullptr, (const float*)(ws + WS_SLAB), modl + (size_t)4 * 12288 + 4096);
            conv_finish(a, (float*)lds, CONV_DENSE_END); }
        SEAM(P0 + 6);
        if (IN(P0 + 7)) REPS(P0 + 7) {
            pg8::Gemm g{(const bf16_t*)(ws + WS_HA), (const bf16_t*)(ws + WS_WGU), NTOK, 2 * DFF, D / 2};
            pg8::StaticOrder S; S.init(NTOK, 2 * DFF, G, bid, D / 2); pg8::EpiSwiGLU8 E{(unsigned char*)(ws + WS_ACT), DFF, 1.0f / (ASCALE * WSCALE), ASCALE};
            GEMM_CALL8(pg8::EpiSwiGLU8, pg8::StaticOrder, g, S, E);
            conv_fill(a, (float*)lds, 4);
        }
        SEAM(P0 + 7);
        if (IN(P0 + 8)) REPS(P0 + 8) {
            pg8::Gemm g{(const bf16_t*)(ws + WS_ACT), (const bf16_t*)(ws + WS_WDN), NTOK, D, DFF / 2};
            pg8::SplitOrder S; S.init(NTOK / 256, D / 256, G, bid, DFF / 2, S_DN);
            const int trow0 = S.nfull / S.nN * 256; pg8::EpiResid E{rep_ ? (float*)(ws + WS_YS) : xs, modl + 10240, (float*)(ws + WS_SLAB), trow0, NTOK - trow0, 1.0f / (ASCALE * WSCALE)};
            GEMM_CALL8(pg8::EpiResid, pg8::SplitOrder, g, S, E);
            conv_fill(a, (float*)lds, 5);
        }
#endif
        SEAM(P0 + 8);
    } else {
        if (IN(P0 + 6)) REPS(P0 + 6) ph_normmod<true, false, true>(xs, xs + (size_t)NLAT * D, a.in[7] + D, modl, 6144, 8192, (bf16_t*)(ws + WS_HA), NLAT, nullptr, a.in[29], (int*)(ws + WS_TOPI), (float*)(ws + WS_TOPW));
        SEAM(P0 + 6);
        if (IN(P0 + 7)) REPS(P0 + 7) { ph_route_gather(a, (int*)lds); conv_finish(a, (float*)lds, NCONV); }
        SEAM(P0 + 7);
        if (IN(P0 + 9)) REPS(P0 + 9) {
            pg8::Gemm g{(const bf16_t*)(ws + WS_HBS), (const bf16_t*)(ws + WS_MGU), MOE_ROWS, 2 * DFE, D / 2};
            pg8::MoeOrder S; S.init((const int*)(ws + WS_CTL), 2 * DFE / 256, G, bid, (size_t)2 * DFE * D, D / 2); pg8::EpiSwiGLU8 E{(unsigned char*)(ws + WS_ACT), DFE, 1.0f / (ASCALE * WSCALE), ASCALE};
            GEMM_CALL8(pg8::EpiSwiGLU8, pg8::MoeOrder, g, S, E);
        }
        SEAM(P0 + 9);
        if (IN(P0 + 10)) REPS(P0 + 10) {
            pg8::Gemm g{(const bf16_t*)(ws + WS_ACT), (const bf16_t*)(ws + WS_MDN), MOE_ROWS, D, DFE / 2};
            pg8::SplitOrder S; S.init_moe((const int*)(ws + WS_CTL), D / 256, G, bid, DFE / 2, (size_t)D * DFE);
            const int trow0 = S.nfull / S.nN * 256; pg8::EpiYs E{(bf16_t*)(ws + WS_YS), (float*)(ws + WS_SLAB), trow0, S.nM * 256 - trow0, 1.0f / (ASCALE * WSCALE)};
            GEMM_CALL8(pg8::EpiYs, pg8::SplitOrder, g, S, E);
        }
        SEAM(P0 + 10);
        if (IN(P0 + 11)) REPS(P0 + 11) ph_final(a);
    }
#undef IN
#undef SEAM
#undef REPS
}

__global__ void __launch_bounds__(NTHR, 2) mk_fwd(Args a) {
    extern __shared__ __attribute__((aligned(16))) unsigned char lds[];
    const int tid = threadIdx.x;
    for (int u = tid; u < (LDS_BYTES - LDSCTL_OFF) / 4; u += NTHR) ((unsigned*)(lds + LDSCTL_OFF))[u] = 0u;
    __syncthreads();
    XcdBarrier bar; bar.bar = (unsigned*)(a.ws + WS_CTL) + CW_BAR; bar.x = 0; bar.st = nullptr;
#if !MK_PER_PHASE
    bar = xcd_barrier_post((unsigned*)(a.ws + WS_CTL) + CW_BAR, (volatile LAS unsigned*)(lds + LDSCTL_OFF + 32));
#endif
    const int lo = a.ph_lo, hi = a.ph_hi;
    if (lo <= 0 && 0 < hi) {
        for (int rep_ = 0; rep_ <= (int)(PROBE_MASK & 1u); ++rep_) { ph_prologue(a, (float*)lds); __syncthreads(); }
#if !MK_PER_PHASE
        if (1 < hi) xcd_barrier(bar);
#endif
    }
    layer_phases<0>(a, lds, bar, lo, hi);
    layer_phases<1>(a, lds, bar, lo, hi);
}

extern "C" void kernel_launch(void* const* d_in, const int* in_sizes, int n_in, void* d_out, int out_size, void* d_ws, size_t ws_size, hipStream_t stream) {
    (void)in_sizes; (void)out_size;
    static int grid = 0;
    if (grid == 0) {
        if (n_in != 34 || ws_size < WS_END) { fprintf(stderr, "kernel_launch: need 34 inputs and >= %zu bytes of workspace (got %d, %zu)\n", (size_t)WS_END, n_in, ws_size); grid = -1; return; }
        int dev = 0, cus = 0, per_cu = 0;
        if (hipGetDevice(&dev) != hipSuccess || hipDeviceGetAttribute(&cus, hipDeviceAttributeMultiprocessorCount, dev) != hipSuccess) { grid = -1; return; }
        if (hipFuncSetAttribute((const void*)mk_fwd, hipFuncAttributeMaxDynamicSharedMemorySize, LDS_BYTES) != hipSuccess) { fprintf(stderr, "kernel_launch: hipFuncSetAttribute failed\n"); grid = -1; return; }
        if (hipOccupancyMaxActiveBlocksPerMultiprocessor(&per_cu, (const void*)mk_fwd, NTHR, LDS_BYTES) != hipSuccess || per_cu < 1) { fprintf(stderr, "kernel_launch: occupancy query says %d blocks per CU\n", per_cu); }
        (void)hipGetLastError();
        grid = cus;
    }
    if (grid < 0) return;
    if (hipMemsetAsync((char*)d_ws + WS_CTL, 0, CTL_ZERO_BYTES, stream) != hipSuccess) return;
    Args a{};
    for (int i = 0; i < 34; ++i) a.in[i] = (const float*)d_in[i];
    a.out = (float*)d_out; a.ws = (unsigned char*)d_ws;
#if MK_PER_PHASE
    for (int p = 0; p < NPHASES; ++p) { a.ph_lo = p; a.ph_hi = p + 1; hipLaunchKernelGGL(mk_fwd, dim3(grid), dim3(NTHR), LDS_BYTES, stream, a); }
#else
    a.ph_lo = 0; a.ph_hi = NPHASES;
    hipLaunchKernelGGL(mk_fwd, dim3(grid), dim3(NTHR), LDS_BYTES, stream, a);
#endif
}
```

```cpp
#include <hip/hip_runtime.h>
#include <stdint.h>
#include <stdio.h>

#ifndef FP8_DENSE
#define FP8_DENSE 0
#endif
#ifndef FP8_DOWN
#define FP8_DOWN 1
#endif
#ifndef I8_WIN
#define I8_WIN 0
#endif
#ifndef I8_GU
#define I8_GU 1
#endif
#ifndef I8_GEMM
#define I8_GEMM (I8_WIN || I8_GU)
#endif
#ifndef TAILQ1
#define TAILQ1 6
#endif
#ifndef TAILQ2
#define TAILQ2 3
#endif
#ifndef TAILQ3
#define TAILQ3 8
#endif
#ifndef TAILQ4
#define TAILQ4 2
#endif
#ifndef CONV_FILL
#define CONV_FILL 0
#endif
#ifndef PROBE_MASK
#define PROBE_MASK 0u
#endif
#ifndef PROBE_SUB
#define PROBE_SUB 0u
#endif
#ifndef MK_PER_PHASE
#define MK_PER_PHASE 0
#endif

typedef unsigned short bf16_t;
typedef float f32x4 __attribute__((ext_vector_type(4)));
typedef float f32x16 __attribute__((ext_vector_type(16)));
typedef unsigned u32x4 __attribute__((ext_vector_type(4)));
typedef unsigned u32x2 __attribute__((ext_vector_type(2)));
typedef short bf16x8 __attribute__((ext_vector_type(8)));

constexpr int D = 2048, NB = 4, L = 2048, C = 256, NLAT = NB * L, NCTX = NB * C, NTOK = NLAT + NCTX;
constexpr int UW = 3840;
constexpr int O_CQ = 0, O_CKV = 768, O_KPE = 1280, O_HY = 1344, O_SQ = 2880, O_SK = 3392, O_SV = 3520, INW = 3648;
constexpr int QW = 1536, KVW = 2048, DFF = 5632, DFE = 7168, NE = 8;
constexpr int MOE_ROWS = 18432;
constexpr float EPS = 1e-6f;
constexpr int NTHR = 512;
constexpr int HY_RBROW = 4112;

__device__ __forceinline__ float bf2f(bf16_t h) { return __uint_as_float(((unsigned)h) << 16); }
__device__ __forceinline__ bf16_t f2bf(float f) { unsigned u = __float_as_uint(f); u += 0x7fffu + ((u >> 16) & 1u); return (bf16_t)(u >> 16); }
__device__ __forceinline__ float wave_sum(float v) { for (int o = 32; o > 0; o >>= 1) v += __shfl_xor(v, o); return v; }
__device__ __forceinline__ float wave_max(float v) { for (int o = 32; o > 0; o >>= 1) v = fmaxf(v, __shfl_xor(v, o)); return v; }
__device__ __forceinline__ float silu(float x) { return x / (1.0f + __expf(-x)); }
__device__ __forceinline__ int tok_mod(int tok) { return tok < NLAT ? (tok >> 11) : 4; }

constexpr size_t al(size_t x) { return (x + 255) & ~(size_t)255; }
constexpr size_t WS_CTL = 0, CTL_ZERO_BYTES = 65536;
constexpr size_t WS_MOD = 65536;
constexpr size_t WS_ROPE = WS_MOD + al((size_t)2 * 5 * 12288 * 4);
constexpr size_t WS_FILTL = WS_ROPE + al((size_t)2 * 2048 * 32 * 4);
constexpr size_t WS_FILTC = WS_FILTL + al((size_t)2 * 512 * 4096 * 4);
constexpr size_t WS_WIN = WS_FILTC + al((size_t)2 * 512 * 512 * 4);
constexpr size_t WS_WQ = WS_WIN + al((size_t)2 * UW * D * 2);
constexpr size_t WS_WKV = WS_WQ + al((size_t)2 * QW * 768 * 2);
constexpr size_t WS_WOUT = WS_WKV + al((size_t)2 * KVW * 512 * 2);
constexpr size_t WS_WGU = WS_WOUT + al((size_t)2 * D * D * 2);
constexpr size_t WS_WDN = WS_WGU + al((size_t)2 * DFF * D * 2);
constexpr size_t WS_MGU = WS_WDN + al((size_t)D * DFF * 2);
constexpr size_t WS_MDN = WS_MGU + al((size_t)NE * 2 * DFE * D * 2);
constexpr size_t WS_HA = WS_MDN + al((size_t)NE * D * DFE * 2);
constexpr size_t WS_U = WS_HA + al((size_t)NTOK * D * 2);
constexpr size_t WS_CQN = WS_U + al((size_t)NTOK * UW * 2);
constexpr size_t WS_CKVN = WS_CQN + al((size_t)NTOK * 768 * 2);
constexpr size_t WS_KPE = WS_CKVN + al((size_t)NTOK * 512 * 2);
constexpr size_t WS_X0 = WS_KPE + al((size_t)NTOK * 64 * 2);
constexpr size_t WS_WTL = WS_X0 + al((size_t)NTOK * 512 * 2);
constexpr size_t WS_WTC = WS_WTL + al((size_t)NB * 512 * L * 2);
constexpr size_t WS_SQ = WS_WTC + al((size_t)NB * 512 * C * 2);
constexpr size_t WS_SK = WS_SQ + al((size_t)NTOK * 512 * 2);
constexpr size_t WS_SV = WS_SK + al((size_t)NTOK * 128 * 2);
constexpr size_t WS_Q = WS_SV + al((size_t)NTOK * 128 * 2);
constexpr size_t WS_KV = WS_Q + al((size_t)NTOK * QW * 2);
constexpr size_t WS_KN = WS_KV;
constexpr size_t WS_VT = WS_KV + (size_t)NTOK * 1024 * 2;
constexpr size_t WS_MIX = WS_KV + al((size_t)NTOK * KVW * 2);
constexpr size_t WS_MIXEND = WS_MIX + al((size_t)NTOK * D * 2);
constexpr size_t WS_YS = WS_U;
static_assert(WS_YS + (size_t)MOE_ROWS * D * 4 <= WS_MIXEND, "ys overlay");
constexpr size_t WS_XS = WS_MIXEND;
constexpr size_t WS_ACT = WS_XS + al((size_t)NTOK * D * 4);
constexpr size_t WS_HBS = WS_ACT + al((size_t)MOE_ROWS * DFE * 2);
constexpr size_t WS_TOPI = WS_HBS + al((size_t)MOE_ROWS * D * 2);
constexpr size_t WS_TOPW = WS_TOPI + al((size_t)NLAT * 2 * 4);
constexpr size_t WS_POS = WS_TOPW + al((size_t)NLAT * 2 * 4);
constexpr size_t WS_SRC = WS_POS + al((size_t)NLAT * 2 * 4);
constexpr size_t WS_SLAB = WS_SRC + al((size_t)MOE_ROWS * 4);
constexpr size_t WS_YT = WS_SLAB + ((size_t)64 << 20);
constexpr size_t WS_RSC = WS_YT + al((size_t)NB * 512 * (L + C) * 2);
constexpr size_t WS_END = WS_RSC + al((size_t)NTOK * 4);
constexpr int CT_EOFF = 1024, CT_EPAD = 1040, CT_NTILE = 1056, CT_MOES = 1057, CT_TROW = 1058, CT_WSC = 1088, CT_AMAXDONE = 1100;
constexpr int CW_BAR = 4096;

constexpr int RING_BYTES = 131072, LDS_BYTES = 147456, LDSCTL_OFF = LDS_BYTES - 256;

namespace pg8 {
#define PG8_LAS __attribute__((address_space(3)))
typedef unsigned short bf16_t;
typedef short bf16x8 __attribute__((ext_vector_type(8)));
typedef float f32x4 __attribute__((ext_vector_type(4)));
typedef unsigned u32x4 __attribute__((ext_vector_type(4)));
constexpr int BM = 256, BK = 64, HALF = 128, HTB = HALF * BK * 2  , STAGE_BYTES = 8 * HTB, NXCD = 8, WGM = 8;

__host__ __device__ __forceinline__ int lds_byte(int r, int c) { const int st = (r >> 4) * 2 + (c >> 5), rr = r & 15, cc = c & 31, ob = rr * 64 + cc * 2; return st * 1024 + (ob ^ (((ob >> 9) & 1) << 5)); }
__host__ __device__ __forceinline__ void stage_rc(int b, int& R, int& C) { const int st = b / 1024, sb = b % 1024, swz = sb ^ (((sb >> 9) & 1) << 5); R = (st >> 1) * 16 + swz / 64; C = (st & 1) * 32 + (swz % 64) / 2; }
__host__ __device__ __forceinline__ int perm32(int rho) { const int n = rho >> 4, i = rho & 15; return 8 * (i >> 2) + 4 * n + (i & 3); }

struct Unit { int pm, pn, kt0, nkt, slab; };
struct Gemm { const bf16_t* A; const bf16_t* Bt; int M, N, K; };

struct StaticOrder {
    int nM, nN, nwg, G, c;
    int nkt;
    __host__ __device__ void init(int M, int N, int G_, int c_, int K) { nM = M / BM; nN = N / BM; nwg = nM * nN; G = G_; c = c_; nkt = K / BK; }
    __host__ __device__ bool next(int i, Unit& u) const {
        const long L = (long)i * G + c; if (L >= nwg) return false;
        int wgid = (int)L; { const int q = nwg / NXCD, r = nwg % NXCD, xcd = wgid % NXCD, off = wgid / NXCD; wgid = (xcd < r ? xcd * (q + 1) : r * (q + 1) + (xcd - r) * q) + off; }
        const int nig = WGM * nN, gid = wgid / nig, fm = gid * WGM, gsz = (nM - fm) < WGM ? (nM - fm) : WGM;
        u.pm = fm + ((wgid % nig) % gsz); u.pn = (wgid % nig) / gsz; u.kt0 = 0; u.nkt = nkt; u.slab = -1; return true;
    }
    __device__ __forceinline__ size_t bt_off(const Unit&) const { return 0; }
    __device__ __forceinline__ void a_ready(const Unit&) const {}
    __device__ __forceinline__ void done(const Unit&) const {}
};

__device__ __forceinline__ unsigned cvt_pk_bf16(float lo, float hi) { unsigned r; asm volatile("v_cvt_pk_bf16_f32 %0, %1, %2" : "=v"(r) : "v"(lo), "v"(hi)); return r; }
typedef float f32x2 __attribute__((ext_vector_type(2)));
typedef int v8i_t __attribute__((ext_vector_type(8))); typedef int v4i_t __attribute__((ext_vector_type(4)));
template <bool F8> struct Frag;
template <> struct Frag<false> { bf16x8 h[2]; __device__ __forceinline__ void set0(bf16x8 x) { h[0] = x; } __device__ __forceinline__ void set1(bf16x8 x) { h[1] = x; } };
template <> struct Frag<true> { v8i_t v; __device__ __forceinline__ void set0(bf16x8 x) { v.lo = __builtin_bit_cast(v4i_t, x); } __device__ __forceinline__ void set1(bf16x8 x) { v.hi = __builtin_bit_cast(v4i_t, x); } };
template <class Epi, class Sched, bool ALIGN_EPI = false, bool SP2 = false, int DT = 0>
__device__ __forceinline__ void gemm_phase(PG8_LAS unsigned char* lds, const Gemm g, const Sched& S, const Epi& E) {
    int tid_ = threadIdx.x; asm volatile("" : "+v"(tid_));
    const int tid = tid_, wid = __builtin_amdgcn_readfirstlane(tid >> 6), lane = tid & 63, wr = wid >> 2, wc = wid & 3, fr = lane & 15, fq = lane >> 4;
    const int K = g.K;
    unsigned voffA[2], voffB[2];
#pragma unroll
    for (int i = 0; i < 2; ++i) { int R, C; stage_rc(tid * 16 + i * 8192, R, C); const int Rb = Epi::PERM ? ((R & ~31) + perm32(R & 31)) : R;
        voffA[i] = (unsigned)(R * K + C) * 2u; voffB[i] = (unsigned)(Rb * K + C) * 2u; }
    const size_t kstep = (size_t)(BK * 2);
    const size_t hstep = (size_t)HALF * K * 2;
    const size_t tstep = 2 * hstep;
    const unsigned ldsw = (unsigned)wid * 1024u;
    const int aoff = lds_byte(wr * 64 + fr, fq * 8), boff = lds_byte(wc * 32 + fr, fq * 8);
#define PG8_SA(b, h) (((b) * 2 + (h)) * HTB)
#define PG8_SB(b, h) ((4 + (b) * 2 + (h)) * HTB)
#define PG8_STAGE(bufoff, gbase, voff) do { _Pragma("unroll") for (int _i = 0; _i < 2; ++_i) \
        __builtin_amdgcn_global_load_lds((const unsigned*)((const char*)(gbase) + (voff)[_i]), (PG8_LAS unsigned*)(lds + (bufoff) + ldsw + _i * 8192), 16, 0, 0); } while (0)
#define PG8_LDA(dst, b, h) do { _Pragma("unroll") for (int m = 0; m < 4; ++m) { dst[m].set0(*(const PG8_LAS bf16x8*)(lds + PG8_SA(b, h) + aoff + m * 2048)); dst[m].set1(*(const PG8_LAS bf16x8*)(lds + PG8_SA(b, h) + aoff + m * 2048 + 1024)); } } while (0)
#define PG8_LDB(dst, b, h) do { _Pragma("unroll") for (int n = 0; n < 2; ++n) { dst[n].set0(*(const PG8_LAS bf16x8*)(lds + PG8_SB(b, h) + boff + n * 2048)); dst[n].set1(*(const PG8_LAS bf16x8*)(lds + PG8_SB(b, h) + boff + n * 2048 + 1024)); } } while (0)
#define PG8_MMA(ai, bj, At, Bt) do { __builtin_amdgcn_s_setprio(1); _Pragma("unroll") for (int m = 0; m < 4; ++m) _Pragma("unroll") for (int n = 0; n < 2; ++n) { \
        if constexpr (DT == 1) asm volatile("v_mfma_f32_16x16x128_f8f6f4 %0, %1, %2, %0" : "+v"(acc[ai][bj][m][n]) : "v"(Bt[n].v), "v"(At[m].v));   \
        else if constexpr (DT == 2) { _Pragma("unroll") for (int k = 0; k < 2; ++k) acc[ai][bj][m][n] = __builtin_bit_cast(f32x4, __builtin_amdgcn_mfma_i32_16x16x64_i8(__builtin_bit_cast(v4i_t, Bt[n].h[k]), __builtin_bit_cast(v4i_t, At[m].h[k]), __builtin_bit_cast(v4i_t, acc[ai][bj][m][n]), 0, 0, 0)); } \
        else { _Pragma("unroll") for (int k = 0; k < 2; ++k) acc[ai][bj][m][n] = __builtin_amdgcn_mfma_f32_16x16x32_bf16(Bt[n].h[k], At[m].h[k], acc[ai][bj][m][n], 0, 0, 0); } } \
        __builtin_amdgcn_s_setprio(0); } while (0)
#define PG8_WAIT_V(n) asm volatile("s_waitcnt vmcnt(" #n ")" ::: "memory")
#define PG8_WAIT_L(n) asm volatile("s_waitcnt lgkmcnt(" #n ")" ::: "memory")
#define PG8_BAR __builtin_amdgcn_s_barrier()
#define PG8_SCHED __builtin_amdgcn_sched_barrier(0)
    Unit cur, nxt; int ui = 0;
    if (!S.next(0, cur)) return;
    f32x4 acc[2][2][4][2];
#pragma unroll
    for (int a = 0; a < 2; ++a)
#pragma unroll
        for (int b = 0; b < 2; ++b)
#pragma unroll
            for (int m = 0; m < 4; ++m)
#pragma unroll
                for (int n = 0; n < 2; ++n) acc[a][b][m][n] = (f32x4){0.f, 0.f, 0.f, 0.f};
    Frag<DT == 1> At[4], B0[2], B1[2];
    const char* cA = (const char*)g.A + (size_t)cur.pm * tstep + (size_t)cur.kt0 * kstep; const char* cB = (const char*)g.Bt + S.bt_off(cur) + (size_t)cur.pn * tstep + (size_t)cur.kt0 * kstep;
    S.a_ready(cur);
    if constexpr (SP2) {
        PG8_STAGE(PG8_SB(0, 0), cB, voffB); PG8_STAGE(PG8_SB(0, 1), cB + hstep, voffB); PG8_STAGE(PG8_SA(0, 0), cA, voffA); PG8_STAGE(PG8_SA(0, 1), cA + hstep, voffA);
        if (wr == 1) PG8_BAR;
        PG8_WAIT_V(2); PG8_BAR;
        PG8_STAGE(PG8_SB(1, 0), cB + kstep, voffB); PG8_STAGE(PG8_SA(1, 0), cA + kstep, voffA); PG8_STAGE(PG8_SB(1, 1), cB + hstep + kstep, voffB);
        PG8_WAIT_V(6); PG8_BAR;
    } else {
        PG8_STAGE(PG8_SB(0, 0), cB, voffB); PG8_STAGE(PG8_SA(0, 0), cA, voffA); PG8_STAGE(PG8_SB(0, 1), cB + hstep, voffB); PG8_STAGE(PG8_SA(0, 1), cA + hstep, voffA);
        if (wr == 1) PG8_BAR;
        PG8_WAIT_V(4); PG8_BAR;
        PG8_STAGE(PG8_SB(1, 0), cB + kstep, voffB); PG8_STAGE(PG8_SA(1, 0), cA + kstep, voffA); PG8_STAGE(PG8_SB(1, 1), cB + hstep + kstep, voffB);
        PG8_WAIT_V(6); PG8_BAR;
    }
    for (;;) {
        const bool has_next = S.next(ui + 1, nxt);
        const char* nA = has_next ? (const char*)g.A + (size_t)nxt.pm * tstep + (size_t)nxt.kt0 * kstep : cA; const char* nB = has_next ? (const char*)g.Bt + S.bt_off(nxt) + (size_t)nxt.pn * tstep + (size_t)nxt.kt0 * kstep : cB;
        const int nt = cur.nkt;
        for (int t = 0; t < nt; t += 2) {
            const bool last = (t == nt - 2);
            const char* a1 = cA + (size_t)(t + 1) * kstep;
            const char* a2 = last ? nA : cA + (size_t)(t + 2) * kstep; const char* b2 = last ? nB : cB + (size_t)(t + 2) * kstep;
            const char* a3 = a2 + kstep; const char* b3 = b2 + kstep;
            if (last && has_next) S.a_ready(nxt);
            if constexpr (SP2) {
            PG8_LDB(B0, 0, 0); PG8_LDB(B1, 0, 1); PG8_SCHED; PG8_LDA(At, 0, 0); PG8_STAGE(PG8_SA(1, 1), a1 + hstep, voffA);
            PG8_WAIT_V(8); PG8_WAIT_L(0); PG8_BAR; PG8_MMA(0, 0, At, B0); PG8_MMA(0, 1, At, B1); PG8_BAR; PG8_SCHED;
            PG8_LDA(At, 0, 1); PG8_STAGE(PG8_SB(0, 0), b2, voffB); PG8_STAGE(PG8_SB(0, 1), b2 + hstep, voffB); PG8_STAGE(PG8_SA(0, 0), a2, voffA);
            PG8_WAIT_V(8); PG8_WAIT_L(0); PG8_BAR; PG8_MMA(1, 0, At, B0); PG8_MMA(1, 1, At, B1); PG8_BAR; PG8_SCHED;
            PG8_LDB(B0, 1, 0); PG8_LDB(B1, 1, 1); PG8_SCHED; PG8_LDA(At, 1, 0); PG8_STAGE(PG8_SA(0, 1), a2 + hstep, voffA);
            PG8_WAIT_V(8); PG8_WAIT_L(0); PG8_BAR; PG8_MMA(0, 0, At, B0); PG8_MMA(0, 1, At, B1); PG8_BAR; PG8_SCHED;
            PG8_LDA(At, 1, 1); PG8_STAGE(PG8_SB(1, 0), b3, voffB); PG8_STAGE(PG8_SB(1, 1), b3 + hstep, voffB); PG8_STAGE(PG8_SA(1, 0), a3, voffA);
            PG8_WAIT_V(8); PG8_WAIT_L(0); PG8_BAR; PG8_MMA(1, 0, At, B0); PG8_MMA(1, 1, At, B1); PG8_BAR; PG8_SCHED;
            } else {
            PG8_LDB(B0, 0, 0); PG8_SCHED; PG8_LDA(At, 0, 0); PG8_STAGE(PG8_SA(1, 1), a1 + hstep, voffA);
            PG8_WAIT_L(8); PG8_BAR; PG8_WAIT_L(0); PG8_MMA(0, 0, At, B0); PG8_BAR; PG8_SCHED;
            PG8_LDB(B1, 0, 1); PG8_STAGE(PG8_SB(0, 0), b2, voffB);
            PG8_BAR; PG8_WAIT_L(0); PG8_MMA(0, 1, At, B1); PG8_BAR;
            PG8_LDA(At, 0, 1); PG8_STAGE(PG8_SA(0, 0), a2, voffA);
            PG8_BAR; PG8_WAIT_L(0); PG8_MMA(1, 0, At, B0); PG8_BAR; PG8_SCHED;
            PG8_STAGE(PG8_SB(0, 1), b2 + hstep, voffB);
            PG8_WAIT_V(6); PG8_BAR; PG8_MMA(1, 1, At, B1); PG8_BAR;
            PG8_LDB(B0, 1, 0); PG8_SCHED; PG8_LDA(At, 1, 0); PG8_STAGE(PG8_SA(0, 1), a2 + hstep, voffA);
            PG8_WAIT_L(8); PG8_BAR; PG8_WAIT_L(0); PG8_MMA(0, 0, At, B0); PG8_BAR; PG8_SCHED;
            PG8_LDB(B1, 1, 1); PG8_STAGE(PG8_SB(1, 0), b3, voffB);
            PG8_BAR; PG8_WAIT_L(0); PG8_MMA(0, 1, At, B1); PG8_BAR;
            PG8_LDA(At, 1, 1); PG8_STAGE(PG8_SA(1, 0), a3, voffA);
            PG8_BAR; PG8_WAIT_L(0); PG8_MMA(1, 0, At, B0); PG8_BAR; PG8_SCHED;
            PG8_STAGE(PG8_SB(1, 1), b3 + hstep, voffB);
            PG8_WAIT_V(6); PG8_BAR; PG8_MMA(1, 1, At, B1); PG8_BAR;
            }
        }
        if constexpr (ALIGN_EPI) { if (wr == 0) PG8_BAR; }
        if constexpr (DT == 1) asm volatile("s_nop 15\n\ts_nop 15" ::: "memory");
        if constexpr (!Epi::AFTER_DRAIN) { E(acc, cur, wr, wc, fr, fq); S.done(cur); }
        if (!has_next) break;
#pragma unroll
        for (int a = 0; a < 2; ++a)
#pragma unroll
            for (int b = 0; b < 2; ++b)
#pragma unroll
                for (int m = 0; m < 4; ++m)
#pragma unroll
                    for (int n = 0; n < 2; ++n) acc[a][b][m][n] = (f32x4){0.f, 0.f, 0.f, 0.f};
        cur = nxt; cA = nA; cB = nB; ++ui;
        if constexpr (ALIGN_EPI) { if (wr == 1) PG8_BAR; }
    }
    PG8_WAIT_V(0);
    if constexpr (!ALIGN_EPI) { if (wr == 0) PG8_BAR; }
    PG8_BAR;
    if constexpr (Epi::AFTER_DRAIN) { E.fused(acc, cur, wr, wc, fr, fq, lds, wid, lane); S.done(cur); }
#undef PG8_SA
#undef PG8_SB
#undef PG8_STAGE
#undef PG8_LDA
#undef PG8_LDB
#undef PG8_MMA
#undef PG8_WAIT_V
#undef PG8_WAIT_L
#undef PG8_BAR
#undef PG8_SCHED
}
}

namespace pg8 {
__device__ __forceinline__ u32x4 pack8(const f32x4 v0, const f32x4 v1) { u32x4 w; w.x = cvt_pk_bf16(v0[0], v0[1]); w.y = cvt_pk_bf16(v0[2], v0[3]); w.z = cvt_pk_bf16(v1[0], v1[1]); w.w = cvt_pk_bf16(v1[2], v1[3]); return w; }
struct EpiStore {
    static constexpr bool PERM = true, AFTER_DRAIN = false;
    bf16_t* O; int ldc;
    __device__ __forceinline__ void operator()(const f32x4 (&acc)[2][2][4][2], const Unit& u, int wr, int wc, int fr, int fq) const {
        const int row0 = u.pm * BM + wr * 64 + fr, col0 = u.pn * BM + wc * 32 + 8 * fq;
#pragma unroll
        for (int ai = 0; ai < 2; ++ai)
#pragma unroll
            for (int m = 0; m < 4; ++m) { bf16_t* rowp = O + (size_t)(row0 + ai * HALF + m * 16) * ldc + col0;
#pragma unroll
                for (int bj = 0; bj < 2; ++bj) *(u32x4*)(rowp + bj * HALF) = pack8(acc[ai][bj][m][0], acc[ai][bj][m][1]); }
    }
};
struct EpiQ {
    static constexpr bool PERM = true, AFTER_DRAIN = false;
    bf16_t* O; const float* cosT; const float* sinT;
    __device__ __forceinline__ void operator()(const f32x4 (&acc)[2][2][4][2], const Unit& u, int wr, int wc, int fr, int fq) const {
        const int row0 = u.pm * BM + wr * 64 + fr, col0 = u.pn * BM + wc * 32 + 8 * fq;
#pragma unroll
        for (int ai = 0; ai < 2; ++ai)
#pragma unroll
            for (int m = 0; m < 4; ++m) { const int row = row0 + ai * HALF + m * 16; const bool lat = row < 8192; const int t = row & 2047;
#pragma unroll
                for (int bj = 0; bj < 2; ++bj) { const int col = col0 + bj * HALF; const int jn = col - 192 * (col / 192);
                    f32x4 v0 = acc[ai][bj][m][0], v1 = acc[ai][bj][m][1];
                    if (jn >= 128 && lat) { const int i0 = (jn - 128) >> 1;
                        const f32x4 cs = *(const f32x4*)(cosT + t * 32 + i0), sn = *(const f32x4*)(sinT + t * 32 + i0);
                        f32x4 r0, r1;
                        r0[0] = v0[0] * cs[0] - v0[1] * sn[0]; r0[1] = v0[0] * sn[0] + v0[1] * cs[0];
                        r0[2] = v0[2] * cs[1] - v0[3] * sn[1]; r0[3] = v0[2] * sn[1] + v0[3] * cs[1];
                        r1[0] = v1[0] * cs[2] - v1[1] * sn[2]; r1[1] = v1[0] * sn[2] + v1[1] * cs[2];
                        r1[2] = v1[2] * cs[3] - v1[3] * sn[3]; r1[3] = v1[2] * sn[3] + v1[3] * cs[3];
                        v0 = r0; v1 = r1; }
                    *(u32x4*)(O + (size_t)row * 1536 + col) = pack8(v0, v1); } }
    }
};
struct EpiResid {
    static constexpr bool PERM = false, AFTER_DRAIN = false;
    float* xs; const float* rd_lat; const float* gate; float* slab; int tail_row0, tail_rows; float scale;
    __device__ __forceinline__ void operator()(const f32x4 (&acc)[2][2][4][2], const Unit& u, int wr, int wc, int fr, int fq) const {
        const int row0 = u.pm * BM + wr * 64 + fr, colb = u.pn * BM + wc * 32 + 4 * fq;
        if (u.slab >= 0) {
#pragma unroll
            for (int ai = 0; ai < 2; ++ai)
#pragma unroll
                for (int m = 0; m < 4; ++m) { float* sp = slab + ((size_t)u.slab * tail_rows + (row0 + ai * HALF + m * 16 - tail_row0)) * 2048;
#pragma unroll
                    for (int bj = 0; bj < 2; ++bj)
#pragma unroll
                        for (int n = 0; n < 2; ++n) *(f32x4*)(sp + colb + bj * HALF + n * 16) = acc[ai][bj][m][n] * scale; }
            return;
        }
#pragma unroll
        for (int ai = 0; ai < 2; ++ai)
#pragma unroll
            for (int m = 0; m < 4; ++m) { const int row = row0 + ai * HALF + m * 16; const float* gv = gate + (size_t)(row < 8192 ? (row >> 11) : 4) * 12288; float* xr = xs + (size_t)row * 2048; const float* rr = row < 8192 ? rd_lat + (size_t)row * 2048 : xr;
#pragma unroll
                for (int bj = 0; bj < 2; ++bj)
#pragma unroll
                    for (int n = 0; n < 2; ++n) { const int col = colb + bj * HALF + n * 16; f32x4 x = *(const f32x4*)(rr + col); const f32x4 g = *(const f32x4*)(gv + col);
                        x += (g * scale) * acc[ai][bj][m][n]; *(f32x4*)(xr + col) = x; }
                if (m & 1) asm volatile("" ::: "memory"); }
    }
};
__device__ __forceinline__ unsigned pack4_fp8(float a, float b, float c, float d) {
    a = __builtin_amdgcn_fmed3f(a, -448.f, 448.f); b = __builtin_amdgcn_fmed3f(b, -448.f, 448.f); c = __builtin_amdgcn_fmed3f(c, -448.f, 448.f); d = __builtin_amdgcn_fmed3f(d, -448.f, 448.f);
    unsigned w = 0; w = __builtin_amdgcn_cvt_pk_fp8_f32(a, b, w, false); w = __builtin_amdgcn_cvt_pk_fp8_f32(c, d, w, true); return w; }
struct EpiSwiGLU8 {
    static constexpr bool PERM = true, AFTER_DRAIN = false;
    unsigned char* O; int ldc; float s, oscale;
    __device__ __forceinline__ void operator()(const f32x4 (&acc)[2][2][4][2], const Unit& u, int wr, int wc, int fr, int fq) const {
        const int row0 = u.pm * BM + wr * 64 + fr, col0 = u.pn * HALF + wc * 32 + 8 * fq;
#pragma unroll
        for (int ai = 0; ai < 2; ++ai)
#pragma unroll
            for (int m = 0; m < 4; ++m) { f32x4 o0, o1;
#pragma unroll
                for (int j = 0; j < 4; ++j) { const float g0 = acc[ai][0][m][0][j] * s, g1 = acc[ai][0][m][1][j] * s;
                    o0[j] = g0 * __builtin_amdgcn_rcpf(1.0f + __expf(-g0)) * (acc[ai][1][m][0][j] * (s * oscale)); o1[j] = g1 * __builtin_amdgcn_rcpf(1.0f + __expf(-g1)) * (acc[ai][1][m][1][j] * (s * oscale)); }
                u32x2 w; w.x = pack4_fp8(o0[0], o0[1], o0[2], o0[3]); w.y = pack4_fp8(o1[0], o1[1], o1[2], o1[3]);
                *(u32x2*)(O + (size_t)(row0 + ai * HALF + m * 16) * ldc + col0) = w; }
    }
};
__device__ __forceinline__ f32x4 i2f4(const f32x4 bits) { const v4i_t iv = __builtin_bit_cast(v4i_t, bits); return (f32x4){(float)iv[0], (float)iv[1], (float)iv[2], (float)iv[3]}; }
struct EpiStoreI8 {
    static constexpr bool PERM = true, AFTER_DRAIN = false;
    bf16_t* O; int ldc; const float* rsc; float sw;
    __device__ __forceinline__ void operator()(const f32x4 (&acc)[2][2][4][2], const Unit& u, int wr, int wc, int fr, int fq) const {
        const int row0 = u.pm * BM + wr * 64 + fr, col0 = u.pn * BM + wc * 32 + 8 * fq;
#pragma unroll
        for (int ai = 0; ai < 2; ++ai)
#pragma unroll
            for (int m = 0; m < 4; ++m) { const int row = row0 + ai * HALF + m * 16; const float sc = rsc[row] * sw; bf16_t* rowp = O + (size_t)row * ldc + col0;
#pragma unroll
                for (int bj = 0; bj < 2; ++bj) *(u32x4*)(rowp + bj * HALF) = pack8(i2f4(acc[ai][bj][m][0]) * sc, i2f4(acc[ai][bj][m][1]) * sc); }
    }
};
struct EpiSwiGLUI8 {
    static constexpr bool PERM = true, AFTER_DRAIN = false;
    unsigned char* O; int ldc; const float* rsc; float swg, swu, oscale;
    __device__ __forceinline__ void operator()(const f32x4 (&acc)[2][2][4][2], const Unit& u, int wr, int wc, int fr, int fq) const {
        const int row0 = u.pm * BM + wr * 64 + fr, col0 = u.pn * HALF + wc * 32 + 8 * fq;
#pragma unroll
        for (int ai = 0; ai < 2; ++ai)
#pragma unroll
            for (int m = 0; m < 4; ++m) { const int row = row0 + ai * HALF + m * 16; const float sa = rsc[row], sg = sa * swg, su = sa * swu * oscale; f32x4 o0, o1;
                const f32x4 g0v = i2f4(acc[ai][0][m][0]) * sg, g1v = i2f4(acc[ai][0][m][1]) * sg, u0v = i2f4(acc[ai][1][m][0]) * su, u1v = i2f4(acc[ai][1][m][1]) * su;
#pragma unroll
                for (int j = 0; j < 4; ++j) { o0[j] = g0v[j] * __builtin_amdgcn_rcpf(1.0f + __expf(-g0v[j])) * u0v[j]; o1[j] = g1v[j] * __builtin_amdgcn_rcpf(1.0f + __expf(-g1v[j])) * u1v[j]; }
                u32x2 w; w.x = pack4_fp8(o0[0], o0[1], o0[2], o0[3]); w.y = pack4_fp8(o1[0], o1[1], o1[2], o1[3]);
                *(u32x2*)(O + (size_t)row * ldc + col0) = w; }
    }
};
struct EpiSwiGLU {
    static constexpr bool PERM = true, AFTER_DRAIN = false;
    bf16_t* O; int ldc;
    __device__ __forceinline__ void operator()(const f32x4 (&acc)[2][2][4][2], const Unit& u, int wr, int wc, int fr, int fq) const {
        const int row0 = u.pm * BM + wr * 64 + fr, col0 = u.pn * HALF + wc * 32 + 8 * fq;
#pragma unroll
        for (int ai = 0; ai < 2; ++ai)
#pragma unroll
            for (int m = 0; m < 4; ++m) { f32x4 o0, o1;
#pragma unroll
                for (int j = 0; j < 4; ++j) { const float g0 = acc[ai][0][m][0][j], g1 = acc[ai][0][m][1][j];
                    o0[j] = g0 / (1.0f + __expf(-g0)) * acc[ai][1][m][0][j]; o1[j] = g1 / (1.0f + __expf(-g1)) * acc[ai][1][m][1][j]; }
                *(u32x4*)(O + (size_t)(row0 + ai * HALF + m * 16) * ldc + col0) = pack8(o0, o1); }
    }
};
struct EpiF32 {
    static constexpr bool PERM = false, AFTER_DRAIN = false;
    float* O; int ldc; float* slab; int tail_row0, tail_rows; float scale;
    __device__ __forceinline__ void operator()(const f32x4 (&acc)[2][2][4][2], const Unit& u, int wr, int wc, int fr, int fq) const {
        const int row0 = u.pm * BM + wr * 64 + fr, colb = u.pn * BM + wc * 32 + 4 * fq;
#pragma unroll
        for (int ai = 0; ai < 2; ++ai)
#pragma unroll
            for (int m = 0; m < 4; ++m) { float* xr = (u.slab >= 0) ? slab + ((size_t)u.slab * tail_rows + (row0 + ai * HALF + m * 16 - tail_row0)) * 2048 : O + (size_t)(row0 + ai * HALF + m * 16) * ldc;
#pragma unroll
                for (int bj = 0; bj < 2; ++bj)
#pragma unroll
                    for (int n = 0; n < 2; ++n) *(f32x4*)(xr + colb + bj * HALF + n * 16) = acc[ai][bj][m][n] * scale; }
    }
};
struct EpiYs {
    static constexpr bool PERM = false, AFTER_DRAIN = false;
    bf16_t* O; float* slab; int tail_row0, tail_rows; float scale;
    __device__ __forceinline__ void operator()(const f32x4 (&acc)[2][2][4][2], const Unit& u, int wr, int wc, int fr, int fq) const {
        const int row0 = u.pm * BM + wr * 64 + fr, colb = u.pn * BM + wc * 32 + 4 * fq;
        if (u.slab >= 0) {
#pragma unroll
            for (int ai = 0; ai < 2; ++ai)
#pragma unroll
                for (int m = 0; m < 4; ++m) { float* sp = slab + ((size_t)u.slab * tail_rows + (row0 + ai * HALF + m * 16 - tail_row0)) * 2048;
#pragma unroll
                    for (int bj = 0; bj < 2; ++bj)
#pragma unroll
                        for (int n = 0; n < 2; ++n) *(f32x4*)(sp + colb + bj * HALF + n * 16) = acc[ai][bj][m][n] * scale; }
            return;
        }
#pragma unroll
        for (int ai = 0; ai < 2; ++ai)
#pragma unroll
            for (int m = 0; m < 4; ++m) { bf16_t* xr = O + (size_t)(row0 + ai * HALF + m * 16) * 2048;
#pragma unroll
                for (int bj = 0; bj < 2; ++bj)
#pragma unroll
                    for (int n = 0; n < 2; ++n) { const f32x4 v = acc[ai][bj][m][n] * scale; u32x2 w; w.x = cvt_pk_bf16(v[0], v[1]); w.y = cvt_pk_bf16(v[2], v[3]); *(u32x2*)(xr + colb + bj * HALF + n * 16) = w; } }
    }
};
struct MoeOrder {
    int nM, nN, nwg, G, c, nkt; int t1[8]; size_t estride;
    __device__ __forceinline__ void init(const int* ctl, int nN_, int G_, int c_, size_t estride_, int K) { nkt = K / BK;
        int acc = 0;
#pragma unroll
        for (int e = 0; e < 8; ++e) { acc += __builtin_amdgcn_readfirstlane(ctl[CT_EPAD + e]) >> 8; t1[e] = acc; }
        nM = acc; nN = nN_; nwg = nM * nN; G = G_; c = c_; estride = estride_;
    }
    __device__ __forceinline__ bool next(int i, Unit& u) const {
        const long L = (long)i * G + c; if (L >= nwg) return false;
        int wgid = (int)L; { const int q = nwg / NXCD, r = nwg % NXCD, xcd = wgid % NXCD, off = wgid / NXCD; wgid = (xcd < r ? xcd * (q + 1) : r * (q + 1) + (xcd - r) * q) + off; }
        const int nig = WGM * nN, gid = wgid / nig, fm = gid * WGM, gsz = (nM - fm) < WGM ? (nM - fm) : WGM;
        u.pm = fm + ((wgid % nig) % gsz); u.pn = (wgid % nig) / gsz; u.kt0 = 0; u.nkt = nkt; u.slab = -1; return true;
    }
    __device__ __forceinline__ size_t bt_off(const Unit& u) const { int e = 0;
#pragma unroll
        for (int k = 0; k < 7; ++k) e += (u.pm >= t1[k]) ? 1 : 0;
        return (size_t)e * estride; }
    __device__ __forceinline__ void a_ready(const Unit&) const {}
    __device__ __forceinline__ void done(const Unit&) const {}
};
struct WinLastOrder {
    StaticOrder so; int G, c;
    __device__ __forceinline__ void init(int G_, int c_, int K) { so.init(NLAT, UW, G_, c_, K); G = G_; c = c_; }
    __device__ __forceinline__ bool next(int i, Unit& u) const {
        if (so.next(i, u)) return true;
        const long L = (long)i * G + c - so.nwg; if (L < 0 || L >= 20) return false;
        const int j = (int)L, k = j % 5; u.pm = 32 + j / 5; u.pn = k < 3 ? 3 + k : 10 + k; u.kt0 = 0; u.nkt = so.nkt; u.slab = -1; return true;
    }
    __device__ __forceinline__ size_t bt_off(const Unit&) const { return 0; }
    __device__ __forceinline__ void a_ready(const Unit&) const {}
    __device__ __forceinline__ void done(const Unit&) const {}
};
struct SplitOrder {
    int nM, nN, nwg, G, c, nfull, ntail, S, nkt, nkts; int t1[8]; size_t estride;
    __device__ __forceinline__ void init(int nM_, int nN_, int G_, int c_, int K, int S_) {
        nM = nM_; nN = nN_; nwg = nM * nN; G = G_; c = c_; nkt = K / BK; nfull = (nwg / 256) * 256; ntail = nwg - nfull; S = S_; nkts = nkt / S; estride = 0;
#pragma unroll
        for (int e = 0; e < 8; ++e) t1[e] = 0;
    }
    __device__ __forceinline__ void init_moe(const int* ctl, int nN_, int G_, int c_, int K, size_t estride_) {
        int acc = 0;
#pragma unroll
        for (int e = 0; e < 8; ++e) { acc += __builtin_amdgcn_readfirstlane(ctl[CT_EPAD + e]) >> 8; t1[e] = acc; }
        init(acc, nN_, G_, c_, K, __builtin_amdgcn_readfirstlane(ctl[CT_MOES])); estride = estride_;
        acc = 0;
#pragma unroll
        for (int e = 0; e < 8; ++e) { acc += __builtin_amdgcn_readfirstlane(ctl[CT_EPAD + e]) >> 8; t1[e] = acc; }
    }
    __device__ __forceinline__ bool next(int i, Unit& u) const {
        const long L = (long)i * G + c; int wgid;
        if (L < nfull) { wgid = (int)L; { const int q = nfull / NXCD, xcd = wgid % NXCD, off = wgid / NXCD; wgid = xcd * q + off; } u.kt0 = 0; u.nkt = nkt; u.slab = -1; }
        else { const int j = (int)(L - nfull); if (j >= ntail * S) return false; const int tu = j / S, sl = j - tu * S; wgid = nfull + tu; u.kt0 = sl * nkts; u.nkt = nkts; u.slab = (S > 1) ? sl : -1; }
        const int nig = WGM * nN, gid = wgid / nig, fm = gid * WGM, gsz = (nM - fm) < WGM ? (nM - fm) : WGM;
        u.pm = fm + ((wgid % nig) % gsz); u.pn = (wgid % nig) / gsz; return true;
    }
    __device__ __forceinline__ size_t bt_off(const Unit& u) const { if (estride == 0) return 0; int e = 0;
#pragma unroll
        for (int k = 0; k < 7; ++k) e += (u.pm >= t1[k]) ? 1 : 0;
        return (size_t)e * estride; }
    __device__ __forceinline__ void a_ready(const Unit&) const {}
    __device__ __forceinline__ void done(const Unit&) const {}
};
__host__ __device__ constexpr int split_S(int nwg, int nkt, int G) {
    const int ntail = nwg - (nwg / G) * G;
    if (ntail == 0) return 1;
    if (nkt % 28 == 0 && ntail * 14 <= G) return 14;
    if (nkt % 16 == 0 && ntail * 8 <= G) return 8;
    if (nkt % 14 == 0 && ntail * 7 <= G) return 7;
    if (nkt % 8 == 0 && ntail * 4 <= G) return 4;
    if (nkt % 4 == 0 && ntail * 2 <= G) return 2;
    return 1;
}
}

#define LAS __attribute__((address_space(3)))
#define XB_TMO      128
#define XB_XCNT(j)  (256  + 64 * (j))
#define XB_XSUB(j)  (1280 + 64 * (j))
#define XB_XGEN(j)  (2304 + 64 * (j))
#define XB_TOP      3328
#define XB_TOPGEN   3392
#define XCD_BAR_WORDS 3456
#define XB_SPIN_CAP (1u << 18)

__device__ __forceinline__ unsigned xb_ld(unsigned* p)              { return __hip_atomic_load(p, __ATOMIC_RELAXED, __HIP_MEMORY_SCOPE_AGENT); }
__device__ __forceinline__ unsigned xb_add(unsigned* p, unsigned v) { return __hip_atomic_fetch_add(p, v, __ATOMIC_RELAXED, __HIP_MEMORY_SCOPE_AGENT); }
__device__ __forceinline__ unsigned xb_xcc_id() { return (unsigned)__builtin_amdgcn_s_getreg((3 << 11) | 20) & 0xFu; }
#define XB_SPIN(cond, bar) do { unsigned _sp = 0; while (cond) { __builtin_amdgcn_s_sleep(1); \
    if ((++_sp & 255u) == 0u) { if (xb_ld(&(bar)[XB_TMO])) break; if (_sp > XB_SPIN_CAP) { atomicAdd(&(bar)[XB_TMO], 1u); break; } } } } while (0)

struct XcdBarrier {
    unsigned* bar; unsigned x;
    volatile LAS unsigned* st;
};

__device__ __forceinline__ XcdBarrier xcd_barrier_post(unsigned* bar, volatile LAS unsigned* st) {
    XcdBarrier b; b.bar = bar; b.x = xb_xcc_id(); b.st = st;
    if (threadIdx.x == 0) (void)xb_add(&bar[XB_XCNT(b.x)], 1u);
    return b;
}
__device__ __forceinline__ void xcd_barrier_complete(unsigned* bar, unsigned x, unsigned& nloc, unsigned& nx) {
    const unsigned G = gridDim.x * gridDim.y * gridDim.z;
    unsigned sum, cnt, mine, sp = 0u;
    for (;;) {
        sum = 0u; cnt = 0u; mine = 0u;
#pragma unroll
        for (unsigned j = 0; j < 16; ++j) { const unsigned c = xb_ld(&bar[XB_XCNT(j)]); sum += c; cnt += (c > 0u) ? 1u : 0u; mine = (j == x) ? c : mine; }
        if (sum == G) break;
        __builtin_amdgcn_s_sleep(1);
        if ((++sp & 255u) == 0u) { if (xb_ld(&bar[XB_TMO])) break; if (sp > XB_SPIN_CAP) { atomicAdd(&bar[XB_TMO], 1u); break; } }
    }
    nloc = mine > 0u ? mine : 1u; nx = cnt > 0u ? cnt : 1u;
}

__device__ __forceinline__ void xcd_barrier(const XcdBarrier& b) {
    asm volatile("s_waitcnt vmcnt(0)" ::: "memory");
    __syncthreads();
    if (threadIdx.x == 0) {
        unsigned* bar = b.bar;
        __builtin_amdgcn_s_waitcnt(0);
        unsigned nloc = b.st[0], nx = b.st[1];
        if (nloc == 0u) { xcd_barrier_complete(bar, b.x, nloc, nx); b.st[0] = nloc; b.st[1] = nx; }
        const unsigned old = xb_add(&bar[XB_XSUB(b.x)], 1u);
        const unsigned gen = old / nloc;
        if (old + 1u == (gen + 1u) * nloc) {
            __builtin_amdgcn_fence(__ATOMIC_RELEASE, "agent");
            asm volatile("s_waitcnt vmcnt(0)" ::: "memory");
            const unsigned og = xb_add(&bar[XB_TOP], 1u);
            const unsigned tg = og / nx;
            if (og + 1u == (tg + 1u) * nx) xb_add(&bar[XB_TOPGEN], 1u);
            else XB_SPIN(xb_ld(&bar[XB_TOPGEN]) == tg, bar);
            __builtin_amdgcn_fence(__ATOMIC_ACQUIRE, "agent");
            xb_add(&bar[XB_XGEN(b.x)], 1u);
            asm volatile("s_waitcnt vmcnt(0)" ::: "memory");
        } else {
            XB_SPIN(xb_ld(&bar[XB_XGEN(b.x)]) == gen, bar);
            __builtin_amdgcn_fence(__ATOMIC_ACQUIRE, "agent");
            asm volatile("s_waitcnt vmcnt(0)" ::: "memory");
        }
    }
    __syncthreads();
}


struct Args { const float* in[34]; float* out; unsigned char* ws; int ph_lo, ph_hi; };

enum { MAP_ID = 0, MAP_ROPEQ = 1, MAP_GU0 = 2, MAP_GU1 = 3, MAP_KV = 4 };
struct JobDesc { int in_idx, K, N, nbatch, upb, map; long long src_off, src_bstride, dst_off, dst_bstride; int fp8, sidx; };
constexpr int NJOBS = 14, NCONV = 12664;
constexpr int TAIL1_BLK0 = 28, TAIL1_N = 228, TAIL2_BLK0 = 48, TAIL2_N = 208;
constexpr int TAIL3_BLK0 = 64, TAIL3_N = 192, TAIL4_BLK0 = 32, TAIL4_N = 224;
constexpr int NCONV_T1 = TAIL1_N * TAILQ1, NCONV_T2 = TAIL2_N * TAILQ2, NCONV_T3 = TAIL3_N * TAILQ3, NCONV_T4 = TAIL4_N * TAILQ4, NCONV_Q = NCONV - NCONV_T1 - NCONV_T2 - NCONV_T3 - NCONV_T4;
static_assert(NCONV_Q % 2 == 0 && TAILQ1 % 2 == 0 || true, "");
__constant__ JobDesc c_jobs[NJOBS] = {
    {8, 2048, 3648, 1, 232, MAP_ID, 0, 0, (long long)WS_WIN, 0, I8_WIN ? 2 : 0, 0},
    {8, 2048, 3648, 1, 232, MAP_ID, 2048LL * 3648, 0, (long long)(WS_WIN + (size_t)UW * D * 2), 0, I8_WIN ? 2 : 0, 1},
    {10, 768, 1536, 1, 36, MAP_ROPEQ, 0, 0, (long long)WS_WQ, 0},
    {10, 768, 1536, 1, 36, MAP_ROPEQ, 768LL * 1536, 0, (long long)(WS_WQ + (size_t)QW * 768 * 2), 0},
    {12, 512, 2048, 1, 32, MAP_KV, 0, 0, (long long)WS_WKV, 0},
    {12, 512, 2048, 1, 32, MAP_KV, 512LL * 2048, 0, (long long)(WS_WKV + (size_t)KVW * 512 * 2), 0},
    {25, 2048, 2048, 1, 128, MAP_ID, 0, 0, (long long)WS_WOUT, 0},
    {25, 2048, 2048, 1, 128, MAP_ID, 2048LL * 2048, 0, (long long)(WS_WOUT + (size_t)D * D * 2), 0},
    {26, 2048, 5632, 1, 352, MAP_GU0, 0, 0, (long long)WS_WGU, 0, I8_GU ? 2 : FP8_DENSE, 2},
    {27, 2048, 5632, 1, 352, MAP_GU1, 0, 0, (long long)WS_WGU, 0, I8_GU ? 2 : FP8_DENSE, 3},
    {28, 5632, 2048, 1, 352, MAP_ID, 0, 0, (long long)WS_WDN, 0, (FP8_DENSE || FP8_DOWN), 0},
    {30, 2048, 7168, 8, 448, MAP_GU0, 0, 2048LL * 7168, (long long)WS_MGU, 2LL * DFE * D, 1, 0},
    {31, 2048, 7168, 8, 448, MAP_GU1, 0, 2048LL * 7168, (long long)WS_MGU, 2LL * DFE * D, 1, 0},
    {32, 7168, 2048, 8, 448, MAP_ID, 0, 7168LL * 2048, (long long)WS_MDN, (long long)D * DFE, 1, 0},
};
struct ConvUnit { const float* src; bf16_t* dst; int K, N, map, k0, n0, fp8; float qs; };
__device__ __forceinline__ unsigned pack4_i8(float a, float b, float c, float d) {
    const int ia = (int)__builtin_rintf(__builtin_amdgcn_fmed3f(a, -127.f, 127.f)), ib = (int)__builtin_rintf(__builtin_amdgcn_fmed3f(b, -127.f, 127.f)), ic = (int)__builtin_rintf(__builtin_amdgcn_fmed3f(c, -127.f, 127.f)), id = (int)__builtin_rintf(__builtin_amdgcn_fmed3f(d, -127.f, 127.f));
    return (unsigned)(ia & 0xff) | ((unsigned)(ib & 0xff) << 8) | ((unsigned)(ic & 0xff) << 16) | ((unsigned)(id & 0xff) << 24); }
constexpr float WSCALE = 64.f, ASCALE = 8.f;
__device__ __forceinline__ void conv_decode(const Args& a, int u, ConvUnit& cu) {
    int j = 0, base = 0;
    for (;;) { const int n = c_jobs[j].nbatch * c_jobs[j].upb; if (u < base + n || j == NJOBS - 1) break; base += n; ++j; }
    const JobDesc& jd = c_jobs[j];
    int r = u - base; const int bt = r / jd.upb; r -= bt * jd.upb; const int ntn = (jd.N + 127) >> 7; int kt = r / ntn, nt = r - kt * ntn;
    if (((jd.K >> 8) & 1) == 0) { const int r2 = r >> 1; kt = 2 * (r2 / ntn) + (r & 1); nt = r2 % ntn; }
    cu.K = jd.K; cu.N = jd.N; cu.map = jd.map; cu.k0 = kt * 256; cu.n0 = nt * 128; cu.fp8 = jd.fp8; cu.qs = 1.0f;
    if (jd.fp8 == 2) { const float am = __uint_as_float(__hip_atomic_load((const unsigned*)(a.ws + WS_CTL) + CT_WSC + jd.sidx, __ATOMIC_RELAXED, __HIP_MEMORY_SCOPE_AGENT)); cu.qs = am > 0.f ? 127.0f / am : 0.f; }
    const float* sb = j < 2 ? a.in[8] : j < 4 ? a.in[10] : j < 6 ? a.in[12] : j < 8 ? a.in[25] : j == 8 ? a.in[26] : j == 9 ? a.in[27] : j == 10 ? a.in[28] : j == 11 ? a.in[30] : j == 12 ? a.in[31] : a.in[32];
    cu.src = sb + jd.src_off + (long long)bt * jd.src_bstride + (size_t)cu.k0 * jd.N + cu.n0;
    cu.dst = (bf16_t*)(a.ws + jd.dst_off + (long long)bt * jd.dst_bstride);
}
__device__ __forceinline__ int conv_row(int map, int n) {
    if (map == MAP_ID) return n;
    if (map == MAP_GU0) return ((n >> 7) << 8) + (n & 127);
    if (map == MAP_GU1) return ((n >> 7) << 8) + 128 + (n & 127);
    if (map == MAP_KV) { const int hh = n >> 8, jn = n & 255; return jn < 128 ? hh * 128 + jn : 1024 + hh * 128 + (jn - 128); }
    const int hh = n / 192, jn = n - hh * 192; if (jn < 128) return n; const int q = jn - 128; return hh * 192 + 128 + 2 * (q & 31) + (q >> 5);
}
constexpr int CV_P = 129;
#define CONV_LOAD(R, CU) do { const bool ok_ = (CU).n0 + (tid & 31) * 4 < (CU).N; _Pragma("unroll") for (int i_ = 0; i_ < 16; ++i_) { const int row_ = 2 * ((tid >> 5) + 16 * (i_ >> 1)) + (i_ & 1); \
        R[i_] = ok_ ? __builtin_nontemporal_load((const f32x4*)((CU).src + (size_t)row_ * (CU).N + (tid & 31) * 4)) : (f32x4){0.f, 0.f, 0.f, 0.f}; } } while (0)
#define CONV_PUT(R, T) do { _Pragma("unroll") for (int i_ = 0; i_ < 16; ++i_) { const int row_ = 2 * ((tid >> 5) + 16 * (i_ >> 1)) + (i_ & 1); float* tp_ = (T) + row_ * CV_P + (tid & 31) * 4; \
        tp_[0] = R[i_][0]; tp_[1] = R[i_][1]; tp_[2] = R[i_][2]; tp_[3] = R[i_][3]; } } while (0)
__device__ __forceinline__ void conv_out(const ConvUnit& cur, const float* tile, int tid) {
    if (cur.fp8 == 2) {
        const float qs = cur.qs;
#pragma unroll
        for (int j = 0; j < 4; ++j) { const int kc = (tid & 7) + 8 * (j & 1), n = (tid >> 3) + 64 * (j >> 1);
            if (cur.n0 + n < cur.N) { const int row = conv_row(cur.map, cur.n0 + n); const float* tp = tile + (kc * 16) * CV_P + n; u32x4 w;
                w.x = pack4_i8(tp[0] * qs, tp[CV_P] * qs, tp[2 * CV_P] * qs, tp[3 * CV_P] * qs); w.y = pack4_i8(tp[4 * CV_P] * qs, tp[5 * CV_P] * qs, tp[6 * CV_P] * qs, tp[7 * CV_P] * qs);
                w.z = pack4_i8(tp[8 * CV_P] * qs, tp[9 * CV_P] * qs, tp[10 * CV_P] * qs, tp[11 * CV_P] * qs); w.w = pack4_i8(tp[12 * CV_P] * qs, tp[13 * CV_P] * qs, tp[14 * CV_P] * qs, tp[15 * CV_P] * qs);
                *(u32x4*)((unsigned char*)cur.dst + (size_t)row * cur.K + cur.k0 + kc * 16) = w; } }
    } else if (cur.fp8) {
#pragma unroll
        for (int j = 0; j < 4; ++j) { const int kc = (tid & 7) + 8 * (j & 1), n = (tid >> 3) + 64 * (j >> 1);
            if (cur.n0 + n < cur.N) { const int row = conv_row(cur.map, cur.n0 + n); const float* tp = tile + (kc * 16) * CV_P + n; u32x4 w;
                w.x = pg8::pack4_fp8(tp[0] * WSCALE, tp[CV_P] * WSCALE, tp[2 * CV_P] * WSCALE, tp[3 * CV_P] * WSCALE); w.y = pg8::pack4_fp8(tp[4 * CV_P] * WSCALE, tp[5 * CV_P] * WSCALE, tp[6 * CV_P] * WSCALE, tp[7 * CV_P] * WSCALE);
                w.z = pg8::pack4_fp8(tp[8 * CV_P] * WSCALE, tp[9 * CV_P] * WSCALE, tp[10 * CV_P] * WSCALE, tp[11 * CV_P] * WSCALE); w.w = pg8::pack4_fp8(tp[12 * CV_P] * WSCALE, tp[13 * CV_P] * WSCALE, tp[14 * CV_P] * WSCALE, tp[15 * CV_P] * WSCALE);
                *(u32x4*)((unsigned char*)cur.dst + (size_t)row * cur.K + cur.k0 + kc * 16) = w; } }
    } else {
#pragma unroll
        for (int j = 0; j < 8; ++j) { const int kc = (tid & 7) + 8 * (j & 3), n = (tid >> 3) + 64 * (j >> 2);
            if (cur.n0 + n < cur.N) { const int row = conv_row(cur.map, cur.n0 + n); const float* tp = tile + (kc * 8) * CV_P + n; u32x4 w;
                w.x = pg8::cvt_pk_bf16(tp[0], tp[CV_P]); w.y = pg8::cvt_pk_bf16(tp[2 * CV_P], tp[3 * CV_P]); w.z = pg8::cvt_pk_bf16(tp[4 * CV_P], tp[5 * CV_P]); w.w = pg8::cvt_pk_bf16(tp[6 * CV_P], tp[7 * CV_P]);
                *(u32x4*)(cur.dst + (size_t)row * cur.K + cur.k0 + kc * 8) = w; } }
    }
}
template <int MODE = 0>
__device__ __forceinline__ void ph_convert(const Args& a, float* tile, int first, int stride, int end) {
    const int tid = threadIdx.x;
    int u = first; ConvUnit cuA, cuB; f32x4 rA[16], rB[16];
#pragma unroll
    for (int i = 0; i < 16; ++i) { rA[i] = (f32x4){0.f, 0.f, 0.f, 0.f}; rB[i] = rA[i]; }
    if (u < end) { conv_decode(a, u, cuA); if (MODE != 2) CONV_LOAD(rA, cuA); }
    if (u + stride < end) { conv_decode(a, u + stride, cuB); if (MODE != 2) CONV_LOAD(rB, cuB); }
    while (u < end) {
        CONV_PUT(rA, tile);
        __syncthreads();
        { const ConvUnit cur = cuA; const int un = u + 2 * stride; if (un < end) { conv_decode(a, un, cuA); if (MODE != 2) CONV_LOAD(rA, cuA); } if (MODE != 1) conv_out(cur, tile, tid); }
        __syncthreads();
        u += stride; if (u >= end) break;
        CONV_PUT(rB, tile);
        __syncthreads();
        { const ConvUnit cur = cuB; const int un = u + 2 * stride; if (un < end) { conv_decode(a, un, cuB); if (MODE != 2) CONV_LOAD(rB, cuB); } if (MODE != 1) conv_out(cur, tile, tid); }
        __syncthreads();
        u += stride;
    }
}
constexpr int CT_QNEXT = 1152;
template <int MODE = 0>
__device__ __forceinline__ void conv_dynamic(const Args& a, float* tile) {
    unsigned* qn = (unsigned*)(a.ws + WS_CTL) + CT_QNEXT; volatile int* bc = (volatile int*)(tile + 256 * CV_P + 4);
    const int tid = threadIdx.x;
    if (tid == 0) { bc[0] = (int)__hip_atomic_fetch_add(qn, 1u, __ATOMIC_RELAXED, __HIP_MEMORY_SCOPE_AGENT); bc[1] = (int)__hip_atomic_fetch_add(qn, 1u, __ATOMIC_RELAXED, __HIP_MEMORY_SCOPE_AGENT); }
    __syncthreads();
    int q = bc[0], qN = bc[1];
    __syncthreads();
    ConvUnit cuA, cuB; f32x4 rA[16], rB[16];
#pragma unroll
    for (int i = 0; i < 16; ++i) { rA[i] = (f32x4){0.f, 0.f, 0.f, 0.f}; rB[i] = rA[i]; }
    if (2 * q < NCONV_Q) { conv_decode(a, 2 * q, cuA); if (MODE != 2) CONV_LOAD(rA, cuA); }
    if (2 * q + 1 < NCONV_Q) { conv_decode(a, 2 * q + 1, cuB); if (MODE != 2) CONV_LOAD(rB, cuB); }
    while (2 * q < NCONV_Q) {
        const bool hasB = 2 * q + 1 < NCONV_Q;
        CONV_PUT(rA, tile);
        __syncthreads();
        { const ConvUnit cur = cuA; if (2 * qN < NCONV_Q) { conv_decode(a, 2 * qN, cuA); if (MODE != 2) CONV_LOAD(rA, cuA); }
          if (tid == 0) bc[0] = (int)__hip_atomic_fetch_add(qn, 1u, __ATOMIC_RELAXED, __HIP_MEMORY_SCOPE_AGENT);
          if (MODE != 1) conv_out(cur, tile, tid); }
        __syncthreads();
        if (hasB) {
            CONV_PUT(rB, tile);
            __syncthreads();
            { const ConvUnit cur = cuB; if (2 * qN + 1 < NCONV_Q) { conv_decode(a, 2 * qN + 1, cuB); if (MODE != 2) CONV_LOAD(rB, cuB); }
              if (MODE != 1) conv_out(cur, tile, tid); }
            __syncthreads();
        }
        q = qN; qN = bc[0];
    }
    __syncthreads();
}
#undef CONV_LOAD
#undef CONV_PUT
constexpr int CONV_STATIC = 856, CONV_DENSE_END = 1912, CONV_BATCH = 2;
__device__ __forceinline__ constexpr int CT_DONE(int k) { return 1216 + 64 * k; }
__device__ __forceinline__ void conv_fill(const Args& a, float* tile, int done_idx) {
#if !CONV_FILL
    (void)a; (void)tile; (void)done_idx; return;
#endif
    unsigned* ctl = (unsigned*)(a.ws + WS_CTL); volatile int* bc = (volatile int*)(tile + 256 * CV_P + 4);
    const int tid = threadIdx.x;
    if (tid == 0) (void)__hip_atomic_fetch_add(ctl + CT_DONE(done_idx), 1u, __ATOMIC_RELAXED, __HIP_MEMORY_SCOPE_AGENT);
    for (;;) {
        if (tid == 0) { int q = -1;
            if (__hip_atomic_load(ctl + CT_DONE(done_idx), __ATOMIC_RELAXED, __HIP_MEMORY_SCOPE_AGENT) < gridDim.x) {
                q = (int)__hip_atomic_fetch_add(ctl + CT_QNEXT, (unsigned)CONV_BATCH, __ATOMIC_RELAXED, __HIP_MEMORY_SCOPE_AGENT) + CONV_STATIC; if (q >= NCONV) q = -1; }
            *bc = q; }
        __syncthreads();
        const int q = *bc;
        __syncthreads();
        if (q < 0) break;
        ph_convert(a, tile, q, 1, (q + CONV_BATCH < NCONV) ? q + CONV_BATCH : NCONV);
    }
}
__device__ __forceinline__ void conv_finish(const Args& a, float* tile, int upto) {
#if !CONV_FILL
    (void)a; (void)tile; (void)upto; return;
#endif
    unsigned* ctl = (unsigned*)(a.ws + WS_CTL); volatile int* bc = (volatile int*)(tile + 256 * CV_P + 4);
    const int tid = threadIdx.x;
    for (;;) {
        if (tid == 0) { int q = -1;
            if ((int)__hip_atomic_load(ctl + CT_QNEXT, __ATOMIC_RELAXED, __HIP_MEMORY_SCOPE_AGENT) + CONV_STATIC < upto) {
                q = (int)__hip_atomic_fetch_add(ctl + CT_QNEXT, (unsigned)CONV_BATCH, __ATOMIC_RELAXED, __HIP_MEMORY_SCOPE_AGENT) + CONV_STATIC; if (q >= NCONV) q = -1; }
            *bc = q; }
        __syncthreads();
        const int q = *bc;
        __syncthreads();
        if (q < 0) break;
        ph_convert(a, tile, q, 1, (q + CONV_BATCH < NCONV) ? q + CONV_BATCH : NCONV);
    }
}
__device__ __forceinline__ void adaln_unit(const Args& a, int unit, float* sm) {
    const float* c = a.in[1]; const float* cctx = a.in[3]; const float* w_mod = a.in[4]; const float* b_mod = a.in[5]; float* mod = (float*)(a.ws + WS_MOD);
    const int tid = threadIdx.x, l = unit / 96, chunk = unit - l * 96;
    const int cg = tid & 31, ks = tid >> 5;
    for (int i = tid; i < 5 * 2048; i += 512) { const int v = i >> 11, k = i & 2047; const float val = v < 4 ? c[v * 2048 + k] : cctx[k]; sm[i] = val / (1.0f + __expf(-val)); }
    __syncthreads();
    float acc[5][4];
#pragma unroll
    for (int v = 0; v < 5; ++v)
#pragma unroll
        for (int j = 0; j < 4; ++j) acc[v][j] = 0.f;
    const float* wp = w_mod + ((size_t)l * 2048 + (size_t)ks * 128) * 12288 + chunk * 128 + cg * 4;
    for (int kb = 0; kb < 128; kb += 16) {
        f32x4 w[16];
#pragma unroll
        for (int kk = 0; kk < 16; ++kk) w[kk] = __builtin_nontemporal_load((const f32x4*)(wp + (size_t)(kb + kk) * 12288));
#pragma unroll
        for (int kk = 0; kk < 16; ++kk) { const int k = ks * 128 + kb + kk;
#pragma unroll
            for (int v = 0; v < 5; ++v) { const float s = sm[v * 2048 + k];
#pragma unroll
                for (int j = 0; j < 4; ++j) acc[v][j] += s * w[kk][j]; } }
    }
    __syncthreads();
#pragma unroll
    for (int v = 0; v < 5; ++v)
#pragma unroll
        for (int j = 0; j < 4; ++j) sm[(ks * 5 + v) * 128 + cg * 4 + j] = acc[v][j];
    __syncthreads();
    for (int o = tid; o < 640; o += 512) {
        const int v = o >> 7, cc = o & 127; float s = 0.f;
#pragma unroll
        for (int k2 = 0; k2 < 16; ++k2) s += sm[(k2 * 5 + v) * 128 + cc];
        mod[((size_t)l * 5 + v) * 12288 + chunk * 128 + cc] = s + b_mod[(size_t)l * 12288 + chunk * 128 + cc];
    }
    __syncthreads();
}
constexpr int FW_W1 = 0, FW_W2 = 2112, FW_W3 = 6208, FW_B1 = 10304, FW_B2 = 10368, FW_B3 = 10432, FW_FR = 10496, FW_ZS = 10560, FW_HA = 10848, FW_HB = 11360, FW_END = 11872;
__device__ __forceinline__ void filters_unit(const Args& a, int l, int r, float* sm) {
    float (*zs)[36] = (float (*)[36])(sm + FW_ZS); float (*ha)[64] = (float (*)[64])(sm + FW_HA); float (*hb)[64] = (float (*)[64])(sm + FW_HB);
    const int tid = threadIdx.x;
    const bool lat = r < 256; const int Lf = lat ? 2048 : 256; const int p0 = lat ? r * 8 : (r - 256) * 8;
    float* T = (float*)(a.ws + WS_FILTC) + (size_t)l * 512 * 512;
    const float* wf = a.in[21] + (size_t)l * 64 * 1024;
    const int p = tid >> 6, j = tid & 63; const int pos = p0 + p;
    const float tn = (float)pos / (float)(Lf - 1);
    if (j < 33) {
        float z;
        if (j == 0) z = tn;
        else { const int bi = (j - 1) & 15; const float band = 1e-4f + (float)bi * ((15.0f - 1e-4f) / 15.0f);
               const float ang = (6.283185307179586f / (float)Lf) * (float)pos * band; z = (j <= 16) ? __cosf(ang) : -__sinf(ang); }
        zs[p][j] = z;
    }
    __syncthreads();
    const float f = sm[FW_FR + j];
    { float s = sm[FW_B1 + j];
#pragma unroll
      for (int i = 0; i < 33; ++i) s += zs[p][i] * sm[FW_W1 + i * 64 + j];
      ha[p][j] = __sinf(f * s); }
    __syncthreads();
    { float s = sm[FW_B2 + j];
#pragma unroll 16
      for (int i = 0; i < 64; ++i) s += ha[p][i] * sm[FW_W2 + i * 64 + j];
      hb[p][j] = __sinf(f * s); }
    __syncthreads();
    { float s = sm[FW_B3 + j];
#pragma unroll 16
      for (int i = 0; i < 64; ++i) s += hb[p][i] * sm[FW_W3 + i * 64 + j];
      ha[p][j] = __sinf(f * s); }
    __syncthreads();
    float acc[2][8];
#pragma unroll
    for (int rr = 0; rr < 2; ++rr)
#pragma unroll
        for (int q = 0; q < 8; ++q) acc[rr][q] = 0.f;
    for (int ib = 0; ib < 64; ib += 16) {
        float wa[16], wb[16];
#pragma unroll
        for (int i = 0; i < 16; ++i) { wa[i] = wf[(ib + i) * 1024 + tid]; wb[i] = wf[(ib + i) * 1024 + 512 + tid]; }
#pragma unroll
        for (int i = 0; i < 16; ++i) {
#pragma unroll
            for (int q = 0; q < 8; ++q) { const float h = ha[q][ib + i]; acc[0][q] += h * wa[i]; acc[1][q] += h * wb[i]; } }
    }
    const int ch = tid;
    const float delta = 3.0701134573253944f + (float)ch * ((15.350567286626972f - 3.0701134573253944f) / 511.0f);
#pragma unroll
    for (int q = 0; q < 8; ++q) {
        const int ps = p0 + q; const float dec = __expf(-((float)ps / (float)(Lf - 1)) * delta);
        const float vf = acc[0][q] * dec, vb = acc[1][q] * dec;
        if (lat) { bf16_t* RBp = (bf16_t*)(a.ws + WS_FILTL) + ((size_t)l * 512 + ch) * HY_RBROW; RBp[2048 - ps] = f2bf(vf); if (ps > 0) RBp[2048 + ps] = f2bf(vb); }
        else { T[(size_t)ch * (2 * Lf) + Lf + ps] = vf; if (ps > 0) T[(size_t)ch * (2 * Lf) + Lf - ps] = vb; else T[(size_t)ch * (2 * Lf)] = 0.f; }
    }
    __syncthreads();
}
__device__ __forceinline__ void ph_filters(const Args& a, float* sm, int fb, int nfb) {
    const int tid = threadIdx.x;
    for (int l = 0; l < 2; ++l) {
        for (int i = tid; i < 2112; i += NTHR) sm[FW_W1 + i] = a.in[15][l * 2112 + i];
        for (int i = tid; i < 4096; i += NTHR) { sm[FW_W2 + i] = a.in[17][l * 4096 + i]; sm[FW_W3 + i] = a.in[19][l * 4096 + i]; }
        if (tid < 64) { sm[FW_B1 + tid] = a.in[16][l * 64 + tid]; sm[FW_B2 + tid] = a.in[18][l * 64 + tid]; sm[FW_B3 + tid] = a.in[20][l * 64 + tid]; sm[FW_FR + tid] = a.in[22][l * 64 + tid]; }
        __syncthreads();
        for (int r = fb; r < 288; r += nfb) filters_unit(a, l, r, sm);
        __syncthreads();
    }
}
#define SUBREP(b) for (int srep_ = 0; srep_ <= (int)((PROBE_SUB >> (b)) & 1u); ++srep_)
__device__ __forceinline__ void ph_absmax(const Args& a, float* sm) {
    unsigned* ctl = (unsigned*)(a.ws + WS_CTL); const int tid = threadIdx.x, G = gridDim.x, bid = blockIdx.x, lane = tid & 63, w = tid >> 6;
#pragma unroll
    for (int j = (I8_WIN ? 0 : 2); j < (I8_GU ? 4 : 2); ++j) {
        const f32x4* p4 = (const f32x4*)(j == 0 ? a.in[8] : j == 1 ? a.in[8] + (size_t)2048 * 3648 : j == 2 ? a.in[26] : a.in[27]);
        const int n4 = (j < 2 ? 2048 * 3648 : 2048 * 5632) / 4, step = G * 512;
        float mm = 0.f;
        for (int i0 = bid * 512 + tid; i0 < n4; i0 += step * 8) {
            f32x4 v[8];
#pragma unroll
            for (int u = 0; u < 8; ++u) { const int i = i0 + u * step; v[u] = i < n4 ? __builtin_nontemporal_load(p4 + i) : (f32x4){0.f, 0.f, 0.f, 0.f}; }
#pragma unroll
            for (int u = 0; u < 8; ++u) mm = fmaxf(mm, fmaxf(fmaxf(fabsf(v[u][0]), fabsf(v[u][1])), fmaxf(fabsf(v[u][2]), fabsf(v[u][3]))));
        }
        mm = wave_max(mm);
        if (lane == 0) sm[w] = mm;
        __syncthreads();
        if (tid == 0) { float t = sm[0];
#pragma unroll
            for (int k = 1; k < 8; ++k) t = fmaxf(t, sm[k]);
            (void)__hip_atomic_fetch_max(ctl + CT_WSC + j, __float_as_uint(t), __ATOMIC_RELAXED, __HIP_MEMORY_SCOPE_AGENT); }
        __syncthreads();
    }
    if (tid == 0) (void)__hip_atomic_fetch_add(ctl + CT_AMAXDONE, 1u, __ATOMIC_RELAXED, __HIP_MEMORY_SCOPE_AGENT);
}
__device__ __forceinline__ void ph_prologue(const Args& a, float* sm) {
    const int bid = blockIdx.x, G = gridDim.x, tid = threadIdx.x;
    const int NF = G >= 128 ? 64 : 0;
    if (I8_GEMM) ph_absmax(a, sm);
    if (NF == 0) { SUBREP(4) for (int u = bid; u < 192; u += G) adaln_unit(a, u, sm); SUBREP(5) ph_filters(a, sm, bid, G); }
    else if (bid < NF) { SUBREP(5) ph_filters(a, sm, bid, NF); }
    else { SUBREP(4) for (int u = bid - NF; u < 192; u += G - NF) adaln_unit(a, u, sm); }
    { float* cosT = (float*)(a.ws + WS_ROPE); float* sinT = cosT + 2048 * 32;
      for (int i = bid * 512 + tid; i < 2048 * 32; i += G * 512) { const int t = i >> 5, f = i & 31;
          const float pos = (float)((f < 16) ? (t >> 6) : (t & 63)); const float freq = powf(10000.0f, -(float)(f & 15) / 16.0f); const float ang = pos * freq;
          cosT[i] = cosf(ang); sinT[i] = sinf(ang); } }
    for (int i = bid * 512 + tid; i < 2 * 512 * 17; i += G * 512) { const int row = i / 17, k = i - row * 17; ((bf16_t*)(a.ws + WS_FILTL))[(size_t)row * HY_RBROW + (k == 0 ? 0 : 4095 + k)] = 0; }
    { constexpr int RB16 = I8_WIN ? 128 : 256;
      for (int i = bid * 512 + tid; i < 2 * 192 * RB16; i += G * 512) { const int l = i / (192 * RB16), r = i % (192 * RB16);
        *(u32x4*)(a.ws + WS_WIN + (size_t)l * UW * D * 2 + (size_t)INW * RB16 * 16 + (size_t)r * 16) = (u32x4){0u, 0u, 0u, 0u}; } }
    if (I8_GEMM) {
        if (tid == 0) { const unsigned* dn = (const unsigned*)(a.ws + WS_CTL) + CT_AMAXDONE; unsigned sp = 0;
            while (__hip_atomic_load(dn, __ATOMIC_RELAXED, __HIP_MEMORY_SCOPE_AGENT) < (unsigned)G && ++sp < (1u << 22)) __builtin_amdgcn_s_sleep(4); }
    }
    __syncthreads();
    if ((PROBE_SUB >> 8) & 1u) ph_convert<2>(a, sm, bid, G, NCONV);
    conv_dynamic<0>(a, sm);
    if (G != 256) ph_convert<0>(a, sm, NCONV_Q + bid, G, NCONV);
    if ((PROBE_SUB >> 6) & 1u) ph_convert<0>(a, sm, bid, G, NCONV);
    if ((PROBE_SUB >> 7) & 1u) ph_convert<1>(a, sm, bid, G, NCONV);
}

template <bool ROUTER, bool COPYX, int OUT8 = 0, int NSLAB = 0>
__device__ __forceinline__ void ph_normmod(const float* __restrict__ xlat, const float* __restrict__ xctx, const float* __restrict__ gain, const float* __restrict__ modl, int sh_off, int sc_off,
                                           bf16_t* __restrict__ out, int nrows, float* __restrict__ xs, const float* __restrict__ router, int* __restrict__ topi, float* __restrict__ topw,
                                           const float* __restrict__ slab = nullptr, const float* __restrict__ slab_gate = nullptr, float* __restrict__ rsc = nullptr) {
    const int lane = threadIdx.x & 63, wid = threadIdx.x >> 6;
    for (int row = blockIdx.x * 8 + wid; row < nrows; row += gridDim.x * 8) {
        const float* xr = row < NLAT ? xlat + (size_t)row * D : xctx + (size_t)(row - NLAT) * D;
        const float* mv = modl + (size_t)tok_mod(row) * 12288;
        f32x4 v[8]; float ss = 0.f;
#pragma unroll
        for (int i = 0; i < 8; ++i) { v[i] = *(const f32x4*)(xr + i * 256 + lane * 4);
            if (NSLAB > 0 && row >= NLAT) { f32x4 sa = *(const f32x4*)(slab + (size_t)(row - NLAT) * D + i * 256 + lane * 4);
#pragma unroll
                for (int sl = 1; sl < NSLAB; ++sl) sa += *(const f32x4*)(slab + ((size_t)sl * NCTX + (row - NLAT)) * D + i * 256 + lane * 4);
                v[i] += *(const f32x4*)(slab_gate + i * 256 + lane * 4) * sa; }
            ss += v[i][0] * v[i][0] + v[i][1] * v[i][1] + v[i][2] * v[i][2] + v[i][3] * v[i][3];
            if (COPYX && (NSLAB == 0 || row >= NLAT)) *(f32x4*)(xs + (size_t)row * D + i * 256 + lane * 4) = v[i]; }
        ss = wave_sum(ss);
        const float rstd = rsqrtf(ss * (1.0f / D) + EPS);
        float lg[8];
#pragma unroll
        for (int e = 0; e < 8; ++e) lg[e] = 0.f;
        float amax = 0.f;
#pragma unroll
        for (int i = 0; i < 8; ++i) {
            const int col = i * 256 + lane * 4;
            const f32x4 g = *(const f32x4*)(gain + col), sc = *(const f32x4*)(mv + sc_off + col), sh = *(const f32x4*)(mv + sh_off + col);
            f32x4 o;
#pragma unroll
            for (int j = 0; j < 4; ++j) o[j] = (v[i][j] * rstd * g[j]) * (1.0f + sc[j]) + sh[j];
            if (OUT8 == 2) { v[i] = o; amax = fmaxf(amax, fmaxf(fmaxf(fabsf(o[0]), fabsf(o[1])), fmaxf(fabsf(o[2]), fabsf(o[3])))); }
            else if (OUT8 == 1) *(unsigned*)((unsigned char*)out + (size_t)row * D + col) = pg8::pack4_fp8(o[0] * ASCALE, o[1] * ASCALE, o[2] * ASCALE, o[3] * ASCALE);
            else { u32x2 w; w.x = (unsigned)f2bf(o[0]) | ((unsigned)f2bf(o[1]) << 16); w.y = (unsigned)f2bf(o[2]) | ((unsigned)f2bf(o[3]) << 16);
                *(u32x2*)(out + (size_t)row * D + col) = w; }
            if (ROUTER) {
#pragma unroll
                for (int j = 0; j < 4; ++j) { const f32x4 r0 = *(const f32x4*)(router + (size_t)(col + j) * 8), r1 = *(const f32x4*)(router + (size_t)(col + j) * 8 + 4);
                    lg[0] += o[j] * r0[0]; lg[1] += o[j] * r0[1]; lg[2] += o[j] * r0[2]; lg[3] += o[j] * r0[3];
                    lg[4] += o[j] * r1[0]; lg[5] += o[j] * r1[1]; lg[6] += o[j] * r1[2]; lg[7] += o[j] * r1[3]; }
                asm volatile("" ::: "memory");
            }
        }
        if (OUT8 == 2) {
            amax = wave_max(amax); const float qs = amax > 0.f ? 127.0f / amax : 0.f;
#pragma unroll
            for (int i = 0; i < 8; ++i) *(unsigned*)((unsigned char*)out + (size_t)row * D + i * 256 + lane * 4) = pack4_i8(v[i][0] * qs, v[i][1] * qs, v[i][2] * qs, v[i][3] * qs);
            if (lane == 0) rsc[row] = amax * (1.0f / 127.0f);
        }
        if (ROUTER) {
#pragma unroll
            for (int e = 0; e < 8; ++e) lg[e] = wave_sum(lg[e]);
            if (lane == 0) {
                int i0 = 0; float v0 = lg[0];
#pragma unroll
                for (int e = 1; e < 8; ++e) if (lg[e] > v0) { v0 = lg[e]; i0 = e; }
                int i1 = -1; float v1 = -3.0e38f;
#pragma unroll
                for (int e = 0; e < 8; ++e) if (e != i0 && lg[e] > v1) { v1 = lg[e]; i1 = e; }
                const float e1 = expf(v1 - v0), w0 = 1.0f / (1.0f + e1), w1 = e1 / (1.0f + e1);
                topi[row * 2] = i0; topi[row * 2 + 1] = i1; topw[row * 2] = w0; topw[row * 2 + 1] = w1;
            }
        }
    }
}

__device__ __forceinline__ float bflo(unsigned w) { return __uint_as_float(w << 16); }
__device__ __forceinline__ float bfhi(unsigned w) { return __uint_as_float(w & 0xffff0000u); }
__device__ __forceinline__ unsigned pkbf(float lo, float hi) { return (unsigned)f2bf(lo) | ((unsigned)f2bf(hi) << 16); }
__device__ __forceinline__ u32x4 rope8(const u32x4 mine, const u32x4 other, bool is_x2, const f32x4 c0, const f32x4 c1, const f32x4 s0, const f32x4 s1) {
    const unsigned mw[4] = {mine.x, mine.y, mine.z, mine.w}, ow[4] = {other.x, other.y, other.z, other.w};
    const float cs[8] = {c0[0], c0[1], c0[2], c0[3], c1[0], c1[1], c1[2], c1[3]}, sn[8] = {s0[0], s0[1], s0[2], s0[3], s1[0], s1[1], s1[2], s1[3]};
    unsigned o[4];
#pragma unroll
    for (int d = 0; d < 4; ++d) {
        const float m0 = bflo(mw[d]), m1 = bfhi(mw[d]), p0 = bflo(ow[d]), p1 = bfhi(ow[d]);
        const float r0 = is_x2 ? (p0 * sn[2 * d] + m0 * cs[2 * d]) : (m0 * cs[2 * d] - p0 * sn[2 * d]);
        const float r1 = is_x2 ? (p1 * sn[2 * d + 1] + m1 * cs[2 * d + 1]) : (m1 * cs[2 * d + 1] - p1 * sn[2 * d + 1]);
        o[d] = pkbf(r0, r1);
    }
    return (u32x4){o[0], o[1], o[2], o[3]};
}
__device__ __forceinline__ u32x4 shfl4(const u32x4 v, int m) { return (u32x4){(unsigned)__shfl_xor((int)v.x, m), (unsigned)__shfl_xor((int)v.y, m), (unsigned)__shfl_xor((int)v.z, m), (unsigned)__shfl_xor((int)v.w, m)}; }
__device__ __forceinline__ void ph_mid(const Args& a, int l) {
    const bf16_t* __restrict__ U = (const bf16_t*)(a.ws + WS_U);
    const float* g_q = a.in[9] + l * 768; const float* g_kv = a.in[11] + l * 512; const float* conv_w = a.in[13] + (size_t)l * 3 * 1536; const float* conv_b = a.in[14] + l * 1536;
    const float* cosT = (const float*)(a.ws + WS_ROPE); const float* sinT = cosT + 2048 * 32;
    bf16_t* cqn = (bf16_t*)(a.ws + WS_CQN); bf16_t* ckvn = (bf16_t*)(a.ws + WS_CKVN); bf16_t* kpe = (bf16_t*)(a.ws + WS_KPE); bf16_t* x0o = (bf16_t*)(a.ws + WS_X0);
    bf16_t* wtl = (bf16_t*)(a.ws + WS_WTL); bf16_t* wtc = (bf16_t*)(a.ws + WS_WTC); bf16_t* sq = (bf16_t*)(a.ws + WS_SQ); bf16_t* sk = (bf16_t*)(a.ws + WS_SK); bf16_t* sv = (bf16_t*)(a.ws + WS_SV);
    int tid_ = threadIdx.x; asm volatile("" : "+v"(tid_));
    const int tid = tid_, lane = tid & 63, wid = tid >> 6;
    for (int unit = blockIdx.x; unit < NTOK / 16; unit += gridDim.x) {
        const int tok0 = unit * 16;
        for (int tt = 0; tt < 2; ++tt) {
            const int tok = tok0 + wid * 2 + tt; const bool lat = tok < NLAT; const int t = lat ? (tok & 2047) : ((tok - NLAT) & 255);
            const bf16_t* u = U + (size_t)tok * UW;
            const u32x2 q0 = *(const u32x2*)(u + O_CQ + lane * 12), q1 = *(const u32x2*)(u + O_CQ + lane * 12 + 4), q2 = *(const u32x2*)(u + O_CQ + lane * 12 + 8);
            const u32x4 kvv = *(const u32x4*)(u + O_CKV + lane * 8);
            const u32x4 sqv = *(const u32x4*)(u + O_SQ + lane * 8);
            const u32x4 skv = *(const u32x4*)(u + O_SK + (lane & 15) * 8);
            const u32x4 kpv = *(const u32x4*)(u + O_KPE + (lane & 7) * 8);
            const int i0 = (lane & 3) * 8;
            f32x4 c0 = (f32x4){1.f, 1.f, 1.f, 1.f}, c1 = c0, s0 = (f32x4){0.f, 0.f, 0.f, 0.f}, s1 = s0;
            if (lat) { c0 = *(const f32x4*)(cosT + t * 32 + i0); c1 = *(const f32x4*)(cosT + t * 32 + i0 + 4); s0 = *(const f32x4*)(sinT + t * 32 + i0); s1 = *(const f32x4*)(sinT + t * 32 + i0 + 4); }
            {
                const unsigned w6[6] = {q0.x, q0.y, q1.x, q1.y, q2.x, q2.y}; float x[12]; float ss = 0.f;
#pragma unroll
                for (int d = 0; d < 6; ++d) { x[2 * d] = bflo(w6[d]); x[2 * d + 1] = bfhi(w6[d]); ss += x[2 * d] * x[2 * d] + x[2 * d + 1] * x[2 * d + 1]; }
                ss = wave_sum(ss); const float rs = rsqrtf(ss * (1.0f / 768.0f) + EPS);
                const f32x4 g0 = *(const f32x4*)(g_q + lane * 12), g1 = *(const f32x4*)(g_q + lane * 12 + 4), g2 = *(const f32x4*)(g_q + lane * 12 + 8);
                u32x2 o0, o1, o2;
                o0.x = pkbf(x[0] * rs * g0[0], x[1] * rs * g0[1]); o0.y = pkbf(x[2] * rs * g0[2], x[3] * rs * g0[3]);
                o1.x = pkbf(x[4] * rs * g1[0], x[5] * rs * g1[1]); o1.y = pkbf(x[6] * rs * g1[2], x[7] * rs * g1[3]);
                o2.x = pkbf(x[8] * rs * g2[0], x[9] * rs * g2[1]); o2.y = pkbf(x[10] * rs * g2[2], x[11] * rs * g2[3]);
                bf16_t* dst = cqn + (size_t)tok * 768 + lane * 12; *(u32x2*)dst = o0; *(u32x2*)(dst + 4) = o1; *(u32x2*)(dst + 8) = o2;
            }
            {
                const unsigned w4[4] = {kvv.x, kvv.y, kvv.z, kvv.w}; float x[8]; float ss = 0.f;
#pragma unroll
                for (int d = 0; d < 4; ++d) { x[2 * d] = bflo(w4[d]); x[2 * d + 1] = bfhi(w4[d]); ss += x[2 * d] * x[2 * d] + x[2 * d + 1] * x[2 * d + 1]; }
                ss = wave_sum(ss); const float rs = rsqrtf(ss * (1.0f / 512.0f) + EPS);
                const f32x4 g0 = *(const f32x4*)(g_kv + lane * 8), g1 = *(const f32x4*)(g_kv + lane * 8 + 4);
                u32x4 o; o.x = pkbf(x[0] * rs * g0[0], x[1] * rs * g0[1]); o.y = pkbf(x[2] * rs * g0[2], x[3] * rs * g0[3]); o.z = pkbf(x[4] * rs * g1[0], x[5] * rs * g1[1]); o.w = pkbf(x[6] * rs * g1[2], x[7] * rs * g1[3]);
                *(u32x4*)(ckvn + (size_t)tok * 512 + lane * 8) = o;
            }
            const bool is_x2 = (lane & 4) != 0;
            {
                const u32x4 r = rope8(sqv, shfl4(sqv, 4), is_x2, c0, c1, s0, s1);
                *(u32x4*)(sq + (size_t)tok * 512 + lane * 8) = r;
            }
            {
                const u32x4 r = rope8(skv, shfl4(skv, 4), is_x2, c0, c1, s0, s1);
                if (lane < 16) *(u32x4*)(sk + (size_t)tok * 128 + lane * 8) = r;
            }
            {
                const u32x4 ot = shfl4(kpv, 4);
                if (lane < 4) {
                    const unsigned mw[4] = {kpv.x, kpv.y, kpv.z, kpv.w}, ow[4] = {ot.x, ot.y, ot.z, ot.w};
                    const float cs[8] = {c0[0], c0[1], c0[2], c0[3], c1[0], c1[1], c1[2], c1[3]}, sn[8] = {s0[0], s0[1], s0[2], s0[3], s1[0], s1[1], s1[2], s1[3]};
                    unsigned o[8];
#pragma unroll
                    for (int d = 0; d < 4; ++d) { const float a0 = bflo(mw[d]), a1 = bfhi(mw[d]), b0 = bflo(ow[d]), b1 = bfhi(ow[d]);
                        o[2 * d] = pkbf(a0 * cs[2 * d] - b0 * sn[2 * d], a0 * sn[2 * d] + b0 * cs[2 * d]);
                        o[2 * d + 1] = pkbf(a1 * cs[2 * d + 1] - b1 * sn[2 * d + 1], a1 * sn[2 * d + 1] + b1 * cs[2 * d + 1]); }
                    bf16_t* dst = kpe + (size_t)tok * 64 + lane * 16;
                    *(u32x4*)dst = (u32x4){o[0], o[1], o[2], o[3]}; *(u32x4*)(dst + 8) = (u32x4){o[4], o[5], o[6], o[7]};
                }
            }
        }
        {
            const bool lat = tok0 < NLAT; const int Ls = lat ? L : C;
            const int b = lat ? (tok0 >> 11) : ((tok0 - NLAT) >> 8), t0 = (lat ? (tok0 & 2047) : ((tok0 - NLAT) & 255));
            const int cp = tid & 255, hf = tid >> 8, ch = cp * 2, ts = t0 + hf * 8, tokb = tok0 + hf * 8;
            float cw[3][3][2], cb[3][2];
#pragma unroll
            for (int g = 0; g < 3; ++g) { cb[g][0] = conv_b[g * 512 + ch]; cb[g][1] = conv_b[g * 512 + ch + 1];
#pragma unroll
                for (int j = 0; j < 3; ++j) { cw[g][j][0] = conv_w[j * 1536 + g * 512 + ch]; cw[g][j][1] = conv_w[j * 1536 + g * 512 + ch + 1]; } }
            unsigned rows[3][10];
#pragma unroll
            for (int r = 0; r < 10; ++r) { const int tr = ts - 1 + r; const bool ok = tr >= 0 && tr < Ls;
#pragma unroll
                for (int g = 0; g < 3; ++g) rows[g][r] = ok ? *(const unsigned*)(U + (size_t)(tokb - 1 + r) * UW + O_HY + g * 512 + ch) : 0u; }
            unsigned wp0[4], wp1[4];
#pragma unroll
            for (int i = 0; i < 8; ++i) {
                float y[3][2];
#pragma unroll
                for (int g = 0; g < 3; ++g) {
                    y[g][0] = cb[g][0] + cw[g][0][0] * bflo(rows[g][i]) + cw[g][1][0] * bflo(rows[g][i + 1]) + cw[g][2][0] * bflo(rows[g][i + 2]);
                    y[g][1] = cb[g][1] + cw[g][0][1] * bfhi(rows[g][i]) + cw[g][1][1] * bfhi(rows[g][i + 1]) + cw[g][2][1] * bfhi(rows[g][i + 2]); }
                *(unsigned*)(x0o + (size_t)(tokb + i) * 512 + ch) = pkbf(y[0][0], y[0][1]);
                const unsigned w0 = f2bf(y[2][0] * y[1][0]), w1 = f2bf(y[2][1] * y[1][1]);
                if (i & 1) { wp0[i >> 1] |= w0 << 16; wp1[i >> 1] |= w1 << 16; } else { wp0[i >> 1] = w0; wp1[i >> 1] = w1; }
            }
            bf16_t* wt = lat ? wtl + ((size_t)b * 512 + ch) * L + ts : wtc + ((size_t)b * 512 + ch) * C + ts;
            *(u32x4*)wt = (u32x4){wp0[0], wp0[1], wp0[2], wp0[3]};
            *(u32x4*)(wt + (lat ? L : C)) = (u32x4){wp1[0], wp1[1], wp1[2], wp1[3]};
        }
        if (tid < 128) {
            unsigned pk[8];
#pragma unroll
            for (int i = 0; i < 16; ++i) { const unsigned v = U[(size_t)(tok0 + i) * UW + O_SV + tid]; if (i & 1) pk[i >> 1] |= v << 16; else pk[i >> 1] = v; }
            bf16_t* dst = sv + (size_t)tid * NTOK + tok0;
            u32x4 w0, w1; w0.x = pk[0]; w0.y = pk[1]; w0.z = pk[2]; w0.w = pk[3]; w1.x = pk[4]; w1.y = pk[5]; w1.z = pk[6]; w1.w = pk[7];
            *(u32x4*)dst = w0; *(u32x4*)(dst + 8) = w1;
        }
    }
}

__device__ __forceinline__ void ph_mla_naive(const Args& a, int nq, float* sm) {
    const bf16_t* __restrict__ Q = (const bf16_t*)(a.ws + WS_Q); const bf16_t* __restrict__ KV = (const bf16_t*)(a.ws + WS_KV); const bf16_t* __restrict__ KPE = (const bf16_t*)(a.ws + WS_KPE);
    bf16_t* mix = (bf16_t*)(a.ws + WS_MIX);
    const int lane = threadIdx.x & 63, w = threadIdx.x >> 6;
    float* qf = sm + w * 192; float* sc = sm + 8 * 192 + w * 2304;
    for (int unit = blockIdx.x; unit < nq; unit += gridDim.x) {
        const int h = unit & 7, qt = (unit >> 3) * 8 + w; const bool lat = qt < NLAT;
        const int b = lat ? (qt >> 11) : ((qt - NLAT) >> 8);
        const int nk = lat ? (L + C) : C;
        for (int i = lane; i < 192; i += 64) qf[i] = bf2f(Q[(size_t)qt * QW + h * 192 + i]);
        __syncthreads();
        const float scale = 0.07216878364870322f;
        float mx = -3.0e38f;
        for (int kc = 0; kc < nk; kc += 64) {
            const int kk = kc + lane;
            const int kt = lat ? (kk < L ? b * L + kk : NLAT + b * C + (kk - L)) : (NLAT + b * C + kk);
            float s = 0.f;
            const u32x4* kp = (const u32x4*)(KV + (size_t)kt * KVW + h * 256);
            for (int i = 0; i < 16; ++i) { const u32x4 v = kp[i]; const float* q8 = qf + i * 8;
                s += q8[0] * __uint_as_float(v.x << 16) + q8[1] * __uint_as_float(v.x & 0xffff0000u) + q8[2] * __uint_as_float(v.y << 16) + q8[3] * __uint_as_float(v.y & 0xffff0000u)
                   + q8[4] * __uint_as_float(v.z << 16) + q8[5] * __uint_as_float(v.z & 0xffff0000u) + q8[6] * __uint_as_float(v.w << 16) + q8[7] * __uint_as_float(v.w & 0xffff0000u); }
            const u32x4* pp = (const u32x4*)(KPE + (size_t)kt * 64);
            for (int i = 0; i < 8; ++i) { const u32x4 v = pp[i]; const float* q8 = qf + 128 + i * 8;
                s += q8[0] * __uint_as_float(v.x << 16) + q8[1] * __uint_as_float(v.x & 0xffff0000u) + q8[2] * __uint_as_float(v.y << 16) + q8[3] * __uint_as_float(v.y & 0xffff0000u)
                   + q8[4] * __uint_as_float(v.z << 16) + q8[5] * __uint_as_float(v.z & 0xffff0000u) + q8[6] * __uint_as_float(v.w << 16) + q8[7] * __uint_as_float(v.w & 0xffff0000u); }
            s *= scale; sc[kk] = s; mx = fmaxf(mx, s);
        }
        mx = wave_max(mx);
        float sum = 0.f;
        for (int kc = 0; kc < nk; kc += 64) { const float p = expf(sc[kc + lane] - mx); sc[kc + lane] = p; sum += p; }
        sum = wave_sum(sum);
        __syncthreads();
        float o0 = 0.f, o1 = 0.f;
        for (int kk = 0; kk < nk; ++kk) {
            const int kt = lat ? (kk < L ? b * L + kk : NLAT + b * C + (kk - L)) : (NLAT + b * C + kk);
            const unsigned v = *(const unsigned*)(KV + (size_t)kt * KVW + h * 256 + 128 + lane * 2);
            const float p = sc[kk];
            o0 += p * __uint_as_float(v << 16); o1 += p * __uint_as_float(v & 0xffff0000u);
        }
        const float inv = 1.0f / sum;
        *(unsigned*)(mix + (size_t)qt * D + h * 128 + lane * 2) = (unsigned)f2bf(o0 * inv) | ((unsigned)f2bf(o1 * inv) << 16);
        __syncthreads();
    }
}
__device__ __forceinline__ void ph_swa_naive(const Args& a, int l, int nq, float* sm) {
    const bf16_t* __restrict__ SQ = (const bf16_t*)(a.ws + WS_SQ); const bf16_t* __restrict__ SK = (const bf16_t*)(a.ws + WS_SK); const bf16_t* __restrict__ SV = (const bf16_t*)(a.ws + WS_SV);
    const float* sink = a.in[24] + l * 8; bf16_t* mix = (bf16_t*)(a.ws + WS_MIX);
    const int lane = threadIdx.x & 63, w = threadIdx.x >> 6;
    float* qf = sm + w * 64; float* sc = sm + 8 * 64 + w * 576; int* kts = (int*)(sm + 8 * 64 + 8 * 576) + w * 576;
    for (int unit = blockIdx.x; unit < nq; unit += gridDim.x) {
        const int hq = unit & 7, hk = hq >> 2, qt = (unit >> 3) * 8 + w; const bool lat = qt < NLAT;
        const int b = lat ? (qt >> 11) : ((qt - NLAT) >> 8), t = lat ? (qt & 2047) : 0;
        int lo = 0, nloc = 0;
        if (lat) { lo = t - 128 < 0 ? 0 : t - 128; const int hi = t + 128 > L - 1 ? L - 1 : t + 128; nloc = hi - lo + 1; }
        const int nk = nloc + C;
        qf[lane] = bf2f(SQ[(size_t)qt * 512 + hq * 64 + lane]);
        __syncthreads();
        const float skv = sink[hq];
        float mx = skv;
        for (int kc = 0; kc < nk; kc += 64) {
            const int kk = kc + lane;
            if (kk < nk) {
                const int kt = kk < nloc ? (b * L + lo + kk) : (NLAT + b * C + (kk - nloc));
                const u32x4* kp = (const u32x4*)(SK + (size_t)kt * 128 + hk * 64);
                float s = 0.f;
                for (int i = 0; i < 8; ++i) { const u32x4 v = kp[i]; const float* q8 = qf + i * 8;
                    s += q8[0] * __uint_as_float(v.x << 16) + q8[1] * __uint_as_float(v.x & 0xffff0000u) + q8[2] * __uint_as_float(v.y << 16) + q8[3] * __uint_as_float(v.y & 0xffff0000u)
                       + q8[4] * __uint_as_float(v.z << 16) + q8[5] * __uint_as_float(v.z & 0xffff0000u) + q8[6] * __uint_as_float(v.w << 16) + q8[7] * __uint_as_float(v.w & 0xffff0000u); }
                s *= 0.125f; sc[kk] = s; kts[kk] = kt; mx = fmaxf(mx, s);
            }
        }
        mx = wave_max(mx);
        float sum = 0.f;
        for (int kc = 0; kc < nk; kc += 64) { const int kk = kc + lane; if (kk < nk) { const float p = expf(sc[kk] - mx); sc[kk] = p; sum += p; } }
        sum = wave_sum(sum) + expf(skv - mx);
        __syncthreads();
        float o = 0.f;
        for (int kk = 0; kk < nk; ++kk) o += sc[kk] * bf2f(SV[(size_t)kts[kk] * 128 + hk * 64 + lane]);
        mix[(size_t)qt * D + 1536 + hq * 64 + lane] = f2bf(o / sum);
        __syncthreads();
    }
}
template <int LS>
__device__ __forceinline__ void ph_hyena_naive(const Args& a, int l, float* sm) {
    const float* filt = LS == L ? (const float*)(a.ws + WS_FILTL) + (size_t)l * 512 * 4096 : (const float*)(a.ws + WS_FILTC) + (size_t)l * 512 * 512;
    const bf16_t* wt = (const bf16_t*)(a.ws + (LS == L ? WS_WTL : WS_WTC)); const bf16_t* x0 = (const bf16_t*)(a.ws + WS_X0); const float* skip = a.in[23] + l * 512;
    bf16_t* mix = (bf16_t*)(a.ws + WS_MIX); const int tok_base = LS == L ? 0 : NLAT;
    float* T = sm; float* ws = sm + 2 * LS; const int tid = threadIdx.x;
    for (int unit = blockIdx.x; unit < 512 * NB; unit += gridDim.x) {
        const int ch = unit >> 2, b = unit & 3;
        for (int i = tid; i < 2 * LS; i += NTHR) T[i] = filt[(size_t)ch * 2 * LS + i];
        for (int i = tid; i < LS; i += NTHR) ws[i] = bf2f(wt[((size_t)b * 512 + ch) * LS + i]);
        __syncthreads();
        const float sk = skip[ch];
        for (int t = tid; t < LS; t += NTHR) {
            float y = 0.f;
            for (int s = 0; s < LS; ++s) y += T[t - s + LS] * ws[s];
            ((bf16_t*)(a.ws + WS_YT))[(LS == L ? (size_t)0 : (size_t)NB * 512 * L) + ((size_t)b * 512 + ch) * LS + t] = f2bf(y);
        }
        __syncthreads();
    }
}
__device__ __forceinline__ void ph_route_gather(const Args& a, int* sm) {
    const int* __restrict__ topi = (const int*)(a.ws + WS_TOPI); int* __restrict__ pos = (int*)(a.ws + WS_POS); int* ctl = (int*)(a.ws + WS_CTL);
    const unsigned char* __restrict__ hb = (const unsigned char*)(a.ws + WS_HA); unsigned char* __restrict__ hbs = (unsigned char*)(a.ws + WS_HBS);
    int (*cnt)[512] = (int (*)[512])sm; int* tot = sm + 8 * 512; int* ppos = sm + 8 * 512 + 16;
    const int tid = threadIdx.x, lane = tid & 63, w = tid >> 6;
    int c[8];
#pragma unroll
    for (int e = 0; e < 8; ++e) c[e] = 0;
    for (int i = 0; i < 32; i += 4) { const u32x4 e4 = *(const u32x4*)(topi + tid * 32 + i);
#pragma unroll
        for (int q = 0; q < 8; ++q) c[q] += (e4.x == (unsigned)q) + (e4.y == (unsigned)q) + (e4.z == (unsigned)q) + (e4.w == (unsigned)q); }
#pragma unroll
    for (int e = 0; e < 8; ++e) cnt[e][tid] = c[e];
    __syncthreads();
    {
        int v[8]; int s8 = 0;
#pragma unroll
        for (int k = 0; k < 8; ++k) { v[k] = cnt[w][lane * 8 + k]; s8 += v[k]; }
        int incl = s8;
#pragma unroll
        for (int off = 1; off < 64; off <<= 1) { const int t = __shfl_up(incl, off); if (lane >= off) incl += t; }
        int run = incl - s8;
#pragma unroll
        for (int k = 0; k < 8; ++k) { cnt[w][lane * 8 + k] = run; run += v[k]; }
        if (lane == 63) tot[w] = incl;
    }
    __syncthreads();
    int eoff[8]; int o = 0;
#pragma unroll
    for (int e = 0; e < 8; ++e) { eoff[e] = o; o += (tot[e] + 255) & ~255; }
    if (blockIdx.x == 0 && tid == 0) {
#pragma unroll
        for (int e = 0; e < 8; ++e) { ctl[CT_EOFF + e] = eoff[e]; ctl[CT_EPAD + e] = (tot[e] + 255) & ~255; }
        ctl[CT_NTILE] = o >> 8; const int nwg = (o >> 8) * (D / 256); ctl[CT_MOES] = pg8::split_S(nwg, DFE / 128, 256); ctl[CT_TROW] = (nwg / 256) * 256 / (D / 256) * 256;
    }
    for (int tg = blockIdx.x; tg < NLAT / 32; tg += gridDim.x) {
        if (tid < 64) {
            const int idx = 64 * tg + tid, owner = idx >> 5, e = topi[idx]; int p = 0;
#pragma unroll
            for (int q = 0; q < 8; ++q) { const unsigned long long mk = __ballot(e == q);
                if (e == q) { const unsigned hm = (unsigned)(mk >> (32 * (tid >> 5))); p = eoff[q] + cnt[q][owner] + __popc(hm & ((1u << (tid & 31)) - 1u)); } }
            pos[idx] = p; ppos[tid] = p;
        }
        __syncthreads();
#pragma unroll
        for (int k = 0; k < 4; ++k) { const int tl = 4 * w + k; const int tok = 32 * tg + tl;
            const u32x4 v0 = *(const u32x4*)(hb + (size_t)tok * D + lane * 32), v1 = *(const u32x4*)(hb + (size_t)tok * D + lane * 32 + 16);
            const int p0 = ppos[2 * tl], p1 = ppos[2 * tl + 1];
            *(u32x4*)(hbs + (size_t)p0 * D + lane * 32) = v0; *(u32x4*)(hbs + (size_t)p0 * D + lane * 32 + 16) = v1;
            *(u32x4*)(hbs + (size_t)p1 * D + lane * 32) = v0; *(u32x4*)(hbs + (size_t)p1 * D + lane * 32 + 16) = v1; }
        __syncthreads();
    }
}
__device__ __forceinline__ void ph_final(const Args& a) {
    const float* xs = (const float*)(a.ws + WS_XS); const bf16_t* ys = (const bf16_t*)(a.ws + WS_YS); const int* pos = (const int*)(a.ws + WS_POS); const float* topw = (const float*)(a.ws + WS_TOPW);
    const float* modl = (const float*)(a.ws + WS_MOD) + (size_t)5 * 12288; const float* gfin = a.in[33]; float* out = a.out;
    const int lane = threadIdx.x & 63, wid = threadIdx.x >> 6;
    const int* ctl = (const int*)(a.ws + WS_CTL); const int nsl = ctl[CT_MOES], trow0 = ctl[CT_TROW], trows = ctl[CT_NTILE] * 256 - trow0; const float* slab = (const float*)(a.ws + WS_SLAB);
    for (int row = blockIdx.x * 8 + wid; row < NLAT; row += gridDim.x * 8) {
        const float* g2 = modl + (size_t)tok_mod(row) * 12288 + 10240;
        const int p0 = pos[row * 2], p1 = pos[row * 2 + 1]; const float w0 = topw[row * 2], w1 = topw[row * 2 + 1];
        const bool t0 = nsl > 1 && p0 >= trow0, t1 = nsl > 1 && p1 >= trow0;
        f32x4 v[8]; float ss = 0.f;
#pragma unroll
        for (int i = 0; i < 8; ++i) { const int col = i * 256 + lane * 4;
            const f32x4 x = *(const f32x4*)(xs + (size_t)row * D + col), g = *(const f32x4*)(g2 + col); f32x4 ya, yb;
            if (t0) { ya = *(const f32x4*)(slab + (size_t)(p0 - trow0) * D + col); for (int sl = 1; sl < nsl; ++sl) ya += *(const f32x4*)(slab + ((size_t)sl * trows + (p0 - trow0)) * D + col); }
            else { const u32x2 q = *(const u32x2*)(ys + (size_t)p0 * D + col); ya = (f32x4){__uint_as_float(q.x << 16), __uint_as_float(q.x & 0xffff0000u), __uint_as_float(q.y << 16), __uint_as_float(q.y & 0xffff0000u)}; }
            if (t1) { yb = *(const f32x4*)(slab + (size_t)(p1 - trow0) * D + col); for (int sl = 1; sl < nsl; ++sl) yb += *(const f32x4*)(slab + ((size_t)sl * trows + (p1 - trow0)) * D + col); }
            else { const u32x2 q = *(const u32x2*)(ys + (size_t)p1 * D + col); yb = (f32x4){__uint_as_float(q.x << 16), __uint_as_float(q.x & 0xffff0000u), __uint_as_float(q.y << 16), __uint_as_float(q.y & 0xffff0000u)}; }
#pragma unroll
            for (int j = 0; j < 4; ++j) { v[i][j] = x[j] + g[j] * (w0 * ya[j] + w1 * yb[j]); ss += v[i][j] * v[i][j]; } }
        ss = wave_sum(ss); const float rstd = rsqrtf(ss * (1.0f / D) + EPS);
#pragma unroll
        for (int i = 0; i < 8; ++i) { const int col = i * 256 + lane * 4; const f32x4 g = *(const f32x4*)(gfin + col); f32x4 o;
#pragma unroll
            for (int j = 0; j < 4; ++j) o[j] = v[i][j] * rstd * g[j];
            *(f32x4*)(out + (size_t)row * D + col) = o; }
    }
}

typedef float f32x2_t __attribute__((ext_vector_type(2))); typedef __bf16 bf16x2_t __attribute__((ext_vector_type(2)));
__device__ __forceinline__ unsigned cvtpk(float lo, float hi) { f32x2_t v = {lo, hi}; bf16x2_t b = __builtin_convertvector(v, bf16x2_t); return __builtin_bit_cast(unsigned, b); }
#define MFMA32(a, b, c) __builtin_amdgcn_mfma_f32_32x32x16_bf16((a), (b), (c), 0, 0, 0)
constexpr int MLA_KP = 400, MLA_VP = 144, MLA_KB = 64 * MLA_KP, MLA_VB = 128 * MLA_VP, MLA_STAGE = MLA_KB + MLA_VB;
static_assert(2 * MLA_STAGE <= RING_BYTES, "MLA LDS");

__device__ __forceinline__ void ph_mla(const Args& a, bool with_ctx, unsigned char* lds) {
    const bf16_t* __restrict__ Q = (const bf16_t*)(a.ws + WS_Q); const bf16_t* __restrict__ KN = (const bf16_t*)(a.ws + WS_KN); const bf16_t* __restrict__ KPE = (const bf16_t*)(a.ws + WS_KPE);
    const bf16_t* __restrict__ VT = (const bf16_t*)(a.ws + WS_VT); bf16_t* __restrict__ mix = (bf16_t*)(a.ws + WS_MIX);
    int tid_ = threadIdx.x; asm volatile("" : "+v"(tid_));
    const int tid = tid_, lane = tid & 63, w = tid >> 6, qi = lane & 31, hh = lane >> 5;
    const int nunits = with_ctx ? 288 : 256;
    const float c = 0.07216878364870322f * 1.4426950408889634f;
    for (int unit = blockIdx.x; unit < nunits; unit += gridDim.x) {
        int h, b, q0tok, nt; bool ctxq;
        if (unit < 256) { h = unit & 7; b = unit >> 6; q0tok = b * L + ((unit >> 3) & 7) * 256; nt = 36; ctxq = false; }
        else { const int u2 = unit - 256; h = u2 & 7; b = u2 >> 3; q0tok = NLAT + b * C; nt = 4; ctxq = true; }
#define MLA_KTOK(t) (ctxq ? (NLAT + b * C + (t) * 64) : ((t) < 32 ? (b * L + (t) * 64) : (NLAT + b * C + ((t) - 32) * 64)))
        u32x4 r0, r1, r2, r3, r4;
#define MLA_ISSUE_K(t) do { const int kt0_ = MLA_KTOK(t); \
            r0 = *(const u32x4*)(KN + (size_t)(kt0_ + (tid >> 4)) * 1024 + h * 128 + (tid & 15) * 8); \
            r1 = *(const u32x4*)(KN + (size_t)(kt0_ + 32 + (tid >> 4)) * 1024 + h * 128 + (tid & 15) * 8); \
            r2 = *(const u32x4*)(KPE + (size_t)(kt0_ + (tid >> 3)) * 64 + (tid & 7) * 8); } while (0)
#define MLA_ISSUE_V(t) do { const int kt0_ = MLA_KTOK(t); \
            r3 = *(const u32x4*)(VT + (size_t)(h * 128 + (tid >> 3)) * NTOK + kt0_ + (tid & 7) * 8); \
            r4 = *(const u32x4*)(VT + (size_t)(h * 128 + 64 + (tid >> 3)) * NTOK + kt0_ + (tid & 7) * 8); } while (0)
#define MLA_ISSUE(t) do { MLA_ISSUE_K(t); MLA_ISSUE_V(t); } while (0)
#define MLA_COMMIT(buf) do { unsigned char* kb_ = lds + (buf) * MLA_STAGE; unsigned char* vb_ = kb_ + MLA_KB; \
            *(u32x4*)(kb_ + (tid >> 4) * MLA_KP + (tid & 15) * 16) = r0; \
            *(u32x4*)(kb_ + (32 + (tid >> 4)) * MLA_KP + (tid & 15) * 16) = r1; \
            *(u32x4*)(kb_ + (tid >> 3) * MLA_KP + 256 + (tid & 7) * 16) = r2; \
            const int g_ = (tid & 7) >> 1, e_ = tid & 1; \
            { u32x2 lo_, hi_; lo_.x = r3.x; lo_.y = r3.y; hi_.x = r3.z; hi_.y = r3.w; \
              *(u32x2*)(vb_ + (tid >> 3) * MLA_VP + g_ * 32 + e_ * 8) = lo_; *(u32x2*)(vb_ + (tid >> 3) * MLA_VP + g_ * 32 + 16 + e_ * 8) = hi_; } \
            { u32x2 lo_, hi_; lo_.x = r4.x; lo_.y = r4.y; hi_.x = r4.z; hi_.y = r4.w; \
              *(u32x2*)(vb_ + (64 + (tid >> 3)) * MLA_VP + g_ * 32 + e_ * 8) = lo_; *(u32x2*)(vb_ + (64 + (tid >> 3)) * MLA_VP + g_ * 32 + 16 + e_ * 8) = hi_; } } while (0)
        const int qtok = q0tok + w * 32 + qi;
        bf16x8 qf[12];
#pragma unroll
        for (int s = 0; s < 12; ++s) qf[s] = *(const bf16x8*)(Q + (size_t)qtok * QW + h * 192 + s * 16 + hh * 8);
        f32x16 o[4];
#pragma unroll
        for (int d = 0; d < 4; ++d)
#pragma unroll
            for (int r = 0; r < 16; ++r) o[d][r] = 0.f;
        float m = -1.0e30f, l = 0.f;
        MLA_ISSUE(0); MLA_COMMIT(0);
        __syncthreads();
        for (int t = 0; t < nt; ++t) {
            const unsigned char* kb = lds + (t & 1) * MLA_STAGE; const unsigned char* vb = kb + MLA_KB;
            f32x16 s0, s1;
#pragma unroll
            for (int r = 0; r < 16; ++r) { s0[r] = 0.f; s1[r] = 0.f; }
            {
                const unsigned char* kp0 = kb + qi * MLA_KP + hh * 16; const unsigned char* kp1 = kp0 + 32 * MLA_KP;
                bf16x8 ka[4], kn[4];
                ka[0] = *(const bf16x8*)(kp0); ka[1] = *(const bf16x8*)(kp1); ka[2] = *(const bf16x8*)(kp0 + 32); ka[3] = *(const bf16x8*)(kp1 + 32);
#pragma unroll
                for (int g = 0; g < 6; ++g) {
                    if (g < 5) { kn[0] = *(const bf16x8*)(kp0 + (2 * g + 2) * 32); kn[1] = *(const bf16x8*)(kp1 + (2 * g + 2) * 32); kn[2] = *(const bf16x8*)(kp0 + (2 * g + 3) * 32); kn[3] = *(const bf16x8*)(kp1 + (2 * g + 3) * 32); }
                    __builtin_amdgcn_sched_barrier(0);
                    s0 = MFMA32(ka[0], qf[2 * g], s0); s1 = MFMA32(ka[1], qf[2 * g], s1); s0 = MFMA32(ka[2], qf[2 * g + 1], s0); s1 = MFMA32(ka[3], qf[2 * g + 1], s1);
                    __builtin_amdgcn_sched_barrier(0);
#pragma unroll
                    for (int q = 0; q < 4; ++q) ka[q] = kn[q];
                }
            }
            if (t + 1 < nt) MLA_ISSUE(t + 1);
            float mx = fmaxf(s0[0], s1[0]);
#pragma unroll
            for (int r = 1; r < 16; ++r) mx = fmaxf(mx, fmaxf(s0[r], s1[r]));
            mx = fmaxf(mx, __shfl_xor(mx, 32));
            const float mnew = fmaxf(m, mx * c);
            const float alpha = __builtin_amdgcn_exp2f(m - mnew);
            m = mnew;
            float ps = 0.f;
#pragma unroll
            for (int r = 0; r < 16; ++r) { s0[r] = __builtin_amdgcn_exp2f(s0[r] * c - mnew); s1[r] = __builtin_amdgcn_exp2f(s1[r] * c - mnew); ps += s0[r] + s1[r]; }
            l = l * alpha + ps;
            if ((PROBE_SUB >> 9) & 1u) {
                float ps2 = 0.f;
#pragma unroll
                for (int r = 0; r < 16; ++r) { float x0 = s0[r], x1 = s1[r]; asm volatile("" : "+v"(x0), "+v"(x1)); ps2 += __builtin_amdgcn_exp2f(x0 * c - 40.f) + __builtin_amdgcn_exp2f(x1 * c - 40.f); }
                float mx2 = ps2;
#pragma unroll
                for (int r = 0; r < 16; ++r) { float x0 = s0[r], x1 = s1[r]; asm volatile("" : "+v"(x0), "+v"(x1)); mx2 = fmaxf(mx2, fmaxf(x0 * c, x1 * c)); }
                if (mx2 == 123456.75f) l += ps2;
            }
            if ((PROBE_SUB >> 10) & 1u) {
                f32x16 sx;
#pragma unroll
                for (int r = 0; r < 16; ++r) sx[r] = 0.f;
#pragma unroll
                for (int s = 0; s < 12; ++s) { bf16x8 k0 = *(const bf16x8*)(kb + qi * MLA_KP + s * 32 + hh * 16); sx = MFMA32(k0, qf[s], sx); }
                if (sx[0] == 123456.75f) l += sx[1];
            }
#pragma unroll
            for (int d = 0; d < 4; ++d)
#pragma unroll
                for (int r = 0; r < 16; ++r) o[d][r] *= alpha;
            bf16x8 pf[4];
            { u32x4 p;
              p.x = cvtpk(s0[0], s0[1]); p.y = cvtpk(s0[2], s0[3]); p.z = cvtpk(s0[4], s0[5]); p.w = cvtpk(s0[6], s0[7]); pf[0] = __builtin_bit_cast(bf16x8, p);
              p.x = cvtpk(s0[8], s0[9]); p.y = cvtpk(s0[10], s0[11]); p.z = cvtpk(s0[12], s0[13]); p.w = cvtpk(s0[14], s0[15]); pf[1] = __builtin_bit_cast(bf16x8, p);
              p.x = cvtpk(s1[0], s1[1]); p.y = cvtpk(s1[2], s1[3]); p.z = cvtpk(s1[4], s1[5]); p.w = cvtpk(s1[6], s1[7]); pf[2] = __builtin_bit_cast(bf16x8, p);
              p.x = cvtpk(s1[8], s1[9]); p.y = cvtpk(s1[10], s1[11]); p.z = cvtpk(s1[12], s1[13]); p.w = cvtpk(s1[14], s1[15]); pf[3] = __builtin_bit_cast(bf16x8, p); }
            asm volatile("" ::: "memory");
            {
                const unsigned char* vp = vb + qi * MLA_VP + hh * 16;
                bf16x8 va[4], vn[4];
#pragma unroll
                for (int g = 0; g < 4; ++g) va[g] = *(const bf16x8*)(vp + g * 32);
#pragma unroll
                for (int d = 0; d < 4; ++d) {
                    if (d < 3) {
#pragma unroll
                        for (int g = 0; g < 4; ++g) vn[g] = *(const bf16x8*)(vp + (d + 1) * 32 * MLA_VP + g * 32); }
                    __builtin_amdgcn_sched_barrier(0);
#pragma unroll
                    for (int g = 0; g < 4; ++g) o[d] = MFMA32(va[g], pf[g], o[d]);
                    __builtin_amdgcn_sched_barrier(0);
#pragma unroll
                    for (int g = 0; g < 4; ++g) va[g] = vn[g];
                }
            }
            if (t + 1 < nt) MLA_COMMIT((t + 1) & 1);
            __syncthreads();
        }
        const float inv = 1.0f / (l + __shfl_xor(l, 32));
        bf16_t* op = mix + (size_t)qtok * D + h * 128 + 4 * hh;
#pragma unroll
        for (int d = 0; d < 4; ++d)
#pragma unroll
            for (int g = 0; g < 4; ++g) { u32x2 wv; wv.x = cvtpk(o[d][4 * g] * inv, o[d][4 * g + 1] * inv); wv.y = cvtpk(o[d][4 * g + 2] * inv, o[d][4 * g + 3] * inv);
                *(u32x2*)(op + d * 32 + 8 * g) = wv; }
#undef MLA_KTOK
#undef MLA_ISSUE
#undef MLA_ISSUE_K
#undef MLA_ISSUE_V
#undef MLA_COMMIT
    }
}

constexpr int HY_CS = 8224, HY_WS = 5136, HY_WOFF = 8 * HY_CS, HY_RBL = HY_WOFF + 4 * HY_WS;
static_assert(HY_RBL + 516 * 16 <= RING_BYTES, "hyena LDS");

__device__ __forceinline__ u32x4 hy_shift(const u32x4 a, const u32x4 b, int r) {
    switch (r) {
    case 0: return b;
    case 1: return (u32x4){__builtin_amdgcn_alignbyte(b.x, a.w, 2), __builtin_amdgcn_alignbyte(b.y, b.x, 2), __builtin_amdgcn_alignbyte(b.z, b.y, 2), __builtin_amdgcn_alignbyte(b.w, b.z, 2)};
    case 2: return (u32x4){a.w, b.x, b.y, b.z};
    case 3: return (u32x4){__builtin_amdgcn_alignbyte(a.w, a.z, 2), __builtin_amdgcn_alignbyte(b.x, a.w, 2), __builtin_amdgcn_alignbyte(b.y, b.x, 2), __builtin_amdgcn_alignbyte(b.z, b.y, 2)};
    case 4: return (u32x4){a.z, a.w, b.x, b.y};
    case 5: return (u32x4){__builtin_amdgcn_alignbyte(a.z, a.y, 2), __builtin_amdgcn_alignbyte(a.w, a.z, 2), __builtin_amdgcn_alignbyte(b.x, a.w, 2), __builtin_amdgcn_alignbyte(b.y, b.x, 2)};
    case 6: return (u32x4){a.y, a.z, a.w, b.x};
    default: return (u32x4){__builtin_amdgcn_alignbyte(a.y, a.x, 2), __builtin_amdgcn_alignbyte(a.z, a.y, 2), __builtin_amdgcn_alignbyte(a.w, a.z, 2), __builtin_amdgcn_alignbyte(b.x, a.w, 2)};
    }
}

__device__ __forceinline__ void ph_hyena(const Args& a, int l, unsigned char* lds) {
    const bf16_t* __restrict__ RB = (const bf16_t*)(a.ws + WS_FILTL) + (size_t)l * 512 * HY_RBROW;
    const bf16_t* __restrict__ wtl = (const bf16_t*)(a.ws + WS_WTL);
    int tid_ = threadIdx.x; asm volatile("" : "+v"(tid_));
    const int tid = tid_, lane = tid & 63, w = __builtin_amdgcn_readfirstlane(tid >> 6), i = lane & 31, hh = lane >> 5;
    for (int unit = blockIdx.x; unit < 512; unit += gridDim.x) {
        const int c = unit;
        for (int k = tid; k < 515; k += NTHR) { u32x4 v = (u32x4){0u, 0u, 0u, 0u}; if (k < 513) v = *(const u32x4*)(RB + (size_t)c * HY_RBROW + k * 8); *(u32x4*)(lds + HY_RBL + k * 16) = v; }
        for (int k = tid; k < 4 * 321; k += NTHR) { const int b = k / 321, sl = k - b * 321; u32x4 v = (u32x4){0u, 0u, 0u, 0u};
            if (sl >= 28 && sl < 284) v = *(const u32x4*)(wtl + ((size_t)b * 512 + c) * L + (sl - 28) * 8);
            *(u32x4*)(lds + HY_WOFF + b * HY_WS + sl * 16) = v; }
        __syncthreads();
        for (int qs = lane; qs < 511; qs += 64) {
            const u32x4 ca = *(const u32x4*)(lds + HY_RBL + qs * 16), cb = *(const u32x4*)(lds + HY_RBL + qs * 16 + 16);
            *(u32x4*)(lds + w * HY_CS + qs * 16) = hy_shift(ca, cb, w);
        }
        __syncthreads();
        f32x16 acc0, acc1;
#pragma unroll
        for (int r = 0; r < 16; ++r) { acc0[r] = 0.f; acc1[r] = 0.f; }
        const int Tl = i >> 2, b = i & 3;
        const unsigned char* ap = lds + (i & 7) * HY_CS + (hh - (i >> 3) + 255) * 16;
        const unsigned char* bp = lds + HY_WOFF + b * HY_WS + (224 + 16 * (2 * (8 * w + Tl)) + 8 * hh) * 2;
        const int d0 = 16 * w - 127;
#pragma unroll 2
        for (int dd = 0; dd < 142; dd += 2) {
            const int d = d0 + dd;
            const bf16x8 a0 = *(const bf16x8*)(ap - 32 * d), b0 = *(const bf16x8*)(bp - 32 * d);
            const bf16x8 a1 = *(const bf16x8*)(ap - 32 * (d + 1)), b1 = *(const bf16x8*)(bp - 32 * (d + 1));
            acc0 = MFMA32(a0, b0, acc0); acc1 = MFMA32(a1, b1, acc1);
        }
        bf16_t* yt = (bf16_t*)(a.ws + WS_YT) + ((size_t)b * 512 + c) * L + 32 * (8 * w + Tl) + 4 * hh;
#pragma unroll
        for (int g = 0; g < 4; ++g) { u32x2 wv; wv.x = cvtpk(acc0[4 * g] + acc1[4 * g], acc0[4 * g + 1] + acc1[4 * g + 1]); wv.y = cvtpk(acc0[4 * g + 2] + acc1[4 * g + 2], acc0[4 * g + 3] + acc1[4 * g + 3]);
            *(u32x2*)(yt + 8 * g) = wv; }
        __syncthreads();
    }
}

__device__ __forceinline__ void ph_hyena_fin(const Args& a, int l, bool with_ctx, unsigned char* lds) {
    const bf16_t* __restrict__ YT = (const bf16_t*)(a.ws + WS_YT); const bf16_t* __restrict__ wtl = (const bf16_t*)(a.ws + WS_WTL); const bf16_t* __restrict__ wtc = (const bf16_t*)(a.ws + WS_WTC);
    const bf16_t* __restrict__ x0 = (const bf16_t*)(a.ws + WS_X0); const float* skip = a.in[23] + l * 512; bf16_t* __restrict__ mix = (bf16_t*)(a.ws + WS_MIX);
    int tid_ = threadIdx.x; asm volatile("" : "+v"(tid_));
    const int tid = tid_;
    bf16_t* T = (bf16_t*)lds;
    constexpr int TP = 520;
    const int nunits = with_ctx ? 144 : 128;
    for (int unit = (int)gridDim.x - 1 - (int)blockIdx.x; unit < nunits; unit += gridDim.x) {
        const bool lat = unit < 128; const int b = lat ? (unit >> 5) : ((unit - 128) >> 2), t0 = lat ? (unit & 31) * 64 : ((unit - 128) & 3) * 64;
        const int Ls = lat ? L : C; const int tok0 = lat ? b * L + t0 : NLAT + b * C + t0;
        const bf16_t* yrow = (lat ? YT : YT + (size_t)NB * 512 * L) + ((size_t)b * 512 + tid) * Ls + t0;
        const bf16_t* wrow = (lat ? wtl : wtc) + ((size_t)b * 512 + tid) * Ls + t0;
        const float sk = skip[tid];
#pragma unroll
        for (int hf = 0; hf < 2; ++hf) {
            u32x4 yv[4], wv[4];
#pragma unroll
            for (int q = 0; q < 4; ++q) { yv[q] = *(const u32x4*)(yrow + hf * 32 + q * 8); wv[q] = *(const u32x4*)(wrow + hf * 32 + q * 8); }
#pragma unroll
            for (int q = 0; q < 4; ++q) { const unsigned yy[4] = {yv[q].x, yv[q].y, yv[q].z, yv[q].w}, ww[4] = {wv[q].x, wv[q].y, wv[q].z, wv[q].w};
#pragma unroll
                for (int d = 0; d < 4; ++d) { const int t = hf * 32 + q * 8 + 2 * d;
                    T[t * TP + tid] = f2bf(__uint_as_float(yy[d] << 16) + sk * __uint_as_float(ww[d] << 16));
                    T[(t + 1) * TP + tid] = f2bf(__uint_as_float(yy[d] & 0xffff0000u) + sk * __uint_as_float(ww[d] & 0xffff0000u)); } }
        }
        __syncthreads();
#pragma unroll
        for (int j = 0; j < 8; ++j) { const int o = tid + 512 * j, t = o >> 6, cc = (o & 63) * 8;
            const u32x4 tv = *(const u32x4*)(T + t * TP + cc), xv = *(const u32x4*)(x0 + (size_t)(tok0 + t) * 512 + cc);
            const unsigned tt[4] = {tv.x, tv.y, tv.z, tv.w}, xx[4] = {xv.x, xv.y, xv.z, xv.w}; unsigned oo[4];
#pragma unroll
            for (int d = 0; d < 4; ++d) oo[d] = cvtpk(__uint_as_float(tt[d] << 16) * __uint_as_float(xx[d] << 16), __uint_as_float(tt[d] & 0xffff0000u) * __uint_as_float(xx[d] & 0xffff0000u));
            *(u32x4*)(mix + (size_t)(tok0 + t) * D + 1024 + cc) = (u32x4){oo[0], oo[1], oo[2], oo[3]}; }
        __syncthreads();
    }
}

constexpr int SWA_P = 144, SWA_KB = 64 * SWA_P, SWA_STAGE = 2 * SWA_KB;
__device__ __forceinline__ void ph_swa(const Args& a, int l, bool with_ctx, unsigned char* lds) {
    const bf16_t* __restrict__ SQ = (const bf16_t*)(a.ws + WS_SQ); const bf16_t* __restrict__ SK = (const bf16_t*)(a.ws + WS_SK); const bf16_t* __restrict__ SVT = (const bf16_t*)(a.ws + WS_SV);
    const float* sink = a.in[24] + l * 8; bf16_t* __restrict__ mix = (bf16_t*)(a.ws + WS_MIX);
    int tid_ = threadIdx.x; asm volatile("" : "+v"(tid_));
    const int tid = tid_, lane = tid & 63, w = tid >> 6, qi = lane & 31, hh = lane >> 5;
    const int nunits = with_ctx ? 288 : 256;
    const float c = 0.125f * 1.4426950408889634f;
    for (int unit = blockIdx.x; unit < nunits; unit += gridDim.x) {
        int hk, b, p0, nloc, t0loc, q0tok; bool ctxq;
        if (unit < 256) { hk = unit & 1; b = (unit >> 1) & 3; p0 = (unit >> 3) * 64; ctxq = false; q0tok = b * L + p0;
            const int lo = p0 - 128 < 0 ? 0 : p0 - 128, hi = p0 + 192 > L ? L : p0 + 192; t0loc = lo; nloc = (hi - lo) >> 6; }
        else { const int u2 = unit - 256; hk = u2 & 1; b = (u2 >> 1) & 3; p0 = (u2 >> 3) * 64; ctxq = true; q0tok = NLAT + b * C + p0; t0loc = 0; nloc = 0; }
        const int nt = nloc + 4;
#define SWA_KTOK(t) ((t) < nloc ? (b * L + t0loc + (t) * 64) : (NLAT + b * C + ((t) - nloc) * 64))
        u32x4 r0, r1;
#define SWA_ISSUE(t) do { const int kt0_ = SWA_KTOK(t); \
            r0 = *(const u32x4*)(SK + (size_t)(kt0_ + (tid >> 3)) * 128 + hk * 64 + (tid & 7) * 8); \
            r1 = *(const u32x4*)(SVT + (size_t)(hk * 64 + (tid >> 3)) * NTOK + kt0_ + (tid & 7) * 8); } while (0)
#define SWA_COMMIT(buf) do { unsigned char* kb_ = lds + (buf) * SWA_STAGE; unsigned char* vb_ = kb_ + SWA_KB; \
            *(u32x4*)(kb_ + (tid >> 3) * SWA_P + (tid & 7) * 16) = r0; \
            const int g_ = (tid & 7) >> 1, e_ = tid & 1; u32x2 lo_, hi_; lo_.x = r1.x; lo_.y = r1.y; hi_.x = r1.z; hi_.y = r1.w; \
            *(u32x2*)(vb_ + (tid >> 3) * SWA_P + g_ * 32 + e_ * 8) = lo_; *(u32x2*)(vb_ + (tid >> 3) * SWA_P + g_ * 32 + 16 + e_ * 8) = hi_; } while (0)
        const int hq = hk * 4 + (w >> 1), qpos = p0 + (w & 1) * 32 + qi, qtok = q0tok + (w & 1) * 32 + qi;
        bf16x8 qf[4];
#pragma unroll
        for (int s = 0; s < 4; ++s) qf[s] = *(const bf16x8*)(SQ + (size_t)qtok * 512 + hq * 64 + s * 16 + hh * 8);
        f32x16 o[2];
#pragma unroll
        for (int d = 0; d < 2; ++d)
#pragma unroll
            for (int r = 0; r < 16; ++r) o[d][r] = 0.f;
        float m = sink[hq] * 1.4426950408889634f, lsum = hh == 0 ? 1.0f : 0.0f;
        SWA_ISSUE(0); SWA_COMMIT(0);
        __syncthreads();
        for (int t = 0; t < nt; ++t) {
            const unsigned char* kb = lds + (t & 1) * SWA_STAGE; const unsigned char* vb = kb + SWA_KB;
            f32x16 s0, s1;
#pragma unroll
            for (int r = 0; r < 16; ++r) { s0[r] = 0.f; s1[r] = 0.f; }
#pragma unroll
            for (int s = 0; s < 4; ++s) {
                const bf16x8 k0 = *(const bf16x8*)(kb + qi * SWA_P + s * 32 + hh * 16);
                const bf16x8 k1 = *(const bf16x8*)(kb + (32 + qi) * SWA_P + s * 32 + hh * 16);
                s0 = MFMA32(k0, qf[s], s0); s1 = MFMA32(k1, qf[s], s1);
            }
            if (t + 1 < nt) SWA_ISSUE(t + 1);
            if (t < nloc) {
                const int kbase = t0loc + t * 64 + 4 * hh - qpos;
#pragma unroll
                for (int r = 0; r < 16; ++r) { const int dlt = kbase + (r & 3) + 8 * (r >> 2);
                    if (dlt > 128 || dlt < -128) s0[r] = -1.0e30f;
                    if (dlt + 32 > 128 || dlt + 32 < -128) s1[r] = -1.0e30f; }
            }
            float mx = fmaxf(s0[0], s1[0]);
#pragma unroll
            for (int r = 1; r < 16; ++r) mx = fmaxf(mx, fmaxf(s0[r], s1[r]));
            mx = fmaxf(mx, __shfl_xor(mx, 32));
            const float mnew = fmaxf(m, mx * c);
            const float alpha = __builtin_amdgcn_exp2f(m - mnew);
            m = mnew;
            float ps = 0.f;
#pragma unroll
            for (int r = 0; r < 16; ++r) { s0[r] = __builtin_amdgcn_exp2f(s0[r] * c - mnew); s1[r] = __builtin_amdgcn_exp2f(s1[r] * c - mnew); ps += s0[r] + s1[r]; }
            lsum = lsum * alpha + ps;
#pragma unroll
            for (int d = 0; d < 2; ++d)
#pragma unroll
                for (int r = 0; r < 16; ++r) o[d][r] *= alpha;
            bf16x8 pf[4];
            { u32x4 p;
              p.x = cvtpk(s0[0], s0[1]); p.y = cvtpk(s0[2], s0[3]); p.z = cvtpk(s0[4], s0[5]); p.w = cvtpk(s0[6], s0[7]); pf[0] = __builtin_bit_cast(bf16x8, p);
              p.x = cvtpk(s0[8], s0[9]); p.y = cvtpk(s0[10], s0[11]); p.z = cvtpk(s0[12], s0[13]); p.w = cvtpk(s0[14], s0[15]); pf[1] = __builtin_bit_cast(bf16x8, p);
              p.x = cvtpk(s1[0], s1[1]); p.y = cvtpk(s1[2], s1[3]); p.z = cvtpk(s1[4], s1[5]); p.w = cvtpk(s1[6], s1[7]); pf[2] = __builtin_bit_cast(bf16x8, p);
              p.x = cvtpk(s1[8], s1[9]); p.y = cvtpk(s1[10], s1[11]); p.z = cvtpk(s1[12], s1[13]); p.w = cvtpk(s1[14], s1[15]); pf[3] = __builtin_bit_cast(bf16x8, p); }
#pragma unroll
            for (int d = 0; d < 2; ++d)
#pragma unroll
                for (int g = 0; g < 4; ++g) {
                    const bf16x8 vf = *(const bf16x8*)(vb + (d * 32 + qi) * SWA_P + g * 32 + hh * 16);
                    o[d] = MFMA32(vf, pf[g], o[d]);
                }
            if (t + 1 < nt) SWA_COMMIT((t + 1) & 1);
            __syncthreads();
        }
        const float inv = 1.0f / (lsum + __shfl_xor(lsum, 32));
        bf16_t* op = mix + (size_t)qtok * D + 1536 + hq * 64 + 4 * hh;
#pragma unroll
        for (int d = 0; d < 2; ++d)
#pragma unroll
            for (int g = 0; g < 4; ++g) { u32x2 wv; wv.x = cvtpk(o[d][4 * g] * inv, o[d][4 * g + 1] * inv); wv.y = cvtpk(o[d][4 * g + 2] * inv, o[d][4 * g + 3] * inv);
                *(u32x2*)(op + d * 32 + 8 * g) = wv; }
#undef SWA_KTOK
#undef SWA_ISSUE
#undef SWA_COMMIT
    }
}


constexpr int NPHASES = 22;
#define GEMM_CALL(EPI, SCHED, g, S, E) pg8::gemm_phase<EPI, SCHED, true, true, 0>((PG8_LAS unsigned char*)lds, g, S, E)
#define GEMM_CALL8(EPI, SCHED, g, S, E) pg8::gemm_phase<EPI, SCHED, true, true, 1>((PG8_LAS unsigned char*)lds, g, S, E)
#define GEMM_CALLI8(EPI, SCHED, g, S, E) pg8::gemm_phase<EPI, SCHED, true, true, 2>((PG8_LAS unsigned char*)lds, g, S, E)

template <int LYR>
__device__ __forceinline__ void layer_phases(const Args& a, unsigned char* lds, const XcdBarrier& bar, int lo, int hi) {
#define IN(k) (lo <= (k) && (k) < hi)
#define REPS(k) for (int rep_ = 0; rep_ <= (int)((PROBE_MASK >> (k)) & 1u); ++rep_)
#if MK_PER_PHASE
#define SEAM(k) do { } while (0)
#else
#define SEAM(k) do { if (IN(k) && IN((k) + 1)) xcd_barrier(bar); } while (0)
#endif
    constexpr int P0 = 1 + LYR * 9;
    constexpr bool LAST = (LYR == 1);
    constexpr int S_WO = pg8::split_S((LAST ? NLAT : NTOK) / 256 * (D / 256), D / 64, 256);
    constexpr int S_WO0 = pg8::split_S(NTOK / 256 * (D / 256), D / 64, 256);
    constexpr int S_DN0 = pg8::split_S(NTOK / 256 * (D / 256), (FP8_DENSE || FP8_DOWN) ? DFF / 128 : DFF / 64, 256);
    constexpr int S_DN = pg8::split_S(NTOK / 256 * (D / 256), (FP8_DENSE || FP8_DOWN) ? DFF / 128 : DFF / 64, 256);
    const int G = gridDim.x, bid = blockIdx.x;
    unsigned char* ws = a.ws;
    const float* modl = (const float*)(ws + WS_MOD) + (size_t)LYR * 5 * 12288;
    float* xs = (float*)(ws + WS_XS);
    const int nq = LAST ? NLAT : NTOK;
    if (IN(P0 + 0)) REPS(P0 + 0) {
        if (LYR == 0) ph_normmod<false, false, I8_WIN ? 2 : 0>(a.in[0], a.in[2], a.in[6], modl, 0, 2048, (bf16_t*)(ws + WS_HA), NTOK, nullptr, nullptr, nullptr, nullptr, nullptr, nullptr, (float*)(ws + WS_RSC));
        else ph_normmod<false, false, I8_WIN ? 2 : 0, S_DN0>(xs, xs + (size_t)NLAT * D, a.in[6] + D, modl, 0, 2048, (bf16_t*)(ws + WS_HA), NTOK, nullptr, nullptr, nullptr, nullptr,
                                                    (const float*)(ws + WS_SLAB), (const float*)(ws + WS_MOD) + (size_t)4 * 12288 + 10240, (float*)(ws + WS_RSC));
    }
    SEAM(P0 + 0);
    if (IN(P0 + 1)) REPS(P0 + 1) {
#if I8_WIN
        pg8::Gemm g{(const bf16_t*)(ws + WS_HA), (const bf16_t*)(ws + WS_WIN + (size_t)LYR * UW * D * 2), NTOK, UW, D / 2};
        const float swin = __uint_as_float(__hip_atomic_load((const unsigned*)(ws + WS_CTL) + CT_WSC + LYR, __ATOMIC_RELAXED, __HIP_MEMORY_SCOPE_AGENT)) * (1.0f / 127.0f);
        pg8::EpiStoreI8 E{(bf16_t*)(ws + WS_U), UW, (const float*)(ws + WS_RSC), swin};
        if constexpr (LAST) { pg8::WinLastOrder S; S.init(G, bid, D / 2); GEMM_CALLI8(pg8::EpiStoreI8, pg8::WinLastOrder, g, S, E); }
        else { pg8::StaticOrder S; S.init(NTOK, UW, G, bid, D / 2); GEMM_CALLI8(pg8::EpiStoreI8, pg8::StaticOrder, g, S, E); }
#else
        pg8::Gemm g{(const bf16_t*)(ws + WS_HA), (const bf16_t*)(ws + WS_WIN + (size_t)LYR * UW * D * 2), NTOK, UW, D};
        pg8::EpiStore E{(bf16_t*)(ws + WS_U), UW};
        if constexpr (LAST) { pg8::WinLastOrder S; S.init(G, bid, D); GEMM_CALL(pg8::EpiStore, pg8::WinLastOrder, g, S, E); }
        else { pg8::StaticOrder S; S.init(NTOK, UW, G, bid, D); GEMM_CALL(pg8::EpiStore, pg8::StaticOrder, g, S, E); }
#endif
        if (!LAST && rep_ == 0 && G == 256 && bid >= TAIL1_BLK0 && TAILQ1 > 0) ph_convert<0>(a, (float*)lds, NCONV_Q + (bid - TAIL1_BLK0) * TAILQ1, 1, NCONV_Q + (bid - TAIL1_BLK0 + 1) * TAILQ1);
        conv_fill(a, (float*)lds, LYR * 6 + 0);
    }
    SEAM(P0 + 1);
    if (IN(P0 + 2)) REPS(P0 + 2) ph_mid(a, LYR);
    SEAM(P0 + 2);
    if (IN(P0 + 3)) REPS(P0 + 3) {
        SUBREP(0) {
        { pg8::Gemm g{(const bf16_t*)(ws + WS_CQN), (const bf16_t*)(ws + WS_WQ + (size_t)LYR * QW * 768 * 2), nq, QW, 768};
          pg8::StaticOrder S; S.init(nq, QW, G, bid, 768); pg8::EpiQ E{(bf16_t*)(ws + WS_Q), (const float*)(ws + WS_ROPE), (const float*)(ws + WS_ROPE) + 2048 * 32};
          GEMM_CALL(pg8::EpiQ, pg8::StaticOrder, g, S, E); }
        __syncthreads();
        { pg8::Gemm g{(const bf16_t*)(ws + WS_CKVN), (const bf16_t*)(ws + WS_WKV + (size_t)LYR * KVW * 512 * 2), NTOK, 1024, 512};
          pg8::StaticOrder S; S.init(NTOK, 1024, G, bid, 512); pg8::EpiStore E{(bf16_t*)(ws + WS_KN), 1024};
          GEMM_CALL(pg8::EpiStore, pg8::StaticOrder, g, S, E); }
        __syncthreads();
        { pg8::Gemm g{(const bf16_t*)(ws + WS_WKV + (size_t)LYR * KVW * 512 * 2 + (size_t)1024 * 512 * 2), (const bf16_t*)(ws + WS_CKVN), 1024, NTOK, 512};
          pg8::StaticOrder S; S.init(1024, NTOK, 108, bid >= 216 ? bid - 216 : (bid >= 144 ? bid - 108 : (1 << 24)), 512); pg8::EpiStore E{(bf16_t*)(ws + WS_VT), NTOK};
          GEMM_CALL(pg8::EpiStore, pg8::StaticOrder, g, S, E); }
        __syncthreads();
        }
        SUBREP(1) ph_hyena(a, LYR, lds);
        SUBREP(3) if (!LAST) ph_hyena_naive<C>(a, LYR, (float*)lds);
        SUBREP(2) ph_swa(a, LYR, !LAST, lds);
        conv_fill(a, (float*)lds, LYR * 6 + 1);
    }
    SEAM(P0 + 3);
    if (IN(P0 + 4)) REPS(P0 + 4) { ph_hyena_fin(a, LYR, !LAST, lds); ph_mla(a, !LAST, lds);
        if (!LAST && rep_ == 0 && G == 256 && bid >= TAIL4_BLK0 && TAILQ4 > 0) ph_convert<0>(a, (float*)lds, NCONV_Q + NCONV_T1 + NCONV_T2 + NCONV_T3 + (bid - TAIL4_BLK0) * TAILQ4, 1, NCONV_Q + NCONV_T1 + NCONV_T2 + NCONV_T3 + (bid - TAIL4_BLK0 + 1) * TAILQ4); conv_fill(a, (float*)lds, LYR * 6 + 2); }
    SEAM(P0 + 4);
    if (IN(P0 + 5)) REPS(P0 + 5) {
        pg8::Gemm g{(const bf16_t*)(ws + WS_MIX), (const bf16_t*)(ws + WS_WOUT + (size_t)LYR * D * D * 2), nq, D, D};
        pg8::SplitOrder S; S.init(nq / 256, D / 256, G, bid, D, S_WO);
        const int trow0 = S.nfull / S.nN * 256; pg8::EpiResid E{rep_ ? (float*)(ws + WS_ACT) : xs, LYR == 0 ? a.in[0] : (const float*)xs, modl + 4096, (float*)(ws + WS_SLAB), trow0, nq - trow0, 1.0f};
        GEMM_CALL(pg8::EpiResid, pg8::SplitOrder, g, S, E);
        conv_fill(a, (float*)lds, LYR * 6 + 3);
    }
    SEAM(P0 + 5);
    if (!LAST) {
#if !FP8_DENSE
        if (IN(P0 + 6)) { ph_normmod<false, true, I8_GU ? 2 : 0, S_WO0>(xs, a.in[2], a.in[7], modl, 6144, 8192, (bf16_t*)(ws + WS_HA), NTOK, xs, nullptr, nullptr, nullptr, (const float*)(ws + WS_SLAB), modl + (size_t)4 * 12288 + 4096, (float*)(ws + WS_RSC));
            conv_finish(a, (float*)lds, CONV_DENSE_END); }
        SEAM(P0 + 6);
        if (IN(P0 + 7)) REPS(P0 + 7) {
#if I8_GU
            pg8::Gemm g{(const bf16_t*)(ws + WS_HA), (const bf16_t*)(ws + WS_WGU), NTOK, 2 * DFF, D / 2};
            pg8::StaticOrder S; S.init(NTOK, 2 * DFF, G, bid, D / 2);
            const float swg = __uint_as_float(__hip_atomic_load((const unsigned*)(ws + WS_CTL) + CT_WSC + 2, __ATOMIC_RELAXED, __HIP_MEMORY_SCOPE_AGENT)) * (1.0f / 127.0f);
            const float swu = __uint_as_float(__hip_atomic_load((const unsigned*)(ws + WS_CTL) + CT_WSC + 3, __ATOMIC_RELAXED, __HIP_MEMORY_SCOPE_AGENT)) * (1.0f / 127.0f);
            pg8::EpiSwiGLUI8 E{(unsigned char*)(ws + WS_ACT), DFF, (const float*)(ws + WS_RSC), swg, swu, ASCALE};
            GEMM_CALLI8(pg8::EpiSwiGLUI8, pg8::StaticOrder, g, S, E);
            if (rep_ == 0 && G == 256 && bid >= TAIL2_BLK0 && TAILQ2 > 0) ph_convert<0>(a, (float*)lds, NCONV_Q + NCONV_T1 + (bid - TAIL2_BLK0) * TAILQ2, 1, NCONV_Q + NCONV_T1 + (bid - TAIL2_BLK0 + 1) * TAILQ2);
#elif FP8_DOWN
            pg8::Gemm g{(const bf16_t*)(ws + WS_HA), (const bf16_t*)(ws + WS_WGU), NTOK, 2 * DFF, D};
            pg8::StaticOrder S; S.init(NTOK, 2 * DFF, G, bid, D);
            pg8::EpiSwiGLU8 E{(unsigned char*)(ws + WS_ACT), DFF, 1.0f, ASCALE};
            GEMM_CALL(pg8::EpiSwiGLU8, pg8::StaticOrder, g, S, E);
#else
            pg8::Gemm g{(const bf16_t*)(ws + WS_HA), (const bf16_t*)(ws + WS_WGU), NTOK, 2 * DFF, D};
            pg8::StaticOrder S; S.init(NTOK, 2 * DFF, G, bid, D);
            pg8::EpiSwiGLU E{(bf16_t*)(ws + WS_ACT), DFF};
            GEMM_CALL(pg8::EpiSwiGLU, pg8::StaticOrder, g, S, E);
#endif
            conv_fill(a, (float*)lds, 4);
        }
        SEAM(P0 + 7);
        if (IN(P0 + 8)) REPS(P0 + 8) {
#if FP8_DOWN
            pg8::Gemm g{(const bf16_t*)(ws + WS_ACT), (const bf16_t*)(ws + WS_WDN), NTOK, D, DFF / 2};
            pg8::SplitOrder S; S.init(NTOK / 256, D / 256, G, bid, DFF / 2, S_DN);
            const int trow0 = S.nfull / S.nN * 256; pg8::EpiResid E{rep_ ? (float*)(ws + WS_YS) : xs, (const float*)xs, modl + 10240, (float*)(ws + WS_SLAB), trow0, NTOK - trow0, 1.0f / (ASCALE * WSCALE)};
            GEMM_CALL8(pg8::EpiResid, pg8::SplitOrder, g, S, E);
            if (rep_ == 0 && G == 256 && bid >= TAIL3_BLK0 && TAILQ3 > 0) ph_convert<0>(a, (float*)lds, NCONV_Q + NCONV_T1 + NCONV_T2 + (bid - TAIL3_BLK0) * TAILQ3, 1, NCONV_Q + NCONV_T1 + NCONV_T2 + (bid - TAIL3_BLK0 + 1) * TAILQ3);
#else
            pg8::Gemm g{(const bf16_t*)(ws + WS_ACT), (const bf16_t*)(ws + WS_WDN), NTOK, D, DFF};
            pg8::SplitOrder S; S.init(NTOK / 256, D / 256, G, bid, DFF, S_DN);
            const int trow0 = S.nfull / S.nN * 256; pg8::EpiResid E{rep_ ? (float*)(ws + WS_YS) : xs, (const float*)xs, modl + 10240, (float*)(ws + WS_SLAB), trow0, NTOK - trow0, 1.0f};
            GEMM_CALL(pg8::EpiResid, pg8::SplitOrder, g, S, E);
#endif
            conv_fill(a, (float*)lds, 5);
        }
#else
        if (IN(P0 + 6)) { ph_normmod<false, true, true, S_WO0>(xs, a.in[2], a.in[7], modl, 6144, 8192, (bf16_t*)(ws + WS_HA), NTOK, xs, nullptr, nullptr, nullptr, (const float*)(ws + WS_SLAB), modl + (size_t)4 * 12288 + 4096);
            conv_finish(a, (float*)lds, CONV_DENSE_END); }
        SEAM(P0 + 6);
        if (IN(P0 + 7)) REPS(P0 + 7) {
            pg8::Gemm g{(const bf16_t*)(ws + WS_HA), (const bf16_t*)(ws + WS_WGU), NTOK, 2 * DFF, D / 2};
            pg8::StaticOrder S; S.init(NTOK, 2 * DFF, G, bid, D / 2); pg8::EpiSwiGLU8 E{(unsigned char*)(ws + WS_ACT), DFF, 1.0f / (ASCALE * WSCALE), ASCALE};
            GEMM_CALL8(pg8::EpiSwiGLU8, pg8::StaticOrder, g, S, E);
            conv_fill(a, (float*)lds, 4);
        }
        SEAM(P0 + 7);
        if (IN(P0 + 8)) REPS(P0 + 8) {
            pg8::Gemm g{(const bf16_t*)(ws + WS_ACT), (const bf16_t*)(ws + WS_WDN), NTOK, D, DFF / 2};
            pg8::SplitOrder S; S.init(NTOK / 256, D / 256, G, bid, DFF / 2, S_DN);
            const int trow0 = S.nfull / S.nN * 256; pg8::EpiResid E{rep_ ? (float*)(ws + WS_YS) : xs, (const float*)xs, modl + 10240, (float*)(ws + WS_SLAB), trow0, NTOK - trow0, 1.0f / (ASCALE * WSCALE)};
            GEMM_CALL8(pg8::EpiResid, pg8::SplitOrder, g, S, E);
            conv_fill(a, (float*)lds, 5);
        }
#endif
        SEAM(P0 + 8);
    } else {
        if (IN(P0 + 6)) REPS(P0 + 6) ph_normmod<true, false, true>(xs, xs + (size_t)NLAT * D, a.in[7] + D, modl, 6144, 8192, (bf16_t*)(ws + WS_HA), NLAT, nullptr, a.in[29], (int*)(ws + WS_TOPI), (float*)(ws + WS_TOPW));
        SEAM(P0 + 6);
        if (IN(P0 + 7)) REPS(P0 + 7) { ph_route_gather(a, (int*)lds); conv_finish(a, (float*)lds, NCONV); }
        SEAM(P0 + 7);
        if (IN(P0 + 9)) REPS(P0 + 9) {
            pg8::Gemm g{(const bf16_t*)(ws + WS_HBS), (const bf16_t*)(ws + WS_MGU), MOE_ROWS, 2 * DFE, D / 2};
            pg8::MoeOrder S; S.init((const int*)(ws + WS_CTL), 2 * DFE / 256, G, bid, (size_t)2 * DFE * D, D / 2); pg8::EpiSwiGLU8 E{(unsigned char*)(ws + WS_ACT), DFE, 1.0f / (ASCALE * WSCALE), ASCALE};
            GEMM_CALL8(pg8::EpiSwiGLU8, pg8::MoeOrder, g, S, E);
        }
        SEAM(P0 + 9);
        if (IN(P0 + 10)) REPS(P0 + 10) {
            pg8::Gemm g{(const bf16_t*)(ws + WS_ACT), (const bf16_t*)(ws + WS_MDN), MOE_ROWS, D, DFE / 2};
            pg8::SplitOrder S; S.init_moe((const int*)(ws + WS_CTL), D / 256, G, bid, DFE / 2, (size_t)D * DFE);
            const int trow0 = S.nfull / S.nN * 256; pg8::EpiYs E{(bf16_t*)(ws + WS_YS), (float*)(ws + WS_SLAB), trow0, S.nM * 256 - trow0, 1.0f / (ASCALE * WSCALE)};
            GEMM_CALL8(pg8::EpiYs, pg8::SplitOrder, g, S, E);
        }
        SEAM(P0 + 10);
        if (IN(P0 + 11)) REPS(P0 + 11) ph_final(a);
    }
#undef IN
#undef SEAM
#undef REPS
}

__global__ void __launch_bounds__(NTHR, 2) mk_fwd(Args a) {
    extern __shared__ __attribute__((aligned(16))) unsigned char lds[];
    const int tid = threadIdx.x;
    for (int u = tid; u < (LDS_BYTES - LDSCTL_OFF) / 4; u += NTHR) ((unsigned*)(lds + LDSCTL_OFF))[u] = 0u;
    __syncthreads();
    XcdBarrier bar; bar.bar = (unsigned*)(a.ws + WS_CTL) + CW_BAR; bar.x = 0; bar.st = nullptr;
#if !MK_PER_PHASE
    bar = xcd_barrier_post((unsigned*)(a.ws + WS_CTL) + CW_BAR, (volatile LAS unsigned*)(lds + LDSCTL_OFF + 32));
#endif
    const int lo = a.ph_lo, hi = a.ph_hi;
    if (lo <= 0 && 0 < hi) {
        for (int rep_ = 0; rep_ <= (int)(PROBE_MASK & 1u); ++rep_) { ph_prologue(a, (float*)lds); __syncthreads(); }
#if !MK_PER_PHASE
        if (1 < hi) xcd_barrier(bar);
#endif
    }
    layer_phases<0>(a, lds, bar, lo, hi);
    layer_phases<1>(a, lds, bar, lo, hi);
}

extern "C" void kernel_launch(void* const* d_in, const int* in_sizes, int n_in, void* d_out, int out_size, void* d_ws, size_t ws_size, hipStream_t stream) {
    (void)in_sizes; (void)out_size;
    static int grid = 0;
    if (grid == 0) {
        if (n_in != 34 || ws_size < WS_END) { fprintf(stderr, "kernel_launch: need 34 inputs and >= %zu bytes of workspace (got %d, %zu)\n", (size_t)WS_END, n_in, ws_size); grid = -1; return; }
        int dev = 0, cus = 0, per_cu = 0;
        if (hipGetDevice(&dev) != hipSuccess || hipDeviceGetAttribute(&cus, hipDeviceAttributeMultiprocessorCount, dev) != hipSuccess) { grid = -1; return; }
        if (hipFuncSetAttribute((const void*)mk_fwd, hipFuncAttributeMaxDynamicSharedMemorySize, LDS_BYTES) != hipSuccess) { fprintf(stderr, "kernel_launch: hipFuncSetAttribute failed\n"); grid = -1; return; }
        if (hipOccupancyMaxActiveBlocksPerMultiprocessor(&per_cu, (const void*)mk_fwd, NTHR, LDS_BYTES) != hipSuccess || per_cu < 1) { fprintf(stderr, "kernel_launch: occupancy query says %d blocks per CU\n", per_cu); }
        (void)hipGetLastError();
        grid = cus;
    }
    if (grid < 0) return;
    if (hipMemsetAsync((char*)d_ws + WS_CTL, 0, CTL_ZERO_BYTES, stream) != hipSuccess) return;
    Args a{};
    for (int i = 0; i < 34; ++i) a.in[i] = (const float*)d_in[i];
    a.out = (float*)d_out; a.ws = (unsigned char*)d_ws;
#if MK_PER_PHASE
    for (int p = 0; p < NPHASES; ++p) { a.ph_lo = p; a.ph_hi = p + 1; hipLaunchKernelGGL(mk_fwd, dim3(grid), dim3(NTHR), LDS_BYTES, stream, a); }
#else
    a.ph_lo = 0; a.ph_hi = NPHASES;
    hipLaunchKernelGGL(mk_fwd, dim3(grid), dim3(NTHR), LDS_BYTES, stream, a);
#endif
}
```

```cpp
#include <hip/hip_runtime.h>
#include <stdint.h>
#include <stdio.h>

#ifndef FP8_DENSE
#define FP8_DENSE 0
#endif
#ifndef FP8_DOWN
#define FP8_DOWN 1
#endif
#ifndef I8_WIN
#define I8_WIN 0
#endif
#ifndef I8_GU
#define I8_GU 1
#endif
#ifndef I8_GEMM
#define I8_GEMM (I8_WIN || I8_GU)
#endif
#ifndef TAILQ1
#define TAILQ1 6
#endif
#ifndef TAILQ2
#define TAILQ2 3
#endif
#ifndef TAILQ3
#define TAILQ3 8
#endif
#ifndef TAILQ4
#define TAILQ4 2
#endif
#ifndef CQ1
#define CQ1 20
#endif
#ifndef CQ2
#define CQ2 26
#endif
#ifndef CONV_FILL
#define CONV_FILL 0
#endif
#ifndef PROBE_MASK
#define PROBE_MASK 0u
#endif
#ifndef PROBE_SUB
#define PROBE_SUB 0u
#endif
#ifndef MK_PER_PHASE
#define MK_PER_PHASE 0
#endif

typedef unsigned short bf16_t;
typedef float f32x4 __attribute__((ext_vector_type(4)));
typedef float f32x16 __attribute__((ext_vector_type(16)));
typedef unsigned u32x4 __attribute__((ext_vector_type(4)));
typedef unsigned u32x2 __attribute__((ext_vector_type(2)));
typedef short bf16x8 __attribute__((ext_vector_type(8)));

constexpr int D = 2048, NB = 4, L = 2048, C = 256, NLAT = NB * L, NCTX = NB * C, NTOK = NLAT + NCTX;
constexpr int UW = 3840;
constexpr int O_CQ = 0, O_CKV = 768, O_KPE = 1280, O_HY = 1344, O_SQ = 2880, O_SK = 3392, O_SV = 3520, INW = 3648;
constexpr int QW = 1536, KVW = 2048, DFF = 5632, DFE = 7168, NE = 8;
constexpr int MOE_ROWS = 18432;
constexpr float EPS = 1e-6f;
constexpr int NTHR = 512;
constexpr int HY_RBROW = 4112;

__device__ __forceinline__ float bf2f(bf16_t h) { return __uint_as_float(((unsigned)h) << 16); }
__device__ __forceinline__ bf16_t f2bf(float f) { unsigned u = __float_as_uint(f); u += 0x7fffu + ((u >> 16) & 1u); return (bf16_t)(u >> 16); }
__device__ __forceinline__ float wave_sum(float v) { for (int o = 32; o > 0; o >>= 1) v += __shfl_xor(v, o); return v; }
__device__ __forceinline__ float wave_max(float v) { for (int o = 32; o > 0; o >>= 1) v = fmaxf(v, __shfl_xor(v, o)); return v; }
__device__ __forceinline__ float silu(float x) { return x / (1.0f + __expf(-x)); }
__device__ __forceinline__ int tok_mod(int tok) { return tok < NLAT ? (tok >> 11) : 4; }

constexpr size_t al(size_t x) { return (x + 255) & ~(size_t)255; }
constexpr size_t WS_CTL = 0, CTL_ZERO_BYTES = 65536;
constexpr size_t WS_MOD = 65536;
constexpr size_t WS_ROPE = WS_MOD + al((size_t)2 * 5 * 12288 * 4);
constexpr size_t WS_FILTL = WS_ROPE + al((size_t)2 * 2048 * 32 * 4);
constexpr size_t WS_FILTC = WS_FILTL + al((size_t)2 * 512 * 4096 * 4);
constexpr size_t WS_WIN = WS_FILTC + al((size_t)2 * 512 * 512 * 4);
constexpr size_t WS_WQ = WS_WIN + al((size_t)2 * UW * D * 2);
constexpr size_t WS_WKV = WS_WQ + al((size_t)2 * QW * 768 * 2);
constexpr size_t WS_WOUT = WS_WKV + al((size_t)2 * KVW * 512 * 2);
constexpr size_t WS_WGU = WS_WOUT + al((size_t)2 * D * D * 2);
constexpr size_t WS_WDN = WS_WGU + al((size_t)2 * DFF * D * 2);
constexpr size_t WS_MGU = WS_WDN + al((size_t)D * DFF * 2);
constexpr size_t WS_MDN = WS_MGU + al((size_t)NE * 2 * DFE * D * 2);
constexpr size_t WS_HA = WS_MDN + al((size_t)NE * D * DFE * 2);
constexpr size_t WS_U = WS_HA + al((size_t)NTOK * D * 2);
constexpr size_t WS_CQN = WS_U + al((size_t)NTOK * UW * 2);
constexpr size_t WS_CKVN = WS_CQN + al((size_t)NTOK * 768 * 2);
constexpr size_t WS_KPE = WS_CKVN + al((size_t)NTOK * 512 * 2);
constexpr size_t WS_X0 = WS_KPE + al((size_t)NTOK * 64 * 2);
constexpr size_t WS_WTL = WS_X0 + al((size_t)NTOK * 512 * 2);
constexpr size_t WS_WTC = WS_WTL + al((size_t)NB * 512 * L * 2);
constexpr size_t WS_SQ = WS_WTC + al((size_t)NB * 512 * C * 2);
constexpr size_t WS_SK = WS_SQ + al((size_t)NTOK * 512 * 2);
constexpr size_t WS_SV = WS_SK + al((size_t)NTOK * 128 * 2);
constexpr size_t WS_Q = WS_SV + al((size_t)NTOK * 128 * 2);
constexpr size_t WS_KV = WS_Q + al((size_t)NTOK * QW * 2);
constexpr size_t WS_KN = WS_KV;
constexpr size_t WS_VT = WS_KV + (size_t)NTOK * 1024 * 2;
constexpr size_t WS_MIX = WS_KV + al((size_t)NTOK * KVW * 2);
constexpr size_t WS_MIXEND = WS_MIX + al((size_t)NTOK * D * 2);
constexpr size_t WS_YS = WS_U;
static_assert(WS_YS + (size_t)MOE_ROWS * D * 4 <= WS_MIXEND, "ys overlay");
constexpr size_t WS_XS = WS_MIXEND;
constexpr size_t WS_ACT = WS_XS + al((size_t)NTOK * D * 4);
constexpr size_t WS_HBS = WS_ACT + al((size_t)MOE_ROWS * DFE * 2);
constexpr size_t WS_TOPI = WS_HBS + al((size_t)MOE_ROWS * D * 2);
constexpr size_t WS_TOPW = WS_TOPI + al((size_t)NLAT * 2 * 4);
constexpr size_t WS_POS = WS_TOPW + al((size_t)NLAT * 2 * 4);
constexpr size_t WS_SRC = WS_POS + al((size_t)NLAT * 2 * 4);
constexpr size_t WS_SLAB = WS_SRC + al((size_t)MOE_ROWS * 4);
constexpr size_t WS_YT = WS_SLAB + ((size_t)64 << 20);
constexpr size_t WS_RSC = WS_YT + al((size_t)NB * 512 * (L + C) * 2);
constexpr size_t WS_END = WS_RSC + al((size_t)NTOK * 4);
constexpr int CT_EOFF = 1024, CT_EPAD = 1040, CT_NTILE = 1056, CT_MOES = 1057, CT_TROW = 1058, CT_WSC = 1088, CT_AMAXDONE = 1100;
constexpr int CW_BAR = 4096;

constexpr int RING_BYTES = 131072, LDS_BYTES = 147456, LDSCTL_OFF = LDS_BYTES - 256;

namespace pg8 {
#define PG8_LAS __attribute__((address_space(3)))
typedef unsigned short bf16_t;
typedef short bf16x8 __attribute__((ext_vector_type(8)));
typedef float f32x4 __attribute__((ext_vector_type(4)));
typedef unsigned u32x4 __attribute__((ext_vector_type(4)));
constexpr int BM = 256, BK = 64, HALF = 128, HTB = HALF * BK * 2  , STAGE_BYTES = 8 * HTB, NXCD = 8, WGM = 8;

__host__ __device__ __forceinline__ int lds_byte(int r, int c) { const int st = (r >> 4) * 2 + (c >> 5), rr = r & 15, cc = c & 31, ob = rr * 64 + cc * 2; return st * 1024 + (ob ^ (((ob >> 9) & 1) << 5)); }
__host__ __device__ __forceinline__ void stage_rc(int b, int& R, int& C) { const int st = b / 1024, sb = b % 1024, swz = sb ^ (((sb >> 9) & 1) << 5); R = (st >> 1) * 16 + swz / 64; C = (st & 1) * 32 + (swz % 64) / 2; }
__host__ __device__ __forceinline__ int perm32(int rho) { const int n = rho >> 4, i = rho & 15; return 8 * (i >> 2) + 4 * n + (i & 3); }

struct Unit { int pm, pn, kt0, nkt, slab; };
struct Gemm { const bf16_t* A; const bf16_t* Bt; int M, N, K; };

struct StaticOrder {
    int nM, nN, nwg, G, c;
    int nkt;
    __host__ __device__ void init(int M, int N, int G_, int c_, int K) { nM = M / BM; nN = N / BM; nwg = nM * nN; G = G_; c = c_; nkt = K / BK; }
    __host__ __device__ bool next(int i, Unit& u) const {
        const long L = (long)i * G + c; if (L >= nwg) return false;
        int wgid = (int)L; { const int q = nwg / NXCD, r = nwg % NXCD, xcd = wgid % NXCD, off = wgid / NXCD; wgid = (xcd < r ? xcd * (q + 1) : r * (q + 1) + (xcd - r) * q) + off; }
        const int nig = WGM * nN, gid = wgid / nig, fm = gid * WGM, gsz = (nM - fm) < WGM ? (nM - fm) : WGM;
        u.pm = fm + ((wgid % nig) % gsz); u.pn = (wgid % nig) / gsz; u.kt0 = 0; u.nkt = nkt; u.slab = -1; return true;
    }
    __device__ __forceinline__ size_t bt_off(const Unit&) const { return 0; }
    __device__ __forceinline__ void a_ready(const Unit&) const {}
    __device__ __forceinline__ void done(const Unit&) const {}
};

__device__ __forceinline__ unsigned cvt_pk_bf16(float lo, float hi) { unsigned r; asm volatile("v_cvt_pk_bf16_f32 %0, %1, %2" : "=v"(r) : "v"(lo), "v"(hi)); return r; }
typedef float f32x2 __attribute__((ext_vector_type(2)));
typedef int v8i_t __attribute__((ext_vector_type(8))); typedef int v4i_t __attribute__((ext_vector_type(4)));
template <bool F8> struct Frag;
template <> struct Frag<false> { bf16x8 h[2]; __device__ __forceinline__ void set0(bf16x8 x) { h[0] = x; } __device__ __forceinline__ void set1(bf16x8 x) { h[1] = x; } };
template <> struct Frag<true> { v8i_t v; __device__ __forceinline__ void set0(bf16x8 x) { v.lo = __builtin_bit_cast(v4i_t, x); } __device__ __forceinline__ void set1(bf16x8 x) { v.hi = __builtin_bit_cast(v4i_t, x); } };
template <class Epi, class Sched, bool ALIGN_EPI = false, bool SP2 = false, int DT = 0>
__device__ __forceinline__ void gemm_phase(PG8_LAS unsigned char* lds, const Gemm g, const Sched& S, const Epi& E) {
    int tid_ = threadIdx.x; asm volatile("" : "+v"(tid_));
    const int tid = tid_, wid = __builtin_amdgcn_readfirstlane(tid >> 6), lane = tid & 63, wr = wid >> 2, wc = wid & 3, fr = lane & 15, fq = lane >> 4;
    const int K = g.K;
    unsigned voffA[2], voffB[2];
#pragma unroll
    for (int i = 0; i < 2; ++i) { int R, C; stage_rc(tid * 16 + i * 8192, R, C); const int Rb = Epi::PERM ? ((R & ~31) + perm32(R & 31)) : R;
        voffA[i] = (unsigned)(R * K + C) * 2u; voffB[i] = (unsigned)(Rb * K + C) * 2u; }
    const size_t kstep = (size_t)(BK * 2);
    const size_t hstep = (size_t)HALF * K * 2;
    const size_t tstep = 2 * hstep;
    const unsigned ldsw = (unsigned)wid * 1024u;
    const int aoff = lds_byte(wr * 64 + fr, fq * 8), boff = lds_byte(wc * 32 + fr, fq * 8);
#define PG8_SA(b, h) (((b) * 2 + (h)) * HTB)
#define PG8_SB(b, h) ((4 + (b) * 2 + (h)) * HTB)
#define PG8_STAGE(bufoff, gbase, voff) do { _Pragma("unroll") for (int _i = 0; _i < 2; ++_i) \
        __builtin_amdgcn_global_load_lds((const unsigned*)((const char*)(gbase) + (voff)[_i]), (PG8_LAS unsigned*)(lds + (bufoff) + ldsw + _i * 8192), 16, 0, 0); } while (0)
#define PG8_LDA(dst, b, h) do { _Pragma("unroll") for (int m = 0; m < 4; ++m) { dst[m].set0(*(const PG8_LAS bf16x8*)(lds + PG8_SA(b, h) + aoff + m * 2048)); dst[m].set1(*(const PG8_LAS bf16x8*)(lds + PG8_SA(b, h) + aoff + m * 2048 + 1024)); } } while (0)
#define PG8_LDB(dst, b, h) do { _Pragma("unroll") for (int n = 0; n < 2; ++n) { dst[n].set0(*(const PG8_LAS bf16x8*)(lds + PG8_SB(b, h) + boff + n * 2048)); dst[n].set1(*(const PG8_LAS bf16x8*)(lds + PG8_SB(b, h) + boff + n * 2048 + 1024)); } } while (0)
#define PG8_MMA(ai, bj, At, Bt) do { __builtin_amdgcn_s_setprio(1); _Pragma("unroll") for (int m = 0; m < 4; ++m) _Pragma("unroll") for (int n = 0; n < 2; ++n) { \
        if constexpr (DT == 1) asm volatile("v_mfma_f32_16x16x128_f8f6f4 %0, %1, %2, %0" : "+v"(acc[ai][bj][m][n]) : "v"(Bt[n].v), "v"(At[m].v));   \
        else if constexpr (DT == 2) { _Pragma("unroll") for (int k = 0; k < 2; ++k) acc[ai][bj][m][n] = __builtin_bit_cast(f32x4, __builtin_amdgcn_mfma_i32_16x16x64_i8(__builtin_bit_cast(v4i_t, Bt[n].h[k]), __builtin_bit_cast(v4i_t, At[m].h[k]), __builtin_bit_cast(v4i_t, acc[ai][bj][m][n]), 0, 0, 0)); } \
        else { _Pragma("unroll") for (int k = 0; k < 2; ++k) acc[ai][bj][m][n] = __builtin_amdgcn_mfma_f32_16x16x32_bf16(Bt[n].h[k], At[m].h[k], acc[ai][bj][m][n], 0, 0, 0); } } \
        __builtin_amdgcn_s_setprio(0); } while (0)
#define PG8_WAIT_V(n) asm volatile("s_waitcnt vmcnt(" #n ")" ::: "memory")
#define PG8_WAIT_L(n) asm volatile("s_waitcnt lgkmcnt(" #n ")" ::: "memory")
#define PG8_BAR __builtin_amdgcn_s_barrier()
#define PG8_SCHED __builtin_amdgcn_sched_barrier(0)
    Unit cur, nxt; int ui = 0;
    if (!S.next(0, cur)) return;
    f32x4 acc[2][2][4][2];
#pragma unroll
    for (int a = 0; a < 2; ++a)
#pragma unroll
        for (int b = 0; b < 2; ++b)
#pragma unroll
            for (int m = 0; m < 4; ++m)
#pragma unroll
                for (int n = 0; n < 2; ++n) acc[a][b][m][n] = (f32x4){0.f, 0.f, 0.f, 0.f};
    Frag<DT == 1> At[4], B0[2], B1[2];
    const char* cA = (const char*)g.A + (size_t)cur.pm * tstep + (size_t)cur.kt0 * kstep; const char* cB = (const char*)g.Bt + S.bt_off(cur) + (size_t)cur.pn * tstep + (size_t)cur.kt0 * kstep;
    S.a_ready(cur);
    if constexpr (SP2) {
        PG8_STAGE(PG8_SB(0, 0), cB, voffB); PG8_STAGE(PG8_SB(0, 1), cB + hstep, voffB); PG8_STAGE(PG8_SA(0, 0), cA, voffA); PG8_STAGE(PG8_SA(0, 1), cA + hstep, voffA);
        if (wr == 1) PG8_BAR;
        PG8_WAIT_V(2); PG8_BAR;
        PG8_STAGE(PG8_SB(1, 0), cB + kstep, voffB); PG8_STAGE(PG8_SA(1, 0), cA + kstep, voffA); PG8_STAGE(PG8_SB(1, 1), cB + hstep + kstep, voffB);
        PG8_WAIT_V(6); PG8_BAR;
    } else {
        PG8_STAGE(PG8_SB(0, 0), cB, voffB); PG8_STAGE(PG8_SA(0, 0), cA, voffA); PG8_STAGE(PG8_SB(0, 1), cB + hstep, voffB); PG8_STAGE(PG8_SA(0, 1), cA + hstep, voffA);
        if (wr == 1) PG8_BAR;
        PG8_WAIT_V(4); PG8_BAR;
        PG8_STAGE(PG8_SB(1, 0), cB + kstep, voffB); PG8_STAGE(PG8_SA(1, 0), cA + kstep, voffA); PG8_STAGE(PG8_SB(1, 1), cB + hstep + kstep, voffB);
        PG8_WAIT_V(6); PG8_BAR;
    }
    for (;;) {
        const bool has_next = S.next(ui + 1, nxt);
        const char* nA = has_next ? (const char*)g.A + (size_t)nxt.pm * tstep + (size_t)nxt.kt0 * kstep : cA; const char* nB = has_next ? (const char*)g.Bt + S.bt_off(nxt) + (size_t)nxt.pn * tstep + (size_t)nxt.kt0 * kstep : cB;
        const int nt = cur.nkt;
        for (int t = 0; t < nt; t += 2) {
            const bool last = (t == nt - 2);
            const char* a1 = cA + (size_t)(t + 1) * kstep;
            const char* a2 = last ? nA : cA + (size_t)(t + 2) * kstep; const char* b2 = last ? nB : cB + (size_t)(t + 2) * kstep;
            const char* a3 = a2 + kstep; const char* b3 = b2 + kstep;
            if (last && has_next) S.a_ready(nxt);
            if constexpr (SP2) {
            PG8_LDB(B0, 0, 0); PG8_LDB(B1, 0, 1); PG8_SCHED; PG8_LDA(At, 0, 0); PG8_STAGE(PG8_SA(1, 1), a1 + hstep, voffA);
            PG8_WAIT_V(8); PG8_WAIT_L(0); PG8_BAR; PG8_MMA(0, 0, At, B0); PG8_MMA(0, 1, At, B1); PG8_BAR; PG8_SCHED;
            PG8_LDA(At, 0, 1); PG8_STAGE(PG8_SB(0, 0), b2, voffB); PG8_STAGE(PG8_SB(0, 1), b2 + hstep, voffB); PG8_STAGE(PG8_SA(0, 0), a2, voffA);
            PG8_WAIT_V(8); PG8_WAIT_L(0); PG8_BAR; PG8_MMA(1, 0, At, B0); PG8_MMA(1, 1, At, B1); PG8_BAR; PG8_SCHED;
            PG8_LDB(B0, 1, 0); PG8_LDB(B1, 1, 1); PG8_SCHED; PG8_LDA(At, 1, 0); PG8_STAGE(PG8_SA(0, 1), a2 + hstep, voffA);
            PG8_WAIT_V(8); PG8_WAIT_L(0); PG8_BAR; PG8_MMA(0, 0, At, B0); PG8_MMA(0, 1, At, B1); PG8_BAR; PG8_SCHED;
            PG8_LDA(At, 1, 1); PG8_STAGE(PG8_SB(1, 0), b3, voffB); PG8_STAGE(PG8_SB(1, 1), b3 + hstep, voffB); PG8_STAGE(PG8_SA(1, 0), a3, voffA);
            PG8_WAIT_V(8); PG8_WAIT_L(0); PG8_BAR; PG8_MMA(1, 0, At, B0); PG8_MMA(1, 1, At, B1); PG8_BAR; PG8_SCHED;
            } else {
            PG8_LDB(B0, 0, 0); PG8_SCHED; PG8_LDA(At, 0, 0); PG8_STAGE(PG8_SA(1, 1), a1 + hstep, voffA);
            PG8_WAIT_L(8); PG8_BAR; PG8_WAIT_L(0); PG8_MMA(0, 0, At, B0); PG8_BAR; PG8_SCHED;
            PG8_LDB(B1, 0, 1); PG8_STAGE(PG8_SB(0, 0), b2, voffB);
            PG8_BAR; PG8_WAIT_L(0); PG8_MMA(0, 1, At, B1); PG8_BAR;
            PG8_LDA(At, 0, 1); PG8_STAGE(PG8_SA(0, 0), a2, voffA);
            PG8_BAR; PG8_WAIT_L(0); PG8_MMA(1, 0, At, B0); PG8_BAR; PG8_SCHED;
            PG8_STAGE(PG8_SB(0, 1), b2 + hstep, voffB);
            PG8_WAIT_V(6); PG8_BAR; PG8_MMA(1, 1, At, B1); PG8_BAR;
            PG8_LDB(B0, 1, 0); PG8_SCHED; PG8_LDA(At, 1, 0); PG8_STAGE(PG8_SA(0, 1), a2 + hstep, voffA);
            PG8_WAIT_L(8); PG8_BAR; PG8_WAIT_L(0); PG8_MMA(0, 0, At, B0); PG8_BAR; PG8_SCHED;
            PG8_LDB(B1, 1, 1); PG8_STAGE(PG8_SB(1, 0), b3, voffB);
            PG8_BAR; PG8_WAIT_L(0); PG8_MMA(0, 1, At, B1); PG8_BAR;
            PG8_LDA(At, 1, 1); PG8_STAGE(PG8_SA(1, 0), a3, voffA);
            PG8_BAR; PG8_WAIT_L(0); PG8_MMA(1, 0, At, B0); PG8_BAR; PG8_SCHED;
            PG8_STAGE(PG8_SB(1, 1), b3 + hstep, voffB);
            PG8_WAIT_V(6); PG8_BAR; PG8_MMA(1, 1, At, B1); PG8_BAR;
            }
        }
        if constexpr (ALIGN_EPI) { if (wr == 0) PG8_BAR; }
        if constexpr (DT == 1) asm volatile("s_nop 15\n\ts_nop 15" ::: "memory");
        if constexpr (!Epi::AFTER_DRAIN) { E(acc, cur, wr, wc, fr, fq); S.done(cur); }
        if (!has_next) break;
#pragma unroll
        for (int a = 0; a < 2; ++a)
#pragma unroll
            for (int b = 0; b < 2; ++b)
#pragma unroll
                for (int m = 0; m < 4; ++m)
#pragma unroll
                    for (int n = 0; n < 2; ++n) acc[a][b][m][n] = (f32x4){0.f, 0.f, 0.f, 0.f};
        cur = nxt; cA = nA; cB = nB; ++ui;
        if constexpr (ALIGN_EPI) { if (wr == 1) PG8_BAR; }
    }
    PG8_WAIT_V(0);
    if constexpr (!ALIGN_EPI) { if (wr == 0) PG8_BAR; }
    PG8_BAR;
    if constexpr (Epi::AFTER_DRAIN) { E.fused(acc, cur, wr, wc, fr, fq, lds, wid, lane); S.done(cur); }
#undef PG8_SA
#undef PG8_SB
#undef PG8_STAGE
#undef PG8_LDA
#undef PG8_LDB
#undef PG8_MMA
#undef PG8_WAIT_V
#undef PG8_WAIT_L
#undef PG8_BAR
#undef PG8_SCHED
}
}

namespace pg8 {
__device__ __forceinline__ u32x4 pack8(const f32x4 v0, const f32x4 v1) { u32x4 w; w.x = cvt_pk_bf16(v0[0], v0[1]); w.y = cvt_pk_bf16(v0[2], v0[3]); w.z = cvt_pk_bf16(v1[0], v1[1]); w.w = cvt_pk_bf16(v1[2], v1[3]); return w; }
struct EpiStore {
    static constexpr bool PERM = true, AFTER_DRAIN = false;
    bf16_t* O; int ldc;
    __device__ __forceinline__ void operator()(const f32x4 (&acc)[2][2][4][2], const Unit& u, int wr, int wc, int fr, int fq) const {
        const int row0 = u.pm * BM + wr * 64 + fr, col0 = u.pn * BM + wc * 32 + 8 * fq;
#pragma unroll
        for (int ai = 0; ai < 2; ++ai)
#pragma unroll
            for (int m = 0; m < 4; ++m) { bf16_t* rowp = O + (size_t)(row0 + ai * HALF + m * 16) * ldc + col0;
#pragma unroll
                for (int bj = 0; bj < 2; ++bj) *(u32x4*)(rowp + bj * HALF) = pack8(acc[ai][bj][m][0], acc[ai][bj][m][1]); }
    }
};
struct EpiQ {
    static constexpr bool PERM = true, AFTER_DRAIN = false;
    bf16_t* O; const float* cosT; const float* sinT;
    __device__ __forceinline__ void operator()(const f32x4 (&acc)[2][2][4][2], const Unit& u, int wr, int wc, int fr, int fq) const {
        const int row0 = u.pm * BM + wr * 64 + fr, col0 = u.pn * BM + wc * 32 + 8 * fq;
#pragma unroll
        for (int ai = 0; ai < 2; ++ai)
#pragma unroll
            for (int m = 0; m < 4; ++m) { const int row = row0 + ai * HALF + m * 16; const bool lat = row < 8192; const int t = row & 2047;
#pragma unroll
                for (int bj = 0; bj < 2; ++bj) { const int col = col0 + bj * HALF; const int jn = col - 192 * (col / 192);
                    f32x4 v0 = acc[ai][bj][m][0], v1 = acc[ai][bj][m][1];
                    if (jn >= 128 && lat) { const int i0 = (jn - 128) >> 1;
                        const f32x4 cs = *(const f32x4*)(cosT + t * 32 + i0), sn = *(const f32x4*)(sinT + t * 32 + i0);
                        f32x4 r0, r1;
                        r0[0] = v0[0] * cs[0] - v0[1] * sn[0]; r0[1] = v0[0] * sn[0] + v0[1] * cs[0];
                        r0[2] = v0[2] * cs[1] - v0[3] * sn[1]; r0[3] = v0[2] * sn[1] + v0[3] * cs[1];
                        r1[0] = v1[0] * cs[2] - v1[1] * sn[2]; r1[1] = v1[0] * sn[2] + v1[1] * cs[2];
                        r1[2] = v1[2] * cs[3] - v1[3] * sn[3]; r1[3] = v1[2] * sn[3] + v1[3] * cs[3];
                        v0 = r0; v1 = r1; }
                    *(u32x4*)(O + (size_t)row * 1536 + col) = pack8(v0, v1); } }
    }
};
struct EpiResid {
    static constexpr bool PERM = false, AFTER_DRAIN = false;
    float* xs; const float* rd_lat; const float* gate; float* slab; int tail_row0, tail_rows; float scale;
    __device__ __forceinline__ void operator()(const f32x4 (&acc)[2][2][4][2], const Unit& u, int wr, int wc, int fr, int fq) const {
        const int row0 = u.pm * BM + wr * 64 + fr, colb = u.pn * BM + wc * 32 + 4 * fq;
        if (u.slab >= 0) {
#pragma unroll
            for (int ai = 0; ai < 2; ++ai)
#pragma unroll
                for (int m = 0; m < 4; ++m) { float* sp = slab + ((size_t)u.slab * tail_rows + (row0 + ai * HALF + m * 16 - tail_row0)) * 2048;
#pragma unroll
                    for (int bj = 0; bj < 2; ++bj)
#pragma unroll
                        for (int n = 0; n < 2; ++n) *(f32x4*)(sp + colb + bj * HALF + n * 16) = acc[ai][bj][m][n] * scale; }
            return;
        }
#pragma unroll
        for (int ai = 0; ai < 2; ++ai)
#pragma unroll
            for (int m = 0; m < 4; ++m) { const int row = row0 + ai * HALF + m * 16; const float* gv = gate + (size_t)(row < 8192 ? (row >> 11) : 4) * 12288; float* xr = xs + (size_t)row * 2048; const float* rr = row < 8192 ? rd_lat + (size_t)row * 2048 : xr;
#pragma unroll
                for (int bj = 0; bj < 2; ++bj)
#pragma unroll
                    for (int n = 0; n < 2; ++n) { const int col = colb + bj * HALF + n * 16; f32x4 x = *(const f32x4*)(rr + col); const f32x4 g = *(const f32x4*)(gv + col);
                        x += (g * scale) * acc[ai][bj][m][n]; *(f32x4*)(xr + col) = x; }
                if (m & 1) asm volatile("" ::: "memory"); }
    }
};
__device__ __forceinline__ unsigned pack4_fp8(float a, float b, float c, float d) {
    a = __builtin_amdgcn_fmed3f(a, -448.f, 448.f); b = __builtin_amdgcn_fmed3f(b, -448.f, 448.f); c = __builtin_amdgcn_fmed3f(c, -448.f, 448.f); d = __builtin_amdgcn_fmed3f(d, -448.f, 448.f);
    unsigned w = 0; w = __builtin_amdgcn_cvt_pk_fp8_f32(a, b, w, false); w = __builtin_amdgcn_cvt_pk_fp8_f32(c, d, w, true); return w; }
struct EpiSwiGLU8 {
    static constexpr bool PERM = true, AFTER_DRAIN = false;
    unsigned char* O; int ldc; float s, oscale;
    __device__ __forceinline__ void operator()(const f32x4 (&acc)[2][2][4][2], const Unit& u, int wr, int wc, int fr, int fq) const {
        const int row0 = u.pm * BM + wr * 64 + fr, col0 = u.pn * HALF + wc * 32 + 8 * fq;
#pragma unroll
        for (int ai = 0; ai < 2; ++ai)
#pragma unroll
            for (int m = 0; m < 4; ++m) { f32x4 o0, o1;
#pragma unroll
                for (int j = 0; j < 4; ++j) { const float g0 = acc[ai][0][m][0][j] * s, g1 = acc[ai][0][m][1][j] * s;
                    o0[j] = g0 * __builtin_amdgcn_rcpf(1.0f + __expf(-g0)) * (acc[ai][1][m][0][j] * (s * oscale)); o1[j] = g1 * __builtin_amdgcn_rcpf(1.0f + __expf(-g1)) * (acc[ai][1][m][1][j] * (s * oscale)); }
                u32x2 w; w.x = pack4_fp8(o0[0], o0[1], o0[2], o0[3]); w.y = pack4_fp8(o1[0], o1[1], o1[2], o1[3]);
                *(u32x2*)(O + (size_t)(row0 + ai * HALF + m * 16) * ldc + col0) = w; }
    }
};
__device__ __forceinline__ f32x4 i2f4(const f32x4 bits) { const v4i_t iv = __builtin_bit_cast(v4i_t, bits); return (f32x4){(float)iv[0], (float)iv[1], (float)iv[2], (float)iv[3]}; }
struct EpiStoreI8 {
    static constexpr bool PERM = true, AFTER_DRAIN = false;
    bf16_t* O; int ldc; const float* rsc; float sw;
    __device__ __forceinline__ void operator()(const f32x4 (&acc)[2][2][4][2], const Unit& u, int wr, int wc, int fr, int fq) const {
        const int row0 = u.pm * BM + wr * 64 + fr, col0 = u.pn * BM + wc * 32 + 8 * fq;
#pragma unroll
        for (int ai = 0; ai < 2; ++ai)
#pragma unroll
            for (int m = 0; m < 4; ++m) { const int row = row0 + ai * HALF + m * 16; const float sc = rsc[row] * sw; bf16_t* rowp = O + (size_t)row * ldc + col0;
#pragma unroll
                for (int bj = 0; bj < 2; ++bj) *(u32x4*)(rowp + bj * HALF) = pack8(i2f4(acc[ai][bj][m][0]) * sc, i2f4(acc[ai][bj][m][1]) * sc); }
    }
};
struct EpiSwiGLUI8 {
    static constexpr bool PERM = true, AFTER_DRAIN = false;
    unsigned char* O; int ldc; const float* rsc; float swg, swu, oscale;
    __device__ __forceinline__ void operator()(const f32x4 (&acc)[2][2][4][2], const Unit& u, int wr, int wc, int fr, int fq) const {
        const int row0 = u.pm * BM + wr * 64 + fr, col0 = u.pn * HALF + wc * 32 + 8 * fq;
#pragma unroll
        for (int ai = 0; ai < 2; ++ai)
#pragma unroll
            for (int m = 0; m < 4; ++m) { const int row = row0 + ai * HALF + m * 16; const float sa = rsc[row], sg = sa * swg, su = sa * swu * oscale; f32x4 o0, o1;
                const f32x4 g0v = i2f4(acc[ai][0][m][0]) * sg, g1v = i2f4(acc[ai][0][m][1]) * sg, u0v = i2f4(acc[ai][1][m][0]) * su, u1v = i2f4(acc[ai][1][m][1]) * su;
#pragma unroll
                for (int j = 0; j < 4; ++j) { o0[j] = g0v[j] * __builtin_amdgcn_rcpf(1.0f + __expf(-g0v[j])) * u0v[j]; o1[j] = g1v[j] * __builtin_amdgcn_rcpf(1.0f + __expf(-g1v[j])) * u1v[j]; }
                u32x2 w; w.x = pack4_fp8(o0[0], o0[1], o0[2], o0[3]); w.y = pack4_fp8(o1[0], o1[1], o1[2], o1[3]);
                *(u32x2*)(O + (size_t)row * ldc + col0) = w; }
    }
};
struct EpiSwiGLU {
    static constexpr bool PERM = true, AFTER_DRAIN = false;
    bf16_t* O; int ldc;
    __device__ __forceinline__ void operator()(const f32x4 (&acc)[2][2][4][2], const Unit& u, int wr, int wc, int fr, int fq) const {
        const int row0 = u.pm * BM + wr * 64 + fr, col0 = u.pn * HALF + wc * 32 + 8 * fq;
#pragma unroll
        for (int ai = 0; ai < 2; ++ai)
#pragma unroll
            for (int m = 0; m < 4; ++m) { f32x4 o0, o1;
#pragma unroll
                for (int j = 0; j < 4; ++j) { const float g0 = acc[ai][0][m][0][j], g1 = acc[ai][0][m][1][j];
                    o0[j] = g0 / (1.0f + __expf(-g0)) * acc[ai][1][m][0][j]; o1[j] = g1 / (1.0f + __expf(-g1)) * acc[ai][1][m][1][j]; }
                *(u32x4*)(O + (size_t)(row0 + ai * HALF + m * 16) * ldc + col0) = pack8(o0, o1); }
    }
};
struct EpiF32 {
    static constexpr bool PERM = false, AFTER_DRAIN = false;
    float* O; int ldc; float* slab; int tail_row0, tail_rows; float scale;
    __device__ __forceinline__ void operator()(const f32x4 (&acc)[2][2][4][2], const Unit& u, int wr, int wc, int fr, int fq) const {
        const int row0 = u.pm * BM + wr * 64 + fr, colb = u.pn * BM + wc * 32 + 4 * fq;
#pragma unroll
        for (int ai = 0; ai < 2; ++ai)
#pragma unroll
            for (int m = 0; m < 4; ++m) { float* xr = (u.slab >= 0) ? slab + ((size_t)u.slab * tail_rows + (row0 + ai * HALF + m * 16 - tail_row0)) * 2048 : O + (size_t)(row0 + ai * HALF + m * 16) * ldc;
#pragma unroll
                for (int bj = 0; bj < 2; ++bj)
#pragma unroll
                    for (int n = 0; n < 2; ++n) *(f32x4*)(xr + colb + bj * HALF + n * 16) = acc[ai][bj][m][n] * scale; }
    }
};
struct EpiYs {
    static constexpr bool PERM = false, AFTER_DRAIN = false;
    bf16_t* O; float* slab; int tail_row0, tail_rows; float scale;
    __device__ __forceinline__ void operator()(const f32x4 (&acc)[2][2][4][2], const Unit& u, int wr, int wc, int fr, int fq) const {
        const int row0 = u.pm * BM + wr * 64 + fr, colb = u.pn * BM + wc * 32 + 4 * fq;
        if (u.slab >= 0) {
#pragma unroll
            for (int ai = 0; ai < 2; ++ai)
#pragma unroll
                for (int m = 0; m < 4; ++m) { float* sp = slab + ((size_t)u.slab * tail_rows + (row0 + ai * HALF + m * 16 - tail_row0)) * 2048;
#pragma unroll
                    for (int bj = 0; bj < 2; ++bj)
#pragma unroll
                        for (int n = 0; n < 2; ++n) *(f32x4*)(sp + colb + bj * HALF + n * 16) = acc[ai][bj][m][n] * scale; }
            return;
        }
#pragma unroll
        for (int ai = 0; ai < 2; ++ai)
#pragma unroll
            for (int m = 0; m < 4; ++m) { bf16_t* xr = O + (size_t)(row0 + ai * HALF + m * 16) * 2048;
#pragma unroll
                for (int bj = 0; bj < 2; ++bj)
#pragma unroll
                    for (int n = 0; n < 2; ++n) { const f32x4 v = acc[ai][bj][m][n] * scale; u32x2 w; w.x = cvt_pk_bf16(v[0], v[1]); w.y = cvt_pk_bf16(v[2], v[3]); *(u32x2*)(xr + colb + bj * HALF + n * 16) = w; } }
    }
};
struct MoeOrder {
    int nM, nN, nwg, G, c, nkt; int t1[8]; size_t estride;
    __device__ __forceinline__ void init(const int* ctl, int nN_, int G_, int c_, size_t estride_, int K) { nkt = K / BK;
        int acc = 0;
#pragma unroll
        for (int e = 0; e < 8; ++e) { acc += __builtin_amdgcn_readfirstlane(ctl[CT_EPAD + e]) >> 8; t1[e] = acc; }
        nM = acc; nN = nN_; nwg = nM * nN; G = G_; c = c_; estride = estride_;
    }
    __device__ __forceinline__ bool next(int i, Unit& u) const {
        const long L = (long)i * G + c; if (L >= nwg) return false;
        int wgid = (int)L; { const int q = nwg / NXCD, r = nwg % NXCD, xcd = wgid % NXCD, off = wgid / NXCD; wgid = (xcd < r ? xcd * (q + 1) : r * (q + 1) + (xcd - r) * q) + off; }
        const int nig = WGM * nN, gid = wgid / nig, fm = gid * WGM, gsz = (nM - fm) < WGM ? (nM - fm) : WGM;
        u.pm = fm + ((wgid % nig) % gsz); u.pn = (wgid % nig) / gsz; u.kt0 = 0; u.nkt = nkt; u.slab = -1; return true;
    }
    __device__ __forceinline__ size_t bt_off(const Unit& u) const { int e = 0;
#pragma unroll
        for (int k = 0; k < 7; ++k) e += (u.pm >= t1[k]) ? 1 : 0;
        return (size_t)e * estride; }
    __device__ __forceinline__ void a_ready(const Unit&) const {}
    __device__ __forceinline__ void done(const Unit&) const {}
};
struct WinLastOrder {
    StaticOrder so; int G, c;
    __device__ __forceinline__ void init(int G_, int c_, int K) { so.init(NLAT, UW, G_, c_, K); G = G_; c = c_; }
    __device__ __forceinline__ bool next(int i, Unit& u) const {
        if (so.next(i, u)) return true;
        const long L = (long)i * G + c - so.nwg; if (L < 0 || L >= 20) return false;
        const int j = (int)L, k = j % 5; u.pm = 32 + j / 5; u.pn = k < 3 ? 3 + k : 10 + k; u.kt0 = 0; u.nkt = so.nkt; u.slab = -1; return true;
    }
    __device__ __forceinline__ size_t bt_off(const Unit&) const { return 0; }
    __device__ __forceinline__ void a_ready(const Unit&) const {}
    __device__ __forceinline__ void done(const Unit&) const {}
};
struct SplitOrder {
    int nM, nN, nwg, G, c, nfull, ntail, S, nkt, nkts; int t1[8]; size_t estride;
    __device__ __forceinline__ void init(int nM_, int nN_, int G_, int c_, int K, int S_) {
        nM = nM_; nN = nN_; nwg = nM * nN; G = G_; c = c_; nkt = K / BK; nfull = (nwg / 256) * 256; ntail = nwg - nfull; S = S_; nkts = nkt / S; estride = 0;
#pragma unroll
        for (int e = 0; e < 8; ++e) t1[e] = 0;
    }
    __device__ __forceinline__ void init_moe(const int* ctl, int nN_, int G_, int c_, int K, size_t estride_) {
        int acc = 0;
#pragma unroll
        for (int e = 0; e < 8; ++e) { acc += __builtin_amdgcn_readfirstlane(ctl[CT_EPAD + e]) >> 8; t1[e] = acc; }
        init(acc, nN_, G_, c_, K, __builtin_amdgcn_readfirstlane(ctl[CT_MOES])); estride = estride_;
        acc = 0;
#pragma unroll
        for (int e = 0; e < 8; ++e) { acc += __builtin_amdgcn_readfirstlane(ctl[CT_EPAD + e]) >> 8; t1[e] = acc; }
    }
    __device__ __forceinline__ bool next(int i, Unit& u) const {
        const long L = (long)i * G + c; int wgid;
        if (L < nfull) { wgid = (int)L; { const int q = nfull / NXCD, xcd = wgid % NXCD, off = wgid / NXCD; wgid = xcd * q + off; } u.kt0 = 0; u.nkt = nkt; u.slab = -1; }
        else { const int j = (int)(L - nfull); if (j >= ntail * S) return false; const int tu = j / S, sl = j - tu * S; wgid = nfull + tu; u.kt0 = sl * nkts; u.nkt = nkts; u.slab = (S > 1) ? sl : -1; }
        const int nig = WGM * nN, gid = wgid / nig, fm = gid * WGM, gsz = (nM - fm) < WGM ? (nM - fm) : WGM;
        u.pm = fm + ((wgid % nig) % gsz); u.pn = (wgid % nig) / gsz; return true;
    }
    __device__ __forceinline__ size_t bt_off(const Unit& u) const { if (estride == 0) return 0; int e = 0;
#pragma unroll
        for (int k = 0; k < 7; ++k) e += (u.pm >= t1[k]) ? 1 : 0;
        return (size_t)e * estride; }
    __device__ __forceinline__ void a_ready(const Unit&) const {}
    __device__ __forceinline__ void done(const Unit&) const {}
};
__host__ __device__ constexpr int split_S(int nwg, int nkt, int G) {
    const int ntail = nwg - (nwg / G) * G;
    if (ntail == 0) return 1;
    if (nkt % 28 == 0 && ntail * 14 <= G) return 14;
    if (nkt % 16 == 0 && ntail * 8 <= G) return 8;
    if (nkt % 14 == 0 && ntail * 7 <= G) return 7;
    if (nkt % 8 == 0 && ntail * 4 <= G) return 4;
    if (nkt % 4 == 0 && ntail * 2 <= G) return 2;
    return 1;
}
}

#define LAS __attribute__((address_space(3)))
#define XB_TMO      128
#define XB_XCNT(j)  (256  + 64 * (j))
#define XB_XSUB(j)  (1280 + 64 * (j))
#define XB_XGEN(j)  (2304 + 64 * (j))
#define XB_TOP      3328
#define XB_TOPGEN   3392
#define XCD_BAR_WORDS 3456
#define XB_SPIN_CAP (1u << 18)

__device__ __forceinline__ unsigned xb_ld(unsigned* p)              { return __hip_atomic_load(p, __ATOMIC_RELAXED, __HIP_MEMORY_SCOPE_AGENT); }
__device__ __forceinline__ unsigned xb_add(unsigned* p, unsigned v) { return __hip_atomic_fetch_add(p, v, __ATOMIC_RELAXED, __HIP_MEMORY_SCOPE_AGENT); }
__device__ __forceinline__ unsigned xb_xcc_id() { return (unsigned)__builtin_amdgcn_s_getreg((3 << 11) | 20) & 0xFu; }
#define XB_SPIN(cond, bar) do { unsigned _sp = 0; while (cond) { __builtin_amdgcn_s_sleep(1); \
    if ((++_sp & 255u) == 0u) { if (xb_ld(&(bar)[XB_TMO])) break; if (_sp > XB_SPIN_CAP) { atomicAdd(&(bar)[XB_TMO], 1u); break; } } } } while (0)

struct XcdBarrier {
    unsigned* bar; unsigned x;
    volatile LAS unsigned* st;
};

__device__ __forceinline__ XcdBarrier xcd_barrier_post(unsigned* bar, volatile LAS unsigned* st) {
    XcdBarrier b; b.bar = bar; b.x = xb_xcc_id(); b.st = st;
    if (threadIdx.x == 0) (void)xb_add(&bar[XB_XCNT(b.x)], 1u);
    return b;
}
__device__ __forceinline__ void xcd_barrier_complete(unsigned* bar, unsigned x, unsigned& nloc, unsigned& nx) {
    const unsigned G = gridDim.x * gridDim.y * gridDim.z;
    unsigned sum, cnt, mine, sp = 0u;
    for (;;) {
        sum = 0u; cnt = 0u; mine = 0u;
#pragma unroll
        for (unsigned j = 0; j < 16; ++j) { const unsigned c = xb_ld(&bar[XB_XCNT(j)]); sum += c; cnt += (c > 0u) ? 1u : 0u; mine = (j == x) ? c : mine; }
        if (sum == G) break;
        __builtin_amdgcn_s_sleep(1);
        if ((++sp & 255u) == 0u) { if (xb_ld(&bar[XB_TMO])) break; if (sp > XB_SPIN_CAP) { atomicAdd(&bar[XB_TMO], 1u); break; } }
    }
    nloc = mine > 0u ? mine : 1u; nx = cnt > 0u ? cnt : 1u;
}

__device__ __forceinline__ void xcd_barrier(const XcdBarrier& b) {
    asm volatile("s_waitcnt vmcnt(0)" ::: "memory");
    __syncthreads();
    if (threadIdx.x == 0) {
        unsigned* bar = b.bar;
        __builtin_amdgcn_s_waitcnt(0);
        unsigned nloc = b.st[0], nx = b.st[1];
        if (nloc == 0u) { xcd_barrier_complete(bar, b.x, nloc, nx); b.st[0] = nloc; b.st[1] = nx; }
        const unsigned old = xb_add(&bar[XB_XSUB(b.x)], 1u);
        const unsigned gen = old / nloc;
        if (old + 1u == (gen + 1u) * nloc) {
            __builtin_amdgcn_fence(__ATOMIC_RELEASE, "agent");
            asm volatile("s_waitcnt vmcnt(0)" ::: "memory");
            const unsigned og = xb_add(&bar[XB_TOP], 1u);
            const unsigned tg = og / nx;
            if (og + 1u == (tg + 1u) * nx) xb_add(&bar[XB_TOPGEN], 1u);
            else XB_SPIN(xb_ld(&bar[XB_TOPGEN]) == tg, bar);
            __builtin_amdgcn_fence(__ATOMIC_ACQUIRE, "agent");
            xb_add(&bar[XB_XGEN(b.x)], 1u);
            asm volatile("s_waitcnt vmcnt(0)" ::: "memory");
        } else {
            XB_SPIN(xb_ld(&bar[XB_XGEN(b.x)]) == gen, bar);
            __builtin_amdgcn_fence(__ATOMIC_ACQUIRE, "agent");
            asm volatile("s_waitcnt vmcnt(0)" ::: "memory");
        }
    }
    __syncthreads();
}


struct Args { const float* in[34]; float* out; unsigned char* ws; int ph_lo, ph_hi; };

enum { MAP_ID = 0, MAP_ROPEQ = 1, MAP_GU0 = 2, MAP_GU1 = 3, MAP_KV = 4 };
struct JobDesc { int in_idx, K, N, nbatch, upb, map; long long src_off, src_bstride, dst_off, dst_bstride; int fp8, sidx; };
constexpr int NJOBS = 14, NCONV = 12664;
constexpr int G1_GEMM = CQ1 > 0 ? 184 : 256, G2_GEMM = CQ2 > 0 ? 232 : 256;
constexpr int TAIL1_BLK0 = 540 - 2 * G1_GEMM, TAIL1_N = G1_GEMM - TAIL1_BLK0, CONV1_N = 256 - G1_GEMM;
constexpr int TAIL2_BLK0 = 1584 - 6 * G2_GEMM, TAIL2_N = G2_GEMM - TAIL2_BLK0, CONV2_N = 256 - G2_GEMM;
constexpr int TAIL3_BLK0 = 64, TAIL3_N = 192, TAIL4_BLK0 = 32, TAIL4_N = 224;
constexpr int NCONV_T1 = TAIL1_N * TAILQ1 + CONV1_N * CQ1, NCONV_T2 = TAIL2_N * TAILQ2 + CONV2_N * CQ2, NCONV_T3 = TAIL3_N * TAILQ3, NCONV_T4 = TAIL4_N * TAILQ4, NCONV_Q = NCONV - NCONV_T1 - NCONV_T2 - NCONV_T3 - NCONV_T4;
static_assert(NCONV_Q % 2 == 0 && NCONV_Q >= 1912, "the prologue queue takes pairs; the tails only hold expert weights");
__constant__ JobDesc c_jobs[NJOBS] = {
    {8, 2048, 3648, 1, 232, MAP_ID, 0, 0, (long long)WS_WIN, 0, I8_WIN ? 2 : 0, 0},
    {8, 2048, 3648, 1, 232, MAP_ID, 2048LL * 3648, 0, (long long)(WS_WIN + (size_t)UW * D * 2), 0, I8_WIN ? 2 : 0, 1},
    {10, 768, 1536, 1, 36, MAP_ROPEQ, 0, 0, (long long)WS_WQ, 0},
    {10, 768, 1536, 1, 36, MAP_ROPEQ, 768LL * 1536, 0, (long long)(WS_WQ + (size_t)QW * 768 * 2), 0},
    {12, 512, 2048, 1, 32, MAP_KV, 0, 0, (long long)WS_WKV, 0},
    {12, 512, 2048, 1, 32, MAP_KV, 512LL * 2048, 0, (long long)(WS_WKV + (size_t)KVW * 512 * 2), 0},
    {25, 2048, 2048, 1, 128, MAP_ID, 0, 0, (long long)WS_WOUT, 0},
    {25, 2048, 2048, 1, 128, MAP_ID, 2048LL * 2048, 0, (long long)(WS_WOUT + (size_t)D * D * 2), 0},
    {26, 2048, 5632, 1, 352, MAP_GU0, 0, 0, (long long)WS_WGU, 0, I8_GU ? 2 : FP8_DENSE, 2},
    {27, 2048, 5632, 1, 352, MAP_GU1, 0, 0, (long long)WS_WGU, 0, I8_GU ? 2 : FP8_DENSE, 3},
    {28, 5632, 2048, 1, 352, MAP_ID, 0, 0, (long long)WS_WDN, 0, (FP8_DENSE || FP8_DOWN), 0},
    {30, 2048, 7168, 8, 448, MAP_GU0, 0, 2048LL * 7168, (long long)WS_MGU, 2LL * DFE * D, 1, 0},
    {31, 2048, 7168, 8, 448, MAP_GU1, 0, 2048LL * 7168, (long long)WS_MGU, 2LL * DFE * D, 1, 0},
    {32, 7168, 2048, 8, 448, MAP_ID, 0, 7168LL * 2048, (long long)WS_MDN, (long long)D * DFE, 1, 0},
};
struct ConvUnit { const float* src; bf16_t* dst; int K, N, map, k0, n0, fp8; float qs; };
__device__ __forceinline__ unsigned pack4_i8(float a, float b, float c, float d) {
    const int ia = (int)__builtin_rintf(__builtin_amdgcn_fmed3f(a, -127.f, 127.f)), ib = (int)__builtin_rintf(__builtin_amdgcn_fmed3f(b, -127.f, 127.f)), ic = (int)__builtin_rintf(__builtin_amdgcn_fmed3f(c, -127.f, 127.f)), id = (int)__builtin_rintf(__builtin_amdgcn_fmed3f(d, -127.f, 127.f));
    return (unsigned)(ia & 0xff) | ((unsigned)(ib & 0xff) << 8) | ((unsigned)(ic & 0xff) << 16) | ((unsigned)(id & 0xff) << 24); }
constexpr float WSCALE = 64.f, ASCALE = 8.f;
__device__ __forceinline__ void conv_decode(const Args& a, int u, ConvUnit& cu) {
    int j = 0, base = 0;
    for (;;) { const int n = c_jobs[j].nbatch * c_jobs[j].upb; if (u < base + n || j == NJOBS - 1) break; base += n; ++j; }
    const JobDesc& jd = c_jobs[j];
    int r = u - base; const int bt = r / jd.upb; r -= bt * jd.upb; const int ntn = (jd.N + 127) >> 7; int kt = r / ntn, nt = r - kt * ntn;
    if (((jd.K >> 8) & 1) == 0) { const int r2 = r >> 1; kt = 2 * (r2 / ntn) + (r & 1); nt = r2 % ntn; }
    cu.K = jd.K; cu.N = jd.N; cu.map = jd.map; cu.k0 = kt * 256; cu.n0 = nt * 128; cu.fp8 = jd.fp8; cu.qs = 1.0f;
    if (jd.fp8 == 2) { const float am = __uint_as_float(__hip_atomic_load((const unsigned*)(a.ws + WS_CTL) + CT_WSC + jd.sidx, __ATOMIC_RELAXED, __HIP_MEMORY_SCOPE_AGENT)); cu.qs = am > 0.f ? 127.0f / am : 0.f; }
    const float* sb = j < 2 ? a.in[8] : j < 4 ? a.in[10] : j < 6 ? a.in[12] : j < 8 ? a.in[25] : j == 8 ? a.in[26] : j == 9 ? a.in[27] : j == 10 ? a.in[28] : j == 11 ? a.in[30] : j == 12 ? a.in[31] : a.in[32];
    cu.src = sb + jd.src_off + (long long)bt * jd.src_bstride + (size_t)cu.k0 * jd.N + cu.n0;
    cu.dst = (bf16_t*)(a.ws + jd.dst_off + (long long)bt * jd.dst_bstride);
}
__device__ __forceinline__ int conv_row(int map, int n) {
    if (map == MAP_ID) return n;
    if (map == MAP_GU0) return ((n >> 7) << 8) + (n & 127);
    if (map == MAP_GU1) return ((n >> 7) << 8) + 128 + (n & 127);
    if (map == MAP_KV) { const int hh = n >> 8, jn = n & 255; return jn < 128 ? hh * 128 + jn : 1024 + hh * 128 + (jn - 128); }
    const int hh = n / 192, jn = n - hh * 192; if (jn < 128) return n; const int q = jn - 128; return hh * 192 + 128 + 2 * (q & 31) + (q >> 5);
}
constexpr int CV_P = 129, CV_BUF = 65536;
#define CONV_LOAD(R, CU) do { const bool ok_ = (CU).n0 + (tid & 31) * 4 < (CU).N; const float* sp_ = (CU).src + (size_t)((tid >> 5) * 16) * (CU).N + (tid & 31) * 4; \
        _Pragma("unroll") for (int i_ = 0; i_ < 16; ++i_) R[i_] = ok_ ? __builtin_nontemporal_load((const f32x4*)(sp_ + (size_t)i_ * (CU).N)) : (f32x4){0.f, 0.f, 0.f, 0.f}; } while (0)
__device__ __forceinline__ void conv_put(const f32x4 (&R)[16], const ConvUnit& cu, unsigned char* buf, int tid) {
    const int nq = tid & 31, kc = tid >> 5;
    if (cu.fp8 == 2) {
        const float qs = cu.qs;
#pragma unroll
        for (int c = 0; c < 4; ++c) { u32x4 w;
            w.x = pack4_i8(R[0][c] * qs, R[1][c] * qs, R[2][c] * qs, R[3][c] * qs); w.y = pack4_i8(R[4][c] * qs, R[5][c] * qs, R[6][c] * qs, R[7][c] * qs);
            w.z = pack4_i8(R[8][c] * qs, R[9][c] * qs, R[10][c] * qs, R[11][c] * qs); w.w = pack4_i8(R[12][c] * qs, R[13][c] * qs, R[14][c] * qs, R[15][c] * qs);
            *(u32x4*)(buf + (4 * nq + c) * 256 + ((kc ^ (nq & 15)) << 4)) = w; }
    } else if (cu.fp8) {
#pragma unroll
        for (int c = 0; c < 4; ++c) { u32x4 w;
            w.x = pg8::pack4_fp8(R[0][c] * WSCALE, R[1][c] * WSCALE, R[2][c] * WSCALE, R[3][c] * WSCALE); w.y = pg8::pack4_fp8(R[4][c] * WSCALE, R[5][c] * WSCALE, R[6][c] * WSCALE, R[7][c] * WSCALE);
            w.z = pg8::pack4_fp8(R[8][c] * WSCALE, R[9][c] * WSCALE, R[10][c] * WSCALE, R[11][c] * WSCALE); w.w = pg8::pack4_fp8(R[12][c] * WSCALE, R[13][c] * WSCALE, R[14][c] * WSCALE, R[15][c] * WSCALE);
            *(u32x4*)(buf + (4 * nq + c) * 256 + ((kc ^ (nq & 15)) << 4)) = w; }
    } else {
#pragma unroll
        for (int c = 0; c < 4; ++c) { u32x4 w0, w1;
            w0.x = pg8::cvt_pk_bf16(R[0][c], R[1][c]); w0.y = pg8::cvt_pk_bf16(R[2][c], R[3][c]); w0.z = pg8::cvt_pk_bf16(R[4][c], R[5][c]); w0.w = pg8::cvt_pk_bf16(R[6][c], R[7][c]);
            w1.x = pg8::cvt_pk_bf16(R[8][c], R[9][c]); w1.y = pg8::cvt_pk_bf16(R[10][c], R[11][c]); w1.z = pg8::cvt_pk_bf16(R[12][c], R[13][c]); w1.w = pg8::cvt_pk_bf16(R[14][c], R[15][c]);
            *(u32x4*)(buf + (4 * nq + c) * 512 + (((2 * kc) ^ nq) << 4)) = w0; *(u32x4*)(buf + (4 * nq + c) * 512 + (((2 * kc + 1) ^ nq) << 4)) = w1; }
    }
}
__device__ __forceinline__ void conv_out(const ConvUnit& cur, const unsigned char* buf, int tid) {
    if (cur.fp8) {
#pragma unroll
        for (int j = 0; j < 4; ++j) { const int nl = (tid >> 4) + 32 * j, ch = tid & 15;
            if (cur.n0 + nl < cur.N) { const int row = conv_row(cur.map, cur.n0 + nl); const u32x4 w = *(const u32x4*)(buf + nl * 256 + ((ch ^ ((nl >> 2) & 15)) << 4));
                *(u32x4*)((unsigned char*)cur.dst + (size_t)row * cur.K + cur.k0 + ch * 16) = w; } }
    } else {
#pragma unroll
        for (int j = 0; j < 8; ++j) { const int nl = (tid >> 5) + 16 * j, ch = tid & 31;
            if (cur.n0 + nl < cur.N) { const int row = conv_row(cur.map, cur.n0 + nl); const u32x4 w = *(const u32x4*)(buf + nl * 512 + ((ch ^ ((nl >> 2) & 31)) << 4));
                *(u32x4*)((unsigned char*)cur.dst + ((size_t)row * cur.K + cur.k0) * 2 + ch * 16) = w; } }
    }
}
template <int MODE = 0>
__device__ __forceinline__ void ph_convert(const Args& a, float* tile, int first, int stride, int end) {
    const int tid = threadIdx.x; unsigned char* buf = (unsigned char*)tile;
    int u = first; ConvUnit cuA, cuB; f32x4 rA[16], rB[16];
#pragma unroll
    for (int i = 0; i < 16; ++i) { rA[i] = (f32x4){0.f, 0.f, 0.f, 0.f}; rB[i] = rA[i]; }
    if (u < end) { conv_decode(a, u, cuA); if (MODE != 2) CONV_LOAD(rA, cuA); }
    if (u + stride < end) { conv_decode(a, u + stride, cuB); if (MODE != 2) CONV_LOAD(rB, cuB); }
    while (u < end) {
        conv_put(rA, cuA, buf, tid);
        __syncthreads();
        { const ConvUnit cur = cuA; const int un = u + 2 * stride; if (un < end) { conv_decode(a, un, cuA); if (MODE != 2) CONV_LOAD(rA, cuA); } if (MODE != 1) conv_out(cur, buf, tid); }
        u += stride; if (u >= end) break;
        conv_put(rB, cuB, buf + CV_BUF, tid);
        __syncthreads();
        { const ConvUnit cur = cuB; const int un = u + 2 * stride; if (un < end) { conv_decode(a, un, cuB); if (MODE != 2) CONV_LOAD(rB, cuB); } if (MODE != 1) conv_out(cur, buf + CV_BUF, tid); }
        u += stride;
    }
    __syncthreads();
}
constexpr int CT_QNEXT = 1152;
template <int MODE = 0>
__device__ __forceinline__ void conv_dynamic(const Args& a, float* tile) {
    unsigned* qn = (unsigned*)(a.ws + WS_CTL) + CT_QNEXT; volatile int* bc = (volatile int*)(tile + 256 * CV_P + 4);
    const int tid = threadIdx.x;
    if (tid == 0) { bc[0] = (int)__hip_atomic_fetch_add(qn, 1u, __ATOMIC_RELAXED, __HIP_MEMORY_SCOPE_AGENT); bc[1] = (int)__hip_atomic_fetch_add(qn, 1u, __ATOMIC_RELAXED, __HIP_MEMORY_SCOPE_AGENT); }
    __syncthreads();
    int q = bc[0], qN = bc[1];
    __syncthreads();
    ConvUnit cuA, cuB; f32x4 rA[16], rB[16];
#pragma unroll
    for (int i = 0; i < 16; ++i) { rA[i] = (f32x4){0.f, 0.f, 0.f, 0.f}; rB[i] = rA[i]; }
    if (2 * q < NCONV_Q) { conv_decode(a, 2 * q, cuA); if (MODE != 2) CONV_LOAD(rA, cuA); }
    if (2 * q + 1 < NCONV_Q) { conv_decode(a, 2 * q + 1, cuB); if (MODE != 2) CONV_LOAD(rB, cuB); }
    unsigned char* buf = (unsigned char*)tile;
    while (2 * q < NCONV_Q) {
        const bool hasB = 2 * q + 1 < NCONV_Q;
        conv_put(rA, cuA, buf, tid);
        __syncthreads();
        { const ConvUnit cur = cuA; if (2 * qN < NCONV_Q) { conv_decode(a, 2 * qN, cuA); if (MODE != 2) CONV_LOAD(rA, cuA); }
          if (tid == 0) bc[0] = (int)__hip_atomic_fetch_add(qn, 1u, __ATOMIC_RELAXED, __HIP_MEMORY_SCOPE_AGENT);
          if (MODE != 1) conv_out(cur, buf, tid); }
        if (hasB) {
            conv_put(rB, cuB, buf + CV_BUF, tid);
            __syncthreads();
            { const ConvUnit cur = cuB; if (2 * qN + 1 < NCONV_Q) { conv_decode(a, 2 * qN + 1, cuB); if (MODE != 2) CONV_LOAD(rB, cuB); }
              if (MODE != 1) conv_out(cur, buf + CV_BUF, tid); }
        } else __syncthreads();
        q = qN; qN = bc[0];
    }
    __syncthreads();
}
#undef CONV_LOAD
constexpr int CONV_STATIC = 856, CONV_DENSE_END = 1912, CONV_BATCH = 2;
__device__ __forceinline__ constexpr int CT_DONE(int k) { return 1216 + 64 * k; }
__device__ __forceinline__ void conv_fill(const Args& a, float* tile, int done_idx) {
#if !CONV_FILL
    (void)a; (void)tile; (void)done_idx; return;
#endif
    unsigned* ctl = (unsigned*)(a.ws + WS_CTL); volatile int* bc = (volatile int*)(tile + 256 * CV_P + 4);
    const int tid = threadIdx.x;
    if (tid == 0) (void)__hip_atomic_fetch_add(ctl + CT_DONE(done_idx), 1u, __ATOMIC_RELAXED, __HIP_MEMORY_SCOPE_AGENT);
    for (;;) {
        if (tid == 0) { int q = -1;
            if (__hip_atomic_load(ctl + CT_DONE(done_idx), __ATOMIC_RELAXED, __HIP_MEMORY_SCOPE_AGENT) < gridDim.x) {
                q = (int)__hip_atomic_fetch_add(ctl + CT_QNEXT, (unsigned)CONV_BATCH, __ATOMIC_RELAXED, __HIP_MEMORY_SCOPE_AGENT) + CONV_STATIC; if (q >= NCONV) q = -1; }
            *bc = q; }
        __syncthreads();
        const int q = *bc;
        __syncthreads();
        if (q < 0) break;
        ph_convert(a, tile, q, 1, (q + CONV_BATCH < NCONV) ? q + CONV_BATCH : NCONV);
    }
}
__device__ __forceinline__ void conv_finish(const Args& a, float* tile, int upto) {
#if !CONV_FILL
    (void)a; (void)tile; (void)upto; return;
#endif
    unsigned* ctl = (unsigned*)(a.ws + WS_CTL); volatile int* bc = (volatile int*)(tile + 256 * CV_P + 4);
    const int tid = threadIdx.x;
    for (;;) {
        if (tid == 0) { int q = -1;
            if ((int)__hip_atomic_load(ctl + CT_QNEXT, __ATOMIC_RELAXED, __HIP_MEMORY_SCOPE_AGENT) + CONV_STATIC < upto) {
                q = (int)__hip_atomic_fetch_add(ctl + CT_QNEXT, (unsigned)CONV_BATCH, __ATOMIC_RELAXED, __HIP_MEMORY_SCOPE_AGENT) + CONV_STATIC; if (q >= NCONV) q = -1; }
            *bc = q; }
        __syncthreads();
        const int q = *bc;
        __syncthreads();
        if (q < 0) break;
        ph_convert(a, tile, q, 1, (q + CONV_BATCH < NCONV) ? q + CONV_BATCH : NCONV);
    }
}
__device__ __forceinline__ void adaln_unit(const Args& a, int unit, float* sm) {
    const float* c = a.in[1]; const float* cctx = a.in[3]; const float* w_mod = a.in[4]; const float* b_mod = a.in[5]; float* mod = (float*)(a.ws + WS_MOD);
    const int tid = threadIdx.x, l = unit / 96, chunk = unit - l * 96;
    const int cg = tid & 31, ks = tid >> 5;
    for (int i = tid; i < 5 * 2048; i += 512) { const int v = i >> 11, k = i & 2047; const float val = v < 4 ? c[v * 2048 + k] : cctx[k]; sm[i] = val / (1.0f + __expf(-val)); }
    __syncthreads();
    float acc[5][4];
#pragma unroll
    for (int v = 0; v < 5; ++v)
#pragma unroll
        for (int j = 0; j < 4; ++j) acc[v][j] = 0.f;
    const float* wp = w_mod + ((size_t)l * 2048 + (size_t)ks * 128) * 12288 + chunk * 128 + cg * 4;
    for (int kb = 0; kb < 128; kb += 16) {
        f32x4 w[16];
#pragma unroll
        for (int kk = 0; kk < 16; ++kk) w[kk] = __builtin_nontemporal_load((const f32x4*)(wp + (size_t)(kb + kk) * 12288));
#pragma unroll
        for (int kk = 0; kk < 16; ++kk) { const int k = ks * 128 + kb + kk;
#pragma unroll
            for (int v = 0; v < 5; ++v) { const float s = sm[v * 2048 + k];
#pragma unroll
                for (int j = 0; j < 4; ++j) acc[v][j] += s * w[kk][j]; } }
    }
    __syncthreads();
#pragma unroll
    for (int v = 0; v < 5; ++v)
#pragma unroll
        for (int j = 0; j < 4; ++j) sm[(ks * 5 + v) * 128 + cg * 4 + j] = acc[v][j];
    __syncthreads();
    for (int o = tid; o < 640; o += 512) {
        const int v = o >> 7, cc = o & 127; float s = 0.f;
#pragma unroll
        for (int k2 = 0; k2 < 16; ++k2) s += sm[(k2 * 5 + v) * 128 + cc];
        mod[((size_t)l * 5 + v) * 12288 + chunk * 128 + cc] = s + b_mod[(size_t)l * 12288 + chunk * 128 + cc];
    }
    __syncthreads();
}
constexpr int FW_W1 = 0, FW_W2 = 2112, FW_W3 = 6208, FW_B1 = 10304, FW_B2 = 10368, FW_B3 = 10432, FW_FR = 10496, FW_ZS = 10560, FW_HA = 10848, FW_HB = 11360, FW_END = 11872;
__device__ __forceinline__ void filters_unit(const Args& a, int l, int r, float* sm) {
    float (*zs)[36] = (float (*)[36])(sm + FW_ZS); float (*ha)[64] = (float (*)[64])(sm + FW_HA); float (*hb)[64] = (float (*)[64])(sm + FW_HB);
    const int tid = threadIdx.x;
    const bool lat = r < 256; const int Lf = lat ? 2048 : 256; const int p0 = lat ? r * 8 : (r - 256) * 8;
    float* T = (float*)(a.ws + WS_FILTC) + (size_t)l * 512 * 512;
    const float* wf = a.in[21] + (size_t)l * 64 * 1024;
    const int p = tid >> 6, j = tid & 63; const int pos = p0 + p;
    const float tn = (float)pos / (float)(Lf - 1);
    if (j < 33) {
        float z;
        if (j == 0) z = tn;
        else { const int bi = (j - 1) & 15; const float band = 1e-4f + (float)bi * ((15.0f - 1e-4f) / 15.0f);
               const float ang = (6.283185307179586f / (float)Lf) * (float)pos * band; z = (j <= 16) ? __cosf(ang) : -__sinf(ang); }
        zs[p][j] = z;
    }
    __syncthreads();
    const float f = sm[FW_FR + j];
    { float s = sm[FW_B1 + j];
#pragma unroll
      for (int i = 0; i < 33; ++i) s += zs[p][i] * sm[FW_W1 + i * 64 + j];
      ha[p][j] = __sinf(f * s); }
    __syncthreads();
    { float s = sm[FW_B2 + j];
#pragma unroll 16
      for (int i = 0; i < 64; ++i) s += ha[p][i] * sm[FW_W2 + i * 64 + j];
      hb[p][j] = __sinf(f * s); }
    __syncthreads();
    { float s = sm[FW_B3 + j];
#pragma unroll 16
      for (int i = 0; i < 64; ++i) s += hb[p][i] * sm[FW_W3 + i * 64 + j];
      ha[p][j] = __sinf(f * s); }
    __syncthreads();
    float acc[2][8];
#pragma unroll
    for (int rr = 0; rr < 2; ++rr)
#pragma unroll
        for (int q = 0; q < 8; ++q) acc[rr][q] = 0.f;
    for (int ib = 0; ib < 64; ib += 16) {
        float wa[16], wb[16];
#pragma unroll
        for (int i = 0; i < 16; ++i) { wa[i] = wf[(ib + i) * 1024 + tid]; wb[i] = wf[(ib + i) * 1024 + 512 + tid]; }
#pragma unroll
        for (int i = 0; i < 16; ++i) {
#pragma unroll
            for (int q = 0; q < 8; ++q) { const float h = ha[q][ib + i]; acc[0][q] += h * wa[i]; acc[1][q] += h * wb[i]; } }
    }
    const int ch = tid;
    const float delta = 3.0701134573253944f + (float)ch * ((15.350567286626972f - 3.0701134573253944f) / 511.0f);
#pragma unroll
    for (int q = 0; q < 8; ++q) {
        const int ps = p0 + q; const float dec = __expf(-((float)ps / (float)(Lf - 1)) * delta);
        const float vf = acc[0][q] * dec, vb = acc[1][q] * dec;
        if (lat) { bf16_t* RBp = (bf16_t*)(a.ws + WS_FILTL) + ((size_t)l * 512 + ch) * HY_RBROW; RBp[2048 - ps] = f2bf(vf); if (ps > 0) RBp[2048 + ps] = f2bf(vb); }
        else { T[(size_t)ch * (2 * Lf) + Lf + ps] = vf; if (ps > 0) T[(size_t)ch * (2 * Lf) + Lf - ps] = vb; else T[(size_t)ch * (2 * Lf)] = 0.f; }
    }
    __syncthreads();
}
__device__ __forceinline__ void ph_filters(const Args& a, float* sm, int fb, int nfb) {
    const int tid = threadIdx.x;
    for (int l = 0; l < 2; ++l) {
        for (int i = tid; i < 2112; i += NTHR) sm[FW_W1 + i] = a.in[15][l * 2112 + i];
        for (int i = tid; i < 4096; i += NTHR) { sm[FW_W2 + i] = a.in[17][l * 4096 + i]; sm[FW_W3 + i] = a.in[19][l * 4096 + i]; }
        if (tid < 64) { sm[FW_B1 + tid] = a.in[16][l * 64 + tid]; sm[FW_B2 + tid] = a.in[18][l * 64 + tid]; sm[FW_B3 + tid] = a.in[20][l * 64 + tid]; sm[FW_FR + tid] = a.in[22][l * 64 + tid]; }
        __syncthreads();
        for (int r = fb; r < 288; r += nfb) filters_unit(a, l, r, sm);
        __syncthreads();
    }
}
#define SUBREP(b) for (int srep_ = 0; srep_ <= (int)((PROBE_SUB >> (b)) & 1u); ++srep_)
__device__ __forceinline__ void ph_absmax(const Args& a, float* sm) {
    unsigned* ctl = (unsigned*)(a.ws + WS_CTL); const int tid = threadIdx.x, G = gridDim.x, bid = blockIdx.x, lane = tid & 63, w = tid >> 6;
#pragma unroll
    for (int j = (I8_WIN ? 0 : 2); j < (I8_GU ? 4 : 2); ++j) {
        const f32x4* p4 = (const f32x4*)(j == 0 ? a.in[8] : j == 1 ? a.in[8] + (size_t)2048 * 3648 : j == 2 ? a.in[26] : a.in[27]);
        const int n4 = (j < 2 ? 2048 * 3648 : 2048 * 5632) / 4, step = G * 512;
        float mm = 0.f;
        for (int i0 = bid * 512 + tid; i0 < n4; i0 += step * 8) {
            f32x4 v[8];
#pragma unroll
            for (int u = 0; u < 8; ++u) { const int i = i0 + u * step; v[u] = i < n4 ? __builtin_nontemporal_load(p4 + i) : (f32x4){0.f, 0.f, 0.f, 0.f}; }
#pragma unroll
            for (int u = 0; u < 8; ++u) mm = fmaxf(mm, fmaxf(fmaxf(fabsf(v[u][0]), fabsf(v[u][1])), fmaxf(fabsf(v[u][2]), fabsf(v[u][3]))));
        }
        mm = wave_max(mm);
        if (lane == 0) sm[w] = mm;
        __syncthreads();
        if (tid == 0) { float t = sm[0];
#pragma unroll
            for (int k = 1; k < 8; ++k) t = fmaxf(t, sm[k]);
            (void)__hip_atomic_fetch_max(ctl + CT_WSC + j, __float_as_uint(t), __ATOMIC_RELAXED, __HIP_MEMORY_SCOPE_AGENT); }
        __syncthreads();
    }
    if (tid == 0) (void)__hip_atomic_fetch_add(ctl + CT_AMAXDONE, 1u, __ATOMIC_RELAXED, __HIP_MEMORY_SCOPE_AGENT);
}
__device__ __forceinline__ void ph_prologue(const Args& a, float* sm) {
    const int bid = blockIdx.x, G = gridDim.x, tid = threadIdx.x;
    const int NF = G >= 128 ? 64 : 0;
    if (I8_GEMM) ph_absmax(a, sm);
    if (NF == 0) { SUBREP(4) for (int u = bid; u < 192; u += G) adaln_unit(a, u, sm); SUBREP(5) ph_filters(a, sm, bid, G); }
    else if (bid < NF) { SUBREP(5) ph_filters(a, sm, bid, NF); }
    else { SUBREP(4) for (int u = bid - NF; u < 192; u += G - NF) adaln_unit(a, u, sm); }
    { float* cosT = (float*)(a.ws + WS_ROPE); float* sinT = cosT + 2048 * 32;
      for (int i = bid * 512 + tid; i < 2048 * 32; i += G * 512) { const int t = i >> 5, f = i & 31;
          const float pos = (float)((f < 16) ? (t >> 6) : (t & 63)); const float freq = powf(10000.0f, -(float)(f & 15) / 16.0f); const float ang = pos * freq;
          cosT[i] = cosf(ang); sinT[i] = sinf(ang); } }
    for (int i = bid * 512 + tid; i < 2 * 512 * 17; i += G * 512) { const int row = i / 17, k = i - row * 17; ((bf16_t*)(a.ws + WS_FILTL))[(size_t)row * HY_RBROW + (k == 0 ? 0 : 4095 + k)] = 0; }
    { constexpr int RB16 = I8_WIN ? 128 : 256;
      for (int i = bid * 512 + tid; i < 2 * 192 * RB16; i += G * 512) { const int l = i / (192 * RB16), r = i % (192 * RB16);
        *(u32x4*)(a.ws + WS_WIN + (size_t)l * UW * D * 2 + (size_t)INW * RB16 * 16 + (size_t)r * 16) = (u32x4){0u, 0u, 0u, 0u}; } }
    if (I8_GEMM) {
        if (tid == 0) { const unsigned* dn = (const unsigned*)(a.ws + WS_CTL) + CT_AMAXDONE; unsigned sp = 0;
            while (__hip_atomic_load(dn, __ATOMIC_RELAXED, __HIP_MEMORY_SCOPE_AGENT) < (unsigned)G && ++sp < (1u << 22)) __builtin_amdgcn_s_sleep(4); }
    }
    __syncthreads();
    if ((PROBE_SUB >> 8) & 1u) ph_convert<2>(a, sm, bid, G, NCONV);
    if (!((PROBE_SUB >> 11) & 1u) || bid < 64) conv_dynamic<0>(a, sm);
    if (G != 256) ph_convert<0>(a, sm, NCONV_Q + bid, G, NCONV);
    if ((PROBE_SUB >> 6) & 1u) ph_convert<0>(a, sm, bid, G, NCONV);
    if ((PROBE_SUB >> 7) & 1u) ph_convert<1>(a, sm, bid, G, NCONV);
}

template <bool ROUTER, bool COPYX, int OUT8 = 0, int NSLAB = 0>
__device__ __forceinline__ void ph_normmod(const float* __restrict__ xlat, const float* __restrict__ xctx, const float* __restrict__ gain, const float* __restrict__ modl, int sh_off, int sc_off,
                                           bf16_t* __restrict__ out, int nrows, float* __restrict__ xs, const float* __restrict__ router, int* __restrict__ topi, float* __restrict__ topw,
                                           const float* __restrict__ slab = nullptr, const float* __restrict__ slab_gate = nullptr, float* __restrict__ rsc = nullptr) {
    const int lane = threadIdx.x & 63, wid = threadIdx.x >> 6;
    for (int row = blockIdx.x * 8 + wid; row < nrows; row += gridDim.x * 8) {
        const float* xr = row < NLAT ? xlat + (size_t)row * D : xctx + (size_t)(row - NLAT) * D;
        const float* mv = modl + (size_t)tok_mod(row) * 12288;
        f32x4 v[8]; float ss = 0.f;
#pragma unroll
        for (int i = 0; i < 8; ++i) { v[i] = *(const f32x4*)(xr + i * 256 + lane * 4);
            if (NSLAB > 0 && row >= NLAT) { f32x4 sa = *(const f32x4*)(slab + (size_t)(row - NLAT) * D + i * 256 + lane * 4);
#pragma unroll
                for (int sl = 1; sl < NSLAB; ++sl) sa += *(const f32x4*)(slab + ((size_t)sl * NCTX + (row - NLAT)) * D + i * 256 + lane * 4);
                v[i] += *(const f32x4*)(slab_gate + i * 256 + lane * 4) * sa; }
            ss += v[i][0] * v[i][0] + v[i][1] * v[i][1] + v[i][2] * v[i][2] + v[i][3] * v[i][3];
            if (COPYX && (NSLAB == 0 || row >= NLAT)) *(f32x4*)(xs + (size_t)row * D + i * 256 + lane * 4) = v[i]; }
        ss = wave_sum(ss);
        const float rstd = rsqrtf(ss * (1.0f / D) + EPS);
        float lg[8];
#pragma unroll
        for (int e = 0; e < 8; ++e) lg[e] = 0.f;
        float amax = 0.f;
#pragma unroll
        for (int i = 0; i < 8; ++i) {
            const int col = i * 256 + lane * 4;
            const f32x4 g = *(const f32x4*)(gain + col), sc = *(const f32x4*)(mv + sc_off + col), sh = *(const f32x4*)(mv + sh_off + col);
            f32x4 o;
#pragma unroll
            for (int j = 0; j < 4; ++j) o[j] = (v[i][j] * rstd * g[j]) * (1.0f + sc[j]) + sh[j];
            if (OUT8 == 2) { v[i] = o; amax = fmaxf(amax, fmaxf(fmaxf(fabsf(o[0]), fabsf(o[1])), fmaxf(fabsf(o[2]), fabsf(o[3])))); }
            else if (OUT8 == 1) *(unsigned*)((unsigned char*)out + (size_t)row * D + col) = pg8::pack4_fp8(o[0] * ASCALE, o[1] * ASCALE, o[2] * ASCALE, o[3] * ASCALE);
            else { u32x2 w; w.x = (unsigned)f2bf(o[0]) | ((unsigned)f2bf(o[1]) << 16); w.y = (unsigned)f2bf(o[2]) | ((unsigned)f2bf(o[3]) << 16);
                *(u32x2*)(out + (size_t)row * D + col) = w; }
            if (ROUTER) {
#pragma unroll
                for (int j = 0; j < 4; ++j) { const f32x4 r0 = *(const f32x4*)(router + (size_t)(col + j) * 8), r1 = *(const f32x4*)(router + (size_t)(col + j) * 8 + 4);
                    lg[0] += o[j] * r0[0]; lg[1] += o[j] * r0[1]; lg[2] += o[j] * r0[2]; lg[3] += o[j] * r0[3];
                    lg[4] += o[j] * r1[0]; lg[5] += o[j] * r1[1]; lg[6] += o[j] * r1[2]; lg[7] += o[j] * r1[3]; }
                asm volatile("" ::: "memory");
            }
        }
        if (OUT8 == 2) {
            amax = wave_max(amax); const float qs = amax > 0.f ? 127.0f / amax : 0.f;
#pragma unroll
            for (int i = 0; i < 8; ++i) *(unsigned*)((unsigned char*)out + (size_t)row * D + i * 256 + lane * 4) = pack4_i8(v[i][0] * qs, v[i][1] * qs, v[i][2] * qs, v[i][3] * qs);
            if (lane == 0) rsc[row] = amax * (1.0f / 127.0f);
        }
        if (ROUTER) {
#pragma unroll
            for (int e = 0; e < 8; ++e) lg[e] = wave_sum(lg[e]);
            if (lane == 0) {
                int i0 = 0; float v0 = lg[0];
#pragma unroll
                for (int e = 1; e < 8; ++e) if (lg[e] > v0) { v0 = lg[e]; i0 = e; }
                int i1 = -1; float v1 = -3.0e38f;
#pragma unroll
                for (int e = 0; e < 8; ++e) if (e != i0 && lg[e] > v1) { v1 = lg[e]; i1 = e; }
                const float e1 = expf(v1 - v0), w0 = 1.0f / (1.0f + e1), w1 = e1 / (1.0f + e1);
                topi[row * 2] = i0; topi[row * 2 + 1] = i1; topw[row * 2] = w0; topw[row * 2 + 1] = w1;
            }
        }
    }
}

__device__ __forceinline__ float bflo(unsigned w) { return __uint_as_float(w << 16); }
__device__ __forceinline__ float bfhi(unsigned w) { return __uint_as_float(w & 0xffff0000u); }
__device__ __forceinline__ unsigned pkbf(float lo, float hi) { return (unsigned)f2bf(lo) | ((unsigned)f2bf(hi) << 16); }
__device__ __forceinline__ u32x4 rope8(const u32x4 mine, const u32x4 other, bool is_x2, const f32x4 c0, const f32x4 c1, const f32x4 s0, const f32x4 s1) {
    const unsigned mw[4] = {mine.x, mine.y, mine.z, mine.w}, ow[4] = {other.x, other.y, other.z, other.w};
    const float cs[8] = {c0[0], c0[1], c0[2], c0[3], c1[0], c1[1], c1[2], c1[3]}, sn[8] = {s0[0], s0[1], s0[2], s0[3], s1[0], s1[1], s1[2], s1[3]};
    unsigned o[4];
#pragma unroll
    for (int d = 0; d < 4; ++d) {
        const float m0 = bflo(mw[d]), m1 = bfhi(mw[d]), p0 = bflo(ow[d]), p1 = bfhi(ow[d]);
        const float r0 = is_x2 ? (p0 * sn[2 * d] + m0 * cs[2 * d]) : (m0 * cs[2 * d] - p0 * sn[2 * d]);
        const float r1 = is_x2 ? (p1 * sn[2 * d + 1] + m1 * cs[2 * d + 1]) : (m1 * cs[2 * d + 1] - p1 * sn[2 * d + 1]);
        o[d] = pkbf(r0, r1);
    }
    return (u32x4){o[0], o[1], o[2], o[3]};
}
__device__ __forceinline__ u32x4 shfl4(const u32x4 v, int m) { return (u32x4){(unsigned)__shfl_xor((int)v.x, m), (unsigned)__shfl_xor((int)v.y, m), (unsigned)__shfl_xor((int)v.z, m), (unsigned)__shfl_xor((int)v.w, m)}; }
__device__ __forceinline__ void ph_mid(const Args& a, int l) {
    const bf16_t* __restrict__ U = (const bf16_t*)(a.ws + WS_U);
    const float* g_q = a.in[9] + l * 768; const float* g_kv = a.in[11] + l * 512; const float* conv_w = a.in[13] + (size_t)l * 3 * 1536; const float* conv_b = a.in[14] + l * 1536;
    const float* cosT = (const float*)(a.ws + WS_ROPE); const float* sinT = cosT + 2048 * 32;
    bf16_t* cqn = (bf16_t*)(a.ws + WS_CQN); bf16_t* ckvn = (bf16_t*)(a.ws + WS_CKVN); bf16_t* kpe = (bf16_t*)(a.ws + WS_KPE); bf16_t* x0o = (bf16_t*)(a.ws + WS_X0);
    bf16_t* wtl = (bf16_t*)(a.ws + WS_WTL); bf16_t* wtc = (bf16_t*)(a.ws + WS_WTC); bf16_t* sq = (bf16_t*)(a.ws + WS_SQ); bf16_t* sk = (bf16_t*)(a.ws + WS_SK); bf16_t* sv = (bf16_t*)(a.ws + WS_SV);
    int tid_ = threadIdx.x; asm volatile("" : "+v"(tid_));
    const int tid = tid_, lane = tid & 63, wid = tid >> 6;
    for (int unit = blockIdx.x; unit < NTOK / 16; unit += gridDim.x) {
        const int tok0 = unit * 16;
        for (int tt = 0; tt < 2; ++tt) {
            const int tok = tok0 + wid * 2 + tt; const bool lat = tok < NLAT; const int t = lat ? (tok & 2047) : ((tok - NLAT) & 255);
            const bf16_t* u = U + (size_t)tok * UW;
            const u32x2 q0 = *(const u32x2*)(u + O_CQ + lane * 12), q1 = *(const u32x2*)(u + O_CQ + lane * 12 + 4), q2 = *(const u32x2*)(u + O_CQ + lane * 12 + 8);
            const u32x4 kvv = *(const u32x4*)(u + O_CKV + lane * 8);
            const u32x4 sqv = *(const u32x4*)(u + O_SQ + lane * 8);
            const u32x4 skv = *(const u32x4*)(u + O_SK + (lane & 15) * 8);
            const u32x4 kpv = *(const u32x4*)(u + O_KPE + (lane & 7) * 8);
            const int i0 = (lane & 3) * 8;
            f32x4 c0 = (f32x4){1.f, 1.f, 1.f, 1.f}, c1 = c0, s0 = (f32x4){0.f, 0.f, 0.f, 0.f}, s1 = s0;
            if (lat) { c0 = *(const f32x4*)(cosT + t * 32 + i0); c1 = *(const f32x4*)(cosT + t * 32 + i0 + 4); s0 = *(const f32x4*)(sinT + t * 32 + i0); s1 = *(const f32x4*)(sinT + t * 32 + i0 + 4); }
            {
                const unsigned w6[6] = {q0.x, q0.y, q1.x, q1.y, q2.x, q2.y}; float x[12]; float ss = 0.f;
#pragma unroll
                for (int d = 0; d < 6; ++d) { x[2 * d] = bflo(w6[d]); x[2 * d + 1] = bfhi(w6[d]); ss += x[2 * d] * x[2 * d] + x[2 * d + 1] * x[2 * d + 1]; }
                ss = wave_sum(ss); const float rs = rsqrtf(ss * (1.0f / 768.0f) + EPS);
                const f32x4 g0 = *(const f32x4*)(g_q + lane * 12), g1 = *(const f32x4*)(g_q + lane * 12 + 4), g2 = *(const f32x4*)(g_q + lane * 12 + 8);
                u32x2 o0, o1, o2;
                o0.x = pkbf(x[0] * rs * g0[0], x[1] * rs * g0[1]); o0.y = pkbf(x[2] * rs * g0[2], x[3] * rs * g0[3]);
                o1.x = pkbf(x[4] * rs * g1[0], x[5] * rs * g1[1]); o1.y = pkbf(x[6] * rs * g1[2], x[7] * rs * g1[3]);
                o2.x = pkbf(x[8] * rs * g2[0], x[9] * rs * g2[1]); o2.y = pkbf(x[10] * rs * g2[2], x[11] * rs * g2[3]);
                bf16_t* dst = cqn + (size_t)tok * 768 + lane * 12; *(u32x2*)dst = o0; *(u32x2*)(dst + 4) = o1; *(u32x2*)(dst + 8) = o2;
            }
            {
                const unsigned w4[4] = {kvv.x, kvv.y, kvv.z, kvv.w}; float x[8]; float ss = 0.f;
#pragma unroll
                for (int d = 0; d < 4; ++d) { x[2 * d] = bflo(w4[d]); x[2 * d + 1] = bfhi(w4[d]); ss += x[2 * d] * x[2 * d] + x[2 * d + 1] * x[2 * d + 1]; }
                ss = wave_sum(ss); const float rs = rsqrtf(ss * (1.0f / 512.0f) + EPS);
                const f32x4 g0 = *(const f32x4*)(g_kv + lane * 8), g1 = *(const f32x4*)(g_kv + lane * 8 + 4);
                u32x4 o; o.x = pkbf(x[0] * rs * g0[0], x[1] * rs * g0[1]); o.y = pkbf(x[2] * rs * g0[2], x[3] * rs * g0[3]); o.z = pkbf(x[4] * rs * g1[0], x[5] * rs * g1[1]); o.w = pkbf(x[6] * rs * g1[2], x[7] * rs * g1[3]);
                *(u32x4*)(ckvn + (size_t)tok * 512 + lane * 8) = o;
            }
            const bool is_x2 = (lane & 4) != 0;
            {
                const u32x4 r = rope8(sqv, shfl4(sqv, 4), is_x2, c0, c1, s0, s1);
                *(u32x4*)(sq + (size_t)tok * 512 + lane * 8) = r;
            }
            {
                const u32x4 r = rope8(skv, shfl4(skv, 4), is_x2, c0, c1, s0, s1);
                if (lane < 16) *(u32x4*)(sk + (size_t)tok * 128 + lane * 8) = r;
            }
            {
                const u32x4 ot = shfl4(kpv, 4);
                if (lane < 4) {
                    const unsigned mw[4] = {kpv.x, kpv.y, kpv.z, kpv.w}, ow[4] = {ot.x, ot.y, ot.z, ot.w};
                    const float cs[8] = {c0[0], c0[1], c0[2], c0[3], c1[0], c1[1], c1[2], c1[3]}, sn[8] = {s0[0], s0[1], s0[2], s0[3], s1[0], s1[1], s1[2], s1[3]};
                    unsigned o[8];
#pragma unroll
                    for (int d = 0; d < 4; ++d) { const float a0 = bflo(mw[d]), a1 = bfhi(mw[d]), b0 = bflo(ow[d]), b1 = bfhi(ow[d]);
                        o[2 * d] = pkbf(a0 * cs[2 * d] - b0 * sn[2 * d], a0 * sn[2 * d] + b0 * cs[2 * d]);
                        o[2 * d + 1] = pkbf(a1 * cs[2 * d + 1] - b1 * sn[2 * d + 1], a1 * sn[2 * d + 1] + b1 * cs[2 * d + 1]); }
                    bf16_t* dst = kpe + (size_t)tok * 64 + lane * 16;
                    *(u32x4*)dst = (u32x4){o[0], o[1], o[2], o[3]}; *(u32x4*)(dst + 8) = (u32x4){o[4], o[5], o[6], o[7]};
                }
            }
        }
        {
            const bool lat = tok0 < NLAT; const int Ls = lat ? L : C;
            const int b = lat ? (tok0 >> 11) : ((tok0 - NLAT) >> 8), t0 = (lat ? (tok0 & 2047) : ((tok0 - NLAT) & 255));
            const int cp = tid & 255, hf = tid >> 8, ch = cp * 2, ts = t0 + hf * 8, tokb = tok0 + hf * 8;
            float cw[3][3][2], cb[3][2];
#pragma unroll
            for (int g = 0; g < 3; ++g) { cb[g][0] = conv_b[g * 512 + ch]; cb[g][1] = conv_b[g * 512 + ch + 1];
#pragma unroll
                for (int j = 0; j < 3; ++j) { cw[g][j][0] = conv_w[j * 1536 + g * 512 + ch]; cw[g][j][1] = conv_w[j * 1536 + g * 512 + ch + 1]; } }
            unsigned rows[3][10];
#pragma unroll
            for (int r = 0; r < 10; ++r) { const int tr = ts - 1 + r; const bool ok = tr >= 0 && tr < Ls;
#pragma unroll
                for (int g = 0; g < 3; ++g) rows[g][r] = ok ? *(const unsigned*)(U + (size_t)(tokb - 1 + r) * UW + O_HY + g * 512 + ch) : 0u; }
            unsigned wp0[4], wp1[4];
#pragma unroll
            for (int i = 0; i < 8; ++i) {
                float y[3][2];
#pragma unroll
                for (int g = 0; g < 3; ++g) {
                    y[g][0] = cb[g][0] + cw[g][0][0] * bflo(rows[g][i]) + cw[g][1][0] * bflo(rows[g][i + 1]) + cw[g][2][0] * bflo(rows[g][i + 2]);
                    y[g][1] = cb[g][1] + cw[g][0][1] * bfhi(rows[g][i]) + cw[g][1][1] * bfhi(rows[g][i + 1]) + cw[g][2][1] * bfhi(rows[g][i + 2]); }
                *(unsigned*)(x0o + (size_t)(tokb + i) * 512 + ch) = pkbf(y[0][0], y[0][1]);
                const unsigned w0 = f2bf(y[2][0] * y[1][0]), w1 = f2bf(y[2][1] * y[1][1]);
                if (i & 1) { wp0[i >> 1] |= w0 << 16; wp1[i >> 1] |= w1 << 16; } else { wp0[i >> 1] = w0; wp1[i >> 1] = w1; }
            }
            bf16_t* wt = lat ? wtl + ((size_t)b * 512 + ch) * L + ts : wtc + ((size_t)b * 512 + ch) * C + ts;
            *(u32x4*)wt = (u32x4){wp0[0], wp0[1], wp0[2], wp0[3]};
            *(u32x4*)(wt + (lat ? L : C)) = (u32x4){wp1[0], wp1[1], wp1[2], wp1[3]};
        }
        if (tid < 128) {
            unsigned pk[8];
#pragma unroll
            for (int i = 0; i < 16; ++i) { const unsigned v = U[(size_t)(tok0 + i) * UW + O_SV + tid]; if (i & 1) pk[i >> 1] |= v << 16; else pk[i >> 1] = v; }
            bf16_t* dst = sv + (size_t)tid * NTOK + tok0;
            u32x4 w0, w1; w0.x = pk[0]; w0.y = pk[1]; w0.z = pk[2]; w0.w = pk[3]; w1.x = pk[4]; w1.y = pk[5]; w1.z = pk[6]; w1.w = pk[7];
            *(u32x4*)dst = w0; *(u32x4*)(dst + 8) = w1;
        }
    }
}

__device__ __forceinline__ void ph_mla_naive(const Args& a, int nq, float* sm) {
    const bf16_t* __restrict__ Q = (const bf16_t*)(a.ws + WS_Q); const bf16_t* __restrict__ KV = (const bf16_t*)(a.ws + WS_KV); const bf16_t* __restrict__ KPE = (const bf16_t*)(a.ws + WS_KPE);
    bf16_t* mix = (bf16_t*)(a.ws + WS_MIX);
    const int lane = threadIdx.x & 63, w = threadIdx.x >> 6;
    float* qf = sm + w * 192; float* sc = sm + 8 * 192 + w * 2304;
    for (int unit = blockIdx.x; unit < nq; unit += gridDim.x) {
        const int h = unit & 7, qt = (unit >> 3) * 8 + w; const bool lat = qt < NLAT;
        const int b = lat ? (qt >> 11) : ((qt - NLAT) >> 8);
        const int nk = lat ? (L + C) : C;
        for (int i = lane; i < 192; i += 64) qf[i] = bf2f(Q[(size_t)qt * QW + h * 192 + i]);
        __syncthreads();
        const float scale = 0.07216878364870322f;
        float mx = -3.0e38f;
        for (int kc = 0; kc < nk; kc += 64) {
            const int kk = kc + lane;
            const int kt = lat ? (kk < L ? b * L + kk : NLAT + b * C + (kk - L)) : (NLAT + b * C + kk);
            float s = 0.f;
            const u32x4* kp = (const u32x4*)(KV + (size_t)kt * KVW + h * 256);
            for (int i = 0; i < 16; ++i) { const u32x4 v = kp[i]; const float* q8 = qf + i * 8;
                s += q8[0] * __uint_as_float(v.x << 16) + q8[1] * __uint_as_float(v.x & 0xffff0000u) + q8[2] * __uint_as_float(v.y << 16) + q8[3] * __uint_as_float(v.y & 0xffff0000u)
                   + q8[4] * __uint_as_float(v.z << 16) + q8[5] * __uint_as_float(v.z & 0xffff0000u) + q8[6] * __uint_as_float(v.w << 16) + q8[7] * __uint_as_float(v.w & 0xffff0000u); }
            const u32x4* pp = (const u32x4*)(KPE + (size_t)kt * 64);
            for (int i = 0; i < 8; ++i) { const u32x4 v = pp[i]; const float* q8 = qf + 128 + i * 8;
                s += q8[0] * __uint_as_float(v.x << 16) + q8[1] * __uint_as_float(v.x & 0xffff0000u) + q8[2] * __uint_as_float(v.y << 16) + q8[3] * __uint_as_float(v.y & 0xffff0000u)
                   + q8[4] * __uint_as_float(v.z << 16) + q8[5] * __uint_as_float(v.z & 0xffff0000u) + q8[6] * __uint_as_float(v.w << 16) + q8[7] * __uint_as_float(v.w & 0xffff0000u); }
            s *= scale; sc[kk] = s; mx = fmaxf(mx, s);
        }
        mx = wave_max(mx);
        float sum = 0.f;
        for (int kc = 0; kc < nk; kc += 64) { const float p = expf(sc[kc + lane] - mx); sc[kc + lane] = p; sum += p; }
        sum = wave_sum(sum);
        __syncthreads();
        float o0 = 0.f, o1 = 0.f;
        for (int kk = 0; kk < nk; ++kk) {
            const int kt = lat ? (kk < L ? b * L + kk : NLAT + b * C + (kk - L)) : (NLAT + b * C + kk);
            const unsigned v = *(const unsigned*)(KV + (size_t)kt * KVW + h * 256 + 128 + lane * 2);
            const float p = sc[kk];
            o0 += p * __uint_as_float(v << 16); o1 += p * __uint_as_float(v & 0xffff0000u);
        }
        const float inv = 1.0f / sum;
        *(unsigned*)(mix + (size_t)qt * D + h * 128 + lane * 2) = (unsigned)f2bf(o0 * inv) | ((unsigned)f2bf(o1 * inv) << 16);
        __syncthreads();
    }
}
__device__ __forceinline__ void ph_swa_naive(const Args& a, int l, int nq, float* sm) {
    const bf16_t* __restrict__ SQ = (const bf16_t*)(a.ws + WS_SQ); const bf16_t* __restrict__ SK = (const bf16_t*)(a.ws + WS_SK); const bf16_t* __restrict__ SV = (const bf16_t*)(a.ws + WS_SV);
    const float* sink = a.in[24] + l * 8; bf16_t* mix = (bf16_t*)(a.ws + WS_MIX);
    const int lane = threadIdx.x & 63, w = threadIdx.x >> 6;
    float* qf = sm + w * 64; float* sc = sm + 8 * 64 + w * 576; int* kts = (int*)(sm + 8 * 64 + 8 * 576) + w * 576;
    for (int unit = blockIdx.x; unit < nq; unit += gridDim.x) {
        const int hq = unit & 7, hk = hq >> 2, qt = (unit >> 3) * 8 + w; const bool lat = qt < NLAT;
        const int b = lat ? (qt >> 11) : ((qt - NLAT) >> 8), t = lat ? (qt & 2047) : 0;
        int lo = 0, nloc = 0;
        if (lat) { lo = t - 128 < 0 ? 0 : t - 128; const int hi = t + 128 > L - 1 ? L - 1 : t + 128; nloc = hi - lo + 1; }
        const int nk = nloc + C;
        qf[lane] = bf2f(SQ[(size_t)qt * 512 + hq * 64 + lane]);
        __syncthreads();
        const float skv = sink[hq];
        float mx = skv;
        for (int kc = 0; kc < nk; kc += 64) {
            const int kk = kc + lane;
            if (kk < nk) {
                const int kt = kk < nloc ? (b * L + lo + kk) : (NLAT + b * C + (kk - nloc));
                const u32x4* kp = (const u32x4*)(SK + (size_t)kt * 128 + hk * 64);
                float s = 0.f;
                for (int i = 0; i < 8; ++i) { const u32x4 v = kp[i]; const float* q8 = qf + i * 8;
                    s += q8[0] * __uint_as_float(v.x << 16) + q8[1] * __uint_as_float(v.x & 0xffff0000u) + q8[2] * __uint_as_float(v.y << 16) + q8[3] * __uint_as_float(v.y & 0xffff0000u)
                       + q8[4] * __uint_as_float(v.z << 16) + q8[5] * __uint_as_float(v.z & 0xffff0000u) + q8[6] * __uint_as_float(v.w << 16) + q8[7] * __uint_as_float(v.w & 0xffff0000u); }
                s *= 0.125f; sc[kk] = s; kts[kk] = kt; mx = fmaxf(mx, s);
            }
        }
        mx = wave_max(mx);
        float sum = 0.f;
        for (int kc = 0; kc < nk; kc += 64) { const int kk = kc + lane; if (kk < nk) { const float p = expf(sc[kk] - mx); sc[kk] = p; sum += p; } }
        sum = wave_sum(sum) + expf(skv - mx);
        __syncthreads();
        float o = 0.f;
        for (int kk = 0; kk < nk; ++kk) o += sc[kk] * bf2f(SV[(size_t)kts[kk] * 128 + hk * 64 + lane]);
        mix[(size_t)qt * D + 1536 + hq * 64 + lane] = f2bf(o / sum);
        __syncthreads();
    }
}
template <int LS>
__device__ __forceinline__ void ph_hyena_naive(const Args& a, int l, float* sm) {
    const float* filt = LS == L ? (const float*)(a.ws + WS_FILTL) + (size_t)l * 512 * 4096 : (const float*)(a.ws + WS_FILTC) + (size_t)l * 512 * 512;
    const bf16_t* wt = (const bf16_t*)(a.ws + (LS == L ? WS_WTL : WS_WTC)); const bf16_t* x0 = (const bf16_t*)(a.ws + WS_X0); const float* skip = a.in[23] + l * 512;
    bf16_t* mix = (bf16_t*)(a.ws + WS_MIX); const int tok_base = LS == L ? 0 : NLAT;
    float* T = sm; float* ws = sm + 2 * LS; const int tid = threadIdx.x;
    for (int unit = blockIdx.x; unit < 512 * NB; unit += gridDim.x) {
        const int ch = unit >> 2, b = unit & 3;
        for (int i = tid; i < 2 * LS; i += NTHR) T[i] = filt[(size_t)ch * 2 * LS + i];
        for (int i = tid; i < LS; i += NTHR) ws[i] = bf2f(wt[((size_t)b * 512 + ch) * LS + i]);
        __syncthreads();
        const float sk = skip[ch];
        for (int t = tid; t < LS; t += NTHR) {
            float y = 0.f;
            for (int s = 0; s < LS; ++s) y += T[t - s + LS] * ws[s];
            ((bf16_t*)(a.ws + WS_YT))[(LS == L ? (size_t)0 : (size_t)NB * 512 * L) + ((size_t)b * 512 + ch) * LS + t] = f2bf(y);
        }
        __syncthreads();
    }
}
__device__ __forceinline__ void ph_route_gather(const Args& a, int* sm) {
    const int* __restrict__ topi = (const int*)(a.ws + WS_TOPI); int* __restrict__ pos = (int*)(a.ws + WS_POS); int* ctl = (int*)(a.ws + WS_CTL);
    const unsigned char* __restrict__ hb = (const unsigned char*)(a.ws + WS_HA); unsigned char* __restrict__ hbs = (unsigned char*)(a.ws + WS_HBS);
    int (*cnt)[512] = (int (*)[512])sm; int* tot = sm + 8 * 512; int* ppos = sm + 8 * 512 + 16;
    const int tid = threadIdx.x, lane = tid & 63, w = tid >> 6;
    int c[8];
#pragma unroll
    for (int e = 0; e < 8; ++e) c[e] = 0;
    for (int i = 0; i < 32; i += 4) { const u32x4 e4 = *(const u32x4*)(topi + tid * 32 + i);
#pragma unroll
        for (int q = 0; q < 8; ++q) c[q] += (e4.x == (unsigned)q) + (e4.y == (unsigned)q) + (e4.z == (unsigned)q) + (e4.w == (unsigned)q); }
#pragma unroll
    for (int e = 0; e < 8; ++e) cnt[e][tid] = c[e];
    __syncthreads();
    {
        int v[8]; int s8 = 0;
#pragma unroll
        for (int k = 0; k < 8; ++k) { v[k] = cnt[w][lane * 8 + k]; s8 += v[k]; }
        int incl = s8;
#pragma unroll
        for (int off = 1; off < 64; off <<= 1) { const int t = __shfl_up(incl, off); if (lane >= off) incl += t; }
        int run = incl - s8;
#pragma unroll
        for (int k = 0; k < 8; ++k) { cnt[w][lane * 8 + k] = run; run += v[k]; }
        if (lane == 63) tot[w] = incl;
    }
    __syncthreads();
    int eoff[8]; int o = 0;
#pragma unroll
    for (int e = 0; e < 8; ++e) { eoff[e] = o; o += (tot[e] + 255) & ~255; }
    if (blockIdx.x == 0 && tid == 0) {
#pragma unroll
        for (int e = 0; e < 8; ++e) { ctl[CT_EOFF + e] = eoff[e]; ctl[CT_EPAD + e] = (tot[e] + 255) & ~255; }
        ctl[CT_NTILE] = o >> 8; const int nwg = (o >> 8) * (D / 256); ctl[CT_MOES] = pg8::split_S(nwg, DFE / 128, 256); ctl[CT_TROW] = (nwg / 256) * 256 / (D / 256) * 256;
    }
    for (int tg = blockIdx.x; tg < NLAT / 32; tg += gridDim.x) {
        if (tid < 64) {
            const int idx = 64 * tg + tid, owner = idx >> 5, e = topi[idx]; int p = 0;
#pragma unroll
            for (int q = 0; q < 8; ++q) { const unsigned long long mk = __ballot(e == q);
                if (e == q) { const unsigned hm = (unsigned)(mk >> (32 * (tid >> 5))); p = eoff[q] + cnt[q][owner] + __popc(hm & ((1u << (tid & 31)) - 1u)); } }
            pos[idx] = p; ppos[tid] = p;
        }
        __syncthreads();
#pragma unroll
        for (int k = 0; k < 4; ++k) { const int tl = 4 * w + k; const int tok = 32 * tg + tl;
            const u32x4 v0 = *(const u32x4*)(hb + (size_t)tok * D + lane * 32), v1 = *(const u32x4*)(hb + (size_t)tok * D + lane * 32 + 16);
            const int p0 = ppos[2 * tl], p1 = ppos[2 * tl + 1];
            *(u32x4*)(hbs + (size_t)p0 * D + lane * 32) = v0; *(u32x4*)(hbs + (size_t)p0 * D + lane * 32 + 16) = v1;
            *(u32x4*)(hbs + (size_t)p1 * D + lane * 32) = v0; *(u32x4*)(hbs + (size_t)p1 * D + lane * 32 + 16) = v1; }
        __syncthreads();
    }
}
__device__ __forceinline__ void ph_final(const Args& a) {
    const float* xs = (const float*)(a.ws + WS_XS); const bf16_t* ys = (const bf16_t*)(a.ws + WS_YS); const int* pos = (const int*)(a.ws + WS_POS); const float* topw = (const float*)(a.ws + WS_TOPW);
    const float* modl = (const float*)(a.ws + WS_MOD) + (size_t)5 * 12288; const float* gfin = a.in[33]; float* out = a.out;
    const int lane = threadIdx.x & 63, wid = threadIdx.x >> 6;
    const int* ctl = (const int*)(a.ws + WS_CTL); const int nsl = ctl[CT_MOES], trow0 = ctl[CT_TROW], trows = ctl[CT_NTILE] * 256 - trow0; const float* slab = (const float*)(a.ws + WS_SLAB);
    for (int row = blockIdx.x * 8 + wid; row < NLAT; row += gridDim.x * 8) {
        const float* g2 = modl + (size_t)tok_mod(row) * 12288 + 10240;
        const int p0 = pos[row * 2], p1 = pos[row * 2 + 1]; const float w0 = topw[row * 2], w1 = topw[row * 2 + 1];
        const bool t0 = nsl > 1 && p0 >= trow0, t1 = nsl > 1 && p1 >= trow0;
        f32x4 v[8]; float ss = 0.f;
#pragma unroll
        for (int i = 0; i < 8; ++i) { const int col = i * 256 + lane * 4;
            const f32x4 x = *(const f32x4*)(xs + (size_t)row * D + col), g = *(const f32x4*)(g2 + col); f32x4 ya, yb;
            if (t0) { ya = *(const f32x4*)(slab + (size_t)(p0 - trow0) * D + col); for (int sl = 1; sl < nsl; ++sl) ya += *(const f32x4*)(slab + ((size_t)sl * trows + (p0 - trow0)) * D + col); }
            else { const u32x2 q = *(const u32x2*)(ys + (size_t)p0 * D + col); ya = (f32x4){__uint_as_float(q.x << 16), __uint_as_float(q.x & 0xffff0000u), __uint_as_float(q.y << 16), __uint_as_float(q.y & 0xffff0000u)}; }
            if (t1) { yb = *(const f32x4*)(slab + (size_t)(p1 - trow0) * D + col); for (int sl = 1; sl < nsl; ++sl) yb += *(const f32x4*)(slab + ((size_t)sl * trows + (p1 - trow0)) * D + col); }
            else { const u32x2 q = *(const u32x2*)(ys + (size_t)p1 * D + col); yb = (f32x4){__uint_as_float(q.x << 16), __uint_as_float(q.x & 0xffff0000u), __uint_as_float(q.y << 16), __uint_as_float(q.y & 0xffff0000u)}; }
#pragma unroll
            for (int j = 0; j < 4; ++j) { v[i][j] = x[j] + g[j] * (w0 * ya[j] + w1 * yb[j]); ss += v[i][j] * v[i][j]; } }
        ss = wave_sum(ss); const float rstd = rsqrtf(ss * (1.0f / D) + EPS);
#pragma unroll
        for (int i = 0; i < 8; ++i) { const int col = i * 256 + lane * 4; const f32x4 g = *(const f32x4*)(gfin + col); f32x4 o;
#pragma unroll
            for (int j = 0; j < 4; ++j) o[j] = v[i][j] * rstd * g[j];
            *(f32x4*)(out + (size_t)row * D + col) = o; }
    }
}

typedef float f32x2_t __attribute__((ext_vector_type(2))); typedef __bf16 bf16x2_t __attribute__((ext_vector_type(2)));
__device__ __forceinline__ unsigned cvtpk(float lo, float hi) { f32x2_t v = {lo, hi}; bf16x2_t b = __builtin_convertvector(v, bf16x2_t); return __builtin_bit_cast(unsigned, b); }
#define MFMA32(a, b, c) __builtin_amdgcn_mfma_f32_32x32x16_bf16((a), (b), (c), 0, 0, 0)
constexpr int MLA_KP = 400, MLA_VP = 144, MLA_KB = 64 * MLA_KP, MLA_VB = 128 * MLA_VP, MLA_STAGE = MLA_KB + MLA_VB;
static_assert(2 * MLA_STAGE <= RING_BYTES, "MLA LDS");

__device__ __forceinline__ void ph_mla(const Args& a, bool with_ctx, unsigned char* lds) {
    const bf16_t* __restrict__ Q = (const bf16_t*)(a.ws + WS_Q); const bf16_t* __restrict__ KN = (const bf16_t*)(a.ws + WS_KN); const bf16_t* __restrict__ KPE = (const bf16_t*)(a.ws + WS_KPE);
    const bf16_t* __restrict__ VT = (const bf16_t*)(a.ws + WS_VT); bf16_t* __restrict__ mix = (bf16_t*)(a.ws + WS_MIX);
    int tid_ = threadIdx.x; asm volatile("" : "+v"(tid_));
    const int tid = tid_, lane = tid & 63, w = tid >> 6, qi = lane & 31, hh = lane >> 5;
    const int nunits = with_ctx ? 288 : 256;
    const float c = 0.07216878364870322f * 1.4426950408889634f;
    for (int unit = blockIdx.x; unit < nunits; unit += gridDim.x) {
        int h, b, q0tok, nt; bool ctxq;
        if (unit < 256) { h = unit & 7; b = unit >> 6; q0tok = b * L + ((unit >> 3) & 7) * 256; nt = 36; ctxq = false; }
        else { const int u2 = unit - 256; h = u2 & 7; b = u2 >> 3; q0tok = NLAT + b * C; nt = 4; ctxq = true; }
#define MLA_KTOK(t) (ctxq ? (NLAT + b * C + (t) * 64) : ((t) < 32 ? (b * L + (t) * 64) : (NLAT + b * C + ((t) - 32) * 64)))
        u32x4 r0, r1, r2, r3, r4;
#define MLA_ISSUE_K(t) do { const int kt0_ = MLA_KTOK(t); \
            r0 = *(const u32x4*)(KN + (size_t)(kt0_ + (tid >> 4)) * 1024 + h * 128 + (tid & 15) * 8); \
            r1 = *(const u32x4*)(KN + (size_t)(kt0_ + 32 + (tid >> 4)) * 1024 + h * 128 + (tid & 15) * 8); \
            r2 = *(const u32x4*)(KPE + (size_t)(kt0_ + (tid >> 3)) * 64 + (tid & 7) * 8); } while (0)
#define MLA_ISSUE_V(t) do { const int kt0_ = MLA_KTOK(t); \
            r3 = *(const u32x4*)(VT + (size_t)(h * 128 + (tid >> 3)) * NTOK + kt0_ + (tid & 7) * 8); \
            r4 = *(const u32x4*)(VT + (size_t)(h * 128 + 64 + (tid >> 3)) * NTOK + kt0_ + (tid & 7) * 8); } while (0)
#define MLA_ISSUE(t) do { MLA_ISSUE_K(t); MLA_ISSUE_V(t); } while (0)
#define MLA_COMMIT(buf) do { unsigned char* kb_ = lds + (buf) * MLA_STAGE; unsigned char* vb_ = kb_ + MLA_KB; \
            *(u32x4*)(kb_ + (tid >> 4) * MLA_KP + (tid & 15) * 16) = r0; \
            *(u32x4*)(kb_ + (32 + (tid >> 4)) * MLA_KP + (tid & 15) * 16) = r1; \
            *(u32x4*)(kb_ + (tid >> 3) * MLA_KP + 256 + (tid & 7) * 16) = r2; \
            const int g_ = (tid & 7) >> 1, e_ = tid & 1; \
            { u32x2 lo_, hi_; lo_.x = r3.x; lo_.y = r3.y; hi_.x = r3.z; hi_.y = r3.w; \
              *(u32x2*)(vb_ + (tid >> 3) * MLA_VP + g_ * 32 + e_ * 8) = lo_; *(u32x2*)(vb_ + (tid >> 3) * MLA_VP + g_ * 32 + 16 + e_ * 8) = hi_; } \
            { u32x2 lo_, hi_; lo_.x = r4.x; lo_.y = r4.y; hi_.x = r4.z; hi_.y = r4.w; \
              *(u32x2*)(vb_ + (64 + (tid >> 3)) * MLA_VP + g_ * 32 + e_ * 8) = lo_; *(u32x2*)(vb_ + (64 + (tid >> 3)) * MLA_VP + g_ * 32 + 16 + e_ * 8) = hi_; } } while (0)
        const int qtok = q0tok + w * 32 + qi;
        bf16x8 qf[12];
#pragma unroll
        for (int s = 0; s < 12; ++s) qf[s] = *(const bf16x8*)(Q + (size_t)qtok * QW + h * 192 + s * 16 + hh * 8);
        f32x16 o[4];
#pragma unroll
        for (int d = 0; d < 4; ++d)
#pragma unroll
            for (int r = 0; r < 16; ++r) o[d][r] = 0.f;
        float m = -1.0e30f, l = 0.f;
        MLA_ISSUE(0); MLA_COMMIT(0);
        __syncthreads();
        for (int t = 0; t < nt; ++t) {
            const unsigned char* kb = lds + (t & 1) * MLA_STAGE; const unsigned char* vb = kb + MLA_KB;
            f32x16 s0, s1;
#pragma unroll
            for (int r = 0; r < 16; ++r) { s0[r] = 0.f; s1[r] = 0.f; }
            {
                const unsigned char* kp0 = kb + qi * MLA_KP + hh * 16; const unsigned char* kp1 = kp0 + 32 * MLA_KP;
                bf16x8 ka[4], kn[4];
                ka[0] = *(const bf16x8*)(kp0); ka[1] = *(const bf16x8*)(kp1); ka[2] = *(const bf16x8*)(kp0 + 32); ka[3] = *(const bf16x8*)(kp1 + 32);
#pragma unroll
                for (int g = 0; g < 6; ++g) {
                    if (g < 5) { kn[0] = *(const bf16x8*)(kp0 + (2 * g + 2) * 32); kn[1] = *(const bf16x8*)(kp1 + (2 * g + 2) * 32); kn[2] = *(const bf16x8*)(kp0 + (2 * g + 3) * 32); kn[3] = *(const bf16x8*)(kp1 + (2 * g + 3) * 32); }
                    __builtin_amdgcn_sched_barrier(0);
                    s0 = MFMA32(ka[0], qf[2 * g], s0); s1 = MFMA32(ka[1], qf[2 * g], s1); s0 = MFMA32(ka[2], qf[2 * g + 1], s0); s1 = MFMA32(ka[3], qf[2 * g + 1], s1);
                    __builtin_amdgcn_sched_barrier(0);
#pragma unroll
                    for (int q = 0; q < 4; ++q) ka[q] = kn[q];
                }
            }
            if (t + 1 < nt) MLA_ISSUE(t + 1);
            float mx = fmaxf(s0[0], s1[0]);
#pragma unroll
            for (int r = 1; r < 16; ++r) mx = fmaxf(mx, fmaxf(s0[r], s1[r]));
            mx = fmaxf(mx, __shfl_xor(mx, 32));
            const float mnew = fmaxf(m, mx * c);
            const float alpha = __builtin_amdgcn_exp2f(m - mnew);
            m = mnew;
            float ps = 0.f;
#pragma unroll
            for (int r = 0; r < 16; ++r) { s0[r] = __builtin_amdgcn_exp2f(s0[r] * c - mnew); s1[r] = __builtin_amdgcn_exp2f(s1[r] * c - mnew); ps += s0[r] + s1[r]; }
            l = l * alpha + ps;
            if ((PROBE_SUB >> 9) & 1u) {
                float ps2 = 0.f;
#pragma unroll
                for (int r = 0; r < 16; ++r) { float x0 = s0[r], x1 = s1[r]; asm volatile("" : "+v"(x0), "+v"(x1)); ps2 += __builtin_amdgcn_exp2f(x0 * c - 40.f) + __builtin_amdgcn_exp2f(x1 * c - 40.f); }
                float mx2 = ps2;
#pragma unroll
                for (int r = 0; r < 16; ++r) { float x0 = s0[r], x1 = s1[r]; asm volatile("" : "+v"(x0), "+v"(x1)); mx2 = fmaxf(mx2, fmaxf(x0 * c, x1 * c)); }
                if (mx2 == 123456.75f) l += ps2;
            }
            if ((PROBE_SUB >> 10) & 1u) {
                f32x16 sx;
#pragma unroll
                for (int r = 0; r < 16; ++r) sx[r] = 0.f;
#pragma unroll
                for (int s = 0; s < 12; ++s) { bf16x8 k0 = *(const bf16x8*)(kb + qi * MLA_KP + s * 32 + hh * 16); sx = MFMA32(k0, qf[s], sx); }
                if (sx[0] == 123456.75f) l += sx[1];
            }
#pragma unroll
            for (int d = 0; d < 4; ++d)
#pragma unroll
                for (int r = 0; r < 16; ++r) o[d][r] *= alpha;
            bf16x8 pf[4];
            { u32x4 p;
              p.x = cvtpk(s0[0], s0[1]); p.y = cvtpk(s0[2], s0[3]); p.z = cvtpk(s0[4], s0[5]); p.w = cvtpk(s0[6], s0[7]); pf[0] = __builtin_bit_cast(bf16x8, p);
              p.x = cvtpk(s0[8], s0[9]); p.y = cvtpk(s0[10], s0[11]); p.z = cvtpk(s0[12], s0[13]); p.w = cvtpk(s0[14], s0[15]); pf[1] = __builtin_bit_cast(bf16x8, p);
              p.x = cvtpk(s1[0], s1[1]); p.y = cvtpk(s1[2], s1[3]); p.z = cvtpk(s1[4], s1[5]); p.w = cvtpk(s1[6], s1[7]); pf[2] = __builtin_bit_cast(bf16x8, p);
              p.x = cvtpk(s1[8], s1[9]); p.y = cvtpk(s1[10], s1[11]); p.z = cvtpk(s1[12], s1[13]); p.w = cvtpk(s1[14], s1[15]); pf[3] = __builtin_bit_cast(bf16x8, p); }
            asm volatile("" ::: "memory");
            {
                const unsigned char* vp = vb + qi * MLA_VP + hh * 16;
                bf16x8 va[4], vn[4];
#pragma unroll
                for (int g = 0; g < 4; ++g) va[g] = *(const bf16x8*)(vp + g * 32);
#pragma unroll
                for (int d = 0; d < 4; ++d) {
                    if (d < 3) {
#pragma unroll
                        for (int g = 0; g < 4; ++g) vn[g] = *(const bf16x8*)(vp + (d + 1) * 32 * MLA_VP + g * 32); }
                    __builtin_amdgcn_sched_barrier(0);
#pragma unroll
                    for (int g = 0; g < 4; ++g) o[d] = MFMA32(va[g], pf[g], o[d]);
                    __builtin_amdgcn_sched_barrier(0);
#pragma unroll
                    for (int g = 0; g < 4; ++g) va[g] = vn[g];
                }
            }
            if (t + 1 < nt) MLA_COMMIT((t + 1) & 1);
            __syncthreads();
        }
        const float inv = 1.0f / (l + __shfl_xor(l, 32));
        bf16_t* op = mix + (size_t)qtok * D + h * 128 + 4 * hh;
#pragma unroll
        for (int d = 0; d < 4; ++d)
#pragma unroll
            for (int g = 0; g < 4; ++g) { u32x2 wv; wv.x = cvtpk(o[d][4 * g] * inv, o[d][4 * g + 1] * inv); wv.y = cvtpk(o[d][4 * g + 2] * inv, o[d][4 * g + 3] * inv);
                *(u32x2*)(op + d * 32 + 8 * g) = wv; }
#undef MLA_KTOK
#undef MLA_ISSUE
#undef MLA_ISSUE_K
#undef MLA_ISSUE_V
#undef MLA_COMMIT
    }
}

constexpr int HY_CS = 8224, HY_WS = 5136, HY_WOFF = 8 * HY_CS, HY_RBL = HY_WOFF + 4 * HY_WS;
static_assert(HY_RBL + 516 * 16 <= RING_BYTES, "hyena LDS");

__device__ __forceinline__ u32x4 hy_shift(const u32x4 a, const u32x4 b, int r) {
    switch (r) {
    case 0: return b;
    case 1: return (u32x4){__builtin_amdgcn_alignbyte(b.x, a.w, 2), __builtin_amdgcn_alignbyte(b.y, b.x, 2), __builtin_amdgcn_alignbyte(b.z, b.y, 2), __builtin_amdgcn_alignbyte(b.w, b.z, 2)};
    case 2: return (u32x4){a.w, b.x, b.y, b.z};
    case 3: return (u32x4){__builtin_amdgcn_alignbyte(a.w, a.z, 2), __builtin_amdgcn_alignbyte(b.x, a.w, 2), __builtin_amdgcn_alignbyte(b.y, b.x, 2), __builtin_amdgcn_alignbyte(b.z, b.y, 2)};
    case 4: return (u32x4){a.z, a.w, b.x, b.y};
    case 5: return (u32x4){__builtin_amdgcn_alignbyte(a.z, a.y, 2), __builtin_amdgcn_alignbyte(a.w, a.z, 2), __builtin_amdgcn_alignbyte(b.x, a.w, 2), __builtin_amdgcn_alignbyte(b.y, b.x, 2)};
    case 6: return (u32x4){a.y, a.z, a.w, b.x};
    default: return (u32x4){__builtin_amdgcn_alignbyte(a.y, a.x, 2), __builtin_amdgcn_alignbyte(a.z, a.y, 2), __builtin_amdgcn_alignbyte(a.w, a.z, 2), __builtin_amdgcn_alignbyte(b.x, a.w, 2)};
    }
}

__device__ __forceinline__ void ph_hyena(const Args& a, int l, unsigned char* lds) {
    const bf16_t* __restrict__ RB = (const bf16_t*)(a.ws + WS_FILTL) + (size_t)l * 512 * HY_RBROW;
    const bf16_t* __restrict__ wtl = (const bf16_t*)(a.ws + WS_WTL);
    int tid_ = threadIdx.x; asm volatile("" : "+v"(tid_));
    const int tid = tid_, lane = tid & 63, w = __builtin_amdgcn_readfirstlane(tid >> 6), i = lane & 31, hh = lane >> 5;
    for (int unit = blockIdx.x; unit < 512; unit += gridDim.x) {
        const int c = unit;
        for (int k = tid; k < 515; k += NTHR) { u32x4 v = (u32x4){0u, 0u, 0u, 0u}; if (k < 513) v = *(const u32x4*)(RB + (size_t)c * HY_RBROW + k * 8); *(u32x4*)(lds + HY_RBL + k * 16) = v; }
        for (int k = tid; k < 4 * 321; k += NTHR) { const int b = k / 321, sl = k - b * 321; u32x4 v = (u32x4){0u, 0u, 0u, 0u};
            if (sl >= 28 && sl < 284) v = *(const u32x4*)(wtl + ((size_t)b * 512 + c) * L + (sl - 28) * 8);
            *(u32x4*)(lds + HY_WOFF + b * HY_WS + sl * 16) = v; }
        __syncthreads();
        for (int qs = lane; qs < 511; qs += 64) {
            const u32x4 ca = *(const u32x4*)(lds + HY_RBL + qs * 16), cb = *(const u32x4*)(lds + HY_RBL + qs * 16 + 16);
            *(u32x4*)(lds + w * HY_CS + qs * 16) = hy_shift(ca, cb, w);
        }
        __syncthreads();
        f32x16 acc0, acc1;
#pragma unroll
        for (int r = 0; r < 16; ++r) { acc0[r] = 0.f; acc1[r] = 0.f; }
        const int Tl = i >> 2, b = i & 3;
        const unsigned char* ap = lds + (i & 7) * HY_CS + (hh - (i >> 3) + 255) * 16;
        const unsigned char* bp = lds + HY_WOFF + b * HY_WS + (224 + 16 * (2 * (8 * w + Tl)) + 8 * hh) * 2;
        const int d0 = 16 * w - 127;
#pragma unroll 2
        for (int dd = 0; dd < 142; dd += 2) {
            const int d = d0 + dd;
            const bf16x8 a0 = *(const bf16x8*)(ap - 32 * d), b0 = *(const bf16x8*)(bp - 32 * d);
            const bf16x8 a1 = *(const bf16x8*)(ap - 32 * (d + 1)), b1 = *(const bf16x8*)(bp - 32 * (d + 1));
            acc0 = MFMA32(a0, b0, acc0); acc1 = MFMA32(a1, b1, acc1);
        }
        bf16_t* yt = (bf16_t*)(a.ws + WS_YT) + ((size_t)b * 512 + c) * L + 32 * (8 * w + Tl) + 4 * hh;
#pragma unroll
        for (int g = 0; g < 4; ++g) { u32x2 wv; wv.x = cvtpk(acc0[4 * g] + acc1[4 * g], acc0[4 * g + 1] + acc1[4 * g + 1]); wv.y = cvtpk(acc0[4 * g + 2] + acc1[4 * g + 2], acc0[4 * g + 3] + acc1[4 * g + 3]);
            *(u32x2*)(yt + 8 * g) = wv; }
        __syncthreads();
    }
}

__device__ __forceinline__ void ph_hyena_fin(const Args& a, int l, bool with_ctx, unsigned char* lds) {
    const bf16_t* __restrict__ YT = (const bf16_t*)(a.ws + WS_YT); const bf16_t* __restrict__ wtl = (const bf16_t*)(a.ws + WS_WTL); const bf16_t* __restrict__ wtc = (const bf16_t*)(a.ws + WS_WTC);
    const bf16_t* __restrict__ x0 = (const bf16_t*)(a.ws + WS_X0); const float* skip = a.in[23] + l * 512; bf16_t* __restrict__ mix = (bf16_t*)(a.ws + WS_MIX);
    int tid_ = threadIdx.x; asm volatile("" : "+v"(tid_));
    const int tid = tid_;
    bf16_t* T = (bf16_t*)lds;
    constexpr int TP = 520;
    const int nunits = with_ctx ? 144 : 128;
    for (int unit = (int)gridDim.x - 1 - (int)blockIdx.x; unit < nunits; unit += gridDim.x) {
        const bool lat = unit < 128; const int b = lat ? (unit >> 5) : ((unit - 128) >> 2), t0 = lat ? (unit & 31) * 64 : ((unit - 128) & 3) * 64;
        const int Ls = lat ? L : C; const int tok0 = lat ? b * L + t0 : NLAT + b * C + t0;
        const bf16_t* yrow = (lat ? YT : YT + (size_t)NB * 512 * L) + ((size_t)b * 512 + tid) * Ls + t0;
        const bf16_t* wrow = (lat ? wtl : wtc) + ((size_t)b * 512 + tid) * Ls + t0;
        const float sk = skip[tid];
#pragma unroll
        for (int hf = 0; hf < 2; ++hf) {
            u32x4 yv[4], wv[4];
#pragma unroll
            for (int q = 0; q < 4; ++q) { yv[q] = *(const u32x4*)(yrow + hf * 32 + q * 8); wv[q] = *(const u32x4*)(wrow + hf * 32 + q * 8); }
#pragma unroll
            for (int q = 0; q < 4; ++q) { const unsigned yy[4] = {yv[q].x, yv[q].y, yv[q].z, yv[q].w}, ww[4] = {wv[q].x, wv[q].y, wv[q].z, wv[q].w};
#pragma unroll
                for (int d = 0; d < 4; ++d) { const int t = hf * 32 + q * 8 + 2 * d;
                    T[t * TP + tid] = f2bf(__uint_as_float(yy[d] << 16) + sk * __uint_as_float(ww[d] << 16));
                    T[(t + 1) * TP + tid] = f2bf(__uint_as_float(yy[d] & 0xffff0000u) + sk * __uint_as_float(ww[d] & 0xffff0000u)); } }
        }
        __syncthreads();
#pragma unroll
        for (int j = 0; j < 8; ++j) { const int o = tid + 512 * j, t = o >> 6, cc = (o & 63) * 8;
            const u32x4 tv = *(const u32x4*)(T + t * TP + cc), xv = *(const u32x4*)(x0 + (size_t)(tok0 + t) * 512 + cc);
            const unsigned tt[4] = {tv.x, tv.y, tv.z, tv.w}, xx[4] = {xv.x, xv.y, xv.z, xv.w}; unsigned oo[4];
#pragma unroll
            for (int d = 0; d < 4; ++d) oo[d] = cvtpk(__uint_as_float(tt[d] << 16) * __uint_as_float(xx[d] << 16), __uint_as_float(tt[d] & 0xffff0000u) * __uint_as_float(xx[d] & 0xffff0000u));
            *(u32x4*)(mix + (size_t)(tok0 + t) * D + 1024 + cc) = (u32x4){oo[0], oo[1], oo[2], oo[3]}; }
        __syncthreads();
    }
}

constexpr int SWA_P = 144, SWA_KB = 64 * SWA_P, SWA_STAGE = 2 * SWA_KB;
__device__ __forceinline__ void ph_swa(const Args& a, int l, bool with_ctx, unsigned char* lds) {
    const bf16_t* __restrict__ SQ = (const bf16_t*)(a.ws + WS_SQ); const bf16_t* __restrict__ SK = (const bf16_t*)(a.ws + WS_SK); const bf16_t* __restrict__ SVT = (const bf16_t*)(a.ws + WS_SV);
    const float* sink = a.in[24] + l * 8; bf16_t* __restrict__ mix = (bf16_t*)(a.ws + WS_MIX);
    int tid_ = threadIdx.x; asm volatile("" : "+v"(tid_));
    const int tid = tid_, lane = tid & 63, w = tid >> 6, qi = lane & 31, hh = lane >> 5;
    const int nunits = with_ctx ? 288 : 256;
    const float c = 0.125f * 1.4426950408889634f;
    for (int unit = blockIdx.x; unit < nunits; unit += gridDim.x) {
        int hk, b, p0, nloc, t0loc, q0tok; bool ctxq;
        if (unit < 256) { hk = unit & 1; b = (unit >> 1) & 3; p0 = (unit >> 3) * 64; ctxq = false; q0tok = b * L + p0;
            const int lo = p0 - 128 < 0 ? 0 : p0 - 128, hi = p0 + 192 > L ? L : p0 + 192; t0loc = lo; nloc = (hi - lo) >> 6; }
        else { const int u2 = unit - 256; hk = u2 & 1; b = (u2 >> 1) & 3; p0 = (u2 >> 3) * 64; ctxq = true; q0tok = NLAT + b * C + p0; t0loc = 0; nloc = 0; }
        const int nt = nloc + 4;
#define SWA_KTOK(t) ((t) < nloc ? (b * L + t0loc + (t) * 64) : (NLAT + b * C + ((t) - nloc) * 64))
        u32x4 r0, r1;
#define SWA_ISSUE(t) do { const int kt0_ = SWA_KTOK(t); \
            r0 = *(const u32x4*)(SK + (size_t)(kt0_ + (tid >> 3)) * 128 + hk * 64 + (tid & 7) * 8); \
            r1 = *(const u32x4*)(SVT + (size_t)(hk * 64 + (tid >> 3)) * NTOK + kt0_ + (tid & 7) * 8); } while (0)
#define SWA_COMMIT(buf) do { unsigned char* kb_ = lds + (buf) * SWA_STAGE; unsigned char* vb_ = kb_ + SWA_KB; \
            *(u32x4*)(kb_ + (tid >> 3) * SWA_P + (tid & 7) * 16) = r0; \
            const int g_ = (tid & 7) >> 1, e_ = tid & 1; u32x2 lo_, hi_; lo_.x = r1.x; lo_.y = r1.y; hi_.x = r1.z; hi_.y = r1.w; \
            *(u32x2*)(vb_ + (tid >> 3) * SWA_P + g_ * 32 + e_ * 8) = lo_; *(u32x2*)(vb_ + (tid >> 3) * SWA_P + g_ * 32 + 16 + e_ * 8) = hi_; } while (0)
        const int hq = hk * 4 + (w >> 1), qpos = p0 + (w & 1) * 32 + qi, qtok = q0tok + (w & 1) * 32 + qi;
        bf16x8 qf[4];
#pragma unroll
        for (int s = 0; s < 4; ++s) qf[s] = *(const bf16x8*)(SQ + (size_t)qtok * 512 + hq * 64 + s * 16 + hh * 8);
        f32x16 o[2];
#pragma unroll
        for (int d = 0; d < 2; ++d)
#pragma unroll
            for (int r = 0; r < 16; ++r) o[d][r] = 0.f;
        float m = sink[hq] * 1.4426950408889634f, lsum = hh == 0 ? 1.0f : 0.0f;
        SWA_ISSUE(0); SWA_COMMIT(0);
        __syncthreads();
        for (int t = 0; t < nt; ++t) {
            const unsigned char* kb = lds + (t & 1) * SWA_STAGE; const unsigned char* vb = kb + SWA_KB;
            f32x16 s0, s1;
#pragma unroll
            for (int r = 0; r < 16; ++r) { s0[r] = 0.f; s1[r] = 0.f; }
#pragma unroll
            for (int s = 0; s < 4; ++s) {
                const bf16x8 k0 = *(const bf16x8*)(kb + qi * SWA_P + s * 32 + hh * 16);
                const bf16x8 k1 = *(const bf16x8*)(kb + (32 + qi) * SWA_P + s * 32 + hh * 16);
                s0 = MFMA32(k0, qf[s], s0); s1 = MFMA32(k1, qf[s], s1);
            }
            if (t + 1 < nt) SWA_ISSUE(t + 1);
            if (t < nloc) {
                const int kbase = t0loc + t * 64 + 4 * hh - qpos;
#pragma unroll
                for (int r = 0; r < 16; ++r) { const int dlt = kbase + (r & 3) + 8 * (r >> 2);
                    if (dlt > 128 || dlt < -128) s0[r] = -1.0e30f;
                    if (dlt + 32 > 128 || dlt + 32 < -128) s1[r] = -1.0e30f; }
            }
            float mx = fmaxf(s0[0], s1[0]);
#pragma unroll
            for (int r = 1; r < 16; ++r) mx = fmaxf(mx, fmaxf(s0[r], s1[r]));
            mx = fmaxf(mx, __shfl_xor(mx, 32));
            const float mnew = fmaxf(m, mx * c);
            const float alpha = __builtin_amdgcn_exp2f(m - mnew);
            m = mnew;
            float ps = 0.f;
#pragma unroll
            for (int r = 0; r < 16; ++r) { s0[r] = __builtin_amdgcn_exp2f(s0[r] * c - mnew); s1[r] = __builtin_amdgcn_exp2f(s1[r] * c - mnew); ps += s0[r] + s1[r]; }
            lsum = lsum * alpha + ps;
#pragma unroll
            for (int d = 0; d < 2; ++d)
#pragma unroll
                for (int r = 0; r < 16; ++r) o[d][r] *= alpha;
            bf16x8 pf[4];
            { u32x4 p;
              p.x = cvtpk(s0[0], s0[1]); p.y = cvtpk(s0[2], s0[3]); p.z = cvtpk(s0[4], s0[5]); p.w = cvtpk(s0[6], s0[7]); pf[0] = __builtin_bit_cast(bf16x8, p);
              p.x = cvtpk(s0[8], s0[9]); p.y = cvtpk(s0[10], s0[11]); p.z = cvtpk(s0[12], s0[13]); p.w = cvtpk(s0[14], s0[15]); pf[1] = __builtin_bit_cast(bf16x8, p);
              p.x = cvtpk(s1[0], s1[1]); p.y = cvtpk(s1[2], s1[3]); p.z = cvtpk(s1[4], s1[5]); p.w = cvtpk(s1[6], s1[7]); pf[2] = __builtin_bit_cast(bf16x8, p);
              p.x = cvtpk(s1[8], s1[9]); p.y = cvtpk(s1[10], s1[11]); p.z = cvtpk(s1[12], s1[13]); p.w = cvtpk(s1[14], s1[15]); pf[3] = __builtin_bit_cast(bf16x8, p); }
#pragma unroll
            for (int d = 0; d < 2; ++d)
#pragma unroll
                for (int g = 0; g < 4; ++g) {
                    const bf16x8 vf = *(const bf16x8*)(vb + (d * 32 + qi) * SWA_P + g * 32 + hh * 16);
                    o[d] = MFMA32(vf, pf[g], o[d]);
                }
            if (t + 1 < nt) SWA_COMMIT((t + 1) & 1);
            __syncthreads();
        }
        const float inv = 1.0f / (lsum + __shfl_xor(lsum, 32));
        bf16_t* op = mix + (size_t)qtok * D + 1536 + hq * 64 + 4 * hh;
#pragma unroll
        for (int d = 0; d < 2; ++d)
#pragma unroll
            for (int g = 0; g < 4; ++g) { u32x2 wv; wv.x = cvtpk(o[d][4 * g] * inv, o[d][4 * g + 1] * inv); wv.y = cvtpk(o[d][4 * g + 2] * inv, o[d][4 * g + 3] * inv);
                *(u32x2*)(op + d * 32 + 8 * g) = wv; }
#undef SWA_KTOK
#undef SWA_ISSUE
#undef SWA_COMMIT
    }
}


constexpr int NPHASES = 22;
#define GEMM_CALL(EPI, SCHED, g, S, E) pg8::gemm_phase<EPI, SCHED, true, true, 0>((PG8_LAS unsigned char*)lds, g, S, E)
#define GEMM_CALL8(EPI, SCHED, g, S, E) pg8::gemm_phase<EPI, SCHED, true, true, 1>((PG8_LAS unsigned char*)lds, g, S, E)
#define GEMM_CALLI8(EPI, SCHED, g, S, E) pg8::gemm_phase<EPI, SCHED, true, true, 2>((PG8_LAS unsigned char*)lds, g, S, E)

template <int LYR>
__device__ __forceinline__ void layer_phases(const Args& a, unsigned char* lds, const XcdBarrier& bar, int lo, int hi) {
#define IN(k) (lo <= (k) && (k) < hi)
#define REPS(k) for (int rep_ = 0; rep_ <= (int)((PROBE_MASK >> (k)) & 1u); ++rep_)
#if MK_PER_PHASE
#define SEAM(k) do { } while (0)
#else
#define SEAM(k) do { if (IN(k) && IN((k) + 1)) xcd_barrier(bar); } while (0)
#endif
    constexpr int P0 = 1 + LYR * 9;
    constexpr bool LAST = (LYR == 1);
    constexpr int S_WO = pg8::split_S((LAST ? NLAT : NTOK) / 256 * (D / 256), D / 64, 256);
    constexpr int S_WO0 = pg8::split_S(NTOK / 256 * (D / 256), D / 64, 256);
    constexpr int S_DN0 = pg8::split_S(NTOK / 256 * (D / 256), (FP8_DENSE || FP8_DOWN) ? DFF / 128 : DFF / 64, 256);
    constexpr int S_DN = pg8::split_S(NTOK / 256 * (D / 256), (FP8_DENSE || FP8_DOWN) ? DFF / 128 : DFF / 64, 256);
    const int G = gridDim.x, bid = blockIdx.x;
    unsigned char* ws = a.ws;
    const float* modl = (const float*)(ws + WS_MOD) + (size_t)LYR * 5 * 12288;
    float* xs = (float*)(ws + WS_XS);
    const int nq = LAST ? NLAT : NTOK;
    if (IN(P0 + 0)) REPS(P0 + 0) {
        if (LYR == 0) ph_normmod<false, false, I8_WIN ? 2 : 0>(a.in[0], a.in[2], a.in[6], modl, 0, 2048, (bf16_t*)(ws + WS_HA), NTOK, nullptr, nullptr, nullptr, nullptr, nullptr, nullptr, (float*)(ws + WS_RSC));
        else ph_normmod<false, false, I8_WIN ? 2 : 0, S_DN0>(xs, xs + (size_t)NLAT * D, a.in[6] + D, modl, 0, 2048, (bf16_t*)(ws + WS_HA), NTOK, nullptr, nullptr, nullptr, nullptr,
                                                    (const float*)(ws + WS_SLAB), (const float*)(ws + WS_MOD) + (size_t)4 * 12288 + 10240, (float*)(ws + WS_RSC));
    }
    SEAM(P0 + 0);
    if (IN(P0 + 1)) REPS(P0 + 1) {
#if I8_WIN
        pg8::Gemm g{(const bf16_t*)(ws + WS_HA), (const bf16_t*)(ws + WS_WIN + (size_t)LYR * UW * D * 2), NTOK, UW, D / 2};
        const float swin = __uint_as_float(__hip_atomic_load((const unsigned*)(ws + WS_CTL) + CT_WSC + LYR, __ATOMIC_RELAXED, __HIP_MEMORY_SCOPE_AGENT)) * (1.0f / 127.0f);
        pg8::EpiStoreI8 E{(bf16_t*)(ws + WS_U), UW, (const float*)(ws + WS_RSC), swin};
        if constexpr (LAST) { pg8::WinLastOrder S; S.init(G, bid, D / 2); GEMM_CALLI8(pg8::EpiStoreI8, pg8::WinLastOrder, g, S, E); }
        else { pg8::StaticOrder S; S.init(NTOK, UW, G, bid, D / 2); GEMM_CALLI8(pg8::EpiStoreI8, pg8::StaticOrder, g, S, E); }
#else
        pg8::Gemm g{(const bf16_t*)(ws + WS_HA), (const bf16_t*)(ws + WS_WIN + (size_t)LYR * UW * D * 2), NTOK, UW, D};
        pg8::EpiStore E{(bf16_t*)(ws + WS_U), UW};
        if constexpr (LAST) { pg8::WinLastOrder S; S.init(G, bid, D); GEMM_CALL(pg8::EpiStore, pg8::WinLastOrder, g, S, E); }
        else { pg8::StaticOrder S; if (G == 256) S.init(NTOK, UW, G1_GEMM, bid < G1_GEMM ? bid : (1 << 24), D); else S.init(NTOK, UW, G, bid, D); GEMM_CALL(pg8::EpiStore, pg8::StaticOrder, g, S, E); }
#endif
        if (!LAST && rep_ == 0 && G == 256 && bid >= TAIL1_BLK0) {
            const int f0 = bid < G1_GEMM ? NCONV_Q + (bid - TAIL1_BLK0) * TAILQ1 : NCONV_Q + TAIL1_N * TAILQ1 + (bid - G1_GEMM) * CQ1;
            ph_convert<0>(a, (float*)lds, f0, 1, f0 + (bid < G1_GEMM ? TAILQ1 : CQ1)); }
        conv_fill(a, (float*)lds, LYR * 6 + 0);
    }
    SEAM(P0 + 1);
    if (IN(P0 + 2)) REPS(P0 + 2) ph_mid(a, LYR);
    SEAM(P0 + 2);
    if (IN(P0 + 3)) REPS(P0 + 3) {
        SUBREP(0) {
        { pg8::Gemm g{(const bf16_t*)(ws + WS_CQN), (const bf16_t*)(ws + WS_WQ + (size_t)LYR * QW * 768 * 2), nq, QW, 768};
          pg8::StaticOrder S; S.init(nq, QW, G, bid, 768); pg8::EpiQ E{(bf16_t*)(ws + WS_Q), (const float*)(ws + WS_ROPE), (const float*)(ws + WS_ROPE) + 2048 * 32};
          GEMM_CALL(pg8::EpiQ, pg8::StaticOrder, g, S, E); }
        __syncthreads();
        { pg8::Gemm g{(const bf16_t*)(ws + WS_CKVN), (const bf16_t*)(ws + WS_WKV + (size_t)LYR * KVW * 512 * 2), NTOK, 1024, 512};
          pg8::StaticOrder S; S.init(NTOK, 1024, G, bid, 512); pg8::EpiStore E{(bf16_t*)(ws + WS_KN), 1024};
          GEMM_CALL(pg8::EpiStore, pg8::StaticOrder, g, S, E); }
        __syncthreads();
        { pg8::Gemm g{(const bf16_t*)(ws + WS_WKV + (size_t)LYR * KVW * 512 * 2 + (size_t)1024 * 512 * 2), (const bf16_t*)(ws + WS_CKVN), 1024, NTOK, 512};
          pg8::StaticOrder S; S.init(1024, NTOK, 108, bid >= 216 ? bid - 216 : (bid >= 144 ? bid - 108 : (1 << 24)), 512); pg8::EpiStore E{(bf16_t*)(ws + WS_VT), NTOK};
          GEMM_CALL(pg8::EpiStore, pg8::StaticOrder, g, S, E); }
        __syncthreads();
        }
        SUBREP(1) ph_hyena(a, LYR, lds);
        SUBREP(3) if (!LAST) ph_hyena_naive<C>(a, LYR, (float*)lds);
        SUBREP(2) ph_swa(a, LYR, !LAST, lds);
        conv_fill(a, (float*)lds, LYR * 6 + 1);
    }
    SEAM(P0 + 3);
    if (IN(P0 + 4)) REPS(P0 + 4) { ph_hyena_fin(a, LYR, !LAST, lds); ph_mla(a, !LAST, lds);
        if (!LAST && rep_ == 0 && G == 256 && bid >= TAIL4_BLK0 && TAILQ4 > 0) ph_convert<0>(a, (float*)lds, NCONV_Q + NCONV_T1 + NCONV_T2 + NCONV_T3 + (bid - TAIL4_BLK0) * TAILQ4, 1, NCONV_Q + NCONV_T1 + NCONV_T2 + NCONV_T3 + (bid - TAIL4_BLK0 + 1) * TAILQ4); conv_fill(a, (float*)lds, LYR * 6 + 2); }
    SEAM(P0 + 4);
    if (IN(P0 + 5)) REPS(P0 + 5) {
        pg8::Gemm g{(const bf16_t*)(ws + WS_MIX), (const bf16_t*)(ws + WS_WOUT + (size_t)LYR * D * D * 2), nq, D, D};
        pg8::SplitOrder S; S.init(nq / 256, D / 256, G, bid, D, S_WO);
        const int trow0 = S.nfull / S.nN * 256; pg8::EpiResid E{rep_ ? (float*)(ws + WS_ACT) : xs, LYR == 0 ? a.in[0] : (const float*)xs, modl + 4096, (float*)(ws + WS_SLAB), trow0, nq - trow0, 1.0f};
        GEMM_CALL(pg8::EpiResid, pg8::SplitOrder, g, S, E);
        conv_fill(a, (float*)lds, LYR * 6 + 3);
    }
    SEAM(P0 + 5);
    if (!LAST) {
#if !FP8_DENSE
        if (IN(P0 + 6)) { ph_normmod<false, true, I8_GU ? 2 : 0, S_WO0>(xs, a.in[2], a.in[7], modl, 6144, 8192, (bf16_t*)(ws + WS_HA), NTOK, xs, nullptr, nullptr, nullptr, (const float*)(ws + WS_SLAB), modl + (size_t)4 * 12288 + 4096, (float*)(ws + WS_RSC));
            conv_finish(a, (float*)lds, CONV_DENSE_END); }
        SEAM(P0 + 6);
        if (IN(P0 + 7)) REPS(P0 + 7) {
#if I8_GU
            pg8::Gemm g{(const bf16_t*)(ws + WS_HA), (const bf16_t*)(ws + WS_WGU), NTOK, 2 * DFF, D / 2};
            pg8::StaticOrder S; if (G == 256) S.init(NTOK, 2 * DFF, G2_GEMM, bid < G2_GEMM ? bid : (1 << 24), D / 2); else S.init(NTOK, 2 * DFF, G, bid, D / 2);
            const float swg = __uint_as_float(__hip_atomic_load((const unsigned*)(ws + WS_CTL) + CT_WSC + 2, __ATOMIC_RELAXED, __HIP_MEMORY_SCOPE_AGENT)) * (1.0f / 127.0f);
            const float swu = __uint_as_float(__hip_atomic_load((const unsigned*)(ws + WS_CTL) + CT_WSC + 3, __ATOMIC_RELAXED, __HIP_MEMORY_SCOPE_AGENT)) * (1.0f / 127.0f);
            pg8::EpiSwiGLUI8 E{(unsigned char*)(ws + WS_ACT), DFF, (const float*)(ws + WS_RSC), swg, swu, ASCALE};
            GEMM_CALLI8(pg8::EpiSwiGLUI8, pg8::StaticOrder, g, S, E);
            if (rep_ == 0 && G == 256 && bid >= TAIL2_BLK0) {
                const int f0 = bid < G2_GEMM ? NCONV_Q + NCONV_T1 + (bid - TAIL2_BLK0) * TAILQ2 : NCONV_Q + NCONV_T1 + TAIL2_N * TAILQ2 + (bid - G2_GEMM) * CQ2;
                ph_convert<0>(a, (float*)lds, f0, 1, f0 + (bid < G2_GEMM ? TAILQ2 : CQ2)); }
#elif FP8_DOWN
            pg8::Gemm g{(const bf16_t*)(ws + WS_HA), (const bf16_t*)(ws + WS_WGU), NTOK, 2 * DFF, D};
            pg8::StaticOrder S; S.init(NTOK, 2 * DFF, G, bid, D);
            pg8::EpiSwiGLU8 E{(unsigned char*)(ws + WS_ACT), DFF, 1.0f, ASCALE};
            GEMM_CALL(pg8::EpiSwiGLU8, pg8::StaticOrder, g, S, E);
#else
            pg8::Gemm g{(const bf16_t*)(ws + WS_HA), (const bf16_t*)(ws + WS_WGU), NTOK, 2 * DFF, D};
            pg8::StaticOrder S; S.init(NTOK, 2 * DFF, G, bid, D);
            pg8::EpiSwiGLU E{(bf16_t*)(ws + WS_ACT), DFF};
            GEMM_CALL(pg8::EpiSwiGLU, pg8::StaticOrder, g, S, E);
#endif
            conv_fill(a, (float*)lds, 4);
        }
        SEAM(P0 + 7);
        if (IN(P0 + 8)) REPS(P0 + 8) {
#if FP8_DOWN
            pg8::Gemm g{(const bf16_t*)(ws + WS_ACT), (const bf16_t*)(ws + WS_WDN), NTOK, D, DFF / 2};
            pg8::SplitOrder S; S.init(NTOK / 256, D / 256, G, bid, DFF / 2, S_DN);
            const int trow0 = S.nfull / S.nN * 256; pg8::EpiResid E{rep_ ? (float*)(ws + WS_YS) : xs, (const float*)xs, modl + 10240, (float*)(ws + WS_SLAB), trow0, NTOK - trow0, 1.0f / (ASCALE * WSCALE)};
            GEMM_CALL8(pg8::EpiResid, pg8::SplitOrder, g, S, E);
            if (rep_ == 0 && G == 256 && bid >= TAIL3_BLK0 && TAILQ3 > 0) ph_convert<0>(a, (float*)lds, NCONV_Q + NCONV_T1 + NCONV_T2 + (bid - TAIL3_BLK0) * TAILQ3, 1, NCONV_Q + NCONV_T1 + NCONV_T2 + (bid - TAIL3_BLK0 + 1) * TAILQ3);
#else
            pg8::Gemm g{(const bf16_t*)(ws + WS_ACT), (const bf16_t*)(ws + WS_WDN), NTOK, D, DFF};
            pg8::SplitOrder S; S.init(NTOK / 256, D / 256, G, bid, DFF, S_DN);
            const int trow0 = S.nfull / S.nN * 256; pg8::EpiResid E{rep_ ? (float*)(ws + WS_YS) : xs, (const float*)xs, modl + 10240, (float*)(ws + WS_SLAB), trow0, NTOK - trow0, 1.0f};
            GEMM_CALL(pg8::EpiResid, pg8::SplitOrder, g, S, E);
#endif
            conv_fill(a, (float*)lds, 5);
        }
#else
        if (IN(P0 + 6)) { ph_normmod<false, true, true, S_WO0>(xs, a.in[2], a.in[7], modl, 6144, 8192, (bf16_t*)(ws + WS_HA), NTOK, xs, nullptr, nullptr, nullptr, (const float*)(ws + WS_SLAB), modl + (size_t)4 * 12288 + 4096);
            conv_finish(a, (float*)lds, CONV_DENSE_END); }
        SEAM(P0 + 6);
        if (IN(P0 + 7)) REPS(P0 + 7) {
            pg8::Gemm g{(const bf16_t*)(ws + WS_HA), (const bf16_t*)(ws + WS_WGU), NTOK, 2 * DFF, D / 2};
            pg8::StaticOrder S; S.init(NTOK, 2 * DFF, G, bid, D / 2); pg8::EpiSwiGLU8 E{(unsigned char*)(ws + WS_ACT), DFF, 1.0f / (ASCALE * WSCALE), ASCALE};
            GEMM_CALL8(pg8::EpiSwiGLU8, pg8::StaticOrder, g, S, E);
            conv_fill(a, (float*)lds, 4);
        }
        SEAM(P0 + 7);
        if (IN(P0 + 8)) REPS(P0 + 8) {
            pg8::Gemm g{(const bf16_t*)(ws + WS_ACT), (const bf16_t*)(ws + WS_WDN), NTOK, D, DFF / 2};
            pg8::SplitOrder S; S.init(NTOK / 256, D / 256, G, bid, DFF / 2, S_DN);
            const int trow0 = S.nfull / S.nN * 256; pg8::EpiResid E{rep_ ? (float*)(ws + WS_YS) : xs, (const float*)xs, modl + 10240, (float*)(ws + WS_SLAB), trow0, NTOK - trow0, 1.0f / (ASCALE * WSCALE)};
            GEMM_CALL8(pg8::EpiResid, pg8::SplitOrder, g, S, E);
            conv_fill(a, (float*)lds, 5);
        }
#endif
        SEAM(P0 + 8);
    } else {
        if (IN(P0 + 6)) REPS(P0 + 6) ph_normmod<true, false, true>(xs, xs + (size_t)NLAT * D, a.in[7] + D, modl, 6144, 8192, (bf16_t*)(ws + WS_HA), NLAT, nullptr, a.in[29], (int*)(ws + WS_TOPI), (float*)(ws + WS_TOPW));
        SEAM(P0 + 6);
        if (IN(P0 + 7)) REPS(P0 + 7) { ph_route_gather(a, (int*)lds); conv_finish(a, (float*)lds, NCONV); }
        SEAM(P0 + 7);
        if (IN(P0 + 9)) REPS(P0 + 9) {
            pg8::Gemm g{(const bf16_t*)(ws + WS_HBS), (const bf16_t*)(ws + WS_MGU), MOE_ROWS, 2 * DFE, D / 2};
            pg8::MoeOrder S; S.init((const int*)(ws + WS_CTL), 2 * DFE / 256, G, bid, (size_t)2 * DFE * D, D / 2); pg8::EpiSwiGLU8 E{(unsigned char*)(ws + WS_ACT), DFE, 1.0f / (ASCALE * WSCALE), ASCALE};
            GEMM_CALL8(pg8::EpiSwiGLU8, pg8::MoeOrder, g, S, E);
        }
        SEAM(P0 + 9);
        if (IN(P0 + 10)) REPS(P0 + 10) {
            pg8::Gemm g{(const bf16_t*)(ws + WS_ACT), (const bf16_t*)(ws + WS_MDN), MOE_ROWS, D, DFE / 2};
            pg8::SplitOrder S; S.init_moe((const int*)(ws + WS_CTL), D / 256, G, bid, DFE / 2, (size_t)D * DFE);
            const int trow0 = S.nfull / S.nN * 256; pg8::EpiYs E{(bf16_t*)(ws + WS_YS), (float*)(ws + WS_SLAB), trow0, S.nM * 256 - trow0, 1.0f / (ASCALE * WSCALE)};
            GEMM_CALL8(pg8::EpiYs, pg8::SplitOrder, g, S, E);
        }
        SEAM(P0 + 10);
        if (IN(P0 + 11)) REPS(P0 + 11) ph_final(a);
    }
#undef IN
#undef SEAM
#undef REPS
}

__global__ void __launch_bounds__(NTHR, 2) mk_fwd(Args a) {
    extern __shared__ __attribute__((aligned(16))) unsigned char lds[];
    const int tid = threadIdx.x;
    for (int u = tid; u < (LDS_BYTES - LDSCTL_OFF) / 4; u += NTHR) ((unsigned*)(lds + LDSCTL_OFF))[u] = 0u;
    __syncthreads();
    XcdBarrier bar; bar.bar = (unsigned*)(a.ws + WS_CTL) + CW_BAR; bar.x = 0; bar.st = nullptr;
#if !MK_PER_PHASE
    bar = xcd_barrier_post((unsigned*)(a.ws + WS_CTL) + CW_BAR, (volatile LAS unsigned*)(lds + LDSCTL_OFF + 32));
#endif
    const int lo = a.ph_lo, hi = a.ph_hi;
    if (lo <= 0 && 0 < hi) {
        for (int rep_ = 0; rep_ <= (int)(PROBE_MASK & 1u); ++rep_) { ph_prologue(a, (float*)lds); __syncthreads(); }
#if !MK_PER_PHASE
        if (1 < hi) xcd_barrier(bar);
#endif
    }
    layer_phases<0>(a, lds, bar, lo, hi);
    layer_phases<1>(a, lds, bar, lo, hi);
}

extern "C" void kernel_launch(void* const* d_in, const int* in_sizes, int n_in, void* d_out, int out_size, void* d_ws, size_t ws_size, hipStream_t stream) {
    (void)in_sizes; (void)out_size;
    static int grid = 0;
    if (grid == 0) {
        if (n_in != 34 || ws_size < WS_END) { fprintf(stderr, "kernel_launch: need 34 inputs and >= %zu bytes of workspace (got %d, %zu)\n", (size_t)WS_END, n_in, ws_size); grid = -1; return; }
        int dev = 0, cus = 0, per_cu = 0;
        if (hipGetDevice(&dev) != hipSuccess || hipDeviceGetAttribute(&cus, hipDeviceAttributeMultiprocessorCount, dev) != hipSuccess) { grid = -1; return; }
        if (hipFuncSetAttribute((const void*)mk_fwd, hipFuncAttributeMaxDynamicSharedMemorySize, LDS_BYTES) != hipSuccess) { fprintf(stderr, "kernel_launch: hipFuncSetAttribute failed\n"); grid = -1; return; }
        if (hipOccupancyMaxActiveBlocksPerMultiprocessor(&per_cu, (const void*)mk_fwd, NTHR, LDS_BYTES) != hipSuccess || per_cu < 1) { fprintf(stderr, "kernel_launch: occupancy query says %d blocks per CU\n", per_cu); }
        (void)hipGetLastError();
        grid = cus;
    }
    if (grid < 0) return;
    if (hipMemsetAsync((char*)d_ws + WS_CTL, 0, CTL_ZERO_BYTES, stream) != hipSuccess) return;
    Args a{};
    for (int i = 0; i < 34; ++i) a.in[i] = (const float*)d_in[i];
    a.out = (float*)d_out; a.ws = (unsigned char*)d_ws;
#if MK_PER_PHASE
    for (int p = 0; p < NPHASES; ++p) { a.ph_lo = p; a.ph_hi = p + 1; hipLaunchKernelGGL(mk_fwd, dim3(grid), dim3(NTHR), LDS_BYTES, stream, a); }
#else
    a.ph_lo = 0; a.ph_hi = NPHASES;
    hipLaunchKernelGGL(mk_fwd, dim3(grid), dim3(NTHR), LDS_BYTES, stream, a);
#endif
}
```

```cpp
#include <hip/hip_runtime.h>
#include <stdint.h>
#include <stdio.h>

#ifndef FP8_DENSE
#define FP8_DENSE 0
#endif
#ifndef FP8_DOWN
#define FP8_DOWN 1
#endif
#ifndef I8_WIN
#define I8_WIN 0
#endif
#ifndef I8_GU
#define I8_GU 1
#endif
#ifndef I8_GEMM
#define I8_GEMM (I8_WIN || I8_GU)
#endif
#ifndef TAILQ1
#define TAILQ1 6
#endif
#ifndef TAILQ2
#define TAILQ2 3
#endif
#ifndef TAILQ3
#define TAILQ3 8
#endif
#ifndef TAILQ4
#define TAILQ4 2
#endif
#ifndef CQ1
#define CQ1 20
#endif
#ifndef CQ2
#define CQ2 26
#endif
#ifndef CONV_FILL
#define CONV_FILL 0
#endif
#ifndef PROBE_MASK
#define PROBE_MASK 0u
#endif
#ifndef PROBE_SUB
#define PROBE_SUB 0u
#endif
#ifndef MK_PER_PHASE
#define MK_PER_PHASE 0
#endif

typedef unsigned short bf16_t;
typedef float f32x4 __attribute__((ext_vector_type(4)));
typedef float f32x16 __attribute__((ext_vector_type(16)));
typedef unsigned u32x4 __attribute__((ext_vector_type(4)));
typedef unsigned u32x2 __attribute__((ext_vector_type(2)));
typedef short bf16x8 __attribute__((ext_vector_type(8)));

constexpr int D = 2048, NB = 4, L = 2048, C = 256, NLAT = NB * L, NCTX = NB * C, NTOK = NLAT + NCTX;
constexpr int UW = 3840;
constexpr int O_CQ = 0, O_CKV = 768, O_KPE = 1280, O_HY = 1344, O_SQ = 2880, O_SK = 3392, O_SV = 3520, INW = 3648;
constexpr int QW = 1536, KVW = 2048, DFF = 5632, DFE = 7168, NE = 8;
constexpr int MOE_ROWS = 18432;
constexpr float EPS = 1e-6f;
constexpr int NTHR = 512;
constexpr int HY_RBROW = 4112;

__device__ __forceinline__ float bf2f(bf16_t h) { return __uint_as_float(((unsigned)h) << 16); }
__device__ __forceinline__ bf16_t f2bf(float f) { unsigned u = __float_as_uint(f); u += 0x7fffu + ((u >> 16) & 1u); return (bf16_t)(u >> 16); }
__device__ __forceinline__ float wave_sum(float v) { for (int o = 32; o > 0; o >>= 1) v += __shfl_xor(v, o); return v; }
__device__ __forceinline__ float wave_max(float v) { for (int o = 32; o > 0; o >>= 1) v = fmaxf(v, __shfl_xor(v, o)); return v; }
__device__ __forceinline__ float silu(float x) { return x / (1.0f + __expf(-x)); }
__device__ __forceinline__ int tok_mod(int tok) { return tok < NLAT ? (tok >> 11) : 4; }

constexpr size_t al(size_t x) { return (x + 255) & ~(size_t)255; }
constexpr size_t WS_CTL = 0, CTL_ZERO_BYTES = 65536;
constexpr size_t WS_MOD = 65536;
constexpr size_t WS_ROPE = WS_MOD + al((size_t)2 * 5 * 12288 * 4);
constexpr size_t WS_FILTL = WS_ROPE + al((size_t)2 * 2048 * 32 * 4);
constexpr size_t WS_FILTC = WS_FILTL + al((size_t)2 * 512 * 4096 * 4);
constexpr size_t WS_WIN = WS_FILTC + al((size_t)2 * 512 * 512 * 4);
constexpr size_t WS_WQ = WS_WIN + al((size_t)2 * UW * D * 2);
constexpr size_t WS_WKV = WS_WQ + al((size_t)2 * QW * 768 * 2);
constexpr size_t WS_WOUT = WS_WKV + al((size_t)2 * KVW * 512 * 2);
constexpr size_t WS_WGU = WS_WOUT + al((size_t)2 * D * D * 2);
constexpr size_t WS_WDN = WS_WGU + al((size_t)2 * DFF * D * 2);
constexpr size_t WS_MGU = WS_WDN + al((size_t)D * DFF * 2);
constexpr size_t WS_MDN = WS_MGU + al((size_t)NE * 2 * DFE * D * 2);
constexpr size_t WS_HA = WS_MDN + al((size_t)NE * D * DFE * 2);
constexpr size_t WS_U = WS_HA + al((size_t)NTOK * D * 2);
constexpr size_t WS_CQN = WS_U + al((size_t)NTOK * UW * 2);
constexpr size_t WS_CKVN = WS_CQN + al((size_t)NTOK * 768 * 2);
constexpr size_t WS_KPE = WS_CKVN + al((size_t)NTOK * 512 * 2);
constexpr size_t WS_X0 = WS_KPE + al((size_t)NTOK * 64 * 2);
constexpr size_t WS_WTL = WS_X0 + al((size_t)NTOK * 512 * 2);
constexpr size_t WS_WTC = WS_WTL + al((size_t)NB * 512 * L * 2);
constexpr size_t WS_SQ = WS_WTC + al((size_t)NB * 512 * C * 2);
constexpr size_t WS_SK = WS_SQ + al((size_t)NTOK * 512 * 2);
constexpr size_t WS_SV = WS_SK + al((size_t)NTOK * 128 * 2);
constexpr size_t WS_Q = WS_SV + al((size_t)NTOK * 128 * 2);
constexpr size_t WS_KV = WS_Q + al((size_t)NTOK * QW * 2);
constexpr size_t WS_KN = WS_KV;
constexpr size_t WS_VT = WS_KV + (size_t)NTOK * 1024 * 2;
constexpr size_t WS_MIX = WS_KV + al((size_t)NTOK * KVW * 2);
constexpr size_t WS_MIXEND = WS_MIX + al((size_t)NTOK * D * 2);
constexpr size_t WS_YS = WS_U;
static_assert(WS_YS + (size_t)MOE_ROWS * D * 4 <= WS_MIXEND, "ys overlay");
constexpr size_t WS_XS = WS_MIXEND;
constexpr size_t WS_ACT = WS_XS + al((size_t)NTOK * D * 4);
constexpr size_t WS_HBS = WS_ACT + al((size_t)MOE_ROWS * DFE * 2);
constexpr size_t WS_TOPI = WS_HBS + al((size_t)MOE_ROWS * D * 2);
constexpr size_t WS_TOPW = WS_TOPI + al((size_t)NLAT * 2 * 4);
constexpr size_t WS_POS = WS_TOPW + al((size_t)NLAT * 2 * 4);
constexpr size_t WS_SRC = WS_POS + al((size_t)NLAT * 2 * 4);
constexpr size_t WS_SLAB = WS_SRC + al((size_t)MOE_ROWS * 4);
constexpr size_t WS_YT = WS_SLAB + ((size_t)64 << 20);
constexpr size_t WS_RSC = WS_YT + al((size_t)NB * 512 * (L + C) * 2);
constexpr size_t WS_END = WS_RSC + al((size_t)NTOK * 4);
constexpr int CT_EOFF = 1024, CT_EPAD = 1040, CT_NTILE = 1056, CT_MOES = 1057, CT_TROW = 1058, CT_WSC = 1088, CT_AMAXDONE = 1100;
constexpr int CW_BAR = 4096;

constexpr int RING_BYTES = 131072, LDS_BYTES = 147456, LDSCTL_OFF = LDS_BYTES - 256;

namespace pg8 {
#define PG8_LAS __attribute__((address_space(3)))
typedef unsigned short bf16_t;
typedef short bf16x8 __attribute__((ext_vector_type(8)));
typedef float f32x4 __attribute__((ext_vector_type(4)));
typedef unsigned u32x4 __attribute__((ext_vector_type(4)));
constexpr int BM = 256, BK = 64, HALF = 128, HTB = HALF * BK * 2  , STAGE_BYTES = 8 * HTB, NXCD = 8, WGM = 8;

__host__ __device__ __forceinline__ int lds_byte(int r, int c) { const int st = (r >> 4) * 2 + (c >> 5), rr = r & 15, cc = c & 31, ob = rr * 64 + cc * 2; return st * 1024 + (ob ^ (((ob >> 9) & 1) << 5)); }
__host__ __device__ __forceinline__ void stage_rc(int b, int& R, int& C) { const int st = b / 1024, sb = b % 1024, swz = sb ^ (((sb >> 9) & 1) << 5); R = (st >> 1) * 16 + swz / 64; C = (st & 1) * 32 + (swz % 64) / 2; }
__host__ __device__ __forceinline__ int perm32(int rho) { const int n = rho >> 4, i = rho & 15; return 8 * (i >> 2) + 4 * n + (i & 3); }

struct Unit { int pm, pn, kt0, nkt, slab; };
struct Gemm { const bf16_t* A; const bf16_t* Bt; int M, N, K; };

struct StaticOrder {
    int nM, nN, nwg, G, c;
    int nkt;
    __host__ __device__ void init(int M, int N, int G_, int c_, int K) { nM = M / BM; nN = N / BM; nwg = nM * nN; G = G_; c = c_; nkt = K / BK; }
    __host__ __device__ bool next(int i, Unit& u) const {
        const long L = (long)i * G + c; if (L >= nwg) return false;
        int wgid = (int)L; { const int q = nwg / NXCD, r = nwg % NXCD, xcd = wgid % NXCD, off = wgid / NXCD; wgid = (xcd < r ? xcd * (q + 1) : r * (q + 1) + (xcd - r) * q) + off; }
        const int nig = WGM * nN, gid = wgid / nig, fm = gid * WGM, gsz = (nM - fm) < WGM ? (nM - fm) : WGM;
        u.pm = fm + ((wgid % nig) % gsz); u.pn = (wgid % nig) / gsz; u.kt0 = 0; u.nkt = nkt; u.slab = -1; return true;
    }
    __device__ __forceinline__ size_t bt_off(const Unit&) const { return 0; }
    __device__ __forceinline__ void a_ready(const Unit&) const {}
    __device__ __forceinline__ void done(const Unit&) const {}
};

__device__ __forceinline__ unsigned cvt_pk_bf16(float lo, float hi) { unsigned r; asm volatile("v_cvt_pk_bf16_f32 %0, %1, %2" : "=v"(r) : "v"(lo), "v"(hi)); return r; }
typedef float f32x2 __attribute__((ext_vector_type(2)));
typedef int v8i_t __attribute__((ext_vector_type(8))); typedef int v4i_t __attribute__((ext_vector_type(4)));
template <bool F8> struct Frag;
template <> struct Frag<false> { bf16x8 h[2]; __device__ __forceinline__ void set0(bf16x8 x) { h[0] = x; } __device__ __forceinline__ void set1(bf16x8 x) { h[1] = x; } };
template <> struct Frag<true> { v8i_t v; __device__ __forceinline__ void set0(bf16x8 x) { v.lo = __builtin_bit_cast(v4i_t, x); } __device__ __forceinline__ void set1(bf16x8 x) { v.hi = __builtin_bit_cast(v4i_t, x); } };
template <class Epi, class Sched, bool ALIGN_EPI = false, bool SP2 = false, int DT = 0>
__device__ __forceinline__ void gemm_phase(PG8_LAS unsigned char* lds, const Gemm g, const Sched& S, const Epi& E) {
    int tid_ = threadIdx.x; asm volatile("" : "+v"(tid_));
    const int tid = tid_, wid = __builtin_amdgcn_readfirstlane(tid >> 6), lane = tid & 63, wr = wid >> 2, wc = wid & 3, fr = lane & 15, fq = lane >> 4;
    const int K = g.K;
    unsigned voffA[2], voffB[2];
#pragma unroll
    for (int i = 0; i < 2; ++i) { int R, C; stage_rc(tid * 16 + i * 8192, R, C); const int Rb = Epi::PERM ? ((R & ~31) + perm32(R & 31)) : R;
        voffA[i] = (unsigned)(R * K + C) * 2u; voffB[i] = (unsigned)(Rb * K + C) * 2u; }
    const size_t kstep = (size_t)(BK * 2);
    const size_t hstep = (size_t)HALF * K * 2;
    const size_t tstep = 2 * hstep;
    const unsigned ldsw = (unsigned)wid * 1024u;
    const int aoff = lds_byte(wr * 64 + fr, fq * 8), boff = lds_byte(wc * 32 + fr, fq * 8);
#define PG8_SA(b, h) (((b) * 2 + (h)) * HTB)
#define PG8_SB(b, h) ((4 + (b) * 2 + (h)) * HTB)
#define PG8_STAGE(bufoff, gbase, voff) do { _Pragma("unroll") for (int _i = 0; _i < 2; ++_i) \
        __builtin_amdgcn_global_load_lds((const unsigned*)((const char*)(gbase) + (voff)[_i]), (PG8_LAS unsigned*)(lds + (bufoff) + ldsw + _i * 8192), 16, 0, 0); } while (0)
#define PG8_LDA(dst, b, h) do { _Pragma("unroll") for (int m = 0; m < 4; ++m) { dst[m].set0(*(const PG8_LAS bf16x8*)(lds + PG8_SA(b, h) + aoff + m * 2048)); dst[m].set1(*(const PG8_LAS bf16x8*)(lds + PG8_SA(b, h) + aoff + m * 2048 + 1024)); } } while (0)
#define PG8_LDB(dst, b, h) do { _Pragma("unroll") for (int n = 0; n < 2; ++n) { dst[n].set0(*(const PG8_LAS bf16x8*)(lds + PG8_SB(b, h) + boff + n * 2048)); dst[n].set1(*(const PG8_LAS bf16x8*)(lds + PG8_SB(b, h) + boff + n * 2048 + 1024)); } } while (0)
#define PG8_MMA(ai, bj, At, Bt) do { __builtin_amdgcn_s_setprio(1); _Pragma("unroll") for (int m = 0; m < 4; ++m) _Pragma("unroll") for (int n = 0; n < 2; ++n) { \
        if constexpr (DT == 1) asm volatile("v_mfma_f32_16x16x128_f8f6f4 %0, %1, %2, %0" : "+v"(acc[ai][bj][m][n]) : "v"(Bt[n].v), "v"(At[m].v));   \
        else if constexpr (DT == 2) { _Pragma("unroll") for (int k = 0; k < 2; ++k) acc[ai][bj][m][n] = __builtin_bit_cast(f32x4, __builtin_amdgcn_mfma_i32_16x16x64_i8(__builtin_bit_cast(v4i_t, Bt[n].h[k]), __builtin_bit_cast(v4i_t, At[m].h[k]), __builtin_bit_cast(v4i_t, acc[ai][bj][m][n]), 0, 0, 0)); } \
        else { _Pragma("unroll") for (int k = 0; k < 2; ++k) acc[ai][bj][m][n] = __builtin_amdgcn_mfma_f32_16x16x32_bf16(Bt[n].h[k], At[m].h[k], acc[ai][bj][m][n], 0, 0, 0); } } \
        __builtin_amdgcn_s_setprio(0); } while (0)
#define PG8_WAIT_V(n) asm volatile("s_waitcnt vmcnt(" #n ")" ::: "memory")
#define PG8_WAIT_L(n) asm volatile("s_waitcnt lgkmcnt(" #n ")" ::: "memory")
#define PG8_BAR __builtin_amdgcn_s_barrier()
#define PG8_SCHED __builtin_amdgcn_sched_barrier(0)
    Unit cur, nxt; int ui = 0;
    if (!S.next(0, cur)) return;
    f32x4 acc[2][2][4][2];
#pragma unroll
    for (int a = 0; a < 2; ++a)
#pragma unroll
        for (int b = 0; b < 2; ++b)
#pragma unroll
            for (int m = 0; m < 4; ++m)
#pragma unroll
                for (int n = 0; n < 2; ++n) acc[a][b][m][n] = (f32x4){0.f, 0.f, 0.f, 0.f};
    Frag<DT == 1> At[4], B0[2], B1[2];
    const char* cA = (const char*)g.A + (size_t)cur.pm * tstep + (size_t)cur.kt0 * kstep; const char* cB = (const char*)g.Bt + S.bt_off(cur) + (size_t)cur.pn * tstep + (size_t)cur.kt0 * kstep;
    S.a_ready(cur);
    if constexpr (SP2) {
        PG8_STAGE(PG8_SB(0, 0), cB, voffB); PG8_STAGE(PG8_SB(0, 1), cB + hstep, voffB); PG8_STAGE(PG8_SA(0, 0), cA, voffA); PG8_STAGE(PG8_SA(0, 1), cA + hstep, voffA);
        if (wr == 1) PG8_BAR;
        PG8_WAIT_V(2); PG8_BAR;
        PG8_STAGE(PG8_SB(1, 0), cB + kstep, voffB); PG8_STAGE(PG8_SA(1, 0), cA + kstep, voffA); PG8_STAGE(PG8_SB(1, 1), cB + hstep + kstep, voffB);
        PG8_WAIT_V(6); PG8_BAR;
    } else {
        PG8_STAGE(PG8_SB(0, 0), cB, voffB); PG8_STAGE(PG8_SA(0, 0), cA, voffA); PG8_STAGE(PG8_SB(0, 1), cB + hstep, voffB); PG8_STAGE(PG8_SA(0, 1), cA + hstep, voffA);
        if (wr == 1) PG8_BAR;
        PG8_WAIT_V(4); PG8_BAR;
        PG8_STAGE(PG8_SB(1, 0), cB + kstep, voffB); PG8_STAGE(PG8_SA(1, 0), cA + kstep, voffA); PG8_STAGE(PG8_SB(1, 1), cB + hstep + kstep, voffB);
        PG8_WAIT_V(6); PG8_BAR;
    }
    for (;;) {
        const bool has_next = S.next(ui + 1, nxt);
        const char* nA = has_next ? (const char*)g.A + (size_t)nxt.pm * tstep + (size_t)nxt.kt0 * kstep : cA; const char* nB = has_next ? (const char*)g.Bt + S.bt_off(nxt) + (size_t)nxt.pn * tstep + (size_t)nxt.kt0 * kstep : cB;
        const int nt = cur.nkt;
        for (int t = 0; t < nt; t += 2) {
            const bool last = (t == nt - 2);
            const char* a1 = cA + (size_t)(t + 1) * kstep;
            const char* a2 = last ? nA : cA + (size_t)(t + 2) * kstep; const char* b2 = last ? nB : cB + (size_t)(t + 2) * kstep;
            const char* a3 = a2 + kstep; const char* b3 = b2 + kstep;
            if (last && has_next) S.a_ready(nxt);
            if constexpr (SP2) {
            PG8_LDB(B0, 0, 0); PG8_LDB(B1, 0, 1); PG8_SCHED; PG8_LDA(At, 0, 0); PG8_STAGE(PG8_SA(1, 1), a1 + hstep, voffA);
            PG8_WAIT_V(8); PG8_WAIT_L(0); PG8_BAR; PG8_MMA(0, 0, At, B0); PG8_MMA(0, 1, At, B1); PG8_BAR; PG8_SCHED;
            PG8_LDA(At, 0, 1); PG8_STAGE(PG8_SB(0, 0), b2, voffB); PG8_STAGE(PG8_SB(0, 1), b2 + hstep, voffB); PG8_STAGE(PG8_SA(0, 0), a2, voffA);
            PG8_WAIT_V(8); PG8_WAIT_L(0); PG8_BAR; PG8_MMA(1, 0, At, B0); PG8_MMA(1, 1, At, B1); PG8_BAR; PG8_SCHED;
            PG8_LDB(B0, 1, 0); PG8_LDB(B1, 1, 1); PG8_SCHED; PG8_LDA(At, 1, 0); PG8_STAGE(PG8_SA(0, 1), a2 + hstep, voffA);
            PG8_WAIT_V(8); PG8_WAIT_L(0); PG8_BAR; PG8_MMA(0, 0, At, B0); PG8_MMA(0, 1, At, B1); PG8_BAR; PG8_SCHED;
            PG8_LDA(At, 1, 1); PG8_STAGE(PG8_SB(1, 0), b3, voffB); PG8_STAGE(PG8_SB(1, 1), b3 + hstep, voffB); PG8_STAGE(PG8_SA(1, 0), a3, voffA);
            PG8_WAIT_V(8); PG8_WAIT_L(0); PG8_BAR; PG8_MMA(1, 0, At, B0); PG8_MMA(1, 1, At, B1); PG8_BAR; PG8_SCHED;
            } else {
            PG8_LDB(B0, 0, 0); PG8_SCHED; PG8_LDA(At, 0, 0); PG8_STAGE(PG8_SA(1, 1), a1 + hstep, voffA);
            PG8_WAIT_L(8); PG8_BAR; PG8_WAIT_L(0); PG8_MMA(0, 0, At, B0); PG8_BAR; PG8_SCHED;
            PG8_LDB(B1, 0, 1); PG8_STAGE(PG8_SB(0, 0), b2, voffB);
            PG8_BAR; PG8_WAIT_L(0); PG8_MMA(0, 1, At, B1); PG8_BAR;
            PG8_LDA(At, 0, 1); PG8_STAGE(PG8_SA(0, 0), a2, voffA);
            PG8_BAR; PG8_WAIT_L(0); PG8_MMA(1, 0, At, B0); PG8_BAR; PG8_SCHED;
            PG8_STAGE(PG8_SB(0, 1), b2 + hstep, voffB);
            PG8_WAIT_V(6); PG8_BAR; PG8_MMA(1, 1, At, B1); PG8_BAR;
            PG8_LDB(B0, 1, 0); PG8_SCHED; PG8_LDA(At, 1, 0); PG8_STAGE(PG8_SA(0, 1), a2 + hstep, voffA);
            PG8_WAIT_L(8); PG8_BAR; PG8_WAIT_L(0); PG8_MMA(0, 0, At, B0); PG8_BAR; PG8_SCHED;
            PG8_LDB(B1, 1, 1); PG8_STAGE(PG8_SB(1, 0), b3, voffB);
            PG8_BAR; PG8_WAIT_L(0); PG8_MMA(0, 1, At, B1); PG8_BAR;
            PG8_LDA(At, 1, 1); PG8_STAGE(PG8_SA(1, 0), a3, voffA);
            PG8_BAR; PG8_WAIT_L(0); PG8_MMA(1, 0, At, B0); PG8_BAR; PG8_SCHED;
            PG8_STAGE(PG8_SB(1, 1), b3 + hstep, voffB);
            PG8_WAIT_V(6); PG8_BAR; PG8_MMA(1, 1, At, B1); PG8_BAR;
            }
        }
        if constexpr (ALIGN_EPI) { if (wr == 0) PG8_BAR; }
        if constexpr (DT == 1) asm volatile("s_nop 15\n\ts_nop 15" ::: "memory");
        if constexpr (!Epi::AFTER_DRAIN) { E(acc, cur, wr, wc, fr, fq); S.done(cur); }
        if (!has_next) break;
#pragma unroll
        for (int a = 0; a < 2; ++a)
#pragma unroll
            for (int b = 0; b < 2; ++b)
#pragma unroll
                for (int m = 0; m < 4; ++m)
#pragma unroll
                    for (int n = 0; n < 2; ++n) acc[a][b][m][n] = (f32x4){0.f, 0.f, 0.f, 0.f};
        cur = nxt; cA = nA; cB = nB; ++ui;
        if constexpr (ALIGN_EPI) { if (wr == 1) PG8_BAR; }
    }
    PG8_WAIT_V(0);
    if constexpr (!ALIGN_EPI) { if (wr == 0) PG8_BAR; }
    PG8_BAR;
    if constexpr (Epi::AFTER_DRAIN) { E.fused(acc, cur, wr, wc, fr, fq, lds, wid, lane); S.done(cur); }
#undef PG8_SA
#undef PG8_SB
#undef PG8_STAGE
#undef PG8_LDA
#undef PG8_LDB
#undef PG8_MMA
#undef PG8_WAIT_V
#undef PG8_WAIT_L
#undef PG8_BAR
#undef PG8_SCHED
}
}

namespace pg8 {
__device__ __forceinline__ u32x4 pack8(const f32x4 v0, const f32x4 v1) { u32x4 w; w.x = cvt_pk_bf16(v0[0], v0[1]); w.y = cvt_pk_bf16(v0[2], v0[3]); w.z = cvt_pk_bf16(v1[0], v1[1]); w.w = cvt_pk_bf16(v1[2], v1[3]); return w; }
struct EpiStore {
    static constexpr bool PERM = true, AFTER_DRAIN = false;
    bf16_t* O; int ldc;
    __device__ __forceinline__ void operator()(const f32x4 (&acc)[2][2][4][2], const Unit& u, int wr, int wc, int fr, int fq) const {
        const int row0 = u.pm * BM + wr * 64 + fr, col0 = u.pn * BM + wc * 32 + 8 * fq;
#pragma unroll
        for (int ai = 0; ai < 2; ++ai)
#pragma unroll
            for (int m = 0; m < 4; ++m) { bf16_t* rowp = O + (size_t)(row0 + ai * HALF + m * 16) * ldc + col0;
#pragma unroll
                for (int bj = 0; bj < 2; ++bj) *(u32x4*)(rowp + bj * HALF) = pack8(acc[ai][bj][m][0], acc[ai][bj][m][1]); }
    }
};
struct EpiQ {
    static constexpr bool PERM = true, AFTER_DRAIN = false;
    bf16_t* O; const float* cosT; const float* sinT;
    __device__ __forceinline__ void operator()(const f32x4 (&acc)[2][2][4][2], const Unit& u, int wr, int wc, int fr, int fq) const {
        const int row0 = u.pm * BM + wr * 64 + fr, col0 = u.pn * BM + wc * 32 + 8 * fq;
#pragma unroll
        for (int ai = 0; ai < 2; ++ai)
#pragma unroll
            for (int m = 0; m < 4; ++m) { const int row = row0 + ai * HALF + m * 16; const bool lat = row < 8192; const int t = row & 2047;
#pragma unroll
                for (int bj = 0; bj < 2; ++bj) { const int col = col0 + bj * HALF; const int jn = col - 192 * (col / 192);
                    f32x4 v0 = acc[ai][bj][m][0], v1 = acc[ai][bj][m][1];
                    if (jn >= 128 && lat) { const int i0 = (jn - 128) >> 1;
                        const f32x4 cs = *(const f32x4*)(cosT + t * 32 + i0), sn = *(const f32x4*)(sinT + t * 32 + i0);
                        f32x4 r0, r1;
                        r0[0] = v0[0] * cs[0] - v0[1] * sn[0]; r0[1] = v0[0] * sn[0] + v0[1] * cs[0];
                        r0[2] = v0[2] * cs[1] - v0[3] * sn[1]; r0[3] = v0[2] * sn[1] + v0[3] * cs[1];
                        r1[0] = v1[0] * cs[2] - v1[1] * sn[2]; r1[1] = v1[0] * sn[2] + v1[1] * cs[2];
                        r1[2] = v1[2] * cs[3] - v1[3] * sn[3]; r1[3] = v1[2] * sn[3] + v1[3] * cs[3];
                        v0 = r0; v1 = r1; }
                    *(u32x4*)(O + (size_t)row * 1536 + col) = pack8(v0, v1); } }
    }
};
__device__ __forceinline__ f32x4 bf4_lo(const u32x4 q) { return (f32x4){__uint_as_float(q.x << 16), __uint_as_float(q.x & 0xffff0000u), __uint_as_float(q.y << 16), __uint_as_float(q.y & 0xffff0000u)}; }
__device__ __forceinline__ f32x4 bf4_hi(const u32x4 q) { return (f32x4){__uint_as_float(q.z << 16), __uint_as_float(q.z & 0xffff0000u), __uint_as_float(q.w << 16), __uint_as_float(q.w & 0xffff0000u)}; }
struct EpiResid {
    static constexpr bool PERM = true, AFTER_DRAIN = false;
    bf16_t* xs; const float* rd_lat; const float* gate; float* slab; int tail_row0, tail_rows; float scale;
    __device__ __forceinline__ void operator()(const f32x4 (&acc)[2][2][4][2], const Unit& u, int wr, int wc, int fr, int fq) const {
        const int row0 = u.pm * BM + wr * 64 + fr, colb = u.pn * BM + wc * 32 + 8 * fq;
        if (u.slab >= 0) {
#pragma unroll
            for (int ai = 0; ai < 2; ++ai)
#pragma unroll
                for (int m = 0; m < 4; ++m) { float* sp = slab + ((size_t)u.slab * tail_rows + (row0 + ai * HALF + m * 16 - tail_row0)) * 2048;
#pragma unroll
                    for (int bj = 0; bj < 2; ++bj)
#pragma unroll
                        for (int n = 0; n < 2; ++n) *(f32x4*)(sp + colb + bj * HALF + n * 4) = acc[ai][bj][m][n] * scale; }
            return;
        }
#pragma unroll
        for (int ai = 0; ai < 2; ++ai)
#pragma unroll
            for (int m = 0; m < 4; ++m) { const int row = row0 + ai * HALF + m * 16; const float* gv = gate + (size_t)(row < 8192 ? (row >> 11) : 4) * 12288; bf16_t* xr = xs + (size_t)row * 2048;
#pragma unroll
                for (int bj = 0; bj < 2; ++bj) { const int col = colb + bj * HALF; f32x4 x0, x1;
                    if (rd_lat) { x0 = *(const f32x4*)(rd_lat + (size_t)row * 2048 + col); x1 = *(const f32x4*)(rd_lat + (size_t)row * 2048 + col + 4); }
                    else { const u32x4 q = *(const u32x4*)(xr + col); x0 = bf4_lo(q); x1 = bf4_hi(q); }
                    const f32x4 g0 = *(const f32x4*)(gv + col), g1 = *(const f32x4*)(gv + col + 4);
                    x0 += (g0 * scale) * acc[ai][bj][m][0]; x1 += (g1 * scale) * acc[ai][bj][m][1]; *(u32x4*)(xr + col) = pack8(x0, x1); }
                if (m & 1) asm volatile("" ::: "memory"); }
    }
};
__device__ __forceinline__ unsigned pack4_fp8(float a, float b, float c, float d) {
    a = __builtin_amdgcn_fmed3f(a, -448.f, 448.f); b = __builtin_amdgcn_fmed3f(b, -448.f, 448.f); c = __builtin_amdgcn_fmed3f(c, -448.f, 448.f); d = __builtin_amdgcn_fmed3f(d, -448.f, 448.f);
    unsigned w = 0; w = __builtin_amdgcn_cvt_pk_fp8_f32(a, b, w, false); w = __builtin_amdgcn_cvt_pk_fp8_f32(c, d, w, true); return w; }
struct EpiSwiGLU8 {
    static constexpr bool PERM = true, AFTER_DRAIN = false;
    unsigned char* O; int ldc; float s, oscale;
    __device__ __forceinline__ void operator()(const f32x4 (&acc)[2][2][4][2], const Unit& u, int wr, int wc, int fr, int fq) const {
        if (PROBE_SUB != 0u && O == nullptr) return;
        const int row0 = u.pm * BM + wr * 64 + fr, col0 = u.pn * HALF + wc * 32 + 8 * fq;
#pragma unroll
        for (int ai = 0; ai < 2; ++ai)
#pragma unroll
            for (int m = 0; m < 4; ++m) { f32x4 o0, o1;
#pragma unroll
                for (int j = 0; j < 4; ++j) { const float g0 = acc[ai][0][m][0][j] * s, g1 = acc[ai][0][m][1][j] * s;
                    o0[j] = g0 * __builtin_amdgcn_rcpf(1.0f + __expf(-g0)) * (acc[ai][1][m][0][j] * (s * oscale)); o1[j] = g1 * __builtin_amdgcn_rcpf(1.0f + __expf(-g1)) * (acc[ai][1][m][1][j] * (s * oscale)); }
                u32x2 w; w.x = pack4_fp8(o0[0], o0[1], o0[2], o0[3]); w.y = pack4_fp8(o1[0], o1[1], o1[2], o1[3]);
                *(u32x2*)(O + (size_t)(row0 + ai * HALF + m * 16) * ldc + col0) = w; }
    }
};
__device__ __forceinline__ f32x4 i2f4(const f32x4 bits) { const v4i_t iv = __builtin_bit_cast(v4i_t, bits); return (f32x4){(float)iv[0], (float)iv[1], (float)iv[2], (float)iv[3]}; }
struct EpiStoreI8 {
    static constexpr bool PERM = true, AFTER_DRAIN = false;
    bf16_t* O; int ldc; const float* rsc; float sw;
    __device__ __forceinline__ void operator()(const f32x4 (&acc)[2][2][4][2], const Unit& u, int wr, int wc, int fr, int fq) const {
        const int row0 = u.pm * BM + wr * 64 + fr, col0 = u.pn * BM + wc * 32 + 8 * fq;
#pragma unroll
        for (int ai = 0; ai < 2; ++ai)
#pragma unroll
            for (int m = 0; m < 4; ++m) { const int row = row0 + ai * HALF + m * 16; const float sc = rsc[row] * sw; bf16_t* rowp = O + (size_t)row * ldc + col0;
#pragma unroll
                for (int bj = 0; bj < 2; ++bj) *(u32x4*)(rowp + bj * HALF) = pack8(i2f4(acc[ai][bj][m][0]) * sc, i2f4(acc[ai][bj][m][1]) * sc); }
    }
};
struct EpiSwiGLUI8 {
    static constexpr bool PERM = true, AFTER_DRAIN = false;
    unsigned char* O; int ldc; const float* rsc; float swg, swu, oscale;
    __device__ __forceinline__ void operator()(const f32x4 (&acc)[2][2][4][2], const Unit& u, int wr, int wc, int fr, int fq) const {
        const int row0 = u.pm * BM + wr * 64 + fr, col0 = u.pn * HALF + wc * 32 + 8 * fq;
#pragma unroll
        for (int ai = 0; ai < 2; ++ai)
#pragma unroll
            for (int m = 0; m < 4; ++m) { const int row = row0 + ai * HALF + m * 16; const float sa = rsc[row], sg = sa * swg, su = sa * swu * oscale; f32x4 o0, o1;
                const f32x4 g0v = i2f4(acc[ai][0][m][0]) * sg, g1v = i2f4(acc[ai][0][m][1]) * sg, u0v = i2f4(acc[ai][1][m][0]) * su, u1v = i2f4(acc[ai][1][m][1]) * su;
#pragma unroll
                for (int j = 0; j < 4; ++j) { o0[j] = g0v[j] * __builtin_amdgcn_rcpf(1.0f + __expf(-g0v[j])) * u0v[j]; o1[j] = g1v[j] * __builtin_amdgcn_rcpf(1.0f + __expf(-g1v[j])) * u1v[j]; }
                u32x2 w; w.x = pack4_fp8(o0[0], o0[1], o0[2], o0[3]); w.y = pack4_fp8(o1[0], o1[1], o1[2], o1[3]);
                *(u32x2*)(O + (size_t)row * ldc + col0) = w; }
    }
};
struct EpiSwiGLU {
    static constexpr bool PERM = true, AFTER_DRAIN = false;
    bf16_t* O; int ldc;
    __device__ __forceinline__ void operator()(const f32x4 (&acc)[2][2][4][2], const Unit& u, int wr, int wc, int fr, int fq) const {
        const int row0 = u.pm * BM + wr * 64 + fr, col0 = u.pn * HALF + wc * 32 + 8 * fq;
#pragma unroll
        for (int ai = 0; ai < 2; ++ai)
#pragma unroll
            for (int m = 0; m < 4; ++m) { f32x4 o0, o1;
#pragma unroll
                for (int j = 0; j < 4; ++j) { const float g0 = acc[ai][0][m][0][j], g1 = acc[ai][0][m][1][j];
                    o0[j] = g0 / (1.0f + __expf(-g0)) * acc[ai][1][m][0][j]; o1[j] = g1 / (1.0f + __expf(-g1)) * acc[ai][1][m][1][j]; }
                *(u32x4*)(O + (size_t)(row0 + ai * HALF + m * 16) * ldc + col0) = pack8(o0, o1); }
    }
};
struct EpiF32 {
    static constexpr bool PERM = false, AFTER_DRAIN = false;
    float* O; int ldc; float* slab; int tail_row0, tail_rows; float scale;
    __device__ __forceinline__ void operator()(const f32x4 (&acc)[2][2][4][2], const Unit& u, int wr, int wc, int fr, int fq) const {
        const int row0 = u.pm * BM + wr * 64 + fr, colb = u.pn * BM + wc * 32 + 4 * fq;
#pragma unroll
        for (int ai = 0; ai < 2; ++ai)
#pragma unroll
            for (int m = 0; m < 4; ++m) { float* xr = (u.slab >= 0) ? slab + ((size_t)u.slab * tail_rows + (row0 + ai * HALF + m * 16 - tail_row0)) * 2048 : O + (size_t)(row0 + ai * HALF + m * 16) * ldc;
#pragma unroll
                for (int bj = 0; bj < 2; ++bj)
#pragma unroll
                    for (int n = 0; n < 2; ++n) *(f32x4*)(xr + colb + bj * HALF + n * 16) = acc[ai][bj][m][n] * scale; }
    }
};
struct EpiYs {
    static constexpr bool PERM = false, AFTER_DRAIN = false;
    bf16_t* O; float* slab; int tail_row0, tail_rows; float scale;
    __device__ __forceinline__ void operator()(const f32x4 (&acc)[2][2][4][2], const Unit& u, int wr, int wc, int fr, int fq) const {
        const int row0 = u.pm * BM + wr * 64 + fr, colb = u.pn * BM + wc * 32 + 4 * fq;
        if (u.slab >= 0) {
#pragma unroll
            for (int ai = 0; ai < 2; ++ai)
#pragma unroll
                for (int m = 0; m < 4; ++m) { float* sp = slab + ((size_t)u.slab * tail_rows + (row0 + ai * HALF + m * 16 - tail_row0)) * 2048;
#pragma unroll
                    for (int bj = 0; bj < 2; ++bj)
#pragma unroll
                        for (int n = 0; n < 2; ++n) *(f32x4*)(sp + colb + bj * HALF + n * 16) = acc[ai][bj][m][n] * scale; }
            return;
        }
#pragma unroll
        for (int ai = 0; ai < 2; ++ai)
#pragma unroll
            for (int m = 0; m < 4; ++m) { bf16_t* xr = O + (size_t)(row0 + ai * HALF + m * 16) * 2048;
#pragma unroll
                for (int bj = 0; bj < 2; ++bj)
#pragma unroll
                    for (int n = 0; n < 2; ++n) { const f32x4 v = acc[ai][bj][m][n] * scale; u32x2 w; w.x = cvt_pk_bf16(v[0], v[1]); w.y = cvt_pk_bf16(v[2], v[3]); *(u32x2*)(xr + colb + bj * HALF + n * 16) = w; } }
    }
};
struct MoeOrder {
    int nM, nN, nwg, G, c, nkt; int t1[8]; size_t estride;
    __device__ __forceinline__ void init(const int* ctl, int nN_, int G_, int c_, size_t estride_, int K) { nkt = K / BK;
        int acc = 0;
#pragma unroll
        for (int e = 0; e < 8; ++e) { acc += __builtin_amdgcn_readfirstlane(ctl[CT_EPAD + e]) >> 8; t1[e] = acc; }
        nM = acc; nN = nN_; nwg = nM * nN; G = G_; c = c_; estride = estride_;
    }
    __device__ __forceinline__ bool next(int i, Unit& u) const {
        const long L = (long)i * G + c; if (L >= nwg) return false;
        int wgid = (int)L; { const int q = nwg / NXCD, r = nwg % NXCD, xcd = wgid % NXCD, off = wgid / NXCD; wgid = (xcd < r ? xcd * (q + 1) : r * (q + 1) + (xcd - r) * q) + off; }
        const int nig = WGM * nN, gid = wgid / nig, fm = gid * WGM, gsz = (nM - fm) < WGM ? (nM - fm) : WGM;
        u.pm = fm + ((wgid % nig) % gsz); u.pn = (wgid % nig) / gsz; u.kt0 = 0; u.nkt = nkt; u.slab = -1; return true;
    }
    __device__ __forceinline__ size_t bt_off(const Unit& u) const { int e = 0;
#pragma unroll
        for (int k = 0; k < 7; ++k) e += (u.pm >= t1[k]) ? 1 : 0;
        return (size_t)e * estride; }
    __device__ __forceinline__ void a_ready(const Unit&) const {}
    __device__ __forceinline__ void done(const Unit&) const {}
};
struct WinLastOrder {
    StaticOrder so; int G, c;
    __device__ __forceinline__ void init(int G_, int c_, int K) { so.init(NLAT, UW, G_, c_, K); G = G_; c = c_; }
    __device__ __forceinline__ bool next(int i, Unit& u) const {
        if (so.next(i, u)) return true;
        const long L = (long)i * G + c - so.nwg; if (L < 0 || L >= 20) return false;
        const int j = (int)L, k = j % 5; u.pm = 32 + j / 5; u.pn = k < 3 ? 3 + k : 10 + k; u.kt0 = 0; u.nkt = so.nkt; u.slab = -1; return true;
    }
    __device__ __forceinline__ size_t bt_off(const Unit&) const { return 0; }
    __device__ __forceinline__ void a_ready(const Unit&) const {}
    __device__ __forceinline__ void done(const Unit&) const {}
};
struct SplitOrder {
    int nM, nN, nwg, G, c, nfull, ntail, S, nkt, nkts; int t1[8]; size_t estride;
    __device__ __forceinline__ void init(int nM_, int nN_, int G_, int c_, int K, int S_) {
        nM = nM_; nN = nN_; nwg = nM * nN; G = G_; c = c_; nkt = K / BK; nfull = (nwg / 256) * 256; ntail = nwg - nfull; S = S_; nkts = nkt / S; estride = 0;
#pragma unroll
        for (int e = 0; e < 8; ++e) t1[e] = 0;
    }
    __device__ __forceinline__ void init_moe(const int* ctl, int nN_, int G_, int c_, int K, size_t estride_) {
        int acc = 0;
#pragma unroll
        for (int e = 0; e < 8; ++e) { acc += __builtin_amdgcn_readfirstlane(ctl[CT_EPAD + e]) >> 8; t1[e] = acc; }
        init(acc, nN_, G_, c_, K, __builtin_amdgcn_readfirstlane(ctl[CT_MOES])); estride = estride_;
        acc = 0;
#pragma unroll
        for (int e = 0; e < 8; ++e) { acc += __builtin_amdgcn_readfirstlane(ctl[CT_EPAD + e]) >> 8; t1[e] = acc; }
    }
    __device__ __forceinline__ bool next(int i, Unit& u) const {
        const long L = (long)i * G + c; int wgid;
        if (L < nfull) { wgid = (int)L; { const int q = nfull / NXCD, xcd = wgid % NXCD, off = wgid / NXCD; wgid = xcd * q + off; } u.kt0 = 0; u.nkt = nkt; u.slab = -1; }
        else { const int j = (int)(L - nfull); if (j >= ntail * S) return false; const int tu = j / S, sl = j - tu * S; wgid = nfull + tu; u.kt0 = sl * nkts; u.nkt = nkts; u.slab = (S > 1) ? sl : -1; }
        const int nig = WGM * nN, gid = wgid / nig, fm = gid * WGM, gsz = (nM - fm) < WGM ? (nM - fm) : WGM;
        u.pm = fm + ((wgid % nig) % gsz); u.pn = (wgid % nig) / gsz; return true;
    }
    __device__ __forceinline__ size_t bt_off(const Unit& u) const { if (estride == 0) return 0; int e = 0;
#pragma unroll
        for (int k = 0; k < 7; ++k) e += (u.pm >= t1[k]) ? 1 : 0;
        return (size_t)e * estride; }
    __device__ __forceinline__ void a_ready(const Unit&) const {}
    __device__ __forceinline__ void done(const Unit&) const {}
};
__host__ __device__ constexpr int split_S(int nwg, int nkt, int G) {
    const int ntail = nwg - (nwg / G) * G;
    if (ntail == 0) return 1;
    if (nkt % 28 == 0 && ntail * 14 <= G) return 14;
    if (nkt % 16 == 0 && ntail * 8 <= G) return 8;
    if (nkt % 14 == 0 && ntail * 7 <= G) return 7;
    if (nkt % 8 == 0 && ntail * 4 <= G) return 4;
    if (nkt % 4 == 0 && ntail * 2 <= G) return 2;
    return 1;
}
}

#define LAS __attribute__((address_space(3)))
#define XB_TMO      128
#define XB_XCNT(j)  (256  + 64 * (j))
#define XB_XSUB(j)  (1280 + 64 * (j))
#define XB_XGEN(j)  (2304 + 64 * (j))
#define XB_TOP      3328
#define XB_TOPGEN   3392
#define XCD_BAR_WORDS 3456
#define XB_SPIN_CAP (1u << 18)

__device__ __forceinline__ unsigned xb_ld(unsigned* p)              { return __hip_atomic_load(p, __ATOMIC_RELAXED, __HIP_MEMORY_SCOPE_AGENT); }
__device__ __forceinline__ unsigned xb_add(unsigned* p, unsigned v) { return __hip_atomic_fetch_add(p, v, __ATOMIC_RELAXED, __HIP_MEMORY_SCOPE_AGENT); }
__device__ __forceinline__ unsigned xb_xcc_id() { return (unsigned)__builtin_amdgcn_s_getreg((3 << 11) | 20) & 0xFu; }
#define XB_SPIN(cond, bar) do { unsigned _sp = 0; while (cond) { __builtin_amdgcn_s_sleep(1); \
    if ((++_sp & 255u) == 0u) { if (xb_ld(&(bar)[XB_TMO])) break; if (_sp > XB_SPIN_CAP) { atomicAdd(&(bar)[XB_TMO], 1u); break; } } } } while (0)

struct XcdBarrier {
    unsigned* bar; unsigned x;
    volatile LAS unsigned* st;
};

__device__ __forceinline__ XcdBarrier xcd_barrier_post(unsigned* bar, volatile LAS unsigned* st) {
    XcdBarrier b; b.bar = bar; b.x = xb_xcc_id(); b.st = st;
    if (threadIdx.x == 0) (void)xb_add(&bar[XB_XCNT(b.x)], 1u);
    return b;
}
__device__ __forceinline__ void xcd_barrier_complete(unsigned* bar, unsigned x, unsigned& nloc, unsigned& nx) {
    const unsigned G = gridDim.x * gridDim.y * gridDim.z;
    unsigned sum, cnt, mine, sp = 0u;
    for (;;) {
        sum = 0u; cnt = 0u; mine = 0u;
#pragma unroll
        for (unsigned j = 0; j < 16; ++j) { const unsigned c = xb_ld(&bar[XB_XCNT(j)]); sum += c; cnt += (c > 0u) ? 1u : 0u; mine = (j == x) ? c : mine; }
        if (sum == G) break;
        __builtin_amdgcn_s_sleep(1);
        if ((++sp & 255u) == 0u) { if (xb_ld(&bar[XB_TMO])) break; if (sp > XB_SPIN_CAP) { atomicAdd(&bar[XB_TMO], 1u); break; } }
    }
    nloc = mine > 0u ? mine : 1u; nx = cnt > 0u ? cnt : 1u;
}

__device__ __forceinline__ void xcd_barrier(const XcdBarrier& b) {
    asm volatile("s_waitcnt vmcnt(0)" ::: "memory");
    __syncthreads();
    if (threadIdx.x == 0) {
        unsigned* bar = b.bar;
        __builtin_amdgcn_s_waitcnt(0);
        unsigned nloc = b.st[0], nx = b.st[1];
        if (nloc == 0u) { xcd_barrier_complete(bar, b.x, nloc, nx); b.st[0] = nloc; b.st[1] = nx; }
        const unsigned old = xb_add(&bar[XB_XSUB(b.x)], 1u);
        const unsigned gen = old / nloc;
        if (old + 1u == (gen + 1u) * nloc) {
            __builtin_amdgcn_fence(__ATOMIC_RELEASE, "agent");
            asm volatile("s_waitcnt vmcnt(0)" ::: "memory");
            const unsigned og = xb_add(&bar[XB_TOP], 1u);
            const unsigned tg = og / nx;
            if (og + 1u == (tg + 1u) * nx) xb_add(&bar[XB_TOPGEN], 1u);
            else XB_SPIN(xb_ld(&bar[XB_TOPGEN]) == tg, bar);
            __builtin_amdgcn_fence(__ATOMIC_ACQUIRE, "agent");
            xb_add(&bar[XB_XGEN(b.x)], 1u);
            asm volatile("s_waitcnt vmcnt(0)" ::: "memory");
        } else {
            XB_SPIN(xb_ld(&bar[XB_XGEN(b.x)]) == gen, bar);
            __builtin_amdgcn_fence(__ATOMIC_ACQUIRE, "agent");
            asm volatile("s_waitcnt vmcnt(0)" ::: "memory");
        }
    }
    __syncthreads();
}


struct Args { const float* in[34]; float* out; unsigned char* ws; int ph_lo, ph_hi; };

enum { MAP_ID = 0, MAP_ROPEQ = 1, MAP_GU0 = 2, MAP_GU1 = 3, MAP_KV = 4 };
struct JobDesc { int in_idx, K, N, nbatch, upb, map; long long src_off, src_bstride, dst_off, dst_bstride; int fp8, sidx; };
constexpr int NJOBS = 14, NCONV = 12664;
constexpr int G1_GEMM = CQ1 > 0 ? 184 : 256, G2_GEMM = CQ2 > 0 ? 232 : 256;
constexpr int TAIL1_BLK0 = 540 - 2 * G1_GEMM, TAIL1_N = G1_GEMM - TAIL1_BLK0, CONV1_N = 256 - G1_GEMM;
constexpr int TAIL2_BLK0 = 1584 - 6 * G2_GEMM, TAIL2_N = G2_GEMM - TAIL2_BLK0, CONV2_N = 256 - G2_GEMM;
constexpr int TAIL3_BLK0 = 64, TAIL3_N = 192, TAIL4_BLK0 = 32, TAIL4_N = 224;
constexpr int NCONV_T1 = TAIL1_N * TAILQ1 + CONV1_N * CQ1, NCONV_T2 = TAIL2_N * TAILQ2 + CONV2_N * CQ2, NCONV_T3 = TAIL3_N * TAILQ3, NCONV_T4 = TAIL4_N * TAILQ4, NCONV_Q = NCONV - NCONV_T1 - NCONV_T2 - NCONV_T3 - NCONV_T4;
static_assert(NCONV_Q % 2 == 0 && NCONV_Q >= 1912, "the prologue queue takes pairs; the tails only hold expert weights");
__constant__ JobDesc c_jobs[NJOBS] = {
    {8, 2048, 3648, 1, 232, MAP_ID, 0, 0, (long long)WS_WIN, 0, I8_WIN ? 2 : 0, 0},
    {8, 2048, 3648, 1, 232, MAP_ID, 2048LL * 3648, 0, (long long)(WS_WIN + (size_t)UW * D * 2), 0, I8_WIN ? 2 : 0, 1},
    {10, 768, 1536, 1, 36, MAP_ROPEQ, 0, 0, (long long)WS_WQ, 0},
    {10, 768, 1536, 1, 36, MAP_ROPEQ, 768LL * 1536, 0, (long long)(WS_WQ + (size_t)QW * 768 * 2), 0},
    {12, 512, 2048, 1, 32, MAP_KV, 0, 0, (long long)WS_WKV, 0},
    {12, 512, 2048, 1, 32, MAP_KV, 512LL * 2048, 0, (long long)(WS_WKV + (size_t)KVW * 512 * 2), 0},
    {25, 2048, 2048, 1, 128, MAP_ID, 0, 0, (long long)WS_WOUT, 0},
    {25, 2048, 2048, 1, 128, MAP_ID, 2048LL * 2048, 0, (long long)(WS_WOUT + (size_t)D * D * 2), 0},
    {26, 2048, 5632, 1, 352, MAP_GU0, 0, 0, (long long)WS_WGU, 0, I8_GU ? 2 : FP8_DENSE, 2},
    {27, 2048, 5632, 1, 352, MAP_GU1, 0, 0, (long long)WS_WGU, 0, I8_GU ? 2 : FP8_DENSE, 3},
    {28, 5632, 2048, 1, 352, MAP_ID, 0, 0, (long long)WS_WDN, 0, (FP8_DENSE || FP8_DOWN), 0},
    {30, 2048, 7168, 8, 448, MAP_GU0, 0, 2048LL * 7168, (long long)WS_MGU, 2LL * DFE * D, 1, 0},
    {31, 2048, 7168, 8, 448, MAP_GU1, 0, 2048LL * 7168, (long long)WS_MGU, 2LL * DFE * D, 1, 0},
    {32, 7168, 2048, 8, 448, MAP_ID, 0, 7168LL * 2048, (long long)WS_MDN, (long long)D * DFE, 1, 0},
};
struct ConvUnit { const float* src; bf16_t* dst; int K, N, map, k0, n0, fp8; float qs; };
__device__ __forceinline__ unsigned pack4_i8(float a, float b, float c, float d) {
    const int ia = (int)__builtin_rintf(__builtin_amdgcn_fmed3f(a, -127.f, 127.f)), ib = (int)__builtin_rintf(__builtin_amdgcn_fmed3f(b, -127.f, 127.f)), ic = (int)__builtin_rintf(__builtin_amdgcn_fmed3f(c, -127.f, 127.f)), id = (int)__builtin_rintf(__builtin_amdgcn_fmed3f(d, -127.f, 127.f));
    return (unsigned)(ia & 0xff) | ((unsigned)(ib & 0xff) << 8) | ((unsigned)(ic & 0xff) << 16) | ((unsigned)(id & 0xff) << 24); }
constexpr float WSCALE = 64.f, ASCALE = 8.f;
__device__ __forceinline__ void conv_decode(const Args& a, int u, ConvUnit& cu) {
    int j = 0, base = 0;
    for (;;) { const int n = c_jobs[j].nbatch * c_jobs[j].upb; if (u < base + n || j == NJOBS - 1) break; base += n; ++j; }
    const JobDesc& jd = c_jobs[j];
    int r = u - base; const int bt = r / jd.upb; r -= bt * jd.upb; const int ntn = (jd.N + 127) >> 7; int kt = r / ntn, nt = r - kt * ntn;
    if (((jd.K >> 8) & 1) == 0) { const int r2 = r >> 1; kt = 2 * (r2 / ntn) + (r & 1); nt = r2 % ntn; }
    cu.K = jd.K; cu.N = jd.N; cu.map = jd.map; cu.k0 = kt * 256; cu.n0 = nt * 128; cu.fp8 = jd.fp8; cu.qs = 1.0f;
    if (jd.fp8 == 2) { const float am = __uint_as_float(__hip_atomic_load((const unsigned*)(a.ws + WS_CTL) + CT_WSC + jd.sidx, __ATOMIC_RELAXED, __HIP_MEMORY_SCOPE_AGENT)); cu.qs = am > 0.f ? 127.0f / am : 0.f; }
    const float* sb = j < 2 ? a.in[8] : j < 4 ? a.in[10] : j < 6 ? a.in[12] : j < 8 ? a.in[25] : j == 8 ? a.in[26] : j == 9 ? a.in[27] : j == 10 ? a.in[28] : j == 11 ? a.in[30] : j == 12 ? a.in[31] : a.in[32];
    cu.src = sb + jd.src_off + (long long)bt * jd.src_bstride + (size_t)cu.k0 * jd.N + cu.n0;
    cu.dst = (bf16_t*)(a.ws + jd.dst_off + (long long)bt * jd.dst_bstride);
}
__device__ __forceinline__ int conv_row(int map, int n) {
    if (map == MAP_ID) return n;
    if (map == MAP_GU0) return ((n >> 7) << 8) + (n & 127);
    if (map == MAP_GU1) return ((n >> 7) << 8) + 128 + (n & 127);
    if (map == MAP_KV) { const int hh = n >> 8, jn = n & 255; return jn < 128 ? hh * 128 + jn : 1024 + hh * 128 + (jn - 128); }
    const int hh = n / 192, jn = n - hh * 192; if (jn < 128) return n; const int q = jn - 128; return hh * 192 + 128 + 2 * (q & 31) + (q >> 5);
}
constexpr int CV_P = 129, CV_BUF = 65536;
#define CONV_LOAD(R, CU) do { const bool ok_ = (CU).n0 + (tid & 31) * 4 < (CU).N; const float* sp_ = (CU).src + (size_t)((tid >> 5) * 16) * (CU).N + (tid & 31) * 4; \
        _Pragma("unroll") for (int i_ = 0; i_ < 16; ++i_) R[i_] = ok_ ? __builtin_nontemporal_load((const f32x4*)(sp_ + (size_t)i_ * (CU).N)) : (f32x4){0.f, 0.f, 0.f, 0.f}; } while (0)
__device__ __forceinline__ void conv_put(const f32x4 (&R)[16], const ConvUnit& cu, unsigned char* buf, int tid) {
    const int nq = tid & 31, kc = tid >> 5;
    if (cu.fp8 == 2) {
        const float qs = cu.qs;
#pragma unroll
        for (int c = 0; c < 4; ++c) { u32x4 w;
            w.x = pack4_i8(R[0][c] * qs, R[1][c] * qs, R[2][c] * qs, R[3][c] * qs); w.y = pack4_i8(R[4][c] * qs, R[5][c] * qs, R[6][c] * qs, R[7][c] * qs);
            w.z = pack4_i8(R[8][c] * qs, R[9][c] * qs, R[10][c] * qs, R[11][c] * qs); w.w = pack4_i8(R[12][c] * qs, R[13][c] * qs, R[14][c] * qs, R[15][c] * qs);
            *(u32x4*)(buf + (4 * nq + c) * 256 + ((kc ^ (nq & 15)) << 4)) = w; }
    } else if (cu.fp8) {
#pragma unroll
        for (int c = 0; c < 4; ++c) { u32x4 w;
            w.x = pg8::pack4_fp8(R[0][c] * WSCALE, R[1][c] * WSCALE, R[2][c] * WSCALE, R[3][c] * WSCALE); w.y = pg8::pack4_fp8(R[4][c] * WSCALE, R[5][c] * WSCALE, R[6][c] * WSCALE, R[7][c] * WSCALE);
            w.z = pg8::pack4_fp8(R[8][c] * WSCALE, R[9][c] * WSCALE, R[10][c] * WSCALE, R[11][c] * WSCALE); w.w = pg8::pack4_fp8(R[12][c] * WSCALE, R[13][c] * WSCALE, R[14][c] * WSCALE, R[15][c] * WSCALE);
            *(u32x4*)(buf + (4 * nq + c) * 256 + ((kc ^ (nq & 15)) << 4)) = w; }
    } else {
#pragma unroll
        for (int c = 0; c < 4; ++c) { u32x4 w0, w1;
            w0.x = pg8::cvt_pk_bf16(R[0][c], R[1][c]); w0.y = pg8::cvt_pk_bf16(R[2][c], R[3][c]); w0.z = pg8::cvt_pk_bf16(R[4][c], R[5][c]); w0.w = pg8::cvt_pk_bf16(R[6][c], R[7][c]);
            w1.x = pg8::cvt_pk_bf16(R[8][c], R[9][c]); w1.y = pg8::cvt_pk_bf16(R[10][c], R[11][c]); w1.z = pg8::cvt_pk_bf16(R[12][c], R[13][c]); w1.w = pg8::cvt_pk_bf16(R[14][c], R[15][c]);
            *(u32x4*)(buf + (4 * nq + c) * 512 + (((2 * kc) ^ nq) << 4)) = w0; *(u32x4*)(buf + (4 * nq + c) * 512 + (((2 * kc + 1) ^ nq) << 4)) = w1; }
    }
}
__device__ __forceinline__ void conv_out(const ConvUnit& cur, const unsigned char* buf, int tid) {
    if (cur.fp8) {
#pragma unroll
        for (int j = 0; j < 4; ++j) { const int nl = (tid >> 4) + 32 * j, ch = tid & 15;
            if (cur.n0 + nl < cur.N) { const int row = conv_row(cur.map, cur.n0 + nl); const u32x4 w = *(const u32x4*)(buf + nl * 256 + ((ch ^ ((nl >> 2) & 15)) << 4));
                *(u32x4*)((unsigned char*)cur.dst + (size_t)row * cur.K + cur.k0 + ch * 16) = w; } }
    } else {
#pragma unroll
        for (int j = 0; j < 8; ++j) { const int nl = (tid >> 5) + 16 * j, ch = tid & 31;
            if (cur.n0 + nl < cur.N) { const int row = conv_row(cur.map, cur.n0 + nl); const u32x4 w = *(const u32x4*)(buf + nl * 512 + ((ch ^ ((nl >> 2) & 31)) << 4));
                *(u32x4*)((unsigned char*)cur.dst + ((size_t)row * cur.K + cur.k0) * 2 + ch * 16) = w; } }
    }
}
template <int MODE = 0>
__device__ __forceinline__ void ph_convert(const Args& a, float* tile, int first, int stride, int end) {
    const int tid = threadIdx.x; unsigned char* buf = (unsigned char*)tile;
    int u = first; ConvUnit cuA, cuB; f32x4 rA[16], rB[16];
#pragma unroll
    for (int i = 0; i < 16; ++i) { rA[i] = (f32x4){0.f, 0.f, 0.f, 0.f}; rB[i] = rA[i]; }
    if (u < end) { conv_decode(a, u, cuA); if (MODE != 2) CONV_LOAD(rA, cuA); }
    if (u + stride < end) { conv_decode(a, u + stride, cuB); if (MODE != 2) CONV_LOAD(rB, cuB); }
    while (u < end) {
        conv_put(rA, cuA, buf, tid);
        __syncthreads();
        { const ConvUnit cur = cuA; const int un = u + 2 * stride; if (un < end) { conv_decode(a, un, cuA); if (MODE != 2) CONV_LOAD(rA, cuA); } if (MODE != 1) conv_out(cur, buf, tid); }
        u += stride; if (u >= end) break;
        conv_put(rB, cuB, buf + CV_BUF, tid);
        __syncthreads();
        { const ConvUnit cur = cuB; const int un = u + 2 * stride; if (un < end) { conv_decode(a, un, cuB); if (MODE != 2) CONV_LOAD(rB, cuB); } if (MODE != 1) conv_out(cur, buf + CV_BUF, tid); }
        u += stride;
    }
    __syncthreads();
}
constexpr int CT_QNEXT = 1152;
template <int MODE = 0>
__device__ __forceinline__ void conv_dynamic(const Args& a, float* tile) {
    unsigned* qn = (unsigned*)(a.ws + WS_CTL) + CT_QNEXT; volatile int* bc = (volatile int*)(tile + 256 * CV_P + 4);
    const int tid = threadIdx.x;
    if (tid == 0) { bc[0] = (int)__hip_atomic_fetch_add(qn, 1u, __ATOMIC_RELAXED, __HIP_MEMORY_SCOPE_AGENT); bc[1] = (int)__hip_atomic_fetch_add(qn, 1u, __ATOMIC_RELAXED, __HIP_MEMORY_SCOPE_AGENT); }
    __syncthreads();
    int q = bc[0], qN = bc[1];
    __syncthreads();
    ConvUnit cuA, cuB; f32x4 rA[16], rB[16];
#pragma unroll
    for (int i = 0; i < 16; ++i) { rA[i] = (f32x4){0.f, 0.f, 0.f, 0.f}; rB[i] = rA[i]; }
    if (2 * q < NCONV_Q) { conv_decode(a, 2 * q, cuA); if (MODE != 2) CONV_LOAD(rA, cuA); }
    if (2 * q + 1 < NCONV_Q) { conv_decode(a, 2 * q + 1, cuB); if (MODE != 2) CONV_LOAD(rB, cuB); }
    unsigned char* buf = (unsigned char*)tile;
    while (2 * q < NCONV_Q) {
        const bool hasB = 2 * q + 1 < NCONV_Q;
        conv_put(rA, cuA, buf, tid);
        __syncthreads();
        { const ConvUnit cur = cuA; if (2 * qN < NCONV_Q) { conv_decode(a, 2 * qN, cuA); if (MODE != 2) CONV_LOAD(rA, cuA); }
          if (tid == 0) bc[0] = (int)__hip_atomic_fetch_add(qn, 1u, __ATOMIC_RELAXED, __HIP_MEMORY_SCOPE_AGENT);
          if (MODE != 1) conv_out(cur, buf, tid); }
        if (hasB) {
            conv_put(rB, cuB, buf + CV_BUF, tid);
            __syncthreads();
            { const ConvUnit cur = cuB; if (2 * qN + 1 < NCONV_Q) { conv_decode(a, 2 * qN + 1, cuB); if (MODE != 2) CONV_LOAD(rB, cuB); }
              if (MODE != 1) conv_out(cur, buf + CV_BUF, tid); }
        } else __syncthreads();
        q = qN; qN = bc[0];
    }
    __syncthreads();
}
#undef CONV_LOAD
constexpr int CONV_STATIC = 856, CONV_DENSE_END = 1912, CONV_BATCH = 2;
__device__ __forceinline__ constexpr int CT_DONE(int k) { return 1216 + 64 * k; }
__device__ __forceinline__ void conv_fill(const Args& a, float* tile, int done_idx) {
#if !CONV_FILL
    (void)a; (void)tile; (void)done_idx; return;
#endif
    unsigned* ctl = (unsigned*)(a.ws + WS_CTL); volatile int* bc = (volatile int*)(tile + 256 * CV_P + 4);
    const int tid = threadIdx.x;
    if (tid == 0) (void)__hip_atomic_fetch_add(ctl + CT_DONE(done_idx), 1u, __ATOMIC_RELAXED, __HIP_MEMORY_SCOPE_AGENT);
    for (;;) {
        if (tid == 0) { int q = -1;
            if (__hip_atomic_load(ctl + CT_DONE(done_idx), __ATOMIC_RELAXED, __HIP_MEMORY_SCOPE_AGENT) < gridDim.x) {
                q = (int)__hip_atomic_fetch_add(ctl + CT_QNEXT, (unsigned)CONV_BATCH, __ATOMIC_RELAXED, __HIP_MEMORY_SCOPE_AGENT) + CONV_STATIC; if (q >= NCONV) q = -1; }
            *bc = q; }
        __syncthreads();
        const int q = *bc;
        __syncthreads();
        if (q < 0) break;
        ph_convert(a, tile, q, 1, (q + CONV_BATCH < NCONV) ? q + CONV_BATCH : NCONV);
    }
}
__device__ __forceinline__ void conv_finish(const Args& a, float* tile, int upto) {
#if !CONV_FILL
    (void)a; (void)tile; (void)upto; return;
#endif
    unsigned* ctl = (unsigned*)(a.ws + WS_CTL); volatile int* bc = (volatile int*)(tile + 256 * CV_P + 4);
    const int tid = threadIdx.x;
    for (;;) {
        if (tid == 0) { int q = -1;
            if ((int)__hip_atomic_load(ctl + CT_QNEXT, __ATOMIC_RELAXED, __HIP_MEMORY_SCOPE_AGENT) + CONV_STATIC < upto) {
                q = (int)__hip_atomic_fetch_add(ctl + CT_QNEXT, (unsigned)CONV_BATCH, __ATOMIC_RELAXED, __HIP_MEMORY_SCOPE_AGENT) + CONV_STATIC; if (q >= NCONV) q = -1; }
            *bc = q; }
        __syncthreads();
        const int q = *bc;
        __syncthreads();
        if (q < 0) break;
        ph_convert(a, tile, q, 1, (q + CONV_BATCH < NCONV) ? q + CONV_BATCH : NCONV);
    }
}
__device__ __forceinline__ void adaln_unit(const Args& a, int unit, float* sm) {
    const float* c = a.in[1]; const float* cctx = a.in[3]; const float* w_mod = a.in[4]; const float* b_mod = a.in[5]; float* mod = (float*)(a.ws + WS_MOD);
    const int tid = threadIdx.x, l = unit / 96, chunk = unit - l * 96;
    const int cg = tid & 31, ks = tid >> 5;
    for (int i = tid; i < 5 * 2048; i += 512) { const int v = i >> 11, k = i & 2047; const float val = v < 4 ? c[v * 2048 + k] : cctx[k]; sm[i] = val / (1.0f + __expf(-val)); }
    __syncthreads();
    float acc[5][4];
#pragma unroll
    for (int v = 0; v < 5; ++v)
#pragma unroll
        for (int j = 0; j < 4; ++j) acc[v][j] = 0.f;
    const float* wp = w_mod + ((size_t)l * 2048 + (size_t)ks * 128) * 12288 + chunk * 128 + cg * 4;
    for (int kb = 0; kb < 128; kb += 16) {
        f32x4 w[16];
#pragma unroll
        for (int kk = 0; kk < 16; ++kk) w[kk] = __builtin_nontemporal_load((const f32x4*)(wp + (size_t)(kb + kk) * 12288));
#pragma unroll
        for (int kk = 0; kk < 16; ++kk) { const int k = ks * 128 + kb + kk;
#pragma unroll
            for (int v = 0; v < 5; ++v) { const float s = sm[v * 2048 + k];
#pragma unroll
                for (int j = 0; j < 4; ++j) acc[v][j] += s * w[kk][j]; } }
    }
    __syncthreads();
#pragma unroll
    for (int v = 0; v < 5; ++v)
#pragma unroll
        for (int j = 0; j < 4; ++j) sm[(ks * 5 + v) * 128 + cg * 4 + j] = acc[v][j];
    __syncthreads();
    for (int o = tid; o < 640; o += 512) {
        const int v = o >> 7, cc = o & 127; float s = 0.f;
#pragma unroll
        for (int k2 = 0; k2 < 16; ++k2) s += sm[(k2 * 5 + v) * 128 + cc];
        mod[((size_t)l * 5 + v) * 12288 + chunk * 128 + cc] = s + b_mod[(size_t)l * 12288 + chunk * 128 + cc];
    }
    __syncthreads();
}
constexpr int FW_W1 = 0, FW_W2 = 2112, FW_W3 = 6208, FW_B1 = 10304, FW_B2 = 10368, FW_B3 = 10432, FW_FR = 10496, FW_ZS = 10560, FW_HA = 10848, FW_HB = 11360, FW_END = 11872;
__device__ __forceinline__ void filters_unit(const Args& a, int l, int r, float* sm) {
    float (*zs)[36] = (float (*)[36])(sm + FW_ZS); float (*ha)[64] = (float (*)[64])(sm + FW_HA); float (*hb)[64] = (float (*)[64])(sm + FW_HB);
    const int tid = threadIdx.x;
    const bool lat = r < 256; const int Lf = lat ? 2048 : 256; const int p0 = lat ? r * 8 : (r - 256) * 8;
    float* T = (float*)(a.ws + WS_FILTC) + (size_t)l * 512 * 512;
    const float* wf = a.in[21] + (size_t)l * 64 * 1024;
    const int p = tid >> 6, j = tid & 63; const int pos = p0 + p;
    const float tn = (float)pos / (float)(Lf - 1);
    if (j < 33) {
        float z;
        if (j == 0) z = tn;
        else { const int bi = (j - 1) & 15; const float band = 1e-4f + (float)bi * ((15.0f - 1e-4f) / 15.0f);
               const float ang = (6.283185307179586f / (float)Lf) * (float)pos * band; z = (j <= 16) ? __cosf(ang) : -__sinf(ang); }
        zs[p][j] = z;
    }
    __syncthreads();
    const float f = sm[FW_FR + j];
    { float s = sm[FW_B1 + j];
#pragma unroll
      for (int i = 0; i < 33; ++i) s += zs[p][i] * sm[FW_W1 + i * 64 + j];
      ha[p][j] = __sinf(f * s); }
    __syncthreads();
    { float s = sm[FW_B2 + j];
#pragma unroll 16
      for (int i = 0; i < 64; ++i) s += ha[p][i] * sm[FW_W2 + i * 64 + j];
      hb[p][j] = __sinf(f * s); }
    __syncthreads();
    { float s = sm[FW_B3 + j];
#pragma unroll 16
      for (int i = 0; i < 64; ++i) s += hb[p][i] * sm[FW_W3 + i * 64 + j];
      ha[p][j] = __sinf(f * s); }
    __syncthreads();
    float acc[2][8];
#pragma unroll
    for (int rr = 0; rr < 2; ++rr)
#pragma unroll
        for (int q = 0; q < 8; ++q) acc[rr][q] = 0.f;
    for (int ib = 0; ib < 64; ib += 16) {
        float wa[16], wb[16];
#pragma unroll
        for (int i = 0; i < 16; ++i) { wa[i] = wf[(ib + i) * 1024 + tid]; wb[i] = wf[(ib + i) * 1024 + 512 + tid]; }
#pragma unroll
        for (int i = 0; i < 16; ++i) {
#pragma unroll
            for (int q = 0; q < 8; ++q) { const float h = ha[q][ib + i]; acc[0][q] += h * wa[i]; acc[1][q] += h * wb[i]; } }
    }
    const int ch = tid;
    const float delta = 3.0701134573253944f + (float)ch * ((15.350567286626972f - 3.0701134573253944f) / 511.0f);
#pragma unroll
    for (int q = 0; q < 8; ++q) {
        const int ps = p0 + q; const float dec = __expf(-((float)ps / (float)(Lf - 1)) * delta);
        const float vf = acc[0][q] * dec, vb = acc[1][q] * dec;
        if (lat) { bf16_t* RBp = (bf16_t*)(a.ws + WS_FILTL) + ((size_t)l * 512 + ch) * HY_RBROW; RBp[2048 - ps] = f2bf(vf); if (ps > 0) RBp[2048 + ps] = f2bf(vb); }
        else { T[(size_t)ch * (2 * Lf) + Lf + ps] = vf; if (ps > 0) T[(size_t)ch * (2 * Lf) + Lf - ps] = vb; else T[(size_t)ch * (2 * Lf)] = 0.f; }
    }
    __syncthreads();
}
__device__ __forceinline__ void ph_filters(const Args& a, float* sm, int fb, int nfb) {
    const int tid = threadIdx.x;
    for (int l = 0; l < 2; ++l) {
        for (int i = tid; i < 2112; i += NTHR) sm[FW_W1 + i] = a.in[15][l * 2112 + i];
        for (int i = tid; i < 4096; i += NTHR) { sm[FW_W2 + i] = a.in[17][l * 4096 + i]; sm[FW_W3 + i] = a.in[19][l * 4096 + i]; }
        if (tid < 64) { sm[FW_B1 + tid] = a.in[16][l * 64 + tid]; sm[FW_B2 + tid] = a.in[18][l * 64 + tid]; sm[FW_B3 + tid] = a.in[20][l * 64 + tid]; sm[FW_FR + tid] = a.in[22][l * 64 + tid]; }
        __syncthreads();
        for (int r = fb; r < 288; r += nfb) filters_unit(a, l, r, sm);
        __syncthreads();
    }
}
#define SUBREP(b) for (int srep_ = 0; srep_ <= (int)((PROBE_SUB >> (b)) & 1u); ++srep_)
__device__ __forceinline__ void ph_absmax(const Args& a, float* sm) {
    unsigned* ctl = (unsigned*)(a.ws + WS_CTL); const int tid = threadIdx.x, G = gridDim.x, bid = blockIdx.x, lane = tid & 63, w = tid >> 6;
#pragma unroll
    for (int j = (I8_WIN ? 0 : 2); j < (I8_GU ? 4 : 2); ++j) {
        const f32x4* p4 = (const f32x4*)(j == 0 ? a.in[8] : j == 1 ? a.in[8] + (size_t)2048 * 3648 : j == 2 ? a.in[26] : a.in[27]);
        const int n4 = (j < 2 ? 2048 * 3648 : 2048 * 5632) / 4, step = G * 512;
        float mm = 0.f;
        for (int i0 = bid * 512 + tid; i0 < n4; i0 += step * 8) {
            f32x4 v[8];
#pragma unroll
            for (int u = 0; u < 8; ++u) { const int i = i0 + u * step; v[u] = i < n4 ? __builtin_nontemporal_load(p4 + i) : (f32x4){0.f, 0.f, 0.f, 0.f}; }
#pragma unroll
            for (int u = 0; u < 8; ++u) mm = fmaxf(mm, fmaxf(fmaxf(fabsf(v[u][0]), fabsf(v[u][1])), fmaxf(fabsf(v[u][2]), fabsf(v[u][3]))));
        }
        mm = wave_max(mm);
        if (lane == 0) sm[w] = mm;
        __syncthreads();
        if (tid == 0) { float t = sm[0];
#pragma unroll
            for (int k = 1; k < 8; ++k) t = fmaxf(t, sm[k]);
            (void)__hip_atomic_fetch_max(ctl + CT_WSC + j, __float_as_uint(t), __ATOMIC_RELAXED, __HIP_MEMORY_SCOPE_AGENT); }
        __syncthreads();
    }
    if (tid == 0) (void)__hip_atomic_fetch_add(ctl + CT_AMAXDONE, 1u, __ATOMIC_RELAXED, __HIP_MEMORY_SCOPE_AGENT);
}
__device__ __forceinline__ void ph_prologue(const Args& a, float* sm) {
    const int bid = blockIdx.x, G = gridDim.x, tid = threadIdx.x;
    const int NF = G >= 128 ? 64 : 0;
    if (I8_GEMM) ph_absmax(a, sm);
    if (NF == 0) { SUBREP(4) for (int u = bid; u < 192; u += G) adaln_unit(a, u, sm); SUBREP(5) ph_filters(a, sm, bid, G); }
    else if (bid < NF) { SUBREP(5) ph_filters(a, sm, bid, NF); }
    else { SUBREP(4) for (int u = bid - NF; u < 192; u += G - NF) adaln_unit(a, u, sm); }
    { float* cosT = (float*)(a.ws + WS_ROPE); float* sinT = cosT + 2048 * 32;
      for (int i = bid * 512 + tid; i < 2048 * 32; i += G * 512) { const int t = i >> 5, f = i & 31;
          const float pos = (float)((f < 16) ? (t >> 6) : (t & 63)); const float freq = powf(10000.0f, -(float)(f & 15) / 16.0f); const float ang = pos * freq;
          cosT[i] = cosf(ang); sinT[i] = sinf(ang); } }
    for (int i = bid * 512 + tid; i < 2 * 512 * 17; i += G * 512) { const int row = i / 17, k = i - row * 17; ((bf16_t*)(a.ws + WS_FILTL))[(size_t)row * HY_RBROW + (k == 0 ? 0 : 4095 + k)] = 0; }
    { constexpr int RB16 = I8_WIN ? 128 : 256;
      for (int i = bid * 512 + tid; i < 2 * 192 * RB16; i += G * 512) { const int l = i / (192 * RB16), r = i % (192 * RB16);
        *(u32x4*)(a.ws + WS_WIN + (size_t)l * UW * D * 2 + (size_t)INW * RB16 * 16 + (size_t)r * 16) = (u32x4){0u, 0u, 0u, 0u}; } }
    if (I8_GEMM) {
        if (tid == 0) { const unsigned* dn = (const unsigned*)(a.ws + WS_CTL) + CT_AMAXDONE; unsigned sp = 0;
            while (__hip_atomic_load(dn, __ATOMIC_RELAXED, __HIP_MEMORY_SCOPE_AGENT) < (unsigned)G && ++sp < (1u << 22)) __builtin_amdgcn_s_sleep(4); }
    }
    __syncthreads();
    if ((PROBE_SUB >> 8) & 1u) ph_convert<2>(a, sm, bid, G, NCONV);
    if (!((PROBE_SUB >> 11) & 1u) || bid < 64) conv_dynamic<0>(a, sm);
    if (G != 256) ph_convert<0>(a, sm, NCONV_Q + bid, G, NCONV);
    if ((PROBE_SUB >> 6) & 1u) ph_convert<0>(a, sm, bid, G, NCONV);
    if ((PROBE_SUB >> 7) & 1u) ph_convert<1>(a, sm, bid, G, NCONV);
}

template <bool ROUTER, bool COPYX, int OUT8 = 0, int NSLAB = 0, bool XLB = true, bool XCB = true>
__device__ __forceinline__ void ph_normmod(const void* __restrict__ xlat, const void* __restrict__ xctx, const float* __restrict__ gain, const float* __restrict__ modl, int sh_off, int sc_off,
                                           bf16_t* __restrict__ out, int nrows, bf16_t* __restrict__ xs, const float* __restrict__ router, int* __restrict__ topi, float* __restrict__ topw,
                                           const float* __restrict__ slab = nullptr, const float* __restrict__ slab_gate = nullptr, float* __restrict__ rsc = nullptr) {
    const int lane = threadIdx.x & 63, wid = threadIdx.x >> 6;
    for (int row = blockIdx.x * 8 + wid; row < nrows; row += gridDim.x * 8) {
        const bool lat = row < NLAT; const size_t xoff = lat ? (size_t)row * D : (size_t)(row - NLAT) * D;
        const float* mv = modl + (size_t)tok_mod(row) * 12288;
        f32x4 v[8]; float ss = 0.f;
#pragma unroll
        for (int i = 0; i < 8; ++i) { const int cl = i * 256 + lane * 4;
            if (lat) { if (XLB) { const u32x2 q = *(const u32x2*)((const bf16_t*)xlat + xoff + cl); v[i] = (f32x4){__uint_as_float(q.x << 16), __uint_as_float(q.x & 0xffff0000u), __uint_as_float(q.y << 16), __uint_as_float(q.y & 0xffff0000u)}; }
                       else v[i] = *(const f32x4*)((const float*)xlat + xoff + cl); }
            else { if (XCB) { const u32x2 q = *(const u32x2*)((const bf16_t*)xctx + xoff + cl); v[i] = (f32x4){__uint_as_float(q.x << 16), __uint_as_float(q.x & 0xffff0000u), __uint_as_float(q.y << 16), __uint_as_float(q.y & 0xffff0000u)}; }
                   else v[i] = *(const f32x4*)((const float*)xctx + xoff + cl); }
            if (NSLAB > 0 && row >= NLAT) { f32x4 sa = *(const f32x4*)(slab + (size_t)(row - NLAT) * D + i * 256 + lane * 4);
#pragma unroll
                for (int sl = 1; sl < NSLAB; ++sl) sa += *(const f32x4*)(slab + ((size_t)sl * NCTX + (row - NLAT)) * D + i * 256 + lane * 4);
                v[i] += *(const f32x4*)(slab_gate + i * 256 + lane * 4) * sa; }
            ss += v[i][0] * v[i][0] + v[i][1] * v[i][1] + v[i][2] * v[i][2] + v[i][3] * v[i][3];
            if (COPYX && (NSLAB == 0 || row >= NLAT)) { u32x2 w; w.x = pg8::cvt_pk_bf16(v[i][0], v[i][1]); w.y = pg8::cvt_pk_bf16(v[i][2], v[i][3]); *(u32x2*)(xs + (size_t)row * D + i * 256 + lane * 4) = w; } }
        ss = wave_sum(ss);
        const float rstd = rsqrtf(ss * (1.0f / D) + EPS);
        float lg[8];
#pragma unroll
        for (int e = 0; e < 8; ++e) lg[e] = 0.f;
        float amax = 0.f;
#pragma unroll
        for (int i = 0; i < 8; ++i) {
            const int col = i * 256 + lane * 4;
            const f32x4 g = *(const f32x4*)(gain + col), sc = *(const f32x4*)(mv + sc_off + col), sh = *(const f32x4*)(mv + sh_off + col);
            f32x4 o;
#pragma unroll
            for (int j = 0; j < 4; ++j) o[j] = (v[i][j] * rstd * g[j]) * (1.0f + sc[j]) + sh[j];
            if (OUT8 == 2) { v[i] = o; amax = fmaxf(amax, fmaxf(fmaxf(fabsf(o[0]), fabsf(o[1])), fmaxf(fabsf(o[2]), fabsf(o[3])))); }
            else if (OUT8 == 1) *(unsigned*)((unsigned char*)out + (size_t)row * D + col) = pg8::pack4_fp8(o[0] * ASCALE, o[1] * ASCALE, o[2] * ASCALE, o[3] * ASCALE);
            else { u32x2 w; w.x = (unsigned)f2bf(o[0]) | ((unsigned)f2bf(o[1]) << 16); w.y = (unsigned)f2bf(o[2]) | ((unsigned)f2bf(o[3]) << 16);
                *(u32x2*)(out + (size_t)row * D + col) = w; }
            if (ROUTER) {
#pragma unroll
                for (int j = 0; j < 4; ++j) { const f32x4 r0 = *(const f32x4*)(router + (size_t)(col + j) * 8), r1 = *(const f32x4*)(router + (size_t)(col + j) * 8 + 4);
                    lg[0] += o[j] * r0[0]; lg[1] += o[j] * r0[1]; lg[2] += o[j] * r0[2]; lg[3] += o[j] * r0[3];
                    lg[4] += o[j] * r1[0]; lg[5] += o[j] * r1[1]; lg[6] += o[j] * r1[2]; lg[7] += o[j] * r1[3]; }
                asm volatile("" ::: "memory");
            }
        }
        if (OUT8 == 2) {
            amax = wave_max(amax); const float qs = amax > 0.f ? 127.0f / amax : 0.f;
#pragma unroll
            for (int i = 0; i < 8; ++i) *(unsigned*)((unsigned char*)out + (size_t)row * D + i * 256 + lane * 4) = pack4_i8(v[i][0] * qs, v[i][1] * qs, v[i][2] * qs, v[i][3] * qs);
            if (lane == 0) rsc[row] = amax * (1.0f / 127.0f);
        }
        if (ROUTER) {
#pragma unroll
            for (int e = 0; e < 8; ++e) lg[e] = wave_sum(lg[e]);
            if (lane == 0) {
                int i0 = 0; float v0 = lg[0];
#pragma unroll
                for (int e = 1; e < 8; ++e) if (lg[e] > v0) { v0 = lg[e]; i0 = e; }
                int i1 = -1; float v1 = -3.0e38f;
#pragma unroll
                for (int e = 0; e < 8; ++e) if (e != i0 && lg[e] > v1) { v1 = lg[e]; i1 = e; }
                const float e1 = expf(v1 - v0), w0 = 1.0f / (1.0f + e1), w1 = e1 / (1.0f + e1);
                topi[row * 2] = i0; topi[row * 2 + 1] = i1; topw[row * 2] = w0; topw[row * 2 + 1] = w1;
            }
        }
    }
}

__device__ __forceinline__ float bflo(unsigned w) { return __uint_as_float(w << 16); }
__device__ __forceinline__ float bfhi(unsigned w) { return __uint_as_float(w & 0xffff0000u); }
__device__ __forceinline__ unsigned pkbf(float lo, float hi) { return (unsigned)f2bf(lo) | ((unsigned)f2bf(hi) << 16); }
__device__ __forceinline__ u32x4 rope8(const u32x4 mine, const u32x4 other, bool is_x2, const f32x4 c0, const f32x4 c1, const f32x4 s0, const f32x4 s1) {
    const unsigned mw[4] = {mine.x, mine.y, mine.z, mine.w}, ow[4] = {other.x, other.y, other.z, other.w};
    const float cs[8] = {c0[0], c0[1], c0[2], c0[3], c1[0], c1[1], c1[2], c1[3]}, sn[8] = {s0[0], s0[1], s0[2], s0[3], s1[0], s1[1], s1[2], s1[3]};
    unsigned o[4];
#pragma unroll
    for (int d = 0; d < 4; ++d) {
        const float m0 = bflo(mw[d]), m1 = bfhi(mw[d]), p0 = bflo(ow[d]), p1 = bfhi(ow[d]);
        const float r0 = is_x2 ? (p0 * sn[2 * d] + m0 * cs[2 * d]) : (m0 * cs[2 * d] - p0 * sn[2 * d]);
        const float r1 = is_x2 ? (p1 * sn[2 * d + 1] + m1 * cs[2 * d + 1]) : (m1 * cs[2 * d + 1] - p1 * sn[2 * d + 1]);
        o[d] = pkbf(r0, r1);
    }
    return (u32x4){o[0], o[1], o[2], o[3]};
}
__device__ __forceinline__ u32x4 shfl4(const u32x4 v, int m) { return (u32x4){(unsigned)__shfl_xor((int)v.x, m), (unsigned)__shfl_xor((int)v.y, m), (unsigned)__shfl_xor((int)v.z, m), (unsigned)__shfl_xor((int)v.w, m)}; }
__device__ __forceinline__ void ph_mid(const Args& a, int l) {
    const bf16_t* __restrict__ U = (const bf16_t*)(a.ws + WS_U);
    const float* g_q = a.in[9] + l * 768; const float* g_kv = a.in[11] + l * 512; const float* conv_w = a.in[13] + (size_t)l * 3 * 1536; const float* conv_b = a.in[14] + l * 1536;
    const float* cosT = (const float*)(a.ws + WS_ROPE); const float* sinT = cosT + 2048 * 32;
    bf16_t* cqn = (bf16_t*)(a.ws + WS_CQN); bf16_t* ckvn = (bf16_t*)(a.ws + WS_CKVN); bf16_t* kpe = (bf16_t*)(a.ws + WS_KPE); bf16_t* x0o = (bf16_t*)(a.ws + WS_X0);
    bf16_t* wtl = (bf16_t*)(a.ws + WS_WTL); bf16_t* wtc = (bf16_t*)(a.ws + WS_WTC); bf16_t* sq = (bf16_t*)(a.ws + WS_SQ); bf16_t* sk = (bf16_t*)(a.ws + WS_SK); bf16_t* sv = (bf16_t*)(a.ws + WS_SV);
    int tid_ = threadIdx.x; asm volatile("" : "+v"(tid_));
    const int tid = tid_, lane = tid & 63, wid = tid >> 6;
    for (int unit = blockIdx.x; unit < NTOK / 16; unit += gridDim.x) {
        const int tok0 = unit * 16;
        for (int tt = 0; tt < 2; ++tt) {
            const int tok = tok0 + wid * 2 + tt; const bool lat = tok < NLAT; const int t = lat ? (tok & 2047) : ((tok - NLAT) & 255);
            const bf16_t* u = U + (size_t)tok * UW;
            const u32x2 q0 = *(const u32x2*)(u + O_CQ + lane * 12), q1 = *(const u32x2*)(u + O_CQ + lane * 12 + 4), q2 = *(const u32x2*)(u + O_CQ + lane * 12 + 8);
            const u32x4 kvv = *(const u32x4*)(u + O_CKV + lane * 8);
            const u32x4 sqv = *(const u32x4*)(u + O_SQ + lane * 8);
            const u32x4 skv = *(const u32x4*)(u + O_SK + (lane & 15) * 8);
            const u32x4 kpv = *(const u32x4*)(u + O_KPE + (lane & 7) * 8);
            const int i0 = (lane & 3) * 8;
            f32x4 c0 = (f32x4){1.f, 1.f, 1.f, 1.f}, c1 = c0, s0 = (f32x4){0.f, 0.f, 0.f, 0.f}, s1 = s0;
            if (lat) { c0 = *(const f32x4*)(cosT + t * 32 + i0); c1 = *(const f32x4*)(cosT + t * 32 + i0 + 4); s0 = *(const f32x4*)(sinT + t * 32 + i0); s1 = *(const f32x4*)(sinT + t * 32 + i0 + 4); }
            {
                const unsigned w6[6] = {q0.x, q0.y, q1.x, q1.y, q2.x, q2.y}; float x[12]; float ss = 0.f;
#pragma unroll
                for (int d = 0; d < 6; ++d) { x[2 * d] = bflo(w6[d]); x[2 * d + 1] = bfhi(w6[d]); ss += x[2 * d] * x[2 * d] + x[2 * d + 1] * x[2 * d + 1]; }
                ss = wave_sum(ss); const float rs = rsqrtf(ss * (1.0f / 768.0f) + EPS);
                const f32x4 g0 = *(const f32x4*)(g_q + lane * 12), g1 = *(const f32x4*)(g_q + lane * 12 + 4), g2 = *(const f32x4*)(g_q + lane * 12 + 8);
                u32x2 o0, o1, o2;
                o0.x = pkbf(x[0] * rs * g0[0], x[1] * rs * g0[1]); o0.y = pkbf(x[2] * rs * g0[2], x[3] * rs * g0[3]);
                o1.x = pkbf(x[4] * rs * g1[0], x[5] * rs * g1[1]); o1.y = pkbf(x[6] * rs * g1[2], x[7] * rs * g1[3]);
                o2.x = pkbf(x[8] * rs * g2[0], x[9] * rs * g2[1]); o2.y = pkbf(x[10] * rs * g2[2], x[11] * rs * g2[3]);
                bf16_t* dst = cqn + (size_t)tok * 768 + lane * 12; *(u32x2*)dst = o0; *(u32x2*)(dst + 4) = o1; *(u32x2*)(dst + 8) = o2;
            }
            {
                const unsigned w4[4] = {kvv.x, kvv.y, kvv.z, kvv.w}; float x[8]; float ss = 0.f;
#pragma unroll
                for (int d = 0; d < 4; ++d) { x[2 * d] = bflo(w4[d]); x[2 * d + 1] = bfhi(w4[d]); ss += x[2 * d] * x[2 * d] + x[2 * d + 1] * x[2 * d + 1]; }
                ss = wave_sum(ss); const float rs = rsqrtf(ss * (1.0f / 512.0f) + EPS);
                const f32x4 g0 = *(const f32x4*)(g_kv + lane * 8), g1 = *(const f32x4*)(g_kv + lane * 8 + 4);
                u32x4 o; o.x = pkbf(x[0] * rs * g0[0], x[1] * rs * g0[1]); o.y = pkbf(x[2] * rs * g0[2], x[3] * rs * g0[3]); o.z = pkbf(x[4] * rs * g1[0], x[5] * rs * g1[1]); o.w = pkbf(x[6] * rs * g1[2], x[7] * rs * g1[3]);
                *(u32x4*)(ckvn + (size_t)tok * 512 + lane * 8) = o;
            }
            const bool is_x2 = (lane & 4) != 0;
            {
                const u32x4 r = rope8(sqv, shfl4(sqv, 4), is_x2, c0, c1, s0, s1);
                *(u32x4*)(sq + (size_t)tok * 512 + lane * 8) = r;
            }
            {
                const u32x4 r = rope8(skv, shfl4(skv, 4), is_x2, c0, c1, s0, s1);
                if (lane < 16) *(u32x4*)(sk + (size_t)tok * 128 + lane * 8) = r;
            }
            {
                const u32x4 ot = shfl4(kpv, 4);
                if (lane < 4) {
                    const unsigned mw[4] = {kpv.x, kpv.y, kpv.z, kpv.w}, ow[4] = {ot.x, ot.y, ot.z, ot.w};
                    const float cs[8] = {c0[0], c0[1], c0[2], c0[3], c1[0], c1[1], c1[2], c1[3]}, sn[8] = {s0[0], s0[1], s0[2], s0[3], s1[0], s1[1], s1[2], s1[3]};
                    unsigned o[8];
#pragma unroll
                    for (int d = 0; d < 4; ++d) { const float a0 = bflo(mw[d]), a1 = bfhi(mw[d]), b0 = bflo(ow[d]), b1 = bfhi(ow[d]);
                        o[2 * d] = pkbf(a0 * cs[2 * d] - b0 * sn[2 * d], a0 * sn[2 * d] + b0 * cs[2 * d]);
                        o[2 * d + 1] = pkbf(a1 * cs[2 * d + 1] - b1 * sn[2 * d + 1], a1 * sn[2 * d + 1] + b1 * cs[2 * d + 1]); }
                    bf16_t* dst = kpe + (size_t)tok * 64 + lane * 16;
                    *(u32x4*)dst = (u32x4){o[0], o[1], o[2], o[3]}; *(u32x4*)(dst + 8) = (u32x4){o[4], o[5], o[6], o[7]};
                }
            }
        }
        {
            const bool lat = tok0 < NLAT; const int Ls = lat ? L : C;
            const int b = lat ? (tok0 >> 11) : ((tok0 - NLAT) >> 8), t0 = (lat ? (tok0 & 2047) : ((tok0 - NLAT) & 255));
            const int cp = tid & 255, hf = tid >> 8, ch = cp * 2, ts = t0 + hf * 8, tokb = tok0 + hf * 8;
            float cw[3][3][2], cb[3][2];
#pragma unroll
            for (int g = 0; g < 3; ++g) { cb[g][0] = conv_b[g * 512 + ch]; cb[g][1] = conv_b[g * 512 + ch + 1];
#pragma unroll
                for (int j = 0; j < 3; ++j) { cw[g][j][0] = conv_w[j * 1536 + g * 512 + ch]; cw[g][j][1] = conv_w[j * 1536 + g * 512 + ch + 1]; } }
            unsigned rows[3][10];
#pragma unroll
            for (int r = 0; r < 10; ++r) { const int tr = ts - 1 + r; const bool ok = tr >= 0 && tr < Ls;
#pragma unroll
                for (int g = 0; g < 3; ++g) rows[g][r] = ok ? *(const unsigned*)(U + (size_t)(tokb - 1 + r) * UW + O_HY + g * 512 + ch) : 0u; }
            unsigned wp0[4], wp1[4];
#pragma unroll
            for (int i = 0; i < 8; ++i) {
                float y[3][2];
#pragma unroll
                for (int g = 0; g < 3; ++g) {
                    y[g][0] = cb[g][0] + cw[g][0][0] * bflo(rows[g][i]) + cw[g][1][0] * bflo(rows[g][i + 1]) + cw[g][2][0] * bflo(rows[g][i + 2]);
                    y[g][1] = cb[g][1] + cw[g][0][1] * bfhi(rows[g][i]) + cw[g][1][1] * bfhi(rows[g][i + 1]) + cw[g][2][1] * bfhi(rows[g][i + 2]); }
                *(unsigned*)(x0o + (size_t)(tokb + i) * 512 + ch) = pkbf(y[0][0], y[0][1]);
                const unsigned w0 = f2bf(y[2][0] * y[1][0]), w1 = f2bf(y[2][1] * y[1][1]);
                if (i & 1) { wp0[i >> 1] |= w0 << 16; wp1[i >> 1] |= w1 << 16; } else { wp0[i >> 1] = w0; wp1[i >> 1] = w1; }
            }
            bf16_t* wt = lat ? wtl + ((size_t)b * 512 + ch) * L + ts : wtc + ((size_t)b * 512 + ch) * C + ts;
            *(u32x4*)wt = (u32x4){wp0[0], wp0[1], wp0[2], wp0[3]};
            *(u32x4*)(wt + (lat ? L : C)) = (u32x4){wp1[0], wp1[1], wp1[2], wp1[3]};
        }
        if (tid < 128) {
            unsigned pk[8];
#pragma unroll
            for (int i = 0; i < 16; ++i) { const unsigned v = U[(size_t)(tok0 + i) * UW + O_SV + tid]; if (i & 1) pk[i >> 1] |= v << 16; else pk[i >> 1] = v; }
            bf16_t* dst = sv + (size_t)tid * NTOK + tok0;
            u32x4 w0, w1; w0.x = pk[0]; w0.y = pk[1]; w0.z = pk[2]; w0.w = pk[3]; w1.x = pk[4]; w1.y = pk[5]; w1.z = pk[6]; w1.w = pk[7];
            *(u32x4*)dst = w0; *(u32x4*)(dst + 8) = w1;
        }
    }
}

__device__ __forceinline__ void ph_mla_naive(const Args& a, int nq, float* sm) {
    const bf16_t* __restrict__ Q = (const bf16_t*)(a.ws + WS_Q); const bf16_t* __restrict__ KV = (const bf16_t*)(a.ws + WS_KV); const bf16_t* __restrict__ KPE = (const bf16_t*)(a.ws + WS_KPE);
    bf16_t* mix = (bf16_t*)(a.ws + WS_MIX);
    const int lane = threadIdx.x & 63, w = threadIdx.x >> 6;
    float* qf = sm + w * 192; float* sc = sm + 8 * 192 + w * 2304;
    for (int unit = blockIdx.x; unit < nq; unit += gridDim.x) {
        const int h = unit & 7, qt = (unit >> 3) * 8 + w; const bool lat = qt < NLAT;
        const int b = lat ? (qt >> 11) : ((qt - NLAT) >> 8);
        const int nk = lat ? (L + C) : C;
        for (int i = lane; i < 192; i += 64) qf[i] = bf2f(Q[(size_t)qt * QW + h * 192 + i]);
        __syncthreads();
        const float scale = 0.07216878364870322f;
        float mx = -3.0e38f;
        for (int kc = 0; kc < nk; kc += 64) {
            const int kk = kc + lane;
            const int kt = lat ? (kk < L ? b * L + kk : NLAT + b * C + (kk - L)) : (NLAT + b * C + kk);
            float s = 0.f;
            const u32x4* kp = (const u32x4*)(KV + (size_t)kt * KVW + h * 256);
            for (int i = 0; i < 16; ++i) { const u32x4 v = kp[i]; const float* q8 = qf + i * 8;
                s += q8[0] * __uint_as_float(v.x << 16) + q8[1] * __uint_as_float(v.x & 0xffff0000u) + q8[2] * __uint_as_float(v.y << 16) + q8[3] * __uint_as_float(v.y & 0xffff0000u)
                   + q8[4] * __uint_as_float(v.z << 16) + q8[5] * __uint_as_float(v.z & 0xffff0000u) + q8[6] * __uint_as_float(v.w << 16) + q8[7] * __uint_as_float(v.w & 0xffff0000u); }
            const u32x4* pp = (const u32x4*)(KPE + (size_t)kt * 64);
            for (int i = 0; i < 8; ++i) { const u32x4 v = pp[i]; const float* q8 = qf + 128 + i * 8;
                s += q8[0] * __uint_as_float(v.x << 16) + q8[1] * __uint_as_float(v.x & 0xffff0000u) + q8[2] * __uint_as_float(v.y << 16) + q8[3] * __uint_as_float(v.y & 0xffff0000u)
                   + q8[4] * __uint_as_float(v.z << 16) + q8[5] * __uint_as_float(v.z & 0xffff0000u) + q8[6] * __uint_as_float(v.w << 16) + q8[7] * __uint_as_float(v.w & 0xffff0000u); }
            s *= scale; sc[kk] = s; mx = fmaxf(mx, s);
        }
        mx = wave_max(mx);
        float sum = 0.f;
        for (int kc = 0; kc < nk; kc += 64) { const float p = expf(sc[kc + lane] - mx); sc[kc + lane] = p; sum += p; }
        sum = wave_sum(sum);
        __syncthreads();
        float o0 = 0.f, o1 = 0.f;
        for (int kk = 0; kk < nk; ++kk) {
            const int kt = lat ? (kk < L ? b * L + kk : NLAT + b * C + (kk - L)) : (NLAT + b * C + kk);
            const unsigned v = *(const unsigned*)(KV + (size_t)kt * KVW + h * 256 + 128 + lane * 2);
            const float p = sc[kk];
            o0 += p * __uint_as_float(v << 16); o1 += p * __uint_as_float(v & 0xffff0000u);
        }
        const float inv = 1.0f / sum;
        *(unsigned*)(mix + (size_t)qt * D + h * 128 + lane * 2) = (unsigned)f2bf(o0 * inv) | ((unsigned)f2bf(o1 * inv) << 16);
        __syncthreads();
    }
}
__device__ __forceinline__ void ph_swa_naive(const Args& a, int l, int nq, float* sm) {
    const bf16_t* __restrict__ SQ = (const bf16_t*)(a.ws + WS_SQ); const bf16_t* __restrict__ SK = (const bf16_t*)(a.ws + WS_SK); const bf16_t* __restrict__ SV = (const bf16_t*)(a.ws + WS_SV);
    const float* sink = a.in[24] + l * 8; bf16_t* mix = (bf16_t*)(a.ws + WS_MIX);
    const int lane = threadIdx.x & 63, w = threadIdx.x >> 6;
    float* qf = sm + w * 64; float* sc = sm + 8 * 64 + w * 576; int* kts = (int*)(sm + 8 * 64 + 8 * 576) + w * 576;
    for (int unit = blockIdx.x; unit < nq; unit += gridDim.x) {
        const int hq = unit & 7, hk = hq >> 2, qt = (unit >> 3) * 8 + w; const bool lat = qt < NLAT;
        const int b = lat ? (qt >> 11) : ((qt - NLAT) >> 8), t = lat ? (qt & 2047) : 0;
        int lo = 0, nloc = 0;
        if (lat) { lo = t - 128 < 0 ? 0 : t - 128; const int hi = t + 128 > L - 1 ? L - 1 : t + 128; nloc = hi - lo + 1; }
        const int nk = nloc + C;
        qf[lane] = bf2f(SQ[(size_t)qt * 512 + hq * 64 + lane]);
        __syncthreads();
        const float skv = sink[hq];
        float mx = skv;
        for (int kc = 0; kc < nk; kc += 64) {
            const int kk = kc + lane;
            if (kk < nk) {
                const int kt = kk < nloc ? (b * L + lo + kk) : (NLAT + b * C + (kk - nloc));
                const u32x4* kp = (const u32x4*)(SK + (size_t)kt * 128 + hk * 64);
                float s = 0.f;
                for (int i = 0; i < 8; ++i) { const u32x4 v = kp[i]; const float* q8 = qf + i * 8;
                    s += q8[0] * __uint_as_float(v.x << 16) + q8[1] * __uint_as_float(v.x & 0xffff0000u) + q8[2] * __uint_as_float(v.y << 16) + q8[3] * __uint_as_float(v.y & 0xffff0000u)
                       + q8[4] * __uint_as_float(v.z << 16) + q8[5] * __uint_as_float(v.z & 0xffff0000u) + q8[6] * __uint_as_float(v.w << 16) + q8[7] * __uint_as_float(v.w & 0xffff0000u); }
                s *= 0.125f; sc[kk] = s; kts[kk] = kt; mx = fmaxf(mx, s);
            }
        }
        mx = wave_max(mx);
        float sum = 0.f;
        for (int kc = 0; kc < nk; kc += 64) { const int kk = kc + lane; if (kk < nk) { const float p = expf(sc[kk] - mx); sc[kk] = p; sum += p; } }
        sum = wave_sum(sum) + expf(skv - mx);
        __syncthreads();
        float o = 0.f;
        for (int kk = 0; kk < nk; ++kk) o += sc[kk] * bf2f(SV[(size_t)kts[kk] * 128 + hk * 64 + lane]);
        mix[(size_t)qt * D + 1536 + hq * 64 + lane] = f2bf(o / sum);
        __syncthreads();
    }
}
template <int LS>
__device__ __forceinline__ void ph_hyena_naive(const Args& a, int l, float* sm) {
    const float* filt = LS == L ? (const float*)(a.ws + WS_FILTL) + (size_t)l * 512 * 4096 : (const float*)(a.ws + WS_FILTC) + (size_t)l * 512 * 512;
    const bf16_t* wt = (const bf16_t*)(a.ws + (LS == L ? WS_WTL : WS_WTC)); const bf16_t* x0 = (const bf16_t*)(a.ws + WS_X0); const float* skip = a.in[23] + l * 512;
    bf16_t* mix = (bf16_t*)(a.ws + WS_MIX); const int tok_base = LS == L ? 0 : NLAT;
    float* T = sm; float* ws = sm + 2 * LS; const int tid = threadIdx.x;
    for (int unit = blockIdx.x; unit < 512 * NB; unit += gridDim.x) {
        const int ch = unit >> 2, b = unit & 3;
        for (int i = tid; i < 2 * LS; i += NTHR) T[i] = filt[(size_t)ch * 2 * LS + i];
        for (int i = tid; i < LS; i += NTHR) ws[i] = bf2f(wt[((size_t)b * 512 + ch) * LS + i]);
        __syncthreads();
        const float sk = skip[ch];
        for (int t = tid; t < LS; t += NTHR) {
            float y = 0.f;
            for (int s = 0; s < LS; ++s) y += T[t - s + LS] * ws[s];
            ((bf16_t*)(a.ws + WS_YT))[(LS == L ? (size_t)0 : (size_t)NB * 512 * L) + ((size_t)b * 512 + ch) * LS + t] = f2bf(y);
        }
        __syncthreads();
    }
}
__device__ __forceinline__ void ph_route_gather(const Args& a, int* sm) {
    const int* __restrict__ topi = (const int*)(a.ws + WS_TOPI); int* __restrict__ pos = (int*)(a.ws + WS_POS); int* ctl = (int*)(a.ws + WS_CTL);
    const unsigned char* __restrict__ hb = (const unsigned char*)(a.ws + WS_HA); unsigned char* __restrict__ hbs = (unsigned char*)(a.ws + WS_HBS);
    int (*cnt)[512] = (int (*)[512])sm; int* tot = sm + 8 * 512; int* ppos = sm + 8 * 512 + 16;
    const int tid = threadIdx.x, lane = tid & 63, w = tid >> 6;
    int c[8];
#pragma unroll
    for (int e = 0; e < 8; ++e) c[e] = 0;
    for (int i = 0; i < 32; i += 4) { const u32x4 e4 = *(const u32x4*)(topi + tid * 32 + i);
#pragma unroll
        for (int q = 0; q < 8; ++q) c[q] += (e4.x == (unsigned)q) + (e4.y == (unsigned)q) + (e4.z == (unsigned)q) + (e4.w == (unsigned)q); }
#pragma unroll
    for (int e = 0; e < 8; ++e) cnt[e][tid] = c[e];
    __syncthreads();
    {
        int v[8]; int s8 = 0;
#pragma unroll
        for (int k = 0; k < 8; ++k) { v[k] = cnt[w][lane * 8 + k]; s8 += v[k]; }
        int incl = s8;
#pragma unroll
        for (int off = 1; off < 64; off <<= 1) { const int t = __shfl_up(incl, off); if (lane >= off) incl += t; }
        int run = incl - s8;
#pragma unroll
        for (int k = 0; k < 8; ++k) { cnt[w][lane * 8 + k] = run; run += v[k]; }
        if (lane == 63) tot[w] = incl;
    }
    __syncthreads();
    int eoff[8]; int o = 0;
#pragma unroll
    for (int e = 0; e < 8; ++e) { eoff[e] = o; o += (tot[e] + 255) & ~255; }
    if (blockIdx.x == 0 && tid == 0) {
#pragma unroll
        for (int e = 0; e < 8; ++e) { ctl[CT_EOFF + e] = eoff[e]; ctl[CT_EPAD + e] = (tot[e] + 255) & ~255; }
        ctl[CT_NTILE] = o >> 8; const int nwg = (o >> 8) * (D / 256); ctl[CT_MOES] = pg8::split_S(nwg, DFE / 128, 256); ctl[CT_TROW] = (nwg / 256) * 256 / (D / 256) * 256;
    }
    for (int tg = blockIdx.x; tg < NLAT / 32; tg += gridDim.x) {
        if (tid < 64) {
            const int idx = 64 * tg + tid, owner = idx >> 5, e = topi[idx]; int p = 0;
#pragma unroll
            for (int q = 0; q < 8; ++q) { const unsigned long long mk = __ballot(e == q);
                if (e == q) { const unsigned hm = (unsigned)(mk >> (32 * (tid >> 5))); p = eoff[q] + cnt[q][owner] + __popc(hm & ((1u << (tid & 31)) - 1u)); } }
            pos[idx] = p; ppos[tid] = p;
        }
        __syncthreads();
#pragma unroll
        for (int k = 0; k < 4; ++k) { const int tl = 4 * w + k; const int tok = 32 * tg + tl;
            const u32x4 v0 = *(const u32x4*)(hb + (size_t)tok * D + lane * 32), v1 = *(const u32x4*)(hb + (size_t)tok * D + lane * 32 + 16);
            const int p0 = ppos[2 * tl], p1 = ppos[2 * tl + 1];
            *(u32x4*)(hbs + (size_t)p0 * D + lane * 32) = v0; *(u32x4*)(hbs + (size_t)p0 * D + lane * 32 + 16) = v1;
            *(u32x4*)(hbs + (size_t)p1 * D + lane * 32) = v0; *(u32x4*)(hbs + (size_t)p1 * D + lane * 32 + 16) = v1; }
        __syncthreads();
    }
}
__device__ __forceinline__ void ph_final(const Args& a) {
    const bf16_t* xs = (const bf16_t*)(a.ws + WS_XS); const bf16_t* ys = (const bf16_t*)(a.ws + WS_YS); const int* pos = (const int*)(a.ws + WS_POS); const float* topw = (const float*)(a.ws + WS_TOPW);
    const float* modl = (const float*)(a.ws + WS_MOD) + (size_t)5 * 12288; const float* gfin = a.in[33]; float* out = a.out;
    const int lane = threadIdx.x & 63, wid = threadIdx.x >> 6;
    const int* ctl = (const int*)(a.ws + WS_CTL); const int nsl = ctl[CT_MOES], trow0 = ctl[CT_TROW], trows = ctl[CT_NTILE] * 256 - trow0; const float* slab = (const float*)(a.ws + WS_SLAB);
    for (int row = blockIdx.x * 8 + wid; row < NLAT; row += gridDim.x * 8) {
        const float* g2 = modl + (size_t)tok_mod(row) * 12288 + 10240;
        const int p0 = pos[row * 2], p1 = pos[row * 2 + 1]; const float w0 = topw[row * 2], w1 = topw[row * 2 + 1];
        const bool t0 = nsl > 1 && p0 >= trow0, t1 = nsl > 1 && p1 >= trow0;
        f32x4 v[8]; float ss = 0.f;
#pragma unroll
        for (int i = 0; i < 8; ++i) { const int col = i * 256 + lane * 4;
            const u32x2 xq = *(const u32x2*)(xs + (size_t)row * D + col); const f32x4 x = (f32x4){__uint_as_float(xq.x << 16), __uint_as_float(xq.x & 0xffff0000u), __uint_as_float(xq.y << 16), __uint_as_float(xq.y & 0xffff0000u)}, g = *(const f32x4*)(g2 + col); f32x4 ya, yb;
            if (t0) { ya = *(const f32x4*)(slab + (size_t)(p0 - trow0) * D + col); for (int sl = 1; sl < nsl; ++sl) ya += *(const f32x4*)(slab + ((size_t)sl * trows + (p0 - trow0)) * D + col); }
            else { const u32x2 q = *(const u32x2*)(ys + (size_t)p0 * D + col); ya = (f32x4){__uint_as_float(q.x << 16), __uint_as_float(q.x & 0xffff0000u), __uint_as_float(q.y << 16), __uint_as_float(q.y & 0xffff0000u)}; }
            if (t1) { yb = *(const f32x4*)(slab + (size_t)(p1 - trow0) * D + col); for (int sl = 1; sl < nsl; ++sl) yb += *(const f32x4*)(slab + ((size_t)sl * trows + (p1 - trow0)) * D + col); }
            else { const u32x2 q = *(const u32x2*)(ys + (size_t)p1 * D + col); yb = (f32x4){__uint_as_float(q.x << 16), __uint_as_float(q.x & 0xffff0000u), __uint_as_float(q.y << 16), __uint_as_float(q.y & 0xffff0000u)}; }
#pragma unroll
            for (int j = 0; j < 4; ++j) { v[i][j] = x[j] + g[j] * (w0 * ya[j] + w1 * yb[j]); ss += v[i][j] * v[i][j]; } }
        ss = wave_sum(ss); const float rstd = rsqrtf(ss * (1.0f / D) + EPS);
#pragma unroll
        for (int i = 0; i < 8; ++i) { const int col = i * 256 + lane * 4; const f32x4 g = *(const f32x4*)(gfin + col); f32x4 o;
#pragma unroll
            for (int j = 0; j < 4; ++j) o[j] = v[i][j] * rstd * g[j];
            *(f32x4*)(out + (size_t)row * D + col) = o; }
    }
}

typedef float f32x2_t __attribute__((ext_vector_type(2))); typedef __bf16 bf16x2_t __attribute__((ext_vector_type(2)));
__device__ __forceinline__ unsigned cvtpk(float lo, float hi) { f32x2_t v = {lo, hi}; bf16x2_t b = __builtin_convertvector(v, bf16x2_t); return __builtin_bit_cast(unsigned, b); }
#define MFMA32(a, b, c) __builtin_amdgcn_mfma_f32_32x32x16_bf16((a), (b), (c), 0, 0, 0)
constexpr int MLA_KP = 400, MLA_VP = 144, MLA_KB = 64 * MLA_KP, MLA_VB = 128 * MLA_VP, MLA_STAGE = MLA_KB + MLA_VB;
static_assert(2 * MLA_STAGE <= RING_BYTES, "MLA LDS");

__device__ __forceinline__ void ph_mla(const Args& a, bool with_ctx, unsigned char* lds) {
    const bf16_t* __restrict__ Q = (const bf16_t*)(a.ws + WS_Q); const bf16_t* __restrict__ KN = (const bf16_t*)(a.ws + WS_KN); const bf16_t* __restrict__ KPE = (const bf16_t*)(a.ws + WS_KPE);
    const bf16_t* __restrict__ VT = (const bf16_t*)(a.ws + WS_VT); bf16_t* __restrict__ mix = (bf16_t*)(a.ws + WS_MIX);
    int tid_ = threadIdx.x; asm volatile("" : "+v"(tid_));
    const int tid = tid_, lane = tid & 63, w = tid >> 6, qi = lane & 31, hh = lane >> 5;
    const int nunits = with_ctx ? 288 : 256;
    const float c = 0.07216878364870322f * 1.4426950408889634f;
    for (int unit = blockIdx.x; unit < nunits; unit += gridDim.x) {
        int h, b, q0tok, nt; bool ctxq;
        if (unit < 256) { h = unit & 7; b = unit >> 6; q0tok = b * L + ((unit >> 3) & 7) * 256; nt = 36; ctxq = false; }
        else { const int u2 = unit - 256; h = u2 & 7; b = u2 >> 3; q0tok = NLAT + b * C; nt = 4; ctxq = true; }
#define MLA_KTOK(t) (ctxq ? (NLAT + b * C + (t) * 64) : ((t) < 32 ? (b * L + (t) * 64) : (NLAT + b * C + ((t) - 32) * 64)))
        u32x4 r0, r1, r2, r3, r4;
#define MLA_ISSUE_K(t) do { const int kt0_ = MLA_KTOK(t); \
            r0 = *(const u32x4*)(KN + (size_t)(kt0_ + (tid >> 4)) * 1024 + h * 128 + (tid & 15) * 8); \
            r1 = *(const u32x4*)(KN + (size_t)(kt0_ + 32 + (tid >> 4)) * 1024 + h * 128 + (tid & 15) * 8); \
            r2 = *(const u32x4*)(KPE + (size_t)(kt0_ + (tid >> 3)) * 64 + (tid & 7) * 8); } while (0)
#define MLA_ISSUE_V(t) do { const int kt0_ = MLA_KTOK(t); \
            r3 = *(const u32x4*)(VT + (size_t)(h * 128 + (tid >> 3)) * NTOK + kt0_ + (tid & 7) * 8); \
            r4 = *(const u32x4*)(VT + (size_t)(h * 128 + 64 + (tid >> 3)) * NTOK + kt0_ + (tid & 7) * 8); } while (0)
#define MLA_ISSUE(t) do { MLA_ISSUE_K(t); MLA_ISSUE_V(t); } while (0)
#define MLA_COMMIT(buf) do { unsigned char* kb_ = lds + (buf) * MLA_STAGE; unsigned char* vb_ = kb_ + MLA_KB; \
            *(u32x4*)(kb_ + (tid >> 4) * MLA_KP + (tid & 15) * 16) = r0; \
            *(u32x4*)(kb_ + (32 + (tid >> 4)) * MLA_KP + (tid & 15) * 16) = r1; \
            *(u32x4*)(kb_ + (tid >> 3) * MLA_KP + 256 + (tid & 7) * 16) = r2; \
            const int g_ = (tid & 7) >> 1, e_ = tid & 1; \
            { u32x2 lo_, hi_; lo_.x = r3.x; lo_.y = r3.y; hi_.x = r3.z; hi_.y = r3.w; \
              *(u32x2*)(vb_ + (tid >> 3) * MLA_VP + g_ * 32 + e_ * 8) = lo_; *(u32x2*)(vb_ + (tid >> 3) * MLA_VP + g_ * 32 + 16 + e_ * 8) = hi_; } \
            { u32x2 lo_, hi_; lo_.x = r4.x; lo_.y = r4.y; hi_.x = r4.z; hi_.y = r4.w; \
              *(u32x2*)(vb_ + (64 + (tid >> 3)) * MLA_VP + g_ * 32 + e_ * 8) = lo_; *(u32x2*)(vb_ + (64 + (tid >> 3)) * MLA_VP + g_ * 32 + 16 + e_ * 8) = hi_; } } while (0)
        const int qtok = q0tok + w * 32 + qi;
        bf16x8 qf[12];
#pragma unroll
        for (int s = 0; s < 12; ++s) qf[s] = *(const bf16x8*)(Q + (size_t)qtok * QW + h * 192 + s * 16 + hh * 8);
        f32x16 o[4];
#pragma unroll
        for (int d = 0; d < 4; ++d)
#pragma unroll
            for (int r = 0; r < 16; ++r) o[d][r] = 0.f;
        float m = -1.0e30f, l = 0.f;
        MLA_ISSUE(0); MLA_COMMIT(0);
        __syncthreads();
        for (int t = 0; t < nt; ++t) {
            const unsigned char* kb = lds + (t & 1) * MLA_STAGE; const unsigned char* vb = kb + MLA_KB;
            f32x16 s0, s1;
#pragma unroll
            for (int r = 0; r < 16; ++r) { s0[r] = 0.f; s1[r] = 0.f; }
            {
                const unsigned char* kp0 = kb + qi * MLA_KP + hh * 16; const unsigned char* kp1 = kp0 + 32 * MLA_KP;
                bf16x8 ka[4], kn[4];
                ka[0] = *(const bf16x8*)(kp0); ka[1] = *(const bf16x8*)(kp1); ka[2] = *(const bf16x8*)(kp0 + 32); ka[3] = *(const bf16x8*)(kp1 + 32);
#pragma unroll
                for (int g = 0; g < 6; ++g) {
                    if (g < 5) { kn[0] = *(const bf16x8*)(kp0 + (2 * g + 2) * 32); kn[1] = *(const bf16x8*)(kp1 + (2 * g + 2) * 32); kn[2] = *(const bf16x8*)(kp0 + (2 * g + 3) * 32); kn[3] = *(const bf16x8*)(kp1 + (2 * g + 3) * 32); }
                    __builtin_amdgcn_sched_barrier(0);
                    s0 = MFMA32(ka[0], qf[2 * g], s0); s1 = MFMA32(ka[1], qf[2 * g], s1); s0 = MFMA32(ka[2], qf[2 * g + 1], s0); s1 = MFMA32(ka[3], qf[2 * g + 1], s1);
                    __builtin_amdgcn_sched_barrier(0);
#pragma unroll
                    for (int q = 0; q < 4; ++q) ka[q] = kn[q];
                }
            }
            if (t + 1 < nt) MLA_ISSUE(t + 1);
            float mx = fmaxf(s0[0], s1[0]);
#pragma unroll
            for (int r = 1; r < 16; ++r) mx = fmaxf(mx, fmaxf(s0[r], s1[r]));
            mx = fmaxf(mx, __shfl_xor(mx, 32));
            const float mnew = fmaxf(m, mx * c);
            const float alpha = __builtin_amdgcn_exp2f(m - mnew);
            m = mnew;
            float ps = 0.f;
#pragma unroll
            for (int r = 0; r < 16; ++r) { s0[r] = __builtin_amdgcn_exp2f(s0[r] * c - mnew); s1[r] = __builtin_amdgcn_exp2f(s1[r] * c - mnew); ps += s0[r] + s1[r]; }
            l = l * alpha + ps;
            if ((PROBE_SUB >> 9) & 1u) {
                float ps2 = 0.f;
#pragma unroll
                for (int r = 0; r < 16; ++r) { float x0 = s0[r], x1 = s1[r]; asm volatile("" : "+v"(x0), "+v"(x1)); ps2 += __builtin_amdgcn_exp2f(x0 * c - 40.f) + __builtin_amdgcn_exp2f(x1 * c - 40.f); }
                float mx2 = ps2;
#pragma unroll
                for (int r = 0; r < 16; ++r) { float x0 = s0[r], x1 = s1[r]; asm volatile("" : "+v"(x0), "+v"(x1)); mx2 = fmaxf(mx2, fmaxf(x0 * c, x1 * c)); }
                if (mx2 == 123456.75f) l += ps2;
            }
            if ((PROBE_SUB >> 10) & 1u) {
                f32x16 sx;
#pragma unroll
                for (int r = 0; r < 16; ++r) sx[r] = 0.f;
#pragma unroll
                for (int s = 0; s < 12; ++s) { bf16x8 k0 = *(const bf16x8*)(kb + qi * MLA_KP + s * 32 + hh * 16); sx = MFMA32(k0, qf[s], sx); }
                if (sx[0] == 123456.75f) l += sx[1];
            }
#pragma unroll
            for (int d = 0; d < 4; ++d)
#pragma unroll
                for (int r = 0; r < 16; ++r) o[d][r] *= alpha;
            bf16x8 pf[4];
            { u32x4 p;
              p.x = cvtpk(s0[0], s0[1]); p.y = cvtpk(s0[2], s0[3]); p.z = cvtpk(s0[4], s0[5]); p.w = cvtpk(s0[6], s0[7]); pf[0] = __builtin_bit_cast(bf16x8, p);
              p.x = cvtpk(s0[8], s0[9]); p.y = cvtpk(s0[10], s0[11]); p.z = cvtpk(s0[12], s0[13]); p.w = cvtpk(s0[14], s0[15]); pf[1] = __builtin_bit_cast(bf16x8, p);
              p.x = cvtpk(s1[0], s1[1]); p.y = cvtpk(s1[2], s1[3]); p.z = cvtpk(s1[4], s1[5]); p.w = cvtpk(s1[6], s1[7]); pf[2] = __builtin_bit_cast(bf16x8, p);
              p.x = cvtpk(s1[8], s1[9]); p.y = cvtpk(s1[10], s1[11]); p.z = cvtpk(s1[12], s1[13]); p.w = cvtpk(s1[14], s1[15]); pf[3] = __builtin_bit_cast(bf16x8, p); }
            asm volatile("" ::: "memory");
            {
                const unsigned char* vp = vb + qi * MLA_VP + hh * 16;
                bf16x8 va[4], vn[4];
#pragma unroll
                for (int g = 0; g < 4; ++g) va[g] = *(const bf16x8*)(vp + g * 32);
#pragma unroll
                for (int d = 0; d < 4; ++d) {
                    if (d < 3) {
#pragma unroll
                        for (int g = 0; g < 4; ++g) vn[g] = *(const bf16x8*)(vp + (d + 1) * 32 * MLA_VP + g * 32); }
                    __builtin_amdgcn_sched_barrier(0);
#pragma unroll
                    for (int g = 0; g < 4; ++g) o[d] = MFMA32(va[g], pf[g], o[d]);
                    __builtin_amdgcn_sched_barrier(0);
#pragma unroll
                    for (int g = 0; g < 4; ++g) va[g] = vn[g];
                }
            }
            if (t + 1 < nt) MLA_COMMIT((t + 1) & 1);
            __syncthreads();
        }
        const float inv = 1.0f / (l + __shfl_xor(l, 32));
        bf16_t* op = mix + (size_t)qtok * D + h * 128 + 4 * hh;
#pragma unroll
        for (int d = 0; d < 4; ++d)
#pragma unroll
            for (int g = 0; g < 4; ++g) { u32x2 wv; wv.x = cvtpk(o[d][4 * g] * inv, o[d][4 * g + 1] * inv); wv.y = cvtpk(o[d][4 * g + 2] * inv, o[d][4 * g + 3] * inv);
                *(u32x2*)(op + d * 32 + 8 * g) = wv; }
#undef MLA_KTOK
#undef MLA_ISSUE
#undef MLA_ISSUE_K
#undef MLA_ISSUE_V
#undef MLA_COMMIT
    }
}

constexpr int HY_CS = 8224, HY_WS = 5136, HY_WOFF = 8 * HY_CS, HY_RBL = HY_WOFF + 4 * HY_WS;
static_assert(HY_RBL + 516 * 16 <= RING_BYTES, "hyena LDS");

__device__ __forceinline__ u32x4 hy_shift(const u32x4 a, const u32x4 b, int r) {
    switch (r) {
    case 0: return b;
    case 1: return (u32x4){__builtin_amdgcn_alignbyte(b.x, a.w, 2), __builtin_amdgcn_alignbyte(b.y, b.x, 2), __builtin_amdgcn_alignbyte(b.z, b.y, 2), __builtin_amdgcn_alignbyte(b.w, b.z, 2)};
    case 2: return (u32x4){a.w, b.x, b.y, b.z};
    case 3: return (u32x4){__builtin_amdgcn_alignbyte(a.w, a.z, 2), __builtin_amdgcn_alignbyte(b.x, a.w, 2), __builtin_amdgcn_alignbyte(b.y, b.x, 2), __builtin_amdgcn_alignbyte(b.z, b.y, 2)};
    case 4: return (u32x4){a.z, a.w, b.x, b.y};
    case 5: return (u32x4){__builtin_amdgcn_alignbyte(a.z, a.y, 2), __builtin_amdgcn_alignbyte(a.w, a.z, 2), __builtin_amdgcn_alignbyte(b.x, a.w, 2), __builtin_amdgcn_alignbyte(b.y, b.x, 2)};
    case 6: return (u32x4){a.y, a.z, a.w, b.x};
    default: return (u32x4){__builtin_amdgcn_alignbyte(a.y, a.x, 2), __builtin_amdgcn_alignbyte(a.z, a.y, 2), __builtin_amdgcn_alignbyte(a.w, a.z, 2), __builtin_amdgcn_alignbyte(b.x, a.w, 2)};
    }
}

__device__ __forceinline__ void ph_hyena(const Args& a, int l, unsigned char* lds) {
    const bf16_t* __restrict__ RB = (const bf16_t*)(a.ws + WS_FILTL) + (size_t)l * 512 * HY_RBROW;
    const bf16_t* __restrict__ wtl = (const bf16_t*)(a.ws + WS_WTL);
    int tid_ = threadIdx.x; asm volatile("" : "+v"(tid_));
    const int tid = tid_, lane = tid & 63, w = __builtin_amdgcn_readfirstlane(tid >> 6), i = lane & 31, hh = lane >> 5;
    for (int unit = blockIdx.x; unit < 512; unit += gridDim.x) {
        const int c = unit;
        for (int k = tid; k < 515; k += NTHR) { u32x4 v = (u32x4){0u, 0u, 0u, 0u}; if (k < 513) v = *(const u32x4*)(RB + (size_t)c * HY_RBROW + k * 8); *(u32x4*)(lds + HY_RBL + k * 16) = v; }
        for (int k = tid; k < 4 * 321; k += NTHR) { const int b = k / 321, sl = k - b * 321; u32x4 v = (u32x4){0u, 0u, 0u, 0u};
            if (sl >= 28 && sl < 284) v = *(const u32x4*)(wtl + ((size_t)b * 512 + c) * L + (sl - 28) * 8);
            *(u32x4*)(lds + HY_WOFF + b * HY_WS + sl * 16) = v; }
        __syncthreads();
        for (int qs = lane; qs < 511; qs += 64) {
            const u32x4 ca = *(const u32x4*)(lds + HY_RBL + qs * 16), cb = *(const u32x4*)(lds + HY_RBL + qs * 16 + 16);
            *(u32x4*)(lds + w * HY_CS + qs * 16) = hy_shift(ca, cb, w);
        }
        __syncthreads();
        f32x16 acc0, acc1;
#pragma unroll
        for (int r = 0; r < 16; ++r) { acc0[r] = 0.f; acc1[r] = 0.f; }
        const int Tl = i >> 2, b = i & 3;
        const unsigned char* ap = lds + (i & 7) * HY_CS + (hh - (i >> 3) + 255) * 16;
        const unsigned char* bp = lds + HY_WOFF + b * HY_WS + (224 + 16 * (2 * (8 * w + Tl)) + 8 * hh) * 2;
        const int d0 = 16 * w - 127;
#pragma unroll 2
        for (int dd = 0; dd < 142; dd += 2) {
            const int d = d0 + dd;
            const bf16x8 a0 = *(const bf16x8*)(ap - 32 * d), b0 = *(const bf16x8*)(bp - 32 * d);
            const bf16x8 a1 = *(const bf16x8*)(ap - 32 * (d + 1)), b1 = *(const bf16x8*)(bp - 32 * (d + 1));
            acc0 = MFMA32(a0, b0, acc0); acc1 = MFMA32(a1, b1, acc1);
        }
        bf16_t* yt = (bf16_t*)(a.ws + WS_YT) + ((size_t)b * 512 + c) * L + 32 * (8 * w + Tl) + 4 * hh;
#pragma unroll
        for (int g = 0; g < 4; ++g) { u32x2 wv; wv.x = cvtpk(acc0[4 * g] + acc1[4 * g], acc0[4 * g + 1] + acc1[4 * g + 1]); wv.y = cvtpk(acc0[4 * g + 2] + acc1[4 * g + 2], acc0[4 * g + 3] + acc1[4 * g + 3]);
            *(u32x2*)(yt + 8 * g) = wv; }
        __syncthreads();
    }
}

__device__ __forceinline__ void ph_hyena_fin(const Args& a, int l, bool with_ctx, unsigned char* lds) {
    const bf16_t* __restrict__ YT = (const bf16_t*)(a.ws + WS_YT); const bf16_t* __restrict__ wtl = (const bf16_t*)(a.ws + WS_WTL); const bf16_t* __restrict__ wtc = (const bf16_t*)(a.ws + WS_WTC);
    const bf16_t* __restrict__ x0 = (const bf16_t*)(a.ws + WS_X0); const float* skip = a.in[23] + l * 512; bf16_t* __restrict__ mix = (bf16_t*)(a.ws + WS_MIX);
    int tid_ = threadIdx.x; asm volatile("" : "+v"(tid_));
    const int tid = tid_;
    bf16_t* T = (bf16_t*)lds;
    constexpr int TP = 520;
    const int nunits = with_ctx ? 144 : 128;
    for (int unit = (int)gridDim.x - 1 - (int)blockIdx.x; unit < nunits; unit += gridDim.x) {
        const bool lat = unit < 128; const int b = lat ? (unit >> 5) : ((unit - 128) >> 2), t0 = lat ? (unit & 31) * 64 : ((unit - 128) & 3) * 64;
        const int Ls = lat ? L : C; const int tok0 = lat ? b * L + t0 : NLAT + b * C + t0;
        const bf16_t* yrow = (lat ? YT : YT + (size_t)NB * 512 * L) + ((size_t)b * 512 + tid) * Ls + t0;
        const bf16_t* wrow = (lat ? wtl : wtc) + ((size_t)b * 512 + tid) * Ls + t0;
        const float sk = skip[tid];
#pragma unroll
        for (int hf = 0; hf < 2; ++hf) {
            u32x4 yv[4], wv[4];
#pragma unroll
            for (int q = 0; q < 4; ++q) { yv[q] = *(const u32x4*)(yrow + hf * 32 + q * 8); wv[q] = *(const u32x4*)(wrow + hf * 32 + q * 8); }
#pragma unroll
            for (int q = 0; q < 4; ++q) { const unsigned yy[4] = {yv[q].x, yv[q].y, yv[q].z, yv[q].w}, ww[4] = {wv[q].x, wv[q].y, wv[q].z, wv[q].w};
#pragma unroll
                for (int d = 0; d < 4; ++d) { const int t = hf * 32 + q * 8 + 2 * d;
                    T[t * TP + tid] = f2bf(__uint_as_float(yy[d] << 16) + sk * __uint_as_float(ww[d] << 16));
                    T[(t + 1) * TP + tid] = f2bf(__uint_as_float(yy[d] & 0xffff0000u) + sk * __uint_as_float(ww[d] & 0xffff0000u)); } }
        }
        __syncthreads();
#pragma unroll
        for (int j = 0; j < 8; ++j) { const int o = tid + 512 * j, t = o >> 6, cc = (o & 63) * 8;
            const u32x4 tv = *(const u32x4*)(T + t * TP + cc), xv = *(const u32x4*)(x0 + (size_t)(tok0 + t) * 512 + cc);
            const unsigned tt[4] = {tv.x, tv.y, tv.z, tv.w}, xx[4] = {xv.x, xv.y, xv.z, xv.w}; unsigned oo[4];
#pragma unroll
            for (int d = 0; d < 4; ++d) oo[d] = cvtpk(__uint_as_float(tt[d] << 16) * __uint_as_float(xx[d] << 16), __uint_as_float(tt[d] & 0xffff0000u) * __uint_as_float(xx[d] & 0xffff0000u));
            *(u32x4*)(mix + (size_t)(tok0 + t) * D + 1024 + cc) = (u32x4){oo[0], oo[1], oo[2], oo[3]}; }
        __syncthreads();
    }
}

constexpr int SWA_P = 144, SWA_KB = 64 * SWA_P, SWA_STAGE = 2 * SWA_KB;
__device__ __forceinline__ void ph_swa(const Args& a, int l, bool with_ctx, unsigned char* lds) {
    const bf16_t* __restrict__ SQ = (const bf16_t*)(a.ws + WS_SQ); const bf16_t* __restrict__ SK = (const bf16_t*)(a.ws + WS_SK); const bf16_t* __restrict__ SVT = (const bf16_t*)(a.ws + WS_SV);
    const float* sink = a.in[24] + l * 8; bf16_t* __restrict__ mix = (bf16_t*)(a.ws + WS_MIX);
    int tid_ = threadIdx.x; asm volatile("" : "+v"(tid_));
    const int tid = tid_, lane = tid & 63, w = tid >> 6, qi = lane & 31, hh = lane >> 5;
    const int nunits = with_ctx ? 288 : 256;
    const float c = 0.125f * 1.4426950408889634f;
    for (int unit = blockIdx.x; unit < nunits; unit += gridDim.x) {
        int hk, b, p0, nloc, t0loc, q0tok; bool ctxq;
        if (unit < 256) { hk = unit & 1; b = (unit >> 1) & 3; p0 = (unit >> 3) * 64; ctxq = false; q0tok = b * L + p0;
            const int lo = p0 - 128 < 0 ? 0 : p0 - 128, hi = p0 + 192 > L ? L : p0 + 192; t0loc = lo; nloc = (hi - lo) >> 6; }
        else { const int u2 = unit - 256; hk = u2 & 1; b = (u2 >> 1) & 3; p0 = (u2 >> 3) * 64; ctxq = true; q0tok = NLAT + b * C + p0; t0loc = 0; nloc = 0; }
        const int nt = nloc + 4;
#define SWA_KTOK(t) ((t) < nloc ? (b * L + t0loc + (t) * 64) : (NLAT + b * C + ((t) - nloc) * 64))
        u32x4 r0, r1;
#define SWA_ISSUE(t) do { const int kt0_ = SWA_KTOK(t); \
            r0 = *(const u32x4*)(SK + (size_t)(kt0_ + (tid >> 3)) * 128 + hk * 64 + (tid & 7) * 8); \
            r1 = *(const u32x4*)(SVT + (size_t)(hk * 64 + (tid >> 3)) * NTOK + kt0_ + (tid & 7) * 8); } while (0)
#define SWA_COMMIT(buf) do { unsigned char* kb_ = lds + (buf) * SWA_STAGE; unsigned char* vb_ = kb_ + SWA_KB; \
            *(u32x4*)(kb_ + (tid >> 3) * SWA_P + (tid & 7) * 16) = r0; \
            const int g_ = (tid & 7) >> 1, e_ = tid & 1; u32x2 lo_, hi_; lo_.x = r1.x; lo_.y = r1.y; hi_.x = r1.z; hi_.y = r1.w; \
            *(u32x2*)(vb_ + (tid >> 3) * SWA_P + g_ * 32 + e_ * 8) = lo_; *(u32x2*)(vb_ + (tid >> 3) * SWA_P + g_ * 32 + 16 + e_ * 8) = hi_; } while (0)
        const int hq = hk * 4 + (w >> 1), qpos = p0 + (w & 1) * 32 + qi, qtok = q0tok + (w & 1) * 32 + qi;
        bf16x8 qf[4];
#pragma unroll
        for (int s = 0; s < 4; ++s) qf[s] = *(const bf16x8*)(SQ + (size_t)qtok * 512 + hq * 64 + s * 16 + hh * 8);
        f32x16 o[2];
#pragma unroll
        for (int d = 0; d < 2; ++d)
#pragma unroll
            for (int r = 0; r < 16; ++r) o[d][r] = 0.f;
        float m = sink[hq] * 1.4426950408889634f, lsum = hh == 0 ? 1.0f : 0.0f;
        SWA_ISSUE(0); SWA_COMMIT(0);
        __syncthreads();
        for (int t = 0; t < nt; ++t) {
            const unsigned char* kb = lds + (t & 1) * SWA_STAGE; const unsigned char* vb = kb + SWA_KB;
            f32x16 s0, s1;
#pragma unroll
            for (int r = 0; r < 16; ++r) { s0[r] = 0.f; s1[r] = 0.f; }
#pragma unroll
            for (int s = 0; s < 4; ++s) {
                const bf16x8 k0 = *(const bf16x8*)(kb + qi * SWA_P + s * 32 + hh * 16);
                const bf16x8 k1 = *(const bf16x8*)(kb + (32 + qi) * SWA_P + s * 32 + hh * 16);
                s0 = MFMA32(k0, qf[s], s0); s1 = MFMA32(k1, qf[s], s1);
            }
            if (t + 1 < nt) SWA_ISSUE(t + 1);
            if (t < nloc) {
                const int kbase = t0loc + t * 64 + 4 * hh - qpos;
#pragma unroll
                for (int r = 0; r < 16; ++r) { const int dlt = kbase + (r & 3) + 8 * (r >> 2);
                    if (dlt > 128 || dlt < -128) s0[r] = -1.0e30f;
                    if (dlt + 32 > 128 || dlt + 32 < -128) s1[r] = -1.0e30f; }
            }
            float mx = fmaxf(s0[0], s1[0]);
#pragma unroll
            for (int r = 1; r < 16; ++r) mx = fmaxf(mx, fmaxf(s0[r], s1[r]));
            mx = fmaxf(mx, __shfl_xor(mx, 32));
            const float mnew = fmaxf(m, mx * c);
            const float alpha = __builtin_amdgcn_exp2f(m - mnew);
            m = mnew;
            float ps = 0.f;
#pragma unroll
            for (int r = 0; r < 16; ++r) { s0[r] = __builtin_amdgcn_exp2f(s0[r] * c - mnew); s1[r] = __builtin_amdgcn_exp2f(s1[r] * c - mnew); ps += s0[r] + s1[r]; }
            lsum = lsum * alpha + ps;
#pragma unroll
            for (int d = 0; d < 2; ++d)
#pragma unroll
                for (int r = 0; r < 16; ++r) o[d][r] *= alpha;
            bf16x8 pf[4];
            { u32x4 p;
              p.x = cvtpk(s0[0], s0[1]); p.y = cvtpk(s0[2], s0[3]); p.z = cvtpk(s0[4], s0[5]); p.w = cvtpk(s0[6], s0[7]); pf[0] = __builtin_bit_cast(bf16x8, p);
              p.x = cvtpk(s0[8], s0[9]); p.y = cvtpk(s0[10], s0[11]); p.z = cvtpk(s0[12], s0[13]); p.w = cvtpk(s0[14], s0[15]); pf[1] = __builtin_bit_cast(bf16x8, p);
              p.x = cvtpk(s1[0], s1[1]); p.y = cvtpk(s1[2], s1[3]); p.z = cvtpk(s1[4], s1[5]); p.w = cvtpk(s1[6], s1[7]); pf[2] = __builtin_bit_cast(bf16x8, p);
              p.x = cvtpk(s1[8], s1[9]); p.y = cvtpk(s1[10], s1[11]); p.z = cvtpk(s1[12], s1[13]); p.w = cvtpk(s1[14], s1[15]); pf[3] = __builtin_bit_cast(bf16x8, p); }
#pragma unroll
            for (int d = 0; d < 2; ++d)
#pragma unroll
                for (int g = 0; g < 4; ++g) {
                    const bf16x8 vf = *(const bf16x8*)(vb + (d * 32 + qi) * SWA_P + g * 32 + hh * 16);
                    o[d] = MFMA32(vf, pf[g], o[d]);
                }
            if (t + 1 < nt) SWA_COMMIT((t + 1) & 1);
            __syncthreads();
        }
        const float inv = 1.0f / (lsum + __shfl_xor(lsum, 32));
        bf16_t* op = mix + (size_t)qtok * D + 1536 + hq * 64 + 4 * hh;
#pragma unroll
        for (int d = 0; d < 2; ++d)
#pragma unroll
            for (int g = 0; g < 4; ++g) { u32x2 wv; wv.x = cvtpk(o[d][4 * g] * inv, o[d][4 * g + 1] * inv); wv.y = cvtpk(o[d][4 * g + 2] * inv, o[d][4 * g + 3] * inv);
                *(u32x2*)(op + d * 32 + 8 * g) = wv; }
#undef SWA_KTOK
#undef SWA_ISSUE
#undef SWA_COMMIT
    }
}


constexpr int NPHASES = 22;
#define GEMM_CALL(EPI, SCHED, g, S, E) pg8::gemm_phase<EPI, SCHED, true, true, 0>((PG8_LAS unsigned char*)lds, g, S, E)
#define GEMM_CALL8(EPI, SCHED, g, S, E) pg8::gemm_phase<EPI, SCHED, true, true, 1>((PG8_LAS unsigned char*)lds, g, S, E)
#define GEMM_CALLI8(EPI, SCHED, g, S, E) pg8::gemm_phase<EPI, SCHED, true, true, 2>((PG8_LAS unsigned char*)lds, g, S, E)

template <int LYR>
__device__ __forceinline__ void layer_phases(const Args& a, unsigned char* lds, const XcdBarrier& bar, int lo, int hi) {
#define IN(k) (lo <= (k) && (k) < hi)
#define REPS(k) for (int rep_ = 0; rep_ <= (int)((PROBE_MASK >> (k)) & 1u); ++rep_)
#if MK_PER_PHASE
#define SEAM(k) do { } while (0)
#else
#define SEAM(k) do { if (IN(k) && IN((k) + 1)) xcd_barrier(bar); } while (0)
#endif
    constexpr int P0 = 1 + LYR * 9;
    constexpr bool LAST = (LYR == 1);
    constexpr int S_WO = pg8::split_S((LAST ? NLAT : NTOK) / 256 * (D / 256), D / 64, 256);
    constexpr int S_WO0 = pg8::split_S(NTOK / 256 * (D / 256), D / 64, 256);
    constexpr int S_DN0 = pg8::split_S(NTOK / 256 * (D / 256), (FP8_DENSE || FP8_DOWN) ? DFF / 128 : DFF / 64, 256);
    constexpr int S_DN = pg8::split_S(NTOK / 256 * (D / 256), (FP8_DENSE || FP8_DOWN) ? DFF / 128 : DFF / 64, 256);
    const int G = gridDim.x, bid = blockIdx.x;
    unsigned char* ws = a.ws;
    const float* modl = (const float*)(ws + WS_MOD) + (size_t)LYR * 5 * 12288;
    bf16_t* xs = (bf16_t*)(ws + WS_XS);
    const int nq = LAST ? NLAT : NTOK;
    if (IN(P0 + 0)) REPS(P0 + 0) {
        if (LYR == 0) ph_normmod<false, false, I8_WIN ? 2 : 0, 0, false, false>(a.in[0], a.in[2], a.in[6], modl, 0, 2048, (bf16_t*)(ws + WS_HA), NTOK, nullptr, nullptr, nullptr, nullptr, nullptr, nullptr, (float*)(ws + WS_RSC));
        else ph_normmod<false, false, I8_WIN ? 2 : 0, S_DN0>(xs, xs + (size_t)NLAT * D, a.in[6] + D, modl, 0, 2048, (bf16_t*)(ws + WS_HA), NTOK, nullptr, nullptr, nullptr, nullptr,
                                                    (const float*)(ws + WS_SLAB), (const float*)(ws + WS_MOD) + (size_t)4 * 12288 + 10240, (float*)(ws + WS_RSC));
    }
    SEAM(P0 + 0);
    if (IN(P0 + 1)) REPS(P0 + 1) {
#if I8_WIN
        pg8::Gemm g{(const bf16_t*)(ws + WS_HA), (const bf16_t*)(ws + WS_WIN + (size_t)LYR * UW * D * 2), NTOK, UW, D / 2};
        const float swin = __uint_as_float(__hip_atomic_load((const unsigned*)(ws + WS_CTL) + CT_WSC + LYR, __ATOMIC_RELAXED, __HIP_MEMORY_SCOPE_AGENT)) * (1.0f / 127.0f);
        pg8::EpiStoreI8 E{(bf16_t*)(ws + WS_U), UW, (const float*)(ws + WS_RSC), swin};
        if constexpr (LAST) { pg8::WinLastOrder S; S.init(G, bid, D / 2); GEMM_CALLI8(pg8::EpiStoreI8, pg8::WinLastOrder, g, S, E); }
        else { pg8::StaticOrder S; S.init(NTOK, UW, G, bid, D / 2); GEMM_CALLI8(pg8::EpiStoreI8, pg8::StaticOrder, g, S, E); }
#else
        pg8::Gemm g{(const bf16_t*)(ws + WS_HA), (const bf16_t*)(ws + WS_WIN + (size_t)LYR * UW * D * 2), NTOK, UW, D};
        pg8::EpiStore E{(bf16_t*)(ws + WS_U), UW};
        if constexpr (LAST) { pg8::WinLastOrder S; S.init(G, bid, D); GEMM_CALL(pg8::EpiStore, pg8::WinLastOrder, g, S, E); }
        else { pg8::StaticOrder S; if (G == 256) S.init(NTOK, UW, G1_GEMM, bid < G1_GEMM ? bid : (1 << 24), D); else S.init(NTOK, UW, G, bid, D); GEMM_CALL(pg8::EpiStore, pg8::StaticOrder, g, S, E); }
#endif
        if (!LAST && rep_ == 0 && G == 256 && bid >= TAIL1_BLK0) {
            const int f0 = bid < G1_GEMM ? NCONV_Q + (bid - TAIL1_BLK0) * TAILQ1 : NCONV_Q + TAIL1_N * TAILQ1 + (bid - G1_GEMM) * CQ1;
            ph_convert<0>(a, (float*)lds, f0, 1, f0 + (bid < G1_GEMM ? TAILQ1 : CQ1)); }
        conv_fill(a, (float*)lds, LYR * 6 + 0);
    }
    SEAM(P0 + 1);
    if (IN(P0 + 2)) REPS(P0 + 2) ph_mid(a, LYR);
    SEAM(P0 + 2);
    if (IN(P0 + 3)) REPS(P0 + 3) {
        SUBREP(0) {
        { pg8::Gemm g{(const bf16_t*)(ws + WS_CQN), (const bf16_t*)(ws + WS_WQ + (size_t)LYR * QW * 768 * 2), nq, QW, 768};
          pg8::StaticOrder S; S.init(nq, QW, G, bid, 768); pg8::EpiQ E{(bf16_t*)(ws + WS_Q), (const float*)(ws + WS_ROPE), (const float*)(ws + WS_ROPE) + 2048 * 32};
          GEMM_CALL(pg8::EpiQ, pg8::StaticOrder, g, S, E); }
        __syncthreads();
        { pg8::Gemm g{(const bf16_t*)(ws + WS_CKVN), (const bf16_t*)(ws + WS_WKV + (size_t)LYR * KVW * 512 * 2), NTOK, 1024, 512};
          pg8::StaticOrder S; S.init(NTOK, 1024, G, bid, 512); pg8::EpiStore E{(bf16_t*)(ws + WS_KN), 1024};
          GEMM_CALL(pg8::EpiStore, pg8::StaticOrder, g, S, E); }
        __syncthreads();
        { pg8::Gemm g{(const bf16_t*)(ws + WS_WKV + (size_t)LYR * KVW * 512 * 2 + (size_t)1024 * 512 * 2), (const bf16_t*)(ws + WS_CKVN), 1024, NTOK, 512};
          pg8::StaticOrder S; S.init(1024, NTOK, 108, bid >= 216 ? bid - 216 : (bid >= 144 ? bid - 108 : (1 << 24)), 512); pg8::EpiStore E{(bf16_t*)(ws + WS_VT), NTOK};
          GEMM_CALL(pg8::EpiStore, pg8::StaticOrder, g, S, E); }
        __syncthreads();
        }
        SUBREP(1) ph_hyena(a, LYR, lds);
        SUBREP(3) if (!LAST) ph_hyena_naive<C>(a, LYR, (float*)lds);
        SUBREP(2) ph_swa(a, LYR, !LAST, lds);
        conv_fill(a, (float*)lds, LYR * 6 + 1);
    }
    SEAM(P0 + 3);
    if (IN(P0 + 4)) REPS(P0 + 4) { ph_hyena_fin(a, LYR, !LAST, lds); ph_mla(a, !LAST, lds);
        if (!LAST && rep_ == 0 && G == 256 && bid >= TAIL4_BLK0 && TAILQ4 > 0) ph_convert<0>(a, (float*)lds, NCONV_Q + NCONV_T1 + NCONV_T2 + NCONV_T3 + (bid - TAIL4_BLK0) * TAILQ4, 1, NCONV_Q + NCONV_T1 + NCONV_T2 + NCONV_T3 + (bid - TAIL4_BLK0 + 1) * TAILQ4); conv_fill(a, (float*)lds, LYR * 6 + 2); }
    SEAM(P0 + 4);
    if (IN(P0 + 5)) REPS(P0 + 5) {
        pg8::Gemm g{(const bf16_t*)(ws + WS_MIX), (const bf16_t*)(ws + WS_WOUT + (size_t)LYR * D * D * 2), nq, D, D};
        pg8::SplitOrder S; S.init(nq / 256, D / 256, G, bid, D, S_WO);
        const int trow0 = S.nfull / S.nN * 256; pg8::EpiResid E{rep_ ? (bf16_t*)(ws + WS_ACT) : xs, LYR == 0 ? a.in[0] : (const float*)nullptr, modl + 4096, (float*)(ws + WS_SLAB), trow0, nq - trow0, 1.0f};
        GEMM_CALL(pg8::EpiResid, pg8::SplitOrder, g, S, E);
        conv_fill(a, (float*)lds, LYR * 6 + 3);
    }
    SEAM(P0 + 5);
    if (!LAST) {
#if !FP8_DENSE
        if (IN(P0 + 6)) { ph_normmod<false, true, I8_GU ? 2 : 0, S_WO0, true, false>(xs, a.in[2], a.in[7], modl, 6144, 8192, (bf16_t*)(ws + WS_HA), NTOK, xs, nullptr, nullptr, nullptr, (const float*)(ws + WS_SLAB), modl + (size_t)4 * 12288 + 4096, (float*)(ws + WS_RSC));
            conv_finish(a, (float*)lds, CONV_DENSE_END); }
        SEAM(P0 + 6);
        if (IN(P0 + 7)) REPS(P0 + 7) {
#if I8_GU
            pg8::Gemm g{(const bf16_t*)(ws + WS_HA), (const bf16_t*)(ws + WS_WGU), NTOK, 2 * DFF, D / 2};
            pg8::StaticOrder S; if (G == 256) S.init(NTOK, 2 * DFF, G2_GEMM, bid < G2_GEMM ? bid : (1 << 24), D / 2); else S.init(NTOK, 2 * DFF, G, bid, D / 2);
            const float swg = __uint_as_float(__hip_atomic_load((const unsigned*)(ws + WS_CTL) + CT_WSC + 2, __ATOMIC_RELAXED, __HIP_MEMORY_SCOPE_AGENT)) * (1.0f / 127.0f);
            const float swu = __uint_as_float(__hip_atomic_load((const unsigned*)(ws + WS_CTL) + CT_WSC + 3, __ATOMIC_RELAXED, __HIP_MEMORY_SCOPE_AGENT)) * (1.0f / 127.0f);
            pg8::EpiSwiGLUI8 E{(unsigned char*)(ws + WS_ACT), DFF, (const float*)(ws + WS_RSC), swg, swu, ASCALE};
            GEMM_CALLI8(pg8::EpiSwiGLUI8, pg8::StaticOrder, g, S, E);
            if (rep_ == 0 && G == 256 && bid >= TAIL2_BLK0) {
                const int f0 = bid < G2_GEMM ? NCONV_Q + NCONV_T1 + (bid - TAIL2_BLK0) * TAILQ2 : NCONV_Q + NCONV_T1 + TAIL2_N * TAILQ2 + (bid - G2_GEMM) * CQ2;
                ph_convert<0>(a, (float*)lds, f0, 1, f0 + (bid < G2_GEMM ? TAILQ2 : CQ2)); }
#elif FP8_DOWN
            pg8::Gemm g{(const bf16_t*)(ws + WS_HA), (const bf16_t*)(ws + WS_WGU), NTOK, 2 * DFF, D};
            pg8::StaticOrder S; S.init(NTOK, 2 * DFF, G, bid, D);
            pg8::EpiSwiGLU8 E{(unsigned char*)(ws + WS_ACT), DFF, 1.0f, ASCALE};
            GEMM_CALL(pg8::EpiSwiGLU8, pg8::StaticOrder, g, S, E);
#else
            pg8::Gemm g{(const bf16_t*)(ws + WS_HA), (const bf16_t*)(ws + WS_WGU), NTOK, 2 * DFF, D};
            pg8::StaticOrder S; S.init(NTOK, 2 * DFF, G, bid, D);
            pg8::EpiSwiGLU E{(bf16_t*)(ws + WS_ACT), DFF};
            GEMM_CALL(pg8::EpiSwiGLU, pg8::StaticOrder, g, S, E);
#endif
            conv_fill(a, (float*)lds, 4);
        }
        SEAM(P0 + 7);
        if (IN(P0 + 8)) REPS(P0 + 8) {
#if FP8_DOWN
            pg8::Gemm g{(const bf16_t*)(ws + WS_ACT), (const bf16_t*)(ws + WS_WDN), NTOK, D, DFF / 2};
            pg8::SplitOrder S; S.init(NTOK / 256, D / 256, G, bid, DFF / 2, S_DN);
            const int trow0 = S.nfull / S.nN * 256; pg8::EpiResid E{rep_ ? (bf16_t*)(ws + WS_YS) : xs, (const float*)nullptr, modl + 10240, (float*)(ws + WS_SLAB), trow0, NTOK - trow0, 1.0f / (ASCALE * WSCALE)};
            GEMM_CALL8(pg8::EpiResid, pg8::SplitOrder, g, S, E);
            if (rep_ == 0 && G == 256 && bid >= TAIL3_BLK0 && TAILQ3 > 0) ph_convert<0>(a, (float*)lds, NCONV_Q + NCONV_T1 + NCONV_T2 + (bid - TAIL3_BLK0) * TAILQ3, 1, NCONV_Q + NCONV_T1 + NCONV_T2 + (bid - TAIL3_BLK0 + 1) * TAILQ3);
#else
            pg8::Gemm g{(const bf16_t*)(ws + WS_ACT), (const bf16_t*)(ws + WS_WDN), NTOK, D, DFF};
            pg8::SplitOrder S; S.init(NTOK / 256, D / 256, G, bid, DFF, S_DN);
            const int trow0 = S.nfull / S.nN * 256; pg8::EpiResid E{rep_ ? (bf16_t*)(ws + WS_YS) : xs, (const float*)nullptr, modl + 10240, (float*)(ws + WS_SLAB), trow0, NTOK - trow0, 1.0f};
            GEMM_CALL(pg8::EpiResid, pg8::SplitOrder, g, S, E);
#endif
            conv_fill(a, (float*)lds, 5);
        }
#else
        if (IN(P0 + 6)) { ph_normmod<false, true, true, S_WO0, true, false>(xs, a.in[2], a.in[7], modl, 6144, 8192, (bf16_t*)(ws + WS_HA), NTOK, xs, nullptr, nullptr, nullptr, (const float*)(ws + WS_SLAB), modl + (size_t)4 * 12288 + 4096);
            conv_finish(a, (float*)lds, CONV_DENSE_END); }
        SEAM(P0 + 6);
        if (IN(P0 + 7)) REPS(P0 + 7) {
            pg8::Gemm g{(const bf16_t*)(ws + WS_HA), (const bf16_t*)(ws + WS_WGU), NTOK, 2 * DFF, D / 2};
            pg8::StaticOrder S; S.init(NTOK, 2 * DFF, G, bid, D / 2); pg8::EpiSwiGLU8 E{(unsigned char*)(ws + WS_ACT), DFF, 1.0f / (ASCALE * WSCALE), ASCALE};
            GEMM_CALL8(pg8::EpiSwiGLU8, pg8::StaticOrder, g, S, E);
            conv_fill(a, (float*)lds, 4);
        }
        SEAM(P0 + 7);
        if (IN(P0 + 8)) REPS(P0 + 8) {
            pg8::Gemm g{(const bf16_t*)(ws + WS_ACT), (const bf16_t*)(ws + WS_WDN), NTOK, D, DFF / 2};
            pg8::SplitOrder S; S.init(NTOK / 256, D / 256, G, bid, DFF / 2, S_DN);
            const int trow0 = S.nfull / S.nN * 256; pg8::EpiResid E{rep_ ? (bf16_t*)(ws + WS_YS) : xs, (const float*)nullptr, modl + 10240, (float*)(ws + WS_SLAB), trow0, NTOK - trow0, 1.0f / (ASCALE * WSCALE)};
            GEMM_CALL8(pg8::EpiResid, pg8::SplitOrder, g, S, E);
            conv_fill(a, (float*)lds, 5);
        }
#endif
        SEAM(P0 + 8);
    } else {
        if (IN(P0 + 6)) REPS(P0 + 6) ph_normmod<true, false, true>(xs, xs + (size_t)NLAT * D, a.in[7] + D, modl, 6144, 8192, (bf16_t*)(ws + WS_HA), NLAT, nullptr, a.in[29], (int*)(ws + WS_TOPI), (float*)(ws + WS_TOPW));
        SEAM(P0 + 6);
        if (IN(P0 + 7)) REPS(P0 + 7) { ph_route_gather(a, (int*)lds); conv_finish(a, (float*)lds, NCONV); }
        SEAM(P0 + 7);
        if (IN(P0 + 9)) REPS(P0 + 9) {
            pg8::Gemm g{(const bf16_t*)(ws + WS_HBS), (const bf16_t*)(ws + WS_MGU), MOE_ROWS, 2 * DFE, D / 2};
            pg8::MoeOrder S; S.init((const int*)(ws + WS_CTL), 2 * DFE / 256, G, bid, (size_t)2 * DFE * D, D / 2); pg8::EpiSwiGLU8 E{(rep_ && ((PROBE_SUB >> 12) & 1u)) ? nullptr : (unsigned char*)(ws + WS_ACT), DFE, 1.0f / (ASCALE * WSCALE), ASCALE};
            GEMM_CALL8(pg8::EpiSwiGLU8, pg8::MoeOrder, g, S, E);
        }
        SEAM(P0 + 9);
        if (IN(P0 + 10)) REPS(P0 + 10) {
            pg8::Gemm g{(const bf16_t*)(ws + WS_ACT), (const bf16_t*)(ws + WS_MDN), MOE_ROWS, D, DFE / 2};
            pg8::SplitOrder S; S.init_moe((const int*)(ws + WS_CTL), D / 256, G, bid, DFE / 2, (size_t)D * DFE);
            const int trow0 = S.nfull / S.nN * 256; pg8::EpiYs E{(bf16_t*)(ws + WS_YS), (float*)(ws + WS_SLAB), trow0, S.nM * 256 - trow0, 1.0f / (ASCALE * WSCALE)};
            GEMM_CALL8(pg8::EpiYs, pg8::SplitOrder, g, S, E);
        }
        SEAM(P0 + 10);
        if (IN(P0 + 11)) REPS(P0 + 11) ph_final(a);
    }
#undef IN
#undef SEAM
#undef REPS
}

__global__ void __launch_bounds__(NTHR, 2) mk_fwd(Args a) {
    extern __shared__ __attribute__((aligned(16))) unsigned char lds[];
    const int tid = threadIdx.x;
    for (int u = tid; u < (LDS_BYTES - LDSCTL_OFF) / 4; u += NTHR) ((unsigned*)(lds + LDSCTL_OFF))[u] = 0u;
    __syncthreads();
    XcdBarrier bar; bar.bar = (unsigned*)(a.ws + WS_CTL) + CW_BAR; bar.x = 0; bar.st = nullptr;
#if !MK_PER_PHASE
    bar = xcd_barrier_post((unsigned*)(a.ws + WS_CTL) + CW_BAR, (volatile LAS unsigned*)(lds + LDSCTL_OFF + 32));
#endif
    const int lo = a.ph_lo, hi = a.ph_hi;
    if (lo <= 0 && 0 < hi) {
        for (int rep_ = 0; rep_ <= (int)(PROBE_MASK & 1u); ++rep_) { ph_prologue(a, (float*)lds); __syncthreads(); }
#if !MK_PER_PHASE
        if (1 < hi) xcd_barrier(bar);
#endif
    }
    layer_phases<0>(a, lds, bar, lo, hi);
    layer_phases<1>(a, lds, bar, lo, hi);
}

extern "C" void kernel_launch(void* const* d_in, const int* in_sizes, int n_in, void* d_out, int out_size, void* d_ws, size_t ws_size, hipStream_t stream) {
    (void)in_sizes; (void)out_size;
    static int grid = 0;
    if (grid == 0) {
        if (n_in != 34 || ws_size < WS_END) { fprintf(stderr, "kernel_launch: need 34 inputs and >= %zu bytes of workspace (got %d, %zu)\n", (size_t)WS_END, n_in, ws_size); grid = -1; return; }
        int dev = 0, cus = 0, per_cu = 0;
        if (hipGetDevice(&dev) != hipSuccess || hipDeviceGetAttribute(&cus, hipDeviceAttributeMultiprocessorCount, dev) != hipSuccess) { grid = -1; return; }
        if (hipFuncSetAttribute((const void*)mk_fwd, hipFuncAttributeMaxDynamicSharedMemorySize, LDS_BYTES) != hipSuccess) { fprintf(stderr, "kernel_launch: hipFuncSetAttribute failed\n"); grid = -1; return; }
        if (hipOccupancyMaxActiveBlocksPerMultiprocessor(&per_cu, (const void*)mk_fwd, NTHR, LDS_BYTES) != hipSuccess || per_cu < 1) { fprintf(stderr, "kernel_launch: occupancy query says %d blocks per CU\n", per_cu); }
        (void)hipGetLastError();
        grid = cus;
    }
    if (grid < 0) return;
    if (hipMemsetAsync((char*)d_ws + WS_CTL, 0, CTL_ZERO_BYTES, stream) != hipSuccess) return;
    Args a{};
    for (int i = 0; i < 34; ++i) a.in[i] = (const float*)d_in[i];
    a.out = (float*)d_out; a.ws = (unsigned char*)d_ws;
#if MK_PER_PHASE
    for (int p = 0; p < NPHASES; ++p) { a.ph_lo = p; a.ph_hi = p + 1; hipLaunchKernelGGL(mk_fwd, dim3(grid), dim3(NTHR), LDS_BYTES, stream, a); }
#else
    a.ph_lo = 0; a.ph_hi = NPHASES;
    hipLaunchKernelGGL(mk_fwd, dim3(grid), dim3(NTHR), LDS_BYTES, stream, a);
#endif
}
```

```cpp
#include <hip/hip_runtime.h>
#include <stdint.h>
#include <stdio.h>

#ifndef FP8_DENSE
#define FP8_DENSE 0
#endif
#ifndef FP8_DOWN
#define FP8_DOWN 1
#endif
#ifndef I8_WIN
#define I8_WIN 0
#endif
#ifndef I8_GU
#define I8_GU 1
#endif
#ifndef I8_GEMM
#define I8_GEMM (I8_WIN || I8_GU)
#endif
#ifndef TAILQ1
#define TAILQ1 6
#endif
#ifndef TAILQ2
#define TAILQ2 3
#endif
#ifndef TAILQ3
#define TAILQ3 8
#endif
#ifndef TAILQ4
#define TAILQ4 2
#endif
#ifndef CQ1
#define CQ1 20
#endif
#ifndef CQ2
#define CQ2 26
#endif
#ifndef CONV_FILL
#define CONV_FILL 0
#endif
#ifndef PROBE_MASK
#define PROBE_MASK 0u
#endif
#ifndef PROBE_SUB
#define PROBE_SUB 0u
#endif
#ifndef MK_PER_PHASE
#define MK_PER_PHASE 0
#endif

typedef unsigned short bf16_t;
typedef float f32x4 __attribute__((ext_vector_type(4)));
typedef float f32x16 __attribute__((ext_vector_type(16)));
typedef unsigned u32x4 __attribute__((ext_vector_type(4)));
typedef unsigned u32x2 __attribute__((ext_vector_type(2)));
typedef short bf16x8 __attribute__((ext_vector_type(8)));

constexpr int D = 2048, NB = 4, L = 2048, C = 256, NLAT = NB * L, NCTX = NB * C, NTOK = NLAT + NCTX;
constexpr int UW = 3840;
constexpr int O_CQ = 0, O_CKV = 768, O_KPE = 1280, O_HY = 1344, O_SQ = 2880, O_SK = 3392, O_SV = 3520, INW = 3648;
constexpr int QW = 1536, KVW = 2048, DFF = 5632, DFE = 7168, NE = 8;
constexpr int MOE_ROWS = 18432;
constexpr float EPS = 1e-6f;
constexpr int NTHR = 512;
constexpr int HY_RBROW = 4112;

__device__ __forceinline__ float bf2f(bf16_t h) { return __uint_as_float(((unsigned)h) << 16); }
__device__ __forceinline__ bf16_t f2bf(float f) { unsigned u = __float_as_uint(f); u += 0x7fffu + ((u >> 16) & 1u); return (bf16_t)(u >> 16); }
__device__ __forceinline__ float wave_sum(float v) { for (int o = 32; o > 0; o >>= 1) v += __shfl_xor(v, o); return v; }
__device__ __forceinline__ float wave_max(float v) { for (int o = 32; o > 0; o >>= 1) v = fmaxf(v, __shfl_xor(v, o)); return v; }
__device__ __forceinline__ float silu(float x) { return x / (1.0f + __expf(-x)); }
__device__ __forceinline__ int tok_mod(int tok) { return tok < NLAT ? (tok >> 11) : 4; }

constexpr size_t al(size_t x) { return (x + 255) & ~(size_t)255; }
constexpr size_t WS_CTL = 0, CTL_ZERO_BYTES = 65536;
constexpr size_t WS_MOD = 65536;
constexpr size_t WS_ROPE = WS_MOD + al((size_t)2 * 5 * 12288 * 4);
constexpr size_t WS_FILTL = WS_ROPE + al((size_t)2 * 2048 * 32 * 4);
constexpr size_t WS_FILTC = WS_FILTL + al((size_t)2 * 512 * 4096 * 4);
constexpr size_t WS_WIN = WS_FILTC + al((size_t)2 * 512 * 512 * 4);
constexpr size_t WS_WQ = WS_WIN + al((size_t)2 * UW * D * 2);
constexpr size_t WS_WKV = WS_WQ + al((size_t)2 * QW * 768 * 2);
constexpr size_t WS_WOUT = WS_WKV + al((size_t)2 * KVW * 512 * 2);
constexpr size_t WS_WGU = WS_WOUT + al((size_t)2 * D * D * 2);
constexpr size_t WS_WDN = WS_WGU + al((size_t)2 * DFF * D * 2);
constexpr size_t WS_MGU = WS_WDN + al((size_t)D * DFF * 2);
constexpr size_t WS_MDN = WS_MGU + al((size_t)NE * 2 * DFE * D * 2);
constexpr size_t WS_HA = WS_MDN + al((size_t)NE * D * DFE * 2);
constexpr size_t WS_U = WS_HA + al((size_t)NTOK * D * 2);
constexpr size_t WS_CQN = WS_U + al((size_t)NTOK * UW * 2);
constexpr size_t WS_CKVN = WS_CQN + al((size_t)NTOK * 768 * 2);
constexpr size_t WS_KPE = WS_CKVN + al((size_t)NTOK * 512 * 2);
constexpr size_t WS_X0 = WS_KPE + al((size_t)NTOK * 64 * 2);
constexpr size_t WS_WTL = WS_X0 + al((size_t)NTOK * 512 * 2);
constexpr size_t WS_WTC = WS_WTL + al((size_t)NB * 512 * L * 2);
constexpr size_t WS_SQ = WS_WTC + al((size_t)NB * 512 * C * 2);
constexpr size_t WS_SK = WS_SQ + al((size_t)NTOK * 512 * 2);
constexpr size_t WS_SV = WS_SK + al((size_t)NTOK * 128 * 2);
constexpr size_t WS_Q = WS_SV + al((size_t)NTOK * 128 * 2);
constexpr size_t WS_KV = WS_Q + al((size_t)NTOK * QW * 2);
constexpr size_t WS_KN = WS_KV;
constexpr size_t WS_VT = WS_KV + (size_t)NTOK * 1024 * 2;
constexpr size_t WS_MIX = WS_KV + al((size_t)NTOK * KVW * 2);
constexpr size_t WS_MIXEND = WS_MIX + al((size_t)NTOK * D * 2);
constexpr size_t WS_YS = WS_U;
static_assert(WS_YS + (size_t)MOE_ROWS * D * 4 <= WS_MIXEND, "ys overlay");
constexpr size_t WS_XS = WS_MIXEND;
constexpr size_t WS_ACT = WS_XS + al((size_t)NTOK * D * 4);
constexpr size_t WS_HBS = WS_ACT + al((size_t)MOE_ROWS * DFE * 2);
constexpr size_t WS_TOPI = WS_HBS + al((size_t)MOE_ROWS * D * 2);
constexpr size_t WS_TOPW = WS_TOPI + al((size_t)NLAT * 2 * 4);
constexpr size_t WS_POS = WS_TOPW + al((size_t)NLAT * 2 * 4);
constexpr size_t WS_SRC = WS_POS + al((size_t)NLAT * 2 * 4);
constexpr size_t WS_SLAB = WS_SRC + al((size_t)MOE_ROWS * 4);
constexpr size_t WS_YT = WS_SLAB + ((size_t)64 << 20);
constexpr size_t WS_RSC = WS_YT + al((size_t)NB * 512 * (L + C) * 2);
constexpr size_t WS_END = WS_RSC + al((size_t)NTOK * 4);
constexpr int CT_EOFF = 1024, CT_EPAD = 1040, CT_NTILE = 1056, CT_MOES = 1057, CT_TROW = 1058, CT_WSC = 1088, CT_AMAXDONE = 1100;
constexpr int CW_BAR = 4096;

constexpr int RING_BYTES = 131072, LDS_BYTES = 147456, LDSCTL_OFF = LDS_BYTES - 256;

namespace pg8 {
#define PG8_LAS __attribute__((address_space(3)))
typedef unsigned short bf16_t;
typedef short bf16x8 __attribute__((ext_vector_type(8)));
typedef float f32x4 __attribute__((ext_vector_type(4)));
typedef unsigned u32x4 __attribute__((ext_vector_type(4)));
constexpr int BM = 256, BK = 64, HALF = 128, HTB = HALF * BK * 2  , STAGE_BYTES = 8 * HTB, NXCD = 8, WGM = 8;

__host__ __device__ __forceinline__ int lds_byte(int r, int c) { const int st = (r >> 4) * 2 + (c >> 5), rr = r & 15, cc = c & 31, ob = rr * 64 + cc * 2; return st * 1024 + (ob ^ (((ob >> 9) & 1) << 5)); }
__host__ __device__ __forceinline__ void stage_rc(int b, int& R, int& C) { const int st = b / 1024, sb = b % 1024, swz = sb ^ (((sb >> 9) & 1) << 5); R = (st >> 1) * 16 + swz / 64; C = (st & 1) * 32 + (swz % 64) / 2; }
__host__ __device__ __forceinline__ int perm32(int rho) { const int n = rho >> 4, i = rho & 15; return 8 * (i >> 2) + 4 * n + (i & 3); }

struct Unit { int pm, pn, kt0, nkt, slab; };
struct Gemm { const bf16_t* A; const bf16_t* Bt; int M, N, K; };

struct StaticOrder {
    int nM, nN, nwg, G, c;
    int nkt;
    __host__ __device__ void init(int M, int N, int G_, int c_, int K) { nM = M / BM; nN = N / BM; nwg = nM * nN; G = G_; c = c_; nkt = K / BK; }
    __host__ __device__ bool next(int i, Unit& u) const {
        const long L = (long)i * G + c; if (L >= nwg) return false;
        int wgid = (int)L; { const int q = nwg / NXCD, r = nwg % NXCD, xcd = wgid % NXCD, off = wgid / NXCD; wgid = (xcd < r ? xcd * (q + 1) : r * (q + 1) + (xcd - r) * q) + off; }
        const int nig = WGM * nN, gid = wgid / nig, fm = gid * WGM, gsz = (nM - fm) < WGM ? (nM - fm) : WGM;
        u.pm = fm + ((wgid % nig) % gsz); u.pn = (wgid % nig) / gsz; u.kt0 = 0; u.nkt = nkt; u.slab = -1; return true;
    }
    __device__ __forceinline__ size_t bt_off(const Unit&) const { return 0; }
    __device__ __forceinline__ void a_ready(const Unit&) const {}
    __device__ __forceinline__ void done(const Unit&) const {}
};

__device__ __forceinline__ unsigned cvt_pk_bf16(float lo, float hi) { unsigned r; asm volatile("v_cvt_pk_bf16_f32 %0, %1, %2" : "=v"(r) : "v"(lo), "v"(hi)); return r; }
typedef float f32x2 __attribute__((ext_vector_type(2)));
typedef int v8i_t __attribute__((ext_vector_type(8))); typedef int v4i_t __attribute__((ext_vector_type(4)));
template <bool F8> struct Frag;
template <> struct Frag<false> { bf16x8 h[2]; __device__ __forceinline__ void set0(bf16x8 x) { h[0] = x; } __device__ __forceinline__ void set1(bf16x8 x) { h[1] = x; } };
template <> struct Frag<true> { v8i_t v; __device__ __forceinline__ void set0(bf16x8 x) { v.lo = __builtin_bit_cast(v4i_t, x); } __device__ __forceinline__ void set1(bf16x8 x) { v.hi = __builtin_bit_cast(v4i_t, x); } };
template <class Epi, class Sched, bool ALIGN_EPI = false, bool SP2 = false, int DT = 0>
__device__ __forceinline__ void gemm_phase(PG8_LAS unsigned char* lds, const Gemm g, const Sched& S, const Epi& E) {
    int tid_ = threadIdx.x; asm volatile("" : "+v"(tid_));
    const int tid = tid_, wid = __builtin_amdgcn_readfirstlane(tid >> 6), lane = tid & 63, wr = wid >> 2, wc = wid & 3, fr = lane & 15, fq = lane >> 4;
    const int K = g.K;
    unsigned voffA[2], voffB[2];
#pragma unroll
    for (int i = 0; i < 2; ++i) { int R, C; stage_rc(tid * 16 + i * 8192, R, C); const int Rb = Epi::PERM ? ((R & ~31) + perm32(R & 31)) : R;
        voffA[i] = (unsigned)(R * K + C) * 2u; voffB[i] = (unsigned)(Rb * K + C) * 2u; }
    const size_t kstep = (size_t)(BK * 2);
    const size_t hstep = (size_t)HALF * K * 2;
    const size_t tstep = 2 * hstep;
    const unsigned ldsw = (unsigned)wid * 1024u;
    const int aoff = lds_byte(wr * 64 + fr, fq * 8), boff = lds_byte(wc * 32 + fr, fq * 8);
#define PG8_SA(b, h) (((b) * 2 + (h)) * HTB)
#define PG8_SB(b, h) ((4 + (b) * 2 + (h)) * HTB)
#define PG8_STAGE(bufoff, gbase, voff) do { _Pragma("unroll") for (int _i = 0; _i < 2; ++_i) \
        __builtin_amdgcn_global_load_lds((const unsigned*)((const char*)(gbase) + (voff)[_i]), (PG8_LAS unsigned*)(lds + (bufoff) + ldsw + _i * 8192), 16, 0, 0); } while (0)
#define PG8_LDA(dst, b, h) do { _Pragma("unroll") for (int m = 0; m < 4; ++m) { dst[m].set0(*(const PG8_LAS bf16x8*)(lds + PG8_SA(b, h) + aoff + m * 2048)); dst[m].set1(*(const PG8_LAS bf16x8*)(lds + PG8_SA(b, h) + aoff + m * 2048 + 1024)); } } while (0)
#define PG8_LDB(dst, b, h) do { _Pragma("unroll") for (int n = 0; n < 2; ++n) { dst[n].set0(*(const PG8_LAS bf16x8*)(lds + PG8_SB(b, h) + boff + n * 2048)); dst[n].set1(*(const PG8_LAS bf16x8*)(lds + PG8_SB(b, h) + boff + n * 2048 + 1024)); } } while (0)
#define PG8_MMA(ai, bj, At, Bt) do { __builtin_amdgcn_s_setprio(1); _Pragma("unroll") for (int m = 0; m < 4; ++m) _Pragma("unroll") for (int n = 0; n < 2; ++n) { \
        if constexpr (DT == 1) asm volatile("v_mfma_f32_16x16x128_f8f6f4 %0, %1, %2, %0" : "+v"(acc[ai][bj][m][n]) : "v"(Bt[n].v), "v"(At[m].v));   \
        else if constexpr (DT == 2) { _Pragma("unroll") for (int k = 0; k < 2; ++k) acc[ai][bj][m][n] = __builtin_bit_cast(f32x4, __builtin_amdgcn_mfma_i32_16x16x64_i8(__builtin_bit_cast(v4i_t, Bt[n].h[k]), __builtin_bit_cast(v4i_t, At[m].h[k]), __builtin_bit_cast(v4i_t, acc[ai][bj][m][n]), 0, 0, 0)); } \
        else { _Pragma("unroll") for (int k = 0; k < 2; ++k) acc[ai][bj][m][n] = __builtin_amdgcn_mfma_f32_16x16x32_bf16(Bt[n].h[k], At[m].h[k], acc[ai][bj][m][n], 0, 0, 0); } } \
        __builtin_amdgcn_s_setprio(0); } while (0)
#define PG8_WAIT_V(n) asm volatile("s_waitcnt vmcnt(" #n ")" ::: "memory")
#define PG8_WAIT_L(n) asm volatile("s_waitcnt lgkmcnt(" #n ")" ::: "memory")
#define PG8_BAR __builtin_amdgcn_s_barrier()
#define PG8_SCHED __builtin_amdgcn_sched_barrier(0)
    Unit cur, nxt; int ui = 0;
    if (!S.next(0, cur)) return;
    f32x4 acc[2][2][4][2];
#pragma unroll
    for (int a = 0; a < 2; ++a)
#pragma unroll
        for (int b = 0; b < 2; ++b)
#pragma unroll
            for (int m = 0; m < 4; ++m)
#pragma unroll
                for (int n = 0; n < 2; ++n) acc[a][b][m][n] = (f32x4){0.f, 0.f, 0.f, 0.f};
    Frag<DT == 1> At[4], B0[2], B1[2];
    const char* cA = (const char*)g.A + (size_t)cur.pm * tstep + (size_t)cur.kt0 * kstep; const char* cB = (const char*)g.Bt + S.bt_off(cur) + (size_t)cur.pn * tstep + (size_t)cur.kt0 * kstep;
    S.a_ready(cur);
    if constexpr (SP2) {
        PG8_STAGE(PG8_SB(0, 0), cB, voffB); PG8_STAGE(PG8_SB(0, 1), cB + hstep, voffB); PG8_STAGE(PG8_SA(0, 0), cA, voffA); PG8_STAGE(PG8_SA(0, 1), cA + hstep, voffA);
        if (wr == 1) PG8_BAR;
        PG8_WAIT_V(2); PG8_BAR;
        PG8_STAGE(PG8_SB(1, 0), cB + kstep, voffB); PG8_STAGE(PG8_SA(1, 0), cA + kstep, voffA); PG8_STAGE(PG8_SB(1, 1), cB + hstep + kstep, voffB);
        PG8_WAIT_V(6); PG8_BAR;
    } else {
        PG8_STAGE(PG8_SB(0, 0), cB, voffB); PG8_STAGE(PG8_SA(0, 0), cA, voffA); PG8_STAGE(PG8_SB(0, 1), cB + hstep, voffB); PG8_STAGE(PG8_SA(0, 1), cA + hstep, voffA);
        if (wr == 1) PG8_BAR;
        PG8_WAIT_V(4); PG8_BAR;
        PG8_STAGE(PG8_SB(1, 0), cB + kstep, voffB); PG8_STAGE(PG8_SA(1, 0), cA + kstep, voffA); PG8_STAGE(PG8_SB(1, 1), cB + hstep + kstep, voffB);
        PG8_WAIT_V(6); PG8_BAR;
    }
    for (;;) {
        const bool has_next = S.next(ui + 1, nxt);
        const char* nA = has_next ? (const char*)g.A + (size_t)nxt.pm * tstep + (size_t)nxt.kt0 * kstep : cA; const char* nB = has_next ? (const char*)g.Bt + S.bt_off(nxt) + (size_t)nxt.pn * tstep + (size_t)nxt.kt0 * kstep : cB;
        const int nt = cur.nkt;
        for (int t = 0; t < nt; t += 2) {
            const bool last = (t == nt - 2);
            const char* a1 = cA + (size_t)(t + 1) * kstep;
            const char* a2 = last ? nA : cA + (size_t)(t + 2) * kstep; const char* b2 = last ? nB : cB + (size_t)(t + 2) * kstep;
            const char* a3 = a2 + kstep; const char* b3 = b2 + kstep;
            if (last && has_next) S.a_ready(nxt);
            if constexpr (SP2) {
            PG8_LDB(B0, 0, 0); PG8_LDB(B1, 0, 1); PG8_SCHED; PG8_LDA(At, 0, 0); PG8_STAGE(PG8_SA(1, 1), a1 + hstep, voffA);
            PG8_WAIT_V(8); PG8_WAIT_L(0); PG8_BAR; PG8_MMA(0, 0, At, B0); PG8_MMA(0, 1, At, B1); PG8_BAR; PG8_SCHED;
            PG8_LDA(At, 0, 1); PG8_STAGE(PG8_SB(0, 0), b2, voffB); PG8_STAGE(PG8_SB(0, 1), b2 + hstep, voffB); PG8_STAGE(PG8_SA(0, 0), a2, voffA);
            PG8_WAIT_V(8); PG8_WAIT_L(0); PG8_BAR; PG8_MMA(1, 0, At, B0); PG8_MMA(1, 1, At, B1); PG8_BAR; PG8_SCHED;
            PG8_LDB(B0, 1, 0); PG8_LDB(B1, 1, 1); PG8_SCHED; PG8_LDA(At, 1, 0); PG8_STAGE(PG8_SA(0, 1), a2 + hstep, voffA);
            PG8_WAIT_V(8); PG8_WAIT_L(0); PG8_BAR; PG8_MMA(0, 0, At, B0); PG8_MMA(0, 1, At, B1); PG8_BAR; PG8_SCHED;
            PG8_LDA(At, 1, 1); PG8_STAGE(PG8_SB(1, 0), b3, voffB); PG8_STAGE(PG8_SB(1, 1), b3 + hstep, voffB); PG8_STAGE(PG8_SA(1, 0), a3, voffA);
            PG8_WAIT_V(8); PG8_WAIT_L(0); PG8_BAR; PG8_MMA(1, 0, At, B0); PG8_MMA(1, 1, At, B1); PG8_BAR; PG8_SCHED;
            } else {
            PG8_LDB(B0, 0, 0); PG8_SCHED; PG8_LDA(At, 0, 0); PG8_STAGE(PG8_SA(1, 1), a1 + hstep, voffA);
            PG8_WAIT_L(8); PG8_BAR; PG8_WAIT_L(0); PG8_MMA(0, 0, At, B0); PG8_BAR; PG8_SCHED;
            PG8_LDB(B1, 0, 1); PG8_STAGE(PG8_SB(0, 0), b2, voffB);
            PG8_BAR; PG8_WAIT_L(0); PG8_MMA(0, 1, At, B1); PG8_BAR;
            PG8_LDA(At, 0, 1); PG8_STAGE(PG8_SA(0, 0), a2, voffA);
            PG8_BAR; PG8_WAIT_L(0); PG8_MMA(1, 0, At, B0); PG8_BAR; PG8_SCHED;
            PG8_STAGE(PG8_SB(0, 1), b2 + hstep, voffB);
            PG8_WAIT_V(6); PG8_BAR; PG8_MMA(1, 1, At, B1); PG8_BAR;
            PG8_LDB(B0, 1, 0); PG8_SCHED; PG8_LDA(At, 1, 0); PG8_STAGE(PG8_SA(0, 1), a2 + hstep, voffA);
            PG8_WAIT_L(8); PG8_BAR; PG8_WAIT_L(0); PG8_MMA(0, 0, At, B0); PG8_BAR; PG8_SCHED;
            PG8_LDB(B1, 1, 1); PG8_STAGE(PG8_SB(1, 0), b3, voffB);
            PG8_BAR; PG8_WAIT_L(0); PG8_MMA(0, 1, At, B1); PG8_BAR;
            PG8_LDA(At, 1, 1); PG8_STAGE(PG8_SA(1, 0), a3, voffA);
            PG8_BAR; PG8_WAIT_L(0); PG8_MMA(1, 0, At, B0); PG8_BAR; PG8_SCHED;
            PG8_STAGE(PG8_SB(1, 1), b3 + hstep, voffB);
            PG8_WAIT_V(6); PG8_BAR; PG8_MMA(1, 1, At, B1); PG8_BAR;
            }
        }
        if constexpr (ALIGN_EPI) { if (wr == 0) PG8_BAR; }
        if constexpr (DT == 1) asm volatile("s_nop 15\n\ts_nop 15" ::: "memory");
        if constexpr (!Epi::AFTER_DRAIN) { E(acc, cur, wr, wc, fr, fq); S.done(cur); }
        if (!has_next) break;
#pragma unroll
        for (int a = 0; a < 2; ++a)
#pragma unroll
            for (int b = 0; b < 2; ++b)
#pragma unroll
                for (int m = 0; m < 4; ++m)
#pragma unroll
                    for (int n = 0; n < 2; ++n) acc[a][b][m][n] = (f32x4){0.f, 0.f, 0.f, 0.f};
        cur = nxt; cA = nA; cB = nB; ++ui;
        if constexpr (ALIGN_EPI) { if (wr == 1) PG8_BAR; }
    }
    PG8_WAIT_V(0);
    if constexpr (!ALIGN_EPI) { if (wr == 0) PG8_BAR; }
    PG8_BAR;
    if constexpr (Epi::AFTER_DRAIN) { E.fused(acc, cur, wr, wc, fr, fq, lds, wid, lane); S.done(cur); }
#undef PG8_SA
#undef PG8_SB
#undef PG8_STAGE
#undef PG8_LDA
#undef PG8_LDB
#undef PG8_MMA
#undef PG8_WAIT_V
#undef PG8_WAIT_L
#undef PG8_BAR
#undef PG8_SCHED
}
}

namespace pg8 {
__device__ __forceinline__ u32x4 pack8(const f32x4 v0, const f32x4 v1) { u32x4 w; w.x = cvt_pk_bf16(v0[0], v0[1]); w.y = cvt_pk_bf16(v0[2], v0[3]); w.z = cvt_pk_bf16(v1[0], v1[1]); w.w = cvt_pk_bf16(v1[2], v1[3]); return w; }
struct EpiStore {
    static constexpr bool PERM = true, AFTER_DRAIN = false;
    bf16_t* O; int ldc;
    __device__ __forceinline__ void operator()(const f32x4 (&acc)[2][2][4][2], const Unit& u, int wr, int wc, int fr, int fq) const {
        const int row0 = u.pm * BM + wr * 64 + fr, col0 = u.pn * BM + wc * 32 + 8 * fq;
#pragma unroll
        for (int ai = 0; ai < 2; ++ai)
#pragma unroll
            for (int m = 0; m < 4; ++m) { bf16_t* rowp = O + (size_t)(row0 + ai * HALF + m * 16) * ldc + col0;
#pragma unroll
                for (int bj = 0; bj < 2; ++bj) *(u32x4*)(rowp + bj * HALF) = pack8(acc[ai][bj][m][0], acc[ai][bj][m][1]); }
    }
};
struct EpiQ {
    static constexpr bool PERM = true, AFTER_DRAIN = false;
    bf16_t* O; const float* cosT; const float* sinT;
    __device__ __forceinline__ void operator()(const f32x4 (&acc)[2][2][4][2], const Unit& u, int wr, int wc, int fr, int fq) const {
        const int row0 = u.pm * BM + wr * 64 + fr, col0 = u.pn * BM + wc * 32 + 8 * fq;
#pragma unroll
        for (int ai = 0; ai < 2; ++ai)
#pragma unroll
            for (int m = 0; m < 4; ++m) { const int row = row0 + ai * HALF + m * 16; const bool lat = row < 8192; const int t = row & 2047;
#pragma unroll
                for (int bj = 0; bj < 2; ++bj) { const int col = col0 + bj * HALF; const int jn = col - 192 * (col / 192);
                    f32x4 v0 = acc[ai][bj][m][0], v1 = acc[ai][bj][m][1];
                    if (jn >= 128 && lat) { const int i0 = (jn - 128) >> 1;
                        const f32x4 cs = *(const f32x4*)(cosT + t * 32 + i0), sn = *(const f32x4*)(sinT + t * 32 + i0);
                        f32x4 r0, r1;
                        r0[0] = v0[0] * cs[0] - v0[1] * sn[0]; r0[1] = v0[0] * sn[0] + v0[1] * cs[0];
                        r0[2] = v0[2] * cs[1] - v0[3] * sn[1]; r0[3] = v0[2] * sn[1] + v0[3] * cs[1];
                        r1[0] = v1[0] * cs[2] - v1[1] * sn[2]; r1[1] = v1[0] * sn[2] + v1[1] * cs[2];
                        r1[2] = v1[2] * cs[3] - v1[3] * sn[3]; r1[3] = v1[2] * sn[3] + v1[3] * cs[3];
                        v0 = r0; v1 = r1; }
                    *(u32x4*)(O + (size_t)row * 1536 + col) = pack8(v0, v1); } }
    }
};
__device__ __forceinline__ f32x4 bf4_lo(const u32x4 q) { return (f32x4){__uint_as_float(q.x << 16), __uint_as_float(q.x & 0xffff0000u), __uint_as_float(q.y << 16), __uint_as_float(q.y & 0xffff0000u)}; }
__device__ __forceinline__ f32x4 bf4_hi(const u32x4 q) { return (f32x4){__uint_as_float(q.z << 16), __uint_as_float(q.z & 0xffff0000u), __uint_as_float(q.w << 16), __uint_as_float(q.w & 0xffff0000u)}; }
struct EpiResid {
    static constexpr bool PERM = true, AFTER_DRAIN = false;
    bf16_t* xs; const float* rd_lat; const float* gate; bf16_t* slab; int tail_row0, tail_rows; float scale;
    __device__ __forceinline__ void operator()(const f32x4 (&acc)[2][2][4][2], const Unit& u, int wr, int wc, int fr, int fq) const {
        const int row0 = u.pm * BM + wr * 64 + fr, colb = u.pn * BM + wc * 32 + 8 * fq;
        if (u.slab >= 0) {
#pragma unroll
            for (int ai = 0; ai < 2; ++ai)
#pragma unroll
                for (int m = 0; m < 4; ++m) { bf16_t* sp = slab + ((size_t)u.slab * tail_rows + (row0 + ai * HALF + m * 16 - tail_row0)) * 2048;
#pragma unroll
                    for (int bj = 0; bj < 2; ++bj) *(u32x4*)(sp + colb + bj * HALF) = pack8(acc[ai][bj][m][0] * scale, acc[ai][bj][m][1] * scale); }
            return;
        }
#pragma unroll
        for (int ai = 0; ai < 2; ++ai)
#pragma unroll
            for (int m = 0; m < 4; ++m) { const int row = row0 + ai * HALF + m * 16; const float* gv = gate + (size_t)(row < 8192 ? (row >> 11) : 4) * 12288; bf16_t* xr = xs + (size_t)row * 2048;
#pragma unroll
                for (int bj = 0; bj < 2; ++bj) { const int col = colb + bj * HALF; f32x4 x0, x1;
                    if (rd_lat) { x0 = *(const f32x4*)(rd_lat + (size_t)row * 2048 + col); x1 = *(const f32x4*)(rd_lat + (size_t)row * 2048 + col + 4); }
                    else { const u32x4 q = *(const u32x4*)(xr + col); x0 = bf4_lo(q); x1 = bf4_hi(q); }
                    const f32x4 g0 = *(const f32x4*)(gv + col), g1 = *(const f32x4*)(gv + col + 4);
                    x0 += (g0 * scale) * acc[ai][bj][m][0]; x1 += (g1 * scale) * acc[ai][bj][m][1]; *(u32x4*)(xr + col) = pack8(x0, x1); }
                if (m & 1) asm volatile("" ::: "memory"); }
    }
};
__device__ __forceinline__ unsigned pack4_fp8(float a, float b, float c, float d) {
    a = __builtin_amdgcn_fmed3f(a, -448.f, 448.f); b = __builtin_amdgcn_fmed3f(b, -448.f, 448.f); c = __builtin_amdgcn_fmed3f(c, -448.f, 448.f); d = __builtin_amdgcn_fmed3f(d, -448.f, 448.f);
    unsigned w = 0; w = __builtin_amdgcn_cvt_pk_fp8_f32(a, b, w, false); w = __builtin_amdgcn_cvt_pk_fp8_f32(c, d, w, true); return w; }
struct EpiSwiGLU8 {
    static constexpr bool PERM = true, AFTER_DRAIN = false;
    unsigned char* O; int ldc; float s, oscale;
    __device__ __forceinline__ void operator()(const f32x4 (&acc)[2][2][4][2], const Unit& u, int wr, int wc, int fr, int fq) const {
        if (PROBE_SUB != 0u && O == nullptr) return;
        const int row0 = u.pm * BM + wr * 64 + fr, col0 = u.pn * HALF + wc * 32 + 8 * fq;
#pragma unroll
        for (int ai = 0; ai < 2; ++ai)
#pragma unroll
            for (int m = 0; m < 4; ++m) { f32x4 o0, o1;
#pragma unroll
                for (int j = 0; j < 4; ++j) { const float g0 = acc[ai][0][m][0][j] * s, g1 = acc[ai][0][m][1][j] * s;
                    o0[j] = g0 * __builtin_amdgcn_rcpf(1.0f + __expf(-g0)) * (acc[ai][1][m][0][j] * (s * oscale)); o1[j] = g1 * __builtin_amdgcn_rcpf(1.0f + __expf(-g1)) * (acc[ai][1][m][1][j] * (s * oscale)); }
                u32x2 w; w.x = pack4_fp8(o0[0], o0[1], o0[2], o0[3]); w.y = pack4_fp8(o1[0], o1[1], o1[2], o1[3]);
                *(u32x2*)(O + (size_t)(row0 + ai * HALF + m * 16) * ldc + col0) = w; }
    }
};
__device__ __forceinline__ f32x4 i2f4(const f32x4 bits) { const v4i_t iv = __builtin_bit_cast(v4i_t, bits); return (f32x4){(float)iv[0], (float)iv[1], (float)iv[2], (float)iv[3]}; }
struct EpiStoreI8 {
    static constexpr bool PERM = true, AFTER_DRAIN = false;
    bf16_t* O; int ldc; const float* rsc; float sw;
    __device__ __forceinline__ void operator()(const f32x4 (&acc)[2][2][4][2], const Unit& u, int wr, int wc, int fr, int fq) const {
        const int row0 = u.pm * BM + wr * 64 + fr, col0 = u.pn * BM + wc * 32 + 8 * fq;
#pragma unroll
        for (int ai = 0; ai < 2; ++ai)
#pragma unroll
            for (int m = 0; m < 4; ++m) { const int row = row0 + ai * HALF + m * 16; const float sc = rsc[row] * sw; bf16_t* rowp = O + (size_t)row * ldc + col0;
#pragma unroll
                for (int bj = 0; bj < 2; ++bj) *(u32x4*)(rowp + bj * HALF) = pack8(i2f4(acc[ai][bj][m][0]) * sc, i2f4(acc[ai][bj][m][1]) * sc); }
    }
};
struct EpiSwiGLUI8 {
    static constexpr bool PERM = true, AFTER_DRAIN = false;
    unsigned char* O; int ldc; const float* rsc; float swg, swu, oscale;
    __device__ __forceinline__ void operator()(const f32x4 (&acc)[2][2][4][2], const Unit& u, int wr, int wc, int fr, int fq) const {
        const int row0 = u.pm * BM + wr * 64 + fr, col0 = u.pn * HALF + wc * 32 + 8 * fq;
#pragma unroll
        for (int ai = 0; ai < 2; ++ai)
#pragma unroll
            for (int m = 0; m < 4; ++m) { const int row = row0 + ai * HALF + m * 16; const float sa = rsc[row], sg = sa * swg, su = sa * swu * oscale; f32x4 o0, o1;
                const f32x4 g0v = i2f4(acc[ai][0][m][0]) * sg, g1v = i2f4(acc[ai][0][m][1]) * sg, u0v = i2f4(acc[ai][1][m][0]) * su, u1v = i2f4(acc[ai][1][m][1]) * su;
#pragma unroll
                for (int j = 0; j < 4; ++j) { o0[j] = g0v[j] * __builtin_amdgcn_rcpf(1.0f + __expf(-g0v[j])) * u0v[j]; o1[j] = g1v[j] * __builtin_amdgcn_rcpf(1.0f + __expf(-g1v[j])) * u1v[j]; }
                u32x2 w; w.x = pack4_fp8(o0[0], o0[1], o0[2], o0[3]); w.y = pack4_fp8(o1[0], o1[1], o1[2], o1[3]);
                *(u32x2*)(O + (size_t)row * ldc + col0) = w; }
    }
};
struct EpiSwiGLU {
    static constexpr bool PERM = true, AFTER_DRAIN = false;
    bf16_t* O; int ldc;
    __device__ __forceinline__ void operator()(const f32x4 (&acc)[2][2][4][2], const Unit& u, int wr, int wc, int fr, int fq) const {
        const int row0 = u.pm * BM + wr * 64 + fr, col0 = u.pn * HALF + wc * 32 + 8 * fq;
#pragma unroll
        for (int ai = 0; ai < 2; ++ai)
#pragma unroll
            for (int m = 0; m < 4; ++m) { f32x4 o0, o1;
#pragma unroll
                for (int j = 0; j < 4; ++j) { const float g0 = acc[ai][0][m][0][j], g1 = acc[ai][0][m][1][j];
                    o0[j] = g0 / (1.0f + __expf(-g0)) * acc[ai][1][m][0][j]; o1[j] = g1 / (1.0f + __expf(-g1)) * acc[ai][1][m][1][j]; }
                *(u32x4*)(O + (size_t)(row0 + ai * HALF + m * 16) * ldc + col0) = pack8(o0, o1); }
    }
};
struct EpiF32 {
    static constexpr bool PERM = false, AFTER_DRAIN = false;
    float* O; int ldc; float* slab; int tail_row0, tail_rows; float scale;
    __device__ __forceinline__ void operator()(const f32x4 (&acc)[2][2][4][2], const Unit& u, int wr, int wc, int fr, int fq) const {
        const int row0 = u.pm * BM + wr * 64 + fr, colb = u.pn * BM + wc * 32 + 4 * fq;
#pragma unroll
        for (int ai = 0; ai < 2; ++ai)
#pragma unroll
            for (int m = 0; m < 4; ++m) { float* xr = (u.slab >= 0) ? slab + ((size_t)u.slab * tail_rows + (row0 + ai * HALF + m * 16 - tail_row0)) * 2048 : O + (size_t)(row0 + ai * HALF + m * 16) * ldc;
#pragma unroll
                for (int bj = 0; bj < 2; ++bj)
#pragma unroll
                    for (int n = 0; n < 2; ++n) *(f32x4*)(xr + colb + bj * HALF + n * 16) = acc[ai][bj][m][n] * scale; }
    }
};
struct EpiYs {
    static constexpr bool PERM = true, AFTER_DRAIN = false;
    bf16_t* O; bf16_t* slab; int tail_row0, tail_rows; float scale;
    __device__ __forceinline__ void operator()(const f32x4 (&acc)[2][2][4][2], const Unit& u, int wr, int wc, int fr, int fq) const {
        const int row0 = u.pm * BM + wr * 64 + fr, colb = u.pn * BM + wc * 32 + 8 * fq;
#pragma unroll
        for (int ai = 0; ai < 2; ++ai)
#pragma unroll
            for (int m = 0; m < 4; ++m) { const int row = row0 + ai * HALF + m * 16; bf16_t* xr = (u.slab >= 0) ? slab + ((size_t)u.slab * tail_rows + (row - tail_row0)) * 2048 : O + (size_t)row * 2048;
#pragma unroll
                for (int bj = 0; bj < 2; ++bj) *(u32x4*)(xr + colb + bj * HALF) = pack8(acc[ai][bj][m][0] * scale, acc[ai][bj][m][1] * scale); }
    }
};
struct MoeOrder {
    int nM, nN, nwg, G, c, nkt; int t1[8]; size_t estride;
    __device__ __forceinline__ void init(const int* ctl, int nN_, int G_, int c_, size_t estride_, int K) { nkt = K / BK;
        int acc = 0;
#pragma unroll
        for (int e = 0; e < 8; ++e) { acc += __builtin_amdgcn_readfirstlane(ctl[CT_EPAD + e]) >> 8; t1[e] = acc; }
        nM = acc; nN = nN_; nwg = nM * nN; G = G_; c = c_; estride = estride_;
    }
    __device__ __forceinline__ bool next(int i, Unit& u) const {
        const long L = (long)i * G + c; if (L >= nwg) return false;
        int wgid = (int)L; { const int q = nwg / NXCD, r = nwg % NXCD, xcd = wgid % NXCD, off = wgid / NXCD; wgid = (xcd < r ? xcd * (q + 1) : r * (q + 1) + (xcd - r) * q) + off; }
        const int nig = WGM * nN, gid = wgid / nig, fm = gid * WGM, gsz = (nM - fm) < WGM ? (nM - fm) : WGM;
        u.pm = fm + ((wgid % nig) % gsz); u.pn = (wgid % nig) / gsz; u.kt0 = 0; u.nkt = nkt; u.slab = -1; return true;
    }
    __device__ __forceinline__ size_t bt_off(const Unit& u) const { int e = 0;
#pragma unroll
        for (int k = 0; k < 7; ++k) e += (u.pm >= t1[k]) ? 1 : 0;
        return (size_t)e * estride; }
    __device__ __forceinline__ void a_ready(const Unit&) const {}
    __device__ __forceinline__ void done(const Unit&) const {}
};
struct WinLastOrder {
    StaticOrder so; int G, c;
    __device__ __forceinline__ void init(int G_, int c_, int K) { so.init(NLAT, UW, G_, c_, K); G = G_; c = c_; }
    __device__ __forceinline__ bool next(int i, Unit& u) const {
        if (so.next(i, u)) return true;
        const long L = (long)i * G + c - so.nwg; if (L < 0 || L >= 20) return false;
        const int j = (int)L, k = j % 5; u.pm = 32 + j / 5; u.pn = k < 3 ? 3 + k : 10 + k; u.kt0 = 0; u.nkt = so.nkt; u.slab = -1; return true;
    }
    __device__ __forceinline__ size_t bt_off(const Unit&) const { return 0; }
    __device__ __forceinline__ void a_ready(const Unit&) const {}
    __device__ __forceinline__ void done(const Unit&) const {}
};
struct SplitOrder {
    int nM, nN, nwg, G, c, nfull, ntail, S, nkt, nkts; int t1[8]; size_t estride;
    __device__ __forceinline__ void init(int nM_, int nN_, int G_, int c_, int K, int S_) {
        nM = nM_; nN = nN_; nwg = nM * nN; G = G_; c = c_; nkt = K / BK; nfull = (nwg / 256) * 256; ntail = nwg - nfull; S = S_; nkts = nkt / S; estride = 0;
#pragma unroll
        for (int e = 0; e < 8; ++e) t1[e] = 0;
    }
    __device__ __forceinline__ void init_moe(const int* ctl, int nN_, int G_, int c_, int K, size_t estride_) {
        int acc = 0;
#pragma unroll
        for (int e = 0; e < 8; ++e) { acc += __builtin_amdgcn_readfirstlane(ctl[CT_EPAD + e]) >> 8; t1[e] = acc; }
        init(acc, nN_, G_, c_, K, __builtin_amdgcn_readfirstlane(ctl[CT_MOES])); estride = estride_;
        acc = 0;
#pragma unroll
        for (int e = 0; e < 8; ++e) { acc += __builtin_amdgcn_readfirstlane(ctl[CT_EPAD + e]) >> 8; t1[e] = acc; }
    }
    __device__ __forceinline__ bool next(int i, Unit& u) const {
        const long L = (long)i * G + c; int wgid;
        if (L < nfull) { wgid = (int)L; { const int q = nfull / NXCD, xcd = wgid % NXCD, off = wgid / NXCD; wgid = xcd * q + off; } u.kt0 = 0; u.nkt = nkt; u.slab = -1; }
        else { const int j = (int)(L - nfull); if (j >= ntail * S) return false; const int tu = j / S, sl = j - tu * S; wgid = nfull + tu; u.kt0 = sl * nkts; u.nkt = nkts; u.slab = (S > 1) ? sl : -1; }
        const int nig = WGM * nN, gid = wgid / nig, fm = gid * WGM, gsz = (nM - fm) < WGM ? (nM - fm) : WGM;
        u.pm = fm + ((wgid % nig) % gsz); u.pn = (wgid % nig) / gsz; return true;
    }
    __device__ __forceinline__ size_t bt_off(const Unit& u) const { if (estride == 0) return 0; int e = 0;
#pragma unroll
        for (int k = 0; k < 7; ++k) e += (u.pm >= t1[k]) ? 1 : 0;
        return (size_t)e * estride; }
    __device__ __forceinline__ void a_ready(const Unit&) const {}
    __device__ __forceinline__ void done(const Unit&) const {}
};
__host__ __device__ constexpr int split_S(int nwg, int nkt, int G) {
    const int ntail = nwg - (nwg / G) * G;
    if (ntail == 0) return 1;
    if (nkt % 28 == 0 && ntail * 14 <= G) return 14;
    if (nkt % 16 == 0 && ntail * 8 <= G) return 8;
    if (nkt % 14 == 0 && ntail * 7 <= G) return 7;
    if (nkt % 8 == 0 && ntail * 4 <= G) return 4;
    if (nkt % 4 == 0 && ntail * 2 <= G) return 2;
    return 1;
}
}

#define LAS __attribute__((address_space(3)))
#define XB_TMO      128
#define XB_XCNT(j)  (256  + 64 * (j))
#define XB_XSUB(j)  (1280 + 64 * (j))
#define XB_XGEN(j)  (2304 + 64 * (j))
#define XB_TOP      3328
#define XB_TOPGEN   3392
#define XCD_BAR_WORDS 3456
#define XB_SPIN_CAP (1u << 18)

__device__ __forceinline__ unsigned xb_ld(unsigned* p)              { return __hip_atomic_load(p, __ATOMIC_RELAXED, __HIP_MEMORY_SCOPE_AGENT); }
__device__ __forceinline__ unsigned xb_add(unsigned* p, unsigned v) { return __hip_atomic_fetch_add(p, v, __ATOMIC_RELAXED, __HIP_MEMORY_SCOPE_AGENT); }
__device__ __forceinline__ unsigned xb_xcc_id() { return (unsigned)__builtin_amdgcn_s_getreg((3 << 11) | 20) & 0xFu; }
#define XB_SPIN(cond, bar) do { unsigned _sp = 0; while (cond) { __builtin_amdgcn_s_sleep(1); \
    if ((++_sp & 255u) == 0u) { if (xb_ld(&(bar)[XB_TMO])) break; if (_sp > XB_SPIN_CAP) { atomicAdd(&(bar)[XB_TMO], 1u); break; } } } } while (0)

struct XcdBarrier {
    unsigned* bar; unsigned x;
    volatile LAS unsigned* st;
};

__device__ __forceinline__ XcdBarrier xcd_barrier_post(unsigned* bar, volatile LAS unsigned* st) {
    XcdBarrier b; b.bar = bar; b.x = xb_xcc_id(); b.st = st;
    if (threadIdx.x == 0) (void)xb_add(&bar[XB_XCNT(b.x)], 1u);
    return b;
}
__device__ __forceinline__ void xcd_barrier_complete(unsigned* bar, unsigned x, unsigned& nloc, unsigned& nx) {
    const unsigned G = gridDim.x * gridDim.y * gridDim.z;
    unsigned sum, cnt, mine, sp = 0u;
    for (;;) {
        sum = 0u; cnt = 0u; mine = 0u;
#pragma unroll
        for (unsigned j = 0; j < 16; ++j) { const unsigned c = xb_ld(&bar[XB_XCNT(j)]); sum += c; cnt += (c > 0u) ? 1u : 0u; mine = (j == x) ? c : mine; }
        if (sum == G) break;
        __builtin_amdgcn_s_sleep(1);
        if ((++sp & 255u) == 0u) { if (xb_ld(&bar[XB_TMO])) break; if (sp > XB_SPIN_CAP) { atomicAdd(&bar[XB_TMO], 1u); break; } }
    }
    nloc = mine > 0u ? mine : 1u; nx = cnt > 0u ? cnt : 1u;
}

__device__ __forceinline__ void xcd_barrier(const XcdBarrier& b) {
    asm volatile("s_waitcnt vmcnt(0)" ::: "memory");
    __syncthreads();
    if (threadIdx.x == 0) {
        unsigned* bar = b.bar;
        __builtin_amdgcn_s_waitcnt(0);
        unsigned nloc = b.st[0], nx = b.st[1];
        if (nloc == 0u) { xcd_barrier_complete(bar, b.x, nloc, nx); b.st[0] = nloc; b.st[1] = nx; }
        const unsigned old = xb_add(&bar[XB_XSUB(b.x)], 1u);
        const unsigned gen = old / nloc;
        if (old + 1u == (gen + 1u) * nloc) {
            __builtin_amdgcn_fence(__ATOMIC_RELEASE, "agent");
            asm volatile("s_waitcnt vmcnt(0)" ::: "memory");
            const unsigned og = xb_add(&bar[XB_TOP], 1u);
            const unsigned tg = og / nx;
            if (og + 1u == (tg + 1u) * nx) xb_add(&bar[XB_TOPGEN], 1u);
            else XB_SPIN(xb_ld(&bar[XB_TOPGEN]) == tg, bar);
            __builtin_amdgcn_fence(__ATOMIC_ACQUIRE, "agent");
            xb_add(&bar[XB_XGEN(b.x)], 1u);
            asm volatile("s_waitcnt vmcnt(0)" ::: "memory");
        } else {
            XB_SPIN(xb_ld(&bar[XB_XGEN(b.x)]) == gen, bar);
            __builtin_amdgcn_fence(__ATOMIC_ACQUIRE, "agent");
            asm volatile("s_waitcnt vmcnt(0)" ::: "memory");
        }
    }
    __syncthreads();
}


struct Args { const float* in[34]; float* out; unsigned char* ws; int ph_lo, ph_hi; };

enum { MAP_ID = 0, MAP_ROPEQ = 1, MAP_GU0 = 2, MAP_GU1 = 3, MAP_KV = 4 };
struct JobDesc { int in_idx, K, N, nbatch, upb, map; long long src_off, src_bstride, dst_off, dst_bstride; int fp8, sidx; };
constexpr int NJOBS = 14, NCONV = 12664;
constexpr int G1_GEMM = CQ1 > 0 ? 184 : 256, G2_GEMM = CQ2 > 0 ? 232 : 256;
constexpr int TAIL1_BLK0 = 540 - 2 * G1_GEMM, TAIL1_N = G1_GEMM - TAIL1_BLK0, CONV1_N = 256 - G1_GEMM;
constexpr int TAIL2_BLK0 = 1584 - 6 * G2_GEMM, TAIL2_N = G2_GEMM - TAIL2_BLK0, CONV2_N = 256 - G2_GEMM;
constexpr int TAIL3_BLK0 = 64, TAIL3_N = 192, TAIL4_BLK0 = 32, TAIL4_N = 224;
constexpr int NCONV_T1 = TAIL1_N * TAILQ1 + CONV1_N * CQ1, NCONV_T2 = TAIL2_N * TAILQ2 + CONV2_N * CQ2, NCONV_T3 = TAIL3_N * TAILQ3, NCONV_T4 = TAIL4_N * TAILQ4, NCONV_Q = NCONV - NCONV_T1 - NCONV_T2 - NCONV_T3 - NCONV_T4;
static_assert(NCONV_Q % 2 == 0 && NCONV_Q >= 1912, "the prologue queue takes pairs; the tails only hold expert weights");
__constant__ JobDesc c_jobs[NJOBS] = {
    {8, 2048, 3648, 1, 232, MAP_ID, 0, 0, (long long)WS_WIN, 0, I8_WIN ? 2 : 0, 0},
    {8, 2048, 3648, 1, 232, MAP_ID, 2048LL * 3648, 0, (long long)(WS_WIN + (size_t)UW * D * 2), 0, I8_WIN ? 2 : 0, 1},
    {10, 768, 1536, 1, 36, MAP_ROPEQ, 0, 0, (long long)WS_WQ, 0},
    {10, 768, 1536, 1, 36, MAP_ROPEQ, 768LL * 1536, 0, (long long)(WS_WQ + (size_t)QW * 768 * 2), 0},
    {12, 512, 2048, 1, 32, MAP_KV, 0, 0, (long long)WS_WKV, 0},
    {12, 512, 2048, 1, 32, MAP_KV, 512LL * 2048, 0, (long long)(WS_WKV + (size_t)KVW * 512 * 2), 0},
    {25, 2048, 2048, 1, 128, MAP_ID, 0, 0, (long long)WS_WOUT, 0},
    {25, 2048, 2048, 1, 128, MAP_ID, 2048LL * 2048, 0, (long long)(WS_WOUT + (size_t)D * D * 2), 0},
    {26, 2048, 5632, 1, 352, MAP_GU0, 0, 0, (long long)WS_WGU, 0, I8_GU ? 2 : FP8_DENSE, 2},
    {27, 2048, 5632, 1, 352, MAP_GU1, 0, 0, (long long)WS_WGU, 0, I8_GU ? 2 : FP8_DENSE, 3},
    {28, 5632, 2048, 1, 352, MAP_ID, 0, 0, (long long)WS_WDN, 0, (FP8_DENSE || FP8_DOWN), 0},
    {30, 2048, 7168, 8, 448, MAP_GU0, 0, 2048LL * 7168, (long long)WS_MGU, 2LL * DFE * D, 1, 0},
    {31, 2048, 7168, 8, 448, MAP_GU1, 0, 2048LL * 7168, (long long)WS_MGU, 2LL * DFE * D, 1, 0},
    {32, 7168, 2048, 8, 448, MAP_ID, 0, 7168LL * 2048, (long long)WS_MDN, (long long)D * DFE, 1, 0},
};
struct ConvUnit { const float* src; bf16_t* dst; int K, N, map, k0, n0, fp8; float qs; };
__device__ __forceinline__ unsigned pack4_i8(float a, float b, float c, float d) {
    const int ia = (int)__builtin_rintf(__builtin_amdgcn_fmed3f(a, -127.f, 127.f)), ib = (int)__builtin_rintf(__builtin_amdgcn_fmed3f(b, -127.f, 127.f)), ic = (int)__builtin_rintf(__builtin_amdgcn_fmed3f(c, -127.f, 127.f)), id = (int)__builtin_rintf(__builtin_amdgcn_fmed3f(d, -127.f, 127.f));
    return (unsigned)(ia & 0xff) | ((unsigned)(ib & 0xff) << 8) | ((unsigned)(ic & 0xff) << 16) | ((unsigned)(id & 0xff) << 24); }
constexpr float WSCALE = 64.f, ASCALE = 8.f;
__device__ __forceinline__ void conv_decode(const Args& a, int u, ConvUnit& cu) {
    int j = 0, base = 0;
    for (;;) { const int n = c_jobs[j].nbatch * c_jobs[j].upb; if (u < base + n || j == NJOBS - 1) break; base += n; ++j; }
    const JobDesc& jd = c_jobs[j];
    int r = u - base; const int bt = r / jd.upb; r -= bt * jd.upb; const int ntn = (jd.N + 127) >> 7; int kt = r / ntn, nt = r - kt * ntn;
    if (((jd.K >> 8) & 1) == 0) { const int r2 = r >> 1; kt = 2 * (r2 / ntn) + (r & 1); nt = r2 % ntn; }
    cu.K = jd.K; cu.N = jd.N; cu.map = jd.map; cu.k0 = kt * 256; cu.n0 = nt * 128; cu.fp8 = jd.fp8; cu.qs = 1.0f;
    if (jd.fp8 == 2) { const float am = __uint_as_float(__hip_atomic_load((const unsigned*)(a.ws + WS_CTL) + CT_WSC + jd.sidx, __ATOMIC_RELAXED, __HIP_MEMORY_SCOPE_AGENT)); cu.qs = am > 0.f ? 127.0f / am : 0.f; }
    const float* sb = j < 2 ? a.in[8] : j < 4 ? a.in[10] : j < 6 ? a.in[12] : j < 8 ? a.in[25] : j == 8 ? a.in[26] : j == 9 ? a.in[27] : j == 10 ? a.in[28] : j == 11 ? a.in[30] : j == 12 ? a.in[31] : a.in[32];
    cu.src = sb + jd.src_off + (long long)bt * jd.src_bstride + (size_t)cu.k0 * jd.N + cu.n0;
    cu.dst = (bf16_t*)(a.ws + jd.dst_off + (long long)bt * jd.dst_bstride);
}
__device__ __forceinline__ int conv_row(int map, int n) {
    if (map == MAP_ID) return n;
    if (map == MAP_GU0) return ((n >> 7) << 8) + (n & 127);
    if (map == MAP_GU1) return ((n >> 7) << 8) + 128 + (n & 127);
    if (map == MAP_KV) { const int hh = n >> 8, jn = n & 255; return jn < 128 ? hh * 128 + jn : 1024 + hh * 128 + (jn - 128); }
    const int hh = n / 192, jn = n - hh * 192; if (jn < 128) return n; const int q = jn - 128; return hh * 192 + 128 + 2 * (q & 31) + (q >> 5);
}
constexpr int CV_P = 129, CV_BUF = 65536;
#define CONV_LOAD(R, CU) do { const bool ok_ = (CU).n0 + (tid & 31) * 4 < (CU).N; const float* sp_ = (CU).src + (size_t)((tid >> 5) * 16) * (CU).N + (tid & 31) * 4; \
        _Pragma("unroll") for (int i_ = 0; i_ < 16; ++i_) R[i_] = ok_ ? __builtin_nontemporal_load((const f32x4*)(sp_ + (size_t)i_ * (CU).N)) : (f32x4){0.f, 0.f, 0.f, 0.f}; } while (0)
__device__ __forceinline__ void conv_put(const f32x4 (&R)[16], const ConvUnit& cu, unsigned char* buf, int tid) {
    const int nq = tid & 31, kc = tid >> 5;
    if (cu.fp8 == 2) {
        const float qs = cu.qs;
#pragma unroll
        for (int c = 0; c < 4; ++c) { u32x4 w;
            w.x = pack4_i8(R[0][c] * qs, R[1][c] * qs, R[2][c] * qs, R[3][c] * qs); w.y = pack4_i8(R[4][c] * qs, R[5][c] * qs, R[6][c] * qs, R[7][c] * qs);
            w.z = pack4_i8(R[8][c] * qs, R[9][c] * qs, R[10][c] * qs, R[11][c] * qs); w.w = pack4_i8(R[12][c] * qs, R[13][c] * qs, R[14][c] * qs, R[15][c] * qs);
            *(u32x4*)(buf + (4 * nq + c) * 256 + ((kc ^ (nq & 15)) << 4)) = w; }
    } else if (cu.fp8) {
#pragma unroll
        for (int c = 0; c < 4; ++c) { u32x4 w;
            w.x = pg8::pack4_fp8(R[0][c] * WSCALE, R[1][c] * WSCALE, R[2][c] * WSCALE, R[3][c] * WSCALE); w.y = pg8::pack4_fp8(R[4][c] * WSCALE, R[5][c] * WSCALE, R[6][c] * WSCALE, R[7][c] * WSCALE);
            w.z = pg8::pack4_fp8(R[8][c] * WSCALE, R[9][c] * WSCALE, R[10][c] * WSCALE, R[11][c] * WSCALE); w.w = pg8::pack4_fp8(R[12][c] * WSCALE, R[13][c] * WSCALE, R[14][c] * WSCALE, R[15][c] * WSCALE);
            *(u32x4*)(buf + (4 * nq + c) * 256 + ((kc ^ (nq & 15)) << 4)) = w; }
    } else {
#pragma unroll
        for (int c = 0; c < 4; ++c) { u32x4 w0, w1;
            w0.x = pg8::cvt_pk_bf16(R[0][c], R[1][c]); w0.y = pg8::cvt_pk_bf16(R[2][c], R[3][c]); w0.z = pg8::cvt_pk_bf16(R[4][c], R[5][c]); w0.w = pg8::cvt_pk_bf16(R[6][c], R[7][c]);
            w1.x = pg8::cvt_pk_bf16(R[8][c], R[9][c]); w1.y = pg8::cvt_pk_bf16(R[10][c], R[11][c]); w1.z = pg8::cvt_pk_bf16(R[12][c], R[13][c]); w1.w = pg8::cvt_pk_bf16(R[14][c], R[15][c]);
            *(u32x4*)(buf + (4 * nq + c) * 512 + (((2 * kc) ^ nq) << 4)) = w0; *(u32x4*)(buf + (4 * nq + c) * 512 + (((2 * kc + 1) ^ nq) << 4)) = w1; }
    }
}
__device__ __forceinline__ void conv_out(const ConvUnit& cur, const unsigned char* buf, int tid) {
    if (cur.fp8) {
#pragma unroll
        for (int j = 0; j < 4; ++j) { const int nl = (tid >> 4) + 32 * j, ch = tid & 15;
            if (cur.n0 + nl < cur.N) { const int row = conv_row(cur.map, cur.n0 + nl); const u32x4 w = *(const u32x4*)(buf + nl * 256 + ((ch ^ ((nl >> 2) & 15)) << 4));
                *(u32x4*)((unsigned char*)cur.dst + (size_t)row * cur.K + cur.k0 + ch * 16) = w; } }
    } else {
#pragma unroll
        for (int j = 0; j < 8; ++j) { const int nl = (tid >> 5) + 16 * j, ch = tid & 31;
            if (cur.n0 + nl < cur.N) { const int row = conv_row(cur.map, cur.n0 + nl); const u32x4 w = *(const u32x4*)(buf + nl * 512 + ((ch ^ ((nl >> 2) & 31)) << 4));
                *(u32x4*)((unsigned char*)cur.dst + ((size_t)row * cur.K + cur.k0) * 2 + ch * 16) = w; } }
    }
}
template <int MODE = 0>
__device__ __forceinline__ void ph_convert(const Args& a, float* tile, int first, int stride, int end) {
    const int tid = threadIdx.x; unsigned char* buf = (unsigned char*)tile;
    int u = first; ConvUnit cuA, cuB; f32x4 rA[16], rB[16];
#pragma unroll
    for (int i = 0; i < 16; ++i) { rA[i] = (f32x4){0.f, 0.f, 0.f, 0.f}; rB[i] = rA[i]; }
    if (u < end) { conv_decode(a, u, cuA); if (MODE != 2) CONV_LOAD(rA, cuA); }
    if (u + stride < end) { conv_decode(a, u + stride, cuB); if (MODE != 2) CONV_LOAD(rB, cuB); }
    while (u < end) {
        conv_put(rA, cuA, buf, tid);
        __syncthreads();
        { const ConvUnit cur = cuA; const int un = u + 2 * stride; if (un < end) { conv_decode(a, un, cuA); if (MODE != 2) CONV_LOAD(rA, cuA); } if (MODE != 1) conv_out(cur, buf, tid); }
        u += stride; if (u >= end) break;
        conv_put(rB, cuB, buf + CV_BUF, tid);
        __syncthreads();
        { const ConvUnit cur = cuB; const int un = u + 2 * stride; if (un < end) { conv_decode(a, un, cuB); if (MODE != 2) CONV_LOAD(rB, cuB); } if (MODE != 1) conv_out(cur, buf + CV_BUF, tid); }
        u += stride;
    }
    __syncthreads();
}
constexpr int CT_QNEXT = 1152;
template <int MODE = 0>
__device__ __forceinline__ void conv_dynamic(const Args& a, float* tile) {
    unsigned* qn = (unsigned*)(a.ws + WS_CTL) + CT_QNEXT; volatile int* bc = (volatile int*)(tile + 256 * CV_P + 4);
    const int tid = threadIdx.x;
    if (tid == 0) { bc[0] = (int)__hip_atomic_fetch_add(qn, 1u, __ATOMIC_RELAXED, __HIP_MEMORY_SCOPE_AGENT); bc[1] = (int)__hip_atomic_fetch_add(qn, 1u, __ATOMIC_RELAXED, __HIP_MEMORY_SCOPE_AGENT); }
    __syncthreads();
    int q = bc[0], qN = bc[1];
    __syncthreads();
    ConvUnit cuA, cuB; f32x4 rA[16], rB[16];
#pragma unroll
    for (int i = 0; i < 16; ++i) { rA[i] = (f32x4){0.f, 0.f, 0.f, 0.f}; rB[i] = rA[i]; }
    if (2 * q < NCONV_Q) { conv_decode(a, 2 * q, cuA); if (MODE != 2) CONV_LOAD(rA, cuA); }
    if (2 * q + 1 < NCONV_Q) { conv_decode(a, 2 * q + 1, cuB); if (MODE != 2) CONV_LOAD(rB, cuB); }
    unsigned char* buf = (unsigned char*)tile;
    while (2 * q < NCONV_Q) {
        const bool hasB = 2 * q + 1 < NCONV_Q;
        conv_put(rA, cuA, buf, tid);
        __syncthreads();
        { const ConvUnit cur = cuA; if (2 * qN < NCONV_Q) { conv_decode(a, 2 * qN, cuA); if (MODE != 2) CONV_LOAD(rA, cuA); }
          if (tid == 0) bc[0] = (int)__hip_atomic_fetch_add(qn, 1u, __ATOMIC_RELAXED, __HIP_MEMORY_SCOPE_AGENT);
          if (MODE != 1) conv_out(cur, buf, tid); }
        if (hasB) {
            conv_put(rB, cuB, buf + CV_BUF, tid);
            __syncthreads();
            { const ConvUnit cur = cuB; if (2 * qN + 1 < NCONV_Q) { conv_decode(a, 2 * qN + 1, cuB); if (MODE != 2) CONV_LOAD(rB, cuB); }
              if (MODE != 1) conv_out(cur, buf + CV_BUF, tid); }
        } else __syncthreads();
        q = qN; qN = bc[0];
    }
    __syncthreads();
}
#undef CONV_LOAD
constexpr int CONV_STATIC = 856, CONV_DENSE_END = 1912, CONV_BATCH = 2;
__device__ __forceinline__ constexpr int CT_DONE(int k) { return 1216 + 64 * k; }
__device__ __forceinline__ void conv_fill(const Args& a, float* tile, int done_idx) {
#if !CONV_FILL
    (void)a; (void)tile; (void)done_idx; return;
#endif
    unsigned* ctl = (unsigned*)(a.ws + WS_CTL); volatile int* bc = (volatile int*)(tile + 256 * CV_P + 4);
    const int tid = threadIdx.x;
    if (tid == 0) (void)__hip_atomic_fetch_add(ctl + CT_DONE(done_idx), 1u, __ATOMIC_RELAXED, __HIP_MEMORY_SCOPE_AGENT);
    for (;;) {
        if (tid == 0) { int q = -1;
            if (__hip_atomic_load(ctl + CT_DONE(done_idx), __ATOMIC_RELAXED, __HIP_MEMORY_SCOPE_AGENT) < gridDim.x) {
                q = (int)__hip_atomic_fetch_add(ctl + CT_QNEXT, (unsigned)CONV_BATCH, __ATOMIC_RELAXED, __HIP_MEMORY_SCOPE_AGENT) + CONV_STATIC; if (q >= NCONV) q = -1; }
            *bc = q; }
        __syncthreads();
        const int q = *bc;
        __syncthreads();
        if (q < 0) break;
        ph_convert(a, tile, q, 1, (q + CONV_BATCH < NCONV) ? q + CONV_BATCH : NCONV);
    }
}
__device__ __forceinline__ void conv_finish(const Args& a, float* tile, int upto) {
#if !CONV_FILL
    (void)a; (void)tile; (void)upto; return;
#endif
    unsigned* ctl = (unsigned*)(a.ws + WS_CTL); volatile int* bc = (volatile int*)(tile + 256 * CV_P + 4);
    const int tid = threadIdx.x;
    for (;;) {
        if (tid == 0) { int q = -1;
            if ((int)__hip_atomic_load(ctl + CT_QNEXT, __ATOMIC_RELAXED, __HIP_MEMORY_SCOPE_AGENT) + CONV_STATIC < upto) {
                q = (int)__hip_atomic_fetch_add(ctl + CT_QNEXT, (unsigned)CONV_BATCH, __ATOMIC_RELAXED, __HIP_MEMORY_SCOPE_AGENT) + CONV_STATIC; if (q >= NCONV) q = -1; }
            *bc = q; }
        __syncthreads();
        const int q = *bc;
        __syncthreads();
        if (q < 0) break;
        ph_convert(a, tile, q, 1, (q + CONV_BATCH < NCONV) ? q + CONV_BATCH : NCONV);
    }
}
__device__ __forceinline__ void adaln_unit(const Args& a, int unit, float* sm) {
    const float* c = a.in[1]; const float* cctx = a.in[3]; const float* w_mod = a.in[4]; const float* b_mod = a.in[5]; float* mod = (float*)(a.ws + WS_MOD);
    const int tid = threadIdx.x, l = unit / 96, chunk = unit - l * 96;
    const int cg = tid & 31, ks = tid >> 5;
    for (int i = tid; i < 5 * 2048; i += 512) { const int v = i >> 11, k = i & 2047; const float val = v < 4 ? c[v * 2048 + k] : cctx[k]; sm[i] = val / (1.0f + __expf(-val)); }
    __syncthreads();
    float acc[5][4];
#pragma unroll
    for (int v = 0; v < 5; ++v)
#pragma unroll
        for (int j = 0; j < 4; ++j) acc[v][j] = 0.f;
    const float* wp = w_mod + ((size_t)l * 2048 + (size_t)ks * 128) * 12288 + chunk * 128 + cg * 4;
    for (int kb = 0; kb < 128; kb += 16) {
        f32x4 w[16];
#pragma unroll
        for (int kk = 0; kk < 16; ++kk) w[kk] = __builtin_nontemporal_load((const f32x4*)(wp + (size_t)(kb + kk) * 12288));
#pragma unroll
        for (int kk = 0; kk < 16; ++kk) { const int k = ks * 128 + kb + kk;
#pragma unroll
            for (int v = 0; v < 5; ++v) { const float s = sm[v * 2048 + k];
#pragma unroll
                for (int j = 0; j < 4; ++j) acc[v][j] += s * w[kk][j]; } }
    }
    __syncthreads();
#pragma unroll
    for (int v = 0; v < 5; ++v)
#pragma unroll
        for (int j = 0; j < 4; ++j) sm[(ks * 5 + v) * 128 + cg * 4 + j] = acc[v][j];
    __syncthreads();
    for (int o = tid; o < 640; o += 512) {
        const int v = o >> 7, cc = o & 127; float s = 0.f;
#pragma unroll
        for (int k2 = 0; k2 < 16; ++k2) s += sm[(k2 * 5 + v) * 128 + cc];
        mod[((size_t)l * 5 + v) * 12288 + chunk * 128 + cc] = s + b_mod[(size_t)l * 12288 + chunk * 128 + cc];
    }
    __syncthreads();
}
constexpr int FW_W1 = 0, FW_W2 = 2112, FW_W3 = 6208, FW_B1 = 10304, FW_B2 = 10368, FW_B3 = 10432, FW_FR = 10496, FW_ZS = 10560, FW_HA = 10848, FW_HB = 11360, FW_END = 11872;
__device__ __forceinline__ void filters_unit(const Args& a, int l, int r, float* sm) {
    float (*zs)[36] = (float (*)[36])(sm + FW_ZS); float (*ha)[64] = (float (*)[64])(sm + FW_HA); float (*hb)[64] = (float (*)[64])(sm + FW_HB);
    const int tid = threadIdx.x;
    const bool lat = r < 256; const int Lf = lat ? 2048 : 256; const int p0 = lat ? r * 8 : (r - 256) * 8;
    float* T = (float*)(a.ws + WS_FILTC) + (size_t)l * 512 * 512;
    const float* wf = a.in[21] + (size_t)l * 64 * 1024;
    const int p = tid >> 6, j = tid & 63; const int pos = p0 + p;
    const float tn = (float)pos / (float)(Lf - 1);
    if (j < 33) {
        float z;
        if (j == 0) z = tn;
        else { const int bi = (j - 1) & 15; const float band = 1e-4f + (float)bi * ((15.0f - 1e-4f) / 15.0f);
               const float ang = (6.283185307179586f / (float)Lf) * (float)pos * band; z = (j <= 16) ? __cosf(ang) : -__sinf(ang); }
        zs[p][j] = z;
    }
    __syncthreads();
    const float f = sm[FW_FR + j];
    { float s = sm[FW_B1 + j];
#pragma unroll
      for (int i = 0; i < 33; ++i) s += zs[p][i] * sm[FW_W1 + i * 64 + j];
      ha[p][j] = __sinf(f * s); }
    __syncthreads();
    { float s = sm[FW_B2 + j];
#pragma unroll 16
      for (int i = 0; i < 64; ++i) s += ha[p][i] * sm[FW_W2 + i * 64 + j];
      hb[p][j] = __sinf(f * s); }
    __syncthreads();
    { float s = sm[FW_B3 + j];
#pragma unroll 16
      for (int i = 0; i < 64; ++i) s += hb[p][i] * sm[FW_W3 + i * 64 + j];
      ha[p][j] = __sinf(f * s); }
    __syncthreads();
    float acc[2][8];
#pragma unroll
    for (int rr = 0; rr < 2; ++rr)
#pragma unroll
        for (int q = 0; q < 8; ++q) acc[rr][q] = 0.f;
    for (int ib = 0; ib < 64; ib += 16) {
        float wa[16], wb[16];
#pragma unroll
        for (int i = 0; i < 16; ++i) { wa[i] = wf[(ib + i) * 1024 + tid]; wb[i] = wf[(ib + i) * 1024 + 512 + tid]; }
#pragma unroll
        for (int i = 0; i < 16; ++i) {
#pragma unroll
            for (int q = 0; q < 8; ++q) { const float h = ha[q][ib + i]; acc[0][q] += h * wa[i]; acc[1][q] += h * wb[i]; } }
    }
    const int ch = tid;
    const float delta = 3.0701134573253944f + (float)ch * ((15.350567286626972f - 3.0701134573253944f) / 511.0f);
#pragma unroll
    for (int q = 0; q < 8; ++q) {
        const int ps = p0 + q; const float dec = __expf(-((float)ps / (float)(Lf - 1)) * delta);
        const float vf = acc[0][q] * dec, vb = acc[1][q] * dec;
        if (lat) { bf16_t* RBp = (bf16_t*)(a.ws + WS_FILTL) + ((size_t)l * 512 + ch) * HY_RBROW; RBp[2048 - ps] = f2bf(vf); if (ps > 0) RBp[2048 + ps] = f2bf(vb); }
        else { T[(size_t)ch * (2 * Lf) + Lf + ps] = vf; if (ps > 0) T[(size_t)ch * (2 * Lf) + Lf - ps] = vb; else T[(size_t)ch * (2 * Lf)] = 0.f; }
    }
    __syncthreads();
}
__device__ __forceinline__ void ph_filters(const Args& a, float* sm, int fb, int nfb) {
    const int tid = threadIdx.x;
    for (int l = 0; l < 2; ++l) {
        for (int i = tid; i < 2112; i += NTHR) sm[FW_W1 + i] = a.in[15][l * 2112 + i];
        for (int i = tid; i < 4096; i += NTHR) { sm[FW_W2 + i] = a.in[17][l * 4096 + i]; sm[FW_W3 + i] = a.in[19][l * 4096 + i]; }
        if (tid < 64) { sm[FW_B1 + tid] = a.in[16][l * 64 + tid]; sm[FW_B2 + tid] = a.in[18][l * 64 + tid]; sm[FW_B3 + tid] = a.in[20][l * 64 + tid]; sm[FW_FR + tid] = a.in[22][l * 64 + tid]; }
        __syncthreads();
        for (int r = fb; r < 288; r += nfb) filters_unit(a, l, r, sm);
        __syncthreads();
    }
}
#define SUBREP(b) for (int srep_ = 0; srep_ <= (int)((PROBE_SUB >> (b)) & 1u); ++srep_)
__device__ __forceinline__ void ph_absmax(const Args& a, float* sm) {
    unsigned* ctl = (unsigned*)(a.ws + WS_CTL); const int tid = threadIdx.x, G = gridDim.x, bid = blockIdx.x, lane = tid & 63, w = tid >> 6;
#pragma unroll
    for (int j = (I8_WIN ? 0 : 2); j < (I8_GU ? 4 : 2); ++j) {
        const f32x4* p4 = (const f32x4*)(j == 0 ? a.in[8] : j == 1 ? a.in[8] + (size_t)2048 * 3648 : j == 2 ? a.in[26] : a.in[27]);
        const int n4 = (j < 2 ? 2048 * 3648 : 2048 * 5632) / 4, step = G * 512;
        float mm = 0.f;
        for (int i0 = bid * 512 + tid; i0 < n4; i0 += step * 8) {
            f32x4 v[8];
#pragma unroll
            for (int u = 0; u < 8; ++u) { const int i = i0 + u * step; v[u] = i < n4 ? __builtin_nontemporal_load(p4 + i) : (f32x4){0.f, 0.f, 0.f, 0.f}; }
#pragma unroll
            for (int u = 0; u < 8; ++u) mm = fmaxf(mm, fmaxf(fmaxf(fabsf(v[u][0]), fabsf(v[u][1])), fmaxf(fabsf(v[u][2]), fabsf(v[u][3]))));
        }
        mm = wave_max(mm);
        if (lane == 0) sm[w] = mm;
        __syncthreads();
        if (tid == 0) { float t = sm[0];
#pragma unroll
            for (int k = 1; k < 8; ++k) t = fmaxf(t, sm[k]);
            (void)__hip_atomic_fetch_max(ctl + CT_WSC + j, __float_as_uint(t), __ATOMIC_RELAXED, __HIP_MEMORY_SCOPE_AGENT); }
        __syncthreads();
    }
    if (tid == 0) (void)__hip_atomic_fetch_add(ctl + CT_AMAXDONE, 1u, __ATOMIC_RELAXED, __HIP_MEMORY_SCOPE_AGENT);
}
__device__ __forceinline__ void ph_prologue(const Args& a, float* sm) {
    const int bid = blockIdx.x, G = gridDim.x, tid = threadIdx.x;
    const int NF = G >= 128 ? 64 : 0;
    if (I8_GEMM) ph_absmax(a, sm);
    if (NF == 0) { SUBREP(4) for (int u = bid; u < 192; u += G) adaln_unit(a, u, sm); SUBREP(5) ph_filters(a, sm, bid, G); }
    else if (bid < NF) { SUBREP(5) ph_filters(a, sm, bid, NF); }
    else { SUBREP(4) for (int u = bid - NF; u < 192; u += G - NF) adaln_unit(a, u, sm); }
    { float* cosT = (float*)(a.ws + WS_ROPE); float* sinT = cosT + 2048 * 32;
      for (int i = bid * 512 + tid; i < 2048 * 32; i += G * 512) { const int t = i >> 5, f = i & 31;
          const float pos = (float)((f < 16) ? (t >> 6) : (t & 63)); const float freq = powf(10000.0f, -(float)(f & 15) / 16.0f); const float ang = pos * freq;
          cosT[i] = cosf(ang); sinT[i] = sinf(ang); } }
    for (int i = bid * 512 + tid; i < 2 * 512 * 17; i += G * 512) { const int row = i / 17, k = i - row * 17; ((bf16_t*)(a.ws + WS_FILTL))[(size_t)row * HY_RBROW + (k == 0 ? 0 : 4095 + k)] = 0; }
    { constexpr int RB16 = I8_WIN ? 128 : 256;
      for (int i = bid * 512 + tid; i < 2 * 192 * RB16; i += G * 512) { const int l = i / (192 * RB16), r = i % (192 * RB16);
        *(u32x4*)(a.ws + WS_WIN + (size_t)l * UW * D * 2 + (size_t)INW * RB16 * 16 + (size_t)r * 16) = (u32x4){0u, 0u, 0u, 0u}; } }
    if (I8_GEMM) {
        if (tid == 0) { const unsigned* dn = (const unsigned*)(a.ws + WS_CTL) + CT_AMAXDONE; unsigned sp = 0;
            while (__hip_atomic_load(dn, __ATOMIC_RELAXED, __HIP_MEMORY_SCOPE_AGENT) < (unsigned)G && ++sp < (1u << 22)) __builtin_amdgcn_s_sleep(4); }
    }
    __syncthreads();
    if ((PROBE_SUB >> 8) & 1u) ph_convert<2>(a, sm, bid, G, NCONV);
    if (!((PROBE_SUB >> 11) & 1u) || bid < 64) conv_dynamic<0>(a, sm);
    if (G != 256) ph_convert<0>(a, sm, NCONV_Q + bid, G, NCONV);
    if ((PROBE_SUB >> 6) & 1u) ph_convert<0>(a, sm, bid, G, NCONV);
    if ((PROBE_SUB >> 7) & 1u) ph_convert<1>(a, sm, bid, G, NCONV);
}

__device__ __forceinline__ f32x4 ld4bf(const bf16_t* p) { const u32x2 q = *(const u32x2*)p; return (f32x4){__uint_as_float(q.x << 16), __uint_as_float(q.x & 0xffff0000u), __uint_as_float(q.y << 16), __uint_as_float(q.y & 0xffff0000u)}; }
template <bool ROUTER, bool COPYX, int OUT8 = 0, int NSLAB = 0, bool XLB = true, bool XCB = true>
__device__ __forceinline__ void ph_normmod(const void* __restrict__ xlat, const void* __restrict__ xctx, const float* __restrict__ gain, const float* __restrict__ modl, int sh_off, int sc_off,
                                           bf16_t* __restrict__ out, int nrows, bf16_t* __restrict__ xs, const float* __restrict__ router, int* __restrict__ topi, float* __restrict__ topw,
                                           const bf16_t* __restrict__ slab = nullptr, const float* __restrict__ slab_gate = nullptr, float* __restrict__ rsc = nullptr) {
    const int lane = threadIdx.x & 63, wid = threadIdx.x >> 6;
    for (int row = blockIdx.x * 8 + wid; row < nrows; row += gridDim.x * 8) {
        const bool lat = row < NLAT; const size_t xoff = lat ? (size_t)row * D : (size_t)(row - NLAT) * D;
        const float* mv = modl + (size_t)tok_mod(row) * 12288;
        f32x4 v[8]; float ss = 0.f;
#pragma unroll
        for (int i = 0; i < 8; ++i) { const int cl = i * 256 + lane * 4;
            if (lat) { if (XLB) { const u32x2 q = *(const u32x2*)((const bf16_t*)xlat + xoff + cl); v[i] = (f32x4){__uint_as_float(q.x << 16), __uint_as_float(q.x & 0xffff0000u), __uint_as_float(q.y << 16), __uint_as_float(q.y & 0xffff0000u)}; }
                       else v[i] = *(const f32x4*)((const float*)xlat + xoff + cl); }
            else { if (XCB) { const u32x2 q = *(const u32x2*)((const bf16_t*)xctx + xoff + cl); v[i] = (f32x4){__uint_as_float(q.x << 16), __uint_as_float(q.x & 0xffff0000u), __uint_as_float(q.y << 16), __uint_as_float(q.y & 0xffff0000u)}; }
                   else v[i] = *(const f32x4*)((const float*)xctx + xoff + cl); }
            if (NSLAB > 0 && row >= NLAT) { f32x4 sa = ld4bf(slab + (size_t)(row - NLAT) * D + i * 256 + lane * 4);
#pragma unroll
                for (int sl = 1; sl < NSLAB; ++sl) sa += ld4bf(slab + ((size_t)sl * NCTX + (row - NLAT)) * D + i * 256 + lane * 4);
                v[i] += *(const f32x4*)(slab_gate + i * 256 + lane * 4) * sa; }
            ss += v[i][0] * v[i][0] + v[i][1] * v[i][1] + v[i][2] * v[i][2] + v[i][3] * v[i][3];
            if (COPYX && (NSLAB == 0 || row >= NLAT)) { u32x2 w; w.x = pg8::cvt_pk_bf16(v[i][0], v[i][1]); w.y = pg8::cvt_pk_bf16(v[i][2], v[i][3]); *(u32x2*)(xs + (size_t)row * D + i * 256 + lane * 4) = w; } }
        ss = wave_sum(ss);
        const float rstd = rsqrtf(ss * (1.0f / D) + EPS);
        float lg[8];
#pragma unroll
        for (int e = 0; e < 8; ++e) lg[e] = 0.f;
        float amax = 0.f;
#pragma unroll
        for (int i = 0; i < 8; ++i) {
            const int col = i * 256 + lane * 4;
            const f32x4 g = *(const f32x4*)(gain + col), sc = *(const f32x4*)(mv + sc_off + col), sh = *(const f32x4*)(mv + sh_off + col);
            f32x4 o;
#pragma unroll
            for (int j = 0; j < 4; ++j) o[j] = (v[i][j] * rstd * g[j]) * (1.0f + sc[j]) + sh[j];
            if (OUT8 == 2) { v[i] = o; amax = fmaxf(amax, fmaxf(fmaxf(fabsf(o[0]), fabsf(o[1])), fmaxf(fabsf(o[2]), fabsf(o[3])))); }
            else if (OUT8 == 1) *(unsigned*)((unsigned char*)out + (size_t)row * D + col) = pg8::pack4_fp8(o[0] * ASCALE, o[1] * ASCALE, o[2] * ASCALE, o[3] * ASCALE);
            else { u32x2 w; w.x = (unsigned)f2bf(o[0]) | ((unsigned)f2bf(o[1]) << 16); w.y = (unsigned)f2bf(o[2]) | ((unsigned)f2bf(o[3]) << 16);
                *(u32x2*)(out + (size_t)row * D + col) = w; }
            if (ROUTER) {
#pragma unroll
                for (int j = 0; j < 4; ++j) { const f32x4 r0 = *(const f32x4*)(router + (size_t)(col + j) * 8), r1 = *(const f32x4*)(router + (size_t)(col + j) * 8 + 4);
                    lg[0] += o[j] * r0[0]; lg[1] += o[j] * r0[1]; lg[2] += o[j] * r0[2]; lg[3] += o[j] * r0[3];
                    lg[4] += o[j] * r1[0]; lg[5] += o[j] * r1[1]; lg[6] += o[j] * r1[2]; lg[7] += o[j] * r1[3]; }
                asm volatile("" ::: "memory");
            }
        }
        if (OUT8 == 2) {
            amax = wave_max(amax); const float qs = amax > 0.f ? 127.0f / amax : 0.f;
#pragma unroll
            for (int i = 0; i < 8; ++i) *(unsigned*)((unsigned char*)out + (size_t)row * D + i * 256 + lane * 4) = pack4_i8(v[i][0] * qs, v[i][1] * qs, v[i][2] * qs, v[i][3] * qs);
            if (lane == 0) rsc[row] = amax * (1.0f / 127.0f);
        }
        if (ROUTER) {
#pragma unroll
            for (int e = 0; e < 8; ++e) lg[e] = wave_sum(lg[e]);
            if (lane == 0) {
                int i0 = 0; float v0 = lg[0];
#pragma unroll
                for (int e = 1; e < 8; ++e) if (lg[e] > v0) { v0 = lg[e]; i0 = e; }
                int i1 = -1; float v1 = -3.0e38f;
#pragma unroll
                for (int e = 0; e < 8; ++e) if (e != i0 && lg[e] > v1) { v1 = lg[e]; i1 = e; }
                const float e1 = expf(v1 - v0), w0 = 1.0f / (1.0f + e1), w1 = e1 / (1.0f + e1);
                topi[row * 2] = i0; topi[row * 2 + 1] = i1; topw[row * 2] = w0; topw[row * 2 + 1] = w1;
            }
        }
    }
}

__device__ __forceinline__ float bflo(unsigned w) { return __uint_as_float(w << 16); }
__device__ __forceinline__ float bfhi(unsigned w) { return __uint_as_float(w & 0xffff0000u); }
__device__ __forceinline__ unsigned pkbf(float lo, float hi) { return (unsigned)f2bf(lo) | ((unsigned)f2bf(hi) << 16); }
__device__ __forceinline__ u32x4 rope8(const u32x4 mine, const u32x4 other, bool is_x2, const f32x4 c0, const f32x4 c1, const f32x4 s0, const f32x4 s1) {
    const unsigned mw[4] = {mine.x, mine.y, mine.z, mine.w}, ow[4] = {other.x, other.y, other.z, other.w};
    const float cs[8] = {c0[0], c0[1], c0[2], c0[3], c1[0], c1[1], c1[2], c1[3]}, sn[8] = {s0[0], s0[1], s0[2], s0[3], s1[0], s1[1], s1[2], s1[3]};
    unsigned o[4];
#pragma unroll
    for (int d = 0; d < 4; ++d) {
        const float m0 = bflo(mw[d]), m1 = bfhi(mw[d]), p0 = bflo(ow[d]), p1 = bfhi(ow[d]);
        const float r0 = is_x2 ? (p0 * sn[2 * d] + m0 * cs[2 * d]) : (m0 * cs[2 * d] - p0 * sn[2 * d]);
        const float r1 = is_x2 ? (p1 * sn[2 * d + 1] + m1 * cs[2 * d + 1]) : (m1 * cs[2 * d + 1] - p1 * sn[2 * d + 1]);
        o[d] = pkbf(r0, r1);
    }
    return (u32x4){o[0], o[1], o[2], o[3]};
}
__device__ __forceinline__ u32x4 shfl4(const u32x4 v, int m) { return (u32x4){(unsigned)__shfl_xor((int)v.x, m), (unsigned)__shfl_xor((int)v.y, m), (unsigned)__shfl_xor((int)v.z, m), (unsigned)__shfl_xor((int)v.w, m)}; }
__device__ __forceinline__ void ph_mid(const Args& a, int l) {
    const bf16_t* __restrict__ U = (const bf16_t*)(a.ws + WS_U);
    const float* g_q = a.in[9] + l * 768; const float* g_kv = a.in[11] + l * 512; const float* conv_w = a.in[13] + (size_t)l * 3 * 1536; const float* conv_b = a.in[14] + l * 1536;
    const float* cosT = (const float*)(a.ws + WS_ROPE); const float* sinT = cosT + 2048 * 32;
    bf16_t* cqn = (bf16_t*)(a.ws + WS_CQN); bf16_t* ckvn = (bf16_t*)(a.ws + WS_CKVN); bf16_t* kpe = (bf16_t*)(a.ws + WS_KPE); bf16_t* x0o = (bf16_t*)(a.ws + WS_X0);
    bf16_t* wtl = (bf16_t*)(a.ws + WS_WTL); bf16_t* wtc = (bf16_t*)(a.ws + WS_WTC); bf16_t* sq = (bf16_t*)(a.ws + WS_SQ); bf16_t* sk = (bf16_t*)(a.ws + WS_SK); bf16_t* sv = (bf16_t*)(a.ws + WS_SV);
    int tid_ = threadIdx.x; asm volatile("" : "+v"(tid_));
    const int tid = tid_, lane = tid & 63, wid = tid >> 6;
    for (int unit = blockIdx.x; unit < NTOK / 16; unit += gridDim.x) {
        const int tok0 = unit * 16;
        for (int tt = 0; tt < 2; ++tt) {
            const int tok = tok0 + wid * 2 + tt; const bool lat = tok < NLAT; const int t = lat ? (tok & 2047) : ((tok - NLAT) & 255);
            const bf16_t* u = U + (size_t)tok * UW;
            const u32x2 q0 = *(const u32x2*)(u + O_CQ + lane * 12), q1 = *(const u32x2*)(u + O_CQ + lane * 12 + 4), q2 = *(const u32x2*)(u + O_CQ + lane * 12 + 8);
            const u32x4 kvv = *(const u32x4*)(u + O_CKV + lane * 8);
            const u32x4 sqv = *(const u32x4*)(u + O_SQ + lane * 8);
            const u32x4 skv = *(const u32x4*)(u + O_SK + (lane & 15) * 8);
            const u32x4 kpv = *(const u32x4*)(u + O_KPE + (lane & 7) * 8);
            const int i0 = (lane & 3) * 8;
            f32x4 c0 = (f32x4){1.f, 1.f, 1.f, 1.f}, c1 = c0, s0 = (f32x4){0.f, 0.f, 0.f, 0.f}, s1 = s0;
            if (lat) { c0 = *(const f32x4*)(cosT + t * 32 + i0); c1 = *(const f32x4*)(cosT + t * 32 + i0 + 4); s0 = *(const f32x4*)(sinT + t * 32 + i0); s1 = *(const f32x4*)(sinT + t * 32 + i0 + 4); }
            {
                const unsigned w6[6] = {q0.x, q0.y, q1.x, q1.y, q2.x, q2.y}; float x[12]; float ss = 0.f;
#pragma unroll
                for (int d = 0; d < 6; ++d) { x[2 * d] = bflo(w6[d]); x[2 * d + 1] = bfhi(w6[d]); ss += x[2 * d] * x[2 * d] + x[2 * d + 1] * x[2 * d + 1]; }
                ss = wave_sum(ss); const float rs = rsqrtf(ss * (1.0f / 768.0f) + EPS);
                const f32x4 g0 = *(const f32x4*)(g_q + lane * 12), g1 = *(const f32x4*)(g_q + lane * 12 + 4), g2 = *(const f32x4*)(g_q + lane * 12 + 8);
                u32x2 o0, o1, o2;
                o0.x = pkbf(x[0] * rs * g0[0], x[1] * rs * g0[1]); o0.y = pkbf(x[2] * rs * g0[2], x[3] * rs * g0[3]);
                o1.x = pkbf(x[4] * rs * g1[0], x[5] * rs * g1[1]); o1.y = pkbf(x[6] * rs * g1[2], x[7] * rs * g1[3]);
                o2.x = pkbf(x[8] * rs * g2[0], x[9] * rs * g2[1]); o2.y = pkbf(x[10] * rs * g2[2], x[11] * rs * g2[3]);
                bf16_t* dst = cqn + (size_t)tok * 768 + lane * 12; *(u32x2*)dst = o0; *(u32x2*)(dst + 4) = o1; *(u32x2*)(dst + 8) = o2;
            }
            {
                const unsigned w4[4] = {kvv.x, kvv.y, kvv.z, kvv.w}; float x[8]; float ss = 0.f;
#pragma unroll
                for (int d = 0; d < 4; ++d) { x[2 * d] = bflo(w4[d]); x[2 * d + 1] = bfhi(w4[d]); ss += x[2 * d] * x[2 * d] + x[2 * d + 1] * x[2 * d + 1]; }
                ss = wave_sum(ss); const float rs = rsqrtf(ss * (1.0f / 512.0f) + EPS);
                const f32x4 g0 = *(const f32x4*)(g_kv + lane * 8), g1 = *(const f32x4*)(g_kv + lane * 8 + 4);
                u32x4 o; o.x = pkbf(x[0] * rs * g0[0], x[1] * rs * g0[1]); o.y = pkbf(x[2] * rs * g0[2], x[3] * rs * g0[3]); o.z = pkbf(x[4] * rs * g1[0], x[5] * rs * g1[1]); o.w = pkbf(x[6] * rs * g1[2], x[7] * rs * g1[3]);
                *(u32x4*)(ckvn + (size_t)tok * 512 + lane * 8) = o;
            }
            const bool is_x2 = (lane & 4) != 0;
            {
                const u32x4 r = rope8(sqv, shfl4(sqv, 4), is_x2, c0, c1, s0, s1);
                *(u32x4*)(sq + (size_t)tok * 512 + lane * 8) = r;
            }
            {
                const u32x4 r = rope8(skv, shfl4(skv, 4), is_x2, c0, c1, s0, s1);
                if (lane < 16) *(u32x4*)(sk + (size_t)tok * 128 + lane * 8) = r;
            }
            {
                const u32x4 ot = shfl4(kpv, 4);
                if (lane < 4) {
                    const unsigned mw[4] = {kpv.x, kpv.y, kpv.z, kpv.w}, ow[4] = {ot.x, ot.y, ot.z, ot.w};
                    const float cs[8] = {c0[0], c0[1], c0[2], c0[3], c1[0], c1[1], c1[2], c1[3]}, sn[8] = {s0[0], s0[1], s0[2], s0[3], s1[0], s1[1], s1[2], s1[3]};
                    unsigned o[8];
#pragma unroll
                    for (int d = 0; d < 4; ++d) { const float a0 = bflo(mw[d]), a1 = bfhi(mw[d]), b0 = bflo(ow[d]), b1 = bfhi(ow[d]);
                        o[2 * d] = pkbf(a0 * cs[2 * d] - b0 * sn[2 * d], a0 * sn[2 * d] + b0 * cs[2 * d]);
                        o[2 * d + 1] = pkbf(a1 * cs[2 * d + 1] - b1 * sn[2 * d + 1], a1 * sn[2 * d + 1] + b1 * cs[2 * d + 1]); }
                    bf16_t* dst = kpe + (size_t)tok * 64 + lane * 16;
                    *(u32x4*)dst = (u32x4){o[0], o[1], o[2], o[3]}; *(u32x4*)(dst + 8) = (u32x4){o[4], o[5], o[6], o[7]};
                }
            }
        }
        {
            const bool lat = tok0 < NLAT; const int Ls = lat ? L : C;
            const int b = lat ? (tok0 >> 11) : ((tok0 - NLAT) >> 8), t0 = (lat ? (tok0 & 2047) : ((tok0 - NLAT) & 255));
            const int cp = tid & 255, hf = tid >> 8, ch = cp * 2, ts = t0 + hf * 8, tokb = tok0 + hf * 8;
            float cw[3][3][2], cb[3][2];
#pragma unroll
            for (int g = 0; g < 3; ++g) { cb[g][0] = conv_b[g * 512 + ch]; cb[g][1] = conv_b[g * 512 + ch + 1];
#pragma unroll
                for (int j = 0; j < 3; ++j) { cw[g][j][0] = conv_w[j * 1536 + g * 512 + ch]; cw[g][j][1] = conv_w[j * 1536 + g * 512 + ch + 1]; } }
            unsigned rows[3][10];
#pragma unroll
            for (int r = 0; r < 10; ++r) { const int tr = ts - 1 + r; const bool ok = tr >= 0 && tr < Ls;
#pragma unroll
                for (int g = 0; g < 3; ++g) rows[g][r] = ok ? *(const unsigned*)(U + (size_t)(tokb - 1 + r) * UW + O_HY + g * 512 + ch) : 0u; }
            unsigned wp0[4], wp1[4];
#pragma unroll
            for (int i = 0; i < 8; ++i) {
                float y[3][2];
#pragma unroll
                for (int g = 0; g < 3; ++g) {
                    y[g][0] = cb[g][0] + cw[g][0][0] * bflo(rows[g][i]) + cw[g][1][0] * bflo(rows[g][i + 1]) + cw[g][2][0] * bflo(rows[g][i + 2]);
                    y[g][1] = cb[g][1] + cw[g][0][1] * bfhi(rows[g][i]) + cw[g][1][1] * bfhi(rows[g][i + 1]) + cw[g][2][1] * bfhi(rows[g][i + 2]); }
                *(unsigned*)(x0o + (size_t)(tokb + i) * 512 + ch) = pkbf(y[0][0], y[0][1]);
                const unsigned w0 = f2bf(y[2][0] * y[1][0]), w1 = f2bf(y[2][1] * y[1][1]);
                if (i & 1) { wp0[i >> 1] |= w0 << 16; wp1[i >> 1] |= w1 << 16; } else { wp0[i >> 1] = w0; wp1[i >> 1] = w1; }
            }
            bf16_t* wt = lat ? wtl + ((size_t)b * 512 + ch) * L + ts : wtc + ((size_t)b * 512 + ch) * C + ts;
            *(u32x4*)wt = (u32x4){wp0[0], wp0[1], wp0[2], wp0[3]};
            *(u32x4*)(wt + (lat ? L : C)) = (u32x4){wp1[0], wp1[1], wp1[2], wp1[3]};
        }
        if (tid < 128) {
            unsigned pk[8];
#pragma unroll
            for (int i = 0; i < 16; ++i) { const unsigned v = U[(size_t)(tok0 + i) * UW + O_SV + tid]; if (i & 1) pk[i >> 1] |= v << 16; else pk[i >> 1] = v; }
            bf16_t* dst = sv + (size_t)tid * NTOK + tok0;
            u32x4 w0, w1; w0.x = pk[0]; w0.y = pk[1]; w0.z = pk[2]; w0.w = pk[3]; w1.x = pk[4]; w1.y = pk[5]; w1.z = pk[6]; w1.w = pk[7];
            *(u32x4*)dst = w0; *(u32x4*)(dst + 8) = w1;
        }
    }
}

__device__ __forceinline__ void ph_mla_naive(const Args& a, int nq, float* sm) {
    const bf16_t* __restrict__ Q = (const bf16_t*)(a.ws + WS_Q); const bf16_t* __restrict__ KV = (const bf16_t*)(a.ws + WS_KV); const bf16_t* __restrict__ KPE = (const bf16_t*)(a.ws + WS_KPE);
    bf16_t* mix = (bf16_t*)(a.ws + WS_MIX);
    const int lane = threadIdx.x & 63, w = threadIdx.x >> 6;
    float* qf = sm + w * 192; float* sc = sm + 8 * 192 + w * 2304;
    for (int unit = blockIdx.x; unit < nq; unit += gridDim.x) {
        const int h = unit & 7, qt = (unit >> 3) * 8 + w; const bool lat = qt < NLAT;
        const int b = lat ? (qt >> 11) : ((qt - NLAT) >> 8);
        const int nk = lat ? (L + C) : C;
        for (int i = lane; i < 192; i += 64) qf[i] = bf2f(Q[(size_t)qt * QW + h * 192 + i]);
        __syncthreads();
        const float scale = 0.07216878364870322f;
        float mx = -3.0e38f;
        for (int kc = 0; kc < nk; kc += 64) {
            const int kk = kc + lane;
            const int kt = lat ? (kk < L ? b * L + kk : NLAT + b * C + (kk - L)) : (NLAT + b * C + kk);
            float s = 0.f;
            const u32x4* kp = (const u32x4*)(KV + (size_t)kt * KVW + h * 256);
            for (int i = 0; i < 16; ++i) { const u32x4 v = kp[i]; const float* q8 = qf + i * 8;
                s += q8[0] * __uint_as_float(v.x << 16) + q8[1] * __uint_as_float(v.x & 0xffff0000u) + q8[2] * __uint_as_float(v.y << 16) + q8[3] * __uint_as_float(v.y & 0xffff0000u)
                   + q8[4] * __uint_as_float(v.z << 16) + q8[5] * __uint_as_float(v.z & 0xffff0000u) + q8[6] * __uint_as_float(v.w << 16) + q8[7] * __uint_as_float(v.w & 0xffff0000u); }
            const u32x4* pp = (const u32x4*)(KPE + (size_t)kt * 64);
            for (int i = 0; i < 8; ++i) { const u32x4 v = pp[i]; const float* q8 = qf + 128 + i * 8;
                s += q8[0] * __uint_as_float(v.x << 16) + q8[1] * __uint_as_float(v.x & 0xffff0000u) + q8[2] * __uint_as_float(v.y << 16) + q8[3] * __uint_as_float(v.y & 0xffff0000u)
                   + q8[4] * __uint_as_float(v.z << 16) + q8[5] * __uint_as_float(v.z & 0xffff0000u) + q8[6] * __uint_as_float(v.w << 16) + q8[7] * __uint_as_float(v.w & 0xffff0000u); }
            s *= scale; sc[kk] = s; mx = fmaxf(mx, s);
        }
        mx = wave_max(mx);
        float sum = 0.f;
        for (int kc = 0; kc < nk; kc += 64) { const float p = expf(sc[kc + lane] - mx); sc[kc + lane] = p; sum += p; }
        sum = wave_sum(sum);
        __syncthreads();
        float o0 = 0.f, o1 = 0.f;
        for (int kk = 0; kk < nk; ++kk) {
            const int kt = lat ? (kk < L ? b * L + kk : NLAT + b * C + (kk - L)) : (NLAT + b * C + kk);
            const unsigned v = *(const unsigned*)(KV + (size_t)kt * KVW + h * 256 + 128 + lane * 2);
            const float p = sc[kk];
            o0 += p * __uint_as_float(v << 16); o1 += p * __uint_as_float(v & 0xffff0000u);
        }
        const float inv = 1.0f / sum;
        *(unsigned*)(mix + (size_t)qt * D + h * 128 + lane * 2) = (unsigned)f2bf(o0 * inv) | ((unsigned)f2bf(o1 * inv) << 16);
        __syncthreads();
    }
}
__device__ __forceinline__ void ph_swa_naive(const Args& a, int l, int nq, float* sm) {
    const bf16_t* __restrict__ SQ = (const bf16_t*)(a.ws + WS_SQ); const bf16_t* __restrict__ SK = (const bf16_t*)(a.ws + WS_SK); const bf16_t* __restrict__ SV = (const bf16_t*)(a.ws + WS_SV);
    const float* sink = a.in[24] + l * 8; bf16_t* mix = (bf16_t*)(a.ws + WS_MIX);
    const int lane = threadIdx.x & 63, w = threadIdx.x >> 6;
    float* qf = sm + w * 64; float* sc = sm + 8 * 64 + w * 576; int* kts = (int*)(sm + 8 * 64 + 8 * 576) + w * 576;
    for (int unit = blockIdx.x; unit < nq; unit += gridDim.x) {
        const int hq = unit & 7, hk = hq >> 2, qt = (unit >> 3) * 8 + w; const bool lat = qt < NLAT;
        const int b = lat ? (qt >> 11) : ((qt - NLAT) >> 8), t = lat ? (qt & 2047) : 0;
        int lo = 0, nloc = 0;
        if (lat) { lo = t - 128 < 0 ? 0 : t - 128; const int hi = t + 128 > L - 1 ? L - 1 : t + 128; nloc = hi - lo + 1; }
        const int nk = nloc + C;
        qf[lane] = bf2f(SQ[(size_t)qt * 512 + hq * 64 + lane]);
        __syncthreads();
        const float skv = sink[hq];
        float mx = skv;
        for (int kc = 0; kc < nk; kc += 64) {
            const int kk = kc + lane;
            if (kk < nk) {
                const int kt = kk < nloc ? (b * L + lo + kk) : (NLAT + b * C + (kk - nloc));
                const u32x4* kp = (const u32x4*)(SK + (size_t)kt * 128 + hk * 64);
                float s = 0.f;
                for (int i = 0; i < 8; ++i) { const u32x4 v = kp[i]; const float* q8 = qf + i * 8;
                    s += q8[0] * __uint_as_float(v.x << 16) + q8[1] * __uint_as_float(v.x & 0xffff0000u) + q8[2] * __uint_as_float(v.y << 16) + q8[3] * __uint_as_float(v.y & 0xffff0000u)
                       + q8[4] * __uint_as_float(v.z << 16) + q8[5] * __uint_as_float(v.z & 0xffff0000u) + q8[6] * __uint_as_float(v.w << 16) + q8[7] * __uint_as_float(v.w & 0xffff0000u); }
                s *= 0.125f; sc[kk] = s; kts[kk] = kt; mx = fmaxf(mx, s);
            }
        }
        mx = wave_max(mx);
        float sum = 0.f;
        for (int kc = 0; kc < nk; kc += 64) { const int kk = kc + lane; if (kk < nk) { const float p = expf(sc[kk] - mx); sc[kk] = p; sum += p; } }
        sum = wave_sum(sum) + expf(skv - mx);
        __syncthreads();
        float o = 0.f;
        for (int kk = 0; kk < nk; ++kk) o += sc[kk] * bf2f(SV[(size_t)kts[kk] * 128 + hk * 64 + lane]);
        mix[(size_t)qt * D + 1536 + hq * 64 + lane] = f2bf(o / sum);
        __syncthreads();
    }
}
template <int LS>
__device__ __forceinline__ void ph_hyena_naive(const Args& a, int l, float* sm) {
    const float* filt = LS == L ? (const float*)(a.ws + WS_FILTL) + (size_t)l * 512 * 4096 : (const float*)(a.ws + WS_FILTC) + (size_t)l * 512 * 512;
    const bf16_t* wt = (const bf16_t*)(a.ws + (LS == L ? WS_WTL : WS_WTC)); const bf16_t* x0 = (const bf16_t*)(a.ws + WS_X0); const float* skip = a.in[23] + l * 512;
    bf16_t* mix = (bf16_t*)(a.ws + WS_MIX); const int tok_base = LS == L ? 0 : NLAT;
    float* T = sm; float* ws = sm + 2 * LS; const int tid = threadIdx.x;
    for (int unit = blockIdx.x; unit < 512 * NB; unit += gridDim.x) {
        const int ch = unit >> 2, b = unit & 3;
        for (int i = tid; i < 2 * LS; i += NTHR) T[i] = filt[(size_t)ch * 2 * LS + i];
        for (int i = tid; i < LS; i += NTHR) ws[i] = bf2f(wt[((size_t)b * 512 + ch) * LS + i]);
        __syncthreads();
        const float sk = skip[ch];
        for (int t = tid; t < LS; t += NTHR) {
            float y = 0.f;
            for (int s = 0; s < LS; ++s) y += T[t - s + LS] * ws[s];
            ((bf16_t*)(a.ws + WS_YT))[(LS == L ? (size_t)0 : (size_t)NB * 512 * L) + ((size_t)b * 512 + ch) * LS + t] = f2bf(y);
        }
        __syncthreads();
    }
}
__device__ __forceinline__ void ph_route_gather(const Args& a, int* sm) {
    const int* __restrict__ topi = (const int*)(a.ws + WS_TOPI); int* __restrict__ pos = (int*)(a.ws + WS_POS); int* ctl = (int*)(a.ws + WS_CTL);
    const unsigned char* __restrict__ hb = (const unsigned char*)(a.ws + WS_HA); unsigned char* __restrict__ hbs = (unsigned char*)(a.ws + WS_HBS);
    int (*cnt)[512] = (int (*)[512])sm; int* tot = sm + 8 * 512; int* ppos = sm + 8 * 512 + 16;
    const int tid = threadIdx.x, lane = tid & 63, w = tid >> 6;
    int c[8];
#pragma unroll
    for (int e = 0; e < 8; ++e) c[e] = 0;
    for (int i = 0; i < 32; i += 4) { const u32x4 e4 = *(const u32x4*)(topi + tid * 32 + i);
#pragma unroll
        for (int q = 0; q < 8; ++q) c[q] += (e4.x == (unsigned)q) + (e4.y == (unsigned)q) + (e4.z == (unsigned)q) + (e4.w == (unsigned)q); }
#pragma unroll
    for (int e = 0; e < 8; ++e) cnt[e][tid] = c[e];
    __syncthreads();
    {
        int v[8]; int s8 = 0;
#pragma unroll
        for (int k = 0; k < 8; ++k) { v[k] = cnt[w][lane * 8 + k]; s8 += v[k]; }
        int incl = s8;
#pragma unroll
        for (int off = 1; off < 64; off <<= 1) { const int t = __shfl_up(incl, off); if (lane >= off) incl += t; }
        int run = incl - s8;
#pragma unroll
        for (int k = 0; k < 8; ++k) { cnt[w][lane * 8 + k] = run; run += v[k]; }
        if (lane == 63) tot[w] = incl;
    }
    __syncthreads();
    int eoff[8]; int o = 0;
#pragma unroll
    for (int e = 0; e < 8; ++e) { eoff[e] = o; o += (tot[e] + 255) & ~255; }
    if (blockIdx.x == 0 && tid == 0) {
#pragma unroll
        for (int e = 0; e < 8; ++e) { ctl[CT_EOFF + e] = eoff[e]; ctl[CT_EPAD + e] = (tot[e] + 255) & ~255; }
        ctl[CT_NTILE] = o >> 8; const int nwg = (o >> 8) * (D / 256); ctl[CT_MOES] = pg8::split_S(nwg, DFE / 128, 256); ctl[CT_TROW] = (nwg / 256) * 256 / (D / 256) * 256;
    }
    for (int tg = blockIdx.x; tg < NLAT / 32; tg += gridDim.x) {
        if (tid < 64) {
            const int idx = 64 * tg + tid, owner = idx >> 5, e = topi[idx]; int p = 0;
#pragma unroll
            for (int q = 0; q < 8; ++q) { const unsigned long long mk = __ballot(e == q);
                if (e == q) { const unsigned hm = (unsigned)(mk >> (32 * (tid >> 5))); p = eoff[q] + cnt[q][owner] + __popc(hm & ((1u << (tid & 31)) - 1u)); } }
            pos[idx] = p; ppos[tid] = p;
        }
        __syncthreads();
#pragma unroll
        for (int k = 0; k < 4; ++k) { const int tl = 4 * w + k; const int tok = 32 * tg + tl;
            const u32x4 v0 = *(const u32x4*)(hb + (size_t)tok * D + lane * 32), v1 = *(const u32x4*)(hb + (size_t)tok * D + lane * 32 + 16);
            const int p0 = ppos[2 * tl], p1 = ppos[2 * tl + 1];
            *(u32x4*)(hbs + (size_t)p0 * D + lane * 32) = v0; *(u32x4*)(hbs + (size_t)p0 * D + lane * 32 + 16) = v1;
            *(u32x4*)(hbs + (size_t)p1 * D + lane * 32) = v0; *(u32x4*)(hbs + (size_t)p1 * D + lane * 32 + 16) = v1; }
        __syncthreads();
    }
}
__device__ __forceinline__ void ph_final(const Args& a) {
    const bf16_t* xs = (const bf16_t*)(a.ws + WS_XS); const bf16_t* ys = (const bf16_t*)(a.ws + WS_YS); const int* pos = (const int*)(a.ws + WS_POS); const float* topw = (const float*)(a.ws + WS_TOPW);
    const float* modl = (const float*)(a.ws + WS_MOD) + (size_t)5 * 12288; const float* gfin = a.in[33]; float* out = a.out;
    const int lane = threadIdx.x & 63, wid = threadIdx.x >> 6;
    const int* ctl = (const int*)(a.ws + WS_CTL); const int nsl = ctl[CT_MOES], trow0 = ctl[CT_TROW], trows = ctl[CT_NTILE] * 256 - trow0; const bf16_t* slab = (const bf16_t*)(a.ws + WS_SLAB);
    for (int row = blockIdx.x * 8 + wid; row < NLAT; row += gridDim.x * 8) {
        const float* g2 = modl + (size_t)tok_mod(row) * 12288 + 10240;
        const int p0 = pos[row * 2], p1 = pos[row * 2 + 1]; const float w0 = topw[row * 2], w1 = topw[row * 2 + 1];
        const bool t0 = nsl > 1 && p0 >= trow0, t1 = nsl > 1 && p1 >= trow0;
        f32x4 v[8]; float ss = 0.f;
#pragma unroll
        for (int i = 0; i < 8; ++i) { const int col = i * 256 + lane * 4;
            const u32x2 xq = *(const u32x2*)(xs + (size_t)row * D + col); const f32x4 x = (f32x4){__uint_as_float(xq.x << 16), __uint_as_float(xq.x & 0xffff0000u), __uint_as_float(xq.y << 16), __uint_as_float(xq.y & 0xffff0000u)}, g = *(const f32x4*)(g2 + col); f32x4 ya, yb;
            if (t0) { ya = ld4bf(slab + (size_t)(p0 - trow0) * D + col); for (int sl = 1; sl < nsl; ++sl) ya += ld4bf(slab + ((size_t)sl * trows + (p0 - trow0)) * D + col); }
            else { const u32x2 q = *(const u32x2*)(ys + (size_t)p0 * D + col); ya = (f32x4){__uint_as_float(q.x << 16), __uint_as_float(q.x & 0xffff0000u), __uint_as_float(q.y << 16), __uint_as_float(q.y & 0xffff0000u)}; }
            if (t1) { yb = ld4bf(slab + (size_t)(p1 - trow0) * D + col); for (int sl = 1; sl < nsl; ++sl) yb += ld4bf(slab + ((size_t)sl * trows + (p1 - trow0)) * D + col); }
            else { const u32x2 q = *(const u32x2*)(ys + (size_t)p1 * D + col); yb = (f32x4){__uint_as_float(q.x << 16), __uint_as_float(q.x & 0xffff0000u), __uint_as_float(q.y << 16), __uint_as_float(q.y & 0xffff0000u)}; }
#pragma unroll
            for (int j = 0; j < 4; ++j) { v[i][j] = x[j] + g[j] * (w0 * ya[j] + w1 * yb[j]); ss += v[i][j] * v[i][j]; } }
        ss = wave_sum(ss); const float rstd = rsqrtf(ss * (1.0f / D) + EPS);
#pragma unroll
        for (int i = 0; i < 8; ++i) { const int col = i * 256 + lane * 4; const f32x4 g = *(const f32x4*)(gfin + col); f32x4 o;
#pragma unroll
            for (int j = 0; j < 4; ++j) o[j] = v[i][j] * rstd * g[j];
            *(f32x4*)(out + (size_t)row * D + col) = o; }
    }
}

typedef float f32x2_t __attribute__((ext_vector_type(2))); typedef __bf16 bf16x2_t __attribute__((ext_vector_type(2)));
__device__ __forceinline__ unsigned cvtpk(float lo, float hi) { f32x2_t v = {lo, hi}; bf16x2_t b = __builtin_convertvector(v, bf16x2_t); return __builtin_bit_cast(unsigned, b); }
#define MFMA32(a, b, c) __builtin_amdgcn_mfma_f32_32x32x16_bf16((a), (b), (c), 0, 0, 0)
constexpr int MLA_KP = 400, MLA_VP = 144, MLA_KB = 64 * MLA_KP, MLA_VB = 128 * MLA_VP, MLA_STAGE = MLA_KB + MLA_VB;
static_assert(2 * MLA_STAGE <= RING_BYTES, "MLA LDS");

__device__ __forceinline__ void ph_mla(const Args& a, bool with_ctx, unsigned char* lds) {
    const bf16_t* __restrict__ Q = (const bf16_t*)(a.ws + WS_Q); const bf16_t* __restrict__ KN = (const bf16_t*)(a.ws + WS_KN); const bf16_t* __restrict__ KPE = (const bf16_t*)(a.ws + WS_KPE);
    const bf16_t* __restrict__ VT = (const bf16_t*)(a.ws + WS_VT); bf16_t* __restrict__ mix = (bf16_t*)(a.ws + WS_MIX);
    int tid_ = threadIdx.x; asm volatile("" : "+v"(tid_));
    const int tid = tid_, lane = tid & 63, w = tid >> 6, qi = lane & 31, hh = lane >> 5;
    const int nunits = with_ctx ? 288 : 256;
    const float c = 0.07216878364870322f * 1.4426950408889634f;
    for (int unit = blockIdx.x; unit < nunits; unit += gridDim.x) {
        int h, b, q0tok, nt; bool ctxq;
        if (unit < 256) { h = unit & 7; b = unit >> 6; q0tok = b * L + ((unit >> 3) & 7) * 256; nt = 36; ctxq = false; }
        else { const int u2 = unit - 256; h = u2 & 7; b = u2 >> 3; q0tok = NLAT + b * C; nt = 4; ctxq = true; }
#define MLA_KTOK(t) (ctxq ? (NLAT + b * C + (t) * 64) : ((t) < 32 ? (b * L + (t) * 64) : (NLAT + b * C + ((t) - 32) * 64)))
        u32x4 r0, r1, r2, r3, r4;
#define MLA_ISSUE_K(t) do { const int kt0_ = MLA_KTOK(t); \
            r0 = *(const u32x4*)(KN + (size_t)(kt0_ + (tid >> 4)) * 1024 + h * 128 + (tid & 15) * 8); \
            r1 = *(const u32x4*)(KN + (size_t)(kt0_ + 32 + (tid >> 4)) * 1024 + h * 128 + (tid & 15) * 8); \
            r2 = *(const u32x4*)(KPE + (size_t)(kt0_ + (tid >> 3)) * 64 + (tid & 7) * 8); } while (0)
#define MLA_ISSUE_V(t) do { const int kt0_ = MLA_KTOK(t); \
            r3 = *(const u32x4*)(VT + (size_t)(h * 128 + (tid >> 3)) * NTOK + kt0_ + (tid & 7) * 8); \
            r4 = *(const u32x4*)(VT + (size_t)(h * 128 + 64 + (tid >> 3)) * NTOK + kt0_ + (tid & 7) * 8); } while (0)
#define MLA_ISSUE(t) do { MLA_ISSUE_K(t); MLA_ISSUE_V(t); } while (0)
#define MLA_COMMIT(buf) do { unsigned char* kb_ = lds + (buf) * MLA_STAGE; unsigned char* vb_ = kb_ + MLA_KB; \
            *(u32x4*)(kb_ + (tid >> 4) * MLA_KP + (tid & 15) * 16) = r0; \
            *(u32x4*)(kb_ + (32 + (tid >> 4)) * MLA_KP + (tid & 15) * 16) = r1; \
            *(u32x4*)(kb_ + (tid >> 3) * MLA_KP + 256 + (tid & 7) * 16) = r2; \
            const int g_ = (tid & 7) >> 1, e_ = tid & 1; \
            { u32x2 lo_, hi_; lo_.x = r3.x; lo_.y = r3.y; hi_.x = r3.z; hi_.y = r3.w; \
              *(u32x2*)(vb_ + (tid >> 3) * MLA_VP + g_ * 32 + e_ * 8) = lo_; *(u32x2*)(vb_ + (tid >> 3) * MLA_VP + g_ * 32 + 16 + e_ * 8) = hi_; } \
            { u32x2 lo_, hi_; lo_.x = r4.x; lo_.y = r4.y; hi_.x = r4.z; hi_.y = r4.w; \
              *(u32x2*)(vb_ + (64 + (tid >> 3)) * MLA_VP + g_ * 32 + e_ * 8) = lo_; *(u32x2*)(vb_ + (64 + (tid >> 3)) * MLA_VP + g_ * 32 + 16 + e_ * 8) = hi_; } } while (0)
        const int qtok = q0tok + w * 32 + qi;
        bf16x8 qf[12];
#pragma unroll
        for (int s = 0; s < 12; ++s) qf[s] = *(const bf16x8*)(Q + (size_t)qtok * QW + h * 192 + s * 16 + hh * 8);
        f32x16 o[4];
#pragma unroll
        for (int d = 0; d < 4; ++d)
#pragma unroll
            for (int r = 0; r < 16; ++r) o[d][r] = 0.f;
        float m = -1.0e30f, l = 0.f;
        MLA_ISSUE(0); MLA_COMMIT(0);
        __syncthreads();
        for (int t = 0; t < nt; ++t) {
            const unsigned char* kb = lds + (t & 1) * MLA_STAGE; const unsigned char* vb = kb + MLA_KB;
            f32x16 s0, s1;
#pragma unroll
            for (int r = 0; r < 16; ++r) { s0[r] = 0.f; s1[r] = 0.f; }
            {
                const unsigned char* kp0 = kb + qi * MLA_KP + hh * 16; const unsigned char* kp1 = kp0 + 32 * MLA_KP;
                bf16x8 ka[4], kn[4];
                ka[0] = *(const bf16x8*)(kp0); ka[1] = *(const bf16x8*)(kp1); ka[2] = *(const bf16x8*)(kp0 + 32); ka[3] = *(const bf16x8*)(kp1 + 32);
#pragma unroll
                for (int g = 0; g < 6; ++g) {
                    if (g < 5) { kn[0] = *(const bf16x8*)(kp0 + (2 * g + 2) * 32); kn[1] = *(const bf16x8*)(kp1 + (2 * g + 2) * 32); kn[2] = *(const bf16x8*)(kp0 + (2 * g + 3) * 32); kn[3] = *(const bf16x8*)(kp1 + (2 * g + 3) * 32); }
                    __builtin_amdgcn_sched_barrier(0);
                    s0 = MFMA32(ka[0], qf[2 * g], s0); s1 = MFMA32(ka[1], qf[2 * g], s1); s0 = MFMA32(ka[2], qf[2 * g + 1], s0); s1 = MFMA32(ka[3], qf[2 * g + 1], s1);
                    __builtin_amdgcn_sched_barrier(0);
#pragma unroll
                    for (int q = 0; q < 4; ++q) ka[q] = kn[q];
                }
            }
            if (t + 1 < nt) MLA_ISSUE(t + 1);
            float mx = fmaxf(s0[0], s1[0]);
#pragma unroll
            for (int r = 1; r < 16; ++r) mx = fmaxf(mx, fmaxf(s0[r], s1[r]));
            mx = fmaxf(mx, __shfl_xor(mx, 32));
            const float mnew = fmaxf(m, mx * c);
            const float alpha = __builtin_amdgcn_exp2f(m - mnew);
            m = mnew;
            float ps = 0.f;
#pragma unroll
            for (int r = 0; r < 16; ++r) { s0[r] = __builtin_amdgcn_exp2f(s0[r] * c - mnew); s1[r] = __builtin_amdgcn_exp2f(s1[r] * c - mnew); ps += s0[r] + s1[r]; }
            l = l * alpha + ps;
            if ((PROBE_SUB >> 9) & 1u) {
                float ps2 = 0.f;
#pragma unroll
                for (int r = 0; r < 16; ++r) { float x0 = s0[r], x1 = s1[r]; asm volatile("" : "+v"(x0), "+v"(x1)); ps2 += __builtin_amdgcn_exp2f(x0 * c - 40.f) + __builtin_amdgcn_exp2f(x1 * c - 40.f); }
                float mx2 = ps2;
#pragma unroll
                for (int r = 0; r < 16; ++r) { float x0 = s0[r], x1 = s1[r]; asm volatile("" : "+v"(x0), "+v"(x1)); mx2 = fmaxf(mx2, fmaxf(x0 * c, x1 * c)); }
                if (mx2 == 123456.75f) l += ps2;
            }
            if ((PROBE_SUB >> 10) & 1u) {
                f32x16 sx;
#pragma unroll
                for (int r = 0; r < 16; ++r) sx[r] = 0.f;
#pragma unroll
                for (int s = 0; s < 12; ++s) { bf16x8 k0 = *(const bf16x8*)(kb + qi * MLA_KP + s * 32 + hh * 16); sx = MFMA32(k0, qf[s], sx); }
                if (sx[0] == 123456.75f) l += sx[1];
            }
#pragma unroll
            for (int d = 0; d < 4; ++d)
#pragma unroll
                for (int r = 0; r < 16; ++r) o[d][r] *= alpha;
            bf16x8 pf[4];
            { u32x4 p;
              p.x = cvtpk(s0[0], s0[1]); p.y = cvtpk(s0[2], s0[3]); p.z = cvtpk(s0[4], s0[5]); p.w = cvtpk(s0[6], s0[7]); pf[0] = __builtin_bit_cast(bf16x8, p);
              p.x = cvtpk(s0[8], s0[9]); p.y = cvtpk(s0[10], s0[11]); p.z = cvtpk(s0[12], s0[13]); p.w = cvtpk(s0[14], s0[15]); pf[1] = __builtin_bit_cast(bf16x8, p);
              p.x = cvtpk(s1[0], s1[1]); p.y = cvtpk(s1[2], s1[3]); p.z = cvtpk(s1[4], s1[5]); p.w = cvtpk(s1[6], s1[7]); pf[2] = __builtin_bit_cast(bf16x8, p);
              p.x = cvtpk(s1[8], s1[9]); p.y = cvtpk(s1[10], s1[11]); p.z = cvtpk(s1[12], s1[13]); p.w = cvtpk(s1[14], s1[15]); pf[3] = __builtin_bit_cast(bf16x8, p); }
            asm volatile("" ::: "memory");
            {
                const unsigned char* vp = vb + qi * MLA_VP + hh * 16;
                bf16x8 va[4], vn[4];
#pragma unroll
                for (int g = 0; g < 4; ++g) va[g] = *(const bf16x8*)(vp + g * 32);
#pragma unroll
                for (int d = 0; d < 4; ++d) {
                    if (d < 3) {
#pragma unroll
                        for (int g = 0; g < 4; ++g) vn[g] = *(const bf16x8*)(vp + (d + 1) * 32 * MLA_VP + g * 32); }
                    __builtin_amdgcn_sched_barrier(0);
#pragma unroll
                    for (int g = 0; g < 4; ++g) o[d] = MFMA32(va[g], pf[g], o[d]);
                    __builtin_amdgcn_sched_barrier(0);
#pragma unroll
                    for (int g = 0; g < 4; ++g) va[g] = vn[g];
                }
            }
            if (t + 1 < nt) MLA_COMMIT((t + 1) & 1);
            __syncthreads();
        }
        const float inv = 1.0f / (l + __shfl_xor(l, 32));
        bf16_t* op = mix + (size_t)qtok * D + h * 128 + 4 * hh;
#pragma unroll
        for (int d = 0; d < 4; ++d)
#pragma unroll
            for (int g = 0; g < 4; ++g) { u32x2 wv; wv.x = cvtpk(o[d][4 * g] * inv, o[d][4 * g + 1] * inv); wv.y = cvtpk(o[d][4 * g + 2] * inv, o[d][4 * g + 3] * inv);
                *(u32x2*)(op + d * 32 + 8 * g) = wv; }
#undef MLA_KTOK
#undef MLA_ISSUE
#undef MLA_ISSUE_K
#undef MLA_ISSUE_V
#undef MLA_COMMIT
    }
}

constexpr int HY_CS = 8224, HY_WS = 5136, HY_WOFF = 8 * HY_CS, HY_RBL = HY_WOFF + 4 * HY_WS;
static_assert(HY_RBL + 516 * 16 <= RING_BYTES, "hyena LDS");

__device__ __forceinline__ u32x4 hy_shift(const u32x4 a, const u32x4 b, int r) {
    switch (r) {
    case 0: return b;
    case 1: return (u32x4){__builtin_amdgcn_alignbyte(b.x, a.w, 2), __builtin_amdgcn_alignbyte(b.y, b.x, 2), __builtin_amdgcn_alignbyte(b.z, b.y, 2), __builtin_amdgcn_alignbyte(b.w, b.z, 2)};
    case 2: return (u32x4){a.w, b.x, b.y, b.z};
    case 3: return (u32x4){__builtin_amdgcn_alignbyte(a.w, a.z, 2), __builtin_amdgcn_alignbyte(b.x, a.w, 2), __builtin_amdgcn_alignbyte(b.y, b.x, 2), __builtin_amdgcn_alignbyte(b.z, b.y, 2)};
    case 4: return (u32x4){a.z, a.w, b.x, b.y};
    case 5: return (u32x4){__builtin_amdgcn_alignbyte(a.z, a.y, 2), __builtin_amdgcn_alignbyte(a.w, a.z, 2), __builtin_amdgcn_alignbyte(b.x, a.w, 2), __builtin_amdgcn_alignbyte(b.y, b.x, 2)};
    case 6: return (u32x4){a.y, a.z, a.w, b.x};
    default: return (u32x4){__builtin_amdgcn_alignbyte(a.y, a.x, 2), __builtin_amdgcn_alignbyte(a.z, a.y, 2), __builtin_amdgcn_alignbyte(a.w, a.z, 2), __builtin_amdgcn_alignbyte(b.x, a.w, 2)};
    }
}

__device__ __forceinline__ void ph_hyena(const Args& a, int l, unsigned char* lds) {
    const bf16_t* __restrict__ RB = (const bf16_t*)(a.ws + WS_FILTL) + (size_t)l * 512 * HY_RBROW;
    const bf16_t* __restrict__ wtl = (const bf16_t*)(a.ws + WS_WTL);
    int tid_ = threadIdx.x; asm volatile("" : "+v"(tid_));
    const int tid = tid_, lane = tid & 63, w = __builtin_amdgcn_readfirstlane(tid >> 6), i = lane & 31, hh = lane >> 5;
    for (int unit = blockIdx.x; unit < 512; unit += gridDim.x) {
        const int c = unit;
        for (int k = tid; k < 515; k += NTHR) { u32x4 v = (u32x4){0u, 0u, 0u, 0u}; if (k < 513) v = *(const u32x4*)(RB + (size_t)c * HY_RBROW + k * 8); *(u32x4*)(lds + HY_RBL + k * 16) = v; }
        for (int k = tid; k < 4 * 321; k += NTHR) { const int b = k / 321, sl = k - b * 321; u32x4 v = (u32x4){0u, 0u, 0u, 0u};
            if (sl >= 28 && sl < 284) v = *(const u32x4*)(wtl + ((size_t)b * 512 + c) * L + (sl - 28) * 8);
            *(u32x4*)(lds + HY_WOFF + b * HY_WS + sl * 16) = v; }
        __syncthreads();
        for (int qs = lane; qs < 511; qs += 64) {
            const u32x4 ca = *(const u32x4*)(lds + HY_RBL + qs * 16), cb = *(const u32x4*)(lds + HY_RBL + qs * 16 + 16);
            *(u32x4*)(lds + w * HY_CS + qs * 16) = hy_shift(ca, cb, w);
        }
        __syncthreads();
        f32x16 acc0, acc1;
#pragma unroll
        for (int r = 0; r < 16; ++r) { acc0[r] = 0.f; acc1[r] = 0.f; }
        const int Tl = i >> 2, b = i & 3;
        const unsigned char* ap = lds + (i & 7) * HY_CS + (hh - (i >> 3) + 255) * 16;
        const unsigned char* bp = lds + HY_WOFF + b * HY_WS + (224 + 16 * (2 * (8 * w + Tl)) + 8 * hh) * 2;
        const int d0 = 16 * w - 127;
#pragma unroll 2
        for (int dd = 0; dd < 142; dd += 2) {
            const int d = d0 + dd;
            const bf16x8 a0 = *(const bf16x8*)(ap - 32 * d), b0 = *(const bf16x8*)(bp - 32 * d);
            const bf16x8 a1 = *(const bf16x8*)(ap - 32 * (d + 1)), b1 = *(const bf16x8*)(bp - 32 * (d + 1));
            acc0 = MFMA32(a0, b0, acc0); acc1 = MFMA32(a1, b1, acc1);
        }
        bf16_t* yt = (bf16_t*)(a.ws + WS_YT) + ((size_t)b * 512 + c) * L + 32 * (8 * w + Tl) + 4 * hh;
#pragma unroll
        for (int g = 0; g < 4; ++g) { u32x2 wv; wv.x = cvtpk(acc0[4 * g] + acc1[4 * g], acc0[4 * g + 1] + acc1[4 * g + 1]); wv.y = cvtpk(acc0[4 * g + 2] + acc1[4 * g + 2], acc0[4 * g + 3] + acc1[4 * g + 3]);
            *(u32x2*)(yt + 8 * g) = wv; }
        __syncthreads();
    }
}

__device__ __forceinline__ void ph_hyena_fin(const Args& a, int l, bool with_ctx, unsigned char* lds) {
    const bf16_t* __restrict__ YT = (const bf16_t*)(a.ws + WS_YT); const bf16_t* __restrict__ wtl = (const bf16_t*)(a.ws + WS_WTL); const bf16_t* __restrict__ wtc = (const bf16_t*)(a.ws + WS_WTC);
    const bf16_t* __restrict__ x0 = (const bf16_t*)(a.ws + WS_X0); const float* skip = a.in[23] + l * 512; bf16_t* __restrict__ mix = (bf16_t*)(a.ws + WS_MIX);
    int tid_ = threadIdx.x; asm volatile("" : "+v"(tid_));
    const int tid = tid_;
    bf16_t* T = (bf16_t*)lds;
    constexpr int TP = 520;
    const int nunits = with_ctx ? 144 : 128;
    for (int unit = (int)gridDim.x - 1 - (int)blockIdx.x; unit < nunits; unit += gridDim.x) {
        const bool lat = unit < 128; const int b = lat ? (unit >> 5) : ((unit - 128) >> 2), t0 = lat ? (unit & 31) * 64 : ((unit - 128) & 3) * 64;
        const int Ls = lat ? L : C; const int tok0 = lat ? b * L + t0 : NLAT + b * C + t0;
        const bf16_t* yrow = (lat ? YT : YT + (size_t)NB * 512 * L) + ((size_t)b * 512 + tid) * Ls + t0;
        const bf16_t* wrow = (lat ? wtl : wtc) + ((size_t)b * 512 + tid) * Ls + t0;
        const float sk = skip[tid];
#pragma unroll
        for (int hf = 0; hf < 2; ++hf) {
            u32x4 yv[4], wv[4];
#pragma unroll
            for (int q = 0; q < 4; ++q) { yv[q] = *(const u32x4*)(yrow + hf * 32 + q * 8); wv[q] = *(const u32x4*)(wrow + hf * 32 + q * 8); }
#pragma unroll
            for (int q = 0; q < 4; ++q) { const unsigned yy[4] = {yv[q].x, yv[q].y, yv[q].z, yv[q].w}, ww[4] = {wv[q].x, wv[q].y, wv[q].z, wv[q].w};
#pragma unroll
                for (int d = 0; d < 4; ++d) { const int t = hf * 32 + q * 8 + 2 * d;
                    T[t * TP + tid] = f2bf(__uint_as_float(yy[d] << 16) + sk * __uint_as_float(ww[d] << 16));
                    T[(t + 1) * TP + tid] = f2bf(__uint_as_float(yy[d] & 0xffff0000u) + sk * __uint_as_float(ww[d] & 0xffff0000u)); } }
        }
        __syncthreads();
#pragma unroll
        for (int j = 0; j < 8; ++j) { const int o = tid + 512 * j, t = o >> 6, cc = (o & 63) * 8;
            const u32x4 tv = *(const u32x4*)(T + t * TP + cc), xv = *(const u32x4*)(x0 + (size_t)(tok0 + t) * 512 + cc);
            const unsigned tt[4] = {tv.x, tv.y, tv.z, tv.w}, xx[4] = {xv.x, xv.y, xv.z, xv.w}; unsigned oo[4];
#pragma unroll
            for (int d = 0; d < 4; ++d) oo[d] = cvtpk(__uint_as_float(tt[d] << 16) * __uint_as_float(xx[d] << 16), __uint_as_float(tt[d] & 0xffff0000u) * __uint_as_float(xx[d] & 0xffff0000u));
            *(u32x4*)(mix + (size_t)(tok0 + t) * D + 1024 + cc) = (u32x4){oo[0], oo[1], oo[2], oo[3]}; }
        __syncthreads();
    }
}

constexpr int SWA_P = 144, SWA_KB = 64 * SWA_P, SWA_STAGE = 2 * SWA_KB;
__device__ __forceinline__ void ph_swa(const Args& a, int l, bool with_ctx, unsigned char* lds) {
    const bf16_t* __restrict__ SQ = (const bf16_t*)(a.ws + WS_SQ); const bf16_t* __restrict__ SK = (const bf16_t*)(a.ws + WS_SK); const bf16_t* __restrict__ SVT = (const bf16_t*)(a.ws + WS_SV);
    const float* sink = a.in[24] + l * 8; bf16_t* __restrict__ mix = (bf16_t*)(a.ws + WS_MIX);
    int tid_ = threadIdx.x; asm volatile("" : "+v"(tid_));
    const int tid = tid_, lane = tid & 63, w = tid >> 6, qi = lane & 31, hh = lane >> 5;
    const int nunits = with_ctx ? 288 : 256;
    const float c = 0.125f * 1.4426950408889634f;
    for (int unit = blockIdx.x; unit < nunits; unit += gridDim.x) {
        int hk, b, p0, nloc, t0loc, q0tok; bool ctxq;
        if (unit < 256) { hk = unit & 1; b = (unit >> 1) & 3; p0 = (unit >> 3) * 64; ctxq = false; q0tok = b * L + p0;
            const int lo = p0 - 128 < 0 ? 0 : p0 - 128, hi = p0 + 192 > L ? L : p0 + 192; t0loc = lo; nloc = (hi - lo) >> 6; }
        else { const int u2 = unit - 256; hk = u2 & 1; b = (u2 >> 1) & 3; p0 = (u2 >> 3) * 64; ctxq = true; q0tok = NLAT + b * C + p0; t0loc = 0; nloc = 0; }
        const int nt = nloc + 4;
#define SWA_KTOK(t) ((t) < nloc ? (b * L + t0loc + (t) * 64) : (NLAT + b * C + ((t) - nloc) * 64))
        u32x4 r0, r1;
#define SWA_ISSUE(t) do { const int kt0_ = SWA_KTOK(t); \
            r0 = *(const u32x4*)(SK + (size_t)(kt0_ + (tid >> 3)) * 128 + hk * 64 + (tid & 7) * 8); \
            r1 = *(const u32x4*)(SVT + (size_t)(hk * 64 + (tid >> 3)) * NTOK + kt0_ + (tid & 7) * 8); } while (0)
#define SWA_COMMIT(buf) do { unsigned char* kb_ = lds + (buf) * SWA_STAGE; unsigned char* vb_ = kb_ + SWA_KB; \
            *(u32x4*)(kb_ + (tid >> 3) * SWA_P + (tid & 7) * 16) = r0; \
            const int g_ = (tid & 7) >> 1, e_ = tid & 1; u32x2 lo_, hi_; lo_.x = r1.x; lo_.y = r1.y; hi_.x = r1.z; hi_.y = r1.w; \
            *(u32x2*)(vb_ + (tid >> 3) * SWA_P + g_ * 32 + e_ * 8) = lo_; *(u32x2*)(vb_ + (tid >> 3) * SWA_P + g_ * 32 + 16 + e_ * 8) = hi_; } while (0)
        const int hq = hk * 4 + (w >> 1), qpos = p0 + (w & 1) * 32 + qi, qtok = q0tok + (w & 1) * 32 + qi;
        bf16x8 qf[4];
#pragma unroll
        for (int s = 0; s < 4; ++s) qf[s] = *(const bf16x8*)(SQ + (size_t)qtok * 512 + hq * 64 + s * 16 + hh * 8);
        f32x16 o[2];
#pragma unroll
        for (int d = 0; d < 2; ++d)
#pragma unroll
            for (int r = 0; r < 16; ++r) o[d][r] = 0.f;
        float m = sink[hq] * 1.4426950408889634f, lsum = hh == 0 ? 1.0f : 0.0f;
        SWA_ISSUE(0); SWA_COMMIT(0);
        __syncthreads();
        for (int t = 0; t < nt; ++t) {
            const unsigned char* kb = lds + (t & 1) * SWA_STAGE; const unsigned char* vb = kb + SWA_KB;
            f32x16 s0, s1;
#pragma unroll
            for (int r = 0; r < 16; ++r) { s0[r] = 0.f; s1[r] = 0.f; }
#pragma unroll
            for (int s = 0; s < 4; ++s) {
                const bf16x8 k0 = *(const bf16x8*)(kb + qi * SWA_P + s * 32 + hh * 16);
                const bf16x8 k1 = *(const bf16x8*)(kb + (32 + qi) * SWA_P + s * 32 + hh * 16);
                s0 = MFMA32(k0, qf[s], s0); s1 = MFMA32(k1, qf[s], s1);
            }
            if (t + 1 < nt) SWA_ISSUE(t + 1);
            if (t < nloc) {
                const int kbase = t0loc + t * 64 + 4 * hh - qpos;
#pragma unroll
                for (int r = 0; r < 16; ++r) { const int dlt = kbase + (r & 3) + 8 * (r >> 2);
                    if (dlt > 128 || dlt < -128) s0[r] = -1.0e30f;
                    if (dlt + 32 > 128 || dlt + 32 < -128) s1[r] = -1.0e30f; }
            }
            float mx = fmaxf(s0[0], s1[0]);
#pragma unroll
            for (int r = 1; r < 16; ++r) mx = fmaxf(mx, fmaxf(s0[r], s1[r]));
            mx = fmaxf(mx, __shfl_xor(mx, 32));
            const float mnew = fmaxf(m, mx * c);
            const float alpha = __builtin_amdgcn_exp2f(m - mnew);
            m = mnew;
            float ps = 0.f;
#pragma unroll
            for (int r = 0; r < 16; ++r) { s0[r] = __builtin_amdgcn_exp2f(s0[r] * c - mnew); s1[r] = __builtin_amdgcn_exp2f(s1[r] * c - mnew); ps += s0[r] + s1[r]; }
            lsum = lsum * alpha + ps;
#pragma unroll
            for (int d = 0; d < 2; ++d)
#pragma unroll
                for (int r = 0; r < 16; ++r) o[d][r] *= alpha;
            bf16x8 pf[4];
            { u32x4 p;
              p.x = cvtpk(s0[0], s0[1]); p.y = cvtpk(s0[2], s0[3]); p.z = cvtpk(s0[4], s0[5]); p.w = cvtpk(s0[6], s0[7]); pf[0] = __builtin_bit_cast(bf16x8, p);
              p.x = cvtpk(s0[8], s0[9]); p.y = cvtpk(s0[10], s0[11]); p.z = cvtpk(s0[12], s0[13]); p.w = cvtpk(s0[14], s0[15]); pf[1] = __builtin_bit_cast(bf16x8, p);
              p.x = cvtpk(s1[0], s1[1]); p.y = cvtpk(s1[2], s1[3]); p.z = cvtpk(s1[4], s1[5]); p.w = cvtpk(s1[6], s1[7]); pf[2] = __builtin_bit_cast(bf16x8, p);
              p.x = cvtpk(s1[8], s1[9]); p.y = cvtpk(s1[10], s1[11]); p.z = cvtpk(s1[12], s1[13]); p.w = cvtpk(s1[14], s1[15]); pf[3] = __builtin_bit_cast(bf16x8, p); }
#pragma unroll
            for (int d = 0; d < 2; ++d)
#pragma unroll
                for (int g = 0; g < 4; ++g) {
                    const bf16x8 vf = *(const bf16x8*)(vb + (d * 32 + qi) * SWA_P + g * 32 + hh * 16);
                    o[d] = MFMA32(vf, pf[g], o[d]);
                }
            if (t + 1 < nt) SWA_COMMIT((t + 1) & 1);
            __syncthreads();
        }
        const float inv = 1.0f / (lsum + __shfl_xor(lsum, 32));
        bf16_t* op = mix + (size_t)qtok * D + 1536 + hq * 64 + 4 * hh;
#pragma unroll
        for (int d = 0; d < 2; ++d)
#pragma unroll
            for (int g = 0; g < 4; ++g) { u32x2 wv; wv.x = cvtpk(o[d][4 * g] * inv, o[d][4 * g + 1] * inv); wv.y = cvtpk(o[d][4 * g + 2] * inv, o[d][4 * g + 3] * inv);
                *(u32x2*)(op + d * 32 + 8 * g) = wv; }
#undef SWA_KTOK
#undef SWA_ISSUE
#undef SWA_COMMIT
    }
}


constexpr int NPHASES = 22;
#define GEMM_CALL(EPI, SCHED, g, S, E) pg8::gemm_phase<EPI, SCHED, true, true, 0>((PG8_LAS unsigned char*)lds, g, S, E)
#define GEMM_CALL8(EPI, SCHED, g, S, E) pg8::gemm_phase<EPI, SCHED, true, true, 1>((PG8_LAS unsigned char*)lds, g, S, E)
#define GEMM_CALLI8(EPI, SCHED, g, S, E) pg8::gemm_phase<EPI, SCHED, true, true, 2>((PG8_LAS unsigned char*)lds, g, S, E)

template <int LYR>
__device__ __forceinline__ void layer_phases(const Args& a, unsigned char* lds, const XcdBarrier& bar, int lo, int hi) {
#define IN(k) (lo <= (k) && (k) < hi)
#define REPS(k) for (int rep_ = 0; rep_ <= (int)((PROBE_MASK >> (k)) & 1u); ++rep_)
#if MK_PER_PHASE
#define SEAM(k) do { } while (0)
#else
#define SEAM(k) do { if (IN(k) && IN((k) + 1)) xcd_barrier(bar); } while (0)
#endif
    constexpr int P0 = 1 + LYR * 9;
    constexpr bool LAST = (LYR == 1);
    constexpr int S_WO = pg8::split_S((LAST ? NLAT : NTOK) / 256 * (D / 256), D / 64, 256);
    constexpr int S_WO0 = pg8::split_S(NTOK / 256 * (D / 256), D / 64, 256);
    constexpr int S_DN0 = pg8::split_S(NTOK / 256 * (D / 256), (FP8_DENSE || FP8_DOWN) ? DFF / 128 : DFF / 64, 256);
    constexpr int S_DN = pg8::split_S(NTOK / 256 * (D / 256), (FP8_DENSE || FP8_DOWN) ? DFF / 128 : DFF / 64, 256);
    const int G = gridDim.x, bid = blockIdx.x;
    unsigned char* ws = a.ws;
    const float* modl = (const float*)(ws + WS_MOD) + (size_t)LYR * 5 * 12288;
    bf16_t* xs = (bf16_t*)(ws + WS_XS);
    const int nq = LAST ? NLAT : NTOK;
    if (IN(P0 + 0)) REPS(P0 + 0) {
        if (LYR == 0) ph_normmod<false, false, I8_WIN ? 2 : 0, 0, false, false>(a.in[0], a.in[2], a.in[6], modl, 0, 2048, (bf16_t*)(ws + WS_HA), NTOK, nullptr, nullptr, nullptr, nullptr, nullptr, nullptr, (float*)(ws + WS_RSC));
        else ph_normmod<false, false, I8_WIN ? 2 : 0, S_DN0>(xs, xs + (size_t)NLAT * D, a.in[6] + D, modl, 0, 2048, (bf16_t*)(ws + WS_HA), NTOK, nullptr, nullptr, nullptr, nullptr,
                                                    (const bf16_t*)(ws + WS_SLAB), (const float*)(ws + WS_MOD) + (size_t)4 * 12288 + 10240, (float*)(ws + WS_RSC));
    }
    SEAM(P0 + 0);
    if (IN(P0 + 1)) REPS(P0 + 1) {
#if I8_WIN
        pg8::Gemm g{(const bf16_t*)(ws + WS_HA), (const bf16_t*)(ws + WS_WIN + (size_t)LYR * UW * D * 2), NTOK, UW, D / 2};
        const float swin = __uint_as_float(__hip_atomic_load((const unsigned*)(ws + WS_CTL) + CT_WSC + LYR, __ATOMIC_RELAXED, __HIP_MEMORY_SCOPE_AGENT)) * (1.0f / 127.0f);
        pg8::EpiStoreI8 E{(bf16_t*)(ws + WS_U), UW, (const float*)(ws + WS_RSC), swin};
        if constexpr (LAST) { pg8::WinLastOrder S; S.init(G, bid, D / 2); GEMM_CALLI8(pg8::EpiStoreI8, pg8::WinLastOrder, g, S, E); }
        else { pg8::StaticOrder S; S.init(NTOK, UW, G, bid, D / 2); GEMM_CALLI8(pg8::EpiStoreI8, pg8::StaticOrder, g, S, E); }
#else
        pg8::Gemm g{(const bf16_t*)(ws + WS_HA), (const bf16_t*)(ws + WS_WIN + (size_t)LYR * UW * D * 2), NTOK, UW, D};
        pg8::EpiStore E{(bf16_t*)(ws + WS_U), UW};
        if constexpr (LAST) { pg8::WinLastOrder S; S.init(G, bid, D); GEMM_CALL(pg8::EpiStore, pg8::WinLastOrder, g, S, E); }
        else { pg8::StaticOrder S; if (G == 256) S.init(NTOK, UW, G1_GEMM, bid < G1_GEMM ? bid : (1 << 24), D); else S.init(NTOK, UW, G, bid, D); GEMM_CALL(pg8::EpiStore, pg8::StaticOrder, g, S, E); }
#endif
        if (!LAST && rep_ == 0 && G == 256 && bid >= TAIL1_BLK0) {
            const int f0 = bid < G1_GEMM ? NCONV_Q + (bid - TAIL1_BLK0) * TAILQ1 : NCONV_Q + TAIL1_N * TAILQ1 + (bid - G1_GEMM) * CQ1;
            ph_convert<0>(a, (float*)lds, f0, 1, f0 + (bid < G1_GEMM ? TAILQ1 : CQ1)); }
        conv_fill(a, (float*)lds, LYR * 6 + 0);
    }
    SEAM(P0 + 1);
    if (IN(P0 + 2)) REPS(P0 + 2) ph_mid(a, LYR);
    SEAM(P0 + 2);
    if (IN(P0 + 3)) REPS(P0 + 3) {
        SUBREP(0) {
        { pg8::Gemm g{(const bf16_t*)(ws + WS_CQN), (const bf16_t*)(ws + WS_WQ + (size_t)LYR * QW * 768 * 2), nq, QW, 768};
          pg8::StaticOrder S; S.init(nq, QW, G, bid, 768); pg8::EpiQ E{(bf16_t*)(ws + WS_Q), (const float*)(ws + WS_ROPE), (const float*)(ws + WS_ROPE) + 2048 * 32};
          GEMM_CALL(pg8::EpiQ, pg8::StaticOrder, g, S, E); }
        __syncthreads();
        { pg8::Gemm g{(const bf16_t*)(ws + WS_CKVN), (const bf16_t*)(ws + WS_WKV + (size_t)LYR * KVW * 512 * 2), NTOK, 1024, 512};
          pg8::StaticOrder S; S.init(NTOK, 1024, G, bid, 512); pg8::EpiStore E{(bf16_t*)(ws + WS_KN), 1024};
          GEMM_CALL(pg8::EpiStore, pg8::StaticOrder, g, S, E); }
        __syncthreads();
        { pg8::Gemm g{(const bf16_t*)(ws + WS_WKV + (size_t)LYR * KVW * 512 * 2 + (size_t)1024 * 512 * 2), (const bf16_t*)(ws + WS_CKVN), 1024, NTOK, 512};
          pg8::StaticOrder S; S.init(1024, NTOK, 108, bid >= 216 ? bid - 216 : (bid >= 144 ? bid - 108 : (1 << 24)), 512); pg8::EpiStore E{(bf16_t*)(ws + WS_VT), NTOK};
          GEMM_CALL(pg8::EpiStore, pg8::StaticOrder, g, S, E); }
        __syncthreads();
        }
        SUBREP(1) ph_hyena(a, LYR, lds);
        SUBREP(3) if (!LAST) ph_hyena_naive<C>(a, LYR, (float*)lds);
        SUBREP(2) ph_swa(a, LYR, !LAST, lds);
        conv_fill(a, (float*)lds, LYR * 6 + 1);
    }
    SEAM(P0 + 3);
    if (IN(P0 + 4)) REPS(P0 + 4) { ph_hyena_fin(a, LYR, !LAST, lds); ph_mla(a, !LAST, lds);
        if (!LAST && rep_ == 0 && G == 256 && bid >= TAIL4_BLK0 && TAILQ4 > 0) ph_convert<0>(a, (float*)lds, NCONV_Q + NCONV_T1 + NCONV_T2 + NCONV_T3 + (bid - TAIL4_BLK0) * TAILQ4, 1, NCONV_Q + NCONV_T1 + NCONV_T2 + NCONV_T3 + (bid - TAIL4_BLK0 + 1) * TAILQ4); conv_fill(a, (float*)lds, LYR * 6 + 2); }
    SEAM(P0 + 4);
    if (IN(P0 + 5)) REPS(P0 + 5) {
        pg8::Gemm g{(const bf16_t*)(ws + WS_MIX), (const bf16_t*)(ws + WS_WOUT + (size_t)LYR * D * D * 2), nq, D, D};
        pg8::SplitOrder S; S.init(nq / 256, D / 256, G, bid, D, S_WO);
        const int trow0 = S.nfull / S.nN * 256; pg8::EpiResid E{rep_ ? (bf16_t*)(ws + WS_ACT) : xs, LYR == 0 ? a.in[0] : (const float*)nullptr, modl + 4096, (bf16_t*)(ws + WS_SLAB), trow0, nq - trow0, 1.0f};
        GEMM_CALL(pg8::EpiResid, pg8::SplitOrder, g, S, E);
        conv_fill(a, (float*)lds, LYR * 6 + 3);
    }
    SEAM(P0 + 5);
    if (!LAST) {
#if !FP8_DENSE
        if (IN(P0 + 6)) { ph_normmod<false, true, I8_GU ? 2 : 0, S_WO0, true, false>(xs, a.in[2], a.in[7], modl, 6144, 8192, (bf16_t*)(ws + WS_HA), NTOK, xs, nullptr, nullptr, nullptr, (const bf16_t*)(ws + WS_SLAB), modl + (size_t)4 * 12288 + 4096, (float*)(ws + WS_RSC));
            conv_finish(a, (float*)lds, CONV_DENSE_END); }
        SEAM(P0 + 6);
        if (IN(P0 + 7)) REPS(P0 + 7) {
#if I8_GU
            pg8::Gemm g{(const bf16_t*)(ws + WS_HA), (const bf16_t*)(ws + WS_WGU), NTOK, 2 * DFF, D / 2};
            pg8::StaticOrder S; if (G == 256) S.init(NTOK, 2 * DFF, G2_GEMM, bid < G2_GEMM ? bid : (1 << 24), D / 2); else S.init(NTOK, 2 * DFF, G, bid, D / 2);
            const float swg = __uint_as_float(__hip_atomic_load((const unsigned*)(ws + WS_CTL) + CT_WSC + 2, __ATOMIC_RELAXED, __HIP_MEMORY_SCOPE_AGENT)) * (1.0f / 127.0f);
            const float swu = __uint_as_float(__hip_atomic_load((const unsigned*)(ws + WS_CTL) + CT_WSC + 3, __ATOMIC_RELAXED, __HIP_MEMORY_SCOPE_AGENT)) * (1.0f / 127.0f);
            pg8::EpiSwiGLUI8 E{(unsigned char*)(ws + WS_ACT), DFF, (const float*)(ws + WS_RSC), swg, swu, ASCALE};
            GEMM_CALLI8(pg8::EpiSwiGLUI8, pg8::StaticOrder, g, S, E);
            if (rep_ == 0 && G == 256 && bid >= TAIL2_BLK0) {
                const int f0 = bid < G2_GEMM ? NCONV_Q + NCONV_T1 + (bid - TAIL2_BLK0) * TAILQ2 : NCONV_Q + NCONV_T1 + TAIL2_N * TAILQ2 + (bid - G2_GEMM) * CQ2;
                ph_convert<0>(a, (float*)lds, f0, 1, f0 + (bid < G2_GEMM ? TAILQ2 : CQ2)); }
#elif FP8_DOWN
            pg8::Gemm g{(const bf16_t*)(ws + WS_HA), (const bf16_t*)(ws + WS_WGU), NTOK, 2 * DFF, D};
            pg8::StaticOrder S; S.init(NTOK, 2 * DFF, G, bid, D);
            pg8::EpiSwiGLU8 E{(unsigned char*)(ws + WS_ACT), DFF, 1.0f, ASCALE};
            GEMM_CALL(pg8::EpiSwiGLU8, pg8::StaticOrder, g, S, E);
#else
            pg8::Gemm g{(const bf16_t*)(ws + WS_HA), (const bf16_t*)(ws + WS_WGU), NTOK, 2 * DFF, D};
            pg8::StaticOrder S; S.init(NTOK, 2 * DFF, G, bid, D);
            pg8::EpiSwiGLU E{(bf16_t*)(ws + WS_ACT), DFF};
            GEMM_CALL(pg8::EpiSwiGLU, pg8::StaticOrder, g, S, E);
#endif
            conv_fill(a, (float*)lds, 4);
        }
        SEAM(P0 + 7);
        if (IN(P0 + 8)) REPS(P0 + 8) {
#if FP8_DOWN
            pg8::Gemm g{(const bf16_t*)(ws + WS_ACT), (const bf16_t*)(ws + WS_WDN), NTOK, D, DFF / 2};
            pg8::SplitOrder S; S.init(NTOK / 256, D / 256, G, bid, DFF / 2, S_DN);
            const int trow0 = S.nfull / S.nN * 256; pg8::EpiResid E{rep_ ? (bf16_t*)(ws + WS_YS) : xs, (const float*)nullptr, modl + 10240, (bf16_t*)(ws + WS_SLAB), trow0, NTOK - trow0, 1.0f / (ASCALE * WSCALE)};
            GEMM_CALL8(pg8::EpiResid, pg8::SplitOrder, g, S, E);
            if (rep_ == 0 && G == 256 && bid >= TAIL3_BLK0 && TAILQ3 > 0) ph_convert<0>(a, (float*)lds, NCONV_Q + NCONV_T1 + NCONV_T2 + (bid - TAIL3_BLK0) * TAILQ3, 1, NCONV_Q + NCONV_T1 + NCONV_T2 + (bid - TAIL3_BLK0 + 1) * TAILQ3);
#else
            pg8::Gemm g{(const bf16_t*)(ws + WS_ACT), (const bf16_t*)(ws + WS_WDN), NTOK, D, DFF};
            pg8::SplitOrder S; S.init(NTOK / 256, D / 256, G, bid, DFF, S_DN);
            const int trow0 = S.nfull / S.nN * 256; pg8::EpiResid E{rep_ ? (bf16_t*)(ws + WS_YS) : xs, (const float*)nullptr, modl + 10240, (bf16_t*)(ws + WS_SLAB), trow0, NTOK - trow0, 1.0f};
            GEMM_CALL(pg8::EpiResid, pg8::SplitOrder, g, S, E);
#endif
            conv_fill(a, (float*)lds, 5);
        }
#else
        if (IN(P0 + 6)) { ph_normmod<false, true, true, S_WO0, true, false>(xs, a.in[2], a.in[7], modl, 6144, 8192, (bf16_t*)(ws + WS_HA), NTOK, xs, nullptr, nullptr, nullptr, (const bf16_t*)(ws + WS_SLAB), modl + (size_t)4 * 12288 + 4096);
            conv_finish(a, (float*)lds, CONV_DENSE_END); }
        SEAM(P0 + 6);
        if (IN(P0 + 7)) REPS(P0 + 7) {
            pg8::Gemm g{(const bf16_t*)(ws + WS_HA), (const bf16_t*)(ws + WS_WGU), NTOK, 2 * DFF, D / 2};
            pg8::StaticOrder S; S.init(NTOK, 2 * DFF, G, bid, D / 2); pg8::EpiSwiGLU8 E{(unsigned char*)(ws + WS_ACT), DFF, 1.0f / (ASCALE * WSCALE), ASCALE};
            GEMM_CALL8(pg8::EpiSwiGLU8, pg8::StaticOrder, g, S, E);
            conv_fill(a, (float*)lds, 4);
        }
        SEAM(P0 + 7);
        if (IN(P0 + 8)) REPS(P0 + 8) {
            pg8::Gemm g{(const bf16_t*)(ws + WS_ACT), (const bf16_t*)(ws + WS_WDN), NTOK, D, DFF / 2};
            pg8::SplitOrder S; S.init(NTOK / 256, D / 256, G, bid, DFF / 2, S_DN);
            const int trow0 = S.nfull / S.nN * 256; pg8::EpiResid E{rep_ ? (bf16_t*)(ws + WS_YS) : xs, (const float*)nullptr, modl + 10240, (bf16_t*)(ws + WS_SLAB), trow0, NTOK - trow0, 1.0f / (ASCALE * WSCALE)};
            GEMM_CALL8(pg8::EpiResid, pg8::SplitOrder, g, S, E);
            conv_fill(a, (float*)lds, 5);
        }
#endif
        SEAM(P0 + 8);
    } else {
        if (IN(P0 + 6)) REPS(P0 + 6) ph_normmod<true, false, true>(xs, xs + (size_t)NLAT * D, a.in[7] + D, modl, 6144, 8192, (bf16_t*)(ws + WS_HA), NLAT, nullptr, a.in[29], (int*)(ws + WS_TOPI), (float*)(ws + WS_TOPW));
        SEAM(P0 + 6);
        if (IN(P0 + 7)) REPS(P0 + 7) { ph_route_gather(a, (int*)lds); conv_finish(a, (float*)lds, NCONV); }
        SEAM(P0 + 7);
        if (IN(P0 + 9)) REPS(P0 + 9) {
            pg8::Gemm g{(const bf16_t*)(ws + WS_HBS), (const bf16_t*)(ws + WS_MGU), MOE_ROWS, 2 * DFE, D / 2};
            pg8::MoeOrder S; S.init((const int*)(ws + WS_CTL), 2 * DFE / 256, G, bid, (size_t)2 * DFE * D, D / 2); pg8::EpiSwiGLU8 E{(rep_ && ((PROBE_SUB >> 12) & 1u)) ? nullptr : (unsigned char*)(ws + WS_ACT), DFE, 1.0f / (ASCALE * WSCALE), ASCALE};
            GEMM_CALL8(pg8::EpiSwiGLU8, pg8::MoeOrder, g, S, E);
        }
        SEAM(P0 + 9);
        if (IN(P0 + 10)) REPS(P0 + 10) {
            pg8::Gemm g{(const bf16_t*)(ws + WS_ACT), (const bf16_t*)(ws + WS_MDN), MOE_ROWS, D, DFE / 2};
            pg8::SplitOrder S; S.init_moe((const int*)(ws + WS_CTL), D / 256, G, bid, DFE / 2, (size_t)D * DFE);
            const int trow0 = S.nfull / S.nN * 256; pg8::EpiYs E{(bf16_t*)(ws + WS_YS), (bf16_t*)(ws + WS_SLAB), trow0, S.nM * 256 - trow0, 1.0f / (ASCALE * WSCALE)};
            GEMM_CALL8(pg8::EpiYs, pg8::SplitOrder, g, S, E);
        }
        SEAM(P0 + 10);
        if (IN(P0 + 11)) REPS(P0 + 11) ph_final(a);
    }
#undef IN
#undef SEAM
#undef REPS
}

__global__ void __launch_bounds__(NTHR, 2) mk_fwd(Args a) {
    extern __shared__ __attribute__((aligned(16))) unsigned char lds[];
    const int tid = threadIdx.x;
    for (int u = tid; u < (LDS_BYTES - LDSCTL_OFF) / 4; u += NTHR) ((unsigned*)(lds + LDSCTL_OFF))[u] = 0u;
    __syncthreads();
    XcdBarrier bar; bar.bar = (unsigned*)(a.ws + WS_CTL) + CW_BAR; bar.x = 0; bar.st = nullptr;
#if !MK_PER_PHASE
    bar = xcd_barrier_post((unsigned*)(a.ws + WS_CTL) + CW_BAR, (volatile LAS unsigned*)(lds + LDSCTL_OFF + 32));
#endif
    const int lo = a.ph_lo, hi = a.ph_hi;
    if (lo <= 0 && 0 < hi) {
        for (int rep_ = 0; rep_ <= (int)(PROBE_MASK & 1u); ++rep_) { ph_prologue(a, (float*)lds); __syncthreads(); }
#if !MK_PER_PHASE
        if (1 < hi) xcd_barrier(bar);
#endif
    }
    layer_phases<0>(a, lds, bar, lo, hi);
    layer_phases<1>(a, lds, bar, lo, hi);
}

extern "C" void kernel_launch(void* const* d_in, const int* in_sizes, int n_in, void* d_out, int out_size, void* d_ws, size_t ws_size, hipStream_t stream) {
    (void)in_sizes; (void)out_size;
    static int grid = 0;
    if (grid == 0) {
        if (n_in != 34 || ws_size < WS_END) { fprintf(stderr, "kernel_launch: need 34 inputs and >= %zu bytes of workspace (got %d, %zu)\n", (size_t)WS_END, n_in, ws_size); grid = -1; return; }
        int dev = 0, cus = 0, per_cu = 0;
        if (hipGetDevice(&dev) != hipSuccess || hipDeviceGetAttribute(&cus, hipDeviceAttributeMultiprocessorCount, dev) != hipSuccess) { grid = -1; return; }
        if (hipFuncSetAttribute((const void*)mk_fwd, hipFuncAttributeMaxDynamicSharedMemorySize, LDS_BYTES) != hipSuccess) { fprintf(stderr, "kernel_launch: hipFuncSetAttribute failed\n"); grid = -1; return; }
        if (hipOccupancyMaxActiveBlocksPerMultiprocessor(&per_cu, (const void*)mk_fwd, NTHR, LDS_BYTES) != hipSuccess || per_cu < 1) { fprintf(stderr, "kernel_launch: occupancy query says %d blocks per CU\n", per_cu); }
        (void)hipGetLastError();
        grid = cus;
    }
    if (grid < 0) return;
    if (hipMemsetAsync((char*)d_ws + WS_CTL, 0, CTL_ZERO_BYTES, stream) != hipSuccess) return;
    Args a{};
    for (int i = 0; i < 34; ++i) a.in[i] = (const float*)d_in[i];
    a.out = (float*)d_out; a.ws = (unsigned char*)d_ws;
#if MK_PER_PHASE
    for (int p = 0; p < NPHASES; ++p) { a.ph_lo = p; a.ph_hi = p + 1; hipLaunchKernelGGL(mk_fwd, dim3(grid), dim3(NTHR), LDS_BYTES, stream, a); }
#else
    a.ph_lo = 0; a.ph_hi = NPHASES;
    hipLaunchKernelGGL(mk_fwd, dim3(grid), dim3(NTHR), LDS_BYTES, stream, a);
#endif
}
```

```cpp
#include <hip/hip_runtime.h>
#include <stdint.h>
#include <stdio.h>

#ifndef FP8_DENSE
#define FP8_DENSE 0
#endif
#ifndef FP8_DOWN
#define FP8_DOWN 1
#endif
#ifndef I8_WIN
#define I8_WIN 0
#endif
#ifndef I8_GU
#define I8_GU 1
#endif
#ifndef I8_GEMM
#define I8_GEMM (I8_WIN || I8_GU)
#endif
#ifndef TAILQ1
#define TAILQ1 6
#endif
#ifndef TAILQ2
#define TAILQ2 3
#endif
#ifndef TAILQ3
#define TAILQ3 8
#endif
#ifndef TAILQ4
#define TAILQ4 2
#endif
#ifndef CQ1
#define CQ1 20
#endif
#ifndef CQ2
#define CQ2 26
#endif
#ifndef CONV_FILL
#define CONV_FILL 0
#endif
#ifndef PROBE_MASK
#define PROBE_MASK 0u
#endif
#ifndef PROBE_SUB
#define PROBE_SUB 0u
#endif
#ifndef MK_PER_PHASE
#define MK_PER_PHASE 0
#endif

typedef unsigned short bf16_t;
typedef float f32x4 __attribute__((ext_vector_type(4)));
typedef float f32x16 __attribute__((ext_vector_type(16)));
typedef unsigned u32x4 __attribute__((ext_vector_type(4)));
typedef unsigned u32x2 __attribute__((ext_vector_type(2)));
typedef short bf16x8 __attribute__((ext_vector_type(8)));

constexpr int D = 2048, NB = 4, L = 2048, C = 256, NLAT = NB * L, NCTX = NB * C, NTOK = NLAT + NCTX;
constexpr int UW = 3840;
constexpr int O_CQ = 0, O_CKV = 768, O_KPE = 1280, O_HY = 1344, O_SQ = 2880, O_SK = 3392, O_SV = 3520, INW = 3648;
constexpr int QW = 1536, KVW = 2048, DFF = 5632, DFE = 7168, NE = 8;
constexpr int MOE_ROWS = 18432;
constexpr float EPS = 1e-6f;
constexpr int NTHR = 512;
constexpr int HY_RBROW = 4112;

__device__ __forceinline__ float bf2f(bf16_t h) { return __uint_as_float(((unsigned)h) << 16); }
__device__ __forceinline__ bf16_t f2bf(float f) { unsigned u = __float_as_uint(f); u += 0x7fffu + ((u >> 16) & 1u); return (bf16_t)(u >> 16); }
__device__ __forceinline__ float wave_sum(float v) { for (int o = 32; o > 0; o >>= 1) v += __shfl_xor(v, o); return v; }
__device__ __forceinline__ float wave_max(float v) { for (int o = 32; o > 0; o >>= 1) v = fmaxf(v, __shfl_xor(v, o)); return v; }
__device__ __forceinline__ float silu(float x) { return x / (1.0f + __expf(-x)); }
__device__ __forceinline__ int tok_mod(int tok) { return tok < NLAT ? (tok >> 11) : 4; }

constexpr size_t al(size_t x) { return (x + 255) & ~(size_t)255; }
constexpr size_t WS_CTL = 0, CTL_ZERO_BYTES = 65536;
constexpr size_t WS_MOD = 65536;
constexpr size_t WS_ROPE = WS_MOD + al((size_t)2 * 5 * 12288 * 4);
constexpr size_t WS_FILTL = WS_ROPE + al((size_t)2 * 2048 * 32 * 4);
constexpr size_t WS_FILTC = WS_FILTL + al((size_t)2 * 512 * 4096 * 4);
constexpr size_t WS_WIN = WS_FILTC + al((size_t)2 * 512 * 512 * 4);
constexpr size_t WS_WQ = WS_WIN + al((size_t)2 * UW * D * 2);
constexpr size_t WS_WKV = WS_WQ + al((size_t)2 * QW * 768 * 2);
constexpr size_t WS_WOUT = WS_WKV + al((size_t)2 * KVW * 512 * 2);
constexpr size_t WS_WGU = WS_WOUT + al((size_t)2 * D * D * 2);
constexpr size_t WS_WDN = WS_WGU + al((size_t)2 * DFF * D * 2);
constexpr size_t WS_MGU = WS_WDN + al((size_t)D * DFF * 2);
constexpr size_t WS_MDN = WS_MGU + al((size_t)NE * 2 * DFE * D * 2);
constexpr size_t WS_HA = WS_MDN + al((size_t)NE * D * DFE * 2);
constexpr size_t WS_U = WS_HA + al((size_t)NTOK * D * 2);
constexpr size_t WS_CQN = WS_U + al((size_t)NTOK * UW * 2);
constexpr size_t WS_CKVN = WS_CQN + al((size_t)NTOK * 768 * 2);
constexpr size_t WS_KPE = WS_CKVN + al((size_t)NTOK * 512 * 2);
constexpr size_t WS_X0 = WS_KPE + al((size_t)NTOK * 64 * 2);
constexpr size_t WS_WTL = WS_X0 + al((size_t)NTOK * 512 * 2);
constexpr size_t WS_WTC = WS_WTL + al((size_t)NB * 512 * L * 2);
constexpr size_t WS_SQ = WS_WTC + al((size_t)NB * 512 * C * 2);
constexpr size_t WS_SK = WS_SQ + al((size_t)NTOK * 512 * 2);
constexpr size_t WS_SV = WS_SK + al((size_t)NTOK * 128 * 2);
constexpr size_t WS_Q = WS_SV + al((size_t)NTOK * 128 * 2);
constexpr size_t WS_KV = WS_Q + al((size_t)NTOK * QW * 2);
constexpr size_t WS_KN = WS_KV;
constexpr size_t WS_VT = WS_KV + (size_t)NTOK * 1024 * 2;
constexpr size_t WS_MIX = WS_KV + al((size_t)NTOK * KVW * 2);
constexpr size_t WS_MIXEND = WS_MIX + al((size_t)NTOK * D * 2);
constexpr size_t WS_YS = WS_U;
static_assert(WS_YS + (size_t)MOE_ROWS * D * 4 <= WS_MIXEND, "ys overlay");
constexpr size_t WS_XS = WS_MIXEND;
constexpr size_t WS_ACT = WS_XS + al((size_t)NTOK * D * 4);
constexpr size_t WS_HBS = WS_ACT + al((size_t)MOE_ROWS * DFE * 2);
constexpr size_t WS_TOPI = WS_HBS + al((size_t)MOE_ROWS * D * 2);
constexpr size_t WS_TOPW = WS_TOPI + al((size_t)NLAT * 2 * 4);
constexpr size_t WS_POS = WS_TOPW + al((size_t)NLAT * 2 * 4);
constexpr size_t WS_SRC = WS_POS + al((size_t)NLAT * 2 * 4);
constexpr size_t WS_SLAB = WS_SRC + al((size_t)MOE_ROWS * 4);
constexpr size_t WS_YT = WS_SLAB + ((size_t)64 << 20);
constexpr size_t WS_RSC = WS_YT + al((size_t)NB * 512 * (L + C) * 2);
constexpr size_t WS_END = WS_RSC + al((size_t)NTOK * 4);
constexpr int CT_EOFF = 1024, CT_EPAD = 1040, CT_NTILE = 1056, CT_MOES = 1057, CT_TROW = 1058, CT_WSC = 1088, CT_AMAXDONE = 1100;
constexpr int CW_BAR = 4096;

constexpr int RING_BYTES = 131072, LDS_BYTES = 147456, LDSCTL_OFF = LDS_BYTES - 256;

namespace pg8 {
#define PG8_LAS __attribute__((address_space(3)))
typedef unsigned short bf16_t;
typedef short bf16x8 __attribute__((ext_vector_type(8)));
typedef float f32x4 __attribute__((ext_vector_type(4)));
typedef unsigned u32x4 __attribute__((ext_vector_type(4)));
constexpr int BM = 256, BK = 64, HALF = 128, HTB = HALF * BK * 2  , STAGE_BYTES = 8 * HTB, NXCD = 8, WGM = 8;

__host__ __device__ __forceinline__ int lds_byte(int r, int c) { const int st = (r >> 4) * 2 + (c >> 5), rr = r & 15, cc = c & 31, ob = rr * 64 + cc * 2; return st * 1024 + (ob ^ (((ob >> 9) & 1) << 5)); }
__host__ __device__ __forceinline__ void stage_rc(int b, int& R, int& C) { const int st = b / 1024, sb = b % 1024, swz = sb ^ (((sb >> 9) & 1) << 5); R = (st >> 1) * 16 + swz / 64; C = (st & 1) * 32 + (swz % 64) / 2; }
__host__ __device__ __forceinline__ int perm32(int rho) { const int n = rho >> 4, i = rho & 15; return 8 * (i >> 2) + 4 * n + (i & 3); }

struct Unit { int pm, pn, kt0, nkt, slab; };
struct Gemm { const bf16_t* A; const bf16_t* Bt; int M, N, K; };

struct StaticOrder {
    int nM, nN, nwg, G, c;
    int nkt;
    __host__ __device__ void init(int M, int N, int G_, int c_, int K) { nM = M / BM; nN = N / BM; nwg = nM * nN; G = G_; c = c_; nkt = K / BK; }
    __host__ __device__ bool next(int i, Unit& u) const {
        const long L = (long)i * G + c; if (L >= nwg) return false;
        int wgid = (int)L; { const int q = nwg / NXCD, r = nwg % NXCD, xcd = wgid % NXCD, off = wgid / NXCD; wgid = (xcd < r ? xcd * (q + 1) : r * (q + 1) + (xcd - r) * q) + off; }
        const int nig = WGM * nN, gid = wgid / nig, fm = gid * WGM, gsz = (nM - fm) < WGM ? (nM - fm) : WGM;
        u.pm = fm + ((wgid % nig) % gsz); u.pn = (wgid % nig) / gsz; u.kt0 = 0; u.nkt = nkt; u.slab = -1; return true;
    }
    __device__ __forceinline__ size_t bt_off(const Unit&) const { return 0; }
    __device__ __forceinline__ void a_ready(const Unit&) const {}
    __device__ __forceinline__ void done(const Unit&) const {}
};

__device__ __forceinline__ unsigned cvt_pk_bf16(float lo, float hi) { unsigned r; asm volatile("v_cvt_pk_bf16_f32 %0, %1, %2" : "=v"(r) : "v"(lo), "v"(hi)); return r; }
typedef float f32x2 __attribute__((ext_vector_type(2)));
typedef int v8i_t __attribute__((ext_vector_type(8))); typedef int v4i_t __attribute__((ext_vector_type(4)));
template <bool F8> struct Frag;
template <> struct Frag<false> { bf16x8 h[2]; __device__ __forceinline__ void set0(bf16x8 x) { h[0] = x; } __device__ __forceinline__ void set1(bf16x8 x) { h[1] = x; } };
template <> struct Frag<true> { v8i_t v; __device__ __forceinline__ void set0(bf16x8 x) { v.lo = __builtin_bit_cast(v4i_t, x); } __device__ __forceinline__ void set1(bf16x8 x) { v.hi = __builtin_bit_cast(v4i_t, x); } };
template <class Epi, class Sched, bool ALIGN_EPI = false, bool SP2 = false, int DT = 0>
__device__ __forceinline__ void gemm_phase(PG8_LAS unsigned char* lds, const Gemm g, const Sched& S, const Epi& E) {
    int tid_ = threadIdx.x; asm volatile("" : "+v"(tid_));
    const int tid = tid_, wid = __builtin_amdgcn_readfirstlane(tid >> 6), lane = tid & 63, wr = wid >> 2, wc = wid & 3, fr = lane & 15, fq = lane >> 4;
    const int K = g.K;
    unsigned voffA[2], voffB[2];
#pragma unroll
    for (int i = 0; i < 2; ++i) { int R, C; stage_rc(tid * 16 + i * 8192, R, C); const int Rb = Epi::PERM ? ((R & ~31) + perm32(R & 31)) : R;
        voffA[i] = (unsigned)(R * K + C) * 2u; voffB[i] = (unsigned)(Rb * K + C) * 2u; }
    const size_t kstep = (size_t)(BK * 2);
    const size_t hstep = (size_t)HALF * K * 2;
    const size_t tstep = 2 * hstep;
    const unsigned ldsw = (unsigned)wid * 1024u;
    const int aoff = lds_byte(wr * 64 + fr, fq * 8), boff = lds_byte(wc * 32 + fr, fq * 8);
#define PG8_SA(b, h) (((b) * 2 + (h)) * HTB)
#define PG8_SB(b, h) ((4 + (b) * 2 + (h)) * HTB)
#define PG8_STAGE(bufoff, gbase, voff) do { _Pragma("unroll") for (int _i = 0; _i < 2; ++_i) \
        __builtin_amdgcn_global_load_lds((const unsigned*)((const char*)(gbase) + (voff)[_i]), (PG8_LAS unsigned*)(lds + (bufoff) + ldsw + _i * 8192), 16, 0, 0); } while (0)
#define PG8_LDA(dst, b, h) do { _Pragma("unroll") for (int m = 0; m < 4; ++m) { dst[m].set0(*(const PG8_LAS bf16x8*)(lds + PG8_SA(b, h) + aoff + m * 2048)); dst[m].set1(*(const PG8_LAS bf16x8*)(lds + PG8_SA(b, h) + aoff + m * 2048 + 1024)); } } while (0)
#define PG8_LDB(dst, b, h) do { _Pragma("unroll") for (int n = 0; n < 2; ++n) { dst[n].set0(*(const PG8_LAS bf16x8*)(lds + PG8_SB(b, h) + boff + n * 2048)); dst[n].set1(*(const PG8_LAS bf16x8*)(lds + PG8_SB(b, h) + boff + n * 2048 + 1024)); } } while (0)
#define PG8_MMA(ai, bj, At, Bt) do { __builtin_amdgcn_s_setprio(1); _Pragma("unroll") for (int m = 0; m < 4; ++m) _Pragma("unroll") for (int n = 0; n < 2; ++n) { \
        if constexpr (DT == 1) asm volatile("v_mfma_f32_16x16x128_f8f6f4 %0, %1, %2, %0" : "+v"(acc[ai][bj][m][n]) : "v"(Bt[n].v), "v"(At[m].v));   \
        else if constexpr (DT == 2) { _Pragma("unroll") for (int k = 0; k < 2; ++k) acc[ai][bj][m][n] = __builtin_bit_cast(f32x4, __builtin_amdgcn_mfma_i32_16x16x64_i8(__builtin_bit_cast(v4i_t, Bt[n].h[k]), __builtin_bit_cast(v4i_t, At[m].h[k]), __builtin_bit_cast(v4i_t, acc[ai][bj][m][n]), 0, 0, 0)); } \
        else { _Pragma("unroll") for (int k = 0; k < 2; ++k) acc[ai][bj][m][n] = __builtin_amdgcn_mfma_f32_16x16x32_bf16(Bt[n].h[k], At[m].h[k], acc[ai][bj][m][n], 0, 0, 0); } } \
        __builtin_amdgcn_s_setprio(0); } while (0)
#define PG8_WAIT_V(n) asm volatile("s_waitcnt vmcnt(" #n ")" ::: "memory")
#define PG8_WAIT_L(n) asm volatile("s_waitcnt lgkmcnt(" #n ")" ::: "memory")
#define PG8_BAR __builtin_amdgcn_s_barrier()
#define PG8_SCHED __builtin_amdgcn_sched_barrier(0)
    Unit cur, nxt; int ui = 0;
    if (!S.next(0, cur)) return;
    f32x4 acc[2][2][4][2];
#pragma unroll
    for (int a = 0; a < 2; ++a)
#pragma unroll
        for (int b = 0; b < 2; ++b)
#pragma unroll
            for (int m = 0; m < 4; ++m)
#pragma unroll
                for (int n = 0; n < 2; ++n) acc[a][b][m][n] = (f32x4){0.f, 0.f, 0.f, 0.f};
    Frag<DT == 1> At[4], B0[2], B1[2];
    const char* cA = (const char*)g.A + (size_t)cur.pm * tstep + (size_t)cur.kt0 * kstep; const char* cB = (const char*)g.Bt + S.bt_off(cur) + (size_t)cur.pn * tstep + (size_t)cur.kt0 * kstep;
    S.a_ready(cur);
    if constexpr (SP2) {
        PG8_STAGE(PG8_SB(0, 0), cB, voffB); PG8_STAGE(PG8_SB(0, 1), cB + hstep, voffB); PG8_STAGE(PG8_SA(0, 0), cA, voffA); PG8_STAGE(PG8_SA(0, 1), cA + hstep, voffA);
        if (wr == 1) PG8_BAR;
        PG8_WAIT_V(2); PG8_BAR;
        PG8_STAGE(PG8_SB(1, 0), cB + kstep, voffB); PG8_STAGE(PG8_SA(1, 0), cA + kstep, voffA); PG8_STAGE(PG8_SB(1, 1), cB + hstep + kstep, voffB);
        PG8_WAIT_V(6); PG8_BAR;
    } else {
        PG8_STAGE(PG8_SB(0, 0), cB, voffB); PG8_STAGE(PG8_SA(0, 0), cA, voffA); PG8_STAGE(PG8_SB(0, 1), cB + hstep, voffB); PG8_STAGE(PG8_SA(0, 1), cA + hstep, voffA);
        if (wr == 1) PG8_BAR;
        PG8_WAIT_V(4); PG8_BAR;
        PG8_STAGE(PG8_SB(1, 0), cB + kstep, voffB); PG8_STAGE(PG8_SA(1, 0), cA + kstep, voffA); PG8_STAGE(PG8_SB(1, 1), cB + hstep + kstep, voffB);
        PG8_WAIT_V(6); PG8_BAR;
    }
    for (;;) {
        const bool has_next = S.next(ui + 1, nxt);
        const char* nA = has_next ? (const char*)g.A + (size_t)nxt.pm * tstep + (size_t)nxt.kt0 * kstep : cA; const char* nB = has_next ? (const char*)g.Bt + S.bt_off(nxt) + (size_t)nxt.pn * tstep + (size_t)nxt.kt0 * kstep : cB;
        const int nt = cur.nkt;
        for (int t = 0; t < nt; t += 2) {
            const bool last = (t == nt - 2);
            const char* a1 = cA + (size_t)(t + 1) * kstep;
            const char* a2 = last ? nA : cA + (size_t)(t + 2) * kstep; const char* b2 = last ? nB : cB + (size_t)(t + 2) * kstep;
            const char* a3 = a2 + kstep; const char* b3 = b2 + kstep;
            if (last && has_next) S.a_ready(nxt);
            if constexpr (SP2) {
            PG8_LDB(B0, 0, 0); PG8_LDB(B1, 0, 1); PG8_SCHED; PG8_LDA(At, 0, 0); PG8_STAGE(PG8_SA(1, 1), a1 + hstep, voffA);
            PG8_WAIT_V(8); PG8_WAIT_L(0); PG8_BAR; PG8_MMA(0, 0, At, B0); PG8_MMA(0, 1, At, B1); PG8_BAR; PG8_SCHED;
            PG8_LDA(At, 0, 1); PG8_STAGE(PG8_SB(0, 0), b2, voffB); PG8_STAGE(PG8_SB(0, 1), b2 + hstep, voffB); PG8_STAGE(PG8_SA(0, 0), a2, voffA);
            PG8_WAIT_V(8); PG8_WAIT_L(0); PG8_BAR; PG8_MMA(1, 0, At, B0); PG8_MMA(1, 1, At, B1); PG8_BAR; PG8_SCHED;
            PG8_LDB(B0, 1, 0); PG8_LDB(B1, 1, 1); PG8_SCHED; PG8_LDA(At, 1, 0); PG8_STAGE(PG8_SA(0, 1), a2 + hstep, voffA);
            PG8_WAIT_V(8); PG8_WAIT_L(0); PG8_BAR; PG8_MMA(0, 0, At, B0); PG8_MMA(0, 1, At, B1); PG8_BAR; PG8_SCHED;
            PG8_LDA(At, 1, 1); PG8_STAGE(PG8_SB(1, 0), b3, voffB); PG8_STAGE(PG8_SB(1, 1), b3 + hstep, voffB); PG8_STAGE(PG8_SA(1, 0), a3, voffA);
            PG8_WAIT_V(8); PG8_WAIT_L(0); PG8_BAR; PG8_MMA(1, 0, At, B0); PG8_MMA(1, 1, At, B1); PG8_BAR; PG8_SCHED;
            } else {
            PG8_LDB(B0, 0, 0); PG8_SCHED; PG8_LDA(At, 0, 0); PG8_STAGE(PG8_SA(1, 1), a1 + hstep, voffA);
            PG8_WAIT_L(8); PG8_BAR; PG8_WAIT_L(0); PG8_MMA(0, 0, At, B0); PG8_BAR; PG8_SCHED;
            PG8_LDB(B1, 0, 1); PG8_STAGE(PG8_SB(0, 0), b2, voffB);
            PG8_BAR; PG8_WAIT_L(0); PG8_MMA(0, 1, At, B1); PG8_BAR;
            PG8_LDA(At, 0, 1); PG8_STAGE(PG8_SA(0, 0), a2, voffA);
            PG8_BAR; PG8_WAIT_L(0); PG8_MMA(1, 0, At, B0); PG8_BAR; PG8_SCHED;
            PG8_STAGE(PG8_SB(0, 1), b2 + hstep, voffB);
            PG8_WAIT_V(6); PG8_BAR; PG8_MMA(1, 1, At, B1); PG8_BAR;
            PG8_LDB(B0, 1, 0); PG8_SCHED; PG8_LDA(At, 1, 0); PG8_STAGE(PG8_SA(0, 1), a2 + hstep, voffA);
            PG8_WAIT_L(8); PG8_BAR; PG8_WAIT_L(0); PG8_MMA(0, 0, At, B0); PG8_BAR; PG8_SCHED;
            PG8_LDB(B1, 1, 1); PG8_STAGE(PG8_SB(1, 0), b3, voffB);
            PG8_BAR; PG8_WAIT_L(0); PG8_MMA(0, 1, At, B1); PG8_BAR;
            PG8_LDA(At, 1, 1); PG8_STAGE(PG8_SA(1, 0), a3, voffA);
            PG8_BAR; PG8_WAIT_L(0); PG8_MMA(1, 0, At, B0); PG8_BAR; PG8_SCHED;
            PG8_STAGE(PG8_SB(1, 1), b3 + hstep, voffB);
            PG8_WAIT_V(6); PG8_BAR; PG8_MMA(1, 1, At, B1); PG8_BAR;
            }
        }
        if constexpr (ALIGN_EPI) { if (wr == 0) PG8_BAR; }
        if constexpr (DT == 1) asm volatile("s_nop 15\n\ts_nop 15" ::: "memory");
        if constexpr (!Epi::AFTER_DRAIN) { E(acc, cur, wr, wc, fr, fq); S.done(cur); }
        if (!has_next) break;
#pragma unroll
        for (int a = 0; a < 2; ++a)
#pragma unroll
            for (int b = 0; b < 2; ++b)
#pragma unroll
                for (int m = 0; m < 4; ++m)
#pragma unroll
                    for (int n = 0; n < 2; ++n) acc[a][b][m][n] = (f32x4){0.f, 0.f, 0.f, 0.f};
        cur = nxt; cA = nA; cB = nB; ++ui;
        if constexpr (ALIGN_EPI) { if (wr == 1) PG8_BAR; }
    }
    PG8_WAIT_V(0);
    if constexpr (!ALIGN_EPI) { if (wr == 0) PG8_BAR; }
    PG8_BAR;
    if constexpr (Epi::AFTER_DRAIN) { E.fused(acc, cur, wr, wc, fr, fq, lds, wid, lane); S.done(cur); }
#undef PG8_SA
#undef PG8_SB
#undef PG8_STAGE
#undef PG8_LDA
#undef PG8_LDB
#undef PG8_MMA
#undef PG8_WAIT_V
#undef PG8_WAIT_L
#undef PG8_BAR
#undef PG8_SCHED
}
}

namespace pg8 {
__device__ __forceinline__ u32x4 pack8(const f32x4 v0, const f32x4 v1) { u32x4 w; w.x = cvt_pk_bf16(v0[0], v0[1]); w.y = cvt_pk_bf16(v0[2], v0[3]); w.z = cvt_pk_bf16(v1[0], v1[1]); w.w = cvt_pk_bf16(v1[2], v1[3]); return w; }
struct EpiStore {
    static constexpr bool PERM = true, AFTER_DRAIN = false;
    bf16_t* O; int ldc;
    __device__ __forceinline__ void operator()(const f32x4 (&acc)[2][2][4][2], const Unit& u, int wr, int wc, int fr, int fq) const {
        const int row0 = u.pm * BM + wr * 64 + fr, col0 = u.pn * BM + wc * 32 + 8 * fq;
#pragma unroll
        for (int ai = 0; ai < 2; ++ai)
#pragma unroll
            for (int m = 0; m < 4; ++m) { bf16_t* rowp = O + (size_t)(row0 + ai * HALF + m * 16) * ldc + col0;
#pragma unroll
                for (int bj = 0; bj < 2; ++bj) *(u32x4*)(rowp + bj * HALF) = pack8(acc[ai][bj][m][0], acc[ai][bj][m][1]); }
    }
};
struct EpiQ {
    static constexpr bool PERM = true, AFTER_DRAIN = false;
    bf16_t* O; const float* cosT; const float* sinT;
    __device__ __forceinline__ void operator()(const f32x4 (&acc)[2][2][4][2], const Unit& u, int wr, int wc, int fr, int fq) const {
        const int row0 = u.pm * BM + wr * 64 + fr, col0 = u.pn * BM + wc * 32 + 8 * fq;
#pragma unroll
        for (int ai = 0; ai < 2; ++ai)
#pragma unroll
            for (int m = 0; m < 4; ++m) { const int row = row0 + ai * HALF + m * 16; const bool lat = row < 8192; const int t = row & 2047;
#pragma unroll
                for (int bj = 0; bj < 2; ++bj) { const int col = col0 + bj * HALF; const int jn = col - 192 * (col / 192);
                    f32x4 v0 = acc[ai][bj][m][0], v1 = acc[ai][bj][m][1];
                    if (jn >= 128 && lat) { const int i0 = (jn - 128) >> 1;
                        const f32x4 cs = *(const f32x4*)(cosT + t * 32 + i0), sn = *(const f32x4*)(sinT + t * 32 + i0);
                        f32x4 r0, r1;
                        r0[0] = v0[0] * cs[0] - v0[1] * sn[0]; r0[1] = v0[0] * sn[0] + v0[1] * cs[0];
                        r0[2] = v0[2] * cs[1] - v0[3] * sn[1]; r0[3] = v0[2] * sn[1] + v0[3] * cs[1];
                        r1[0] = v1[0] * cs[2] - v1[1] * sn[2]; r1[1] = v1[0] * sn[2] + v1[1] * cs[2];
                        r1[2] = v1[2] * cs[3] - v1[3] * sn[3]; r1[3] = v1[2] * sn[3] + v1[3] * cs[3];
                        v0 = r0; v1 = r1; }
                    *(u32x4*)(O + (size_t)row * 1536 + col) = pack8(v0, v1); } }
    }
};
__device__ __forceinline__ f32x4 bf4_lo(const u32x4 q) { return (f32x4){__uint_as_float(q.x << 16), __uint_as_float(q.x & 0xffff0000u), __uint_as_float(q.y << 16), __uint_as_float(q.y & 0xffff0000u)}; }
__device__ __forceinline__ f32x4 bf4_hi(const u32x4 q) { return (f32x4){__uint_as_float(q.z << 16), __uint_as_float(q.z & 0xffff0000u), __uint_as_float(q.w << 16), __uint_as_float(q.w & 0xffff0000u)}; }
struct EpiResid {
    static constexpr bool PERM = true, AFTER_DRAIN = false;
    bf16_t* xs; const float* rd_lat; const float* gate; bf16_t* slab; int tail_row0, tail_rows; float scale;
    __device__ __forceinline__ void operator()(const f32x4 (&acc)[2][2][4][2], const Unit& u, int wr, int wc, int fr, int fq) const {
        const int row0 = u.pm * BM + wr * 64 + fr, colb = u.pn * BM + wc * 32 + 8 * fq;
        if (u.slab >= 0) {
#pragma unroll
            for (int ai = 0; ai < 2; ++ai)
#pragma unroll
                for (int m = 0; m < 4; ++m) { bf16_t* sp = slab + ((size_t)u.slab * tail_rows + (row0 + ai * HALF + m * 16 - tail_row0)) * 2048;
#pragma unroll
                    for (int bj = 0; bj < 2; ++bj) *(u32x4*)(sp + colb + bj * HALF) = pack8(acc[ai][bj][m][0] * scale, acc[ai][bj][m][1] * scale); }
            return;
        }
#pragma unroll
        for (int ai = 0; ai < 2; ++ai)
#pragma unroll
            for (int m = 0; m < 4; ++m) { const int row = row0 + ai * HALF + m * 16; const float* gv = gate + (size_t)(row < 8192 ? (row >> 11) : 4) * 12288; bf16_t* xr = xs + (size_t)row * 2048;
#pragma unroll
                for (int bj = 0; bj < 2; ++bj) { const int col = colb + bj * HALF; f32x4 x0, x1;
                    if (rd_lat) { x0 = *(const f32x4*)(rd_lat + (size_t)row * 2048 + col); x1 = *(const f32x4*)(rd_lat + (size_t)row * 2048 + col + 4); }
                    else { const u32x4 q = *(const u32x4*)(xr + col); x0 = bf4_lo(q); x1 = bf4_hi(q); }
                    const f32x4 g0 = *(const f32x4*)(gv + col), g1 = *(const f32x4*)(gv + col + 4);
                    x0 += (g0 * scale) * acc[ai][bj][m][0]; x1 += (g1 * scale) * acc[ai][bj][m][1]; *(u32x4*)(xr + col) = pack8(x0, x1); }
                if (m & 1) asm volatile("" ::: "memory"); }
    }
};
__device__ __forceinline__ unsigned pack4_fp8(float a, float b, float c, float d) {
    a = __builtin_amdgcn_fmed3f(a, -448.f, 448.f); b = __builtin_amdgcn_fmed3f(b, -448.f, 448.f); c = __builtin_amdgcn_fmed3f(c, -448.f, 448.f); d = __builtin_amdgcn_fmed3f(d, -448.f, 448.f);
    unsigned w = 0; w = __builtin_amdgcn_cvt_pk_fp8_f32(a, b, w, false); w = __builtin_amdgcn_cvt_pk_fp8_f32(c, d, w, true); return w; }
struct EpiSwiGLU8 {
    static constexpr bool PERM = true, AFTER_DRAIN = false;
    unsigned char* O; int ldc; float s, oscale;
    __device__ __forceinline__ void operator()(const f32x4 (&acc)[2][2][4][2], const Unit& u, int wr, int wc, int fr, int fq) const {
        if (PROBE_SUB != 0u && O == nullptr) return;
        const int row0 = u.pm * BM + wr * 64 + fr, col0 = u.pn * HALF + wc * 32 + 8 * fq;
#pragma unroll
        for (int ai = 0; ai < 2; ++ai)
#pragma unroll
            for (int m = 0; m < 4; ++m) { f32x4 o0, o1;
#pragma unroll
                for (int j = 0; j < 4; ++j) { const float g0 = acc[ai][0][m][0][j] * s, g1 = acc[ai][0][m][1][j] * s;
                    o0[j] = g0 * __builtin_amdgcn_rcpf(1.0f + __expf(-g0)) * (acc[ai][1][m][0][j] * (s * oscale)); o1[j] = g1 * __builtin_amdgcn_rcpf(1.0f + __expf(-g1)) * (acc[ai][1][m][1][j] * (s * oscale)); }
                u32x2 w; w.x = pack4_fp8(o0[0], o0[1], o0[2], o0[3]); w.y = pack4_fp8(o1[0], o1[1], o1[2], o1[3]);
                *(u32x2*)(O + (size_t)(row0 + ai * HALF + m * 16) * ldc + col0) = w; }
    }
};
__device__ __forceinline__ f32x4 i2f4(const f32x4 bits) { const v4i_t iv = __builtin_bit_cast(v4i_t, bits); return (f32x4){(float)iv[0], (float)iv[1], (float)iv[2], (float)iv[3]}; }
struct EpiStoreI8 {
    static constexpr bool PERM = true, AFTER_DRAIN = false;
    bf16_t* O; int ldc; const float* rsc; float sw;
    __device__ __forceinline__ void operator()(const f32x4 (&acc)[2][2][4][2], const Unit& u, int wr, int wc, int fr, int fq) const {
        const int row0 = u.pm * BM + wr * 64 + fr, col0 = u.pn * BM + wc * 32 + 8 * fq;
#pragma unroll
        for (int ai = 0; ai < 2; ++ai)
#pragma unroll
            for (int m = 0; m < 4; ++m) { const int row = row0 + ai * HALF + m * 16; const float sc = rsc[row] * sw; bf16_t* rowp = O + (size_t)row * ldc + col0;
#pragma unroll
                for (int bj = 0; bj < 2; ++bj) *(u32x4*)(rowp + bj * HALF) = pack8(i2f4(acc[ai][bj][m][0]) * sc, i2f4(acc[ai][bj][m][1]) * sc); }
    }
};
struct EpiSwiGLUI8 {
    static constexpr bool PERM = true, AFTER_DRAIN = false;
    unsigned char* O; int ldc; const float* rsc; float swg, swu, oscale;
    __device__ __forceinline__ void operator()(const f32x4 (&acc)[2][2][4][2], const Unit& u, int wr, int wc, int fr, int fq) const {
        const int row0 = u.pm * BM + wr * 64 + fr, col0 = u.pn * HALF + wc * 32 + 8 * fq;
#pragma unroll
        for (int ai = 0; ai < 2; ++ai)
#pragma unroll
            for (int m = 0; m < 4; ++m) { const int row = row0 + ai * HALF + m * 16; const float sa = rsc[row], sg = sa * swg, su = sa * swu * oscale; f32x4 o0, o1;
                const f32x4 g0v = i2f4(acc[ai][0][m][0]) * sg, g1v = i2f4(acc[ai][0][m][1]) * sg, u0v = i2f4(acc[ai][1][m][0]) * su, u1v = i2f4(acc[ai][1][m][1]) * su;
#pragma unroll
                for (int j = 0; j < 4; ++j) { o0[j] = g0v[j] * __builtin_amdgcn_rcpf(1.0f + __expf(-g0v[j])) * u0v[j]; o1[j] = g1v[j] * __builtin_amdgcn_rcpf(1.0f + __expf(-g1v[j])) * u1v[j]; }
                u32x2 w; w.x = pack4_fp8(o0[0], o0[1], o0[2], o0[3]); w.y = pack4_fp8(o1[0], o1[1], o1[2], o1[3]);
                *(u32x2*)(O + (size_t)row * ldc + col0) = w; }
    }
};
struct EpiSwiGLU {
    static constexpr bool PERM = true, AFTER_DRAIN = false;
    bf16_t* O; int ldc;
    __device__ __forceinline__ void operator()(const f32x4 (&acc)[2][2][4][2], const Unit& u, int wr, int wc, int fr, int fq) const {
        const int row0 = u.pm * BM + wr * 64 + fr, col0 = u.pn * HALF + wc * 32 + 8 * fq;
#pragma unroll
        for (int ai = 0; ai < 2; ++ai)
#pragma unroll
            for (int m = 0; m < 4; ++m) { f32x4 o0, o1;
#pragma unroll
                for (int j = 0; j < 4; ++j) { const float g0 = acc[ai][0][m][0][j], g1 = acc[ai][0][m][1][j];
                    o0[j] = g0 / (1.0f + __expf(-g0)) * acc[ai][1][m][0][j]; o1[j] = g1 / (1.0f + __expf(-g1)) * acc[ai][1][m][1][j]; }
                *(u32x4*)(O + (size_t)(row0 + ai * HALF + m * 16) * ldc + col0) = pack8(o0, o1); }
    }
};
struct EpiF32 {
    static constexpr bool PERM = false, AFTER_DRAIN = false;
    float* O; int ldc; float* slab; int tail_row0, tail_rows; float scale;
    __device__ __forceinline__ void operator()(const f32x4 (&acc)[2][2][4][2], const Unit& u, int wr, int wc, int fr, int fq) const {
        const int row0 = u.pm * BM + wr * 64 + fr, colb = u.pn * BM + wc * 32 + 4 * fq;
#pragma unroll
        for (int ai = 0; ai < 2; ++ai)
#pragma unroll
            for (int m = 0; m < 4; ++m) { float* xr = (u.slab >= 0) ? slab + ((size_t)u.slab * tail_rows + (row0 + ai * HALF + m * 16 - tail_row0)) * 2048 : O + (size_t)(row0 + ai * HALF + m * 16) * ldc;
#pragma unroll
                for (int bj = 0; bj < 2; ++bj)
#pragma unroll
                    for (int n = 0; n < 2; ++n) *(f32x4*)(xr + colb + bj * HALF + n * 16) = acc[ai][bj][m][n] * scale; }
    }
};
struct EpiYs {
    static constexpr bool PERM = true, AFTER_DRAIN = false;
    bf16_t* O; bf16_t* slab; int tail_row0, tail_rows; float scale;
    __device__ __forceinline__ void operator()(const f32x4 (&acc)[2][2][4][2], const Unit& u, int wr, int wc, int fr, int fq) const {
        const int row0 = u.pm * BM + wr * 64 + fr, colb = u.pn * BM + wc * 32 + 8 * fq;
#pragma unroll
        for (int ai = 0; ai < 2; ++ai)
#pragma unroll
            for (int m = 0; m < 4; ++m) { const int row = row0 + ai * HALF + m * 16; bf16_t* xr = (u.slab >= 0) ? slab + ((size_t)u.slab * tail_rows + (row - tail_row0)) * 2048 : O + (size_t)row * 2048;
#pragma unroll
                for (int bj = 0; bj < 2; ++bj) *(u32x4*)(xr + colb + bj * HALF) = pack8(acc[ai][bj][m][0] * scale, acc[ai][bj][m][1] * scale); }
    }
};
struct MoeOrder {
    int nM, nN, nwg, G, c, nkt; int t1[8]; size_t estride;
    __device__ __forceinline__ void init(const int* ctl, int nN_, int G_, int c_, size_t estride_, int K) { nkt = K / BK;
        int acc = 0;
#pragma unroll
        for (int e = 0; e < 8; ++e) { acc += __builtin_amdgcn_readfirstlane(ctl[CT_EPAD + e]) >> 8; t1[e] = acc; }
        nM = acc; nN = nN_; nwg = nM * nN; G = G_; c = c_; estride = estride_;
    }
    __device__ __forceinline__ bool next(int i, Unit& u) const {
        const long L = (long)i * G + c; if (L >= nwg) return false;
        int wgid = (int)L; { const int q = nwg / NXCD, r = nwg % NXCD, xcd = wgid % NXCD, off = wgid / NXCD; wgid = (xcd < r ? xcd * (q + 1) : r * (q + 1) + (xcd - r) * q) + off; }
        const int nig = WGM * nN, gid = wgid / nig, fm = gid * WGM, gsz = (nM - fm) < WGM ? (nM - fm) : WGM;
        u.pm = fm + ((wgid % nig) % gsz); u.pn = (wgid % nig) / gsz; u.kt0 = 0; u.nkt = nkt; u.slab = -1; return true;
    }
    __device__ __forceinline__ size_t bt_off(const Unit& u) const { int e = 0;
#pragma unroll
        for (int k = 0; k < 7; ++k) e += (u.pm >= t1[k]) ? 1 : 0;
        return (size_t)e * estride; }
    __device__ __forceinline__ void a_ready(const Unit&) const {}
    __device__ __forceinline__ void done(const Unit&) const {}
};
struct WinLastOrder {
    StaticOrder so; int G, c;
    __device__ __forceinline__ void init(int G_, int c_, int K) { so.init(NLAT, UW, G_, c_, K); G = G_; c = c_; }
    __device__ __forceinline__ bool next(int i, Unit& u) const {
        if (so.next(i, u)) return true;
        const long L = (long)i * G + c - so.nwg; if (L < 0 || L >= 20) return false;
        const int j = (int)L, k = j % 5; u.pm = 32 + j / 5; u.pn = k < 3 ? 3 + k : 10 + k; u.kt0 = 0; u.nkt = so.nkt; u.slab = -1; return true;
    }
    __device__ __forceinline__ size_t bt_off(const Unit&) const { return 0; }
    __device__ __forceinline__ void a_ready(const Unit&) const {}
    __device__ __forceinline__ void done(const Unit&) const {}
};
struct SplitOrder {
    int nM, nN, nwg, G, c, nfull, ntail, S, nkt, nkts; int t1[8]; size_t estride;
    __device__ __forceinline__ void init(int nM_, int nN_, int G_, int c_, int K, int S_) {
        nM = nM_; nN = nN_; nwg = nM * nN; G = G_; c = c_; nkt = K / BK; nfull = (nwg / 256) * 256; ntail = nwg - nfull; S = S_; nkts = nkt / S; estride = 0;
#pragma unroll
        for (int e = 0; e < 8; ++e) t1[e] = 0;
    }
    __device__ __forceinline__ void init_moe(const int* ctl, int nN_, int G_, int c_, int K, size_t estride_) {
        int acc = 0;
#pragma unroll
        for (int e = 0; e < 8; ++e) { acc += __builtin_amdgcn_readfirstlane(ctl[CT_EPAD + e]) >> 8; t1[e] = acc; }
        init(acc, nN_, G_, c_, K, __builtin_amdgcn_readfirstlane(ctl[CT_MOES])); estride = estride_;
        acc = 0;
#pragma unroll
        for (int e = 0; e < 8; ++e) { acc += __builtin_amdgcn_readfirstlane(ctl[CT_EPAD + e]) >> 8; t1[e] = acc; }
    }
    __device__ __forceinline__ bool next(int i, Unit& u) const {
        const long L = (long)i * G + c; int wgid;
        if (L < nfull) { wgid = (int)L; { const int q = nfull / NXCD, xcd = wgid % NXCD, off = wgid / NXCD; wgid = xcd * q + off; } u.kt0 = 0; u.nkt = nkt; u.slab = -1; }
        else { const int j = (int)(L - nfull); if (j >= ntail * S) return false; const int tu = j / S, sl = j - tu * S; wgid = nfull + tu; u.kt0 = sl * nkts; u.nkt = nkts; u.slab = (S > 1) ? sl : -1; }
        const int nig = WGM * nN, gid = wgid / nig, fm = gid * WGM, gsz = (nM - fm) < WGM ? (nM - fm) : WGM;
        u.pm = fm + ((wgid % nig) % gsz); u.pn = (wgid % nig) / gsz; return true;
    }
    __device__ __forceinline__ size_t bt_off(const Unit& u) const { if (estride == 0) return 0; int e = 0;
#pragma unroll
        for (int k = 0; k < 7; ++k) e += (u.pm >= t1[k]) ? 1 : 0;
        return (size_t)e * estride; }
    __device__ __forceinline__ void a_ready(const Unit&) const {}
    __device__ __forceinline__ void done(const Unit&) const {}
};
__host__ __device__ constexpr int split_S(int nwg, int nkt, int G) {
    const int ntail = nwg - (nwg / G) * G;
    if (ntail == 0) return 1;
    if (nkt % 28 == 0 && ntail * 14 <= G) return 14;
    if (nkt % 16 == 0 && ntail * 8 <= G) return 8;
    if (nkt % 14 == 0 && ntail * 7 <= G) return 7;
    if (nkt % 8 == 0 && ntail * 4 <= G) return 4;
    if (nkt % 4 == 0 && ntail * 2 <= G) return 2;
    return 1;
}
}

#define LAS __attribute__((address_space(3)))
#define XB_TMO      128
#define XB_XCNT(j)  (256  + 64 * (j))
#define XB_XSUB(j)  (1280 + 64 * (j))
#define XB_XGEN(j)  (2304 + 64 * (j))
#define XB_TOP      3328
#define XB_TOPGEN   3392
#define XCD_BAR_WORDS 3456
#define XB_SPIN_CAP (1u << 18)

__device__ __forceinline__ unsigned xb_ld(unsigned* p)              { return __hip_atomic_load(p, __ATOMIC_RELAXED, __HIP_MEMORY_SCOPE_AGENT); }
__device__ __forceinline__ unsigned xb_add(unsigned* p, unsigned v) { return __hip_atomic_fetch_add(p, v, __ATOMIC_RELAXED, __HIP_MEMORY_SCOPE_AGENT); }
__device__ __forceinline__ unsigned xb_xcc_id() { return (unsigned)__builtin_amdgcn_s_getreg((3 << 11) | 20) & 0xFu; }
#define XB_SPIN(cond, bar) do { unsigned _sp = 0; while (cond) { __builtin_amdgcn_s_sleep(1); \
    if ((++_sp & 255u) == 0u) { if (xb_ld(&(bar)[XB_TMO])) break; if (_sp > XB_SPIN_CAP) { atomicAdd(&(bar)[XB_TMO], 1u); break; } } } } while (0)

struct XcdBarrier {
    unsigned* bar; unsigned x;
    volatile LAS unsigned* st;
};

__device__ __forceinline__ XcdBarrier xcd_barrier_post(unsigned* bar, volatile LAS unsigned* st) {
    XcdBarrier b; b.bar = bar; b.x = xb_xcc_id(); b.st = st;
    if (threadIdx.x == 0) (void)xb_add(&bar[XB_XCNT(b.x)], 1u);
    return b;
}
__device__ __forceinline__ void xcd_barrier_complete(unsigned* bar, unsigned x, unsigned& nloc, unsigned& nx) {
    const unsigned G = gridDim.x * gridDim.y * gridDim.z;
    unsigned sum, cnt, mine, sp = 0u;
    for (;;) {
        sum = 0u; cnt = 0u; mine = 0u;
#pragma unroll
        for (unsigned j = 0; j < 16; ++j) { const unsigned c = xb_ld(&bar[XB_XCNT(j)]); sum += c; cnt += (c > 0u) ? 1u : 0u; mine = (j == x) ? c : mine; }
        if (sum == G) break;
        __builtin_amdgcn_s_sleep(1);
        if ((++sp & 255u) == 0u) { if (xb_ld(&bar[XB_TMO])) break; if (sp > XB_SPIN_CAP) { atomicAdd(&bar[XB_TMO], 1u); break; } }
    }
    nloc = mine > 0u ? mine : 1u; nx = cnt > 0u ? cnt : 1u;
}

__device__ __forceinline__ void xcd_barrier(const XcdBarrier& b) {
    asm volatile("s_waitcnt vmcnt(0)" ::: "memory");
    __syncthreads();
    if (threadIdx.x == 0) {
        unsigned* bar = b.bar;
        __builtin_amdgcn_s_waitcnt(0);
        unsigned nloc = b.st[0], nx = b.st[1];
        if (nloc == 0u) { xcd_barrier_complete(bar, b.x, nloc, nx); b.st[0] = nloc; b.st[1] = nx; }
        const unsigned old = xb_add(&bar[XB_XSUB(b.x)], 1u);
        const unsigned gen = old / nloc;
        if (old + 1u == (gen + 1u) * nloc) {
            __builtin_amdgcn_fence(__ATOMIC_RELEASE, "agent");
            asm volatile("s_waitcnt vmcnt(0)" ::: "memory");
            const unsigned og = xb_add(&bar[XB_TOP], 1u);
            const unsigned tg = og / nx;
            if (og + 1u == (tg + 1u) * nx) xb_add(&bar[XB_TOPGEN], 1u);
            else XB_SPIN(xb_ld(&bar[XB_TOPGEN]) == tg, bar);
            __builtin_amdgcn_fence(__ATOMIC_ACQUIRE, "agent");
            xb_add(&bar[XB_XGEN(b.x)], 1u);
            asm volatile("s_waitcnt vmcnt(0)" ::: "memory");
        } else {
            XB_SPIN(xb_ld(&bar[XB_XGEN(b.x)]) == gen, bar);
            __builtin_amdgcn_fence(__ATOMIC_ACQUIRE, "agent");
            asm volatile("s_waitcnt vmcnt(0)" ::: "memory");
        }
    }
    __syncthreads();
}


struct Args { const float* in[34]; float* out; unsigned char* ws; int ph_lo, ph_hi; };

enum { MAP_ID = 0, MAP_ROPEQ = 1, MAP_GU0 = 2, MAP_GU1 = 3, MAP_KV = 4 };
struct JobDesc { int in_idx, K, N, nbatch, upb, map; long long src_off, src_bstride, dst_off, dst_bstride; int fp8, sidx; };
constexpr int NJOBS = 14, NCONV = 12664;
constexpr int G1_GEMM = CQ1 > 0 ? 184 : 256, G2_GEMM = CQ2 > 0 ? 232 : 256;
constexpr int TAIL1_BLK0 = 540 - 2 * G1_GEMM, TAIL1_N = G1_GEMM - TAIL1_BLK0, CONV1_N = 256 - G1_GEMM;
constexpr int TAIL2_BLK0 = 1584 - 6 * G2_GEMM, TAIL2_N = G2_GEMM - TAIL2_BLK0, CONV2_N = 256 - G2_GEMM;
constexpr int TAIL3_BLK0 = 64, TAIL3_N = 192, TAIL4_BLK0 = 32, TAIL4_N = 224;
constexpr int NCONV_T1 = TAIL1_N * TAILQ1 + CONV1_N * CQ1, NCONV_T2 = TAIL2_N * TAILQ2 + CONV2_N * CQ2, NCONV_T3 = TAIL3_N * TAILQ3, NCONV_T4 = TAIL4_N * TAILQ4, NCONV_Q = NCONV - NCONV_T1 - NCONV_T2 - NCONV_T3 - NCONV_T4;
static_assert(NCONV_Q % 2 == 0 && NCONV_Q >= 1912, "the prologue queue takes pairs; the tails only hold expert weights");
__constant__ JobDesc c_jobs[NJOBS] = {
    {8, 2048, 3648, 1, 232, MAP_ID, 0, 0, (long long)WS_WIN, 0, I8_WIN ? 2 : 0, 0},
    {8, 2048, 3648, 1, 232, MAP_ID, 2048LL * 3648, 0, (long long)(WS_WIN + (size_t)UW * D * 2), 0, I8_WIN ? 2 : 0, 1},
    {10, 768, 1536, 1, 36, MAP_ROPEQ, 0, 0, (long long)WS_WQ, 0},
    {10, 768, 1536, 1, 36, MAP_ROPEQ, 768LL * 1536, 0, (long long)(WS_WQ + (size_t)QW * 768 * 2), 0},
    {12, 512, 2048, 1, 32, MAP_KV, 0, 0, (long long)WS_WKV, 0},
    {12, 512, 2048, 1, 32, MAP_KV, 512LL * 2048, 0, (long long)(WS_WKV + (size_t)KVW * 512 * 2), 0},
    {25, 2048, 2048, 1, 128, MAP_ID, 0, 0, (long long)WS_WOUT, 0},
    {25, 2048, 2048, 1, 128, MAP_ID, 2048LL * 2048, 0, (long long)(WS_WOUT + (size_t)D * D * 2), 0},
    {26, 2048, 5632, 1, 352, MAP_GU0, 0, 0, (long long)WS_WGU, 0, I8_GU ? 2 : FP8_DENSE, 2},
    {27, 2048, 5632, 1, 352, MAP_GU1, 0, 0, (long long)WS_WGU, 0, I8_GU ? 2 : FP8_DENSE, 3},
    {28, 5632, 2048, 1, 352, MAP_ID, 0, 0, (long long)WS_WDN, 0, (FP8_DENSE || FP8_DOWN), 0},
    {30, 2048, 7168, 8, 448, MAP_GU0, 0, 2048LL * 7168, (long long)WS_MGU, 2LL * DFE * D, 1, 0},
    {31, 2048, 7168, 8, 448, MAP_GU1, 0, 2048LL * 7168, (long long)WS_MGU, 2LL * DFE * D, 1, 0},
    {32, 7168, 2048, 8, 448, MAP_ID, 0, 7168LL * 2048, (long long)WS_MDN, (long long)D * DFE, 1, 0},
};
struct ConvUnit { const float* src; bf16_t* dst; int K, N, map, k0, n0, fp8; float qs; };
__device__ __forceinline__ unsigned pack4_i8(float a, float b, float c, float d) {
    const int ia = (int)__builtin_rintf(__builtin_amdgcn_fmed3f(a, -127.f, 127.f)), ib = (int)__builtin_rintf(__builtin_amdgcn_fmed3f(b, -127.f, 127.f)), ic = (int)__builtin_rintf(__builtin_amdgcn_fmed3f(c, -127.f, 127.f)), id = (int)__builtin_rintf(__builtin_amdgcn_fmed3f(d, -127.f, 127.f));
    return (unsigned)(ia & 0xff) | ((unsigned)(ib & 0xff) << 8) | ((unsigned)(ic & 0xff) << 16) | ((unsigned)(id & 0xff) << 24); }
constexpr float WSCALE = 64.f, ASCALE = 8.f;
__device__ __forceinline__ void conv_decode(const Args& a, int u, ConvUnit& cu) {
    int j = 0, base = 0;
    for (;;) { const int n = c_jobs[j].nbatch * c_jobs[j].upb; if (u < base + n || j == NJOBS - 1) break; base += n; ++j; }
    const JobDesc& jd = c_jobs[j];
    int r = u - base; const int bt = r / jd.upb; r -= bt * jd.upb; const int ntn = (jd.N + 127) >> 7; int kt = r / ntn, nt = r - kt * ntn;
    if (((jd.K >> 8) & 1) == 0) { const int r2 = r >> 1; kt = 2 * (r2 / ntn) + (r & 1); nt = r2 % ntn; }
    cu.K = jd.K; cu.N = jd.N; cu.map = jd.map; cu.k0 = kt * 256; cu.n0 = nt * 128; cu.fp8 = jd.fp8; cu.qs = 1.0f;
    if (jd.fp8 == 2) { const float am = __uint_as_float(__hip_atomic_load((const unsigned*)(a.ws + WS_CTL) + CT_WSC + jd.sidx, __ATOMIC_RELAXED, __HIP_MEMORY_SCOPE_AGENT)); cu.qs = am > 0.f ? 127.0f / am : 0.f; }
    const float* sb = j < 2 ? a.in[8] : j < 4 ? a.in[10] : j < 6 ? a.in[12] : j < 8 ? a.in[25] : j == 8 ? a.in[26] : j == 9 ? a.in[27] : j == 10 ? a.in[28] : j == 11 ? a.in[30] : j == 12 ? a.in[31] : a.in[32];
    cu.src = sb + jd.src_off + (long long)bt * jd.src_bstride + (size_t)cu.k0 * jd.N + cu.n0;
    cu.dst = (bf16_t*)(a.ws + jd.dst_off + (long long)bt * jd.dst_bstride);
}
__device__ __forceinline__ int conv_row(int map, int n) {
    if (map == MAP_ID) return n;
    if (map == MAP_GU0) return ((n >> 7) << 8) + (n & 127);
    if (map == MAP_GU1) return ((n >> 7) << 8) + 128 + (n & 127);
    if (map == MAP_KV) { const int hh = n >> 8, jn = n & 255; return jn < 128 ? hh * 128 + jn : 1024 + hh * 128 + (jn - 128); }
    const int hh = n / 192, jn = n - hh * 192; if (jn < 128) return n; const int q = jn - 128; return hh * 192 + 128 + 2 * (q & 31) + (q >> 5);
}
constexpr int CV_P = 129, CV_BUF = 65536;
#define CONV_LOAD(R, CU) do { const bool ok_ = (CU).n0 + (tid & 31) * 4 < (CU).N; const float* sp_ = (CU).src + (size_t)((tid >> 5) * 16) * (CU).N + (tid & 31) * 4; \
        _Pragma("unroll") for (int i_ = 0; i_ < 16; ++i_) R[i_] = ok_ ? __builtin_nontemporal_load((const f32x4*)(sp_ + (size_t)i_ * (CU).N)) : (f32x4){0.f, 0.f, 0.f, 0.f}; } while (0)
__device__ __forceinline__ void conv_put(const f32x4 (&R)[16], const ConvUnit& cu, unsigned char* buf, int tid) {
    const int nq = tid & 31, kc = tid >> 5;
    if (cu.fp8 == 2) {
        const float qs = cu.qs;
#pragma unroll
        for (int c = 0; c < 4; ++c) { u32x4 w;
            w.x = pack4_i8(R[0][c] * qs, R[1][c] * qs, R[2][c] * qs, R[3][c] * qs); w.y = pack4_i8(R[4][c] * qs, R[5][c] * qs, R[6][c] * qs, R[7][c] * qs);
            w.z = pack4_i8(R[8][c] * qs, R[9][c] * qs, R[10][c] * qs, R[11][c] * qs); w.w = pack4_i8(R[12][c] * qs, R[13][c] * qs, R[14][c] * qs, R[15][c] * qs);
            *(u32x4*)(buf + (4 * nq + c) * 256 + ((kc ^ (nq & 15)) << 4)) = w; }
    } else if (cu.fp8) {
#pragma unroll
        for (int c = 0; c < 4; ++c) { u32x4 w;
            w.x = pg8::pack4_fp8(R[0][c] * WSCALE, R[1][c] * WSCALE, R[2][c] * WSCALE, R[3][c] * WSCALE); w.y = pg8::pack4_fp8(R[4][c] * WSCALE, R[5][c] * WSCALE, R[6][c] * WSCALE, R[7][c] * WSCALE);
            w.z = pg8::pack4_fp8(R[8][c] * WSCALE, R[9][c] * WSCALE, R[10][c] * WSCALE, R[11][c] * WSCALE); w.w = pg8::pack4_fp8(R[12][c] * WSCALE, R[13][c] * WSCALE, R[14][c] * WSCALE, R[15][c] * WSCALE);
            *(u32x4*)(buf + (4 * nq + c) * 256 + ((kc ^ (nq & 15)) << 4)) = w; }
    } else {
#pragma unroll
        for (int c = 0; c < 4; ++c) { u32x4 w0, w1;
            w0.x = pg8::cvt_pk_bf16(R[0][c], R[1][c]); w0.y = pg8::cvt_pk_bf16(R[2][c], R[3][c]); w0.z = pg8::cvt_pk_bf16(R[4][c], R[5][c]); w0.w = pg8::cvt_pk_bf16(R[6][c], R[7][c]);
            w1.x = pg8::cvt_pk_bf16(R[8][c], R[9][c]); w1.y = pg8::cvt_pk_bf16(R[10][c], R[11][c]); w1.z = pg8::cvt_pk_bf16(R[12][c], R[13][c]); w1.w = pg8::cvt_pk_bf16(R[14][c], R[15][c]);
            *(u32x4*)(buf + (4 * nq + c) * 512 + (((2 * kc) ^ nq) << 4)) = w0; *(u32x4*)(buf + (4 * nq + c) * 512 + (((2 * kc + 1) ^ nq) << 4)) = w1; }
    }
}
__device__ __forceinline__ void conv_out(const ConvUnit& cur, const unsigned char* buf, int tid) {
    if (cur.fp8) {
#pragma unroll
        for (int j = 0; j < 4; ++j) { const int nl = (tid >> 4) + 32 * j, ch = tid & 15;
            if (cur.n0 + nl < cur.N) { const int row = conv_row(cur.map, cur.n0 + nl); const u32x4 w = *(const u32x4*)(buf + nl * 256 + ((ch ^ ((nl >> 2) & 15)) << 4));
                *(u32x4*)((unsigned char*)cur.dst + (size_t)row * cur.K + cur.k0 + ch * 16) = w; } }
    } else {
#pragma unroll
        for (int j = 0; j < 8; ++j) { const int nl = (tid >> 5) + 16 * j, ch = tid & 31;
            if (cur.n0 + nl < cur.N) { const int row = conv_row(cur.map, cur.n0 + nl); const u32x4 w = *(const u32x4*)(buf + nl * 512 + ((ch ^ ((nl >> 2) & 31)) << 4));
                *(u32x4*)((unsigned char*)cur.dst + ((size_t)row * cur.K + cur.k0) * 2 + ch * 16) = w; } }
    }
}
template <int MODE = 0>
__device__ __forceinline__ void ph_convert(const Args& a, float* tile, int first, int stride, int end) {
    const int tid = threadIdx.x; unsigned char* buf = (unsigned char*)tile;
    int u = first; ConvUnit cuA, cuB; f32x4 rA[16], rB[16];
#pragma unroll
    for (int i = 0; i < 16; ++i) { rA[i] = (f32x4){0.f, 0.f, 0.f, 0.f}; rB[i] = rA[i]; }
    if (u < end) { conv_decode(a, u, cuA); if (MODE != 2) CONV_LOAD(rA, cuA); }
    if (u + stride < end) { conv_decode(a, u + stride, cuB); if (MODE != 2) CONV_LOAD(rB, cuB); }
    while (u < end) {
        conv_put(rA, cuA, buf, tid);
        __syncthreads();
        { const ConvUnit cur = cuA; const int un = u + 2 * stride; if (un < end) { conv_decode(a, un, cuA); if (MODE != 2) CONV_LOAD(rA, cuA); } if (MODE != 1) conv_out(cur, buf, tid); }
        u += stride; if (u >= end) break;
        conv_put(rB, cuB, buf + CV_BUF, tid);
        __syncthreads();
        { const ConvUnit cur = cuB; const int un = u + 2 * stride; if (un < end) { conv_decode(a, un, cuB); if (MODE != 2) CONV_LOAD(rB, cuB); } if (MODE != 1) conv_out(cur, buf + CV_BUF, tid); }
        u += stride;
    }
    __syncthreads();
}
constexpr int CT_QNEXT = 1152;
template <int MODE = 0>
__device__ __forceinline__ void conv_dynamic(const Args& a, float* tile) {
    unsigned* qn = (unsigned*)(a.ws + WS_CTL) + CT_QNEXT; volatile int* bc = (volatile int*)(tile + 256 * CV_P + 4);
    const int tid = threadIdx.x;
    if (tid == 0) { bc[0] = (int)__hip_atomic_fetch_add(qn, 1u, __ATOMIC_RELAXED, __HIP_MEMORY_SCOPE_AGENT); bc[1] = (int)__hip_atomic_fetch_add(qn, 1u, __ATOMIC_RELAXED, __HIP_MEMORY_SCOPE_AGENT); }
    __syncthreads();
    int q = bc[0], qN = bc[1];
    __syncthreads();
    ConvUnit cuA, cuB; f32x4 rA[16], rB[16];
#pragma unroll
    for (int i = 0; i < 16; ++i) { rA[i] = (f32x4){0.f, 0.f, 0.f, 0.f}; rB[i] = rA[i]; }
    if (2 * q < NCONV_Q) { conv_decode(a, 2 * q, cuA); if (MODE != 2) CONV_LOAD(rA, cuA); }
    if (2 * q + 1 < NCONV_Q) { conv_decode(a, 2 * q + 1, cuB); if (MODE != 2) CONV_LOAD(rB, cuB); }
    unsigned char* buf = (unsigned char*)tile;
    while (2 * q < NCONV_Q) {
        const bool hasB = 2 * q + 1 < NCONV_Q;
        conv_put(rA, cuA, buf, tid);
        __syncthreads();
        { const ConvUnit cur = cuA; if (2 * qN < NCONV_Q) { conv_decode(a, 2 * qN, cuA); if (MODE != 2) CONV_LOAD(rA, cuA); }
          if (tid == 0) bc[0] = (int)__hip_atomic_fetch_add(qn, 1u, __ATOMIC_RELAXED, __HIP_MEMORY_SCOPE_AGENT);
          if (MODE != 1) conv_out(cur, buf, tid); }
        if (hasB) {
            conv_put(rB, cuB, buf + CV_BUF, tid);
            __syncthreads();
            { const ConvUnit cur = cuB; if (2 * qN + 1 < NCONV_Q) { conv_decode(a, 2 * qN + 1, cuB); if (MODE != 2) CONV_LOAD(rB, cuB); }
              if (MODE != 1) conv_out(cur, buf + CV_BUF, tid); }
        } else __syncthreads();
        q = qN; qN = bc[0];
    }
    __syncthreads();
}
#undef CONV_LOAD
constexpr int CONV_STATIC = 856, CONV_DENSE_END = 1912, CONV_BATCH = 2;
__device__ __forceinline__ constexpr int CT_DONE(int k) { return 1216 + 64 * k; }
__device__ __forceinline__ void conv_fill(const Args& a, float* tile, int done_idx) {
#if !CONV_FILL
    (void)a; (void)tile; (void)done_idx; return;
#endif
    unsigned* ctl = (unsigned*)(a.ws + WS_CTL); volatile int* bc = (volatile int*)(tile + 256 * CV_P + 4);
    const int tid = threadIdx.x;
    if (tid == 0) (void)__hip_atomic_fetch_add(ctl + CT_DONE(done_idx), 1u, __ATOMIC_RELAXED, __HIP_MEMORY_SCOPE_AGENT);
    for (;;) {
        if (tid == 0) { int q = -1;
            if (__hip_atomic_load(ctl + CT_DONE(done_idx), __ATOMIC_RELAXED, __HIP_MEMORY_SCOPE_AGENT) < gridDim.x) {
                q = (int)__hip_atomic_fetch_add(ctl + CT_QNEXT, (unsigned)CONV_BATCH, __ATOMIC_RELAXED, __HIP_MEMORY_SCOPE_AGENT) + CONV_STATIC; if (q >= NCONV) q = -1; }
            *bc = q; }
        __syncthreads();
        const int q = *bc;
        __syncthreads();
        if (q < 0) break;
        ph_convert(a, tile, q, 1, (q + CONV_BATCH < NCONV) ? q + CONV_BATCH : NCONV);
    }
}
__device__ __forceinline__ void conv_finish(const Args& a, float* tile, int upto) {
#if !CONV_FILL
    (void)a; (void)tile; (void)upto; return;
#endif
    unsigned* ctl = (unsigned*)(a.ws + WS_CTL); volatile int* bc = (volatile int*)(tile + 256 * CV_P + 4);
    const int tid = threadIdx.x;
    for (;;) {
        if (tid == 0) { int q = -1;
            if ((int)__hip_atomic_load(ctl + CT_QNEXT, __ATOMIC_RELAXED, __HIP_MEMORY_SCOPE_AGENT) + CONV_STATIC < upto) {
                q = (int)__hip_atomic_fetch_add(ctl + CT_QNEXT, (unsigned)CONV_BATCH, __ATOMIC_RELAXED, __HIP_MEMORY_SCOPE_AGENT) + CONV_STATIC; if (q >= NCONV) q = -1; }
            *bc = q; }
        __syncthreads();
        const int q = *bc;
        __syncthreads();
        if (q < 0) break;
        ph_convert(a, tile, q, 1, (q + CONV_BATCH < NCONV) ? q + CONV_BATCH : NCONV);
    }
}
__device__ __forceinline__ void adaln_unit(const Args& a, int unit, float* sm) {
    const float* c = a.in[1]; const float* cctx = a.in[3]; const float* w_mod = a.in[4]; const float* b_mod = a.in[5]; float* mod = (float*)(a.ws + WS_MOD);
    const int tid = threadIdx.x, l = unit / 96, chunk = unit - l * 96;
    const int cg = tid & 31, ks = tid >> 5;
    for (int i = tid; i < 5 * 2048; i += 512) { const int v = i >> 11, k = i & 2047; const float val = v < 4 ? c[v * 2048 + k] : cctx[k]; sm[i] = val / (1.0f + __expf(-val)); }
    __syncthreads();
    float acc[5][4];
#pragma unroll
    for (int v = 0; v < 5; ++v)
#pragma unroll
        for (int j = 0; j < 4; ++j) acc[v][j] = 0.f;
    const float* wp = w_mod + ((size_t)l * 2048 + (size_t)ks * 128) * 12288 + chunk * 128 + cg * 4;
    for (int kb = 0; kb < 128; kb += 16) {
        f32x4 w[16];
#pragma unroll
        for (int kk = 0; kk < 16; ++kk) w[kk] = __builtin_nontemporal_load((const f32x4*)(wp + (size_t)(kb + kk) * 12288));
#pragma unroll
        for (int kk = 0; kk < 16; ++kk) { const int k = ks * 128 + kb + kk;
#pragma unroll
            for (int v = 0; v < 5; ++v) { const float s = sm[v * 2048 + k];
#pragma unroll
                for (int j = 0; j < 4; ++j) acc[v][j] += s * w[kk][j]; } }
    }
    __syncthreads();
#pragma unroll
    for (int v = 0; v < 5; ++v)
#pragma unroll
        for (int j = 0; j < 4; ++j) sm[(ks * 5 + v) * 128 + cg * 4 + j] = acc[v][j];
    __syncthreads();
    for (int o = tid; o < 640; o += 512) {
        const int v = o >> 7, cc = o & 127; float s = 0.f;
#pragma unroll
        for (int k2 = 0; k2 < 16; ++k2) s += sm[(k2 * 5 + v) * 128 + cc];
        mod[((size_t)l * 5 + v) * 12288 + chunk * 128 + cc] = s + b_mod[(size_t)l * 12288 + chunk * 128 + cc];
    }
    __syncthreads();
}
constexpr int FW_W1 = 0, FW_W2 = 2112, FW_W3 = 6208, FW_B1 = 10304, FW_B2 = 10368, FW_B3 = 10432, FW_FR = 10496, FW_ZS = 10560, FW_HA = 10848, FW_HB = 11360, FW_END = 11872;
__device__ __forceinline__ void filters_unit(const Args& a, int l, int r, float* sm) {
    float (*zs)[36] = (float (*)[36])(sm + FW_ZS); float (*ha)[64] = (float (*)[64])(sm + FW_HA); float (*hb)[64] = (float (*)[64])(sm + FW_HB);
    const int tid = threadIdx.x;
    const bool lat = r < 256; const int Lf = lat ? 2048 : 256; const int p0 = lat ? r * 8 : (r - 256) * 8;
    float* T = (float*)(a.ws + WS_FILTC) + (size_t)l * 512 * 512;
    const float* wf = a.in[21] + (size_t)l * 64 * 1024;
    const int p = tid >> 6, j = tid & 63; const int pos = p0 + p;
    const float tn = (float)pos / (float)(Lf - 1);
    if (j < 33) {
        float z;
        if (j == 0) z = tn;
        else { const int bi = (j - 1) & 15; const float band = 1e-4f + (float)bi * ((15.0f - 1e-4f) / 15.0f);
               const float ang = (6.283185307179586f / (float)Lf) * (float)pos * band; z = (j <= 16) ? __cosf(ang) : -__sinf(ang); }
        zs[p][j] = z;
    }
    __syncthreads();
    const float f = sm[FW_FR + j];
    { float s = sm[FW_B1 + j];
#pragma unroll
      for (int i = 0; i < 33; ++i) s += zs[p][i] * sm[FW_W1 + i * 64 + j];
      ha[p][j] = __sinf(f * s); }
    __syncthreads();
    { float s = sm[FW_B2 + j];
#pragma unroll 16
      for (int i = 0; i < 64; ++i) s += ha[p][i] * sm[FW_W2 + i * 64 + j];
      hb[p][j] = __sinf(f * s); }
    __syncthreads();
    { float s = sm[FW_B3 + j];
#pragma unroll 16
      for (int i = 0; i < 64; ++i) s += hb[p][i] * sm[FW_W3 + i * 64 + j];
      ha[p][j] = __sinf(f * s); }
    __syncthreads();
    float acc[2][8];
#pragma unroll
    for (int rr = 0; rr < 2; ++rr)
#pragma unroll
        for (int q = 0; q < 8; ++q) acc[rr][q] = 0.f;
    for (int ib = 0; ib < 64; ib += 16) {
        float wa[16], wb[16];
#pragma unroll
        for (int i = 0; i < 16; ++i) { wa[i] = wf[(ib + i) * 1024 + tid]; wb[i] = wf[(ib + i) * 1024 + 512 + tid]; }
#pragma unroll
        for (int i = 0; i < 16; ++i) {
#pragma unroll
            for (int q = 0; q < 8; ++q) { const float h = ha[q][ib + i]; acc[0][q] += h * wa[i]; acc[1][q] += h * wb[i]; } }
    }
    const int ch = tid;
    const float delta = 3.0701134573253944f + (float)ch * ((15.350567286626972f - 3.0701134573253944f) / 511.0f);
#pragma unroll
    for (int q = 0; q < 8; ++q) {
        const int ps = p0 + q; const float dec = __expf(-((float)ps / (float)(Lf - 1)) * delta);
        const float vf = acc[0][q] * dec, vb = acc[1][q] * dec;
        if (lat) { bf16_t* RBp = (bf16_t*)(a.ws + WS_FILTL) + ((size_t)l * 512 + ch) * HY_RBROW; RBp[2048 - ps] = f2bf(vf); if (ps > 0) RBp[2048 + ps] = f2bf(vb); }
        else { T[(size_t)ch * (2 * Lf) + Lf + ps] = vf; if (ps > 0) T[(size_t)ch * (2 * Lf) + Lf - ps] = vb; else T[(size_t)ch * (2 * Lf)] = 0.f; }
    }
    __syncthreads();
}
__device__ __forceinline__ void ph_filters(const Args& a, float* sm, int fb, int nfb) {
    const int tid = threadIdx.x;
    for (int l = 0; l < 2; ++l) {
        for (int i = tid; i < 2112; i += NTHR) sm[FW_W1 + i] = a.in[15][l * 2112 + i];
        for (int i = tid; i < 4096; i += NTHR) { sm[FW_W2 + i] = a.in[17][l * 4096 + i]; sm[FW_W3 + i] = a.in[19][l * 4096 + i]; }
        if (tid < 64) { sm[FW_B1 + tid] = a.in[16][l * 64 + tid]; sm[FW_B2 + tid] = a.in[18][l * 64 + tid]; sm[FW_B3 + tid] = a.in[20][l * 64 + tid]; sm[FW_FR + tid] = a.in[22][l * 64 + tid]; }
        __syncthreads();
        for (int r = fb; r < 288; r += nfb) filters_unit(a, l, r, sm);
        __syncthreads();
    }
}
#define SUBREP(b) for (int srep_ = 0; srep_ <= (int)((PROBE_SUB >> (b)) & 1u); ++srep_)
__device__ __forceinline__ void ph_absmax(const Args& a, float* sm) {
    unsigned* ctl = (unsigned*)(a.ws + WS_CTL); const int tid = threadIdx.x, G = gridDim.x, bid = blockIdx.x, lane = tid & 63, w = tid >> 6;
#pragma unroll
    for (int j = (I8_WIN ? 0 : 2); j < (I8_GU ? 4 : 2); ++j) {
        const f32x4* p4 = (const f32x4*)(j == 0 ? a.in[8] : j == 1 ? a.in[8] + (size_t)2048 * 3648 : j == 2 ? a.in[26] : a.in[27]);
        const int n4 = (j < 2 ? 2048 * 3648 : 2048 * 5632) / 4, step = G * 512;
        float mm = 0.f;
        for (int i0 = bid * 512 + tid; i0 < n4; i0 += step * 8) {
            f32x4 v[8];
#pragma unroll
            for (int u = 0; u < 8; ++u) { const int i = i0 + u * step; v[u] = i < n4 ? __builtin_nontemporal_load(p4 + i) : (f32x4){0.f, 0.f, 0.f, 0.f}; }
#pragma unroll
            for (int u = 0; u < 8; ++u) mm = fmaxf(mm, fmaxf(fmaxf(fabsf(v[u][0]), fabsf(v[u][1])), fmaxf(fabsf(v[u][2]), fabsf(v[u][3]))));
        }
        mm = wave_max(mm);
        if (lane == 0) sm[w] = mm;
        __syncthreads();
        if (tid == 0) { float t = sm[0];
#pragma unroll
            for (int k = 1; k < 8; ++k) t = fmaxf(t, sm[k]);
            (void)__hip_atomic_fetch_max(ctl + CT_WSC + j, __float_as_uint(t), __ATOMIC_RELAXED, __HIP_MEMORY_SCOPE_AGENT); }
        __syncthreads();
    }
    if (tid == 0) (void)__hip_atomic_fetch_add(ctl + CT_AMAXDONE, 1u, __ATOMIC_RELAXED, __HIP_MEMORY_SCOPE_AGENT);
}
__device__ __forceinline__ void ph_prologue(const Args& a, float* sm) {
    const int bid = blockIdx.x, G = gridDim.x, tid = threadIdx.x;
    const int NF = G >= 128 ? 64 : 0;
    if (I8_GEMM) ph_absmax(a, sm);
    if (NF == 0) { SUBREP(4) for (int u = bid; u < 192; u += G) adaln_unit(a, u, sm); SUBREP(5) ph_filters(a, sm, bid, G); }
    else if (bid < NF) { SUBREP(5) ph_filters(a, sm, bid, NF); }
    else { SUBREP(4) for (int u = bid - NF; u < 192; u += G - NF) adaln_unit(a, u, sm); }
    { float* cosT = (float*)(a.ws + WS_ROPE); float* sinT = cosT + 2048 * 32;
      for (int i = bid * 512 + tid; i < 2048 * 32; i += G * 512) { const int t = i >> 5, f = i & 31;
          const float pos = (float)((f < 16) ? (t >> 6) : (t & 63)); const float freq = powf(10000.0f, -(float)(f & 15) / 16.0f); const float ang = pos * freq;
          cosT[i] = cosf(ang); sinT[i] = sinf(ang); } }
    for (int i = bid * 512 + tid; i < 2 * 512 * 17; i += G * 512) { const int row = i / 17, k = i - row * 17; ((bf16_t*)(a.ws + WS_FILTL))[(size_t)row * HY_RBROW + (k == 0 ? 0 : 4095 + k)] = 0; }
    { constexpr int RB16 = I8_WIN ? 128 : 256;
      for (int i = bid * 512 + tid; i < 2 * 192 * RB16; i += G * 512) { const int l = i / (192 * RB16), r = i % (192 * RB16);
        *(u32x4*)(a.ws + WS_WIN + (size_t)l * UW * D * 2 + (size_t)INW * RB16 * 16 + (size_t)r * 16) = (u32x4){0u, 0u, 0u, 0u}; } }
    if (I8_GEMM) {
        if (tid == 0) { const unsigned* dn = (const unsigned*)(a.ws + WS_CTL) + CT_AMAXDONE; unsigned sp = 0;
            while (__hip_atomic_load(dn, __ATOMIC_RELAXED, __HIP_MEMORY_SCOPE_AGENT) < (unsigned)G && ++sp < (1u << 22)) __builtin_amdgcn_s_sleep(4); }
    }
    __syncthreads();
    if ((PROBE_SUB >> 8) & 1u) ph_convert<2>(a, sm, bid, G, NCONV);
    if (!((PROBE_SUB >> 11) & 1u) || bid < 64) conv_dynamic<0>(a, sm);
    if (G != 256) ph_convert<0>(a, sm, NCONV_Q + bid, G, NCONV);
    if ((PROBE_SUB >> 6) & 1u) ph_convert<0>(a, sm, bid, G, NCONV);
    if ((PROBE_SUB >> 7) & 1u) ph_convert<1>(a, sm, bid, G, NCONV);
}

__device__ __forceinline__ f32x4 ld4bf(const bf16_t* p) { const u32x2 q = *(const u32x2*)p; return (f32x4){__uint_as_float(q.x << 16), __uint_as_float(q.x & 0xffff0000u), __uint_as_float(q.y << 16), __uint_as_float(q.y & 0xffff0000u)}; }
template <bool ROUTER, bool COPYX, int OUT8 = 0, int NSLAB = 0, bool XLB = true, bool XCB = true>
__device__ __forceinline__ void ph_normmod(const void* __restrict__ xlat, const void* __restrict__ xctx, const float* __restrict__ gain, const float* __restrict__ modl, int sh_off, int sc_off,
                                           bf16_t* __restrict__ out, int nrows, bf16_t* __restrict__ xs, const float* __restrict__ router, int* __restrict__ topi, float* __restrict__ topw,
                                           const bf16_t* __restrict__ slab = nullptr, const float* __restrict__ slab_gate = nullptr, float* __restrict__ rsc = nullptr, float* rl = nullptr) {
    const int lane = threadIdx.x & 63, wid = threadIdx.x >> 6;
    if (ROUTER) {
        for (int idx = threadIdx.x; idx < 4096; idx += NTHR) { const int col = idx >> 1, h = idx & 1, i = col >> 8, ln = (col & 255) >> 2, j = col & 3;
            *(f32x4*)(rl + ((((i * 4 + j) * 2 + h) * 64 + ln) << 2)) = *(const f32x4*)(router + (size_t)idx * 4); }
        __syncthreads();
    }
    for (int row = blockIdx.x * 8 + wid; row < nrows; row += gridDim.x * 8) {
        const bool lat = row < NLAT; const size_t xoff = lat ? (size_t)row * D : (size_t)(row - NLAT) * D;
        const float* mv = modl + (size_t)tok_mod(row) * 12288;
        f32x4 v[8]; float ss = 0.f;
#pragma unroll
        for (int i = 0; i < 8; ++i) { const int cl = i * 256 + lane * 4;
            if (lat) { if (XLB) { const u32x2 q = *(const u32x2*)((const bf16_t*)xlat + xoff + cl); v[i] = (f32x4){__uint_as_float(q.x << 16), __uint_as_float(q.x & 0xffff0000u), __uint_as_float(q.y << 16), __uint_as_float(q.y & 0xffff0000u)}; }
                       else v[i] = *(const f32x4*)((const float*)xlat + xoff + cl); }
            else { if (XCB) { const u32x2 q = *(const u32x2*)((const bf16_t*)xctx + xoff + cl); v[i] = (f32x4){__uint_as_float(q.x << 16), __uint_as_float(q.x & 0xffff0000u), __uint_as_float(q.y << 16), __uint_as_float(q.y & 0xffff0000u)}; }
                   else v[i] = *(const f32x4*)((const float*)xctx + xoff + cl); }
            if (NSLAB > 0 && row >= NLAT) { f32x4 sa = ld4bf(slab + (size_t)(row - NLAT) * D + i * 256 + lane * 4);
#pragma unroll
                for (int sl = 1; sl < NSLAB; ++sl) sa += ld4bf(slab + ((size_t)sl * NCTX + (row - NLAT)) * D + i * 256 + lane * 4);
                v[i] += *(const f32x4*)(slab_gate + i * 256 + lane * 4) * sa; }
            ss += v[i][0] * v[i][0] + v[i][1] * v[i][1] + v[i][2] * v[i][2] + v[i][3] * v[i][3];
            if (COPYX && (NSLAB == 0 || row >= NLAT)) { u32x2 w; w.x = pg8::cvt_pk_bf16(v[i][0], v[i][1]); w.y = pg8::cvt_pk_bf16(v[i][2], v[i][3]); *(u32x2*)(xs + (size_t)row * D + i * 256 + lane * 4) = w; } }
        ss = wave_sum(ss);
        const float rstd = rsqrtf(ss * (1.0f / D) + EPS);
        float lg[8];
#pragma unroll
        for (int e = 0; e < 8; ++e) lg[e] = 0.f;
        float amax = 0.f;
#pragma unroll
        for (int i = 0; i < 8; ++i) {
            const int col = i * 256 + lane * 4;
            const f32x4 g = *(const f32x4*)(gain + col), sc = *(const f32x4*)(mv + sc_off + col), sh = *(const f32x4*)(mv + sh_off + col);
            f32x4 o;
#pragma unroll
            for (int j = 0; j < 4; ++j) o[j] = (v[i][j] * rstd * g[j]) * (1.0f + sc[j]) + sh[j];
            if (OUT8 == 2) { v[i] = o; amax = fmaxf(amax, fmaxf(fmaxf(fabsf(o[0]), fabsf(o[1])), fmaxf(fabsf(o[2]), fabsf(o[3])))); }
            else if (OUT8 == 1) *(unsigned*)((unsigned char*)out + (size_t)row * D + col) = pg8::pack4_fp8(o[0] * ASCALE, o[1] * ASCALE, o[2] * ASCALE, o[3] * ASCALE);
            else { u32x2 w; w.x = (unsigned)f2bf(o[0]) | ((unsigned)f2bf(o[1]) << 16); w.y = (unsigned)f2bf(o[2]) | ((unsigned)f2bf(o[3]) << 16);
                *(u32x2*)(out + (size_t)row * D + col) = w; }
            if (ROUTER) v[i] = o;
        }
        if (ROUTER) {
#pragma unroll
            for (int i = 0; i < 8; ++i) {
#pragma unroll
                for (int j = 0; j < 4; ++j) { const f32x4 r0 = *(const f32x4*)(rl + ((((i * 4 + j) * 2 + 0) * 64 + lane) << 2)), r1 = *(const f32x4*)(rl + ((((i * 4 + j) * 2 + 1) * 64 + lane) << 2));
                    lg[0] += v[i][j] * r0[0]; lg[1] += v[i][j] * r0[1]; lg[2] += v[i][j] * r0[2]; lg[3] += v[i][j] * r0[3];
                    lg[4] += v[i][j] * r1[0]; lg[5] += v[i][j] * r1[1]; lg[6] += v[i][j] * r1[2]; lg[7] += v[i][j] * r1[3]; }
                if (i & 1) __builtin_amdgcn_sched_barrier(0);
            }
        }
        if (OUT8 == 2) {
            amax = wave_max(amax); const float qs = amax > 0.f ? 127.0f / amax : 0.f;
#pragma unroll
            for (int i = 0; i < 8; ++i) *(unsigned*)((unsigned char*)out + (size_t)row * D + i * 256 + lane * 4) = pack4_i8(v[i][0] * qs, v[i][1] * qs, v[i][2] * qs, v[i][3] * qs);
            if (lane == 0) rsc[row] = amax * (1.0f / 127.0f);
        }
        if (ROUTER) {
#pragma unroll
            for (int e = 0; e < 8; ++e) lg[e] = wave_sum(lg[e]);
            if (lane == 0) {
                int i0 = 0; float v0 = lg[0];
#pragma unroll
                for (int e = 1; e < 8; ++e) if (lg[e] > v0) { v0 = lg[e]; i0 = e; }
                int i1 = -1; float v1 = -3.0e38f;
#pragma unroll
                for (int e = 0; e < 8; ++e) if (e != i0 && lg[e] > v1) { v1 = lg[e]; i1 = e; }
                const float e1 = expf(v1 - v0), w0 = 1.0f / (1.0f + e1), w1 = e1 / (1.0f + e1);
                topi[row * 2] = i0; topi[row * 2 + 1] = i1; topw[row * 2] = w0; topw[row * 2 + 1] = w1;
            }
        }
    }
}

__device__ __forceinline__ float bflo(unsigned w) { return __uint_as_float(w << 16); }
__device__ __forceinline__ float bfhi(unsigned w) { return __uint_as_float(w & 0xffff0000u); }
__device__ __forceinline__ unsigned pkbf(float lo, float hi) { return (unsigned)f2bf(lo) | ((unsigned)f2bf(hi) << 16); }
__device__ __forceinline__ u32x4 rope8(const u32x4 mine, const u32x4 other, bool is_x2, const f32x4 c0, const f32x4 c1, const f32x4 s0, const f32x4 s1) {
    const unsigned mw[4] = {mine.x, mine.y, mine.z, mine.w}, ow[4] = {other.x, other.y, other.z, other.w};
    const float cs[8] = {c0[0], c0[1], c0[2], c0[3], c1[0], c1[1], c1[2], c1[3]}, sn[8] = {s0[0], s0[1], s0[2], s0[3], s1[0], s1[1], s1[2], s1[3]};
    unsigned o[4];
#pragma unroll
    for (int d = 0; d < 4; ++d) {
        const float m0 = bflo(mw[d]), m1 = bfhi(mw[d]), p0 = bflo(ow[d]), p1 = bfhi(ow[d]);
        const float r0 = is_x2 ? (p0 * sn[2 * d] + m0 * cs[2 * d]) : (m0 * cs[2 * d] - p0 * sn[2 * d]);
        const float r1 = is_x2 ? (p1 * sn[2 * d + 1] + m1 * cs[2 * d + 1]) : (m1 * cs[2 * d + 1] - p1 * sn[2 * d + 1]);
        o[d] = pkbf(r0, r1);
    }
    return (u32x4){o[0], o[1], o[2], o[3]};
}
__device__ __forceinline__ u32x4 shfl4(const u32x4 v, int m) { return (u32x4){(unsigned)__shfl_xor((int)v.x, m), (unsigned)__shfl_xor((int)v.y, m), (unsigned)__shfl_xor((int)v.z, m), (unsigned)__shfl_xor((int)v.w, m)}; }
__device__ __forceinline__ void ph_mid(const Args& a, int l) {
    const bf16_t* __restrict__ U = (const bf16_t*)(a.ws + WS_U);
    const float* g_q = a.in[9] + l * 768; const float* g_kv = a.in[11] + l * 512; const float* conv_w = a.in[13] + (size_t)l * 3 * 1536; const float* conv_b = a.in[14] + l * 1536;
    const float* cosT = (const float*)(a.ws + WS_ROPE); const float* sinT = cosT + 2048 * 32;
    bf16_t* cqn = (bf16_t*)(a.ws + WS_CQN); bf16_t* ckvn = (bf16_t*)(a.ws + WS_CKVN); bf16_t* kpe = (bf16_t*)(a.ws + WS_KPE); bf16_t* x0o = (bf16_t*)(a.ws + WS_X0);
    bf16_t* wtl = (bf16_t*)(a.ws + WS_WTL); bf16_t* wtc = (bf16_t*)(a.ws + WS_WTC); bf16_t* sq = (bf16_t*)(a.ws + WS_SQ); bf16_t* sk = (bf16_t*)(a.ws + WS_SK); bf16_t* sv = (bf16_t*)(a.ws + WS_SV);
    int tid_ = threadIdx.x; asm volatile("" : "+v"(tid_));
    const int tid = tid_, lane = tid & 63, wid = tid >> 6;
    for (int unit = blockIdx.x; unit < NTOK / 16; unit += gridDim.x) {
        const int tok0 = unit * 16;
        for (int tt = 0; tt < 2; ++tt) {
            const int tok = tok0 + wid * 2 + tt; const bool lat = tok < NLAT; const int t = lat ? (tok & 2047) : ((tok - NLAT) & 255);
            const bf16_t* u = U + (size_t)tok * UW;
            const u32x2 q0 = *(const u32x2*)(u + O_CQ + lane * 12), q1 = *(const u32x2*)(u + O_CQ + lane * 12 + 4), q2 = *(const u32x2*)(u + O_CQ + lane * 12 + 8);
            const u32x4 kvv = *(const u32x4*)(u + O_CKV + lane * 8);
            const u32x4 sqv = *(const u32x4*)(u + O_SQ + lane * 8);
            const u32x4 skv = *(const u32x4*)(u + O_SK + (lane & 15) * 8);
            const u32x4 kpv = *(const u32x4*)(u + O_KPE + (lane & 7) * 8);
            const int i0 = (lane & 3) * 8;
            f32x4 c0 = (f32x4){1.f, 1.f, 1.f, 1.f}, c1 = c0, s0 = (f32x4){0.f, 0.f, 0.f, 0.f}, s1 = s0;
            if (lat) { c0 = *(const f32x4*)(cosT + t * 32 + i0); c1 = *(const f32x4*)(cosT + t * 32 + i0 + 4); s0 = *(const f32x4*)(sinT + t * 32 + i0); s1 = *(const f32x4*)(sinT + t * 32 + i0 + 4); }
            {
                const unsigned w6[6] = {q0.x, q0.y, q1.x, q1.y, q2.x, q2.y}; float x[12]; float ss = 0.f;
#pragma unroll
                for (int d = 0; d < 6; ++d) { x[2 * d] = bflo(w6[d]); x[2 * d + 1] = bfhi(w6[d]); ss += x[2 * d] * x[2 * d] + x[2 * d + 1] * x[2 * d + 1]; }
                ss = wave_sum(ss); const float rs = rsqrtf(ss * (1.0f / 768.0f) + EPS);
                const f32x4 g0 = *(const f32x4*)(g_q + lane * 12), g1 = *(const f32x4*)(g_q + lane * 12 + 4), g2 = *(const f32x4*)(g_q + lane * 12 + 8);
                u32x2 o0, o1, o2;
                o0.x = pkbf(x[0] * rs * g0[0], x[1] * rs * g0[1]); o0.y = pkbf(x[2] * rs * g0[2], x[3] * rs * g0[3]);
                o1.x = pkbf(x[4] * rs * g1[0], x[5] * rs * g1[1]); o1.y = pkbf(x[6] * rs * g1[2], x[7] * rs * g1[3]);
                o2.x = pkbf(x[8] * rs * g2[0], x[9] * rs * g2[1]); o2.y = pkbf(x[10] * rs * g2[2], x[11] * rs * g2[3]);
                bf16_t* dst = cqn + (size_t)tok * 768 + lane * 12; *(u32x2*)dst = o0; *(u32x2*)(dst + 4) = o1; *(u32x2*)(dst + 8) = o2;
            }
            {
                const unsigned w4[4] = {kvv.x, kvv.y, kvv.z, kvv.w}; float x[8]; float ss = 0.f;
#pragma unroll
                for (int d = 0; d < 4; ++d) { x[2 * d] = bflo(w4[d]); x[2 * d + 1] = bfhi(w4[d]); ss += x[2 * d] * x[2 * d] + x[2 * d + 1] * x[2 * d + 1]; }
                ss = wave_sum(ss); const float rs = rsqrtf(ss * (1.0f / 512.0f) + EPS);
                const f32x4 g0 = *(const f32x4*)(g_kv + lane * 8), g1 = *(const f32x4*)(g_kv + lane * 8 + 4);
                u32x4 o; o.x = pkbf(x[0] * rs * g0[0], x[1] * rs * g0[1]); o.y = pkbf(x[2] * rs * g0[2], x[3] * rs * g0[3]); o.z = pkbf(x[4] * rs * g1[0], x[5] * rs * g1[1]); o.w = pkbf(x[6] * rs * g1[2], x[7] * rs * g1[3]);
                *(u32x4*)(ckvn + (size_t)tok * 512 + lane * 8) = o;
            }
            const bool is_x2 = (lane & 4) != 0;
            {
                const u32x4 r = rope8(sqv, shfl4(sqv, 4), is_x2, c0, c1, s0, s1);
                *(u32x4*)(sq + (size_t)tok * 512 + lane * 8) = r;
            }
            {
                const u32x4 r = rope8(skv, shfl4(skv, 4), is_x2, c0, c1, s0, s1);
                if (lane < 16) *(u32x4*)(sk + (size_t)tok * 128 + lane * 8) = r;
            }
            {
                const u32x4 ot = shfl4(kpv, 4);
                if (lane < 4) {
                    const unsigned mw[4] = {kpv.x, kpv.y, kpv.z, kpv.w}, ow[4] = {ot.x, ot.y, ot.z, ot.w};
                    const float cs[8] = {c0[0], c0[1], c0[2], c0[3], c1[0], c1[1], c1[2], c1[3]}, sn[8] = {s0[0], s0[1], s0[2], s0[3], s1[0], s1[1], s1[2], s1[3]};
                    unsigned o[8];
#pragma unroll
                    for (int d = 0; d < 4; ++d) { const float a0 = bflo(mw[d]), a1 = bfhi(mw[d]), b0 = bflo(ow[d]), b1 = bfhi(ow[d]);
                        o[2 * d] = pkbf(a0 * cs[2 * d] - b0 * sn[2 * d], a0 * sn[2 * d] + b0 * cs[2 * d]);
                        o[2 * d + 1] = pkbf(a1 * cs[2 * d + 1] - b1 * sn[2 * d + 1], a1 * sn[2 * d + 1] + b1 * cs[2 * d + 1]); }
                    bf16_t* dst = kpe + (size_t)tok * 64 + lane * 16;
                    *(u32x4*)dst = (u32x4){o[0], o[1], o[2], o[3]}; *(u32x4*)(dst + 8) = (u32x4){o[4], o[5], o[6], o[7]};
                }
            }
        }
        {
            const bool lat = tok0 < NLAT; const int Ls = lat ? L : C;
            const int b = lat ? (tok0 >> 11) : ((tok0 - NLAT) >> 8), t0 = (lat ? (tok0 & 2047) : ((tok0 - NLAT) & 255));
            const int cp = tid & 255, hf = tid >> 8, ch = cp * 2, ts = t0 + hf * 8, tokb = tok0 + hf * 8;
            float cw[3][3][2], cb[3][2];
#pragma unroll
            for (int g = 0; g < 3; ++g) { cb[g][0] = conv_b[g * 512 + ch]; cb[g][1] = conv_b[g * 512 + ch + 1];
#pragma unroll
                for (int j = 0; j < 3; ++j) { cw[g][j][0] = conv_w[j * 1536 + g * 512 + ch]; cw[g][j][1] = conv_w[j * 1536 + g * 512 + ch + 1]; } }
            unsigned rows[3][10];
#pragma unroll
            for (int r = 0; r < 10; ++r) { const int tr = ts - 1 + r; const bool ok = tr >= 0 && tr < Ls;
#pragma unroll
                for (int g = 0; g < 3; ++g) rows[g][r] = ok ? *(const unsigned*)(U + (size_t)(tokb - 1 + r) * UW + O_HY + g * 512 + ch) : 0u; }
            unsigned wp0[4], wp1[4];
#pragma unroll
            for (int i = 0; i < 8; ++i) {
                float y[3][2];
#pragma unroll
                for (int g = 0; g < 3; ++g) {
                    y[g][0] = cb[g][0] + cw[g][0][0] * bflo(rows[g][i]) + cw[g][1][0] * bflo(rows[g][i + 1]) + cw[g][2][0] * bflo(rows[g][i + 2]);
                    y[g][1] = cb[g][1] + cw[g][0][1] * bfhi(rows[g][i]) + cw[g][1][1] * bfhi(rows[g][i + 1]) + cw[g][2][1] * bfhi(rows[g][i + 2]); }
                *(unsigned*)(x0o + (size_t)(tokb + i) * 512 + ch) = pkbf(y[0][0], y[0][1]);
                const unsigned w0 = f2bf(y[2][0] * y[1][0]), w1 = f2bf(y[2][1] * y[1][1]);
                if (i & 1) { wp0[i >> 1] |= w0 << 16; wp1[i >> 1] |= w1 << 16; } else { wp0[i >> 1] = w0; wp1[i >> 1] = w1; }
            }
            bf16_t* wt = lat ? wtl + ((size_t)b * 512 + ch) * L + ts : wtc + ((size_t)b * 512 + ch) * C + ts;
            *(u32x4*)wt = (u32x4){wp0[0], wp0[1], wp0[2], wp0[3]};
            *(u32x4*)(wt + (lat ? L : C)) = (u32x4){wp1[0], wp1[1], wp1[2], wp1[3]};
        }
        if (tid < 128) {
            unsigned pk[8];
#pragma unroll
            for (int i = 0; i < 16; ++i) { const unsigned v = U[(size_t)(tok0 + i) * UW + O_SV + tid]; if (i & 1) pk[i >> 1] |= v << 16; else pk[i >> 1] = v; }
            bf16_t* dst = sv + (size_t)tid * NTOK + tok0;
            u32x4 w0, w1; w0.x = pk[0]; w0.y = pk[1]; w0.z = pk[2]; w0.w = pk[3]; w1.x = pk[4]; w1.y = pk[5]; w1.z = pk[6]; w1.w = pk[7];
            *(u32x4*)dst = w0; *(u32x4*)(dst + 8) = w1;
        }
    }
}

__device__ __forceinline__ void ph_mla_naive(const Args& a, int nq, float* sm) {
    const bf16_t* __restrict__ Q = (const bf16_t*)(a.ws + WS_Q); const bf16_t* __restrict__ KV = (const bf16_t*)(a.ws + WS_KV); const bf16_t* __restrict__ KPE = (const bf16_t*)(a.ws + WS_KPE);
    bf16_t* mix = (bf16_t*)(a.ws + WS_MIX);
    const int lane = threadIdx.x & 63, w = threadIdx.x >> 6;
    float* qf = sm + w * 192; float* sc = sm + 8 * 192 + w * 2304;
    for (int unit = blockIdx.x; unit < nq; unit += gridDim.x) {
        const int h = unit & 7, qt = (unit >> 3) * 8 + w; const bool lat = qt < NLAT;
        const int b = lat ? (qt >> 11) : ((qt - NLAT) >> 8);
        const int nk = lat ? (L + C) : C;
        for (int i = lane; i < 192; i += 64) qf[i] = bf2f(Q[(size_t)qt * QW + h * 192 + i]);
        __syncthreads();
        const float scale = 0.07216878364870322f;
        float mx = -3.0e38f;
        for (int kc = 0; kc < nk; kc += 64) {
            const int kk = kc + lane;
            const int kt = lat ? (kk < L ? b * L + kk : NLAT + b * C + (kk - L)) : (NLAT + b * C + kk);
            float s = 0.f;
            const u32x4* kp = (const u32x4*)(KV + (size_t)kt * KVW + h * 256);
            for (int i = 0; i < 16; ++i) { const u32x4 v = kp[i]; const float* q8 = qf + i * 8;
                s += q8[0] * __uint_as_float(v.x << 16) + q8[1] * __uint_as_float(v.x & 0xffff0000u) + q8[2] * __uint_as_float(v.y << 16) + q8[3] * __uint_as_float(v.y & 0xffff0000u)
                   + q8[4] * __uint_as_float(v.z << 16) + q8[5] * __uint_as_float(v.z & 0xffff0000u) + q8[6] * __uint_as_float(v.w << 16) + q8[7] * __uint_as_float(v.w & 0xffff0000u); }
            const u32x4* pp = (const u32x4*)(KPE + (size_t)kt * 64);
            for (int i = 0; i < 8; ++i) { const u32x4 v = pp[i]; const float* q8 = qf + 128 + i * 8;
                s += q8[0] * __uint_as_float(v.x << 16) + q8[1] * __uint_as_float(v.x & 0xffff0000u) + q8[2] * __uint_as_float(v.y << 16) + q8[3] * __uint_as_float(v.y & 0xffff0000u)
                   + q8[4] * __uint_as_float(v.z << 16) + q8[5] * __uint_as_float(v.z & 0xffff0000u) + q8[6] * __uint_as_float(v.w << 16) + q8[7] * __uint_as_float(v.w & 0xffff0000u); }
            s *= scale; sc[kk] = s; mx = fmaxf(mx, s);
        }
        mx = wave_max(mx);
        float sum = 0.f;
        for (int kc = 0; kc < nk; kc += 64) { const float p = expf(sc[kc + lane] - mx); sc[kc + lane] = p; sum += p; }
        sum = wave_sum(sum);
        __syncthreads();
        float o0 = 0.f, o1 = 0.f;
        for (int kk = 0; kk < nk; ++kk) {
            const int kt = lat ? (kk < L ? b * L + kk : NLAT + b * C + (kk - L)) : (NLAT + b * C + kk);
            const unsigned v = *(const unsigned*)(KV + (size_t)kt * KVW + h * 256 + 128 + lane * 2);
            const float p = sc[kk];
            o0 += p * __uint_as_float(v << 16); o1 += p * __uint_as_float(v & 0xffff0000u);
        }
        const float inv = 1.0f / sum;
        *(unsigned*)(mix + (size_t)qt * D + h * 128 + lane * 2) = (unsigned)f2bf(o0 * inv) | ((unsigned)f2bf(o1 * inv) << 16);
        __syncthreads();
    }
}
__device__ __forceinline__ void ph_swa_naive(const Args& a, int l, int nq, float* sm) {
    const bf16_t* __restrict__ SQ = (const bf16_t*)(a.ws + WS_SQ); const bf16_t* __restrict__ SK = (const bf16_t*)(a.ws + WS_SK); const bf16_t* __restrict__ SV = (const bf16_t*)(a.ws + WS_SV);
    const float* sink = a.in[24] + l * 8; bf16_t* mix = (bf16_t*)(a.ws + WS_MIX);
    const int lane = threadIdx.x & 63, w = threadIdx.x >> 6;
    float* qf = sm + w * 64; float* sc = sm + 8 * 64 + w * 576; int* kts = (int*)(sm + 8 * 64 + 8 * 576) + w * 576;
    for (int unit = blockIdx.x; unit < nq; unit += gridDim.x) {
        const int hq = unit & 7, hk = hq >> 2, qt = (unit >> 3) * 8 + w; const bool lat = qt < NLAT;
        const int b = lat ? (qt >> 11) : ((qt - NLAT) >> 8), t = lat ? (qt & 2047) : 0;
        int lo = 0, nloc = 0;
        if (lat) { lo = t - 128 < 0 ? 0 : t - 128; const int hi = t + 128 > L - 1 ? L - 1 : t + 128; nloc = hi - lo + 1; }
        const int nk = nloc + C;
        qf[lane] = bf2f(SQ[(size_t)qt * 512 + hq * 64 + lane]);
        __syncthreads();
        const float skv = sink[hq];
        float mx = skv;
        for (int kc = 0; kc < nk; kc += 64) {
            const int kk = kc + lane;
            if (kk < nk) {
                const int kt = kk < nloc ? (b * L + lo + kk) : (NLAT + b * C + (kk - nloc));
                const u32x4* kp = (const u32x4*)(SK + (size_t)kt * 128 + hk * 64);
                float s = 0.f;
                for (int i = 0; i < 8; ++i) { const u32x4 v = kp[i]; const float* q8 = qf + i * 8;
                    s += q8[0] * __uint_as_float(v.x << 16) + q8[1] * __uint_as_float(v.x & 0xffff0000u) + q8[2] * __uint_as_float(v.y << 16) + q8[3] * __uint_as_float(v.y & 0xffff0000u)
                       + q8[4] * __uint_as_float(v.z << 16) + q8[5] * __uint_as_float(v.z & 0xffff0000u) + q8[6] * __uint_as_float(v.w << 16) + q8[7] * __uint_as_float(v.w & 0xffff0000u); }
                s *= 0.125f; sc[kk] = s; kts[kk] = kt; mx = fmaxf(mx, s);
            }
        }
        mx = wave_max(mx);
        float sum = 0.f;
        for (int kc = 0; kc < nk; kc += 64) { const int kk = kc + lane; if (kk < nk) { const float p = expf(sc[kk] - mx); sc[kk] = p; sum += p; } }
        sum = wave_sum(sum) + expf(skv - mx);
        __syncthreads();
        float o = 0.f;
        for (int kk = 0; kk < nk; ++kk) o += sc[kk] * bf2f(SV[(size_t)kts[kk] * 128 + hk * 64 + lane]);
        mix[(size_t)qt * D + 1536 + hq * 64 + lane] = f2bf(o / sum);
        __syncthreads();
    }
}
template <int LS>
__device__ __forceinline__ void ph_hyena_naive(const Args& a, int l, float* sm) {
    const float* filt = LS == L ? (const float*)(a.ws + WS_FILTL) + (size_t)l * 512 * 4096 : (const float*)(a.ws + WS_FILTC) + (size_t)l * 512 * 512;
    const bf16_t* wt = (const bf16_t*)(a.ws + (LS == L ? WS_WTL : WS_WTC)); const bf16_t* x0 = (const bf16_t*)(a.ws + WS_X0); const float* skip = a.in[23] + l * 512;
    bf16_t* mix = (bf16_t*)(a.ws + WS_MIX); const int tok_base = LS == L ? 0 : NLAT;
    float* T = sm; float* ws = sm + 2 * LS; const int tid = threadIdx.x;
    for (int unit = blockIdx.x; unit < 512 * NB; unit += gridDim.x) {
        const int ch = unit >> 2, b = unit & 3;
        for (int i = tid; i < 2 * LS; i += NTHR) T[i] = filt[(size_t)ch * 2 * LS + i];
        for (int i = tid; i < LS; i += NTHR) ws[i] = bf2f(wt[((size_t)b * 512 + ch) * LS + i]);
        __syncthreads();
        const float sk = skip[ch];
        for (int t = tid; t < LS; t += NTHR) {
            float y = 0.f;
            for (int s = 0; s < LS; ++s) y += T[t - s + LS] * ws[s];
            ((bf16_t*)(a.ws + WS_YT))[(LS == L ? (size_t)0 : (size_t)NB * 512 * L) + ((size_t)b * 512 + ch) * LS + t] = f2bf(y);
        }
        __syncthreads();
    }
}
__device__ __forceinline__ void ph_route_gather(const Args& a, int* sm) {
    const int* __restrict__ topi = (const int*)(a.ws + WS_TOPI); int* __restrict__ pos = (int*)(a.ws + WS_POS); int* ctl = (int*)(a.ws + WS_CTL);
    const unsigned char* __restrict__ hb = (const unsigned char*)(a.ws + WS_HA); unsigned char* __restrict__ hbs = (unsigned char*)(a.ws + WS_HBS);
    int (*cnt)[512] = (int (*)[512])sm; int* tot = sm + 8 * 512; int* ppos = sm + 8 * 512 + 16;
    const int tid = threadIdx.x, lane = tid & 63, w = tid >> 6;
    int c[8];
#pragma unroll
    for (int e = 0; e < 8; ++e) c[e] = 0;
    for (int i = 0; i < 32; i += 4) { const u32x4 e4 = *(const u32x4*)(topi + tid * 32 + i);
#pragma unroll
        for (int q = 0; q < 8; ++q) c[q] += (e4.x == (unsigned)q) + (e4.y == (unsigned)q) + (e4.z == (unsigned)q) + (e4.w == (unsigned)q); }
#pragma unroll
    for (int e = 0; e < 8; ++e) cnt[e][tid] = c[e];
    __syncthreads();
    {
        int v[8]; int s8 = 0;
#pragma unroll
        for (int k = 0; k < 8; ++k) { v[k] = cnt[w][lane * 8 + k]; s8 += v[k]; }
        int incl = s8;
#pragma unroll
        for (int off = 1; off < 64; off <<= 1) { const int t = __shfl_up(incl, off); if (lane >= off) incl += t; }
        int run = incl - s8;
#pragma unroll
        for (int k = 0; k < 8; ++k) { cnt[w][lane * 8 + k] = run; run += v[k]; }
        if (lane == 63) tot[w] = incl;
    }
    __syncthreads();
    int eoff[8]; int o = 0;
#pragma unroll
    for (int e = 0; e < 8; ++e) { eoff[e] = o; o += (tot[e] + 255) & ~255; }
    if (blockIdx.x == 0 && tid == 0) {
#pragma unroll
        for (int e = 0; e < 8; ++e) { ctl[CT_EOFF + e] = eoff[e]; ctl[CT_EPAD + e] = (tot[e] + 255) & ~255; }
        ctl[CT_NTILE] = o >> 8; const int nwg = (o >> 8) * (D / 256); ctl[CT_MOES] = pg8::split_S(nwg, DFE / 128, 256); ctl[CT_TROW] = (nwg / 256) * 256 / (D / 256) * 256;
    }
    for (int tg = blockIdx.x; tg < NLAT / 32; tg += gridDim.x) {
        if (tid < 64) {
            const int idx = 64 * tg + tid, owner = idx >> 5, e = topi[idx]; int p = 0;
#pragma unroll
            for (int q = 0; q < 8; ++q) { const unsigned long long mk = __ballot(e == q);
                if (e == q) { const unsigned hm = (unsigned)(mk >> (32 * (tid >> 5))); p = eoff[q] + cnt[q][owner] + __popc(hm & ((1u << (tid & 31)) - 1u)); } }
            pos[idx] = p; ppos[tid] = p;
        }
        __syncthreads();
#pragma unroll
        for (int k = 0; k < 4; ++k) { const int tl = 4 * w + k; const int tok = 32 * tg + tl;
            const u32x4 v0 = *(const u32x4*)(hb + (size_t)tok * D + lane * 32), v1 = *(const u32x4*)(hb + (size_t)tok * D + lane * 32 + 16);
            const int p0 = ppos[2 * tl], p1 = ppos[2 * tl + 1];
            *(u32x4*)(hbs + (size_t)p0 * D + lane * 32) = v0; *(u32x4*)(hbs + (size_t)p0 * D + lane * 32 + 16) = v1;
            *(u32x4*)(hbs + (size_t)p1 * D + lane * 32) = v0; *(u32x4*)(hbs + (size_t)p1 * D + lane * 32 + 16) = v1; }
        __syncthreads();
    }
}
__device__ __forceinline__ void ph_final(const Args& a) {
    const bf16_t* xs = (const bf16_t*)(a.ws + WS_XS); const bf16_t* ys = (const bf16_t*)(a.ws + WS_YS); const int* pos = (const int*)(a.ws + WS_POS); const float* topw = (const float*)(a.ws + WS_TOPW);
    const float* modl = (const float*)(a.ws + WS_MOD) + (size_t)5 * 12288; const float* gfin = a.in[33]; float* out = a.out;
    const int lane = threadIdx.x & 63, wid = threadIdx.x >> 6;
    const int* ctl = (const int*)(a.ws + WS_CTL); const int nsl = ctl[CT_MOES], trow0 = ctl[CT_TROW], trows = ctl[CT_NTILE] * 256 - trow0; const bf16_t* slab = (const bf16_t*)(a.ws + WS_SLAB);
    for (int row = blockIdx.x * 8 + wid; row < NLAT; row += gridDim.x * 8) {
        const float* g2 = modl + (size_t)tok_mod(row) * 12288 + 10240;
        const int p0 = pos[row * 2], p1 = pos[row * 2 + 1]; const float w0 = topw[row * 2], w1 = topw[row * 2 + 1];
        const bool t0 = nsl > 1 && p0 >= trow0, t1 = nsl > 1 && p1 >= trow0;
        f32x4 v[8]; float ss = 0.f;
#pragma unroll
        for (int i = 0; i < 8; ++i) { const int col = i * 256 + lane * 4;
            const u32x2 xq = *(const u32x2*)(xs + (size_t)row * D + col); const f32x4 x = (f32x4){__uint_as_float(xq.x << 16), __uint_as_float(xq.x & 0xffff0000u), __uint_as_float(xq.y << 16), __uint_as_float(xq.y & 0xffff0000u)}, g = *(const f32x4*)(g2 + col); f32x4 ya, yb;
            if (t0) { ya = ld4bf(slab + (size_t)(p0 - trow0) * D + col); for (int sl = 1; sl < nsl; ++sl) ya += ld4bf(slab + ((size_t)sl * trows + (p0 - trow0)) * D + col); }
            else { const u32x2 q = *(const u32x2*)(ys + (size_t)p0 * D + col); ya = (f32x4){__uint_as_float(q.x << 16), __uint_as_float(q.x & 0xffff0000u), __uint_as_float(q.y << 16), __uint_as_float(q.y & 0xffff0000u)}; }
            if (t1) { yb = ld4bf(slab + (size_t)(p1 - trow0) * D + col); for (int sl = 1; sl < nsl; ++sl) yb += ld4bf(slab + ((size_t)sl * trows + (p1 - trow0)) * D + col); }
            else { const u32x2 q = *(const u32x2*)(ys + (size_t)p1 * D + col); yb = (f32x4){__uint_as_float(q.x << 16), __uint_as_float(q.x & 0xffff0000u), __uint_as_float(q.y << 16), __uint_as_float(q.y & 0xffff0000u)}; }
#pragma unroll
            for (int j = 0; j < 4; ++j) { v[i][j] = x[j] + g[j] * (w0 * ya[j] + w1 * yb[j]); ss += v[i][j] * v[i][j]; } }
        ss = wave_sum(ss); const float rstd = rsqrtf(ss * (1.0f / D) + EPS);
#pragma unroll
        for (int i = 0; i < 8; ++i) { const int col = i * 256 + lane * 4; const f32x4 g = *(const f32x4*)(gfin + col); f32x4 o;
#pragma unroll
            for (int j = 0; j < 4; ++j) o[j] = v[i][j] * rstd * g[j];
            *(f32x4*)(out + (size_t)row * D + col) = o; }
    }
}

typedef float f32x2_t __attribute__((ext_vector_type(2))); typedef __bf16 bf16x2_t __attribute__((ext_vector_type(2)));
__device__ __forceinline__ unsigned cvtpk(float lo, float hi) { f32x2_t v = {lo, hi}; bf16x2_t b = __builtin_convertvector(v, bf16x2_t); return __builtin_bit_cast(unsigned, b); }
#define MFMA32(a, b, c) __builtin_amdgcn_mfma_f32_32x32x16_bf16((a), (b), (c), 0, 0, 0)
constexpr int MLA_KP = 400, MLA_VP = 144, MLA_KB = 64 * MLA_KP, MLA_VB = 128 * MLA_VP, MLA_STAGE = MLA_KB + MLA_VB;
static_assert(2 * MLA_STAGE <= RING_BYTES, "MLA LDS");

__device__ __forceinline__ void ph_mla(const Args& a, bool with_ctx, unsigned char* lds) {
    const bf16_t* __restrict__ Q = (const bf16_t*)(a.ws + WS_Q); const bf16_t* __restrict__ KN = (const bf16_t*)(a.ws + WS_KN); const bf16_t* __restrict__ KPE = (const bf16_t*)(a.ws + WS_KPE);
    const bf16_t* __restrict__ VT = (const bf16_t*)(a.ws + WS_VT); bf16_t* __restrict__ mix = (bf16_t*)(a.ws + WS_MIX);
    int tid_ = threadIdx.x; asm volatile("" : "+v"(tid_));
    const int tid = tid_, lane = tid & 63, w = tid >> 6, qi = lane & 31, hh = lane >> 5;
    const int nunits = with_ctx ? 288 : 256;
    const float c = 0.07216878364870322f * 1.4426950408889634f;
    for (int unit = blockIdx.x; unit < nunits; unit += gridDim.x) {
        int h, b, q0tok, nt; bool ctxq;
        if (unit < 256) { h = unit & 7; b = unit >> 6; q0tok = b * L + ((unit >> 3) & 7) * 256; nt = 36; ctxq = false; }
        else { const int u2 = unit - 256; h = u2 & 7; b = u2 >> 3; q0tok = NLAT + b * C; nt = 4; ctxq = true; }
#define MLA_KTOK(t) (ctxq ? (NLAT + b * C + (t) * 64) : ((t) < 32 ? (b * L + (t) * 64) : (NLAT + b * C + ((t) - 32) * 64)))
        u32x4 r0, r1, r2, r3, r4;
#define MLA_ISSUE_K(t) do { const int kt0_ = MLA_KTOK(t); \
            r0 = *(const u32x4*)(KN + (size_t)(kt0_ + (tid >> 4)) * 1024 + h * 128 + (tid & 15) * 8); \
            r1 = *(const u32x4*)(KN + (size_t)(kt0_ + 32 + (tid >> 4)) * 1024 + h * 128 + (tid & 15) * 8); \
            r2 = *(const u32x4*)(KPE + (size_t)(kt0_ + (tid >> 3)) * 64 + (tid & 7) * 8); } while (0)
#define MLA_ISSUE_V(t) do { const int kt0_ = MLA_KTOK(t); \
            r3 = *(const u32x4*)(VT + (size_t)(h * 128 + (tid >> 3)) * NTOK + kt0_ + (tid & 7) * 8); \
            r4 = *(const u32x4*)(VT + (size_t)(h * 128 + 64 + (tid >> 3)) * NTOK + kt0_ + (tid & 7) * 8); } while (0)
#define MLA_ISSUE(t) do { MLA_ISSUE_K(t); MLA_ISSUE_V(t); } while (0)
#define MLA_COMMIT(buf) do { unsigned char* kb_ = lds + (buf) * MLA_STAGE; unsigned char* vb_ = kb_ + MLA_KB; \
            *(u32x4*)(kb_ + (tid >> 4) * MLA_KP + (tid & 15) * 16) = r0; \
            *(u32x4*)(kb_ + (32 + (tid >> 4)) * MLA_KP + (tid & 15) * 16) = r1; \
            *(u32x4*)(kb_ + (tid >> 3) * MLA_KP + 256 + (tid & 7) * 16) = r2; \
            const int g_ = (tid & 7) >> 1, e_ = tid & 1; \
            { u32x2 lo_, hi_; lo_.x = r3.x; lo_.y = r3.y; hi_.x = r3.z; hi_.y = r3.w; \
              *(u32x2*)(vb_ + (tid >> 3) * MLA_VP + g_ * 32 + e_ * 8) = lo_; *(u32x2*)(vb_ + (tid >> 3) * MLA_VP + g_ * 32 + 16 + e_ * 8) = hi_; } \
            { u32x2 lo_, hi_; lo_.x = r4.x; lo_.y = r4.y; hi_.x = r4.z; hi_.y = r4.w; \
              *(u32x2*)(vb_ + (64 + (tid >> 3)) * MLA_VP + g_ * 32 + e_ * 8) = lo_; *(u32x2*)(vb_ + (64 + (tid >> 3)) * MLA_VP + g_ * 32 + 16 + e_ * 8) = hi_; } } while (0)
        const int qtok = q0tok + w * 32 + qi;
        bf16x8 qf[12];
#pragma unroll
        for (int s = 0; s < 12; ++s) qf[s] = *(const bf16x8*)(Q + (size_t)qtok * QW + h * 192 + s * 16 + hh * 8);
        f32x16 o[4];
#pragma unroll
        for (int d = 0; d < 4; ++d)
#pragma unroll
            for (int r = 0; r < 16; ++r) o[d][r] = 0.f;
        float m = -1.0e30f, l = 0.f;
        MLA_ISSUE(0); MLA_COMMIT(0);
        __syncthreads();
        for (int t = 0; t < nt; ++t) {
            const unsigned char* kb = lds + (t & 1) * MLA_STAGE; const unsigned char* vb = kb + MLA_KB;
            f32x16 s0, s1;
#pragma unroll
            for (int r = 0; r < 16; ++r) { s0[r] = 0.f; s1[r] = 0.f; }
            {
                const unsigned char* kp0 = kb + qi * MLA_KP + hh * 16; const unsigned char* kp1 = kp0 + 32 * MLA_KP;
                bf16x8 ka[4], kn[4];
                ka[0] = *(const bf16x8*)(kp0); ka[1] = *(const bf16x8*)(kp1); ka[2] = *(const bf16x8*)(kp0 + 32); ka[3] = *(const bf16x8*)(kp1 + 32);
#pragma unroll
                for (int g = 0; g < 6; ++g) {
                    if (g < 5) { kn[0] = *(const bf16x8*)(kp0 + (2 * g + 2) * 32); kn[1] = *(const bf16x8*)(kp1 + (2 * g + 2) * 32); kn[2] = *(const bf16x8*)(kp0 + (2 * g + 3) * 32); kn[3] = *(const bf16x8*)(kp1 + (2 * g + 3) * 32); }
                    __builtin_amdgcn_sched_barrier(0);
                    s0 = MFMA32(ka[0], qf[2 * g], s0); s1 = MFMA32(ka[1], qf[2 * g], s1); s0 = MFMA32(ka[2], qf[2 * g + 1], s0); s1 = MFMA32(ka[3], qf[2 * g + 1], s1);
                    __builtin_amdgcn_sched_barrier(0);
#pragma unroll
                    for (int q = 0; q < 4; ++q) ka[q] = kn[q];
                }
            }
            if (t + 1 < nt) MLA_ISSUE(t + 1);
            float mx = fmaxf(s0[0], s1[0]);
#pragma unroll
            for (int r = 1; r < 16; ++r) mx = fmaxf(mx, fmaxf(s0[r], s1[r]));
            mx = fmaxf(mx, __shfl_xor(mx, 32));
            const float mnew = fmaxf(m, mx * c);
            const float alpha = __builtin_amdgcn_exp2f(m - mnew);
            m = mnew;
            float ps = 0.f;
#pragma unroll
            for (int r = 0; r < 16; ++r) { s0[r] = __builtin_amdgcn_exp2f(s0[r] * c - mnew); s1[r] = __builtin_amdgcn_exp2f(s1[r] * c - mnew); ps += s0[r] + s1[r]; }
            l = l * alpha + ps;
            if ((PROBE_SUB >> 9) & 1u) {
                float ps2 = 0.f;
#pragma unroll
                for (int r = 0; r < 16; ++r) { float x0 = s0[r], x1 = s1[r]; asm volatile("" : "+v"(x0), "+v"(x1)); ps2 += __builtin_amdgcn_exp2f(x0 * c - 40.f) + __builtin_amdgcn_exp2f(x1 * c - 40.f); }
                float mx2 = ps2;
#pragma unroll
                for (int r = 0; r < 16; ++r) { float x0 = s0[r], x1 = s1[r]; asm volatile("" : "+v"(x0), "+v"(x1)); mx2 = fmaxf(mx2, fmaxf(x0 * c, x1 * c)); }
                if (mx2 == 123456.75f) l += ps2;
            }
            if ((PROBE_SUB >> 10) & 1u) {
                f32x16 sx;
#pragma unroll
                for (int r = 0; r < 16; ++r) sx[r] = 0.f;
#pragma unroll
                for (int s = 0; s < 12; ++s) { bf16x8 k0 = *(const bf16x8*)(kb + qi * MLA_KP + s * 32 + hh * 16); sx = MFMA32(k0, qf[s], sx); }
                if (sx[0] == 123456.75f) l += sx[1];
            }
#pragma unroll
            for (int d = 0; d < 4; ++d)
#pragma unroll
                for (int r = 0; r < 16; ++r) o[d][r] *= alpha;
            bf16x8 pf[4];
            { u32x4 p;
              p.x = cvtpk(s0[0], s0[1]); p.y = cvtpk(s0[2], s0[3]); p.z = cvtpk(s0[4], s0[5]); p.w = cvtpk(s0[6], s0[7]); pf[0] = __builtin_bit_cast(bf16x8, p);
              p.x = cvtpk(s0[8], s0[9]); p.y = cvtpk(s0[10], s0[11]); p.z = cvtpk(s0[12], s0[13]); p.w = cvtpk(s0[14], s0[15]); pf[1] = __builtin_bit_cast(bf16x8, p);
              p.x = cvtpk(s1[0], s1[1]); p.y = cvtpk(s1[2], s1[3]); p.z = cvtpk(s1[4], s1[5]); p.w = cvtpk(s1[6], s1[7]); pf[2] = __builtin_bit_cast(bf16x8, p);
              p.x = cvtpk(s1[8], s1[9]); p.y = cvtpk(s1[10], s1[11]); p.z = cvtpk(s1[12], s1[13]); p.w = cvtpk(s1[14], s1[15]); pf[3] = __builtin_bit_cast(bf16x8, p); }
            asm volatile("" ::: "memory");
            {
                const unsigned char* vp = vb + qi * MLA_VP + hh * 16;
                bf16x8 va[4], vn[4];
#pragma unroll
                for (int g = 0; g < 4; ++g) va[g] = *(const bf16x8*)(vp + g * 32);
#pragma unroll
                for (int d = 0; d < 4; ++d) {
                    if (d < 3) {
#pragma unroll
                        for (int g = 0; g < 4; ++g) vn[g] = *(const bf16x8*)(vp + (d + 1) * 32 * MLA_VP + g * 32); }
                    __builtin_amdgcn_sched_barrier(0);
#pragma unroll
                    for (int g = 0; g < 4; ++g) o[d] = MFMA32(va[g], pf[g], o[d]);
                    __builtin_amdgcn_sched_barrier(0);
#pragma unroll
                    for (int g = 0; g < 4; ++g) va[g] = vn[g];
                }
            }
            if (t + 1 < nt) MLA_COMMIT((t + 1) & 1);
            __syncthreads();
        }
        const float inv = 1.0f / (l + __shfl_xor(l, 32));
        bf16_t* op = mix + (size_t)qtok * D + h * 128 + 4 * hh;
#pragma unroll
        for (int d = 0; d < 4; ++d)
#pragma unroll
            for (int g = 0; g < 4; ++g) { u32x2 wv; wv.x = cvtpk(o[d][4 * g] * inv, o[d][4 * g + 1] * inv); wv.y = cvtpk(o[d][4 * g + 2] * inv, o[d][4 * g + 3] * inv);
                *(u32x2*)(op + d * 32 + 8 * g) = wv; }
#undef MLA_KTOK
#undef MLA_ISSUE
#undef MLA_ISSUE_K
#undef MLA_ISSUE_V
#undef MLA_COMMIT
    }
}

constexpr int HY_CS = 8224, HY_WS = 5136, HY_WOFF = 8 * HY_CS, HY_RBL = HY_WOFF + 4 * HY_WS;
static_assert(HY_RBL + 516 * 16 <= RING_BYTES, "hyena LDS");

__device__ __forceinline__ u32x4 hy_shift(const u32x4 a, const u32x4 b, int r) {
    switch (r) {
    case 0: return b;
    case 1: return (u32x4){__builtin_amdgcn_alignbyte(b.x, a.w, 2), __builtin_amdgcn_alignbyte(b.y, b.x, 2), __builtin_amdgcn_alignbyte(b.z, b.y, 2), __builtin_amdgcn_alignbyte(b.w, b.z, 2)};
    case 2: return (u32x4){a.w, b.x, b.y, b.z};
    case 3: return (u32x4){__builtin_amdgcn_alignbyte(a.w, a.z, 2), __builtin_amdgcn_alignbyte(b.x, a.w, 2), __builtin_amdgcn_alignbyte(b.y, b.x, 2), __builtin_amdgcn_alignbyte(b.z, b.y, 2)};
    case 4: return (u32x4){a.z, a.w, b.x, b.y};
    case 5: return (u32x4){__builtin_amdgcn_alignbyte(a.z, a.y, 2), __builtin_amdgcn_alignbyte(a.w, a.z, 2), __builtin_amdgcn_alignbyte(b.x, a.w, 2), __builtin_amdgcn_alignbyte(b.y, b.x, 2)};
    case 6: return (u32x4){a.y, a.z, a.w, b.x};
    default: return (u32x4){__builtin_amdgcn_alignbyte(a.y, a.x, 2), __builtin_amdgcn_alignbyte(a.z, a.y, 2), __builtin_amdgcn_alignbyte(a.w, a.z, 2), __builtin_amdgcn_alignbyte(b.x, a.w, 2)};
    }
}

__device__ __forceinline__ void ph_hyena(const Args& a, int l, unsigned char* lds) {
    const bf16_t* __restrict__ RB = (const bf16_t*)(a.ws + WS_FILTL) + (size_t)l * 512 * HY_RBROW;
    const bf16_t* __restrict__ wtl = (const bf16_t*)(a.ws + WS_WTL);
    int tid_ = threadIdx.x; asm volatile("" : "+v"(tid_));
    const int tid = tid_, lane = tid & 63, w = __builtin_amdgcn_readfirstlane(tid >> 6), i = lane & 31, hh = lane >> 5;
    for (int unit = blockIdx.x; unit < 512; unit += gridDim.x) {
        const int c = unit;
        for (int k = tid; k < 515; k += NTHR) { u32x4 v = (u32x4){0u, 0u, 0u, 0u}; if (k < 513) v = *(const u32x4*)(RB + (size_t)c * HY_RBROW + k * 8); *(u32x4*)(lds + HY_RBL + k * 16) = v; }
        for (int k = tid; k < 4 * 321; k += NTHR) { const int b = k / 321, sl = k - b * 321; u32x4 v = (u32x4){0u, 0u, 0u, 0u};
            if (sl >= 28 && sl < 284) v = *(const u32x4*)(wtl + ((size_t)b * 512 + c) * L + (sl - 28) * 8);
            *(u32x4*)(lds + HY_WOFF + b * HY_WS + sl * 16) = v; }
        __syncthreads();
        for (int qs = lane; qs < 511; qs += 64) {
            const u32x4 ca = *(const u32x4*)(lds + HY_RBL + qs * 16), cb = *(const u32x4*)(lds + HY_RBL + qs * 16 + 16);
            *(u32x4*)(lds + w * HY_CS + qs * 16) = hy_shift(ca, cb, w);
        }
        __syncthreads();
        f32x16 acc0, acc1;
#pragma unroll
        for (int r = 0; r < 16; ++r) { acc0[r] = 0.f; acc1[r] = 0.f; }
        const int Tl = i >> 2, b = i & 3;
        const unsigned char* ap = lds + (i & 7) * HY_CS + (hh - (i >> 3) + 255) * 16;
        const unsigned char* bp = lds + HY_WOFF + b * HY_WS + (224 + 16 * (2 * (8 * w + Tl)) + 8 * hh) * 2;
        const int d0 = 16 * w - 127;
#pragma unroll 2
        for (int dd = 0; dd < 142; dd += 2) {
            const int d = d0 + dd;
            const bf16x8 a0 = *(const bf16x8*)(ap - 32 * d), b0 = *(const bf16x8*)(bp - 32 * d);
            const bf16x8 a1 = *(const bf16x8*)(ap - 32 * (d + 1)), b1 = *(const bf16x8*)(bp - 32 * (d + 1));
            acc0 = MFMA32(a0, b0, acc0); acc1 = MFMA32(a1, b1, acc1);
        }
        bf16_t* yt = (bf16_t*)(a.ws + WS_YT) + ((size_t)b * 512 + c) * L + 32 * (8 * w + Tl) + 4 * hh;
#pragma unroll
        for (int g = 0; g < 4; ++g) { u32x2 wv; wv.x = cvtpk(acc0[4 * g] + acc1[4 * g], acc0[4 * g + 1] + acc1[4 * g + 1]); wv.y = cvtpk(acc0[4 * g + 2] + acc1[4 * g + 2], acc0[4 * g + 3] + acc1[4 * g + 3]);
            *(u32x2*)(yt + 8 * g) = wv; }
        __syncthreads();
    }
}

__device__ __forceinline__ void ph_hyena_fin(const Args& a, int l, bool with_ctx, unsigned char* lds) {
    const bf16_t* __restrict__ YT = (const bf16_t*)(a.ws + WS_YT); const bf16_t* __restrict__ wtl = (const bf16_t*)(a.ws + WS_WTL); const bf16_t* __restrict__ wtc = (const bf16_t*)(a.ws + WS_WTC);
    const bf16_t* __restrict__ x0 = (const bf16_t*)(a.ws + WS_X0); const float* skip = a.in[23] + l * 512; bf16_t* __restrict__ mix = (bf16_t*)(a.ws + WS_MIX);
    int tid_ = threadIdx.x; asm volatile("" : "+v"(tid_));
    const int tid = tid_;
    bf16_t* T = (bf16_t*)lds;
    constexpr int TP = 520;
    const int nunits = with_ctx ? 144 : 128;
    for (int unit = (int)gridDim.x - 1 - (int)blockIdx.x; unit < nunits; unit += gridDim.x) {
        const bool lat = unit < 128; const int b = lat ? (unit >> 5) : ((unit - 128) >> 2), t0 = lat ? (unit & 31) * 64 : ((unit - 128) & 3) * 64;
        const int Ls = lat ? L : C; const int tok0 = lat ? b * L + t0 : NLAT + b * C + t0;
        const bf16_t* yrow = (lat ? YT : YT + (size_t)NB * 512 * L) + ((size_t)b * 512 + tid) * Ls + t0;
        const bf16_t* wrow = (lat ? wtl : wtc) + ((size_t)b * 512 + tid) * Ls + t0;
        const float sk = skip[tid];
#pragma unroll
        for (int hf = 0; hf < 2; ++hf) {
            u32x4 yv[4], wv[4];
#pragma unroll
            for (int q = 0; q < 4; ++q) { yv[q] = *(const u32x4*)(yrow + hf * 32 + q * 8); wv[q] = *(const u32x4*)(wrow + hf * 32 + q * 8); }
#pragma unroll
            for (int q = 0; q < 4; ++q) { const unsigned yy[4] = {yv[q].x, yv[q].y, yv[q].z, yv[q].w}, ww[4] = {wv[q].x, wv[q].y, wv[q].z, wv[q].w};
#pragma unroll
                for (int d = 0; d < 4; ++d) { const int t = hf * 32 + q * 8 + 2 * d;
                    T[t * TP + tid] = f2bf(__uint_as_float(yy[d] << 16) + sk * __uint_as_float(ww[d] << 16));
                    T[(t + 1) * TP + tid] = f2bf(__uint_as_float(yy[d] & 0xffff0000u) + sk * __uint_as_float(ww[d] & 0xffff0000u)); } }
        }
        __syncthreads();
#pragma unroll
        for (int j = 0; j < 8; ++j) { const int o = tid + 512 * j, t = o >> 6, cc = (o & 63) * 8;
            const u32x4 tv = *(const u32x4*)(T + t * TP + cc), xv = *(const u32x4*)(x0 + (size_t)(tok0 + t) * 512 + cc);
            const unsigned tt[4] = {tv.x, tv.y, tv.z, tv.w}, xx[4] = {xv.x, xv.y, xv.z, xv.w}; unsigned oo[4];
#pragma unroll
            for (int d = 0; d < 4; ++d) oo[d] = cvtpk(__uint_as_float(tt[d] << 16) * __uint_as_float(xx[d] << 16), __uint_as_float(tt[d] & 0xffff0000u) * __uint_as_float(xx[d] & 0xffff0000u));
            *(u32x4*)(mix + (size_t)(tok0 + t) * D + 1024 + cc) = (u32x4){oo[0], oo[1], oo[2], oo[3]}; }
        __syncthreads();
    }
}

constexpr int SWA_P = 144, SWA_KB = 64 * SWA_P, SWA_STAGE = 2 * SWA_KB;
__device__ __forceinline__ void ph_swa(const Args& a, int l, bool with_ctx, unsigned char* lds) {
    const bf16_t* __restrict__ SQ = (const bf16_t*)(a.ws + WS_SQ); const bf16_t* __restrict__ SK = (const bf16_t*)(a.ws + WS_SK); const bf16_t* __restrict__ SVT = (const bf16_t*)(a.ws + WS_SV);
    const float* sink = a.in[24] + l * 8; bf16_t* __restrict__ mix = (bf16_t*)(a.ws + WS_MIX);
    int tid_ = threadIdx.x; asm volatile("" : "+v"(tid_));
    const int tid = tid_, lane = tid & 63, w = tid >> 6, qi = lane & 31, hh = lane >> 5;
    const int nunits = with_ctx ? 288 : 256;
    const float c = 0.125f * 1.4426950408889634f;
    const int G_ = gridDim.x, bid_ = blockIdx.x;
    for (int it = 0;; ++it) {
        int unit;
        if (G_ == 256) { if (it == 0) unit = bid_; else if (it == 1 && nunits > 256 && bid_ >= 224) unit = 256 + (255 - bid_); else break; }
        else { unit = bid_ + it * G_; if (unit >= nunits) break; }
        int hk, b, p0, nloc, t0loc, q0tok; bool ctxq;
        if (unit < 256) { hk = unit & 1; b = (unit >> 1) & 3; p0 = (unit >> 3) * 64; ctxq = false; q0tok = b * L + p0;
            const int lo = p0 - 128 < 0 ? 0 : p0 - 128, hi = p0 + 192 > L ? L : p0 + 192; t0loc = lo; nloc = (hi - lo) >> 6; }
        else { const int u2 = unit - 256; hk = u2 & 1; b = (u2 >> 1) & 3; p0 = (u2 >> 3) * 64; ctxq = true; q0tok = NLAT + b * C + p0; t0loc = 0; nloc = 0; }
        const int nt = nloc + 4;
#define SWA_KTOK(t) ((t) < nloc ? (b * L + t0loc + (t) * 64) : (NLAT + b * C + ((t) - nloc) * 64))
        u32x4 r0, r1;
#define SWA_ISSUE(t) do { const int kt0_ = SWA_KTOK(t); \
            r0 = *(const u32x4*)(SK + (size_t)(kt0_ + (tid >> 3)) * 128 + hk * 64 + (tid & 7) * 8); \
            r1 = *(const u32x4*)(SVT + (size_t)(hk * 64 + (tid >> 3)) * NTOK + kt0_ + (tid & 7) * 8); } while (0)
#define SWA_COMMIT(buf) do { unsigned char* kb_ = lds + (buf) * SWA_STAGE; unsigned char* vb_ = kb_ + SWA_KB; \
            *(u32x4*)(kb_ + (tid >> 3) * SWA_P + (tid & 7) * 16) = r0; \
            const int g_ = (tid & 7) >> 1, e_ = tid & 1; u32x2 lo_, hi_; lo_.x = r1.x; lo_.y = r1.y; hi_.x = r1.z; hi_.y = r1.w; \
            *(u32x2*)(vb_ + (tid >> 3) * SWA_P + g_ * 32 + e_ * 8) = lo_; *(u32x2*)(vb_ + (tid >> 3) * SWA_P + g_ * 32 + 16 + e_ * 8) = hi_; } while (0)
        const int hq = hk * 4 + (w >> 1), qpos = p0 + (w & 1) * 32 + qi, qtok = q0tok + (w & 1) * 32 + qi;
        bf16x8 qf[4];
#pragma unroll
        for (int s = 0; s < 4; ++s) qf[s] = *(const bf16x8*)(SQ + (size_t)qtok * 512 + hq * 64 + s * 16 + hh * 8);
        f32x16 o[2];
#pragma unroll
        for (int d = 0; d < 2; ++d)
#pragma unroll
            for (int r = 0; r < 16; ++r) o[d][r] = 0.f;
        float m = sink[hq] * 1.4426950408889634f, lsum = hh == 0 ? 1.0f : 0.0f;
        SWA_ISSUE(0); SWA_COMMIT(0);
        __syncthreads();
        for (int t = 0; t < nt; ++t) {
            const unsigned char* kb = lds + (t & 1) * SWA_STAGE; const unsigned char* vb = kb + SWA_KB;
            f32x16 s0, s1;
#pragma unroll
            for (int r = 0; r < 16; ++r) { s0[r] = 0.f; s1[r] = 0.f; }
#pragma unroll
            for (int s = 0; s < 4; ++s) {
                const bf16x8 k0 = *(const bf16x8*)(kb + qi * SWA_P + s * 32 + hh * 16);
                const bf16x8 k1 = *(const bf16x8*)(kb + (32 + qi) * SWA_P + s * 32 + hh * 16);
                s0 = MFMA32(k0, qf[s], s0); s1 = MFMA32(k1, qf[s], s1);
            }
            if (t + 1 < nt) SWA_ISSUE(t + 1);
            if (t < nloc) {
                const int kbase = t0loc + t * 64 + 4 * hh - qpos;
#pragma unroll
                for (int r = 0; r < 16; ++r) { const int dlt = kbase + (r & 3) + 8 * (r >> 2);
                    if (dlt > 128 || dlt < -128) s0[r] = -1.0e30f;
                    if (dlt + 32 > 128 || dlt + 32 < -128) s1[r] = -1.0e30f; }
            }
            float mx = fmaxf(s0[0], s1[0]);
#pragma unroll
            for (int r = 1; r < 16; ++r) mx = fmaxf(mx, fmaxf(s0[r], s1[r]));
            mx = fmaxf(mx, __shfl_xor(mx, 32));
            const float mnew = fmaxf(m, mx * c);
            const float alpha = __builtin_amdgcn_exp2f(m - mnew);
            m = mnew;
            float ps = 0.f;
#pragma unroll
            for (int r = 0; r < 16; ++r) { s0[r] = __builtin_amdgcn_exp2f(s0[r] * c - mnew); s1[r] = __builtin_amdgcn_exp2f(s1[r] * c - mnew); ps += s0[r] + s1[r]; }
            lsum = lsum * alpha + ps;
#pragma unroll
            for (int d = 0; d < 2; ++d)
#pragma unroll
                for (int r = 0; r < 16; ++r) o[d][r] *= alpha;
            bf16x8 pf[4];
            { u32x4 p;
              p.x = cvtpk(s0[0], s0[1]); p.y = cvtpk(s0[2], s0[3]); p.z = cvtpk(s0[4], s0[5]); p.w = cvtpk(s0[6], s0[7]); pf[0] = __builtin_bit_cast(bf16x8, p);
              p.x = cvtpk(s0[8], s0[9]); p.y = cvtpk(s0[10], s0[11]); p.z = cvtpk(s0[12], s0[13]); p.w = cvtpk(s0[14], s0[15]); pf[1] = __builtin_bit_cast(bf16x8, p);
              p.x = cvtpk(s1[0], s1[1]); p.y = cvtpk(s1[2], s1[3]); p.z = cvtpk(s1[4], s1[5]); p.w = cvtpk(s1[6], s1[7]); pf[2] = __builtin_bit_cast(bf16x8, p);
              p.x = cvtpk(s1[8], s1[9]); p.y = cvtpk(s1[10], s1[11]); p.z = cvtpk(s1[12], s1[13]); p.w = cvtpk(s1[14], s1[15]); pf[3] = __builtin_bit_cast(bf16x8, p); }
#pragma unroll
            for (int d = 0; d < 2; ++d)
#pragma unroll
                for (int g = 0; g < 4; ++g) {
                    const bf16x8 vf = *(const bf16x8*)(vb + (d * 32 + qi) * SWA_P + g * 32 + hh * 16);
                    o[d] = MFMA32(vf, pf[g], o[d]);
                }
            if (t + 1 < nt) SWA_COMMIT((t + 1) & 1);
            __syncthreads();
        }
        const float inv = 1.0f / (lsum + __shfl_xor(lsum, 32));
        bf16_t* op = mix + (size_t)qtok * D + 1536 + hq * 64 + 4 * hh;
#pragma unroll
        for (int d = 0; d < 2; ++d)
#pragma unroll
            for (int g = 0; g < 4; ++g) { u32x2 wv; wv.x = cvtpk(o[d][4 * g] * inv, o[d][4 * g + 1] * inv); wv.y = cvtpk(o[d][4 * g + 2] * inv, o[d][4 * g + 3] * inv);
                *(u32x2*)(op + d * 32 + 8 * g) = wv; }
#undef SWA_KTOK
#undef SWA_ISSUE
#undef SWA_COMMIT
    }
}


constexpr int NPHASES = 22;
#define GEMM_CALL(EPI, SCHED, g, S, E) pg8::gemm_phase<EPI, SCHED, true, true, 0>((PG8_LAS unsigned char*)lds, g, S, E)
#define GEMM_CALL8(EPI, SCHED, g, S, E) pg8::gemm_phase<EPI, SCHED, true, true, 1>((PG8_LAS unsigned char*)lds, g, S, E)
#define GEMM_CALLI8(EPI, SCHED, g, S, E) pg8::gemm_phase<EPI, SCHED, true, true, 2>((PG8_LAS unsigned char*)lds, g, S, E)

template <int LYR>
__device__ __forceinline__ void layer_phases(const Args& a, unsigned char* lds, const XcdBarrier& bar, int lo, int hi) {
#define IN(k) (lo <= (k) && (k) < hi)
#define REPS(k) for (int rep_ = 0; rep_ <= (int)((PROBE_MASK >> (k)) & 1u); ++rep_)
#if MK_PER_PHASE
#define SEAM(k) do { } while (0)
#else
#define SEAM(k) do { if (IN(k) && IN((k) + 1)) xcd_barrier(bar); } while (0)
#endif
    constexpr int P0 = 1 + LYR * 9;
    constexpr bool LAST = (LYR == 1);
    constexpr int S_WO = pg8::split_S((LAST ? NLAT : NTOK) / 256 * (D / 256), D / 64, 256);
    constexpr int S_WO0 = pg8::split_S(NTOK / 256 * (D / 256), D / 64, 256);
    constexpr int S_DN0 = pg8::split_S(NTOK / 256 * (D / 256), (FP8_DENSE || FP8_DOWN) ? DFF / 128 : DFF / 64, 256);
    constexpr int S_DN = pg8::split_S(NTOK / 256 * (D / 256), (FP8_DENSE || FP8_DOWN) ? DFF / 128 : DFF / 64, 256);
    const int G = gridDim.x, bid = blockIdx.x;
    unsigned char* ws = a.ws;
    const float* modl = (const float*)(ws + WS_MOD) + (size_t)LYR * 5 * 12288;
    bf16_t* xs = (bf16_t*)(ws + WS_XS);
    const int nq = LAST ? NLAT : NTOK;
    if (IN(P0 + 0)) REPS(P0 + 0) {
        if (LYR == 0) ph_normmod<false, false, I8_WIN ? 2 : 0, 0, false, false>(a.in[0], a.in[2], a.in[6], modl, 0, 2048, (bf16_t*)(ws + WS_HA), NTOK, nullptr, nullptr, nullptr, nullptr, nullptr, nullptr, (float*)(ws + WS_RSC));
        else ph_normmod<false, false, I8_WIN ? 2 : 0, S_DN0>(xs, xs + (size_t)NLAT * D, a.in[6] + D, modl, 0, 2048, (bf16_t*)(ws + WS_HA), NTOK, nullptr, nullptr, nullptr, nullptr,
                                                    (const bf16_t*)(ws + WS_SLAB), (const float*)(ws + WS_MOD) + (size_t)4 * 12288 + 10240, (float*)(ws + WS_RSC));
    }
    SEAM(P0 + 0);
    if (IN(P0 + 1)) REPS(P0 + 1) {
#if I8_WIN
        pg8::Gemm g{(const bf16_t*)(ws + WS_HA), (const bf16_t*)(ws + WS_WIN + (size_t)LYR * UW * D * 2), NTOK, UW, D / 2};
        const float swin = __uint_as_float(__hip_atomic_load((const unsigned*)(ws + WS_CTL) + CT_WSC + LYR, __ATOMIC_RELAXED, __HIP_MEMORY_SCOPE_AGENT)) * (1.0f / 127.0f);
        pg8::EpiStoreI8 E{(bf16_t*)(ws + WS_U), UW, (const float*)(ws + WS_RSC), swin};
        if constexpr (LAST) { pg8::WinLastOrder S; S.init(G, bid, D / 2); GEMM_CALLI8(pg8::EpiStoreI8, pg8::WinLastOrder, g, S, E); }
        else { pg8::StaticOrder S; S.init(NTOK, UW, G, bid, D / 2); GEMM_CALLI8(pg8::EpiStoreI8, pg8::StaticOrder, g, S, E); }
#else
        pg8::Gemm g{(const bf16_t*)(ws + WS_HA), (const bf16_t*)(ws + WS_WIN + (size_t)LYR * UW * D * 2), NTOK, UW, D};
        pg8::EpiStore E{(bf16_t*)(ws + WS_U), UW};
        if constexpr (LAST) { pg8::WinLastOrder S; S.init(G, bid, D); GEMM_CALL(pg8::EpiStore, pg8::WinLastOrder, g, S, E); }
        else { pg8::StaticOrder S; if (G == 256) S.init(NTOK, UW, G1_GEMM, bid < G1_GEMM ? bid : (1 << 24), D); else S.init(NTOK, UW, G, bid, D); GEMM_CALL(pg8::EpiStore, pg8::StaticOrder, g, S, E); }
#endif
        if (!LAST && rep_ == 0 && G == 256 && bid >= TAIL1_BLK0) {
            const int f0 = bid < G1_GEMM ? NCONV_Q + (bid - TAIL1_BLK0) * TAILQ1 : NCONV_Q + TAIL1_N * TAILQ1 + (bid - G1_GEMM) * CQ1;
            ph_convert<0>(a, (float*)lds, f0, 1, f0 + (bid < G1_GEMM ? TAILQ1 : CQ1)); }
        conv_fill(a, (float*)lds, LYR * 6 + 0);
    }
    SEAM(P0 + 1);
    if (IN(P0 + 2)) REPS(P0 + 2) ph_mid(a, LYR);
    SEAM(P0 + 2);
    if (IN(P0 + 3)) REPS(P0 + 3) {
        SUBREP(0) {
        { pg8::Gemm g{(const bf16_t*)(ws + WS_CQN), (const bf16_t*)(ws + WS_WQ + (size_t)LYR * QW * 768 * 2), nq, QW, 768};
          pg8::StaticOrder S; S.init(nq, QW, G, bid, 768); pg8::EpiQ E{(bf16_t*)(ws + WS_Q), (const float*)(ws + WS_ROPE), (const float*)(ws + WS_ROPE) + 2048 * 32};
          GEMM_CALL(pg8::EpiQ, pg8::StaticOrder, g, S, E); }
        __syncthreads();
        { pg8::Gemm g{(const bf16_t*)(ws + WS_CKVN), (const bf16_t*)(ws + WS_WKV + (size_t)LYR * KVW * 512 * 2), NTOK, 1024, 512};
          pg8::StaticOrder S; S.init(NTOK, 1024, G, bid, 512); pg8::EpiStore E{(bf16_t*)(ws + WS_KN), 1024};
          GEMM_CALL(pg8::EpiStore, pg8::StaticOrder, g, S, E); }
        __syncthreads();
        { pg8::Gemm g{(const bf16_t*)(ws + WS_WKV + (size_t)LYR * KVW * 512 * 2 + (size_t)1024 * 512 * 2), (const bf16_t*)(ws + WS_CKVN), 1024, NTOK, 512};
          pg8::StaticOrder S; S.init(1024, NTOK, 108, bid >= 216 ? bid - 216 : (bid >= 144 ? bid - 108 : (1 << 24)), 512); pg8::EpiStore E{(bf16_t*)(ws + WS_VT), NTOK};
          GEMM_CALL(pg8::EpiStore, pg8::StaticOrder, g, S, E); }
        __syncthreads();
        }
        SUBREP(1) ph_hyena(a, LYR, lds);
        SUBREP(3) if (!LAST) ph_hyena_naive<C>(a, LYR, (float*)lds);
        SUBREP(2) ph_swa(a, LYR, !LAST, lds);
        conv_fill(a, (float*)lds, LYR * 6 + 1);
    }
    SEAM(P0 + 3);
    if (IN(P0 + 4)) REPS(P0 + 4) { ph_hyena_fin(a, LYR, !LAST, lds); ph_mla(a, !LAST, lds);
        if (!LAST && rep_ == 0 && G == 256 && bid >= TAIL4_BLK0 && TAILQ4 > 0) ph_convert<0>(a, (float*)lds, NCONV_Q + NCONV_T1 + NCONV_T2 + NCONV_T3 + (bid - TAIL4_BLK0) * TAILQ4, 1, NCONV_Q + NCONV_T1 + NCONV_T2 + NCONV_T3 + (bid - TAIL4_BLK0 + 1) * TAILQ4); conv_fill(a, (float*)lds, LYR * 6 + 2); }
    SEAM(P0 + 4);
    if (IN(P0 + 5)) REPS(P0 + 5) {
        pg8::Gemm g{(const bf16_t*)(ws + WS_MIX), (const bf16_t*)(ws + WS_WOUT + (size_t)LYR * D * D * 2), nq, D, D};
        pg8::SplitOrder S; S.init(nq / 256, D / 256, G, bid, D, S_WO);
        const int trow0 = S.nfull / S.nN * 256; pg8::EpiResid E{rep_ ? (bf16_t*)(ws + WS_ACT) : xs, LYR == 0 ? a.in[0] : (const float*)nullptr, modl + 4096, (bf16_t*)(ws + WS_SLAB), trow0, nq - trow0, 1.0f};
        GEMM_CALL(pg8::EpiResid, pg8::SplitOrder, g, S, E);
        conv_fill(a, (float*)lds, LYR * 6 + 3);
    }
    SEAM(P0 + 5);
    if (!LAST) {
#if !FP8_DENSE
        if (IN(P0 + 6)) { ph_normmod<false, true, I8_GU ? 2 : 0, S_WO0, true, false>(xs, a.in[2], a.in[7], modl, 6144, 8192, (bf16_t*)(ws + WS_HA), NTOK, xs, nullptr, nullptr, nullptr, (const bf16_t*)(ws + WS_SLAB), modl + (size_t)4 * 12288 + 4096, (float*)(ws + WS_RSC));
            conv_finish(a, (float*)lds, CONV_DENSE_END); }
        SEAM(P0 + 6);
        if (IN(P0 + 7)) REPS(P0 + 7) {
#if I8_GU
            pg8::Gemm g{(const bf16_t*)(ws + WS_HA), (const bf16_t*)(ws + WS_WGU), NTOK, 2 * DFF, D / 2};
            pg8::StaticOrder S; if (G == 256) S.init(NTOK, 2 * DFF, G2_GEMM, bid < G2_GEMM ? bid : (1 << 24), D / 2); else S.init(NTOK, 2 * DFF, G, bid, D / 2);
            const float swg = __uint_as_float(__hip_atomic_load((const unsigned*)(ws + WS_CTL) + CT_WSC + 2, __ATOMIC_RELAXED, __HIP_MEMORY_SCOPE_AGENT)) * (1.0f / 127.0f);
            const float swu = __uint_as_float(__hip_atomic_load((const unsigned*)(ws + WS_CTL) + CT_WSC + 3, __ATOMIC_RELAXED, __HIP_MEMORY_SCOPE_AGENT)) * (1.0f / 127.0f);
            pg8::EpiSwiGLUI8 E{(unsigned char*)(ws + WS_ACT), DFF, (const float*)(ws + WS_RSC), swg, swu, ASCALE};
            GEMM_CALLI8(pg8::EpiSwiGLUI8, pg8::StaticOrder, g, S, E);
            if (rep_ == 0 && G == 256 && bid >= TAIL2_BLK0) {
                const int f0 = bid < G2_GEMM ? NCONV_Q + NCONV_T1 + (bid - TAIL2_BLK0) * TAILQ2 : NCONV_Q + NCONV_T1 + TAIL2_N * TAILQ2 + (bid - G2_GEMM) * CQ2;
                ph_convert<0>(a, (float*)lds, f0, 1, f0 + (bid < G2_GEMM ? TAILQ2 : CQ2)); }
#elif FP8_DOWN
            pg8::Gemm g{(const bf16_t*)(ws + WS_HA), (const bf16_t*)(ws + WS_WGU), NTOK, 2 * DFF, D};
            pg8::StaticOrder S; S.init(NTOK, 2 * DFF, G, bid, D);
            pg8::EpiSwiGLU8 E{(unsigned char*)(ws + WS_ACT), DFF, 1.0f, ASCALE};
            GEMM_CALL(pg8::EpiSwiGLU8, pg8::StaticOrder, g, S, E);
#else
            pg8::Gemm g{(const bf16_t*)(ws + WS_HA), (const bf16_t*)(ws + WS_WGU), NTOK, 2 * DFF, D};
            pg8::StaticOrder S; S.init(NTOK, 2 * DFF, G, bid, D);
            pg8::EpiSwiGLU E{(bf16_t*)(ws + WS_ACT), DFF};
            GEMM_CALL(pg8::EpiSwiGLU, pg8::StaticOrder, g, S, E);
#endif
            conv_fill(a, (float*)lds, 4);
        }
        SEAM(P0 + 7);
        if (IN(P0 + 8)) REPS(P0 + 8) {
#if FP8_DOWN
            pg8::Gemm g{(const bf16_t*)(ws + WS_ACT), (const bf16_t*)(ws + WS_WDN), NTOK, D, DFF / 2};
            pg8::SplitOrder S; S.init(NTOK / 256, D / 256, G, bid, DFF / 2, S_DN);
            const int trow0 = S.nfull / S.nN * 256; pg8::EpiResid E{rep_ ? (bf16_t*)(ws + WS_YS) : xs, (const float*)nullptr, modl + 10240, (bf16_t*)(ws + WS_SLAB), trow0, NTOK - trow0, 1.0f / (ASCALE * WSCALE)};
            GEMM_CALL8(pg8::EpiResid, pg8::SplitOrder, g, S, E);
            if (rep_ == 0 && G == 256 && bid >= TAIL3_BLK0 && TAILQ3 > 0) ph_convert<0>(a, (float*)lds, NCONV_Q + NCONV_T1 + NCONV_T2 + (bid - TAIL3_BLK0) * TAILQ3, 1, NCONV_Q + NCONV_T1 + NCONV_T2 + (bid - TAIL3_BLK0 + 1) * TAILQ3);
#else
            pg8::Gemm g{(const bf16_t*)(ws + WS_ACT), (const bf16_t*)(ws + WS_WDN), NTOK, D, DFF};
            pg8::SplitOrder S; S.init(NTOK / 256, D / 256, G, bid, DFF, S_DN);
            const int trow0 = S.nfull / S.nN * 256; pg8::EpiResid E{rep_ ? (bf16_t*)(ws + WS_YS) : xs, (const float*)nullptr, modl + 10240, (bf16_t*)(ws + WS_SLAB), trow0, NTOK - trow0, 1.0f};
            GEMM_CALL(pg8::EpiResid, pg8::SplitOrder, g, S, E);
#endif
            conv_fill(a, (float*)lds, 5);
        }
#else
        if (IN(P0 + 6)) { ph_normmod<false, true, true, S_WO0, true, false>(xs, a.in[2], a.in[7], modl, 6144, 8192, (bf16_t*)(ws + WS_HA), NTOK, xs, nullptr, nullptr, nullptr, (const bf16_t*)(ws + WS_SLAB), modl + (size_t)4 * 12288 + 4096);
            conv_finish(a, (float*)lds, CONV_DENSE_END); }
        SEAM(P0 + 6);
        if (IN(P0 + 7)) REPS(P0 + 7) {
            pg8::Gemm g{(const bf16_t*)(ws + WS_HA), (const bf16_t*)(ws + WS_WGU), NTOK, 2 * DFF, D / 2};
            pg8::StaticOrder S; S.init(NTOK, 2 * DFF, G, bid, D / 2); pg8::EpiSwiGLU8 E{(unsigned char*)(ws + WS_ACT), DFF, 1.0f / (ASCALE * WSCALE), ASCALE};
            GEMM_CALL8(pg8::EpiSwiGLU8, pg8::StaticOrder, g, S, E);
            conv_fill(a, (float*)lds, 4);
        }
        SEAM(P0 + 7);
        if (IN(P0 + 8)) REPS(P0 + 8) {
            pg8::Gemm g{(const bf16_t*)(ws + WS_ACT), (const bf16_t*)(ws + WS_WDN), NTOK, D, DFF / 2};
            pg8::SplitOrder S; S.init(NTOK / 256, D / 256, G, bid, DFF / 2, S_DN);
            const int trow0 = S.nfull / S.nN * 256; pg8::EpiResid E{rep_ ? (bf16_t*)(ws + WS_YS) : xs, (const float*)nullptr, modl + 10240, (bf16_t*)(ws + WS_SLAB), trow0, NTOK - trow0, 1.0f / (ASCALE * WSCALE)};
            GEMM_CALL8(pg8::EpiResid, pg8::SplitOrder, g, S, E);
            conv_fill(a, (float*)lds, 5);
        }
#endif
        SEAM(P0 + 8);
    } else {
        if (IN(P0 + 6)) REPS(P0 + 6) ph_normmod<true, false, true>(xs, xs + (size_t)NLAT * D, a.in[7] + D, modl, 6144, 8192, (bf16_t*)(ws + WS_HA), NLAT, nullptr, a.in[29], (int*)(ws + WS_TOPI), (float*)(ws + WS_TOPW), nullptr, nullptr, nullptr, (float*)lds);
        SEAM(P0 + 6);
        if (IN(P0 + 7)) REPS(P0 + 7) { ph_route_gather(a, (int*)lds); conv_finish(a, (float*)lds, NCONV); }
        SEAM(P0 + 7);
        if (IN(P0 + 9)) REPS(P0 + 9) {
            pg8::Gemm g{(const bf16_t*)(ws + WS_HBS), (const bf16_t*)(ws + WS_MGU), MOE_ROWS, 2 * DFE, D / 2};
            pg8::MoeOrder S; S.init((const int*)(ws + WS_CTL), 2 * DFE / 256, G, bid, (size_t)2 * DFE * D, D / 2); pg8::EpiSwiGLU8 E{(rep_ && ((PROBE_SUB >> 12) & 1u)) ? nullptr : (unsigned char*)(ws + WS_ACT), DFE, 1.0f / (ASCALE * WSCALE), ASCALE};
            GEMM_CALL8(pg8::EpiSwiGLU8, pg8::MoeOrder, g, S, E);
        }
        SEAM(P0 + 9);
        if (IN(P0 + 10)) REPS(P0 + 10) {
            pg8::Gemm g{(const bf16_t*)(ws + WS_ACT), (const bf16_t*)(ws + WS_MDN), MOE_ROWS, D, DFE / 2};
            pg8::SplitOrder S; S.init_moe((const int*)(ws + WS_CTL), D / 256, G, bid, DFE / 2, (size_t)D * DFE);
            const int trow0 = S.nfull / S.nN * 256; pg8::EpiYs E{(bf16_t*)(ws + WS_YS), (bf16_t*)(ws + WS_SLAB), trow0, S.nM * 256 - trow0, 1.0f / (ASCALE * WSCALE)};
            GEMM_CALL8(pg8::EpiYs, pg8::SplitOrder, g, S, E);
        }
        SEAM(P0 + 10);
        if (IN(P0 + 11)) REPS(P0 + 11) ph_final(a);
    }
#undef IN
#undef SEAM
#undef REPS
}

__global__ void __launch_bounds__(NTHR, 2) mk_fwd(Args a) {
    extern __shared__ __attribute__((aligned(16))) unsigned char lds[];
    const int tid = threadIdx.x;
    for (int u = tid; u < (LDS_BYTES - LDSCTL_OFF) / 4; u += NTHR) ((unsigned*)(lds + LDSCTL_OFF))[u] = 0u;
    __syncthreads();
    XcdBarrier bar; bar.bar = (unsigned*)(a.ws + WS_CTL) + CW_BAR; bar.x = 0; bar.st = nullptr;
#if !MK_PER_PHASE
    bar = xcd_barrier_post((unsigned*)(a.ws + WS_CTL) + CW_BAR, (volatile LAS unsigned*)(lds + LDSCTL_OFF + 32));
#endif
    const int lo = a.ph_lo, hi = a.ph_hi;
    if (lo <= 0 && 0 < hi) {
        for (int rep_ = 0; rep_ <= (int)(PROBE_MASK & 1u); ++rep_) { ph_prologue(a, (float*)lds); __syncthreads(); }
#if !MK_PER_PHASE
        if (1 < hi) xcd_barrier(bar);
#endif
    }
    layer_phases<0>(a, lds, bar, lo, hi);
    layer_phases<1>(a, lds, bar, lo, hi);
}

extern "C" void kernel_launch(void* const* d_in, const int* in_sizes, int n_in, void* d_out, int out_size, void* d_ws, size_t ws_size, hipStream_t stream) {
    (void)in_sizes; (void)out_size;
    static int grid = 0;
    if (grid == 0) {
        if (n_in != 34 || ws_size < WS_END) { fprintf(stderr, "kernel_launch: need 34 inputs and >= %zu bytes of workspace (got %d, %zu)\n", (size_t)WS_END, n_in, ws_size); grid = -1; return; }
        int dev = 0, cus = 0, per_cu = 0;
        if (hipGetDevice(&dev) != hipSuccess || hipDeviceGetAttribute(&cus, hipDeviceAttributeMultiprocessorCount, dev) != hipSuccess) { grid = -1; return; }
        if (hipFuncSetAttribute((const void*)mk_fwd, hipFuncAttributeMaxDynamicSharedMemorySize, LDS_BYTES) != hipSuccess) { fprintf(stderr, "kernel_launch: hipFuncSetAttribute failed\n"); grid = -1; return; }
        if (hipOccupancyMaxActiveBlocksPerMultiprocessor(&per_cu, (const void*)mk_fwd, NTHR, LDS_BYTES) != hipSuccess || per_cu < 1) { fprintf(stderr, "kernel_launch: occupancy query says %d blocks per CU\n", per_cu); }
        (void)hipGetLastError();
        grid = cus;
    }
    if (grid < 0) return;
    if (hipMemsetAsync((char*)d_ws + WS_CTL, 0, CTL_ZERO_BYTES, stream) != hipSuccess) return;
    Args a{};
    for (int i = 0; i < 34; ++i) a.in[i] = (const float*)d_in[i];
    a.out = (float*)d_out; a.ws = (unsigned char*)d_ws;
#if MK_PER_PHASE
    for (int p = 0; p < NPHASES; ++p) { a.ph_lo = p; a.ph_hi = p + 1; hipLaunchKernelGGL(mk_fwd, dim3(grid), dim3(NTHR), LDS_BYTES, stream, a); }
#else
    a.ph_lo = 0; a.ph_hi = NPHASES;
    hipLaunchKernelGGL(mk_fwd, dim3(grid), dim3(NTHR), LDS_BYTES, stream, a);
#endif
}
```

```cpp
#include <hip/hip_runtime.h>
#include <stdint.h>
#include <stdio.h>

#ifndef FP8_DENSE
#define FP8_DENSE 0
#endif
#ifndef FP8_DOWN
#define FP8_DOWN 1
#endif
#ifndef I8_WIN
#define I8_WIN 0
#endif
#ifndef I8_GU
#define I8_GU 1
#endif
#ifndef I8_GEMM
#define I8_GEMM (I8_WIN || I8_GU)
#endif
#ifndef TAILQ1
#define TAILQ1 6
#endif
#ifndef TAILQ2
#define TAILQ2 3
#endif
#ifndef TAILQ3
#define TAILQ3 8
#endif
#ifndef TAILQ4
#define TAILQ4 2
#endif
#ifndef CQ1
#define CQ1 20
#endif
#ifndef CQ2
#define CQ2 26
#endif
#ifndef CONV_FILL
#define CONV_FILL 0
#endif
#ifndef PROBE_MASK
#define PROBE_MASK 0u
#endif
#ifndef PROBE_SUB
#define PROBE_SUB 0u
#endif
#ifndef MK_PER_PHASE
#define MK_PER_PHASE 0
#endif

typedef unsigned short bf16_t;
typedef float f32x4 __attribute__((ext_vector_type(4)));
typedef float f32x16 __attribute__((ext_vector_type(16)));
typedef unsigned u32x4 __attribute__((ext_vector_type(4)));
typedef unsigned u32x2 __attribute__((ext_vector_type(2)));
typedef short bf16x8 __attribute__((ext_vector_type(8)));

constexpr int D = 2048, NB = 4, L = 2048, C = 256, NLAT = NB * L, NCTX = NB * C, NTOK = NLAT + NCTX;
constexpr int UW = 3840;
constexpr int O_CQ = 0, O_CKV = 768, O_KPE = 1280, O_HY = 1344, O_SQ = 2880, O_SK = 3392, O_SV = 3520, INW = 3648;
constexpr int QW = 1536, KVW = 2048, DFF = 5632, DFE = 7168, NE = 8;
constexpr int MOE_ROWS = 18432;
constexpr float EPS = 1e-6f;
constexpr int NTHR = 512;
constexpr int HY_RBROW = 4112;

__device__ __forceinline__ float bf2f(bf16_t h) { return __uint_as_float(((unsigned)h) << 16); }
__device__ __forceinline__ bf16_t f2bf(float f) { unsigned u = __float_as_uint(f); u += 0x7fffu + ((u >> 16) & 1u); return (bf16_t)(u >> 16); }
__device__ __forceinline__ float wave_sum(float v) { for (int o = 32; o > 0; o >>= 1) v += __shfl_xor(v, o); return v; }
__device__ __forceinline__ float wave_max(float v) { for (int o = 32; o > 0; o >>= 1) v = fmaxf(v, __shfl_xor(v, o)); return v; }
__device__ __forceinline__ float silu(float x) { return x / (1.0f + __expf(-x)); }
__device__ __forceinline__ int tok_mod(int tok) { return tok < NLAT ? (tok >> 11) : 4; }

constexpr size_t al(size_t x) { return (x + 255) & ~(size_t)255; }
constexpr size_t WS_CTL = 0, CTL_ZERO_BYTES = 65536;
constexpr size_t WS_MOD = 65536;
constexpr size_t WS_ROPE = WS_MOD + al((size_t)2 * 5 * 12288 * 4);
constexpr size_t WS_FILTL = WS_ROPE + al((size_t)2 * 2048 * 32 * 4);
constexpr size_t WS_FILTC = WS_FILTL + al((size_t)2 * 512 * 4096 * 4);
constexpr size_t WS_WIN = WS_FILTC + al((size_t)2 * 512 * 512 * 4);
constexpr size_t WS_WQ = WS_WIN + al((size_t)2 * UW * D * 2);
constexpr size_t WS_WKV = WS_WQ + al((size_t)2 * QW * 768 * 2);
constexpr size_t WS_WOUT = WS_WKV + al((size_t)2 * KVW * 512 * 2);
constexpr size_t WS_WGU = WS_WOUT + al((size_t)2 * D * D * 2);
constexpr size_t WS_WDN = WS_WGU + al((size_t)2 * DFF * D * 2);
constexpr size_t WS_MGU = WS_WDN + al((size_t)D * DFF * 2);
constexpr size_t WS_MDN = WS_MGU + al((size_t)NE * 2 * DFE * D * 2);
constexpr size_t WS_HA = WS_MDN + al((size_t)NE * D * DFE * 2);
constexpr size_t WS_U = WS_HA + al((size_t)NTOK * D * 2);
constexpr size_t WS_CQN = WS_U + al((size_t)NTOK * UW * 2);
constexpr size_t WS_CKVN = WS_CQN + al((size_t)NTOK * 768 * 2);
constexpr size_t WS_KPE = WS_CKVN + al((size_t)NTOK * 512 * 2);
constexpr size_t WS_X0 = WS_KPE + al((size_t)NTOK * 64 * 2);
constexpr size_t WS_WTL = WS_X0 + al((size_t)NTOK * 512 * 2);
constexpr size_t WS_WTC = WS_WTL + al((size_t)NB * 512 * L * 2);
constexpr size_t WS_SQ = WS_WTC + al((size_t)NB * 512 * C * 2);
constexpr size_t WS_SK = WS_SQ + al((size_t)NTOK * 512 * 2);
constexpr size_t WS_SV = WS_SK + al((size_t)NTOK * 128 * 2);
constexpr size_t WS_Q = WS_SV + al((size_t)NTOK * 128 * 2);
constexpr size_t WS_KV = WS_Q + al((size_t)NTOK * QW * 2);
constexpr size_t WS_KN = WS_KV;
constexpr size_t WS_VT = WS_KV + (size_t)NTOK * 1024 * 2;
constexpr size_t WS_MIX = WS_KV + al((size_t)NTOK * KVW * 2);
constexpr size_t WS_MIXEND = WS_MIX + al((size_t)NTOK * D * 2);
constexpr size_t WS_YS = WS_U;
static_assert(WS_YS + (size_t)MOE_ROWS * D * 4 <= WS_MIXEND, "ys overlay");
constexpr size_t WS_XS = WS_MIXEND;
constexpr size_t WS_ACT = WS_XS + al((size_t)NTOK * D * 4);
constexpr size_t WS_HBS = WS_ACT + al((size_t)MOE_ROWS * DFE * 2);
constexpr size_t WS_TOPI = WS_HBS + al((size_t)MOE_ROWS * D * 2);
constexpr size_t WS_TOPW = WS_TOPI + al((size_t)NLAT * 2 * 4);
constexpr size_t WS_POS = WS_TOPW + al((size_t)NLAT * 2 * 4);
constexpr size_t WS_SRC = WS_POS + al((size_t)NLAT * 2 * 4);
constexpr size_t WS_SLAB = WS_SRC + al((size_t)MOE_ROWS * 4);
constexpr size_t WS_YT = WS_SLAB + ((size_t)64 << 20);
constexpr size_t WS_RSC = WS_YT + al((size_t)NB * 512 * (L + C) * 2);
constexpr size_t WS_END = WS_RSC + al((size_t)NTOK * 4);
constexpr int CT_EOFF = 1024, CT_EPAD = 1040, CT_NTILE = 1056, CT_MOES = 1057, CT_TROW = 1058, CT_WSC = 1088, CT_AMAXDONE = 1100;
constexpr int CW_BAR = 4096;

constexpr int RING_BYTES = 131072, LDS_BYTES = 147456, LDSCTL_OFF = LDS_BYTES - 256;

namespace pg8 {
#define PG8_LAS __attribute__((address_space(3)))
typedef unsigned short bf16_t;
typedef short bf16x8 __attribute__((ext_vector_type(8)));
typedef float f32x4 __attribute__((ext_vector_type(4)));
typedef unsigned u32x4 __attribute__((ext_vector_type(4)));
constexpr int BM = 256, BK = 64, HALF = 128, HTB = HALF * BK * 2  , STAGE_BYTES = 8 * HTB, NXCD = 8, WGM = 8;

__host__ __device__ __forceinline__ int lds_byte(int r, int c) { const int st = (r >> 4) * 2 + (c >> 5), rr = r & 15, cc = c & 31, ob = rr * 64 + cc * 2; return st * 1024 + (ob ^ (((ob >> 9) & 1) << 5)); }
__host__ __device__ __forceinline__ void stage_rc(int b, int& R, int& C) { const int st = b / 1024, sb = b % 1024, swz = sb ^ (((sb >> 9) & 1) << 5); R = (st >> 1) * 16 + swz / 64; C = (st & 1) * 32 + (swz % 64) / 2; }
__host__ __device__ __forceinline__ int perm32(int rho) { const int n = rho >> 4, i = rho & 15; return 8 * (i >> 2) + 4 * n + (i & 3); }

struct Unit { int pm, pn, kt0, nkt, slab; };
struct Gemm { const bf16_t* A; const bf16_t* Bt; int M, N, K; };

struct StaticOrder {
    int nM, nN, nwg, G, c;
    int nkt;
    __host__ __device__ void init(int M, int N, int G_, int c_, int K) { nM = M / BM; nN = N / BM; nwg = nM * nN; G = G_; c = c_; nkt = K / BK; }
    __host__ __device__ bool next(int i, Unit& u) const {
        const long L = (long)i * G + c; if (L >= nwg) return false;
        int wgid = (int)L; { const int q = nwg / NXCD, r = nwg % NXCD, xcd = wgid % NXCD, off = wgid / NXCD; wgid = (xcd < r ? xcd * (q + 1) : r * (q + 1) + (xcd - r) * q) + off; }
        const int nig = WGM * nN, gid = wgid / nig, fm = gid * WGM, gsz = (nM - fm) < WGM ? (nM - fm) : WGM;
        u.pm = fm + ((wgid % nig) % gsz); u.pn = (wgid % nig) / gsz; u.kt0 = 0; u.nkt = nkt; u.slab = -1; return true;
    }
    __device__ __forceinline__ size_t bt_off(const Unit&) const { return 0; }
    __device__ __forceinline__ void a_ready(const Unit&) const {}
    __device__ __forceinline__ void done(const Unit&) const {}
};

__device__ __forceinline__ unsigned cvt_pk_bf16(float lo, float hi) { unsigned r; asm volatile("v_cvt_pk_bf16_f32 %0, %1, %2" : "=v"(r) : "v"(lo), "v"(hi)); return r; }
typedef float f32x2 __attribute__((ext_vector_type(2)));
typedef int v8i_t __attribute__((ext_vector_type(8))); typedef int v4i_t __attribute__((ext_vector_type(4)));
template <bool F8> struct Frag;
template <> struct Frag<false> { bf16x8 h[2]; __device__ __forceinline__ void set0(bf16x8 x) { h[0] = x; } __device__ __forceinline__ void set1(bf16x8 x) { h[1] = x; } };
template <> struct Frag<true> { v8i_t v; __device__ __forceinline__ void set0(bf16x8 x) { v.lo = __builtin_bit_cast(v4i_t, x); } __device__ __forceinline__ void set1(bf16x8 x) { v.hi = __builtin_bit_cast(v4i_t, x); } };
template <class Epi, class Sched, bool ALIGN_EPI = false, bool SP2 = false, int DT = 0>
__device__ __forceinline__ void gemm_phase(PG8_LAS unsigned char* lds, const Gemm g, const Sched& S, const Epi& E) {
    int tid_ = threadIdx.x; asm volatile("" : "+v"(tid_));
    const int tid = tid_, wid = __builtin_amdgcn_readfirstlane(tid >> 6), lane = tid & 63, wr = wid >> 2, wc = wid & 3, fr = lane & 15, fq = lane >> 4;
    const int K = g.K;
    unsigned voffA[2], voffB[2];
#pragma unroll
    for (int i = 0; i < 2; ++i) { int R, C; stage_rc(tid * 16 + i * 8192, R, C); const int Rb = Epi::PERM ? ((R & ~31) + perm32(R & 31)) : R;
        voffA[i] = (unsigned)(R * K + C) * 2u; voffB[i] = (unsigned)(Rb * K + C) * 2u; }
    const size_t kstep = (size_t)(BK * 2);
    const size_t hstep = (size_t)HALF * K * 2;
    const size_t tstep = 2 * hstep;
    const unsigned ldsw = (unsigned)wid * 1024u;
    const int aoff = lds_byte(wr * 64 + fr, fq * 8), boff = lds_byte(wc * 32 + fr, fq * 8);
#define PG8_SA(b, h) (((b) * 2 + (h)) * HTB)
#define PG8_SB(b, h) ((4 + (b) * 2 + (h)) * HTB)
#define PG8_STAGE(bufoff, gbase, voff) do { _Pragma("unroll") for (int _i = 0; _i < 2; ++_i) \
        __builtin_amdgcn_global_load_lds((const unsigned*)((const char*)(gbase) + (voff)[_i]), (PG8_LAS unsigned*)(lds + (bufoff) + ldsw + _i * 8192), 16, 0, 0); } while (0)
#define PG8_LDA(dst, b, h) do { _Pragma("unroll") for (int m = 0; m < 4; ++m) { dst[m].set0(*(const PG8_LAS bf16x8*)(lds + PG8_SA(b, h) + aoff + m * 2048)); dst[m].set1(*(const PG8_LAS bf16x8*)(lds + PG8_SA(b, h) + aoff + m * 2048 + 1024)); } } while (0)
#define PG8_LDB(dst, b, h) do { _Pragma("unroll") for (int n = 0; n < 2; ++n) { dst[n].set0(*(const PG8_LAS bf16x8*)(lds + PG8_SB(b, h) + boff + n * 2048)); dst[n].set1(*(const PG8_LAS bf16x8*)(lds + PG8_SB(b, h) + boff + n * 2048 + 1024)); } } while (0)
#define PG8_MMA(ai, bj, At, Bt) do { __builtin_amdgcn_s_setprio(1); _Pragma("unroll") for (int m = 0; m < 4; ++m) _Pragma("unroll") for (int n = 0; n < 2; ++n) { \
        if constexpr (DT == 1) asm volatile("v_mfma_f32_16x16x128_f8f6f4 %0, %1, %2, %0" : "+v"(acc[ai][bj][m][n]) : "v"(Bt[n].v), "v"(At[m].v));   \
        else if constexpr (DT == 2) { _Pragma("unroll") for (int k = 0; k < 2; ++k) acc[ai][bj][m][n] = __builtin_bit_cast(f32x4, __builtin_amdgcn_mfma_i32_16x16x64_i8(__builtin_bit_cast(v4i_t, Bt[n].h[k]), __builtin_bit_cast(v4i_t, At[m].h[k]), __builtin_bit_cast(v4i_t, acc[ai][bj][m][n]), 0, 0, 0)); } \
        else { _Pragma("unroll") for (int k = 0; k < 2; ++k) acc[ai][bj][m][n] = __builtin_amdgcn_mfma_f32_16x16x32_bf16(Bt[n].h[k], At[m].h[k], acc[ai][bj][m][n], 0, 0, 0); } } \
        __builtin_amdgcn_s_setprio(0); } while (0)
#define PG8_WAIT_V(n) asm volatile("s_waitcnt vmcnt(" #n ")" ::: "memory")
#define PG8_WAIT_L(n) asm volatile("s_waitcnt lgkmcnt(" #n ")" ::: "memory")
#define PG8_BAR __builtin_amdgcn_s_barrier()
#define PG8_SCHED __builtin_amdgcn_sched_barrier(0)
    Unit cur, nxt; int ui = 0;
    if (!S.next(0, cur)) return;
    f32x4 acc[2][2][4][2];
#pragma unroll
    for (int a = 0; a < 2; ++a)
#pragma unroll
        for (int b = 0; b < 2; ++b)
#pragma unroll
            for (int m = 0; m < 4; ++m)
#pragma unroll
                for (int n = 0; n < 2; ++n) acc[a][b][m][n] = (f32x4){0.f, 0.f, 0.f, 0.f};
    Frag<DT == 1> At[4], B0[2], B1[2];
    const char* cA = (const char*)g.A + (size_t)cur.pm * tstep + (size_t)cur.kt0 * kstep; const char* cB = (const char*)g.Bt + S.bt_off(cur) + (size_t)cur.pn * tstep + (size_t)cur.kt0 * kstep;
    S.a_ready(cur);
    if constexpr (SP2) {
        PG8_STAGE(PG8_SB(0, 0), cB, voffB); PG8_STAGE(PG8_SB(0, 1), cB + hstep, voffB); PG8_STAGE(PG8_SA(0, 0), cA, voffA); PG8_STAGE(PG8_SA(0, 1), cA + hstep, voffA);
        if (wr == 1) PG8_BAR;
        PG8_WAIT_V(2); PG8_BAR;
        PG8_STAGE(PG8_SB(1, 0), cB + kstep, voffB); PG8_STAGE(PG8_SA(1, 0), cA + kstep, voffA); PG8_STAGE(PG8_SB(1, 1), cB + hstep + kstep, voffB);
        PG8_WAIT_V(6); PG8_BAR;
    } else {
        PG8_STAGE(PG8_SB(0, 0), cB, voffB); PG8_STAGE(PG8_SA(0, 0), cA, voffA); PG8_STAGE(PG8_SB(0, 1), cB + hstep, voffB); PG8_STAGE(PG8_SA(0, 1), cA + hstep, voffA);
        if (wr == 1) PG8_BAR;
        PG8_WAIT_V(4); PG8_BAR;
        PG8_STAGE(PG8_SB(1, 0), cB + kstep, voffB); PG8_STAGE(PG8_SA(1, 0), cA + kstep, voffA); PG8_STAGE(PG8_SB(1, 1), cB + hstep + kstep, voffB);
        PG8_WAIT_V(6); PG8_BAR;
    }
    for (;;) {
        const bool has_next = S.next(ui + 1, nxt);
        const char* nA = has_next ? (const char*)g.A + (size_t)nxt.pm * tstep + (size_t)nxt.kt0 * kstep : cA; const char* nB = has_next ? (const char*)g.Bt + S.bt_off(nxt) + (size_t)nxt.pn * tstep + (size_t)nxt.kt0 * kstep : cB;
        const int nt = cur.nkt;
        for (int t = 0; t < nt; t += 2) {
            const bool last = (t == nt - 2);
            const char* a1 = cA + (size_t)(t + 1) * kstep;
            const char* a2 = last ? nA : cA + (size_t)(t + 2) * kstep; const char* b2 = last ? nB : cB + (size_t)(t + 2) * kstep;
            const char* a3 = a2 + kstep; const char* b3 = b2 + kstep;
            if (last && has_next) S.a_ready(nxt);
            if constexpr (SP2) {
            PG8_LDB(B0, 0, 0); PG8_LDB(B1, 0, 1); PG8_SCHED; PG8_LDA(At, 0, 0); PG8_STAGE(PG8_SA(1, 1), a1 + hstep, voffA);
            PG8_WAIT_V(8); PG8_WAIT_L(0); PG8_BAR; PG8_MMA(0, 0, At, B0); PG8_MMA(0, 1, At, B1); PG8_BAR; PG8_SCHED;
            PG8_LDA(At, 0, 1); PG8_STAGE(PG8_SB(0, 0), b2, voffB); PG8_STAGE(PG8_SB(0, 1), b2 + hstep, voffB); PG8_STAGE(PG8_SA(0, 0), a2, voffA);
            PG8_WAIT_V(8); PG8_WAIT_L(0); PG8_BAR; PG8_MMA(1, 0, At, B0); PG8_MMA(1, 1, At, B1); PG8_BAR; PG8_SCHED;
            PG8_LDB(B0, 1, 0); PG8_LDB(B1, 1, 1); PG8_SCHED; PG8_LDA(At, 1, 0); PG8_STAGE(PG8_SA(0, 1), a2 + hstep, voffA);
            PG8_WAIT_V(8); PG8_WAIT_L(0); PG8_BAR; PG8_MMA(0, 0, At, B0); PG8_MMA(0, 1, At, B1); PG8_BAR; PG8_SCHED;
            PG8_LDA(At, 1, 1); PG8_STAGE(PG8_SB(1, 0), b3, voffB); PG8_STAGE(PG8_SB(1, 1), b3 + hstep, voffB); PG8_STAGE(PG8_SA(1, 0), a3, voffA);
            PG8_WAIT_V(8); PG8_WAIT_L(0); PG8_BAR; PG8_MMA(1, 0, At, B0); PG8_MMA(1, 1, At, B1); PG8_BAR; PG8_SCHED;
            } else {
            PG8_LDB(B0, 0, 0); PG8_SCHED; PG8_LDA(At, 0, 0); PG8_STAGE(PG8_SA(1, 1), a1 + hstep, voffA);
            PG8_WAIT_L(8); PG8_BAR; PG8_WAIT_L(0); PG8_MMA(0, 0, At, B0); PG8_BAR; PG8_SCHED;
            PG8_LDB(B1, 0, 1); PG8_STAGE(PG8_SB(0, 0), b2, voffB);
            PG8_BAR; PG8_WAIT_L(0); PG8_MMA(0, 1, At, B1); PG8_BAR;
            PG8_LDA(At, 0, 1); PG8_STAGE(PG8_SA(0, 0), a2, voffA);
            PG8_BAR; PG8_WAIT_L(0); PG8_MMA(1, 0, At, B0); PG8_BAR; PG8_SCHED;
            PG8_STAGE(PG8_SB(0, 1), b2 + hstep, voffB);
            PG8_WAIT_V(6); PG8_BAR; PG8_MMA(1, 1, At, B1); PG8_BAR;
            PG8_LDB(B0, 1, 0); PG8_SCHED; PG8_LDA(At, 1, 0); PG8_STAGE(PG8_SA(0, 1), a2 + hstep, voffA);
            PG8_WAIT_L(8); PG8_BAR; PG8_WAIT_L(0); PG8_MMA(0, 0, At, B0); PG8_BAR; PG8_SCHED;
            PG8_LDB(B1, 1, 1); PG8_STAGE(PG8_SB(1, 0), b3, voffB);
            PG8_BAR; PG8_WAIT_L(0); PG8_MMA(0, 1, At, B1); PG8_BAR;
            PG8_LDA(At, 1, 1); PG8_STAGE(PG8_SA(1, 0), a3, voffA);
            PG8_BAR; PG8_WAIT_L(0); PG8_MMA(1, 0, At, B0); PG8_BAR; PG8_SCHED;
            PG8_STAGE(PG8_SB(1, 1), b3 + hstep, voffB);
            PG8_WAIT_V(6); PG8_BAR; PG8_MMA(1, 1, At, B1); PG8_BAR;
            }
        }
        if constexpr (ALIGN_EPI) { if (wr == 0) PG8_BAR; }
        if constexpr (DT == 1) asm volatile("s_nop 15\n\ts_nop 15" ::: "memory");
        if constexpr (!Epi::AFTER_DRAIN) { E(acc, cur, wr, wc, fr, fq); S.done(cur); }
        if (!has_next) break;
#pragma unroll
        for (int a = 0; a < 2; ++a)
#pragma unroll
            for (int b = 0; b < 2; ++b)
#pragma unroll
                for (int m = 0; m < 4; ++m)
#pragma unroll
                    for (int n = 0; n < 2; ++n) acc[a][b][m][n] = (f32x4){0.f, 0.f, 0.f, 0.f};
        cur = nxt; cA = nA; cB = nB; ++ui;
        if constexpr (ALIGN_EPI) { if (wr == 1) PG8_BAR; }
    }
    PG8_WAIT_V(0);
    if constexpr (!ALIGN_EPI) { if (wr == 0) PG8_BAR; }
    PG8_BAR;
    if constexpr (Epi::AFTER_DRAIN) { E.fused(acc, cur, wr, wc, fr, fq, lds, wid, lane); S.done(cur); }
#undef PG8_SA
#undef PG8_SB
#undef PG8_STAGE
#undef PG8_LDA
#undef PG8_LDB
#undef PG8_MMA
#undef PG8_WAIT_V
#undef PG8_WAIT_L
#undef PG8_BAR
#undef PG8_SCHED
}
}

namespace pg8 {
__device__ __forceinline__ u32x4 pack8(const f32x4 v0, const f32x4 v1) { u32x4 w; w.x = cvt_pk_bf16(v0[0], v0[1]); w.y = cvt_pk_bf16(v0[2], v0[3]); w.z = cvt_pk_bf16(v1[0], v1[1]); w.w = cvt_pk_bf16(v1[2], v1[3]); return w; }
struct EpiStore {
    static constexpr bool PERM = true, AFTER_DRAIN = false;
    bf16_t* O; int ldc;
    __device__ __forceinline__ void operator()(const f32x4 (&acc)[2][2][4][2], const Unit& u, int wr, int wc, int fr, int fq) const {
        const int row0 = u.pm * BM + wr * 64 + fr, col0 = u.pn * BM + wc * 32 + 8 * fq;
#pragma unroll
        for (int ai = 0; ai < 2; ++ai)
#pragma unroll
            for (int m = 0; m < 4; ++m) { bf16_t* rowp = O + (size_t)(row0 + ai * HALF + m * 16) * ldc + col0;
#pragma unroll
                for (int bj = 0; bj < 2; ++bj) *(u32x4*)(rowp + bj * HALF) = pack8(acc[ai][bj][m][0], acc[ai][bj][m][1]); }
    }
};
struct EpiQ {
    static constexpr bool PERM = true, AFTER_DRAIN = false;
    bf16_t* O; const float* cosT; const float* sinT;
    __device__ __forceinline__ void operator()(const f32x4 (&acc)[2][2][4][2], const Unit& u, int wr, int wc, int fr, int fq) const {
        const int row0 = u.pm * BM + wr * 64 + fr, col0 = u.pn * BM + wc * 32 + 8 * fq;
#pragma unroll
        for (int ai = 0; ai < 2; ++ai)
#pragma unroll
            for (int m = 0; m < 4; ++m) { const int row = row0 + ai * HALF + m * 16; const bool lat = row < 8192; const int t = row & 2047;
#pragma unroll
                for (int bj = 0; bj < 2; ++bj) { const int col = col0 + bj * HALF; const int jn = col - 192 * (col / 192);
                    f32x4 v0 = acc[ai][bj][m][0], v1 = acc[ai][bj][m][1];
                    if (jn >= 128 && lat) { const int i0 = (jn - 128) >> 1;
                        const f32x4 cs = *(const f32x4*)(cosT + t * 32 + i0), sn = *(const f32x4*)(sinT + t * 32 + i0);
                        f32x4 r0, r1;
                        r0[0] = v0[0] * cs[0] - v0[1] * sn[0]; r0[1] = v0[0] * sn[0] + v0[1] * cs[0];
                        r0[2] = v0[2] * cs[1] - v0[3] * sn[1]; r0[3] = v0[2] * sn[1] + v0[3] * cs[1];
                        r1[0] = v1[0] * cs[2] - v1[1] * sn[2]; r1[1] = v1[0] * sn[2] + v1[1] * cs[2];
                        r1[2] = v1[2] * cs[3] - v1[3] * sn[3]; r1[3] = v1[2] * sn[3] + v1[3] * cs[3];
                        v0 = r0; v1 = r1; }
                    *(u32x4*)(O + (size_t)row * 1536 + col) = pack8(v0, v1); } }
    }
};
__device__ __forceinline__ f32x4 bf4_lo(const u32x4 q) { return (f32x4){__uint_as_float(q.x << 16), __uint_as_float(q.x & 0xffff0000u), __uint_as_float(q.y << 16), __uint_as_float(q.y & 0xffff0000u)}; }
__device__ __forceinline__ f32x4 bf4_hi(const u32x4 q) { return (f32x4){__uint_as_float(q.z << 16), __uint_as_float(q.z & 0xffff0000u), __uint_as_float(q.w << 16), __uint_as_float(q.w & 0xffff0000u)}; }
struct EpiResid {
    static constexpr bool PERM = true, AFTER_DRAIN = false;
    bf16_t* xs; const float* rd_lat; const float* gate; bf16_t* slab; int tail_row0, tail_rows; float scale;
    __device__ __forceinline__ void operator()(const f32x4 (&acc)[2][2][4][2], const Unit& u, int wr, int wc, int fr, int fq) const {
        const int row0 = u.pm * BM + wr * 64 + fr, colb = u.pn * BM + wc * 32 + 8 * fq;
        if (u.slab >= 0) {
#pragma unroll
            for (int ai = 0; ai < 2; ++ai)
#pragma unroll
                for (int m = 0; m < 4; ++m) { bf16_t* sp = slab + ((size_t)u.slab * tail_rows + (row0 + ai * HALF + m * 16 - tail_row0)) * 2048;
#pragma unroll
                    for (int bj = 0; bj < 2; ++bj) *(u32x4*)(sp + colb + bj * HALF) = pack8(acc[ai][bj][m][0] * scale, acc[ai][bj][m][1] * scale); }
            return;
        }
#pragma unroll
        for (int ai = 0; ai < 2; ++ai)
#pragma unroll
            for (int m = 0; m < 4; ++m) { const int row = row0 + ai * HALF + m * 16; const float* gv = gate + (size_t)(row < 8192 ? (row >> 11) : 4) * 12288; bf16_t* xr = xs + (size_t)row * 2048;
#pragma unroll
                for (int bj = 0; bj < 2; ++bj) { const int col = colb + bj * HALF; f32x4 x0, x1;
                    if (rd_lat) { x0 = *(const f32x4*)(rd_lat + (size_t)row * 2048 + col); x1 = *(const f32x4*)(rd_lat + (size_t)row * 2048 + col + 4); }
                    else { const u32x4 q = *(const u32x4*)(xr + col); x0 = bf4_lo(q); x1 = bf4_hi(q); }
                    const f32x4 g0 = *(const f32x4*)(gv + col), g1 = *(const f32x4*)(gv + col + 4);
                    x0 += (g0 * scale) * acc[ai][bj][m][0]; x1 += (g1 * scale) * acc[ai][bj][m][1]; *(u32x4*)(xr + col) = pack8(x0, x1); }
                if (m & 1) asm volatile("" ::: "memory"); }
    }
};
__device__ __forceinline__ unsigned pack4_fp8(float a, float b, float c, float d) {
    a = __builtin_amdgcn_fmed3f(a, -448.f, 448.f); b = __builtin_amdgcn_fmed3f(b, -448.f, 448.f); c = __builtin_amdgcn_fmed3f(c, -448.f, 448.f); d = __builtin_amdgcn_fmed3f(d, -448.f, 448.f);
    unsigned w = 0; w = __builtin_amdgcn_cvt_pk_fp8_f32(a, b, w, false); w = __builtin_amdgcn_cvt_pk_fp8_f32(c, d, w, true); return w; }
struct EpiSwiGLU8 {
    static constexpr bool PERM = true, AFTER_DRAIN = false;
    unsigned char* O; int ldc; float s, oscale;
    __device__ __forceinline__ void operator()(const f32x4 (&acc)[2][2][4][2], const Unit& u, int wr, int wc, int fr, int fq) const {
        if (PROBE_SUB != 0u && O == nullptr) return;
        const int row0 = u.pm * BM + wr * 64 + fr, col0 = u.pn * HALF + wc * 32 + 8 * fq;
#pragma unroll
        for (int ai = 0; ai < 2; ++ai)
#pragma unroll
            for (int m = 0; m < 4; ++m) { f32x4 o0, o1;
#pragma unroll
                for (int j = 0; j < 4; ++j) { const float g0 = acc[ai][0][m][0][j] * s, g1 = acc[ai][0][m][1][j] * s;
                    o0[j] = g0 * __builtin_amdgcn_rcpf(1.0f + __expf(-g0)) * (acc[ai][1][m][0][j] * (s * oscale)); o1[j] = g1 * __builtin_amdgcn_rcpf(1.0f + __expf(-g1)) * (acc[ai][1][m][1][j] * (s * oscale)); }
                u32x2 w; w.x = pack4_fp8(o0[0], o0[1], o0[2], o0[3]); w.y = pack4_fp8(o1[0], o1[1], o1[2], o1[3]);
                *(u32x2*)(O + (size_t)(row0 + ai * HALF + m * 16) * ldc + col0) = w; }
    }
};
__device__ __forceinline__ f32x4 i2f4(const f32x4 bits) { const v4i_t iv = __builtin_bit_cast(v4i_t, bits); return (f32x4){(float)iv[0], (float)iv[1], (float)iv[2], (float)iv[3]}; }
struct EpiStoreI8 {
    static constexpr bool PERM = true, AFTER_DRAIN = false;
    bf16_t* O; int ldc; const float* rsc; float sw;
    __device__ __forceinline__ void operator()(const f32x4 (&acc)[2][2][4][2], const Unit& u, int wr, int wc, int fr, int fq) const {
        const int row0 = u.pm * BM + wr * 64 + fr, col0 = u.pn * BM + wc * 32 + 8 * fq;
#pragma unroll
        for (int ai = 0; ai < 2; ++ai)
#pragma unroll
            for (int m = 0; m < 4; ++m) { const int row = row0 + ai * HALF + m * 16; const float sc = rsc[row] * sw; bf16_t* rowp = O + (size_t)row * ldc + col0;
#pragma unroll
                for (int bj = 0; bj < 2; ++bj) *(u32x4*)(rowp + bj * HALF) = pack8(i2f4(acc[ai][bj][m][0]) * sc, i2f4(acc[ai][bj][m][1]) * sc); }
    }
};
struct EpiSwiGLUI8 {
    static constexpr bool PERM = true, AFTER_DRAIN = false;
    unsigned char* O; int ldc; const float* rsc; float swg, swu, oscale;
    __device__ __forceinline__ void operator()(const f32x4 (&acc)[2][2][4][2], const Unit& u, int wr, int wc, int fr, int fq) const {
        const int row0 = u.pm * BM + wr * 64 + fr, col0 = u.pn * HALF + wc * 32 + 8 * fq;
#pragma unroll
        for (int ai = 0; ai < 2; ++ai)
#pragma unroll
            for (int m = 0; m < 4; ++m) { const int row = row0 + ai * HALF + m * 16; const float sa = rsc[row], sg = sa * swg, su = sa * swu * oscale; f32x4 o0, o1;
                const f32x4 g0v = i2f4(acc[ai][0][m][0]) * sg, g1v = i2f4(acc[ai][0][m][1]) * sg, u0v = i2f4(acc[ai][1][m][0]) * su, u1v = i2f4(acc[ai][1][m][1]) * su;
#pragma unroll
                for (int j = 0; j < 4; ++j) { o0[j] = g0v[j] * __builtin_amdgcn_rcpf(1.0f + __expf(-g0v[j])) * u0v[j]; o1[j] = g1v[j] * __builtin_amdgcn_rcpf(1.0f + __expf(-g1v[j])) * u1v[j]; }
                u32x2 w; w.x = pack4_fp8(o0[0], o0[1], o0[2], o0[3]); w.y = pack4_fp8(o1[0], o1[1], o1[2], o1[3]);
                *(u32x2*)(O + (size_t)row * ldc + col0) = w; }
    }
};
struct EpiSwiGLU {
    static constexpr bool PERM = true, AFTER_DRAIN = false;
    bf16_t* O; int ldc;
    __device__ __forceinline__ void operator()(const f32x4 (&acc)[2][2][4][2], const Unit& u, int wr, int wc, int fr, int fq) const {
        const int row0 = u.pm * BM + wr * 64 + fr, col0 = u.pn * HALF + wc * 32 + 8 * fq;
#pragma unroll
        for (int ai = 0; ai < 2; ++ai)
#pragma unroll
            for (int m = 0; m < 4; ++m) { f32x4 o0, o1;
#pragma unroll
                for (int j = 0; j < 4; ++j) { const float g0 = acc[ai][0][m][0][j], g1 = acc[ai][0][m][1][j];
                    o0[j] = g0 / (1.0f + __expf(-g0)) * acc[ai][1][m][0][j]; o1[j] = g1 / (1.0f + __expf(-g1)) * acc[ai][1][m][1][j]; }
                *(u32x4*)(O + (size_t)(row0 + ai * HALF + m * 16) * ldc + col0) = pack8(o0, o1); }
    }
};
struct EpiF32 {
    static constexpr bool PERM = false, AFTER_DRAIN = false;
    float* O; int ldc; float* slab; int tail_row0, tail_rows; float scale;
    __device__ __forceinline__ void operator()(const f32x4 (&acc)[2][2][4][2], const Unit& u, int wr, int wc, int fr, int fq) const {
        const int row0 = u.pm * BM + wr * 64 + fr, colb = u.pn * BM + wc * 32 + 4 * fq;
#pragma unroll
        for (int ai = 0; ai < 2; ++ai)
#pragma unroll
            for (int m = 0; m < 4; ++m) { float* xr = (u.slab >= 0) ? slab + ((size_t)u.slab * tail_rows + (row0 + ai * HALF + m * 16 - tail_row0)) * 2048 : O + (size_t)(row0 + ai * HALF + m * 16) * ldc;
#pragma unroll
                for (int bj = 0; bj < 2; ++bj)
#pragma unroll
                    for (int n = 0; n < 2; ++n) *(f32x4*)(xr + colb + bj * HALF + n * 16) = acc[ai][bj][m][n] * scale; }
    }
};
struct EpiYs {
    static constexpr bool PERM = true, AFTER_DRAIN = false;
    bf16_t* O; bf16_t* slab; int tail_row0, tail_rows; float scale;
    __device__ __forceinline__ void operator()(const f32x4 (&acc)[2][2][4][2], const Unit& u, int wr, int wc, int fr, int fq) const {
        const int row0 = u.pm * BM + wr * 64 + fr, colb = u.pn * BM + wc * 32 + 8 * fq;
#pragma unroll
        for (int ai = 0; ai < 2; ++ai)
#pragma unroll
            for (int m = 0; m < 4; ++m) { const int row = row0 + ai * HALF + m * 16; bf16_t* xr = (u.slab >= 0) ? slab + ((size_t)u.slab * tail_rows + (row - tail_row0)) * 2048 : O + (size_t)row * 2048;
#pragma unroll
                for (int bj = 0; bj < 2; ++bj) *(u32x4*)(xr + colb + bj * HALF) = pack8(acc[ai][bj][m][0] * scale, acc[ai][bj][m][1] * scale); }
    }
};
struct MoeOrder {
    int nM, nN, nwg, G, c, nkt; int t1[8]; size_t estride;
    __device__ __forceinline__ void init(const int* ctl, int nN_, int G_, int c_, size_t estride_, int K) { nkt = K / BK;
        int acc = 0;
#pragma unroll
        for (int e = 0; e < 8; ++e) { acc += __builtin_amdgcn_readfirstlane(ctl[CT_EPAD + e]) >> 8; t1[e] = acc; }
        nM = acc; nN = nN_; nwg = nM * nN; G = G_; c = c_; estride = estride_;
    }
    __device__ __forceinline__ bool next(int i, Unit& u) const {
        const long L = (long)i * G + c; if (L >= nwg) return false;
        int wgid = (int)L; { const int q = nwg / NXCD, r = nwg % NXCD, xcd = wgid % NXCD, off = wgid / NXCD; wgid = (xcd < r ? xcd * (q + 1) : r * (q + 1) + (xcd - r) * q) + off; }
        const int nig = WGM * nN, gid = wgid / nig, fm = gid * WGM, gsz = (nM - fm) < WGM ? (nM - fm) : WGM;
        u.pm = fm + ((wgid % nig) % gsz); u.pn = (wgid % nig) / gsz; u.kt0 = 0; u.nkt = nkt; u.slab = -1; return true;
    }
    __device__ __forceinline__ size_t bt_off(const Unit& u) const { int e = 0;
#pragma unroll
        for (int k = 0; k < 7; ++k) e += (u.pm >= t1[k]) ? 1 : 0;
        return (size_t)e * estride; }
    __device__ __forceinline__ void a_ready(const Unit&) const {}
    __device__ __forceinline__ void done(const Unit&) const {}
};
struct WinLastOrder {
    StaticOrder so; int G, c;
    __device__ __forceinline__ void init(int G_, int c_, int K) { so.init(NLAT, UW, G_, c_, K); G = G_; c = c_; }
    __device__ __forceinline__ bool next(int i, Unit& u) const {
        if (so.next(i, u)) return true;
        const long L = (long)i * G + c - so.nwg; if (L < 0 || L >= 20) return false;
        const int j = (int)L, k = j % 5; u.pm = 32 + j / 5; u.pn = k < 3 ? 3 + k : 10 + k; u.kt0 = 0; u.nkt = so.nkt; u.slab = -1; return true;
    }
    __device__ __forceinline__ size_t bt_off(const Unit&) const { return 0; }
    __device__ __forceinline__ void a_ready(const Unit&) const {}
    __device__ __forceinline__ void done(const Unit&) const {}
};
struct SplitOrder {
    int nM, nN, nwg, G, c, nfull, ntail, S, nkt, nkts; int t1[8]; size_t estride;
    __device__ __forceinline__ void init(int nM_, int nN_, int G_, int c_, int K, int S_) {
        nM = nM_; nN = nN_; nwg = nM * nN; G = G_; c = c_; nkt = K / BK; nfull = (nwg / 256) * 256; ntail = nwg - nfull; S = S_; nkts = nkt / S; estride = 0;
#pragma unroll
        for (int e = 0; e < 8; ++e) t1[e] = 0;
    }
    __device__ __forceinline__ void init_moe(const int* ctl, int nN_, int G_, int c_, int K, size_t estride_) {
        int acc = 0;
#pragma unroll
        for (int e = 0; e < 8; ++e) { acc += __builtin_amdgcn_readfirstlane(ctl[CT_EPAD + e]) >> 8; t1[e] = acc; }
        init(acc, nN_, G_, c_, K, __builtin_amdgcn_readfirstlane(ctl[CT_MOES])); estride = estride_;
        acc = 0;
#pragma unroll
        for (int e = 0; e < 8; ++e) { acc += __builtin_amdgcn_readfirstlane(ctl[CT_EPAD + e]) >> 8; t1[e] = acc; }
    }
    __device__ __forceinline__ bool next(int i, Unit& u) const {
        const long L = (long)i * G + c; int wgid;
        if (L < nfull) { wgid = (int)L; { const int q = nfull / NXCD, xcd = wgid % NXCD, off = wgid / NXCD; wgid = xcd * q + off; } u.kt0 = 0; u.nkt = nkt; u.slab = -1; }
        else { const int j = (int)(L - nfull); if (j >= ntail * S) return false; const int tu = j / S, sl = j - tu * S; wgid = nfull + tu; u.kt0 = sl * nkts; u.nkt = nkts; u.slab = (S > 1) ? sl : -1; }
        const int nig = WGM * nN, gid = wgid / nig, fm = gid * WGM, gsz = (nM - fm) < WGM ? (nM - fm) : WGM;
        u.pm = fm + ((wgid % nig) % gsz); u.pn = (wgid % nig) / gsz; return true;
    }
    __device__ __forceinline__ size_t bt_off(const Unit& u) const { if (estride == 0) return 0; int e = 0;
#pragma unroll
        for (int k = 0; k < 7; ++k) e += (u.pm >= t1[k]) ? 1 : 0;
        return (size_t)e * estride; }
    __device__ __forceinline__ void a_ready(const Unit&) const {}
    __device__ __forceinline__ void done(const Unit&) const {}
};
__host__ __device__ constexpr int split_S(int nwg, int nkt, int G) {
    const int ntail = nwg - (nwg / G) * G;
    if (ntail == 0) return 1;
    if (nkt % 28 == 0 && ntail * 14 <= G) return 14;
    if (nkt % 16 == 0 && ntail * 8 <= G) return 8;
    if (nkt % 14 == 0 && ntail * 7 <= G) return 7;
    if (nkt % 8 == 0 && ntail * 4 <= G) return 4;
    if (nkt % 4 == 0 && ntail * 2 <= G) return 2;
    return 1;
}
}

#define LAS __attribute__((address_space(3)))
#define XB_TMO      128
#define XB_XCNT(j)  (256  + 64 * (j))
#define XB_XSUB(j)  (1280 + 64 * (j))
#define XB_XGEN(j)  (2304 + 64 * (j))
#define XB_TOP      3328
#define XB_TOPGEN   3392
#define XCD_BAR_WORDS 3456
#define XB_SPIN_CAP (1u << 18)

__device__ __forceinline__ unsigned xb_ld(unsigned* p)              { return __hip_atomic_load(p, __ATOMIC_RELAXED, __HIP_MEMORY_SCOPE_AGENT); }
__device__ __forceinline__ unsigned xb_add(unsigned* p, unsigned v) { return __hip_atomic_fetch_add(p, v, __ATOMIC_RELAXED, __HIP_MEMORY_SCOPE_AGENT); }
__device__ __forceinline__ unsigned xb_xcc_id() { return (unsigned)__builtin_amdgcn_s_getreg((3 << 11) | 20) & 0xFu; }
#define XB_SPIN(cond, bar) do { unsigned _sp = 0; while (cond) { __builtin_amdgcn_s_sleep(1); \
    if ((++_sp & 255u) == 0u) { if (xb_ld(&(bar)[XB_TMO])) break; if (_sp > XB_SPIN_CAP) { atomicAdd(&(bar)[XB_TMO], 1u); break; } } } } while (0)

struct XcdBarrier {
    unsigned* bar; unsigned x;
    volatile LAS unsigned* st;
};

__device__ __forceinline__ XcdBarrier xcd_barrier_post(unsigned* bar, volatile LAS unsigned* st) {
    XcdBarrier b; b.bar = bar; b.x = xb_xcc_id(); b.st = st;
    if (threadIdx.x == 0) (void)xb_add(&bar[XB_XCNT(b.x)], 1u);
    return b;
}
__device__ __forceinline__ void xcd_barrier_complete(unsigned* bar, unsigned x, unsigned& nloc, unsigned& nx) {
    const unsigned G = gridDim.x * gridDim.y * gridDim.z;
    unsigned sum, cnt, mine, sp = 0u;
    for (;;) {
        sum = 0u; cnt = 0u; mine = 0u;
#pragma unroll
        for (unsigned j = 0; j < 16; ++j) { const unsigned c = xb_ld(&bar[XB_XCNT(j)]); sum += c; cnt += (c > 0u) ? 1u : 0u; mine = (j == x) ? c : mine; }
        if (sum == G) break;
        __builtin_amdgcn_s_sleep(1);
        if ((++sp & 255u) == 0u) { if (xb_ld(&bar[XB_TMO])) break; if (sp > XB_SPIN_CAP) { atomicAdd(&bar[XB_TMO], 1u); break; } }
    }
    nloc = mine > 0u ? mine : 1u; nx = cnt > 0u ? cnt : 1u;
}

__device__ __forceinline__ void xcd_barrier(const XcdBarrier& b) {
    asm volatile("s_waitcnt vmcnt(0)" ::: "memory");
    __syncthreads();
    if (threadIdx.x == 0) {
        unsigned* bar = b.bar;
        __builtin_amdgcn_s_waitcnt(0);
        unsigned nloc = b.st[0], nx = b.st[1];
        if (nloc == 0u) { xcd_barrier_complete(bar, b.x, nloc, nx); b.st[0] = nloc; b.st[1] = nx; }
        const unsigned old = xb_add(&bar[XB_XSUB(b.x)], 1u);
        const unsigned gen = old / nloc;
        if (old + 1u == (gen + 1u) * nloc) {
            __builtin_amdgcn_fence(__ATOMIC_RELEASE, "agent");
            asm volatile("s_waitcnt vmcnt(0)" ::: "memory");
            const unsigned og = xb_add(&bar[XB_TOP], 1u);
            const unsigned tg = og / nx;
            if (og + 1u == (tg + 1u) * nx) xb_add(&bar[XB_TOPGEN], 1u);
            else XB_SPIN(xb_ld(&bar[XB_TOPGEN]) == tg, bar);
            __builtin_amdgcn_fence(__ATOMIC_ACQUIRE, "agent");
            xb_add(&bar[XB_XGEN(b.x)], 1u);
            asm volatile("s_waitcnt vmcnt(0)" ::: "memory");
        } else {
            XB_SPIN(xb_ld(&bar[XB_XGEN(b.x)]) == gen, bar);
            __builtin_amdgcn_fence(__ATOMIC_ACQUIRE, "agent");
            asm volatile("s_waitcnt vmcnt(0)" ::: "memory");
        }
    }
    __syncthreads();
}


struct Args { const float* in[34]; float* out; unsigned char* ws; int ph_lo, ph_hi; };

enum { MAP_ID = 0, MAP_ROPEQ = 1, MAP_GU0 = 2, MAP_GU1 = 3, MAP_KV = 4 };
struct JobDesc { int in_idx, K, N, nbatch, upb, map; long long src_off, src_bstride, dst_off, dst_bstride; int fp8, sidx; };
constexpr int NJOBS = 14, NCONV = 12664;
constexpr int G1_GEMM = CQ1 > 0 ? 184 : 256, G2_GEMM = CQ2 > 0 ? 232 : 256;
constexpr int TAIL1_BLK0 = 540 - 2 * G1_GEMM, TAIL1_N = G1_GEMM - TAIL1_BLK0, CONV1_N = 256 - G1_GEMM;
constexpr int TAIL2_BLK0 = 1584 - 6 * G2_GEMM, TAIL2_N = G2_GEMM - TAIL2_BLK0, CONV2_N = 256 - G2_GEMM;
constexpr int TAIL3_BLK0 = 64, TAIL3_N = 192, TAIL4_BLK0 = 32, TAIL4_N = 224;
constexpr int NCONV_T1 = TAIL1_N * TAILQ1 + CONV1_N * CQ1, NCONV_T2 = TAIL2_N * TAILQ2 + CONV2_N * CQ2, NCONV_T3 = TAIL3_N * TAILQ3, NCONV_T4 = TAIL4_N * TAILQ4, NCONV_Q = NCONV - NCONV_T1 - NCONV_T2 - NCONV_T3 - NCONV_T4;
static_assert(NCONV_Q % 2 == 0 && NCONV_Q >= 1912, "the prologue queue takes pairs; the tails only hold expert weights");
__constant__ JobDesc c_jobs[NJOBS] = {
    {8, 2048, 3648, 1, 232, MAP_ID, 0, 0, (long long)WS_WIN, 0, I8_WIN ? 2 : 0, 0},
    {8, 2048, 3648, 1, 232, MAP_ID, 2048LL * 3648, 0, (long long)(WS_WIN + (size_t)UW * D * 2), 0, I8_WIN ? 2 : 0, 1},
    {10, 768, 1536, 1, 36, MAP_ROPEQ, 0, 0, (long long)WS_WQ, 0},
    {10, 768, 1536, 1, 36, MAP_ROPEQ, 768LL * 1536, 0, (long long)(WS_WQ + (size_t)QW * 768 * 2), 0},
    {12, 512, 2048, 1, 32, MAP_KV, 0, 0, (long long)WS_WKV, 0},
    {12, 512, 2048, 1, 32, MAP_KV, 512LL * 2048, 0, (long long)(WS_WKV + (size_t)KVW * 512 * 2), 0},
    {25, 2048, 2048, 1, 128, MAP_ID, 0, 0, (long long)WS_WOUT, 0},
    {25, 2048, 2048, 1, 128, MAP_ID, 2048LL * 2048, 0, (long long)(WS_WOUT + (size_t)D * D * 2), 0},
    {26, 2048, 5632, 1, 352, MAP_GU0, 0, 0, (long long)WS_WGU, 0, I8_GU ? 2 : FP8_DENSE, 2},
    {27, 2048, 5632, 1, 352, MAP_GU1, 0, 0, (long long)WS_WGU, 0, I8_GU ? 2 : FP8_DENSE, 3},
    {28, 5632, 2048, 1, 352, MAP_ID, 0, 0, (long long)WS_WDN, 0, (FP8_DENSE || FP8_DOWN), 0},
    {30, 2048, 7168, 8, 448, MAP_GU0, 0, 2048LL * 7168, (long long)WS_MGU, 2LL * DFE * D, 1, 0},
    {31, 2048, 7168, 8, 448, MAP_GU1, 0, 2048LL * 7168, (long long)WS_MGU, 2LL * DFE * D, 1, 0},
    {32, 7168, 2048, 8, 448, MAP_ID, 0, 7168LL * 2048, (long long)WS_MDN, (long long)D * DFE, 1, 0},
};
struct ConvUnit { const float* src; bf16_t* dst; int K, N, map, k0, n0, fp8; float qs; };
__device__ __forceinline__ unsigned pack4_i8(float a, float b, float c, float d) {
    const int ia = (int)__builtin_rintf(__builtin_amdgcn_fmed3f(a, -127.f, 127.f)), ib = (int)__builtin_rintf(__builtin_amdgcn_fmed3f(b, -127.f, 127.f)), ic = (int)__builtin_rintf(__builtin_amdgcn_fmed3f(c, -127.f, 127.f)), id = (int)__builtin_rintf(__builtin_amdgcn_fmed3f(d, -127.f, 127.f));
    return (unsigned)(ia & 0xff) | ((unsigned)(ib & 0xff) << 8) | ((unsigned)(ic & 0xff) << 16) | ((unsigned)(id & 0xff) << 24); }
constexpr float WSCALE = 64.f, ASCALE = 8.f;
__device__ __forceinline__ void conv_decode(const Args& a, int u, ConvUnit& cu) {
    int j = 0, base = 0;
    for (;;) { const int n = c_jobs[j].nbatch * c_jobs[j].upb; if (u < base + n || j == NJOBS - 1) break; base += n; ++j; }
    const JobDesc& jd = c_jobs[j];
    int r = u - base; const int bt = r / jd.upb; r -= bt * jd.upb; const int ntn = (jd.N + 127) >> 7; int kt = r / ntn, nt = r - kt * ntn;
    if (((jd.K >> 8) & 1) == 0) { const int r2 = r >> 1; kt = 2 * (r2 / ntn) + (r & 1); nt = r2 % ntn; }
    cu.K = jd.K; cu.N = jd.N; cu.map = jd.map; cu.k0 = kt * 256; cu.n0 = nt * 128; cu.fp8 = jd.fp8; cu.qs = 1.0f;
    if (jd.fp8 == 2) { const float am = __uint_as_float(__hip_atomic_load((const unsigned*)(a.ws + WS_CTL) + CT_WSC + jd.sidx, __ATOMIC_RELAXED, __HIP_MEMORY_SCOPE_AGENT)); cu.qs = am > 0.f ? 127.0f / am : 0.f; }
    const float* sb = j < 2 ? a.in[8] : j < 4 ? a.in[10] : j < 6 ? a.in[12] : j < 8 ? a.in[25] : j == 8 ? a.in[26] : j == 9 ? a.in[27] : j == 10 ? a.in[28] : j == 11 ? a.in[30] : j == 12 ? a.in[31] : a.in[32];
    cu.src = sb + jd.src_off + (long long)bt * jd.src_bstride + (size_t)cu.k0 * jd.N + cu.n0;
    cu.dst = (bf16_t*)(a.ws + jd.dst_off + (long long)bt * jd.dst_bstride);
}
__device__ __forceinline__ int conv_row(int map, int n) {
    if (map == MAP_ID) return n;
    if (map == MAP_GU0) return ((n >> 7) << 8) + (n & 127);
    if (map == MAP_GU1) return ((n >> 7) << 8) + 128 + (n & 127);
    if (map == MAP_KV) { const int hh = n >> 8, jn = n & 255; return jn < 128 ? hh * 128 + jn : 1024 + hh * 128 + (jn - 128); }
    const int hh = n / 192, jn = n - hh * 192; if (jn < 128) return n; const int q = jn - 128; return hh * 192 + 128 + 2 * (q & 31) + (q >> 5);
}
constexpr int CV_P = 129, CV_BUF = 65536;
#define CONV_LOAD(R, CU) do { const bool ok_ = (CU).n0 + (tid & 31) * 4 < (CU).N; const float* sp_ = (CU).src + (size_t)((tid >> 5) * 16) * (CU).N + (tid & 31) * 4; \
        _Pragma("unroll") for (int i_ = 0; i_ < 16; ++i_) R[i_] = ok_ ? __builtin_nontemporal_load((const f32x4*)(sp_ + (size_t)i_ * (CU).N)) : (f32x4){0.f, 0.f, 0.f, 0.f}; } while (0)
__device__ __forceinline__ void conv_put(const f32x4 (&R)[16], const ConvUnit& cu, unsigned char* buf, int tid) {
    const int nq = tid & 31, kc = tid >> 5;
    if (cu.fp8 == 2) {
        const float qs = cu.qs;
#pragma unroll
        for (int c = 0; c < 4; ++c) { u32x4 w;
            w.x = pack4_i8(R[0][c] * qs, R[1][c] * qs, R[2][c] * qs, R[3][c] * qs); w.y = pack4_i8(R[4][c] * qs, R[5][c] * qs, R[6][c] * qs, R[7][c] * qs);
            w.z = pack4_i8(R[8][c] * qs, R[9][c] * qs, R[10][c] * qs, R[11][c] * qs); w.w = pack4_i8(R[12][c] * qs, R[13][c] * qs, R[14][c] * qs, R[15][c] * qs);
            *(u32x4*)(buf + (4 * nq + c) * 256 + ((kc ^ (nq & 15)) << 4)) = w; }
    } else if (cu.fp8) {
#pragma unroll
        for (int c = 0; c < 4; ++c) { u32x4 w;
            w.x = pg8::pack4_fp8(R[0][c] * WSCALE, R[1][c] * WSCALE, R[2][c] * WSCALE, R[3][c] * WSCALE); w.y = pg8::pack4_fp8(R[4][c] * WSCALE, R[5][c] * WSCALE, R[6][c] * WSCALE, R[7][c] * WSCALE);
            w.z = pg8::pack4_fp8(R[8][c] * WSCALE, R[9][c] * WSCALE, R[10][c] * WSCALE, R[11][c] * WSCALE); w.w = pg8::pack4_fp8(R[12][c] * WSCALE, R[13][c] * WSCALE, R[14][c] * WSCALE, R[15][c] * WSCALE);
            *(u32x4*)(buf + (4 * nq + c) * 256 + ((kc ^ (nq & 15)) << 4)) = w; }
    } else {
#pragma unroll
        for (int c = 0; c < 4; ++c) { u32x4 w0, w1;
            w0.x = pg8::cvt_pk_bf16(R[0][c], R[1][c]); w0.y = pg8::cvt_pk_bf16(R[2][c], R[3][c]); w0.z = pg8::cvt_pk_bf16(R[4][c], R[5][c]); w0.w = pg8::cvt_pk_bf16(R[6][c], R[7][c]);
            w1.x = pg8::cvt_pk_bf16(R[8][c], R[9][c]); w1.y = pg8::cvt_pk_bf16(R[10][c], R[11][c]); w1.z = pg8::cvt_pk_bf16(R[12][c], R[13][c]); w1.w = pg8::cvt_pk_bf16(R[14][c], R[15][c]);
            *(u32x4*)(buf + (4 * nq + c) * 512 + (((2 * kc) ^ nq) << 4)) = w0; *(u32x4*)(buf + (4 * nq + c) * 512 + (((2 * kc + 1) ^ nq) << 4)) = w1; }
    }
}
__device__ __forceinline__ void conv_out(const ConvUnit& cur, const unsigned char* buf, int tid) {
    if (cur.fp8) {
#pragma unroll
        for (int j = 0; j < 4; ++j) { const int nl = (tid >> 4) + 32 * j, ch = tid & 15;
            if (cur.n0 + nl < cur.N) { const int row = conv_row(cur.map, cur.n0 + nl); const u32x4 w = *(const u32x4*)(buf + nl * 256 + ((ch ^ ((nl >> 2) & 15)) << 4));
                *(u32x4*)((unsigned char*)cur.dst + (size_t)row * cur.K + cur.k0 + ch * 16) = w; } }
    } else {
#pragma unroll
        for (int j = 0; j < 8; ++j) { const int nl = (tid >> 5) + 16 * j, ch = tid & 31;
            if (cur.n0 + nl < cur.N) { const int row = conv_row(cur.map, cur.n0 + nl); const u32x4 w = *(const u32x4*)(buf + nl * 512 + ((ch ^ ((nl >> 2) & 31)) << 4));
                *(u32x4*)((unsigned char*)cur.dst + ((size_t)row * cur.K + cur.k0) * 2 + ch * 16) = w; } }
    }
}
template <int MODE = 0>
__device__ __forceinline__ void ph_convert(const Args& a, float* tile, int first, int stride, int end) {
    const int tid = threadIdx.x; unsigned char* buf = (unsigned char*)tile;
    int u = first; ConvUnit cuA, cuB; f32x4 rA[16], rB[16];
#pragma unroll
    for (int i = 0; i < 16; ++i) { rA[i] = (f32x4){0.f, 0.f, 0.f, 0.f}; rB[i] = rA[i]; }
    if (u < end) { conv_decode(a, u, cuA); if (MODE != 2) CONV_LOAD(rA, cuA); }
    if (u + stride < end) { conv_decode(a, u + stride, cuB); if (MODE != 2) CONV_LOAD(rB, cuB); }
    while (u < end) {
        conv_put(rA, cuA, buf, tid);
        __syncthreads();
        { const ConvUnit cur = cuA; const int un = u + 2 * stride; if (un < end) { conv_decode(a, un, cuA); if (MODE != 2) CONV_LOAD(rA, cuA); } if (MODE != 1) conv_out(cur, buf, tid); }
        u += stride; if (u >= end) break;
        conv_put(rB, cuB, buf + CV_BUF, tid);
        __syncthreads();
        { const ConvUnit cur = cuB; const int un = u + 2 * stride; if (un < end) { conv_decode(a, un, cuB); if (MODE != 2) CONV_LOAD(rB, cuB); } if (MODE != 1) conv_out(cur, buf + CV_BUF, tid); }
        u += stride;
    }
    __syncthreads();
}
constexpr int CT_QNEXT = 1152;
template <int MODE = 0>
__device__ __forceinline__ void conv_dynamic(const Args& a, float* tile) {
    unsigned* qn = (unsigned*)(a.ws + WS_CTL) + CT_QNEXT; volatile int* bc = (volatile int*)(tile + 256 * CV_P + 4);
    const int tid = threadIdx.x;
    if (tid == 0) { bc[0] = (int)__hip_atomic_fetch_add(qn, 1u, __ATOMIC_RELAXED, __HIP_MEMORY_SCOPE_AGENT); bc[1] = (int)__hip_atomic_fetch_add(qn, 1u, __ATOMIC_RELAXED, __HIP_MEMORY_SCOPE_AGENT); }
    __syncthreads();
    int q = bc[0], qN = bc[1];
    __syncthreads();
    ConvUnit cuA, cuB; f32x4 rA[16], rB[16];
#pragma unroll
    for (int i = 0; i < 16; ++i) { rA[i] = (f32x4){0.f, 0.f, 0.f, 0.f}; rB[i] = rA[i]; }
    if (2 * q < NCONV_Q) { conv_decode(a, 2 * q, cuA); if (MODE != 2) CONV_LOAD(rA, cuA); }
    if (2 * q + 1 < NCONV_Q) { conv_decode(a, 2 * q + 1, cuB); if (MODE != 2) CONV_LOAD(rB, cuB); }
    unsigned char* buf = (unsigned char*)tile;
    while (2 * q < NCONV_Q) {
        const bool hasB = 2 * q + 1 < NCONV_Q;
        conv_put(rA, cuA, buf, tid);
        __syncthreads();
        { const ConvUnit cur = cuA; if (2 * qN < NCONV_Q) { conv_decode(a, 2 * qN, cuA); if (MODE != 2) CONV_LOAD(rA, cuA); }
          if (tid == 0) bc[0] = (int)__hip_atomic_fetch_add(qn, 1u, __ATOMIC_RELAXED, __HIP_MEMORY_SCOPE_AGENT);
          if (MODE != 1) conv_out(cur, buf, tid); }
        if (hasB) {
            conv_put(rB, cuB, buf + CV_BUF, tid);
            __syncthreads();
            { const ConvUnit cur = cuB; if (2 * qN + 1 < NCONV_Q) { conv_decode(a, 2 * qN + 1, cuB); if (MODE != 2) CONV_LOAD(rB, cuB); }
              if (MODE != 1) conv_out(cur, buf + CV_BUF, tid); }
        } else __syncthreads();
        q = qN; qN = bc[0];
    }
    __syncthreads();
}
#undef CONV_LOAD
constexpr int CONV_STATIC = 856, CONV_DENSE_END = 1912, CONV_BATCH = 2;
__device__ __forceinline__ constexpr int CT_DONE(int k) { return 1216 + 64 * k; }
__device__ __forceinline__ void conv_fill(const Args& a, float* tile, int done_idx) {
#if !CONV_FILL
    (void)a; (void)tile; (void)done_idx; return;
#endif
    unsigned* ctl = (unsigned*)(a.ws + WS_CTL); volatile int* bc = (volatile int*)(tile + 256 * CV_P + 4);
    const int tid = threadIdx.x;
    if (tid == 0) (void)__hip_atomic_fetch_add(ctl + CT_DONE(done_idx), 1u, __ATOMIC_RELAXED, __HIP_MEMORY_SCOPE_AGENT);
    for (;;) {
        if (tid == 0) { int q = -1;
            if (__hip_atomic_load(ctl + CT_DONE(done_idx), __ATOMIC_RELAXED, __HIP_MEMORY_SCOPE_AGENT) < gridDim.x) {
                q = (int)__hip_atomic_fetch_add(ctl + CT_QNEXT, (unsigned)CONV_BATCH, __ATOMIC_RELAXED, __HIP_MEMORY_SCOPE_AGENT) + CONV_STATIC; if (q >= NCONV) q = -1; }
            *bc = q; }
        __syncthreads();
        const int q = *bc;
        __syncthreads();
        if (q < 0) break;
        ph_convert(a, tile, q, 1, (q + CONV_BATCH < NCONV) ? q + CONV_BATCH : NCONV);
    }
}
__device__ __forceinline__ void conv_finish(const Args& a, float* tile, int upto) {
#if !CONV_FILL
    (void)a; (void)tile; (void)upto; return;
#endif
    unsigned* ctl = (unsigned*)(a.ws + WS_CTL); volatile int* bc = (volatile int*)(tile + 256 * CV_P + 4);
    const int tid = threadIdx.x;
    for (;;) {
        if (tid == 0) { int q = -1;
            if ((int)__hip_atomic_load(ctl + CT_QNEXT, __ATOMIC_RELAXED, __HIP_MEMORY_SCOPE_AGENT) + CONV_STATIC < upto) {
                q = (int)__hip_atomic_fetch_add(ctl + CT_QNEXT, (unsigned)CONV_BATCH, __ATOMIC_RELAXED, __HIP_MEMORY_SCOPE_AGENT) + CONV_STATIC; if (q >= NCONV) q = -1; }
            *bc = q; }
        __syncthreads();
        const int q = *bc;
        __syncthreads();
        if (q < 0) break;
        ph_convert(a, tile, q, 1, (q + CONV_BATCH < NCONV) ? q + CONV_BATCH : NCONV);
    }
}
__device__ __forceinline__ void adaln_unit(const Args& a, int unit, float* sm) {
    const float* c = a.in[1]; const float* cctx = a.in[3]; const float* w_mod = a.in[4]; const float* b_mod = a.in[5]; float* mod = (float*)(a.ws + WS_MOD);
    const int tid = threadIdx.x, l = unit / 96, chunk = unit - l * 96;
    const int cg = tid & 31, ks = tid >> 5;
    for (int i = tid; i < 5 * 2048; i += 512) { const int v = i >> 11, k = i & 2047; const float val = v < 4 ? c[v * 2048 + k] : cctx[k]; sm[i] = val / (1.0f + __expf(-val)); }
    __syncthreads();
    float acc[5][4];
#pragma unroll
    for (int v = 0; v < 5; ++v)
#pragma unroll
        for (int j = 0; j < 4; ++j) acc[v][j] = 0.f;
    const float* wp = w_mod + ((size_t)l * 2048 + (size_t)ks * 128) * 12288 + chunk * 128 + cg * 4;
    for (int kb = 0; kb < 128; kb += 16) {
        f32x4 w[16];
#pragma unroll
        for (int kk = 0; kk < 16; ++kk) w[kk] = __builtin_nontemporal_load((const f32x4*)(wp + (size_t)(kb + kk) * 12288));
#pragma unroll
        for (int kk = 0; kk < 16; ++kk) { const int k = ks * 128 + kb + kk;
#pragma unroll
            for (int v = 0; v < 5; ++v) { const float s = sm[v * 2048 + k];
#pragma unroll
                for (int j = 0; j < 4; ++j) acc[v][j] += s * w[kk][j]; } }
    }
    __syncthreads();
#pragma unroll
    for (int v = 0; v < 5; ++v)
#pragma unroll
        for (int j = 0; j < 4; ++j) sm[(ks * 5 + v) * 128 + cg * 4 + j] = acc[v][j];
    __syncthreads();
    for (int o = tid; o < 640; o += 512) {
        const int v = o >> 7, cc = o & 127; float s = 0.f;
#pragma unroll
        for (int k2 = 0; k2 < 16; ++k2) s += sm[(k2 * 5 + v) * 128 + cc];
        mod[((size_t)l * 5 + v) * 12288 + chunk * 128 + cc] = s + b_mod[(size_t)l * 12288 + chunk * 128 + cc];
    }
    __syncthreads();
}
constexpr int FW_W1 = 0, FW_W2 = 2112, FW_W3 = 6208, FW_B1 = 10304, FW_B2 = 10368, FW_B3 = 10432, FW_FR = 10496, FW_ZS = 10560, FW_HA = 10848, FW_HB = 11360, FW_END = 11872;
__device__ __forceinline__ void filters_unit(const Args& a, int l, int r, float* sm) {
    float (*zs)[36] = (float (*)[36])(sm + FW_ZS); float (*ha)[64] = (float (*)[64])(sm + FW_HA); float (*hb)[64] = (float (*)[64])(sm + FW_HB);
    const int tid = threadIdx.x;
    const bool lat = r < 256; const int Lf = lat ? 2048 : 256; const int p0 = lat ? r * 8 : (r - 256) * 8;
    float* T = (float*)(a.ws + WS_FILTC) + (size_t)l * 512 * 512;
    const float* wf = a.in[21] + (size_t)l * 64 * 1024;
    const int p = tid >> 6, j = tid & 63; const int pos = p0 + p;
    const float tn = (float)pos / (float)(Lf - 1);
    if (j < 33) {
        float z;
        if (j == 0) z = tn;
        else { const int bi = (j - 1) & 15; const float band = 1e-4f + (float)bi * ((15.0f - 1e-4f) / 15.0f);
               const float ang = (6.283185307179586f / (float)Lf) * (float)pos * band; z = (j <= 16) ? __cosf(ang) : -__sinf(ang); }
        zs[p][j] = z;
    }
    __syncthreads();
    const float f = sm[FW_FR + j];
    { float s = sm[FW_B1 + j];
#pragma unroll
      for (int i = 0; i < 33; ++i) s += zs[p][i] * sm[FW_W1 + i * 64 + j];
      ha[p][j] = __sinf(f * s); }
    __syncthreads();
    { float s = sm[FW_B2 + j];
#pragma unroll 16
      for (int i = 0; i < 64; ++i) s += ha[p][i] * sm[FW_W2 + i * 64 + j];
      hb[p][j] = __sinf(f * s); }
    __syncthreads();
    { float s = sm[FW_B3 + j];
#pragma unroll 16
      for (int i = 0; i < 64; ++i) s += hb[p][i] * sm[FW_W3 + i * 64 + j];
      ha[p][j] = __sinf(f * s); }
    __syncthreads();
    float acc[2][8];
#pragma unroll
    for (int rr = 0; rr < 2; ++rr)
#pragma unroll
        for (int q = 0; q < 8; ++q) acc[rr][q] = 0.f;
    for (int ib = 0; ib < 64; ib += 16) {
        float wa[16], wb[16];
#pragma unroll
        for (int i = 0; i < 16; ++i) { wa[i] = wf[(ib + i) * 1024 + tid]; wb[i] = wf[(ib + i) * 1024 + 512 + tid]; }
#pragma unroll
        for (int i = 0; i < 16; ++i) {
#pragma unroll
            for (int q = 0; q < 8; ++q) { const float h = ha[q][ib + i]; acc[0][q] += h * wa[i]; acc[1][q] += h * wb[i]; } }
    }
    const int ch = tid;
    const float delta = 3.0701134573253944f + (float)ch * ((15.350567286626972f - 3.0701134573253944f) / 511.0f);
#pragma unroll
    for (int q = 0; q < 8; ++q) {
        const int ps = p0 + q; const float dec = __expf(-((float)ps / (float)(Lf - 1)) * delta);
        const float vf = acc[0][q] * dec, vb = acc[1][q] * dec;
        if (lat) { bf16_t* RBp = (bf16_t*)(a.ws + WS_FILTL) + ((size_t)l * 512 + ch) * HY_RBROW; RBp[2048 - ps] = f2bf(vf); if (ps > 0) RBp[2048 + ps] = f2bf(vb); }
        else { T[(size_t)ch * (2 * Lf) + Lf + ps] = vf; if (ps > 0) T[(size_t)ch * (2 * Lf) + Lf - ps] = vb; else T[(size_t)ch * (2 * Lf)] = 0.f; }
    }
    __syncthreads();
}
__device__ __forceinline__ void ph_filters(const Args& a, float* sm, int fb, int nfb) {
    const int tid = threadIdx.x;
    for (int l = 0; l < 2; ++l) {
        for (int i = tid; i < 2112; i += NTHR) sm[FW_W1 + i] = a.in[15][l * 2112 + i];
        for (int i = tid; i < 4096; i += NTHR) { sm[FW_W2 + i] = a.in[17][l * 4096 + i]; sm[FW_W3 + i] = a.in[19][l * 4096 + i]; }
        if (tid < 64) { sm[FW_B1 + tid] = a.in[16][l * 64 + tid]; sm[FW_B2 + tid] = a.in[18][l * 64 + tid]; sm[FW_B3 + tid] = a.in[20][l * 64 + tid]; sm[FW_FR + tid] = a.in[22][l * 64 + tid]; }
        __syncthreads();
        for (int r = fb; r < 288; r += nfb) filters_unit(a, l, r, sm);
        __syncthreads();
    }
}
#define SUBREP(b) for (int srep_ = 0; srep_ <= (int)((PROBE_SUB >> (b)) & 1u); ++srep_)
__device__ __forceinline__ void ph_absmax(const Args& a, float* sm) {
    unsigned* ctl = (unsigned*)(a.ws + WS_CTL); const int tid = threadIdx.x, G = gridDim.x, bid = blockIdx.x, lane = tid & 63, w = tid >> 6;
#pragma unroll
    for (int j = (I8_WIN ? 0 : 2); j < (I8_GU ? 4 : 2); ++j) {
        const f32x4* p4 = (const f32x4*)(j == 0 ? a.in[8] : j == 1 ? a.in[8] + (size_t)2048 * 3648 : j == 2 ? a.in[26] : a.in[27]);
        const int n4 = (j < 2 ? 2048 * 3648 : 2048 * 5632) / 4, step = G * 512;
        float mm = 0.f;
        for (int i0 = bid * 512 + tid; i0 < n4; i0 += step * 8) {
            f32x4 v[8];
#pragma unroll
            for (int u = 0; u < 8; ++u) { const int i = i0 + u * step; v[u] = i < n4 ? __builtin_nontemporal_load(p4 + i) : (f32x4){0.f, 0.f, 0.f, 0.f}; }
#pragma unroll
            for (int u = 0; u < 8; ++u) mm = fmaxf(mm, fmaxf(fmaxf(fabsf(v[u][0]), fabsf(v[u][1])), fmaxf(fabsf(v[u][2]), fabsf(v[u][3]))));
        }
        mm = wave_max(mm);
        if (lane == 0) sm[w] = mm;
        __syncthreads();
        if (tid == 0) { float t = sm[0];
#pragma unroll
            for (int k = 1; k < 8; ++k) t = fmaxf(t, sm[k]);
            (void)__hip_atomic_fetch_max(ctl + CT_WSC + j, __float_as_uint(t), __ATOMIC_RELAXED, __HIP_MEMORY_SCOPE_AGENT); }
        __syncthreads();
    }
    if (tid == 0) (void)__hip_atomic_fetch_add(ctl + CT_AMAXDONE, 1u, __ATOMIC_RELAXED, __HIP_MEMORY_SCOPE_AGENT);
}
__device__ __forceinline__ void ph_prologue(const Args& a, float* sm) {
    const int bid = blockIdx.x, G = gridDim.x, tid = threadIdx.x;
    const int NF = G >= 128 ? 64 : 0;
    if (I8_GEMM) ph_absmax(a, sm);
    if (NF == 0) { SUBREP(4) for (int u = bid; u < 192; u += G) adaln_unit(a, u, sm); SUBREP(5) ph_filters(a, sm, bid, G); }
    else if (bid < NF) { SUBREP(5) ph_filters(a, sm, bid, NF); }
    else { SUBREP(4) for (int u = bid - NF; u < 192; u += G - NF) adaln_unit(a, u, sm); }
    { float* cosT = (float*)(a.ws + WS_ROPE); float* sinT = cosT + 2048 * 32;
      for (int i = bid * 512 + tid; i < 2048 * 32; i += G * 512) { const int t = i >> 5, f = i & 31;
          const float pos = (float)((f < 16) ? (t >> 6) : (t & 63)); const float freq = powf(10000.0f, -(float)(f & 15) / 16.0f); const float ang = pos * freq;
          cosT[i] = cosf(ang); sinT[i] = sinf(ang); } }
    for (int i = bid * 512 + tid; i < 2 * 512 * 17; i += G * 512) { const int row = i / 17, k = i - row * 17; ((bf16_t*)(a.ws + WS_FILTL))[(size_t)row * HY_RBROW + (k == 0 ? 0 : 4095 + k)] = 0; }
    { constexpr int RB16 = I8_WIN ? 128 : 256;
      for (int i = bid * 512 + tid; i < 2 * 192 * RB16; i += G * 512) { const int l = i / (192 * RB16), r = i % (192 * RB16);
        *(u32x4*)(a.ws + WS_WIN + (size_t)l * UW * D * 2 + (size_t)INW * RB16 * 16 + (size_t)r * 16) = (u32x4){0u, 0u, 0u, 0u}; } }
    if (I8_GEMM) {
        if (tid == 0) { const unsigned* dn = (const unsigned*)(a.ws + WS_CTL) + CT_AMAXDONE; unsigned sp = 0;
            while (__hip_atomic_load(dn, __ATOMIC_RELAXED, __HIP_MEMORY_SCOPE_AGENT) < (unsigned)G && ++sp < (1u << 22)) __builtin_amdgcn_s_sleep(4); }
    }
    __syncthreads();
    if ((PROBE_SUB >> 8) & 1u) ph_convert<2>(a, sm, bid, G, NCONV);
    if (!((PROBE_SUB >> 11) & 1u) || bid < 64) conv_dynamic<0>(a, sm);
    if (G != 256) ph_convert<0>(a, sm, NCONV_Q + bid, G, NCONV);
    if ((PROBE_SUB >> 6) & 1u) ph_convert<0>(a, sm, bid, G, NCONV);
    if ((PROBE_SUB >> 7) & 1u) ph_convert<1>(a, sm, bid, G, NCONV);
}

__device__ __forceinline__ f32x4 ld4bf(const bf16_t* p) { const u32x2 q = *(const u32x2*)p; return (f32x4){__uint_as_float(q.x << 16), __uint_as_float(q.x & 0xffff0000u), __uint_as_float(q.y << 16), __uint_as_float(q.y & 0xffff0000u)}; }
template <bool ROUTER, bool COPYX, int OUT8 = 0, int NSLAB = 0, bool XLB = true, bool XCB = true>
__device__ __forceinline__ void ph_normmod(const void* __restrict__ xlat, const void* __restrict__ xctx, const float* __restrict__ gain, const float* __restrict__ modl, int sh_off, int sc_off,
                                           bf16_t* __restrict__ out, int nrows, bf16_t* __restrict__ xs, const float* __restrict__ router, int* __restrict__ topi, float* __restrict__ topw,
                                           const bf16_t* __restrict__ slab = nullptr, const float* __restrict__ slab_gate = nullptr, float* __restrict__ rsc = nullptr, float* rl = nullptr) {
    const int lane = threadIdx.x & 63, wid = threadIdx.x >> 6;
    if (ROUTER) {
        for (int idx = threadIdx.x; idx < 4096; idx += NTHR) { const int col = idx >> 1, h = idx & 1, i = col >> 8, ln = (col & 255) >> 2, j = col & 3;
            *(f32x4*)(rl + ((((i * 4 + j) * 2 + h) * 64 + ln) << 2)) = *(const f32x4*)(router + (size_t)idx * 4); }
        __syncthreads();
    }
    for (int row = blockIdx.x * 8 + wid; row < nrows; row += gridDim.x * 8) {
        const bool lat = row < NLAT; const size_t xoff = lat ? (size_t)row * D : (size_t)(row - NLAT) * D;
        const float* mv = modl + (size_t)tok_mod(row) * 12288;
        f32x4 v[8]; float ss = 0.f;
#pragma unroll
        for (int i = 0; i < 8; ++i) { const int cl = i * 256 + lane * 4;
            if (lat) { if (XLB) { const u32x2 q = *(const u32x2*)((const bf16_t*)xlat + xoff + cl); v[i] = (f32x4){__uint_as_float(q.x << 16), __uint_as_float(q.x & 0xffff0000u), __uint_as_float(q.y << 16), __uint_as_float(q.y & 0xffff0000u)}; }
                       else v[i] = *(const f32x4*)((const float*)xlat + xoff + cl); }
            else { if (XCB) { const u32x2 q = *(const u32x2*)((const bf16_t*)xctx + xoff + cl); v[i] = (f32x4){__uint_as_float(q.x << 16), __uint_as_float(q.x & 0xffff0000u), __uint_as_float(q.y << 16), __uint_as_float(q.y & 0xffff0000u)}; }
                   else v[i] = *(const f32x4*)((const float*)xctx + xoff + cl); }
            if (NSLAB > 0 && row >= NLAT) { f32x4 sa = ld4bf(slab + (size_t)(row - NLAT) * D + i * 256 + lane * 4);
#pragma unroll
                for (int sl = 1; sl < NSLAB; ++sl) sa += ld4bf(slab + ((size_t)sl * NCTX + (row - NLAT)) * D + i * 256 + lane * 4);
                v[i] += *(const f32x4*)(slab_gate + i * 256 + lane * 4) * sa; }
            ss += v[i][0] * v[i][0] + v[i][1] * v[i][1] + v[i][2] * v[i][2] + v[i][3] * v[i][3];
            if (COPYX && (NSLAB == 0 || row >= NLAT)) { u32x2 w; w.x = pg8::cvt_pk_bf16(v[i][0], v[i][1]); w.y = pg8::cvt_pk_bf16(v[i][2], v[i][3]); *(u32x2*)(xs + (size_t)row * D + i * 256 + lane * 4) = w; } }
        ss = wave_sum(ss);
        const float rstd = rsqrtf(ss * (1.0f / D) + EPS);
        float lg[8];
#pragma unroll
        for (int e = 0; e < 8; ++e) lg[e] = 0.f;
        float amax = 0.f;
#pragma unroll
        for (int i = 0; i < 8; ++i) {
            const int col = i * 256 + lane * 4;
            const f32x4 g = *(const f32x4*)(gain + col), sc = *(const f32x4*)(mv + sc_off + col), sh = *(const f32x4*)(mv + sh_off + col);
            f32x4 o;
#pragma unroll
            for (int j = 0; j < 4; ++j) o[j] = (v[i][j] * rstd * g[j]) * (1.0f + sc[j]) + sh[j];
            if (OUT8 == 2) { v[i] = o; amax = fmaxf(amax, fmaxf(fmaxf(fabsf(o[0]), fabsf(o[1])), fmaxf(fabsf(o[2]), fabsf(o[3])))); }
            else if (OUT8 == 1) *(unsigned*)((unsigned char*)out + (size_t)row * D + col) = pg8::pack4_fp8(o[0] * ASCALE, o[1] * ASCALE, o[2] * ASCALE, o[3] * ASCALE);
            else { u32x2 w; w.x = (unsigned)f2bf(o[0]) | ((unsigned)f2bf(o[1]) << 16); w.y = (unsigned)f2bf(o[2]) | ((unsigned)f2bf(o[3]) << 16);
                *(u32x2*)(out + (size_t)row * D + col) = w; }
            if (ROUTER) v[i] = o;
        }
        if (ROUTER) {
#pragma unroll
            for (int i = 0; i < 8; ++i) {
#pragma unroll
                for (int j = 0; j < 4; ++j) { const f32x4 r0 = *(const f32x4*)(rl + ((((i * 4 + j) * 2 + 0) * 64 + lane) << 2)), r1 = *(const f32x4*)(rl + ((((i * 4 + j) * 2 + 1) * 64 + lane) << 2));
                    lg[0] += v[i][j] * r0[0]; lg[1] += v[i][j] * r0[1]; lg[2] += v[i][j] * r0[2]; lg[3] += v[i][j] * r0[3];
                    lg[4] += v[i][j] * r1[0]; lg[5] += v[i][j] * r1[1]; lg[6] += v[i][j] * r1[2]; lg[7] += v[i][j] * r1[3]; }
                if (i & 1) __builtin_amdgcn_sched_barrier(0);
            }
        }
        if (OUT8 == 2) {
            amax = wave_max(amax); const float qs = amax > 0.f ? 127.0f / amax : 0.f;
#pragma unroll
            for (int i = 0; i < 8; ++i) *(unsigned*)((unsigned char*)out + (size_t)row * D + i * 256 + lane * 4) = pack4_i8(v[i][0] * qs, v[i][1] * qs, v[i][2] * qs, v[i][3] * qs);
            if (lane == 0) rsc[row] = amax * (1.0f / 127.0f);
        }
        if (ROUTER) {
#pragma unroll
            for (int e = 0; e < 8; ++e) lg[e] = wave_sum(lg[e]);
            if (lane == 0) {
                int i0 = 0; float v0 = lg[0];
#pragma unroll
                for (int e = 1; e < 8; ++e) if (lg[e] > v0) { v0 = lg[e]; i0 = e; }
                int i1 = -1; float v1 = -3.0e38f;
#pragma unroll
                for (int e = 0; e < 8; ++e) if (e != i0 && lg[e] > v1) { v1 = lg[e]; i1 = e; }
                const float e1 = expf(v1 - v0), w0 = 1.0f / (1.0f + e1), w1 = e1 / (1.0f + e1);
                topi[row * 2] = i0; topi[row * 2 + 1] = i1; topw[row * 2] = w0; topw[row * 2 + 1] = w1;
            }
        }
    }
}

__device__ __forceinline__ float bflo(unsigned w) { return __uint_as_float(w << 16); }
__device__ __forceinline__ float bfhi(unsigned w) { return __uint_as_float(w & 0xffff0000u); }
__device__ __forceinline__ unsigned pkbf(float lo, float hi) { return (unsigned)f2bf(lo) | ((unsigned)f2bf(hi) << 16); }
__device__ __forceinline__ u32x4 rope8(const u32x4 mine, const u32x4 other, bool is_x2, const f32x4 c0, const f32x4 c1, const f32x4 s0, const f32x4 s1) {
    const unsigned mw[4] = {mine.x, mine.y, mine.z, mine.w}, ow[4] = {other.x, other.y, other.z, other.w};
    const float cs[8] = {c0[0], c0[1], c0[2], c0[3], c1[0], c1[1], c1[2], c1[3]}, sn[8] = {s0[0], s0[1], s0[2], s0[3], s1[0], s1[1], s1[2], s1[3]};
    unsigned o[4];
#pragma unroll
    for (int d = 0; d < 4; ++d) {
        const float m0 = bflo(mw[d]), m1 = bfhi(mw[d]), p0 = bflo(ow[d]), p1 = bfhi(ow[d]);
        const float r0 = is_x2 ? (p0 * sn[2 * d] + m0 * cs[2 * d]) : (m0 * cs[2 * d] - p0 * sn[2 * d]);
        const float r1 = is_x2 ? (p1 * sn[2 * d + 1] + m1 * cs[2 * d + 1]) : (m1 * cs[2 * d + 1] - p1 * sn[2 * d + 1]);
        o[d] = pkbf(r0, r1);
    }
    return (u32x4){o[0], o[1], o[2], o[3]};
}
__device__ __forceinline__ u32x4 shfl4(const u32x4 v, int m) { return (u32x4){(unsigned)__shfl_xor((int)v.x, m), (unsigned)__shfl_xor((int)v.y, m), (unsigned)__shfl_xor((int)v.z, m), (unsigned)__shfl_xor((int)v.w, m)}; }
__device__ __forceinline__ void ph_mid(const Args& a, int l) {
    const bf16_t* __restrict__ U = (const bf16_t*)(a.ws + WS_U);
    const float* g_q = a.in[9] + l * 768; const float* g_kv = a.in[11] + l * 512; const float* conv_w = a.in[13] + (size_t)l * 3 * 1536; const float* conv_b = a.in[14] + l * 1536;
    const float* cosT = (const float*)(a.ws + WS_ROPE); const float* sinT = cosT + 2048 * 32;
    bf16_t* cqn = (bf16_t*)(a.ws + WS_CQN); bf16_t* ckvn = (bf16_t*)(a.ws + WS_CKVN); bf16_t* kpe = (bf16_t*)(a.ws + WS_KPE); bf16_t* x0o = (bf16_t*)(a.ws + WS_X0);
    bf16_t* wtl = (bf16_t*)(a.ws + WS_WTL); bf16_t* wtc = (bf16_t*)(a.ws + WS_WTC); bf16_t* sq = (bf16_t*)(a.ws + WS_SQ); bf16_t* sk = (bf16_t*)(a.ws + WS_SK); bf16_t* sv = (bf16_t*)(a.ws + WS_SV);
    int tid_ = threadIdx.x; asm volatile("" : "+v"(tid_));
    const int tid = tid_, lane = tid & 63, wid = tid >> 6;
    for (int unit = blockIdx.x; unit < NTOK / 16; unit += gridDim.x) {
        const int tok0 = unit * 16;
        for (int tt = 0; tt < 2; ++tt) {
            const int tok = tok0 + wid * 2 + tt; const bool lat = tok < NLAT; const int t = lat ? (tok & 2047) : ((tok - NLAT) & 255);
            const bf16_t* u = U + (size_t)tok * UW;
            const u32x2 q0 = *(const u32x2*)(u + O_CQ + lane * 12), q1 = *(const u32x2*)(u + O_CQ + lane * 12 + 4), q2 = *(const u32x2*)(u + O_CQ + lane * 12 + 8);
            const u32x4 kvv = *(const u32x4*)(u + O_CKV + lane * 8);
            const u32x4 sqv = *(const u32x4*)(u + O_SQ + lane * 8);
            const u32x4 skv = *(const u32x4*)(u + O_SK + (lane & 15) * 8);
            const u32x4 kpv = *(const u32x4*)(u + O_KPE + (lane & 7) * 8);
            const int i0 = (lane & 3) * 8;
            f32x4 c0 = (f32x4){1.f, 1.f, 1.f, 1.f}, c1 = c0, s0 = (f32x4){0.f, 0.f, 0.f, 0.f}, s1 = s0;
            if (lat) { c0 = *(const f32x4*)(cosT + t * 32 + i0); c1 = *(const f32x4*)(cosT + t * 32 + i0 + 4); s0 = *(const f32x4*)(sinT + t * 32 + i0); s1 = *(const f32x4*)(sinT + t * 32 + i0 + 4); }
            {
                const unsigned w6[6] = {q0.x, q0.y, q1.x, q1.y, q2.x, q2.y}; float x[12]; float ss = 0.f;
#pragma unroll
                for (int d = 0; d < 6; ++d) { x[2 * d] = bflo(w6[d]); x[2 * d + 1] = bfhi(w6[d]); ss += x[2 * d] * x[2 * d] + x[2 * d + 1] * x[2 * d + 1]; }
                ss = wave_sum(ss); const float rs = rsqrtf(ss * (1.0f / 768.0f) + EPS);
                const f32x4 g0 = *(const f32x4*)(g_q + lane * 12), g1 = *(const f32x4*)(g_q + lane * 12 + 4), g2 = *(const f32x4*)(g_q + lane * 12 + 8);
                u32x2 o0, o1, o2;
                o0.x = pkbf(x[0] * rs * g0[0], x[1] * rs * g0[1]); o0.y = pkbf(x[2] * rs * g0[2], x[3] * rs * g0[3]);
                o1.x = pkbf(x[4] * rs * g1[0], x[5] * rs * g1[1]); o1.y = pkbf(x[6] * rs * g1[2], x[7] * rs * g1[3]);
                o2.x = pkbf(x[8] * rs * g2[0], x[9] * rs * g2[1]); o2.y = pkbf(x[10] * rs * g2[2], x[11] * rs * g2[3]);
                bf16_t* dst = cqn + (size_t)tok * 768 + lane * 12; *(u32x2*)dst = o0; *(u32x2*)(dst + 4) = o1; *(u32x2*)(dst + 8) = o2;
            }
            {
                const unsigned w4[4] = {kvv.x, kvv.y, kvv.z, kvv.w}; float x[8]; float ss = 0.f;
#pragma unroll
                for (int d = 0; d < 4; ++d) { x[2 * d] = bflo(w4[d]); x[2 * d + 1] = bfhi(w4[d]); ss += x[2 * d] * x[2 * d] + x[2 * d + 1] * x[2 * d + 1]; }
                ss = wave_sum(ss); const float rs = rsqrtf(ss * (1.0f / 512.0f) + EPS);
                const f32x4 g0 = *(const f32x4*)(g_kv + lane * 8), g1 = *(const f32x4*)(g_kv + lane * 8 + 4);
                u32x4 o; o.x = pkbf(x[0] * rs * g0[0], x[1] * rs * g0[1]); o.y = pkbf(x[2] * rs * g0[2], x[3] * rs * g0[3]); o.z = pkbf(x[4] * rs * g1[0], x[5] * rs * g1[1]); o.w = pkbf(x[6] * rs * g1[2], x[7] * rs * g1[3]);
                *(u32x4*)(ckvn + (size_t)tok * 512 + lane * 8) = o;
            }
            const bool is_x2 = (lane & 4) != 0;
            {
                const u32x4 r = rope8(sqv, shfl4(sqv, 4), is_x2, c0, c1, s0, s1);
                *(u32x4*)(sq + (size_t)tok * 512 + lane * 8) = r;
            }
            {
                const u32x4 r = rope8(skv, shfl4(skv, 4), is_x2, c0, c1, s0, s1);
                if (lane < 16) *(u32x4*)(sk + (size_t)tok * 128 + lane * 8) = r;
            }
            {
                const u32x4 ot = shfl4(kpv, 4);
                if (lane < 4) {
                    const unsigned mw[4] = {kpv.x, kpv.y, kpv.z, kpv.w}, ow[4] = {ot.x, ot.y, ot.z, ot.w};
                    const float cs[8] = {c0[0], c0[1], c0[2], c0[3], c1[0], c1[1], c1[2], c1[3]}, sn[8] = {s0[0], s0[1], s0[2], s0[3], s1[0], s1[1], s1[2], s1[3]};
                    unsigned o[8];
#pragma unroll
                    for (int d = 0; d < 4; ++d) { const float a0 = bflo(mw[d]), a1 = bfhi(mw[d]), b0 = bflo(ow[d]), b1 = bfhi(ow[d]);
                        o[2 * d] = pkbf(a0 * cs[2 * d] - b0 * sn[2 * d], a0 * sn[2 * d] + b0 * cs[2 * d]);
                        o[2 * d + 1] = pkbf(a1 * cs[2 * d + 1] - b1 * sn[2 * d + 1], a1 * sn[2 * d + 1] + b1 * cs[2 * d + 1]); }
                    bf16_t* dst = kpe + (size_t)tok * 64 + lane * 16;
                    *(u32x4*)dst = (u32x4){o[0], o[1], o[2], o[3]}; *(u32x4*)(dst + 8) = (u32x4){o[4], o[5], o[6], o[7]};
                }
            }
        }
        {
            const bool lat = tok0 < NLAT; const int Ls = lat ? L : C;
            const int b = lat ? (tok0 >> 11) : ((tok0 - NLAT) >> 8), t0 = (lat ? (tok0 & 2047) : ((tok0 - NLAT) & 255));
            const int cp = tid & 255, hf = tid >> 8, ch = cp * 2, ts = t0 + hf * 8, tokb = tok0 + hf * 8;
            float cw[3][3][2], cb[3][2];
#pragma unroll
            for (int g = 0; g < 3; ++g) { cb[g][0] = conv_b[g * 512 + ch]; cb[g][1] = conv_b[g * 512 + ch + 1];
#pragma unroll
                for (int j = 0; j < 3; ++j) { cw[g][j][0] = conv_w[j * 1536 + g * 512 + ch]; cw[g][j][1] = conv_w[j * 1536 + g * 512 + ch + 1]; } }
            unsigned rows[3][10];
#pragma unroll
            for (int r = 0; r < 10; ++r) { const int tr = ts - 1 + r; const bool ok = tr >= 0 && tr < Ls;
#pragma unroll
                for (int g = 0; g < 3; ++g) rows[g][r] = ok ? *(const unsigned*)(U + (size_t)(tokb - 1 + r) * UW + O_HY + g * 512 + ch) : 0u; }
            unsigned wp0[4], wp1[4];
#pragma unroll
            for (int i = 0; i < 8; ++i) {
                float y[3][2];
#pragma unroll
                for (int g = 0; g < 3; ++g) {
                    y[g][0] = cb[g][0] + cw[g][0][0] * bflo(rows[g][i]) + cw[g][1][0] * bflo(rows[g][i + 1]) + cw[g][2][0] * bflo(rows[g][i + 2]);
                    y[g][1] = cb[g][1] + cw[g][0][1] * bfhi(rows[g][i]) + cw[g][1][1] * bfhi(rows[g][i + 1]) + cw[g][2][1] * bfhi(rows[g][i + 2]); }
                *(unsigned*)(x0o + (size_t)(tokb + i) * 512 + ch) = pkbf(y[0][0], y[0][1]);
                const unsigned w0 = f2bf(y[2][0] * y[1][0]), w1 = f2bf(y[2][1] * y[1][1]);
                if (i & 1) { wp0[i >> 1] |= w0 << 16; wp1[i >> 1] |= w1 << 16; } else { wp0[i >> 1] = w0; wp1[i >> 1] = w1; }
            }
            bf16_t* wt = lat ? wtl + ((size_t)b * 512 + ch) * L + ts : wtc + ((size_t)b * 512 + ch) * C + ts;
            *(u32x4*)wt = (u32x4){wp0[0], wp0[1], wp0[2], wp0[3]};
            *(u32x4*)(wt + (lat ? L : C)) = (u32x4){wp1[0], wp1[1], wp1[2], wp1[3]};
        }
        if (tid < 128) {
            unsigned pk[8];
#pragma unroll
            for (int i = 0; i < 16; ++i) { const unsigned v = U[(size_t)(tok0 + i) * UW + O_SV + tid]; if (i & 1) pk[i >> 1] |= v << 16; else pk[i >> 1] = v; }
            bf16_t* dst = sv + (size_t)tid * NTOK + tok0;
            u32x4 w0, w1; w0.x = pk[0]; w0.y = pk[1]; w0.z = pk[2]; w0.w = pk[3]; w1.x = pk[4]; w1.y = pk[5]; w1.z = pk[6]; w1.w = pk[7];
            *(u32x4*)dst = w0; *(u32x4*)(dst + 8) = w1;
        }
    }
}

__device__ __forceinline__ void ph_mla_naive(const Args& a, int nq, float* sm) {
    const bf16_t* __restrict__ Q = (const bf16_t*)(a.ws + WS_Q); const bf16_t* __restrict__ KV = (const bf16_t*)(a.ws + WS_KV); const bf16_t* __restrict__ KPE = (const bf16_t*)(a.ws + WS_KPE);
    bf16_t* mix = (bf16_t*)(a.ws + WS_MIX);
    const int lane = threadIdx.x & 63, w = threadIdx.x >> 6;
    float* qf = sm + w * 192; float* sc = sm + 8 * 192 + w * 2304;
    for (int unit = blockIdx.x; unit < nq; unit += gridDim.x) {
        const int h = unit & 7, qt = (unit >> 3) * 8 + w; const bool lat = qt < NLAT;
        const int b = lat ? (qt >> 11) : ((qt - NLAT) >> 8);
        const int nk = lat ? (L + C) : C;
        for (int i = lane; i < 192; i += 64) qf[i] = bf2f(Q[(size_t)qt * QW + h * 192 + i]);
        __syncthreads();
        const float scale = 0.07216878364870322f;
        float mx = -3.0e38f;
        for (int kc = 0; kc < nk; kc += 64) {
            const int kk = kc + lane;
            const int kt = lat ? (kk < L ? b * L + kk : NLAT + b * C + (kk - L)) : (NLAT + b * C + kk);
            float s = 0.f;
            const u32x4* kp = (const u32x4*)(KV + (size_t)kt * KVW + h * 256);
            for (int i = 0; i < 16; ++i) { const u32x4 v = kp[i]; const float* q8 = qf + i * 8;
                s += q8[0] * __uint_as_float(v.x << 16) + q8[1] * __uint_as_float(v.x & 0xffff0000u) + q8[2] * __uint_as_float(v.y << 16) + q8[3] * __uint_as_float(v.y & 0xffff0000u)
                   + q8[4] * __uint_as_float(v.z << 16) + q8[5] * __uint_as_float(v.z & 0xffff0000u) + q8[6] * __uint_as_float(v.w << 16) + q8[7] * __uint_as_float(v.w & 0xffff0000u); }
            const u32x4* pp = (const u32x4*)(KPE + (size_t)kt * 64);
            for (int i = 0; i < 8; ++i) { const u32x4 v = pp[i]; const float* q8 = qf + 128 + i * 8;
                s += q8[0] * __uint_as_float(v.x << 16) + q8[1] * __uint_as_float(v.x & 0xffff0000u) + q8[2] * __uint_as_float(v.y << 16) + q8[3] * __uint_as_float(v.y & 0xffff0000u)
                   + q8[4] * __uint_as_float(v.z << 16) + q8[5] * __uint_as_float(v.z & 0xffff0000u) + q8[6] * __uint_as_float(v.w << 16) + q8[7] * __uint_as_float(v.w & 0xffff0000u); }
            s *= scale; sc[kk] = s; mx = fmaxf(mx, s);
        }
        mx = wave_max(mx);
        float sum = 0.f;
        for (int kc = 0; kc < nk; kc += 64) { const float p = expf(sc[kc + lane] - mx); sc[kc + lane] = p; sum += p; }
        sum = wave_sum(sum);
        __syncthreads();
        float o0 = 0.f, o1 = 0.f;
        for (int kk = 0; kk < nk; ++kk) {
            const int kt = lat ? (kk < L ? b * L + kk : NLAT + b * C + (kk - L)) : (NLAT + b * C + kk);
            const unsigned v = *(const unsigned*)(KV + (size_t)kt * KVW + h * 256 + 128 + lane * 2);
            const float p = sc[kk];
            o0 += p * __uint_as_float(v << 16); o1 += p * __uint_as_float(v & 0xffff0000u);
        }
        const float inv = 1.0f / sum;
        *(unsigned*)(mix + (size_t)qt * D + h * 128 + lane * 2) = (unsigned)f2bf(o0 * inv) | ((unsigned)f2bf(o1 * inv) << 16);
        __syncthreads();
    }
}
__device__ __forceinline__ void ph_swa_naive(const Args& a, int l, int nq, float* sm) {
    const bf16_t* __restrict__ SQ = (const bf16_t*)(a.ws + WS_SQ); const bf16_t* __restrict__ SK = (const bf16_t*)(a.ws + WS_SK); const bf16_t* __restrict__ SV = (const bf16_t*)(a.ws + WS_SV);
    const float* sink = a.in[24] + l * 8; bf16_t* mix = (bf16_t*)(a.ws + WS_MIX);
    const int lane = threadIdx.x & 63, w = threadIdx.x >> 6;
    float* qf = sm + w * 64; float* sc = sm + 8 * 64 + w * 576; int* kts = (int*)(sm + 8 * 64 + 8 * 576) + w * 576;
    for (int unit = blockIdx.x; unit < nq; unit += gridDim.x) {
        const int hq = unit & 7, hk = hq >> 2, qt = (unit >> 3) * 8 + w; const bool lat = qt < NLAT;
        const int b = lat ? (qt >> 11) : ((qt - NLAT) >> 8), t = lat ? (qt & 2047) : 0;
        int lo = 0, nloc = 0;
        if (lat) { lo = t - 128 < 0 ? 0 : t - 128; const int hi = t + 128 > L - 1 ? L - 1 : t + 128; nloc = hi - lo + 1; }
        const int nk = nloc + C;
        qf[lane] = bf2f(SQ[(size_t)qt * 512 + hq * 64 + lane]);
        __syncthreads();
        const float skv = sink[hq];
        float mx = skv;
        for (int kc = 0; kc < nk; kc += 64) {
            const int kk = kc + lane;
            if (kk < nk) {
                const int kt = kk < nloc ? (b * L + lo + kk) : (NLAT + b * C + (kk - nloc));
                const u32x4* kp = (const u32x4*)(SK + (size_t)kt * 128 + hk * 64);
                float s = 0.f;
                for (int i = 0; i < 8; ++i) { const u32x4 v = kp[i]; const float* q8 = qf + i * 8;
                    s += q8[0] * __uint_as_float(v.x << 16) + q8[1] * __uint_as_float(v.x & 0xffff0000u) + q8[2] * __uint_as_float(v.y << 16) + q8[3] * __uint_as_float(v.y & 0xffff0000u)
                       + q8[4] * __uint_as_float(v.z << 16) + q8[5] * __uint_as_float(v.z & 0xffff0000u) + q8[6] * __uint_as_float(v.w << 16) + q8[7] * __uint_as_float(v.w & 0xffff0000u); }
                s *= 0.125f; sc[kk] = s; kts[kk] = kt; mx = fmaxf(mx, s);
            }
        }
        mx = wave_max(mx);
        float sum = 0.f;
        for (int kc = 0; kc < nk; kc += 64) { const int kk = kc + lane; if (kk < nk) { const float p = expf(sc[kk] - mx); sc[kk] = p; sum += p; } }
        sum = wave_sum(sum) + expf(skv - mx);
        __syncthreads();
        float o = 0.f;
        for (int kk = 0; kk < nk; ++kk) o += sc[kk] * bf2f(SV[(size_t)kts[kk] * 128 + hk * 64 + lane]);
        mix[(size_t)qt * D + 1536 + hq * 64 + lane] = f2bf(o / sum);
        __syncthreads();
    }
}
template <int LS>
__device__ __forceinline__ void ph_hyena_naive(const Args& a, int l, float* sm) {
    const float* filt = LS == L ? (const float*)(a.ws + WS_FILTL) + (size_t)l * 512 * 4096 : (const float*)(a.ws + WS_FILTC) + (size_t)l * 512 * 512;
    const bf16_t* wt = (const bf16_t*)(a.ws + (LS == L ? WS_WTL : WS_WTC)); const bf16_t* x0 = (const bf16_t*)(a.ws + WS_X0); const float* skip = a.in[23] + l * 512;
    bf16_t* mix = (bf16_t*)(a.ws + WS_MIX); const int tok_base = LS == L ? 0 : NLAT;
    float* T = sm; float* ws = sm + 2 * LS; const int tid = threadIdx.x;
    for (int unit = blockIdx.x; unit < 512 * NB; unit += gridDim.x) {
        const int ch = unit >> 2, b = unit & 3;
        for (int i = tid; i < 2 * LS; i += NTHR) T[i] = filt[(size_t)ch * 2 * LS + i];
        for (int i = tid; i < LS; i += NTHR) ws[i] = bf2f(wt[((size_t)b * 512 + ch) * LS + i]);
        __syncthreads();
        const float sk = skip[ch];
        for (int t = tid; t < LS; t += NTHR) {
            float y = 0.f;
            for (int s = 0; s < LS; ++s) y += T[t - s + LS] * ws[s];
            ((bf16_t*)(a.ws + WS_YT))[(LS == L ? (size_t)0 : (size_t)NB * 512 * L) + ((size_t)b * 512 + ch) * LS + t] = f2bf(y);
        }
        __syncthreads();
    }
}
__device__ __forceinline__ void ph_route_gather(const Args& a, int* sm) {
    const int* __restrict__ topi = (const int*)(a.ws + WS_TOPI); int* __restrict__ pos = (int*)(a.ws + WS_POS); int* ctl = (int*)(a.ws + WS_CTL);
    const unsigned char* __restrict__ hb = (const unsigned char*)(a.ws + WS_HA); unsigned char* __restrict__ hbs = (unsigned char*)(a.ws + WS_HBS);
    int (*cnt)[512] = (int (*)[512])sm; int* tot = sm + 8 * 512; int* ppos = sm + 8 * 512 + 16;
    const int tid = threadIdx.x, lane = tid & 63, w = tid >> 6;
    int c[8];
#pragma unroll
    for (int e = 0; e < 8; ++e) c[e] = 0;
    for (int i = 0; i < 32; i += 4) { const u32x4 e4 = *(const u32x4*)(topi + tid * 32 + i);
#pragma unroll
        for (int q = 0; q < 8; ++q) c[q] += (e4.x == (unsigned)q) + (e4.y == (unsigned)q) + (e4.z == (unsigned)q) + (e4.w == (unsigned)q); }
#pragma unroll
    for (int e = 0; e < 8; ++e) cnt[e][tid] = c[e];
    __syncthreads();
    {
        int v[8]; int s8 = 0;
#pragma unroll
        for (int k = 0; k < 8; ++k) { v[k] = cnt[w][lane * 8 + k]; s8 += v[k]; }
        int incl = s8;
#pragma unroll
        for (int off = 1; off < 64; off <<= 1) { const int t = __shfl_up(incl, off); if (lane >= off) incl += t; }
        int run = incl - s8;
#pragma unroll
        for (int k = 0; k < 8; ++k) { cnt[w][lane * 8 + k] = run; run += v[k]; }
        if (lane == 63) tot[w] = incl;
    }
    __syncthreads();
    int eoff[8]; int o = 0;
#pragma unroll
    for (int e = 0; e < 8; ++e) { eoff[e] = o; o += (tot[e] + 255) & ~255; }
    if (blockIdx.x == 0 && tid == 0) {
#pragma unroll
        for (int e = 0; e < 8; ++e) { ctl[CT_EOFF + e] = eoff[e]; ctl[CT_EPAD + e] = (tot[e] + 255) & ~255; }
        ctl[CT_NTILE] = o >> 8; const int nwg = (o >> 8) * (D / 256); ctl[CT_MOES] = pg8::split_S(nwg, DFE / 128, 256); ctl[CT_TROW] = (nwg / 256) * 256 / (D / 256) * 256;
    }
    for (int tg = blockIdx.x; tg < NLAT / 32; tg += gridDim.x) {
        if (tid < 64) {
            const int idx = 64 * tg + tid, owner = idx >> 5, e = topi[idx]; int p = 0;
#pragma unroll
            for (int q = 0; q < 8; ++q) { const unsigned long long mk = __ballot(e == q);
                if (e == q) { const unsigned hm = (unsigned)(mk >> (32 * (tid >> 5))); p = eoff[q] + cnt[q][owner] + __popc(hm & ((1u << (tid & 31)) - 1u)); } }
            pos[idx] = p; ppos[tid] = p;
        }
        __syncthreads();
#pragma unroll
        for (int k = 0; k < 4; ++k) { const int tl = 4 * w + k; const int tok = 32 * tg + tl;
            const u32x4 v0 = *(const u32x4*)(hb + (size_t)tok * D + lane * 32), v1 = *(const u32x4*)(hb + (size_t)tok * D + lane * 32 + 16);
            const int p0 = ppos[2 * tl], p1 = ppos[2 * tl + 1];
            *(u32x4*)(hbs + (size_t)p0 * D + lane * 32) = v0; *(u32x4*)(hbs + (size_t)p0 * D + lane * 32 + 16) = v1;
            *(u32x4*)(hbs + (size_t)p1 * D + lane * 32) = v0; *(u32x4*)(hbs + (size_t)p1 * D + lane * 32 + 16) = v1; }
        __syncthreads();
    }
}
__device__ __forceinline__ void fin_load(const bf16_t* __restrict__ xs, const bf16_t* __restrict__ ys, const bf16_t* __restrict__ slab, int row, int p0, int p1, int nsl, int trow0, int trows, int lane, u32x2 (&x)[8], u32x2 (&ya)[8], u32x2 (&yb)[8]) {
    const bool t0 = nsl > 1 && p0 >= trow0, t1 = nsl > 1 && p1 >= trow0;
#pragma unroll
    for (int i = 0; i < 8; ++i) { const int col = i * 256 + lane * 4;
        x[i] = *(const u32x2*)(xs + (size_t)row * D + col);
        if (t0) { f32x4 sa = ld4bf(slab + (size_t)(p0 - trow0) * D + col); for (int sl = 1; sl < nsl; ++sl) sa += ld4bf(slab + ((size_t)sl * trows + (p0 - trow0)) * D + col);
            ya[i].x = pg8::cvt_pk_bf16(sa[0], sa[1]); ya[i].y = pg8::cvt_pk_bf16(sa[2], sa[3]); }
        else ya[i] = *(const u32x2*)(ys + (size_t)p0 * D + col);
        if (t1) { f32x4 sb = ld4bf(slab + (size_t)(p1 - trow0) * D + col); for (int sl = 1; sl < nsl; ++sl) sb += ld4bf(slab + ((size_t)sl * trows + (p1 - trow0)) * D + col);
            yb[i].x = pg8::cvt_pk_bf16(sb[0], sb[1]); yb[i].y = pg8::cvt_pk_bf16(sb[2], sb[3]); }
        else yb[i] = *(const u32x2*)(ys + (size_t)p1 * D + col); }
}
__device__ __forceinline__ void fin_store(const float* __restrict__ g2, const float* __restrict__ gfin, float* __restrict__ out, int row, float w0, float w1, int lane, const u32x2 (&x)[8], const u32x2 (&ya)[8], const u32x2 (&yb)[8]) {
    f32x4 v[8]; float ss = 0.f;
#pragma unroll
    for (int i = 0; i < 8; ++i) { const int col = i * 256 + lane * 4; const f32x4 g = *(const f32x4*)(g2 + col);
        const f32x4 xv = (f32x4){__uint_as_float(x[i].x << 16), __uint_as_float(x[i].x & 0xffff0000u), __uint_as_float(x[i].y << 16), __uint_as_float(x[i].y & 0xffff0000u)};
        const f32x4 av = (f32x4){__uint_as_float(ya[i].x << 16), __uint_as_float(ya[i].x & 0xffff0000u), __uint_as_float(ya[i].y << 16), __uint_as_float(ya[i].y & 0xffff0000u)};
        const f32x4 bv = (f32x4){__uint_as_float(yb[i].x << 16), __uint_as_float(yb[i].x & 0xffff0000u), __uint_as_float(yb[i].y << 16), __uint_as_float(yb[i].y & 0xffff0000u)};
#pragma unroll
        for (int j = 0; j < 4; ++j) { v[i][j] = xv[j] + g[j] * (w0 * av[j] + w1 * bv[j]); ss += v[i][j] * v[i][j]; } }
    ss = wave_sum(ss); const float rstd = rsqrtf(ss * (1.0f / D) + EPS);
#pragma unroll
    for (int i = 0; i < 8; ++i) { const int col = i * 256 + lane * 4; const f32x4 g = *(const f32x4*)(gfin + col); f32x4 o;
#pragma unroll
        for (int j = 0; j < 4; ++j) o[j] = v[i][j] * rstd * g[j];
        *(f32x4*)(out + (size_t)row * D + col) = o; }
}
__device__ __forceinline__ void ph_final(const Args& a) {
    const bf16_t* xs = (const bf16_t*)(a.ws + WS_XS); const bf16_t* ys = (const bf16_t*)(a.ws + WS_YS); const int* pos = (const int*)(a.ws + WS_POS); const float* topw = (const float*)(a.ws + WS_TOPW);
    const float* modl = (const float*)(a.ws + WS_MOD) + (size_t)5 * 12288; const float* gfin = a.in[33]; float* out = a.out;
    const int lane = threadIdx.x & 63, wid = threadIdx.x >> 6;
    const int* ctl = (const int*)(a.ws + WS_CTL); const int nsl = ctl[CT_MOES], trow0 = ctl[CT_TROW], trows = ctl[CT_NTILE] * 256 - trow0; const bf16_t* slab = (const bf16_t*)(a.ws + WS_SLAB);
    const int stride = gridDim.x * 8;
    for (int row = blockIdx.x * 8 + wid; row < NLAT; row += 2 * stride) {
        const int rowB = row + stride; const bool hasB = rowB < NLAT;
        const int p0 = pos[row * 2], p1 = pos[row * 2 + 1]; const float w0 = topw[row * 2], w1 = topw[row * 2 + 1];
        const int q0 = hasB ? pos[rowB * 2] : 0, q1 = hasB ? pos[rowB * 2 + 1] : 0; const float u0 = hasB ? topw[rowB * 2] : 0.f, u1 = hasB ? topw[rowB * 2 + 1] : 0.f;
        u32x2 xA[8], xB[8], yaA[8], ybA[8], yaB[8], ybB[8];
        fin_load(xs, ys, slab, row, p0, p1, nsl, trow0, trows, lane, xA, yaA, ybA);
        if (hasB) fin_load(xs, ys, slab, rowB, q0, q1, nsl, trow0, trows, lane, xB, yaB, ybB);
        fin_store(modl + (size_t)tok_mod(row) * 12288 + 10240, gfin, out, row, w0, w1, lane, xA, yaA, ybA);
        if (hasB) fin_store(modl + (size_t)tok_mod(rowB) * 12288 + 10240, gfin, out, rowB, u0, u1, lane, xB, yaB, ybB);
    }
}

typedef float f32x2_t __attribute__((ext_vector_type(2))); typedef __bf16 bf16x2_t __attribute__((ext_vector_type(2)));
__device__ __forceinline__ unsigned cvtpk(float lo, float hi) { f32x2_t v = {lo, hi}; bf16x2_t b = __builtin_convertvector(v, bf16x2_t); return __builtin_bit_cast(unsigned, b); }
#define MFMA32(a, b, c) __builtin_amdgcn_mfma_f32_32x32x16_bf16((a), (b), (c), 0, 0, 0)
constexpr int MLA_KP = 400, MLA_VP = 144, MLA_KB = 64 * MLA_KP, MLA_VB = 128 * MLA_VP, MLA_STAGE = MLA_KB + MLA_VB;
static_assert(2 * MLA_STAGE <= RING_BYTES, "MLA LDS");

__device__ __forceinline__ void ph_mla(const Args& a, bool with_ctx, unsigned char* lds) {
    const bf16_t* __restrict__ Q = (const bf16_t*)(a.ws + WS_Q); const bf16_t* __restrict__ KN = (const bf16_t*)(a.ws + WS_KN); const bf16_t* __restrict__ KPE = (const bf16_t*)(a.ws + WS_KPE);
    const bf16_t* __restrict__ VT = (const bf16_t*)(a.ws + WS_VT); bf16_t* __restrict__ mix = (bf16_t*)(a.ws + WS_MIX);
    int tid_ = threadIdx.x; asm volatile("" : "+v"(tid_));
    const int tid = tid_, lane = tid & 63, w = tid >> 6, qi = lane & 31, hh = lane >> 5;
    const int nunits = with_ctx ? 288 : 256;
    const float c = 0.07216878364870322f * 1.4426950408889634f;
    for (int unit = blockIdx.x; unit < nunits; unit += gridDim.x) {
        int h, b, q0tok, nt; bool ctxq;
        if (unit < 256) { h = unit & 7; b = unit >> 6; q0tok = b * L + ((unit >> 3) & 7) * 256; nt = 36; ctxq = false; }
        else { const int u2 = unit - 256; h = u2 & 7; b = u2 >> 3; q0tok = NLAT + b * C; nt = 4; ctxq = true; }
#define MLA_KTOK(t) (ctxq ? (NLAT + b * C + (t) * 64) : ((t) < 32 ? (b * L + (t) * 64) : (NLAT + b * C + ((t) - 32) * 64)))
        u32x4 r0, r1, r2, r3, r4;
#define MLA_ISSUE_K(t) do { const int kt0_ = MLA_KTOK(t); \
            r0 = *(const u32x4*)(KN + (size_t)(kt0_ + (tid >> 4)) * 1024 + h * 128 + (tid & 15) * 8); \
            r1 = *(const u32x4*)(KN + (size_t)(kt0_ + 32 + (tid >> 4)) * 1024 + h * 128 + (tid & 15) * 8); \
            r2 = *(const u32x4*)(KPE + (size_t)(kt0_ + (tid >> 3)) * 64 + (tid & 7) * 8); } while (0)
#define MLA_ISSUE_V(t) do { const int kt0_ = MLA_KTOK(t); \
            r3 = *(const u32x4*)(VT + (size_t)(h * 128 + (tid >> 3)) * NTOK + kt0_ + (tid & 7) * 8); \
            r4 = *(const u32x4*)(VT + (size_t)(h * 128 + 64 + (tid >> 3)) * NTOK + kt0_ + (tid & 7) * 8); } while (0)
#define MLA_ISSUE(t) do { MLA_ISSUE_K(t); MLA_ISSUE_V(t); } while (0)
#define MLA_COMMIT(buf) do { unsigned char* kb_ = lds + (buf) * MLA_STAGE; unsigned char* vb_ = kb_ + MLA_KB; \
            *(u32x4*)(kb_ + (tid >> 4) * MLA_KP + (tid & 15) * 16) = r0; \
            *(u32x4*)(kb_ + (32 + (tid >> 4)) * MLA_KP + (tid & 15) * 16) = r1; \
            *(u32x4*)(kb_ + (tid >> 3) * MLA_KP + 256 + (tid & 7) * 16) = r2; \
            const int g_ = (tid & 7) >> 1, e_ = tid & 1; \
            { u32x2 lo_, hi_; lo_.x = r3.x; lo_.y = r3.y; hi_.x = r3.z; hi_.y = r3.w; \
              *(u32x2*)(vb_ + (tid >> 3) * MLA_VP + g_ * 32 + e_ * 8) = lo_; *(u32x2*)(vb_ + (tid >> 3) * MLA_VP + g_ * 32 + 16 + e_ * 8) = hi_; } \
            { u32x2 lo_, hi_; lo_.x = r4.x; lo_.y = r4.y; hi_.x = r4.z; hi_.y = r4.w; \
              *(u32x2*)(vb_ + (64 + (tid >> 3)) * MLA_VP + g_ * 32 + e_ * 8) = lo_; *(u32x2*)(vb_ + (64 + (tid >> 3)) * MLA_VP + g_ * 32 + 16 + e_ * 8) = hi_; } } while (0)
        const int qtok = q0tok + w * 32 + qi;
        bf16x8 qf[12];
#pragma unroll
        for (int s = 0; s < 12; ++s) qf[s] = *(const bf16x8*)(Q + (size_t)qtok * QW + h * 192 + s * 16 + hh * 8);
        f32x16 o[4];
#pragma unroll
        for (int d = 0; d < 4; ++d)
#pragma unroll
            for (int r = 0; r < 16; ++r) o[d][r] = 0.f;
        float m = -1.0e30f, l = 0.f;
        MLA_ISSUE(0); MLA_COMMIT(0);
        __syncthreads();
        for (int t = 0; t < nt; ++t) {
            const unsigned char* kb = lds + (t & 1) * MLA_STAGE; const unsigned char* vb = kb + MLA_KB;
            f32x16 s0, s1;
#pragma unroll
            for (int r = 0; r < 16; ++r) { s0[r] = 0.f; s1[r] = 0.f; }
            {
                const unsigned char* kp0 = kb + qi * MLA_KP + hh * 16; const unsigned char* kp1 = kp0 + 32 * MLA_KP;
                bf16x8 ka[4], kn[4];
                ka[0] = *(const bf16x8*)(kp0); ka[1] = *(const bf16x8*)(kp1); ka[2] = *(const bf16x8*)(kp0 + 32); ka[3] = *(const bf16x8*)(kp1 + 32);
#pragma unroll
                for (int g = 0; g < 6; ++g) {
                    if (g < 5) { kn[0] = *(const bf16x8*)(kp0 + (2 * g + 2) * 32); kn[1] = *(const bf16x8*)(kp1 + (2 * g + 2) * 32); kn[2] = *(const bf16x8*)(kp0 + (2 * g + 3) * 32); kn[3] = *(const bf16x8*)(kp1 + (2 * g + 3) * 32); }
                    __builtin_amdgcn_sched_barrier(0);
                    s0 = MFMA32(ka[0], qf[2 * g], s0); s1 = MFMA32(ka[1], qf[2 * g], s1); s0 = MFMA32(ka[2], qf[2 * g + 1], s0); s1 = MFMA32(ka[3], qf[2 * g + 1], s1);
                    __builtin_amdgcn_sched_barrier(0);
#pragma unroll
                    for (int q = 0; q < 4; ++q) ka[q] = kn[q];
                }
            }
            if (t + 1 < nt) MLA_ISSUE(t + 1);
            float mx = fmaxf(s0[0], s1[0]);
#pragma unroll
            for (int r = 1; r < 16; ++r) mx = fmaxf(mx, fmaxf(s0[r], s1[r]));
            mx = fmaxf(mx, __shfl_xor(mx, 32));
            const float mnew = fmaxf(m, mx * c);
            const float alpha = __builtin_amdgcn_exp2f(m - mnew);
            m = mnew;
            float ps = 0.f;
#pragma unroll
            for (int r = 0; r < 16; ++r) { s0[r] = __builtin_amdgcn_exp2f(s0[r] * c - mnew); s1[r] = __builtin_amdgcn_exp2f(s1[r] * c - mnew); ps += s0[r] + s1[r]; }
            l = l * alpha + ps;
            if ((PROBE_SUB >> 9) & 1u) {
                float ps2 = 0.f;
#pragma unroll
                for (int r = 0; r < 16; ++r) { float x0 = s0[r], x1 = s1[r]; asm volatile("" : "+v"(x0), "+v"(x1)); ps2 += __builtin_amdgcn_exp2f(x0 * c - 40.f) + __builtin_amdgcn_exp2f(x1 * c - 40.f); }
                float mx2 = ps2;
#pragma unroll
                for (int r = 0; r < 16; ++r) { float x0 = s0[r], x1 = s1[r]; asm volatile("" : "+v"(x0), "+v"(x1)); mx2 = fmaxf(mx2, fmaxf(x0 * c, x1 * c)); }
                if (mx2 == 123456.75f) l += ps2;
            }
            if ((PROBE_SUB >> 10) & 1u) {
                f32x16 sx;
#pragma unroll
                for (int r = 0; r < 16; ++r) sx[r] = 0.f;
#pragma unroll
                for (int s = 0; s < 12; ++s) { bf16x8 k0 = *(const bf16x8*)(kb + qi * MLA_KP + s * 32 + hh * 16); sx = MFMA32(k0, qf[s], sx); }
                if (sx[0] == 123456.75f) l += sx[1];
            }
#pragma unroll
            for (int d = 0; d < 4; ++d)
#pragma unroll
                for (int r = 0; r < 16; ++r) o[d][r] *= alpha;
            bf16x8 pf[4];
            { u32x4 p;
              p.x = cvtpk(s0[0], s0[1]); p.y = cvtpk(s0[2], s0[3]); p.z = cvtpk(s0[4], s0[5]); p.w = cvtpk(s0[6], s0[7]); pf[0] = __builtin_bit_cast(bf16x8, p);
              p.x = cvtpk(s0[8], s0[9]); p.y = cvtpk(s0[10], s0[11]); p.z = cvtpk(s0[12], s0[13]); p.w = cvtpk(s0[14], s0[15]); pf[1] = __builtin_bit_cast(bf16x8, p);
              p.x = cvtpk(s1[0], s1[1]); p.y = cvtpk(s1[2], s1[3]); p.z = cvtpk(s1[4], s1[5]); p.w = cvtpk(s1[6], s1[7]); pf[2] = __builtin_bit_cast(bf16x8, p);
              p.x = cvtpk(s1[8], s1[9]); p.y = cvtpk(s1[10], s1[11]); p.z = cvtpk(s1[12], s1[13]); p.w = cvtpk(s1[14], s1[15]); pf[3] = __builtin_bit_cast(bf16x8, p); }
            asm volatile("" ::: "memory");
            {
                const unsigned char* vp = vb + qi * MLA_VP + hh * 16;
                bf16x8 va[4], vn[4];
#pragma unroll
                for (int g = 0; g < 4; ++g) va[g] = *(const bf16x8*)(vp + g * 32);
#pragma unroll
                for (int d = 0; d < 4; ++d) {
                    if (d < 3) {
#pragma unroll
                        for (int g = 0; g < 4; ++g) vn[g] = *(const bf16x8*)(vp + (d + 1) * 32 * MLA_VP + g * 32); }
                    __builtin_amdgcn_sched_barrier(0);
#pragma unroll
                    for (int g = 0; g < 4; ++g) o[d] = MFMA32(va[g], pf[g], o[d]);
                    __builtin_amdgcn_sched_barrier(0);
#pragma unroll
                    for (int g = 0; g < 4; ++g) va[g] = vn[g];
                }
            }
            if (t + 1 < nt) MLA_COMMIT((t + 1) & 1);
            __syncthreads();
        }
        const float inv = 1.0f / (l + __shfl_xor(l, 32));
        bf16_t* op = mix + (size_t)qtok * D + h * 128 + 4 * hh;
#pragma unroll
        for (int d = 0; d < 4; ++d)
#pragma unroll
            for (int g = 0; g < 4; ++g) { u32x2 wv; wv.x = cvtpk(o[d][4 * g] * inv, o[d][4 * g + 1] * inv); wv.y = cvtpk(o[d][4 * g + 2] * inv, o[d][4 * g + 3] * inv);
                *(u32x2*)(op + d * 32 + 8 * g) = wv; }
#undef MLA_KTOK
#undef MLA_ISSUE
#undef MLA_ISSUE_K
#undef MLA_ISSUE_V
#undef MLA_COMMIT
    }
}

constexpr int HY_CS = 8224, HY_WS = 5136, HY_WOFF = 8 * HY_CS, HY_RBL = HY_WOFF + 4 * HY_WS;
static_assert(HY_RBL + 516 * 16 <= RING_BYTES, "hyena LDS");

__device__ __forceinline__ u32x4 hy_shift(const u32x4 a, const u32x4 b, int r) {
    switch (r) {
    case 0: return b;
    case 1: return (u32x4){__builtin_amdgcn_alignbyte(b.x, a.w, 2), __builtin_amdgcn_alignbyte(b.y, b.x, 2), __builtin_amdgcn_alignbyte(b.z, b.y, 2), __builtin_amdgcn_alignbyte(b.w, b.z, 2)};
    case 2: return (u32x4){a.w, b.x, b.y, b.z};
    case 3: return (u32x4){__builtin_amdgcn_alignbyte(a.w, a.z, 2), __builtin_amdgcn_alignbyte(b.x, a.w, 2), __builtin_amdgcn_alignbyte(b.y, b.x, 2), __builtin_amdgcn_alignbyte(b.z, b.y, 2)};
    case 4: return (u32x4){a.z, a.w, b.x, b.y};
    case 5: return (u32x4){__builtin_amdgcn_alignbyte(a.z, a.y, 2), __builtin_amdgcn_alignbyte(a.w, a.z, 2), __builtin_amdgcn_alignbyte(b.x, a.w, 2), __builtin_amdgcn_alignbyte(b.y, b.x, 2)};
    case 6: return (u32x4){a.y, a.z, a.w, b.x};
    default: return (u32x4){__builtin_amdgcn_alignbyte(a.y, a.x, 2), __builtin_amdgcn_alignbyte(a.z, a.y, 2), __builtin_amdgcn_alignbyte(a.w, a.z, 2), __builtin_amdgcn_alignbyte(b.x, a.w, 2)};
    }
}

__device__ __forceinline__ void ph_hyena(const Args& a, int l, unsigned char* lds) {
    const bf16_t* __restrict__ RB = (const bf16_t*)(a.ws + WS_FILTL) + (size_t)l * 512 * HY_RBROW;
    const bf16_t* __restrict__ wtl = (const bf16_t*)(a.ws + WS_WTL);
    int tid_ = threadIdx.x; asm volatile("" : "+v"(tid_));
    const int tid = tid_, lane = tid & 63, w = __builtin_amdgcn_readfirstlane(tid >> 6), i = lane & 31, hh = lane >> 5;
    for (int unit = blockIdx.x; unit < 512; unit += gridDim.x) {
        const int c = unit;
        for (int k = tid; k < 515; k += NTHR) { u32x4 v = (u32x4){0u, 0u, 0u, 0u}; if (k < 513) v = *(const u32x4*)(RB + (size_t)c * HY_RBROW + k * 8); *(u32x4*)(lds + HY_RBL + k * 16) = v; }
        for (int k = tid; k < 4 * 321; k += NTHR) { const int b = k / 321, sl = k - b * 321; u32x4 v = (u32x4){0u, 0u, 0u, 0u};
            if (sl >= 28 && sl < 284) v = *(const u32x4*)(wtl + ((size_t)b * 512 + c) * L + (sl - 28) * 8);
            *(u32x4*)(lds + HY_WOFF + b * HY_WS + sl * 16) = v; }
        __syncthreads();
        for (int qs = lane; qs < 511; qs += 64) {
            const u32x4 ca = *(const u32x4*)(lds + HY_RBL + qs * 16), cb = *(const u32x4*)(lds + HY_RBL + qs * 16 + 16);
            *(u32x4*)(lds + w * HY_CS + qs * 16) = hy_shift(ca, cb, w);
        }
        __syncthreads();
        f32x16 acc0, acc1;
#pragma unroll
        for (int r = 0; r < 16; ++r) { acc0[r] = 0.f; acc1[r] = 0.f; }
        const int Tl = i >> 2, b = i & 3;
        const unsigned char* ap = lds + (i & 7) * HY_CS + (hh - (i >> 3) + 255) * 16;
        const unsigned char* bp = lds + HY_WOFF + b * HY_WS + (224 + 16 * (2 * (8 * w + Tl)) + 8 * hh) * 2;
        const int d0 = 16 * w - 127;
#pragma unroll 2
        for (int dd = 0; dd < 142; dd += 2) {
            const int d = d0 + dd;
            const bf16x8 a0 = *(const bf16x8*)(ap - 32 * d), b0 = *(const bf16x8*)(bp - 32 * d);
            const bf16x8 a1 = *(const bf16x8*)(ap - 32 * (d + 1)), b1 = *(const bf16x8*)(bp - 32 * (d + 1));
            acc0 = MFMA32(a0, b0, acc0); acc1 = MFMA32(a1, b1, acc1);
        }
        bf16_t* yt = (bf16_t*)(a.ws + WS_YT) + ((size_t)b * 512 + c) * L + 32 * (8 * w + Tl) + 4 * hh;
#pragma unroll
        for (int g = 0; g < 4; ++g) { u32x2 wv; wv.x = cvtpk(acc0[4 * g] + acc1[4 * g], acc0[4 * g + 1] + acc1[4 * g + 1]); wv.y = cvtpk(acc0[4 * g + 2] + acc1[4 * g + 2], acc0[4 * g + 3] + acc1[4 * g + 3]);
            *(u32x2*)(yt + 8 * g) = wv; }
        __syncthreads();
    }
}

__device__ __forceinline__ void ph_hyena_fin(const Args& a, int l, bool with_ctx, unsigned char* lds) {
    const bf16_t* __restrict__ YT = (const bf16_t*)(a.ws + WS_YT); const bf16_t* __restrict__ wtl = (const bf16_t*)(a.ws + WS_WTL); const bf16_t* __restrict__ wtc = (const bf16_t*)(a.ws + WS_WTC);
    const bf16_t* __restrict__ x0 = (const bf16_t*)(a.ws + WS_X0); const float* skip = a.in[23] + l * 512; bf16_t* __restrict__ mix = (bf16_t*)(a.ws + WS_MIX);
    int tid_ = threadIdx.x; asm volatile("" : "+v"(tid_));
    const int tid = tid_;
    bf16_t* T = (bf16_t*)lds;
    constexpr int TP = 520;
    const int nunits = with_ctx ? 144 : 128;
    for (int unit = (int)gridDim.x - 1 - (int)blockIdx.x; unit < nunits; unit += gridDim.x) {
        const bool lat = unit < 128; const int b = lat ? (unit >> 5) : ((unit - 128) >> 2), t0 = lat ? (unit & 31) * 64 : ((unit - 128) & 3) * 64;
        const int Ls = lat ? L : C; const int tok0 = lat ? b * L + t0 : NLAT + b * C + t0;
        const bf16_t* yrow = (lat ? YT : YT + (size_t)NB * 512 * L) + ((size_t)b * 512 + tid) * Ls + t0;
        const bf16_t* wrow = (lat ? wtl : wtc) + ((size_t)b * 512 + tid) * Ls + t0;
        const float sk = skip[tid];
#pragma unroll
        for (int hf = 0; hf < 2; ++hf) {
            u32x4 yv[4], wv[4];
#pragma unroll
            for (int q = 0; q < 4; ++q) { yv[q] = *(const u32x4*)(yrow + hf * 32 + q * 8); wv[q] = *(const u32x4*)(wrow + hf * 32 + q * 8); }
#pragma unroll
            for (int q = 0; q < 4; ++q) { const unsigned yy[4] = {yv[q].x, yv[q].y, yv[q].z, yv[q].w}, ww[4] = {wv[q].x, wv[q].y, wv[q].z, wv[q].w};
#pragma unroll
                for (int d = 0; d < 4; ++d) { const int t = hf * 32 + q * 8 + 2 * d;
                    T[t * TP + tid] = f2bf(__uint_as_float(yy[d] << 16) + sk * __uint_as_float(ww[d] << 16));
                    T[(t + 1) * TP + tid] = f2bf(__uint_as_float(yy[d] & 0xffff0000u) + sk * __uint_as_float(ww[d] & 0xffff0000u)); } }
        }
        __syncthreads();
#pragma unroll
        for (int j = 0; j < 8; ++j) { const int o = tid + 512 * j, t = o >> 6, cc = (o & 63) * 8;
            const u32x4 tv = *(const u32x4*)(T + t * TP + cc), xv = *(const u32x4*)(x0 + (size_t)(tok0 + t) * 512 + cc);
            const unsigned tt[4] = {tv.x, tv.y, tv.z, tv.w}, xx[4] = {xv.x, xv.y, xv.z, xv.w}; unsigned oo[4];
#pragma unroll
            for (int d = 0; d < 4; ++d) oo[d] = cvtpk(__uint_as_float(tt[d] << 16) * __uint_as_float(xx[d] << 16), __uint_as_float(tt[d] & 0xffff0000u) * __uint_as_float(xx[d] & 0xffff0000u));
            *(u32x4*)(mix + (size_t)(tok0 + t) * D + 1024 + cc) = (u32x4){oo[0], oo[1], oo[2], oo[3]}; }
        __syncthreads();
    }
}

constexpr int SWA_P = 144, SWA_KB = 64 * SWA_P, SWA_STAGE = 2 * SWA_KB;
__device__ __forceinline__ void ph_swa(const Args& a, int l, bool with_ctx, unsigned char* lds) {
    const bf16_t* __restrict__ SQ = (const bf16_t*)(a.ws + WS_SQ); const bf16_t* __restrict__ SK = (const bf16_t*)(a.ws + WS_SK); const bf16_t* __restrict__ SVT = (const bf16_t*)(a.ws + WS_SV);
    const float* sink = a.in[24] + l * 8; bf16_t* __restrict__ mix = (bf16_t*)(a.ws + WS_MIX);
    int tid_ = threadIdx.x; asm volatile("" : "+v"(tid_));
    const int tid = tid_, lane = tid & 63, w = tid >> 6, qi = lane & 31, hh = lane >> 5;
    const int nunits = with_ctx ? 288 : 256;
    const float c = 0.125f * 1.4426950408889634f;
    const int G_ = gridDim.x, bid_ = blockIdx.x;
    for (int it = 0;; ++it) {
        int unit;
        if (G_ == 256) { if (it == 0) unit = bid_; else if (it == 1 && nunits > 256 && bid_ >= 224) unit = 256 + (255 - bid_); else break; }
        else { unit = bid_ + it * G_; if (unit >= nunits) break; }
        int hk, b, p0, nloc, t0loc, q0tok; bool ctxq;
        if (unit < 256) { hk = unit & 1; b = (unit >> 1) & 3; p0 = (unit >> 3) * 64; ctxq = false; q0tok = b * L + p0;
            const int lo = p0 - 128 < 0 ? 0 : p0 - 128, hi = p0 + 192 > L ? L : p0 + 192; t0loc = lo; nloc = (hi - lo) >> 6; }
        else { const int u2 = unit - 256; hk = u2 & 1; b = (u2 >> 1) & 3; p0 = (u2 >> 3) * 64; ctxq = true; q0tok = NLAT + b * C + p0; t0loc = 0; nloc = 0; }
        const int nt = nloc + 4;
#define SWA_KTOK(t) ((t) < nloc ? (b * L + t0loc + (t) * 64) : (NLAT + b * C + ((t) - nloc) * 64))
        u32x4 r0, r1;
#define SWA_ISSUE(t) do { const int kt0_ = SWA_KTOK(t); \
            r0 = *(const u32x4*)(SK + (size_t)(kt0_ + (tid >> 3)) * 128 + hk * 64 + (tid & 7) * 8); \
            r1 = *(const u32x4*)(SVT + (size_t)(hk * 64 + (tid >> 3)) * NTOK + kt0_ + (tid & 7) * 8); } while (0)
#define SWA_COMMIT(buf) do { unsigned char* kb_ = lds + (buf) * SWA_STAGE; unsigned char* vb_ = kb_ + SWA_KB; \
            *(u32x4*)(kb_ + (tid >> 3) * SWA_P + (tid & 7) * 16) = r0; \
            const int g_ = (tid & 7) >> 1, e_ = tid & 1; u32x2 lo_, hi_; lo_.x = r1.x; lo_.y = r1.y; hi_.x = r1.z; hi_.y = r1.w; \
            *(u32x2*)(vb_ + (tid >> 3) * SWA_P + g_ * 32 + e_ * 8) = lo_; *(u32x2*)(vb_ + (tid >> 3) * SWA_P + g_ * 32 + 16 + e_ * 8) = hi_; } while (0)
        const int hq = hk * 4 + (w >> 1), qpos = p0 + (w & 1) * 32 + qi, qtok = q0tok + (w & 1) * 32 + qi;
        bf16x8 qf[4];
#pragma unroll
        for (int s = 0; s < 4; ++s) qf[s] = *(const bf16x8*)(SQ + (size_t)qtok * 512 + hq * 64 + s * 16 + hh * 8);
        f32x16 o[2];
#pragma unroll
        for (int d = 0; d < 2; ++d)
#pragma unroll
            for (int r = 0; r < 16; ++r) o[d][r] = 0.f;
        float m = sink[hq] * 1.4426950408889634f, lsum = hh == 0 ? 1.0f : 0.0f;
        SWA_ISSUE(0); SWA_COMMIT(0);
        __syncthreads();
        for (int t = 0; t < nt; ++t) {
            const unsigned char* kb = lds + (t & 1) * SWA_STAGE; const unsigned char* vb = kb + SWA_KB;
            f32x16 s0, s1;
#pragma unroll
            for (int r = 0; r < 16; ++r) { s0[r] = 0.f; s1[r] = 0.f; }
#pragma unroll
            for (int s = 0; s < 4; ++s) {
                const bf16x8 k0 = *(const bf16x8*)(kb + qi * SWA_P + s * 32 + hh * 16);
                const bf16x8 k1 = *(const bf16x8*)(kb + (32 + qi) * SWA_P + s * 32 + hh * 16);
                s0 = MFMA32(k0, qf[s], s0); s1 = MFMA32(k1, qf[s], s1);
            }
            if (t + 1 < nt) SWA_ISSUE(t + 1);
            if (t < nloc) {
                const int kbase = t0loc + t * 64 + 4 * hh - qpos;
#pragma unroll
                for (int r = 0; r < 16; ++r) { const int dlt = kbase + (r & 3) + 8 * (r >> 2);
                    if (dlt > 128 || dlt < -128) s0[r] = -1.0e30f;
                    if (dlt + 32 > 128 || dlt + 32 < -128) s1[r] = -1.0e30f; }
            }
            float mx = fmaxf(s0[0], s1[0]);
#pragma unroll
            for (int r = 1; r < 16; ++r) mx = fmaxf(mx, fmaxf(s0[r], s1[r]));
            mx = fmaxf(mx, __shfl_xor(mx, 32));
            const float mnew = fmaxf(m, mx * c);
            const float alpha = __builtin_amdgcn_exp2f(m - mnew);
            m = mnew;
            float ps = 0.f;
#pragma unroll
            for (int r = 0; r < 16; ++r) { s0[r] = __builtin_amdgcn_exp2f(s0[r] * c - mnew); s1[r] = __builtin_amdgcn_exp2f(s1[r] * c - mnew); ps += s0[r] + s1[r]; }
            lsum = lsum * alpha + ps;
#pragma unroll
            for (int d = 0; d < 2; ++d)
#pragma unroll
                for (int r = 0; r < 16; ++r) o[d][r] *= alpha;
            bf16x8 pf[4];
            { u32x4 p;
              p.x = cvtpk(s0[0], s0[1]); p.y = cvtpk(s0[2], s0[3]); p.z = cvtpk(s0[4], s0[5]); p.w = cvtpk(s0[6], s0[7]); pf[0] = __builtin_bit_cast(bf16x8, p);
              p.x = cvtpk(s0[8], s0[9]); p.y = cvtpk(s0[10], s0[11]); p.z = cvtpk(s0[12], s0[13]); p.w = cvtpk(s0[14], s0[15]); pf[1] = __builtin_bit_cast(bf16x8, p);
              p.x = cvtpk(s1[0], s1[1]); p.y = cvtpk(s1[2], s1[3]); p.z = cvtpk(s1[4], s1[5]); p.w = cvtpk(s1[6], s1[7]); pf[2] = __builtin_bit_cast(bf16x8, p);
              p.x = cvtpk(s1[8], s1[9]); p.y = cvtpk(s1[10], s1[11]); p.z = cvtpk(s1[12], s1[13]); p.w = cvtpk(s1[14], s1[15]); pf[3] = __builtin_bit_cast(bf16x8, p); }
#pragma unroll
            for (int d = 0; d < 2; ++d)
#pragma unroll
                for (int g = 0; g < 4; ++g) {
                    const bf16x8 vf = *(const bf16x8*)(vb + (d * 32 + qi) * SWA_P + g * 32 + hh * 16);
                    o[d] = MFMA32(vf, pf[g], o[d]);
                }
            if (t + 1 < nt) SWA_COMMIT((t + 1) & 1);
            __syncthreads();
        }
        const float inv = 1.0f / (lsum + __shfl_xor(lsum, 32));
        bf16_t* op = mix + (size_t)qtok * D + 1536 + hq * 64 + 4 * hh;
#pragma unroll
        for (int d = 0; d < 2; ++d)
#pragma unroll
            for (int g = 0; g < 4; ++g) { u32x2 wv; wv.x = cvtpk(o[d][4 * g] * inv, o[d][4 * g + 1] * inv); wv.y = cvtpk(o[d][4 * g + 2] * inv, o[d][4 * g + 3] * inv);
                *(u32x2*)(op + d * 32 + 8 * g) = wv; }
#undef SWA_KTOK
#undef SWA_ISSUE
#undef SWA_COMMIT
    }
}


constexpr int NPHASES = 22;
#define GEMM_CALL(EPI, SCHED, g, S, E) pg8::gemm_phase<EPI, SCHED, true, true, 0>((PG8_LAS unsigned char*)lds, g, S, E)
#define GEMM_CALL8(EPI, SCHED, g, S, E) pg8::gemm_phase<EPI, SCHED, true, true, 1>((PG8_LAS unsigned char*)lds, g, S, E)
#define GEMM_CALLI8(EPI, SCHED, g, S, E) pg8::gemm_phase<EPI, SCHED, true, true, 2>((PG8_LAS unsigned char*)lds, g, S, E)

template <int LYR>
__device__ __forceinline__ void layer_phases(const Args& a, unsigned char* lds, const XcdBarrier& bar, int lo, int hi) {
#define IN(k) (lo <= (k) && (k) < hi)
#define REPS(k) for (int rep_ = 0; rep_ <= (int)((PROBE_MASK >> (k)) & 1u); ++rep_)
#if MK_PER_PHASE
#define SEAM(k) do { } while (0)
#else
#define SEAM(k) do { if (IN(k) && IN((k) + 1)) xcd_barrier(bar); } while (0)
#endif
    constexpr int P0 = 1 + LYR * 9;
    constexpr bool LAST = (LYR == 1);
    constexpr int S_WO = pg8::split_S((LAST ? NLAT : NTOK) / 256 * (D / 256), D / 64, 256);
    constexpr int S_WO0 = pg8::split_S(NTOK / 256 * (D / 256), D / 64, 256);
    constexpr int S_DN0 = pg8::split_S(NTOK / 256 * (D / 256), (FP8_DENSE || FP8_DOWN) ? DFF / 128 : DFF / 64, 256);
    constexpr int S_DN = pg8::split_S(NTOK / 256 * (D / 256), (FP8_DENSE || FP8_DOWN) ? DFF / 128 : DFF / 64, 256);
    const int G = gridDim.x, bid = blockIdx.x;
    unsigned char* ws = a.ws;
    const float* modl = (const float*)(ws + WS_MOD) + (size_t)LYR * 5 * 12288;
    bf16_t* xs = (bf16_t*)(ws + WS_XS);
    const int nq = LAST ? NLAT : NTOK;
    if (IN(P0 + 0)) REPS(P0 + 0) {
        if (LYR == 0) ph_normmod<false, false, I8_WIN ? 2 : 0, 0, false, false>(a.in[0], a.in[2], a.in[6], modl, 0, 2048, (bf16_t*)(ws + WS_HA), NTOK, nullptr, nullptr, nullptr, nullptr, nullptr, nullptr, (float*)(ws + WS_RSC));
        else ph_normmod<false, false, I8_WIN ? 2 : 0, S_DN0>(xs, xs + (size_t)NLAT * D, a.in[6] + D, modl, 0, 2048, (bf16_t*)(ws + WS_HA), NTOK, nullptr, nullptr, nullptr, nullptr,
                                                    (const bf16_t*)(ws + WS_SLAB), (const float*)(ws + WS_MOD) + (size_t)4 * 12288 + 10240, (float*)(ws + WS_RSC));
    }
    SEAM(P0 + 0);
    if (IN(P0 + 1)) REPS(P0 + 1) {
#if I8_WIN
        pg8::Gemm g{(const bf16_t*)(ws + WS_HA), (const bf16_t*)(ws + WS_WIN + (size_t)LYR * UW * D * 2), NTOK, UW, D / 2};
        const float swin = __uint_as_float(__hip_atomic_load((const unsigned*)(ws + WS_CTL) + CT_WSC + LYR, __ATOMIC_RELAXED, __HIP_MEMORY_SCOPE_AGENT)) * (1.0f / 127.0f);
        pg8::EpiStoreI8 E{(bf16_t*)(ws + WS_U), UW, (const float*)(ws + WS_RSC), swin};
        if constexpr (LAST) { pg8::WinLastOrder S; S.init(G, bid, D / 2); GEMM_CALLI8(pg8::EpiStoreI8, pg8::WinLastOrder, g, S, E); }
        else { pg8::StaticOrder S; S.init(NTOK, UW, G, bid, D / 2); GEMM_CALLI8(pg8::EpiStoreI8, pg8::StaticOrder, g, S, E); }
#else
        pg8::Gemm g{(const bf16_t*)(ws + WS_HA), (const bf16_t*)(ws + WS_WIN + (size_t)LYR * UW * D * 2), NTOK, UW, D};
        pg8::EpiStore E{(bf16_t*)(ws + WS_U), UW};
        if constexpr (LAST) { pg8::WinLastOrder S; S.init(G, bid, D); GEMM_CALL(pg8::EpiStore, pg8::WinLastOrder, g, S, E); }
        else { pg8::StaticOrder S; if (G == 256) S.init(NTOK, UW, G1_GEMM, bid < G1_GEMM ? bid : (1 << 24), D); else S.init(NTOK, UW, G, bid, D); GEMM_CALL(pg8::EpiStore, pg8::StaticOrder, g, S, E); }
#endif
        if (!LAST && rep_ == 0 && G == 256 && bid >= TAIL1_BLK0) {
            const int f0 = bid < G1_GEMM ? NCONV_Q + (bid - TAIL1_BLK0) * TAILQ1 : NCONV_Q + TAIL1_N * TAILQ1 + (bid - G1_GEMM) * CQ1;
            ph_convert<0>(a, (float*)lds, f0, 1, f0 + (bid < G1_GEMM ? TAILQ1 : CQ1)); }
        conv_fill(a, (float*)lds, LYR * 6 + 0);
    }
    SEAM(P0 + 1);
    if (IN(P0 + 2)) REPS(P0 + 2) ph_mid(a, LYR);
    SEAM(P0 + 2);
    if (IN(P0 + 3)) REPS(P0 + 3) {
        SUBREP(0) {
        { pg8::Gemm g{(const bf16_t*)(ws + WS_CQN), (const bf16_t*)(ws + WS_WQ + (size_t)LYR * QW * 768 * 2), nq, QW, 768};
          pg8::StaticOrder S; S.init(nq, QW, G, bid, 768); pg8::EpiQ E{(bf16_t*)(ws + WS_Q), (const float*)(ws + WS_ROPE), (const float*)(ws + WS_ROPE) + 2048 * 32};
          GEMM_CALL(pg8::EpiQ, pg8::StaticOrder, g, S, E); }
        __syncthreads();
        { pg8::Gemm g{(const bf16_t*)(ws + WS_CKVN), (const bf16_t*)(ws + WS_WKV + (size_t)LYR * KVW * 512 * 2), NTOK, 1024, 512};
          pg8::StaticOrder S; S.init(NTOK, 1024, G, bid, 512); pg8::EpiStore E{(bf16_t*)(ws + WS_KN), 1024};
          GEMM_CALL(pg8::EpiStore, pg8::StaticOrder, g, S, E); }
        __syncthreads();
        { pg8::Gemm g{(const bf16_t*)(ws + WS_WKV + (size_t)LYR * KVW * 512 * 2 + (size_t)1024 * 512 * 2), (const bf16_t*)(ws + WS_CKVN), 1024, NTOK, 512};
          pg8::StaticOrder S; S.init(1024, NTOK, 108, bid >= 216 ? bid - 216 : (bid >= 144 ? bid - 108 : (1 << 24)), 512); pg8::EpiStore E{(bf16_t*)(ws + WS_VT), NTOK};
          GEMM_CALL(pg8::EpiStore, pg8::StaticOrder, g, S, E); }
        __syncthreads();
        }
        SUBREP(1) ph_hyena(a, LYR, lds);
        SUBREP(3) if (!LAST) ph_hyena_naive<C>(a, LYR, (float*)lds);
        SUBREP(2) ph_swa(a, LYR, !LAST, lds);
        conv_fill(a, (float*)lds, LYR * 6 + 1);
    }
    SEAM(P0 + 3);
    if (IN(P0 + 4)) REPS(P0 + 4) { ph_hyena_fin(a, LYR, !LAST, lds); ph_mla(a, !LAST, lds);
        if (!LAST && rep_ == 0 && G == 256 && bid >= TAIL4_BLK0 && TAILQ4 > 0) ph_convert<0>(a, (float*)lds, NCONV_Q + NCONV_T1 + NCONV_T2 + NCONV_T3 + (bid - TAIL4_BLK0) * TAILQ4, 1, NCONV_Q + NCONV_T1 + NCONV_T2 + NCONV_T3 + (bid - TAIL4_BLK0 + 1) * TAILQ4); conv_fill(a, (float*)lds, LYR * 6 + 2); }
    SEAM(P0 + 4);
    if (IN(P0 + 5)) REPS(P0 + 5) {
        pg8::Gemm g{(const bf16_t*)(ws + WS_MIX), (const bf16_t*)(ws + WS_WOUT + (size_t)LYR * D * D * 2), nq, D, D};
        pg8::SplitOrder S; S.init(nq / 256, D / 256, G, bid, D, S_WO);
        const int trow0 = S.nfull / S.nN * 256; pg8::EpiResid E{rep_ ? (bf16_t*)(ws + WS_ACT) : xs, LYR == 0 ? a.in[0] : (const float*)nullptr, modl + 4096, (bf16_t*)(ws + WS_SLAB), trow0, nq - trow0, 1.0f};
        GEMM_CALL(pg8::EpiResid, pg8::SplitOrder, g, S, E);
        conv_fill(a, (float*)lds, LYR * 6 + 3);
    }
    SEAM(P0 + 5);
    if (!LAST) {
#if !FP8_DENSE
        if (IN(P0 + 6)) { ph_normmod<false, true, I8_GU ? 2 : 0, S_WO0, true, false>(xs, a.in[2], a.in[7], modl, 6144, 8192, (bf16_t*)(ws + WS_HA), NTOK, xs, nullptr, nullptr, nullptr, (const bf16_t*)(ws + WS_SLAB), modl + (size_t)4 * 12288 + 4096, (float*)(ws + WS_RSC));
            conv_finish(a, (float*)lds, CONV_DENSE_END); }
        SEAM(P0 + 6);
        if (IN(P0 + 7)) REPS(P0 + 7) {
#if I8_GU
            pg8::Gemm g{(const bf16_t*)(ws + WS_HA), (const bf16_t*)(ws + WS_WGU), NTOK, 2 * DFF, D / 2};
            pg8::StaticOrder S; if (G == 256) S.init(NTOK, 2 * DFF, G2_GEMM, bid < G2_GEMM ? bid : (1 << 24), D / 2); else S.init(NTOK, 2 * DFF, G, bid, D / 2);
            const float swg = __uint_as_float(__hip_atomic_load((const unsigned*)(ws + WS_CTL) + CT_WSC + 2, __ATOMIC_RELAXED, __HIP_MEMORY_SCOPE_AGENT)) * (1.0f / 127.0f);
            const float swu = __uint_as_float(__hip_atomic_load((const unsigned*)(ws + WS_CTL) + CT_WSC + 3, __ATOMIC_RELAXED, __HIP_MEMORY_SCOPE_AGENT)) * (1.0f / 127.0f);
            pg8::EpiSwiGLUI8 E{(unsigned char*)(ws + WS_ACT), DFF, (const float*)(ws + WS_RSC), swg, swu, ASCALE};
            GEMM_CALLI8(pg8::EpiSwiGLUI8, pg8::StaticOrder, g, S, E);
            if (rep_ == 0 && G == 256 && bid >= TAIL2_BLK0) {
                const int f0 = bid < G2_GEMM ? NCONV_Q + NCONV_T1 + (bid - TAIL2_BLK0) * TAILQ2 : NCONV_Q + NCONV_T1 + TAIL2_N * TAILQ2 + (bid - G2_GEMM) * CQ2;
                ph_convert<0>(a, (float*)lds, f0, 1, f0 + (bid < G2_GEMM ? TAILQ2 : CQ2)); }
#elif FP8_DOWN
            pg8::Gemm g{(const bf16_t*)(ws + WS_HA), (const bf16_t*)(ws + WS_WGU), NTOK, 2 * DFF, D};
            pg8::StaticOrder S; S.init(NTOK, 2 * DFF, G, bid, D);
            pg8::EpiSwiGLU8 E{(unsigned char*)(ws + WS_ACT), DFF, 1.0f, ASCALE};
            GEMM_CALL(pg8::EpiSwiGLU8, pg8::StaticOrder, g, S, E);
#else
            pg8::Gemm g{(const bf16_t*)(ws + WS_HA), (const bf16_t*)(ws + WS_WGU), NTOK, 2 * DFF, D};
            pg8::StaticOrder S; S.init(NTOK, 2 * DFF, G, bid, D);
            pg8::EpiSwiGLU E{(bf16_t*)(ws + WS_ACT), DFF};
            GEMM_CALL(pg8::EpiSwiGLU, pg8::StaticOrder, g, S, E);
#endif
            conv_fill(a, (float*)lds, 4);
        }
        SEAM(P0 + 7);
        if (IN(P0 + 8)) REPS(P0 + 8) {
#if FP8_DOWN
            pg8::Gemm g{(const bf16_t*)(ws + WS_ACT), (const bf16_t*)(ws + WS_WDN), NTOK, D, DFF / 2};
            pg8::SplitOrder S; S.init(NTOK / 256, D / 256, G, bid, DFF / 2, S_DN);
            const int trow0 = S.nfull / S.nN * 256; pg8::EpiResid E{rep_ ? (bf16_t*)(ws + WS_YS) : xs, (const float*)nullptr, modl + 10240, (bf16_t*)(ws + WS_SLAB), trow0, NTOK - trow0, 1.0f / (ASCALE * WSCALE)};
            GEMM_CALL8(pg8::EpiResid, pg8::SplitOrder, g, S, E);
            if (rep_ == 0 && G == 256 && bid >= TAIL3_BLK0 && TAILQ3 > 0) ph_convert<0>(a, (float*)lds, NCONV_Q + NCONV_T1 + NCONV_T2 + (bid - TAIL3_BLK0) * TAILQ3, 1, NCONV_Q + NCONV_T1 + NCONV_T2 + (bid - TAIL3_BLK0 + 1) * TAILQ3);
#else
            pg8::Gemm g{(const bf16_t*)(ws + WS_ACT), (const bf16_t*)(ws + WS_WDN), NTOK, D, DFF};
            pg8::SplitOrder S; S.init(NTOK / 256, D / 256, G, bid, DFF, S_DN);
            const int trow0 = S.nfull / S.nN * 256; pg8::EpiResid E{rep_ ? (bf16_t*)(ws + WS_YS) : xs, (const float*)nullptr, modl + 10240, (bf16_t*)(ws + WS_SLAB), trow0, NTOK - trow0, 1.0f};
            GEMM_CALL(pg8::EpiResid, pg8::SplitOrder, g, S, E);
#endif
            conv_fill(a, (float*)lds, 5);
        }
#else
        if (IN(P0 + 6)) { ph_normmod<false, true, true, S_WO0, true, false>(xs, a.in[2], a.in[7], modl, 6144, 8192, (bf16_t*)(ws + WS_HA), NTOK, xs, nullptr, nullptr, nullptr, (const bf16_t*)(ws + WS_SLAB), modl + (size_t)4 * 12288 + 4096);
            conv_finish(a, (float*)lds, CONV_DENSE_END); }
        SEAM(P0 + 6);
        if (IN(P0 + 7)) REPS(P0 + 7) {
            pg8::Gemm g{(const bf16_t*)(ws + WS_HA), (const bf16_t*)(ws + WS_WGU), NTOK, 2 * DFF, D / 2};
            pg8::StaticOrder S; S.init(NTOK, 2 * DFF, G, bid, D / 2); pg8::EpiSwiGLU8 E{(unsigned char*)(ws + WS_ACT), DFF, 1.0f / (ASCALE * WSCALE), ASCALE};
            GEMM_CALL8(pg8::EpiSwiGLU8, pg8::StaticOrder, g, S, E);
            conv_fill(a, (float*)lds, 4);
        }
        SEAM(P0 + 7);
        if (IN(P0 + 8)) REPS(P0 + 8) {
            pg8::Gemm g{(const bf16_t*)(ws + WS_ACT), (const bf16_t*)(ws + WS_WDN), NTOK, D, DFF / 2};
            pg8::SplitOrder S; S.init(NTOK / 256, D / 256, G, bid, DFF / 2, S_DN);
            const int trow0 = S.nfull / S.nN * 256; pg8::EpiResid E{rep_ ? (bf16_t*)(ws + WS_YS) : xs, (const float*)nullptr, modl + 10240, (bf16_t*)(ws + WS_SLAB), trow0, NTOK - trow0, 1.0f / (ASCALE * WSCALE)};
            GEMM_CALL8(pg8::EpiResid, pg8::SplitOrder, g, S, E);
            conv_fill(a, (float*)lds, 5);
        }
#endif
        SEAM(P0 + 8);
    } else {
        if (IN(P0 + 6)) REPS(P0 + 6) ph_normmod<true, false, true>(xs, xs + (size_t)NLAT * D, a.in[7] + D, modl, 6144, 8192, (bf16_t*)(ws + WS_HA), NLAT, nullptr, a.in[29], (int*)(ws + WS_TOPI), (float*)(ws + WS_TOPW), nullptr, nullptr, nullptr, (float*)lds);
        SEAM(P0 + 6);
        if (IN(P0 + 7)) REPS(P0 + 7) { ph_route_gather(a, (int*)lds); conv_finish(a, (float*)lds, NCONV); }
        SEAM(P0 + 7);
        if (IN(P0 + 9)) REPS(P0 + 9) {
            pg8::Gemm g{(const bf16_t*)(ws + WS_HBS), (const bf16_t*)(ws + WS_MGU), MOE_ROWS, 2 * DFE, D / 2};
            pg8::MoeOrder S; S.init((const int*)(ws + WS_CTL), 2 * DFE / 256, G, bid, (size_t)2 * DFE * D, D / 2); pg8::EpiSwiGLU8 E{(rep_ && ((PROBE_SUB >> 12) & 1u)) ? nullptr : (unsigned char*)(ws + WS_ACT), DFE, 1.0f / (ASCALE * WSCALE), ASCALE};
            GEMM_CALL8(pg8::EpiSwiGLU8, pg8::MoeOrder, g, S, E);
        }
        SEAM(P0 + 9);
        if (IN(P0 + 10)) REPS(P0 + 10) {
            pg8::Gemm g{(const bf16_t*)(ws + WS_ACT), (const bf16_t*)(ws + WS_MDN), MOE_ROWS, D, DFE / 2};
            pg8::SplitOrder S; S.init_moe((const int*)(ws + WS_CTL), D / 256, G, bid, DFE / 2, (size_t)D * DFE);
            const int trow0 = S.nfull / S.nN * 256; pg8::EpiYs E{(bf16_t*)(ws + WS_YS), (bf16_t*)(ws + WS_SLAB), trow0, S.nM * 256 - trow0, 1.0f / (ASCALE * WSCALE)};
            GEMM_CALL8(pg8::EpiYs, pg8::SplitOrder, g, S, E);
        }
        SEAM(P0 + 10);
        if (IN(P0 + 11)) REPS(P0 + 11) ph_final(a);
    }
#undef IN
#undef SEAM
#undef REPS
}

__global__ void __launch_bounds__(NTHR, 2) mk_fwd(Args a) {
    extern __shared__ __attribute__((aligned(16))) unsigned char lds[];
    const int tid = threadIdx.x;
    for (int u = tid; u < (LDS_BYTES - LDSCTL_OFF) / 4; u += NTHR) ((unsigned*)(lds + LDSCTL_OFF))[u] = 0u;
    __syncthreads();
    XcdBarrier bar; bar.bar = (unsigned*)(a.ws + WS_CTL) + CW_BAR; bar.x = 0; bar.st = nullptr;
#if !MK_PER_PHASE
    bar = xcd_barrier_post((unsigned*)(a.ws + WS_CTL) + CW_BAR, (volatile LAS unsigned*)(lds + LDSCTL_OFF + 32));
#endif
    const int lo = a.ph_lo, hi = a.ph_hi;
    if (lo <= 0 && 0 < hi) {
        for (int rep_ = 0; rep_ <= (int)(PROBE_MASK & 1u); ++rep_) { ph_prologue(a, (float*)lds); __syncthreads(); }
#if !MK_PER_PHASE
        if (1 < hi) xcd_barrier(bar);
#endif
    }
    layer_phases<0>(a, lds, bar, lo, hi);
    layer_phases<1>(a, lds, bar, lo, hi);
}

extern "C" void kernel_launch(void* const* d_in, const int* in_sizes, int n_in, void* d_out, int out_size, void* d_ws, size_t ws_size, hipStream_t stream) {
    (void)in_sizes; (void)out_size;
    static int grid = 0;
    if (grid == 0) {
        if (n_in != 34 || ws_size < WS_END) { fprintf(stderr, "kernel_launch: need 34 inputs and >= %zu bytes of workspace (got %d, %zu)\n", (size_t)WS_END, n_in, ws_size); grid = -1; return; }
        int dev = 0, cus = 0, per_cu = 0;
        if (hipGetDevice(&dev) != hipSuccess || hipDeviceGetAttribute(&cus, hipDeviceAttributeMultiprocessorCount, dev) != hipSuccess) { grid = -1; return; }
        if (hipFuncSetAttribute((const void*)mk_fwd, hipFuncAttributeMaxDynamicSharedMemorySize, LDS_BYTES) != hipSuccess) { fprintf(stderr, "kernel_launch: hipFuncSetAttribute failed\n"); grid = -1; return; }
        if (hipOccupancyMaxActiveBlocksPerMultiprocessor(&per_cu, (const void*)mk_fwd, NTHR, LDS_BYTES) != hipSuccess || per_cu < 1) { fprintf(stderr, "kernel_launch: occupancy query says %d blocks per CU\n", per_cu); }
        (void)hipGetLastError();
        grid = cus;
    }
    if (grid < 0) return;
    if (hipMemsetAsync((char*)d_ws + WS_CTL, 0, CTL_ZERO_BYTES, stream) != hipSuccess) return;
    Args a{};
    for (int i = 0; i < 34; ++i) a.in[i] = (const float*)d_in[i];
    a.out = (float*)d_out; a.ws = (unsigned char*)d_ws;
#if MK_PER_PHASE
    for (int p = 0; p < NPHASES; ++p) { a.ph_lo = p; a.ph_hi = p + 1; hipLaunchKernelGGL(mk_fwd, dim3(grid), dim3(NTHR), LDS_BYTES, stream, a); }
#else
    a.ph_lo = 0; a.ph_hi = NPHASES;
    hipLaunchKernelGGL(mk_fwd, dim3(grid), dim3(NTHR), LDS_BYTES, stream, a);
#endif
}
```
